# Optimizing an MI355X kernel written in HIP

```python
import jax, jax.numpy as jnp
from jax import lax
import numpy as np

D_MODEL = 1024
BATCH = 4
SEQ = 4096
DEPTH = 2

GRID_W = 64
CTX_LEN = 256
EPS = 1e-6
GLA_HEADS = 4
GLA_DK = D_MODEL // (2 * GLA_HEADS)
GLA_DV = D_MODEL // GLA_HEADS
GLA_QK = GLA_HEADS * GLA_DK
GLA_V = GLA_HEADS * GLA_DV
GLA_LOWRANK = 16
GLA_TAU = 16.0
GLA_CHUNK = 64
SC_WIDTH = D_MODEL
SC_CONV = 3
RG_WIDTH = 2 * D_MODEL
RG_BLOCKS = 16
RG_BLOCK_W = RG_WIDTH // RG_BLOCKS
RG_C = 8.0
RG_CONV = 4

EVEN_SIZES = (GLA_QK, GLA_QK, GLA_V, GLA_V, GLA_LOWRANK, GLA_LOWRANK,
              SC_WIDTH, SC_WIDTH, SC_WIDTH, SC_WIDTH)
EVEN_IN = 2 * GLA_QK + 2 * GLA_V + 2 * GLA_LOWRANK + 4 * SC_WIDTH
EVEN_OUT = GLA_V + SC_WIDTH

kernel_name = "hybrid_gla_shortconv_rglru_prefix_dit"


def _rmsnorm(x, g):
    xf = x.astype(jnp.float32)
    y = xf * lax.rsqrt(jnp.mean(xf * xf, axis=-1, keepdims=True) + EPS)
    return (y * g.astype(jnp.float32)).astype(x.dtype)


def _modulate(x, g, shift, scale):
    return _rmsnorm(x, g) * (1 + scale) + shift


def _split_cols(p, sizes):
    out, off = [], 0
    for s in sizes:
        out.append(p[..., off:off + s])
        off += s
    return out


def _conv3_centered(x, w):
    n = x.shape[-2]
    pad = [(0, 0)] * (x.ndim - 2) + [(1, 1), (0, 0)]
    xp = jnp.pad(x, pad)
    return w[0] * xp[..., 0:n, :] + w[1] * xp[..., 1:n + 1, :] + w[2] * xp[..., 2:n + 2, :]


def _conv4_directional(x, w, b, reverse):
    if reverse:
        x = jnp.flip(x, 1)
    length = x.shape[1]
    xp = jnp.pad(x, ((0, 0), (RG_CONV - 1, 0), (0, 0)))
    y = b
    for j in range(RG_CONV):
        y = y + w[j] * xp[:, j:j + length]
    return jnp.flip(y, 1) if reverse else y


def _gla_direction(q, k, v, log_g, s0):
    bsz, length, heads, _ = q.shape
    dv = v.shape[-1]
    n = length // GLA_CHUNK

    def chunks(t):
        return t.reshape(bsz, n, GLA_CHUNK, heads, t.shape[-1])

    q, k, v, log_g = chunks(q), chunks(k), chunks(v), chunks(log_g)
    b = jnp.cumsum(log_g, axis=2)
    b_last = b[:, :, -1:]
    q_in = q * jnp.exp(b)
    k_in = k * jnp.exp(-b)
    scores = jnp.einsum("bnthk,bnshk->bnhts", q_in, k_in)
    mask = jnp.tril(jnp.ones((GLA_CHUNK, GLA_CHUNK), dtype=bool))
    scores = jnp.where(mask, scores, 0.0)
    o_intra = jnp.einsum("bnhts,bnshv->bnthv", scores, v)
    k_end = k * jnp.exp(b_last - b)
    incr = jnp.einsum("bnshk,bnshv->bnhkv", k_end, v)
    decay = jnp.exp(b_last[:, :, 0])

    def step(state, inp):
        d, u = inp
        return d[..., None] * state + u, state

    s_final, s_prev = lax.scan(step, s0, (jnp.moveaxis(decay, 1, 0), jnp.moveaxis(incr, 1, 0)))
    o_inter = jnp.einsum("bnthk,nbhkv->bnthv", q_in, s_prev)
    return (o_intra + o_inter).reshape(bsz, length, heads, dv), s_final


def _even_branch(h, s0_f, s0_b, on_grid, need_out, w_in, w_a2, b_a2, gla_g, conv_w):
    f32 = jnp.float32
    bsz, length, _ = h.shape
    p = h @ w_in
    q, k, v, g_a, a_f, a_b, c_b, c_c, c_x, g_b = _split_cols(p, EVEN_SIZES)
    q = q.reshape(bsz, length, GLA_HEADS, GLA_DK).astype(f32) * (GLA_DK ** -0.5)
    k = k.reshape(bsz, length, GLA_HEADS, GLA_DK).astype(f32)
    v = v.reshape(bsz, length, GLA_HEADS, GLA_DV).astype(f32)

    def log_gate(a_lr, d):
        z = a_lr.astype(f32) @ w_a2[d].astype(f32) + b_a2[d].astype(f32)
        return (jax.nn.log_sigmoid(z) / GLA_TAU).reshape(bsz, length, GLA_HEADS, GLA_DK)

    o_f, s_f = _gla_direction(q, k, v, log_gate(a_f, 0), s0_f)
    fl = lambda t: jnp.flip(t, 1)
    o_b, s_b = _gla_direction(fl(q), fl(k), fl(v), fl(log_gate(a_b, 1)), s0_b)
    if not need_out:
        return None, s_f, s_b
    o = _rmsnorm(o_f + fl(o_b), gla_g).reshape(bsz, length, GLA_V).astype(h.dtype)
    o = o * jax.nn.silu(g_a)
    z = c_c * c_x
    if on_grid:
        rows = length // GRID_W
        zc = _conv3_centered(z.reshape(bsz, rows, GRID_W, SC_WIDTH), conv_w).reshape(bsz, length, SC_WIDTH)
    else:
        zc = _conv3_centered(z, conv_w)
    y = c_b * zc * jax.nn.silu(g_b)
    return jnp.concatenate([o, y], axis=-1), s_f, s_b


def _lin_combine(e1, e2):
    a1, b1 = e1
    a2, b2 = e2
    return a1 * a2, a2 * b1 + b2


def _rglru_direction(xr, conv_w, conv_b, w_a, b_a, w_x, b_x, lam, h0, reverse):
    f32 = jnp.float32
    xc = _conv4_directional(xr.astype(f32), conv_w.astype(f32), conv_b.astype(f32), reverse)
    bsz, length, _ = xc.shape
    blk = xc.reshape(bsz, length, RG_BLOCKS, RG_BLOCK_W)
    r = jax.nn.sigmoid(jnp.einsum("blni,nij->blnj", blk, w_a.astype(f32)) + b_a.astype(f32))
    i = jax.nn.sigmoid(jnp.einsum("blni,nij->blnj", blk, w_x.astype(f32)) + b_x.astype(f32))
    r = r.reshape(bsz, length, RG_WIDTH)
    i = i.reshape(bsz, length, RG_WIDTH)
    log_a = -RG_C * r * jax.nn.softplus(-lam.astype(f32))
    a = jnp.exp(log_a)
    u = jnp.sqrt(-jnp.expm1(2.0 * log_a)) * (i * xc)
    a_cum, hs = lax.associative_scan(_lin_combine, (a, u), reverse=reverse, axis=1)
    hs = hs + a_cum * h0[:, None, :]
    fin = hs[:, 0] if reverse else hs[:, -1]
    return hs, fin


def _odd_branch(h, h0_f, h0_b, need_out, w_in, conv_w, conv_b, w_a, b_a, w_x, b_x, lam):
    xr = h @ w_in[:, :RG_WIDTH]
    h_f, fin_f = _rglru_direction(xr, conv_w[0], conv_b[0], w_a[0], b_a[0], w_x[0], b_x[0], lam[0], h0_f, False)
    h_b, fin_b = _rglru_direction(xr, conv_w[1], conv_b[1], w_a[1], b_a[1], w_x[1], b_x[1], lam[1], h0_b, True)
    if not need_out:
        return None, fin_f, fin_b
    gate = h @ w_in[:, RG_WIDTH:]
    y = (h_f + h_b).astype(h.dtype) * jax.nn.silu(gate)
    return y, fin_f, fin_b


def setup_inputs(seed: int = 0) -> dict:
    key = jax.random.key(seed)
    ks = jax.random.split(key, 32)
    n_even = (DEPTH + 1) // 2
    n_odd = DEPTH // 2
    nrm = lambda k, shape, s: jax.random.normal(k, shape, jnp.float32) * s
    a8 = jax.random.uniform(ks[22], (n_odd, 2, RG_WIDTH), jnp.float32, minval=0.9, maxval=0.999)
    s = a8 ** (1.0 / RG_C)
    lam = jnp.log(s) - jnp.log1p(-s)
    return {
        "x": nrm(ks[0], (BATCH, SEQ, D_MODEL), 1.0),
        "c": nrm(ks[1], (BATCH, D_MODEL), 1.0),
        "ctx": nrm(ks[2], (BATCH, CTX_LEN, D_MODEL), 1.0),
        "c_ctx": nrm(ks[3], (D_MODEL,), 1.0),
        "norm_g": 1.0 + nrm(ks[4], (DEPTH, D_MODEL), 0.02),
        "w_mod": nrm(ks[5], (DEPTH, D_MODEL, 3 * D_MODEL), 0.5 * D_MODEL ** -0.5),
        "b_mod": nrm(ks[6], (DEPTH, 3 * D_MODEL), 0.02),
        "e_w_in": nrm(ks[7], (n_even, D_MODEL, EVEN_IN), D_MODEL ** -0.5),
        "e_w_a2": nrm(ks[8], (n_even, 2, GLA_LOWRANK, GLA_QK), GLA_LOWRANK ** -0.5),
        "e_b_a2": nrm(ks[9], (n_even, 2, GLA_QK), 0.1),
        "e_gla_g": 1.0 + nrm(ks[10], (n_even, GLA_DV), 0.02),
        "e_conv_w": nrm(ks[11], (n_even, SC_CONV, SC_WIDTH), SC_CONV ** -0.5),
        "e_w_out": nrm(ks[12], (n_even, EVEN_OUT, D_MODEL), EVEN_OUT ** -0.5),
        "o_w_in": nrm(ks[13], (n_odd, D_MODEL, 2 * RG_WIDTH), D_MODEL ** -0.5),
        "o_conv_w": nrm(ks[14], (n_odd, 2, RG_CONV, RG_WIDTH), RG_CONV ** -0.5),
        "o_conv_b": nrm(ks[15], (n_odd, 2, RG_WIDTH), 0.02),
        "o_w_a": nrm(ks[16], (n_odd, 2, RG_BLOCKS, RG_BLOCK_W, RG_BLOCK_W), RG_BLOCK_W ** -0.5),
        "o_b_a": nrm(ks[17], (n_odd, 2, RG_BLOCKS, RG_BLOCK_W), 0.02),
        "o_w_x": nrm(ks[18], (n_odd, 2, RG_BLOCKS, RG_BLOCK_W, RG_BLOCK_W), RG_BLOCK_W ** -0.5),
        "o_b_x": nrm(ks[19], (n_odd, 2, RG_BLOCKS, RG_BLOCK_W), 0.02),
        "o_lam": lam,
        "o_w_out": nrm(ks[20], (n_odd, RG_WIDTH, D_MODEL), RG_WIDTH ** -0.5),
        "final_g": 1.0 + nrm(ks[21], (D_MODEL,), 0.02),
    }


def reference(x, c, ctx, c_ctx, norm_g, w_mod, b_mod, e_w_in, e_w_a2, e_b_a2, e_gla_g,
              e_conv_w, e_w_out, o_w_in, o_conv_w, o_conv_b, o_w_a, o_b_a, o_w_x, o_b_x,
              o_lam, o_w_out, final_g):
    bsz = x.shape[0]
    s_c = jax.nn.silu(c)
    s_cc = jax.nn.silu(c_ctx)
    x_ctx = ctx
    for li in range(DEPTH):
        last = li == DEPTH - 1
        mod = s_c @ w_mod[li] + b_mod[li]
        shift, scale, gate = jnp.split(mod[:, None, :], 3, axis=-1)
        mod_c = s_cc @ w_mod[li] + b_mod[li]
        shift_c, scale_c, gate_c = jnp.split(mod_c, 3, axis=-1)
        h = _modulate(x, norm_g[li], shift, scale)
        h_c = _modulate(x_ctx, norm_g[li], shift_c, scale_c)
        if li % 2 == 0:
            j = li // 2
            prm = (e_w_in[j], e_w_a2[j], e_b_a2[j], e_gla_g[j], e_conv_w[j])
            s0 = jnp.zeros((bsz, GLA_HEADS, GLA_DK, GLA_DV), jnp.float32)
            y_c, s_f, s_b = _even_branch(h_c, s0, s0, False, not last, *prm)
            y, _, _ = _even_branch(h, s_f, s_b, True, True, *prm)
            w_out = e_w_out[j]
        else:
            j = li // 2
            prm = (o_w_in[j], o_conv_w[j], o_conv_b[j], o_w_a[j], o_b_a[j], o_w_x[j], o_b_x[j], o_lam[j])
            h0 = jnp.zeros((bsz, RG_WIDTH), jnp.float32)
            y_c, h_f, h_b = _odd_branch(h_c, h0, h0, not last, *prm)
            y, _, _ = _odd_branch(h, h_f, h_b, True, *prm)
            w_out = o_w_out[j]
        x = x + gate * (y @ w_out)
        if not last:
            x_ctx = x_ctx + gate_c * (y_c @ w_out)
    return _rmsnorm(x, final_g)
```

```cpp
#include <hip/hip_runtime.h>
#include <cstdio>
#include <cstdint>

typedef unsigned short bf16_t;
#define DEVI __device__ __forceinline__

constexpr int D = 1024, NB = 4, SEQ = 4096, CTXL = 256;
constexpr int NLAT = NB * SEQ;
constexpr int NCTX = NB * CTXL;
constexpr int NT = NLAT + NCTX;
constexpr int NCH = 68;
constexpr int EVEN_IN = 7200;
constexpr int N1 = 7424;
constexpr int N1A = 13 * 256;
constexpr int RGW = 2048;
constexpr float EPS = 1e-6f;

constexpr size_t MiB = 1u << 20;
constexpr size_t WS_CTL = 0;
constexpr size_t WS_MOD = 1 * MiB;
constexpr size_t WS_ALR = 2 * MiB;
constexpr size_t WS_X1C = 5 * MiB;
constexpr size_t WS_SUMA = 9 * MiB;
constexpr size_t WS_SUMH = 9 * MiB + 4608 * 1024;
constexpr size_t WS_DEC = 18 * MiB;
constexpr size_t WS_BT1 = 19 * MiB + 512 * 1024;
constexpr size_t WS_BT2 = 34 * MiB;
constexpr size_t WS_BT3 = 38 * MiB;
constexpr size_t WS_BT4 = 46 * MiB;
constexpr size_t WS_BD = 50 * MiB;
constexpr size_t WS_S0 = 52 * MiB;
constexpr size_t SLOT = 34 * MiB;
constexpr size_t WS_END = WS_S0 + 6 * SLOT;
static_assert(WS_END == 256 * MiB, "ws map");
#define WS_SLOT(i) (WS_S0 + (size_t)(i) * SLOT)

struct Params {
    const float* x; const float* c; const float* ctx; const float* c_ctx; const float* norm_g; const float* w_mod; const float* b_mod;
    const float* e_w_in; const float* e_w_a2; const float* e_b_a2; const float* e_gla_g; const float* e_conv_w; const float* e_w_out;
    const float* o_w_in; const float* o_conv_w; const float* o_conv_b; const float* o_w_a; const float* o_b_a; const float* o_w_x; const float* o_b_x;
    const float* o_lam; const float* o_w_out; const float* final_g;
    float* out; unsigned char* ws;
};

DEVI float bf2f(bf16_t v) { return __uint_as_float((unsigned)v << 16); }
DEVI bf16_t f2bf(float f) { unsigned u = __float_as_uint(f); return (bf16_t)((u + 0x7fffu + ((u >> 16) & 1u)) >> 16); }
DEVI float sigmoidf_(float x) { return 1.0f / (1.0f + __expf(-x)); }
DEVI float siluf_(float x) { return x / (1.0f + __expf(-x)); }
DEVI float softplusf_(float x) { return fmaxf(x, 0.f) + log1pf(__expf(-fabsf(x))); }
DEVI float logsigmoidf_(float x) { return fminf(x, 0.f) - log1pf(__expf(-fabsf(x))); }
DEVI int row_of(int bb, int c, int t) { return c < 64 ? bb * 4096 + c * 64 + t : NLAT + bb * 256 + (c - 64) * 64 + t; }
DEVI int mod_idx(int row) { return row < NLAT ? (row >> 12) : 4; }
DEVI float wave_sum(float v) {
#pragma unroll
    for (int o = 1; o < 64; o <<= 1) v += __shfl_xor(v, o);
    return v;
}
__host__ __device__ inline int colmap1(int n) {
    const int t = n >> 8, c = n & 255;
    if (t < 12) return n;
    if (t == 12) return c < 32 ? 3072 + c : -1;
    if (t < 21) { const int j = t - 13; return c < 128 ? 4128 + 128 * j + c : 5152 + 128 * j + (c - 128); }
    const int j = t - 21; return c < 128 ? 3104 + 128 * j + c : 6176 + 128 * j + (c - 128);
}

#define NTHREADS 512

__device__ void st_mod(const Params& p, int vb, int nvb, float* lds) {
    float* MOD = (float*)(p.ws + WS_MOD);
    for (int i = threadIdx.x; i < 5 * 1024; i += NTHREADS) { const int s = i >> 10, k = i & 1023; const float v = s < 4 ? p.c[s * 1024 + k] : p.c_ctx[k]; lds[i] = siluf_(v); }
    __syncthreads();
    for (int it = vb; it < 2 * 6; it += nvb) {
        const int li = it / 6, j = (it % 6) * 512 + threadIdx.x;
        const float* W = p.w_mod + (size_t)li * 1024 * 3072 + j;
        float a0 = 0.f, a1 = 0.f, a2 = 0.f, a3 = 0.f, a4 = 0.f;
        for (int k = 0; k < 1024; ++k) { const float w = W[(size_t)k * 3072]; a0 += lds[k] * w; a1 += lds[1024 + k] * w; a2 += lds[2048 + k] * w; a3 += lds[3072 + k] * w; a4 += lds[4096 + k] * w; }
        const float bv = p.b_mod[li * 3072 + j];
        float* o = MOD + (size_t)li * 5 * 3072 + j;
        o[0] = a0 + bv; o[3072] = a1 + bv; o[2 * 3072] = a2 + bv; o[3 * 3072] = a3 + bv; o[4 * 3072] = a4 + bv;
    }
    __syncthreads();
}

__device__ void st_wprep(const Params& p, int vb, int nvb) {
    bf16_t* Bt1 = (bf16_t*)(p.ws + WS_BT1); bf16_t* Bt2 = (bf16_t*)(p.ws + WS_BT2); bf16_t* Bt3 = (bf16_t*)(p.ws + WS_BT3); bf16_t* Bt4 = (bf16_t*)(p.ws + WS_BT4);
    bf16_t* BD = (bf16_t*)(p.ws + WS_BD);
    const size_t gtid = (size_t)vb * NTHREADS + threadIdx.x, gn = (size_t)nvb * NTHREADS;
    for (size_t e = gtid; e < (size_t)N1 * 1024; e += gn) { const int k = (int)(e / N1), n = (int)(e % N1); const int sc = colmap1(n); Bt1[(size_t)n * 1024 + k] = sc < 0 ? (bf16_t)0 : f2bf(p.e_w_in[(size_t)k * EVEN_IN + sc]); }
    for (size_t e = gtid; e < (size_t)2048 * 1024; e += gn) { const int k = (int)(e / 1024), n = (int)(e % 1024); Bt2[(size_t)n * 2048 + k] = f2bf(p.e_w_out[e]); Bt4[(size_t)n * 2048 + k] = f2bf(p.o_w_out[e]); }
    for (size_t e = gtid; e < (size_t)1024 * 4096; e += gn) { const int k = (int)(e / 4096), n = (int)(e % 4096); Bt3[(size_t)n * 1024 + k] = f2bf(p.o_w_in[e]); }
    for (size_t e = gtid; e < (size_t)2 * 16 * 128 * 128; e += gn) { const int j = (int)(e & 127), i = (int)((e >> 7) & 127), dn = (int)(e >> 14);
        BD[((size_t)dn * 128 + j) * 128 + i] = f2bf(p.o_w_a[e]); BD[(size_t)2 * 16 * 128 * 128 + ((size_t)dn * 128 + j) * 128 + i] = f2bf(p.o_w_x[e]); }
}

__device__ void st_modulate(const Params& p, int vb, int nvb, int li, const float* xlat, const float* xctx, bf16_t* H) {
    const float* MOD = (const float*)(p.ws + WS_MOD) + (size_t)li * 5 * 3072;
    const float* g = p.norm_g + li * 1024;
    const int lane = threadIdx.x & 63, gw = vb * (NTHREADS / 64) + (threadIdx.x >> 6), ngw = nvb * (NTHREADS / 64);
    for (int row = gw; row < NT; row += ngw) {
        const float* xr = row < NLAT ? xlat + (size_t)row * 1024 : xctx + (size_t)(row - NLAT) * 1024;
        const float* md = MOD + (size_t)mod_idx(row) * 3072;
        float4 v[4]; float ss = 0.f;
#pragma unroll
        for (int j = 0; j < 4; ++j) { v[j] = *(const float4*)(xr + j * 256 + lane * 4); ss += v[j].x * v[j].x + v[j].y * v[j].y + v[j].z * v[j].z + v[j].w * v[j].w; }
        const float rinv = rsqrtf(wave_sum(ss) * (1.f / 1024.f) + EPS);
#pragma unroll
        for (int j = 0; j < 4; ++j) { const int c0 = j * 256 + lane * 4; const float4 gg = *(const float4*)(g + c0), sh = *(const float4*)(md + c0), sc = *(const float4*)(md + 1024 + c0);
            ushort4 o; o.x = f2bf(v[j].x * rinv * gg.x * (1.f + sc.x) + sh.x); o.y = f2bf(v[j].y * rinv * gg.y * (1.f + sc.y) + sh.y);
            o.z = f2bf(v[j].z * rinv * gg.z * (1.f + sc.z) + sh.z); o.w = f2bf(v[j].w * rinv * gg.w * (1.f + sc.w) + sh.w);
            *(ushort4*)(H + (size_t)row * 1024 + c0) = o; }
    }
}

template <class Epi>
__device__ void st_gemm_naive(int vb, int nvb, float* lds, const bf16_t* A, const bf16_t* Bt, int mt0, int mt1, int nt0, int nt1, int K, const Epi& E) {
    float* As = lds;
    float* Bs = lds + 32 * 33;
    const int tid = threadIdx.x, tx = tid & 63, ty = tid >> 6;
    const int nmt = mt1 - mt0, nnt = nt1 - nt0;
    for (int it = vb; it < nmt * nnt; it += nvb) {
        const int m0 = (mt0 + it / nnt) * 32, n0 = (nt0 + it % nnt) * 256;
        float acc[4][4];
#pragma unroll
        for (int i = 0; i < 4; ++i)
#pragma unroll
            for (int j = 0; j < 4; ++j) acc[i][j] = 0.f;
        for (int k0 = 0; k0 < K; k0 += 32) {
            __syncthreads();
            for (int e = tid; e < 32 * 32; e += NTHREADS) { const int r = e >> 5, kk = e & 31; As[r * 33 + kk] = bf2f(A[(size_t)(m0 + r) * K + k0 + kk]); }
            for (int e = tid; e < 256 * 32; e += NTHREADS) { const int r = e >> 5, kk = e & 31; Bs[r * 33 + kk] = bf2f(Bt[(size_t)(n0 + r) * K + k0 + kk]); }
            __syncthreads();
#pragma unroll 8
            for (int kk = 0; kk < 32; ++kk) {
                float a[4], b[4];
#pragma unroll
                for (int i = 0; i < 4; ++i) a[i] = As[(ty * 4 + i) * 33 + kk];
#pragma unroll
                for (int j = 0; j < 4; ++j) b[j] = Bs[(tx + 64 * j) * 33 + kk];
#pragma unroll
                for (int i = 0; i < 4; ++i)
#pragma unroll
                    for (int j = 0; j < 4; ++j) acc[i][j] += a[i] * b[j];
            }
        }
#pragma unroll
        for (int i = 0; i < 4; ++i) E(m0 + ty * 4 + i, n0, tx, acc[i]);
    }
    __syncthreads();
}

struct Epi1 {
    bf16_t *QK, *V, *SGA, *Z, *CBG; float* ALR;
    DEVI void operator()(int row, int n0, int cl, const float (&v)[4]) const {
        const int t = n0 >> 8;
        if (t < 4) { for (int j = 0; j < 4; ++j) QK[(size_t)row * 1024 + n0 + cl + 64 * j] = f2bf(v[j]); }
        else if (t < 8) { for (int j = 0; j < 4; ++j) V[(size_t)row * 1024 + (n0 - 1024) + cl + 64 * j] = f2bf(v[j]); }
        else if (t < 12) { for (int j = 0; j < 4; ++j) SGA[(size_t)row * 1024 + (n0 - 2048) + cl + 64 * j] = f2bf(siluf_(v[j])); }
        else if (t == 12) { if (cl < 32) ALR[(size_t)row * 32 + cl] = v[0]; }
        else if (t < 21) { const int jt = t - 13; Z[(size_t)row * 1024 + 128 * jt + cl] = f2bf(v[0] * v[2]); Z[(size_t)row * 1024 + 128 * jt + cl + 64] = f2bf(v[1] * v[3]); }
        else { const int jt = t - 21; CBG[(size_t)row * 1024 + 128 * jt + cl] = f2bf(v[0] * siluf_(v[2])); CBG[(size_t)row * 1024 + 128 * jt + cl + 64] = f2bf(v[1] * siluf_(v[3])); }
    }
};
struct EpiRes {
    const float* xl; const float* xc; float* outl; float* outc; const float* MODl;
    DEVI void operator()(int row, int n0, int cl, const float (&v)[4]) const {
        const float* gate = MODl + (size_t)mod_idx(row) * 3072 + 2048;
        for (int j = 0; j < 4; ++j) { const int col = n0 + cl + 64 * j;
            if (row < NLAT) outl[(size_t)row * 1024 + col] = xl[(size_t)row * 1024 + col] + gate[col] * v[j];
            else if (outc) outc[(size_t)(row - NLAT) * 1024 + col] = xc[(size_t)(row - NLAT) * 1024 + col] + gate[col] * v[j]; }
    }
};
struct Epi3 {
    bf16_t* XR; bf16_t* SG;
    DEVI void operator()(int row, int n0, int cl, const float (&v)[4]) const {
        for (int j = 0; j < 4; ++j) { const int col = n0 + cl + 64 * j;
            if (col < 2048) XR[(size_t)row * 2048 + col] = f2bf(v[j]); else if (row < NLAT) SG[(size_t)row * 2048 + col - 2048] = f2bf(siluf_(v[j])); }
    }
};

__device__ void st_glaprep(const Params& p, int vb, int nvb, unsigned char* ldsb, const bf16_t* QK, const bf16_t* V, const float* ALR, bf16_t* QIN, bf16_t* KET, bf16_t* SC, float* DEC, bf16_t* VT) {
    bf16_t* qs = (bf16_t*)ldsb;
    bf16_t* ks = qs + 64 * 136;
    float* tot = (float*)(ks + 64 * 136);
    bf16_t* vs = (bf16_t*)(tot + 4 * 128);
    const int tid = threadIdx.x, kk = tid & 127, tq = tid >> 7;
    for (int u = vb; u < NB * NCH * 4 * 2; u += nvb) {
        const int d = u & 1, h = (u >> 1) & 3, bc = u >> 3, c = bc % NCH, bb = bc / NCH;
        const int row0 = row_of(bb, c, 0);
        float w2[16];
#pragma unroll
        for (int r = 0; r < 16; ++r) w2[r] = p.e_w_a2[((size_t)d * 16 + r) * 512 + h * 128 + kk];
        const float b2 = p.e_b_a2[d * 512 + h * 128 + kk];
        float lg[16];
#pragma unroll
        for (int i = 0; i < 16; ++i) { const float* a = ALR + (size_t)(row0 + tq * 16 + i) * 32 + d * 16; float z = b2;
#pragma unroll
            for (int r = 0; r < 16; ++r) z += a[r] * w2[r];
            lg[i] = logsigmoidf_(z) * (1.f / 16.f); }
        float bcum[16];
        if (d == 0) { float s = 0.f;
#pragma unroll
            for (int i = 0; i < 16; ++i) { s += lg[i]; bcum[i] = s; } tot[tq * 128 + kk] = s; }
        else { float s = 0.f;
#pragma unroll
            for (int i = 15; i >= 0; --i) { s += lg[i]; bcum[i] = s; } tot[tq * 128 + kk] = s; }
        __syncthreads();
        float off = 0.f, blast = 0.f;
        for (int q = 0; q < 4; ++q) { const float tv = tot[q * 128 + kk]; blast += tv; if (d == 0 ? (q < tq) : (q > tq)) off += tv; }
        const float scale = 0.08838834764831845f;
        unsigned short ke[16];
#pragma unroll
        for (int i = 0; i < 16; ++i) { const int t = tq * 16 + i; const float b = bcum[i] + off;
            const float qv = bf2f(QK[(size_t)(row0 + t) * 1024 + h * 128 + kk]) * scale, kv = bf2f(QK[(size_t)(row0 + t) * 1024 + 512 + h * 128 + kk]);
            const bf16_t qi = f2bf(qv * __expf(b)), ki = f2bf(kv * __expf(-b));
            qs[t * 136 + kk] = qi; ks[t * 136 + kk] = ki; ke[i] = f2bf(kv * __expf(blast - b));
            QIN[((size_t)u * 64 + t) * 128 + kk] = qi; }
        { uint4 w0, w1; w0.x = ke[0] | (ke[1] << 16); w0.y = ke[2] | (ke[3] << 16); w0.z = ke[4] | (ke[5] << 16); w0.w = ke[6] | (ke[7] << 16);
          w1.x = ke[8] | (ke[9] << 16); w1.y = ke[10] | (ke[11] << 16); w1.z = ke[12] | (ke[13] << 16); w1.w = ke[14] | (ke[15] << 16);
          uint4* dst = (uint4*)(KET + ((size_t)u * 128 + kk) * 64 + tq * 16); dst[0] = w0; dst[1] = w1; }
        if (tq == 0) DEC[(size_t)u * 128 + kk] = __expf(blast);
        for (int e = tid; e < 64 * 128; e += NTHREADS) { const int t = e >> 7, cc = e & 127; vs[t * 130 + cc] = V[(size_t)(row0 + t) * 1024 + h * 256 + d * 128 + cc]; }
        __syncthreads();
        for (int e = tid; e < 64 * 64; e += NTHREADS) { const int t = e >> 6, s = e & 63; float a = 0.f;
            if (d == 0 ? (s <= t) : (s >= t)) { for (int k2 = 0; k2 < 128; ++k2) a += bf2f(qs[t * 136 + k2]) * bf2f(ks[s * 136 + k2]); }
            SC[((size_t)u * 64 + t) * 64 + s] = f2bf(a); }
        { unsigned short vv[16];
#pragma unroll
          for (int i = 0; i < 16; ++i) vv[i] = vs[(tq * 16 + i) * 130 + kk];
          uint4 w0, w1; w0.x = vv[0] | (vv[1] << 16); w0.y = vv[2] | (vv[3] << 16); w0.z = vv[4] | (vv[5] << 16); w0.w = vv[6] | (vv[7] << 16);
          w1.x = vv[8] | (vv[9] << 16); w1.y = vv[10] | (vv[11] << 16); w1.z = vv[12] | (vv[13] << 16); w1.w = vv[14] | (vv[15] << 16);
          uint4* dst = (uint4*)(VT + (((size_t)(u >> 1)) * 256 + d * 128 + kk) * 64 + tq * 16); dst[0] = w0; dst[1] = w1; }
        __syncthreads();
    }
}

__device__ void st_glawalk_naive(const Params& p, int vb, int nvb, float* Sl, const bf16_t* QIN, const bf16_t* KET, const bf16_t* SC, const float* DEC, const bf16_t* VT, bf16_t* OF, bf16_t* OB) {
    const int vc = threadIdx.x & 255, half = threadIdx.x >> 8;
    for (int combo = vb; combo < 32; combo += nvb) {
        const int d = combo & 1, h = (combo >> 1) & 3, bb = combo >> 3;
        __syncthreads();
        for (int k = half * 64; k < half * 64 + 64; ++k) Sl[k * 256 + vc] = 0.f;
        __syncthreads();
        bf16_t* O = d == 0 ? OF : OB;
        for (int step = 0; step < NCH; ++step) {
            const int c = d == 0 ? (step < 4 ? 64 + step : step - 4) : 67 - step;
            const int u = ((bb * NCH + c) * 4 + h) * 2 + d;
            const bf16_t* q = QIN + (size_t)u * 64 * 128; const bf16_t* ke = KET + (size_t)u * 128 * 64; const bf16_t* sc = SC + (size_t)u * 64 * 64;
            const bf16_t* vt = VT + (((size_t)(u >> 1)) * 256 + vc) * 64;
            float vv[64];
#pragma unroll
            for (int t = 0; t < 64; ++t) vv[t] = bf2f(vt[t]);
            const int row0 = row_of(bb, c, 0);
            for (int t = half * 32; t < half * 32 + 32; ++t) { float a = 0.f;
                for (int k = 0; k < 128; ++k) a += bf2f(q[t * 128 + k]) * bf2f(f2bf(Sl[k * 256 + vc]));
#pragma unroll
                for (int s = 0; s < 64; ++s) a += bf2f(sc[t * 64 + s]) * vv[s];
                O[(size_t)(row0 + t) * 1024 + h * 256 + vc] = f2bf(a); }
            __syncthreads();
            for (int k = half * 64; k < half * 64 + 64; ++k) { float a = DEC[(size_t)u * 128 + k] * Sl[k * 256 + vc];
#pragma unroll
                for (int t = 0; t < 64; ++t) a += bf2f(ke[k * 64 + t]) * vv[t];
                Sl[k * 256 + vc] = a; }
            __syncthreads();
        }
    }
}

__device__ void st_inner(const Params& p, int vb, int nvb, const bf16_t* OF, const bf16_t* OB, const bf16_t* SGA, const bf16_t* Z, const bf16_t* CBG, bf16_t* INNER) {
    const int lane = threadIdx.x & 63, gw = vb * (NTHREADS / 64) + (threadIdx.x >> 6), ngw = nvb * (NTHREADS / 64);
    for (int row = gw; row < NT; row += ngw) {
        bool hasp, hasn;
        if (row < NLAT) { const int t = row & 63; hasp = t != 0; hasn = t != 63; } else { const int t = (row - NLAT) & 255; hasp = t != 0; hasn = t != 255; }
#pragma unroll
        for (int h = 0; h < 4; ++h) {
            const int c0 = h * 256 + lane * 4;
            const ushort4 a = *(const ushort4*)(OF + (size_t)row * 1024 + c0), b = *(const ushort4*)(OB + (size_t)row * 1024 + c0);
            const float o0 = bf2f(a.x) + bf2f(b.x), o1 = bf2f(a.y) + bf2f(b.y), o2 = bf2f(a.z) + bf2f(b.z), o3 = bf2f(a.w) + bf2f(b.w);
            const float rinv = rsqrtf(wave_sum(o0 * o0 + o1 * o1 + o2 * o2 + o3 * o3) * (1.f / 256.f) + EPS);
            const float4 gg = *(const float4*)(p.e_gla_g + lane * 4);
            const ushort4 sg = *(const ushort4*)(SGA + (size_t)row * 1024 + c0);
            ushort4 o; o.x = f2bf(o0 * rinv * gg.x * bf2f(sg.x)); o.y = f2bf(o1 * rinv * gg.y * bf2f(sg.y)); o.z = f2bf(o2 * rinv * gg.z * bf2f(sg.z)); o.w = f2bf(o3 * rinv * gg.w * bf2f(sg.w));
            *(ushort4*)(INNER + (size_t)row * 2048 + c0) = o;
            const ushort4 zc = *(const ushort4*)(Z + (size_t)row * 1024 + c0);
            ushort4 zp = {0, 0, 0, 0}, zn = {0, 0, 0, 0};
            if (hasp) zp = *(const ushort4*)(Z + (size_t)(row - 1) * 1024 + c0);
            if (hasn) zn = *(const ushort4*)(Z + (size_t)(row + 1) * 1024 + c0);
            const float4 w0 = *(const float4*)(p.e_conv_w + c0), w1 = *(const float4*)(p.e_conv_w + 1024 + c0), w2 = *(const float4*)(p.e_conv_w + 2048 + c0);
            const ushort4 cb = *(const ushort4*)(CBG + (size_t)row * 1024 + c0);
            ushort4 y; y.x = f2bf(bf2f(cb.x) * (w0.x * bf2f(zp.x) + w1.x * bf2f(zc.x) + w2.x * bf2f(zn.x)));
            y.y = f2bf(bf2f(cb.y) * (w0.y * bf2f(zp.y) + w1.y * bf2f(zc.y) + w2.y * bf2f(zn.y)));
            y.z = f2bf(bf2f(cb.z) * (w0.z * bf2f(zp.z) + w1.z * bf2f(zc.z) + w2.z * bf2f(zn.z)));
            y.w = f2bf(bf2f(cb.w) * (w0.w * bf2f(zp.w) + w1.w * bf2f(zc.w) + w2.w * bf2f(zn.w)));
            *(ushort4*)(INNER + (size_t)row * 2048 + 1024 + c0) = y;
        }
    }
}

template <int MODE>
__device__ void st_rglru_naive(const Params& p, int vb, int nvb, float* lds, const bf16_t* XR, const bf16_t* SG, float* SUMA, float* SUMH, bf16_t* Y) {
    float* xc = lds;
    float* av = xc + 64 * 128;
    float* uv = av + 64 * 128;
    float* hf = uv + 64 * 128;
    const int tid = threadIdx.x, j = tid & 127, tq = tid >> 7;
    const int nitems = MODE == 0 ? NB * NCH * 16 * 2 : NB * 64 * 16;
    for (int it = vb; it < nitems; it += nvb) {
        int bb, c, nb;
        if (MODE == 0) { nb = (it >> 1) & 15; const int bc = it >> 5; c = bc % NCH; bb = bc / NCH; } else { nb = it & 15; const int bc = it >> 4; c = bc & 63; bb = bc >> 6; }
        const int row0 = row_of(bb, c, 0);
        const int seg0 = c < 64 ? bb * 4096 : NLAT + bb * 256, segn = c < 64 ? 4096 : 256;
        const int tl0 = row0 - seg0;
        for (int dd = 0; dd < (MODE == 0 ? 1 : 2); ++dd) {
            const int d = MODE == 0 ? (it & 1) : dd;
            __syncthreads();
            for (int e = tid; e < 64 * 128; e += NTHREADS) { const int t = e >> 7, i = e & 127, ch = nb * 128 + i; float a = p.o_conv_b[d * 2048 + ch];
#pragma unroll
                for (int jj = 0; jj < 4; ++jj) { const int tt = d == 0 ? tl0 + t - 3 + jj : tl0 + t + 3 - jj;
                    if (tt >= 0 && tt < segn) a += p.o_conv_w[((size_t)d * 4 + jj) * 2048 + ch] * bf2f(XR[(size_t)(seg0 + tt) * 2048 + ch]); }
                xc[e] = a; }
            __syncthreads();
            const float* WA = p.o_w_a + ((size_t)d * 16 + nb) * 128 * 128; const float* WX = p.o_w_x + ((size_t)d * 16 + nb) * 128 * 128;
            const int ch = nb * 128 + j;
            const float ba = p.o_b_a[d * 2048 + ch], bx = p.o_b_x[d * 2048 + ch], sp = softplusf_(-p.o_lam[d * 2048 + ch]);
            for (int i16 = 0; i16 < 16; ++i16) { const int t = tq * 16 + i16; float ra = ba, rx = bx;
                for (int i = 0; i < 128; ++i) { const float xv = bf2f(f2bf(xc[t * 128 + i])); ra += xv * bf2f(f2bf(WA[i * 128 + j])); rx += xv * bf2f(f2bf(WX[i * 128 + j])); }
                const float r = sigmoidf_(ra), ig = sigmoidf_(rx); const float la = -8.f * r * sp; const float a = __expf(la);
                av[t * 128 + j] = a; uv[t * 128 + j] = sqrtf(-expm1f(2.f * la)) * (ig * xc[t * 128 + j]); }
            __syncthreads();
            if (tid < 128) {
                const size_t sidx = (((size_t)bb * 2 + d) * NCH + c) * 2048 + ch;
                if (MODE == 0) { float A = 1.f, hh = 0.f;
                    if (d == 0) for (int t = 0; t < 64; ++t) { const float a = av[t * 128 + j]; hh = a * hh + uv[t * 128 + j]; A *= a; }
                    else for (int t = 63; t >= 0; --t) { const float a = av[t * 128 + j]; hh = a * hh + uv[t * 128 + j]; A *= a; }
                    SUMA[sidx] = A; SUMH[sidx] = hh;
                } else { float hh = SUMH[sidx];
                    if (d == 0) for (int t = 0; t < 64; ++t) { hh = av[t * 128 + j] * hh + uv[t * 128 + j]; hf[t * 128 + j] = hh; }
                    else for (int t = 63; t >= 0; --t) { hh = av[t * 128 + j] * hh + uv[t * 128 + j]; const size_t o = (size_t)(row0 + t) * 2048 + ch; Y[o] = f2bf((hf[t * 128 + j] + hh) * bf2f(SG[o])); }
                }
            }
        }
    }
    __syncthreads();
}
__device__ void st_carry(const Params& p, int vb, int nvb, const float* SUMA, float* SUMH) {
    for (int e = vb * NTHREADS + threadIdx.x; e < NB * 2 * 2048; e += nvb * NTHREADS) {
        const int ch = e & 2047, d = (e >> 11) & 1, bb = e >> 12; float hh = 0.f;
        for (int step = 0; step < NCH; ++step) { const int c = d == 0 ? (step < 4 ? 64 + step : step - 4) : 67 - step;
            const size_t sidx = (((size_t)bb * 2 + d) * NCH + c) * 2048 + ch; const float A = SUMA[sidx], hl = SUMH[sidx]; SUMH[sidx] = hh; hh = A * hh + hl; }
    }
}
__device__ void st_final(const Params& p, int vb, int nvb) {
    const int lane = threadIdx.x & 63, gw = vb * (NTHREADS / 64) + (threadIdx.x >> 6), ngw = nvb * (NTHREADS / 64);
    for (int row = gw; row < NLAT; row += ngw) { float* xr = p.out + (size_t)row * 1024; float4 v[4]; float ss = 0.f;
#pragma unroll
        for (int j = 0; j < 4; ++j) { v[j] = *(const float4*)(xr + j * 256 + lane * 4); ss += v[j].x * v[j].x + v[j].y * v[j].y + v[j].z * v[j].z + v[j].w * v[j].w; }
        const float rinv = rsqrtf(wave_sum(ss) * (1.f / 1024.f) + EPS);
#pragma unroll
        for (int j = 0; j < 4; ++j) { const float4 g = *(const float4*)(p.final_g + j * 256 + lane * 4); float4 o; o.x = v[j].x * rinv * g.x; o.y = v[j].y * rinv * g.y; o.z = v[j].z * rinv * g.z; o.w = v[j].w * rinv * g.w; *(float4*)(xr + j * 256 + lane * 4) = o; }
    }
}

__device__ void run_stage(const Params& p, int st, int vb, int nvb, unsigned char* lds) {
    unsigned char* ws = p.ws;
    float* MOD = (float*)(ws + WS_MOD); float* ALR = (float*)(ws + WS_ALR); float* X1C = (float*)(ws + WS_X1C);
    float* SUMA = (float*)(ws + WS_SUMA); float* SUMH = (float*)(ws + WS_SUMH); float* DEC = (float*)(ws + WS_DEC);
    bf16_t* Bt1 = (bf16_t*)(ws + WS_BT1); bf16_t* Bt2 = (bf16_t*)(ws + WS_BT2); bf16_t* Bt3 = (bf16_t*)(ws + WS_BT3); bf16_t* Bt4 = (bf16_t*)(ws + WS_BT4);
    bf16_t* S0 = (bf16_t*)(ws + WS_SLOT(0)); bf16_t* S1 = (bf16_t*)(ws + WS_SLOT(1)); bf16_t* S2 = (bf16_t*)(ws + WS_SLOT(2));
    bf16_t* S3 = (bf16_t*)(ws + WS_SLOT(3)); bf16_t* S4 = (bf16_t*)(ws + WS_SLOT(4)); bf16_t* S5 = (bf16_t*)(ws + WS_SLOT(5));
    bf16_t* DO0 = (bf16_t*)p.out; bf16_t* DOSC = (bf16_t*)((unsigned char*)p.out + 34 * MiB);
    switch (st) {
    case 0: st_mod(p, vb, nvb, (float*)lds); st_wprep(p, vb, nvb); break;
    case 1: st_modulate(p, vb, nvb, 0, p.x, p.ctx, S0); break;
    case 2: { Epi1 E{S1, S2, S3, S4, S5, ALR}; st_gemm_naive(vb, nvb, (float*)lds, S0, Bt1, 0, NT / 32, 0, 8, 1024, E); st_gemm_naive(vb, nvb, (float*)lds, S0, Bt1, 0, NT / 32, 12, 13, 1024, E); } break;
    case 3: st_glaprep(p, vb, nvb, lds, S1, S2, ALR, S3, S4, DOSC, DEC, S5); break;
    case 4: st_glawalk_naive(p, vb, nvb, (float*)lds, S3, S4, DOSC, DEC, S5, S2, DO0); break;
    case 5: { Epi1 E{S1, S2, S3, S4, S5, ALR}; st_gemm_naive(vb, nvb, (float*)lds, S0, Bt1, 0, NT / 32, 8, 12, 1024, E); st_gemm_naive(vb, nvb, (float*)lds, S0, Bt1, 0, NT / 32, 13, 29, 1024, E); } break;
    case 6: st_inner(p, vb, nvb, S2, DO0, S3, S4, S5, S0); break;
    case 7: { EpiRes E{p.x, p.ctx, p.out, X1C, MOD}; st_gemm_naive(vb, nvb, (float*)lds, S0, Bt2, 0, NT / 32, 0, 4, 2048, E); } break;
    case 8: st_modulate(p, vb, nvb, 1, p.out, X1C, S2); break;
    case 9: { Epi3 E{S3, S0}; st_gemm_naive(vb, nvb, (float*)lds, S2, Bt3, 0, NLAT / 32, 0, 16, 1024, E); st_gemm_naive(vb, nvb, (float*)lds, S2, Bt3, NLAT / 32, NT / 32, 0, 8, 1024, E); } break;
    case 10: st_rglru_naive<0>(p, vb, nvb, (float*)lds, S3, S0, SUMA, SUMH, S0); break;
    case 11: st_carry(p, vb, nvb, SUMA, SUMH); break;
    case 12: st_rglru_naive<1>(p, vb, nvb, (float*)lds, S3, S0, SUMA, SUMH, S0); break;
    case 13: { EpiRes E{p.out, nullptr, p.out, nullptr, MOD + 5 * 3072}; st_gemm_naive(vb, nvb, (float*)lds, S0, Bt4, 0, NLAT / 32, 0, 4, 2048, E); } break;
    case 14: st_final(p, vb, nvb); break;
    }
}
constexpr int NSTAGES = 15;
constexpr int LDS_BYTES = 147456;

__global__ void __launch_bounds__(NTHREADS) k_stage(Params p, int st) {
    extern __shared__ __attribute__((aligned(16))) unsigned char lds[];
    run_stage(p, st, blockIdx.x, gridDim.x, lds);
}

extern "C" void kernel_launch(void* const* d_in, const int* in_sizes, int n_in, void* d_out, int out_size, void* d_ws, size_t ws_size, hipStream_t stream) {
    static int inited = 0;
    if (!inited) {
        if (n_in != 23 || ws_size < WS_END || out_size != NLAT * D) { fprintf(stderr, "kernel_launch: unexpected shapes n_in %d ws %zu out %d\n", n_in, ws_size, out_size); inited = -1; return; }
        if (hipFuncSetAttribute((const void*)k_stage, hipFuncAttributeMaxDynamicSharedMemorySize, LDS_BYTES) != hipSuccess) { fprintf(stderr, "hipFuncSetAttribute failed\n"); inited = -1; return; }
        inited = 1;
    }
    if (inited < 0) return;
    Params p{};
    const float** f = (const float**)&p;
    for (int i = 0; i < 23; ++i) f[i] = (const float*)d_in[i];
    p.out = (float*)d_out; p.ws = (unsigned char*)d_ws;
    for (int st = 0; st < NSTAGES; ++st) hipLaunchKernelGGL(k_stage, dim3(1024), dim3(NTHREADS), LDS_BYTES, stream, p, st);
}
```

```cpp
#include <hip/hip_runtime.h>
#include <hip/hip_cooperative_groups.h>
namespace cg = cooperative_groups;
#include <cstdio>
#include <cstdint>

typedef unsigned short bf16_t;
#define DEVI __device__ __forceinline__

constexpr int D = 1024, NB = 4, SEQ = 4096, CTXL = 256;
constexpr int NLAT = NB * SEQ;
constexpr int NCTX = NB * CTXL;
constexpr int NT = NLAT + NCTX;
constexpr int NCH = 68;
constexpr int EVEN_IN = 7200;
constexpr int N1 = 7424;
constexpr int N1A = 13 * 256;
constexpr int RGW = 2048;
constexpr float EPS = 1e-6f;

constexpr size_t MiB = 1u << 20;
constexpr size_t WS_CTL = 0;
constexpr size_t WS_MOD = 1 * MiB;
constexpr size_t WS_ALR = 2 * MiB;
constexpr size_t WS_X1C = 5 * MiB;
constexpr size_t WS_SUMA = 9 * MiB;
constexpr size_t WS_SUMH = 9 * MiB + 4608 * 1024;
constexpr size_t WS_DEC = 18 * MiB;
constexpr size_t WS_BT1 = 19 * MiB + 512 * 1024;
constexpr size_t WS_BT2 = 34 * MiB;
constexpr size_t WS_BT3 = 38 * MiB;
constexpr size_t WS_BT4 = 46 * MiB;
constexpr size_t WS_BD = 50 * MiB;
constexpr size_t WS_S0 = 52 * MiB;
constexpr size_t SLOT = 34 * MiB;
constexpr size_t WS_END = WS_S0 + 6 * SLOT;
static_assert(WS_END == 256 * MiB, "ws map");
#define WS_SLOT(i) (WS_S0 + (size_t)(i) * SLOT)

struct Params {
    const float* x; const float* c; const float* ctx; const float* c_ctx; const float* norm_g; const float* w_mod; const float* b_mod;
    const float* e_w_in; const float* e_w_a2; const float* e_b_a2; const float* e_gla_g; const float* e_conv_w; const float* e_w_out;
    const float* o_w_in; const float* o_conv_w; const float* o_conv_b; const float* o_w_a; const float* o_b_a; const float* o_w_x; const float* o_b_x;
    const float* o_lam; const float* o_w_out; const float* final_g;
    float* out; unsigned char* ws;
};

DEVI float bf2f(bf16_t v) { return __uint_as_float((unsigned)v << 16); }
DEVI bf16_t f2bf(float f) { unsigned u = __float_as_uint(f); return (bf16_t)((u + 0x7fffu + ((u >> 16) & 1u)) >> 16); }
DEVI float sigmoidf_(float x) { return 1.0f / (1.0f + __expf(-x)); }
DEVI float siluf_(float x) { return x / (1.0f + __expf(-x)); }
DEVI float softplusf_(float x) { return fmaxf(x, 0.f) + log1pf(__expf(-fabsf(x))); }
DEVI float logsigmoidf_(float x) { return fminf(x, 0.f) - log1pf(__expf(-fabsf(x))); }
DEVI int row_of(int bb, int c, int t) { return c < 64 ? bb * 4096 + c * 64 + t : NLAT + bb * 256 + (c - 64) * 64 + t; }
DEVI int mod_idx(int row) { return row < NLAT ? (row >> 12) : 4; }
DEVI float wave_sum(float v) {
#pragma unroll
    for (int o = 1; o < 64; o <<= 1) v += __shfl_xor(v, o);
    return v;
}
__host__ __device__ inline int colmap1(int n) {
    const int t = n >> 8, c = n & 255;
    if (t < 12) return n;
    if (t == 12) return c < 32 ? 3072 + c : -1;
    if (t < 21) { const int j = t - 13; return c < 128 ? 4128 + 128 * j + c : 5152 + 128 * j + (c - 128); }
    const int j = t - 21; return c < 128 ? 3104 + 128 * j + c : 6176 + 128 * j + (c - 128);
}

#define NTHREADS 512

__device__ void st_mod(const Params& p, int vb, int nvb, float* lds) {
    float* MOD = (float*)(p.ws + WS_MOD);
    for (int i = threadIdx.x; i < 5 * 1024; i += NTHREADS) { const int s = i >> 10, k = i & 1023; const float v = s < 4 ? p.c[s * 1024 + k] : p.c_ctx[k]; lds[i] = siluf_(v); }
    __syncthreads();
    for (int it = vb; it < 2 * 6; it += nvb) {
        const int li = it / 6, j = (it % 6) * 512 + threadIdx.x;
        const float* W = p.w_mod + (size_t)li * 1024 * 3072 + j;
        float a0 = 0.f, a1 = 0.f, a2 = 0.f, a3 = 0.f, a4 = 0.f;
        for (int k = 0; k < 1024; ++k) { const float w = W[(size_t)k * 3072]; a0 += lds[k] * w; a1 += lds[1024 + k] * w; a2 += lds[2048 + k] * w; a3 += lds[3072 + k] * w; a4 += lds[4096 + k] * w; }
        const float bv = p.b_mod[li * 3072 + j];
        float* o = MOD + (size_t)li * 5 * 3072 + j;
        o[0] = a0 + bv; o[3072] = a1 + bv; o[2 * 3072] = a2 + bv; o[3 * 3072] = a3 + bv; o[4 * 3072] = a4 + bv;
    }
    __syncthreads();
}

__device__ void st_wprep(const Params& p, int vb, int nvb) {
    bf16_t* Bt1 = (bf16_t*)(p.ws + WS_BT1); bf16_t* Bt2 = (bf16_t*)(p.ws + WS_BT2); bf16_t* Bt3 = (bf16_t*)(p.ws + WS_BT3); bf16_t* Bt4 = (bf16_t*)(p.ws + WS_BT4);
    bf16_t* BD = (bf16_t*)(p.ws + WS_BD);
    const size_t gtid = (size_t)vb * NTHREADS + threadIdx.x, gn = (size_t)nvb * NTHREADS;
    for (size_t e = gtid; e < (size_t)N1 * 1024; e += gn) { const int k = (int)(e / N1), n = (int)(e % N1); const int sc = colmap1(n); Bt1[(size_t)n * 1024 + k] = sc < 0 ? (bf16_t)0 : f2bf(p.e_w_in[(size_t)k * EVEN_IN + sc]); }
    for (size_t e = gtid; e < (size_t)2048 * 1024; e += gn) { const int k = (int)(e / 1024), n = (int)(e % 1024); Bt2[(size_t)n * 2048 + k] = f2bf(p.e_w_out[e]); Bt4[(size_t)n * 2048 + k] = f2bf(p.o_w_out[e]); }
    for (size_t e = gtid; e < (size_t)1024 * 4096; e += gn) { const int k = (int)(e / 4096), n = (int)(e % 4096); Bt3[(size_t)n * 1024 + k] = f2bf(p.o_w_in[e]); }
    for (size_t e = gtid; e < (size_t)2 * 16 * 128 * 128; e += gn) { const int j = (int)(e & 127), i = (int)((e >> 7) & 127), dn = (int)(e >> 14);
        BD[((size_t)dn * 128 + j) * 128 + i] = f2bf(p.o_w_a[e]); BD[(size_t)2 * 16 * 128 * 128 + ((size_t)dn * 128 + j) * 128 + i] = f2bf(p.o_w_x[e]); }
}

__device__ void st_modulate(const Params& p, int vb, int nvb, int li, const float* xlat, const float* xctx, bf16_t* H) {
    const float* MOD = (const float*)(p.ws + WS_MOD) + (size_t)li * 5 * 3072;
    const float* g = p.norm_g + li * 1024;
    const int lane = threadIdx.x & 63, gw = vb * (NTHREADS / 64) + (threadIdx.x >> 6), ngw = nvb * (NTHREADS / 64);
    for (int row = gw; row < NT; row += ngw) {
        const float* xr = row < NLAT ? xlat + (size_t)row * 1024 : xctx + (size_t)(row - NLAT) * 1024;
        const float* md = MOD + (size_t)mod_idx(row) * 3072;
        float4 v[4]; float ss = 0.f;
#pragma unroll
        for (int j = 0; j < 4; ++j) { v[j] = *(const float4*)(xr + j * 256 + lane * 4); ss += v[j].x * v[j].x + v[j].y * v[j].y + v[j].z * v[j].z + v[j].w * v[j].w; }
        const float rinv = rsqrtf(wave_sum(ss) * (1.f / 1024.f) + EPS);
#pragma unroll
        for (int j = 0; j < 4; ++j) { const int c0 = j * 256 + lane * 4; const float4 gg = *(const float4*)(g + c0), sh = *(const float4*)(md + c0), sc = *(const float4*)(md + 1024 + c0);
            ushort4 o; o.x = f2bf(v[j].x * rinv * gg.x * (1.f + sc.x) + sh.x); o.y = f2bf(v[j].y * rinv * gg.y * (1.f + sc.y) + sh.y);
            o.z = f2bf(v[j].z * rinv * gg.z * (1.f + sc.z) + sh.z); o.w = f2bf(v[j].w * rinv * gg.w * (1.f + sc.w) + sh.w);
            *(ushort4*)(H + (size_t)row * 1024 + c0) = o; }
    }
}

template <class Epi>
__device__ void st_gemm_naive(int vb, int nvb, float* lds, const bf16_t* A, const bf16_t* Bt, int mt0, int mt1, int nt0, int nt1, int K, const Epi& E) {
    float* As = lds;
    float* Bs = lds + 32 * 33;
    const int tid = threadIdx.x, tx = tid & 63, ty = tid >> 6;
    const int nmt = mt1 - mt0, nnt = nt1 - nt0;
    for (int it = vb; it < nmt * nnt; it += nvb) {
        const int m0 = (mt0 + it / nnt) * 32, n0 = (nt0 + it % nnt) * 256;
        float acc[4][4];
#pragma unroll
        for (int i = 0; i < 4; ++i)
#pragma unroll
            for (int j = 0; j < 4; ++j) acc[i][j] = 0.f;
        for (int k0 = 0; k0 < K; k0 += 32) {
            __syncthreads();
            for (int e = tid; e < 32 * 32; e += NTHREADS) { const int r = e >> 5, kk = e & 31; As[r * 33 + kk] = bf2f(A[(size_t)(m0 + r) * K + k0 + kk]); }
            for (int e = tid; e < 256 * 32; e += NTHREADS) { const int r = e >> 5, kk = e & 31; Bs[r * 33 + kk] = bf2f(Bt[(size_t)(n0 + r) * K + k0 + kk]); }
            __syncthreads();
#pragma unroll 8
            for (int kk = 0; kk < 32; ++kk) {
                float a[4], b[4];
#pragma unroll
                for (int i = 0; i < 4; ++i) a[i] = As[(ty * 4 + i) * 33 + kk];
#pragma unroll
                for (int j = 0; j < 4; ++j) b[j] = Bs[(tx + 64 * j) * 33 + kk];
#pragma unroll
                for (int i = 0; i < 4; ++i)
#pragma unroll
                    for (int j = 0; j < 4; ++j) acc[i][j] += a[i] * b[j];
            }
        }
#pragma unroll
        for (int i = 0; i < 4; ++i) E(m0 + ty * 4 + i, n0, tx, acc[i]);
    }
    __syncthreads();
}

struct Epi1 {
    bf16_t *QK, *V, *SGA, *Z, *CBG; float* ALR;
    DEVI void operator()(int row, int n0, int cl, const float (&v)[4]) const {
        const int t = n0 >> 8;
        if (t < 4) { for (int j = 0; j < 4; ++j) QK[(size_t)row * 1024 + n0 + cl + 64 * j] = f2bf(v[j]); }
        else if (t < 8) { for (int j = 0; j < 4; ++j) V[(size_t)row * 1024 + (n0 - 1024) + cl + 64 * j] = f2bf(v[j]); }
        else if (t < 12) { for (int j = 0; j < 4; ++j) SGA[(size_t)row * 1024 + (n0 - 2048) + cl + 64 * j] = f2bf(siluf_(v[j])); }
        else if (t == 12) { if (cl < 32) ALR[(size_t)row * 32 + cl] = v[0]; }
        else if (t < 21) { const int jt = t - 13; Z[(size_t)row * 1024 + 128 * jt + cl] = f2bf(v[0] * v[2]); Z[(size_t)row * 1024 + 128 * jt + cl + 64] = f2bf(v[1] * v[3]); }
        else { const int jt = t - 21; CBG[(size_t)row * 1024 + 128 * jt + cl] = f2bf(v[0] * siluf_(v[2])); CBG[(size_t)row * 1024 + 128 * jt + cl + 64] = f2bf(v[1] * siluf_(v[3])); }
    }
};
struct EpiRes {
    const float* xl; const float* xc; float* outl; float* outc; const float* MODl;
    DEVI void operator()(int row, int n0, int cl, const float (&v)[4]) const {
        const float* gate = MODl + (size_t)mod_idx(row) * 3072 + 2048;
        for (int j = 0; j < 4; ++j) { const int col = n0 + cl + 64 * j;
            if (row < NLAT) outl[(size_t)row * 1024 + col] = xl[(size_t)row * 1024 + col] + gate[col] * v[j];
            else if (outc) outc[(size_t)(row - NLAT) * 1024 + col] = xc[(size_t)(row - NLAT) * 1024 + col] + gate[col] * v[j]; }
    }
};
struct Epi3 {
    bf16_t* XR; bf16_t* SG;
    DEVI void operator()(int row, int n0, int cl, const float (&v)[4]) const {
        for (int j = 0; j < 4; ++j) { const int col = n0 + cl + 64 * j;
            if (col < 2048) XR[(size_t)row * 2048 + col] = f2bf(v[j]); else if (row < NLAT) SG[(size_t)row * 2048 + col - 2048] = f2bf(siluf_(v[j])); }
    }
};

__device__ void st_glaprep(const Params& p, int vb, int nvb, unsigned char* ldsb, const bf16_t* QK, const bf16_t* V, const float* ALR, bf16_t* QIN, bf16_t* KET, bf16_t* SC, float* DEC, bf16_t* VT) {
    bf16_t* qs = (bf16_t*)ldsb;
    bf16_t* ks = qs + 64 * 136;
    float* tot = (float*)(ks + 64 * 136);
    bf16_t* vs = (bf16_t*)(tot + 4 * 128);
    const int tid = threadIdx.x, kk = tid & 127, tq = tid >> 7;
    for (int u = vb; u < NB * NCH * 4 * 2; u += nvb) {
        const int d = u & 1, h = (u >> 1) & 3, bc = u >> 3, c = bc % NCH, bb = bc / NCH;
        const int row0 = row_of(bb, c, 0);
        float w2[16];
#pragma unroll
        for (int r = 0; r < 16; ++r) w2[r] = p.e_w_a2[((size_t)d * 16 + r) * 512 + h * 128 + kk];
        const float b2 = p.e_b_a2[d * 512 + h * 128 + kk];
        float lg[16];
#pragma unroll
        for (int i = 0; i < 16; ++i) { const float* a = ALR + (size_t)(row0 + tq * 16 + i) * 32 + d * 16; float z = b2;
#pragma unroll
            for (int r = 0; r < 16; ++r) z += a[r] * w2[r];
            lg[i] = logsigmoidf_(z) * (1.f / 16.f); }
        float bcum[16];
        if (d == 0) { float s = 0.f;
#pragma unroll
            for (int i = 0; i < 16; ++i) { s += lg[i]; bcum[i] = s; } tot[tq * 128 + kk] = s; }
        else { float s = 0.f;
#pragma unroll
            for (int i = 15; i >= 0; --i) { s += lg[i]; bcum[i] = s; } tot[tq * 128 + kk] = s; }
        __syncthreads();
        float off = 0.f, blast = 0.f;
        for (int q = 0; q < 4; ++q) { const float tv = tot[q * 128 + kk]; blast += tv; if (d == 0 ? (q < tq) : (q > tq)) off += tv; }
        const float scale = 0.08838834764831845f;
        unsigned short ke[16];
#pragma unroll
        for (int i = 0; i < 16; ++i) { const int t = tq * 16 + i; const float b = bcum[i] + off;
            const float qv = bf2f(QK[(size_t)(row0 + t) * 1024 + h * 128 + kk]) * scale, kv = bf2f(QK[(size_t)(row0 + t) * 1024 + 512 + h * 128 + kk]);
            const bf16_t qi = f2bf(qv * __expf(b)), ki = f2bf(kv * __expf(-b));
            qs[t * 136 + kk] = qi; ks[t * 136 + kk] = ki; ke[i] = f2bf(kv * __expf(blast - b));
            QIN[((size_t)u * 64 + t) * 128 + kk] = qi; }
        { uint4 w0, w1; w0.x = ke[0] | (ke[1] << 16); w0.y = ke[2] | (ke[3] << 16); w0.z = ke[4] | (ke[5] << 16); w0.w = ke[6] | (ke[7] << 16);
          w1.x = ke[8] | (ke[9] << 16); w1.y = ke[10] | (ke[11] << 16); w1.z = ke[12] | (ke[13] << 16); w1.w = ke[14] | (ke[15] << 16);
          uint4* dst = (uint4*)(KET + ((size_t)u * 128 + kk) * 64 + tq * 16); dst[0] = w0; dst[1] = w1; }
        if (tq == 0) DEC[(size_t)u * 128 + kk] = __expf(blast);
        for (int e = tid; e < 64 * 128; e += NTHREADS) { const int t = e >> 7, cc = e & 127; vs[t * 130 + cc] = V[(size_t)(row0 + t) * 1024 + h * 256 + d * 128 + cc]; }
        __syncthreads();
        for (int e = tid; e < 64 * 64; e += NTHREADS) { const int t = e >> 6, s = e & 63; float a = 0.f;
            if (d == 0 ? (s <= t) : (s >= t)) { for (int k2 = 0; k2 < 128; ++k2) a += bf2f(qs[t * 136 + k2]) * bf2f(ks[s * 136 + k2]); }
            SC[((size_t)u * 64 + t) * 64 + s] = f2bf(a); }
        { unsigned short vv[16];
#pragma unroll
          for (int i = 0; i < 16; ++i) vv[i] = vs[(tq * 16 + i) * 130 + kk];
          uint4 w0, w1; w0.x = vv[0] | (vv[1] << 16); w0.y = vv[2] | (vv[3] << 16); w0.z = vv[4] | (vv[5] << 16); w0.w = vv[6] | (vv[7] << 16);
          w1.x = vv[8] | (vv[9] << 16); w1.y = vv[10] | (vv[11] << 16); w1.z = vv[12] | (vv[13] << 16); w1.w = vv[14] | (vv[15] << 16);
          uint4* dst = (uint4*)(VT + (((size_t)(u >> 1)) * 256 + d * 128 + kk) * 64 + tq * 16); dst[0] = w0; dst[1] = w1; }
        __syncthreads();
    }
}

__device__ void st_glawalk_naive(const Params& p, int vb, int nvb, float* Sl, const bf16_t* QIN, const bf16_t* KET, const bf16_t* SC, const float* DEC, const bf16_t* VT, bf16_t* OF, bf16_t* OB) {
    const int vc = threadIdx.x & 255, half = threadIdx.x >> 8;
    for (int combo = vb; combo < 32; combo += nvb) {
        const int d = combo & 1, h = (combo >> 1) & 3, bb = combo >> 3;
        __syncthreads();
        for (int k = half * 64; k < half * 64 + 64; ++k) Sl[k * 256 + vc] = 0.f;
        __syncthreads();
        bf16_t* O = d == 0 ? OF : OB;
        for (int step = 0; step < NCH; ++step) {
            const int c = d == 0 ? (step < 4 ? 64 + step : step - 4) : 67 - step;
            const int u = ((bb * NCH + c) * 4 + h) * 2 + d;
            const bf16_t* q = QIN + (size_t)u * 64 * 128; const bf16_t* ke = KET + (size_t)u * 128 * 64; const bf16_t* sc = SC + (size_t)u * 64 * 64;
            const bf16_t* vt = VT + (((size_t)(u >> 1)) * 256 + vc) * 64;
            float vv[64];
#pragma unroll
            for (int t = 0; t < 64; ++t) vv[t] = bf2f(vt[t]);
            const int row0 = row_of(bb, c, 0);
            for (int t = half * 32; t < half * 32 + 32; ++t) { float a = 0.f;
                for (int k = 0; k < 128; ++k) a += bf2f(q[t * 128 + k]) * bf2f(f2bf(Sl[k * 256 + vc]));
#pragma unroll
                for (int s = 0; s < 64; ++s) a += bf2f(sc[t * 64 + s]) * vv[s];
                O[(size_t)(row0 + t) * 1024 + h * 256 + vc] = f2bf(a); }
            __syncthreads();
            for (int k = half * 64; k < half * 64 + 64; ++k) { float a = DEC[(size_t)u * 128 + k] * Sl[k * 256 + vc];
#pragma unroll
                for (int t = 0; t < 64; ++t) a += bf2f(ke[k * 64 + t]) * vv[t];
                Sl[k * 256 + vc] = a; }
            __syncthreads();
        }
    }
}

__device__ void st_inner(const Params& p, int vb, int nvb, const bf16_t* OF, const bf16_t* OB, const bf16_t* SGA, const bf16_t* Z, const bf16_t* CBG, bf16_t* INNER) {
    const int lane = threadIdx.x & 63, gw = vb * (NTHREADS / 64) + (threadIdx.x >> 6), ngw = nvb * (NTHREADS / 64);
    for (int row = gw; row < NT; row += ngw) {
        bool hasp, hasn;
        if (row < NLAT) { const int t = row & 63; hasp = t != 0; hasn = t != 63; } else { const int t = (row - NLAT) & 255; hasp = t != 0; hasn = t != 255; }
#pragma unroll
        for (int h = 0; h < 4; ++h) {
            const int c0 = h * 256 + lane * 4;
            const ushort4 a = *(const ushort4*)(OF + (size_t)row * 1024 + c0), b = *(const ushort4*)(OB + (size_t)row * 1024 + c0);
            const float o0 = bf2f(a.x) + bf2f(b.x), o1 = bf2f(a.y) + bf2f(b.y), o2 = bf2f(a.z) + bf2f(b.z), o3 = bf2f(a.w) + bf2f(b.w);
            const float rinv = rsqrtf(wave_sum(o0 * o0 + o1 * o1 + o2 * o2 + o3 * o3) * (1.f / 256.f) + EPS);
            const float4 gg = *(const float4*)(p.e_gla_g + lane * 4);
            const ushort4 sg = *(const ushort4*)(SGA + (size_t)row * 1024 + c0);
            ushort4 o; o.x = f2bf(o0 * rinv * gg.x * bf2f(sg.x)); o.y = f2bf(o1 * rinv * gg.y * bf2f(sg.y)); o.z = f2bf(o2 * rinv * gg.z * bf2f(sg.z)); o.w = f2bf(o3 * rinv * gg.w * bf2f(sg.w));
            *(ushort4*)(INNER + (size_t)row * 2048 + c0) = o;
            const ushort4 zc = *(const ushort4*)(Z + (size_t)row * 1024 + c0);
            ushort4 zp = {0, 0, 0, 0}, zn = {0, 0, 0, 0};
            if (hasp) zp = *(const ushort4*)(Z + (size_t)(row - 1) * 1024 + c0);
            if (hasn) zn = *(const ushort4*)(Z + (size_t)(row + 1) * 1024 + c0);
            const float4 w0 = *(const float4*)(p.e_conv_w + c0), w1 = *(const float4*)(p.e_conv_w + 1024 + c0), w2 = *(const float4*)(p.e_conv_w + 2048 + c0);
            const ushort4 cb = *(const ushort4*)(CBG + (size_t)row * 1024 + c0);
            ushort4 y; y.x = f2bf(bf2f(cb.x) * (w0.x * bf2f(zp.x) + w1.x * bf2f(zc.x) + w2.x * bf2f(zn.x)));
            y.y = f2bf(bf2f(cb.y) * (w0.y * bf2f(zp.y) + w1.y * bf2f(zc.y) + w2.y * bf2f(zn.y)));
            y.z = f2bf(bf2f(cb.z) * (w0.z * bf2f(zp.z) + w1.z * bf2f(zc.z) + w2.z * bf2f(zn.z)));
            y.w = f2bf(bf2f(cb.w) * (w0.w * bf2f(zp.w) + w1.w * bf2f(zc.w) + w2.w * bf2f(zn.w)));
            *(ushort4*)(INNER + (size_t)row * 2048 + 1024 + c0) = y;
        }
    }
}

template <int MODE>
__device__ void st_rglru_naive(const Params& p, int vb, int nvb, float* lds, const bf16_t* XR, const bf16_t* SG, float* SUMA, float* SUMH, bf16_t* Y) {
    float* xc = lds;
    float* av = xc + 64 * 128;
    float* uv = av + 64 * 128;
    float* hf = uv + 64 * 128;
    const int tid = threadIdx.x, j = tid & 127, tq = tid >> 7;
    const int nitems = MODE == 0 ? NB * NCH * 16 * 2 : NB * 64 * 16;
    for (int it = vb; it < nitems; it += nvb) {
        int bb, c, nb;
        if (MODE == 0) { nb = (it >> 1) & 15; const int bc = it >> 5; c = bc % NCH; bb = bc / NCH; } else { nb = it & 15; const int bc = it >> 4; c = bc & 63; bb = bc >> 6; }
        const int row0 = row_of(bb, c, 0);
        const int seg0 = c < 64 ? bb * 4096 : NLAT + bb * 256, segn = c < 64 ? 4096 : 256;
        const int tl0 = row0 - seg0;
        for (int dd = 0; dd < (MODE == 0 ? 1 : 2); ++dd) {
            const int d = MODE == 0 ? (it & 1) : dd;
            __syncthreads();
            for (int e = tid; e < 64 * 128; e += NTHREADS) { const int t = e >> 7, i = e & 127, ch = nb * 128 + i; float a = p.o_conv_b[d * 2048 + ch];
#pragma unroll
                for (int jj = 0; jj < 4; ++jj) { const int tt = d == 0 ? tl0 + t - 3 + jj : tl0 + t + 3 - jj;
                    if (tt >= 0 && tt < segn) a += p.o_conv_w[((size_t)d * 4 + jj) * 2048 + ch] * bf2f(XR[(size_t)(seg0 + tt) * 2048 + ch]); }
                xc[e] = a; }
            __syncthreads();
            const float* WA = p.o_w_a + ((size_t)d * 16 + nb) * 128 * 128; const float* WX = p.o_w_x + ((size_t)d * 16 + nb) * 128 * 128;
            const int ch = nb * 128 + j;
            const float ba = p.o_b_a[d * 2048 + ch], bx = p.o_b_x[d * 2048 + ch], sp = softplusf_(-p.o_lam[d * 2048 + ch]);
            for (int i16 = 0; i16 < 16; ++i16) { const int t = tq * 16 + i16; float ra = ba, rx = bx;
                for (int i = 0; i < 128; ++i) { const float xv = bf2f(f2bf(xc[t * 128 + i])); ra += xv * bf2f(f2bf(WA[i * 128 + j])); rx += xv * bf2f(f2bf(WX[i * 128 + j])); }
                const float r = sigmoidf_(ra), ig = sigmoidf_(rx); const float la = -8.f * r * sp; const float a = __expf(la);
                av[t * 128 + j] = a; uv[t * 128 + j] = sqrtf(-expm1f(2.f * la)) * (ig * xc[t * 128 + j]); }
            __syncthreads();
            if (tid < 128) {
                const size_t sidx = (((size_t)bb * 2 + d) * NCH + c) * 2048 + ch;
                if (MODE == 0) { float A = 1.f, hh = 0.f;
                    if (d == 0) for (int t = 0; t < 64; ++t) { const float a = av[t * 128 + j]; hh = a * hh + uv[t * 128 + j]; A *= a; }
                    else for (int t = 63; t >= 0; --t) { const float a = av[t * 128 + j]; hh = a * hh + uv[t * 128 + j]; A *= a; }
                    SUMA[sidx] = A; SUMH[sidx] = hh;
                } else { float hh = SUMH[sidx];
                    if (d == 0) for (int t = 0; t < 64; ++t) { hh = av[t * 128 + j] * hh + uv[t * 128 + j]; hf[t * 128 + j] = hh; }
                    else for (int t = 63; t >= 0; --t) { hh = av[t * 128 + j] * hh + uv[t * 128 + j]; const size_t o = (size_t)(row0 + t) * 2048 + ch; Y[o] = f2bf((hf[t * 128 + j] + hh) * bf2f(SG[o])); }
                }
            }
        }
    }
    __syncthreads();
}
__device__ void st_carry(const Params& p, int vb, int nvb, const float* SUMA, float* SUMH) {
    for (int e = vb * NTHREADS + threadIdx.x; e < NB * 2 * 2048; e += nvb * NTHREADS) {
        const int ch = e & 2047, d = (e >> 11) & 1, bb = e >> 12; float hh = 0.f;
        for (int step = 0; step < NCH; ++step) { const int c = d == 0 ? (step < 4 ? 64 + step : step - 4) : 67 - step;
            const size_t sidx = (((size_t)bb * 2 + d) * NCH + c) * 2048 + ch; const float A = SUMA[sidx], hl = SUMH[sidx]; SUMH[sidx] = hh; hh = A * hh + hl; }
    }
}
__device__ void st_final(const Params& p, int vb, int nvb) {
    const int lane = threadIdx.x & 63, gw = vb * (NTHREADS / 64) + (threadIdx.x >> 6), ngw = nvb * (NTHREADS / 64);
    for (int row = gw; row < NLAT; row += ngw) { float* xr = p.out + (size_t)row * 1024; float4 v[4]; float ss = 0.f;
#pragma unroll
        for (int j = 0; j < 4; ++j) { v[j] = *(const float4*)(xr + j * 256 + lane * 4); ss += v[j].x * v[j].x + v[j].y * v[j].y + v[j].z * v[j].z + v[j].w * v[j].w; }
        const float rinv = rsqrtf(wave_sum(ss) * (1.f / 1024.f) + EPS);
#pragma unroll
        for (int j = 0; j < 4; ++j) { const float4 g = *(const float4*)(p.final_g + j * 256 + lane * 4); float4 o; o.x = v[j].x * rinv * g.x; o.y = v[j].y * rinv * g.y; o.z = v[j].z * rinv * g.z; o.w = v[j].w * rinv * g.w; *(float4*)(xr + j * 256 + lane * 4) = o; }
    }
}

__device__ __forceinline__ void run_stage(const Params& p, int st, int vb, int nvb, unsigned char* lds) {
    unsigned char* ws = p.ws;
    float* MOD = (float*)(ws + WS_MOD); float* ALR = (float*)(ws + WS_ALR); float* X1C = (float*)(ws + WS_X1C);
    float* SUMA = (float*)(ws + WS_SUMA); float* SUMH = (float*)(ws + WS_SUMH); float* DEC = (float*)(ws + WS_DEC);
    bf16_t* Bt1 = (bf16_t*)(ws + WS_BT1); bf16_t* Bt2 = (bf16_t*)(ws + WS_BT2); bf16_t* Bt3 = (bf16_t*)(ws + WS_BT3); bf16_t* Bt4 = (bf16_t*)(ws + WS_BT4);
    bf16_t* S0 = (bf16_t*)(ws + WS_SLOT(0)); bf16_t* S1 = (bf16_t*)(ws + WS_SLOT(1)); bf16_t* S2 = (bf16_t*)(ws + WS_SLOT(2));
    bf16_t* S3 = (bf16_t*)(ws + WS_SLOT(3)); bf16_t* S4 = (bf16_t*)(ws + WS_SLOT(4)); bf16_t* S5 = (bf16_t*)(ws + WS_SLOT(5));
    bf16_t* DO0 = (bf16_t*)p.out; bf16_t* DOSC = (bf16_t*)((unsigned char*)p.out + 34 * MiB);
    switch (st) {
    case 0: st_mod(p, vb, nvb, (float*)lds); st_wprep(p, vb, nvb); break;
    case 1: st_modulate(p, vb, nvb, 0, p.x, p.ctx, S0); break;
    case 2: { Epi1 E{S1, S2, S3, S4, S5, ALR}; st_gemm_naive(vb, nvb, (float*)lds, S0, Bt1, 0, NT / 32, 0, 8, 1024, E); st_gemm_naive(vb, nvb, (float*)lds, S0, Bt1, 0, NT / 32, 12, 13, 1024, E); } break;
    case 3: st_glaprep(p, vb, nvb, lds, S1, S2, ALR, S3, S4, DOSC, DEC, S5); break;
    case 4: st_glawalk_naive(p, vb, nvb, (float*)lds, S3, S4, DOSC, DEC, S5, S2, DO0); break;
    case 5: { Epi1 E{S1, S2, S3, S4, S5, ALR}; st_gemm_naive(vb, nvb, (float*)lds, S0, Bt1, 0, NT / 32, 8, 12, 1024, E); st_gemm_naive(vb, nvb, (float*)lds, S0, Bt1, 0, NT / 32, 13, 29, 1024, E); } break;
    case 6: st_inner(p, vb, nvb, S2, DO0, S3, S4, S5, S0); break;
    case 7: { EpiRes E{p.x, p.ctx, p.out, X1C, MOD}; st_gemm_naive(vb, nvb, (float*)lds, S0, Bt2, 0, NT / 32, 0, 4, 2048, E); } break;
    case 8: st_modulate(p, vb, nvb, 1, p.out, X1C, S2); break;
    case 9: { Epi3 E{S3, S0}; st_gemm_naive(vb, nvb, (float*)lds, S2, Bt3, 0, NLAT / 32, 0, 16, 1024, E); st_gemm_naive(vb, nvb, (float*)lds, S2, Bt3, NLAT / 32, NT / 32, 0, 8, 1024, E); } break;
    case 10: st_rglru_naive<0>(p, vb, nvb, (float*)lds, S3, S0, SUMA, SUMH, S0); break;
    case 11: st_carry(p, vb, nvb, SUMA, SUMH); break;
    case 12: st_rglru_naive<1>(p, vb, nvb, (float*)lds, S3, S0, SUMA, SUMH, S0); break;
    case 13: { EpiRes E{p.out, nullptr, p.out, nullptr, MOD + 5 * 3072}; st_gemm_naive(vb, nvb, (float*)lds, S0, Bt4, 0, NLAT / 32, 0, 4, 2048, E); } break;
    case 14: st_final(p, vb, nvb); break;
    }
}
constexpr int NSTAGES = 15;
constexpr int LDS_BYTES = 147456;

#ifndef ONE_LAUNCH
#define ONE_LAUNCH 1
#endif
#if !ONE_LAUNCH
__global__ void __launch_bounds__(NTHREADS) k_mega(Params p, int st) {
    extern __shared__ __attribute__((aligned(16))) unsigned char lds[];
    run_stage(p, st, blockIdx.x, gridDim.x, lds);
}
#else
__global__ void __launch_bounds__(NTHREADS) k_mega(Params p) {
    extern __shared__ __attribute__((aligned(16))) unsigned char lds[];
    cg::grid_group grid = cg::this_grid();
#define RS(k) run_stage(p, k, blockIdx.x, gridDim.x, lds)
    RS(0); grid.sync(); RS(1); grid.sync(); RS(2); grid.sync(); RS(3); grid.sync(); RS(4); grid.sync(); RS(5); grid.sync(); RS(6); grid.sync(); RS(7); grid.sync();
    RS(8); grid.sync(); RS(9); grid.sync(); RS(10); grid.sync(); RS(11); grid.sync(); RS(12); grid.sync(); RS(13); grid.sync(); RS(14);
#undef RS
}
#endif

extern "C" void kernel_launch(void* const* d_in, const int* in_sizes, int n_in, void* d_out, int out_size, void* d_ws, size_t ws_size, hipStream_t stream) {
    static int inited = 0, grid_blocks = 0;
    if (!inited) {
        if (n_in != 23 || ws_size < WS_END || out_size != NLAT * D) { fprintf(stderr, "kernel_launch: unexpected shapes n_in %d ws %zu out %d\n", n_in, ws_size, out_size); inited = -1; return; }
        if (hipFuncSetAttribute((const void*)k_mega, hipFuncAttributeMaxDynamicSharedMemorySize, LDS_BYTES) != hipSuccess) { fprintf(stderr, "hipFuncSetAttribute failed\n"); inited = -1; return; }
        int dev = 0, cus = 0, per_cu = 0;
        (void)hipGetDevice(&dev); (void)hipDeviceGetAttribute(&cus, hipDeviceAttributeMultiprocessorCount, dev);
        (void)hipOccupancyMaxActiveBlocksPerMultiprocessor(&per_cu, (const void*)k_mega, NTHREADS, LDS_BYTES);
        if (per_cu < 1) { fprintf(stderr, "kernel_launch: occupancy query says %d blocks per CU\n", per_cu); per_cu = 1; }
        if (per_cu > 1) per_cu = 1;
        grid_blocks = cus * per_cu;
        inited = 1;
    }
    if (inited < 0) return;
    Params p{};
    const float** f = (const float**)&p;
    for (int i = 0; i < 23; ++i) f[i] = (const float*)d_in[i];
    p.out = (float*)d_out; p.ws = (unsigned char*)d_ws;
#if ONE_LAUNCH
    void* args[] = {&p};
    hipError_t e = hipLaunchCooperativeKernel((const void*)k_mega, dim3(grid_blocks), dim3(NTHREADS), args, LDS_BYTES, stream);
    if (e != hipSuccess) fprintf(stderr, "cooperative launch failed: %s (grid %d)\n", hipGetErrorString(e), grid_blocks);
#else
    for (int st = 0; st < NSTAGES; ++st) hipLaunchKernelGGL(k_mega, dim3(1024), dim3(NTHREADS), LDS_BYTES, stream, p, st);
#endif
}
```

```cpp
#include <hip/hip_runtime.h>
#include <hip/hip_cooperative_groups.h>
namespace cg = cooperative_groups;
#include <cstdio>
#include <cstdint>

typedef unsigned short bf16_t;
#define DEVI __device__ __forceinline__

constexpr int D = 1024, NB = 4, SEQ = 4096, CTXL = 256;
constexpr int NLAT = NB * SEQ;
constexpr int NCTX = NB * CTXL;
constexpr int NT = NLAT + NCTX;
constexpr int NCH = 68;
constexpr int EVEN_IN = 7200;
constexpr int N1 = 7424;
constexpr int N1A = 13 * 256;
constexpr int RGW = 2048;
constexpr float EPS = 1e-6f;

constexpr size_t MiB = 1u << 20;
constexpr size_t WS_CTL = 0;
constexpr size_t WS_MOD = 1 * MiB;
constexpr size_t WS_ALR = 2 * MiB;
constexpr size_t WS_X1C = 5 * MiB;
constexpr size_t WS_SUMA = 9 * MiB;
constexpr size_t WS_SUMH = 9 * MiB + 4608 * 1024;
constexpr size_t WS_DEC = 18 * MiB;
constexpr size_t WS_BT1 = 19 * MiB + 512 * 1024;
constexpr size_t WS_BT2 = 34 * MiB;
constexpr size_t WS_BT3 = 38 * MiB;
constexpr size_t WS_BT4 = 46 * MiB;
constexpr size_t WS_BD = 50 * MiB;
constexpr size_t WS_S0 = 52 * MiB;
constexpr size_t SLOT = 34 * MiB;
constexpr size_t WS_END = WS_S0 + 6 * SLOT;
static_assert(WS_END == 256 * MiB, "ws map");
#define WS_SLOT(i) (WS_S0 + (size_t)(i) * SLOT)

struct Params {
    const float* x; const float* c; const float* ctx; const float* c_ctx; const float* norm_g; const float* w_mod; const float* b_mod;
    const float* e_w_in; const float* e_w_a2; const float* e_b_a2; const float* e_gla_g; const float* e_conv_w; const float* e_w_out;
    const float* o_w_in; const float* o_conv_w; const float* o_conv_b; const float* o_w_a; const float* o_b_a; const float* o_w_x; const float* o_b_x;
    const float* o_lam; const float* o_w_out; const float* final_g;
    float* out; unsigned char* ws;
};

DEVI float bf2f(bf16_t v) { return __uint_as_float((unsigned)v << 16); }
DEVI bf16_t f2bf(float f) { unsigned u = __float_as_uint(f); return (bf16_t)((u + 0x7fffu + ((u >> 16) & 1u)) >> 16); }
DEVI float sigmoidf_(float x) { return 1.0f / (1.0f + __expf(-x)); }
DEVI float siluf_(float x) { return x / (1.0f + __expf(-x)); }
DEVI float softplusf_(float x) { return fmaxf(x, 0.f) + log1pf(__expf(-fabsf(x))); }
DEVI float logsigmoidf_(float x) { return fminf(x, 0.f) - log1pf(__expf(-fabsf(x))); }
DEVI int row_of(int bb, int c, int t) { return c < 64 ? bb * 4096 + c * 64 + t : NLAT + bb * 256 + (c - 64) * 64 + t; }
DEVI int mod_idx(int row) { return row < NLAT ? (row >> 12) : 4; }
DEVI float wave_sum(float v) {
#pragma unroll
    for (int o = 1; o < 64; o <<= 1) v += __shfl_xor(v, o);
    return v;
}
__host__ __device__ inline int colmap1(int n) {
    const int t = n >> 8, c = n & 255;
    if (t < 12) return n;
    if (t == 12) return c < 32 ? 3072 + c : -1;
    if (t < 21) { const int j = t - 13; return c < 128 ? 4128 + 128 * j + c : 5152 + 128 * j + (c - 128); }
    const int j = t - 21; return c < 128 ? 3104 + 128 * j + c : 6176 + 128 * j + (c - 128);
}

#define NTHREADS 512

__device__ void st_mod(const Params& p, int vb, int nvb, float* lds) {
    float* MOD = (float*)(p.ws + WS_MOD);
    for (int i = threadIdx.x; i < 5 * 1024; i += NTHREADS) { const int s = i >> 10, k = i & 1023; const float v = s < 4 ? p.c[s * 1024 + k] : p.c_ctx[k]; lds[i] = siluf_(v); }
    __syncthreads();
    for (int it = vb; it < 2 * 6; it += nvb) {
        const int li = it / 6, j = (it % 6) * 512 + threadIdx.x;
        const float* W = p.w_mod + (size_t)li * 1024 * 3072 + j;
        float a0 = 0.f, a1 = 0.f, a2 = 0.f, a3 = 0.f, a4 = 0.f;
        for (int k = 0; k < 1024; ++k) { const float w = W[(size_t)k * 3072]; a0 += lds[k] * w; a1 += lds[1024 + k] * w; a2 += lds[2048 + k] * w; a3 += lds[3072 + k] * w; a4 += lds[4096 + k] * w; }
        const float bv = p.b_mod[li * 3072 + j];
        float* o = MOD + (size_t)li * 5 * 3072 + j;
        o[0] = a0 + bv; o[3072] = a1 + bv; o[2 * 3072] = a2 + bv; o[3 * 3072] = a3 + bv; o[4 * 3072] = a4 + bv;
    }
    __syncthreads();
}

__device__ void st_wprep(const Params& p, int vb, int nvb) {
    bf16_t* Bt1 = (bf16_t*)(p.ws + WS_BT1); bf16_t* Bt2 = (bf16_t*)(p.ws + WS_BT2); bf16_t* Bt3 = (bf16_t*)(p.ws + WS_BT3); bf16_t* Bt4 = (bf16_t*)(p.ws + WS_BT4);
    bf16_t* BD = (bf16_t*)(p.ws + WS_BD);
    const size_t gtid = (size_t)vb * NTHREADS + threadIdx.x, gn = (size_t)nvb * NTHREADS;
    for (size_t e = gtid; e < (size_t)N1 * 1024; e += gn) { const int k = (int)(e / N1), n = (int)(e % N1); const int sc = colmap1(n); Bt1[(size_t)n * 1024 + k] = sc < 0 ? (bf16_t)0 : f2bf(p.e_w_in[(size_t)k * EVEN_IN + sc]); }
    for (size_t e = gtid; e < (size_t)2048 * 1024; e += gn) { const int k = (int)(e / 1024), n = (int)(e % 1024); Bt2[(size_t)n * 2048 + k] = f2bf(p.e_w_out[e]); Bt4[(size_t)n * 2048 + k] = f2bf(p.o_w_out[e]); }
    for (size_t e = gtid; e < (size_t)1024 * 4096; e += gn) { const int k = (int)(e / 4096), n = (int)(e % 4096); Bt3[(size_t)n * 1024 + k] = f2bf(p.o_w_in[e]); }
    for (size_t e = gtid; e < (size_t)2 * 16 * 128 * 128; e += gn) { const int j = (int)(e & 127), i = (int)((e >> 7) & 127), dn = (int)(e >> 14);
        BD[((size_t)dn * 128 + j) * 128 + i] = f2bf(p.o_w_a[e]); BD[(size_t)2 * 16 * 128 * 128 + ((size_t)dn * 128 + j) * 128 + i] = f2bf(p.o_w_x[e]); }
}

__device__ void st_modulate(const Params& p, int vb, int nvb, int li, const float* xlat, const float* xctx, bf16_t* H) {
    const float* MOD = (const float*)(p.ws + WS_MOD) + (size_t)li * 5 * 3072;
    const float* g = p.norm_g + li * 1024;
    const int lane = threadIdx.x & 63, gw = vb * (NTHREADS / 64) + (threadIdx.x >> 6), ngw = nvb * (NTHREADS / 64);
    for (int row = gw; row < NT; row += ngw) {
        const float* xr = row < NLAT ? xlat + (size_t)row * 1024 : xctx + (size_t)(row - NLAT) * 1024;
        const float* md = MOD + (size_t)mod_idx(row) * 3072;
        float4 v[4]; float ss = 0.f;
#pragma unroll
        for (int j = 0; j < 4; ++j) { v[j] = *(const float4*)(xr + j * 256 + lane * 4); ss += v[j].x * v[j].x + v[j].y * v[j].y + v[j].z * v[j].z + v[j].w * v[j].w; }
        const float rinv = rsqrtf(wave_sum(ss) * (1.f / 1024.f) + EPS);
#pragma unroll
        for (int j = 0; j < 4; ++j) { const int c0 = j * 256 + lane * 4; const float4 gg = *(const float4*)(g + c0), sh = *(const float4*)(md + c0), sc = *(const float4*)(md + 1024 + c0);
            ushort4 o; o.x = f2bf(v[j].x * rinv * gg.x * (1.f + sc.x) + sh.x); o.y = f2bf(v[j].y * rinv * gg.y * (1.f + sc.y) + sh.y);
            o.z = f2bf(v[j].z * rinv * gg.z * (1.f + sc.z) + sh.z); o.w = f2bf(v[j].w * rinv * gg.w * (1.f + sc.w) + sh.w);
            *(ushort4*)(H + (size_t)row * 1024 + c0) = o; }
    }
}

template <class Epi>
__device__ void st_gemm_naive(int vb, int nvb, float* lds, const bf16_t* A, const bf16_t* Bt, int mt0, int mt1, int nt0, int nt1, int K, const Epi& E) {
    float* As = lds;
    float* Bs = lds + 32 * 33;
    const int tid = threadIdx.x, tx = tid & 63, ty = tid >> 6;
    const int nmt = mt1 - mt0, nnt = nt1 - nt0;
    for (int it = vb; it < nmt * nnt; it += nvb) {
        const int m0 = (mt0 + it / nnt) * 32, n0 = (nt0 + it % nnt) * 256;
        float acc[4][4];
#pragma unroll
        for (int i = 0; i < 4; ++i)
#pragma unroll
            for (int j = 0; j < 4; ++j) acc[i][j] = 0.f;
        for (int k0 = 0; k0 < K; k0 += 32) {
            __syncthreads();
            for (int e = tid; e < 32 * 32; e += NTHREADS) { const int r = e >> 5, kk = e & 31; As[r * 33 + kk] = bf2f(A[(size_t)(m0 + r) * K + k0 + kk]); }
            for (int e = tid; e < 256 * 32; e += NTHREADS) { const int r = e >> 5, kk = e & 31; Bs[r * 33 + kk] = bf2f(Bt[(size_t)(n0 + r) * K + k0 + kk]); }
            __syncthreads();
#pragma unroll 8
            for (int kk = 0; kk < 32; ++kk) {
                float a[4], b[4];
#pragma unroll
                for (int i = 0; i < 4; ++i) a[i] = As[(ty * 4 + i) * 33 + kk];
#pragma unroll
                for (int j = 0; j < 4; ++j) b[j] = Bs[(tx + 64 * j) * 33 + kk];
#pragma unroll
                for (int i = 0; i < 4; ++i)
#pragma unroll
                    for (int j = 0; j < 4; ++j) acc[i][j] += a[i] * b[j];
            }
        }
#pragma unroll
        for (int i = 0; i < 4; ++i) E(m0 + ty * 4 + i, n0, tx, acc[i]);
    }
    __syncthreads();
}

struct Epi1 {
    bf16_t *QK, *V, *SGA, *Z, *CBG; float* ALR;
    DEVI void operator()(int row, int n0, int cl, const float (&v)[4]) const {
        const int t = n0 >> 8;
        if (t < 4) { for (int j = 0; j < 4; ++j) QK[(size_t)row * 1024 + n0 + cl + 64 * j] = f2bf(v[j]); }
        else if (t < 8) { for (int j = 0; j < 4; ++j) V[(size_t)row * 1024 + (n0 - 1024) + cl + 64 * j] = f2bf(v[j]); }
        else if (t < 12) { for (int j = 0; j < 4; ++j) SGA[(size_t)row * 1024 + (n0 - 2048) + cl + 64 * j] = f2bf(siluf_(v[j])); }
        else if (t == 12) { if (cl < 32) ALR[(size_t)row * 32 + cl] = v[0]; }
        else if (t < 21) { const int jt = t - 13; Z[(size_t)row * 1024 + 128 * jt + cl] = f2bf(v[0] * v[2]); Z[(size_t)row * 1024 + 128 * jt + cl + 64] = f2bf(v[1] * v[3]); }
        else { const int jt = t - 21; CBG[(size_t)row * 1024 + 128 * jt + cl] = f2bf(v[0] * siluf_(v[2])); CBG[(size_t)row * 1024 + 128 * jt + cl + 64] = f2bf(v[1] * siluf_(v[3])); }
    }
};
struct EpiRes {
    const float* xl; const float* xc; float* outl; float* outc; const float* MODl;
    DEVI void operator()(int row, int n0, int cl, const float (&v)[4]) const {
        const float* gate = MODl + (size_t)mod_idx(row) * 3072 + 2048;
        for (int j = 0; j < 4; ++j) { const int col = n0 + cl + 64 * j;
            if (row < NLAT) outl[(size_t)row * 1024 + col] = xl[(size_t)row * 1024 + col] + gate[col] * v[j];
            else if (outc) outc[(size_t)(row - NLAT) * 1024 + col] = xc[(size_t)(row - NLAT) * 1024 + col] + gate[col] * v[j]; }
    }
};
struct Epi3 {
    bf16_t* XR; bf16_t* SG;
    DEVI void operator()(int row, int n0, int cl, const float (&v)[4]) const {
        for (int j = 0; j < 4; ++j) { const int col = n0 + cl + 64 * j;
            if (col < 2048) XR[(size_t)row * 2048 + col] = f2bf(v[j]); else if (row < NLAT) SG[(size_t)row * 2048 + col - 2048] = f2bf(siluf_(v[j])); }
    }
};

__device__ void st_glaprep(const Params& p, int vb, int nvb, unsigned char* ldsb, const bf16_t* QK, const bf16_t* V, const float* ALR, bf16_t* QIN, bf16_t* KET, bf16_t* SC, float* DEC, bf16_t* VT) {
    bf16_t* qs = (bf16_t*)ldsb;
    bf16_t* ks = qs + 64 * 136;
    float* tot = (float*)(ks + 64 * 136);
    bf16_t* vs = (bf16_t*)(tot + 4 * 128);
    const int tid = threadIdx.x, kk = tid & 127, tq = tid >> 7;
    for (int u = vb; u < NB * NCH * 4 * 2; u += nvb) {
        const int d = u & 1, h = (u >> 1) & 3, bc = u >> 3, c = bc % NCH, bb = bc / NCH;
        const int row0 = row_of(bb, c, 0);
        float w2[16];
#pragma unroll
        for (int r = 0; r < 16; ++r) w2[r] = p.e_w_a2[((size_t)d * 16 + r) * 512 + h * 128 + kk];
        const float b2 = p.e_b_a2[d * 512 + h * 128 + kk];
        float lg[16];
#pragma unroll
        for (int i = 0; i < 16; ++i) { const float* a = ALR + (size_t)(row0 + tq * 16 + i) * 32 + d * 16; float z = b2;
#pragma unroll
            for (int r = 0; r < 16; ++r) z += a[r] * w2[r];
            lg[i] = logsigmoidf_(z) * (1.f / 16.f); }
        float bcum[16];
        if (d == 0) { float s = 0.f;
#pragma unroll
            for (int i = 0; i < 16; ++i) { s += lg[i]; bcum[i] = s; } tot[tq * 128 + kk] = s; }
        else { float s = 0.f;
#pragma unroll
            for (int i = 15; i >= 0; --i) { s += lg[i]; bcum[i] = s; } tot[tq * 128 + kk] = s; }
        __syncthreads();
        float off = 0.f, blast = 0.f;
        for (int q = 0; q < 4; ++q) { const float tv = tot[q * 128 + kk]; blast += tv; if (d == 0 ? (q < tq) : (q > tq)) off += tv; }
        const float scale = 0.08838834764831845f;
        unsigned short ke[16];
#pragma unroll
        for (int i = 0; i < 16; ++i) { const int t = tq * 16 + i; const float b = bcum[i] + off;
            const float qv = bf2f(QK[(size_t)(row0 + t) * 1024 + h * 128 + kk]) * scale, kv = bf2f(QK[(size_t)(row0 + t) * 1024 + 512 + h * 128 + kk]);
            const bf16_t qi = f2bf(qv * __expf(b)), ki = f2bf(kv * __expf(-b));
            qs[t * 136 + kk] = qi; ks[t * 136 + kk] = ki; ke[i] = f2bf(kv * __expf(blast - b));
            QIN[((size_t)u * 64 + t) * 128 + kk] = qi; }
        { uint4 w0, w1; w0.x = ke[0] | (ke[1] << 16); w0.y = ke[2] | (ke[3] << 16); w0.z = ke[4] | (ke[5] << 16); w0.w = ke[6] | (ke[7] << 16);
          w1.x = ke[8] | (ke[9] << 16); w1.y = ke[10] | (ke[11] << 16); w1.z = ke[12] | (ke[13] << 16); w1.w = ke[14] | (ke[15] << 16);
          uint4* dst = (uint4*)(KET + ((size_t)u * 128 + kk) * 64 + tq * 16); dst[0] = w0; dst[1] = w1; }
        if (tq == 0) DEC[(size_t)u * 128 + kk] = __expf(blast);
        for (int e = tid; e < 64 * 128; e += NTHREADS) { const int t = e >> 7, cc = e & 127; vs[t * 130 + cc] = V[(size_t)(row0 + t) * 1024 + h * 256 + d * 128 + cc]; }
        __syncthreads();
        for (int e = tid; e < 64 * 64; e += NTHREADS) { const int t = e >> 6, s = e & 63; float a = 0.f;
            if (d == 0 ? (s <= t) : (s >= t)) { for (int k2 = 0; k2 < 128; ++k2) a += bf2f(qs[t * 136 + k2]) * bf2f(ks[s * 136 + k2]); }
            SC[((size_t)u * 64 + t) * 64 + s] = f2bf(a); }
        { unsigned short vv[16];
#pragma unroll
          for (int i = 0; i < 16; ++i) vv[i] = vs[(tq * 16 + i) * 130 + kk];
          uint4 w0, w1; w0.x = vv[0] | (vv[1] << 16); w0.y = vv[2] | (vv[3] << 16); w0.z = vv[4] | (vv[5] << 16); w0.w = vv[6] | (vv[7] << 16);
          w1.x = vv[8] | (vv[9] << 16); w1.y = vv[10] | (vv[11] << 16); w1.z = vv[12] | (vv[13] << 16); w1.w = vv[14] | (vv[15] << 16);
          uint4* dst = (uint4*)(VT + (((size_t)(u >> 1)) * 256 + d * 128 + kk) * 64 + tq * 16); dst[0] = w0; dst[1] = w1; }
        __syncthreads();
    }
}

__device__ void st_glawalk_naive(const Params& p, int vb, int nvb, float* Sl, const bf16_t* QIN, const bf16_t* KET, const bf16_t* SC, const float* DEC, const bf16_t* VT, bf16_t* OF, bf16_t* OB) {
    const int vc = threadIdx.x & 255, half = threadIdx.x >> 8;
    for (int combo = vb; combo < 32; combo += nvb) {
        const int d = combo & 1, h = (combo >> 1) & 3, bb = combo >> 3;
        __syncthreads();
        for (int k = half * 64; k < half * 64 + 64; ++k) Sl[k * 256 + vc] = 0.f;
        __syncthreads();
        bf16_t* O = d == 0 ? OF : OB;
        for (int step = 0; step < NCH; ++step) {
            const int c = d == 0 ? (step < 4 ? 64 + step : step - 4) : 67 - step;
            const int u = ((bb * NCH + c) * 4 + h) * 2 + d;
            const bf16_t* q = QIN + (size_t)u * 64 * 128; const bf16_t* ke = KET + (size_t)u * 128 * 64; const bf16_t* sc = SC + (size_t)u * 64 * 64;
            const bf16_t* vt = VT + (((size_t)(u >> 1)) * 256 + vc) * 64;
            float vv[64];
#pragma unroll
            for (int t = 0; t < 64; ++t) vv[t] = bf2f(vt[t]);
            const int row0 = row_of(bb, c, 0);
            for (int t = half * 32; t < half * 32 + 32; ++t) { float a = 0.f;
                for (int k = 0; k < 128; ++k) a += bf2f(q[t * 128 + k]) * bf2f(f2bf(Sl[k * 256 + vc]));
#pragma unroll
                for (int s = 0; s < 64; ++s) a += bf2f(sc[t * 64 + s]) * vv[s];
                O[(size_t)(row0 + t) * 1024 + h * 256 + vc] = f2bf(a); }
            __syncthreads();
            for (int k = half * 64; k < half * 64 + 64; ++k) { float a = DEC[(size_t)u * 128 + k] * Sl[k * 256 + vc];
#pragma unroll
                for (int t = 0; t < 64; ++t) a += bf2f(ke[k * 64 + t]) * vv[t];
                Sl[k * 256 + vc] = a; }
            __syncthreads();
        }
    }
}

__device__ void st_inner(const Params& p, int vb, int nvb, const bf16_t* OF, const bf16_t* OB, const bf16_t* SGA, const bf16_t* Z, const bf16_t* CBG, bf16_t* INNER) {
    const int lane = threadIdx.x & 63, gw = vb * (NTHREADS / 64) + (threadIdx.x >> 6), ngw = nvb * (NTHREADS / 64);
    for (int row = gw; row < NT; row += ngw) {
        bool hasp, hasn;
        if (row < NLAT) { const int t = row & 63; hasp = t != 0; hasn = t != 63; } else { const int t = (row - NLAT) & 255; hasp = t != 0; hasn = t != 255; }
#pragma unroll
        for (int h = 0; h < 4; ++h) {
            const int c0 = h * 256 + lane * 4;
            const ushort4 a = *(const ushort4*)(OF + (size_t)row * 1024 + c0), b = *(const ushort4*)(OB + (size_t)row * 1024 + c0);
            const float o0 = bf2f(a.x) + bf2f(b.x), o1 = bf2f(a.y) + bf2f(b.y), o2 = bf2f(a.z) + bf2f(b.z), o3 = bf2f(a.w) + bf2f(b.w);
            const float rinv = rsqrtf(wave_sum(o0 * o0 + o1 * o1 + o2 * o2 + o3 * o3) * (1.f / 256.f) + EPS);
            const float4 gg = *(const float4*)(p.e_gla_g + lane * 4);
            const ushort4 sg = *(const ushort4*)(SGA + (size_t)row * 1024 + c0);
            ushort4 o; o.x = f2bf(o0 * rinv * gg.x * bf2f(sg.x)); o.y = f2bf(o1 * rinv * gg.y * bf2f(sg.y)); o.z = f2bf(o2 * rinv * gg.z * bf2f(sg.z)); o.w = f2bf(o3 * rinv * gg.w * bf2f(sg.w));
            *(ushort4*)(INNER + (size_t)row * 2048 + c0) = o;
            const ushort4 zc = *(const ushort4*)(Z + (size_t)row * 1024 + c0);
            ushort4 zp = {0, 0, 0, 0}, zn = {0, 0, 0, 0};
            if (hasp) zp = *(const ushort4*)(Z + (size_t)(row - 1) * 1024 + c0);
            if (hasn) zn = *(const ushort4*)(Z + (size_t)(row + 1) * 1024 + c0);
            const float4 w0 = *(const float4*)(p.e_conv_w + c0), w1 = *(const float4*)(p.e_conv_w + 1024 + c0), w2 = *(const float4*)(p.e_conv_w + 2048 + c0);
            const ushort4 cb = *(const ushort4*)(CBG + (size_t)row * 1024 + c0);
            ushort4 y; y.x = f2bf(bf2f(cb.x) * (w0.x * bf2f(zp.x) + w1.x * bf2f(zc.x) + w2.x * bf2f(zn.x)));
            y.y = f2bf(bf2f(cb.y) * (w0.y * bf2f(zp.y) + w1.y * bf2f(zc.y) + w2.y * bf2f(zn.y)));
            y.z = f2bf(bf2f(cb.z) * (w0.z * bf2f(zp.z) + w1.z * bf2f(zc.z) + w2.z * bf2f(zn.z)));
            y.w = f2bf(bf2f(cb.w) * (w0.w * bf2f(zp.w) + w1.w * bf2f(zc.w) + w2.w * bf2f(zn.w)));
            *(ushort4*)(INNER + (size_t)row * 2048 + 1024 + c0) = y;
        }
    }
}

template <int MODE>
__device__ void st_rglru_naive(const Params& p, int vb, int nvb, float* lds, const bf16_t* XR, const bf16_t* SG, float* SUMA, float* SUMH, bf16_t* Y) {
    float* xc = lds;
    float* av = xc + 64 * 128;
    float* uv = av + 64 * 128;
    float* hf = uv + 64 * 128;
    const int tid = threadIdx.x, j = tid & 127, tq = tid >> 7;
    const int nitems = MODE == 0 ? NB * NCH * 16 * 2 : NB * 64 * 16;
    for (int it = vb; it < nitems; it += nvb) {
        int bb, c, nb;
        if (MODE == 0) { nb = (it >> 1) & 15; const int bc = it >> 5; c = bc % NCH; bb = bc / NCH; } else { nb = it & 15; const int bc = it >> 4; c = bc & 63; bb = bc >> 6; }
        const int row0 = row_of(bb, c, 0);
        const int seg0 = c < 64 ? bb * 4096 : NLAT + bb * 256, segn = c < 64 ? 4096 : 256;
        const int tl0 = row0 - seg0;
        for (int dd = 0; dd < (MODE == 0 ? 1 : 2); ++dd) {
            const int d = MODE == 0 ? (it & 1) : dd;
            __syncthreads();
            for (int e = tid; e < 64 * 128; e += NTHREADS) { const int t = e >> 7, i = e & 127, ch = nb * 128 + i; float a = p.o_conv_b[d * 2048 + ch];
#pragma unroll
                for (int jj = 0; jj < 4; ++jj) { const int tt = d == 0 ? tl0 + t - 3 + jj : tl0 + t + 3 - jj;
                    if (tt >= 0 && tt < segn) a += p.o_conv_w[((size_t)d * 4 + jj) * 2048 + ch] * bf2f(XR[(size_t)(seg0 + tt) * 2048 + ch]); }
                xc[e] = a; }
            __syncthreads();
            const float* WA = p.o_w_a + ((size_t)d * 16 + nb) * 128 * 128; const float* WX = p.o_w_x + ((size_t)d * 16 + nb) * 128 * 128;
            const int ch = nb * 128 + j;
            const float ba = p.o_b_a[d * 2048 + ch], bx = p.o_b_x[d * 2048 + ch], sp = softplusf_(-p.o_lam[d * 2048 + ch]);
            for (int i16 = 0; i16 < 16; ++i16) { const int t = tq * 16 + i16; float ra = ba, rx = bx;
                for (int i = 0; i < 128; ++i) { const float xv = bf2f(f2bf(xc[t * 128 + i])); ra += xv * bf2f(f2bf(WA[i * 128 + j])); rx += xv * bf2f(f2bf(WX[i * 128 + j])); }
                const float r = sigmoidf_(ra), ig = sigmoidf_(rx); const float la = -8.f * r * sp; const float a = __expf(la);
                av[t * 128 + j] = a; uv[t * 128 + j] = sqrtf(-expm1f(2.f * la)) * (ig * xc[t * 128 + j]); }
            __syncthreads();
            if (tid < 128) {
                const size_t sidx = (((size_t)bb * 2 + d) * NCH + c) * 2048 + ch;
                if (MODE == 0) { float A = 1.f, hh = 0.f;
                    if (d == 0) for (int t = 0; t < 64; ++t) { const float a = av[t * 128 + j]; hh = a * hh + uv[t * 128 + j]; A *= a; }
                    else for (int t = 63; t >= 0; --t) { const float a = av[t * 128 + j]; hh = a * hh + uv[t * 128 + j]; A *= a; }
                    SUMA[sidx] = A; SUMH[sidx] = hh;
                } else { float hh = SUMH[sidx];
                    if (d == 0) for (int t = 0; t < 64; ++t) { hh = av[t * 128 + j] * hh + uv[t * 128 + j]; hf[t * 128 + j] = hh; }
                    else for (int t = 63; t >= 0; --t) { hh = av[t * 128 + j] * hh + uv[t * 128 + j]; const size_t o = (size_t)(row0 + t) * 2048 + ch; Y[o] = f2bf((hf[t * 128 + j] + hh) * bf2f(SG[o])); }
                }
            }
        }
    }
    __syncthreads();
}
__device__ void st_carry(const Params& p, int vb, int nvb, const float* SUMA, float* SUMH) {
    for (int e = vb * NTHREADS + threadIdx.x; e < NB * 2 * 2048; e += nvb * NTHREADS) {
        const int ch = e & 2047, d = (e >> 11) & 1, bb = e >> 12; float hh = 0.f;
        for (int step = 0; step < NCH; ++step) { const int c = d == 0 ? (step < 4 ? 64 + step : step - 4) : 67 - step;
            const size_t sidx = (((size_t)bb * 2 + d) * NCH + c) * 2048 + ch; const float A = SUMA[sidx], hl = SUMH[sidx]; SUMH[sidx] = hh; hh = A * hh + hl; }
    }
}
__device__ void st_final(const Params& p, int vb, int nvb) {
    const int lane = threadIdx.x & 63, gw = vb * (NTHREADS / 64) + (threadIdx.x >> 6), ngw = nvb * (NTHREADS / 64);
    for (int row = gw; row < NLAT; row += ngw) { float* xr = p.out + (size_t)row * 1024; float4 v[4]; float ss = 0.f;
#pragma unroll
        for (int j = 0; j < 4; ++j) { v[j] = *(const float4*)(xr + j * 256 + lane * 4); ss += v[j].x * v[j].x + v[j].y * v[j].y + v[j].z * v[j].z + v[j].w * v[j].w; }
        const float rinv = rsqrtf(wave_sum(ss) * (1.f / 1024.f) + EPS);
#pragma unroll
        for (int j = 0; j < 4; ++j) { const float4 g = *(const float4*)(p.final_g + j * 256 + lane * 4); float4 o; o.x = v[j].x * rinv * g.x; o.y = v[j].y * rinv * g.y; o.z = v[j].z * rinv * g.z; o.w = v[j].w * rinv * g.w; *(float4*)(xr + j * 256 + lane * 4) = o; }
    }
}


namespace pg8 {
#define PG8_LAS __attribute__((address_space(3)))
typedef short bf16x8 __attribute__((ext_vector_type(8)));
typedef float f32x4 __attribute__((ext_vector_type(4)));
typedef unsigned u32x4 __attribute__((ext_vector_type(4)));
constexpr int BM = 256, BK = 64, HALF = 128, HTB = HALF * BK * 2, STAGE_BYTES = 8 * HTB, NXCD = 8, WGM = 8;
__host__ __device__ __forceinline__ int lds_byte(int r, int c) { const int st = (r >> 4) * 2 + (c >> 5), rr = r & 15, cc = c & 31, ob = rr * 64 + cc * 2; return st * 1024 + (ob ^ (((ob >> 9) & 1) << 5)); }
__host__ __device__ __forceinline__ void stage_rc(int b, int& R, int& C) { const int st = b / 1024, sb = b % 1024, swz = sb ^ (((sb >> 9) & 1) << 5); R = (st >> 1) * 16 + swz / 64; C = (st & 1) * 32 + (swz % 64) / 2; }
__host__ __device__ __forceinline__ int perm32(int rho) { const int n = rho >> 4, i = rho & 15; return 8 * (i >> 2) + 4 * n + (i & 3); }
struct Unit { int pm, pn; };
struct Gemm { const bf16_t* A; const bf16_t* Bt; int M, N, K; };
struct TileOrder {
    int nM, nN, nwg, G, c, m0, split, base0, base1, nM2, nN2, m02;
    __device__ void init(int nM_, int nN_, int G_, int c_, int m0_ = 0, int split_ = 1 << 30, int base0_ = 0, int base1_ = 0, int nM2_ = 0, int nN2_ = 0, int m02_ = 0) {
        nM = nM_; nN = nN_; nwg = nM * nN; G = G_; c = c_; m0 = m0_; split = split_; base0 = base0_; base1 = base1_; nM2 = nM2_; nN2 = nN2_; m02 = m02_; }
    __device__ bool next(int i, Unit& u) const {
        const long L = (long)i * G + c;
        if (L >= nwg) { const long L2 = L - nwg; if (L2 >= (long)nM2 * nN2) return false; u.pm = m02 + (int)(L2 / nN2); u.pn = (int)(L2 % nN2); return true; }
        int wgid = (int)L; { const int q = nwg / NXCD, r = nwg % NXCD, xcd = wgid % NXCD, off = wgid / NXCD; wgid = (xcd < r ? xcd * (q + 1) : r * (q + 1) + (xcd - r) * q) + off; }
        const int nig = WGM * nN, gid = wgid / nig, fm = gid * WGM, gsz = (nM - fm) < WGM ? (nM - fm) : WGM;
        const int pm = fm + ((wgid % nig) % gsz), j = (wgid % nig) / gsz;
        u.pm = m0 + pm; u.pn = j < split ? base0 + j : base1 + (j - split); return true;
    }
    __device__ __forceinline__ void a_ready(const Unit&) const {}
    __device__ __forceinline__ void done(const Unit&) const {}
};
__device__ __forceinline__ unsigned cvt_pk_bf16(float lo, float hi) { unsigned r; asm volatile("v_cvt_pk_bf16_f32 %0, %1, %2" : "=v"(r) : "v"(lo), "v"(hi)); return r; }
template <class Epi, class Sched, bool ALIGN_EPI = false, bool SP2 = false>
__device__ __forceinline__ void gemm_phase(PG8_LAS unsigned char* lds, const Gemm g, const Sched& S, const Epi& E) {
    const int tid = threadIdx.x, wid = __builtin_amdgcn_readfirstlane(tid >> 6), lane = tid & 63, wr = wid >> 2, wc = wid & 3, fr = lane & 15, fq = lane >> 4;
    const int K = g.K, nt = K / BK;
    unsigned voffA[2], voffB[2];
#pragma unroll
    for (int i = 0; i < 2; ++i) { int R, C; stage_rc(tid * 16 + i * 8192, R, C); const int Rb = Epi::PERM ? ((R & ~31) + perm32(R & 31)) : R;
        voffA[i] = (unsigned)(R * K + C) * 2u; voffB[i] = (unsigned)(Rb * K + C) * 2u; }
    const size_t kstep = (size_t)(BK * 2);
    const size_t hstep = (size_t)HALF * K * 2;
    const size_t tstep = 2 * hstep;
    const unsigned ldsw = (unsigned)wid * 1024u;
    const int aoff = lds_byte(wr * 64 + fr, fq * 8), boff = lds_byte(wc * 32 + fr, fq * 8);
#define PG8_SA(b, h) (((b) * 2 + (h)) * HTB)
#define PG8_SB(b, h) ((4 + (b) * 2 + (h)) * HTB)
#define PG8_STAGE(bufoff, gbase, voff) do { _Pragma("unroll") for (int _i = 0; _i < 2; ++_i) \
        __builtin_amdgcn_global_load_lds((const unsigned*)((const char*)(gbase) + (voff)[_i]), (PG8_LAS unsigned*)(lds + (bufoff) + ldsw + _i * 8192), 16, 0, 0); } while (0)
#define PG8_LDA(dst, b, h) do { _Pragma("unroll") for (int m = 0; m < 4; ++m) _Pragma("unroll") for (int k = 0; k < 2; ++k) dst[m][k] = *(const PG8_LAS bf16x8*)(lds + PG8_SA(b, h) + aoff + m * 2048 + k * 1024); } while (0)
#define PG8_LDB(dst, b, h) do { _Pragma("unroll") for (int n = 0; n < 2; ++n) _Pragma("unroll") for (int k = 0; k < 2; ++k) dst[n][k] = *(const PG8_LAS bf16x8*)(lds + PG8_SB(b, h) + boff + n * 2048 + k * 1024); } while (0)
#define PG8_MMA(ai, bj, At, Bt) do { __builtin_amdgcn_s_setprio(1); _Pragma("unroll") for (int m = 0; m < 4; ++m) _Pragma("unroll") for (int n = 0; n < 2; ++n) _Pragma("unroll") for (int k = 0; k < 2; ++k) \
        acc[ai][bj][m][n] = __builtin_amdgcn_mfma_f32_16x16x32_bf16(Bt[n][k], At[m][k], acc[ai][bj][m][n], 0, 0, 0); __builtin_amdgcn_s_setprio(0); } while (0)
#define PG8_WAIT_V(n) asm volatile("s_waitcnt vmcnt(" #n ")" ::: "memory")
#define PG8_WAIT_L(n) asm volatile("s_waitcnt lgkmcnt(" #n ")" ::: "memory")
#define PG8_BAR __builtin_amdgcn_s_barrier()
#define PG8_SCHED __builtin_amdgcn_sched_barrier(0)
    Unit cur, nxt; int ui = 0;
    if (!S.next(0, cur)) return;
    f32x4 acc[2][2][4][2];
#pragma unroll
    for (int a = 0; a < 2; ++a)
#pragma unroll
        for (int b = 0; b < 2; ++b)
#pragma unroll
            for (int m = 0; m < 4; ++m)
#pragma unroll
                for (int n = 0; n < 2; ++n) acc[a][b][m][n] = (f32x4){0.f, 0.f, 0.f, 0.f};
    bf16x8 At[4][2], B0[2][2], B1[2][2];
    const char* cA = (const char*)g.A + (size_t)cur.pm * tstep; const char* cB = (const char*)g.Bt + (size_t)cur.pn * tstep;
    S.a_ready(cur);
    if constexpr (SP2) {
        PG8_STAGE(PG8_SB(0, 0), cB, voffB); PG8_STAGE(PG8_SB(0, 1), cB + hstep, voffB); PG8_STAGE(PG8_SA(0, 0), cA, voffA); PG8_STAGE(PG8_SA(0, 1), cA + hstep, voffA);
        if (wr == 1) PG8_BAR;
        PG8_WAIT_V(2); PG8_BAR;
        PG8_STAGE(PG8_SB(1, 0), cB + kstep, voffB); PG8_STAGE(PG8_SA(1, 0), cA + kstep, voffA); PG8_STAGE(PG8_SB(1, 1), cB + hstep + kstep, voffB);
        PG8_WAIT_V(6); PG8_BAR;
    } else {
        PG8_STAGE(PG8_SB(0, 0), cB, voffB); PG8_STAGE(PG8_SA(0, 0), cA, voffA); PG8_STAGE(PG8_SB(0, 1), cB + hstep, voffB); PG8_STAGE(PG8_SA(0, 1), cA + hstep, voffA);
        if (wr == 1) PG8_BAR;
        PG8_WAIT_V(4); PG8_BAR;
        PG8_STAGE(PG8_SB(1, 0), cB + kstep, voffB); PG8_STAGE(PG8_SA(1, 0), cA + kstep, voffA); PG8_STAGE(PG8_SB(1, 1), cB + hstep + kstep, voffB);
        PG8_WAIT_V(6); PG8_BAR;
    }
    for (;;) {
        const bool has_next = S.next(ui + 1, nxt);
        const char* nA = has_next ? (const char*)g.A + (size_t)nxt.pm * tstep : cA; const char* nB = has_next ? (const char*)g.Bt + (size_t)nxt.pn * tstep : cB;
        for (int t = 0; t < nt; t += 2) {
            const bool last = (t == nt - 2);
            const char* a1 = cA + (size_t)(t + 1) * kstep;
            const char* a2 = last ? nA : cA + (size_t)(t + 2) * kstep; const char* b2 = last ? nB : cB + (size_t)(t + 2) * kstep;
            const char* a3 = a2 + kstep; const char* b3 = b2 + kstep;
            if (last && has_next) S.a_ready(nxt);
            if constexpr (SP2) {
            PG8_LDB(B0, 0, 0); PG8_LDB(B1, 0, 1); PG8_SCHED; PG8_LDA(At, 0, 0); PG8_STAGE(PG8_SA(1, 1), a1 + hstep, voffA);
            PG8_WAIT_V(8); PG8_WAIT_L(0); PG8_BAR; PG8_MMA(0, 0, At, B0); PG8_MMA(0, 1, At, B1); PG8_BAR; PG8_SCHED;
            PG8_LDA(At, 0, 1); PG8_STAGE(PG8_SB(0, 0), b2, voffB); PG8_STAGE(PG8_SB(0, 1), b2 + hstep, voffB); PG8_STAGE(PG8_SA(0, 0), a2, voffA);
            PG8_WAIT_V(8); PG8_WAIT_L(0); PG8_BAR; PG8_MMA(1, 0, At, B0); PG8_MMA(1, 1, At, B1); PG8_BAR; PG8_SCHED;
            PG8_LDB(B0, 1, 0); PG8_LDB(B1, 1, 1); PG8_SCHED; PG8_LDA(At, 1, 0); PG8_STAGE(PG8_SA(0, 1), a2 + hstep, voffA);
            PG8_WAIT_V(8); PG8_WAIT_L(0); PG8_BAR; PG8_MMA(0, 0, At, B0); PG8_MMA(0, 1, At, B1); PG8_BAR; PG8_SCHED;
            PG8_LDA(At, 1, 1); PG8_STAGE(PG8_SB(1, 0), b3, voffB); PG8_STAGE(PG8_SB(1, 1), b3 + hstep, voffB); PG8_STAGE(PG8_SA(1, 0), a3, voffA);
            PG8_WAIT_V(8); PG8_WAIT_L(0); PG8_BAR; PG8_MMA(1, 0, At, B0); PG8_MMA(1, 1, At, B1); PG8_BAR; PG8_SCHED;
            } else {
            PG8_LDB(B0, 0, 0); PG8_SCHED; PG8_LDA(At, 0, 0); PG8_STAGE(PG8_SA(1, 1), a1 + hstep, voffA);
            PG8_WAIT_L(8); PG8_BAR; PG8_WAIT_L(0); PG8_MMA(0, 0, At, B0); PG8_BAR; PG8_SCHED;
            PG8_LDB(B1, 0, 1); PG8_STAGE(PG8_SB(0, 0), b2, voffB);
            PG8_BAR; PG8_WAIT_L(0); PG8_MMA(0, 1, At, B1); PG8_BAR;
            PG8_LDA(At, 0, 1); PG8_STAGE(PG8_SA(0, 0), a2, voffA);
            PG8_BAR; PG8_WAIT_L(0); PG8_MMA(1, 0, At, B0); PG8_BAR; PG8_SCHED;
            PG8_STAGE(PG8_SB(0, 1), b2 + hstep, voffB);
            PG8_WAIT_V(6); PG8_BAR; PG8_MMA(1, 1, At, B1); PG8_BAR;
            PG8_LDB(B0, 1, 0); PG8_SCHED; PG8_LDA(At, 1, 0); PG8_STAGE(PG8_SA(0, 1), a2 + hstep, voffA);
            PG8_WAIT_L(8); PG8_BAR; PG8_WAIT_L(0); PG8_MMA(0, 0, At, B0); PG8_BAR; PG8_SCHED;
            PG8_LDB(B1, 1, 1); PG8_STAGE(PG8_SB(1, 0), b3, voffB);
            PG8_BAR; PG8_WAIT_L(0); PG8_MMA(0, 1, At, B1); PG8_BAR;
            PG8_LDA(At, 1, 1); PG8_STAGE(PG8_SA(1, 0), a3, voffA);
            PG8_BAR; PG8_WAIT_L(0); PG8_MMA(1, 0, At, B0); PG8_BAR; PG8_SCHED;
            PG8_STAGE(PG8_SB(1, 1), b3 + hstep, voffB);
            PG8_WAIT_V(6); PG8_BAR; PG8_MMA(1, 1, At, B1); PG8_BAR;
            }
        }
        if constexpr (ALIGN_EPI) { if (wr == 0) PG8_BAR; }
        if constexpr (!Epi::AFTER_DRAIN) { E(acc, cur, wr, wc, fr, fq); S.done(cur); }
        if (!has_next) break;
#pragma unroll
        for (int a = 0; a < 2; ++a)
#pragma unroll
            for (int b = 0; b < 2; ++b)
#pragma unroll
                for (int m = 0; m < 4; ++m)
#pragma unroll
                    for (int n = 0; n < 2; ++n) acc[a][b][m][n] = (f32x4){0.f, 0.f, 0.f, 0.f};
        cur = nxt; cA = nA; cB = nB; ++ui;
        if constexpr (ALIGN_EPI) { if (wr == 1) PG8_BAR; }
    }
    PG8_WAIT_V(0);
    if constexpr (!ALIGN_EPI) { if (wr == 0) PG8_BAR; }
    PG8_BAR;
    if constexpr (Epi::AFTER_DRAIN) { E.fused(acc, cur, wr, wc, fr, fq, lds, wid, lane); S.done(cur); }
#undef PG8_SA
#undef PG8_SB
#undef PG8_STAGE
#undef PG8_LDA
#undef PG8_LDB
#undef PG8_MMA
#undef PG8_WAIT_V
#undef PG8_WAIT_L
#undef PG8_BAR
#undef PG8_SCHED
}
}

DEVI pg8::u32x4 pack8(const pg8::f32x4& a, const pg8::f32x4& b) { pg8::u32x4 w; w.x = pg8::cvt_pk_bf16(a[0], a[1]); w.y = pg8::cvt_pk_bf16(a[2], a[3]); w.z = pg8::cvt_pk_bf16(b[0], b[1]); w.w = pg8::cvt_pk_bf16(b[2], b[3]); return w; }
DEVI pg8::f32x4 silu4(const pg8::f32x4& a) { pg8::f32x4 r; r[0] = siluf_(a[0]); r[1] = siluf_(a[1]); r[2] = siluf_(a[2]); r[3] = siluf_(a[3]); return r; }
struct FEpi1 {
    static constexpr bool PERM = true, AFTER_DRAIN = false;
    bf16_t *QK, *V, *SGA, *Z, *CBG; float* ALR;
    DEVI void operator()(const pg8::f32x4 (&acc)[2][2][4][2], const pg8::Unit& u, int wr, int wc, int fr, int fq) const {
        const int t = u.pn, row0 = u.pm * 256 + wr * 64 + fr, cw = wc * 32 + 8 * fq;
#pragma unroll
        for (int ai = 0; ai < 2; ++ai)
#pragma unroll
            for (int m = 0; m < 4; ++m) {
                const size_t row = (size_t)(row0 + ai * 128 + m * 16);
                if (t < 12) {
                    bf16_t* base = t < 4 ? QK + row * 1024 + t * 256 : (t < 8 ? V + row * 1024 + (t - 4) * 256 : SGA + row * 1024 + (t - 8) * 256);
#pragma unroll
                    for (int bj = 0; bj < 2; ++bj) { pg8::f32x4 v0 = acc[ai][bj][m][0], v1 = acc[ai][bj][m][1]; if (t >= 8) { v0 = silu4(v0); v1 = silu4(v1); }
                        *(pg8::u32x4*)(base + bj * 128 + cw) = pack8(v0, v1); }
                } else if (t == 12) {
                    if (wc == 0) { *(pg8::f32x4*)(ALR + row * 32 + 8 * fq) = acc[ai][0][m][0]; *(pg8::f32x4*)(ALR + row * 32 + 8 * fq + 4) = acc[ai][0][m][1]; }
                } else if (t < 21) {
                    *(pg8::u32x4*)(Z + row * 1024 + (t - 13) * 128 + cw) = pack8(acc[ai][0][m][0] * acc[ai][1][m][0], acc[ai][0][m][1] * acc[ai][1][m][1]);
                } else {
                    *(pg8::u32x4*)(CBG + row * 1024 + (t - 21) * 128 + cw) = pack8(acc[ai][0][m][0] * silu4(acc[ai][1][m][0]), acc[ai][0][m][1] * silu4(acc[ai][1][m][1]));
                }
            }
    }
};
struct FEpiRes {
    static constexpr bool PERM = false, AFTER_DRAIN = false;
    const float* xl; const float* xc; float* outl; float* outc; const float* MODl;
    DEVI void operator()(const pg8::f32x4 (&acc)[2][2][4][2], const pg8::Unit& u, int wr, int wc, int fr, int fq) const {
        const int row0 = u.pm * 256 + wr * 64 + fr, col0 = u.pn * 256 + wc * 32 + 4 * fq;
        const bool lat = u.pm < NLAT / 256;
        const float* gate = MODl + (size_t)(lat ? (u.pm >> 4) : 4) * 3072 + 2048 + col0;
        pg8::f32x4 gv[2][2];
#pragma unroll
        for (int bj = 0; bj < 2; ++bj)
#pragma unroll
            for (int n = 0; n < 2; ++n) gv[bj][n] = *(const pg8::f32x4*)(gate + bj * 128 + n * 16);
        const float* xin = lat ? xl : xc - (size_t)NLAT * 1024; float* o = lat ? outl : outc - (size_t)NLAT * 1024;
#pragma unroll
        for (int ai = 0; ai < 2; ++ai)
#pragma unroll
            for (int m = 0; m < 4; ++m) { const size_t off = (size_t)(row0 + ai * 128 + m * 16) * 1024 + col0;
#pragma unroll
                for (int bj = 0; bj < 2; ++bj)
#pragma unroll
                    for (int n = 0; n < 2; ++n) { const pg8::f32x4 xv = *(const pg8::f32x4*)(xin + off + bj * 128 + n * 16); *(pg8::f32x4*)(o + off + bj * 128 + n * 16) = xv + gv[bj][n] * acc[ai][bj][m][n]; } }
    }
};
struct FEpi3 {
    static constexpr bool PERM = true, AFTER_DRAIN = false;
    bf16_t* XR; bf16_t* SG;
    DEVI void operator()(const pg8::f32x4 (&acc)[2][2][4][2], const pg8::Unit& u, int wr, int wc, int fr, int fq) const {
        const int t = u.pn, row0 = u.pm * 256 + wr * 64 + fr, cw = wc * 32 + 8 * fq;
        bf16_t* base = t < 8 ? XR + t * 256 : SG + (t - 8) * 256;
#pragma unroll
        for (int ai = 0; ai < 2; ++ai)
#pragma unroll
            for (int m = 0; m < 4; ++m) { bf16_t* rp = base + (size_t)(row0 + ai * 128 + m * 16) * 2048 + cw;
#pragma unroll
                for (int bj = 0; bj < 2; ++bj) { pg8::f32x4 v0 = acc[ai][bj][m][0], v1 = acc[ai][bj][m][1]; if (t >= 8) { v0 = silu4(v0); v1 = silu4(v1); }
                    *(pg8::u32x4*)(rp + bj * 128) = pack8(v0, v1); } }
    }
};
#ifndef FAST_GEMM
#define FAST_GEMM 1
#endif

__device__ __forceinline__ void run_stage(const Params& p, int st, int vb, int nvb, unsigned char* lds) {
    unsigned char* ws = p.ws;
    float* MOD = (float*)(ws + WS_MOD); float* ALR = (float*)(ws + WS_ALR); float* X1C = (float*)(ws + WS_X1C);
    float* SUMA = (float*)(ws + WS_SUMA); float* SUMH = (float*)(ws + WS_SUMH); float* DEC = (float*)(ws + WS_DEC);
    bf16_t* Bt1 = (bf16_t*)(ws + WS_BT1); bf16_t* Bt2 = (bf16_t*)(ws + WS_BT2); bf16_t* Bt3 = (bf16_t*)(ws + WS_BT3); bf16_t* Bt4 = (bf16_t*)(ws + WS_BT4);
    bf16_t* S0 = (bf16_t*)(ws + WS_SLOT(0)); bf16_t* S1 = (bf16_t*)(ws + WS_SLOT(1)); bf16_t* S2 = (bf16_t*)(ws + WS_SLOT(2));
    bf16_t* S3 = (bf16_t*)(ws + WS_SLOT(3)); bf16_t* S4 = (bf16_t*)(ws + WS_SLOT(4)); bf16_t* S5 = (bf16_t*)(ws + WS_SLOT(5));
    bf16_t* DO0 = (bf16_t*)p.out; bf16_t* DOSC = (bf16_t*)((unsigned char*)p.out + 34 * MiB);
    switch (st) {
    case 0: st_mod(p, vb, nvb, (float*)lds); st_wprep(p, vb, nvb); break;
    case 1: st_modulate(p, vb, nvb, 0, p.x, p.ctx, S0); break;
    case 3: st_glaprep(p, vb, nvb, lds, S1, S2, ALR, S3, S4, DOSC, DEC, S5); break;
    case 4: st_glawalk_naive(p, vb, nvb, (float*)lds, S3, S4, DOSC, DEC, S5, S2, DO0); break;
    case 6: st_inner(p, vb, nvb, S2, DO0, S3, S4, S5, S0); break;
    case 8: st_modulate(p, vb, nvb, 1, p.out, X1C, S2); break;
    case 10: st_rglru_naive<0>(p, vb, nvb, (float*)lds, S3, S0, SUMA, SUMH, S0); break;
    case 11: st_carry(p, vb, nvb, SUMA, SUMH); break;
    case 12: st_rglru_naive<1>(p, vb, nvb, (float*)lds, S3, S0, SUMA, SUMH, S0); break;
    case 14: st_final(p, vb, nvb); break;
#if FAST_GEMM
    case 2: { FEpi1 E{S1, S2, S3, S4, S5, ALR}; pg8::Gemm g{S0, Bt1, NT, N1, 1024}; pg8::TileOrder S; S.init(NT / 256, 9, nvb, vb, 0, 8, 0, 12);
              pg8::gemm_phase<FEpi1, pg8::TileOrder, true, true>((PG8_LAS unsigned char*)lds, g, S, E); } break;
    case 5: { FEpi1 E{S1, S2, S3, S4, S5, ALR}; pg8::Gemm g{S0, Bt1, NT, N1, 1024}; pg8::TileOrder S; S.init(NT / 256, 20, nvb, vb, 0, 4, 8, 13);
              pg8::gemm_phase<FEpi1, pg8::TileOrder, true, true>((PG8_LAS unsigned char*)lds, g, S, E); } break;
    case 7: { FEpiRes E{p.x, p.ctx, p.out, X1C, MOD}; pg8::Gemm g{S0, Bt2, NT, 1024, 2048}; pg8::TileOrder S; S.init(NT / 256, 4, nvb, vb);
              pg8::gemm_phase<FEpiRes, pg8::TileOrder, true, true>((PG8_LAS unsigned char*)lds, g, S, E); } break;
    case 9: { FEpi3 E{S3, S0}; pg8::Gemm g{S2, Bt3, NT, 4096, 1024}; pg8::TileOrder S; S.init(NLAT / 256, 16, nvb, vb, 0, 1 << 30, 0, 0, NCTX / 256, 8, NLAT / 256);
              pg8::gemm_phase<FEpi3, pg8::TileOrder, true, true>((PG8_LAS unsigned char*)lds, g, S, E); } break;
    case 13: { FEpiRes E{p.out, nullptr, p.out, nullptr, MOD + 5 * 3072}; pg8::Gemm g{S0, Bt4, NLAT, 1024, 2048}; pg8::TileOrder S; S.init(NLAT / 256, 4, nvb, vb);
              pg8::gemm_phase<FEpiRes, pg8::TileOrder, true, true>((PG8_LAS unsigned char*)lds, g, S, E); } break;
#else
    case 2: { Epi1 E{S1, S2, S3, S4, S5, ALR}; st_gemm_naive(vb, nvb, (float*)lds, S0, Bt1, 0, NT / 32, 0, 8, 1024, E); st_gemm_naive(vb, nvb, (float*)lds, S0, Bt1, 0, NT / 32, 12, 13, 1024, E); } break;
    case 5: { Epi1 E{S1, S2, S3, S4, S5, ALR}; st_gemm_naive(vb, nvb, (float*)lds, S0, Bt1, 0, NT / 32, 8, 12, 1024, E); st_gemm_naive(vb, nvb, (float*)lds, S0, Bt1, 0, NT / 32, 13, 29, 1024, E); } break;
    case 7: { EpiRes E{p.x, p.ctx, p.out, X1C, MOD}; st_gemm_naive(vb, nvb, (float*)lds, S0, Bt2, 0, NT / 32, 0, 4, 2048, E); } break;
    case 9: { Epi3 E{S3, S0}; st_gemm_naive(vb, nvb, (float*)lds, S2, Bt3, 0, NLAT / 32, 0, 16, 1024, E); st_gemm_naive(vb, nvb, (float*)lds, S2, Bt3, NLAT / 32, NT / 32, 0, 8, 1024, E); } break;
    case 13: { EpiRes E{p.out, nullptr, p.out, nullptr, MOD + 5 * 3072}; st_gemm_naive(vb, nvb, (float*)lds, S0, Bt4, 0, NLAT / 32, 0, 4, 2048, E); } break;
#endif
    }
}
constexpr int NSTAGES = 15;
constexpr int LDS_BYTES = 147456;

#ifndef ONE_LAUNCH
#define ONE_LAUNCH 1
#endif
#if !ONE_LAUNCH
__global__ void __launch_bounds__(NTHREADS) k_mega(Params p, int st) {
    extern __shared__ __attribute__((aligned(16))) unsigned char lds[];
    run_stage(p, st, blockIdx.x, gridDim.x, lds);
}
#else
__global__ void __launch_bounds__(NTHREADS) k_mega(Params p) {
    extern __shared__ __attribute__((aligned(16))) unsigned char lds[];
    cg::grid_group grid = cg::this_grid();
#define RS(k) run_stage(p, k, blockIdx.x, gridDim.x, lds)
    RS(0); grid.sync(); RS(1); grid.sync(); RS(2); grid.sync(); RS(3); grid.sync(); RS(4); grid.sync(); RS(5); grid.sync(); RS(6); grid.sync(); RS(7); grid.sync();
    RS(8); grid.sync(); RS(9); grid.sync(); RS(10); grid.sync(); RS(11); grid.sync(); RS(12); grid.sync(); RS(13); grid.sync(); RS(14);
#undef RS
}
#endif

extern "C" void kernel_launch(void* const* d_in, const int* in_sizes, int n_in, void* d_out, int out_size, void* d_ws, size_t ws_size, hipStream_t stream) {
    static int inited = 0, grid_blocks = 0;
    if (!inited) {
        if (n_in != 23 || ws_size < WS_END || out_size != NLAT * D) { fprintf(stderr, "kernel_launch: unexpected shapes n_in %d ws %zu out %d\n", n_in, ws_size, out_size); inited = -1; return; }
        if (hipFuncSetAttribute((const void*)k_mega, hipFuncAttributeMaxDynamicSharedMemorySize, LDS_BYTES) != hipSuccess) { fprintf(stderr, "hipFuncSetAttribute failed\n"); inited = -1; return; }
        int dev = 0, cus = 0, per_cu = 0;
        (void)hipGetDevice(&dev); (void)hipDeviceGetAttribute(&cus, hipDeviceAttributeMultiprocessorCount, dev);
        (void)hipOccupancyMaxActiveBlocksPerMultiprocessor(&per_cu, (const void*)k_mega, NTHREADS, LDS_BYTES);
        if (per_cu < 1) { fprintf(stderr, "kernel_launch: occupancy query says %d blocks per CU\n", per_cu); per_cu = 1; }
        if (per_cu > 1) per_cu = 1;
        grid_blocks = cus * per_cu;
        inited = 1;
    }
    if (inited < 0) return;
    Params p{};
    const float** f = (const float**)&p;
    for (int i = 0; i < 23; ++i) f[i] = (const float*)d_in[i];
    p.out = (float*)d_out; p.ws = (unsigned char*)d_ws;
#if ONE_LAUNCH
    void* args[] = {&p};
    hipError_t e = hipLaunchCooperativeKernel((const void*)k_mega, dim3(grid_blocks), dim3(NTHREADS), args, LDS_BYTES, stream);
    if (e != hipSuccess) fprintf(stderr, "cooperative launch failed: %s (grid %d)\n", hipGetErrorString(e), grid_blocks);
#else
    for (int st = 0; st < NSTAGES; ++st) hipLaunchKernelGGL(k_mega, dim3(1024), dim3(NTHREADS), LDS_BYTES, stream, p, st);
#endif
}
```

```cpp
#include <hip/hip_runtime.h>
#include <hip/hip_cooperative_groups.h>
namespace cg = cooperative_groups;
#include <cstdio>
#include <cstdint>

typedef unsigned short bf16_t;
#define DEVI __device__ __forceinline__

constexpr int D = 1024, NB = 4, SEQ = 4096, CTXL = 256;
constexpr int NLAT = NB * SEQ;
constexpr int NCTX = NB * CTXL;
constexpr int NT = NLAT + NCTX;
constexpr int NCH = 68;
constexpr int EVEN_IN = 7200;
constexpr int N1 = 7424;
constexpr int N1A = 13 * 256;
constexpr int RGW = 2048;
constexpr float EPS = 1e-6f;

constexpr size_t MiB = 1u << 20;
constexpr size_t WS_CTL = 0;
constexpr size_t WS_MOD = 1 * MiB;
constexpr size_t WS_ALR = 2 * MiB;
constexpr size_t WS_X1C = 5 * MiB;
constexpr size_t WS_SUMA = 9 * MiB;
constexpr size_t WS_SUMH = 9 * MiB + 4608 * 1024;
constexpr size_t WS_DEC = 18 * MiB;
constexpr size_t WS_BT1 = 19 * MiB + 512 * 1024;
constexpr size_t WS_BT2 = 34 * MiB;
constexpr size_t WS_BT3 = 38 * MiB;
constexpr size_t WS_BT4 = 46 * MiB;
constexpr size_t WS_BD = 50 * MiB;
constexpr size_t WS_S0 = 52 * MiB;
constexpr size_t SLOT = 34 * MiB;
constexpr size_t WS_END = WS_S0 + 6 * SLOT;
static_assert(WS_END == 256 * MiB, "ws map");
#define WS_SLOT(i) (WS_S0 + (size_t)(i) * SLOT)

struct Params {
    const float* x; const float* c; const float* ctx; const float* c_ctx; const float* norm_g; const float* w_mod; const float* b_mod;
    const float* e_w_in; const float* e_w_a2; const float* e_b_a2; const float* e_gla_g; const float* e_conv_w; const float* e_w_out;
    const float* o_w_in; const float* o_conv_w; const float* o_conv_b; const float* o_w_a; const float* o_b_a; const float* o_w_x; const float* o_b_x;
    const float* o_lam; const float* o_w_out; const float* final_g;
    float* out; unsigned char* ws;
};

DEVI float bf2f(bf16_t v) { return __uint_as_float((unsigned)v << 16); }
DEVI bf16_t f2bf(float f) { unsigned u = __float_as_uint(f); return (bf16_t)((u + 0x7fffu + ((u >> 16) & 1u)) >> 16); }
DEVI float sigmoidf_(float x) { return 1.0f / (1.0f + __expf(-x)); }
DEVI float siluf_(float x) { return x / (1.0f + __expf(-x)); }
DEVI float softplusf_(float x) { return fmaxf(x, 0.f) + log1pf(__expf(-fabsf(x))); }
DEVI float logsigmoidf_(float x) { return fminf(x, 0.f) - log1pf(__expf(-fabsf(x))); }
DEVI int row_of(int bb, int c, int t) { return c < 64 ? bb * 4096 + c * 64 + t : NLAT + bb * 256 + (c - 64) * 64 + t; }
DEVI int mod_idx(int row) { return row < NLAT ? (row >> 12) : 4; }
DEVI float wave_sum(float v) {
#pragma unroll
    for (int o = 1; o < 64; o <<= 1) v += __shfl_xor(v, o);
    return v;
}
__host__ __device__ inline int colmap1(int n) {
    const int t = n >> 8, c = n & 255;
    if (t < 12) return n;
    if (t == 12) return c < 32 ? 3072 + c : -1;
    if (t < 21) { const int j = t - 13; return c < 128 ? 4128 + 128 * j + c : 5152 + 128 * j + (c - 128); }
    const int j = t - 21; return c < 128 ? 3104 + 128 * j + c : 6176 + 128 * j + (c - 128);
}

#define NTHREADS 512

__device__ void st_mod(const Params& p, int vb, int nvb, float* lds) {
    float* MOD = (float*)(p.ws + WS_MOD);
    for (int i = threadIdx.x; i < 5 * 1024; i += NTHREADS) { const int s = i >> 10, k = i & 1023; const float v = s < 4 ? p.c[s * 1024 + k] : p.c_ctx[k]; lds[i] = siluf_(v); }
    __syncthreads();
    for (int it = vb; it < 2 * 6; it += nvb) {
        const int li = it / 6, j = (it % 6) * 512 + threadIdx.x;
        const float* W = p.w_mod + (size_t)li * 1024 * 3072 + j;
        float a0 = 0.f, a1 = 0.f, a2 = 0.f, a3 = 0.f, a4 = 0.f;
        for (int k = 0; k < 1024; ++k) { const float w = W[(size_t)k * 3072]; a0 += lds[k] * w; a1 += lds[1024 + k] * w; a2 += lds[2048 + k] * w; a3 += lds[3072 + k] * w; a4 += lds[4096 + k] * w; }
        const float bv = p.b_mod[li * 3072 + j];
        float* o = MOD + (size_t)li * 5 * 3072 + j;
        o[0] = a0 + bv; o[3072] = a1 + bv; o[2 * 3072] = a2 + bv; o[3 * 3072] = a3 + bv; o[4 * 3072] = a4 + bv;
    }
    __syncthreads();
}

__device__ void st_wprep(const Params& p, int vb, int nvb) {
    bf16_t* Bt1 = (bf16_t*)(p.ws + WS_BT1); bf16_t* Bt2 = (bf16_t*)(p.ws + WS_BT2); bf16_t* Bt3 = (bf16_t*)(p.ws + WS_BT3); bf16_t* Bt4 = (bf16_t*)(p.ws + WS_BT4);
    bf16_t* BD = (bf16_t*)(p.ws + WS_BD);
    const size_t gtid = (size_t)vb * NTHREADS + threadIdx.x, gn = (size_t)nvb * NTHREADS;
    for (size_t e = gtid; e < (size_t)N1 * 1024; e += gn) { const int k = (int)(e / N1), n = (int)(e % N1); const int sc = colmap1(n); Bt1[(size_t)n * 1024 + k] = sc < 0 ? (bf16_t)0 : f2bf(p.e_w_in[(size_t)k * EVEN_IN + sc]); }
    for (size_t e = gtid; e < (size_t)2048 * 1024; e += gn) { const int k = (int)(e / 1024), n = (int)(e % 1024); Bt2[(size_t)n * 2048 + k] = f2bf(p.e_w_out[e]); Bt4[(size_t)n * 2048 + k] = f2bf(p.o_w_out[e]); }
    for (size_t e = gtid; e < (size_t)1024 * 4096; e += gn) { const int k = (int)(e / 4096), n = (int)(e % 4096); Bt3[(size_t)n * 1024 + k] = f2bf(p.o_w_in[e]); }
    for (size_t e = gtid; e < (size_t)2 * 16 * 128 * 128; e += gn) { const int j = (int)(e & 127), i = (int)((e >> 7) & 127), dn = (int)(e >> 14);
        BD[((size_t)dn * 128 + j) * 128 + i] = f2bf(p.o_w_a[e]); BD[(size_t)2 * 16 * 128 * 128 + ((size_t)dn * 128 + j) * 128 + i] = f2bf(p.o_w_x[e]); }
}

__device__ void st_modulate(const Params& p, int vb, int nvb, int li, const float* xlat, const float* xctx, bf16_t* H) {
    const float* MOD = (const float*)(p.ws + WS_MOD) + (size_t)li * 5 * 3072;
    const float* g = p.norm_g + li * 1024;
    const int lane = threadIdx.x & 63, gw = vb * (NTHREADS / 64) + (threadIdx.x >> 6), ngw = nvb * (NTHREADS / 64);
    for (int row = gw; row < NT; row += ngw) {
        const float* xr = row < NLAT ? xlat + (size_t)row * 1024 : xctx + (size_t)(row - NLAT) * 1024;
        const float* md = MOD + (size_t)mod_idx(row) * 3072;
        float4 v[4]; float ss = 0.f;
#pragma unroll
        for (int j = 0; j < 4; ++j) { v[j] = *(const float4*)(xr + j * 256 + lane * 4); ss += v[j].x * v[j].x + v[j].y * v[j].y + v[j].z * v[j].z + v[j].w * v[j].w; }
        const float rinv = rsqrtf(wave_sum(ss) * (1.f / 1024.f) + EPS);
#pragma unroll
        for (int j = 0; j < 4; ++j) { const int c0 = j * 256 + lane * 4; const float4 gg = *(const float4*)(g + c0), sh = *(const float4*)(md + c0), sc = *(const float4*)(md + 1024 + c0);
            ushort4 o; o.x = f2bf(v[j].x * rinv * gg.x * (1.f + sc.x) + sh.x); o.y = f2bf(v[j].y * rinv * gg.y * (1.f + sc.y) + sh.y);
            o.z = f2bf(v[j].z * rinv * gg.z * (1.f + sc.z) + sh.z); o.w = f2bf(v[j].w * rinv * gg.w * (1.f + sc.w) + sh.w);
            *(ushort4*)(H + (size_t)row * 1024 + c0) = o; }
    }
}

template <class Epi>
__device__ void st_gemm_naive(int vb, int nvb, float* lds, const bf16_t* A, const bf16_t* Bt, int mt0, int mt1, int nt0, int nt1, int K, const Epi& E) {
    float* As = lds;
    float* Bs = lds + 32 * 33;
    const int tid = threadIdx.x, tx = tid & 63, ty = tid >> 6;
    const int nmt = mt1 - mt0, nnt = nt1 - nt0;
    for (int it = vb; it < nmt * nnt; it += nvb) {
        const int m0 = (mt0 + it / nnt) * 32, n0 = (nt0 + it % nnt) * 256;
        float acc[4][4];
#pragma unroll
        for (int i = 0; i < 4; ++i)
#pragma unroll
            for (int j = 0; j < 4; ++j) acc[i][j] = 0.f;
        for (int k0 = 0; k0 < K; k0 += 32) {
            __syncthreads();
            for (int e = tid; e < 32 * 32; e += NTHREADS) { const int r = e >> 5, kk = e & 31; As[r * 33 + kk] = bf2f(A[(size_t)(m0 + r) * K + k0 + kk]); }
            for (int e = tid; e < 256 * 32; e += NTHREADS) { const int r = e >> 5, kk = e & 31; Bs[r * 33 + kk] = bf2f(Bt[(size_t)(n0 + r) * K + k0 + kk]); }
            __syncthreads();
#pragma unroll 8
            for (int kk = 0; kk < 32; ++kk) {
                float a[4], b[4];
#pragma unroll
                for (int i = 0; i < 4; ++i) a[i] = As[(ty * 4 + i) * 33 + kk];
#pragma unroll
                for (int j = 0; j < 4; ++j) b[j] = Bs[(tx + 64 * j) * 33 + kk];
#pragma unroll
                for (int i = 0; i < 4; ++i)
#pragma unroll
                    for (int j = 0; j < 4; ++j) acc[i][j] += a[i] * b[j];
            }
        }
#pragma unroll
        for (int i = 0; i < 4; ++i) E(m0 + ty * 4 + i, n0, tx, acc[i]);
    }
    __syncthreads();
}

struct Epi1 {
    bf16_t *QK, *V, *SGA, *Z, *CBG; float* ALR;
    DEVI void operator()(int row, int n0, int cl, const float (&v)[4]) const {
        const int t = n0 >> 8;
        if (t < 4) { for (int j = 0; j < 4; ++j) QK[(size_t)row * 1024 + n0 + cl + 64 * j] = f2bf(v[j]); }
        else if (t < 8) { for (int j = 0; j < 4; ++j) V[(size_t)row * 1024 + (n0 - 1024) + cl + 64 * j] = f2bf(v[j]); }
        else if (t < 12) { for (int j = 0; j < 4; ++j) SGA[(size_t)row * 1024 + (n0 - 2048) + cl + 64 * j] = f2bf(siluf_(v[j])); }
        else if (t == 12) { if (cl < 32) ALR[(size_t)row * 32 + cl] = v[0]; }
        else if (t < 21) { const int jt = t - 13; Z[(size_t)row * 1024 + 128 * jt + cl] = f2bf(v[0] * v[2]); Z[(size_t)row * 1024 + 128 * jt + cl + 64] = f2bf(v[1] * v[3]); }
        else { const int jt = t - 21; CBG[(size_t)row * 1024 + 128 * jt + cl] = f2bf(v[0] * siluf_(v[2])); CBG[(size_t)row * 1024 + 128 * jt + cl + 64] = f2bf(v[1] * siluf_(v[3])); }
    }
};
struct EpiRes {
    const float* xl; const float* xc; float* outl; float* outc; const float* MODl;
    DEVI void operator()(int row, int n0, int cl, const float (&v)[4]) const {
        const float* gate = MODl + (size_t)mod_idx(row) * 3072 + 2048;
        for (int j = 0; j < 4; ++j) { const int col = n0 + cl + 64 * j;
            if (row < NLAT) outl[(size_t)row * 1024 + col] = xl[(size_t)row * 1024 + col] + gate[col] * v[j];
            else if (outc) outc[(size_t)(row - NLAT) * 1024 + col] = xc[(size_t)(row - NLAT) * 1024 + col] + gate[col] * v[j]; }
    }
};
struct Epi3 {
    bf16_t* XR; bf16_t* SG;
    DEVI void operator()(int row, int n0, int cl, const float (&v)[4]) const {
        for (int j = 0; j < 4; ++j) { const int col = n0 + cl + 64 * j;
            if (col < 2048) XR[(size_t)row * 2048 + col] = f2bf(v[j]); else if (row < NLAT) SG[(size_t)row * 2048 + col - 2048] = f2bf(siluf_(v[j])); }
    }
};

__device__ void st_glaprep(const Params& p, int vb, int nvb, unsigned char* ldsb, const bf16_t* QK, const bf16_t* V, const float* ALR, bf16_t* QIN, bf16_t* KET, bf16_t* SC, float* DEC, bf16_t* VT) {
    bf16_t* qs = (bf16_t*)ldsb;
    bf16_t* ks = qs + 64 * 136;
    float* tot = (float*)(ks + 64 * 136);
    bf16_t* vs = (bf16_t*)(tot + 4 * 128);
    const int tid = threadIdx.x, kk = tid & 127, tq = tid >> 7;
    for (int u = vb; u < NB * NCH * 4 * 2; u += nvb) {
        const int d = u & 1, h = (u >> 1) & 3, bc = u >> 3, c = bc % NCH, bb = bc / NCH;
        const int row0 = row_of(bb, c, 0);
        float w2[16];
#pragma unroll
        for (int r = 0; r < 16; ++r) w2[r] = p.e_w_a2[((size_t)d * 16 + r) * 512 + h * 128 + kk];
        const float b2 = p.e_b_a2[d * 512 + h * 128 + kk];
        float lg[16];
#pragma unroll
        for (int i = 0; i < 16; ++i) { const float* a = ALR + (size_t)(row0 + tq * 16 + i) * 32 + d * 16; float z = b2;
#pragma unroll
            for (int r = 0; r < 16; ++r) z += a[r] * w2[r];
            lg[i] = logsigmoidf_(z) * (1.f / 16.f); }
        float bcum[16];
        if (d == 0) { float s = 0.f;
#pragma unroll
            for (int i = 0; i < 16; ++i) { s += lg[i]; bcum[i] = s; } tot[tq * 128 + kk] = s; }
        else { float s = 0.f;
#pragma unroll
            for (int i = 15; i >= 0; --i) { s += lg[i]; bcum[i] = s; } tot[tq * 128 + kk] = s; }
        __syncthreads();
        float off = 0.f, blast = 0.f;
        for (int q = 0; q < 4; ++q) { const float tv = tot[q * 128 + kk]; blast += tv; if (d == 0 ? (q < tq) : (q > tq)) off += tv; }
        const float scale = 0.08838834764831845f;
        unsigned short ke[16];
#pragma unroll
        for (int i = 0; i < 16; ++i) { const int t = tq * 16 + i; const float b = bcum[i] + off;
            const float qv = bf2f(QK[(size_t)(row0 + t) * 1024 + h * 128 + kk]) * scale, kv = bf2f(QK[(size_t)(row0 + t) * 1024 + 512 + h * 128 + kk]);
            const bf16_t qi = f2bf(qv * __expf(b)), ki = f2bf(kv * __expf(-b));
            qs[t * 136 + kk] = qi; ks[t * 136 + kk] = ki; ke[i] = f2bf(kv * __expf(blast - b));
            QIN[((size_t)u * 64 + t) * 128 + kk] = qi; }
        { uint4 w0, w1; w0.x = ke[0] | (ke[1] << 16); w0.y = ke[2] | (ke[3] << 16); w0.z = ke[4] | (ke[5] << 16); w0.w = ke[6] | (ke[7] << 16);
          w1.x = ke[8] | (ke[9] << 16); w1.y = ke[10] | (ke[11] << 16); w1.z = ke[12] | (ke[13] << 16); w1.w = ke[14] | (ke[15] << 16);
          uint4* dst = (uint4*)(KET + ((size_t)u * 128 + kk) * 64 + tq * 16); dst[0] = w0; dst[1] = w1; }
        if (tq == 0) DEC[(size_t)u * 128 + kk] = __expf(blast);
        for (int e = tid; e < 64 * 128; e += NTHREADS) { const int t = e >> 7, cc = e & 127; vs[t * 130 + cc] = V[(size_t)(row0 + t) * 1024 + h * 256 + d * 128 + cc]; }
        __syncthreads();
        for (int e = tid; e < 64 * 64; e += NTHREADS) { const int t = e >> 6, s = e & 63; float a = 0.f;
            if (d == 0 ? (s <= t) : (s >= t)) { for (int k2 = 0; k2 < 128; ++k2) a += bf2f(qs[t * 136 + k2]) * bf2f(ks[s * 136 + k2]); }
            SC[((size_t)u * 64 + t) * 64 + s] = f2bf(a); }
        { unsigned short vv[16];
#pragma unroll
          for (int i = 0; i < 16; ++i) vv[i] = vs[(tq * 16 + i) * 130 + kk];
          uint4 w0, w1; w0.x = vv[0] | (vv[1] << 16); w0.y = vv[2] | (vv[3] << 16); w0.z = vv[4] | (vv[5] << 16); w0.w = vv[6] | (vv[7] << 16);
          w1.x = vv[8] | (vv[9] << 16); w1.y = vv[10] | (vv[11] << 16); w1.z = vv[12] | (vv[13] << 16); w1.w = vv[14] | (vv[15] << 16);
          uint4* dst = (uint4*)(VT + (((size_t)(u >> 1)) * 256 + d * 128 + kk) * 64 + tq * 16); dst[0] = w0; dst[1] = w1; }
        __syncthreads();
    }
}

__device__ void st_glawalk_naive(const Params& p, int vb, int nvb, float* Sl, const bf16_t* QIN, const bf16_t* KET, const bf16_t* SC, const float* DEC, const bf16_t* VT, bf16_t* OF, bf16_t* OB) {
    const int vc = threadIdx.x & 255, half = threadIdx.x >> 8;
    for (int combo = vb; combo < 32; combo += nvb) {
        const int d = combo & 1, h = (combo >> 1) & 3, bb = combo >> 3;
        __syncthreads();
        for (int k = half * 64; k < half * 64 + 64; ++k) Sl[k * 256 + vc] = 0.f;
        __syncthreads();
        bf16_t* O = d == 0 ? OF : OB;
        for (int step = 0; step < NCH; ++step) {
            const int c = d == 0 ? (step < 4 ? 64 + step : step - 4) : 67 - step;
            const int u = ((bb * NCH + c) * 4 + h) * 2 + d;
            const bf16_t* q = QIN + (size_t)u * 64 * 128; const bf16_t* ke = KET + (size_t)u * 128 * 64; const bf16_t* sc = SC + (size_t)u * 64 * 64;
            const bf16_t* vt = VT + (((size_t)(u >> 1)) * 256 + vc) * 64;
            float vv[64];
#pragma unroll
            for (int t = 0; t < 64; ++t) vv[t] = bf2f(vt[t]);
            const int row0 = row_of(bb, c, 0);
            for (int t = half * 32; t < half * 32 + 32; ++t) { float a = 0.f;
                for (int k = 0; k < 128; ++k) a += bf2f(q[t * 128 + k]) * bf2f(f2bf(Sl[k * 256 + vc]));
#pragma unroll
                for (int s = 0; s < 64; ++s) a += bf2f(sc[t * 64 + s]) * vv[s];
                O[(size_t)(row0 + t) * 1024 + h * 256 + vc] = f2bf(a); }
            __syncthreads();
            for (int k = half * 64; k < half * 64 + 64; ++k) { float a = DEC[(size_t)u * 128 + k] * Sl[k * 256 + vc];
#pragma unroll
                for (int t = 0; t < 64; ++t) a += bf2f(ke[k * 64 + t]) * vv[t];
                Sl[k * 256 + vc] = a; }
            __syncthreads();
        }
    }
}

__device__ void st_inner(const Params& p, int vb, int nvb, const bf16_t* OF, const bf16_t* OB, const bf16_t* SGA, const bf16_t* Z, const bf16_t* CBG, bf16_t* INNER) {
    const int lane = threadIdx.x & 63, gw = vb * (NTHREADS / 64) + (threadIdx.x >> 6), ngw = nvb * (NTHREADS / 64);
    for (int row = gw; row < NT; row += ngw) {
        bool hasp, hasn;
        if (row < NLAT) { const int t = row & 63; hasp = t != 0; hasn = t != 63; } else { const int t = (row - NLAT) & 255; hasp = t != 0; hasn = t != 255; }
#pragma unroll
        for (int h = 0; h < 4; ++h) {
            const int c0 = h * 256 + lane * 4;
            const ushort4 a = *(const ushort4*)(OF + (size_t)row * 1024 + c0), b = *(const ushort4*)(OB + (size_t)row * 1024 + c0);
            const float o0 = bf2f(a.x) + bf2f(b.x), o1 = bf2f(a.y) + bf2f(b.y), o2 = bf2f(a.z) + bf2f(b.z), o3 = bf2f(a.w) + bf2f(b.w);
            const float rinv = rsqrtf(wave_sum(o0 * o0 + o1 * o1 + o2 * o2 + o3 * o3) * (1.f / 256.f) + EPS);
            const float4 gg = *(const float4*)(p.e_gla_g + lane * 4);
            const ushort4 sg = *(const ushort4*)(SGA + (size_t)row * 1024 + c0);
            ushort4 o; o.x = f2bf(o0 * rinv * gg.x * bf2f(sg.x)); o.y = f2bf(o1 * rinv * gg.y * bf2f(sg.y)); o.z = f2bf(o2 * rinv * gg.z * bf2f(sg.z)); o.w = f2bf(o3 * rinv * gg.w * bf2f(sg.w));
            *(ushort4*)(INNER + (size_t)row * 2048 + c0) = o;
            const ushort4 zc = *(const ushort4*)(Z + (size_t)row * 1024 + c0);
            ushort4 zp = {0, 0, 0, 0}, zn = {0, 0, 0, 0};
            if (hasp) zp = *(const ushort4*)(Z + (size_t)(row - 1) * 1024 + c0);
            if (hasn) zn = *(const ushort4*)(Z + (size_t)(row + 1) * 1024 + c0);
            const float4 w0 = *(const float4*)(p.e_conv_w + c0), w1 = *(const float4*)(p.e_conv_w + 1024 + c0), w2 = *(const float4*)(p.e_conv_w + 2048 + c0);
            const ushort4 cb = *(const ushort4*)(CBG + (size_t)row * 1024 + c0);
            ushort4 y; y.x = f2bf(bf2f(cb.x) * (w0.x * bf2f(zp.x) + w1.x * bf2f(zc.x) + w2.x * bf2f(zn.x)));
            y.y = f2bf(bf2f(cb.y) * (w0.y * bf2f(zp.y) + w1.y * bf2f(zc.y) + w2.y * bf2f(zn.y)));
            y.z = f2bf(bf2f(cb.z) * (w0.z * bf2f(zp.z) + w1.z * bf2f(zc.z) + w2.z * bf2f(zn.z)));
            y.w = f2bf(bf2f(cb.w) * (w0.w * bf2f(zp.w) + w1.w * bf2f(zc.w) + w2.w * bf2f(zn.w)));
            *(ushort4*)(INNER + (size_t)row * 2048 + 1024 + c0) = y;
        }
    }
}

template <int MODE>
__device__ void st_rglru_naive(const Params& p, int vb, int nvb, float* lds, const bf16_t* XR, const bf16_t* SG, float* SUMA, float* SUMH, bf16_t* Y) {
    float* xc = lds;
    float* av = xc + 64 * 128;
    float* uv = av + 64 * 128;
    float* hf = uv + 64 * 128;
    const int tid = threadIdx.x, j = tid & 127, tq = tid >> 7;
    const int nitems = MODE == 0 ? NB * NCH * 16 * 2 : NB * 64 * 16;
    for (int it = vb; it < nitems; it += nvb) {
        int bb, c, nb;
        if (MODE == 0) { nb = (it >> 1) & 15; const int bc = it >> 5; c = bc % NCH; bb = bc / NCH; } else { nb = it & 15; const int bc = it >> 4; c = bc & 63; bb = bc >> 6; }
        const int row0 = row_of(bb, c, 0);
        const int seg0 = c < 64 ? bb * 4096 : NLAT + bb * 256, segn = c < 64 ? 4096 : 256;
        const int tl0 = row0 - seg0;
        for (int dd = 0; dd < (MODE == 0 ? 1 : 2); ++dd) {
            const int d = MODE == 0 ? (it & 1) : dd;
            __syncthreads();
            for (int e = tid; e < 64 * 128; e += NTHREADS) { const int t = e >> 7, i = e & 127, ch = nb * 128 + i; float a = p.o_conv_b[d * 2048 + ch];
#pragma unroll
                for (int jj = 0; jj < 4; ++jj) { const int tt = d == 0 ? tl0 + t - 3 + jj : tl0 + t + 3 - jj;
                    if (tt >= 0 && tt < segn) a += p.o_conv_w[((size_t)d * 4 + jj) * 2048 + ch] * bf2f(XR[(size_t)(seg0 + tt) * 2048 + ch]); }
                xc[e] = a; }
            __syncthreads();
            const float* WA = p.o_w_a + ((size_t)d * 16 + nb) * 128 * 128; const float* WX = p.o_w_x + ((size_t)d * 16 + nb) * 128 * 128;
            const int ch = nb * 128 + j;
            const float ba = p.o_b_a[d * 2048 + ch], bx = p.o_b_x[d * 2048 + ch], sp = softplusf_(-p.o_lam[d * 2048 + ch]);
            for (int i16 = 0; i16 < 16; ++i16) { const int t = tq * 16 + i16; float ra = ba, rx = bx;
                for (int i = 0; i < 128; ++i) { const float xv = bf2f(f2bf(xc[t * 128 + i])); ra += xv * bf2f(f2bf(WA[i * 128 + j])); rx += xv * bf2f(f2bf(WX[i * 128 + j])); }
                const float r = sigmoidf_(ra), ig = sigmoidf_(rx); const float la = -8.f * r * sp; const float a = __expf(la);
                av[t * 128 + j] = a; uv[t * 128 + j] = sqrtf(-expm1f(2.f * la)) * (ig * xc[t * 128 + j]); }
            __syncthreads();
            if (tid < 128) {
                const size_t sidx = (((size_t)bb * 2 + d) * NCH + c) * 2048 + ch;
                if (MODE == 0) { float A = 1.f, hh = 0.f;
                    if (d == 0) for (int t = 0; t < 64; ++t) { const float a = av[t * 128 + j]; hh = a * hh + uv[t * 128 + j]; A *= a; }
                    else for (int t = 63; t >= 0; --t) { const float a = av[t * 128 + j]; hh = a * hh + uv[t * 128 + j]; A *= a; }
                    SUMA[sidx] = A; SUMH[sidx] = hh;
                } else { float hh = SUMH[sidx];
                    if (d == 0) for (int t = 0; t < 64; ++t) { hh = av[t * 128 + j] * hh + uv[t * 128 + j]; hf[t * 128 + j] = hh; }
                    else for (int t = 63; t >= 0; --t) { hh = av[t * 128 + j] * hh + uv[t * 128 + j]; const size_t o = (size_t)(row0 + t) * 2048 + ch; Y[o] = f2bf((hf[t * 128 + j] + hh) * bf2f(SG[o])); }
                }
            }
        }
    }
    __syncthreads();
}
__device__ void st_carry(const Params& p, int vb, int nvb, const float* SUMA, float* SUMH) {
    for (int e = vb * NTHREADS + threadIdx.x; e < NB * 2 * 2048; e += nvb * NTHREADS) {
        const int ch = e & 2047, d = (e >> 11) & 1, bb = e >> 12; float hh = 0.f;
        for (int step = 0; step < NCH; ++step) { const int c = d == 0 ? (step < 4 ? 64 + step : step - 4) : 67 - step;
            const size_t sidx = (((size_t)bb * 2 + d) * NCH + c) * 2048 + ch; const float A = SUMA[sidx], hl = SUMH[sidx]; SUMH[sidx] = hh; hh = A * hh + hl; }
    }
}
__device__ void st_final(const Params& p, int vb, int nvb) {
    const int lane = threadIdx.x & 63, gw = vb * (NTHREADS / 64) + (threadIdx.x >> 6), ngw = nvb * (NTHREADS / 64);
    for (int row = gw; row < NLAT; row += ngw) { float* xr = p.out + (size_t)row * 1024; float4 v[4]; float ss = 0.f;
#pragma unroll
        for (int j = 0; j < 4; ++j) { v[j] = *(const float4*)(xr + j * 256 + lane * 4); ss += v[j].x * v[j].x + v[j].y * v[j].y + v[j].z * v[j].z + v[j].w * v[j].w; }
        const float rinv = rsqrtf(wave_sum(ss) * (1.f / 1024.f) + EPS);
#pragma unroll
        for (int j = 0; j < 4; ++j) { const float4 g = *(const float4*)(p.final_g + j * 256 + lane * 4); float4 o; o.x = v[j].x * rinv * g.x; o.y = v[j].y * rinv * g.y; o.z = v[j].z * rinv * g.z; o.w = v[j].w * rinv * g.w; *(float4*)(xr + j * 256 + lane * 4) = o; }
    }
}


namespace pg8 {
#define PG8_LAS __attribute__((address_space(3)))
typedef short bf16x8 __attribute__((ext_vector_type(8)));
typedef float f32x4 __attribute__((ext_vector_type(4)));
typedef unsigned u32x4 __attribute__((ext_vector_type(4)));
constexpr int BM = 256, BK = 64, HALF = 128, HTB = HALF * BK * 2, STAGE_BYTES = 8 * HTB, NXCD = 8, WGM = 8;
__host__ __device__ __forceinline__ int lds_byte(int r, int c) { const int st = (r >> 4) * 2 + (c >> 5), rr = r & 15, cc = c & 31, ob = rr * 64 + cc * 2; return st * 1024 + (ob ^ (((ob >> 9) & 1) << 5)); }
__host__ __device__ __forceinline__ void stage_rc(int b, int& R, int& C) { const int st = b / 1024, sb = b % 1024, swz = sb ^ (((sb >> 9) & 1) << 5); R = (st >> 1) * 16 + swz / 64; C = (st & 1) * 32 + (swz % 64) / 2; }
__host__ __device__ __forceinline__ int perm32(int rho) { const int n = rho >> 4, i = rho & 15; return 8 * (i >> 2) + 4 * n + (i & 3); }
struct Unit { int pm, pn; };
struct Gemm { const bf16_t* A; const bf16_t* Bt; int M, N, K; };
struct TileOrder {
    int nM, nN, nwg, G, c, m0, split, base0, base1, nM2, nN2, m02;
    __device__ void init(int nM_, int nN_, int G_, int c_, int m0_ = 0, int split_ = 1 << 30, int base0_ = 0, int base1_ = 0, int nM2_ = 0, int nN2_ = 0, int m02_ = 0) {
        nM = nM_; nN = nN_; nwg = nM * nN; G = G_; c = c_; m0 = m0_; split = split_; base0 = base0_; base1 = base1_; nM2 = nM2_; nN2 = nN2_; m02 = m02_; }
    __device__ bool next(int i, Unit& u) const {
        const long L = (long)i * G + c;
        if (L >= nwg) { const long L2 = L - nwg; if (L2 >= (long)nM2 * nN2) return false; u.pm = m02 + (int)(L2 / nN2); u.pn = (int)(L2 % nN2); return true; }
        int wgid = (int)L; { const int q = nwg / NXCD, r = nwg % NXCD, xcd = wgid % NXCD, off = wgid / NXCD; wgid = (xcd < r ? xcd * (q + 1) : r * (q + 1) + (xcd - r) * q) + off; }
        const int nig = WGM * nN, gid = wgid / nig, fm = gid * WGM, gsz = (nM - fm) < WGM ? (nM - fm) : WGM;
        const int pm = fm + ((wgid % nig) % gsz), j = (wgid % nig) / gsz;
        u.pm = m0 + pm; u.pn = j < split ? base0 + j : base1 + (j - split); return true;
    }
    __device__ __forceinline__ void a_ready(const Unit&) const {}
    __device__ __forceinline__ void done(const Unit&) const {}
};
typedef float f32x2_t __attribute__((ext_vector_type(2))); typedef __bf16 bf16x2_t __attribute__((ext_vector_type(2)));
__device__ __forceinline__ unsigned cvt_pk_bf16(float lo, float hi) { f32x2_t v = {lo, hi}; bf16x2_t b = __builtin_convertvector(v, bf16x2_t); return __builtin_bit_cast(unsigned, b); }
template <class Epi, class Sched, bool ALIGN_EPI = false, bool SP2 = false>
__device__ __forceinline__ void gemm_phase(PG8_LAS unsigned char* lds, const Gemm g, const Sched& S, const Epi& E) {
    const int tid = threadIdx.x, wid = __builtin_amdgcn_readfirstlane(tid >> 6), lane = tid & 63, wr = wid >> 2, wc = wid & 3, fr = lane & 15, fq = lane >> 4;
    const int K = g.K, nt = K / BK;
    unsigned voffA[2], voffB[2];
#pragma unroll
    for (int i = 0; i < 2; ++i) { int R, C; stage_rc(tid * 16 + i * 8192, R, C); const int Rb = Epi::PERM ? ((R & ~31) + perm32(R & 31)) : R;
        voffA[i] = (unsigned)(R * K + C) * 2u; voffB[i] = (unsigned)(Rb * K + C) * 2u; }
    const size_t kstep = (size_t)(BK * 2);
    const size_t hstep = (size_t)HALF * K * 2;
    const size_t tstep = 2 * hstep;
    const unsigned ldsw = (unsigned)wid * 1024u;
    const int aoff = lds_byte(wr * 64 + fr, fq * 8), boff = lds_byte(wc * 32 + fr, fq * 8);
#define PG8_SA(b, h) (((b) * 2 + (h)) * HTB)
#define PG8_SB(b, h) ((4 + (b) * 2 + (h)) * HTB)
#define PG8_STAGE(bufoff, gbase, voff) do { _Pragma("unroll") for (int _i = 0; _i < 2; ++_i) \
        __builtin_amdgcn_global_load_lds((const unsigned*)((const char*)(gbase) + (voff)[_i]), (PG8_LAS unsigned*)(lds + (bufoff) + ldsw + _i * 8192), 16, 0, 0); } while (0)
#define PG8_LDA(dst, b, h) do { _Pragma("unroll") for (int m = 0; m < 4; ++m) _Pragma("unroll") for (int k = 0; k < 2; ++k) dst[m][k] = *(const PG8_LAS bf16x8*)(lds + PG8_SA(b, h) + aoff + m * 2048 + k * 1024); } while (0)
#define PG8_LDB(dst, b, h) do { _Pragma("unroll") for (int n = 0; n < 2; ++n) _Pragma("unroll") for (int k = 0; k < 2; ++k) dst[n][k] = *(const PG8_LAS bf16x8*)(lds + PG8_SB(b, h) + boff + n * 2048 + k * 1024); } while (0)
#define PG8_MMA(ai, bj, At, Bt) do { __builtin_amdgcn_s_setprio(1); _Pragma("unroll") for (int m = 0; m < 4; ++m) _Pragma("unroll") for (int n = 0; n < 2; ++n) _Pragma("unroll") for (int k = 0; k < 2; ++k) \
        acc[ai][bj][m][n] = __builtin_amdgcn_mfma_f32_16x16x32_bf16(Bt[n][k], At[m][k], acc[ai][bj][m][n], 0, 0, 0); __builtin_amdgcn_s_setprio(0); } while (0)
#define PG8_WAIT_V(n) asm volatile("s_waitcnt vmcnt(" #n ")" ::: "memory")
#define PG8_WAIT_L(n) asm volatile("s_waitcnt lgkmcnt(" #n ")" ::: "memory")
#define PG8_BAR __builtin_amdgcn_s_barrier()
#define PG8_SCHED __builtin_amdgcn_sched_barrier(0)
    Unit cur, nxt; int ui = 0;
    if (!S.next(0, cur)) return;
    f32x4 acc[2][2][4][2];
#pragma unroll
    for (int a = 0; a < 2; ++a)
#pragma unroll
        for (int b = 0; b < 2; ++b)
#pragma unroll
            for (int m = 0; m < 4; ++m)
#pragma unroll
                for (int n = 0; n < 2; ++n) acc[a][b][m][n] = (f32x4){0.f, 0.f, 0.f, 0.f};
    bf16x8 At[4][2], B0[2][2], B1[2][2];
    const char* cA = (const char*)g.A + (size_t)cur.pm * tstep; const char* cB = (const char*)g.Bt + (size_t)cur.pn * tstep;
    S.a_ready(cur);
    if constexpr (SP2) {
        PG8_STAGE(PG8_SB(0, 0), cB, voffB); PG8_STAGE(PG8_SB(0, 1), cB + hstep, voffB); PG8_STAGE(PG8_SA(0, 0), cA, voffA); PG8_STAGE(PG8_SA(0, 1), cA + hstep, voffA);
        if (wr == 1) PG8_BAR;
        PG8_WAIT_V(2); PG8_BAR;
        PG8_STAGE(PG8_SB(1, 0), cB + kstep, voffB); PG8_STAGE(PG8_SA(1, 0), cA + kstep, voffA); PG8_STAGE(PG8_SB(1, 1), cB + hstep + kstep, voffB);
        PG8_WAIT_V(6); PG8_BAR;
    } else {
        PG8_STAGE(PG8_SB(0, 0), cB, voffB); PG8_STAGE(PG8_SA(0, 0), cA, voffA); PG8_STAGE(PG8_SB(0, 1), cB + hstep, voffB); PG8_STAGE(PG8_SA(0, 1), cA + hstep, voffA);
        if (wr == 1) PG8_BAR;
        PG8_WAIT_V(4); PG8_BAR;
        PG8_STAGE(PG8_SB(1, 0), cB + kstep, voffB); PG8_STAGE(PG8_SA(1, 0), cA + kstep, voffA); PG8_STAGE(PG8_SB(1, 1), cB + hstep + kstep, voffB);
        PG8_WAIT_V(6); PG8_BAR;
    }
    for (;;) {
        const bool has_next = S.next(ui + 1, nxt);
        const char* nA = has_next ? (const char*)g.A + (size_t)nxt.pm * tstep : cA; const char* nB = has_next ? (const char*)g.Bt + (size_t)nxt.pn * tstep : cB;
        for (int t = 0; t < nt; t += 2) {
            const bool last = (t == nt - 2);
            const char* a1 = cA + (size_t)(t + 1) * kstep;
            const char* a2 = last ? nA : cA + (size_t)(t + 2) * kstep; const char* b2 = last ? nB : cB + (size_t)(t + 2) * kstep;
            const char* a3 = a2 + kstep; const char* b3 = b2 + kstep;
            if (last && has_next) S.a_ready(nxt);
            if constexpr (SP2) {
            PG8_LDB(B0, 0, 0); PG8_LDB(B1, 0, 1); PG8_SCHED; PG8_LDA(At, 0, 0); PG8_STAGE(PG8_SA(1, 1), a1 + hstep, voffA);
            PG8_WAIT_V(8); PG8_WAIT_L(0); PG8_BAR; PG8_MMA(0, 0, At, B0); PG8_MMA(0, 1, At, B1); PG8_BAR; PG8_SCHED;
            PG8_LDA(At, 0, 1); PG8_STAGE(PG8_SB(0, 0), b2, voffB); PG8_STAGE(PG8_SB(0, 1), b2 + hstep, voffB); PG8_STAGE(PG8_SA(0, 0), a2, voffA);
            PG8_WAIT_V(8); PG8_WAIT_L(0); PG8_BAR; PG8_MMA(1, 0, At, B0); PG8_MMA(1, 1, At, B1); PG8_BAR; PG8_SCHED;
            PG8_LDB(B0, 1, 0); PG8_LDB(B1, 1, 1); PG8_SCHED; PG8_LDA(At, 1, 0); PG8_STAGE(PG8_SA(0, 1), a2 + hstep, voffA);
            PG8_WAIT_V(8); PG8_WAIT_L(0); PG8_BAR; PG8_MMA(0, 0, At, B0); PG8_MMA(0, 1, At, B1); PG8_BAR; PG8_SCHED;
            PG8_LDA(At, 1, 1); PG8_STAGE(PG8_SB(1, 0), b3, voffB); PG8_STAGE(PG8_SB(1, 1), b3 + hstep, voffB); PG8_STAGE(PG8_SA(1, 0), a3, voffA);
            PG8_WAIT_V(8); PG8_WAIT_L(0); PG8_BAR; PG8_MMA(1, 0, At, B0); PG8_MMA(1, 1, At, B1); PG8_BAR; PG8_SCHED;
            } else {
            PG8_LDB(B0, 0, 0); PG8_SCHED; PG8_LDA(At, 0, 0); PG8_STAGE(PG8_SA(1, 1), a1 + hstep, voffA);
            PG8_WAIT_L(8); PG8_BAR; PG8_WAIT_L(0); PG8_MMA(0, 0, At, B0); PG8_BAR; PG8_SCHED;
            PG8_LDB(B1, 0, 1); PG8_STAGE(PG8_SB(0, 0), b2, voffB);
            PG8_BAR; PG8_WAIT_L(0); PG8_MMA(0, 1, At, B1); PG8_BAR;
            PG8_LDA(At, 0, 1); PG8_STAGE(PG8_SA(0, 0), a2, voffA);
            PG8_BAR; PG8_WAIT_L(0); PG8_MMA(1, 0, At, B0); PG8_BAR; PG8_SCHED;
            PG8_STAGE(PG8_SB(0, 1), b2 + hstep, voffB);
            PG8_WAIT_V(6); PG8_BAR; PG8_MMA(1, 1, At, B1); PG8_BAR;
            PG8_LDB(B0, 1, 0); PG8_SCHED; PG8_LDA(At, 1, 0); PG8_STAGE(PG8_SA(0, 1), a2 + hstep, voffA);
            PG8_WAIT_L(8); PG8_BAR; PG8_WAIT_L(0); PG8_MMA(0, 0, At, B0); PG8_BAR; PG8_SCHED;
            PG8_LDB(B1, 1, 1); PG8_STAGE(PG8_SB(1, 0), b3, voffB);
            PG8_BAR; PG8_WAIT_L(0); PG8_MMA(0, 1, At, B1); PG8_BAR;
            PG8_LDA(At, 1, 1); PG8_STAGE(PG8_SA(1, 0), a3, voffA);
            PG8_BAR; PG8_WAIT_L(0); PG8_MMA(1, 0, At, B0); PG8_BAR; PG8_SCHED;
            PG8_STAGE(PG8_SB(1, 1), b3 + hstep, voffB);
            PG8_WAIT_V(6); PG8_BAR; PG8_MMA(1, 1, At, B1); PG8_BAR;
            }
        }
        if constexpr (ALIGN_EPI) { if (wr == 0) PG8_BAR; }
        if constexpr (!Epi::AFTER_DRAIN) { E(acc, cur, wr, wc, fr, fq); S.done(cur); }
        if (!has_next) break;
#pragma unroll
        for (int a = 0; a < 2; ++a)
#pragma unroll
            for (int b = 0; b < 2; ++b)
#pragma unroll
                for (int m = 0; m < 4; ++m)
#pragma unroll
                    for (int n = 0; n < 2; ++n) acc[a][b][m][n] = (f32x4){0.f, 0.f, 0.f, 0.f};
        cur = nxt; cA = nA; cB = nB; ++ui;
        if constexpr (ALIGN_EPI) { if (wr == 1) PG8_BAR; }
    }
    PG8_WAIT_V(0);
    if constexpr (!ALIGN_EPI) { if (wr == 0) PG8_BAR; }
    PG8_BAR;
    if constexpr (Epi::AFTER_DRAIN) { E.fused(acc, cur, wr, wc, fr, fq, lds, wid, lane); S.done(cur); }
#undef PG8_SA
#undef PG8_SB
#undef PG8_STAGE
#undef PG8_LDA
#undef PG8_LDB
#undef PG8_MMA
#undef PG8_WAIT_V
#undef PG8_WAIT_L
#undef PG8_BAR
#undef PG8_SCHED
}
}

DEVI pg8::u32x4 pack8(const pg8::f32x4& a, const pg8::f32x4& b) { pg8::u32x4 w; w.x = pg8::cvt_pk_bf16(a[0], a[1]); w.y = pg8::cvt_pk_bf16(a[2], a[3]); w.z = pg8::cvt_pk_bf16(b[0], b[1]); w.w = pg8::cvt_pk_bf16(b[2], b[3]); return w; }
DEVI pg8::f32x4 silu4(const pg8::f32x4& a) { pg8::f32x4 r; r[0] = siluf_(a[0]); r[1] = siluf_(a[1]); r[2] = siluf_(a[2]); r[3] = siluf_(a[3]); return r; }
struct FEpi1 {
    static constexpr bool PERM = true, AFTER_DRAIN = false;
    bf16_t *QK, *V, *SGA, *Z, *CBG; float* ALR;
    DEVI void operator()(const pg8::f32x4 (&acc)[2][2][4][2], const pg8::Unit& u, int wr, int wc, int fr, int fq) const {
        const int t = u.pn, row0 = u.pm * 256 + wr * 64 + fr, cw = wc * 32 + 8 * fq;
#pragma unroll
        for (int ai = 0; ai < 2; ++ai)
#pragma unroll
            for (int m = 0; m < 4; ++m) {
                const size_t row = (size_t)(row0 + ai * 128 + m * 16);
                if (t < 12) {
                    bf16_t* base = t < 4 ? QK + row * 1024 + t * 256 : (t < 8 ? V + row * 1024 + (t - 4) * 256 : SGA + row * 1024 + (t - 8) * 256);
#pragma unroll
                    for (int bj = 0; bj < 2; ++bj) { pg8::f32x4 v0 = acc[ai][bj][m][0], v1 = acc[ai][bj][m][1]; if (t >= 8) { v0 = silu4(v0); v1 = silu4(v1); }
                        *(pg8::u32x4*)(base + bj * 128 + cw) = pack8(v0, v1); }
                } else if (t == 12) {
                    if (wc == 0) { *(pg8::f32x4*)(ALR + row * 32 + 8 * fq) = acc[ai][0][m][0]; *(pg8::f32x4*)(ALR + row * 32 + 8 * fq + 4) = acc[ai][0][m][1]; }
                } else if (t < 21) {
                    *(pg8::u32x4*)(Z + row * 1024 + (t - 13) * 128 + cw) = pack8(acc[ai][0][m][0] * acc[ai][1][m][0], acc[ai][0][m][1] * acc[ai][1][m][1]);
                } else {
                    *(pg8::u32x4*)(CBG + row * 1024 + (t - 21) * 128 + cw) = pack8(acc[ai][0][m][0] * silu4(acc[ai][1][m][0]), acc[ai][0][m][1] * silu4(acc[ai][1][m][1]));
                }
            }
    }
};
struct FEpiRes {
    static constexpr bool PERM = false, AFTER_DRAIN = false;
    const float* xl; const float* xc; float* outl; float* outc; const float* MODl;
    DEVI void operator()(const pg8::f32x4 (&acc)[2][2][4][2], const pg8::Unit& u, int wr, int wc, int fr, int fq) const {
        const int row0 = u.pm * 256 + wr * 64 + fr, col0 = u.pn * 256 + wc * 32 + 4 * fq;
        const bool lat = u.pm < NLAT / 256;
        const float* gate = MODl + (size_t)(lat ? (u.pm >> 4) : 4) * 3072 + 2048 + col0;
        pg8::f32x4 gv[2][2];
#pragma unroll
        for (int bj = 0; bj < 2; ++bj)
#pragma unroll
            for (int n = 0; n < 2; ++n) gv[bj][n] = *(const pg8::f32x4*)(gate + bj * 128 + n * 16);
        const float* xin = lat ? xl : xc - (size_t)NLAT * 1024; float* o = lat ? outl : outc - (size_t)NLAT * 1024;
#pragma unroll
        for (int ai = 0; ai < 2; ++ai)
#pragma unroll
            for (int m = 0; m < 4; ++m) { const size_t off = (size_t)(row0 + ai * 128 + m * 16) * 1024 + col0;
#pragma unroll
                for (int bj = 0; bj < 2; ++bj)
#pragma unroll
                    for (int n = 0; n < 2; ++n) { const pg8::f32x4 xv = *(const pg8::f32x4*)(xin + off + bj * 128 + n * 16); *(pg8::f32x4*)(o + off + bj * 128 + n * 16) = xv + gv[bj][n] * acc[ai][bj][m][n]; } }
    }
};
struct FEpi3 {
    static constexpr bool PERM = true, AFTER_DRAIN = false;
    bf16_t* XR; bf16_t* SG;
    DEVI void operator()(const pg8::f32x4 (&acc)[2][2][4][2], const pg8::Unit& u, int wr, int wc, int fr, int fq) const {
        const int t = u.pn, row0 = u.pm * 256 + wr * 64 + fr, cw = wc * 32 + 8 * fq;
        bf16_t* base = t < 8 ? XR + t * 256 : SG + (t - 8) * 256;
#pragma unroll
        for (int ai = 0; ai < 2; ++ai)
#pragma unroll
            for (int m = 0; m < 4; ++m) { bf16_t* rp = base + (size_t)(row0 + ai * 128 + m * 16) * 2048 + cw;
#pragma unroll
                for (int bj = 0; bj < 2; ++bj) { pg8::f32x4 v0 = acc[ai][bj][m][0], v1 = acc[ai][bj][m][1]; if (t >= 8) { v0 = silu4(v0); v1 = silu4(v1); }
                    *(pg8::u32x4*)(rp + bj * 128) = pack8(v0, v1); } }
    }
};
#ifndef FAST_GEMM
#define FAST_GEMM 1
#endif


#define LASP __attribute__((address_space(3)))
__device__ void st_glawalk(const Params& p, int vb, int nvb, unsigned char* lds_, const bf16_t* QIN, const bf16_t* KET, const bf16_t* SC, const float* DEC, const bf16_t* VT, bf16_t* OF, bf16_t* OB) {
    typedef pg8::bf16x8 bx8; typedef pg8::f32x4 f4; typedef unsigned u32x2 __attribute__((ext_vector_type(2)));
    LASP unsigned char* lds = (LASP unsigned char*)lds_;
    constexpr int QOFF = 0, KOFF = 17408, SOFF = KOFF + 18432, VOFF = SOFF + 9216, DOFF = VOFF + 4608, BUFSZ = 50176;
    const int tid = threadIdx.x, wid = __builtin_amdgcn_readfirstlane(tid >> 6), lane = tid & 63, c = lane & 15, g = lane >> 4;
    for (int item = vb; item < 256; item += nvb) {
        const int vs = item & 7, combo = item >> 3, d = combo & 1, h = (combo >> 1) & 3, bb = combo >> 3;
        int soff[6], doff[6];
        { const int p0 = tid, p1 = tid + 512; soff[0] = (p0 >> 4) * 256 + (p0 & 15) * 16; doff[0] = QOFF + (p0 >> 4) * 272 + (p0 & 15) * 16; soff[1] = (p1 >> 4) * 256 + (p1 & 15) * 16; doff[1] = QOFF + (p1 >> 4) * 272 + (p1 & 15) * 16;
          const int q2 = tid, q3 = tid + 512; soff[2] = (q2 >> 3) * 128 + (q2 & 7) * 16; doff[2] = KOFF + (q2 >> 3) * 144 + (q2 & 7) * 16; soff[3] = (q3 >> 3) * 128 + (q3 & 7) * 16; doff[3] = KOFF + (q3 >> 3) * 144 + (q3 & 7) * 16;
          soff[4] = (tid >> 3) * 128 + (tid & 7) * 16; doff[4] = SOFF + (tid >> 3) * 144 + (tid & 7) * 16;
          if (tid < 256) { soff[5] = (vs * 32 + (tid >> 3)) * 128 + (tid & 7) * 16; doff[5] = VOFF + (tid >> 3) * 144 + (tid & 7) * 16; } else { soff[5] = (tid - 256) * 16; doff[5] = DOFF + (tid - 256) * 16; } }
        const bool has5 = tid < 288;
        pg8::u32x4 r[6];
#define GW_LOAD(step) do { const int cc_ = d == 0 ? ((step) < 4 ? 64 + (step) : (step) - 4) : 67 - (step); const size_t u_ = (size_t)((bb * NCH + cc_) * 4 + h) * 2 + d; \
            const unsigned char* q_ = (const unsigned char*)QIN + u_ * 16384; const unsigned char* k_ = (const unsigned char*)KET + u_ * 16384; const unsigned char* s_ = (const unsigned char*)SC + u_ * 8192; \
            const unsigned char* x5_ = tid < 256 ? (const unsigned char*)VT + (u_ >> 1) * 32768 : (const unsigned char*)DEC + u_ * 512; \
            r[0] = *(const pg8::u32x4*)(q_ + soff[0]); r[1] = *(const pg8::u32x4*)(q_ + soff[1]); r[2] = *(const pg8::u32x4*)(k_ + soff[2]); r[3] = *(const pg8::u32x4*)(k_ + soff[3]); r[4] = *(const pg8::u32x4*)(s_ + soff[4]); \
            if (has5) r[5] = *(const pg8::u32x4*)(x5_ + soff[5]); } while (0)
#define GW_WRITE(bufi) do { LASP unsigned char* b_ = lds + (bufi) * BUFSZ; _Pragma("unroll") for (int j_ = 0; j_ < 5; ++j_) *(LASP pg8::u32x4*)(b_ + doff[j_]) = r[j_]; if (has5) *(LASP pg8::u32x4*)(b_ + doff[5]) = r[5]; } while (0)
        f4 S[8];
#pragma unroll
        for (int m = 0; m < 8; ++m) S[m] = (f4){0.f, 0.f, 0.f, 0.f};
        bf16_t* O = d == 0 ? OF : OB;
        __syncthreads();
        GW_LOAD(0); GW_WRITE(0); GW_LOAD(1);
        __syncthreads();
        for (int step = 0; step < NCH; ++step) {
            if (step + 1 < NCH) { GW_WRITE((step + 1) & 1); if (step + 2 < NCH) GW_LOAD(step + 2); }
            if (wid < 2) {
                const LASP unsigned char* B = lds + (step & 1) * BUFSZ;
                const bx8 bv0 = *(const LASP bx8*)(B + VOFF + (16 * wid + c) * 144 + g * 16), bv1 = *(const LASP bx8*)(B + VOFF + (16 * wid + c) * 144 + 64 + g * 16);
                bx8 sB[4];
#pragma unroll
                for (int ks = 0; ks < 4; ++ks) { pg8::u32x4 w; w.x = pg8::cvt_pk_bf16(S[2 * ks][0], S[2 * ks][1]); w.y = pg8::cvt_pk_bf16(S[2 * ks][2], S[2 * ks][3]);
                    w.z = pg8::cvt_pk_bf16(S[2 * ks + 1][0], S[2 * ks + 1][1]); w.w = pg8::cvt_pk_bf16(S[2 * ks + 1][2], S[2 * ks + 1][3]); sB[ks] = __builtin_bit_cast(bx8, w); }
                f4 o[4];
#pragma unroll
                for (int mt = 0; mt < 4; ++mt) o[mt] = (f4){0.f, 0.f, 0.f, 0.f};
#pragma unroll
                for (int ks = 0; ks < 4; ++ks)
#pragma unroll
                    for (int mt = 0; mt < 4; ++mt) { const LASP unsigned char* qa = B + QOFF + (16 * mt + c) * 272 + (32 * ks + 4 * g) * 2;
                        const u32x2 lo = *(const LASP u32x2*)qa, hi = *(const LASP u32x2*)(qa + 32); pg8::u32x4 w; w.x = lo.x; w.y = lo.y; w.z = hi.x; w.w = hi.y;
                        o[mt] = __builtin_amdgcn_mfma_f32_16x16x32_bf16(sB[ks], __builtin_bit_cast(bx8, w), o[mt], 0, 0, 0); }
#pragma unroll
                for (int mt = 0; mt < 4; ++mt) { const LASP unsigned char* sa = B + SOFF + (16 * mt + c) * 144 + g * 16;
                    o[mt] = __builtin_amdgcn_mfma_f32_16x16x32_bf16(bv0, *(const LASP bx8*)sa, o[mt], 0, 0, 0);
                    o[mt] = __builtin_amdgcn_mfma_f32_16x16x32_bf16(bv1, *(const LASP bx8*)(sa + 64), o[mt], 0, 0, 0); }
                const int cc = d == 0 ? (step < 4 ? 64 + step : step - 4) : 67 - step; const int row0 = row_of(bb, cc, 0);
#pragma unroll
                for (int mt = 0; mt < 4; ++mt) { u32x2 w; w.x = pg8::cvt_pk_bf16(o[mt][0], o[mt][1]); w.y = pg8::cvt_pk_bf16(o[mt][2], o[mt][3]);
                    *(u32x2*)(O + (size_t)(row0 + 16 * mt + c) * 1024 + h * 256 + vs * 32 + 16 * wid + 4 * g) = w; }
#pragma unroll
                for (int m = 0; m < 8; ++m) { const f4 dv = *(const LASP f4*)(B + DOFF + (16 * m + 4 * g) * 4); const LASP unsigned char* ka = B + KOFF + (16 * m + c) * 144 + g * 16;
                    S[m] = S[m] * dv;
                    S[m] = __builtin_amdgcn_mfma_f32_16x16x32_bf16(*(const LASP bx8*)ka, bv0, S[m], 0, 0, 0);
                    S[m] = __builtin_amdgcn_mfma_f32_16x16x32_bf16(*(const LASP bx8*)(ka + 64), bv1, S[m], 0, 0, 0); }
            }
            __syncthreads();
        }
#undef GW_LOAD
#undef GW_WRITE
    }
}
#ifndef FAST_WALK
#define FAST_WALK 1
#endif
__device__ __forceinline__ void run_stage(const Params& p, int st, int vb, int nvb, unsigned char* lds) {
    unsigned char* ws = p.ws;
    float* MOD = (float*)(ws + WS_MOD); float* ALR = (float*)(ws + WS_ALR); float* X1C = (float*)(ws + WS_X1C);
    float* SUMA = (float*)(ws + WS_SUMA); float* SUMH = (float*)(ws + WS_SUMH); float* DEC = (float*)(ws + WS_DEC);
    bf16_t* Bt1 = (bf16_t*)(ws + WS_BT1); bf16_t* Bt2 = (bf16_t*)(ws + WS_BT2); bf16_t* Bt3 = (bf16_t*)(ws + WS_BT3); bf16_t* Bt4 = (bf16_t*)(ws + WS_BT4);
    bf16_t* S0 = (bf16_t*)(ws + WS_SLOT(0)); bf16_t* S1 = (bf16_t*)(ws + WS_SLOT(1)); bf16_t* S2 = (bf16_t*)(ws + WS_SLOT(2));
    bf16_t* S3 = (bf16_t*)(ws + WS_SLOT(3)); bf16_t* S4 = (bf16_t*)(ws + WS_SLOT(4)); bf16_t* S5 = (bf16_t*)(ws + WS_SLOT(5));
    bf16_t* DO0 = (bf16_t*)p.out; bf16_t* DOSC = (bf16_t*)((unsigned char*)p.out + 34 * MiB);
    switch (st) {
    case 0: st_mod(p, vb, nvb, (float*)lds); st_wprep(p, vb, nvb); break;
    case 1: st_modulate(p, vb, nvb, 0, p.x, p.ctx, S0); break;
    case 3: st_glaprep(p, vb, nvb, lds, S1, S2, ALR, S3, S4, DOSC, DEC, S5); break;
#if FAST_WALK
    case 4: st_glawalk(p, vb, nvb, lds, S3, S4, DOSC, DEC, S5, S2, DO0); break;
#else
    case 4: st_glawalk_naive(p, vb, nvb, (float*)lds, S3, S4, DOSC, DEC, S5, S2, DO0); break;
#endif
    case 6: st_inner(p, vb, nvb, S2, DO0, S3, S4, S5, S0); break;
    case 8: st_modulate(p, vb, nvb, 1, p.out, X1C, S2); break;
    case 10: st_rglru_naive<0>(p, vb, nvb, (float*)lds, S3, S0, SUMA, SUMH, S0); break;
    case 11: st_carry(p, vb, nvb, SUMA, SUMH); break;
    case 12: st_rglru_naive<1>(p, vb, nvb, (float*)lds, S3, S0, SUMA, SUMH, S0); break;
    case 14: st_final(p, vb, nvb); break;
#if FAST_GEMM
    case 2: { FEpi1 E{S1, S2, S3, S4, S5, ALR}; pg8::Gemm g{S0, Bt1, NT, N1, 1024}; pg8::TileOrder S; S.init(NT / 256, 9, nvb, vb, 0, 8, 0, 12);
              pg8::gemm_phase<FEpi1, pg8::TileOrder, true, true>((PG8_LAS unsigned char*)lds, g, S, E); } break;
    case 5: { FEpi1 E{S1, S2, S3, S4, S5, ALR}; pg8::Gemm g{S0, Bt1, NT, N1, 1024}; pg8::TileOrder S; S.init(NT / 256, 20, nvb, vb, 0, 4, 8, 13);
              pg8::gemm_phase<FEpi1, pg8::TileOrder, true, true>((PG8_LAS unsigned char*)lds, g, S, E); } break;
    case 7: { FEpiRes E{p.x, p.ctx, p.out, X1C, MOD}; pg8::Gemm g{S0, Bt2, NT, 1024, 2048}; pg8::TileOrder S; S.init(NT / 256, 4, nvb, vb);
              pg8::gemm_phase<FEpiRes, pg8::TileOrder, true, true>((PG8_LAS unsigned char*)lds, g, S, E); } break;
    case 9: { FEpi3 E{S3, S0}; pg8::Gemm g{S2, Bt3, NT, 4096, 1024}; pg8::TileOrder S; S.init(NLAT / 256, 16, nvb, vb, 0, 1 << 30, 0, 0, NCTX / 256, 8, NLAT / 256);
              pg8::gemm_phase<FEpi3, pg8::TileOrder, true, true>((PG8_LAS unsigned char*)lds, g, S, E); } break;
    case 13: { FEpiRes E{p.out, nullptr, p.out, nullptr, MOD + 5 * 3072}; pg8::Gemm g{S0, Bt4, NLAT, 1024, 2048}; pg8::TileOrder S; S.init(NLAT / 256, 4, nvb, vb);
              pg8::gemm_phase<FEpiRes, pg8::TileOrder, true, true>((PG8_LAS unsigned char*)lds, g, S, E); } break;
#else
    case 2: { Epi1 E{S1, S2, S3, S4, S5, ALR}; st_gemm_naive(vb, nvb, (float*)lds, S0, Bt1, 0, NT / 32, 0, 8, 1024, E); st_gemm_naive(vb, nvb, (float*)lds, S0, Bt1, 0, NT / 32, 12, 13, 1024, E); } break;
    case 5: { Epi1 E{S1, S2, S3, S4, S5, ALR}; st_gemm_naive(vb, nvb, (float*)lds, S0, Bt1, 0, NT / 32, 8, 12, 1024, E); st_gemm_naive(vb, nvb, (float*)lds, S0, Bt1, 0, NT / 32, 13, 29, 1024, E); } break;
    case 7: { EpiRes E{p.x, p.ctx, p.out, X1C, MOD}; st_gemm_naive(vb, nvb, (float*)lds, S0, Bt2, 0, NT / 32, 0, 4, 2048, E); } break;
    case 9: { Epi3 E{S3, S0}; st_gemm_naive(vb, nvb, (float*)lds, S2, Bt3, 0, NLAT / 32, 0, 16, 1024, E); st_gemm_naive(vb, nvb, (float*)lds, S2, Bt3, NLAT / 32, NT / 32, 0, 8, 1024, E); } break;
    case 13: { EpiRes E{p.out, nullptr, p.out, nullptr, MOD + 5 * 3072}; st_gemm_naive(vb, nvb, (float*)lds, S0, Bt4, 0, NLAT / 32, 0, 4, 2048, E); } break;
#endif
    }
}
constexpr int NSTAGES = 15;
constexpr int LDS_BYTES = 147456;

#ifndef ONE_LAUNCH
#define ONE_LAUNCH 1
#endif
#if !ONE_LAUNCH
__global__ void __launch_bounds__(NTHREADS) k_mega(Params p, int st) {
    extern __shared__ __attribute__((aligned(16))) unsigned char lds[];
    run_stage(p, st, blockIdx.x, gridDim.x, lds);
}
#else
__global__ void __launch_bounds__(NTHREADS) k_mega(Params p) {
    extern __shared__ __attribute__((aligned(16))) unsigned char lds[];
    cg::grid_group grid = cg::this_grid();
#define RS(k) run_stage(p, k, blockIdx.x, gridDim.x, lds)
    RS(0); grid.sync(); RS(1); grid.sync(); RS(2); grid.sync(); RS(3); grid.sync(); RS(4); grid.sync(); RS(5); grid.sync(); RS(6); grid.sync(); RS(7); grid.sync();
    RS(8); grid.sync(); RS(9); grid.sync(); RS(10); grid.sync(); RS(11); grid.sync(); RS(12); grid.sync(); RS(13); grid.sync(); RS(14);
#undef RS
}
#endif

extern "C" void kernel_launch(void* const* d_in, const int* in_sizes, int n_in, void* d_out, int out_size, void* d_ws, size_t ws_size, hipStream_t stream) {
    static int inited = 0, grid_blocks = 0;
    if (!inited) {
        if (n_in != 23 || ws_size < WS_END || out_size != NLAT * D) { fprintf(stderr, "kernel_launch: unexpected shapes n_in %d ws %zu out %d\n", n_in, ws_size, out_size); inited = -1; return; }
        if (hipFuncSetAttribute((const void*)k_mega, hipFuncAttributeMaxDynamicSharedMemorySize, LDS_BYTES) != hipSuccess) { fprintf(stderr, "hipFuncSetAttribute failed\n"); inited = -1; return; }
        int dev = 0, cus = 0, per_cu = 0;
        (void)hipGetDevice(&dev); (void)hipDeviceGetAttribute(&cus, hipDeviceAttributeMultiprocessorCount, dev);
        (void)hipOccupancyMaxActiveBlocksPerMultiprocessor(&per_cu, (const void*)k_mega, NTHREADS, LDS_BYTES);
        if (per_cu < 1) { fprintf(stderr, "kernel_launch: occupancy query says %d blocks per CU\n", per_cu); per_cu = 1; }
        if (per_cu > 1) per_cu = 1;
        grid_blocks = cus * per_cu;
        inited = 1;
    }
    if (inited < 0) return;
    Params p{};
    const float** f = (const float**)&p;
    for (int i = 0; i < 23; ++i) f[i] = (const float*)d_in[i];
    p.out = (float*)d_out; p.ws = (unsigned char*)d_ws;
#if ONE_LAUNCH
    void* args[] = {&p};
    hipError_t e = hipLaunchCooperativeKernel((const void*)k_mega, dim3(grid_blocks), dim3(NTHREADS), args, LDS_BYTES, stream);
    if (e != hipSuccess) fprintf(stderr, "cooperative launch failed: %s (grid %d)\n", hipGetErrorString(e), grid_blocks);
#else
    for (int st = 0; st < NSTAGES; ++st) hipLaunchKernelGGL(k_mega, dim3(1024), dim3(NTHREADS), LDS_BYTES, stream, p, st);
#endif
}
```

```cpp
#include <hip/hip_runtime.h>
#include <hip/hip_cooperative_groups.h>
namespace cg = cooperative_groups;
#include <cstdio>
#include <cstdint>

typedef unsigned short bf16_t;
#define DEVI __device__ __forceinline__

constexpr int D = 1024, NB = 4, SEQ = 4096, CTXL = 256;
constexpr int NLAT = NB * SEQ;
constexpr int NCTX = NB * CTXL;
constexpr int NT = NLAT + NCTX;
constexpr int NCH = 68;
constexpr int EVEN_IN = 7200;
constexpr int N1 = 7424;
constexpr int N1A = 13 * 256;
constexpr int RGW = 2048;
constexpr float EPS = 1e-6f;

constexpr size_t MiB = 1u << 20;
constexpr size_t WS_CTL = 0;
constexpr size_t WS_MOD = 1 * MiB;
constexpr size_t WS_ALR = 2 * MiB;
constexpr size_t WS_X1C = 5 * MiB;
constexpr size_t WS_SUMA = 9 * MiB;
constexpr size_t WS_SUMH = 9 * MiB + 4608 * 1024;
constexpr size_t WS_DEC = 18 * MiB;
constexpr size_t WS_BT1 = 19 * MiB + 512 * 1024;
constexpr size_t WS_BT2 = 34 * MiB;
constexpr size_t WS_BT3 = 38 * MiB;
constexpr size_t WS_BT4 = 46 * MiB;
constexpr size_t WS_BD = 50 * MiB;
constexpr size_t WS_S0 = 52 * MiB;
constexpr size_t SLOT = 34 * MiB;
constexpr size_t WS_END = WS_S0 + 6 * SLOT;
static_assert(WS_END == 256 * MiB, "ws map");
#define WS_SLOT(i) (WS_S0 + (size_t)(i) * SLOT)

struct Params {
    const float* x; const float* c; const float* ctx; const float* c_ctx; const float* norm_g; const float* w_mod; const float* b_mod;
    const float* e_w_in; const float* e_w_a2; const float* e_b_a2; const float* e_gla_g; const float* e_conv_w; const float* e_w_out;
    const float* o_w_in; const float* o_conv_w; const float* o_conv_b; const float* o_w_a; const float* o_b_a; const float* o_w_x; const float* o_b_x;
    const float* o_lam; const float* o_w_out; const float* final_g;
    float* out; unsigned char* ws;
};

DEVI float bf2f(bf16_t v) { return __uint_as_float((unsigned)v << 16); }
DEVI bf16_t f2bf(float f) { unsigned u = __float_as_uint(f); return (bf16_t)((u + 0x7fffu + ((u >> 16) & 1u)) >> 16); }
DEVI float sigmoidf_(float x) { return 1.0f / (1.0f + __expf(-x)); }
DEVI float siluf_(float x) { return x / (1.0f + __expf(-x)); }
DEVI float softplusf_(float x) { return fmaxf(x, 0.f) + log1pf(__expf(-fabsf(x))); }
DEVI float logsigmoidf_(float x) { return fminf(x, 0.f) - log1pf(__expf(-fabsf(x))); }
DEVI int row_of(int bb, int c, int t) { return c < 64 ? bb * 4096 + c * 64 + t : NLAT + bb * 256 + (c - 64) * 64 + t; }
DEVI int mod_idx(int row) { return row < NLAT ? (row >> 12) : 4; }
DEVI float wave_sum(float v) {
#pragma unroll
    for (int o = 1; o < 64; o <<= 1) v += __shfl_xor(v, o);
    return v;
}
__host__ __device__ inline int colmap1(int n) {
    const int t = n >> 8, c = n & 255;
    if (t < 12) return n;
    if (t == 12) return c < 32 ? 3072 + c : -1;
    if (t < 21) { const int j = t - 13; return c < 128 ? 4128 + 128 * j + c : 5152 + 128 * j + (c - 128); }
    const int j = t - 21; return c < 128 ? 3104 + 128 * j + c : 6176 + 128 * j + (c - 128);
}

#define NTHREADS 512

__device__ void st_mod(const Params& p, int vb, int nvb, float* lds) {
    float* MOD = (float*)(p.ws + WS_MOD);
    for (int i = threadIdx.x; i < 5 * 1024; i += NTHREADS) { const int s = i >> 10, k = i & 1023; const float v = s < 4 ? p.c[s * 1024 + k] : p.c_ctx[k]; lds[i] = siluf_(v); }
    __syncthreads();
    for (int it = vb; it < 2 * 6; it += nvb) {
        const int li = it / 6, j = (it % 6) * 512 + threadIdx.x;
        const float* W = p.w_mod + (size_t)li * 1024 * 3072 + j;
        float a0 = 0.f, a1 = 0.f, a2 = 0.f, a3 = 0.f, a4 = 0.f;
        for (int k = 0; k < 1024; ++k) { const float w = W[(size_t)k * 3072]; a0 += lds[k] * w; a1 += lds[1024 + k] * w; a2 += lds[2048 + k] * w; a3 += lds[3072 + k] * w; a4 += lds[4096 + k] * w; }
        const float bv = p.b_mod[li * 3072 + j];
        float* o = MOD + (size_t)li * 5 * 3072 + j;
        o[0] = a0 + bv; o[3072] = a1 + bv; o[2 * 3072] = a2 + bv; o[3 * 3072] = a3 + bv; o[4 * 3072] = a4 + bv;
    }
    __syncthreads();
}

__device__ void st_wprep(const Params& p, int vb, int nvb) {
    bf16_t* Bt1 = (bf16_t*)(p.ws + WS_BT1); bf16_t* Bt2 = (bf16_t*)(p.ws + WS_BT2); bf16_t* Bt3 = (bf16_t*)(p.ws + WS_BT3); bf16_t* Bt4 = (bf16_t*)(p.ws + WS_BT4);
    bf16_t* BD = (bf16_t*)(p.ws + WS_BD);
    const size_t gtid = (size_t)vb * NTHREADS + threadIdx.x, gn = (size_t)nvb * NTHREADS;
    for (size_t e = gtid; e < (size_t)N1 * 1024; e += gn) { const int k = (int)(e / N1), n = (int)(e % N1); const int sc = colmap1(n); Bt1[(size_t)n * 1024 + k] = sc < 0 ? (bf16_t)0 : f2bf(p.e_w_in[(size_t)k * EVEN_IN + sc]); }
    for (size_t e = gtid; e < (size_t)2048 * 1024; e += gn) { const int k = (int)(e / 1024), n = (int)(e % 1024); Bt2[(size_t)n * 2048 + k] = f2bf(p.e_w_out[e]); Bt4[(size_t)n * 2048 + k] = f2bf(p.o_w_out[e]); }
    for (size_t e = gtid; e < (size_t)1024 * 4096; e += gn) { const int k = (int)(e / 4096), n = (int)(e % 4096); Bt3[(size_t)n * 1024 + k] = f2bf(p.o_w_in[e]); }
    for (size_t e = gtid; e < (size_t)2 * 16 * 128 * 128; e += gn) { const int j = (int)(e & 127), i = (int)((e >> 7) & 127), dn = (int)(e >> 14);
        BD[((size_t)dn * 128 + j) * 128 + i] = f2bf(p.o_w_a[e]); BD[(size_t)2 * 16 * 128 * 128 + ((size_t)dn * 128 + j) * 128 + i] = f2bf(p.o_w_x[e]); }
}

__device__ void st_modulate(const Params& p, int vb, int nvb, int li, const float* xlat, const float* xctx, bf16_t* H) {
    const float* MOD = (const float*)(p.ws + WS_MOD) + (size_t)li * 5 * 3072;
    const float* g = p.norm_g + li * 1024;
    const int lane = threadIdx.x & 63, gw = vb * (NTHREADS / 64) + (threadIdx.x >> 6), ngw = nvb * (NTHREADS / 64);
    for (int row = gw; row < NT; row += ngw) {
        const float* xr = row < NLAT ? xlat + (size_t)row * 1024 : xctx + (size_t)(row - NLAT) * 1024;
        const float* md = MOD + (size_t)mod_idx(row) * 3072;
        float4 v[4]; float ss = 0.f;
#pragma unroll
        for (int j = 0; j < 4; ++j) { v[j] = *(const float4*)(xr + j * 256 + lane * 4); ss += v[j].x * v[j].x + v[j].y * v[j].y + v[j].z * v[j].z + v[j].w * v[j].w; }
        const float rinv = rsqrtf(wave_sum(ss) * (1.f / 1024.f) + EPS);
#pragma unroll
        for (int j = 0; j < 4; ++j) { const int c0 = j * 256 + lane * 4; const float4 gg = *(const float4*)(g + c0), sh = *(const float4*)(md + c0), sc = *(const float4*)(md + 1024 + c0);
            ushort4 o; o.x = f2bf(v[j].x * rinv * gg.x * (1.f + sc.x) + sh.x); o.y = f2bf(v[j].y * rinv * gg.y * (1.f + sc.y) + sh.y);
            o.z = f2bf(v[j].z * rinv * gg.z * (1.f + sc.z) + sh.z); o.w = f2bf(v[j].w * rinv * gg.w * (1.f + sc.w) + sh.w);
            *(ushort4*)(H + (size_t)row * 1024 + c0) = o; }
    }
}

template <class Epi>
__device__ void st_gemm_naive(int vb, int nvb, float* lds, const bf16_t* A, const bf16_t* Bt, int mt0, int mt1, int nt0, int nt1, int K, const Epi& E) {
    float* As = lds;
    float* Bs = lds + 32 * 33;
    const int tid = threadIdx.x, tx = tid & 63, ty = tid >> 6;
    const int nmt = mt1 - mt0, nnt = nt1 - nt0;
    for (int it = vb; it < nmt * nnt; it += nvb) {
        const int m0 = (mt0 + it / nnt) * 32, n0 = (nt0 + it % nnt) * 256;
        float acc[4][4];
#pragma unroll
        for (int i = 0; i < 4; ++i)
#pragma unroll
            for (int j = 0; j < 4; ++j) acc[i][j] = 0.f;
        for (int k0 = 0; k0 < K; k0 += 32) {
            __syncthreads();
            for (int e = tid; e < 32 * 32; e += NTHREADS) { const int r = e >> 5, kk = e & 31; As[r * 33 + kk] = bf2f(A[(size_t)(m0 + r) * K + k0 + kk]); }
            for (int e = tid; e < 256 * 32; e += NTHREADS) { const int r = e >> 5, kk = e & 31; Bs[r * 33 + kk] = bf2f(Bt[(size_t)(n0 + r) * K + k0 + kk]); }
            __syncthreads();
#pragma unroll 8
            for (int kk = 0; kk < 32; ++kk) {
                float a[4], b[4];
#pragma unroll
                for (int i = 0; i < 4; ++i) a[i] = As[(ty * 4 + i) * 33 + kk];
#pragma unroll
                for (int j = 0; j < 4; ++j) b[j] = Bs[(tx + 64 * j) * 33 + kk];
#pragma unroll
                for (int i = 0; i < 4; ++i)
#pragma unroll
                    for (int j = 0; j < 4; ++j) acc[i][j] += a[i] * b[j];
            }
        }
#pragma unroll
        for (int i = 0; i < 4; ++i) E(m0 + ty * 4 + i, n0, tx, acc[i]);
    }
    __syncthreads();
}

struct Epi1 {
    bf16_t *QK, *V, *SGA, *Z, *CBG; float* ALR;
    DEVI void operator()(int row, int n0, int cl, const float (&v)[4]) const {
        const int t = n0 >> 8;
        if (t < 4) { for (int j = 0; j < 4; ++j) QK[(size_t)row * 1024 + n0 + cl + 64 * j] = f2bf(v[j]); }
        else if (t < 8) { for (int j = 0; j < 4; ++j) V[(size_t)row * 1024 + (n0 - 1024) + cl + 64 * j] = f2bf(v[j]); }
        else if (t < 12) { for (int j = 0; j < 4; ++j) SGA[(size_t)row * 1024 + (n0 - 2048) + cl + 64 * j] = f2bf(siluf_(v[j])); }
        else if (t == 12) { if (cl < 32) ALR[(size_t)row * 32 + cl] = v[0]; }
        else if (t < 21) { const int jt = t - 13; Z[(size_t)row * 1024 + 128 * jt + cl] = f2bf(v[0] * v[2]); Z[(size_t)row * 1024 + 128 * jt + cl + 64] = f2bf(v[1] * v[3]); }
        else { const int jt = t - 21; CBG[(size_t)row * 1024 + 128 * jt + cl] = f2bf(v[0] * siluf_(v[2])); CBG[(size_t)row * 1024 + 128 * jt + cl + 64] = f2bf(v[1] * siluf_(v[3])); }
    }
};
struct EpiRes {
    const float* xl; const float* xc; float* outl; float* outc; const float* MODl;
    DEVI void operator()(int row, int n0, int cl, const float (&v)[4]) const {
        const float* gate = MODl + (size_t)mod_idx(row) * 3072 + 2048;
        for (int j = 0; j < 4; ++j) { const int col = n0 + cl + 64 * j;
            if (row < NLAT) outl[(size_t)row * 1024 + col] = xl[(size_t)row * 1024 + col] + gate[col] * v[j];
            else if (outc) outc[(size_t)(row - NLAT) * 1024 + col] = xc[(size_t)(row - NLAT) * 1024 + col] + gate[col] * v[j]; }
    }
};
struct Epi3 {
    bf16_t* XR; bf16_t* SG;
    DEVI void operator()(int row, int n0, int cl, const float (&v)[4]) const {
        for (int j = 0; j < 4; ++j) { const int col = n0 + cl + 64 * j;
            if (col < 2048) XR[(size_t)row * 2048 + col] = f2bf(v[j]); else if (row < NLAT) SG[(size_t)row * 2048 + col - 2048] = f2bf(siluf_(v[j])); }
    }
};

__device__ void st_glaprep(const Params& p, int vb, int nvb, unsigned char* ldsb, const bf16_t* QK, const bf16_t* V, const float* ALR, bf16_t* QIN, bf16_t* KET, bf16_t* SC, float* DEC, bf16_t* VT) {
    bf16_t* qs = (bf16_t*)ldsb;
    bf16_t* ks = qs + 64 * 136;
    float* tot = (float*)(ks + 64 * 136);
    bf16_t* vs = (bf16_t*)(tot + 4 * 128);
    const int tid = threadIdx.x, kk = tid & 127, tq = tid >> 7;
    for (int u = vb; u < NB * NCH * 4 * 2; u += nvb) {
        const int d = u & 1, h = (u >> 1) & 3, bc = u >> 3, c = bc % NCH, bb = bc / NCH;
        const int row0 = row_of(bb, c, 0);
        float w2[16];
#pragma unroll
        for (int r = 0; r < 16; ++r) w2[r] = p.e_w_a2[((size_t)d * 16 + r) * 512 + h * 128 + kk];
        const float b2 = p.e_b_a2[d * 512 + h * 128 + kk];
        float lg[16];
#pragma unroll
        for (int i = 0; i < 16; ++i) { const float* a = ALR + (size_t)(row0 + tq * 16 + i) * 32 + d * 16; float z = b2;
#pragma unroll
            for (int r = 0; r < 16; ++r) z += a[r] * w2[r];
            lg[i] = logsigmoidf_(z) * (1.f / 16.f); }
        float bcum[16];
        if (d == 0) { float s = 0.f;
#pragma unroll
            for (int i = 0; i < 16; ++i) { s += lg[i]; bcum[i] = s; } tot[tq * 128 + kk] = s; }
        else { float s = 0.f;
#pragma unroll
            for (int i = 15; i >= 0; --i) { s += lg[i]; bcum[i] = s; } tot[tq * 128 + kk] = s; }
        __syncthreads();
        float off = 0.f, blast = 0.f;
        for (int q = 0; q < 4; ++q) { const float tv = tot[q * 128 + kk]; blast += tv; if (d == 0 ? (q < tq) : (q > tq)) off += tv; }
        const float scale = 0.08838834764831845f;
        unsigned short ke[16];
#pragma unroll
        for (int i = 0; i < 16; ++i) { const int t = tq * 16 + i; const float b = bcum[i] + off;
            const float qv = bf2f(QK[(size_t)(row0 + t) * 1024 + h * 128 + kk]) * scale, kv = bf2f(QK[(size_t)(row0 + t) * 1024 + 512 + h * 128 + kk]);
            const bf16_t qi = f2bf(qv * __expf(b)), ki = f2bf(kv * __expf(-b));
            qs[t * 136 + kk] = qi; ks[t * 136 + kk] = ki; ke[i] = f2bf(kv * __expf(blast - b));
            QIN[((size_t)u * 64 + t) * 128 + kk] = qi; }
        { uint4 w0, w1; w0.x = ke[0] | (ke[1] << 16); w0.y = ke[2] | (ke[3] << 16); w0.z = ke[4] | (ke[5] << 16); w0.w = ke[6] | (ke[7] << 16);
          w1.x = ke[8] | (ke[9] << 16); w1.y = ke[10] | (ke[11] << 16); w1.z = ke[12] | (ke[13] << 16); w1.w = ke[14] | (ke[15] << 16);
          uint4* dst = (uint4*)(KET + ((size_t)u * 128 + kk) * 64 + tq * 16); dst[0] = w0; dst[1] = w1; }
        if (tq == 0) DEC[(size_t)u * 128 + kk] = __expf(blast);
        for (int e = tid; e < 64 * 128; e += NTHREADS) { const int t = e >> 7, cc = e & 127; vs[t * 130 + cc] = V[(size_t)(row0 + t) * 1024 + h * 256 + d * 128 + cc]; }
        __syncthreads();
        for (int e = tid; e < 64 * 64; e += NTHREADS) { const int t = e >> 6, s = e & 63; float a = 0.f;
            if (d == 0 ? (s <= t) : (s >= t)) { for (int k2 = 0; k2 < 128; ++k2) a += bf2f(qs[t * 136 + k2]) * bf2f(ks[s * 136 + k2]); }
            SC[((size_t)u * 64 + t) * 64 + s] = f2bf(a); }
        { unsigned short vv[16];
#pragma unroll
          for (int i = 0; i < 16; ++i) vv[i] = vs[(tq * 16 + i) * 130 + kk];
          uint4 w0, w1; w0.x = vv[0] | (vv[1] << 16); w0.y = vv[2] | (vv[3] << 16); w0.z = vv[4] | (vv[5] << 16); w0.w = vv[6] | (vv[7] << 16);
          w1.x = vv[8] | (vv[9] << 16); w1.y = vv[10] | (vv[11] << 16); w1.z = vv[12] | (vv[13] << 16); w1.w = vv[14] | (vv[15] << 16);
          uint4* dst = (uint4*)(VT + (((size_t)(u >> 1)) * 256 + d * 128 + kk) * 64 + tq * 16); dst[0] = w0; dst[1] = w1; }
        __syncthreads();
    }
}

__device__ void st_glawalk_naive(const Params& p, int vb, int nvb, float* Sl, const bf16_t* QIN, const bf16_t* KET, const bf16_t* SC, const float* DEC, const bf16_t* VT, bf16_t* OF, bf16_t* OB) {
    const int vc = threadIdx.x & 255, half = threadIdx.x >> 8;
    for (int combo = vb; combo < 32; combo += nvb) {
        const int d = combo & 1, h = (combo >> 1) & 3, bb = combo >> 3;
        __syncthreads();
        for (int k = half * 64; k < half * 64 + 64; ++k) Sl[k * 256 + vc] = 0.f;
        __syncthreads();
        bf16_t* O = d == 0 ? OF : OB;
        for (int step = 0; step < NCH; ++step) {
            const int c = d == 0 ? (step < 4 ? 64 + step : step - 4) : 67 - step;
            const int u = ((bb * NCH + c) * 4 + h) * 2 + d;
            const bf16_t* q = QIN + (size_t)u * 64 * 128; const bf16_t* ke = KET + (size_t)u * 128 * 64; const bf16_t* sc = SC + (size_t)u * 64 * 64;
            const bf16_t* vt = VT + (((size_t)(u >> 1)) * 256 + vc) * 64;
            float vv[64];
#pragma unroll
            for (int t = 0; t < 64; ++t) vv[t] = bf2f(vt[t]);
            const int row0 = row_of(bb, c, 0);
            for (int t = half * 32; t < half * 32 + 32; ++t) { float a = 0.f;
                for (int k = 0; k < 128; ++k) a += bf2f(q[t * 128 + k]) * bf2f(f2bf(Sl[k * 256 + vc]));
#pragma unroll
                for (int s = 0; s < 64; ++s) a += bf2f(sc[t * 64 + s]) * vv[s];
                O[(size_t)(row0 + t) * 1024 + h * 256 + vc] = f2bf(a); }
            __syncthreads();
            for (int k = half * 64; k < half * 64 + 64; ++k) { float a = DEC[(size_t)u * 128 + k] * Sl[k * 256 + vc];
#pragma unroll
                for (int t = 0; t < 64; ++t) a += bf2f(ke[k * 64 + t]) * vv[t];
                Sl[k * 256 + vc] = a; }
            __syncthreads();
        }
    }
}

__device__ void st_inner(const Params& p, int vb, int nvb, const bf16_t* OF, const bf16_t* OB, const bf16_t* SGA, const bf16_t* Z, const bf16_t* CBG, bf16_t* INNER) {
    const int lane = threadIdx.x & 63, gw = vb * (NTHREADS / 64) + (threadIdx.x >> 6), ngw = nvb * (NTHREADS / 64);
    for (int row = gw; row < NT; row += ngw) {
        bool hasp, hasn;
        if (row < NLAT) { const int t = row & 63; hasp = t != 0; hasn = t != 63; } else { const int t = (row - NLAT) & 255; hasp = t != 0; hasn = t != 255; }
#pragma unroll
        for (int h = 0; h < 4; ++h) {
            const int c0 = h * 256 + lane * 4;
            const ushort4 a = *(const ushort4*)(OF + (size_t)row * 1024 + c0), b = *(const ushort4*)(OB + (size_t)row * 1024 + c0);
            const float o0 = bf2f(a.x) + bf2f(b.x), o1 = bf2f(a.y) + bf2f(b.y), o2 = bf2f(a.z) + bf2f(b.z), o3 = bf2f(a.w) + bf2f(b.w);
            const float rinv = rsqrtf(wave_sum(o0 * o0 + o1 * o1 + o2 * o2 + o3 * o3) * (1.f / 256.f) + EPS);
            const float4 gg = *(const float4*)(p.e_gla_g + lane * 4);
            const ushort4 sg = *(const ushort4*)(SGA + (size_t)row * 1024 + c0);
            ushort4 o; o.x = f2bf(o0 * rinv * gg.x * bf2f(sg.x)); o.y = f2bf(o1 * rinv * gg.y * bf2f(sg.y)); o.z = f2bf(o2 * rinv * gg.z * bf2f(sg.z)); o.w = f2bf(o3 * rinv * gg.w * bf2f(sg.w));
            *(ushort4*)(INNER + (size_t)row * 2048 + c0) = o;
            const ushort4 zc = *(const ushort4*)(Z + (size_t)row * 1024 + c0);
            ushort4 zp = {0, 0, 0, 0}, zn = {0, 0, 0, 0};
            if (hasp) zp = *(const ushort4*)(Z + (size_t)(row - 1) * 1024 + c0);
            if (hasn) zn = *(const ushort4*)(Z + (size_t)(row + 1) * 1024 + c0);
            const float4 w0 = *(const float4*)(p.e_conv_w + c0), w1 = *(const float4*)(p.e_conv_w + 1024 + c0), w2 = *(const float4*)(p.e_conv_w + 2048 + c0);
            const ushort4 cb = *(const ushort4*)(CBG + (size_t)row * 1024 + c0);
            ushort4 y; y.x = f2bf(bf2f(cb.x) * (w0.x * bf2f(zp.x) + w1.x * bf2f(zc.x) + w2.x * bf2f(zn.x)));
            y.y = f2bf(bf2f(cb.y) * (w0.y * bf2f(zp.y) + w1.y * bf2f(zc.y) + w2.y * bf2f(zn.y)));
            y.z = f2bf(bf2f(cb.z) * (w0.z * bf2f(zp.z) + w1.z * bf2f(zc.z) + w2.z * bf2f(zn.z)));
            y.w = f2bf(bf2f(cb.w) * (w0.w * bf2f(zp.w) + w1.w * bf2f(zc.w) + w2.w * bf2f(zn.w)));
            *(ushort4*)(INNER + (size_t)row * 2048 + 1024 + c0) = y;
        }
    }
}

template <int MODE>
__device__ void st_rglru_naive(const Params& p, int vb, int nvb, float* lds, const bf16_t* XR, const bf16_t* SG, float* SUMA, float* SUMH, bf16_t* Y) {
    float* xc = lds;
    float* av = xc + 64 * 128;
    float* uv = av + 64 * 128;
    float* hf = uv + 64 * 128;
    const int tid = threadIdx.x, j = tid & 127, tq = tid >> 7;
    const int nitems = MODE == 0 ? NB * NCH * 16 * 2 : NB * 64 * 16;
    for (int it = vb; it < nitems; it += nvb) {
        int bb, c, nb;
        if (MODE == 0) { nb = (it >> 1) & 15; const int bc = it >> 5; c = bc % NCH; bb = bc / NCH; } else { nb = it & 15; const int bc = it >> 4; c = bc & 63; bb = bc >> 6; }
        const int row0 = row_of(bb, c, 0);
        const int seg0 = c < 64 ? bb * 4096 : NLAT + bb * 256, segn = c < 64 ? 4096 : 256;
        const int tl0 = row0 - seg0;
        for (int dd = 0; dd < (MODE == 0 ? 1 : 2); ++dd) {
            const int d = MODE == 0 ? (it & 1) : dd;
            __syncthreads();
            for (int e = tid; e < 64 * 128; e += NTHREADS) { const int t = e >> 7, i = e & 127, ch = nb * 128 + i; float a = p.o_conv_b[d * 2048 + ch];
#pragma unroll
                for (int jj = 0; jj < 4; ++jj) { const int tt = d == 0 ? tl0 + t - 3 + jj : tl0 + t + 3 - jj;
                    if (tt >= 0 && tt < segn) a += p.o_conv_w[((size_t)d * 4 + jj) * 2048 + ch] * bf2f(XR[(size_t)(seg0 + tt) * 2048 + ch]); }
                xc[e] = a; }
            __syncthreads();
            const float* WA = p.o_w_a + ((size_t)d * 16 + nb) * 128 * 128; const float* WX = p.o_w_x + ((size_t)d * 16 + nb) * 128 * 128;
            const int ch = nb * 128 + j;
            const float ba = p.o_b_a[d * 2048 + ch], bx = p.o_b_x[d * 2048 + ch], sp = softplusf_(-p.o_lam[d * 2048 + ch]);
            for (int i16 = 0; i16 < 16; ++i16) { const int t = tq * 16 + i16; float ra = ba, rx = bx;
                for (int i = 0; i < 128; ++i) { const float xv = bf2f(f2bf(xc[t * 128 + i])); ra += xv * bf2f(f2bf(WA[i * 128 + j])); rx += xv * bf2f(f2bf(WX[i * 128 + j])); }
                const float r = sigmoidf_(ra), ig = sigmoidf_(rx); const float la = -8.f * r * sp; const float a = __expf(la);
                av[t * 128 + j] = a; uv[t * 128 + j] = sqrtf(-expm1f(2.f * la)) * (ig * xc[t * 128 + j]); }
            __syncthreads();
            if (tid < 128) {
                const size_t sidx = (((size_t)bb * 2 + d) * NCH + c) * 2048 + ch;
                if (MODE == 0) { float A = 1.f, hh = 0.f;
                    if (d == 0) for (int t = 0; t < 64; ++t) { const float a = av[t * 128 + j]; hh = a * hh + uv[t * 128 + j]; A *= a; }
                    else for (int t = 63; t >= 0; --t) { const float a = av[t * 128 + j]; hh = a * hh + uv[t * 128 + j]; A *= a; }
                    SUMA[sidx] = A; SUMH[sidx] = hh;
                } else { float hh = SUMH[sidx];
                    if (d == 0) for (int t = 0; t < 64; ++t) { hh = av[t * 128 + j] * hh + uv[t * 128 + j]; hf[t * 128 + j] = hh; }
                    else for (int t = 63; t >= 0; --t) { hh = av[t * 128 + j] * hh + uv[t * 128 + j]; const size_t o = (size_t)(row0 + t) * 2048 + ch; Y[o] = f2bf((hf[t * 128 + j] + hh) * bf2f(SG[o])); }
                }
            }
        }
    }
    __syncthreads();
}
__device__ void st_carry(const Params& p, int vb, int nvb, const float* SUMA, float* SUMH) {
    for (int e = vb * NTHREADS + threadIdx.x; e < NB * 2 * 2048; e += nvb * NTHREADS) {
        const int ch = e & 2047, d = (e >> 11) & 1, bb = e >> 12; float hh = 0.f;
        for (int step = 0; step < NCH; ++step) { const int c = d == 0 ? (step < 4 ? 64 + step : step - 4) : 67 - step;
            const size_t sidx = (((size_t)bb * 2 + d) * NCH + c) * 2048 + ch; const float A = SUMA[sidx], hl = SUMH[sidx]; SUMH[sidx] = hh; hh = A * hh + hl; }
    }
}
__device__ void st_final(const Params& p, int vb, int nvb) {
    const int lane = threadIdx.x & 63, gw = vb * (NTHREADS / 64) + (threadIdx.x >> 6), ngw = nvb * (NTHREADS / 64);
    for (int row = gw; row < NLAT; row += ngw) { float* xr = p.out + (size_t)row * 1024; float4 v[4]; float ss = 0.f;
#pragma unroll
        for (int j = 0; j < 4; ++j) { v[j] = *(const float4*)(xr + j * 256 + lane * 4); ss += v[j].x * v[j].x + v[j].y * v[j].y + v[j].z * v[j].z + v[j].w * v[j].w; }
        const float rinv = rsqrtf(wave_sum(ss) * (1.f / 1024.f) + EPS);
#pragma unroll
        for (int j = 0; j < 4; ++j) { const float4 g = *(const float4*)(p.final_g + j * 256 + lane * 4); float4 o; o.x = v[j].x * rinv * g.x; o.y = v[j].y * rinv * g.y; o.z = v[j].z * rinv * g.z; o.w = v[j].w * rinv * g.w; *(float4*)(xr + j * 256 + lane * 4) = o; }
    }
}


namespace pg8 {
#define PG8_LAS __attribute__((address_space(3)))
typedef short bf16x8 __attribute__((ext_vector_type(8)));
typedef float f32x4 __attribute__((ext_vector_type(4)));
typedef unsigned u32x4 __attribute__((ext_vector_type(4)));
constexpr int BM = 256, BK = 64, HALF = 128, HTB = HALF * BK * 2, STAGE_BYTES = 8 * HTB, NXCD = 8, WGM = 8;
__host__ __device__ __forceinline__ int lds_byte(int r, int c) { const int st = (r >> 4) * 2 + (c >> 5), rr = r & 15, cc = c & 31, ob = rr * 64 + cc * 2; return st * 1024 + (ob ^ (((ob >> 9) & 1) << 5)); }
__host__ __device__ __forceinline__ void stage_rc(int b, int& R, int& C) { const int st = b / 1024, sb = b % 1024, swz = sb ^ (((sb >> 9) & 1) << 5); R = (st >> 1) * 16 + swz / 64; C = (st & 1) * 32 + (swz % 64) / 2; }
__host__ __device__ __forceinline__ int perm32(int rho) { const int n = rho >> 4, i = rho & 15; return 8 * (i >> 2) + 4 * n + (i & 3); }
struct Unit { int pm, pn; };
struct Gemm { const bf16_t* A; const bf16_t* Bt; int M, N, K; };
struct TileOrder {
    int nM, nN, nwg, G, c, m0, split, base0, base1, nM2, nN2, m02;
    __device__ void init(int nM_, int nN_, int G_, int c_, int m0_ = 0, int split_ = 1 << 30, int base0_ = 0, int base1_ = 0, int nM2_ = 0, int nN2_ = 0, int m02_ = 0) {
        nM = nM_; nN = nN_; nwg = nM * nN; G = G_; c = c_; m0 = m0_; split = split_; base0 = base0_; base1 = base1_; nM2 = nM2_; nN2 = nN2_; m02 = m02_; }
    __device__ bool next(int i, Unit& u) const {
        const long L = (long)i * G + c;
        if (L >= nwg) { const long L2 = L - nwg; if (L2 >= (long)nM2 * nN2) return false; u.pm = m02 + (int)(L2 / nN2); u.pn = (int)(L2 % nN2); return true; }
        int wgid = (int)L; { const int q = nwg / NXCD, r = nwg % NXCD, xcd = wgid % NXCD, off = wgid / NXCD; wgid = (xcd < r ? xcd * (q + 1) : r * (q + 1) + (xcd - r) * q) + off; }
        const int nig = WGM * nN, gid = wgid / nig, fm = gid * WGM, gsz = (nM - fm) < WGM ? (nM - fm) : WGM;
        const int pm = fm + ((wgid % nig) % gsz), j = (wgid % nig) / gsz;
        u.pm = m0 + pm; u.pn = j < split ? base0 + j : base1 + (j - split); return true;
    }
    __device__ __forceinline__ void a_ready(const Unit&) const {}
    __device__ __forceinline__ void done(const Unit&) const {}
};
typedef float f32x2_t __attribute__((ext_vector_type(2))); typedef __bf16 bf16x2_t __attribute__((ext_vector_type(2)));
__device__ __forceinline__ unsigned cvt_pk_bf16(float lo, float hi) { f32x2_t v = {lo, hi}; bf16x2_t b = __builtin_convertvector(v, bf16x2_t); return __builtin_bit_cast(unsigned, b); }
template <class Epi, class Sched, bool ALIGN_EPI = false, bool SP2 = false>
__device__ __forceinline__ void gemm_phase(PG8_LAS unsigned char* lds, const Gemm g, const Sched& S, const Epi& E) {
    const int tid = threadIdx.x, wid = __builtin_amdgcn_readfirstlane(tid >> 6), lane = tid & 63, wr = wid >> 2, wc = wid & 3, fr = lane & 15, fq = lane >> 4;
    const int K = g.K, nt = K / BK;
    unsigned voffA[2], voffB[2];
#pragma unroll
    for (int i = 0; i < 2; ++i) { int R, C; stage_rc(tid * 16 + i * 8192, R, C); const int Rb = Epi::PERM ? ((R & ~31) + perm32(R & 31)) : R;
        voffA[i] = (unsigned)(R * K + C) * 2u; voffB[i] = (unsigned)(Rb * K + C) * 2u; }
    const size_t kstep = (size_t)(BK * 2);
    const size_t hstep = (size_t)HALF * K * 2;
    const size_t tstep = 2 * hstep;
    const unsigned ldsw = (unsigned)wid * 1024u;
    const int aoff = lds_byte(wr * 64 + fr, fq * 8), boff = lds_byte(wc * 32 + fr, fq * 8);
#define PG8_SA(b, h) (((b) * 2 + (h)) * HTB)
#define PG8_SB(b, h) ((4 + (b) * 2 + (h)) * HTB)
#define PG8_STAGE(bufoff, gbase, voff) do { _Pragma("unroll") for (int _i = 0; _i < 2; ++_i) \
        __builtin_amdgcn_global_load_lds((const unsigned*)((const char*)(gbase) + (voff)[_i]), (PG8_LAS unsigned*)(lds + (bufoff) + ldsw + _i * 8192), 16, 0, 0); } while (0)
#define PG8_LDA(dst, b, h) do { _Pragma("unroll") for (int m = 0; m < 4; ++m) _Pragma("unroll") for (int k = 0; k < 2; ++k) dst[m][k] = *(const PG8_LAS bf16x8*)(lds + PG8_SA(b, h) + aoff + m * 2048 + k * 1024); } while (0)
#define PG8_LDB(dst, b, h) do { _Pragma("unroll") for (int n = 0; n < 2; ++n) _Pragma("unroll") for (int k = 0; k < 2; ++k) dst[n][k] = *(const PG8_LAS bf16x8*)(lds + PG8_SB(b, h) + boff + n * 2048 + k * 1024); } while (0)
#define PG8_MMA(ai, bj, At, Bt) do { __builtin_amdgcn_s_setprio(1); _Pragma("unroll") for (int m = 0; m < 4; ++m) _Pragma("unroll") for (int n = 0; n < 2; ++n) _Pragma("unroll") for (int k = 0; k < 2; ++k) \
        acc[ai][bj][m][n] = __builtin_amdgcn_mfma_f32_16x16x32_bf16(Bt[n][k], At[m][k], acc[ai][bj][m][n], 0, 0, 0); __builtin_amdgcn_s_setprio(0); } while (0)
#define PG8_WAIT_V(n) asm volatile("s_waitcnt vmcnt(" #n ")" ::: "memory")
#define PG8_WAIT_L(n) asm volatile("s_waitcnt lgkmcnt(" #n ")" ::: "memory")
#define PG8_BAR __builtin_amdgcn_s_barrier()
#define PG8_SCHED __builtin_amdgcn_sched_barrier(0)
    Unit cur, nxt; int ui = 0;
    if (!S.next(0, cur)) return;
    f32x4 acc[2][2][4][2];
#pragma unroll
    for (int a = 0; a < 2; ++a)
#pragma unroll
        for (int b = 0; b < 2; ++b)
#pragma unroll
            for (int m = 0; m < 4; ++m)
#pragma unroll
                for (int n = 0; n < 2; ++n) acc[a][b][m][n] = (f32x4){0.f, 0.f, 0.f, 0.f};
    bf16x8 At[4][2], B0[2][2], B1[2][2];
    const char* cA = (const char*)g.A + (size_t)cur.pm * tstep; const char* cB = (const char*)g.Bt + (size_t)cur.pn * tstep;
    S.a_ready(cur);
    if constexpr (SP2) {
        PG8_STAGE(PG8_SB(0, 0), cB, voffB); PG8_STAGE(PG8_SB(0, 1), cB + hstep, voffB); PG8_STAGE(PG8_SA(0, 0), cA, voffA); PG8_STAGE(PG8_SA(0, 1), cA + hstep, voffA);
        if (wr == 1) PG8_BAR;
        PG8_WAIT_V(2); PG8_BAR;
        PG8_STAGE(PG8_SB(1, 0), cB + kstep, voffB); PG8_STAGE(PG8_SA(1, 0), cA + kstep, voffA); PG8_STAGE(PG8_SB(1, 1), cB + hstep + kstep, voffB);
        PG8_WAIT_V(6); PG8_BAR;
    } else {
        PG8_STAGE(PG8_SB(0, 0), cB, voffB); PG8_STAGE(PG8_SA(0, 0), cA, voffA); PG8_STAGE(PG8_SB(0, 1), cB + hstep, voffB); PG8_STAGE(PG8_SA(0, 1), cA + hstep, voffA);
        if (wr == 1) PG8_BAR;
        PG8_WAIT_V(4); PG8_BAR;
        PG8_STAGE(PG8_SB(1, 0), cB + kstep, voffB); PG8_STAGE(PG8_SA(1, 0), cA + kstep, voffA); PG8_STAGE(PG8_SB(1, 1), cB + hstep + kstep, voffB);
        PG8_WAIT_V(6); PG8_BAR;
    }
    for (;;) {
        const bool has_next = S.next(ui + 1, nxt);
        const char* nA = has_next ? (const char*)g.A + (size_t)nxt.pm * tstep : cA; const char* nB = has_next ? (const char*)g.Bt + (size_t)nxt.pn * tstep : cB;
        for (int t = 0; t < nt; t += 2) {
            const bool last = (t == nt - 2);
            const char* a1 = cA + (size_t)(t + 1) * kstep;
            const char* a2 = last ? nA : cA + (size_t)(t + 2) * kstep; const char* b2 = last ? nB : cB + (size_t)(t + 2) * kstep;
            const char* a3 = a2 + kstep; const char* b3 = b2 + kstep;
            if (last && has_next) S.a_ready(nxt);
            if constexpr (SP2) {
            PG8_LDB(B0, 0, 0); PG8_LDB(B1, 0, 1); PG8_SCHED; PG8_LDA(At, 0, 0); PG8_STAGE(PG8_SA(1, 1), a1 + hstep, voffA);
            PG8_WAIT_V(8); PG8_WAIT_L(0); PG8_BAR; PG8_MMA(0, 0, At, B0); PG8_MMA(0, 1, At, B1); PG8_BAR; PG8_SCHED;
            PG8_LDA(At, 0, 1); PG8_STAGE(PG8_SB(0, 0), b2, voffB); PG8_STAGE(PG8_SB(0, 1), b2 + hstep, voffB); PG8_STAGE(PG8_SA(0, 0), a2, voffA);
            PG8_WAIT_V(8); PG8_WAIT_L(0); PG8_BAR; PG8_MMA(1, 0, At, B0); PG8_MMA(1, 1, At, B1); PG8_BAR; PG8_SCHED;
            PG8_LDB(B0, 1, 0); PG8_LDB(B1, 1, 1); PG8_SCHED; PG8_LDA(At, 1, 0); PG8_STAGE(PG8_SA(0, 1), a2 + hstep, voffA);
            PG8_WAIT_V(8); PG8_WAIT_L(0); PG8_BAR; PG8_MMA(0, 0, At, B0); PG8_MMA(0, 1, At, B1); PG8_BAR; PG8_SCHED;
            PG8_LDA(At, 1, 1); PG8_STAGE(PG8_SB(1, 0), b3, voffB); PG8_STAGE(PG8_SB(1, 1), b3 + hstep, voffB); PG8_STAGE(PG8_SA(1, 0), a3, voffA);
            PG8_WAIT_V(8); PG8_WAIT_L(0); PG8_BAR; PG8_MMA(1, 0, At, B0); PG8_MMA(1, 1, At, B1); PG8_BAR; PG8_SCHED;
            } else {
            PG8_LDB(B0, 0, 0); PG8_SCHED; PG8_LDA(At, 0, 0); PG8_STAGE(PG8_SA(1, 1), a1 + hstep, voffA);
            PG8_WAIT_L(8); PG8_BAR; PG8_WAIT_L(0); PG8_MMA(0, 0, At, B0); PG8_BAR; PG8_SCHED;
            PG8_LDB(B1, 0, 1); PG8_STAGE(PG8_SB(0, 0), b2, voffB);
            PG8_BAR; PG8_WAIT_L(0); PG8_MMA(0, 1, At, B1); PG8_BAR;
            PG8_LDA(At, 0, 1); PG8_STAGE(PG8_SA(0, 0), a2, voffA);
            PG8_BAR; PG8_WAIT_L(0); PG8_MMA(1, 0, At, B0); PG8_BAR; PG8_SCHED;
            PG8_STAGE(PG8_SB(0, 1), b2 + hstep, voffB);
            PG8_WAIT_V(6); PG8_BAR; PG8_MMA(1, 1, At, B1); PG8_BAR;
            PG8_LDB(B0, 1, 0); PG8_SCHED; PG8_LDA(At, 1, 0); PG8_STAGE(PG8_SA(0, 1), a2 + hstep, voffA);
            PG8_WAIT_L(8); PG8_BAR; PG8_WAIT_L(0); PG8_MMA(0, 0, At, B0); PG8_BAR; PG8_SCHED;
            PG8_LDB(B1, 1, 1); PG8_STAGE(PG8_SB(1, 0), b3, voffB);
            PG8_BAR; PG8_WAIT_L(0); PG8_MMA(0, 1, At, B1); PG8_BAR;
            PG8_LDA(At, 1, 1); PG8_STAGE(PG8_SA(1, 0), a3, voffA);
            PG8_BAR; PG8_WAIT_L(0); PG8_MMA(1, 0, At, B0); PG8_BAR; PG8_SCHED;
            PG8_STAGE(PG8_SB(1, 1), b3 + hstep, voffB);
            PG8_WAIT_V(6); PG8_BAR; PG8_MMA(1, 1, At, B1); PG8_BAR;
            }
        }
        if constexpr (ALIGN_EPI) { if (wr == 0) PG8_BAR; }
        if constexpr (!Epi::AFTER_DRAIN) { E(acc, cur, wr, wc, fr, fq); S.done(cur); }
        if (!has_next) break;
#pragma unroll
        for (int a = 0; a < 2; ++a)
#pragma unroll
            for (int b = 0; b < 2; ++b)
#pragma unroll
                for (int m = 0; m < 4; ++m)
#pragma unroll
                    for (int n = 0; n < 2; ++n) acc[a][b][m][n] = (f32x4){0.f, 0.f, 0.f, 0.f};
        cur = nxt; cA = nA; cB = nB; ++ui;
        if constexpr (ALIGN_EPI) { if (wr == 1) PG8_BAR; }
    }
    PG8_WAIT_V(0);
    if constexpr (!ALIGN_EPI) { if (wr == 0) PG8_BAR; }
    PG8_BAR;
    if constexpr (Epi::AFTER_DRAIN) { E.fused(acc, cur, wr, wc, fr, fq, lds, wid, lane); S.done(cur); }
#undef PG8_SA
#undef PG8_SB
#undef PG8_STAGE
#undef PG8_LDA
#undef PG8_LDB
#undef PG8_MMA
#undef PG8_WAIT_V
#undef PG8_WAIT_L
#undef PG8_BAR
#undef PG8_SCHED
}
}

DEVI pg8::u32x4 pack8(const pg8::f32x4& a, const pg8::f32x4& b) { pg8::u32x4 w; w.x = pg8::cvt_pk_bf16(a[0], a[1]); w.y = pg8::cvt_pk_bf16(a[2], a[3]); w.z = pg8::cvt_pk_bf16(b[0], b[1]); w.w = pg8::cvt_pk_bf16(b[2], b[3]); return w; }
DEVI pg8::f32x4 silu4(const pg8::f32x4& a) { pg8::f32x4 r; r[0] = siluf_(a[0]); r[1] = siluf_(a[1]); r[2] = siluf_(a[2]); r[3] = siluf_(a[3]); return r; }
struct FEpi1 {
    static constexpr bool PERM = true, AFTER_DRAIN = false;
    bf16_t *QK, *V, *SGA, *Z, *CBG; float* ALR;
    DEVI void operator()(const pg8::f32x4 (&acc)[2][2][4][2], const pg8::Unit& u, int wr, int wc, int fr, int fq) const {
        const int t = u.pn, row0 = u.pm * 256 + wr * 64 + fr, cw = wc * 32 + 8 * fq;
#pragma unroll
        for (int ai = 0; ai < 2; ++ai)
#pragma unroll
            for (int m = 0; m < 4; ++m) {
                const size_t row = (size_t)(row0 + ai * 128 + m * 16);
                if (t < 12) {
                    bf16_t* base = t < 4 ? QK + row * 1024 + t * 256 : (t < 8 ? V + row * 1024 + (t - 4) * 256 : SGA + row * 1024 + (t - 8) * 256);
#pragma unroll
                    for (int bj = 0; bj < 2; ++bj) { pg8::f32x4 v0 = acc[ai][bj][m][0], v1 = acc[ai][bj][m][1]; if (t >= 8) { v0 = silu4(v0); v1 = silu4(v1); }
                        *(pg8::u32x4*)(base + bj * 128 + cw) = pack8(v0, v1); }
                } else if (t == 12) {
                    if (wc == 0) { *(pg8::f32x4*)(ALR + row * 32 + 8 * fq) = acc[ai][0][m][0]; *(pg8::f32x4*)(ALR + row * 32 + 8 * fq + 4) = acc[ai][0][m][1]; }
                } else if (t < 21) {
                    *(pg8::u32x4*)(Z + row * 1024 + (t - 13) * 128 + cw) = pack8(acc[ai][0][m][0] * acc[ai][1][m][0], acc[ai][0][m][1] * acc[ai][1][m][1]);
                } else {
                    *(pg8::u32x4*)(CBG + row * 1024 + (t - 21) * 128 + cw) = pack8(acc[ai][0][m][0] * silu4(acc[ai][1][m][0]), acc[ai][0][m][1] * silu4(acc[ai][1][m][1]));
                }
            }
    }
};
struct FEpiRes {
    static constexpr bool PERM = false, AFTER_DRAIN = false;
    const float* xl; const float* xc; float* outl; float* outc; const float* MODl;
    DEVI void operator()(const pg8::f32x4 (&acc)[2][2][4][2], const pg8::Unit& u, int wr, int wc, int fr, int fq) const {
        const int row0 = u.pm * 256 + wr * 64 + fr, col0 = u.pn * 256 + wc * 32 + 4 * fq;
        const bool lat = u.pm < NLAT / 256;
        const float* gate = MODl + (size_t)(lat ? (u.pm >> 4) : 4) * 3072 + 2048 + col0;
        pg8::f32x4 gv[2][2];
#pragma unroll
        for (int bj = 0; bj < 2; ++bj)
#pragma unroll
            for (int n = 0; n < 2; ++n) gv[bj][n] = *(const pg8::f32x4*)(gate + bj * 128 + n * 16);
        const float* xin = lat ? xl : xc - (size_t)NLAT * 1024; float* o = lat ? outl : outc - (size_t)NLAT * 1024;
#pragma unroll
        for (int ai = 0; ai < 2; ++ai)
#pragma unroll
            for (int m = 0; m < 4; ++m) { const size_t off = (size_t)(row0 + ai * 128 + m * 16) * 1024 + col0;
#pragma unroll
                for (int bj = 0; bj < 2; ++bj)
#pragma unroll
                    for (int n = 0; n < 2; ++n) { const pg8::f32x4 xv = *(const pg8::f32x4*)(xin + off + bj * 128 + n * 16); *(pg8::f32x4*)(o + off + bj * 128 + n * 16) = xv + gv[bj][n] * acc[ai][bj][m][n]; } }
    }
};
struct FEpi3 {
    static constexpr bool PERM = true, AFTER_DRAIN = false;
    bf16_t* XR; bf16_t* SG;
    DEVI void operator()(const pg8::f32x4 (&acc)[2][2][4][2], const pg8::Unit& u, int wr, int wc, int fr, int fq) const {
        const int t = u.pn, row0 = u.pm * 256 + wr * 64 + fr, cw = wc * 32 + 8 * fq;
        bf16_t* base = t < 8 ? XR + t * 256 : SG + (t - 8) * 256;
#pragma unroll
        for (int ai = 0; ai < 2; ++ai)
#pragma unroll
            for (int m = 0; m < 4; ++m) { bf16_t* rp = base + (size_t)(row0 + ai * 128 + m * 16) * 2048 + cw;
#pragma unroll
                for (int bj = 0; bj < 2; ++bj) { pg8::f32x4 v0 = acc[ai][bj][m][0], v1 = acc[ai][bj][m][1]; if (t >= 8) { v0 = silu4(v0); v1 = silu4(v1); }
                    *(pg8::u32x4*)(rp + bj * 128) = pack8(v0, v1); } }
    }
};
#ifndef FAST_GEMM
#define FAST_GEMM 1
#endif


#define LASP __attribute__((address_space(3)))
__device__ void st_glawalk(const Params& p, int vb, int nvb, unsigned char* lds_, const bf16_t* QIN, const bf16_t* KET, const bf16_t* SC, const float* DEC, const bf16_t* VT, bf16_t* OF, bf16_t* OB) {
    typedef pg8::bf16x8 bx8; typedef pg8::f32x4 f4; typedef unsigned u32x2 __attribute__((ext_vector_type(2)));
    LASP unsigned char* lds = (LASP unsigned char*)lds_;
    constexpr int QOFF = 0, KOFF = 17408, SOFF = KOFF + 18432, VOFF = SOFF + 9216, DOFF = VOFF + 4608, BUFSZ = 50176;
    const int tid = threadIdx.x, wid = __builtin_amdgcn_readfirstlane(tid >> 6), lane = tid & 63, c = lane & 15, g = lane >> 4;
    for (int item = vb; item < 256; item += nvb) {
        const int vs = item & 7, combo = item >> 3, d = combo & 1, h = (combo >> 1) & 3, bb = combo >> 3;
        int soff[6], doff[6];
        { const int p0 = tid, p1 = tid + 512; soff[0] = (p0 >> 4) * 256 + (p0 & 15) * 16; doff[0] = QOFF + (p0 >> 4) * 272 + (p0 & 15) * 16; soff[1] = (p1 >> 4) * 256 + (p1 & 15) * 16; doff[1] = QOFF + (p1 >> 4) * 272 + (p1 & 15) * 16;
          const int q2 = tid, q3 = tid + 512; soff[2] = (q2 >> 3) * 128 + (q2 & 7) * 16; doff[2] = KOFF + (q2 >> 3) * 144 + (q2 & 7) * 16; soff[3] = (q3 >> 3) * 128 + (q3 & 7) * 16; doff[3] = KOFF + (q3 >> 3) * 144 + (q3 & 7) * 16;
          soff[4] = (tid >> 3) * 128 + (tid & 7) * 16; doff[4] = SOFF + (tid >> 3) * 144 + (tid & 7) * 16;
          if (tid < 256) { soff[5] = (vs * 32 + (tid >> 3)) * 128 + (tid & 7) * 16; doff[5] = VOFF + (tid >> 3) * 144 + (tid & 7) * 16; } else { soff[5] = (tid - 256) * 16; doff[5] = DOFF + (tid - 256) * 16; } }
        const bool has5 = tid < 288;
        pg8::u32x4 r[6];
#define GW_LOAD(step) do { const int cc_ = d == 0 ? ((step) < 4 ? 64 + (step) : (step) - 4) : 67 - (step); const size_t u_ = (size_t)((bb * NCH + cc_) * 4 + h) * 2 + d; \
            const unsigned char* q_ = (const unsigned char*)QIN + u_ * 16384; const unsigned char* k_ = (const unsigned char*)KET + u_ * 16384; const unsigned char* s_ = (const unsigned char*)SC + u_ * 8192; \
            const unsigned char* x5_ = tid < 256 ? (const unsigned char*)VT + (u_ >> 1) * 32768 : (const unsigned char*)DEC + u_ * 512; \
            r[0] = *(const pg8::u32x4*)(q_ + soff[0]); r[1] = *(const pg8::u32x4*)(q_ + soff[1]); r[2] = *(const pg8::u32x4*)(k_ + soff[2]); r[3] = *(const pg8::u32x4*)(k_ + soff[3]); r[4] = *(const pg8::u32x4*)(s_ + soff[4]); \
            if (has5) r[5] = *(const pg8::u32x4*)(x5_ + soff[5]); } while (0)
#define GW_WRITE(bufi) do { LASP unsigned char* b_ = lds + (bufi) * BUFSZ; _Pragma("unroll") for (int j_ = 0; j_ < 5; ++j_) *(LASP pg8::u32x4*)(b_ + doff[j_]) = r[j_]; if (has5) *(LASP pg8::u32x4*)(b_ + doff[5]) = r[5]; } while (0)
        f4 S[8];
#pragma unroll
        for (int m = 0; m < 8; ++m) S[m] = (f4){0.f, 0.f, 0.f, 0.f};
        bf16_t* O = d == 0 ? OF : OB;
        __syncthreads();
        GW_LOAD(0); GW_WRITE(0); GW_LOAD(1);
        __syncthreads();
        for (int step = 0; step < NCH; ++step) {
            if (step + 1 < NCH) { GW_WRITE((step + 1) & 1); if (step + 2 < NCH) GW_LOAD(step + 2); }
            if (wid < 2) {
                const LASP unsigned char* B = lds + (step & 1) * BUFSZ;
                const bx8 bv0 = *(const LASP bx8*)(B + VOFF + (16 * wid + c) * 144 + g * 16), bv1 = *(const LASP bx8*)(B + VOFF + (16 * wid + c) * 144 + 64 + g * 16);
                bx8 sB[4];
#pragma unroll
                for (int ks = 0; ks < 4; ++ks) { pg8::u32x4 w; w.x = pg8::cvt_pk_bf16(S[2 * ks][0], S[2 * ks][1]); w.y = pg8::cvt_pk_bf16(S[2 * ks][2], S[2 * ks][3]);
                    w.z = pg8::cvt_pk_bf16(S[2 * ks + 1][0], S[2 * ks + 1][1]); w.w = pg8::cvt_pk_bf16(S[2 * ks + 1][2], S[2 * ks + 1][3]); sB[ks] = __builtin_bit_cast(bx8, w); }
                f4 o[4];
#pragma unroll
                for (int mt = 0; mt < 4; ++mt) o[mt] = (f4){0.f, 0.f, 0.f, 0.f};
#pragma unroll
                for (int ks = 0; ks < 4; ++ks)
#pragma unroll
                    for (int mt = 0; mt < 4; ++mt) { const LASP unsigned char* qa = B + QOFF + (16 * mt + c) * 272 + (32 * ks + 4 * g) * 2;
                        const u32x2 lo = *(const LASP u32x2*)qa, hi = *(const LASP u32x2*)(qa + 32); pg8::u32x4 w; w.x = lo.x; w.y = lo.y; w.z = hi.x; w.w = hi.y;
                        o[mt] = __builtin_amdgcn_mfma_f32_16x16x32_bf16(sB[ks], __builtin_bit_cast(bx8, w), o[mt], 0, 0, 0); }
#pragma unroll
                for (int mt = 0; mt < 4; ++mt) { const LASP unsigned char* sa = B + SOFF + (16 * mt + c) * 144 + g * 16;
                    o[mt] = __builtin_amdgcn_mfma_f32_16x16x32_bf16(bv0, *(const LASP bx8*)sa, o[mt], 0, 0, 0);
                    o[mt] = __builtin_amdgcn_mfma_f32_16x16x32_bf16(bv1, *(const LASP bx8*)(sa + 64), o[mt], 0, 0, 0); }
                const int cc = d == 0 ? (step < 4 ? 64 + step : step - 4) : 67 - step; const int row0 = row_of(bb, cc, 0);
#pragma unroll
                for (int mt = 0; mt < 4; ++mt) { u32x2 w; w.x = pg8::cvt_pk_bf16(o[mt][0], o[mt][1]); w.y = pg8::cvt_pk_bf16(o[mt][2], o[mt][3]);
                    *(u32x2*)(O + (size_t)(row0 + 16 * mt + c) * 1024 + h * 256 + vs * 32 + 16 * wid + 4 * g) = w; }
#pragma unroll
                for (int m = 0; m < 8; ++m) { const f4 dv = *(const LASP f4*)(B + DOFF + (16 * m + 4 * g) * 4); const LASP unsigned char* ka = B + KOFF + (16 * m + c) * 144 + g * 16;
                    S[m] = S[m] * dv;
                    S[m] = __builtin_amdgcn_mfma_f32_16x16x32_bf16(*(const LASP bx8*)ka, bv0, S[m], 0, 0, 0);
                    S[m] = __builtin_amdgcn_mfma_f32_16x16x32_bf16(*(const LASP bx8*)(ka + 64), bv1, S[m], 0, 0, 0); }
            }
            __syncthreads();
        }
#undef GW_LOAD
#undef GW_WRITE
    }
}
#ifndef FAST_WALK
#define FAST_WALK 1
#endif

template <int MODE>
__device__ void st_rglru(const Params& p, int vb, int nvb, unsigned char* lds_, const bf16_t* XR, const bf16_t* SG, const bf16_t* BD, float* SUMA, float* SUMH, bf16_t* Y) {
    typedef pg8::bf16x8 bx8; typedef pg8::f32x4 f4; typedef float f32x2v __attribute__((ext_vector_type(2)));
    LASP unsigned char* lds = (LASP unsigned char*)lds_;
    constexpr int AOFF = 0, FOFF = 17408, BUF = 51200, CWOFF = 2 * BUF;
    constexpr int ND = MODE == 0 ? 1 : 2, NCOMBO = MODE == 0 ? 32 : 16, NTILE = MODE == 0 ? NB * NCH : NB * 64;
    const int tid = threadIdx.x, wid = __builtin_amdgcn_readfirstlane(tid >> 6), lane = tid & 63, c = lane & 15, g = lane >> 4, cp = tid & 63, tg = tid >> 6;
    int P, part, cstep, combo0;
    if (nvb >= NCOMBO) { P = nvb / NCOMBO; part = vb / NCOMBO; cstep = NCOMBO; combo0 = vb % NCOMBO; if (part >= P) return; } else { P = 1; part = 0; cstep = nvb; combo0 = vb; }
    for (int combo = combo0; combo < NCOMBO; combo += cstep) {
        const int nb = MODE == 0 ? (combo >> 1) : combo, d0 = MODE == 0 ? (combo & 1) : 0;
        const int ch = nb * 128 + 16 * wid + c;
        bx8 wa[ND][4], wx[ND][4]; float ba[ND], bxx[ND], k8[ND];
        __syncthreads();
#pragma unroll
        for (int dd = 0; dd < ND; ++dd) { const int d = d0 + dd;
            const bf16_t* wA = BD + ((size_t)(d * 16 + nb) * 128 + 16 * wid + c) * 128 + 8 * g; const bf16_t* wX = wA + (size_t)2 * 16 * 128 * 128;
#pragma unroll
            for (int ks = 0; ks < 4; ++ks) { wa[dd][ks] = *(const bx8*)(wA + 32 * ks); wx[dd][ks] = *(const bx8*)(wX + 32 * ks); }
            ba[dd] = p.o_b_a[d * 2048 + ch]; bxx[dd] = p.o_b_x[d * 2048 + ch]; k8[dd] = 8.f * softplusf_(-p.o_lam[d * 2048 + ch]);
            if (tg < 5) { const f32x2v w2 = tg < 4 ? *(const f32x2v*)(p.o_conv_w + ((size_t)d * 4 + tg) * 2048 + nb * 128 + 2 * cp) : *(const f32x2v*)(p.o_conv_b + (size_t)d * 2048 + nb * 128 + 2 * cp);
                *(LASP f32x2v*)(lds + CWOFF + ((dd * 5 + tg) * 128 + 2 * cp) * 4) = w2; } }
        __syncthreads();
        unsigned xr[14];
#define RG_PREF(tile) do { const int bb_ = MODE == 0 ? (tile) / NCH : (tile) >> 6, cc_ = MODE == 0 ? (tile) % NCH : (tile) & 63; const int seg0_ = cc_ < 64 ? bb_ * 4096 : NLAT + bb_ * 256, segn_ = cc_ < 64 ? 4096 : 256; \
            const int tl_ = row_of(bb_, cc_, 0) - seg0_ + 8 * tg - 3; _Pragma("unroll") for (int jr = 0; jr < 14; ++jr) { const int tt_ = tl_ + jr; const bool need_ = MODE == 1 || (d0 == 0 ? jr < 11 : jr >= 3); \
                xr[jr] = (need_ && tt_ >= 0 && tt_ < segn_) ? *(const unsigned*)(XR + (size_t)(seg0_ + tt_) * 2048 + nb * 128 + 2 * cp) : 0u; } } while (0)
        int it = 0;
        if (part < NTILE) RG_PREF(part);
        for (int tile = part; tile < NTILE; tile += P) {
            const int bb = MODE == 0 ? tile / NCH : tile >> 6, cc = MODE == 0 ? tile % NCH : tile & 63; const int row0 = row_of(bb, cc, 0);
            unsigned xcur[14];
#pragma unroll
            for (int jr = 0; jr < 14; ++jr) xcur[jr] = xr[jr];
            if (tile + P < NTILE) RG_PREF(tile + P);
            float hsum[4][4];
#pragma unroll
            for (int dd = 0; dd < ND; ++dd) { const int d = d0 + dd;
                LASP unsigned char* B = lds + (it & 1) * BUF; ++it;
                { f32x2v cv[8]; const f32x2v cbv = *(const LASP f32x2v*)(lds + CWOFF + ((dd * 5 + 4) * 128 + 2 * cp) * 4);
#pragma unroll
                  for (int i = 0; i < 8; ++i) cv[i] = cbv;
#pragma unroll
                  for (int jj = 0; jj < 4; ++jj) { const f32x2v cwv = *(const LASP f32x2v*)(lds + CWOFF + ((dd * 5 + jj) * 128 + 2 * cp) * 4);
#pragma unroll
                      for (int i = 0; i < 8; ++i) { const int jr = d == 0 ? i + jj : i + 6 - jj; cv[i].x += cwv.x * __uint_as_float(xcur[jr] << 16); cv[i].y += cwv.y * __uint_as_float(xcur[jr] & 0xffff0000u); } }
#pragma unroll
                  for (int i = 0; i < 8; ++i) { *(LASP unsigned*)(B + AOFF + (8 * tg + i) * 272 + 4 * cp) = pg8::cvt_pk_bf16(cv[i].x, cv[i].y); *(LASP f32x2v*)(B + FOFF + (8 * tg + i) * 528 + 8 * cp) = cv[i]; } }
                __syncthreads();
                f4 aa[4], ax[4];
#pragma unroll
                for (int mt = 0; mt < 4; ++mt) { aa[mt] = (f4){0.f, 0.f, 0.f, 0.f}; ax[mt] = (f4){0.f, 0.f, 0.f, 0.f}; }
#pragma unroll
                for (int ks = 0; ks < 4; ++ks)
#pragma unroll
                    for (int mt = 0; mt < 4; ++mt) { const bx8 af = *(const LASP bx8*)(B + AOFF + (16 * mt + c) * 272 + (32 * ks + 8 * g) * 2);
                        aa[mt] = __builtin_amdgcn_mfma_f32_16x16x32_bf16(af, wa[dd][ks], aa[mt], 0, 0, 0); ax[mt] = __builtin_amdgcn_mfma_f32_16x16x32_bf16(af, wx[dd][ks], ax[mt], 0, 0, 0); }
                const int gl = d == 0 ? g : 3 - g;
                const int src1 = d == 0 ? lane - 16 : lane + 16, src2 = d == 0 ? lane - 32 : lane + 32, srcT = d == 0 ? 48 + c : c;
                const size_t sidx = (((size_t)bb * 2 + d) * NCH + cc) * 2048 + ch;
                float carryH = MODE == 0 ? 0.f : SUMH[sidx], carryA = 1.f;
#pragma unroll
                for (int mtl = 0; mtl < 4; ++mtl) { const int mt = d == 0 ? mtl : 3 - mtl;
                    float Pq[4], Lq[4]; float pa = 1.f, lh = 0.f;
#pragma unroll
                    for (int sq = 0; sq < 4; ++sq) { const int r = d == 0 ? sq : 3 - sq;
                        const float xv = *(const LASP float*)(B + FOFF + (16 * mt + 4 * g + r) * 528 + (16 * wid + c) * 4);
                        const float rr = sigmoidf_(aa[mt][r] + ba[dd]), ii = sigmoidf_(ax[mt][r] + bxx[dd]);
                        const float a = __expf(-k8[dd] * rr), u = sqrtf(fmaxf(1.f - a * a, 0.f)) * (ii * xv);
                        lh = a * lh + u; pa *= a; Pq[sq] = pa; Lq[sq] = lh; }
                    float XA = pa, XU = lh, tA, tU;
                    tA = __shfl(XA, src1); tU = __shfl(XU, src1); if (gl >= 1) { XU = tU * XA + XU; XA = tA * XA; }
                    tA = __shfl(XA, src2); tU = __shfl(XU, src2); if (gl >= 2) { XU = tU * XA + XU; XA = tA * XA; }
                    const float totA = __shfl(XA, srcT), totU = __shfl(XU, srcT);
                    if (MODE == 1) {
                        float eA = __shfl(XA, src1), eU = __shfl(XU, src1); if (gl == 0) { eA = 1.f; eU = 0.f; }
                        const float hin = carryH * eA + eU;
#pragma unroll
                        for (int sq = 0; sq < 4; ++sq) { const int r = d == 0 ? sq : 3 - sq; const float hv = hin * Pq[sq] + Lq[sq]; if (dd == 0) hsum[mt][r] = hv; else hsum[mt][r] += hv; }
                    }
                    carryH = carryH * totA + totU; carryA *= totA;
                }
                if (MODE == 0) { if (g == 0) { SUMA[sidx] = carryA; SUMH[sidx] = carryH; } }
            }
            if (MODE == 1) {
#pragma unroll
                for (int mt = 0; mt < 4; ++mt)
#pragma unroll
                    for (int r = 0; r < 4; ++r) { const size_t o = (size_t)(row0 + 16 * mt + 4 * g + r) * 2048 + ch; Y[o] = f2bf(hsum[mt][r] * bf2f(SG[o])); }
            }
        }
        __syncthreads();
#undef RG_PREF
    }
}
#ifndef FAST_RG
#define FAST_RG 1
#endif
__device__ __forceinline__ void run_stage(const Params& p, int st, int vb, int nvb, unsigned char* lds) {
    unsigned char* ws = p.ws;
    float* MOD = (float*)(ws + WS_MOD); float* ALR = (float*)(ws + WS_ALR); float* X1C = (float*)(ws + WS_X1C);
    float* SUMA = (float*)(ws + WS_SUMA); float* SUMH = (float*)(ws + WS_SUMH); float* DEC = (float*)(ws + WS_DEC);
    bf16_t* Bt1 = (bf16_t*)(ws + WS_BT1); bf16_t* Bt2 = (bf16_t*)(ws + WS_BT2); bf16_t* Bt3 = (bf16_t*)(ws + WS_BT3); bf16_t* Bt4 = (bf16_t*)(ws + WS_BT4);
    bf16_t* S0 = (bf16_t*)(ws + WS_SLOT(0)); bf16_t* S1 = (bf16_t*)(ws + WS_SLOT(1)); bf16_t* S2 = (bf16_t*)(ws + WS_SLOT(2));
    bf16_t* S3 = (bf16_t*)(ws + WS_SLOT(3)); bf16_t* S4 = (bf16_t*)(ws + WS_SLOT(4)); bf16_t* S5 = (bf16_t*)(ws + WS_SLOT(5));
    bf16_t* DO0 = (bf16_t*)p.out; bf16_t* DOSC = (bf16_t*)((unsigned char*)p.out + 34 * MiB);
    switch (st) {
    case 0: st_mod(p, vb, nvb, (float*)lds); st_wprep(p, vb, nvb); break;
    case 1: st_modulate(p, vb, nvb, 0, p.x, p.ctx, S0); break;
    case 3: st_glaprep(p, vb, nvb, lds, S1, S2, ALR, S3, S4, DOSC, DEC, S5); break;
#if FAST_WALK
    case 4: st_glawalk(p, vb, nvb, lds, S3, S4, DOSC, DEC, S5, S2, DO0); break;
#else
    case 4: st_glawalk_naive(p, vb, nvb, (float*)lds, S3, S4, DOSC, DEC, S5, S2, DO0); break;
#endif
    case 6: st_inner(p, vb, nvb, S2, DO0, S3, S4, S5, S0); break;
    case 8: st_modulate(p, vb, nvb, 1, p.out, X1C, S2); break;
    case 11: st_carry(p, vb, nvb, SUMA, SUMH); break;
#if FAST_RG
    case 10: st_rglru<0>(p, vb, nvb, lds, S3, S0, (const bf16_t*)(ws + WS_BD), SUMA, SUMH, S0); break;
    case 12: st_rglru<1>(p, vb, nvb, lds, S3, S0, (const bf16_t*)(ws + WS_BD), SUMA, SUMH, S0); break;
#else
    case 10: st_rglru_naive<0>(p, vb, nvb, (float*)lds, S3, S0, SUMA, SUMH, S0); break;
    case 12: st_rglru_naive<1>(p, vb, nvb, (float*)lds, S3, S0, SUMA, SUMH, S0); break;
#endif
    case 14: st_final(p, vb, nvb); break;
#if FAST_GEMM
    case 2: { FEpi1 E{S1, S2, S3, S4, S5, ALR}; pg8::Gemm g{S0, Bt1, NT, N1, 1024}; pg8::TileOrder S; S.init(NT / 256, 9, nvb, vb, 0, 8, 0, 12);
              pg8::gemm_phase<FEpi1, pg8::TileOrder, true, true>((PG8_LAS unsigned char*)lds, g, S, E); } break;
    case 5: { FEpi1 E{S1, S2, S3, S4, S5, ALR}; pg8::Gemm g{S0, Bt1, NT, N1, 1024}; pg8::TileOrder S; S.init(NT / 256, 20, nvb, vb, 0, 4, 8, 13);
              pg8::gemm_phase<FEpi1, pg8::TileOrder, true, true>((PG8_LAS unsigned char*)lds, g, S, E); } break;
    case 7: { FEpiRes E{p.x, p.ctx, p.out, X1C, MOD}; pg8::Gemm g{S0, Bt2, NT, 1024, 2048}; pg8::TileOrder S; S.init(NT / 256, 4, nvb, vb);
              pg8::gemm_phase<FEpiRes, pg8::TileOrder, true, true>((PG8_LAS unsigned char*)lds, g, S, E); } break;
    case 9: { FEpi3 E{S3, S0}; pg8::Gemm g{S2, Bt3, NT, 4096, 1024}; pg8::TileOrder S; S.init(NLAT / 256, 16, nvb, vb, 0, 1 << 30, 0, 0, NCTX / 256, 8, NLAT / 256);
              pg8::gemm_phase<FEpi3, pg8::TileOrder, true, true>((PG8_LAS unsigned char*)lds, g, S, E); } break;
    case 13: { FEpiRes E{p.out, nullptr, p.out, nullptr, MOD + 5 * 3072}; pg8::Gemm g{S0, Bt4, NLAT, 1024, 2048}; pg8::TileOrder S; S.init(NLAT / 256, 4, nvb, vb);
              pg8::gemm_phase<FEpiRes, pg8::TileOrder, true, true>((PG8_LAS unsigned char*)lds, g, S, E); } break;
#else
    case 2: { Epi1 E{S1, S2, S3, S4, S5, ALR}; st_gemm_naive(vb, nvb, (float*)lds, S0, Bt1, 0, NT / 32, 0, 8, 1024, E); st_gemm_naive(vb, nvb, (float*)lds, S0, Bt1, 0, NT / 32, 12, 13, 1024, E); } break;
    case 5: { Epi1 E{S1, S2, S3, S4, S5, ALR}; st_gemm_naive(vb, nvb, (float*)lds, S0, Bt1, 0, NT / 32, 8, 12, 1024, E); st_gemm_naive(vb, nvb, (float*)lds, S0, Bt1, 0, NT / 32, 13, 29, 1024, E); } break;
    case 7: { EpiRes E{p.x, p.ctx, p.out, X1C, MOD}; st_gemm_naive(vb, nvb, (float*)lds, S0, Bt2, 0, NT / 32, 0, 4, 2048, E); } break;
    case 9: { Epi3 E{S3, S0}; st_gemm_naive(vb, nvb, (float*)lds, S2, Bt3, 0, NLAT / 32, 0, 16, 1024, E); st_gemm_naive(vb, nvb, (float*)lds, S2, Bt3, NLAT / 32, NT / 32, 0, 8, 1024, E); } break;
    case 13: { EpiRes E{p.out, nullptr, p.out, nullptr, MOD + 5 * 3072}; st_gemm_naive(vb, nvb, (float*)lds, S0, Bt4, 0, NLAT / 32, 0, 4, 2048, E); } break;
#endif
    }
}
constexpr int NSTAGES = 15;
constexpr int LDS_BYTES = 147456;

#ifndef ONE_LAUNCH
#define ONE_LAUNCH 1
#endif
#if !ONE_LAUNCH
__global__ void __launch_bounds__(NTHREADS) k_mega(Params p, int st) {
    extern __shared__ __attribute__((aligned(16))) unsigned char lds[];
    run_stage(p, st, blockIdx.x, gridDim.x, lds);
}
#else
__global__ void __launch_bounds__(NTHREADS) k_mega(Params p) {
    extern __shared__ __attribute__((aligned(16))) unsigned char lds[];
    cg::grid_group grid = cg::this_grid();
#define RS(k) run_stage(p, k, blockIdx.x, gridDim.x, lds)
    RS(0); grid.sync(); RS(1); grid.sync(); RS(2); grid.sync(); RS(3); grid.sync(); RS(4); grid.sync(); RS(5); grid.sync(); RS(6); grid.sync(); RS(7); grid.sync();
    RS(8); grid.sync(); RS(9); grid.sync(); RS(10); grid.sync(); RS(11); grid.sync(); RS(12); grid.sync(); RS(13); grid.sync(); RS(14);
#undef RS
}
#endif

extern "C" void kernel_launch(void* const* d_in, const int* in_sizes, int n_in, void* d_out, int out_size, void* d_ws, size_t ws_size, hipStream_t stream) {
    static int inited = 0, grid_blocks = 0;
    if (!inited) {
        if (n_in != 23 || ws_size < WS_END || out_size != NLAT * D) { fprintf(stderr, "kernel_launch: unexpected shapes n_in %d ws %zu out %d\n", n_in, ws_size, out_size); inited = -1; return; }
        if (hipFuncSetAttribute((const void*)k_mega, hipFuncAttributeMaxDynamicSharedMemorySize, LDS_BYTES) != hipSuccess) { fprintf(stderr, "hipFuncSetAttribute failed\n"); inited = -1; return; }
        int dev = 0, cus = 0, per_cu = 0;
        (void)hipGetDevice(&dev); (void)hipDeviceGetAttribute(&cus, hipDeviceAttributeMultiprocessorCount, dev);
        (void)hipOccupancyMaxActiveBlocksPerMultiprocessor(&per_cu, (const void*)k_mega, NTHREADS, LDS_BYTES);
        if (per_cu < 1) { fprintf(stderr, "kernel_launch: occupancy query says %d blocks per CU\n", per_cu); per_cu = 1; }
        if (per_cu > 1) per_cu = 1;
        grid_blocks = cus * per_cu;
        inited = 1;
    }
    if (inited < 0) return;
    Params p{};
    const float** f = (const float**)&p;
    for (int i = 0; i < 23; ++i) f[i] = (const float*)d_in[i];
    p.out = (float*)d_out; p.ws = (unsigned char*)d_ws;
#if ONE_LAUNCH
    void* args[] = {&p};
    hipError_t e = hipLaunchCooperativeKernel((const void*)k_mega, dim3(grid_blocks), dim3(NTHREADS), args, LDS_BYTES, stream);
    if (e != hipSuccess) fprintf(stderr, "cooperative launch failed: %s (grid %d)\n", hipGetErrorString(e), grid_blocks);
#else
    for (int st = 0; st < NSTAGES; ++st) hipLaunchKernelGGL(k_mega, dim3(1024), dim3(NTHREADS), LDS_BYTES, stream, p, st);
#endif
}
```

```cpp
#include <hip/hip_runtime.h>
#include <hip/hip_cooperative_groups.h>
namespace cg = cooperative_groups;
#include <cstdio>
#include <cstdint>

typedef unsigned short bf16_t;
#define DEVI __device__ __forceinline__

constexpr int D = 1024, NB = 4, SEQ = 4096, CTXL = 256;
constexpr int NLAT = NB * SEQ;
constexpr int NCTX = NB * CTXL;
constexpr int NT = NLAT + NCTX;
constexpr int NCH = 68;
constexpr int EVEN_IN = 7200;
constexpr int N1 = 7424;
constexpr int N1A = 13 * 256;
constexpr int RGW = 2048;
constexpr float EPS = 1e-6f;

constexpr size_t MiB = 1u << 20;
constexpr size_t WS_CTL = 0;
constexpr size_t WS_MOD = 1 * MiB;
constexpr size_t WS_ALR = 2 * MiB;
constexpr size_t WS_X1C = 5 * MiB;
constexpr size_t WS_SUMA = 9 * MiB;
constexpr size_t WS_SUMH = 9 * MiB + 4608 * 1024;
constexpr size_t WS_DEC = 18 * MiB;
constexpr size_t WS_BT1 = 19 * MiB + 512 * 1024;
constexpr size_t WS_BT2 = 34 * MiB;
constexpr size_t WS_BT3 = 38 * MiB;
constexpr size_t WS_BT4 = 46 * MiB;
constexpr size_t WS_BD = 50 * MiB;
constexpr size_t WS_S0 = 52 * MiB;
constexpr size_t SLOT = 34 * MiB;
constexpr size_t WS_END = WS_S0 + 6 * SLOT;
static_assert(WS_END == 256 * MiB, "ws map");
#define WS_SLOT(i) (WS_S0 + (size_t)(i) * SLOT)

struct Params {
    const float* x; const float* c; const float* ctx; const float* c_ctx; const float* norm_g; const float* w_mod; const float* b_mod;
    const float* e_w_in; const float* e_w_a2; const float* e_b_a2; const float* e_gla_g; const float* e_conv_w; const float* e_w_out;
    const float* o_w_in; const float* o_conv_w; const float* o_conv_b; const float* o_w_a; const float* o_b_a; const float* o_w_x; const float* o_b_x;
    const float* o_lam; const float* o_w_out; const float* final_g;
    float* out; unsigned char* ws;
};

DEVI float bf2f(bf16_t v) { return __uint_as_float((unsigned)v << 16); }
DEVI bf16_t f2bf(float f) { unsigned u = __float_as_uint(f); return (bf16_t)((u + 0x7fffu + ((u >> 16) & 1u)) >> 16); }
DEVI unsigned pk2(float lo, float hi) { return (unsigned)f2bf(lo) | ((unsigned)f2bf(hi) << 16); }
DEVI float sigmoidf_(float x) { return 1.0f / (1.0f + __expf(-x)); }
DEVI float siluf_(float x) { return x / (1.0f + __expf(-x)); }
DEVI float softplusf_(float x) { return fmaxf(x, 0.f) + log1pf(__expf(-fabsf(x))); }
DEVI float logsigmoidf_(float x) { return fminf(x, 0.f) - log1pf(__expf(-fabsf(x))); }
DEVI int row_of(int bb, int c, int t) { return c < 64 ? bb * 4096 + c * 64 + t : NLAT + bb * 256 + (c - 64) * 64 + t; }
DEVI int mod_idx(int row) { return row < NLAT ? (row >> 12) : 4; }
DEVI float wave_sum(float v) {
#pragma unroll
    for (int o = 1; o < 64; o <<= 1) v += __shfl_xor(v, o);
    return v;
}
__host__ __device__ inline int colmap1(int n) {
    const int t = n >> 8, c = n & 255;
    if (t < 12) return n;
    if (t == 12) return c < 32 ? 3072 + c : -1;
    if (t < 21) { const int j = t - 13; return c < 128 ? 4128 + 128 * j + c : 5152 + 128 * j + (c - 128); }
    const int j = t - 21; return c < 128 ? 3104 + 128 * j + c : 6176 + 128 * j + (c - 128);
}

#define NTHREADS 512

__device__ void st_mod(const Params& p, int vb, int nvb, float* lds) {
    float* MOD = (float*)(p.ws + WS_MOD);
    for (int i = threadIdx.x; i < 5 * 1024; i += NTHREADS) { const int s = i >> 10, k = i & 1023; const float v = s < 4 ? p.c[s * 1024 + k] : p.c_ctx[k]; lds[i] = siluf_(v); }
    __syncthreads();
    const int lane = threadIdx.x & 63, gw = vb * (NTHREADS / 64) + (threadIdx.x >> 6), ngw = nvb * (NTHREADS / 64);
    for (int it = gw; it < 2 * 48 * 32; it += ngw) {
        const int kc = it & 31, cb = (it >> 5) % 48, li = it / (32 * 48), j = cb * 64 + lane, k0 = kc * 32;
        const float* W = p.w_mod + ((size_t)li * 1024 + k0) * 3072 + j;
        float wv[32];
#pragma unroll
        for (int k = 0; k < 32; ++k) wv[k] = W[(size_t)k * 3072];
        float a0 = 0.f, a1 = 0.f, a2 = 0.f, a3 = 0.f, a4 = 0.f;
#pragma unroll
        for (int k = 0; k < 32; ++k) { const float w = wv[k]; a0 += lds[k0 + k] * w; a1 += lds[1024 + k0 + k] * w; a2 += lds[2048 + k0 + k] * w; a3 += lds[3072 + k0 + k] * w; a4 += lds[4096 + k0 + k] * w; }
        const float bv = kc == 0 ? p.b_mod[li * 3072 + j] : 0.f;
        float* o = MOD + (size_t)li * 5 * 3072 + j;
        atomicAdd(o, a0 + bv); atomicAdd(o + 3072, a1 + bv); atomicAdd(o + 2 * 3072, a2 + bv); atomicAdd(o + 3 * 3072, a3 + bv); atomicAdd(o + 4 * 3072, a4 + bv);
    }
    __syncthreads();
}

__device__ __forceinline__ void wt_item(const float* src, int ldw, bf16_t* dst, int K, int k0, __attribute__((address_space(3))) float* scr, int lane) {
    typedef unsigned v4u __attribute__((ext_vector_type(4)));
    if (src) {
#pragma unroll 8
        for (int i = 0; i < 32; ++i) { const int kk = 2 * i + (lane >> 5); scr[kk * 33 + (lane & 31)] = src[(size_t)(k0 + kk) * ldw + (lane & 31)]; }
    }
    asm volatile("s_waitcnt lgkmcnt(0)" ::: "memory");
    const int cch = lane & 7;
#pragma unroll
    for (int j = 0; j < 4; ++j) { const int n = (lane >> 3) + 8 * j; const __attribute__((address_space(3))) float* sp = scr + (8 * cch) * 33 + n;
        v4u o = {0u, 0u, 0u, 0u};
        if (src) { o.x = pk2(sp[0 * 33], sp[1 * 33]); o.y = pk2(sp[2 * 33], sp[3 * 33]); o.z = pk2(sp[4 * 33], sp[5 * 33]); o.w = pk2(sp[6 * 33], sp[7 * 33]); }
        *(v4u*)(dst + (size_t)n * K + k0 + 8 * cch) = o; }
    asm volatile("s_waitcnt lgkmcnt(0)" ::: "memory");
}
__device__ void st_wprep(const Params& p, int vb, int nvb, unsigned char* lds_) {
    bf16_t* Bt1 = (bf16_t*)(p.ws + WS_BT1); bf16_t* Bt2 = (bf16_t*)(p.ws + WS_BT2); bf16_t* Bt3 = (bf16_t*)(p.ws + WS_BT3); bf16_t* Bt4 = (bf16_t*)(p.ws + WS_BT4);
    bf16_t* BD = (bf16_t*)(p.ws + WS_BD);
    const int lane = threadIdx.x & 63, wv = threadIdx.x >> 6, gw = vb * (NTHREADS / 64) + wv, ngw = nvb * (NTHREADS / 64);
    __attribute__((address_space(3))) float* scr = (__attribute__((address_space(3))) float*)lds_ + 8192 + wv * (64 * 33);
    constexpr int I1 = 16 * (N1 / 32), I2 = 32 * 32, I3 = 16 * 128, I4 = 32 * 32, I5 = 64 * 8;
    for (int it = gw; it < I1 + I2 + I3 + I4 + I5; it += ngw) {
        int r = it;
        if (r < I1) { const int nbk = N1 / 32, kb = r / nbk, nb = r % nbk; const int sc = colmap1(nb * 32); wt_item(sc < 0 ? nullptr : p.e_w_in + sc, EVEN_IN, Bt1 + (size_t)nb * 32 * 1024, 1024, kb * 64, scr, lane); continue; } r -= I1;
        if (r < I2) { const int kb = r / 32, nb = r % 32; wt_item(p.e_w_out + nb * 32, 1024, Bt2 + (size_t)nb * 32 * 2048, 2048, kb * 64, scr, lane); continue; } r -= I2;
        if (r < I3) { const int kb = r / 128, nb = r % 128; wt_item(p.o_w_in + nb * 32, 4096, Bt3 + (size_t)nb * 32 * 1024, 1024, kb * 64, scr, lane); continue; } r -= I3;
        if (r < I4) { const int kb = r / 32, nb = r % 32; wt_item(p.o_w_out + nb * 32, 1024, Bt4 + (size_t)nb * 32 * 2048, 2048, kb * 64, scr, lane); continue; } r -= I4;
        { const int m = r >> 8, dn = (r >> 3) & 31, kb = (r >> 2) & 1, nb = r & 3; const float* W = (m == 0 ? p.o_w_a : p.o_w_x) + (size_t)dn * 16384;
          wt_item(W + nb * 32, 128, BD + (size_t)m * 2 * 16 * 16384 + (size_t)dn * 16384 + (size_t)nb * 32 * 128, 128, kb * 64, scr, lane); }
    }
}

__device__ void st_modulate(const Params& p, int vb, int nvb, int li, const float* xlat, const float* xctx, bf16_t* H) {
    const float* MOD = (const float*)(p.ws + WS_MOD) + (size_t)li * 5 * 3072;
    const float* g = p.norm_g + li * 1024;
    const int lane = threadIdx.x & 63, gw = vb * (NTHREADS / 64) + (threadIdx.x >> 6), ngw = nvb * (NTHREADS / 64);
    for (int row = gw; row < NT; row += ngw) {
        const float* xr = row < NLAT ? xlat + (size_t)row * 1024 : xctx + (size_t)(row - NLAT) * 1024;
        const float* md = MOD + (size_t)mod_idx(row) * 3072;
        float4 v[4]; float ss = 0.f;
#pragma unroll
        for (int j = 0; j < 4; ++j) { v[j] = *(const float4*)(xr + j * 256 + lane * 4); ss += v[j].x * v[j].x + v[j].y * v[j].y + v[j].z * v[j].z + v[j].w * v[j].w; }
        const float rinv = rsqrtf(wave_sum(ss) * (1.f / 1024.f) + EPS);
#pragma unroll
        for (int j = 0; j < 4; ++j) { const int c0 = j * 256 + lane * 4; const float4 gg = *(const float4*)(g + c0), sh = *(const float4*)(md + c0), sc = *(const float4*)(md + 1024 + c0);
            ushort4 o; o.x = f2bf(v[j].x * rinv * gg.x * (1.f + sc.x) + sh.x); o.y = f2bf(v[j].y * rinv * gg.y * (1.f + sc.y) + sh.y);
            o.z = f2bf(v[j].z * rinv * gg.z * (1.f + sc.z) + sh.z); o.w = f2bf(v[j].w * rinv * gg.w * (1.f + sc.w) + sh.w);
            *(ushort4*)(H + (size_t)row * 1024 + c0) = o; }
    }
}

template <class Epi>
__device__ void st_gemm_naive(int vb, int nvb, float* lds, const bf16_t* A, const bf16_t* Bt, int mt0, int mt1, int nt0, int nt1, int K, const Epi& E) {
    float* As = lds;
    float* Bs = lds + 32 * 33;
    const int tid = threadIdx.x, tx = tid & 63, ty = tid >> 6;
    const int nmt = mt1 - mt0, nnt = nt1 - nt0;
    for (int it = vb; it < nmt * nnt; it += nvb) {
        const int m0 = (mt0 + it / nnt) * 32, n0 = (nt0 + it % nnt) * 256;
        float acc[4][4];
#pragma unroll
        for (int i = 0; i < 4; ++i)
#pragma unroll
            for (int j = 0; j < 4; ++j) acc[i][j] = 0.f;
        for (int k0 = 0; k0 < K; k0 += 32) {
            __syncthreads();
            for (int e = tid; e < 32 * 32; e += NTHREADS) { const int r = e >> 5, kk = e & 31; As[r * 33 + kk] = bf2f(A[(size_t)(m0 + r) * K + k0 + kk]); }
            for (int e = tid; e < 256 * 32; e += NTHREADS) { const int r = e >> 5, kk = e & 31; Bs[r * 33 + kk] = bf2f(Bt[(size_t)(n0 + r) * K + k0 + kk]); }
            __syncthreads();
#pragma unroll 8
            for (int kk = 0; kk < 32; ++kk) {
                float a[4], b[4];
#pragma unroll
                for (int i = 0; i < 4; ++i) a[i] = As[(ty * 4 + i) * 33 + kk];
#pragma unroll
                for (int j = 0; j < 4; ++j) b[j] = Bs[(tx + 64 * j) * 33 + kk];
#pragma unroll
                for (int i = 0; i < 4; ++i)
#pragma unroll
                    for (int j = 0; j < 4; ++j) acc[i][j] += a[i] * b[j];
            }
        }
#pragma unroll
        for (int i = 0; i < 4; ++i) E(m0 + ty * 4 + i, n0, tx, acc[i]);
    }
    __syncthreads();
}

struct Epi1 {
    bf16_t *QK, *V, *SGA, *Z, *CBG; float* ALR;
    DEVI void operator()(int row, int n0, int cl, const float (&v)[4]) const {
        const int t = n0 >> 8;
        if (t < 4) { for (int j = 0; j < 4; ++j) QK[(size_t)row * 1024 + n0 + cl + 64 * j] = f2bf(v[j]); }
        else if (t < 8) { for (int j = 0; j < 4; ++j) V[(size_t)row * 1024 + (n0 - 1024) + cl + 64 * j] = f2bf(v[j]); }
        else if (t < 12) { for (int j = 0; j < 4; ++j) SGA[(size_t)row * 1024 + (n0 - 2048) + cl + 64 * j] = f2bf(siluf_(v[j])); }
        else if (t == 12) { if (cl < 32) ALR[(size_t)row * 32 + cl] = v[0]; }
        else if (t < 21) { const int jt = t - 13; Z[(size_t)row * 1024 + 128 * jt + cl] = f2bf(v[0] * v[2]); Z[(size_t)row * 1024 + 128 * jt + cl + 64] = f2bf(v[1] * v[3]); }
        else { const int jt = t - 21; CBG[(size_t)row * 1024 + 128 * jt + cl] = f2bf(v[0] * siluf_(v[2])); CBG[(size_t)row * 1024 + 128 * jt + cl + 64] = f2bf(v[1] * siluf_(v[3])); }
    }
};
struct EpiRes {
    const float* xl; const float* xc; float* outl; float* outc; const float* MODl;
    DEVI void operator()(int row, int n0, int cl, const float (&v)[4]) const {
        const float* gate = MODl + (size_t)mod_idx(row) * 3072 + 2048;
        for (int j = 0; j < 4; ++j) { const int col = n0 + cl + 64 * j;
            if (row < NLAT) outl[(size_t)row * 1024 + col] = xl[(size_t)row * 1024 + col] + gate[col] * v[j];
            else if (outc) outc[(size_t)(row - NLAT) * 1024 + col] = xc[(size_t)(row - NLAT) * 1024 + col] + gate[col] * v[j]; }
    }
};
struct Epi3 {
    bf16_t* XR; bf16_t* SG;
    DEVI void operator()(int row, int n0, int cl, const float (&v)[4]) const {
        for (int j = 0; j < 4; ++j) { const int col = n0 + cl + 64 * j;
            if (col < 2048) XR[(size_t)row * 2048 + col] = f2bf(v[j]); else if (row < NLAT) SG[(size_t)row * 2048 + col - 2048] = f2bf(siluf_(v[j])); }
    }
};

__device__ void st_glaprep(const Params& p, int vb, int nvb, unsigned char* ldsb, const bf16_t* QK, const bf16_t* V, const float* ALR, bf16_t* QIN, bf16_t* KET, bf16_t* SC, float* DEC, bf16_t* VT) {
    bf16_t* qs = (bf16_t*)ldsb;
    bf16_t* ks = qs + 64 * 136;
    float* tot = (float*)(ks + 64 * 136);
    bf16_t* vs = (bf16_t*)(tot + 4 * 128);
    const int tid = threadIdx.x, kk = tid & 127, tq = tid >> 7;
    for (int u = vb; u < NB * NCH * 4 * 2; u += nvb) {
        const int d = u & 1, h = (u >> 1) & 3, bc = u >> 3, c = bc % NCH, bb = bc / NCH;
        const int row0 = row_of(bb, c, 0);
        float w2[16];
#pragma unroll
        for (int r = 0; r < 16; ++r) w2[r] = p.e_w_a2[((size_t)d * 16 + r) * 512 + h * 128 + kk];
        const float b2 = p.e_b_a2[d * 512 + h * 128 + kk];
        float lg[16];
#pragma unroll
        for (int i = 0; i < 16; ++i) { const float* a = ALR + (size_t)(row0 + tq * 16 + i) * 32 + d * 16; float z = b2;
#pragma unroll
            for (int r = 0; r < 16; ++r) z += a[r] * w2[r];
            lg[i] = logsigmoidf_(z) * (1.f / 16.f); }
        float bcum[16];
        if (d == 0) { float s = 0.f;
#pragma unroll
            for (int i = 0; i < 16; ++i) { s += lg[i]; bcum[i] = s; } tot[tq * 128 + kk] = s; }
        else { float s = 0.f;
#pragma unroll
            for (int i = 15; i >= 0; --i) { s += lg[i]; bcum[i] = s; } tot[tq * 128 + kk] = s; }
        __syncthreads();
        float off = 0.f, blast = 0.f;
        for (int q = 0; q < 4; ++q) { const float tv = tot[q * 128 + kk]; blast += tv; if (d == 0 ? (q < tq) : (q > tq)) off += tv; }
        const float scale = 0.08838834764831845f;
        unsigned short ke[16];
#pragma unroll
        for (int i = 0; i < 16; ++i) { const int t = tq * 16 + i; const float b = bcum[i] + off;
            const float qv = bf2f(QK[(size_t)(row0 + t) * 1024 + h * 128 + kk]) * scale, kv = bf2f(QK[(size_t)(row0 + t) * 1024 + 512 + h * 128 + kk]);
            const bf16_t qi = f2bf(qv * __expf(b)), ki = f2bf(kv * __expf(-b));
            qs[t * 136 + kk] = qi; ks[t * 136 + kk] = ki; ke[i] = f2bf(kv * __expf(blast - b));
            QIN[((size_t)u * 64 + t) * 128 + kk] = qi; }
        { uint4 w0, w1; w0.x = ke[0] | (ke[1] << 16); w0.y = ke[2] | (ke[3] << 16); w0.z = ke[4] | (ke[5] << 16); w0.w = ke[6] | (ke[7] << 16);
          w1.x = ke[8] | (ke[9] << 16); w1.y = ke[10] | (ke[11] << 16); w1.z = ke[12] | (ke[13] << 16); w1.w = ke[14] | (ke[15] << 16);
          uint4* dst = (uint4*)(KET + ((size_t)u * 128 + kk) * 64 + tq * 16); dst[0] = w0; dst[1] = w1; }
        if (tq == 0) DEC[(size_t)u * 128 + kk] = __expf(blast);
        for (int e = tid; e < 64 * 128; e += NTHREADS) { const int t = e >> 7, cc = e & 127; vs[t * 130 + cc] = V[(size_t)(row0 + t) * 1024 + h * 256 + d * 128 + cc]; }
        __syncthreads();
        { typedef short bx8 __attribute__((ext_vector_type(8))); typedef float f4 __attribute__((ext_vector_type(4))); typedef unsigned u2 __attribute__((ext_vector_type(2)));
          const int wv = tid >> 6, ln = tid & 63, cl = ln & 15, gq = ln >> 4, mt = wv >> 1;
          const __attribute__((address_space(3))) unsigned char* qb = (const __attribute__((address_space(3))) unsigned char*)qs; const __attribute__((address_space(3))) unsigned char* kb = (const __attribute__((address_space(3))) unsigned char*)ks;
#pragma unroll
          for (int nn = 0; nn < 2; ++nn) { const int nt = 2 * (wv & 1) + nn; f4 acc = {0.f, 0.f, 0.f, 0.f};
#pragma unroll
              for (int k4 = 0; k4 < 4; ++k4) { const bx8 kf = *(const __attribute__((address_space(3))) bx8*)(kb + (16 * nt + cl) * 272 + (32 * k4 + 8 * gq) * 2), qf = *(const __attribute__((address_space(3))) bx8*)(qb + (16 * mt + cl) * 272 + (32 * k4 + 8 * gq) * 2);
                  acc = __builtin_amdgcn_mfma_f32_16x16x32_bf16(kf, qf, acc, 0, 0, 0); }
              const int t = 16 * mt + cl, s0 = 16 * nt + 4 * gq; float v[4];
#pragma unroll
              for (int r = 0; r < 4; ++r) { const int sx = s0 + r; v[r] = (d == 0 ? (sx <= t) : (sx >= t)) ? acc[r] : 0.f; }
              u2 w; w.x = pk2(v[0], v[1]); w.y = pk2(v[2], v[3]); *(u2*)(SC + ((size_t)u * 64 + t) * 64 + s0) = w; } }
        { unsigned short vv[16];
#pragma unroll
          for (int i = 0; i < 16; ++i) vv[i] = vs[(tq * 16 + i) * 130 + kk];
          uint4 w0, w1; w0.x = vv[0] | (vv[1] << 16); w0.y = vv[2] | (vv[3] << 16); w0.z = vv[4] | (vv[5] << 16); w0.w = vv[6] | (vv[7] << 16);
          w1.x = vv[8] | (vv[9] << 16); w1.y = vv[10] | (vv[11] << 16); w1.z = vv[12] | (vv[13] << 16); w1.w = vv[14] | (vv[15] << 16);
          uint4* dst = (uint4*)(VT + (((size_t)(u >> 1)) * 256 + d * 128 + kk) * 64 + tq * 16); dst[0] = w0; dst[1] = w1; }
        __syncthreads();
    }
}

__device__ void st_glawalk_naive(const Params& p, int vb, int nvb, float* Sl, const bf16_t* QIN, const bf16_t* KET, const bf16_t* SC, const float* DEC, const bf16_t* VT, bf16_t* OF, bf16_t* OB) {
    const int vc = threadIdx.x & 255, half = threadIdx.x >> 8;
    for (int combo = vb; combo < 32; combo += nvb) {
        const int d = combo & 1, h = (combo >> 1) & 3, bb = combo >> 3;
        __syncthreads();
        for (int k = half * 64; k < half * 64 + 64; ++k) Sl[k * 256 + vc] = 0.f;
        __syncthreads();
        bf16_t* O = d == 0 ? OF : OB;
        for (int step = 0; step < NCH; ++step) {
            const int c = d == 0 ? (step < 4 ? 64 + step : step - 4) : 67 - step;
            const int u = ((bb * NCH + c) * 4 + h) * 2 + d;
            const bf16_t* q = QIN + (size_t)u * 64 * 128; const bf16_t* ke = KET + (size_t)u * 128 * 64; const bf16_t* sc = SC + (size_t)u * 64 * 64;
            const bf16_t* vt = VT + (((size_t)(u >> 1)) * 256 + vc) * 64;
            float vv[64];
#pragma unroll
            for (int t = 0; t < 64; ++t) vv[t] = bf2f(vt[t]);
            const int row0 = row_of(bb, c, 0);
            for (int t = half * 32; t < half * 32 + 32; ++t) { float a = 0.f;
                for (int k = 0; k < 128; ++k) a += bf2f(q[t * 128 + k]) * bf2f(f2bf(Sl[k * 256 + vc]));
#pragma unroll
                for (int s = 0; s < 64; ++s) a += bf2f(sc[t * 64 + s]) * vv[s];
                O[(size_t)(row0 + t) * 1024 + h * 256 + vc] = f2bf(a); }
            __syncthreads();
            for (int k = half * 64; k < half * 64 + 64; ++k) { float a = DEC[(size_t)u * 128 + k] * Sl[k * 256 + vc];
#pragma unroll
                for (int t = 0; t < 64; ++t) a += bf2f(ke[k * 64 + t]) * vv[t];
                Sl[k * 256 + vc] = a; }
            __syncthreads();
        }
    }
}

__device__ void st_inner(const Params& p, int vb, int nvb, const bf16_t* OF, const bf16_t* OB, const bf16_t* SGA, const bf16_t* Z, const bf16_t* CBG, bf16_t* INNER) {
    const int lane = threadIdx.x & 63, gw = vb * (NTHREADS / 64) + (threadIdx.x >> 6), ngw = nvb * (NTHREADS / 64);
    for (int row = gw; row < NT; row += ngw) {
        bool hasp, hasn;
        if (row < NLAT) { const int t = row & 63; hasp = t != 0; hasn = t != 63; } else { const int t = (row - NLAT) & 255; hasp = t != 0; hasn = t != 255; }
#pragma unroll
        for (int h = 0; h < 4; ++h) {
            const int c0 = h * 256 + lane * 4;
            const ushort4 a = *(const ushort4*)(OF + (size_t)row * 1024 + c0), b = *(const ushort4*)(OB + (size_t)row * 1024 + c0);
            const float o0 = bf2f(a.x) + bf2f(b.x), o1 = bf2f(a.y) + bf2f(b.y), o2 = bf2f(a.z) + bf2f(b.z), o3 = bf2f(a.w) + bf2f(b.w);
            const float rinv = rsqrtf(wave_sum(o0 * o0 + o1 * o1 + o2 * o2 + o3 * o3) * (1.f / 256.f) + EPS);
            const float4 gg = *(const float4*)(p.e_gla_g + lane * 4);
            const ushort4 sg = *(const ushort4*)(SGA + (size_t)row * 1024 + c0);
            ushort4 o; o.x = f2bf(o0 * rinv * gg.x * bf2f(sg.x)); o.y = f2bf(o1 * rinv * gg.y * bf2f(sg.y)); o.z = f2bf(o2 * rinv * gg.z * bf2f(sg.z)); o.w = f2bf(o3 * rinv * gg.w * bf2f(sg.w));
            *(ushort4*)(INNER + (size_t)row * 2048 + c0) = o;
            const ushort4 zc = *(const ushort4*)(Z + (size_t)row * 1024 + c0);
            ushort4 zp = {0, 0, 0, 0}, zn = {0, 0, 0, 0};
            if (hasp) zp = *(const ushort4*)(Z + (size_t)(row - 1) * 1024 + c0);
            if (hasn) zn = *(const ushort4*)(Z + (size_t)(row + 1) * 1024 + c0);
            const float4 w0 = *(const float4*)(p.e_conv_w + c0), w1 = *(const float4*)(p.e_conv_w + 1024 + c0), w2 = *(const float4*)(p.e_conv_w + 2048 + c0);
            const ushort4 cb = *(const ushort4*)(CBG + (size_t)row * 1024 + c0);
            ushort4 y; y.x = f2bf(bf2f(cb.x) * (w0.x * bf2f(zp.x) + w1.x * bf2f(zc.x) + w2.x * bf2f(zn.x)));
            y.y = f2bf(bf2f(cb.y) * (w0.y * bf2f(zp.y) + w1.y * bf2f(zc.y) + w2.y * bf2f(zn.y)));
            y.z = f2bf(bf2f(cb.z) * (w0.z * bf2f(zp.z) + w1.z * bf2f(zc.z) + w2.z * bf2f(zn.z)));
            y.w = f2bf(bf2f(cb.w) * (w0.w * bf2f(zp.w) + w1.w * bf2f(zc.w) + w2.w * bf2f(zn.w)));
            *(ushort4*)(INNER + (size_t)row * 2048 + 1024 + c0) = y;
        }
    }
}

template <int MODE>
__device__ void st_rglru_naive(const Params& p, int vb, int nvb, float* lds, const bf16_t* XR, const bf16_t* SG, float* SUMA, float* SUMH, bf16_t* Y) {
    float* xc = lds;
    float* av = xc + 64 * 128;
    float* uv = av + 64 * 128;
    float* hf = uv + 64 * 128;
    const int tid = threadIdx.x, j = tid & 127, tq = tid >> 7;
    const int nitems = MODE == 0 ? NB * NCH * 16 * 2 : NB * 64 * 16;
    for (int it = vb; it < nitems; it += nvb) {
        int bb, c, nb;
        if (MODE == 0) { nb = (it >> 1) & 15; const int bc = it >> 5; c = bc % NCH; bb = bc / NCH; } else { nb = it & 15; const int bc = it >> 4; c = bc & 63; bb = bc >> 6; }
        const int row0 = row_of(bb, c, 0);
        const int seg0 = c < 64 ? bb * 4096 : NLAT + bb * 256, segn = c < 64 ? 4096 : 256;
        const int tl0 = row0 - seg0;
        for (int dd = 0; dd < (MODE == 0 ? 1 : 2); ++dd) {
            const int d = MODE == 0 ? (it & 1) : dd;
            __syncthreads();
            for (int e = tid; e < 64 * 128; e += NTHREADS) { const int t = e >> 7, i = e & 127, ch = nb * 128 + i; float a = p.o_conv_b[d * 2048 + ch];
#pragma unroll
                for (int jj = 0; jj < 4; ++jj) { const int tt = d == 0 ? tl0 + t - 3 + jj : tl0 + t + 3 - jj;
                    if (tt >= 0 && tt < segn) a += p.o_conv_w[((size_t)d * 4 + jj) * 2048 + ch] * bf2f(XR[(size_t)(seg0 + tt) * 2048 + ch]); }
                xc[e] = a; }
            __syncthreads();
            const float* WA = p.o_w_a + ((size_t)d * 16 + nb) * 128 * 128; const float* WX = p.o_w_x + ((size_t)d * 16 + nb) * 128 * 128;
            const int ch = nb * 128 + j;
            const float ba = p.o_b_a[d * 2048 + ch], bx = p.o_b_x[d * 2048 + ch], sp = softplusf_(-p.o_lam[d * 2048 + ch]);
            for (int i16 = 0; i16 < 16; ++i16) { const int t = tq * 16 + i16; float ra = ba, rx = bx;
                for (int i = 0; i < 128; ++i) { const float xv = bf2f(f2bf(xc[t * 128 + i])); ra += xv * bf2f(f2bf(WA[i * 128 + j])); rx += xv * bf2f(f2bf(WX[i * 128 + j])); }
                const float r = sigmoidf_(ra), ig = sigmoidf_(rx); const float la = -8.f * r * sp; const float a = __expf(la);
                av[t * 128 + j] = a; uv[t * 128 + j] = sqrtf(-expm1f(2.f * la)) * (ig * xc[t * 128 + j]); }
            __syncthreads();
            if (tid < 128) {
                const size_t sidx = (((size_t)bb * 2 + d) * NCH + c) * 2048 + ch;
                if (MODE == 0) { float A = 1.f, hh = 0.f;
                    if (d == 0) for (int t = 0; t < 64; ++t) { const float a = av[t * 128 + j]; hh = a * hh + uv[t * 128 + j]; A *= a; }
                    else for (int t = 63; t >= 0; --t) { const float a = av[t * 128 + j]; hh = a * hh + uv[t * 128 + j]; A *= a; }
                    SUMA[sidx] = A; SUMH[sidx] = hh;
                } else { float hh = SUMH[sidx];
                    if (d == 0) for (int t = 0; t < 64; ++t) { hh = av[t * 128 + j] * hh + uv[t * 128 + j]; hf[t * 128 + j] = hh; }
                    else for (int t = 63; t >= 0; --t) { hh = av[t * 128 + j] * hh + uv[t * 128 + j]; const size_t o = (size_t)(row0 + t) * 2048 + ch; Y[o] = f2bf((hf[t * 128 + j] + hh) * bf2f(SG[o])); }
                }
            }
        }
    }
    __syncthreads();
}
__device__ void st_carry(const Params& p, int vb, int nvb, const float* SUMA, float* SUMH) {
    for (int e = vb * NTHREADS + threadIdx.x; e < NB * 2 * 2048; e += nvb * NTHREADS) {
        const int ch = e & 2047, d = (e >> 11) & 1, bb = e >> 12; float hh = 0.f;
        for (int s0 = 0; s0 < NCH; s0 += 17) {
            float A[17], H[17];
#pragma unroll
            for (int i = 0; i < 17; ++i) { const int step = s0 + i, c = d == 0 ? (step < 4 ? 64 + step : step - 4) : 67 - step; const size_t sidx = (((size_t)bb * 2 + d) * NCH + c) * 2048 + ch; A[i] = SUMA[sidx]; H[i] = SUMH[sidx]; }
#pragma unroll
            for (int i = 0; i < 17; ++i) { const int step = s0 + i, c = d == 0 ? (step < 4 ? 64 + step : step - 4) : 67 - step; const size_t sidx = (((size_t)bb * 2 + d) * NCH + c) * 2048 + ch; SUMH[sidx] = hh; hh = A[i] * hh + H[i]; }
        }
    }
}
__device__ void st_final(const Params& p, int vb, int nvb) {
    const int lane = threadIdx.x & 63, gw = vb * (NTHREADS / 64) + (threadIdx.x >> 6), ngw = nvb * (NTHREADS / 64);
    for (int row = gw; row < NLAT; row += ngw) { float* xr = p.out + (size_t)row * 1024; float4 v[4]; float ss = 0.f;
#pragma unroll
        for (int j = 0; j < 4; ++j) { v[j] = *(const float4*)(xr + j * 256 + lane * 4); ss += v[j].x * v[j].x + v[j].y * v[j].y + v[j].z * v[j].z + v[j].w * v[j].w; }
        const float rinv = rsqrtf(wave_sum(ss) * (1.f / 1024.f) + EPS);
#pragma unroll
        for (int j = 0; j < 4; ++j) { const float4 g = *(const float4*)(p.final_g + j * 256 + lane * 4); float4 o; o.x = v[j].x * rinv * g.x; o.y = v[j].y * rinv * g.y; o.z = v[j].z * rinv * g.z; o.w = v[j].w * rinv * g.w; *(float4*)(xr + j * 256 + lane * 4) = o; }
    }
}


namespace pg8 {
#define PG8_LAS __attribute__((address_space(3)))
typedef short bf16x8 __attribute__((ext_vector_type(8)));
typedef float f32x4 __attribute__((ext_vector_type(4)));
typedef unsigned u32x4 __attribute__((ext_vector_type(4)));
constexpr int BM = 256, BK = 64, HALF = 128, HTB = HALF * BK * 2, STAGE_BYTES = 8 * HTB, NXCD = 8, WGM = 8;
__host__ __device__ __forceinline__ int lds_byte(int r, int c) { const int st = (r >> 4) * 2 + (c >> 5), rr = r & 15, cc = c & 31, ob = rr * 64 + cc * 2; return st * 1024 + (ob ^ (((ob >> 9) & 1) << 5)); }
__host__ __device__ __forceinline__ void stage_rc(int b, int& R, int& C) { const int st = b / 1024, sb = b % 1024, swz = sb ^ (((sb >> 9) & 1) << 5); R = (st >> 1) * 16 + swz / 64; C = (st & 1) * 32 + (swz % 64) / 2; }
__host__ __device__ __forceinline__ int perm32(int rho) { const int n = rho >> 4, i = rho & 15; return 8 * (i >> 2) + 4 * n + (i & 3); }
struct Unit { int pm, pn; };
struct Gemm { const bf16_t* A; const bf16_t* Bt; int M, N, K; };
struct TileOrder {
    int nM, nN, nwg, G, c, m0, split, base0, base1, nM2, nN2, m02;
    __device__ void init(int nM_, int nN_, int G_, int c_, int m0_ = 0, int split_ = 1 << 30, int base0_ = 0, int base1_ = 0, int nM2_ = 0, int nN2_ = 0, int m02_ = 0) {
        nM = nM_; nN = nN_; nwg = nM * nN; G = G_; c = c_; m0 = m0_; split = split_; base0 = base0_; base1 = base1_; nM2 = nM2_; nN2 = nN2_; m02 = m02_; }
    __device__ bool next(int i, Unit& u) const {
        const long L = (long)i * G + c;
        if (L >= nwg) { const long L2 = L - nwg; if (L2 >= (long)nM2 * nN2) return false; u.pm = m02 + (int)(L2 / nN2); u.pn = (int)(L2 % nN2); return true; }
        int wgid = (int)L; { const int q = nwg / NXCD, r = nwg % NXCD, xcd = wgid % NXCD, off = wgid / NXCD; wgid = (xcd < r ? xcd * (q + 1) : r * (q + 1) + (xcd - r) * q) + off; }
        const int nig = WGM * nN, gid = wgid / nig, fm = gid * WGM, gsz = (nM - fm) < WGM ? (nM - fm) : WGM;
        const int pm = fm + ((wgid % nig) % gsz), j = (wgid % nig) / gsz;
        u.pm = m0 + pm; u.pn = j < split ? base0 + j : base1 + (j - split); return true;
    }
    __device__ __forceinline__ void a_ready(const Unit&) const {}
    __device__ __forceinline__ void done(const Unit&) const {}
};
typedef float f32x2_t __attribute__((ext_vector_type(2))); typedef __bf16 bf16x2_t __attribute__((ext_vector_type(2)));
__device__ __forceinline__ unsigned cvt_pk_bf16(float lo, float hi) { f32x2_t v = {lo, hi}; bf16x2_t b = __builtin_convertvector(v, bf16x2_t); return __builtin_bit_cast(unsigned, b); }
template <class Epi, class Sched, bool ALIGN_EPI = false, bool SP2 = false>
__device__ __forceinline__ void gemm_phase(PG8_LAS unsigned char* lds, const Gemm g, const Sched& S, const Epi& E) {
    const int tid = threadIdx.x, wid = __builtin_amdgcn_readfirstlane(tid >> 6), lane = tid & 63, wr = wid >> 2, wc = wid & 3, fr = lane & 15, fq = lane >> 4;
    const int K = g.K, nt = K / BK;
    unsigned voffA[2], voffB[2];
#pragma unroll
    for (int i = 0; i < 2; ++i) { int R, C; stage_rc(tid * 16 + i * 8192, R, C); const int Rb = Epi::PERM ? ((R & ~31) + perm32(R & 31)) : R;
        voffA[i] = (unsigned)(R * K + C) * 2u; voffB[i] = (unsigned)(Rb * K + C) * 2u; }
    const size_t kstep = (size_t)(BK * 2);
    const size_t hstep = (size_t)HALF * K * 2;
    const size_t tstep = 2 * hstep;
    const unsigned ldsw = (unsigned)wid * 1024u;
    const int aoff = lds_byte(wr * 64 + fr, fq * 8), boff = lds_byte(wc * 32 + fr, fq * 8);
#define PG8_SA(b, h) (((b) * 2 + (h)) * HTB)
#define PG8_SB(b, h) ((4 + (b) * 2 + (h)) * HTB)
#define PG8_STAGE(bufoff, gbase, voff) do { _Pragma("unroll") for (int _i = 0; _i < 2; ++_i) \
        __builtin_amdgcn_global_load_lds((const unsigned*)((const char*)(gbase) + (voff)[_i]), (PG8_LAS unsigned*)(lds + (bufoff) + ldsw + _i * 8192), 16, 0, 0); } while (0)
#define PG8_LDA(dst, b, h) do { _Pragma("unroll") for (int m = 0; m < 4; ++m) _Pragma("unroll") for (int k = 0; k < 2; ++k) dst[m][k] = *(const PG8_LAS bf16x8*)(lds + PG8_SA(b, h) + aoff + m * 2048 + k * 1024); } while (0)
#define PG8_LDB(dst, b, h) do { _Pragma("unroll") for (int n = 0; n < 2; ++n) _Pragma("unroll") for (int k = 0; k < 2; ++k) dst[n][k] = *(const PG8_LAS bf16x8*)(lds + PG8_SB(b, h) + boff + n * 2048 + k * 1024); } while (0)
#define PG8_MMA(ai, bj, At, Bt) do { __builtin_amdgcn_s_setprio(1); _Pragma("unroll") for (int m = 0; m < 4; ++m) _Pragma("unroll") for (int n = 0; n < 2; ++n) _Pragma("unroll") for (int k = 0; k < 2; ++k) \
        acc[ai][bj][m][n] = __builtin_amdgcn_mfma_f32_16x16x32_bf16(Bt[n][k], At[m][k], acc[ai][bj][m][n], 0, 0, 0); __builtin_amdgcn_s_setprio(0); } while (0)
#define PG8_WAIT_V(n) asm volatile("s_waitcnt vmcnt(" #n ")" ::: "memory")
#define PG8_WAIT_L(n) asm volatile("s_waitcnt lgkmcnt(" #n ")" ::: "memory")
#define PG8_BAR __builtin_amdgcn_s_barrier()
#define PG8_SCHED __builtin_amdgcn_sched_barrier(0)
    Unit cur, nxt; int ui = 0;
    if (!S.next(0, cur)) return;
    f32x4 acc[2][2][4][2];
#pragma unroll
    for (int a = 0; a < 2; ++a)
#pragma unroll
        for (int b = 0; b < 2; ++b)
#pragma unroll
            for (int m = 0; m < 4; ++m)
#pragma unroll
                for (int n = 0; n < 2; ++n) acc[a][b][m][n] = (f32x4){0.f, 0.f, 0.f, 0.f};
    bf16x8 At[4][2], B0[2][2], B1[2][2];
    const char* cA = (const char*)g.A + (size_t)cur.pm * tstep; const char* cB = (const char*)g.Bt + (size_t)cur.pn * tstep;
    S.a_ready(cur);
    if constexpr (SP2) {
        PG8_STAGE(PG8_SB(0, 0), cB, voffB); PG8_STAGE(PG8_SB(0, 1), cB + hstep, voffB); PG8_STAGE(PG8_SA(0, 0), cA, voffA); PG8_STAGE(PG8_SA(0, 1), cA + hstep, voffA);
        if (wr == 1) PG8_BAR;
        PG8_WAIT_V(2); PG8_BAR;
        PG8_STAGE(PG8_SB(1, 0), cB + kstep, voffB); PG8_STAGE(PG8_SA(1, 0), cA + kstep, voffA); PG8_STAGE(PG8_SB(1, 1), cB + hstep + kstep, voffB);
        PG8_WAIT_V(6); PG8_BAR;
    } else {
        PG8_STAGE(PG8_SB(0, 0), cB, voffB); PG8_STAGE(PG8_SA(0, 0), cA, voffA); PG8_STAGE(PG8_SB(0, 1), cB + hstep, voffB); PG8_STAGE(PG8_SA(0, 1), cA + hstep, voffA);
        if (wr == 1) PG8_BAR;
        PG8_WAIT_V(4); PG8_BAR;
        PG8_STAGE(PG8_SB(1, 0), cB + kstep, voffB); PG8_STAGE(PG8_SA(1, 0), cA + kstep, voffA); PG8_STAGE(PG8_SB(1, 1), cB + hstep + kstep, voffB);
        PG8_WAIT_V(6); PG8_BAR;
    }
    for (;;) {
        const bool has_next = S.next(ui + 1, nxt);
        const char* nA = has_next ? (const char*)g.A + (size_t)nxt.pm * tstep : cA; const char* nB = has_next ? (const char*)g.Bt + (size_t)nxt.pn * tstep : cB;
        for (int t = 0; t < nt; t += 2) {
            const bool last = (t == nt - 2);
            const char* a1 = cA + (size_t)(t + 1) * kstep;
            const char* a2 = last ? nA : cA + (size_t)(t + 2) * kstep; const char* b2 = last ? nB : cB + (size_t)(t + 2) * kstep;
            const char* a3 = a2 + kstep; const char* b3 = b2 + kstep;
            if (last && has_next) S.a_ready(nxt);
            if constexpr (SP2) {
            PG8_LDB(B0, 0, 0); PG8_LDB(B1, 0, 1); PG8_SCHED; PG8_LDA(At, 0, 0); PG8_STAGE(PG8_SA(1, 1), a1 + hstep, voffA);
            PG8_WAIT_V(8); PG8_WAIT_L(0); PG8_BAR; PG8_MMA(0, 0, At, B0); PG8_MMA(0, 1, At, B1); PG8_BAR; PG8_SCHED;
            PG8_LDA(At, 0, 1); PG8_STAGE(PG8_SB(0, 0), b2, voffB); PG8_STAGE(PG8_SB(0, 1), b2 + hstep, voffB); PG8_STAGE(PG8_SA(0, 0), a2, voffA);
            PG8_WAIT_V(8); PG8_WAIT_L(0); PG8_BAR; PG8_MMA(1, 0, At, B0); PG8_MMA(1, 1, At, B1); PG8_BAR; PG8_SCHED;
            PG8_LDB(B0, 1, 0); PG8_LDB(B1, 1, 1); PG8_SCHED; PG8_LDA(At, 1, 0); PG8_STAGE(PG8_SA(0, 1), a2 + hstep, voffA);
            PG8_WAIT_V(8); PG8_WAIT_L(0); PG8_BAR; PG8_MMA(0, 0, At, B0); PG8_MMA(0, 1, At, B1); PG8_BAR; PG8_SCHED;
            PG8_LDA(At, 1, 1); PG8_STAGE(PG8_SB(1, 0), b3, voffB); PG8_STAGE(PG8_SB(1, 1), b3 + hstep, voffB); PG8_STAGE(PG8_SA(1, 0), a3, voffA);
            PG8_WAIT_V(8); PG8_WAIT_L(0); PG8_BAR; PG8_MMA(1, 0, At, B0); PG8_MMA(1, 1, At, B1); PG8_BAR; PG8_SCHED;
            } else {
            PG8_LDB(B0, 0, 0); PG8_SCHED; PG8_LDA(At, 0, 0); PG8_STAGE(PG8_SA(1, 1), a1 + hstep, voffA);
            PG8_WAIT_L(8); PG8_BAR; PG8_WAIT_L(0); PG8_MMA(0, 0, At, B0); PG8_BAR; PG8_SCHED;
            PG8_LDB(B1, 0, 1); PG8_STAGE(PG8_SB(0, 0), b2, voffB);
            PG8_BAR; PG8_WAIT_L(0); PG8_MMA(0, 1, At, B1); PG8_BAR;
            PG8_LDA(At, 0, 1); PG8_STAGE(PG8_SA(0, 0), a2, voffA);
            PG8_BAR; PG8_WAIT_L(0); PG8_MMA(1, 0, At, B0); PG8_BAR; PG8_SCHED;
            PG8_STAGE(PG8_SB(0, 1), b2 + hstep, voffB);
            PG8_WAIT_V(6); PG8_BAR; PG8_MMA(1, 1, At, B1); PG8_BAR;
            PG8_LDB(B0, 1, 0); PG8_SCHED; PG8_LDA(At, 1, 0); PG8_STAGE(PG8_SA(0, 1), a2 + hstep, voffA);
            PG8_WAIT_L(8); PG8_BAR; PG8_WAIT_L(0); PG8_MMA(0, 0, At, B0); PG8_BAR; PG8_SCHED;
            PG8_LDB(B1, 1, 1); PG8_STAGE(PG8_SB(1, 0), b3, voffB);
            PG8_BAR; PG8_WAIT_L(0); PG8_MMA(0, 1, At, B1); PG8_BAR;
            PG8_LDA(At, 1, 1); PG8_STAGE(PG8_SA(1, 0), a3, voffA);
            PG8_BAR; PG8_WAIT_L(0); PG8_MMA(1, 0, At, B0); PG8_BAR; PG8_SCHED;
            PG8_STAGE(PG8_SB(1, 1), b3 + hstep, voffB);
            PG8_WAIT_V(6); PG8_BAR; PG8_MMA(1, 1, At, B1); PG8_BAR;
            }
        }
        if constexpr (ALIGN_EPI) { if (wr == 0) PG8_BAR; }
        if constexpr (!Epi::AFTER_DRAIN) { E(acc, cur, wr, wc, fr, fq); S.done(cur); }
        if (!has_next) break;
#pragma unroll
        for (int a = 0; a < 2; ++a)
#pragma unroll
            for (int b = 0; b < 2; ++b)
#pragma unroll
                for (int m = 0; m < 4; ++m)
#pragma unroll
                    for (int n = 0; n < 2; ++n) acc[a][b][m][n] = (f32x4){0.f, 0.f, 0.f, 0.f};
        cur = nxt; cA = nA; cB = nB; ++ui;
        if constexpr (ALIGN_EPI) { if (wr == 1) PG8_BAR; }
    }
    PG8_WAIT_V(0);
    if constexpr (!ALIGN_EPI) { if (wr == 0) PG8_BAR; }
    PG8_BAR;
    if constexpr (Epi::AFTER_DRAIN) { E.fused(acc, cur, wr, wc, fr, fq, lds, wid, lane); S.done(cur); }
#undef PG8_SA
#undef PG8_SB
#undef PG8_STAGE
#undef PG8_LDA
#undef PG8_LDB
#undef PG8_MMA
#undef PG8_WAIT_V
#undef PG8_WAIT_L
#undef PG8_BAR
#undef PG8_SCHED
}
}

DEVI pg8::u32x4 pack8(const pg8::f32x4& a, const pg8::f32x4& b) { pg8::u32x4 w; w.x = pg8::cvt_pk_bf16(a[0], a[1]); w.y = pg8::cvt_pk_bf16(a[2], a[3]); w.z = pg8::cvt_pk_bf16(b[0], b[1]); w.w = pg8::cvt_pk_bf16(b[2], b[3]); return w; }
DEVI pg8::f32x4 silu4(const pg8::f32x4& a) { pg8::f32x4 r; r[0] = siluf_(a[0]); r[1] = siluf_(a[1]); r[2] = siluf_(a[2]); r[3] = siluf_(a[3]); return r; }
struct FEpi1 {
    static constexpr bool PERM = true, AFTER_DRAIN = false;
    bf16_t *QK, *V, *SGA, *Z, *CBG; float* ALR;
    DEVI void operator()(const pg8::f32x4 (&acc)[2][2][4][2], const pg8::Unit& u, int wr, int wc, int fr, int fq) const {
        const int t = u.pn, row0 = u.pm * 256 + wr * 64 + fr, cw = wc * 32 + 8 * fq;
#pragma unroll
        for (int ai = 0; ai < 2; ++ai)
#pragma unroll
            for (int m = 0; m < 4; ++m) {
                const size_t row = (size_t)(row0 + ai * 128 + m * 16);
                if (t < 12) {
                    bf16_t* base = t < 4 ? QK + row * 1024 + t * 256 : (t < 8 ? V + row * 1024 + (t - 4) * 256 : SGA + row * 1024 + (t - 8) * 256);
#pragma unroll
                    for (int bj = 0; bj < 2; ++bj) { pg8::f32x4 v0 = acc[ai][bj][m][0], v1 = acc[ai][bj][m][1]; if (t >= 8) { v0 = silu4(v0); v1 = silu4(v1); }
                        *(pg8::u32x4*)(base + bj * 128 + cw) = pack8(v0, v1); }
                } else if (t == 12) {
                    if (wc == 0) { *(pg8::f32x4*)(ALR + row * 32 + 8 * fq) = acc[ai][0][m][0]; *(pg8::f32x4*)(ALR + row * 32 + 8 * fq + 4) = acc[ai][0][m][1]; }
                } else if (t < 21) {
                    *(pg8::u32x4*)(Z + row * 1024 + (t - 13) * 128 + cw) = pack8(acc[ai][0][m][0] * acc[ai][1][m][0], acc[ai][0][m][1] * acc[ai][1][m][1]);
                } else {
                    *(pg8::u32x4*)(CBG + row * 1024 + (t - 21) * 128 + cw) = pack8(acc[ai][0][m][0] * silu4(acc[ai][1][m][0]), acc[ai][0][m][1] * silu4(acc[ai][1][m][1]));
                }
            }
    }
};
struct FEpiRes {
    static constexpr bool PERM = false, AFTER_DRAIN = false;
    const float* xl; const float* xc; float* outl; float* outc; const float* MODl;
    DEVI void operator()(const pg8::f32x4 (&acc)[2][2][4][2], const pg8::Unit& u, int wr, int wc, int fr, int fq) const {
        const int row0 = u.pm * 256 + wr * 64 + fr, col0 = u.pn * 256 + wc * 32 + 4 * fq;
        const bool lat = u.pm < NLAT / 256;
        const float* gate = MODl + (size_t)(lat ? (u.pm >> 4) : 4) * 3072 + 2048 + col0;
        pg8::f32x4 gv[2][2];
#pragma unroll
        for (int bj = 0; bj < 2; ++bj)
#pragma unroll
            for (int n = 0; n < 2; ++n) gv[bj][n] = *(const pg8::f32x4*)(gate + bj * 128 + n * 16);
        const float* xin = lat ? xl : xc - (size_t)NLAT * 1024; float* o = lat ? outl : outc - (size_t)NLAT * 1024;
#pragma unroll
        for (int ai = 0; ai < 2; ++ai)
#pragma unroll
            for (int m = 0; m < 4; ++m) { const size_t off = (size_t)(row0 + ai * 128 + m * 16) * 1024 + col0;
#pragma unroll
                for (int bj = 0; bj < 2; ++bj)
#pragma unroll
                    for (int n = 0; n < 2; ++n) { const pg8::f32x4 xv = *(const pg8::f32x4*)(xin + off + bj * 128 + n * 16); *(pg8::f32x4*)(o + off + bj * 128 + n * 16) = xv + gv[bj][n] * acc[ai][bj][m][n]; } }
    }
};
struct FEpi3 {
    static constexpr bool PERM = true, AFTER_DRAIN = false;
    bf16_t* XR; bf16_t* SG;
    DEVI void operator()(const pg8::f32x4 (&acc)[2][2][4][2], const pg8::Unit& u, int wr, int wc, int fr, int fq) const {
        const int t = u.pn, row0 = u.pm * 256 + wr * 64 + fr, cw = wc * 32 + 8 * fq;
        bf16_t* base = t < 8 ? XR + t * 256 : SG + (t - 8) * 256;
#pragma unroll
        for (int ai = 0; ai < 2; ++ai)
#pragma unroll
            for (int m = 0; m < 4; ++m) { bf16_t* rp = base + (size_t)(row0 + ai * 128 + m * 16) * 2048 + cw;
#pragma unroll
                for (int bj = 0; bj < 2; ++bj) { pg8::f32x4 v0 = acc[ai][bj][m][0], v1 = acc[ai][bj][m][1]; if (t >= 8) { v0 = silu4(v0); v1 = silu4(v1); }
                    *(pg8::u32x4*)(rp + bj * 128) = pack8(v0, v1); } }
    }
};
#ifndef FAST_GEMM
#define FAST_GEMM 1
#endif


#define LASP __attribute__((address_space(3)))
__device__ void st_glawalk(const Params& p, int vb, int nvb, unsigned char* lds_, const bf16_t* QIN, const bf16_t* KET, const bf16_t* SC, const float* DEC, const bf16_t* VT, bf16_t* OF, bf16_t* OB) {
    typedef pg8::bf16x8 bx8; typedef pg8::f32x4 f4; typedef unsigned u32x2 __attribute__((ext_vector_type(2)));
    LASP unsigned char* lds = (LASP unsigned char*)lds_;
    constexpr int QOFF = 0, KOFF = 17408, SOFF = KOFF + 18432, VOFF = SOFF + 9216, DOFF = VOFF + 4608, BUFSZ = 50176;
    const int tid = threadIdx.x, wid = __builtin_amdgcn_readfirstlane(tid >> 6), lane = tid & 63, c = lane & 15, g = lane >> 4;
    for (int item = vb; item < 256; item += nvb) {
        const int vs = item & 7, combo = item >> 3, d = combo & 1, h = (combo >> 1) & 3, bb = combo >> 3;
        int soff[6], doff[6];
        { const int p0 = tid, p1 = tid + 512; soff[0] = (p0 >> 4) * 256 + (p0 & 15) * 16; doff[0] = QOFF + (p0 >> 4) * 272 + (p0 & 15) * 16; soff[1] = (p1 >> 4) * 256 + (p1 & 15) * 16; doff[1] = QOFF + (p1 >> 4) * 272 + (p1 & 15) * 16;
          const int q2 = tid, q3 = tid + 512; soff[2] = (q2 >> 3) * 128 + (q2 & 7) * 16; doff[2] = KOFF + (q2 >> 3) * 144 + (q2 & 7) * 16; soff[3] = (q3 >> 3) * 128 + (q3 & 7) * 16; doff[3] = KOFF + (q3 >> 3) * 144 + (q3 & 7) * 16;
          soff[4] = (tid >> 3) * 128 + (tid & 7) * 16; doff[4] = SOFF + (tid >> 3) * 144 + (tid & 7) * 16;
          if (tid < 256) { soff[5] = (vs * 32 + (tid >> 3)) * 128 + (tid & 7) * 16; doff[5] = VOFF + (tid >> 3) * 144 + (tid & 7) * 16; } else { soff[5] = (tid - 256) * 16; doff[5] = DOFF + (tid - 256) * 16; } }
        const bool has5 = tid < 288;
        pg8::u32x4 r[6];
#define GW_LOAD(step) do { const int cc_ = d == 0 ? ((step) < 4 ? 64 + (step) : (step) - 4) : 67 - (step); const size_t u_ = (size_t)((bb * NCH + cc_) * 4 + h) * 2 + d; \
            const unsigned char* q_ = (const unsigned char*)QIN + u_ * 16384; const unsigned char* k_ = (const unsigned char*)KET + u_ * 16384; const unsigned char* s_ = (const unsigned char*)SC + u_ * 8192; \
            const unsigned char* x5_ = tid < 256 ? (const unsigned char*)VT + (u_ >> 1) * 32768 : (const unsigned char*)DEC + u_ * 512; \
            r[0] = *(const pg8::u32x4*)(q_ + soff[0]); r[1] = *(const pg8::u32x4*)(q_ + soff[1]); r[2] = *(const pg8::u32x4*)(k_ + soff[2]); r[3] = *(const pg8::u32x4*)(k_ + soff[3]); r[4] = *(const pg8::u32x4*)(s_ + soff[4]); \
            if (has5) r[5] = *(const pg8::u32x4*)(x5_ + soff[5]); } while (0)
#define GW_WRITE(bufi) do { LASP unsigned char* b_ = lds + (bufi) * BUFSZ; _Pragma("unroll") for (int j_ = 0; j_ < 5; ++j_) *(LASP pg8::u32x4*)(b_ + doff[j_]) = r[j_]; if (has5) *(LASP pg8::u32x4*)(b_ + doff[5]) = r[5]; } while (0)
        f4 S[8];
#pragma unroll
        for (int m = 0; m < 8; ++m) S[m] = (f4){0.f, 0.f, 0.f, 0.f};
        bf16_t* O = d == 0 ? OF : OB;
        __syncthreads();
        GW_LOAD(0); GW_WRITE(0); GW_LOAD(1);
        __syncthreads();
        for (int step = 0; step < NCH; ++step) {
            if (step + 1 < NCH) { GW_WRITE((step + 1) & 1); if (step + 2 < NCH) GW_LOAD(step + 2); }
            if (wid < 2) {
                const LASP unsigned char* B = lds + (step & 1) * BUFSZ;
                const bx8 bv0 = *(const LASP bx8*)(B + VOFF + (16 * wid + c) * 144 + g * 16), bv1 = *(const LASP bx8*)(B + VOFF + (16 * wid + c) * 144 + 64 + g * 16);
                bx8 sB[4];
#pragma unroll
                for (int ks = 0; ks < 4; ++ks) { pg8::u32x4 w; w.x = pg8::cvt_pk_bf16(S[2 * ks][0], S[2 * ks][1]); w.y = pg8::cvt_pk_bf16(S[2 * ks][2], S[2 * ks][3]);
                    w.z = pg8::cvt_pk_bf16(S[2 * ks + 1][0], S[2 * ks + 1][1]); w.w = pg8::cvt_pk_bf16(S[2 * ks + 1][2], S[2 * ks + 1][3]); sB[ks] = __builtin_bit_cast(bx8, w); }
                f4 o[4];
#pragma unroll
                for (int mt = 0; mt < 4; ++mt) o[mt] = (f4){0.f, 0.f, 0.f, 0.f};
#pragma unroll
                for (int ks = 0; ks < 4; ++ks)
#pragma unroll
                    for (int mt = 0; mt < 4; ++mt) { const LASP unsigned char* qa = B + QOFF + (16 * mt + c) * 272 + (32 * ks + 4 * g) * 2;
                        const u32x2 lo = *(const LASP u32x2*)qa, hi = *(const LASP u32x2*)(qa + 32); pg8::u32x4 w; w.x = lo.x; w.y = lo.y; w.z = hi.x; w.w = hi.y;
                        o[mt] = __builtin_amdgcn_mfma_f32_16x16x32_bf16(sB[ks], __builtin_bit_cast(bx8, w), o[mt], 0, 0, 0); }
#pragma unroll
                for (int mt = 0; mt < 4; ++mt) { const LASP unsigned char* sa = B + SOFF + (16 * mt + c) * 144 + g * 16;
                    o[mt] = __builtin_amdgcn_mfma_f32_16x16x32_bf16(bv0, *(const LASP bx8*)sa, o[mt], 0, 0, 0);
                    o[mt] = __builtin_amdgcn_mfma_f32_16x16x32_bf16(bv1, *(const LASP bx8*)(sa + 64), o[mt], 0, 0, 0); }
                const int cc = d == 0 ? (step < 4 ? 64 + step : step - 4) : 67 - step; const int row0 = row_of(bb, cc, 0);
#pragma unroll
                for (int mt = 0; mt < 4; ++mt) { u32x2 w; w.x = pg8::cvt_pk_bf16(o[mt][0], o[mt][1]); w.y = pg8::cvt_pk_bf16(o[mt][2], o[mt][3]);
                    *(u32x2*)(O + (size_t)(row0 + 16 * mt + c) * 1024 + h * 256 + vs * 32 + 16 * wid + 4 * g) = w; }
#pragma unroll
                for (int m = 0; m < 8; ++m) { const f4 dv = *(const LASP f4*)(B + DOFF + (16 * m + 4 * g) * 4); const LASP unsigned char* ka = B + KOFF + (16 * m + c) * 144 + g * 16;
                    S[m] = S[m] * dv;
                    S[m] = __builtin_amdgcn_mfma_f32_16x16x32_bf16(*(const LASP bx8*)ka, bv0, S[m], 0, 0, 0);
                    S[m] = __builtin_amdgcn_mfma_f32_16x16x32_bf16(*(const LASP bx8*)(ka + 64), bv1, S[m], 0, 0, 0); }
            }
            __syncthreads();
        }
#undef GW_LOAD
#undef GW_WRITE
    }
}
#ifndef FAST_WALK
#define FAST_WALK 1
#endif

template <int MODE>
__device__ void st_rglru(const Params& p, int vb, int nvb, unsigned char* lds_, const bf16_t* XR, const bf16_t* SG, const bf16_t* BD, float* SUMA, float* SUMH, bf16_t* Y) {
    typedef pg8::bf16x8 bx8; typedef pg8::f32x4 f4; typedef float f32x2v __attribute__((ext_vector_type(2)));
    LASP unsigned char* lds = (LASP unsigned char*)lds_;
    constexpr int AOFF = 0, FOFF = 17408, BUF = 51200, CWOFF = 2 * BUF;
    constexpr int ND = MODE == 0 ? 1 : 2, NCOMBO = MODE == 0 ? 32 : 16, NTILE = MODE == 0 ? NB * NCH : NB * 64;
    const int tid = threadIdx.x, wid = __builtin_amdgcn_readfirstlane(tid >> 6), lane = tid & 63, c = lane & 15, g = lane >> 4, cp = tid & 63, tg = tid >> 6;
    int P, part, cstep, combo0;
    if (nvb >= NCOMBO) { P = nvb / NCOMBO; part = vb / NCOMBO; cstep = NCOMBO; combo0 = vb % NCOMBO; if (part >= P) return; } else { P = 1; part = 0; cstep = nvb; combo0 = vb; }
    for (int combo = combo0; combo < NCOMBO; combo += cstep) {
        const int nb = MODE == 0 ? (combo >> 1) : combo, d0 = MODE == 0 ? (combo & 1) : 0;
        const int ch = nb * 128 + 16 * wid + c;
        bx8 wa[ND][4], wx[ND][4]; float ba[ND], bxx[ND], k8[ND];
        __syncthreads();
#pragma unroll
        for (int dd = 0; dd < ND; ++dd) { const int d = d0 + dd;
            const bf16_t* wA = BD + ((size_t)(d * 16 + nb) * 128 + 16 * wid + c) * 128 + 8 * g; const bf16_t* wX = wA + (size_t)2 * 16 * 128 * 128;
#pragma unroll
            for (int ks = 0; ks < 4; ++ks) { wa[dd][ks] = *(const bx8*)(wA + 32 * ks); wx[dd][ks] = *(const bx8*)(wX + 32 * ks); }
            ba[dd] = p.o_b_a[d * 2048 + ch]; bxx[dd] = p.o_b_x[d * 2048 + ch]; k8[dd] = 8.f * softplusf_(-p.o_lam[d * 2048 + ch]);
            if (tg < 5) { const f32x2v w2 = tg < 4 ? *(const f32x2v*)(p.o_conv_w + ((size_t)d * 4 + tg) * 2048 + nb * 128 + 2 * cp) : *(const f32x2v*)(p.o_conv_b + (size_t)d * 2048 + nb * 128 + 2 * cp);
                *(LASP f32x2v*)(lds + CWOFF + ((dd * 5 + tg) * 128 + 2 * cp) * 4) = w2; } }
        __syncthreads();
        unsigned xr[14];
#define RG_PREF(tile) do { const int bb_ = MODE == 0 ? (tile) / NCH : (tile) >> 6, cc_ = MODE == 0 ? (tile) % NCH : (tile) & 63; const int seg0_ = cc_ < 64 ? bb_ * 4096 : NLAT + bb_ * 256, segn_ = cc_ < 64 ? 4096 : 256; \
            const int tl_ = row_of(bb_, cc_, 0) - seg0_ + 8 * tg - 3; _Pragma("unroll") for (int jr = 0; jr < 14; ++jr) { const int tt_ = tl_ + jr; const bool need_ = MODE == 1 || (d0 == 0 ? jr < 11 : jr >= 3); \
                xr[jr] = (need_ && tt_ >= 0 && tt_ < segn_) ? *(const unsigned*)(XR + (size_t)(seg0_ + tt_) * 2048 + nb * 128 + 2 * cp) : 0u; } } while (0)
        int it = 0;
        if (part < NTILE) RG_PREF(part);
        for (int tile = part; tile < NTILE; tile += P) {
            const int bb = MODE == 0 ? tile / NCH : tile >> 6, cc = MODE == 0 ? tile % NCH : tile & 63; const int row0 = row_of(bb, cc, 0);
            unsigned xcur[14];
#pragma unroll
            for (int jr = 0; jr < 14; ++jr) xcur[jr] = xr[jr];
            if (tile + P < NTILE) RG_PREF(tile + P);
            float hsum[4][4];
#pragma unroll
            for (int dd = 0; dd < ND; ++dd) { const int d = d0 + dd;
                LASP unsigned char* B = lds + (it & 1) * BUF; ++it;
                { f32x2v cv[8]; const f32x2v cbv = *(const LASP f32x2v*)(lds + CWOFF + ((dd * 5 + 4) * 128 + 2 * cp) * 4);
#pragma unroll
                  for (int i = 0; i < 8; ++i) cv[i] = cbv;
#pragma unroll
                  for (int jj = 0; jj < 4; ++jj) { const f32x2v cwv = *(const LASP f32x2v*)(lds + CWOFF + ((dd * 5 + jj) * 128 + 2 * cp) * 4);
#pragma unroll
                      for (int i = 0; i < 8; ++i) { const int jr = d == 0 ? i + jj : i + 6 - jj; cv[i].x += cwv.x * __uint_as_float(xcur[jr] << 16); cv[i].y += cwv.y * __uint_as_float(xcur[jr] & 0xffff0000u); } }
#pragma unroll
                  for (int i = 0; i < 8; ++i) { *(LASP unsigned*)(B + AOFF + (8 * tg + i) * 272 + 4 * cp) = pg8::cvt_pk_bf16(cv[i].x, cv[i].y); *(LASP f32x2v*)(B + FOFF + (8 * tg + i) * 528 + 8 * cp) = cv[i]; } }
                __syncthreads();
                f4 aa[4], ax[4];
#pragma unroll
                for (int mt = 0; mt < 4; ++mt) { aa[mt] = (f4){0.f, 0.f, 0.f, 0.f}; ax[mt] = (f4){0.f, 0.f, 0.f, 0.f}; }
#pragma unroll
                for (int ks = 0; ks < 4; ++ks)
#pragma unroll
                    for (int mt = 0; mt < 4; ++mt) { const bx8 af = *(const LASP bx8*)(B + AOFF + (16 * mt + c) * 272 + (32 * ks + 8 * g) * 2);
                        aa[mt] = __builtin_amdgcn_mfma_f32_16x16x32_bf16(af, wa[dd][ks], aa[mt], 0, 0, 0); ax[mt] = __builtin_amdgcn_mfma_f32_16x16x32_bf16(af, wx[dd][ks], ax[mt], 0, 0, 0); }
                const int gl = d == 0 ? g : 3 - g;
                const int src1 = d == 0 ? lane - 16 : lane + 16, src2 = d == 0 ? lane - 32 : lane + 32, srcT = d == 0 ? 48 + c : c;
                const size_t sidx = (((size_t)bb * 2 + d) * NCH + cc) * 2048 + ch;
                float carryH = MODE == 0 ? 0.f : SUMH[sidx], carryA = 1.f;
#pragma unroll
                for (int mtl = 0; mtl < 4; ++mtl) { const int mt = d == 0 ? mtl : 3 - mtl;
                    float Pq[4], Lq[4]; float pa = 1.f, lh = 0.f;
#pragma unroll
                    for (int sq = 0; sq < 4; ++sq) { const int r = d == 0 ? sq : 3 - sq;
                        const float xv = *(const LASP float*)(B + FOFF + (16 * mt + 4 * g + r) * 528 + (16 * wid + c) * 4);
                        const float rr = sigmoidf_(aa[mt][r] + ba[dd]), ii = sigmoidf_(ax[mt][r] + bxx[dd]);
                        const float a = __expf(-k8[dd] * rr), u = sqrtf(fmaxf(1.f - a * a, 0.f)) * (ii * xv);
                        lh = a * lh + u; pa *= a; Pq[sq] = pa; Lq[sq] = lh; }
                    float XA = pa, XU = lh, tA, tU;
                    tA = __shfl(XA, src1); tU = __shfl(XU, src1); if (gl >= 1) { XU = tU * XA + XU; XA = tA * XA; }
                    tA = __shfl(XA, src2); tU = __shfl(XU, src2); if (gl >= 2) { XU = tU * XA + XU; XA = tA * XA; }
                    const float totA = __shfl(XA, srcT), totU = __shfl(XU, srcT);
                    if (MODE == 1) {
                        float eA = __shfl(XA, src1), eU = __shfl(XU, src1); if (gl == 0) { eA = 1.f; eU = 0.f; }
                        const float hin = carryH * eA + eU;
#pragma unroll
                        for (int sq = 0; sq < 4; ++sq) { const int r = d == 0 ? sq : 3 - sq; const float hv = hin * Pq[sq] + Lq[sq]; if (dd == 0) hsum[mt][r] = hv; else hsum[mt][r] += hv; }
                    }
                    carryH = carryH * totA + totU; carryA *= totA;
                }
                if (MODE == 0) { if (g == 0) { SUMA[sidx] = carryA; SUMH[sidx] = carryH; } }
            }
            if (MODE == 1) {
#pragma unroll
                for (int mt = 0; mt < 4; ++mt)
#pragma unroll
                    for (int r = 0; r < 4; ++r) { const size_t o = (size_t)(row0 + 16 * mt + 4 * g + r) * 2048 + ch; Y[o] = f2bf(hsum[mt][r] * bf2f(SG[o])); }
            }
        }
        __syncthreads();
#undef RG_PREF
    }
}
#ifndef FAST_RG
#define FAST_RG 1
#endif

#define XB_TMO      128
#define XB_XCNT(j)  (256  + 64 * (j))
#define XB_XSUB(j)  (1280 + 64 * (j))
#define XB_XGEN(j)  (2304 + 64 * (j))
#define XB_TOP      3328
#define XB_TOPGEN   3392
#define XB_SPIN_CAP (1u << 20)
DEVI unsigned xb_ld(unsigned* p)              { return __hip_atomic_load(p, __ATOMIC_RELAXED, __HIP_MEMORY_SCOPE_AGENT); }
DEVI unsigned xb_add(unsigned* p, unsigned v) { return __hip_atomic_fetch_add(p, v, __ATOMIC_RELAXED, __HIP_MEMORY_SCOPE_AGENT); }
DEVI unsigned xb_xcc_id() { return (unsigned)__builtin_amdgcn_s_getreg((3 << 11) | 20) & 0xFu; }
#define XB_SPIN(cond, bar) do { unsigned _sp = 0; while (cond) { __builtin_amdgcn_s_sleep(1); \
    if ((++_sp & 255u) == 0u) { if (xb_ld(&(bar)[XB_TMO])) break; if (_sp > XB_SPIN_CAP) { atomicAdd(&(bar)[XB_TMO], 1u); break; } } } } while (0)
struct XcdBarrier { unsigned* bar; unsigned x; volatile __attribute__((address_space(3))) unsigned* st; };
DEVI XcdBarrier xcd_barrier_post(unsigned* bar, volatile __attribute__((address_space(3))) unsigned* st) {
    XcdBarrier b; b.bar = bar; b.x = xb_xcc_id(); b.st = st;
    if (threadIdx.x == 0) (void)xb_add(&bar[XB_XCNT(b.x)], 1u);
    return b;
}
DEVI void xcd_barrier_complete(unsigned* bar, unsigned x, unsigned& nloc, unsigned& nx) {
    const unsigned G = gridDim.x * gridDim.y * gridDim.z;
    unsigned sum, cnt, mine, sp = 0u;
    for (;;) {
        sum = 0u; cnt = 0u; mine = 0u;
#pragma unroll
        for (unsigned j = 0; j < 16; ++j) { const unsigned c = xb_ld(&bar[XB_XCNT(j)]); sum += c; cnt += (c > 0u) ? 1u : 0u; mine = (j == x) ? c : mine; }
        if (sum == G) break;
        __builtin_amdgcn_s_sleep(1);
        if ((++sp & 255u) == 0u) { if (xb_ld(&bar[XB_TMO])) break; if (sp > XB_SPIN_CAP) { atomicAdd(&bar[XB_TMO], 1u); break; } }
    }
    nloc = mine > 0u ? mine : 1u; nx = cnt > 0u ? cnt : 1u;
}
DEVI void xcd_barrier(const XcdBarrier& b) {
    asm volatile("s_waitcnt vmcnt(0)" ::: "memory");
    __syncthreads();
    if (threadIdx.x == 0) {
        unsigned* bar = b.bar;
        __builtin_amdgcn_s_waitcnt(0);
        unsigned nloc = b.st[0], nx = b.st[1];
        if (nloc == 0u) { xcd_barrier_complete(bar, b.x, nloc, nx); b.st[0] = nloc; b.st[1] = nx; }
        const unsigned old = xb_add(&bar[XB_XSUB(b.x)], 1u);
        const unsigned gen = old / nloc;
        if (old + 1u == (gen + 1u) * nloc) {
            __builtin_amdgcn_fence(__ATOMIC_RELEASE, "agent");
            asm volatile("s_waitcnt vmcnt(0)" ::: "memory");
            const unsigned og = xb_add(&bar[XB_TOP], 1u);
            const unsigned tg = og / nx;
            if (og + 1u == (tg + 1u) * nx) xb_add(&bar[XB_TOPGEN], 1u);
            else XB_SPIN(xb_ld(&bar[XB_TOPGEN]) == tg, bar);
            __builtin_amdgcn_fence(__ATOMIC_ACQUIRE, "agent");
            xb_add(&bar[XB_XGEN(b.x)], 1u);
            asm volatile("s_waitcnt vmcnt(0)" ::: "memory");
        } else {
            XB_SPIN(xb_ld(&bar[XB_XGEN(b.x)]) == gen, bar);
            __builtin_amdgcn_fence(__ATOMIC_ACQUIRE, "agent");
            asm volatile("s_waitcnt vmcnt(0)" ::: "memory");
        }
    }
    __syncthreads();
}
__device__ __forceinline__ void run_stage(const Params& p, int st, int vb, int nvb, unsigned char* lds) {
    unsigned char* ws = p.ws;
    float* MOD = (float*)(ws + WS_MOD); float* ALR = (float*)(ws + WS_ALR); float* X1C = (float*)(ws + WS_X1C);
    float* SUMA = (float*)(ws + WS_SUMA); float* SUMH = (float*)(ws + WS_SUMH); float* DEC = (float*)(ws + WS_DEC);
    bf16_t* Bt1 = (bf16_t*)(ws + WS_BT1); bf16_t* Bt2 = (bf16_t*)(ws + WS_BT2); bf16_t* Bt3 = (bf16_t*)(ws + WS_BT3); bf16_t* Bt4 = (bf16_t*)(ws + WS_BT4);
    bf16_t* S0 = (bf16_t*)(ws + WS_SLOT(0)); bf16_t* S1 = (bf16_t*)(ws + WS_SLOT(1)); bf16_t* S2 = (bf16_t*)(ws + WS_SLOT(2));
    bf16_t* S3 = (bf16_t*)(ws + WS_SLOT(3)); bf16_t* S4 = (bf16_t*)(ws + WS_SLOT(4)); bf16_t* S5 = (bf16_t*)(ws + WS_SLOT(5));
    bf16_t* DO0 = (bf16_t*)p.out; bf16_t* DOSC = (bf16_t*)((unsigned char*)p.out + 34 * MiB);
    switch (st) {
    case 0: st_mod(p, vb, nvb, (float*)lds); st_wprep(p, vb, nvb, lds); break;
    case 1: st_modulate(p, vb, nvb, 0, p.x, p.ctx, S0); break;
    case 3: st_glaprep(p, vb, nvb, lds, S1, S2, ALR, S3, S4, DOSC, DEC, S5); break;
#if FAST_WALK
    case 4: st_glawalk(p, vb, nvb, lds, S3, S4, DOSC, DEC, S5, S2, DO0); break;
#else
    case 4: st_glawalk_naive(p, vb, nvb, (float*)lds, S3, S4, DOSC, DEC, S5, S2, DO0); break;
#endif
    case 6: st_inner(p, vb, nvb, S2, DO0, S3, S4, S5, S0); break;
    case 8: st_modulate(p, vb, nvb, 1, p.out, X1C, S2); break;
    case 11: st_carry(p, vb, nvb, SUMA, SUMH); break;
#if FAST_RG
    case 10: st_rglru<0>(p, vb, nvb, lds, S3, S0, (const bf16_t*)(ws + WS_BD), SUMA, SUMH, S0); break;
    case 12: st_rglru<1>(p, vb, nvb, lds, S3, S0, (const bf16_t*)(ws + WS_BD), SUMA, SUMH, S0); break;
#else
    case 10: st_rglru_naive<0>(p, vb, nvb, (float*)lds, S3, S0, SUMA, SUMH, S0); break;
    case 12: st_rglru_naive<1>(p, vb, nvb, (float*)lds, S3, S0, SUMA, SUMH, S0); break;
#endif
    case 14: st_final(p, vb, nvb); break;
#if FAST_GEMM
    case 2: { FEpi1 E{S1, S2, S3, S4, S5, ALR}; pg8::Gemm g{S0, Bt1, NT, N1, 1024}; pg8::TileOrder S; S.init(NT / 256, 9, nvb, vb, 0, 8, 0, 12);
              pg8::gemm_phase<FEpi1, pg8::TileOrder, true, true>((PG8_LAS unsigned char*)lds, g, S, E); } break;
    case 5: { FEpi1 E{S1, S2, S3, S4, S5, ALR}; pg8::Gemm g{S0, Bt1, NT, N1, 1024}; pg8::TileOrder S; S.init(NT / 256, 20, nvb, vb, 0, 4, 8, 13);
              pg8::gemm_phase<FEpi1, pg8::TileOrder, true, true>((PG8_LAS unsigned char*)lds, g, S, E); } break;
    case 7: { FEpiRes E{p.x, p.ctx, p.out, X1C, MOD}; pg8::Gemm g{S0, Bt2, NT, 1024, 2048}; pg8::TileOrder S; S.init(NT / 256, 4, nvb, vb);
              pg8::gemm_phase<FEpiRes, pg8::TileOrder, true, true>((PG8_LAS unsigned char*)lds, g, S, E); } break;
    case 9: { FEpi3 E{S3, S0}; pg8::Gemm g{S2, Bt3, NT, 4096, 1024}; pg8::TileOrder S; S.init(NLAT / 256, 16, nvb, vb, 0, 1 << 30, 0, 0, NCTX / 256, 8, NLAT / 256);
              pg8::gemm_phase<FEpi3, pg8::TileOrder, true, true>((PG8_LAS unsigned char*)lds, g, S, E); } break;
    case 13: { FEpiRes E{p.out, nullptr, p.out, nullptr, MOD + 5 * 3072}; pg8::Gemm g{S0, Bt4, NLAT, 1024, 2048}; pg8::TileOrder S; S.init(NLAT / 256, 4, nvb, vb);
              pg8::gemm_phase<FEpiRes, pg8::TileOrder, true, true>((PG8_LAS unsigned char*)lds, g, S, E); } break;
#else
    case 2: { Epi1 E{S1, S2, S3, S4, S5, ALR}; st_gemm_naive(vb, nvb, (float*)lds, S0, Bt1, 0, NT / 32, 0, 8, 1024, E); st_gemm_naive(vb, nvb, (float*)lds, S0, Bt1, 0, NT / 32, 12, 13, 1024, E); } break;
    case 5: { Epi1 E{S1, S2, S3, S4, S5, ALR}; st_gemm_naive(vb, nvb, (float*)lds, S0, Bt1, 0, NT / 32, 8, 12, 1024, E); st_gemm_naive(vb, nvb, (float*)lds, S0, Bt1, 0, NT / 32, 13, 29, 1024, E); } break;
    case 7: { EpiRes E{p.x, p.ctx, p.out, X1C, MOD}; st_gemm_naive(vb, nvb, (float*)lds, S0, Bt2, 0, NT / 32, 0, 4, 2048, E); } break;
    case 9: { Epi3 E{S3, S0}; st_gemm_naive(vb, nvb, (float*)lds, S2, Bt3, 0, NLAT / 32, 0, 16, 1024, E); st_gemm_naive(vb, nvb, (float*)lds, S2, Bt3, NLAT / 32, NT / 32, 0, 8, 1024, E); } break;
    case 13: { EpiRes E{p.out, nullptr, p.out, nullptr, MOD + 5 * 3072}; st_gemm_naive(vb, nvb, (float*)lds, S0, Bt4, 0, NLAT / 32, 0, 4, 2048, E); } break;
#endif
    }
}
constexpr int NSTAGES = 15;
constexpr int LDS_BYTES = 147456;

#ifndef ONE_LAUNCH
#define ONE_LAUNCH 1
#endif
#if !ONE_LAUNCH
__global__ void __launch_bounds__(NTHREADS) k_mega(Params p, int st) {
    extern __shared__ __attribute__((aligned(16))) unsigned char lds[];
    run_stage(p, st, blockIdx.x, gridDim.x, lds);
}
#else
__global__ void __launch_bounds__(NTHREADS) k_mega(Params p) {
    extern __shared__ __attribute__((aligned(16))) unsigned char lds[];
    volatile __attribute__((address_space(3))) unsigned* st = (volatile __attribute__((address_space(3))) unsigned*)((__attribute__((address_space(3))) unsigned char*)lds + (LDS_BYTES - 64));
    if (threadIdx.x < 2) st[threadIdx.x] = 0u;
    __syncthreads();
    const XcdBarrier bar = xcd_barrier_post((unsigned*)(p.ws + WS_CTL) + 4096, st);
#ifndef REP_STAGE
#define REP_STAGE -1
#endif
#ifndef REP_N
#define REP_N 1
#endif
#define RS(k) do { run_stage(p, k, blockIdx.x, gridDim.x, lds); if ((k) == REP_STAGE) { for (int rep_ = 0; rep_ < REP_N; ++rep_) { xcd_barrier(bar); run_stage(p, k, blockIdx.x, gridDim.x, lds); } } } while (0)
#define GS() xcd_barrier(bar)
    RS(0); GS(); RS(1); GS(); RS(2); GS(); RS(3); GS(); RS(4); GS(); RS(5); GS(); RS(6); GS(); RS(7); GS();
    RS(8); GS(); RS(9); GS(); RS(10); GS(); RS(11); GS(); RS(12); GS(); RS(13); GS(); RS(14);
#undef RS
#undef GS
}
#endif

extern "C" void kernel_launch(void* const* d_in, const int* in_sizes, int n_in, void* d_out, int out_size, void* d_ws, size_t ws_size, hipStream_t stream) {
    static int inited = 0, grid_blocks = 0;
    if (!inited) {
        if (n_in != 23 || ws_size < WS_END || out_size != NLAT * D) { fprintf(stderr, "kernel_launch: unexpected shapes n_in %d ws %zu out %d\n", n_in, ws_size, out_size); inited = -1; return; }
        if (hipFuncSetAttribute((const void*)k_mega, hipFuncAttributeMaxDynamicSharedMemorySize, LDS_BYTES) != hipSuccess) { fprintf(stderr, "hipFuncSetAttribute failed\n"); inited = -1; return; }
        int dev = 0, cus = 0, per_cu = 0;
        (void)hipGetDevice(&dev); (void)hipDeviceGetAttribute(&cus, hipDeviceAttributeMultiprocessorCount, dev);
        (void)hipOccupancyMaxActiveBlocksPerMultiprocessor(&per_cu, (const void*)k_mega, NTHREADS, LDS_BYTES);
        if (per_cu < 1) { fprintf(stderr, "kernel_launch: occupancy query says %d blocks per CU\n", per_cu); per_cu = 1; }
        if (per_cu > 1) per_cu = 1;
        grid_blocks = cus * per_cu;
        inited = 1;
    }
    if (inited < 0) return;
    Params p{};
    const float** f = (const float**)&p;
    for (int i = 0; i < 23; ++i) f[i] = (const float*)d_in[i];
    p.out = (float*)d_out; p.ws = (unsigned char*)d_ws;
    (void)hipMemsetAsync((unsigned char*)d_ws + WS_CTL, 0, 2 * MiB, stream);
#if ONE_LAUNCH
    void* args[] = {&p};
    hipError_t e = hipLaunchCooperativeKernel((const void*)k_mega, dim3(grid_blocks), dim3(NTHREADS), args, LDS_BYTES, stream);
    if (e != hipSuccess) fprintf(stderr, "cooperative launch failed: %s (grid %d)\n", hipGetErrorString(e), grid_blocks);
#else
    for (int st = 0; st < NSTAGES; ++st) hipLaunchKernelGGL(k_mega, dim3(1024), dim3(NTHREADS), LDS_BYTES, stream, p, st);
#endif
}
```

```cpp
#include <hip/hip_runtime.h>
#include <hip/hip_cooperative_groups.h>
namespace cg = cooperative_groups;
#include <cstdio>
#include <cstdint>

typedef unsigned short bf16_t;
#define DEVI __device__ __forceinline__

constexpr int D = 1024, NB = 4, SEQ = 4096, CTXL = 256;
constexpr int NLAT = NB * SEQ;
constexpr int NCTX = NB * CTXL;
constexpr int NT = NLAT + NCTX;
constexpr int NCH = 68;
constexpr int EVEN_IN = 7200;
constexpr int N1 = 7424;
constexpr int N1A = 13 * 256;
constexpr int RGW = 2048;
constexpr float EPS = 1e-6f;

constexpr size_t MiB = 1u << 20;
constexpr size_t WS_CTL = 0;
constexpr size_t WS_MOD = 1 * MiB;
constexpr size_t WS_ALR = 2 * MiB;
constexpr size_t WS_X1C = 5 * MiB;
constexpr size_t WS_SUMA = 9 * MiB;
constexpr size_t WS_SUMH = 9 * MiB + 4608 * 1024;
constexpr size_t WS_DEC = 18 * MiB;
constexpr size_t WS_BT1 = 19 * MiB + 512 * 1024;
constexpr size_t WS_BT2 = 34 * MiB;
constexpr size_t WS_BT3 = 38 * MiB;
constexpr size_t WS_BT4 = 46 * MiB;
constexpr size_t WS_BD = 50 * MiB;
constexpr size_t WS_S0 = 52 * MiB;
constexpr size_t SLOT = 34 * MiB;
constexpr size_t WS_END = WS_S0 + 6 * SLOT;
static_assert(WS_END == 256 * MiB, "ws map");
#define WS_SLOT(i) (WS_S0 + (size_t)(i) * SLOT)

struct Params {
    const float* x; const float* c; const float* ctx; const float* c_ctx; const float* norm_g; const float* w_mod; const float* b_mod;
    const float* e_w_in; const float* e_w_a2; const float* e_b_a2; const float* e_gla_g; const float* e_conv_w; const float* e_w_out;
    const float* o_w_in; const float* o_conv_w; const float* o_conv_b; const float* o_w_a; const float* o_b_a; const float* o_w_x; const float* o_b_x;
    const float* o_lam; const float* o_w_out; const float* final_g;
    float* out; unsigned char* ws;
};

DEVI float bf2f(bf16_t v) { return __uint_as_float((unsigned)v << 16); }
DEVI bf16_t f2bf(float f) { unsigned u = __float_as_uint(f); return (bf16_t)((u + 0x7fffu + ((u >> 16) & 1u)) >> 16); }
DEVI unsigned pk2(float lo, float hi) { return (unsigned)f2bf(lo) | ((unsigned)f2bf(hi) << 16); }
DEVI float fexp2_(float x) { return __builtin_amdgcn_exp2f(x); }
DEVI float frcp_(float x) { return __builtin_amdgcn_rcpf(x); }
DEVI float sigmoidf_(float x) { return frcp_(1.0f + fexp2_(-1.4426950408889634f * x)); }
DEVI float siluf_(float x) { return x * frcp_(1.0f + fexp2_(-1.4426950408889634f * x)); }
DEVI float softplusf_(float x) { return fmaxf(x, 0.f) + log1pf(__expf(-fabsf(x))); }
DEVI float logsigmoidf_(float x) { return fminf(x, 0.f) - 0.6931471805599453f * __builtin_amdgcn_logf(1.0f + fexp2_(-1.4426950408889634f * fabsf(x))); }
DEVI int row_of(int bb, int c, int t) { return c < 64 ? bb * 4096 + c * 64 + t : NLAT + bb * 256 + (c - 64) * 64 + t; }
DEVI int mod_idx(int row) { return row < NLAT ? (row >> 12) : 4; }
DEVI float wave_sum(float v) {
#pragma unroll
    for (int o = 1; o < 64; o <<= 1) v += __shfl_xor(v, o);
    return v;
}
__host__ __device__ inline int colmap1(int n) {
    const int t = n >> 8, c = n & 255;
    if (t < 12) return n;
    if (t == 12) return c < 32 ? 3072 + c : -1;
    if (t < 21) { const int j = t - 13; return c < 128 ? 4128 + 128 * j + c : 5152 + 128 * j + (c - 128); }
    const int j = t - 21; return c < 128 ? 3104 + 128 * j + c : 6176 + 128 * j + (c - 128);
}

#define NTHREADS 512

__device__ void st_mod(const Params& p, int vb, int nvb, float* lds) {
    float* MOD = (float*)(p.ws + WS_MOD);
    for (int i = threadIdx.x; i < 5 * 1024; i += NTHREADS) { const int s = i >> 10, k = i & 1023; const float v = s < 4 ? p.c[s * 1024 + k] : p.c_ctx[k]; lds[i] = siluf_(v); }
    __syncthreads();
    const int lane = threadIdx.x & 63, gw = vb * (NTHREADS / 64) + (threadIdx.x >> 6), ngw = nvb * (NTHREADS / 64);
    for (int it = gw; it < 2 * 48 * 32; it += ngw) {
        const int kc = it & 31, cb = (it >> 5) % 48, li = it / (32 * 48), j = cb * 64 + lane, k0 = kc * 32;
        const float* W = p.w_mod + ((size_t)li * 1024 + k0) * 3072 + j;
        float wv[32];
#pragma unroll
        for (int k = 0; k < 32; ++k) wv[k] = W[(size_t)k * 3072];
        float a0 = 0.f, a1 = 0.f, a2 = 0.f, a3 = 0.f, a4 = 0.f;
#pragma unroll
        for (int k = 0; k < 32; ++k) { const float w = wv[k]; a0 += lds[k0 + k] * w; a1 += lds[1024 + k0 + k] * w; a2 += lds[2048 + k0 + k] * w; a3 += lds[3072 + k0 + k] * w; a4 += lds[4096 + k0 + k] * w; }
        const float bv = kc == 0 ? p.b_mod[li * 3072 + j] : 0.f;
        float* o = MOD + (size_t)li * 5 * 3072 + j;
        atomicAdd(o, a0 + bv); atomicAdd(o + 3072, a1 + bv); atomicAdd(o + 2 * 3072, a2 + bv); atomicAdd(o + 3 * 3072, a3 + bv); atomicAdd(o + 4 * 3072, a4 + bv);
    }
    __syncthreads();
}

__device__ __forceinline__ void wt_item(const float* src, int ldw, bf16_t* dst, int K, int k0, __attribute__((address_space(3))) float* scr, int lane) {
    typedef unsigned v4u __attribute__((ext_vector_type(4)));
    if (src) {
#pragma unroll 8
        for (int i = 0; i < 32; ++i) { const int kk = 2 * i + (lane >> 5); scr[kk * 33 + (lane & 31)] = src[(size_t)(k0 + kk) * ldw + (lane & 31)]; }
    }
    asm volatile("s_waitcnt lgkmcnt(0)" ::: "memory");
    const int cch = lane & 7;
#pragma unroll
    for (int j = 0; j < 4; ++j) { const int n = (lane >> 3) + 8 * j; const __attribute__((address_space(3))) float* sp = scr + (8 * cch) * 33 + n;
        v4u o = {0u, 0u, 0u, 0u};
        if (src) { o.x = pk2(sp[0 * 33], sp[1 * 33]); o.y = pk2(sp[2 * 33], sp[3 * 33]); o.z = pk2(sp[4 * 33], sp[5 * 33]); o.w = pk2(sp[6 * 33], sp[7 * 33]); }
        *(v4u*)(dst + (size_t)n * K + k0 + 8 * cch) = o; }
    asm volatile("s_waitcnt lgkmcnt(0)" ::: "memory");
}
__device__ void st_wprep(const Params& p, int vb, int nvb, unsigned char* lds_) {
    bf16_t* Bt1 = (bf16_t*)(p.ws + WS_BT1); bf16_t* Bt2 = (bf16_t*)(p.ws + WS_BT2); bf16_t* Bt3 = (bf16_t*)(p.ws + WS_BT3); bf16_t* Bt4 = (bf16_t*)(p.ws + WS_BT4);
    bf16_t* BD = (bf16_t*)(p.ws + WS_BD);
    const int lane = threadIdx.x & 63, wv = threadIdx.x >> 6, gw = vb * (NTHREADS / 64) + wv, ngw = nvb * (NTHREADS / 64);
    __attribute__((address_space(3))) float* scr = (__attribute__((address_space(3))) float*)lds_ + 8192 + wv * (64 * 33);
    constexpr int I1 = 16 * (N1 / 32), I2 = 32 * 32, I3 = 16 * 128, I4 = 32 * 32, I5 = 64 * 8;
    for (int it = gw; it < I1 + I2 + I3 + I4 + I5; it += ngw) {
        int r = it;
        if (r < I1) { const int nbk = N1 / 32, kb = r / nbk, nb = r % nbk; const int sc = colmap1(nb * 32); wt_item(sc < 0 ? nullptr : p.e_w_in + sc, EVEN_IN, Bt1 + (size_t)nb * 32 * 1024, 1024, kb * 64, scr, lane); continue; } r -= I1;
        if (r < I2) { const int kb = r / 32, nb = r % 32; wt_item(p.e_w_out + nb * 32, 1024, Bt2 + (size_t)nb * 32 * 2048, 2048, kb * 64, scr, lane); continue; } r -= I2;
        if (r < I3) { const int kb = r / 128, nb = r % 128; wt_item(p.o_w_in + nb * 32, 4096, Bt3 + (size_t)nb * 32 * 1024, 1024, kb * 64, scr, lane); continue; } r -= I3;
        if (r < I4) { const int kb = r / 32, nb = r % 32; wt_item(p.o_w_out + nb * 32, 1024, Bt4 + (size_t)nb * 32 * 2048, 2048, kb * 64, scr, lane); continue; } r -= I4;
        { const int m = r >> 8, dn = (r >> 3) & 31, kb = (r >> 2) & 1, nb = r & 3; const float* W = (m == 0 ? p.o_w_a : p.o_w_x) + (size_t)dn * 16384;
          wt_item(W + nb * 32, 128, BD + (size_t)m * 2 * 16 * 16384 + (size_t)dn * 16384 + (size_t)nb * 32 * 128, 128, kb * 64, scr, lane); }
    }
}

__device__ void st_modulate(const Params& p, int vb, int nvb, int li, const float* xlat, const float* xctx, bf16_t* H) {
    const float* MOD = (const float*)(p.ws + WS_MOD) + (size_t)li * 5 * 3072;
    const float* g = p.norm_g + li * 1024;
    const int lane = threadIdx.x & 63, gw = vb * (NTHREADS / 64) + (threadIdx.x >> 6), ngw = nvb * (NTHREADS / 64);
    for (int row = gw; row < NT; row += ngw) {
        const float* xr = row < NLAT ? xlat + (size_t)row * 1024 : xctx + (size_t)(row - NLAT) * 1024;
        const float* md = MOD + (size_t)mod_idx(row) * 3072;
        float4 v[4]; float ss = 0.f;
#pragma unroll
        for (int j = 0; j < 4; ++j) { v[j] = *(const float4*)(xr + j * 256 + lane * 4); ss += v[j].x * v[j].x + v[j].y * v[j].y + v[j].z * v[j].z + v[j].w * v[j].w; }
        const float rinv = rsqrtf(wave_sum(ss) * (1.f / 1024.f) + EPS);
#pragma unroll
        for (int j = 0; j < 4; ++j) { const int c0 = j * 256 + lane * 4; const float4 gg = *(const float4*)(g + c0), sh = *(const float4*)(md + c0), sc = *(const float4*)(md + 1024 + c0);
            ushort4 o; o.x = f2bf(v[j].x * rinv * gg.x * (1.f + sc.x) + sh.x); o.y = f2bf(v[j].y * rinv * gg.y * (1.f + sc.y) + sh.y);
            o.z = f2bf(v[j].z * rinv * gg.z * (1.f + sc.z) + sh.z); o.w = f2bf(v[j].w * rinv * gg.w * (1.f + sc.w) + sh.w);
            *(ushort4*)(H + (size_t)row * 1024 + c0) = o; }
    }
}

template <class Epi>
__device__ void st_gemm_naive(int vb, int nvb, float* lds, const bf16_t* A, const bf16_t* Bt, int mt0, int mt1, int nt0, int nt1, int K, const Epi& E) {
    float* As = lds;
    float* Bs = lds + 32 * 33;
    const int tid = threadIdx.x, tx = tid & 63, ty = tid >> 6;
    const int nmt = mt1 - mt0, nnt = nt1 - nt0;
    for (int it = vb; it < nmt * nnt; it += nvb) {
        const int m0 = (mt0 + it / nnt) * 32, n0 = (nt0 + it % nnt) * 256;
        float acc[4][4];
#pragma unroll
        for (int i = 0; i < 4; ++i)
#pragma unroll
            for (int j = 0; j < 4; ++j) acc[i][j] = 0.f;
        for (int k0 = 0; k0 < K; k0 += 32) {
            __syncthreads();
            for (int e = tid; e < 32 * 32; e += NTHREADS) { const int r = e >> 5, kk = e & 31; As[r * 33 + kk] = bf2f(A[(size_t)(m0 + r) * K + k0 + kk]); }
            for (int e = tid; e < 256 * 32; e += NTHREADS) { const int r = e >> 5, kk = e & 31; Bs[r * 33 + kk] = bf2f(Bt[(size_t)(n0 + r) * K + k0 + kk]); }
            __syncthreads();
#pragma unroll 8
            for (int kk = 0; kk < 32; ++kk) {
                float a[4], b[4];
#pragma unroll
                for (int i = 0; i < 4; ++i) a[i] = As[(ty * 4 + i) * 33 + kk];
#pragma unroll
                for (int j = 0; j < 4; ++j) b[j] = Bs[(tx + 64 * j) * 33 + kk];
#pragma unroll
                for (int i = 0; i < 4; ++i)
#pragma unroll
                    for (int j = 0; j < 4; ++j) acc[i][j] += a[i] * b[j];
            }
        }
#pragma unroll
        for (int i = 0; i < 4; ++i) E(m0 + ty * 4 + i, n0, tx, acc[i]);
    }
    __syncthreads();
}

struct Epi1 {
    bf16_t *QK, *V, *SGA, *Z, *CBG; float* ALR;
    DEVI void operator()(int row, int n0, int cl, const float (&v)[4]) const {
        const int t = n0 >> 8;
        if (t < 4) { for (int j = 0; j < 4; ++j) QK[(size_t)row * 1024 + n0 + cl + 64 * j] = f2bf(v[j]); }
        else if (t < 8) { for (int j = 0; j < 4; ++j) V[(size_t)row * 1024 + (n0 - 1024) + cl + 64 * j] = f2bf(v[j]); }
        else if (t < 12) { for (int j = 0; j < 4; ++j) SGA[(size_t)row * 1024 + (n0 - 2048) + cl + 64 * j] = f2bf(siluf_(v[j])); }
        else if (t == 12) { if (cl < 32) ALR[(size_t)row * 32 + cl] = v[0]; }
        else if (t < 21) { const int jt = t - 13; Z[(size_t)row * 1024 + 128 * jt + cl] = f2bf(v[0] * v[2]); Z[(size_t)row * 1024 + 128 * jt + cl + 64] = f2bf(v[1] * v[3]); }
        else { const int jt = t - 21; CBG[(size_t)row * 1024 + 128 * jt + cl] = f2bf(v[0] * siluf_(v[2])); CBG[(size_t)row * 1024 + 128 * jt + cl + 64] = f2bf(v[1] * siluf_(v[3])); }
    }
};
struct EpiRes {
    const float* xl; const float* xc; float* outl; float* outc; const float* MODl;
    DEVI void operator()(int row, int n0, int cl, const float (&v)[4]) const {
        const float* gate = MODl + (size_t)mod_idx(row) * 3072 + 2048;
        for (int j = 0; j < 4; ++j) { const int col = n0 + cl + 64 * j;
            if (row < NLAT) outl[(size_t)row * 1024 + col] = xl[(size_t)row * 1024 + col] + gate[col] * v[j];
            else if (outc) outc[(size_t)(row - NLAT) * 1024 + col] = xc[(size_t)(row - NLAT) * 1024 + col] + gate[col] * v[j]; }
    }
};
struct Epi3 {
    bf16_t* XR; bf16_t* SG;
    DEVI void operator()(int row, int n0, int cl, const float (&v)[4]) const {
        for (int j = 0; j < 4; ++j) { const int col = n0 + cl + 64 * j;
            if (col < 2048) XR[(size_t)row * 2048 + col] = f2bf(v[j]); else if (row < NLAT) SG[(size_t)row * 2048 + col - 2048] = f2bf(siluf_(v[j])); }
    }
};

#define LASQ __attribute__((address_space(3)))
__device__ void st_glaprep(const Params& p, int vb, int nvb, unsigned char* ldsb, const bf16_t* QK, const bf16_t* V, const float* ALR, bf16_t* QIN, bf16_t* KET, bf16_t* SC, float* DEC, bf16_t* VT) {
    typedef unsigned u4 __attribute__((ext_vector_type(4))); typedef unsigned u2 __attribute__((ext_vector_type(2))); typedef float f4 __attribute__((ext_vector_type(4))); typedef short bx8 __attribute__((ext_vector_type(8)));
    LASQ unsigned char* lds = (LASQ unsigned char*)ldsb;
    constexpr int RQ = 0, RK = 17408, Q0 = 34816, K0 = 52224, VR = 69632, AL = VR + 33792, TT = AL + 8192;
    const int tid = threadIdx.x, kk = tid & 127, tq = tid >> 7, wv = tid >> 6, ln = tid & 63, cl = ln & 15, gq = ln >> 4;
    u4 r[9];
#define GP_LOAD(item) do { const int h_ = (item) & 3, bc_ = (item) >> 2, c_ = bc_ % NCH, bb_ = bc_ / NCH; const size_t row0_ = (size_t)row_of(bb_, c_, 0); \
        _Pragma("unroll") for (int j_ = 0; j_ < 2; ++j_) { const int p_ = tid + 512 * j_; r[j_] = *(const u4*)(QK + (row0_ + (p_ >> 4)) * 1024 + h_ * 128 + (p_ & 15) * 8); r[2 + j_] = *(const u4*)(QK + (row0_ + (p_ >> 4)) * 1024 + 512 + h_ * 128 + (p_ & 15) * 8); } \
        _Pragma("unroll") for (int j_ = 0; j_ < 4; ++j_) { const int p_ = tid + 512 * j_; r[4 + j_] = *(const u4*)(V + (row0_ + (p_ >> 5)) * 1024 + h_ * 256 + (p_ & 31) * 8); } \
        r[8] = *(const u4*)(ALR + (row0_ + (tid >> 3)) * 32 + (tid & 7) * 4); } while (0)
    const int NIT = NB * NCH * 4;
    if (vb < NIT) GP_LOAD(vb);
    for (int item = vb; item < NIT; item += nvb) {
        const int h = item & 3;
        __syncthreads();
#pragma unroll
        for (int j = 0; j < 2; ++j) { const int pp = tid + 512 * j; *(LASQ u4*)(lds + RQ + (pp >> 4) * 272 + (pp & 15) * 16) = r[j]; *(LASQ u4*)(lds + RK + (pp >> 4) * 272 + (pp & 15) * 16) = r[2 + j]; }
#pragma unroll
        for (int j = 0; j < 4; ++j) { const int pp = tid + 512 * j; *(LASQ u4*)(lds + VR + (pp >> 5) * 528 + (pp & 31) * 16) = r[4 + j]; }
        *(LASQ u4*)(lds + AL + (tid >> 3) * 128 + (tid & 7) * 16) = r[8];
        if (item + nvb < NIT) GP_LOAD(item + nvb);
        __syncthreads();
        unsigned short qr[16], kr[16];
#pragma unroll
        for (int i = 0; i < 16; ++i) { qr[i] = *(const LASQ unsigned short*)(lds + RQ + (tq * 16 + i) * 272 + kk * 2); kr[i] = *(const LASQ unsigned short*)(lds + RK + (tq * 16 + i) * 272 + kk * 2); }
        float bc[2][16];
#pragma unroll
        for (int d = 0; d < 2; ++d) {
            float w2[16];
#pragma unroll
            for (int rr = 0; rr < 16; ++rr) w2[rr] = p.e_w_a2[((size_t)d * 16 + rr) * 512 + h * 128 + kk];
            const float b2 = p.e_b_a2[d * 512 + h * 128 + kk];
#pragma unroll
            for (int i = 0; i < 16; ++i) { const LASQ f4* a = (const LASQ f4*)(lds + AL + (tq * 16 + i) * 128 + d * 64); const f4 a0 = a[0], a1 = a[1], a2 = a[2], a3 = a[3];
                float z = b2 + a0[0] * w2[0] + a0[1] * w2[1] + a0[2] * w2[2] + a0[3] * w2[3] + a1[0] * w2[4] + a1[1] * w2[5] + a1[2] * w2[6] + a1[3] * w2[7]
                        + a2[0] * w2[8] + a2[1] * w2[9] + a2[2] * w2[10] + a2[3] * w2[11] + a3[0] * w2[12] + a3[1] * w2[13] + a3[2] * w2[14] + a3[3] * w2[15];
                bc[d][i] = logsigmoidf_(z) * (1.f / 16.f); }
            float sacc = 0.f;
            if (d == 0) {
#pragma unroll
                for (int i = 0; i < 16; ++i) { sacc += bc[d][i]; bc[d][i] = sacc; } }
            else {
#pragma unroll
                for (int i = 15; i >= 0; --i) { sacc += bc[d][i]; bc[d][i] = sacc; } }
            *(LASQ float*)(lds + TT + ((d * 4 + tq) * 128 + kk) * 4) = sacc;
        }
        __syncthreads();
        const float scale = 0.08838834764831845f;
#pragma unroll
        for (int d = 0; d < 2; ++d) {
            const size_t u = (size_t)item * 2 + d;
            float off = 0.f, blast = 0.f;
#pragma unroll
            for (int q = 0; q < 4; ++q) { const float tv = *(const LASQ float*)(lds + TT + ((d * 4 + q) * 128 + kk) * 4); blast += tv; if (d == 0 ? (q < tq) : (q > tq)) off += tv; }
            LASQ unsigned char* qd = lds + (d == 0 ? Q0 : RQ); LASQ unsigned char* kd = lds + (d == 0 ? K0 : RK);
            unsigned ke[8];
#pragma unroll
            for (int i = 0; i < 16; ++i) { const int t = tq * 16 + i; const float bq = bc[d][i] + off;
                const float qv = bf2f(qr[i]) * scale, kv = bf2f(kr[i]);
                const float eb = fexp2_(1.4426950408889634f * bq);
                *(LASQ unsigned short*)(qd + t * 272 + kk * 2) = f2bf(qv * eb); *(LASQ unsigned short*)(kd + t * 272 + kk * 2) = f2bf(kv * frcp_(eb));
                const unsigned kev = f2bf(kv * fexp2_(1.4426950408889634f * (blast - bq)));
                if (i & 1) ke[i >> 1] |= kev << 16; else ke[i >> 1] = kev; }
            { u4 w0 = {ke[0], ke[1], ke[2], ke[3]}, w1 = {ke[4], ke[5], ke[6], ke[7]}; u4* dst = (u4*)(KET + (u * 128 + kk) * 64 + tq * 16); dst[0] = w0; dst[1] = w1; }
            if (tq == 0) DEC[u * 128 + kk] = fexp2_(1.4426950408889634f * blast);
        }
        __syncthreads();
#pragma unroll
        for (int d = 0; d < 2; ++d) {
            const size_t u = (size_t)item * 2 + d;
            const LASQ unsigned char* qd = lds + (d == 0 ? Q0 : RQ); const LASQ unsigned char* kd = lds + (d == 0 ? K0 : RK);
#pragma unroll
            for (int j = 0; j < 2; ++j) { const int pp = tid + 512 * j; *(u4*)(QIN + u * 8192 + (pp >> 4) * 128 + (pp & 15) * 8) = *(const LASQ u4*)(qd + (pp >> 4) * 272 + (pp & 15) * 16); }
            const int mt = wv >> 1;
#pragma unroll
            for (int nn = 0; nn < 2; ++nn) { const int nt = 2 * (wv & 1) + nn; f4 acc = {0.f, 0.f, 0.f, 0.f};
#pragma unroll
                for (int k4 = 0; k4 < 4; ++k4) { const bx8 kf = *(const LASQ bx8*)(kd + (16 * nt + cl) * 272 + (32 * k4 + 8 * gq) * 2), qf = *(const LASQ bx8*)(qd + (16 * mt + cl) * 272 + (32 * k4 + 8 * gq) * 2);
                    acc = __builtin_amdgcn_mfma_f32_16x16x32_bf16(kf, qf, acc, 0, 0, 0); }
                const int t = 16 * mt + cl, s0 = 16 * nt + 4 * gq; float v[4];
#pragma unroll
                for (int rr = 0; rr < 4; ++rr) { const int sx = s0 + rr; v[rr] = (d == 0 ? (sx <= t) : (sx >= t)) ? acc[rr] : 0.f; }
                u2 w; w.x = pk2(v[0], v[1]); w.y = pk2(v[2], v[3]); *(u2*)(SC + (u * 64 + t) * 64 + s0) = w; }
        }
        { const int vc = tid & 255, th = tid >> 8; unsigned vv[16];
#pragma unroll
          for (int i = 0; i < 32; ++i) { const unsigned x = *(const LASQ unsigned short*)(lds + VR + (32 * th + i) * 528 + vc * 2); if (i & 1) vv[i >> 1] |= x << 16; else vv[i >> 1] = x; }
          u4* dst = (u4*)(VT + ((size_t)item * 256 + vc) * 64 + 32 * th);
          dst[0] = (u4){vv[0], vv[1], vv[2], vv[3]}; dst[1] = (u4){vv[4], vv[5], vv[6], vv[7]}; dst[2] = (u4){vv[8], vv[9], vv[10], vv[11]}; dst[3] = (u4){vv[12], vv[13], vv[14], vv[15]}; }
    }
    __syncthreads();
#undef GP_LOAD
}

__device__ void st_glawalk_naive(const Params& p, int vb, int nvb, float* Sl, const bf16_t* QIN, const bf16_t* KET, const bf16_t* SC, const float* DEC, const bf16_t* VT, bf16_t* OF, bf16_t* OB) {
    const int vc = threadIdx.x & 255, half = threadIdx.x >> 8;
    for (int combo = vb; combo < 32; combo += nvb) {
        const int d = combo & 1, h = (combo >> 1) & 3, bb = combo >> 3;
        __syncthreads();
        for (int k = half * 64; k < half * 64 + 64; ++k) Sl[k * 256 + vc] = 0.f;
        __syncthreads();
        bf16_t* O = d == 0 ? OF : OB;
        for (int step = 0; step < NCH; ++step) {
            const int c = d == 0 ? (step < 4 ? 64 + step : step - 4) : 67 - step;
            const int u = ((bb * NCH + c) * 4 + h) * 2 + d;
            const bf16_t* q = QIN + (size_t)u * 64 * 128; const bf16_t* ke = KET + (size_t)u * 128 * 64; const bf16_t* sc = SC + (size_t)u * 64 * 64;
            const bf16_t* vt = VT + (((size_t)(u >> 1)) * 256 + vc) * 64;
            float vv[64];
#pragma unroll
            for (int t = 0; t < 64; ++t) vv[t] = bf2f(vt[t]);
            const int row0 = row_of(bb, c, 0);
            for (int t = half * 32; t < half * 32 + 32; ++t) { float a = 0.f;
                for (int k = 0; k < 128; ++k) a += bf2f(q[t * 128 + k]) * bf2f(f2bf(Sl[k * 256 + vc]));
#pragma unroll
                for (int s = 0; s < 64; ++s) a += bf2f(sc[t * 64 + s]) * vv[s];
                O[(size_t)(row0 + t) * 1024 + h * 256 + vc] = f2bf(a); }
            __syncthreads();
            for (int k = half * 64; k < half * 64 + 64; ++k) { float a = DEC[(size_t)u * 128 + k] * Sl[k * 256 + vc];
#pragma unroll
                for (int t = 0; t < 64; ++t) a += bf2f(ke[k * 64 + t]) * vv[t];
                Sl[k * 256 + vc] = a; }
            __syncthreads();
        }
    }
}

__device__ void st_inner(const Params& p, int vb, int nvb, const bf16_t* OF, const bf16_t* OB, const bf16_t* SGA, const bf16_t* Z, const bf16_t* CBG, bf16_t* INNER) {
    const int lane = threadIdx.x & 63, gw = vb * (NTHREADS / 64) + (threadIdx.x >> 6), ngw = nvb * (NTHREADS / 64);
    for (int row = gw; row < NT; row += ngw) {
        bool hasp, hasn;
        if (row < NLAT) { const int t = row & 63; hasp = t != 0; hasn = t != 63; } else { const int t = (row - NLAT) & 255; hasp = t != 0; hasn = t != 255; }
#pragma unroll
        for (int h = 0; h < 4; ++h) {
            const int c0 = h * 256 + lane * 4;
            const ushort4 a = *(const ushort4*)(OF + (size_t)row * 1024 + c0), b = *(const ushort4*)(OB + (size_t)row * 1024 + c0);
            const float o0 = bf2f(a.x) + bf2f(b.x), o1 = bf2f(a.y) + bf2f(b.y), o2 = bf2f(a.z) + bf2f(b.z), o3 = bf2f(a.w) + bf2f(b.w);
            const float rinv = rsqrtf(wave_sum(o0 * o0 + o1 * o1 + o2 * o2 + o3 * o3) * (1.f / 256.f) + EPS);
            const float4 gg = *(const float4*)(p.e_gla_g + lane * 4);
            const ushort4 sg = *(const ushort4*)(SGA + (size_t)row * 1024 + c0);
            ushort4 o; o.x = f2bf(o0 * rinv * gg.x * bf2f(sg.x)); o.y = f2bf(o1 * rinv * gg.y * bf2f(sg.y)); o.z = f2bf(o2 * rinv * gg.z * bf2f(sg.z)); o.w = f2bf(o3 * rinv * gg.w * bf2f(sg.w));
            *(ushort4*)(INNER + (size_t)row * 2048 + c0) = o;
            const ushort4 zc = *(const ushort4*)(Z + (size_t)row * 1024 + c0);
            ushort4 zp = {0, 0, 0, 0}, zn = {0, 0, 0, 0};
            if (hasp) zp = *(const ushort4*)(Z + (size_t)(row - 1) * 1024 + c0);
            if (hasn) zn = *(const ushort4*)(Z + (size_t)(row + 1) * 1024 + c0);
            const float4 w0 = *(const float4*)(p.e_conv_w + c0), w1 = *(const float4*)(p.e_conv_w + 1024 + c0), w2 = *(const float4*)(p.e_conv_w + 2048 + c0);
            const ushort4 cb = *(const ushort4*)(CBG + (size_t)row * 1024 + c0);
            ushort4 y; y.x = f2bf(bf2f(cb.x) * (w0.x * bf2f(zp.x) + w1.x * bf2f(zc.x) + w2.x * bf2f(zn.x)));
            y.y = f2bf(bf2f(cb.y) * (w0.y * bf2f(zp.y) + w1.y * bf2f(zc.y) + w2.y * bf2f(zn.y)));
            y.z = f2bf(bf2f(cb.z) * (w0.z * bf2f(zp.z) + w1.z * bf2f(zc.z) + w2.z * bf2f(zn.z)));
            y.w = f2bf(bf2f(cb.w) * (w0.w * bf2f(zp.w) + w1.w * bf2f(zc.w) + w2.w * bf2f(zn.w)));
            *(ushort4*)(INNER + (size_t)row * 2048 + 1024 + c0) = y;
        }
    }
}

template <int MODE>
__device__ void st_rglru_naive(const Params& p, int vb, int nvb, float* lds, const bf16_t* XR, const bf16_t* SG, float* SUMA, float* SUMH, bf16_t* Y) {
    float* xc = lds;
    float* av = xc + 64 * 128;
    float* uv = av + 64 * 128;
    float* hf = uv + 64 * 128;
    const int tid = threadIdx.x, j = tid & 127, tq = tid >> 7;
    const int nitems = MODE == 0 ? NB * NCH * 16 * 2 : NB * 64 * 16;
    for (int it = vb; it < nitems; it += nvb) {
        int bb, c, nb;
        if (MODE == 0) { nb = (it >> 1) & 15; const int bc = it >> 5; c = bc % NCH; bb = bc / NCH; } else { nb = it & 15; const int bc = it >> 4; c = bc & 63; bb = bc >> 6; }
        const int row0 = row_of(bb, c, 0);
        const int seg0 = c < 64 ? bb * 4096 : NLAT + bb * 256, segn = c < 64 ? 4096 : 256;
        const int tl0 = row0 - seg0;
        for (int dd = 0; dd < (MODE == 0 ? 1 : 2); ++dd) {
            const int d = MODE == 0 ? (it & 1) : dd;
            __syncthreads();
            for (int e = tid; e < 64 * 128; e += NTHREADS) { const int t = e >> 7, i = e & 127, ch = nb * 128 + i; float a = p.o_conv_b[d * 2048 + ch];
#pragma unroll
                for (int jj = 0; jj < 4; ++jj) { const int tt = d == 0 ? tl0 + t - 3 + jj : tl0 + t + 3 - jj;
                    if (tt >= 0 && tt < segn) a += p.o_conv_w[((size_t)d * 4 + jj) * 2048 + ch] * bf2f(XR[(size_t)(seg0 + tt) * 2048 + ch]); }
                xc[e] = a; }
            __syncthreads();
            const float* WA = p.o_w_a + ((size_t)d * 16 + nb) * 128 * 128; const float* WX = p.o_w_x + ((size_t)d * 16 + nb) * 128 * 128;
            const int ch = nb * 128 + j;
            const float ba = p.o_b_a[d * 2048 + ch], bx = p.o_b_x[d * 2048 + ch], sp = softplusf_(-p.o_lam[d * 2048 + ch]);
            for (int i16 = 0; i16 < 16; ++i16) { const int t = tq * 16 + i16; float ra = ba, rx = bx;
                for (int i = 0; i < 128; ++i) { const float xv = bf2f(f2bf(xc[t * 128 + i])); ra += xv * bf2f(f2bf(WA[i * 128 + j])); rx += xv * bf2f(f2bf(WX[i * 128 + j])); }
                const float r = sigmoidf_(ra), ig = sigmoidf_(rx); const float la = -8.f * r * sp; const float a = __expf(la);
                av[t * 128 + j] = a; uv[t * 128 + j] = sqrtf(-expm1f(2.f * la)) * (ig * xc[t * 128 + j]); }
            __syncthreads();
            if (tid < 128) {
                const size_t sidx = (((size_t)bb * 2 + d) * NCH + c) * 2048 + ch;
                if (MODE == 0) { float A = 1.f, hh = 0.f;
                    if (d == 0) for (int t = 0; t < 64; ++t) { const float a = av[t * 128 + j]; hh = a * hh + uv[t * 128 + j]; A *= a; }
                    else for (int t = 63; t >= 0; --t) { const float a = av[t * 128 + j]; hh = a * hh + uv[t * 128 + j]; A *= a; }
                    SUMA[sidx] = A; SUMH[sidx] = hh;
                } else { float hh = SUMH[sidx];
                    if (d == 0) for (int t = 0; t < 64; ++t) { hh = av[t * 128 + j] * hh + uv[t * 128 + j]; hf[t * 128 + j] = hh; }
                    else for (int t = 63; t >= 0; --t) { hh = av[t * 128 + j] * hh + uv[t * 128 + j]; const size_t o = (size_t)(row0 + t) * 2048 + ch; Y[o] = f2bf((hf[t * 128 + j] + hh) * bf2f(SG[o])); }
                }
            }
        }
    }
    __syncthreads();
}
__device__ void st_carry(const Params& p, int vb, int nvb, const float* SUMA, float* SUMH) {
    for (int e = vb * NTHREADS + threadIdx.x; e < NB * 2 * 2048; e += nvb * NTHREADS) {
        const int ch = e & 2047, d = (e >> 11) & 1, bb = e >> 12; float hh = 0.f;
        for (int s0 = 0; s0 < NCH; s0 += 17) {
            float A[17], H[17];
#pragma unroll
            for (int i = 0; i < 17; ++i) { const int step = s0 + i, c = d == 0 ? (step < 4 ? 64 + step : step - 4) : 67 - step; const size_t sidx = (((size_t)bb * 2 + d) * NCH + c) * 2048 + ch; A[i] = SUMA[sidx]; H[i] = SUMH[sidx]; }
#pragma unroll
            for (int i = 0; i < 17; ++i) { const int step = s0 + i, c = d == 0 ? (step < 4 ? 64 + step : step - 4) : 67 - step; const size_t sidx = (((size_t)bb * 2 + d) * NCH + c) * 2048 + ch; SUMH[sidx] = hh; hh = A[i] * hh + H[i]; }
        }
    }
}
__device__ void st_final(const Params& p, int vb, int nvb) {
    const int lane = threadIdx.x & 63, gw = vb * (NTHREADS / 64) + (threadIdx.x >> 6), ngw = nvb * (NTHREADS / 64);
    for (int row = gw; row < NLAT; row += ngw) { float* xr = p.out + (size_t)row * 1024; float4 v[4]; float ss = 0.f;
#pragma unroll
        for (int j = 0; j < 4; ++j) { v[j] = *(const float4*)(xr + j * 256 + lane * 4); ss += v[j].x * v[j].x + v[j].y * v[j].y + v[j].z * v[j].z + v[j].w * v[j].w; }
        const float rinv = rsqrtf(wave_sum(ss) * (1.f / 1024.f) + EPS);
#pragma unroll
        for (int j = 0; j < 4; ++j) { const float4 g = *(const float4*)(p.final_g + j * 256 + lane * 4); float4 o; o.x = v[j].x * rinv * g.x; o.y = v[j].y * rinv * g.y; o.z = v[j].z * rinv * g.z; o.w = v[j].w * rinv * g.w; *(float4*)(xr + j * 256 + lane * 4) = o; }
    }
}


namespace pg8 {
#define PG8_LAS __attribute__((address_space(3)))
typedef short bf16x8 __attribute__((ext_vector_type(8)));
typedef float f32x4 __attribute__((ext_vector_type(4)));
typedef unsigned u32x4 __attribute__((ext_vector_type(4)));
constexpr int BM = 256, BK = 64, HALF = 128, HTB = HALF * BK * 2, STAGE_BYTES = 8 * HTB, NXCD = 8, WGM = 8;
__host__ __device__ __forceinline__ int lds_byte(int r, int c) { const int st = (r >> 4) * 2 + (c >> 5), rr = r & 15, cc = c & 31, ob = rr * 64 + cc * 2; return st * 1024 + (ob ^ (((ob >> 9) & 1) << 5)); }
__host__ __device__ __forceinline__ void stage_rc(int b, int& R, int& C) { const int st = b / 1024, sb = b % 1024, swz = sb ^ (((sb >> 9) & 1) << 5); R = (st >> 1) * 16 + swz / 64; C = (st & 1) * 32 + (swz % 64) / 2; }
__host__ __device__ __forceinline__ int perm32(int rho) { const int n = rho >> 4, i = rho & 15; return 8 * (i >> 2) + 4 * n + (i & 3); }
struct Unit { int pm, pn; };
struct Gemm { const bf16_t* A; const bf16_t* Bt; int M, N, K; };
struct TileOrder {
    int nM, nN, nwg, G, c, m0, split, base0, base1, nM2, nN2, m02;
    __device__ void init(int nM_, int nN_, int G_, int c_, int m0_ = 0, int split_ = 1 << 30, int base0_ = 0, int base1_ = 0, int nM2_ = 0, int nN2_ = 0, int m02_ = 0) {
        nM = nM_; nN = nN_; nwg = nM * nN; G = G_; c = c_; m0 = m0_; split = split_; base0 = base0_; base1 = base1_; nM2 = nM2_; nN2 = nN2_; m02 = m02_; }
    __device__ bool next(int i, Unit& u) const {
        const long L = (long)i * G + c;
        if (L >= nwg) { const long L2 = L - nwg; if (L2 >= (long)nM2 * nN2) return false; u.pm = m02 + (int)(L2 / nN2); u.pn = (int)(L2 % nN2); return true; }
        int wgid = (int)L; { const int q = nwg / NXCD, r = nwg % NXCD, xcd = wgid % NXCD, off = wgid / NXCD; wgid = (xcd < r ? xcd * (q + 1) : r * (q + 1) + (xcd - r) * q) + off; }
        const int nig = WGM * nN, gid = wgid / nig, fm = gid * WGM, gsz = (nM - fm) < WGM ? (nM - fm) : WGM;
        const int pm = fm + ((wgid % nig) % gsz), j = (wgid % nig) / gsz;
        u.pm = m0 + pm; u.pn = j < split ? base0 + j : base1 + (j - split); return true;
    }
    __device__ __forceinline__ void a_ready(const Unit&) const {}
    __device__ __forceinline__ void done(const Unit&) const {}
};
typedef float f32x2_t __attribute__((ext_vector_type(2))); typedef __bf16 bf16x2_t __attribute__((ext_vector_type(2)));
__device__ __forceinline__ unsigned cvt_pk_bf16(float lo, float hi) { f32x2_t v = {lo, hi}; bf16x2_t b = __builtin_convertvector(v, bf16x2_t); return __builtin_bit_cast(unsigned, b); }
template <class Epi, class Sched, bool ALIGN_EPI = false, bool SP2 = false>
__device__ __forceinline__ void gemm_phase(PG8_LAS unsigned char* lds, const Gemm g, const Sched& S, const Epi& E) {
    const int tid = threadIdx.x, wid = __builtin_amdgcn_readfirstlane(tid >> 6), lane = tid & 63, wr = wid >> 2, wc = wid & 3, fr = lane & 15, fq = lane >> 4;
    const int K = g.K, nt = K / BK;
    unsigned voffA[2], voffB[2];
#pragma unroll
    for (int i = 0; i < 2; ++i) { int R, C; stage_rc(tid * 16 + i * 8192, R, C); const int Rb = Epi::PERM ? ((R & ~31) + perm32(R & 31)) : R;
        voffA[i] = (unsigned)(R * K + C) * 2u; voffB[i] = (unsigned)(Rb * K + C) * 2u; }
    const size_t kstep = (size_t)(BK * 2);
    const size_t hstep = (size_t)HALF * K * 2;
    const size_t tstep = 2 * hstep;
    const unsigned ldsw = (unsigned)wid * 1024u;
    const int aoff = lds_byte(wr * 64 + fr, fq * 8), boff = lds_byte(wc * 32 + fr, fq * 8);
#define PG8_SA(b, h) (((b) * 2 + (h)) * HTB)
#define PG8_SB(b, h) ((4 + (b) * 2 + (h)) * HTB)
#define PG8_STAGE(bufoff, gbase, voff) do { _Pragma("unroll") for (int _i = 0; _i < 2; ++_i) \
        __builtin_amdgcn_global_load_lds((const unsigned*)((const char*)(gbase) + (voff)[_i]), (PG8_LAS unsigned*)(lds + (bufoff) + ldsw + _i * 8192), 16, 0, 0); } while (0)
#define PG8_LDA(dst, b, h) do { _Pragma("unroll") for (int m = 0; m < 4; ++m) _Pragma("unroll") for (int k = 0; k < 2; ++k) dst[m][k] = *(const PG8_LAS bf16x8*)(lds + PG8_SA(b, h) + aoff + m * 2048 + k * 1024); } while (0)
#define PG8_LDB(dst, b, h) do { _Pragma("unroll") for (int n = 0; n < 2; ++n) _Pragma("unroll") for (int k = 0; k < 2; ++k) dst[n][k] = *(const PG8_LAS bf16x8*)(lds + PG8_SB(b, h) + boff + n * 2048 + k * 1024); } while (0)
#define PG8_MMA(ai, bj, At, Bt) do { __builtin_amdgcn_s_setprio(1); _Pragma("unroll") for (int m = 0; m < 4; ++m) _Pragma("unroll") for (int n = 0; n < 2; ++n) _Pragma("unroll") for (int k = 0; k < 2; ++k) \
        acc[ai][bj][m][n] = __builtin_amdgcn_mfma_f32_16x16x32_bf16(Bt[n][k], At[m][k], acc[ai][bj][m][n], 0, 0, 0); __builtin_amdgcn_s_setprio(0); } while (0)
#define PG8_WAIT_V(n) asm volatile("s_waitcnt vmcnt(" #n ")" ::: "memory")
#define PG8_WAIT_L(n) asm volatile("s_waitcnt lgkmcnt(" #n ")" ::: "memory")
#define PG8_BAR __builtin_amdgcn_s_barrier()
#define PG8_SCHED __builtin_amdgcn_sched_barrier(0)
    Unit cur, nxt; int ui = 0;
    if (!S.next(0, cur)) return;
    f32x4 acc[2][2][4][2];
#pragma unroll
    for (int a = 0; a < 2; ++a)
#pragma unroll
        for (int b = 0; b < 2; ++b)
#pragma unroll
            for (int m = 0; m < 4; ++m)
#pragma unroll
                for (int n = 0; n < 2; ++n) acc[a][b][m][n] = (f32x4){0.f, 0.f, 0.f, 0.f};
    bf16x8 At[4][2], B0[2][2], B1[2][2];
    const char* cA = (const char*)g.A + (size_t)cur.pm * tstep; const char* cB = (const char*)g.Bt + (size_t)cur.pn * tstep;
    S.a_ready(cur);
    if constexpr (SP2) {
        PG8_STAGE(PG8_SB(0, 0), cB, voffB); PG8_STAGE(PG8_SB(0, 1), cB + hstep, voffB); PG8_STAGE(PG8_SA(0, 0), cA, voffA); PG8_STAGE(PG8_SA(0, 1), cA + hstep, voffA);
        if (wr == 1) PG8_BAR;
        PG8_WAIT_V(2); PG8_BAR;
        PG8_STAGE(PG8_SB(1, 0), cB + kstep, voffB); PG8_STAGE(PG8_SA(1, 0), cA + kstep, voffA); PG8_STAGE(PG8_SB(1, 1), cB + hstep + kstep, voffB);
        PG8_WAIT_V(6); PG8_BAR;
    } else {
        PG8_STAGE(PG8_SB(0, 0), cB, voffB); PG8_STAGE(PG8_SA(0, 0), cA, voffA); PG8_STAGE(PG8_SB(0, 1), cB + hstep, voffB); PG8_STAGE(PG8_SA(0, 1), cA + hstep, voffA);
        if (wr == 1) PG8_BAR;
        PG8_WAIT_V(4); PG8_BAR;
        PG8_STAGE(PG8_SB(1, 0), cB + kstep, voffB); PG8_STAGE(PG8_SA(1, 0), cA + kstep, voffA); PG8_STAGE(PG8_SB(1, 1), cB + hstep + kstep, voffB);
        PG8_WAIT_V(6); PG8_BAR;
    }
    for (;;) {
        const bool has_next = S.next(ui + 1, nxt);
        const char* nA = has_next ? (const char*)g.A + (size_t)nxt.pm * tstep : cA; const char* nB = has_next ? (const char*)g.Bt + (size_t)nxt.pn * tstep : cB;
        for (int t = 0; t < nt; t += 2) {
            const bool last = (t == nt - 2);
            const char* a1 = cA + (size_t)(t + 1) * kstep;
            const char* a2 = last ? nA : cA + (size_t)(t + 2) * kstep; const char* b2 = last ? nB : cB + (size_t)(t + 2) * kstep;
            const char* a3 = a2 + kstep; const char* b3 = b2 + kstep;
            if (last && has_next) S.a_ready(nxt);
            if constexpr (SP2) {
            PG8_LDB(B0, 0, 0); PG8_LDB(B1, 0, 1); PG8_SCHED; PG8_LDA(At, 0, 0); PG8_STAGE(PG8_SA(1, 1), a1 + hstep, voffA);
            PG8_WAIT_V(8); PG8_WAIT_L(0); PG8_BAR; PG8_MMA(0, 0, At, B0); PG8_MMA(0, 1, At, B1); PG8_BAR; PG8_SCHED;
            PG8_LDA(At, 0, 1); PG8_STAGE(PG8_SB(0, 0), b2, voffB); PG8_STAGE(PG8_SB(0, 1), b2 + hstep, voffB); PG8_STAGE(PG8_SA(0, 0), a2, voffA);
            PG8_WAIT_V(8); PG8_WAIT_L(0); PG8_BAR; PG8_MMA(1, 0, At, B0); PG8_MMA(1, 1, At, B1); PG8_BAR; PG8_SCHED;
            PG8_LDB(B0, 1, 0); PG8_LDB(B1, 1, 1); PG8_SCHED; PG8_LDA(At, 1, 0); PG8_STAGE(PG8_SA(0, 1), a2 + hstep, voffA);
            PG8_WAIT_V(8); PG8_WAIT_L(0); PG8_BAR; PG8_MMA(0, 0, At, B0); PG8_MMA(0, 1, At, B1); PG8_BAR; PG8_SCHED;
            PG8_LDA(At, 1, 1); PG8_STAGE(PG8_SB(1, 0), b3, voffB); PG8_STAGE(PG8_SB(1, 1), b3 + hstep, voffB); PG8_STAGE(PG8_SA(1, 0), a3, voffA);
            PG8_WAIT_V(8); PG8_WAIT_L(0); PG8_BAR; PG8_MMA(1, 0, At, B0); PG8_MMA(1, 1, At, B1); PG8_BAR; PG8_SCHED;
            } else {
            PG8_LDB(B0, 0, 0); PG8_SCHED; PG8_LDA(At, 0, 0); PG8_STAGE(PG8_SA(1, 1), a1 + hstep, voffA);
            PG8_WAIT_L(8); PG8_BAR; PG8_WAIT_L(0); PG8_MMA(0, 0, At, B0); PG8_BAR; PG8_SCHED;
            PG8_LDB(B1, 0, 1); PG8_STAGE(PG8_SB(0, 0), b2, voffB);
            PG8_BAR; PG8_WAIT_L(0); PG8_MMA(0, 1, At, B1); PG8_BAR;
            PG8_LDA(At, 0, 1); PG8_STAGE(PG8_SA(0, 0), a2, voffA);
            PG8_BAR; PG8_WAIT_L(0); PG8_MMA(1, 0, At, B0); PG8_BAR; PG8_SCHED;
            PG8_STAGE(PG8_SB(0, 1), b2 + hstep, voffB);
            PG8_WAIT_V(6); PG8_BAR; PG8_MMA(1, 1, At, B1); PG8_BAR;
            PG8_LDB(B0, 1, 0); PG8_SCHED; PG8_LDA(At, 1, 0); PG8_STAGE(PG8_SA(0, 1), a2 + hstep, voffA);
            PG8_WAIT_L(8); PG8_BAR; PG8_WAIT_L(0); PG8_MMA(0, 0, At, B0); PG8_BAR; PG8_SCHED;
            PG8_LDB(B1, 1, 1); PG8_STAGE(PG8_SB(1, 0), b3, voffB);
            PG8_BAR; PG8_WAIT_L(0); PG8_MMA(0, 1, At, B1); PG8_BAR;
            PG8_LDA(At, 1, 1); PG8_STAGE(PG8_SA(1, 0), a3, voffA);
            PG8_BAR; PG8_WAIT_L(0); PG8_MMA(1, 0, At, B0); PG8_BAR; PG8_SCHED;
            PG8_STAGE(PG8_SB(1, 1), b3 + hstep, voffB);
            PG8_WAIT_V(6); PG8_BAR; PG8_MMA(1, 1, At, B1); PG8_BAR;
            }
        }
        if constexpr (ALIGN_EPI) { if (wr == 0) PG8_BAR; }
        if constexpr (!Epi::AFTER_DRAIN) { E(acc, cur, wr, wc, fr, fq); S.done(cur); }
        if (!has_next) break;
#pragma unroll
        for (int a = 0; a < 2; ++a)
#pragma unroll
            for (int b = 0; b < 2; ++b)
#pragma unroll
                for (int m = 0; m < 4; ++m)
#pragma unroll
                    for (int n = 0; n < 2; ++n) acc[a][b][m][n] = (f32x4){0.f, 0.f, 0.f, 0.f};
        cur = nxt; cA = nA; cB = nB; ++ui;
        if constexpr (ALIGN_EPI) { if (wr == 1) PG8_BAR; }
    }
    PG8_WAIT_V(0);
    if constexpr (!ALIGN_EPI) { if (wr == 0) PG8_BAR; }
    PG8_BAR;
    if constexpr (Epi::AFTER_DRAIN) { E.fused(acc, cur, wr, wc, fr, fq, lds, wid, lane); S.done(cur); }
#undef PG8_SA
#undef PG8_SB
#undef PG8_STAGE
#undef PG8_LDA
#undef PG8_LDB
#undef PG8_MMA
#undef PG8_WAIT_V
#undef PG8_WAIT_L
#undef PG8_BAR
#undef PG8_SCHED
}
}

DEVI pg8::u32x4 pack8(const pg8::f32x4& a, const pg8::f32x4& b) { pg8::u32x4 w; w.x = pg8::cvt_pk_bf16(a[0], a[1]); w.y = pg8::cvt_pk_bf16(a[2], a[3]); w.z = pg8::cvt_pk_bf16(b[0], b[1]); w.w = pg8::cvt_pk_bf16(b[2], b[3]); return w; }
DEVI pg8::f32x4 silu4(const pg8::f32x4& a) { pg8::f32x4 r; r[0] = siluf_(a[0]); r[1] = siluf_(a[1]); r[2] = siluf_(a[2]); r[3] = siluf_(a[3]); return r; }
struct FEpi1 {
    static constexpr bool PERM = true, AFTER_DRAIN = false;
    bf16_t *QK, *V, *SGA, *Z, *CBG; float* ALR;
    DEVI void operator()(const pg8::f32x4 (&acc)[2][2][4][2], const pg8::Unit& u, int wr, int wc, int fr, int fq) const {
        const int t = u.pn, row0 = u.pm * 256 + wr * 64 + fr, cw = wc * 32 + 8 * fq;
#pragma unroll
        for (int ai = 0; ai < 2; ++ai)
#pragma unroll
            for (int m = 0; m < 4; ++m) {
                const size_t row = (size_t)(row0 + ai * 128 + m * 16);
                if (t < 12) {
                    bf16_t* base = t < 4 ? QK + row * 1024 + t * 256 : (t < 8 ? V + row * 1024 + (t - 4) * 256 : SGA + row * 1024 + (t - 8) * 256);
#pragma unroll
                    for (int bj = 0; bj < 2; ++bj) { pg8::f32x4 v0 = acc[ai][bj][m][0], v1 = acc[ai][bj][m][1]; if (t >= 8) { v0 = silu4(v0); v1 = silu4(v1); }
                        *(pg8::u32x4*)(base + bj * 128 + cw) = pack8(v0, v1); }
                } else if (t == 12) {
                    if (wc == 0) { *(pg8::f32x4*)(ALR + row * 32 + 8 * fq) = acc[ai][0][m][0]; *(pg8::f32x4*)(ALR + row * 32 + 8 * fq + 4) = acc[ai][0][m][1]; }
                } else if (t < 21) {
                    *(pg8::u32x4*)(Z + row * 1024 + (t - 13) * 128 + cw) = pack8(acc[ai][0][m][0] * acc[ai][1][m][0], acc[ai][0][m][1] * acc[ai][1][m][1]);
                } else {
                    *(pg8::u32x4*)(CBG + row * 1024 + (t - 21) * 128 + cw) = pack8(acc[ai][0][m][0] * silu4(acc[ai][1][m][0]), acc[ai][0][m][1] * silu4(acc[ai][1][m][1]));
                }
            }
    }
};
struct FEpiRes {
    static constexpr bool PERM = false, AFTER_DRAIN = false;
    const float* xl; const float* xc; float* outl; float* outc; const float* MODl;
    DEVI void operator()(const pg8::f32x4 (&acc)[2][2][4][2], const pg8::Unit& u, int wr, int wc, int fr, int fq) const {
        const int row0 = u.pm * 256 + wr * 64 + fr, col0 = u.pn * 256 + wc * 32 + 4 * fq;
        const bool lat = u.pm < NLAT / 256;
        const float* gate = MODl + (size_t)(lat ? (u.pm >> 4) : 4) * 3072 + 2048 + col0;
        pg8::f32x4 gv[2][2];
#pragma unroll
        for (int bj = 0; bj < 2; ++bj)
#pragma unroll
            for (int n = 0; n < 2; ++n) gv[bj][n] = *(const pg8::f32x4*)(gate + bj * 128 + n * 16);
        const float* xin = lat ? xl : xc - (size_t)NLAT * 1024; float* o = lat ? outl : outc - (size_t)NLAT * 1024;
#pragma unroll
        for (int ai = 0; ai < 2; ++ai)
#pragma unroll
            for (int m = 0; m < 4; ++m) { const size_t off = (size_t)(row0 + ai * 128 + m * 16) * 1024 + col0;
#pragma unroll
                for (int bj = 0; bj < 2; ++bj)
#pragma unroll
                    for (int n = 0; n < 2; ++n) { const pg8::f32x4 xv = *(const pg8::f32x4*)(xin + off + bj * 128 + n * 16); *(pg8::f32x4*)(o + off + bj * 128 + n * 16) = xv + gv[bj][n] * acc[ai][bj][m][n]; } }
    }
};
struct FEpi3 {
    static constexpr bool PERM = true, AFTER_DRAIN = false;
    bf16_t* XR; bf16_t* SG;
    DEVI void operator()(const pg8::f32x4 (&acc)[2][2][4][2], const pg8::Unit& u, int wr, int wc, int fr, int fq) const {
        const int t = u.pn, row0 = u.pm * 256 + wr * 64 + fr, cw = wc * 32 + 8 * fq;
        bf16_t* base = t < 8 ? XR + t * 256 : SG + (t - 8) * 256;
#pragma unroll
        for (int ai = 0; ai < 2; ++ai)
#pragma unroll
            for (int m = 0; m < 4; ++m) { bf16_t* rp = base + (size_t)(row0 + ai * 128 + m * 16) * 2048 + cw;
#pragma unroll
                for (int bj = 0; bj < 2; ++bj) { pg8::f32x4 v0 = acc[ai][bj][m][0], v1 = acc[ai][bj][m][1]; if (t >= 8) { v0 = silu4(v0); v1 = silu4(v1); }
                    *(pg8::u32x4*)(rp + bj * 128) = pack8(v0, v1); } }
    }
};
#ifndef FAST_GEMM
#define FAST_GEMM 1
#endif


#define LASP __attribute__((address_space(3)))
__device__ void st_glawalk(const Params& p, int vb, int nvb, unsigned char* lds_, const bf16_t* QIN, const bf16_t* KET, const bf16_t* SC, const float* DEC, const bf16_t* VT, bf16_t* OF, bf16_t* OB) {
    typedef pg8::bf16x8 bx8; typedef pg8::f32x4 f4; typedef unsigned u32x2 __attribute__((ext_vector_type(2)));
    LASP unsigned char* lds = (LASP unsigned char*)lds_;
    constexpr int QOFF = 0, KOFF = 17408, SOFF = KOFF + 18432, VOFF = SOFF + 9216, DOFF = VOFF + 4608, BUFSZ = 50176;
    const int tid = threadIdx.x, wid = __builtin_amdgcn_readfirstlane(tid >> 6), lane = tid & 63, c = lane & 15, g = lane >> 4;
    for (int item = vb; item < 256; item += nvb) {
        const int vs = item & 7, combo = item >> 3, d = combo & 1, h = (combo >> 1) & 3, bb = combo >> 3;
        int soff[6], doff[6];
        { const int p0 = tid, p1 = tid + 512; soff[0] = (p0 >> 4) * 256 + (p0 & 15) * 16; doff[0] = QOFF + (p0 >> 4) * 272 + (p0 & 15) * 16; soff[1] = (p1 >> 4) * 256 + (p1 & 15) * 16; doff[1] = QOFF + (p1 >> 4) * 272 + (p1 & 15) * 16;
          const int q2 = tid, q3 = tid + 512; soff[2] = (q2 >> 3) * 128 + (q2 & 7) * 16; doff[2] = KOFF + (q2 >> 3) * 144 + (q2 & 7) * 16; soff[3] = (q3 >> 3) * 128 + (q3 & 7) * 16; doff[3] = KOFF + (q3 >> 3) * 144 + (q3 & 7) * 16;
          soff[4] = (tid >> 3) * 128 + (tid & 7) * 16; doff[4] = SOFF + (tid >> 3) * 144 + (tid & 7) * 16;
          if (tid < 256) { soff[5] = (vs * 32 + (tid >> 3)) * 128 + (tid & 7) * 16; doff[5] = VOFF + (tid >> 3) * 144 + (tid & 7) * 16; } else { soff[5] = (tid - 256) * 16; doff[5] = DOFF + (tid - 256) * 16; } }
        const bool has5 = tid < 288;
        pg8::u32x4 r0[6], r1[6];
#define GW_LOAD(R, step) do { const int cc_ = d == 0 ? ((step) < 4 ? 64 + (step) : (step) - 4) : 67 - (step); const size_t u_ = (size_t)((bb * NCH + cc_) * 4 + h) * 2 + d; \
            const unsigned char* q_ = (const unsigned char*)QIN + u_ * 16384; const unsigned char* k_ = (const unsigned char*)KET + u_ * 16384; const unsigned char* s_ = (const unsigned char*)SC + u_ * 8192; \
            const unsigned char* x5_ = tid < 256 ? (const unsigned char*)VT + (u_ >> 1) * 32768 : (const unsigned char*)DEC + u_ * 512; \
            R[0] = *(const pg8::u32x4*)(q_ + soff[0]); R[1] = *(const pg8::u32x4*)(q_ + soff[1]); R[2] = *(const pg8::u32x4*)(k_ + soff[2]); R[3] = *(const pg8::u32x4*)(k_ + soff[3]); R[4] = *(const pg8::u32x4*)(s_ + soff[4]); \
            if (has5) R[5] = *(const pg8::u32x4*)(x5_ + soff[5]); } while (0)
#define GW_WRITE(R, bufi) do { LASP unsigned char* b_ = lds + (bufi) * BUFSZ; _Pragma("unroll") for (int j_ = 0; j_ < 5; ++j_) *(LASP pg8::u32x4*)(b_ + doff[j_]) = R[j_]; if (has5) *(LASP pg8::u32x4*)(b_ + doff[5]) = R[5]; } while (0)
#define GW_COMPUTE(step) do { if (wid < 2) { \
                const LASP unsigned char* B = lds + ((step) & 1) * BUFSZ; \
                const bx8 bv0 = *(const LASP bx8*)(B + VOFF + (16 * wid + c) * 144 + g * 16), bv1 = *(const LASP bx8*)(B + VOFF + (16 * wid + c) * 144 + 64 + g * 16); \
                bx8 sB[4]; \
                _Pragma("unroll") for (int ks = 0; ks < 4; ++ks) { pg8::u32x4 w; w.x = pg8::cvt_pk_bf16(S[2 * ks][0], S[2 * ks][1]); w.y = pg8::cvt_pk_bf16(S[2 * ks][2], S[2 * ks][3]); \
                    w.z = pg8::cvt_pk_bf16(S[2 * ks + 1][0], S[2 * ks + 1][1]); w.w = pg8::cvt_pk_bf16(S[2 * ks + 1][2], S[2 * ks + 1][3]); sB[ks] = __builtin_bit_cast(bx8, w); } \
                f4 o[4]; \
                _Pragma("unroll") for (int mt = 0; mt < 4; ++mt) o[mt] = (f4){0.f, 0.f, 0.f, 0.f}; \
                _Pragma("unroll") for (int ks = 0; ks < 4; ++ks) \
                    _Pragma("unroll") for (int mt = 0; mt < 4; ++mt) { const LASP unsigned char* qa = B + QOFF + (16 * mt + c) * 272 + (32 * ks + 4 * g) * 2; \
                        const u32x2 lo = *(const LASP u32x2*)qa, hi = *(const LASP u32x2*)(qa + 32); pg8::u32x4 w; w.x = lo.x; w.y = lo.y; w.z = hi.x; w.w = hi.y; \
                        o[mt] = __builtin_amdgcn_mfma_f32_16x16x32_bf16(sB[ks], __builtin_bit_cast(bx8, w), o[mt], 0, 0, 0); } \
                _Pragma("unroll") for (int mt = 0; mt < 4; ++mt) { const LASP unsigned char* sa = B + SOFF + (16 * mt + c) * 144 + g * 16; \
                    o[mt] = __builtin_amdgcn_mfma_f32_16x16x32_bf16(bv0, *(const LASP bx8*)sa, o[mt], 0, 0, 0); \
                    o[mt] = __builtin_amdgcn_mfma_f32_16x16x32_bf16(bv1, *(const LASP bx8*)(sa + 64), o[mt], 0, 0, 0); } \
                const int cc = d == 0 ? ((step) < 4 ? 64 + (step) : (step) - 4) : 67 - (step); const int row0 = row_of(bb, cc, 0); \
                _Pragma("unroll") for (int mt = 0; mt < 4; ++mt) { u32x2 w; w.x = pg8::cvt_pk_bf16(o[mt][0], o[mt][1]); w.y = pg8::cvt_pk_bf16(o[mt][2], o[mt][3]); \
                    *(u32x2*)(O + (size_t)(row0 + 16 * mt + c) * 1024 + h * 256 + vs * 32 + 16 * wid + 4 * g) = w; } \
                _Pragma("unroll") for (int m = 0; m < 8; ++m) { const f4 dv = *(const LASP f4*)(B + DOFF + (16 * m + 4 * g) * 4); const LASP unsigned char* ka = B + KOFF + (16 * m + c) * 144 + g * 16; \
                    S[m] = S[m] * dv; \
                    S[m] = __builtin_amdgcn_mfma_f32_16x16x32_bf16(*(const LASP bx8*)ka, bv0, S[m], 0, 0, 0); \
                    S[m] = __builtin_amdgcn_mfma_f32_16x16x32_bf16(*(const LASP bx8*)(ka + 64), bv1, S[m], 0, 0, 0); } \
            } } while (0)
        f4 S[8];
#pragma unroll
        for (int m = 0; m < 8; ++m) S[m] = (f4){0.f, 0.f, 0.f, 0.f};
        bf16_t* O = d == 0 ? OF : OB;
        __syncthreads();
        GW_LOAD(r0, 0); GW_WRITE(r0, 0); GW_LOAD(r0, 1); GW_LOAD(r1, 2);
        __syncthreads();
        for (int step = 0; step < NCH; step += 2) {
            GW_WRITE(r0, 1); if (step + 3 < NCH) GW_LOAD(r0, step + 3);
            GW_COMPUTE(step);
            __syncthreads();
            if (step + 2 < NCH) { GW_WRITE(r1, 0); if (step + 4 < NCH) GW_LOAD(r1, step + 4); }
            GW_COMPUTE(step + 1);
            __syncthreads();
        }
#undef GW_COMPUTE
#undef GW_LOAD
#undef GW_WRITE
    }
}
#ifndef FAST_WALK
#define FAST_WALK 1
#endif

template <int MODE>
__device__ void st_rglru(const Params& p, int vb, int nvb, unsigned char* lds_, const bf16_t* XR, const bf16_t* SG, const bf16_t* BD, float* SUMA, float* SUMH, bf16_t* Y) {
    typedef pg8::bf16x8 bx8; typedef pg8::f32x4 f4; typedef float f32x2v __attribute__((ext_vector_type(2)));
    LASP unsigned char* lds = (LASP unsigned char*)lds_;
    constexpr int AOFF = 0, FOFF = 17408, BUF = 51200, CWOFF = 2 * BUF;
    constexpr int ND = MODE == 0 ? 1 : 2, NCOMBO = MODE == 0 ? 32 : 16, NTILE = MODE == 0 ? NB * NCH : NB * 64;
    const int tid = threadIdx.x, wid = __builtin_amdgcn_readfirstlane(tid >> 6), lane = tid & 63, c = lane & 15, g = lane >> 4, cp = tid & 63, tg = tid >> 6;
    int P, part, cstep, combo0;
    if (nvb >= NCOMBO) { P = nvb / NCOMBO; part = vb / NCOMBO; cstep = NCOMBO; combo0 = vb % NCOMBO; if (part >= P) return; } else { P = 1; part = 0; cstep = nvb; combo0 = vb; }
    for (int combo = combo0; combo < NCOMBO; combo += cstep) {
        const int nb = MODE == 0 ? (combo >> 1) : combo, d0 = MODE == 0 ? (combo & 1) : 0;
        const int ch = nb * 128 + 16 * wid + c;
        bx8 wa[ND][4], wx[ND][4]; float ba[ND], bxx[ND], k8[ND];
        __syncthreads();
#pragma unroll
        for (int dd = 0; dd < ND; ++dd) { const int d = d0 + dd;
            const bf16_t* wA = BD + ((size_t)(d * 16 + nb) * 128 + 16 * wid + c) * 128 + 8 * g; const bf16_t* wX = wA + (size_t)2 * 16 * 128 * 128;
#pragma unroll
            for (int ks = 0; ks < 4; ++ks) { wa[dd][ks] = *(const bx8*)(wA + 32 * ks); wx[dd][ks] = *(const bx8*)(wX + 32 * ks); }
            ba[dd] = p.o_b_a[d * 2048 + ch]; bxx[dd] = p.o_b_x[d * 2048 + ch]; k8[dd] = 8.f * 1.4426950408889634f * softplusf_(-p.o_lam[d * 2048 + ch]);
            if (tg < 5) { const f32x2v w2 = tg < 4 ? *(const f32x2v*)(p.o_conv_w + ((size_t)d * 4 + tg) * 2048 + nb * 128 + 2 * cp) : *(const f32x2v*)(p.o_conv_b + (size_t)d * 2048 + nb * 128 + 2 * cp);
                *(LASP f32x2v*)(lds + CWOFF + ((dd * 5 + tg) * 128 + 2 * cp) * 4) = w2; } }
        __syncthreads();
        unsigned xr[14];
#define RG_PREF(tile) do { const int bb_ = MODE == 0 ? (tile) / NCH : (tile) >> 6, cc_ = MODE == 0 ? (tile) % NCH : (tile) & 63; const int seg0_ = cc_ < 64 ? bb_ * 4096 : NLAT + bb_ * 256, segn_ = cc_ < 64 ? 4096 : 256; \
            const int tl_ = row_of(bb_, cc_, 0) - seg0_ + 8 * tg - 3; _Pragma("unroll") for (int jr = 0; jr < 14; ++jr) { const int tt_ = tl_ + jr; const bool need_ = MODE == 1 || (d0 == 0 ? jr < 11 : jr >= 3); \
                xr[jr] = (need_ && tt_ >= 0 && tt_ < segn_) ? *(const unsigned*)(XR + (size_t)(seg0_ + tt_) * 2048 + nb * 128 + 2 * cp) : 0u; } } while (0)
        int it = 0;
        if (part < NTILE) RG_PREF(part);
        for (int tile = part; tile < NTILE; tile += P) {
            const int bb = MODE == 0 ? tile / NCH : tile >> 6, cc = MODE == 0 ? tile % NCH : tile & 63; const int row0 = row_of(bb, cc, 0);
            unsigned xcur[14];
#pragma unroll
            for (int jr = 0; jr < 14; ++jr) xcur[jr] = xr[jr];
            if (tile + P < NTILE) RG_PREF(tile + P);
            float hsum[4][4];
#pragma unroll
            for (int dd = 0; dd < ND; ++dd) { const int d = d0 + dd;
                LASP unsigned char* B = lds + (it & 1) * BUF; ++it;
                { f32x2v cv[8]; const f32x2v cbv = *(const LASP f32x2v*)(lds + CWOFF + ((dd * 5 + 4) * 128 + 2 * cp) * 4);
#pragma unroll
                  for (int i = 0; i < 8; ++i) cv[i] = cbv;
#pragma unroll
                  for (int jj = 0; jj < 4; ++jj) { const f32x2v cwv = *(const LASP f32x2v*)(lds + CWOFF + ((dd * 5 + jj) * 128 + 2 * cp) * 4);
#pragma unroll
                      for (int i = 0; i < 8; ++i) { const int jr = d == 0 ? i + jj : i + 6 - jj; cv[i].x += cwv.x * __uint_as_float(xcur[jr] << 16); cv[i].y += cwv.y * __uint_as_float(xcur[jr] & 0xffff0000u); } }
#pragma unroll
                  for (int i = 0; i < 8; ++i) { *(LASP unsigned*)(B + AOFF + (8 * tg + i) * 272 + 4 * cp) = pg8::cvt_pk_bf16(cv[i].x, cv[i].y); *(LASP f32x2v*)(B + FOFF + (8 * tg + i) * 528 + 8 * cp) = cv[i]; } }
                __syncthreads();
                f4 aa[4], ax[4];
#pragma unroll
                for (int mt = 0; mt < 4; ++mt) { aa[mt] = (f4){0.f, 0.f, 0.f, 0.f}; ax[mt] = (f4){0.f, 0.f, 0.f, 0.f}; }
#pragma unroll
                for (int ks = 0; ks < 4; ++ks)
#pragma unroll
                    for (int mt = 0; mt < 4; ++mt) { const bx8 af = *(const LASP bx8*)(B + AOFF + (16 * mt + c) * 272 + (32 * ks + 8 * g) * 2);
                        aa[mt] = __builtin_amdgcn_mfma_f32_16x16x32_bf16(af, wa[dd][ks], aa[mt], 0, 0, 0); ax[mt] = __builtin_amdgcn_mfma_f32_16x16x32_bf16(af, wx[dd][ks], ax[mt], 0, 0, 0); }
                const int gl = d == 0 ? g : 3 - g;
                const int src1 = d == 0 ? lane - 16 : lane + 16, src2 = d == 0 ? lane - 32 : lane + 32, srcT = d == 0 ? 48 + c : c;
                const size_t sidx = (((size_t)bb * 2 + d) * NCH + cc) * 2048 + ch;
                float carryH = MODE == 0 ? 0.f : SUMH[sidx], carryA = 1.f;
#pragma unroll
                for (int mtl = 0; mtl < 4; ++mtl) { const int mt = d == 0 ? mtl : 3 - mtl;
                    float Pq[4], Lq[4]; float pa = 1.f, lh = 0.f;
#pragma unroll
                    for (int sq = 0; sq < 4; ++sq) { const int r = d == 0 ? sq : 3 - sq;
                        const float xv = *(const LASP float*)(B + FOFF + (16 * mt + 4 * g + r) * 528 + (16 * wid + c) * 4);
                        const float rr = sigmoidf_(aa[mt][r] + ba[dd]), ii = sigmoidf_(ax[mt][r] + bxx[dd]);
                        const float a = fexp2_(-k8[dd] * rr), u = __builtin_amdgcn_sqrtf(fmaxf(1.f - a * a, 0.f)) * (ii * xv);
                        lh = a * lh + u; pa *= a; Pq[sq] = pa; Lq[sq] = lh; }
                    float XA = pa, XU = lh, tA, tU;
                    tA = __shfl(XA, src1); tU = __shfl(XU, src1); if (gl >= 1) { XU = tU * XA + XU; XA = tA * XA; }
                    tA = __shfl(XA, src2); tU = __shfl(XU, src2); if (gl >= 2) { XU = tU * XA + XU; XA = tA * XA; }
                    const float totA = __shfl(XA, srcT), totU = __shfl(XU, srcT);
                    if (MODE == 1) {
                        float eA = __shfl(XA, src1), eU = __shfl(XU, src1); if (gl == 0) { eA = 1.f; eU = 0.f; }
                        const float hin = carryH * eA + eU;
#pragma unroll
                        for (int sq = 0; sq < 4; ++sq) { const int r = d == 0 ? sq : 3 - sq; const float hv = hin * Pq[sq] + Lq[sq]; if (dd == 0) hsum[mt][r] = hv; else hsum[mt][r] += hv; }
                    }
                    carryH = carryH * totA + totU; carryA *= totA;
                }
                if (MODE == 0) { if (g == 0) { SUMA[sidx] = carryA; SUMH[sidx] = carryH; } }
            }
            if (MODE == 1) {
#pragma unroll
                for (int mt = 0; mt < 4; ++mt)
#pragma unroll
                    for (int r = 0; r < 4; ++r) { const size_t o = (size_t)(row0 + 16 * mt + 4 * g + r) * 2048 + ch; Y[o] = f2bf(hsum[mt][r] * bf2f(SG[o])); }
            }
        }
        __syncthreads();
#undef RG_PREF
    }
}
#ifndef FAST_RG
#define FAST_RG 1
#endif

#define XB_TMO      128
#define XB_XCNT(j)  (256  + 64 * (j))
#define XB_XSUB(j)  (1280 + 64 * (j))
#define XB_XGEN(j)  (2304 + 64 * (j))
#define XB_TOP      3328
#define XB_TOPGEN   3392
#define XB_SPIN_CAP (1u << 20)
DEVI unsigned xb_ld(unsigned* p)              { return __hip_atomic_load(p, __ATOMIC_RELAXED, __HIP_MEMORY_SCOPE_AGENT); }
DEVI unsigned xb_add(unsigned* p, unsigned v) { return __hip_atomic_fetch_add(p, v, __ATOMIC_RELAXED, __HIP_MEMORY_SCOPE_AGENT); }
DEVI unsigned xb_xcc_id() { return (unsigned)__builtin_amdgcn_s_getreg((3 << 11) | 20) & 0xFu; }
#define XB_SPIN(cond, bar) do { unsigned _sp = 0; while (cond) { __builtin_amdgcn_s_sleep(1); \
    if ((++_sp & 255u) == 0u) { if (xb_ld(&(bar)[XB_TMO])) break; if (_sp > XB_SPIN_CAP) { atomicAdd(&(bar)[XB_TMO], 1u); break; } } } } while (0)
struct XcdBarrier { unsigned* bar; unsigned x; volatile __attribute__((address_space(3))) unsigned* st; };
DEVI XcdBarrier xcd_barrier_post(unsigned* bar, volatile __attribute__((address_space(3))) unsigned* st) {
    XcdBarrier b; b.bar = bar; b.x = xb_xcc_id(); b.st = st;
    if (threadIdx.x == 0) (void)xb_add(&bar[XB_XCNT(b.x)], 1u);
    return b;
}
DEVI void xcd_barrier_complete(unsigned* bar, unsigned x, unsigned& nloc, unsigned& nx) {
    const unsigned G = gridDim.x * gridDim.y * gridDim.z;
    unsigned sum, cnt, mine, sp = 0u;
    for (;;) {
        sum = 0u; cnt = 0u; mine = 0u;
#pragma unroll
        for (unsigned j = 0; j < 16; ++j) { const unsigned c = xb_ld(&bar[XB_XCNT(j)]); sum += c; cnt += (c > 0u) ? 1u : 0u; mine = (j == x) ? c : mine; }
        if (sum == G) break;
        __builtin_amdgcn_s_sleep(1);
        if ((++sp & 255u) == 0u) { if (xb_ld(&bar[XB_TMO])) break; if (sp > XB_SPIN_CAP) { atomicAdd(&bar[XB_TMO], 1u); break; } }
    }
    nloc = mine > 0u ? mine : 1u; nx = cnt > 0u ? cnt : 1u;
}
DEVI void xcd_barrier(const XcdBarrier& b) {
    asm volatile("s_waitcnt vmcnt(0)" ::: "memory");
    __syncthreads();
    if (threadIdx.x == 0) {
        unsigned* bar = b.bar;
        __builtin_amdgcn_s_waitcnt(0);
        unsigned nloc = b.st[0], nx = b.st[1];
        if (nloc == 0u) { xcd_barrier_complete(bar, b.x, nloc, nx); b.st[0] = nloc; b.st[1] = nx; }
        const unsigned old = xb_add(&bar[XB_XSUB(b.x)], 1u);
        const unsigned gen = old / nloc;
        if (old + 1u == (gen + 1u) * nloc) {
            __builtin_amdgcn_fence(__ATOMIC_RELEASE, "agent");
            asm volatile("s_waitcnt vmcnt(0)" ::: "memory");
            const unsigned og = xb_add(&bar[XB_TOP], 1u);
            const unsigned tg = og / nx;
            if (og + 1u == (tg + 1u) * nx) xb_add(&bar[XB_TOPGEN], 1u);
            else XB_SPIN(xb_ld(&bar[XB_TOPGEN]) == tg, bar);
            __builtin_amdgcn_fence(__ATOMIC_ACQUIRE, "agent");
            xb_add(&bar[XB_XGEN(b.x)], 1u);
            asm volatile("s_waitcnt vmcnt(0)" ::: "memory");
        } else {
            XB_SPIN(xb_ld(&bar[XB_XGEN(b.x)]) == gen, bar);
            __builtin_amdgcn_fence(__ATOMIC_ACQUIRE, "agent");
            asm volatile("s_waitcnt vmcnt(0)" ::: "memory");
        }
    }
    __syncthreads();
}
__device__ __forceinline__ void run_stage(const Params& p, int st, int vb, int nvb, unsigned char* lds) {
    unsigned char* ws = p.ws;
    float* MOD = (float*)(ws + WS_MOD); float* ALR = (float*)(ws + WS_ALR); float* X1C = (float*)(ws + WS_X1C);
    float* SUMA = (float*)(ws + WS_SUMA); float* SUMH = (float*)(ws + WS_SUMH); float* DEC = (float*)(ws + WS_DEC);
    bf16_t* Bt1 = (bf16_t*)(ws + WS_BT1); bf16_t* Bt2 = (bf16_t*)(ws + WS_BT2); bf16_t* Bt3 = (bf16_t*)(ws + WS_BT3); bf16_t* Bt4 = (bf16_t*)(ws + WS_BT4);
    bf16_t* S0 = (bf16_t*)(ws + WS_SLOT(0)); bf16_t* S1 = (bf16_t*)(ws + WS_SLOT(1)); bf16_t* S2 = (bf16_t*)(ws + WS_SLOT(2));
    bf16_t* S3 = (bf16_t*)(ws + WS_SLOT(3)); bf16_t* S4 = (bf16_t*)(ws + WS_SLOT(4)); bf16_t* S5 = (bf16_t*)(ws + WS_SLOT(5));
    bf16_t* DO0 = (bf16_t*)p.out; bf16_t* DOSC = (bf16_t*)((unsigned char*)p.out + 34 * MiB);
    switch (st) {
    case 0: st_mod(p, vb, nvb, (float*)lds); st_wprep(p, vb, nvb, lds); break;
    case 1: st_modulate(p, vb, nvb, 0, p.x, p.ctx, S0); break;
    case 3: st_glaprep(p, vb, nvb, lds, S1, S2, ALR, S3, S4, DOSC, DEC, S5); break;
#if FAST_WALK
    case 4: st_glawalk(p, vb, nvb, lds, S3, S4, DOSC, DEC, S5, S2, DO0); break;
#else
    case 4: st_glawalk_naive(p, vb, nvb, (float*)lds, S3, S4, DOSC, DEC, S5, S2, DO0); break;
#endif
    case 6: st_inner(p, vb, nvb, S2, DO0, S3, S4, S5, S0); break;
    case 8: st_modulate(p, vb, nvb, 1, p.out, X1C, S2); break;
    case 11: st_carry(p, vb, nvb, SUMA, SUMH); break;
#if FAST_RG
    case 10: st_rglru<0>(p, vb, nvb, lds, S3, S0, (const bf16_t*)(ws + WS_BD), SUMA, SUMH, S0); break;
    case 12: st_rglru<1>(p, vb, nvb, lds, S3, S0, (const bf16_t*)(ws + WS_BD), SUMA, SUMH, S0); break;
#else
    case 10: st_rglru_naive<0>(p, vb, nvb, (float*)lds, S3, S0, SUMA, SUMH, S0); break;
    case 12: st_rglru_naive<1>(p, vb, nvb, (float*)lds, S3, S0, SUMA, SUMH, S0); break;
#endif
    case 14: st_final(p, vb, nvb); break;
#if FAST_GEMM
    case 2: { FEpi1 E{S1, S2, S3, S4, S5, ALR}; pg8::Gemm g{S0, Bt1, NT, N1, 1024}; pg8::TileOrder S; S.init(NT / 256, 9, nvb, vb, 0, 8, 0, 12);
              pg8::gemm_phase<FEpi1, pg8::TileOrder, true, true>((PG8_LAS unsigned char*)lds, g, S, E); } break;
    case 5: { FEpi1 E{S1, S2, S3, S4, S5, ALR}; pg8::Gemm g{S0, Bt1, NT, N1, 1024}; pg8::TileOrder S; S.init(NT / 256, 20, nvb, vb, 0, 4, 8, 13);
              pg8::gemm_phase<FEpi1, pg8::TileOrder, true, true>((PG8_LAS unsigned char*)lds, g, S, E); } break;
    case 7: { FEpiRes E{p.x, p.ctx, p.out, X1C, MOD}; pg8::Gemm g{S0, Bt2, NT, 1024, 2048}; pg8::TileOrder S; S.init(NT / 256, 4, nvb, vb);
              pg8::gemm_phase<FEpiRes, pg8::TileOrder, true, true>((PG8_LAS unsigned char*)lds, g, S, E); } break;
    case 9: { FEpi3 E{S3, S0}; pg8::Gemm g{S2, Bt3, NT, 4096, 1024}; pg8::TileOrder S; S.init(NLAT / 256, 16, nvb, vb, 0, 1 << 30, 0, 0, NCTX / 256, 8, NLAT / 256);
              pg8::gemm_phase<FEpi3, pg8::TileOrder, true, true>((PG8_LAS unsigned char*)lds, g, S, E); } break;
    case 13: { FEpiRes E{p.out, nullptr, p.out, nullptr, MOD + 5 * 3072}; pg8::Gemm g{S0, Bt4, NLAT, 1024, 2048}; pg8::TileOrder S; S.init(NLAT / 256, 4, nvb, vb);
              pg8::gemm_phase<FEpiRes, pg8::TileOrder, true, true>((PG8_LAS unsigned char*)lds, g, S, E); } break;
#else
    case 2: { Epi1 E{S1, S2, S3, S4, S5, ALR}; st_gemm_naive(vb, nvb, (float*)lds, S0, Bt1, 0, NT / 32, 0, 8, 1024, E); st_gemm_naive(vb, nvb, (float*)lds, S0, Bt1, 0, NT / 32, 12, 13, 1024, E); } break;
    case 5: { Epi1 E{S1, S2, S3, S4, S5, ALR}; st_gemm_naive(vb, nvb, (float*)lds, S0, Bt1, 0, NT / 32, 8, 12, 1024, E); st_gemm_naive(vb, nvb, (float*)lds, S0, Bt1, 0, NT / 32, 13, 29, 1024, E); } break;
    case 7: { EpiRes E{p.x, p.ctx, p.out, X1C, MOD}; st_gemm_naive(vb, nvb, (float*)lds, S0, Bt2, 0, NT / 32, 0, 4, 2048, E); } break;
    case 9: { Epi3 E{S3, S0}; st_gemm_naive(vb, nvb, (float*)lds, S2, Bt3, 0, NLAT / 32, 0, 16, 1024, E); st_gemm_naive(vb, nvb, (float*)lds, S2, Bt3, NLAT / 32, NT / 32, 0, 8, 1024, E); } break;
    case 13: { EpiRes E{p.out, nullptr, p.out, nullptr, MOD + 5 * 3072}; st_gemm_naive(vb, nvb, (float*)lds, S0, Bt4, 0, NLAT / 32, 0, 4, 2048, E); } break;
#endif
    }
}
constexpr int NSTAGES = 15;
constexpr int LDS_BYTES = 147456;

#ifndef ONE_LAUNCH
#define ONE_LAUNCH 1
#endif
#if !ONE_LAUNCH
__global__ void __launch_bounds__(NTHREADS) k_mega(Params p, int st) {
    extern __shared__ __attribute__((aligned(16))) unsigned char lds[];
    run_stage(p, st, blockIdx.x, gridDim.x, lds);
}
#else
__global__ void __launch_bounds__(NTHREADS) k_mega(Params p) {
    extern __shared__ __attribute__((aligned(16))) unsigned char lds[];
    volatile __attribute__((address_space(3))) unsigned* st = (volatile __attribute__((address_space(3))) unsigned*)((__attribute__((address_space(3))) unsigned char*)lds + (LDS_BYTES - 64));
    if (threadIdx.x < 2) st[threadIdx.x] = 0u;
    __syncthreads();
    const XcdBarrier bar = xcd_barrier_post((unsigned*)(p.ws + WS_CTL) + 4096, st);
#ifndef REP_STAGE
#define REP_STAGE -1
#endif
#ifndef REP_N
#define REP_N 1
#endif
#define RS(k) do { run_stage(p, k, blockIdx.x, gridDim.x, lds); if ((k) == REP_STAGE) { for (int rep_ = 0; rep_ < REP_N; ++rep_) { xcd_barrier(bar); run_stage(p, k, blockIdx.x, gridDim.x, lds); } } } while (0)
#define GS() xcd_barrier(bar)
    RS(0); GS(); RS(1); GS(); RS(2); GS(); RS(3); GS(); RS(4); GS(); RS(5); GS(); RS(6); GS(); RS(7); GS();
    RS(8); GS(); RS(9); GS(); RS(10); GS(); RS(11); GS(); RS(12); GS(); RS(13); GS(); RS(14);
#undef RS
#undef GS
}
#endif

extern "C" void kernel_launch(void* const* d_in, const int* in_sizes, int n_in, void* d_out, int out_size, void* d_ws, size_t ws_size, hipStream_t stream) {
    static int inited = 0, grid_blocks = 0;
    if (!inited) {
        if (n_in != 23 || ws_size < WS_END || out_size != NLAT * D) { fprintf(stderr, "kernel_launch: unexpected shapes n_in %d ws %zu out %d\n", n_in, ws_size, out_size); inited = -1; return; }
        if (hipFuncSetAttribute((const void*)k_mega, hipFuncAttributeMaxDynamicSharedMemorySize, LDS_BYTES) != hipSuccess) { fprintf(stderr, "hipFuncSetAttribute failed\n"); inited = -1; return; }
        int dev = 0, cus = 0, per_cu = 0;
        (void)hipGetDevice(&dev); (void)hipDeviceGetAttribute(&cus, hipDeviceAttributeMultiprocessorCount, dev);
        (void)hipOccupancyMaxActiveBlocksPerMultiprocessor(&per_cu, (const void*)k_mega, NTHREADS, LDS_BYTES);
        if (per_cu < 1) { fprintf(stderr, "kernel_launch: occupancy query says %d blocks per CU\n", per_cu); per_cu = 1; }
        if (per_cu > 1) per_cu = 1;
        grid_blocks = cus * per_cu;
        inited = 1;
    }
    if (inited < 0) return;
    Params p{};
    const float** f = (const float**)&p;
    for (int i = 0; i < 23; ++i) f[i] = (const float*)d_in[i];
    p.out = (float*)d_out; p.ws = (unsigned char*)d_ws;
    (void)hipMemsetAsync((unsigned char*)d_ws + WS_CTL, 0, 2 * MiB, stream);
#if ONE_LAUNCH
    void* args[] = {&p};
    hipError_t e = hipLaunchCooperativeKernel((const void*)k_mega, dim3(grid_blocks), dim3(NTHREADS), args, LDS_BYTES, stream);
    if (e != hipSuccess) fprintf(stderr, "cooperative launch failed: %s (grid %d)\n", hipGetErrorString(e), grid_blocks);
#else
    for (int st = 0; st < NSTAGES; ++st) hipLaunchKernelGGL(k_mega, dim3(1024), dim3(NTHREADS), LDS_BYTES, stream, p, st);
#endif
}
```

```cpp
#include <hip/hip_runtime.h>
#include <hip/hip_cooperative_groups.h>
namespace cg = cooperative_groups;
#include <cstdio>
#include <cstdint>

typedef unsigned short bf16_t;
#define DEVI __device__ __forceinline__
#define LDS_BARRIER() do { asm volatile("s_waitcnt lgkmcnt(0)" ::: "memory"); __builtin_amdgcn_s_barrier(); asm volatile("" ::: "memory"); } while (0)

constexpr int D = 1024, NB = 4, SEQ = 4096, CTXL = 256;
constexpr int NLAT = NB * SEQ;
constexpr int NCTX = NB * CTXL;
constexpr int NT = NLAT + NCTX;
constexpr int NCH = 68;
constexpr int EVEN_IN = 7200;
constexpr int N1 = 7424;
constexpr int N1A = 13 * 256;
constexpr int RGW = 2048;
constexpr float EPS = 1e-6f;

constexpr size_t MiB = 1u << 20;
constexpr size_t WS_CTL = 0;
constexpr size_t WS_MOD = 1 * MiB;
constexpr size_t WS_ALR = 2 * MiB;
constexpr size_t WS_X1C = 5 * MiB;
constexpr size_t WS_SUMA = 9 * MiB;
constexpr size_t WS_SUMH = 9 * MiB + 4608 * 1024;
constexpr size_t WS_DEC = 18 * MiB;
constexpr size_t WS_BT1 = 19 * MiB + 512 * 1024;
constexpr size_t WS_BT2 = 34 * MiB;
constexpr size_t WS_BT3 = 38 * MiB;
constexpr size_t WS_BT4 = 46 * MiB;
constexpr size_t WS_BD = 50 * MiB;
constexpr size_t WS_S0 = 52 * MiB;
constexpr size_t SLOT = 34 * MiB;
constexpr size_t WS_END = WS_S0 + 6 * SLOT;
static_assert(WS_END == 256 * MiB, "ws map");
#define WS_SLOT(i) (WS_S0 + (size_t)(i) * SLOT)

struct Params {
    const float* x; const float* c; const float* ctx; const float* c_ctx; const float* norm_g; const float* w_mod; const float* b_mod;
    const float* e_w_in; const float* e_w_a2; const float* e_b_a2; const float* e_gla_g; const float* e_conv_w; const float* e_w_out;
    const float* o_w_in; const float* o_conv_w; const float* o_conv_b; const float* o_w_a; const float* o_b_a; const float* o_w_x; const float* o_b_x;
    const float* o_lam; const float* o_w_out; const float* final_g;
    float* out; unsigned char* ws;
};

DEVI float bf2f(bf16_t v) { return __uint_as_float((unsigned)v << 16); }
DEVI bf16_t f2bf(float f) { unsigned u = __float_as_uint(f); return (bf16_t)((u + 0x7fffu + ((u >> 16) & 1u)) >> 16); }
DEVI unsigned pk2(float lo, float hi) { return (unsigned)f2bf(lo) | ((unsigned)f2bf(hi) << 16); }
DEVI float fexp2_(float x) { return __builtin_amdgcn_exp2f(x); }
DEVI float frcp_(float x) { return __builtin_amdgcn_rcpf(x); }
DEVI float sigmoidf_(float x) { return frcp_(1.0f + fexp2_(-1.4426950408889634f * x)); }
DEVI float siluf_(float x) { return x * frcp_(1.0f + fexp2_(-1.4426950408889634f * x)); }
DEVI float softplusf_(float x) { return fmaxf(x, 0.f) + log1pf(__expf(-fabsf(x))); }
DEVI float logsigmoidf_(float x) { return fminf(x, 0.f) - 0.6931471805599453f * __builtin_amdgcn_logf(1.0f + fexp2_(-1.4426950408889634f * fabsf(x))); }
DEVI int row_of(int bb, int c, int t) { return c < 64 ? bb * 4096 + c * 64 + t : NLAT + bb * 256 + (c - 64) * 64 + t; }
DEVI int mod_idx(int row) { return row < NLAT ? (row >> 12) : 4; }
DEVI float wave_sum(float v) {
#pragma unroll
    for (int o = 1; o < 64; o <<= 1) v += __shfl_xor(v, o);
    return v;
}
__host__ __device__ inline int colmap1(int n) {
    const int t = n >> 8, c = n & 255;
    if (t < 12) return n;
    if (t == 12) return c < 32 ? 3072 + c : -1;
    if (t < 21) { const int j = t - 13; return c < 128 ? 4128 + 128 * j + c : 5152 + 128 * j + (c - 128); }
    const int j = t - 21; return c < 128 ? 3104 + 128 * j + c : 6176 + 128 * j + (c - 128);
}

#define NTHREADS 512

__device__ void st_mod(const Params& p, int vb, int nvb, float* lds) {
    float* MOD = (float*)(p.ws + WS_MOD);
    for (int i = threadIdx.x; i < 5 * 1024; i += NTHREADS) { const int s = i >> 10, k = i & 1023; const float v = s < 4 ? p.c[s * 1024 + k] : p.c_ctx[k]; lds[i] = siluf_(v); }
    __syncthreads();
    const int lane = threadIdx.x & 63, gw = vb * (NTHREADS / 64) + (threadIdx.x >> 6), ngw = nvb * (NTHREADS / 64);
    for (int it = gw; it < 2 * 48 * 32; it += ngw) {
        const int kc = it & 31, cb = (it >> 5) % 48, li = it / (32 * 48), j = cb * 64 + lane, k0 = kc * 32;
        const float* W = p.w_mod + ((size_t)li * 1024 + k0) * 3072 + j;
        float wv[32];
#pragma unroll
        for (int k = 0; k < 32; ++k) wv[k] = W[(size_t)k * 3072];
        float a0 = 0.f, a1 = 0.f, a2 = 0.f, a3 = 0.f, a4 = 0.f;
#pragma unroll
        for (int k = 0; k < 32; ++k) { const float w = wv[k]; a0 += lds[k0 + k] * w; a1 += lds[1024 + k0 + k] * w; a2 += lds[2048 + k0 + k] * w; a3 += lds[3072 + k0 + k] * w; a4 += lds[4096 + k0 + k] * w; }
        const float bv = kc == 0 ? p.b_mod[li * 3072 + j] : 0.f;
        float* o = MOD + (size_t)li * 5 * 3072 + j;
        atomicAdd(o, a0 + bv); atomicAdd(o + 3072, a1 + bv); atomicAdd(o + 2 * 3072, a2 + bv); atomicAdd(o + 3 * 3072, a3 + bv); atomicAdd(o + 4 * 3072, a4 + bv);
    }
    __syncthreads();
}

__device__ __forceinline__ void wt_item(const float* src, int ldw, bf16_t* dst, int K, int k0, __attribute__((address_space(3))) float* scr, int lane) {
    typedef unsigned v4u __attribute__((ext_vector_type(4)));
    if (src) {
#pragma unroll 8
        for (int i = 0; i < 32; ++i) { const int kk = 2 * i + (lane >> 5); scr[kk * 33 + (lane & 31)] = src[(size_t)(k0 + kk) * ldw + (lane & 31)]; }
    }
    asm volatile("s_waitcnt lgkmcnt(0)" ::: "memory");
    const int cch = lane & 7;
#pragma unroll
    for (int j = 0; j < 4; ++j) { const int n = (lane >> 3) + 8 * j; const __attribute__((address_space(3))) float* sp = scr + (8 * cch) * 33 + n;
        v4u o = {0u, 0u, 0u, 0u};
        if (src) { o.x = pk2(sp[0 * 33], sp[1 * 33]); o.y = pk2(sp[2 * 33], sp[3 * 33]); o.z = pk2(sp[4 * 33], sp[5 * 33]); o.w = pk2(sp[6 * 33], sp[7 * 33]); }
        *(v4u*)(dst + (size_t)n * K + k0 + 8 * cch) = o; }
    asm volatile("s_waitcnt lgkmcnt(0)" ::: "memory");
}
__device__ void st_wprep(const Params& p, int vb, int nvb, unsigned char* lds_) {
    bf16_t* Bt1 = (bf16_t*)(p.ws + WS_BT1); bf16_t* Bt2 = (bf16_t*)(p.ws + WS_BT2); bf16_t* Bt3 = (bf16_t*)(p.ws + WS_BT3); bf16_t* Bt4 = (bf16_t*)(p.ws + WS_BT4);
    bf16_t* BD = (bf16_t*)(p.ws + WS_BD);
    const int lane = threadIdx.x & 63, wv = threadIdx.x >> 6, gw = vb * (NTHREADS / 64) + wv, ngw = nvb * (NTHREADS / 64);
    __attribute__((address_space(3))) float* scr = (__attribute__((address_space(3))) float*)lds_ + 8192 + wv * (64 * 33);
    constexpr int I1 = 16 * (N1 / 32), I2 = 32 * 32, I3 = 16 * 128, I4 = 32 * 32, I5 = 64 * 8;
    for (int it = gw; it < I1 + I2 + I3 + I4 + I5; it += ngw) {
        int r = it;
        if (r < I1) { const int nbk = N1 / 32, kb = r / nbk, nb = r % nbk; const int sc = colmap1(nb * 32); wt_item(sc < 0 ? nullptr : p.e_w_in + sc, EVEN_IN, Bt1 + (size_t)nb * 32 * 1024, 1024, kb * 64, scr, lane); continue; } r -= I1;
        if (r < I2) { const int kb = r / 32, nb = r % 32; wt_item(p.e_w_out + nb * 32, 1024, Bt2 + (size_t)nb * 32 * 2048, 2048, kb * 64, scr, lane); continue; } r -= I2;
        if (r < I3) { const int kb = r / 128, nb = r % 128; wt_item(p.o_w_in + nb * 32, 4096, Bt3 + (size_t)nb * 32 * 1024, 1024, kb * 64, scr, lane); continue; } r -= I3;
        if (r < I4) { const int kb = r / 32, nb = r % 32; wt_item(p.o_w_out + nb * 32, 1024, Bt4 + (size_t)nb * 32 * 2048, 2048, kb * 64, scr, lane); continue; } r -= I4;
        { const int m = r >> 8, dn = (r >> 3) & 31, kb = (r >> 2) & 1, nb = r & 3; const float* W = (m == 0 ? p.o_w_a : p.o_w_x) + (size_t)dn * 16384;
          wt_item(W + nb * 32, 128, BD + (size_t)m * 2 * 16 * 16384 + (size_t)dn * 16384 + (size_t)nb * 32 * 128, 128, kb * 64, scr, lane); }
    }
}

__device__ void st_modulate(const Params& p, int vb, int nvb, int li, const float* xlat, const float* xctx, bf16_t* H) {
    const float* MOD = (const float*)(p.ws + WS_MOD) + (size_t)li * 5 * 3072;
    const float* g = p.norm_g + li * 1024;
    const int lane = threadIdx.x & 63, gw = vb * (NTHREADS / 64) + (threadIdx.x >> 6), ngw = nvb * (NTHREADS / 64);
    for (int row = gw; row < NT; row += ngw) {
        const float* xr = row < NLAT ? xlat + (size_t)row * 1024 : xctx + (size_t)(row - NLAT) * 1024;
        const float* md = MOD + (size_t)mod_idx(row) * 3072;
        float4 v[4]; float ss = 0.f;
#pragma unroll
        for (int j = 0; j < 4; ++j) { v[j] = *(const float4*)(xr + j * 256 + lane * 4); ss += v[j].x * v[j].x + v[j].y * v[j].y + v[j].z * v[j].z + v[j].w * v[j].w; }
        const float rinv = rsqrtf(wave_sum(ss) * (1.f / 1024.f) + EPS);
#pragma unroll
        for (int j = 0; j < 4; ++j) { const int c0 = j * 256 + lane * 4; const float4 gg = *(const float4*)(g + c0), sh = *(const float4*)(md + c0), sc = *(const float4*)(md + 1024 + c0);
            ushort4 o; o.x = f2bf(v[j].x * rinv * gg.x * (1.f + sc.x) + sh.x); o.y = f2bf(v[j].y * rinv * gg.y * (1.f + sc.y) + sh.y);
            o.z = f2bf(v[j].z * rinv * gg.z * (1.f + sc.z) + sh.z); o.w = f2bf(v[j].w * rinv * gg.w * (1.f + sc.w) + sh.w);
            *(ushort4*)(H + (size_t)row * 1024 + c0) = o; }
    }
}

template <class Epi>
__device__ void st_gemm_naive(int vb, int nvb, float* lds, const bf16_t* A, const bf16_t* Bt, int mt0, int mt1, int nt0, int nt1, int K, const Epi& E) {
    float* As = lds;
    float* Bs = lds + 32 * 33;
    const int tid = threadIdx.x, tx = tid & 63, ty = tid >> 6;
    const int nmt = mt1 - mt0, nnt = nt1 - nt0;
    for (int it = vb; it < nmt * nnt; it += nvb) {
        const int m0 = (mt0 + it / nnt) * 32, n0 = (nt0 + it % nnt) * 256;
        float acc[4][4];
#pragma unroll
        for (int i = 0; i < 4; ++i)
#pragma unroll
            for (int j = 0; j < 4; ++j) acc[i][j] = 0.f;
        for (int k0 = 0; k0 < K; k0 += 32) {
            __syncthreads();
            for (int e = tid; e < 32 * 32; e += NTHREADS) { const int r = e >> 5, kk = e & 31; As[r * 33 + kk] = bf2f(A[(size_t)(m0 + r) * K + k0 + kk]); }
            for (int e = tid; e < 256 * 32; e += NTHREADS) { const int r = e >> 5, kk = e & 31; Bs[r * 33 + kk] = bf2f(Bt[(size_t)(n0 + r) * K + k0 + kk]); }
            __syncthreads();
#pragma unroll 8
            for (int kk = 0; kk < 32; ++kk) {
                float a[4], b[4];
#pragma unroll
                for (int i = 0; i < 4; ++i) a[i] = As[(ty * 4 + i) * 33 + kk];
#pragma unroll
                for (int j = 0; j < 4; ++j) b[j] = Bs[(tx + 64 * j) * 33 + kk];
#pragma unroll
                for (int i = 0; i < 4; ++i)
#pragma unroll
                    for (int j = 0; j < 4; ++j) acc[i][j] += a[i] * b[j];
            }
        }
#pragma unroll
        for (int i = 0; i < 4; ++i) E(m0 + ty * 4 + i, n0, tx, acc[i]);
    }
    __syncthreads();
}

struct Epi1 {
    bf16_t *QK, *V, *SGA, *Z, *CBG; float* ALR;
    DEVI void operator()(int row, int n0, int cl, const float (&v)[4]) const {
        const int t = n0 >> 8;
        if (t < 4) { for (int j = 0; j < 4; ++j) QK[(size_t)row * 1024 + n0 + cl + 64 * j] = f2bf(v[j]); }
        else if (t < 8) { for (int j = 0; j < 4; ++j) V[(size_t)row * 1024 + (n0 - 1024) + cl + 64 * j] = f2bf(v[j]); }
        else if (t < 12) { for (int j = 0; j < 4; ++j) SGA[(size_t)row * 1024 + (n0 - 2048) + cl + 64 * j] = f2bf(siluf_(v[j])); }
        else if (t == 12) { if (cl < 32) ALR[(size_t)row * 32 + cl] = v[0]; }
        else if (t < 21) { const int jt = t - 13; Z[(size_t)row * 1024 + 128 * jt + cl] = f2bf(v[0] * v[2]); Z[(size_t)row * 1024 + 128 * jt + cl + 64] = f2bf(v[1] * v[3]); }
        else { const int jt = t - 21; CBG[(size_t)row * 1024 + 128 * jt + cl] = f2bf(v[0] * siluf_(v[2])); CBG[(size_t)row * 1024 + 128 * jt + cl + 64] = f2bf(v[1] * siluf_(v[3])); }
    }
};
struct EpiRes {
    const float* xl; const float* xc; float* outl; float* outc; const float* MODl;
    DEVI void operator()(int row, int n0, int cl, const float (&v)[4]) const {
        const float* gate = MODl + (size_t)mod_idx(row) * 3072 + 2048;
        for (int j = 0; j < 4; ++j) { const int col = n0 + cl + 64 * j;
            if (row < NLAT) outl[(size_t)row * 1024 + col] = xl[(size_t)row * 1024 + col] + gate[col] * v[j];
            else if (outc) outc[(size_t)(row - NLAT) * 1024 + col] = xc[(size_t)(row - NLAT) * 1024 + col] + gate[col] * v[j]; }
    }
};
struct Epi3 {
    bf16_t* XR; bf16_t* SG;
    DEVI void operator()(int row, int n0, int cl, const float (&v)[4]) const {
        for (int j = 0; j < 4; ++j) { const int col = n0 + cl + 64 * j;
            if (col < 2048) XR[(size_t)row * 2048 + col] = f2bf(v[j]); else if (row < NLAT) SG[(size_t)row * 2048 + col - 2048] = f2bf(siluf_(v[j])); }
    }
};

#define LASQ __attribute__((address_space(3)))
__device__ void st_glaprep(const Params& p, int vb, int nvb, unsigned char* ldsb, const bf16_t* QK, const bf16_t* V, const float* ALR, bf16_t* QIN, bf16_t* KET, bf16_t* SC, float* DEC, bf16_t* VT) {
    typedef unsigned u4 __attribute__((ext_vector_type(4))); typedef unsigned u2 __attribute__((ext_vector_type(2))); typedef float f4 __attribute__((ext_vector_type(4))); typedef short bx8 __attribute__((ext_vector_type(8)));
    LASQ unsigned char* lds = (LASQ unsigned char*)ldsb;
    constexpr int RQ = 0, RK = 17408, Q0 = 34816, K0 = 52224, VR = 69632, AL = VR + 33792, TT = AL + 8192;
    const int tid = threadIdx.x, kk = tid & 127, tq = tid >> 7, wv = tid >> 6, ln = tid & 63, cl = ln & 15, gq = ln >> 4;
    u4 r[9];
#define GP_LOAD(item) do { const int h_ = (item) & 3, bc_ = (item) >> 2, c_ = bc_ % NCH, bb_ = bc_ / NCH; const size_t row0_ = (size_t)row_of(bb_, c_, 0); \
        _Pragma("unroll") for (int j_ = 0; j_ < 2; ++j_) { const int p_ = tid + 512 * j_; r[j_] = *(const u4*)(QK + (row0_ + (p_ >> 4)) * 1024 + h_ * 128 + (p_ & 15) * 8); r[2 + j_] = *(const u4*)(QK + (row0_ + (p_ >> 4)) * 1024 + 512 + h_ * 128 + (p_ & 15) * 8); } \
        _Pragma("unroll") for (int j_ = 0; j_ < 4; ++j_) { const int p_ = tid + 512 * j_; r[4 + j_] = *(const u4*)(V + (row0_ + (p_ >> 5)) * 1024 + h_ * 256 + (p_ & 31) * 8); } \
        r[8] = *(const u4*)(ALR + (row0_ + (tid >> 3)) * 32 + (tid & 7) * 4); } while (0)
    const int NIT = NB * NCH * 4;
    if (vb < NIT) GP_LOAD(vb);
    for (int item = vb; item < NIT; item += nvb) {
        const int h = item & 3;
        LDS_BARRIER();
#pragma unroll
        for (int j = 0; j < 2; ++j) { const int pp = tid + 512 * j; *(LASQ u4*)(lds + RQ + (pp >> 4) * 272 + (pp & 15) * 16) = r[j]; *(LASQ u4*)(lds + RK + (pp >> 4) * 272 + (pp & 15) * 16) = r[2 + j]; }
#pragma unroll
        for (int j = 0; j < 4; ++j) { const int pp = tid + 512 * j; *(LASQ u4*)(lds + VR + (pp >> 5) * 528 + (pp & 31) * 16) = r[4 + j]; }
        *(LASQ u4*)(lds + AL + (tid >> 3) * 128 + (tid & 7) * 16) = r[8];
        float w2a[2][16], b2a[2];
#pragma unroll
        for (int d = 0; d < 2; ++d) {
#pragma unroll
            for (int rr = 0; rr < 16; ++rr) w2a[d][rr] = p.e_w_a2[((size_t)d * 16 + rr) * 512 + h * 128 + kk];
            b2a[d] = p.e_b_a2[d * 512 + h * 128 + kk]; }
        asm volatile("" ::: "memory");
        if (item + nvb < NIT) GP_LOAD(item + nvb);
        LDS_BARRIER();
        unsigned qkr[16];
#pragma unroll
        for (int i = 0; i < 16; ++i) { qkr[i] = (unsigned)*(const LASQ unsigned short*)(lds + RQ + (tq * 16 + i) * 272 + kk * 2) | ((unsigned)*(const LASQ unsigned short*)(lds + RK + (tq * 16 + i) * 272 + kk * 2) << 16); }
        float bc[2][16];
#pragma unroll
        for (int d = 0; d < 2; ++d) {
            const float (&w2)[16] = w2a[d]; const float b2 = b2a[d];
#pragma unroll
            for (int i = 0; i < 16; ++i) { const LASQ f4* a = (const LASQ f4*)(lds + AL + (tq * 16 + i) * 128 + d * 64); const f4 a0 = a[0], a1 = a[1], a2 = a[2], a3 = a[3];
                float z = b2 + a0[0] * w2[0] + a0[1] * w2[1] + a0[2] * w2[2] + a0[3] * w2[3] + a1[0] * w2[4] + a1[1] * w2[5] + a1[2] * w2[6] + a1[3] * w2[7]
                        + a2[0] * w2[8] + a2[1] * w2[9] + a2[2] * w2[10] + a2[3] * w2[11] + a3[0] * w2[12] + a3[1] * w2[13] + a3[2] * w2[14] + a3[3] * w2[15];
                bc[d][i] = logsigmoidf_(z) * (1.f / 16.f); }
            float sacc = 0.f;
            if (d == 0) {
#pragma unroll
                for (int i = 0; i < 16; ++i) { sacc += bc[d][i]; bc[d][i] = sacc; } }
            else {
#pragma unroll
                for (int i = 15; i >= 0; --i) { sacc += bc[d][i]; bc[d][i] = sacc; } }
            *(LASQ float*)(lds + TT + ((d * 4 + tq) * 128 + kk) * 4) = sacc;
        }
        LDS_BARRIER();
        const float scale = 0.08838834764831845f;
#pragma unroll
        for (int d = 0; d < 2; ++d) {
            const size_t u = (size_t)item * 2 + d;
            float off = 0.f, blast = 0.f;
#pragma unroll
            for (int q = 0; q < 4; ++q) { const float tv = *(const LASQ float*)(lds + TT + ((d * 4 + q) * 128 + kk) * 4); blast += tv; if (d == 0 ? (q < tq) : (q > tq)) off += tv; }
            LASQ unsigned char* qd = lds + (d == 0 ? Q0 : RQ); LASQ unsigned char* kd = lds + (d == 0 ? K0 : RK);
            unsigned ke[8];
#pragma unroll
            for (int i = 0; i < 16; ++i) { const int t = tq * 16 + i; const float bq = bc[d][i] + off;
                const float qv = __uint_as_float(qkr[i] << 16) * scale, kv = __uint_as_float(qkr[i] & 0xffff0000u);
                const float eb = fexp2_(1.4426950408889634f * bq);
                *(LASQ unsigned short*)(qd + t * 272 + kk * 2) = f2bf(qv * eb); *(LASQ unsigned short*)(kd + t * 272 + kk * 2) = f2bf(kv * frcp_(eb));
                const unsigned kev = f2bf(kv * fexp2_(1.4426950408889634f * (blast - bq)));
                if (i & 1) ke[i >> 1] |= kev << 16; else ke[i >> 1] = kev; }
            { u4 w0 = {ke[0], ke[1], ke[2], ke[3]}, w1 = {ke[4], ke[5], ke[6], ke[7]}; u4* dst = (u4*)(KET + (u * 128 + kk) * 64 + tq * 16); dst[0] = w0; dst[1] = w1; }
            if (tq == 0) DEC[u * 128 + kk] = fexp2_(1.4426950408889634f * blast);
        }
        LDS_BARRIER();
#pragma unroll
        for (int d = 0; d < 2; ++d) {
            const size_t u = (size_t)item * 2 + d;
            const LASQ unsigned char* qd = lds + (d == 0 ? Q0 : RQ); const LASQ unsigned char* kd = lds + (d == 0 ? K0 : RK);
#pragma unroll
            for (int j = 0; j < 2; ++j) { const int pp = tid + 512 * j; *(u4*)(QIN + u * 8192 + (pp >> 4) * 128 + (pp & 15) * 8) = *(const LASQ u4*)(qd + (pp >> 4) * 272 + (pp & 15) * 16); }
            const int mt = wv >> 1;
#pragma unroll
            for (int nn = 0; nn < 2; ++nn) { const int nt = 2 * (wv & 1) + nn; f4 acc = {0.f, 0.f, 0.f, 0.f};
#pragma unroll
                for (int k4 = 0; k4 < 4; ++k4) { const bx8 kf = *(const LASQ bx8*)(kd + (16 * nt + cl) * 272 + (32 * k4 + 8 * gq) * 2), qf = *(const LASQ bx8*)(qd + (16 * mt + cl) * 272 + (32 * k4 + 8 * gq) * 2);
                    acc = __builtin_amdgcn_mfma_f32_16x16x32_bf16(kf, qf, acc, 0, 0, 0); }
                const int t = 16 * mt + cl, s0 = 16 * nt + 4 * gq; float v[4];
#pragma unroll
                for (int rr = 0; rr < 4; ++rr) { const int sx = s0 + rr; v[rr] = (d == 0 ? (sx <= t) : (sx >= t)) ? acc[rr] : 0.f; }
                u2 w; w.x = pk2(v[0], v[1]); w.y = pk2(v[2], v[3]); *(u2*)(SC + (u * 64 + t) * 64 + s0) = w; }
        }
        { const int vc = tid & 255, th = tid >> 8; unsigned vv[16];
#pragma unroll
          for (int i = 0; i < 32; ++i) { const unsigned x = *(const LASQ unsigned short*)(lds + VR + (32 * th + i) * 528 + vc * 2); if (i & 1) vv[i >> 1] |= x << 16; else vv[i >> 1] = x; }
          u4* dst = (u4*)(VT + ((size_t)item * 256 + vc) * 64 + 32 * th);
          dst[0] = (u4){vv[0], vv[1], vv[2], vv[3]}; dst[1] = (u4){vv[4], vv[5], vv[6], vv[7]}; dst[2] = (u4){vv[8], vv[9], vv[10], vv[11]}; dst[3] = (u4){vv[12], vv[13], vv[14], vv[15]}; }
    }
    LDS_BARRIER();
#undef GP_LOAD
}

__device__ void st_glawalk_naive(const Params& p, int vb, int nvb, float* Sl, const bf16_t* QIN, const bf16_t* KET, const bf16_t* SC, const float* DEC, const bf16_t* VT, bf16_t* OF, bf16_t* OB) {
    const int vc = threadIdx.x & 255, half = threadIdx.x >> 8;
    for (int combo = vb; combo < 32; combo += nvb) {
        const int d = combo & 1, h = (combo >> 1) & 3, bb = combo >> 3;
        __syncthreads();
        for (int k = half * 64; k < half * 64 + 64; ++k) Sl[k * 256 + vc] = 0.f;
        __syncthreads();
        bf16_t* O = d == 0 ? OF : OB;
        for (int step = 0; step < NCH; ++step) {
            const int c = d == 0 ? (step < 4 ? 64 + step : step - 4) : 67 - step;
            const int u = ((bb * NCH + c) * 4 + h) * 2 + d;
            const bf16_t* q = QIN + (size_t)u * 64 * 128; const bf16_t* ke = KET + (size_t)u * 128 * 64; const bf16_t* sc = SC + (size_t)u * 64 * 64;
            const bf16_t* vt = VT + (((size_t)(u >> 1)) * 256 + vc) * 64;
            float vv[64];
#pragma unroll
            for (int t = 0; t < 64; ++t) vv[t] = bf2f(vt[t]);
            const int row0 = row_of(bb, c, 0);
            for (int t = half * 32; t < half * 32 + 32; ++t) { float a = 0.f;
                for (int k = 0; k < 128; ++k) a += bf2f(q[t * 128 + k]) * bf2f(f2bf(Sl[k * 256 + vc]));
#pragma unroll
                for (int s = 0; s < 64; ++s) a += bf2f(sc[t * 64 + s]) * vv[s];
                O[(size_t)(row0 + t) * 1024 + h * 256 + vc] = f2bf(a); }
            __syncthreads();
            for (int k = half * 64; k < half * 64 + 64; ++k) { float a = DEC[(size_t)u * 128 + k] * Sl[k * 256 + vc];
#pragma unroll
                for (int t = 0; t < 64; ++t) a += bf2f(ke[k * 64 + t]) * vv[t];
                Sl[k * 256 + vc] = a; }
            __syncthreads();
        }
    }
}

__device__ void st_inner(const Params& p, int vb, int nvb, const bf16_t* OF, const bf16_t* OB, const bf16_t* SGA, const bf16_t* Z, const bf16_t* CBG, bf16_t* INNER) {
    const int lane = threadIdx.x & 63, gw = vb * (NTHREADS / 64) + (threadIdx.x >> 6), ngw = nvb * (NTHREADS / 64);
    for (int row = gw; row < NT; row += ngw) {
        bool hasp, hasn;
        if (row < NLAT) { const int t = row & 63; hasp = t != 0; hasn = t != 63; } else { const int t = (row - NLAT) & 255; hasp = t != 0; hasn = t != 255; }
#pragma unroll
        for (int h = 0; h < 4; ++h) {
            const int c0 = h * 256 + lane * 4;
            const ushort4 a = *(const ushort4*)(OF + (size_t)row * 1024 + c0), b = *(const ushort4*)(OB + (size_t)row * 1024 + c0);
            const float o0 = bf2f(a.x) + bf2f(b.x), o1 = bf2f(a.y) + bf2f(b.y), o2 = bf2f(a.z) + bf2f(b.z), o3 = bf2f(a.w) + bf2f(b.w);
            const float rinv = rsqrtf(wave_sum(o0 * o0 + o1 * o1 + o2 * o2 + o3 * o3) * (1.f / 256.f) + EPS);
            const float4 gg = *(const float4*)(p.e_gla_g + lane * 4);
            const ushort4 sg = *(const ushort4*)(SGA + (size_t)row * 1024 + c0);
            ushort4 o; o.x = f2bf(o0 * rinv * gg.x * bf2f(sg.x)); o.y = f2bf(o1 * rinv * gg.y * bf2f(sg.y)); o.z = f2bf(o2 * rinv * gg.z * bf2f(sg.z)); o.w = f2bf(o3 * rinv * gg.w * bf2f(sg.w));
            *(ushort4*)(INNER + (size_t)row * 2048 + c0) = o;
            const ushort4 zc = *(const ushort4*)(Z + (size_t)row * 1024 + c0);
            ushort4 zp = {0, 0, 0, 0}, zn = {0, 0, 0, 0};
            if (hasp) zp = *(const ushort4*)(Z + (size_t)(row - 1) * 1024 + c0);
            if (hasn) zn = *(const ushort4*)(Z + (size_t)(row + 1) * 1024 + c0);
            const float4 w0 = *(const float4*)(p.e_conv_w + c0), w1 = *(const float4*)(p.e_conv_w + 1024 + c0), w2 = *(const float4*)(p.e_conv_w + 2048 + c0);
            const ushort4 cb = *(const ushort4*)(CBG + (size_t)row * 1024 + c0);
            ushort4 y; y.x = f2bf(bf2f(cb.x) * (w0.x * bf2f(zp.x) + w1.x * bf2f(zc.x) + w2.x * bf2f(zn.x)));
            y.y = f2bf(bf2f(cb.y) * (w0.y * bf2f(zp.y) + w1.y * bf2f(zc.y) + w2.y * bf2f(zn.y)));
            y.z = f2bf(bf2f(cb.z) * (w0.z * bf2f(zp.z) + w1.z * bf2f(zc.z) + w2.z * bf2f(zn.z)));
            y.w = f2bf(bf2f(cb.w) * (w0.w * bf2f(zp.w) + w1.w * bf2f(zc.w) + w2.w * bf2f(zn.w)));
            *(ushort4*)(INNER + (size_t)row * 2048 + 1024 + c0) = y;
        }
    }
}

template <int MODE>
__device__ void st_rglru_naive(const Params& p, int vb, int nvb, float* lds, const bf16_t* XR, const bf16_t* SG, float* SUMA, float* SUMH, bf16_t* Y) {
    float* xc = lds;
    float* av = xc + 64 * 128;
    float* uv = av + 64 * 128;
    float* hf = uv + 64 * 128;
    const int tid = threadIdx.x, j = tid & 127, tq = tid >> 7;
    const int nitems = MODE == 0 ? NB * NCH * 16 * 2 : NB * 64 * 16;
    for (int it = vb; it < nitems; it += nvb) {
        int bb, c, nb;
        if (MODE == 0) { nb = (it >> 1) & 15; const int bc = it >> 5; c = bc % NCH; bb = bc / NCH; } else { nb = it & 15; const int bc = it >> 4; c = bc & 63; bb = bc >> 6; }
        const int row0 = row_of(bb, c, 0);
        const int seg0 = c < 64 ? bb * 4096 : NLAT + bb * 256, segn = c < 64 ? 4096 : 256;
        const int tl0 = row0 - seg0;
        for (int dd = 0; dd < (MODE == 0 ? 1 : 2); ++dd) {
            const int d = MODE == 0 ? (it & 1) : dd;
            __syncthreads();
            for (int e = tid; e < 64 * 128; e += NTHREADS) { const int t = e >> 7, i = e & 127, ch = nb * 128 + i; float a = p.o_conv_b[d * 2048 + ch];
#pragma unroll
                for (int jj = 0; jj < 4; ++jj) { const int tt = d == 0 ? tl0 + t - 3 + jj : tl0 + t + 3 - jj;
                    if (tt >= 0 && tt < segn) a += p.o_conv_w[((size_t)d * 4 + jj) * 2048 + ch] * bf2f(XR[(size_t)(seg0 + tt) * 2048 + ch]); }
                xc[e] = a; }
            __syncthreads();
            const float* WA = p.o_w_a + ((size_t)d * 16 + nb) * 128 * 128; const float* WX = p.o_w_x + ((size_t)d * 16 + nb) * 128 * 128;
            const int ch = nb * 128 + j;
            const float ba = p.o_b_a[d * 2048 + ch], bx = p.o_b_x[d * 2048 + ch], sp = softplusf_(-p.o_lam[d * 2048 + ch]);
            for (int i16 = 0; i16 < 16; ++i16) { const int t = tq * 16 + i16; float ra = ba, rx = bx;
                for (int i = 0; i < 128; ++i) { const float xv = bf2f(f2bf(xc[t * 128 + i])); ra += xv * bf2f(f2bf(WA[i * 128 + j])); rx += xv * bf2f(f2bf(WX[i * 128 + j])); }
                const float r = sigmoidf_(ra), ig = sigmoidf_(rx); const float la = -8.f * r * sp; const float a = __expf(la);
                av[t * 128 + j] = a; uv[t * 128 + j] = sqrtf(-expm1f(2.f * la)) * (ig * xc[t * 128 + j]); }
            __syncthreads();
            if (tid < 128) {
                const size_t sidx = (((size_t)bb * 2 + d) * NCH + c) * 2048 + ch;
                if (MODE == 0) { float A = 1.f, hh = 0.f;
                    if (d == 0) for (int t = 0; t < 64; ++t) { const float a = av[t * 128 + j]; hh = a * hh + uv[t * 128 + j]; A *= a; }
                    else for (int t = 63; t >= 0; --t) { const float a = av[t * 128 + j]; hh = a * hh + uv[t * 128 + j]; A *= a; }
                    SUMA[sidx] = A; SUMH[sidx] = hh;
                } else { float hh = SUMH[sidx];
                    if (d == 0) for (int t = 0; t < 64; ++t) { hh = av[t * 128 + j] * hh + uv[t * 128 + j]; hf[t * 128 + j] = hh; }
                    else for (int t = 63; t >= 0; --t) { hh = av[t * 128 + j] * hh + uv[t * 128 + j]; const size_t o = (size_t)(row0 + t) * 2048 + ch; Y[o] = f2bf((hf[t * 128 + j] + hh) * bf2f(SG[o])); }
                }
            }
        }
    }
    __syncthreads();
}
__device__ void st_carry(const Params& p, int vb, int nvb, const float* SUMA, float* SUMH) {
    for (int e = vb * NTHREADS + threadIdx.x; e < NB * 2 * 2048; e += nvb * NTHREADS) {
        const int ch = e & 2047, d = (e >> 11) & 1, bb = e >> 12; float hh = 0.f;
        for (int s0 = 0; s0 < NCH; s0 += 17) {
            float A[17], H[17];
#pragma unroll
            for (int i = 0; i < 17; ++i) { const int step = s0 + i, c = d == 0 ? (step < 4 ? 64 + step : step - 4) : 67 - step; const size_t sidx = (((size_t)bb * 2 + d) * NCH + c) * 2048 + ch; A[i] = SUMA[sidx]; H[i] = SUMH[sidx]; }
#pragma unroll
            for (int i = 0; i < 17; ++i) { const int step = s0 + i, c = d == 0 ? (step < 4 ? 64 + step : step - 4) : 67 - step; const size_t sidx = (((size_t)bb * 2 + d) * NCH + c) * 2048 + ch; SUMH[sidx] = hh; hh = A[i] * hh + H[i]; }
        }
    }
}
__device__ void st_final(const Params& p, int vb, int nvb) {
    const int lane = threadIdx.x & 63, gw = vb * (NTHREADS / 64) + (threadIdx.x >> 6), ngw = nvb * (NTHREADS / 64);
    for (int row = gw; row < NLAT; row += ngw) { float* xr = p.out + (size_t)row * 1024; float4 v[4]; float ss = 0.f;
#pragma unroll
        for (int j = 0; j < 4; ++j) { v[j] = *(const float4*)(xr + j * 256 + lane * 4); ss += v[j].x * v[j].x + v[j].y * v[j].y + v[j].z * v[j].z + v[j].w * v[j].w; }
        const float rinv = rsqrtf(wave_sum(ss) * (1.f / 1024.f) + EPS);
#pragma unroll
        for (int j = 0; j < 4; ++j) { const float4 g = *(const float4*)(p.final_g + j * 256 + lane * 4); float4 o; o.x = v[j].x * rinv * g.x; o.y = v[j].y * rinv * g.y; o.z = v[j].z * rinv * g.z; o.w = v[j].w * rinv * g.w; *(float4*)(xr + j * 256 + lane * 4) = o; }
    }
}


namespace pg8 {
#define PG8_LAS __attribute__((address_space(3)))
typedef short bf16x8 __attribute__((ext_vector_type(8)));
typedef float f32x4 __attribute__((ext_vector_type(4)));
typedef unsigned u32x4 __attribute__((ext_vector_type(4)));
constexpr int BM = 256, BK = 64, HALF = 128, HTB = HALF * BK * 2, STAGE_BYTES = 8 * HTB, NXCD = 8, WGM = 8;
__host__ __device__ __forceinline__ int lds_byte(int r, int c) { const int st = (r >> 4) * 2 + (c >> 5), rr = r & 15, cc = c & 31, ob = rr * 64 + cc * 2; return st * 1024 + (ob ^ (((ob >> 9) & 1) << 5)); }
__host__ __device__ __forceinline__ void stage_rc(int b, int& R, int& C) { const int st = b / 1024, sb = b % 1024, swz = sb ^ (((sb >> 9) & 1) << 5); R = (st >> 1) * 16 + swz / 64; C = (st & 1) * 32 + (swz % 64) / 2; }
__host__ __device__ __forceinline__ int perm32(int rho) { const int n = rho >> 4, i = rho & 15; return 8 * (i >> 2) + 4 * n + (i & 3); }
struct Unit { int pm, pn; };
struct Gemm { const bf16_t* A; const bf16_t* Bt; int M, N, K; };
struct TileOrder {
    int nM, nN, nwg, G, c, m0, split, base0, base1, nM2, nN2, m02;
    __device__ void init(int nM_, int nN_, int G_, int c_, int m0_ = 0, int split_ = 1 << 30, int base0_ = 0, int base1_ = 0, int nM2_ = 0, int nN2_ = 0, int m02_ = 0) {
        nM = nM_; nN = nN_; nwg = nM * nN; G = G_; c = c_; m0 = m0_; split = split_; base0 = base0_; base1 = base1_; nM2 = nM2_; nN2 = nN2_; m02 = m02_; }
    __device__ bool next(int i, Unit& u) const {
        const long L = (long)i * G + c;
        if (L >= nwg) { const long L2 = L - nwg; if (L2 >= (long)nM2 * nN2) return false; u.pm = m02 + (int)(L2 / nN2); u.pn = (int)(L2 % nN2); return true; }
        int wgid = (int)L; { const int q = nwg / NXCD, r = nwg % NXCD, xcd = wgid % NXCD, off = wgid / NXCD; wgid = (xcd < r ? xcd * (q + 1) : r * (q + 1) + (xcd - r) * q) + off; }
        const int nig = WGM * nN, gid = wgid / nig, fm = gid * WGM, gsz = (nM - fm) < WGM ? (nM - fm) : WGM;
        const int pm = fm + ((wgid % nig) % gsz), j = (wgid % nig) / gsz;
        u.pm = m0 + pm; u.pn = j < split ? base0 + j : base1 + (j - split); return true;
    }
    __device__ __forceinline__ void a_ready(const Unit&) const {}
    __device__ __forceinline__ void done(const Unit&) const {}
};
typedef float f32x2_t __attribute__((ext_vector_type(2))); typedef __bf16 bf16x2_t __attribute__((ext_vector_type(2)));
__device__ __forceinline__ unsigned cvt_pk_bf16(float lo, float hi) { f32x2_t v = {lo, hi}; bf16x2_t b = __builtin_convertvector(v, bf16x2_t); return __builtin_bit_cast(unsigned, b); }
template <class Epi, class Sched, bool ALIGN_EPI = false, bool SP2 = false>
__device__ __forceinline__ void gemm_phase(PG8_LAS unsigned char* lds, const Gemm g, const Sched& S, const Epi& E) {
    const int tid = threadIdx.x, wid = __builtin_amdgcn_readfirstlane(tid >> 6), lane = tid & 63, wr = wid >> 2, wc = wid & 3, fr = lane & 15, fq = lane >> 4;
    const int K = g.K, nt = K / BK;
    unsigned voffA[2], voffB[2];
#pragma unroll
    for (int i = 0; i < 2; ++i) { int R, C; stage_rc(tid * 16 + i * 8192, R, C); const int Rb = Epi::PERM ? ((R & ~31) + perm32(R & 31)) : R;
        voffA[i] = (unsigned)(R * K + C) * 2u; voffB[i] = (unsigned)(Rb * K + C) * 2u; }
    const size_t kstep = (size_t)(BK * 2);
    const size_t hstep = (size_t)HALF * K * 2;
    const size_t tstep = 2 * hstep;
    const unsigned ldsw = (unsigned)wid * 1024u;
    const int aoff = lds_byte(wr * 64 + fr, fq * 8), boff = lds_byte(wc * 32 + fr, fq * 8);
#define PG8_SA(b, h) (((b) * 2 + (h)) * HTB)
#define PG8_SB(b, h) ((4 + (b) * 2 + (h)) * HTB)
#define PG8_STAGE(bufoff, gbase, voff) do { _Pragma("unroll") for (int _i = 0; _i < 2; ++_i) \
        __builtin_amdgcn_global_load_lds((const unsigned*)((const char*)(gbase) + (voff)[_i]), (PG8_LAS unsigned*)(lds + (bufoff) + ldsw + _i * 8192), 16, 0, 0); } while (0)
#define PG8_LDA(dst, b, h) do { _Pragma("unroll") for (int m = 0; m < 4; ++m) _Pragma("unroll") for (int k = 0; k < 2; ++k) dst[m][k] = *(const PG8_LAS bf16x8*)(lds + PG8_SA(b, h) + aoff + m * 2048 + k * 1024); } while (0)
#define PG8_LDB(dst, b, h) do { _Pragma("unroll") for (int n = 0; n < 2; ++n) _Pragma("unroll") for (int k = 0; k < 2; ++k) dst[n][k] = *(const PG8_LAS bf16x8*)(lds + PG8_SB(b, h) + boff + n * 2048 + k * 1024); } while (0)
#define PG8_MMA(ai, bj, At, Bt) do { __builtin_amdgcn_s_setprio(1); _Pragma("unroll") for (int m = 0; m < 4; ++m) _Pragma("unroll") for (int n = 0; n < 2; ++n) _Pragma("unroll") for (int k = 0; k < 2; ++k) \
        acc[ai][bj][m][n] = __builtin_amdgcn_mfma_f32_16x16x32_bf16(Bt[n][k], At[m][k], acc[ai][bj][m][n], 0, 0, 0); __builtin_amdgcn_s_setprio(0); } while (0)
#define PG8_WAIT_V(n) asm volatile("s_waitcnt vmcnt(" #n ")" ::: "memory")
#define PG8_WAIT_L(n) asm volatile("s_waitcnt lgkmcnt(" #n ")" ::: "memory")
#define PG8_BAR __builtin_amdgcn_s_barrier()
#define PG8_SCHED __builtin_amdgcn_sched_barrier(0)
    Unit cur, nxt; int ui = 0;
    if (!S.next(0, cur)) return;
    f32x4 acc[2][2][4][2];
#pragma unroll
    for (int a = 0; a < 2; ++a)
#pragma unroll
        for (int b = 0; b < 2; ++b)
#pragma unroll
            for (int m = 0; m < 4; ++m)
#pragma unroll
                for (int n = 0; n < 2; ++n) acc[a][b][m][n] = (f32x4){0.f, 0.f, 0.f, 0.f};
    bf16x8 At[4][2], B0[2][2], B1[2][2];
    const char* cA = (const char*)g.A + (size_t)cur.pm * tstep; const char* cB = (const char*)g.Bt + (size_t)cur.pn * tstep;
    S.a_ready(cur);
    if constexpr (SP2) {
        PG8_STAGE(PG8_SB(0, 0), cB, voffB); PG8_STAGE(PG8_SB(0, 1), cB + hstep, voffB); PG8_STAGE(PG8_SA(0, 0), cA, voffA); PG8_STAGE(PG8_SA(0, 1), cA + hstep, voffA);
        if (wr == 1) PG8_BAR;
        PG8_WAIT_V(2); PG8_BAR;
        PG8_STAGE(PG8_SB(1, 0), cB + kstep, voffB); PG8_STAGE(PG8_SA(1, 0), cA + kstep, voffA); PG8_STAGE(PG8_SB(1, 1), cB + hstep + kstep, voffB);
        PG8_WAIT_V(6); PG8_BAR;
    } else {
        PG8_STAGE(PG8_SB(0, 0), cB, voffB); PG8_STAGE(PG8_SA(0, 0), cA, voffA); PG8_STAGE(PG8_SB(0, 1), cB + hstep, voffB); PG8_STAGE(PG8_SA(0, 1), cA + hstep, voffA);
        if (wr == 1) PG8_BAR;
        PG8_WAIT_V(4); PG8_BAR;
        PG8_STAGE(PG8_SB(1, 0), cB + kstep, voffB); PG8_STAGE(PG8_SA(1, 0), cA + kstep, voffA); PG8_STAGE(PG8_SB(1, 1), cB + hstep + kstep, voffB);
        PG8_WAIT_V(6); PG8_BAR;
    }
    for (;;) {
        const bool has_next = S.next(ui + 1, nxt);
        const char* nA = has_next ? (const char*)g.A + (size_t)nxt.pm * tstep : cA; const char* nB = has_next ? (const char*)g.Bt + (size_t)nxt.pn * tstep : cB;
        for (int t = 0; t < nt; t += 2) {
            const bool last = (t == nt - 2);
            const char* a1 = cA + (size_t)(t + 1) * kstep;
            const char* a2 = last ? nA : cA + (size_t)(t + 2) * kstep; const char* b2 = last ? nB : cB + (size_t)(t + 2) * kstep;
            const char* a3 = a2 + kstep; const char* b3 = b2 + kstep;
            if (last && has_next) S.a_ready(nxt);
            if constexpr (SP2) {
            PG8_LDB(B0, 0, 0); PG8_LDB(B1, 0, 1); PG8_SCHED; PG8_LDA(At, 0, 0); PG8_STAGE(PG8_SA(1, 1), a1 + hstep, voffA);
            PG8_WAIT_V(8); PG8_WAIT_L(0); PG8_BAR; PG8_MMA(0, 0, At, B0); PG8_MMA(0, 1, At, B1); PG8_BAR; PG8_SCHED;
            PG8_LDA(At, 0, 1); PG8_STAGE(PG8_SB(0, 0), b2, voffB); PG8_STAGE(PG8_SB(0, 1), b2 + hstep, voffB); PG8_STAGE(PG8_SA(0, 0), a2, voffA);
            PG8_WAIT_V(8); PG8_WAIT_L(0); PG8_BAR; PG8_MMA(1, 0, At, B0); PG8_MMA(1, 1, At, B1); PG8_BAR; PG8_SCHED;
            PG8_LDB(B0, 1, 0); PG8_LDB(B1, 1, 1); PG8_SCHED; PG8_LDA(At, 1, 0); PG8_STAGE(PG8_SA(0, 1), a2 + hstep, voffA);
            PG8_WAIT_V(8); PG8_WAIT_L(0); PG8_BAR; PG8_MMA(0, 0, At, B0); PG8_MMA(0, 1, At, B1); PG8_BAR; PG8_SCHED;
            PG8_LDA(At, 1, 1); PG8_STAGE(PG8_SB(1, 0), b3, voffB); PG8_STAGE(PG8_SB(1, 1), b3 + hstep, voffB); PG8_STAGE(PG8_SA(1, 0), a3, voffA);
            PG8_WAIT_V(8); PG8_WAIT_L(0); PG8_BAR; PG8_MMA(1, 0, At, B0); PG8_MMA(1, 1, At, B1); PG8_BAR; PG8_SCHED;
            } else {
            PG8_LDB(B0, 0, 0); PG8_SCHED; PG8_LDA(At, 0, 0); PG8_STAGE(PG8_SA(1, 1), a1 + hstep, voffA);
            PG8_WAIT_L(8); PG8_BAR; PG8_WAIT_L(0); PG8_MMA(0, 0, At, B0); PG8_BAR; PG8_SCHED;
            PG8_LDB(B1, 0, 1); PG8_STAGE(PG8_SB(0, 0), b2, voffB);
            PG8_BAR; PG8_WAIT_L(0); PG8_MMA(0, 1, At, B1); PG8_BAR;
            PG8_LDA(At, 0, 1); PG8_STAGE(PG8_SA(0, 0), a2, voffA);
            PG8_BAR; PG8_WAIT_L(0); PG8_MMA(1, 0, At, B0); PG8_BAR; PG8_SCHED;
            PG8_STAGE(PG8_SB(0, 1), b2 + hstep, voffB);
            PG8_WAIT_V(6); PG8_BAR; PG8_MMA(1, 1, At, B1); PG8_BAR;
            PG8_LDB(B0, 1, 0); PG8_SCHED; PG8_LDA(At, 1, 0); PG8_STAGE(PG8_SA(0, 1), a2 + hstep, voffA);
            PG8_WAIT_L(8); PG8_BAR; PG8_WAIT_L(0); PG8_MMA(0, 0, At, B0); PG8_BAR; PG8_SCHED;
            PG8_LDB(B1, 1, 1); PG8_STAGE(PG8_SB(1, 0), b3, voffB);
            PG8_BAR; PG8_WAIT_L(0); PG8_MMA(0, 1, At, B1); PG8_BAR;
            PG8_LDA(At, 1, 1); PG8_STAGE(PG8_SA(1, 0), a3, voffA);
            PG8_BAR; PG8_WAIT_L(0); PG8_MMA(1, 0, At, B0); PG8_BAR; PG8_SCHED;
            PG8_STAGE(PG8_SB(1, 1), b3 + hstep, voffB);
            PG8_WAIT_V(6); PG8_BAR; PG8_MMA(1, 1, At, B1); PG8_BAR;
            }
        }
        if constexpr (ALIGN_EPI) { if (wr == 0) PG8_BAR; }
        if constexpr (!Epi::AFTER_DRAIN) { E(acc, cur, wr, wc, fr, fq); S.done(cur); }
        if (!has_next) break;
#pragma unroll
        for (int a = 0; a < 2; ++a)
#pragma unroll
            for (int b = 0; b < 2; ++b)
#pragma unroll
                for (int m = 0; m < 4; ++m)
#pragma unroll
                    for (int n = 0; n < 2; ++n) acc[a][b][m][n] = (f32x4){0.f, 0.f, 0.f, 0.f};
        cur = nxt; cA = nA; cB = nB; ++ui;
        if constexpr (ALIGN_EPI) { if (wr == 1) PG8_BAR; }
    }
    PG8_WAIT_V(0);
    if constexpr (!ALIGN_EPI) { if (wr == 0) PG8_BAR; }
    PG8_BAR;
    if constexpr (Epi::AFTER_DRAIN) { E.fused(acc, cur, wr, wc, fr, fq, lds, wid, lane); S.done(cur); }
#undef PG8_SA
#undef PG8_SB
#undef PG8_STAGE
#undef PG8_LDA
#undef PG8_LDB
#undef PG8_MMA
#undef PG8_WAIT_V
#undef PG8_WAIT_L
#undef PG8_BAR
#undef PG8_SCHED
}
}

DEVI pg8::u32x4 pack8(const pg8::f32x4& a, const pg8::f32x4& b) { pg8::u32x4 w; w.x = pg8::cvt_pk_bf16(a[0], a[1]); w.y = pg8::cvt_pk_bf16(a[2], a[3]); w.z = pg8::cvt_pk_bf16(b[0], b[1]); w.w = pg8::cvt_pk_bf16(b[2], b[3]); return w; }
DEVI pg8::f32x4 silu4(const pg8::f32x4& a) { pg8::f32x4 r; r[0] = siluf_(a[0]); r[1] = siluf_(a[1]); r[2] = siluf_(a[2]); r[3] = siluf_(a[3]); return r; }
struct FEpi1 {
    static constexpr bool PERM = true, AFTER_DRAIN = false;
    bf16_t *QK, *V, *SGA, *Z, *CBG; float* ALR;
    DEVI void operator()(const pg8::f32x4 (&acc)[2][2][4][2], const pg8::Unit& u, int wr, int wc, int fr, int fq) const {
        const int t = u.pn, row0 = u.pm * 256 + wr * 64 + fr, cw = wc * 32 + 8 * fq;
#pragma unroll
        for (int ai = 0; ai < 2; ++ai)
#pragma unroll
            for (int m = 0; m < 4; ++m) {
                const size_t row = (size_t)(row0 + ai * 128 + m * 16);
                if (t < 12) {
                    bf16_t* base = t < 4 ? QK + row * 1024 + t * 256 : (t < 8 ? V + row * 1024 + (t - 4) * 256 : SGA + row * 1024 + (t - 8) * 256);
#pragma unroll
                    for (int bj = 0; bj < 2; ++bj) { pg8::f32x4 v0 = acc[ai][bj][m][0], v1 = acc[ai][bj][m][1]; if (t >= 8) { v0 = silu4(v0); v1 = silu4(v1); }
                        *(pg8::u32x4*)(base + bj * 128 + cw) = pack8(v0, v1); }
                } else if (t == 12) {
                    if (wc == 0) { *(pg8::f32x4*)(ALR + row * 32 + 8 * fq) = acc[ai][0][m][0]; *(pg8::f32x4*)(ALR + row * 32 + 8 * fq + 4) = acc[ai][0][m][1]; }
                } else if (t < 21) {
                    *(pg8::u32x4*)(Z + row * 1024 + (t - 13) * 128 + cw) = pack8(acc[ai][0][m][0] * acc[ai][1][m][0], acc[ai][0][m][1] * acc[ai][1][m][1]);
                } else {
                    *(pg8::u32x4*)(CBG + row * 1024 + (t - 21) * 128 + cw) = pack8(acc[ai][0][m][0] * silu4(acc[ai][1][m][0]), acc[ai][0][m][1] * silu4(acc[ai][1][m][1]));
                }
            }
    }
};
struct FEpiRes {
    static constexpr bool PERM = false, AFTER_DRAIN = false;
    const float* xl; const float* xc; float* outl; float* outc; const float* MODl;
    DEVI void operator()(const pg8::f32x4 (&acc)[2][2][4][2], const pg8::Unit& u, int wr, int wc, int fr, int fq) const {
        const int row0 = u.pm * 256 + wr * 64 + fr, col0 = u.pn * 256 + wc * 32 + 4 * fq;
        const bool lat = u.pm < NLAT / 256;
        const float* gate = MODl + (size_t)(lat ? (u.pm >> 4) : 4) * 3072 + 2048 + col0;
        pg8::f32x4 gv[2][2];
#pragma unroll
        for (int bj = 0; bj < 2; ++bj)
#pragma unroll
            for (int n = 0; n < 2; ++n) gv[bj][n] = *(const pg8::f32x4*)(gate + bj * 128 + n * 16);
        const float* xin = lat ? xl : xc - (size_t)NLAT * 1024; float* o = lat ? outl : outc - (size_t)NLAT * 1024;
#pragma unroll
        for (int ai = 0; ai < 2; ++ai)
#pragma unroll
            for (int m = 0; m < 4; ++m) { const size_t off = (size_t)(row0 + ai * 128 + m * 16) * 1024 + col0;
#pragma unroll
                for (int bj = 0; bj < 2; ++bj)
#pragma unroll
                    for (int n = 0; n < 2; ++n) { const pg8::f32x4 xv = *(const pg8::f32x4*)(xin + off + bj * 128 + n * 16); *(pg8::f32x4*)(o + off + bj * 128 + n * 16) = xv + gv[bj][n] * acc[ai][bj][m][n]; } }
    }
};
struct FEpi3 {
    static constexpr bool PERM = true, AFTER_DRAIN = false;
    bf16_t* XR; bf16_t* SG;
    DEVI void operator()(const pg8::f32x4 (&acc)[2][2][4][2], const pg8::Unit& u, int wr, int wc, int fr, int fq) const {
        const int t = u.pn, row0 = u.pm * 256 + wr * 64 + fr, cw = wc * 32 + 8 * fq;
        bf16_t* base = t < 8 ? XR + t * 256 : SG + (t - 8) * 256;
#pragma unroll
        for (int ai = 0; ai < 2; ++ai)
#pragma unroll
            for (int m = 0; m < 4; ++m) { bf16_t* rp = base + (size_t)(row0 + ai * 128 + m * 16) * 2048 + cw;
#pragma unroll
                for (int bj = 0; bj < 2; ++bj) { pg8::f32x4 v0 = acc[ai][bj][m][0], v1 = acc[ai][bj][m][1]; if (t >= 8) { v0 = silu4(v0); v1 = silu4(v1); }
                    *(pg8::u32x4*)(rp + bj * 128) = pack8(v0, v1); } }
    }
};
#ifndef FAST_GEMM
#define FAST_GEMM 1
#endif


#define LASP __attribute__((address_space(3)))
__device__ void st_glawalk(const Params& p, int vb, int nvb, unsigned char* lds_, const bf16_t* QIN, const bf16_t* KET, const bf16_t* SC, const float* DEC, const bf16_t* VT, bf16_t* OF, bf16_t* OB) {
    typedef pg8::bf16x8 bx8; typedef pg8::f32x4 f4; typedef unsigned u32x2 __attribute__((ext_vector_type(2)));
    LASP unsigned char* lds = (LASP unsigned char*)lds_;
    constexpr int QOFF = 0, KOFF = 17408, SOFF = KOFF + 18432, VOFF = SOFF + 9216, DOFF = VOFF + 4608, BUFSZ = 50176;
    const int tid = threadIdx.x, wid = __builtin_amdgcn_readfirstlane(tid >> 6), lane = tid & 63, c = lane & 15, g = lane >> 4;
    for (int item = vb; item < 256; item += nvb) {
        const int vs = item & 7, combo = item >> 3, d = combo & 1, h = (combo >> 1) & 3, bb = combo >> 3;
        int soff[6], doff[6];
        { const int p0 = tid, p1 = tid + 512; soff[0] = (p0 >> 4) * 256 + (p0 & 15) * 16; doff[0] = QOFF + (p0 >> 4) * 272 + (p0 & 15) * 16; soff[1] = (p1 >> 4) * 256 + (p1 & 15) * 16; doff[1] = QOFF + (p1 >> 4) * 272 + (p1 & 15) * 16;
          const int q2 = tid, q3 = tid + 512; soff[2] = (q2 >> 3) * 128 + (q2 & 7) * 16; doff[2] = KOFF + (q2 >> 3) * 144 + (q2 & 7) * 16; soff[3] = (q3 >> 3) * 128 + (q3 & 7) * 16; doff[3] = KOFF + (q3 >> 3) * 144 + (q3 & 7) * 16;
          soff[4] = (tid >> 3) * 128 + (tid & 7) * 16; doff[4] = SOFF + (tid >> 3) * 144 + (tid & 7) * 16;
          if (tid < 256) { soff[5] = (vs * 32 + (tid >> 3)) * 128 + (tid & 7) * 16; doff[5] = VOFF + (tid >> 3) * 144 + (tid & 7) * 16; } else { soff[5] = (tid - 256) * 16; doff[5] = DOFF + (tid - 256) * 16; } }
        const bool has5 = tid < 288;
        pg8::u32x4 r0[6], r1[6];
#define GW_LOAD(R, step) do { const int cc_ = d == 0 ? ((step) < 4 ? 64 + (step) : (step) - 4) : 67 - (step); const size_t u_ = (size_t)((bb * NCH + cc_) * 4 + h) * 2 + d; \
            const unsigned char* q_ = (const unsigned char*)QIN + u_ * 16384; const unsigned char* k_ = (const unsigned char*)KET + u_ * 16384; const unsigned char* s_ = (const unsigned char*)SC + u_ * 8192; \
            const unsigned char* x5_ = tid < 256 ? (const unsigned char*)VT + (u_ >> 1) * 32768 : (const unsigned char*)DEC + u_ * 512; \
            R[0] = *(const pg8::u32x4*)(q_ + soff[0]); R[1] = *(const pg8::u32x4*)(q_ + soff[1]); R[2] = *(const pg8::u32x4*)(k_ + soff[2]); R[3] = *(const pg8::u32x4*)(k_ + soff[3]); R[4] = *(const pg8::u32x4*)(s_ + soff[4]); \
            if (has5) R[5] = *(const pg8::u32x4*)(x5_ + soff[5]); } while (0)
#define GW_WRITE(R, bufi) do { LASP unsigned char* b_ = lds + (bufi) * BUFSZ; _Pragma("unroll") for (int j_ = 0; j_ < 5; ++j_) *(LASP pg8::u32x4*)(b_ + doff[j_]) = R[j_]; if (has5) *(LASP pg8::u32x4*)(b_ + doff[5]) = R[5]; } while (0)
#define GW_COMPUTE(step) do { if (wid < 2) { \
                const LASP unsigned char* B = lds + ((step) & 1) * BUFSZ; \
                const bx8 bv0 = *(const LASP bx8*)(B + VOFF + (16 * wid + c) * 144 + g * 16), bv1 = *(const LASP bx8*)(B + VOFF + (16 * wid + c) * 144 + 64 + g * 16); \
                bx8 sB[4]; \
                _Pragma("unroll") for (int ks = 0; ks < 4; ++ks) { pg8::u32x4 w; w.x = pg8::cvt_pk_bf16(S[2 * ks][0], S[2 * ks][1]); w.y = pg8::cvt_pk_bf16(S[2 * ks][2], S[2 * ks][3]); \
                    w.z = pg8::cvt_pk_bf16(S[2 * ks + 1][0], S[2 * ks + 1][1]); w.w = pg8::cvt_pk_bf16(S[2 * ks + 1][2], S[2 * ks + 1][3]); sB[ks] = __builtin_bit_cast(bx8, w); } \
                f4 o[4]; \
                _Pragma("unroll") for (int mt = 0; mt < 4; ++mt) o[mt] = (f4){0.f, 0.f, 0.f, 0.f}; \
                _Pragma("unroll") for (int ks = 0; ks < 4; ++ks) \
                    _Pragma("unroll") for (int mt = 0; mt < 4; ++mt) { const LASP unsigned char* qa = B + QOFF + (16 * mt + c) * 272 + (32 * ks + 4 * g) * 2; \
                        const u32x2 lo = *(const LASP u32x2*)qa, hi = *(const LASP u32x2*)(qa + 32); pg8::u32x4 w; w.x = lo.x; w.y = lo.y; w.z = hi.x; w.w = hi.y; \
                        o[mt] = __builtin_amdgcn_mfma_f32_16x16x32_bf16(sB[ks], __builtin_bit_cast(bx8, w), o[mt], 0, 0, 0); } \
                _Pragma("unroll") for (int mt = 0; mt < 4; ++mt) { const LASP unsigned char* sa = B + SOFF + (16 * mt + c) * 144 + g * 16; \
                    o[mt] = __builtin_amdgcn_mfma_f32_16x16x32_bf16(bv0, *(const LASP bx8*)sa, o[mt], 0, 0, 0); \
                    o[mt] = __builtin_amdgcn_mfma_f32_16x16x32_bf16(bv1, *(const LASP bx8*)(sa + 64), o[mt], 0, 0, 0); } \
                const int cc = d == 0 ? ((step) < 4 ? 64 + (step) : (step) - 4) : 67 - (step); const int row0 = row_of(bb, cc, 0); \
                _Pragma("unroll") for (int mt = 0; mt < 4; ++mt) { u32x2 w; w.x = pg8::cvt_pk_bf16(o[mt][0], o[mt][1]); w.y = pg8::cvt_pk_bf16(o[mt][2], o[mt][3]); \
                    *(u32x2*)(O + (size_t)(row0 + 16 * mt + c) * 1024 + h * 256 + vs * 32 + 16 * wid + 4 * g) = w; } \
                _Pragma("unroll") for (int m = 0; m < 8; ++m) { const f4 dv = *(const LASP f4*)(B + DOFF + (16 * m + 4 * g) * 4); const LASP unsigned char* ka = B + KOFF + (16 * m + c) * 144 + g * 16; \
                    S[m] = S[m] * dv; \
                    S[m] = __builtin_amdgcn_mfma_f32_16x16x32_bf16(*(const LASP bx8*)ka, bv0, S[m], 0, 0, 0); \
                    S[m] = __builtin_amdgcn_mfma_f32_16x16x32_bf16(*(const LASP bx8*)(ka + 64), bv1, S[m], 0, 0, 0); } \
            } } while (0)
        f4 S[8];
#pragma unroll
        for (int m = 0; m < 8; ++m) S[m] = (f4){0.f, 0.f, 0.f, 0.f};
        bf16_t* O = d == 0 ? OF : OB;
        LDS_BARRIER();
        GW_LOAD(r0, 0); GW_WRITE(r0, 0); GW_LOAD(r0, 1); GW_LOAD(r1, 2);
        LDS_BARRIER();
        for (int step = 0; step < NCH; step += 2) {
            GW_WRITE(r0, 1); if (step + 3 < NCH) GW_LOAD(r0, step + 3);
            GW_COMPUTE(step);
            LDS_BARRIER();
            if (step + 2 < NCH) { GW_WRITE(r1, 0); if (step + 4 < NCH) GW_LOAD(r1, step + 4); }
            GW_COMPUTE(step + 1);
            LDS_BARRIER();
        }
#undef GW_COMPUTE
#undef GW_LOAD
#undef GW_WRITE
    }
}
#ifndef FAST_WALK
#define FAST_WALK 1
#endif

template <int MODE>
__device__ void st_rglru(const Params& p, int vb, int nvb, unsigned char* lds_, const bf16_t* XR, const bf16_t* SG, const bf16_t* BD, float* SUMA, float* SUMH, bf16_t* Y) {
    typedef pg8::bf16x8 bx8; typedef pg8::f32x4 f4; typedef float f32x2v __attribute__((ext_vector_type(2)));
    LASP unsigned char* lds = (LASP unsigned char*)lds_;
    constexpr int AOFF = 0, FOFF = 17408, BUF = 51200, CWOFF = 2 * BUF;
    constexpr int ND = MODE == 0 ? 1 : 2, NCOMBO = MODE == 0 ? 32 : 16, NTILE = MODE == 0 ? NB * NCH : NB * 64;
    const int tid = threadIdx.x, wid = __builtin_amdgcn_readfirstlane(tid >> 6), lane = tid & 63, c = lane & 15, g = lane >> 4, cp = tid & 63, tg = tid >> 6;
    int P, part, cstep, combo0;
    if (nvb >= NCOMBO) { P = nvb / NCOMBO; part = vb / NCOMBO; cstep = NCOMBO; combo0 = vb % NCOMBO; if (part >= P) return; } else { P = 1; part = 0; cstep = nvb; combo0 = vb; }
    for (int combo = combo0; combo < NCOMBO; combo += cstep) {
        const int nb = MODE == 0 ? (combo >> 1) : combo, d0 = MODE == 0 ? (combo & 1) : 0;
        const int ch = nb * 128 + 16 * wid + c;
        bx8 wa[ND][4], wx[ND][4]; float ba[ND], bxx[ND], k8[ND];
        LDS_BARRIER();
#pragma unroll
        for (int dd = 0; dd < ND; ++dd) { const int d = d0 + dd;
            const bf16_t* wA = BD + ((size_t)(d * 16 + nb) * 128 + 16 * wid + c) * 128 + 8 * g; const bf16_t* wX = wA + (size_t)2 * 16 * 128 * 128;
#pragma unroll
            for (int ks = 0; ks < 4; ++ks) { wa[dd][ks] = *(const bx8*)(wA + 32 * ks); wx[dd][ks] = *(const bx8*)(wX + 32 * ks); }
            ba[dd] = p.o_b_a[d * 2048 + ch]; bxx[dd] = p.o_b_x[d * 2048 + ch]; k8[dd] = 8.f * 1.4426950408889634f * softplusf_(-p.o_lam[d * 2048 + ch]);
            if (tg < 5) { const f32x2v w2 = tg < 4 ? *(const f32x2v*)(p.o_conv_w + ((size_t)d * 4 + tg) * 2048 + nb * 128 + 2 * cp) : *(const f32x2v*)(p.o_conv_b + (size_t)d * 2048 + nb * 128 + 2 * cp);
                *(LASP f32x2v*)(lds + CWOFF + ((dd * 5 + tg) * 128 + 2 * cp) * 4) = w2; } }
        LDS_BARRIER();
        unsigned xr[14]; float cnext[2] = {0.f, 0.f};
#define RG_PREF(tile) do { const int bb_ = MODE == 0 ? (tile) / NCH : (tile) >> 6, cc_ = MODE == 0 ? (tile) % NCH : (tile) & 63; const int seg0_ = cc_ < 64 ? bb_ * 4096 : NLAT + bb_ * 256, segn_ = cc_ < 64 ? 4096 : 256; \
            const int tl_ = row_of(bb_, cc_, 0) - seg0_ + 8 * tg - 3; _Pragma("unroll") for (int jr = 0; jr < 14; ++jr) { const int tt_ = tl_ + jr; const bool need_ = MODE == 1 || (d0 == 0 ? jr < 11 : jr >= 3); \
                xr[jr] = (need_ && tt_ >= 0 && tt_ < segn_) ? *(const unsigned*)(XR + (size_t)(seg0_ + tt_) * 2048 + nb * 128 + 2 * cp) : 0u; } \
            if (MODE == 1) { cnext[0] = SUMH[(((size_t)bb_ * 2 + 0) * NCH + cc_) * 2048 + ch]; cnext[1] = SUMH[(((size_t)bb_ * 2 + 1) * NCH + cc_) * 2048 + ch]; } } while (0)
        int it = 0;
        if (part < NTILE) RG_PREF(part);
        for (int tile = part; tile < NTILE; tile += P) {
            const int bb = MODE == 0 ? tile / NCH : tile >> 6, cc = MODE == 0 ? tile % NCH : tile & 63; const int row0 = row_of(bb, cc, 0);
            unsigned xcur[14]; float ccur[2];
#pragma unroll
            for (int jr = 0; jr < 14; ++jr) xcur[jr] = xr[jr];
            ccur[0] = cnext[0]; ccur[1] = cnext[1];
            if (tile + P < NTILE) RG_PREF(tile + P);
            float hsum[4][4];
#pragma unroll
            for (int dd = 0; dd < ND; ++dd) { const int d = d0 + dd;
                LASP unsigned char* B = lds + (it & 1) * BUF; ++it;
                { f32x2v cv[8]; const f32x2v cbv = *(const LASP f32x2v*)(lds + CWOFF + ((dd * 5 + 4) * 128 + 2 * cp) * 4);
#pragma unroll
                  for (int i = 0; i < 8; ++i) cv[i] = cbv;
#pragma unroll
                  for (int jj = 0; jj < 4; ++jj) { const f32x2v cwv = *(const LASP f32x2v*)(lds + CWOFF + ((dd * 5 + jj) * 128 + 2 * cp) * 4);
#pragma unroll
                      for (int i = 0; i < 8; ++i) { const int jr = d == 0 ? i + jj : i + 6 - jj; cv[i].x += cwv.x * __uint_as_float(xcur[jr] << 16); cv[i].y += cwv.y * __uint_as_float(xcur[jr] & 0xffff0000u); } }
#pragma unroll
                  for (int i = 0; i < 8; ++i) { *(LASP unsigned*)(B + AOFF + (8 * tg + i) * 272 + 4 * cp) = pg8::cvt_pk_bf16(cv[i].x, cv[i].y); *(LASP f32x2v*)(B + FOFF + (8 * tg + i) * 528 + 8 * cp) = cv[i]; } }
                LDS_BARRIER();
                const int gl = d == 0 ? g : 3 - g;
                const int src1 = d == 0 ? lane - 16 : lane + 16, src2 = d == 0 ? lane - 32 : lane + 32, srcT = d == 0 ? 48 + c : c;
                const size_t sidx = (((size_t)bb * 2 + d) * NCH + cc) * 2048 + ch;
                float carryH = MODE == 0 ? 0.f : ccur[dd], carryA = 1.f;
#pragma unroll
                for (int mtl = 0; mtl < 4; ++mtl) { const int mt = d == 0 ? mtl : 3 - mtl;
                    f4 aam = (f4){0.f, 0.f, 0.f, 0.f}, axm = (f4){0.f, 0.f, 0.f, 0.f};
#pragma unroll
                    for (int ks = 0; ks < 4; ++ks) { const bx8 af = *(const LASP bx8*)(B + AOFF + (16 * mt + c) * 272 + (32 * ks + 8 * g) * 2);
                        aam = __builtin_amdgcn_mfma_f32_16x16x32_bf16(af, wa[dd][ks], aam, 0, 0, 0); axm = __builtin_amdgcn_mfma_f32_16x16x32_bf16(af, wx[dd][ks], axm, 0, 0, 0); }
                    float Pq[4], Lq[4]; float pa = 1.f, lh = 0.f;
#pragma unroll
                    for (int sq = 0; sq < 4; ++sq) { const int r = d == 0 ? sq : 3 - sq;
                        const float xv = *(const LASP float*)(B + FOFF + (16 * mt + 4 * g + r) * 528 + (16 * wid + c) * 4);
                        const float rr = sigmoidf_(aam[r] + ba[dd]), ii = sigmoidf_(axm[r] + bxx[dd]);
                        const float a = fexp2_(-k8[dd] * rr), u = __builtin_amdgcn_sqrtf(fmaxf(1.f - a * a, 0.f)) * (ii * xv);
                        lh = a * lh + u; pa *= a; Pq[sq] = pa; Lq[sq] = lh; }
                    float XA = pa, XU = lh, tA, tU;
                    tA = __shfl(XA, src1); tU = __shfl(XU, src1); if (gl >= 1) { XU = tU * XA + XU; XA = tA * XA; }
                    tA = __shfl(XA, src2); tU = __shfl(XU, src2); if (gl >= 2) { XU = tU * XA + XU; XA = tA * XA; }
                    const float totA = __shfl(XA, srcT), totU = __shfl(XU, srcT);
                    if (MODE == 1) {
                        float eA = __shfl(XA, src1), eU = __shfl(XU, src1); if (gl == 0) { eA = 1.f; eU = 0.f; }
                        const float hin = carryH * eA + eU;
#pragma unroll
                        for (int sq = 0; sq < 4; ++sq) { const int r = d == 0 ? sq : 3 - sq; const float hv = hin * Pq[sq] + Lq[sq]; if (dd == 0) hsum[mt][r] = hv; else hsum[mt][r] += hv; }
                    }
                    carryH = carryH * totA + totU; carryA *= totA;
                }
                if (MODE == 0) { if (g == 0) { SUMA[sidx] = carryA; SUMH[sidx] = carryH; } }
            }
            if (MODE == 1) {
#pragma unroll
                for (int mt = 0; mt < 4; ++mt)
#pragma unroll
                    for (int r = 0; r < 4; ++r) { const size_t o = (size_t)(row0 + 16 * mt + 4 * g + r) * 2048 + ch; Y[o] = f2bf(hsum[mt][r] * bf2f(SG[o])); }
            }
        }
        LDS_BARRIER();
#undef RG_PREF
    }
}
#ifndef FAST_RG
#define FAST_RG 1
#endif

#define XB_TMO      128
#define XB_XCNT(j)  (256  + 64 * (j))
#define XB_XSUB(j)  (1280 + 64 * (j))
#define XB_XGEN(j)  (2304 + 64 * (j))
#define XB_TOP      3328
#define XB_TOPGEN   3392
#define XB_SPIN_CAP (1u << 20)
DEVI unsigned xb_ld(unsigned* p)              { return __hip_atomic_load(p, __ATOMIC_RELAXED, __HIP_MEMORY_SCOPE_AGENT); }
DEVI unsigned xb_add(unsigned* p, unsigned v) { return __hip_atomic_fetch_add(p, v, __ATOMIC_RELAXED, __HIP_MEMORY_SCOPE_AGENT); }
DEVI unsigned xb_xcc_id() { return (unsigned)__builtin_amdgcn_s_getreg((3 << 11) | 20) & 0xFu; }
#define XB_SPIN(cond, bar) do { unsigned _sp = 0; while (cond) { __builtin_amdgcn_s_sleep(1); \
    if ((++_sp & 255u) == 0u) { if (xb_ld(&(bar)[XB_TMO])) break; if (_sp > XB_SPIN_CAP) { atomicAdd(&(bar)[XB_TMO], 1u); break; } } } } while (0)
struct XcdBarrier { unsigned* bar; unsigned x; volatile __attribute__((address_space(3))) unsigned* st; };
DEVI XcdBarrier xcd_barrier_post(unsigned* bar, volatile __attribute__((address_space(3))) unsigned* st) {
    XcdBarrier b; b.bar = bar; b.x = xb_xcc_id(); b.st = st;
    if (threadIdx.x == 0) (void)xb_add(&bar[XB_XCNT(b.x)], 1u);
    return b;
}
DEVI void xcd_barrier_complete(unsigned* bar, unsigned x, unsigned& nloc, unsigned& nx) {
    const unsigned G = gridDim.x * gridDim.y * gridDim.z;
    unsigned sum, cnt, mine, sp = 0u;
    for (;;) {
        sum = 0u; cnt = 0u; mine = 0u;
#pragma unroll
        for (unsigned j = 0; j < 16; ++j) { const unsigned c = xb_ld(&bar[XB_XCNT(j)]); sum += c; cnt += (c > 0u) ? 1u : 0u; mine = (j == x) ? c : mine; }
        if (sum == G) break;
        __builtin_amdgcn_s_sleep(1);
        if ((++sp & 255u) == 0u) { if (xb_ld(&bar[XB_TMO])) break; if (sp > XB_SPIN_CAP) { atomicAdd(&bar[XB_TMO], 1u); break; } }
    }
    nloc = mine > 0u ? mine : 1u; nx = cnt > 0u ? cnt : 1u;
}
DEVI void xcd_barrier(const XcdBarrier& b) {
    asm volatile("s_waitcnt vmcnt(0)" ::: "memory");
    __syncthreads();
    if (threadIdx.x == 0) {
        unsigned* bar = b.bar;
        __builtin_amdgcn_s_waitcnt(0);
        unsigned nloc = b.st[0], nx = b.st[1];
        if (nloc == 0u) { xcd_barrier_complete(bar, b.x, nloc, nx); b.st[0] = nloc; b.st[1] = nx; }
        const unsigned old = xb_add(&bar[XB_XSUB(b.x)], 1u);
        const unsigned gen = old / nloc;
        if (old + 1u == (gen + 1u) * nloc) {
            __builtin_amdgcn_fence(__ATOMIC_RELEASE, "agent");
            asm volatile("s_waitcnt vmcnt(0)" ::: "memory");
            const unsigned og = xb_add(&bar[XB_TOP], 1u);
            const unsigned tg = og / nx;
            if (og + 1u == (tg + 1u) * nx) xb_add(&bar[XB_TOPGEN], 1u);
            else XB_SPIN(xb_ld(&bar[XB_TOPGEN]) == tg, bar);
            __builtin_amdgcn_fence(__ATOMIC_ACQUIRE, "agent");
            xb_add(&bar[XB_XGEN(b.x)], 1u);
            asm volatile("s_waitcnt vmcnt(0)" ::: "memory");
        } else {
            XB_SPIN(xb_ld(&bar[XB_XGEN(b.x)]) == gen, bar);
            __builtin_amdgcn_fence(__ATOMIC_ACQUIRE, "agent");
            asm volatile("s_waitcnt vmcnt(0)" ::: "memory");
        }
    }
    __syncthreads();
}
__device__ __forceinline__ void run_stage(const Params& p, int st, int vb, int nvb, unsigned char* lds) {
    unsigned char* ws = p.ws;
    float* MOD = (float*)(ws + WS_MOD); float* ALR = (float*)(ws + WS_ALR); float* X1C = (float*)(ws + WS_X1C);
    float* SUMA = (float*)(ws + WS_SUMA); float* SUMH = (float*)(ws + WS_SUMH); float* DEC = (float*)(ws + WS_DEC);
    bf16_t* Bt1 = (bf16_t*)(ws + WS_BT1); bf16_t* Bt2 = (bf16_t*)(ws + WS_BT2); bf16_t* Bt3 = (bf16_t*)(ws + WS_BT3); bf16_t* Bt4 = (bf16_t*)(ws + WS_BT4);
    bf16_t* S0 = (bf16_t*)(ws + WS_SLOT(0)); bf16_t* S1 = (bf16_t*)(ws + WS_SLOT(1)); bf16_t* S2 = (bf16_t*)(ws + WS_SLOT(2));
    bf16_t* S3 = (bf16_t*)(ws + WS_SLOT(3)); bf16_t* S4 = (bf16_t*)(ws + WS_SLOT(4)); bf16_t* S5 = (bf16_t*)(ws + WS_SLOT(5));
    bf16_t* DO0 = (bf16_t*)p.out; bf16_t* DOSC = (bf16_t*)((unsigned char*)p.out + 34 * MiB);
    switch (st) {
    case 0: st_mod(p, vb, nvb, (float*)lds); st_wprep(p, vb, nvb, lds); break;
    case 1: st_modulate(p, vb, nvb, 0, p.x, p.ctx, S0); break;
    case 3: st_glaprep(p, vb, nvb, lds, S1, S2, ALR, S3, S4, DOSC, DEC, S5); break;
#if FAST_WALK
    case 4: st_glawalk(p, vb, nvb, lds, S3, S4, DOSC, DEC, S5, S2, DO0); break;
#else
    case 4: st_glawalk_naive(p, vb, nvb, (float*)lds, S3, S4, DOSC, DEC, S5, S2, DO0); break;
#endif
    case 6: st_inner(p, vb, nvb, S2, DO0, S3, S4, S5, S0); break;
    case 8: st_modulate(p, vb, nvb, 1, p.out, X1C, S2); break;
    case 11: st_carry(p, vb, nvb, SUMA, SUMH); break;
#if FAST_RG
    case 10: st_rglru<0>(p, vb, nvb, lds, S3, S0, (const bf16_t*)(ws + WS_BD), SUMA, SUMH, S0); break;
    case 12: st_rglru<1>(p, vb, nvb, lds, S3, S0, (const bf16_t*)(ws + WS_BD), SUMA, SUMH, S0); break;
#else
    case 10: st_rglru_naive<0>(p, vb, nvb, (float*)lds, S3, S0, SUMA, SUMH, S0); break;
    case 12: st_rglru_naive<1>(p, vb, nvb, (float*)lds, S3, S0, SUMA, SUMH, S0); break;
#endif
    case 14: st_final(p, vb, nvb); break;
#if FAST_GEMM
    case 2: { FEpi1 E{S1, S2, S3, S4, S5, ALR}; pg8::Gemm g{S0, Bt1, NT, N1, 1024}; pg8::TileOrder S; S.init(NT / 256, 9, nvb, vb, 0, 8, 0, 12);
              pg8::gemm_phase<FEpi1, pg8::TileOrder, true, true>((PG8_LAS unsigned char*)lds, g, S, E); } break;
    case 5: { FEpi1 E{S1, S2, S3, S4, S5, ALR}; pg8::Gemm g{S0, Bt1, NT, N1, 1024}; pg8::TileOrder S; S.init(NT / 256, 20, nvb, vb, 0, 4, 8, 13);
              pg8::gemm_phase<FEpi1, pg8::TileOrder, true, true>((PG8_LAS unsigned char*)lds, g, S, E); } break;
    case 7: { FEpiRes E{p.x, p.ctx, p.out, X1C, MOD}; pg8::Gemm g{S0, Bt2, NT, 1024, 2048}; pg8::TileOrder S; S.init(NT / 256, 4, nvb, vb);
              pg8::gemm_phase<FEpiRes, pg8::TileOrder, true, true>((PG8_LAS unsigned char*)lds, g, S, E); } break;
    case 9: { FEpi3 E{S3, S0}; pg8::Gemm g{S2, Bt3, NT, 4096, 1024}; pg8::TileOrder S; S.init(NLAT / 256, 16, nvb, vb, 0, 1 << 30, 0, 0, NCTX / 256, 8, NLAT / 256);
              pg8::gemm_phase<FEpi3, pg8::TileOrder, true, true>((PG8_LAS unsigned char*)lds, g, S, E); } break;
    case 13: { FEpiRes E{p.out, nullptr, p.out, nullptr, MOD + 5 * 3072}; pg8::Gemm g{S0, Bt4, NLAT, 1024, 2048}; pg8::TileOrder S; S.init(NLAT / 256, 4, nvb, vb);
              pg8::gemm_phase<FEpiRes, pg8::TileOrder, true, true>((PG8_LAS unsigned char*)lds, g, S, E); } break;
#else
    case 2: { Epi1 E{S1, S2, S3, S4, S5, ALR}; st_gemm_naive(vb, nvb, (float*)lds, S0, Bt1, 0, NT / 32, 0, 8, 1024, E); st_gemm_naive(vb, nvb, (float*)lds, S0, Bt1, 0, NT / 32, 12, 13, 1024, E); } break;
    case 5: { Epi1 E{S1, S2, S3, S4, S5, ALR}; st_gemm_naive(vb, nvb, (float*)lds, S0, Bt1, 0, NT / 32, 8, 12, 1024, E); st_gemm_naive(vb, nvb, (float*)lds, S0, Bt1, 0, NT / 32, 13, 29, 1024, E); } break;
    case 7: { EpiRes E{p.x, p.ctx, p.out, X1C, MOD}; st_gemm_naive(vb, nvb, (float*)lds, S0, Bt2, 0, NT / 32, 0, 4, 2048, E); } break;
    case 9: { Epi3 E{S3, S0}; st_gemm_naive(vb, nvb, (float*)lds, S2, Bt3, 0, NLAT / 32, 0, 16, 1024, E); st_gemm_naive(vb, nvb, (float*)lds, S2, Bt3, NLAT / 32, NT / 32, 0, 8, 1024, E); } break;
    case 13: { EpiRes E{p.out, nullptr, p.out, nullptr, MOD + 5 * 3072}; st_gemm_naive(vb, nvb, (float*)lds, S0, Bt4, 0, NLAT / 32, 0, 4, 2048, E); } break;
#endif
    }
}
constexpr int NSTAGES = 15;
constexpr int LDS_BYTES = 147456;

#ifndef ONE_LAUNCH
#define ONE_LAUNCH 1
#endif
#if !ONE_LAUNCH
__global__ void __launch_bounds__(NTHREADS) k_mega(Params p, int st) {
    extern __shared__ __attribute__((aligned(16))) unsigned char lds[];
    run_stage(p, st, blockIdx.x, gridDim.x, lds);
}
#else
__global__ void __launch_bounds__(NTHREADS) k_mega(Params p) {
    extern __shared__ __attribute__((aligned(16))) unsigned char lds[];
    volatile __attribute__((address_space(3))) unsigned* st = (volatile __attribute__((address_space(3))) unsigned*)((__attribute__((address_space(3))) unsigned char*)lds + (LDS_BYTES - 64));
    if (threadIdx.x < 2) st[threadIdx.x] = 0u;
    __syncthreads();
    const XcdBarrier bar = xcd_barrier_post((unsigned*)(p.ws + WS_CTL) + 4096, st);
#ifndef REP_STAGE
#define REP_STAGE -1
#endif
#ifndef REP_N
#define REP_N 1
#endif
#define RS(k) do { run_stage(p, k, blockIdx.x, gridDim.x, lds); if ((k) == REP_STAGE) { for (int rep_ = 0; rep_ < REP_N; ++rep_) { xcd_barrier(bar); run_stage(p, k, blockIdx.x, gridDim.x, lds); } } } while (0)
#define GS() xcd_barrier(bar)
    RS(0); GS(); RS(1); GS(); RS(2); GS(); RS(3); GS(); RS(4); GS(); RS(5); GS(); RS(6); GS(); RS(7); GS();
    RS(8); GS(); RS(9); GS(); RS(10); GS(); RS(11); GS(); RS(12); GS(); RS(13); GS(); RS(14);
#undef RS
#undef GS
}
#endif

extern "C" void kernel_launch(void* const* d_in, const int* in_sizes, int n_in, void* d_out, int out_size, void* d_ws, size_t ws_size, hipStream_t stream) {
    static int inited = 0, grid_blocks = 0;
    if (!inited) {
        if (n_in != 23 || ws_size < WS_END || out_size != NLAT * D) { fprintf(stderr, "kernel_launch: unexpected shapes n_in %d ws %zu out %d\n", n_in, ws_size, out_size); inited = -1; return; }
        if (hipFuncSetAttribute((const void*)k_mega, hipFuncAttributeMaxDynamicSharedMemorySize, LDS_BYTES) != hipSuccess) { fprintf(stderr, "hipFuncSetAttribute failed\n"); inited = -1; return; }
        int dev = 0, cus = 0, per_cu = 0;
        (void)hipGetDevice(&dev); (void)hipDeviceGetAttribute(&cus, hipDeviceAttributeMultiprocessorCount, dev);
        (void)hipOccupancyMaxActiveBlocksPerMultiprocessor(&per_cu, (const void*)k_mega, NTHREADS, LDS_BYTES);
        if (per_cu < 1) { fprintf(stderr, "kernel_launch: occupancy query says %d blocks per CU\n", per_cu); per_cu = 1; }
        if (per_cu > 1) per_cu = 1;
        grid_blocks = cus * per_cu;
        inited = 1;
    }
    if (inited < 0) return;
    Params p{};
    const float** f = (const float**)&p;
    for (int i = 0; i < 23; ++i) f[i] = (const float*)d_in[i];
    p.out = (float*)d_out; p.ws = (unsigned char*)d_ws;
    (void)hipMemsetAsync((unsigned char*)d_ws + WS_CTL, 0, 2 * MiB, stream);
#if ONE_LAUNCH
    void* args[] = {&p};
    hipError_t e = hipLaunchCooperativeKernel((const void*)k_mega, dim3(grid_blocks), dim3(NTHREADS), args, LDS_BYTES, stream);
    if (e != hipSuccess) fprintf(stderr, "cooperative launch failed: %s (grid %d)\n", hipGetErrorString(e), grid_blocks);
#else
    for (int st = 0; st < NSTAGES; ++st) hipLaunchKernelGGL(k_mega, dim3(1024), dim3(NTHREADS), LDS_BYTES, stream, p, st);
#endif
}
```

```cpp
#include <hip/hip_runtime.h>
#include <hip/hip_cooperative_groups.h>
namespace cg = cooperative_groups;
#include <cstdio>
#include <cstdint>

typedef unsigned short bf16_t;
#define DEVI __device__ __forceinline__
#define LDS_BARRIER() do { asm volatile("s_waitcnt lgkmcnt(0)" ::: "memory"); __builtin_amdgcn_s_barrier(); asm volatile("" ::: "memory"); } while (0)

constexpr int D = 1024, NB = 4, SEQ = 4096, CTXL = 256;
constexpr int NLAT = NB * SEQ;
constexpr int NCTX = NB * CTXL;
constexpr int NT = NLAT + NCTX;
constexpr int NCH = 68;
constexpr int EVEN_IN = 7200;
constexpr int N1 = 7424;
constexpr int N1A = 13 * 256;
constexpr int RGW = 2048;
constexpr float EPS = 1e-6f;

constexpr size_t MiB = 1u << 20;
constexpr size_t WS_CTL = 0;
constexpr size_t WS_MOD = 1 * MiB;
constexpr size_t WS_ALR = 2 * MiB;
constexpr size_t WS_X1C = 5 * MiB;
constexpr size_t WS_SUMA = 9 * MiB;
constexpr size_t WS_SUMH = 9 * MiB + 4608 * 1024;
constexpr size_t WS_DEC = 18 * MiB;
constexpr size_t WS_BT1 = 19 * MiB + 512 * 1024;
constexpr size_t WS_BT2 = 34 * MiB;
constexpr size_t WS_BT3 = 38 * MiB;
constexpr size_t WS_BT4 = 46 * MiB;
constexpr size_t WS_BD = 50 * MiB;
constexpr size_t WS_S0 = 52 * MiB;
constexpr size_t SLOT = 34 * MiB;
constexpr size_t WS_END = WS_S0 + 6 * SLOT;
static_assert(WS_END == 256 * MiB, "ws map");
#define WS_SLOT(i) (WS_S0 + (size_t)(i) * SLOT)

struct Params {
    const float* x; const float* c; const float* ctx; const float* c_ctx; const float* norm_g; const float* w_mod; const float* b_mod;
    const float* e_w_in; const float* e_w_a2; const float* e_b_a2; const float* e_gla_g; const float* e_conv_w; const float* e_w_out;
    const float* o_w_in; const float* o_conv_w; const float* o_conv_b; const float* o_w_a; const float* o_b_a; const float* o_w_x; const float* o_b_x;
    const float* o_lam; const float* o_w_out; const float* final_g;
    float* out; unsigned char* ws;
};

DEVI float bf2f(bf16_t v) { return __uint_as_float((unsigned)v << 16); }
DEVI bf16_t f2bf(float f) { unsigned u = __float_as_uint(f); return (bf16_t)((u + 0x7fffu + ((u >> 16) & 1u)) >> 16); }
DEVI unsigned pk2(float lo, float hi) { return (unsigned)f2bf(lo) | ((unsigned)f2bf(hi) << 16); }
DEVI float fexp2_(float x) { return __builtin_amdgcn_exp2f(x); }
DEVI float frcp_(float x) { return __builtin_amdgcn_rcpf(x); }
DEVI float sigmoidf_(float x) { return frcp_(1.0f + fexp2_(-1.4426950408889634f * x)); }
DEVI float siluf_(float x) { return x * frcp_(1.0f + fexp2_(-1.4426950408889634f * x)); }
DEVI float softplusf_(float x) { return fmaxf(x, 0.f) + log1pf(__expf(-fabsf(x))); }
DEVI float logsigmoidf_(float x) { return fminf(x, 0.f) - 0.6931471805599453f * __builtin_amdgcn_logf(1.0f + fexp2_(-1.4426950408889634f * fabsf(x))); }
DEVI int row_of(int bb, int c, int t) { return c < 64 ? bb * 4096 + c * 64 + t : NLAT + bb * 256 + (c - 64) * 64 + t; }
DEVI int mod_idx(int row) { return row < NLAT ? (row >> 12) : 4; }
DEVI int xr_pad_of_tile(int pm) { return pm < 64 ? 4 * ((pm >> 4) + 1) : 20 + 4 * (pm - 64); }
constexpr int XR_ROWS = NT + 36;
DEVI float wave_sum(float v) {
#pragma unroll
    for (int o = 1; o < 64; o <<= 1) v += __shfl_xor(v, o);
    return v;
}
__host__ __device__ inline int colmap1(int n) {
    const int t = n >> 8, c = n & 255;
    if (t < 12) return n;
    if (t == 12) return c < 32 ? 3072 + c : -1;
    if (t < 21) { const int j = t - 13; return c < 128 ? 4128 + 128 * j + c : 5152 + 128 * j + (c - 128); }
    const int j = t - 21; return c < 128 ? 3104 + 128 * j + c : 6176 + 128 * j + (c - 128);
}

#define NTHREADS 512

__device__ void st_mod(const Params& p, int vb, int nvb, float* lds) {
    float* MOD = (float*)(p.ws + WS_MOD);
    for (int i = threadIdx.x; i < 5 * 1024; i += NTHREADS) { const int s = i >> 10, k = i & 1023; const float v = s < 4 ? p.c[s * 1024 + k] : p.c_ctx[k]; lds[i] = siluf_(v); }
    __syncthreads();
    const int lane = threadIdx.x & 63, gw = vb * (NTHREADS / 64) + (threadIdx.x >> 6), ngw = nvb * (NTHREADS / 64);
    for (int it = gw; it < 2 * 48 * 32; it += ngw) {
        const int kc = it & 31, cb = (it >> 5) % 48, li = it / (32 * 48), j = cb * 64 + lane, k0 = kc * 32;
        const float* W = p.w_mod + ((size_t)li * 1024 + k0) * 3072 + j;
        float wv[32];
#pragma unroll
        for (int k = 0; k < 32; ++k) wv[k] = W[(size_t)k * 3072];
        float a0 = 0.f, a1 = 0.f, a2 = 0.f, a3 = 0.f, a4 = 0.f;
#pragma unroll
        for (int k = 0; k < 32; ++k) { const float w = wv[k]; a0 += lds[k0 + k] * w; a1 += lds[1024 + k0 + k] * w; a2 += lds[2048 + k0 + k] * w; a3 += lds[3072 + k0 + k] * w; a4 += lds[4096 + k0 + k] * w; }
        const float bv = kc == 0 ? p.b_mod[li * 3072 + j] : 0.f;
        float* o = MOD + (size_t)li * 5 * 3072 + j;
        atomicAdd(o, a0 + bv); atomicAdd(o + 3072, a1 + bv); atomicAdd(o + 2 * 3072, a2 + bv); atomicAdd(o + 3 * 3072, a3 + bv); atomicAdd(o + 4 * 3072, a4 + bv);
    }
    __syncthreads();
}

__device__ __forceinline__ void wt_item(const float* src, int ldw, bf16_t* dst, int K, int k0, __attribute__((address_space(3))) float* scr, int lane) {
    typedef unsigned v4u __attribute__((ext_vector_type(4)));
    if (src) {
#pragma unroll 8
        for (int i = 0; i < 32; ++i) { const int kk = 2 * i + (lane >> 5); scr[kk * 33 + (lane & 31)] = src[(size_t)(k0 + kk) * ldw + (lane & 31)]; }
    }
    asm volatile("s_waitcnt lgkmcnt(0)" ::: "memory");
    const int cch = lane & 7;
#pragma unroll
    for (int j = 0; j < 4; ++j) { const int n = (lane >> 3) + 8 * j; const __attribute__((address_space(3))) float* sp = scr + (8 * cch) * 33 + n;
        v4u o = {0u, 0u, 0u, 0u};
        if (src) { o.x = pk2(sp[0 * 33], sp[1 * 33]); o.y = pk2(sp[2 * 33], sp[3 * 33]); o.z = pk2(sp[4 * 33], sp[5 * 33]); o.w = pk2(sp[6 * 33], sp[7 * 33]); }
        *(v4u*)(dst + (size_t)n * K + k0 + 8 * cch) = o; }
    asm volatile("s_waitcnt lgkmcnt(0)" ::: "memory");
}
__device__ void st_wprep(const Params& p, int vb, int nvb, unsigned char* lds_) {
    bf16_t* Bt1 = (bf16_t*)(p.ws + WS_BT1); bf16_t* Bt2 = (bf16_t*)(p.ws + WS_BT2); bf16_t* Bt3 = (bf16_t*)(p.ws + WS_BT3); bf16_t* Bt4 = (bf16_t*)(p.ws + WS_BT4);
    bf16_t* BD = (bf16_t*)(p.ws + WS_BD);
    const int lane = threadIdx.x & 63, wv = threadIdx.x >> 6, gw = vb * (NTHREADS / 64) + wv, ngw = nvb * (NTHREADS / 64);
    __attribute__((address_space(3))) float* scr = (__attribute__((address_space(3))) float*)lds_ + 8192 + wv * (64 * 33);
    constexpr int I1 = 16 * (N1 / 32), I2 = 32 * 32, I3 = 16 * 128, I4 = 32 * 32, I5 = 64 * 8;
    for (int it = gw; it < I1 + I2 + I3 + I4 + I5; it += ngw) {
        int r = it;
        if (r < I1) { const int nbk = N1 / 32, kb = r / nbk, nb = r % nbk; const int sc = colmap1(nb * 32); wt_item(sc < 0 ? nullptr : p.e_w_in + sc, EVEN_IN, Bt1 + (size_t)nb * 32 * 1024, 1024, kb * 64, scr, lane); continue; } r -= I1;
        if (r < I2) { const int kb = r / 32, nb = r % 32; wt_item(p.e_w_out + nb * 32, 1024, Bt2 + (size_t)nb * 32 * 2048, 2048, kb * 64, scr, lane); continue; } r -= I2;
        if (r < I3) { const int kb = r / 128, nb = r % 128; wt_item(p.o_w_in + nb * 32, 4096, Bt3 + (size_t)nb * 32 * 1024, 1024, kb * 64, scr, lane); continue; } r -= I3;
        if (r < I4) { const int kb = r / 32, nb = r % 32; wt_item(p.o_w_out + nb * 32, 1024, Bt4 + (size_t)nb * 32 * 2048, 2048, kb * 64, scr, lane); continue; } r -= I4;
        { const int m = r >> 8, dn = (r >> 3) & 31, kb = (r >> 2) & 1, nb = r & 3; const float* W = (m == 0 ? p.o_w_a : p.o_w_x) + (size_t)dn * 16384;
          wt_item(W + nb * 32, 128, BD + (size_t)m * 2 * 16 * 16384 + (size_t)dn * 16384 + (size_t)nb * 32 * 128, 128, kb * 64, scr, lane); }
    }
}

__device__ void st_modulate(const Params& p, int vb, int nvb, int li, const float* xlat, const float* xctx, bf16_t* H) {
    const float* MOD = (const float*)(p.ws + WS_MOD) + (size_t)li * 5 * 3072;
    const float* g = p.norm_g + li * 1024;
    const int lane = threadIdx.x & 63, gw = vb * (NTHREADS / 64) + (threadIdx.x >> 6), ngw = nvb * (NTHREADS / 64);
    for (int row = gw; row < NT; row += ngw) {
        const float* xr = row < NLAT ? xlat + (size_t)row * 1024 : xctx + (size_t)(row - NLAT) * 1024;
        const float* md = MOD + (size_t)mod_idx(row) * 3072;
        float4 v[4]; float ss = 0.f;
#pragma unroll
        for (int j = 0; j < 4; ++j) { v[j] = *(const float4*)(xr + j * 256 + lane * 4); ss += v[j].x * v[j].x + v[j].y * v[j].y + v[j].z * v[j].z + v[j].w * v[j].w; }
        const float rinv = rsqrtf(wave_sum(ss) * (1.f / 1024.f) + EPS);
#pragma unroll
        for (int j = 0; j < 4; ++j) { const int c0 = j * 256 + lane * 4; const float4 gg = *(const float4*)(g + c0), sh = *(const float4*)(md + c0), sc = *(const float4*)(md + 1024 + c0);
            ushort4 o; o.x = f2bf(v[j].x * rinv * gg.x * (1.f + sc.x) + sh.x); o.y = f2bf(v[j].y * rinv * gg.y * (1.f + sc.y) + sh.y);
            o.z = f2bf(v[j].z * rinv * gg.z * (1.f + sc.z) + sh.z); o.w = f2bf(v[j].w * rinv * gg.w * (1.f + sc.w) + sh.w);
            *(ushort4*)(H + (size_t)row * 1024 + c0) = o; }
    }
}

template <class Epi>
__device__ void st_gemm_naive(int vb, int nvb, float* lds, const bf16_t* A, const bf16_t* Bt, int mt0, int mt1, int nt0, int nt1, int K, const Epi& E) {
    float* As = lds;
    float* Bs = lds + 32 * 33;
    const int tid = threadIdx.x, tx = tid & 63, ty = tid >> 6;
    const int nmt = mt1 - mt0, nnt = nt1 - nt0;
    for (int it = vb; it < nmt * nnt; it += nvb) {
        const int m0 = (mt0 + it / nnt) * 32, n0 = (nt0 + it % nnt) * 256;
        float acc[4][4];
#pragma unroll
        for (int i = 0; i < 4; ++i)
#pragma unroll
            for (int j = 0; j < 4; ++j) acc[i][j] = 0.f;
        for (int k0 = 0; k0 < K; k0 += 32) {
            __syncthreads();
            for (int e = tid; e < 32 * 32; e += NTHREADS) { const int r = e >> 5, kk = e & 31; As[r * 33 + kk] = bf2f(A[(size_t)(m0 + r) * K + k0 + kk]); }
            for (int e = tid; e < 256 * 32; e += NTHREADS) { const int r = e >> 5, kk = e & 31; Bs[r * 33 + kk] = bf2f(Bt[(size_t)(n0 + r) * K + k0 + kk]); }
            __syncthreads();
#pragma unroll 8
            for (int kk = 0; kk < 32; ++kk) {
                float a[4], b[4];
#pragma unroll
                for (int i = 0; i < 4; ++i) a[i] = As[(ty * 4 + i) * 33 + kk];
#pragma unroll
                for (int j = 0; j < 4; ++j) b[j] = Bs[(tx + 64 * j) * 33 + kk];
#pragma unroll
                for (int i = 0; i < 4; ++i)
#pragma unroll
                    for (int j = 0; j < 4; ++j) acc[i][j] += a[i] * b[j];
            }
        }
#pragma unroll
        for (int i = 0; i < 4; ++i) E(m0 + ty * 4 + i, n0, tx, acc[i]);
    }
    __syncthreads();
}

struct Epi1 {
    bf16_t *QK, *V, *SGA, *Z, *CBG; float* ALR;
    DEVI void operator()(int row, int n0, int cl, const float (&v)[4]) const {
        const int t = n0 >> 8;
        if (t < 4) { for (int j = 0; j < 4; ++j) QK[(size_t)row * 1024 + n0 + cl + 64 * j] = f2bf(v[j]); }
        else if (t < 8) { for (int j = 0; j < 4; ++j) V[(size_t)row * 1024 + (n0 - 1024) + cl + 64 * j] = f2bf(v[j]); }
        else if (t < 12) { for (int j = 0; j < 4; ++j) SGA[(size_t)row * 1024 + (n0 - 2048) + cl + 64 * j] = f2bf(siluf_(v[j])); }
        else if (t == 12) { if (cl < 32) ALR[(size_t)row * 32 + cl] = v[0]; }
        else if (t < 21) { const int jt = t - 13; Z[(size_t)row * 1024 + 128 * jt + cl] = f2bf(v[0] * v[2]); Z[(size_t)row * 1024 + 128 * jt + cl + 64] = f2bf(v[1] * v[3]); }
        else { const int jt = t - 21; CBG[(size_t)row * 1024 + 128 * jt + cl] = f2bf(v[0] * siluf_(v[2])); CBG[(size_t)row * 1024 + 128 * jt + cl + 64] = f2bf(v[1] * siluf_(v[3])); }
    }
};
struct EpiRes {
    const float* xl; const float* xc; float* outl; float* outc; const float* MODl;
    DEVI void operator()(int row, int n0, int cl, const float (&v)[4]) const {
        const float* gate = MODl + (size_t)mod_idx(row) * 3072 + 2048;
        for (int j = 0; j < 4; ++j) { const int col = n0 + cl + 64 * j;
            if (row < NLAT) outl[(size_t)row * 1024 + col] = xl[(size_t)row * 1024 + col] + gate[col] * v[j];
            else if (outc) outc[(size_t)(row - NLAT) * 1024 + col] = xc[(size_t)(row - NLAT) * 1024 + col] + gate[col] * v[j]; }
    }
};
struct Epi3 {
    bf16_t* XR; bf16_t* SG;
    DEVI void operator()(int row, int n0, int cl, const float (&v)[4]) const {
        for (int j = 0; j < 4; ++j) { const int col = n0 + cl + 64 * j;
            if (col < 2048) XR[(size_t)row * 2048 + col] = f2bf(v[j]); else if (row < NLAT) SG[(size_t)row * 2048 + col - 2048] = f2bf(siluf_(v[j])); }
    }
};

#define LASQ __attribute__((address_space(3)))
__device__ void st_glaprep(const Params& p, int vb, int nvb, unsigned char* ldsb, const bf16_t* QK, const bf16_t* V, const float* ALR, bf16_t* QIN, bf16_t* KET, bf16_t* SC, float* DEC, bf16_t* VT) {
    typedef unsigned u4 __attribute__((ext_vector_type(4))); typedef unsigned u2 __attribute__((ext_vector_type(2))); typedef float f4 __attribute__((ext_vector_type(4))); typedef short bx8 __attribute__((ext_vector_type(8)));
    LASQ unsigned char* lds = (LASQ unsigned char*)ldsb;
    constexpr int RQ = 0, RK = 17408, Q0 = 34816, K0 = 52224, VR = 69632, AL = VR + 33792, TT = AL + 8192;
    const int tid = threadIdx.x, kk = tid & 127, tq = tid >> 7, wv = tid >> 6, ln = tid & 63, cl = ln & 15, gq = ln >> 4;
    u4 r[9];
#define GP_LOAD(item) do { const int h_ = (item) & 3, bc_ = (item) >> 2, c_ = bc_ % NCH, bb_ = bc_ / NCH; const size_t row0_ = (size_t)row_of(bb_, c_, 0); \
        _Pragma("unroll") for (int j_ = 0; j_ < 2; ++j_) { const int p_ = tid + 512 * j_; r[j_] = *(const u4*)(QK + (row0_ + (p_ >> 4)) * 1024 + h_ * 128 + (p_ & 15) * 8); r[2 + j_] = *(const u4*)(QK + (row0_ + (p_ >> 4)) * 1024 + 512 + h_ * 128 + (p_ & 15) * 8); } \
        _Pragma("unroll") for (int j_ = 0; j_ < 4; ++j_) { const int p_ = tid + 512 * j_; r[4 + j_] = *(const u4*)(V + (row0_ + (p_ >> 5)) * 1024 + h_ * 256 + (p_ & 31) * 8); } \
        r[8] = *(const u4*)(ALR + (row0_ + (tid >> 3)) * 32 + (tid & 7) * 4); } while (0)
    const int NIT = NB * NCH * 4;
    if (vb < NIT) GP_LOAD(vb);
    for (int item = vb; item < NIT; item += nvb) {
        const int h = item & 3;
        LDS_BARRIER();
#pragma unroll
        for (int j = 0; j < 2; ++j) { const int pp = tid + 512 * j; *(LASQ u4*)(lds + RQ + (pp >> 4) * 272 + (pp & 15) * 16) = r[j]; *(LASQ u4*)(lds + RK + (pp >> 4) * 272 + (pp & 15) * 16) = r[2 + j]; }
#pragma unroll
        for (int j = 0; j < 4; ++j) { const int pp = tid + 512 * j; *(LASQ u4*)(lds + VR + (pp >> 5) * 528 + (pp & 31) * 16) = r[4 + j]; }
        *(LASQ u4*)(lds + AL + (tid >> 3) * 128 + (tid & 7) * 16) = r[8];
        float w2a[2][16], b2a[2];
#pragma unroll
        for (int d = 0; d < 2; ++d) {
#pragma unroll
            for (int rr = 0; rr < 16; ++rr) w2a[d][rr] = p.e_w_a2[((size_t)d * 16 + rr) * 512 + h * 128 + kk];
            b2a[d] = p.e_b_a2[d * 512 + h * 128 + kk]; }
        asm volatile("" ::: "memory");
        if (item + nvb < NIT) GP_LOAD(item + nvb);
        LDS_BARRIER();
        unsigned qkr[16];
#pragma unroll
        for (int i = 0; i < 16; ++i) { qkr[i] = (unsigned)*(const LASQ unsigned short*)(lds + RQ + (tq * 16 + i) * 272 + kk * 2) | ((unsigned)*(const LASQ unsigned short*)(lds + RK + (tq * 16 + i) * 272 + kk * 2) << 16); }
        float bc[2][16];
#pragma unroll
        for (int d = 0; d < 2; ++d) {
            const float (&w2)[16] = w2a[d]; const float b2 = b2a[d];
#pragma unroll
            for (int i = 0; i < 16; ++i) { const LASQ f4* a = (const LASQ f4*)(lds + AL + (tq * 16 + i) * 128 + d * 64); const f4 a0 = a[0], a1 = a[1], a2 = a[2], a3 = a[3];
                float z = b2 + a0[0] * w2[0] + a0[1] * w2[1] + a0[2] * w2[2] + a0[3] * w2[3] + a1[0] * w2[4] + a1[1] * w2[5] + a1[2] * w2[6] + a1[3] * w2[7]
                        + a2[0] * w2[8] + a2[1] * w2[9] + a2[2] * w2[10] + a2[3] * w2[11] + a3[0] * w2[12] + a3[1] * w2[13] + a3[2] * w2[14] + a3[3] * w2[15];
                bc[d][i] = logsigmoidf_(z) * (1.f / 16.f); }
            float sacc = 0.f;
            if (d == 0) {
#pragma unroll
                for (int i = 0; i < 16; ++i) { sacc += bc[d][i]; bc[d][i] = sacc; } }
            else {
#pragma unroll
                for (int i = 15; i >= 0; --i) { sacc += bc[d][i]; bc[d][i] = sacc; } }
            *(LASQ float*)(lds + TT + ((d * 4 + tq) * 128 + kk) * 4) = sacc;
        }
        LDS_BARRIER();
        const float scale = 0.08838834764831845f;
#pragma unroll
        for (int d = 0; d < 2; ++d) {
            const size_t u = (size_t)item * 2 + d;
            float off = 0.f, blast = 0.f;
#pragma unroll
            for (int q = 0; q < 4; ++q) { const float tv = *(const LASQ float*)(lds + TT + ((d * 4 + q) * 128 + kk) * 4); blast += tv; if (d == 0 ? (q < tq) : (q > tq)) off += tv; }
            LASQ unsigned char* qd = lds + (d == 0 ? Q0 : RQ); LASQ unsigned char* kd = lds + (d == 0 ? K0 : RK);
            unsigned ke[8];
#pragma unroll
            for (int i = 0; i < 16; ++i) { const int t = tq * 16 + i; const float bq = bc[d][i] + off;
                const float qv = __uint_as_float(qkr[i] << 16) * scale, kv = __uint_as_float(qkr[i] & 0xffff0000u);
                const float eb = fexp2_(1.4426950408889634f * bq);
                *(LASQ unsigned short*)(qd + t * 272 + kk * 2) = f2bf(qv * eb); *(LASQ unsigned short*)(kd + t * 272 + kk * 2) = f2bf(kv * frcp_(eb));
                const unsigned kev = f2bf(kv * fexp2_(1.4426950408889634f * (blast - bq)));
                if (i & 1) ke[i >> 1] |= kev << 16; else ke[i >> 1] = kev; }
            { u4 w0 = {ke[0], ke[1], ke[2], ke[3]}, w1 = {ke[4], ke[5], ke[6], ke[7]}; u4* dst = (u4*)(KET + (u * 128 + kk) * 64 + tq * 16); dst[0] = w0; dst[1] = w1; }
            if (tq == 0) DEC[u * 128 + kk] = fexp2_(1.4426950408889634f * blast);
        }
        LDS_BARRIER();
#pragma unroll
        for (int d = 0; d < 2; ++d) {
            const size_t u = (size_t)item * 2 + d;
            const LASQ unsigned char* qd = lds + (d == 0 ? Q0 : RQ); const LASQ unsigned char* kd = lds + (d == 0 ? K0 : RK);
#pragma unroll
            for (int j = 0; j < 2; ++j) { const int pp = tid + 512 * j; *(u4*)(QIN + u * 8192 + (pp >> 4) * 128 + (pp & 15) * 8) = *(const LASQ u4*)(qd + (pp >> 4) * 272 + (pp & 15) * 16); }
            const int mt = wv >> 1;
#pragma unroll
            for (int nn = 0; nn < 2; ++nn) { const int nt = 2 * (wv & 1) + nn; f4 acc = {0.f, 0.f, 0.f, 0.f};
#pragma unroll
                for (int k4 = 0; k4 < 4; ++k4) { const bx8 kf = *(const LASQ bx8*)(kd + (16 * nt + cl) * 272 + (32 * k4 + 8 * gq) * 2), qf = *(const LASQ bx8*)(qd + (16 * mt + cl) * 272 + (32 * k4 + 8 * gq) * 2);
                    acc = __builtin_amdgcn_mfma_f32_16x16x32_bf16(kf, qf, acc, 0, 0, 0); }
                const int t = 16 * mt + cl, s0 = 16 * nt + 4 * gq; float v[4];
#pragma unroll
                for (int rr = 0; rr < 4; ++rr) { const int sx = s0 + rr; v[rr] = (d == 0 ? (sx <= t) : (sx >= t)) ? acc[rr] : 0.f; }
                u2 w; w.x = pk2(v[0], v[1]); w.y = pk2(v[2], v[3]); *(u2*)(SC + (u * 64 + t) * 64 + s0) = w; }
        }
        { const int vc = tid & 255, th = tid >> 8; unsigned vv[16];
#pragma unroll
          for (int i = 0; i < 32; ++i) { const unsigned x = *(const LASQ unsigned short*)(lds + VR + (32 * th + i) * 528 + vc * 2); if (i & 1) vv[i >> 1] |= x << 16; else vv[i >> 1] = x; }
          u4* dst = (u4*)(VT + ((size_t)item * 256 + vc) * 64 + 32 * th);
          dst[0] = (u4){vv[0], vv[1], vv[2], vv[3]}; dst[1] = (u4){vv[4], vv[5], vv[6], vv[7]}; dst[2] = (u4){vv[8], vv[9], vv[10], vv[11]}; dst[3] = (u4){vv[12], vv[13], vv[14], vv[15]}; }
    }
    LDS_BARRIER();
#undef GP_LOAD
}

__device__ void st_glawalk_naive(const Params& p, int vb, int nvb, float* Sl, const bf16_t* QIN, const bf16_t* KET, const bf16_t* SC, const float* DEC, const bf16_t* VT, bf16_t* OF, bf16_t* OB) {
    const int vc = threadIdx.x & 255, half = threadIdx.x >> 8;
    for (int combo = vb; combo < 32; combo += nvb) {
        const int d = combo & 1, h = (combo >> 1) & 3, bb = combo >> 3;
        __syncthreads();
        for (int k = half * 64; k < half * 64 + 64; ++k) Sl[k * 256 + vc] = 0.f;
        __syncthreads();
        bf16_t* O = d == 0 ? OF : OB;
        for (int step = 0; step < NCH; ++step) {
            const int c = d == 0 ? (step < 4 ? 64 + step : step - 4) : 67 - step;
            const int u = ((bb * NCH + c) * 4 + h) * 2 + d;
            const bf16_t* q = QIN + (size_t)u * 64 * 128; const bf16_t* ke = KET + (size_t)u * 128 * 64; const bf16_t* sc = SC + (size_t)u * 64 * 64;
            const bf16_t* vt = VT + (((size_t)(u >> 1)) * 256 + vc) * 64;
            float vv[64];
#pragma unroll
            for (int t = 0; t < 64; ++t) vv[t] = bf2f(vt[t]);
            const int row0 = row_of(bb, c, 0);
            for (int t = half * 32; t < half * 32 + 32; ++t) { float a = 0.f;
                for (int k = 0; k < 128; ++k) a += bf2f(q[t * 128 + k]) * bf2f(f2bf(Sl[k * 256 + vc]));
#pragma unroll
                for (int s = 0; s < 64; ++s) a += bf2f(sc[t * 64 + s]) * vv[s];
                O[(size_t)(row0 + t) * 1024 + h * 256 + vc] = f2bf(a); }
            __syncthreads();
            for (int k = half * 64; k < half * 64 + 64; ++k) { float a = DEC[(size_t)u * 128 + k] * Sl[k * 256 + vc];
#pragma unroll
                for (int t = 0; t < 64; ++t) a += bf2f(ke[k * 64 + t]) * vv[t];
                Sl[k * 256 + vc] = a; }
            __syncthreads();
        }
    }
}

__device__ void st_inner(const Params& p, int vb, int nvb, const bf16_t* OF, const bf16_t* OB, const bf16_t* SGA, const bf16_t* Z, const bf16_t* CBG, bf16_t* INNER) {
    const int lane = threadIdx.x & 63, gw = vb * (NTHREADS / 64) + (threadIdx.x >> 6), ngw = nvb * (NTHREADS / 64);
    for (int row = gw; row < NT; row += ngw) {
        bool hasp, hasn;
        if (row < NLAT) { const int t = row & 63; hasp = t != 0; hasn = t != 63; } else { const int t = (row - NLAT) & 255; hasp = t != 0; hasn = t != 255; }
#pragma unroll
        for (int h = 0; h < 4; ++h) {
            const int c0 = h * 256 + lane * 4;
            const ushort4 a = *(const ushort4*)(OF + (size_t)row * 1024 + c0), b = *(const ushort4*)(OB + (size_t)row * 1024 + c0);
            const float o0 = bf2f(a.x) + bf2f(b.x), o1 = bf2f(a.y) + bf2f(b.y), o2 = bf2f(a.z) + bf2f(b.z), o3 = bf2f(a.w) + bf2f(b.w);
            const float rinv = rsqrtf(wave_sum(o0 * o0 + o1 * o1 + o2 * o2 + o3 * o3) * (1.f / 256.f) + EPS);
            const float4 gg = *(const float4*)(p.e_gla_g + lane * 4);
            const ushort4 sg = *(const ushort4*)(SGA + (size_t)row * 1024 + c0);
            ushort4 o; o.x = f2bf(o0 * rinv * gg.x * bf2f(sg.x)); o.y = f2bf(o1 * rinv * gg.y * bf2f(sg.y)); o.z = f2bf(o2 * rinv * gg.z * bf2f(sg.z)); o.w = f2bf(o3 * rinv * gg.w * bf2f(sg.w));
            *(ushort4*)(INNER + (size_t)row * 2048 + c0) = o;
            const ushort4 zc = *(const ushort4*)(Z + (size_t)row * 1024 + c0);
            ushort4 zp = {0, 0, 0, 0}, zn = {0, 0, 0, 0};
            if (hasp) zp = *(const ushort4*)(Z + (size_t)(row - 1) * 1024 + c0);
            if (hasn) zn = *(const ushort4*)(Z + (size_t)(row + 1) * 1024 + c0);
            const float4 w0 = *(const float4*)(p.e_conv_w + c0), w1 = *(const float4*)(p.e_conv_w + 1024 + c0), w2 = *(const float4*)(p.e_conv_w + 2048 + c0);
            const ushort4 cb = *(const ushort4*)(CBG + (size_t)row * 1024 + c0);
            ushort4 y; y.x = f2bf(bf2f(cb.x) * (w0.x * bf2f(zp.x) + w1.x * bf2f(zc.x) + w2.x * bf2f(zn.x)));
            y.y = f2bf(bf2f(cb.y) * (w0.y * bf2f(zp.y) + w1.y * bf2f(zc.y) + w2.y * bf2f(zn.y)));
            y.z = f2bf(bf2f(cb.z) * (w0.z * bf2f(zp.z) + w1.z * bf2f(zc.z) + w2.z * bf2f(zn.z)));
            y.w = f2bf(bf2f(cb.w) * (w0.w * bf2f(zp.w) + w1.w * bf2f(zc.w) + w2.w * bf2f(zn.w)));
            *(ushort4*)(INNER + (size_t)row * 2048 + 1024 + c0) = y;
        }
    }
}

template <int MODE>
__device__ void st_rglru_naive(const Params& p, int vb, int nvb, float* lds, const bf16_t* XR, const bf16_t* SG, float* SUMA, float* SUMH, bf16_t* Y) {
    float* xc = lds;
    float* av = xc + 64 * 128;
    float* uv = av + 64 * 128;
    float* hf = uv + 64 * 128;
    const int tid = threadIdx.x, j = tid & 127, tq = tid >> 7;
    const int nitems = MODE == 0 ? NB * NCH * 16 * 2 : NB * 64 * 16;
    for (int it = vb; it < nitems; it += nvb) {
        int bb, c, nb;
        if (MODE == 0) { nb = (it >> 1) & 15; const int bc = it >> 5; c = bc % NCH; bb = bc / NCH; } else { nb = it & 15; const int bc = it >> 4; c = bc & 63; bb = bc >> 6; }
        const int row0 = row_of(bb, c, 0);
        const int seg0 = c < 64 ? bb * 4096 : NLAT + bb * 256, segn = c < 64 ? 4096 : 256;
        const int tl0 = row0 - seg0;
        for (int dd = 0; dd < (MODE == 0 ? 1 : 2); ++dd) {
            const int d = MODE == 0 ? (it & 1) : dd;
            __syncthreads();
            for (int e = tid; e < 64 * 128; e += NTHREADS) { const int t = e >> 7, i = e & 127, ch = nb * 128 + i; float a = p.o_conv_b[d * 2048 + ch];
#pragma unroll
                for (int jj = 0; jj < 4; ++jj) { const int tt = d == 0 ? tl0 + t - 3 + jj : tl0 + t + 3 - jj;
                    if (tt >= 0 && tt < segn) a += p.o_conv_w[((size_t)d * 4 + jj) * 2048 + ch] * bf2f(XR[(size_t)(seg0 + tt) * 2048 + ch]); }
                xc[e] = a; }
            __syncthreads();
            const float* WA = p.o_w_a + ((size_t)d * 16 + nb) * 128 * 128; const float* WX = p.o_w_x + ((size_t)d * 16 + nb) * 128 * 128;
            const int ch = nb * 128 + j;
            const float ba = p.o_b_a[d * 2048 + ch], bx = p.o_b_x[d * 2048 + ch], sp = softplusf_(-p.o_lam[d * 2048 + ch]);
            for (int i16 = 0; i16 < 16; ++i16) { const int t = tq * 16 + i16; float ra = ba, rx = bx;
                for (int i = 0; i < 128; ++i) { const float xv = bf2f(f2bf(xc[t * 128 + i])); ra += xv * bf2f(f2bf(WA[i * 128 + j])); rx += xv * bf2f(f2bf(WX[i * 128 + j])); }
                const float r = sigmoidf_(ra), ig = sigmoidf_(rx); const float la = -8.f * r * sp; const float a = __expf(la);
                av[t * 128 + j] = a; uv[t * 128 + j] = sqrtf(-expm1f(2.f * la)) * (ig * xc[t * 128 + j]); }
            __syncthreads();
            if (tid < 128) {
                const size_t sidx = (((size_t)bb * 2 + d) * NCH + c) * 2048 + ch;
                if (MODE == 0) { float A = 1.f, hh = 0.f;
                    if (d == 0) for (int t = 0; t < 64; ++t) { const float a = av[t * 128 + j]; hh = a * hh + uv[t * 128 + j]; A *= a; }
                    else for (int t = 63; t >= 0; --t) { const float a = av[t * 128 + j]; hh = a * hh + uv[t * 128 + j]; A *= a; }
                    SUMA[sidx] = A; SUMH[sidx] = hh;
                } else { float hh = SUMH[sidx];
                    if (d == 0) for (int t = 0; t < 64; ++t) { hh = av[t * 128 + j] * hh + uv[t * 128 + j]; hf[t * 128 + j] = hh; }
                    else for (int t = 63; t >= 0; --t) { hh = av[t * 128 + j] * hh + uv[t * 128 + j]; const size_t o = (size_t)(row0 + t) * 2048 + ch; Y[o] = f2bf((hf[t * 128 + j] + hh) * bf2f(SG[o])); }
                }
            }
        }
    }
    __syncthreads();
}
__device__ void st_carry(const Params& p, int vb, int nvb, const float* SUMA, float* SUMH) {
    for (int e = vb * NTHREADS + threadIdx.x; e < NB * 2 * 2048; e += nvb * NTHREADS) {
        const int ch = e & 2047, d = (e >> 11) & 1, bb = e >> 12; float hh = 0.f;
        for (int s0 = 0; s0 < NCH; s0 += 17) {
            float A[17], H[17];
#pragma unroll
            for (int i = 0; i < 17; ++i) { const int step = s0 + i, c = d == 0 ? (step < 4 ? 64 + step : step - 4) : 67 - step; const size_t sidx = (((size_t)bb * 2 + d) * NCH + c) * 2048 + ch; A[i] = SUMA[sidx]; H[i] = SUMH[sidx]; }
#pragma unroll
            for (int i = 0; i < 17; ++i) { const int step = s0 + i, c = d == 0 ? (step < 4 ? 64 + step : step - 4) : 67 - step; const size_t sidx = (((size_t)bb * 2 + d) * NCH + c) * 2048 + ch; SUMH[sidx] = hh; hh = A[i] * hh + H[i]; }
        }
    }
}
__device__ void st_final(const Params& p, int vb, int nvb) {
    const int lane = threadIdx.x & 63, gw = vb * (NTHREADS / 64) + (threadIdx.x >> 6), ngw = nvb * (NTHREADS / 64);
    for (int row = gw; row < NLAT; row += ngw) { float* xr = p.out + (size_t)row * 1024; float4 v[4]; float ss = 0.f;
#pragma unroll
        for (int j = 0; j < 4; ++j) { v[j] = *(const float4*)(xr + j * 256 + lane * 4); ss += v[j].x * v[j].x + v[j].y * v[j].y + v[j].z * v[j].z + v[j].w * v[j].w; }
        const float rinv = rsqrtf(wave_sum(ss) * (1.f / 1024.f) + EPS);
#pragma unroll
        for (int j = 0; j < 4; ++j) { const float4 g = *(const float4*)(p.final_g + j * 256 + lane * 4); float4 o; o.x = v[j].x * rinv * g.x; o.y = v[j].y * rinv * g.y; o.z = v[j].z * rinv * g.z; o.w = v[j].w * rinv * g.w; *(float4*)(xr + j * 256 + lane * 4) = o; }
    }
}


namespace pg8 {
#define PG8_LAS __attribute__((address_space(3)))
typedef short bf16x8 __attribute__((ext_vector_type(8)));
typedef float f32x4 __attribute__((ext_vector_type(4)));
typedef unsigned u32x4 __attribute__((ext_vector_type(4)));
constexpr int BM = 256, BK = 64, HALF = 128, HTB = HALF * BK * 2, STAGE_BYTES = 8 * HTB, NXCD = 8, WGM = 8;
__host__ __device__ __forceinline__ int lds_byte(int r, int c) { const int st = (r >> 4) * 2 + (c >> 5), rr = r & 15, cc = c & 31, ob = rr * 64 + cc * 2; return st * 1024 + (ob ^ (((ob >> 9) & 1) << 5)); }
__host__ __device__ __forceinline__ void stage_rc(int b, int& R, int& C) { const int st = b / 1024, sb = b % 1024, swz = sb ^ (((sb >> 9) & 1) << 5); R = (st >> 1) * 16 + swz / 64; C = (st & 1) * 32 + (swz % 64) / 2; }
__host__ __device__ __forceinline__ int perm32(int rho) { const int n = rho >> 4, i = rho & 15; return 8 * (i >> 2) + 4 * n + (i & 3); }
struct Unit { int pm, pn; };
struct Gemm { const bf16_t* A; const bf16_t* Bt; int M, N, K; };
struct TileOrder {
    int nM, nN, nwg, G, c, m0, split, base0, base1, nM2, nN2, m02;
    __device__ void init(int nM_, int nN_, int G_, int c_, int m0_ = 0, int split_ = 1 << 30, int base0_ = 0, int base1_ = 0, int nM2_ = 0, int nN2_ = 0, int m02_ = 0) {
        nM = nM_; nN = nN_; nwg = nM * nN; G = G_; c = c_; m0 = m0_; split = split_; base0 = base0_; base1 = base1_; nM2 = nM2_; nN2 = nN2_; m02 = m02_; }
    __device__ bool next(int i, Unit& u) const {
        const long L = (long)i * G + c;
        if (L >= nwg) { const long L2 = L - nwg; if (L2 >= (long)nM2 * nN2) return false; u.pm = m02 + (int)(L2 / nN2); u.pn = (int)(L2 % nN2); return true; }
        int wgid = (int)L; { const int q = nwg / NXCD, r = nwg % NXCD, xcd = wgid % NXCD, off = wgid / NXCD; wgid = (xcd < r ? xcd * (q + 1) : r * (q + 1) + (xcd - r) * q) + off; }
        const int nig = WGM * nN, gid = wgid / nig, fm = gid * WGM, gsz = (nM - fm) < WGM ? (nM - fm) : WGM;
        const int pm = fm + ((wgid % nig) % gsz), j = (wgid % nig) / gsz;
        u.pm = m0 + pm; u.pn = j < split ? base0 + j : base1 + (j - split); return true;
    }
    __device__ __forceinline__ void a_ready(const Unit&) const {}
    __device__ __forceinline__ void done(const Unit&) const {}
};
typedef float f32x2_t __attribute__((ext_vector_type(2))); typedef __bf16 bf16x2_t __attribute__((ext_vector_type(2)));
__device__ __forceinline__ unsigned cvt_pk_bf16(float lo, float hi) { f32x2_t v = {lo, hi}; bf16x2_t b = __builtin_convertvector(v, bf16x2_t); return __builtin_bit_cast(unsigned, b); }
template <class Epi, class Sched, bool ALIGN_EPI = false, bool SP2 = false>
__device__ __forceinline__ void gemm_phase(PG8_LAS unsigned char* lds, const Gemm g, const Sched& S, const Epi& E) {
    const int tid = threadIdx.x, wid = __builtin_amdgcn_readfirstlane(tid >> 6), lane = tid & 63, wr = wid >> 2, wc = wid & 3, fr = lane & 15, fq = lane >> 4;
    const int K = g.K, nt = K / BK;
    unsigned voffA[2], voffB[2];
#pragma unroll
    for (int i = 0; i < 2; ++i) { int R, C; stage_rc(tid * 16 + i * 8192, R, C); const int Rb = Epi::PERM ? ((R & ~31) + perm32(R & 31)) : R;
        voffA[i] = (unsigned)(R * K + C) * 2u; voffB[i] = (unsigned)(Rb * K + C) * 2u; }
    const size_t kstep = (size_t)(BK * 2);
    const size_t hstep = (size_t)HALF * K * 2;
    const size_t tstep = 2 * hstep;
    const unsigned ldsw = (unsigned)wid * 1024u;
    const int aoff = lds_byte(wr * 64 + fr, fq * 8), boff = lds_byte(wc * 32 + fr, fq * 8);
#define PG8_SA(b, h) (((b) * 2 + (h)) * HTB)
#define PG8_SB(b, h) ((4 + (b) * 2 + (h)) * HTB)
#define PG8_STAGE(bufoff, gbase, voff) do { _Pragma("unroll") for (int _i = 0; _i < 2; ++_i) \
        __builtin_amdgcn_global_load_lds((const unsigned*)((const char*)(gbase) + (voff)[_i]), (PG8_LAS unsigned*)(lds + (bufoff) + ldsw + _i * 8192), 16, 0, 0); } while (0)
#define PG8_LDA(dst, b, h) do { _Pragma("unroll") for (int m = 0; m < 4; ++m) _Pragma("unroll") for (int k = 0; k < 2; ++k) dst[m][k] = *(const PG8_LAS bf16x8*)(lds + PG8_SA(b, h) + aoff + m * 2048 + k * 1024); } while (0)
#define PG8_LDB(dst, b, h) do { _Pragma("unroll") for (int n = 0; n < 2; ++n) _Pragma("unroll") for (int k = 0; k < 2; ++k) dst[n][k] = *(const PG8_LAS bf16x8*)(lds + PG8_SB(b, h) + boff + n * 2048 + k * 1024); } while (0)
#define PG8_MMA(ai, bj, At, Bt) do { __builtin_amdgcn_s_setprio(1); _Pragma("unroll") for (int m = 0; m < 4; ++m) _Pragma("unroll") for (int n = 0; n < 2; ++n) _Pragma("unroll") for (int k = 0; k < 2; ++k) \
        acc[ai][bj][m][n] = __builtin_amdgcn_mfma_f32_16x16x32_bf16(Bt[n][k], At[m][k], acc[ai][bj][m][n], 0, 0, 0); __builtin_amdgcn_s_setprio(0); } while (0)
#define PG8_WAIT_V(n) asm volatile("s_waitcnt vmcnt(" #n ")" ::: "memory")
#define PG8_WAIT_L(n) asm volatile("s_waitcnt lgkmcnt(" #n ")" ::: "memory")
#define PG8_BAR __builtin_amdgcn_s_barrier()
#define PG8_SCHED __builtin_amdgcn_sched_barrier(0)
    Unit cur, nxt; int ui = 0;
    if (!S.next(0, cur)) return;
    f32x4 acc[2][2][4][2];
#pragma unroll
    for (int a = 0; a < 2; ++a)
#pragma unroll
        for (int b = 0; b < 2; ++b)
#pragma unroll
            for (int m = 0; m < 4; ++m)
#pragma unroll
                for (int n = 0; n < 2; ++n) acc[a][b][m][n] = (f32x4){0.f, 0.f, 0.f, 0.f};
    bf16x8 At[4][2], B0[2][2], B1[2][2];
    const char* cA = (const char*)g.A + (size_t)cur.pm * tstep; const char* cB = (const char*)g.Bt + (size_t)cur.pn * tstep;
    S.a_ready(cur);
    if constexpr (SP2) {
        PG8_STAGE(PG8_SB(0, 0), cB, voffB); PG8_STAGE(PG8_SB(0, 1), cB + hstep, voffB); PG8_STAGE(PG8_SA(0, 0), cA, voffA); PG8_STAGE(PG8_SA(0, 1), cA + hstep, voffA);
        if (wr == 1) PG8_BAR;
        PG8_WAIT_V(2); PG8_BAR;
        PG8_STAGE(PG8_SB(1, 0), cB + kstep, voffB); PG8_STAGE(PG8_SA(1, 0), cA + kstep, voffA); PG8_STAGE(PG8_SB(1, 1), cB + hstep + kstep, voffB);
        PG8_WAIT_V(6); PG8_BAR;
    } else {
        PG8_STAGE(PG8_SB(0, 0), cB, voffB); PG8_STAGE(PG8_SA(0, 0), cA, voffA); PG8_STAGE(PG8_SB(0, 1), cB + hstep, voffB); PG8_STAGE(PG8_SA(0, 1), cA + hstep, voffA);
        if (wr == 1) PG8_BAR;
        PG8_WAIT_V(4); PG8_BAR;
        PG8_STAGE(PG8_SB(1, 0), cB + kstep, voffB); PG8_STAGE(PG8_SA(1, 0), cA + kstep, voffA); PG8_STAGE(PG8_SB(1, 1), cB + hstep + kstep, voffB);
        PG8_WAIT_V(6); PG8_BAR;
    }
    for (;;) {
        const bool has_next = S.next(ui + 1, nxt);
        const char* nA = has_next ? (const char*)g.A + (size_t)nxt.pm * tstep : cA; const char* nB = has_next ? (const char*)g.Bt + (size_t)nxt.pn * tstep : cB;
        for (int t = 0; t < nt; t += 2) {
            const bool last = (t == nt - 2);
            const char* a1 = cA + (size_t)(t + 1) * kstep;
            const char* a2 = last ? nA : cA + (size_t)(t + 2) * kstep; const char* b2 = last ? nB : cB + (size_t)(t + 2) * kstep;
            const char* a3 = a2 + kstep; const char* b3 = b2 + kstep;
            if (last && has_next) S.a_ready(nxt);
            if constexpr (SP2) {
            PG8_LDB(B0, 0, 0); PG8_LDB(B1, 0, 1); PG8_SCHED; PG8_LDA(At, 0, 0); PG8_STAGE(PG8_SA(1, 1), a1 + hstep, voffA);
            PG8_WAIT_V(8); PG8_WAIT_L(0); PG8_BAR; PG8_MMA(0, 0, At, B0); PG8_MMA(0, 1, At, B1); PG8_BAR; PG8_SCHED;
            PG8_LDA(At, 0, 1); PG8_STAGE(PG8_SB(0, 0), b2, voffB); PG8_STAGE(PG8_SB(0, 1), b2 + hstep, voffB); PG8_STAGE(PG8_SA(0, 0), a2, voffA);
            PG8_WAIT_V(8); PG8_WAIT_L(0); PG8_BAR; PG8_MMA(1, 0, At, B0); PG8_MMA(1, 1, At, B1); PG8_BAR; PG8_SCHED;
            PG8_LDB(B0, 1, 0); PG8_LDB(B1, 1, 1); PG8_SCHED; PG8_LDA(At, 1, 0); PG8_STAGE(PG8_SA(0, 1), a2 + hstep, voffA);
            PG8_WAIT_V(8); PG8_WAIT_L(0); PG8_BAR; PG8_MMA(0, 0, At, B0); PG8_MMA(0, 1, At, B1); PG8_BAR; PG8_SCHED;
            PG8_LDA(At, 1, 1); PG8_STAGE(PG8_SB(1, 0), b3, voffB); PG8_STAGE(PG8_SB(1, 1), b3 + hstep, voffB); PG8_STAGE(PG8_SA(1, 0), a3, voffA);
            PG8_WAIT_V(8); PG8_WAIT_L(0); PG8_BAR; PG8_MMA(1, 0, At, B0); PG8_MMA(1, 1, At, B1); PG8_BAR; PG8_SCHED;
            } else {
            PG8_LDB(B0, 0, 0); PG8_SCHED; PG8_LDA(At, 0, 0); PG8_STAGE(PG8_SA(1, 1), a1 + hstep, voffA);
            PG8_WAIT_L(8); PG8_BAR; PG8_WAIT_L(0); PG8_MMA(0, 0, At, B0); PG8_BAR; PG8_SCHED;
            PG8_LDB(B1, 0, 1); PG8_STAGE(PG8_SB(0, 0), b2, voffB);
            PG8_BAR; PG8_WAIT_L(0); PG8_MMA(0, 1, At, B1); PG8_BAR;
            PG8_LDA(At, 0, 1); PG8_STAGE(PG8_SA(0, 0), a2, voffA);
            PG8_BAR; PG8_WAIT_L(0); PG8_MMA(1, 0, At, B0); PG8_BAR; PG8_SCHED;
            PG8_STAGE(PG8_SB(0, 1), b2 + hstep, voffB);
            PG8_WAIT_V(6); PG8_BAR; PG8_MMA(1, 1, At, B1); PG8_BAR;
            PG8_LDB(B0, 1, 0); PG8_SCHED; PG8_LDA(At, 1, 0); PG8_STAGE(PG8_SA(0, 1), a2 + hstep, voffA);
            PG8_WAIT_L(8); PG8_BAR; PG8_WAIT_L(0); PG8_MMA(0, 0, At, B0); PG8_BAR; PG8_SCHED;
            PG8_LDB(B1, 1, 1); PG8_STAGE(PG8_SB(1, 0), b3, voffB);
            PG8_BAR; PG8_WAIT_L(0); PG8_MMA(0, 1, At, B1); PG8_BAR;
            PG8_LDA(At, 1, 1); PG8_STAGE(PG8_SA(1, 0), a3, voffA);
            PG8_BAR; PG8_WAIT_L(0); PG8_MMA(1, 0, At, B0); PG8_BAR; PG8_SCHED;
            PG8_STAGE(PG8_SB(1, 1), b3 + hstep, voffB);
            PG8_WAIT_V(6); PG8_BAR; PG8_MMA(1, 1, At, B1); PG8_BAR;
            }
        }
        if constexpr (ALIGN_EPI) { if (wr == 0) PG8_BAR; }
        if constexpr (!Epi::AFTER_DRAIN) { E(acc, cur, wr, wc, fr, fq); S.done(cur); }
        if (!has_next) break;
#pragma unroll
        for (int a = 0; a < 2; ++a)
#pragma unroll
            for (int b = 0; b < 2; ++b)
#pragma unroll
                for (int m = 0; m < 4; ++m)
#pragma unroll
                    for (int n = 0; n < 2; ++n) acc[a][b][m][n] = (f32x4){0.f, 0.f, 0.f, 0.f};
        cur = nxt; cA = nA; cB = nB; ++ui;
        if constexpr (ALIGN_EPI) { if (wr == 1) PG8_BAR; }
    }
    PG8_WAIT_V(0);
    if constexpr (!ALIGN_EPI) { if (wr == 0) PG8_BAR; }
    PG8_BAR;
    if constexpr (Epi::AFTER_DRAIN) { E.fused(acc, cur, wr, wc, fr, fq, lds, wid, lane); S.done(cur); }
#undef PG8_SA
#undef PG8_SB
#undef PG8_STAGE
#undef PG8_LDA
#undef PG8_LDB
#undef PG8_MMA
#undef PG8_WAIT_V
#undef PG8_WAIT_L
#undef PG8_BAR
#undef PG8_SCHED
}
}

DEVI pg8::u32x4 pack8(const pg8::f32x4& a, const pg8::f32x4& b) { pg8::u32x4 w; w.x = pg8::cvt_pk_bf16(a[0], a[1]); w.y = pg8::cvt_pk_bf16(a[2], a[3]); w.z = pg8::cvt_pk_bf16(b[0], b[1]); w.w = pg8::cvt_pk_bf16(b[2], b[3]); return w; }
DEVI pg8::f32x4 silu4(const pg8::f32x4& a) { pg8::f32x4 r; r[0] = siluf_(a[0]); r[1] = siluf_(a[1]); r[2] = siluf_(a[2]); r[3] = siluf_(a[3]); return r; }
struct FEpi1 {
    static constexpr bool PERM = true, AFTER_DRAIN = false;
    bf16_t *QK, *V, *SGA, *Z, *CBG; float* ALR;
    DEVI void operator()(const pg8::f32x4 (&acc)[2][2][4][2], const pg8::Unit& u, int wr, int wc, int fr, int fq) const {
        const int t = u.pn, row0 = u.pm * 256 + wr * 64 + fr, cw = wc * 32 + 8 * fq;
#pragma unroll
        for (int ai = 0; ai < 2; ++ai)
#pragma unroll
            for (int m = 0; m < 4; ++m) {
                const size_t row = (size_t)(row0 + ai * 128 + m * 16);
                if (t < 12) {
                    bf16_t* base = t < 4 ? QK + row * 1024 + t * 256 : (t < 8 ? V + row * 1024 + (t - 4) * 256 : SGA + row * 1024 + (t - 8) * 256);
#pragma unroll
                    for (int bj = 0; bj < 2; ++bj) { pg8::f32x4 v0 = acc[ai][bj][m][0], v1 = acc[ai][bj][m][1]; if (t >= 8) { v0 = silu4(v0); v1 = silu4(v1); }
                        *(pg8::u32x4*)(base + bj * 128 + cw) = pack8(v0, v1); }
                } else if (t == 12) {
                    if (wc == 0) { *(pg8::f32x4*)(ALR + row * 32 + 8 * fq) = acc[ai][0][m][0]; *(pg8::f32x4*)(ALR + row * 32 + 8 * fq + 4) = acc[ai][0][m][1]; }
                } else if (t < 21) {
                    *(pg8::u32x4*)(Z + row * 1024 + (t - 13) * 128 + cw) = pack8(acc[ai][0][m][0] * acc[ai][1][m][0], acc[ai][0][m][1] * acc[ai][1][m][1]);
                } else {
                    *(pg8::u32x4*)(CBG + row * 1024 + (t - 21) * 128 + cw) = pack8(acc[ai][0][m][0] * silu4(acc[ai][1][m][0]), acc[ai][0][m][1] * silu4(acc[ai][1][m][1]));
                }
            }
    }
};
struct FEpiRes {
    static constexpr bool PERM = false, AFTER_DRAIN = false;
    const float* xl; const float* xc; float* outl; float* outc; const float* MODl;
    DEVI void operator()(const pg8::f32x4 (&acc)[2][2][4][2], const pg8::Unit& u, int wr, int wc, int fr, int fq) const {
        const int row0 = u.pm * 256 + wr * 64 + fr, col0 = u.pn * 256 + wc * 32 + 4 * fq;
        const bool lat = u.pm < NLAT / 256;
        const float* gate = MODl + (size_t)(lat ? (u.pm >> 4) : 4) * 3072 + 2048 + col0;
        pg8::f32x4 gv[2][2];
#pragma unroll
        for (int bj = 0; bj < 2; ++bj)
#pragma unroll
            for (int n = 0; n < 2; ++n) gv[bj][n] = *(const pg8::f32x4*)(gate + bj * 128 + n * 16);
        const float* xin = lat ? xl : xc - (size_t)NLAT * 1024; float* o = lat ? outl : outc - (size_t)NLAT * 1024;
#pragma unroll
        for (int ai = 0; ai < 2; ++ai)
#pragma unroll
            for (int m = 0; m < 4; ++m) { const size_t off = (size_t)(row0 + ai * 128 + m * 16) * 1024 + col0;
#pragma unroll
                for (int bj = 0; bj < 2; ++bj)
#pragma unroll
                    for (int n = 0; n < 2; ++n) { const pg8::f32x4 xv = *(const pg8::f32x4*)(xin + off + bj * 128 + n * 16); *(pg8::f32x4*)(o + off + bj * 128 + n * 16) = xv + gv[bj][n] * acc[ai][bj][m][n]; } }
    }
};
struct FEpi3 {
    static constexpr bool PERM = true, AFTER_DRAIN = false;
    bf16_t* XR; bf16_t* SG;
    DEVI void operator()(const pg8::f32x4 (&acc)[2][2][4][2], const pg8::Unit& u, int wr, int wc, int fr, int fq) const {
        const int t = u.pn, row0 = u.pm * 256 + wr * 64 + fr, cw = wc * 32 + 8 * fq;
        bf16_t* base = t < 8 ? XR + (size_t)xr_pad_of_tile(u.pm) * 2048 + t * 256 : SG + (t - 8) * 256;
#pragma unroll
        for (int ai = 0; ai < 2; ++ai)
#pragma unroll
            for (int m = 0; m < 4; ++m) { bf16_t* rp = base + (size_t)(row0 + ai * 128 + m * 16) * 2048 + cw;
#pragma unroll
                for (int bj = 0; bj < 2; ++bj) { pg8::f32x4 v0 = acc[ai][bj][m][0], v1 = acc[ai][bj][m][1]; if (t >= 8) { v0 = silu4(v0); v1 = silu4(v1); }
                    *(pg8::u32x4*)(rp + bj * 128) = pack8(v0, v1); } }
    }
};
#ifndef FAST_GEMM
#define FAST_GEMM 1
#endif


#define LASP __attribute__((address_space(3)))
__device__ void st_glawalk(const Params& p, int vb, int nvb, unsigned char* lds_, const bf16_t* QIN, const bf16_t* KET, const bf16_t* SC, const float* DEC, const bf16_t* VT, bf16_t* OF, bf16_t* OB) {
    typedef pg8::bf16x8 bx8; typedef pg8::f32x4 f4; typedef unsigned u32x2 __attribute__((ext_vector_type(2))); typedef pg8::u32x4 u4;
    LASP unsigned char* lds = (LASP unsigned char*)lds_;
    constexpr int QOFF = 0, KOFF = 17408, SOFF = KOFF + 18432, VOFF = SOFF + 9216, DOFF = VOFF + 4608, BUFSZ = 50176;
    const int tid = threadIdx.x, wid = __builtin_amdgcn_readfirstlane(tid >> 6), lane = tid & 63, c = lane & 15, g = lane >> 4;
    for (int it0 = vb; it0 < 256; it0 += nvb) {
        const int item = (nvb == 256) ? ((it0 & 7) * 32 + (it0 >> 3)) : it0;
        const int vs = item & 7, combo = item >> 3, d = combo & 1, h = (combo >> 1) & 3, bb = combo >> 3;
        LDS_BARRIER();
        if (wid >= 2) {
            const int lt = tid - 128;
            unsigned long long cst[8]; unsigned mult[8]; int doff[8];
#pragma unroll
            for (int j = 0; j < 8; ++j) { const int pp = lt + 384 * j;
                if (pp < 1024) { cst[j] = (unsigned long long)QIN + (pp >> 4) * 256 + (pp & 15) * 16; mult[j] = 16384u; doff[j] = QOFF + (pp >> 4) * 272 + (pp & 15) * 16; }
                else if (pp < 2048) { const int q = pp - 1024; cst[j] = (unsigned long long)KET + (q >> 3) * 128 + (q & 7) * 16; mult[j] = 16384u; doff[j] = KOFF + (q >> 3) * 144 + (q & 7) * 16; }
                else if (pp < 2560) { const int q = pp - 2048; cst[j] = (unsigned long long)SC + (q >> 3) * 128 + (q & 7) * 16; mult[j] = 8192u; doff[j] = SOFF + (q >> 3) * 144 + (q & 7) * 16; }
                else if (pp < 2816) { const int q = pp - 2560; cst[j] = (unsigned long long)VT + (vs * 32 + (q >> 3)) * 128 + (q & 7) * 16 - (unsigned long long)d * 16384; mult[j] = 16384u; doff[j] = VOFF + (q >> 3) * 144 + (q & 7) * 16; }
                else if (pp < 2848) { const int q = pp - 2816; cst[j] = (unsigned long long)DEC + q * 16; mult[j] = 512u; doff[j] = DOFF + q * 16; }
                else { cst[j] = (unsigned long long)DEC; mult[j] = 0u; doff[j] = -1; } }
            u4 r0[8], r1[8];
#define GW_LOAD(R, step) do { const int cc_ = d == 0 ? ((step) < 4 ? 64 + (step) : (step) - 4) : 67 - (step); const unsigned u_ = (unsigned)(((bb * NCH + cc_) * 4 + h) * 2 + d); \
                _Pragma("unroll") for (int j_ = 0; j_ < 8; ++j_) R[j_] = *(const u4*)(cst[j_] + (unsigned long long)u_ * mult[j_]); } while (0)
#define GW_WRITE(R, bufi) do { LASP unsigned char* b_ = lds + (bufi) * BUFSZ; _Pragma("unroll") for (int j_ = 0; j_ < 8; ++j_) if (doff[j_] >= 0) *(LASP u4*)(b_ + doff[j_]) = R[j_]; } while (0)
            GW_LOAD(r0, 0); GW_WRITE(r0, 0); GW_LOAD(r0, 1); GW_LOAD(r1, 2);
            LDS_BARRIER();
            for (int step = 0; step < NCH; step += 2) {
                GW_WRITE(r0, 1); if (step + 3 < NCH) GW_LOAD(r0, step + 3);
                LDS_BARRIER();
                if (step + 2 < NCH) { GW_WRITE(r1, 0); if (step + 4 < NCH) GW_LOAD(r1, step + 4); }
                LDS_BARRIER();
            }
#undef GW_LOAD
#undef GW_WRITE
        } else {
            f4 S[8];
#pragma unroll
            for (int m = 0; m < 8; ++m) S[m] = (f4){0.f, 0.f, 0.f, 0.f};
            bf16_t* O = d == 0 ? OF : OB;
            LDS_BARRIER();
            for (int step = 0; step < NCH; ++step) {
                const LASP unsigned char* B = lds + (step & 1) * BUFSZ;
#define SB0() __builtin_amdgcn_sched_barrier(0)
#define RDQ(dst_lo, dst_hi, ks) do { _Pragma("unroll") for (int mt = 0; mt < 4; ++mt) { const LASP unsigned char* qa = B + QOFF + (16 * mt + c) * 272 + (32 * (ks) + 4 * g) * 2; dst_lo[mt] = *(const LASP u32x2*)qa; dst_hi[mt] = *(const LASP u32x2*)(qa + 32); } } while (0)
#define MMQ(lo, hi, ks) do { _Pragma("unroll") for (int mt = 0; mt < 4; ++mt) { u4 w; w.x = lo[mt].x; w.y = lo[mt].y; w.z = hi[mt].x; w.w = hi[mt].y; o[mt] = __builtin_amdgcn_mfma_f32_16x16x32_bf16(sB[ks], __builtin_bit_cast(bx8, w), o[mt], 0, 0, 0); } } while (0)
#define RDK(kf, dv, m0) do { _Pragma("unroll") for (int mm = 0; mm < 4; ++mm) { const LASP unsigned char* ka = B + KOFF + (16 * ((m0) + mm) + c) * 144 + g * 16; kf[mm][0] = *(const LASP bx8*)ka; kf[mm][1] = *(const LASP bx8*)(ka + 64); dv[mm] = *(const LASP f4*)(B + DOFF + (16 * ((m0) + mm) + 4 * g) * 4); } } while (0)
#define MMK(kf, dv, m0) do { _Pragma("unroll") for (int mm = 0; mm < 4; ++mm) { S[(m0) + mm] = S[(m0) + mm] * dv[mm]; S[(m0) + mm] = __builtin_amdgcn_mfma_f32_16x16x32_bf16(kf[mm][0], bv0, S[(m0) + mm], 0, 0, 0); S[(m0) + mm] = __builtin_amdgcn_mfma_f32_16x16x32_bf16(kf[mm][1], bv1, S[(m0) + mm], 0, 0, 0); } } while (0)
                const bx8 bv0 = *(const LASP bx8*)(B + VOFF + (16 * wid + c) * 144 + g * 16), bv1 = *(const LASP bx8*)(B + VOFF + (16 * wid + c) * 144 + 64 + g * 16);
                u32x2 qa_lo[4], qa_hi[4], qb_lo[4], qb_hi[4];
                RDQ(qa_lo, qa_hi, 0); RDQ(qb_lo, qb_hi, 1);
                bx8 sB[4];
#pragma unroll
                for (int ks = 0; ks < 4; ++ks) { u4 w; w.x = pg8::cvt_pk_bf16(S[2 * ks][0], S[2 * ks][1]); w.y = pg8::cvt_pk_bf16(S[2 * ks][2], S[2 * ks][3]);
                    w.z = pg8::cvt_pk_bf16(S[2 * ks + 1][0], S[2 * ks + 1][1]); w.w = pg8::cvt_pk_bf16(S[2 * ks + 1][2], S[2 * ks + 1][3]); sB[ks] = __builtin_bit_cast(bx8, w); }
                f4 o[4];
#pragma unroll
                for (int mt = 0; mt < 4; ++mt) o[mt] = (f4){0.f, 0.f, 0.f, 0.f};
                SB0();
                MMQ(qa_lo, qa_hi, 0); SB0();
                RDQ(qa_lo, qa_hi, 2); SB0();
                MMQ(qb_lo, qb_hi, 1); SB0();
                RDQ(qb_lo, qb_hi, 3); SB0();
                MMQ(qa_lo, qa_hi, 2); SB0();
                bx8 sf[4][2];
#pragma unroll
                for (int mt = 0; mt < 4; ++mt) { const LASP unsigned char* sa = B + SOFF + (16 * mt + c) * 144 + g * 16; sf[mt][0] = *(const LASP bx8*)sa; sf[mt][1] = *(const LASP bx8*)(sa + 64); }
                SB0();
                MMQ(qb_lo, qb_hi, 3); SB0();
                bx8 kfa[4][2], kfb[4][2]; f4 dva[4], dvb[4];
                RDK(kfa, dva, 0); SB0();
#pragma unroll
                for (int mt = 0; mt < 4; ++mt) { o[mt] = __builtin_amdgcn_mfma_f32_16x16x32_bf16(bv0, sf[mt][0], o[mt], 0, 0, 0); o[mt] = __builtin_amdgcn_mfma_f32_16x16x32_bf16(bv1, sf[mt][1], o[mt], 0, 0, 0); }
                SB0();
                RDK(kfb, dvb, 4); SB0();
                MMK(kfa, dva, 0); SB0();
                MMK(kfb, dvb, 4); SB0();
#undef SB0
#undef RDQ
#undef MMQ
#undef RDK
#undef MMK
                const int cc = d == 0 ? (step < 4 ? 64 + step : step - 4) : 67 - step; const int row0 = row_of(bb, cc, 0);
#pragma unroll
                for (int mt = 0; mt < 4; ++mt) { u32x2 w; w.x = pg8::cvt_pk_bf16(o[mt][0], o[mt][1]); w.y = pg8::cvt_pk_bf16(o[mt][2], o[mt][3]);
                    *(u32x2*)(O + (size_t)(row0 + 16 * mt + c) * 1024 + h * 256 + vs * 32 + 16 * wid + 4 * g) = w; }
                LDS_BARRIER();
            }
        }
    }
}
#ifndef FAST_WALK
#define FAST_WALK 1
#endif

template <int MODE, int DIR>
__device__ __forceinline__ void st_rglru_impl(const Params& p, int vb, int nvb, unsigned char* lds_, const bf16_t* XR, const bf16_t* SG, const bf16_t* BD, float* SUMA, float* SUMH, bf16_t* Y) {
    typedef pg8::bf16x8 bx8; typedef pg8::f32x4 f4; typedef float f32x2v __attribute__((ext_vector_type(2)));
    LASP unsigned char* lds = (LASP unsigned char*)lds_;
    constexpr int AOFF = 0, FOFF = 17408, BUF = 51200, CWOFF = 2 * BUF;
    constexpr int ND = MODE == 0 ? 1 : 2, NCOMBO = MODE == 0 ? 32 : 16, NTILE = MODE == 0 ? NB * NCH : NB * 64;
    const int tid = threadIdx.x, wid = __builtin_amdgcn_readfirstlane(tid >> 6), lane = tid & 63, c = lane & 15, g = lane >> 4, cp = tid & 63, tg = tid >> 6;
    int P, part, cstep, combo0;
    if (nvb >= NCOMBO) { P = nvb / NCOMBO; part = vb / NCOMBO; cstep = NCOMBO; combo0 = vb % NCOMBO; if (part >= P) return; } else { P = 1; part = 0; cstep = nvb; combo0 = vb; }
    for (int combo = combo0; combo < NCOMBO; combo += cstep) {
        if (MODE == 0 && (combo & 1) != DIR) continue;
        const int nb = MODE == 0 ? (combo >> 1) : combo; constexpr int d0 = MODE == 0 ? DIR : 0;
        const int ch = nb * 128 + 16 * wid + c;
        bx8 wa[ND][4], wx[ND][4]; float ba[ND], bxx[ND], k8[ND];
        LDS_BARRIER();
#pragma unroll
        for (int dd = 0; dd < ND; ++dd) { constexpr int dzero = d0; const int d = dzero + dd;
            const bf16_t* wA = BD + ((size_t)(d * 16 + nb) * 128 + 16 * wid + c) * 128 + 8 * g; const bf16_t* wX = wA + (size_t)2 * 16 * 128 * 128;
#pragma unroll
            for (int ks = 0; ks < 4; ++ks) { wa[dd][ks] = *(const bx8*)(wA + 32 * ks); wx[dd][ks] = *(const bx8*)(wX + 32 * ks); }
            ba[dd] = p.o_b_a[d * 2048 + ch]; bxx[dd] = p.o_b_x[d * 2048 + ch]; k8[dd] = 8.f * 1.4426950408889634f * softplusf_(-p.o_lam[d * 2048 + ch]);
            if (tg < 5) { const f32x2v w2 = tg < 4 ? *(const f32x2v*)(p.o_conv_w + ((size_t)d * 4 + tg) * 2048 + nb * 128 + 2 * cp) : *(const f32x2v*)(p.o_conv_b + (size_t)d * 2048 + nb * 128 + 2 * cp);
                *(LASP f32x2v*)(lds + CWOFF + ((dd * 5 + tg) * 128 + 2 * cp) * 4) = w2; } }
        LDS_BARRIER();
        unsigned xr[14]; float cnext[2] = {0.f, 0.f};
#pragma unroll
        for (int jr = 0; jr < 14; ++jr) xr[jr] = 0u;
#define RG_PREF(tile) do { const int bb_ = MODE == 0 ? (tile) / NCH : (tile) >> 6, cc_ = MODE == 0 ? (tile) % NCH : (tile) & 63; const int row0_ = row_of(bb_, cc_, 0); \
            const bf16_t* xp_ = XR + (size_t)(row0_ + xr_pad_of_tile(row0_ >> 8) + 8 * tg - 3) * 2048 + nb * 128 + 2 * cp; \
            _Pragma("unroll") for (int jr = 0; jr < 14; ++jr) { if (MODE == 1 || (d0 == 0 ? jr < 11 : jr >= 3)) xr[jr] = *(const unsigned*)(xp_ + (size_t)jr * 2048); } \
            if (MODE == 1) { cnext[0] = SUMH[(((size_t)bb_ * 2 + 0) * NCH + cc_) * 2048 + ch]; cnext[1] = SUMH[(((size_t)bb_ * 2 + 1) * NCH + cc_) * 2048 + ch]; } } while (0)
        int it = 0;
        if (part < NTILE) RG_PREF(part);
        for (int tile = part; tile < NTILE; tile += P) {
            const int bb = MODE == 0 ? tile / NCH : tile >> 6, cc = MODE == 0 ? tile % NCH : tile & 63; const int row0 = row_of(bb, cc, 0);
            unsigned xcur[14]; float ccur[2];
#pragma unroll
            for (int jr = 0; jr < 14; ++jr) xcur[jr] = xr[jr];
            ccur[0] = cnext[0]; ccur[1] = cnext[1];
            if (tile + P < NTILE) RG_PREF(tile + P);
            float hsum[4][4];
#pragma unroll
            for (int dd = 0; dd < ND; ++dd) { constexpr int dzero = d0; const int d = dzero + dd;
                LASP unsigned char* B = lds + (it & 1) * BUF; ++it;
                { f32x2v cv[8]; const f32x2v cbv = *(const LASP f32x2v*)(lds + CWOFF + ((dd * 5 + 4) * 128 + 2 * cp) * 4);
#pragma unroll
                  for (int i = 0; i < 8; ++i) cv[i] = cbv;
#pragma unroll
                  for (int jj = 0; jj < 4; ++jj) { const f32x2v cwv = *(const LASP f32x2v*)(lds + CWOFF + ((dd * 5 + jj) * 128 + 2 * cp) * 4);
#pragma unroll
                      for (int i = 0; i < 8; ++i) { const int jr = d == 0 ? i + jj : i + 6 - jj; cv[i].x += cwv.x * __uint_as_float(xcur[jr] << 16); cv[i].y += cwv.y * __uint_as_float(xcur[jr] & 0xffff0000u); } }
#pragma unroll
                  for (int i = 0; i < 8; ++i) { const int rho = 16 * (2 * (tg & 1) + (i >> 2)) + 4 * (tg >> 1) + (i & 3);
                      *(LASP unsigned*)(B + AOFF + rho * 272 + 4 * cp) = pg8::cvt_pk_bf16(cv[i].x, cv[i].y); *(LASP f32x2v*)(B + FOFF + rho * 528 + 8 * cp) = cv[i]; } }
                LDS_BARRIER();
                const int gl = d == 0 ? g : 3 - g;
                const int src1 = d == 0 ? lane - 16 : lane + 16, src2 = d == 0 ? lane - 32 : lane + 32, srcT = d == 0 ? 48 + c : c;
                const size_t sidx = (((size_t)bb * 2 + d) * NCH + cc) * 2048 + ch;
                float av[16], uv[16]; float pa = 1.f, lh = 0.f;
#pragma unroll
                for (int mtl = 0; mtl < 4; ++mtl) { const int mt = d == 0 ? mtl : 3 - mtl;
                    f4 aam = (f4){0.f, 0.f, 0.f, 0.f}, axm = (f4){0.f, 0.f, 0.f, 0.f};
#pragma unroll
                    for (int ks = 0; ks < 4; ++ks) { const bx8 af = *(const LASP bx8*)(B + AOFF + (16 * mt + c) * 272 + (32 * ks + 8 * g) * 2);
                        aam = __builtin_amdgcn_mfma_f32_16x16x32_bf16(af, wa[dd][ks], aam, 0, 0, 0); axm = __builtin_amdgcn_mfma_f32_16x16x32_bf16(af, wx[dd][ks], axm, 0, 0, 0); }
#pragma unroll
                    for (int sq = 0; sq < 4; ++sq) { const int r = d == 0 ? sq : 3 - sq;
                        const float xv = *(const LASP float*)(B + FOFF + (16 * mt + 4 * g + r) * 528 + (16 * wid + c) * 4);
                        const float rr = sigmoidf_(aam[r] + ba[dd]), ii = sigmoidf_(axm[r] + bxx[dd]);
                        const float a = fexp2_(-k8[dd] * rr), u = __builtin_amdgcn_sqrtf(fmaxf(1.f - a * a, 0.f)) * (ii * xv);
                        lh = a * lh + u; pa *= a; if (MODE == 1) { av[mt * 4 + r] = a; uv[mt * 4 + r] = u; } }
                }
                float XA = pa, XU = lh, tA, tU;
                tA = __shfl(XA, src1); tU = __shfl(XU, src1); if (gl >= 1) { XU = tU * XA + XU; XA = tA * XA; }
                tA = __shfl(XA, src2); tU = __shfl(XU, src2); if (gl >= 2) { XU = tU * XA + XU; XA = tA * XA; }
                if (MODE == 0) { if (gl == 3) { SUMA[sidx] = XA; SUMH[sidx] = XU; } }
                else {
                    float eA = __shfl(XA, src1), eU = __shfl(XU, src1); if (gl == 0) { eA = 1.f; eU = 0.f; }
                    float hh = ccur[dd] * eA + eU;
#pragma unroll
                    for (int mtl = 0; mtl < 4; ++mtl) { const int mt = d == 0 ? mtl : 3 - mtl;
#pragma unroll
                        for (int sq = 0; sq < 4; ++sq) { const int r = d == 0 ? sq : 3 - sq; hh = av[mt * 4 + r] * hh + uv[mt * 4 + r]; if (dd == 0) hsum[mt][r] = hh; else hsum[mt][r] += hh; } }
                }
            }
            if (MODE == 1) {
#pragma unroll
                for (int mt = 0; mt < 4; ++mt)
#pragma unroll
                    for (int r = 0; r < 4; ++r) { const size_t o = (size_t)(row0 + 16 * g + 4 * mt + r) * 2048 + ch; Y[o] = f2bf(hsum[mt][r] * bf2f(SG[o])); }
            }
        }
        LDS_BARRIER();
#undef RG_PREF
    }
}
template <int MODE>
__device__ __forceinline__ void st_rglru(const Params& p, int vb, int nvb, unsigned char* lds_, const bf16_t* XR, const bf16_t* SG, const bf16_t* BD, float* SUMA, float* SUMH, bf16_t* Y) {
    if (MODE == 1) { st_rglru_impl<1, 0>(p, vb, nvb, lds_, XR, SG, BD, SUMA, SUMH, Y); return; }
    const int combo0 = nvb >= 32 ? vb % 32 : vb;
    if (nvb >= 32) { if ((combo0 & 1) == 0) st_rglru_impl<0, 0>(p, vb, nvb, lds_, XR, SG, BD, SUMA, SUMH, Y); else st_rglru_impl<0, 1>(p, vb, nvb, lds_, XR, SG, BD, SUMA, SUMH, Y); }
    else { st_rglru_impl<0, 0>(p, vb, nvb, lds_, XR, SG, BD, SUMA, SUMH, Y); st_rglru_impl<0, 1>(p, vb, nvb, lds_, XR, SG, BD, SUMA, SUMH, Y); }
}
#ifndef FAST_RG
#define FAST_RG 1
#endif

#define XB_TMO      128
#define XB_XCNT(j)  (256  + 64 * (j))
#define XB_XSUB(j)  (1280 + 64 * (j))
#define XB_XGEN(j)  (2304 + 64 * (j))
#define XB_TOP      3328
#define XB_TOPGEN   3392
#define XB_SPIN_CAP (1u << 20)
DEVI unsigned xb_ld(unsigned* p)              { return __hip_atomic_load(p, __ATOMIC_RELAXED, __HIP_MEMORY_SCOPE_AGENT); }
DEVI unsigned xb_add(unsigned* p, unsigned v) { return __hip_atomic_fetch_add(p, v, __ATOMIC_RELAXED, __HIP_MEMORY_SCOPE_AGENT); }
DEVI unsigned xb_xcc_id() { return (unsigned)__builtin_amdgcn_s_getreg((3 << 11) | 20) & 0xFu; }
#define XB_SPIN(cond, bar) do { unsigned _sp = 0; while (cond) { __builtin_amdgcn_s_sleep(1); \
    if ((++_sp & 255u) == 0u) { if (xb_ld(&(bar)[XB_TMO])) break; if (_sp > XB_SPIN_CAP) { atomicAdd(&(bar)[XB_TMO], 1u); break; } } } } while (0)
struct XcdBarrier { unsigned* bar; unsigned x; volatile __attribute__((address_space(3))) unsigned* st; };
DEVI XcdBarrier xcd_barrier_post(unsigned* bar, volatile __attribute__((address_space(3))) unsigned* st) {
    XcdBarrier b; b.bar = bar; b.x = xb_xcc_id(); b.st = st;
    if (threadIdx.x == 0) (void)xb_add(&bar[XB_XCNT(b.x)], 1u);
    return b;
}
DEVI void xcd_barrier_complete(unsigned* bar, unsigned x, unsigned& nloc, unsigned& nx) {
    const unsigned G = gridDim.x * gridDim.y * gridDim.z;
    unsigned sum, cnt, mine, sp = 0u;
    for (;;) {
        sum = 0u; cnt = 0u; mine = 0u;
#pragma unroll
        for (unsigned j = 0; j < 16; ++j) { const unsigned c = xb_ld(&bar[XB_XCNT(j)]); sum += c; cnt += (c > 0u) ? 1u : 0u; mine = (j == x) ? c : mine; }
        if (sum == G) break;
        __builtin_amdgcn_s_sleep(1);
        if ((++sp & 255u) == 0u) { if (xb_ld(&bar[XB_TMO])) break; if (sp > XB_SPIN_CAP) { atomicAdd(&bar[XB_TMO], 1u); break; } }
    }
    nloc = mine > 0u ? mine : 1u; nx = cnt > 0u ? cnt : 1u;
}
DEVI void xcd_barrier(const XcdBarrier& b) {
    asm volatile("s_waitcnt vmcnt(0)" ::: "memory");
    __syncthreads();
    if (threadIdx.x == 0) {
        unsigned* bar = b.bar;
        __builtin_amdgcn_s_waitcnt(0);
        unsigned nloc = b.st[0], nx = b.st[1];
        if (nloc == 0u) { xcd_barrier_complete(bar, b.x, nloc, nx); b.st[0] = nloc; b.st[1] = nx; }
        const unsigned old = xb_add(&bar[XB_XSUB(b.x)], 1u);
        const unsigned gen = old / nloc;
        if (old + 1u == (gen + 1u) * nloc) {
            __builtin_amdgcn_fence(__ATOMIC_RELEASE, "agent");
            asm volatile("s_waitcnt vmcnt(0)" ::: "memory");
            const unsigned og = xb_add(&bar[XB_TOP], 1u);
            const unsigned tg = og / nx;
            if (og + 1u == (tg + 1u) * nx) xb_add(&bar[XB_TOPGEN], 1u);
            else XB_SPIN(xb_ld(&bar[XB_TOPGEN]) == tg, bar);
            __builtin_amdgcn_fence(__ATOMIC_ACQUIRE, "agent");
            xb_add(&bar[XB_XGEN(b.x)], 1u);
            asm volatile("s_waitcnt vmcnt(0)" ::: "memory");
        } else {
            XB_SPIN(xb_ld(&bar[XB_XGEN(b.x)]) == gen, bar);
            __builtin_amdgcn_fence(__ATOMIC_ACQUIRE, "agent");
            asm volatile("s_waitcnt vmcnt(0)" ::: "memory");
        }
    }
    __syncthreads();
}
__device__ __forceinline__ void run_stage(const Params& p, int st, int vb, int nvb, unsigned char* lds) {
    unsigned char* ws = p.ws;
    float* MOD = (float*)(ws + WS_MOD); float* ALR = (float*)(ws + WS_ALR); float* X1C = (float*)(ws + WS_X1C);
    float* SUMA = (float*)(ws + WS_SUMA); float* SUMH = (float*)(ws + WS_SUMH); float* DEC = (float*)(ws + WS_DEC);
    bf16_t* Bt1 = (bf16_t*)(ws + WS_BT1); bf16_t* Bt2 = (bf16_t*)(ws + WS_BT2); bf16_t* Bt3 = (bf16_t*)(ws + WS_BT3); bf16_t* Bt4 = (bf16_t*)(ws + WS_BT4);
    bf16_t* S0 = (bf16_t*)(ws + WS_SLOT(0)); bf16_t* S1 = (bf16_t*)(ws + WS_SLOT(1)); bf16_t* S2 = (bf16_t*)(ws + WS_SLOT(2));
    bf16_t* S3 = (bf16_t*)(ws + WS_SLOT(3)); bf16_t* S4 = (bf16_t*)(ws + WS_SLOT(4)); bf16_t* S5 = (bf16_t*)(ws + WS_SLOT(5));
    bf16_t* DO0 = (bf16_t*)p.out; bf16_t* DOSC = (bf16_t*)((unsigned char*)p.out + 34 * MiB);
    switch (st) {
    case 0: st_mod(p, vb, nvb, (float*)lds); st_wprep(p, vb, nvb, lds); break;
    case 1: st_modulate(p, vb, nvb, 0, p.x, p.ctx, S0); break;
    case 3: st_glaprep(p, vb, nvb, lds, S1, S2, ALR, S3, S4, DOSC, DEC, S5); break;
#if FAST_WALK
    case 4: st_glawalk(p, vb, nvb, lds, S3, S4, DOSC, DEC, S5, S2, DO0); break;
#else
    case 4: st_glawalk_naive(p, vb, nvb, (float*)lds, S3, S4, DOSC, DEC, S5, S2, DO0); break;
#endif
    case 6: st_inner(p, vb, nvb, S2, DO0, S3, S4, S5, S0); break;
    case 8: st_modulate(p, vb, nvb, 1, p.out, X1C, S2);
            {
              for (int e = vb * NTHREADS + threadIdx.x; e < 9 * 4 * 256; e += nvb * NTHREADS) { const int gi = e >> 10, w = e & 1023; const int r0 = gi < 4 ? 4096 * gi + 4 * gi : (gi < 8 ? NLAT + 16 + 256 * (gi - 4) + 4 * (gi - 4) : NT + 32);
                  *(uint4*)(S3 + (size_t)r0 * 2048 + w * 8) = uint4{0u, 0u, 0u, 0u}; } }
            break;
    case 11: st_carry(p, vb, nvb, SUMA, SUMH); break;
#if FAST_RG
    case 10: st_rglru<0>(p, vb, nvb, lds, S3, S0, (const bf16_t*)(ws + WS_BD), SUMA, SUMH, S0); break;
    case 12: st_rglru<1>(p, vb, nvb, lds, S3, S0, (const bf16_t*)(ws + WS_BD), SUMA, SUMH, S0); break;
#else
    case 10: st_rglru_naive<0>(p, vb, nvb, (float*)lds, S3, S0, SUMA, SUMH, S0); break;
    case 12: st_rglru_naive<1>(p, vb, nvb, (float*)lds, S3, S0, SUMA, SUMH, S0); break;
#endif
    case 14: st_final(p, vb, nvb); break;
#if FAST_GEMM
    case 2: { FEpi1 E{S1, S2, S3, S4, S5, ALR}; pg8::Gemm g{S0, Bt1, NT, N1, 1024}; pg8::TileOrder S; S.init(NT / 256, 9, nvb, vb, 0, 8, 0, 12);
              pg8::gemm_phase<FEpi1, pg8::TileOrder, true, true>((PG8_LAS unsigned char*)lds, g, S, E); } break;
    case 5: { FEpi1 E{S1, S2, S3, S4, S5, ALR}; pg8::Gemm g{S0, Bt1, NT, N1, 1024}; pg8::TileOrder S; S.init(NT / 256, 20, nvb, vb, 0, 4, 8, 13);
              pg8::gemm_phase<FEpi1, pg8::TileOrder, true, true>((PG8_LAS unsigned char*)lds, g, S, E); } break;
    case 7: { FEpiRes E{p.x, p.ctx, p.out, X1C, MOD}; pg8::Gemm g{S0, Bt2, NT, 1024, 2048}; pg8::TileOrder S; S.init(NT / 256, 4, nvb, vb);
              pg8::gemm_phase<FEpiRes, pg8::TileOrder, true, true>((PG8_LAS unsigned char*)lds, g, S, E); } break;
    case 9: { FEpi3 E{S3, S0}; pg8::Gemm g{S2, Bt3, NT, 4096, 1024}; pg8::TileOrder S; S.init(NLAT / 256, 16, nvb, vb, 0, 1 << 30, 0, 0, NCTX / 256, 8, NLAT / 256);
              pg8::gemm_phase<FEpi3, pg8::TileOrder, true, true>((PG8_LAS unsigned char*)lds, g, S, E); } break;
    case 13: { FEpiRes E{p.out, nullptr, p.out, nullptr, MOD + 5 * 3072}; pg8::Gemm g{S0, Bt4, NLAT, 1024, 2048}; pg8::TileOrder S; S.init(NLAT / 256, 4, nvb, vb);
              pg8::gemm_phase<FEpiRes, pg8::TileOrder, true, true>((PG8_LAS unsigned char*)lds, g, S, E); } break;
#else
    case 2: { Epi1 E{S1, S2, S3, S4, S5, ALR}; st_gemm_naive(vb, nvb, (float*)lds, S0, Bt1, 0, NT / 32, 0, 8, 1024, E); st_gemm_naive(vb, nvb, (float*)lds, S0, Bt1, 0, NT / 32, 12, 13, 1024, E); } break;
    case 5: { Epi1 E{S1, S2, S3, S4, S5, ALR}; st_gemm_naive(vb, nvb, (float*)lds, S0, Bt1, 0, NT / 32, 8, 12, 1024, E); st_gemm_naive(vb, nvb, (float*)lds, S0, Bt1, 0, NT / 32, 13, 29, 1024, E); } break;
    case 7: { EpiRes E{p.x, p.ctx, p.out, X1C, MOD}; st_gemm_naive(vb, nvb, (float*)lds, S0, Bt2, 0, NT / 32, 0, 4, 2048, E); } break;
    case 9: { Epi3 E{S3, S0}; st_gemm_naive(vb, nvb, (float*)lds, S2, Bt3, 0, NLAT / 32, 0, 16, 1024, E); st_gemm_naive(vb, nvb, (float*)lds, S2, Bt3, NLAT / 32, NT / 32, 0, 8, 1024, E); } break;
    case 13: { EpiRes E{p.out, nullptr, p.out, nullptr, MOD + 5 * 3072}; st_gemm_naive(vb, nvb, (float*)lds, S0, Bt4, 0, NLAT / 32, 0, 4, 2048, E); } break;
#endif
    }
}
constexpr int NSTAGES = 15;
constexpr int LDS_BYTES = 147456;

#ifndef ONE_LAUNCH
#define ONE_LAUNCH 1
#endif
#if !ONE_LAUNCH
__global__ void __launch_bounds__(NTHREADS) k_mega(Params p, int st) {
    extern __shared__ __attribute__((aligned(16))) unsigned char lds[];
    run_stage(p, st, blockIdx.x, gridDim.x, lds);
}
#else
__global__ void __launch_bounds__(NTHREADS) k_mega(Params p) {
    extern __shared__ __attribute__((aligned(16))) unsigned char lds[];
    volatile __attribute__((address_space(3))) unsigned* st = (volatile __attribute__((address_space(3))) unsigned*)((__attribute__((address_space(3))) unsigned char*)lds + (LDS_BYTES - 64));
    if (threadIdx.x < 2) st[threadIdx.x] = 0u;
    __syncthreads();
    const XcdBarrier bar = xcd_barrier_post((unsigned*)(p.ws + WS_CTL) + 4096, st);
#ifndef REP_STAGE
#define REP_STAGE -1
#endif
#ifndef REP_N
#define REP_N 1
#endif
#define RS(k) do { run_stage(p, k, blockIdx.x, gridDim.x, lds); if ((k) == REP_STAGE) { for (int rep_ = 0; rep_ < REP_N; ++rep_) { xcd_barrier(bar); run_stage(p, k, blockIdx.x, gridDim.x, lds); } } } while (0)
#define GS() xcd_barrier(bar)
    RS(0); GS(); RS(1); GS(); RS(2); GS(); RS(3); GS(); RS(4); GS(); RS(5); GS(); RS(6); GS(); RS(7); GS();
    RS(8); GS(); RS(9); GS(); RS(10); GS(); RS(11); GS(); RS(12); GS(); RS(13); GS(); RS(14);
#undef RS
#undef GS
}
#endif

extern "C" void kernel_launch(void* const* d_in, const int* in_sizes, int n_in, void* d_out, int out_size, void* d_ws, size_t ws_size, hipStream_t stream) {
    static int inited = 0, grid_blocks = 0;
    if (!inited) {
        if (n_in != 23 || ws_size < WS_END || out_size != NLAT * D) { fprintf(stderr, "kernel_launch: unexpected shapes n_in %d ws %zu out %d\n", n_in, ws_size, out_size); inited = -1; return; }
        if (hipFuncSetAttribute((const void*)k_mega, hipFuncAttributeMaxDynamicSharedMemorySize, LDS_BYTES) != hipSuccess) { fprintf(stderr, "hipFuncSetAttribute failed\n"); inited = -1; return; }
        int dev = 0, cus = 0, per_cu = 0;
        (void)hipGetDevice(&dev); (void)hipDeviceGetAttribute(&cus, hipDeviceAttributeMultiprocessorCount, dev);
        (void)hipOccupancyMaxActiveBlocksPerMultiprocessor(&per_cu, (const void*)k_mega, NTHREADS, LDS_BYTES);
        if (per_cu < 1) { fprintf(stderr, "kernel_launch: occupancy query says %d blocks per CU\n", per_cu); per_cu = 1; }
        if (per_cu > 1) per_cu = 1;
        grid_blocks = cus * per_cu;
        inited = 1;
    }
    if (inited < 0) return;
    Params p{};
    const float** f = (const float**)&p;
    for (int i = 0; i < 23; ++i) f[i] = (const float*)d_in[i];
    p.out = (float*)d_out; p.ws = (unsigned char*)d_ws;
    (void)hipMemsetAsync((unsigned char*)d_ws + WS_CTL, 0, 2 * MiB, stream);
#if ONE_LAUNCH
    void* args[] = {&p};
    hipError_t e = hipLaunchCooperativeKernel((const void*)k_mega, dim3(grid_blocks), dim3(NTHREADS), args, LDS_BYTES, stream);
    if (e != hipSuccess) fprintf(stderr, "cooperative launch failed: %s (grid %d)\n", hipGetErrorString(e), grid_blocks);
#else
    for (int st = 0; st < NSTAGES; ++st) hipLaunchKernelGGL(k_mega, dim3(1024), dim3(NTHREADS), LDS_BYTES, stream, p, st);
#endif
}
```

```cpp
#include <hip/hip_runtime.h>
#include <hip/hip_cooperative_groups.h>
namespace cg = cooperative_groups;
#include <cstdio>
#include <cstdint>

typedef unsigned short bf16_t;
#define DEVI __device__ __forceinline__
#define LDS_BARRIER() do { asm volatile("s_waitcnt lgkmcnt(0)" ::: "memory"); __builtin_amdgcn_s_barrier(); asm volatile("" ::: "memory"); } while (0)

constexpr int D = 1024, NB = 4, SEQ = 4096, CTXL = 256;
constexpr int NLAT = NB * SEQ;
constexpr int NCTX = NB * CTXL;
constexpr int NT = NLAT + NCTX;
constexpr int NCH = 68;
constexpr int EVEN_IN = 7200;
constexpr int N1 = 7424;
constexpr int N1A = 13 * 256;
constexpr int RGW = 2048;
constexpr float EPS = 1e-6f;

constexpr size_t MiB = 1u << 20;
constexpr size_t WS_CTL = 0;
constexpr size_t WS_MOD = 1 * MiB;
constexpr size_t WS_ALR = 2 * MiB;
constexpr size_t WS_X1C = 5 * MiB;
constexpr size_t WS_SUMA = 9 * MiB;
constexpr size_t WS_SUMH = 9 * MiB + 4608 * 1024;
constexpr size_t WS_DEC = 18 * MiB;
constexpr size_t WS_BT1 = 19 * MiB + 512 * 1024;
constexpr size_t WS_BT2 = 34 * MiB;
constexpr size_t WS_BT3 = 38 * MiB;
constexpr size_t WS_BT4 = 46 * MiB;
constexpr size_t WS_BD = 50 * MiB;
constexpr size_t WS_S0 = 52 * MiB;
constexpr size_t SLOT = 34 * MiB;
constexpr size_t WS_END = WS_S0 + 6 * SLOT;
static_assert(WS_END == 256 * MiB, "ws map");
#define WS_SLOT(i) (WS_S0 + (size_t)(i) * SLOT)

struct Params {
    const float* x; const float* c; const float* ctx; const float* c_ctx; const float* norm_g; const float* w_mod; const float* b_mod;
    const float* e_w_in; const float* e_w_a2; const float* e_b_a2; const float* e_gla_g; const float* e_conv_w; const float* e_w_out;
    const float* o_w_in; const float* o_conv_w; const float* o_conv_b; const float* o_w_a; const float* o_b_a; const float* o_w_x; const float* o_b_x;
    const float* o_lam; const float* o_w_out; const float* final_g;
    float* out; unsigned char* ws;
};

DEVI float bf2f(bf16_t v) { return __uint_as_float((unsigned)v << 16); }
DEVI bf16_t f2bf(float f) { unsigned u = __float_as_uint(f); return (bf16_t)((u + 0x7fffu + ((u >> 16) & 1u)) >> 16); }
DEVI unsigned pk2(float lo, float hi) { return (unsigned)f2bf(lo) | ((unsigned)f2bf(hi) << 16); }
DEVI float fexp2_(float x) { return __builtin_amdgcn_exp2f(x); }
DEVI float frcp_(float x) { return __builtin_amdgcn_rcpf(x); }
DEVI float sigmoidf_(float x) { return frcp_(1.0f + fexp2_(-1.4426950408889634f * x)); }
DEVI float siluf_(float x) { return x * frcp_(1.0f + fexp2_(-1.4426950408889634f * x)); }
DEVI float softplusf_(float x) { return fmaxf(x, 0.f) + log1pf(__expf(-fabsf(x))); }
DEVI float logsigmoidf_(float x) { return fminf(x, 0.f) - 0.6931471805599453f * __builtin_amdgcn_logf(1.0f + fexp2_(-1.4426950408889634f * fabsf(x))); }
DEVI int row_of(int bb, int c, int t) { return c < 64 ? bb * 4096 + c * 64 + t : NLAT + bb * 256 + (c - 64) * 64 + t; }
DEVI int mod_idx(int row) { return row < NLAT ? (row >> 12) : 4; }
DEVI int xr_pad_of_tile(int pm) { return pm < 64 ? 4 * ((pm >> 4) + 1) : 20 + 4 * (pm - 64); }
constexpr int XR_ROWS = NT + 36;
DEVI float wave_sum(float v) {
#pragma unroll
    for (int o = 1; o < 64; o <<= 1) v += __shfl_xor(v, o);
    return v;
}
__host__ __device__ inline int colmap1(int n) {
    const int t = n >> 8, c = n & 255;
    if (t < 12) return n;
    if (t == 12) return c < 32 ? 3072 + c : -1;
    if (t < 21) { const int j = t - 13; return c < 128 ? 4128 + 128 * j + c : 5152 + 128 * j + (c - 128); }
    const int j = t - 21; return c < 128 ? 3104 + 128 * j + c : 6176 + 128 * j + (c - 128);
}

#define NTHREADS 512

__device__ void st_mod(const Params& p, int vb, int nvb, float* lds) {
    float* MOD = (float*)(p.ws + WS_MOD);
    for (int i = threadIdx.x; i < 5 * 1024; i += NTHREADS) { const int s = i >> 10, k = i & 1023; const float v = s < 4 ? p.c[s * 1024 + k] : p.c_ctx[k]; lds[i] = siluf_(v); }
    __syncthreads();
    const int lane = threadIdx.x & 63, gw = vb * (NTHREADS / 64) + (threadIdx.x >> 6), ngw = nvb * (NTHREADS / 64);
    for (int it = gw; it < 2 * 48 * 32; it += ngw) {
        const int kc = it & 31, cb = (it >> 5) % 48, li = it / (32 * 48), j = cb * 64 + lane, k0 = kc * 32;
        const float* W = p.w_mod + ((size_t)li * 1024 + k0) * 3072 + j;
        float wv[32];
#pragma unroll
        for (int k = 0; k < 32; ++k) wv[k] = W[(size_t)k * 3072];
        float a0 = 0.f, a1 = 0.f, a2 = 0.f, a3 = 0.f, a4 = 0.f;
#pragma unroll
        for (int k = 0; k < 32; ++k) { const float w = wv[k]; a0 += lds[k0 + k] * w; a1 += lds[1024 + k0 + k] * w; a2 += lds[2048 + k0 + k] * w; a3 += lds[3072 + k0 + k] * w; a4 += lds[4096 + k0 + k] * w; }
        const float bv = kc == 0 ? p.b_mod[li * 3072 + j] : 0.f;
        float* o = MOD + (size_t)li * 5 * 3072 + j;
        atomicAdd(o, a0 + bv); atomicAdd(o + 3072, a1 + bv); atomicAdd(o + 2 * 3072, a2 + bv); atomicAdd(o + 3 * 3072, a3 + bv); atomicAdd(o + 4 * 3072, a4 + bv);
    }
    __syncthreads();
}

__device__ __forceinline__ void wt_item(const float* src, int ldw, bf16_t* dst, int K, int k0, __attribute__((address_space(3))) float* scr, int lane) {
    typedef unsigned v4u __attribute__((ext_vector_type(4)));
    if (src) {
#pragma unroll 8
        for (int i = 0; i < 32; ++i) { const int kk = 2 * i + (lane >> 5); scr[kk * 33 + (lane & 31)] = src[(size_t)(k0 + kk) * ldw + (lane & 31)]; }
    }
    asm volatile("s_waitcnt lgkmcnt(0)" ::: "memory");
    const int cch = lane & 7;
#pragma unroll
    for (int j = 0; j < 4; ++j) { const int n = (lane >> 3) + 8 * j; const __attribute__((address_space(3))) float* sp = scr + (8 * cch) * 33 + n;
        v4u o = {0u, 0u, 0u, 0u};
        if (src) { o.x = pk2(sp[0 * 33], sp[1 * 33]); o.y = pk2(sp[2 * 33], sp[3 * 33]); o.z = pk2(sp[4 * 33], sp[5 * 33]); o.w = pk2(sp[6 * 33], sp[7 * 33]); }
        *(v4u*)(dst + (size_t)n * K + k0 + 8 * cch) = o; }
    asm volatile("s_waitcnt lgkmcnt(0)" ::: "memory");
}
__device__ void st_wprep(const Params& p, int vb, int nvb, unsigned char* lds_) {
    bf16_t* Bt1 = (bf16_t*)(p.ws + WS_BT1); bf16_t* Bt2 = (bf16_t*)(p.ws + WS_BT2); bf16_t* Bt3 = (bf16_t*)(p.ws + WS_BT3); bf16_t* Bt4 = (bf16_t*)(p.ws + WS_BT4);
    bf16_t* BD = (bf16_t*)(p.ws + WS_BD);
    const int lane = threadIdx.x & 63, wv = threadIdx.x >> 6, gw = vb * (NTHREADS / 64) + wv, ngw = nvb * (NTHREADS / 64);
    __attribute__((address_space(3))) float* scr = (__attribute__((address_space(3))) float*)lds_ + 8192 + wv * (64 * 33);
    constexpr int I1 = 16 * (N1 / 32), I2 = 32 * 32, I3 = 16 * 128, I4 = 32 * 32, I5 = 64 * 8;
    for (int it = gw; it < I1 + I2 + I3 + I4 + I5; it += ngw) {
        int r = it;
        if (r < I1) { const int nbk = N1 / 32, kb = r / nbk, nb = r % nbk; const int sc = colmap1(nb * 32); wt_item(sc < 0 ? nullptr : p.e_w_in + sc, EVEN_IN, Bt1 + (size_t)nb * 32 * 1024, 1024, kb * 64, scr, lane); continue; } r -= I1;
        if (r < I2) { const int kb = r / 32, nb = r % 32; wt_item(p.e_w_out + nb * 32, 1024, Bt2 + (size_t)nb * 32 * 2048, 2048, kb * 64, scr, lane); continue; } r -= I2;
        if (r < I3) { const int kb = r / 128, nb = r % 128; wt_item(p.o_w_in + nb * 32, 4096, Bt3 + (size_t)nb * 32 * 1024, 1024, kb * 64, scr, lane); continue; } r -= I3;
        if (r < I4) { const int kb = r / 32, nb = r % 32; wt_item(p.o_w_out + nb * 32, 1024, Bt4 + (size_t)nb * 32 * 2048, 2048, kb * 64, scr, lane); continue; } r -= I4;
        { const int m = r >> 8, dn = (r >> 3) & 31, kb = (r >> 2) & 1, nb = r & 3; const float* W = (m == 0 ? p.o_w_a : p.o_w_x) + (size_t)dn * 16384;
          wt_item(W + nb * 32, 128, BD + (size_t)m * 2 * 16 * 16384 + (size_t)dn * 16384 + (size_t)nb * 32 * 128, 128, kb * 64, scr, lane); }
    }
}

__device__ void st_modulate(const Params& p, int vb, int nvb, int li, const float* xlat, const float* xctx, bf16_t* H, const float* slab = nullptr, int nslab = 0, const float* gatec = nullptr) {
    const float* MOD = (const float*)(p.ws + WS_MOD) + (size_t)li * 5 * 3072;
    const float* g = p.norm_g + li * 1024;
    const int lane = threadIdx.x & 63, gw = vb * (NTHREADS / 64) + (threadIdx.x >> 6), ngw = nvb * (NTHREADS / 64);
    for (int row = gw; row < NT; row += ngw) {
        const float* xr = row < NLAT ? xlat + (size_t)row * 1024 : xctx + (size_t)(row - NLAT) * 1024;
        const float* md = MOD + (size_t)mod_idx(row) * 3072;
        float4 v[4]; float ss = 0.f;
#pragma unroll
        for (int j = 0; j < 4; ++j) { v[j] = *(const float4*)(xr + j * 256 + lane * 4);
            if (slab && row >= NLAT) {
                float4 a = {0.f, 0.f, 0.f, 0.f};
                for (int ks = 0; ks < nslab; ++ks) { const float4 t = *(const float4*)(slab + ((size_t)ks * NCTX + (row - NLAT)) * 1024 + j * 256 + lane * 4); a.x += t.x; a.y += t.y; a.z += t.z; a.w += t.w; }
                const float4 gt = *(const float4*)(gatec + j * 256 + lane * 4); v[j].x += gt.x * a.x; v[j].y += gt.y * a.y; v[j].z += gt.z * a.z; v[j].w += gt.w * a.w; }
            ss += v[j].x * v[j].x + v[j].y * v[j].y + v[j].z * v[j].z + v[j].w * v[j].w; }
        const float rinv = rsqrtf(wave_sum(ss) * (1.f / 1024.f) + EPS);
#pragma unroll
        for (int j = 0; j < 4; ++j) { const int c0 = j * 256 + lane * 4; const float4 gg = *(const float4*)(g + c0), sh = *(const float4*)(md + c0), sc = *(const float4*)(md + 1024 + c0);
            ushort4 o; o.x = f2bf(v[j].x * rinv * gg.x * (1.f + sc.x) + sh.x); o.y = f2bf(v[j].y * rinv * gg.y * (1.f + sc.y) + sh.y);
            o.z = f2bf(v[j].z * rinv * gg.z * (1.f + sc.z) + sh.z); o.w = f2bf(v[j].w * rinv * gg.w * (1.f + sc.w) + sh.w);
            *(ushort4*)(H + (size_t)row * 1024 + c0) = o; }
    }
}

template <class Epi>
__device__ void st_gemm_naive(int vb, int nvb, float* lds, const bf16_t* A, const bf16_t* Bt, int mt0, int mt1, int nt0, int nt1, int K, const Epi& E) {
    float* As = lds;
    float* Bs = lds + 32 * 33;
    const int tid = threadIdx.x, tx = tid & 63, ty = tid >> 6;
    const int nmt = mt1 - mt0, nnt = nt1 - nt0;
    for (int it = vb; it < nmt * nnt; it += nvb) {
        const int m0 = (mt0 + it / nnt) * 32, n0 = (nt0 + it % nnt) * 256;
        float acc[4][4];
#pragma unroll
        for (int i = 0; i < 4; ++i)
#pragma unroll
            for (int j = 0; j < 4; ++j) acc[i][j] = 0.f;
        for (int k0 = 0; k0 < K; k0 += 32) {
            __syncthreads();
            for (int e = tid; e < 32 * 32; e += NTHREADS) { const int r = e >> 5, kk = e & 31; As[r * 33 + kk] = bf2f(A[(size_t)(m0 + r) * K + k0 + kk]); }
            for (int e = tid; e < 256 * 32; e += NTHREADS) { const int r = e >> 5, kk = e & 31; Bs[r * 33 + kk] = bf2f(Bt[(size_t)(n0 + r) * K + k0 + kk]); }
            __syncthreads();
#pragma unroll 8
            for (int kk = 0; kk < 32; ++kk) {
                float a[4], b[4];
#pragma unroll
                for (int i = 0; i < 4; ++i) a[i] = As[(ty * 4 + i) * 33 + kk];
#pragma unroll
                for (int j = 0; j < 4; ++j) b[j] = Bs[(tx + 64 * j) * 33 + kk];
#pragma unroll
                for (int i = 0; i < 4; ++i)
#pragma unroll
                    for (int j = 0; j < 4; ++j) acc[i][j] += a[i] * b[j];
            }
        }
#pragma unroll
        for (int i = 0; i < 4; ++i) E(m0 + ty * 4 + i, n0, tx, acc[i]);
    }
    __syncthreads();
}

struct Epi1 {
    bf16_t *QK, *V, *SGA, *Z, *CBG; float* ALR;
    DEVI void operator()(int row, int n0, int cl, const float (&v)[4]) const {
        const int t = n0 >> 8;
        if (t < 4) { for (int j = 0; j < 4; ++j) QK[(size_t)row * 1024 + n0 + cl + 64 * j] = f2bf(v[j]); }
        else if (t < 8) { for (int j = 0; j < 4; ++j) V[(size_t)row * 1024 + (n0 - 1024) + cl + 64 * j] = f2bf(v[j]); }
        else if (t < 12) { for (int j = 0; j < 4; ++j) SGA[(size_t)row * 1024 + (n0 - 2048) + cl + 64 * j] = f2bf(siluf_(v[j])); }
        else if (t == 12) { if (cl < 32) ALR[(size_t)row * 32 + cl] = v[0]; }
        else if (t < 21) { const int jt = t - 13; Z[(size_t)row * 1024 + 128 * jt + cl] = f2bf(v[0] * v[2]); Z[(size_t)row * 1024 + 128 * jt + cl + 64] = f2bf(v[1] * v[3]); }
        else { const int jt = t - 21; CBG[(size_t)row * 1024 + 128 * jt + cl] = f2bf(v[0] * siluf_(v[2])); CBG[(size_t)row * 1024 + 128 * jt + cl + 64] = f2bf(v[1] * siluf_(v[3])); }
    }
};
struct EpiRes {
    const float* xl; const float* xc; float* outl; float* outc; const float* MODl;
    DEVI void operator()(int row, int n0, int cl, const float (&v)[4]) const {
        const float* gate = MODl + (size_t)mod_idx(row) * 3072 + 2048;
        for (int j = 0; j < 4; ++j) { const int col = n0 + cl + 64 * j;
            if (row < NLAT) outl[(size_t)row * 1024 + col] = xl[(size_t)row * 1024 + col] + gate[col] * v[j];
            else if (outc) outc[(size_t)(row - NLAT) * 1024 + col] = xc[(size_t)(row - NLAT) * 1024 + col] + gate[col] * v[j]; }
    }
};
struct Epi3 {
    bf16_t* XR; bf16_t* SG;
    DEVI void operator()(int row, int n0, int cl, const float (&v)[4]) const {
        for (int j = 0; j < 4; ++j) { const int col = n0 + cl + 64 * j;
            if (col < 2048) XR[(size_t)row * 2048 + col] = f2bf(v[j]); else if (row < NLAT) SG[(size_t)row * 2048 + col - 2048] = f2bf(siluf_(v[j])); }
    }
};

#define LASQ __attribute__((address_space(3)))
__device__ void st_glaprep(const Params& p, int vb, int nvb, unsigned char* ldsb, const bf16_t* QK, const bf16_t* V, const float* ALR, bf16_t* QIN, bf16_t* KET, bf16_t* SC, float* DEC, bf16_t* VT) {
    typedef unsigned u4 __attribute__((ext_vector_type(4))); typedef unsigned u2 __attribute__((ext_vector_type(2))); typedef float f4 __attribute__((ext_vector_type(4))); typedef short bx8 __attribute__((ext_vector_type(8)));
    LASQ unsigned char* lds = (LASQ unsigned char*)ldsb;
    constexpr int RQ = 0, RK = 17408, Q0 = 34816, K0 = 52224, VR = 69632, AL = VR + 33792, TT = AL + 8192;
    const int tid = threadIdx.x, kk = tid & 127, tq = tid >> 7, wv = tid >> 6, ln = tid & 63, cl = ln & 15, gq = ln >> 4;
    u4 r[9];
#define GP_LOAD(item) do { const int h_ = (item) & 3, bc_ = (item) >> 2, c_ = bc_ % NCH, bb_ = bc_ / NCH; const size_t row0_ = (size_t)row_of(bb_, c_, 0); \
        _Pragma("unroll") for (int j_ = 0; j_ < 2; ++j_) { const int p_ = tid + 512 * j_; r[j_] = *(const u4*)(QK + (row0_ + (p_ >> 4)) * 1024 + h_ * 128 + (p_ & 15) * 8); r[2 + j_] = *(const u4*)(QK + (row0_ + (p_ >> 4)) * 1024 + 512 + h_ * 128 + (p_ & 15) * 8); } \
        _Pragma("unroll") for (int j_ = 0; j_ < 4; ++j_) { const int p_ = tid + 512 * j_; r[4 + j_] = *(const u4*)(V + (row0_ + (p_ >> 5)) * 1024 + h_ * 256 + (p_ & 31) * 8); } \
        r[8] = *(const u4*)(ALR + (row0_ + (tid >> 3)) * 32 + (tid & 7) * 4); } while (0)
    const int NIT = NB * NCH * 4;
    if (vb < NIT) GP_LOAD(vb);
    for (int item = vb; item < NIT; item += nvb) {
        const int h = item & 3;
        LDS_BARRIER();
#pragma unroll
        for (int j = 0; j < 2; ++j) { const int pp = tid + 512 * j; *(LASQ u4*)(lds + RQ + (pp >> 4) * 272 + (pp & 15) * 16) = r[j]; *(LASQ u4*)(lds + RK + (pp >> 4) * 272 + (pp & 15) * 16) = r[2 + j]; }
#pragma unroll
        for (int j = 0; j < 4; ++j) { const int pp = tid + 512 * j; *(LASQ u4*)(lds + VR + (pp >> 5) * 528 + (pp & 31) * 16) = r[4 + j]; }
        *(LASQ u4*)(lds + AL + (tid >> 3) * 128 + (tid & 7) * 16) = r[8];
        float w2a[2][16], b2a[2];
#pragma unroll
        for (int d = 0; d < 2; ++d) {
#pragma unroll
            for (int rr = 0; rr < 16; ++rr) w2a[d][rr] = p.e_w_a2[((size_t)d * 16 + rr) * 512 + h * 128 + kk];
            b2a[d] = p.e_b_a2[d * 512 + h * 128 + kk]; }
        asm volatile("" ::: "memory");
        if (item + nvb < NIT) GP_LOAD(item + nvb);
        LDS_BARRIER();
        unsigned qkr[16];
#pragma unroll
        for (int i = 0; i < 16; ++i) { qkr[i] = (unsigned)*(const LASQ unsigned short*)(lds + RQ + (tq * 16 + i) * 272 + kk * 2) | ((unsigned)*(const LASQ unsigned short*)(lds + RK + (tq * 16 + i) * 272 + kk * 2) << 16); }
        float bc[2][16];
#pragma unroll
        for (int d = 0; d < 2; ++d) {
            const float (&w2)[16] = w2a[d]; const float b2 = b2a[d];
#pragma unroll
            for (int i = 0; i < 16; ++i) { const LASQ f4* a = (const LASQ f4*)(lds + AL + (tq * 16 + i) * 128 + d * 64); const f4 a0 = a[0], a1 = a[1], a2 = a[2], a3 = a[3];
                float z = b2 + a0[0] * w2[0] + a0[1] * w2[1] + a0[2] * w2[2] + a0[3] * w2[3] + a1[0] * w2[4] + a1[1] * w2[5] + a1[2] * w2[6] + a1[3] * w2[7]
                        + a2[0] * w2[8] + a2[1] * w2[9] + a2[2] * w2[10] + a2[3] * w2[11] + a3[0] * w2[12] + a3[1] * w2[13] + a3[2] * w2[14] + a3[3] * w2[15];
                bc[d][i] = logsigmoidf_(z) * (1.f / 16.f); }
            float sacc = 0.f;
            if (d == 0) {
#pragma unroll
                for (int i = 0; i < 16; ++i) { sacc += bc[d][i]; bc[d][i] = sacc; } }
            else {
#pragma unroll
                for (int i = 15; i >= 0; --i) { sacc += bc[d][i]; bc[d][i] = sacc; } }
            *(LASQ float*)(lds + TT + ((d * 4 + tq) * 128 + kk) * 4) = sacc;
        }
        LDS_BARRIER();
        const float scale = 0.08838834764831845f;
#pragma unroll
        for (int d = 0; d < 2; ++d) {
            const size_t u = (size_t)item * 2 + d;
            float off = 0.f, blast = 0.f;
#pragma unroll
            for (int q = 0; q < 4; ++q) { const float tv = *(const LASQ float*)(lds + TT + ((d * 4 + q) * 128 + kk) * 4); blast += tv; if (d == 0 ? (q < tq) : (q > tq)) off += tv; }
            LASQ unsigned char* qd = lds + (d == 0 ? Q0 : RQ); LASQ unsigned char* kd = lds + (d == 0 ? K0 : RK);
            unsigned ke[8];
#pragma unroll
            for (int i = 0; i < 16; ++i) { const int t = tq * 16 + i; const float bq = bc[d][i] + off;
                const float qv = __uint_as_float(qkr[i] << 16) * scale, kv = __uint_as_float(qkr[i] & 0xffff0000u);
                const float eb = fexp2_(1.4426950408889634f * bq);
                *(LASQ unsigned short*)(qd + t * 272 + kk * 2) = f2bf(qv * eb); *(LASQ unsigned short*)(kd + t * 272 + kk * 2) = f2bf(kv * frcp_(eb));
                const unsigned kev = f2bf(kv * fexp2_(1.4426950408889634f * (blast - bq)));
                if (i & 1) ke[i >> 1] |= kev << 16; else ke[i >> 1] = kev; }
            { u4 w0 = {ke[0], ke[1], ke[2], ke[3]}, w1 = {ke[4], ke[5], ke[6], ke[7]}; u4* dst = (u4*)(KET + (u * 128 + kk) * 64 + tq * 16); dst[0] = w0; dst[1] = w1; }
            if (tq == 0) DEC[u * 128 + kk] = fexp2_(1.4426950408889634f * blast);
        }
        LDS_BARRIER();
#pragma unroll
        for (int d = 0; d < 2; ++d) {
            const size_t u = (size_t)item * 2 + d;
            const LASQ unsigned char* qd = lds + (d == 0 ? Q0 : RQ); const LASQ unsigned char* kd = lds + (d == 0 ? K0 : RK);
#pragma unroll
            for (int j = 0; j < 2; ++j) { const int pp = tid + 512 * j; *(u4*)(QIN + u * 8192 + (pp >> 4) * 128 + (pp & 15) * 8) = *(const LASQ u4*)(qd + (pp >> 4) * 272 + (pp & 15) * 16); }
            const int mt = wv >> 1;
#pragma unroll
            for (int nn = 0; nn < 2; ++nn) { const int nt = 2 * (wv & 1) + nn; f4 acc = {0.f, 0.f, 0.f, 0.f};
#pragma unroll
                for (int k4 = 0; k4 < 4; ++k4) { const bx8 kf = *(const LASQ bx8*)(kd + (16 * nt + cl) * 272 + (32 * k4 + 8 * gq) * 2), qf = *(const LASQ bx8*)(qd + (16 * mt + cl) * 272 + (32 * k4 + 8 * gq) * 2);
                    acc = __builtin_amdgcn_mfma_f32_16x16x32_bf16(kf, qf, acc, 0, 0, 0); }
                const int t = 16 * mt + cl, s0 = 16 * nt + 4 * gq; float v[4];
#pragma unroll
                for (int rr = 0; rr < 4; ++rr) { const int sx = s0 + rr; v[rr] = (d == 0 ? (sx <= t) : (sx >= t)) ? acc[rr] : 0.f; }
                u2 w; w.x = pk2(v[0], v[1]); w.y = pk2(v[2], v[3]); *(u2*)(SC + (u * 64 + t) * 64 + s0) = w; }
        }
        { const int vc = tid & 255, th = tid >> 8; unsigned vv[16];
#pragma unroll
          for (int i = 0; i < 32; ++i) { const unsigned x = *(const LASQ unsigned short*)(lds + VR + (32 * th + i) * 528 + vc * 2); if (i & 1) vv[i >> 1] |= x << 16; else vv[i >> 1] = x; }
          u4* dst = (u4*)(VT + ((size_t)item * 256 + vc) * 64 + 32 * th);
          dst[0] = (u4){vv[0], vv[1], vv[2], vv[3]}; dst[1] = (u4){vv[4], vv[5], vv[6], vv[7]}; dst[2] = (u4){vv[8], vv[9], vv[10], vv[11]}; dst[3] = (u4){vv[12], vv[13], vv[14], vv[15]}; }
    }
    LDS_BARRIER();
#undef GP_LOAD
}

__device__ void st_glawalk_naive(const Params& p, int vb, int nvb, float* Sl, const bf16_t* QIN, const bf16_t* KET, const bf16_t* SC, const float* DEC, const bf16_t* VT, bf16_t* OF, bf16_t* OB) {
    const int vc = threadIdx.x & 255, half = threadIdx.x >> 8;
    for (int combo = vb; combo < 32; combo += nvb) {
        const int d = combo & 1, h = (combo >> 1) & 3, bb = combo >> 3;
        __syncthreads();
        for (int k = half * 64; k < half * 64 + 64; ++k) Sl[k * 256 + vc] = 0.f;
        __syncthreads();
        bf16_t* O = d == 0 ? OF : OB;
        for (int step = 0; step < NCH; ++step) {
            const int c = d == 0 ? (step < 4 ? 64 + step : step - 4) : 67 - step;
            const int u = ((bb * NCH + c) * 4 + h) * 2 + d;
            const bf16_t* q = QIN + (size_t)u * 64 * 128; const bf16_t* ke = KET + (size_t)u * 128 * 64; const bf16_t* sc = SC + (size_t)u * 64 * 64;
            const bf16_t* vt = VT + (((size_t)(u >> 1)) * 256 + vc) * 64;
            float vv[64];
#pragma unroll
            for (int t = 0; t < 64; ++t) vv[t] = bf2f(vt[t]);
            const int row0 = row_of(bb, c, 0);
            for (int t = half * 32; t < half * 32 + 32; ++t) { float a = 0.f;
                for (int k = 0; k < 128; ++k) a += bf2f(q[t * 128 + k]) * bf2f(f2bf(Sl[k * 256 + vc]));
#pragma unroll
                for (int s = 0; s < 64; ++s) a += bf2f(sc[t * 64 + s]) * vv[s];
                O[(size_t)(row0 + t) * 1024 + h * 256 + vc] = f2bf(a); }
            __syncthreads();
            for (int k = half * 64; k < half * 64 + 64; ++k) { float a = DEC[(size_t)u * 128 + k] * Sl[k * 256 + vc];
#pragma unroll
                for (int t = 0; t < 64; ++t) a += bf2f(ke[k * 64 + t]) * vv[t];
                Sl[k * 256 + vc] = a; }
            __syncthreads();
        }
    }
}

__device__ void st_inner(const Params& p, int vb, int nvb, const bf16_t* OF, const bf16_t* OB, const bf16_t* SGA, const bf16_t* Z, const bf16_t* CBG, bf16_t* INNER, const bf16_t* ZA, float* X1C) {
    const int lane = threadIdx.x & 63, gw = vb * (NTHREADS / 64) + (threadIdx.x >> 6), ngw = nvb * (NTHREADS / 64);
    for (int row = gw; row < NT; row += ngw) {
        bool hasp, hasn;
        if (row < NLAT) { const int t = row & 63; hasp = t != 0; hasn = t != 63; } else { const int t = (row - NLAT) & 255; hasp = t != 0; hasn = t != 255; }
#pragma unroll
        for (int h = 0; h < 4; ++h) {
            const int c0 = h * 256 + lane * 4;
            const ushort4 a = *(const ushort4*)(OF + (size_t)row * 1024 + c0), b = *(const ushort4*)(OB + (size_t)row * 1024 + c0);
            const float o0 = bf2f(a.x) + bf2f(b.x), o1 = bf2f(a.y) + bf2f(b.y), o2 = bf2f(a.z) + bf2f(b.z), o3 = bf2f(a.w) + bf2f(b.w);
            const float rinv = rsqrtf(wave_sum(o0 * o0 + o1 * o1 + o2 * o2 + o3 * o3) * (1.f / 256.f) + EPS);
            const float4 gg = *(const float4*)(p.e_gla_g + lane * 4);
            const ushort4 sg = *(const ushort4*)(SGA + (size_t)row * 1024 + c0);
            ushort4 o; o.x = f2bf(o0 * rinv * gg.x * bf2f(sg.x)); o.y = f2bf(o1 * rinv * gg.y * bf2f(sg.y)); o.z = f2bf(o2 * rinv * gg.z * bf2f(sg.z)); o.w = f2bf(o3 * rinv * gg.w * bf2f(sg.w));
            *(ushort4*)(INNER + (size_t)row * 2048 + c0) = o;
            const bf16_t* zb = h == 0 ? ZA + lane * 4 : Z + c0; const size_t zpitch = h == 0 ? 256 : 1024;
            const ushort4 zc = *(const ushort4*)(zb + (size_t)row * zpitch);
            ushort4 zp = {0, 0, 0, 0}, zn = {0, 0, 0, 0};
            if (hasp) zp = *(const ushort4*)(zb + (size_t)(row - 1) * zpitch);
            if (hasn) zn = *(const ushort4*)(zb + (size_t)(row + 1) * zpitch);
            const float4 w0 = *(const float4*)(p.e_conv_w + c0), w1 = *(const float4*)(p.e_conv_w + 1024 + c0), w2 = *(const float4*)(p.e_conv_w + 2048 + c0);
            const ushort4 cb = *(const ushort4*)(CBG + (size_t)row * 1024 + c0);
            ushort4 y; y.x = f2bf(bf2f(cb.x) * (w0.x * bf2f(zp.x) + w1.x * bf2f(zc.x) + w2.x * bf2f(zn.x)));
            y.y = f2bf(bf2f(cb.y) * (w0.y * bf2f(zp.y) + w1.y * bf2f(zc.y) + w2.y * bf2f(zn.y)));
            y.z = f2bf(bf2f(cb.z) * (w0.z * bf2f(zp.z) + w1.z * bf2f(zc.z) + w2.z * bf2f(zn.z)));
            y.w = f2bf(bf2f(cb.w) * (w0.w * bf2f(zp.w) + w1.w * bf2f(zc.w) + w2.w * bf2f(zn.w)));
            *(ushort4*)(INNER + (size_t)row * 2048 + 1024 + c0) = y;
        }
    }
}

template <int MODE>
__device__ void st_rglru_naive(const Params& p, int vb, int nvb, float* lds, const bf16_t* XR, const bf16_t* SG, float* SUMA, float* SUMH, bf16_t* Y) {
    float* xc = lds;
    float* av = xc + 64 * 128;
    float* uv = av + 64 * 128;
    float* hf = uv + 64 * 128;
    const int tid = threadIdx.x, j = tid & 127, tq = tid >> 7;
    const int nitems = MODE == 0 ? NB * NCH * 16 * 2 : NB * 64 * 16;
    for (int it = vb; it < nitems; it += nvb) {
        int bb, c, nb;
        if (MODE == 0) { nb = (it >> 1) & 15; const int bc = it >> 5; c = bc % NCH; bb = bc / NCH; } else { nb = it & 15; const int bc = it >> 4; c = bc & 63; bb = bc >> 6; }
        const int row0 = row_of(bb, c, 0);
        const int seg0 = c < 64 ? bb * 4096 : NLAT + bb * 256, segn = c < 64 ? 4096 : 256;
        const int tl0 = row0 - seg0;
        for (int dd = 0; dd < (MODE == 0 ? 1 : 2); ++dd) {
            const int d = MODE == 0 ? (it & 1) : dd;
            __syncthreads();
            for (int e = tid; e < 64 * 128; e += NTHREADS) { const int t = e >> 7, i = e & 127, ch = nb * 128 + i; float a = p.o_conv_b[d * 2048 + ch];
#pragma unroll
                for (int jj = 0; jj < 4; ++jj) { const int tt = d == 0 ? tl0 + t - 3 + jj : tl0 + t + 3 - jj;
                    if (tt >= 0 && tt < segn) a += p.o_conv_w[((size_t)d * 4 + jj) * 2048 + ch] * bf2f(XR[(size_t)(seg0 + tt) * 2048 + ch]); }
                xc[e] = a; }
            __syncthreads();
            const float* WA = p.o_w_a + ((size_t)d * 16 + nb) * 128 * 128; const float* WX = p.o_w_x + ((size_t)d * 16 + nb) * 128 * 128;
            const int ch = nb * 128 + j;
            const float ba = p.o_b_a[d * 2048 + ch], bx = p.o_b_x[d * 2048 + ch], sp = softplusf_(-p.o_lam[d * 2048 + ch]);
            for (int i16 = 0; i16 < 16; ++i16) { const int t = tq * 16 + i16; float ra = ba, rx = bx;
                for (int i = 0; i < 128; ++i) { const float xv = bf2f(f2bf(xc[t * 128 + i])); ra += xv * bf2f(f2bf(WA[i * 128 + j])); rx += xv * bf2f(f2bf(WX[i * 128 + j])); }
                const float r = sigmoidf_(ra), ig = sigmoidf_(rx); const float la = -8.f * r * sp; const float a = __expf(la);
                av[t * 128 + j] = a; uv[t * 128 + j] = sqrtf(-expm1f(2.f * la)) * (ig * xc[t * 128 + j]); }
            __syncthreads();
            if (tid < 128) {
                const size_t sidx = (((size_t)bb * 2 + d) * NCH + c) * 2048 + ch;
                if (MODE == 0) { float A = 1.f, hh = 0.f;
                    if (d == 0) for (int t = 0; t < 64; ++t) { const float a = av[t * 128 + j]; hh = a * hh + uv[t * 128 + j]; A *= a; }
                    else for (int t = 63; t >= 0; --t) { const float a = av[t * 128 + j]; hh = a * hh + uv[t * 128 + j]; A *= a; }
                    SUMA[sidx] = A; SUMH[sidx] = hh;
                } else { float hh = SUMH[sidx];
                    if (d == 0) for (int t = 0; t < 64; ++t) { hh = av[t * 128 + j] * hh + uv[t * 128 + j]; hf[t * 128 + j] = hh; }
                    else for (int t = 63; t >= 0; --t) { hh = av[t * 128 + j] * hh + uv[t * 128 + j]; const size_t o = (size_t)(row0 + t) * 2048 + ch; Y[o] = f2bf((hf[t * 128 + j] + hh) * bf2f(SG[o])); }
                }
            }
        }
    }
    __syncthreads();
}
__device__ void st_carry(const Params& p, int vb, int nvb, const float* SUMA, float* SUMH) {
    for (int e = vb * NTHREADS + threadIdx.x; e < NB * 2 * 2048; e += nvb * NTHREADS) {
        const int ch = e & 2047, d = (e >> 11) & 1, bb = e >> 12; float hh = 0.f;
        for (int s0 = 0; s0 < NCH; s0 += 17) {
            float A[17], H[17];
#pragma unroll
            for (int i = 0; i < 17; ++i) { const int step = s0 + i, c = d == 0 ? (step < 4 ? 64 + step : step - 4) : 67 - step; const size_t sidx = (((size_t)bb * 2 + d) * NCH + c) * 2048 + ch; A[i] = SUMA[sidx]; H[i] = SUMH[sidx]; }
#pragma unroll
            for (int i = 0; i < 17; ++i) { const int step = s0 + i, c = d == 0 ? (step < 4 ? 64 + step : step - 4) : 67 - step; const size_t sidx = (((size_t)bb * 2 + d) * NCH + c) * 2048 + ch; SUMH[sidx] = hh; hh = A[i] * hh + H[i]; }
        }
    }
}
__device__ void st_final(const Params& p, int vb, int nvb) {
    const int lane = threadIdx.x & 63, gw = vb * (NTHREADS / 64) + (threadIdx.x >> 6), ngw = nvb * (NTHREADS / 64);
    for (int row = gw; row < NLAT; row += ngw) { float* xr = p.out + (size_t)row * 1024; float4 v[4]; float ss = 0.f;
#pragma unroll
        for (int j = 0; j < 4; ++j) { v[j] = *(const float4*)(xr + j * 256 + lane * 4); ss += v[j].x * v[j].x + v[j].y * v[j].y + v[j].z * v[j].z + v[j].w * v[j].w; }
        const float rinv = rsqrtf(wave_sum(ss) * (1.f / 1024.f) + EPS);
#pragma unroll
        for (int j = 0; j < 4; ++j) { const float4 g = *(const float4*)(p.final_g + j * 256 + lane * 4); float4 o; o.x = v[j].x * rinv * g.x; o.y = v[j].y * rinv * g.y; o.z = v[j].z * rinv * g.z; o.w = v[j].w * rinv * g.w; *(float4*)(xr + j * 256 + lane * 4) = o; }
    }
}


namespace pg8 {
#define PG8_LAS __attribute__((address_space(3)))
typedef short bf16x8 __attribute__((ext_vector_type(8)));
typedef float f32x4 __attribute__((ext_vector_type(4)));
typedef unsigned u32x4 __attribute__((ext_vector_type(4)));
constexpr int BM = 256, BK = 64, HALF = 128, HTB = HALF * BK * 2, STAGE_BYTES = 8 * HTB, NXCD = 8, WGM = 8;
__host__ __device__ __forceinline__ int lds_byte(int r, int c) { const int st = (r >> 4) * 2 + (c >> 5), rr = r & 15, cc = c & 31, ob = rr * 64 + cc * 2; return st * 1024 + (ob ^ (((ob >> 9) & 1) << 5)); }
__host__ __device__ __forceinline__ void stage_rc(int b, int& R, int& C) { const int st = b / 1024, sb = b % 1024, swz = sb ^ (((sb >> 9) & 1) << 5); R = (st >> 1) * 16 + swz / 64; C = (st & 1) * 32 + (swz % 64) / 2; }
__host__ __device__ __forceinline__ int perm32(int rho) { const int n = rho >> 4, i = rho & 15; return 8 * (i >> 2) + 4 * n + (i & 3); }
struct Unit { int pm, pn, k0, nk; };
struct Gemm { const bf16_t* A; const bf16_t* Bt; int M, N, K; };
struct TileOrder {
    int nM, nN, nwg, G, c, m0, split, base0, base1, nkfull, nM2, nN2, m02, nKS, nk2;
    __device__ void init(int nM_, int nN_, int nkfull_, int G_, int c_, int m0_ = 0, int split_ = 1 << 30, int base0_ = 0, int base1_ = 0, int nM2_ = 0, int nN2_ = 0, int m02_ = 0, int nKS_ = 1, int nk2_ = 0) {
        nM = nM_; nN = nN_; nwg = nM * nN; nkfull = nkfull_; G = G_; c = c_; m0 = m0_; split = split_; base0 = base0_; base1 = base1_; nM2 = nM2_; nN2 = nN2_; m02 = m02_; nKS = nKS_; nk2 = nk2_; }
    __device__ bool next(int i, Unit& u) const {
        const long L = (long)i * G + c;
        if (L >= nwg) { const long L2 = L - nwg; if (L2 >= (long)nM2 * nN2 * nKS) return false; const int ks = (int)(L2 % nKS), rest = (int)(L2 / nKS);
            u.pm = m02 + rest / nN2; u.pn = rest % nN2; u.k0 = ks * nk2 * 64; u.nk = nk2; return true; }
        int wgid = (int)L; { const int q = nwg / NXCD, r = nwg % NXCD, xcd = wgid % NXCD, off = wgid / NXCD; wgid = (xcd < r ? xcd * (q + 1) : r * (q + 1) + (xcd - r) * q) + off; }
        const int nig = WGM * nN, gid = wgid / nig, fm = gid * WGM, gsz = (nM - fm) < WGM ? (nM - fm) : WGM;
        const int pm = fm + ((wgid % nig) % gsz), j = (wgid % nig) / gsz;
        u.pm = m0 + pm; u.pn = j < split ? base0 + j : base1 + (j - split); u.k0 = 0; u.nk = nkfull; return true;
    }
    __device__ __forceinline__ void a_ready(const Unit&) const {}
    __device__ __forceinline__ void done(const Unit&) const {}
};
typedef float f32x2_t __attribute__((ext_vector_type(2))); typedef __bf16 bf16x2_t __attribute__((ext_vector_type(2)));
__device__ __forceinline__ unsigned cvt_pk_bf16(float lo, float hi) { f32x2_t v = {lo, hi}; bf16x2_t b = __builtin_convertvector(v, bf16x2_t); return __builtin_bit_cast(unsigned, b); }
template <class Epi, class Sched, bool ALIGN_EPI = false, bool SP2 = false>
__device__ __forceinline__ void gemm_phase(PG8_LAS unsigned char* lds, const Gemm g, const Sched& S, const Epi& E) {
    const int tid = threadIdx.x, wid = __builtin_amdgcn_readfirstlane(tid >> 6), lane = tid & 63, wr = wid >> 2, wc = wid & 3, fr = lane & 15, fq = lane >> 4;
    const int K = g.K;
    unsigned voffA[2], voffB[2];
#pragma unroll
    for (int i = 0; i < 2; ++i) { int R, C; stage_rc(tid * 16 + i * 8192, R, C); const int Rb = Epi::PERM ? ((R & ~31) + perm32(R & 31)) : R;
        voffA[i] = (unsigned)(R * K + C) * 2u; voffB[i] = (unsigned)(Rb * K + C) * 2u; }
    const size_t kstep = (size_t)(BK * 2);
    const size_t hstep = (size_t)HALF * K * 2;
    const size_t tstep = 2 * hstep;
    const unsigned ldsw = (unsigned)wid * 1024u;
    const int aoff = lds_byte(wr * 64 + fr, fq * 8), boff = lds_byte(wc * 32 + fr, fq * 8);
#define PG8_SA(b, h) (((b) * 2 + (h)) * HTB)
#define PG8_SB(b, h) ((4 + (b) * 2 + (h)) * HTB)
#define PG8_STAGE(bufoff, gbase, voff) do { _Pragma("unroll") for (int _i = 0; _i < 2; ++_i) \
        __builtin_amdgcn_global_load_lds((const unsigned*)((const char*)(gbase) + (voff)[_i]), (PG8_LAS unsigned*)(lds + (bufoff) + ldsw + _i * 8192), 16, 0, 0); } while (0)
#define PG8_LDA(dst, b, h) do { _Pragma("unroll") for (int m = 0; m < 4; ++m) _Pragma("unroll") for (int k = 0; k < 2; ++k) dst[m][k] = *(const PG8_LAS bf16x8*)(lds + PG8_SA(b, h) + aoff + m * 2048 + k * 1024); } while (0)
#define PG8_LDB(dst, b, h) do { _Pragma("unroll") for (int n = 0; n < 2; ++n) _Pragma("unroll") for (int k = 0; k < 2; ++k) dst[n][k] = *(const PG8_LAS bf16x8*)(lds + PG8_SB(b, h) + boff + n * 2048 + k * 1024); } while (0)
#define PG8_MMA(ai, bj, At, Bt) do { __builtin_amdgcn_s_setprio(1); _Pragma("unroll") for (int m = 0; m < 4; ++m) _Pragma("unroll") for (int n = 0; n < 2; ++n) _Pragma("unroll") for (int k = 0; k < 2; ++k) \
        acc[ai][bj][m][n] = __builtin_amdgcn_mfma_f32_16x16x32_bf16(Bt[n][k], At[m][k], acc[ai][bj][m][n], 0, 0, 0); __builtin_amdgcn_s_setprio(0); } while (0)
#define PG8_WAIT_V(n) asm volatile("s_waitcnt vmcnt(" #n ")" ::: "memory")
#define PG8_WAIT_L(n) asm volatile("s_waitcnt lgkmcnt(" #n ")" ::: "memory")
#define PG8_BAR __builtin_amdgcn_s_barrier()
#define PG8_SCHED __builtin_amdgcn_sched_barrier(0)
    Unit cur, nxt; int ui = 0;
    if (!S.next(0, cur)) return;
    f32x4 acc[2][2][4][2];
#pragma unroll
    for (int a = 0; a < 2; ++a)
#pragma unroll
        for (int b = 0; b < 2; ++b)
#pragma unroll
            for (int m = 0; m < 4; ++m)
#pragma unroll
                for (int n = 0; n < 2; ++n) acc[a][b][m][n] = (f32x4){0.f, 0.f, 0.f, 0.f};
    bf16x8 At[4][2], B0[2][2], B1[2][2];
    const char* cA = (const char*)g.A + (size_t)cur.pm * tstep + (size_t)cur.k0 * 2; const char* cB = (const char*)g.Bt + (size_t)cur.pn * tstep + (size_t)cur.k0 * 2;
    S.a_ready(cur);
    if constexpr (SP2) {
        PG8_STAGE(PG8_SB(0, 0), cB, voffB); PG8_STAGE(PG8_SB(0, 1), cB + hstep, voffB); PG8_STAGE(PG8_SA(0, 0), cA, voffA); PG8_STAGE(PG8_SA(0, 1), cA + hstep, voffA);
        if (wr == 1) PG8_BAR;
        PG8_WAIT_V(2); PG8_BAR;
        PG8_STAGE(PG8_SB(1, 0), cB + kstep, voffB); PG8_STAGE(PG8_SA(1, 0), cA + kstep, voffA); PG8_STAGE(PG8_SB(1, 1), cB + hstep + kstep, voffB);
        PG8_WAIT_V(6); PG8_BAR;
    } else {
        PG8_STAGE(PG8_SB(0, 0), cB, voffB); PG8_STAGE(PG8_SA(0, 0), cA, voffA); PG8_STAGE(PG8_SB(0, 1), cB + hstep, voffB); PG8_STAGE(PG8_SA(0, 1), cA + hstep, voffA);
        if (wr == 1) PG8_BAR;
        PG8_WAIT_V(4); PG8_BAR;
        PG8_STAGE(PG8_SB(1, 0), cB + kstep, voffB); PG8_STAGE(PG8_SA(1, 0), cA + kstep, voffA); PG8_STAGE(PG8_SB(1, 1), cB + hstep + kstep, voffB);
        PG8_WAIT_V(6); PG8_BAR;
    }
    for (;;) {
        const bool has_next = S.next(ui + 1, nxt);
        const char* nA = has_next ? (const char*)g.A + (size_t)nxt.pm * tstep + (size_t)nxt.k0 * 2 : cA; const char* nB = has_next ? (const char*)g.Bt + (size_t)nxt.pn * tstep + (size_t)nxt.k0 * 2 : cB;
        const int nt = cur.nk;
        for (int t = 0; t < nt; t += 2) {
            const bool last = (t == nt - 2);
            const char* a1 = cA + (size_t)(t + 1) * kstep;
            const char* a2 = last ? nA : cA + (size_t)(t + 2) * kstep; const char* b2 = last ? nB : cB + (size_t)(t + 2) * kstep;
            const char* a3 = a2 + kstep; const char* b3 = b2 + kstep;
            if (last && has_next) S.a_ready(nxt);
            if constexpr (SP2) {
            PG8_LDB(B0, 0, 0); PG8_LDB(B1, 0, 1); PG8_SCHED; PG8_LDA(At, 0, 0); PG8_STAGE(PG8_SA(1, 1), a1 + hstep, voffA);
            PG8_WAIT_V(8); PG8_WAIT_L(0); PG8_BAR; PG8_MMA(0, 0, At, B0); PG8_MMA(0, 1, At, B1); PG8_BAR; PG8_SCHED;
            PG8_LDA(At, 0, 1); PG8_STAGE(PG8_SB(0, 0), b2, voffB); PG8_STAGE(PG8_SB(0, 1), b2 + hstep, voffB); PG8_STAGE(PG8_SA(0, 0), a2, voffA);
            PG8_WAIT_V(8); PG8_WAIT_L(0); PG8_BAR; PG8_MMA(1, 0, At, B0); PG8_MMA(1, 1, At, B1); PG8_BAR; PG8_SCHED;
            PG8_LDB(B0, 1, 0); PG8_LDB(B1, 1, 1); PG8_SCHED; PG8_LDA(At, 1, 0); PG8_STAGE(PG8_SA(0, 1), a2 + hstep, voffA);
            PG8_WAIT_V(8); PG8_WAIT_L(0); PG8_BAR; PG8_MMA(0, 0, At, B0); PG8_MMA(0, 1, At, B1); PG8_BAR; PG8_SCHED;
            PG8_LDA(At, 1, 1); PG8_STAGE(PG8_SB(1, 0), b3, voffB); PG8_STAGE(PG8_SB(1, 1), b3 + hstep, voffB); PG8_STAGE(PG8_SA(1, 0), a3, voffA);
            PG8_WAIT_V(8); PG8_WAIT_L(0); PG8_BAR; PG8_MMA(1, 0, At, B0); PG8_MMA(1, 1, At, B1); PG8_BAR; PG8_SCHED;
            } else {
            PG8_LDB(B0, 0, 0); PG8_SCHED; PG8_LDA(At, 0, 0); PG8_STAGE(PG8_SA(1, 1), a1 + hstep, voffA);
            PG8_WAIT_L(8); PG8_BAR; PG8_WAIT_L(0); PG8_MMA(0, 0, At, B0); PG8_BAR; PG8_SCHED;
            PG8_LDB(B1, 0, 1); PG8_STAGE(PG8_SB(0, 0), b2, voffB);
            PG8_BAR; PG8_WAIT_L(0); PG8_MMA(0, 1, At, B1); PG8_BAR;
            PG8_LDA(At, 0, 1); PG8_STAGE(PG8_SA(0, 0), a2, voffA);
            PG8_BAR; PG8_WAIT_L(0); PG8_MMA(1, 0, At, B0); PG8_BAR; PG8_SCHED;
            PG8_STAGE(PG8_SB(0, 1), b2 + hstep, voffB);
            PG8_WAIT_V(6); PG8_BAR; PG8_MMA(1, 1, At, B1); PG8_BAR;
            PG8_LDB(B0, 1, 0); PG8_SCHED; PG8_LDA(At, 1, 0); PG8_STAGE(PG8_SA(0, 1), a2 + hstep, voffA);
            PG8_WAIT_L(8); PG8_BAR; PG8_WAIT_L(0); PG8_MMA(0, 0, At, B0); PG8_BAR; PG8_SCHED;
            PG8_LDB(B1, 1, 1); PG8_STAGE(PG8_SB(1, 0), b3, voffB);
            PG8_BAR; PG8_WAIT_L(0); PG8_MMA(0, 1, At, B1); PG8_BAR;
            PG8_LDA(At, 1, 1); PG8_STAGE(PG8_SA(1, 0), a3, voffA);
            PG8_BAR; PG8_WAIT_L(0); PG8_MMA(1, 0, At, B0); PG8_BAR; PG8_SCHED;
            PG8_STAGE(PG8_SB(1, 1), b3 + hstep, voffB);
            PG8_WAIT_V(6); PG8_BAR; PG8_MMA(1, 1, At, B1); PG8_BAR;
            }
        }
        if constexpr (ALIGN_EPI) { if (wr == 0) PG8_BAR; }
        if constexpr (!Epi::AFTER_DRAIN) { E(acc, cur, wr, wc, fr, fq); S.done(cur); }
        if (!has_next) break;
#pragma unroll
        for (int a = 0; a < 2; ++a)
#pragma unroll
            for (int b = 0; b < 2; ++b)
#pragma unroll
                for (int m = 0; m < 4; ++m)
#pragma unroll
                    for (int n = 0; n < 2; ++n) acc[a][b][m][n] = (f32x4){0.f, 0.f, 0.f, 0.f};
        cur = nxt; cA = nA; cB = nB; ++ui;
        if constexpr (ALIGN_EPI) { if (wr == 1) PG8_BAR; }
    }
    PG8_WAIT_V(0);
    if constexpr (!ALIGN_EPI) { if (wr == 0) PG8_BAR; }
    PG8_BAR;
    if constexpr (Epi::AFTER_DRAIN) { E.fused(acc, cur, wr, wc, fr, fq, lds, wid, lane); S.done(cur); }
#undef PG8_SA
#undef PG8_SB
#undef PG8_STAGE
#undef PG8_LDA
#undef PG8_LDB
#undef PG8_MMA
#undef PG8_WAIT_V
#undef PG8_WAIT_L
#undef PG8_BAR
#undef PG8_SCHED
}
}

DEVI pg8::u32x4 pack8(const pg8::f32x4& a, const pg8::f32x4& b) { pg8::u32x4 w; w.x = pg8::cvt_pk_bf16(a[0], a[1]); w.y = pg8::cvt_pk_bf16(a[2], a[3]); w.z = pg8::cvt_pk_bf16(b[0], b[1]); w.w = pg8::cvt_pk_bf16(b[2], b[3]); return w; }
DEVI pg8::f32x4 silu4(const pg8::f32x4& a) { pg8::f32x4 r; r[0] = siluf_(a[0]); r[1] = siluf_(a[1]); r[2] = siluf_(a[2]); r[3] = siluf_(a[3]); return r; }
struct FEpi1 {
    static constexpr bool PERM = true, AFTER_DRAIN = false;
    bf16_t *QK, *V, *SGA, *Z, *CBG; float* ALR; bf16_t* ZA;
    DEVI void operator()(const pg8::f32x4 (&acc)[2][2][4][2], const pg8::Unit& u, int wr, int wc, int fr, int fq) const {
        const int t = u.pn, row0 = u.pm * 256 + wr * 64 + fr, cw = wc * 32 + 8 * fq;
#pragma unroll
        for (int ai = 0; ai < 2; ++ai)
#pragma unroll
            for (int m = 0; m < 4; ++m) {
                const size_t row = (size_t)(row0 + ai * 128 + m * 16);
                if (t < 12) {
                    bf16_t* base = t < 4 ? QK + row * 1024 + t * 256 : (t < 8 ? V + row * 1024 + (t - 4) * 256 : SGA + row * 1024 + (t - 8) * 256);
#pragma unroll
                    for (int bj = 0; bj < 2; ++bj) { pg8::f32x4 v0 = acc[ai][bj][m][0], v1 = acc[ai][bj][m][1]; if (t >= 8) { v0 = silu4(v0); v1 = silu4(v1); }
                        *(pg8::u32x4*)(base + bj * 128 + cw) = pack8(v0, v1); }
                } else if (t == 12) {
                    if (wc == 0) { *(pg8::f32x4*)(ALR + row * 32 + 8 * fq) = acc[ai][0][m][0]; *(pg8::f32x4*)(ALR + row * 32 + 8 * fq + 4) = acc[ai][0][m][1]; }
                } else if (t < 21) {
                    bf16_t* zp = t < 15 ? ZA + row * 256 + (t - 13) * 128 + cw : Z + row * 1024 + (t - 13) * 128 + cw;
                    *(pg8::u32x4*)zp = pack8(acc[ai][0][m][0] * acc[ai][1][m][0], acc[ai][0][m][1] * acc[ai][1][m][1]);
                } else {
                    *(pg8::u32x4*)(CBG + row * 1024 + (t - 21) * 128 + cw) = pack8(acc[ai][0][m][0] * silu4(acc[ai][1][m][0]), acc[ai][0][m][1] * silu4(acc[ai][1][m][1]));
                }
            }
    }
};
template <bool HAS_TAIL> struct FEpiRes {
    static constexpr bool PERM = false, AFTER_DRAIN = false;
    const float* xl; const float* xc; float* outl; float* outc; const float* MODl;
    DEVI void operator()(const pg8::f32x4 (&acc)[2][2][4][2], const pg8::Unit& u, int wr, int wc, int fr, int fq) const {
        const int row0 = u.pm * 256 + wr * 64 + fr, col0 = u.pn * 256 + wc * 32 + 4 * fq;
        const bool lat = u.pm < NLAT / 256;
        const float* gate = MODl + (size_t)(lat ? (u.pm >> 4) : 4) * 3072 + 2048 + col0;
        pg8::f32x4 gv[2][2];
#pragma unroll
        for (int bj = 0; bj < 2; ++bj)
#pragma unroll
            for (int n = 0; n < 2; ++n) gv[bj][n] = *(const pg8::f32x4*)(gate + bj * 128 + n * 16);
        if (HAS_TAIL && !lat) {
            float* o = outc + (size_t)(u.k0 >> 8) * NCTX * 1024 - (size_t)NLAT * 1024;
#pragma unroll
            for (int ai = 0; ai < 2; ++ai)
#pragma unroll
                for (int m = 0; m < 4; ++m) { const size_t off = (size_t)(row0 + ai * 128 + m * 16) * 1024 + col0;
#pragma unroll
                    for (int bj = 0; bj < 2; ++bj)
#pragma unroll
                        for (int n = 0; n < 2; ++n) *(pg8::f32x4*)(o + off + bj * 128 + n * 16) = acc[ai][bj][m][n]; }
            return;
        }
        const float* xin = xl; float* o = outl;
#pragma unroll
        for (int ai = 0; ai < 2; ++ai)
#pragma unroll
            for (int m = 0; m < 4; ++m) { const size_t off = (size_t)(row0 + ai * 128 + m * 16) * 1024 + col0;
#pragma unroll
                for (int bj = 0; bj < 2; ++bj)
#pragma unroll
                    for (int n = 0; n < 2; ++n) { const pg8::f32x4 xv = *(const pg8::f32x4*)(xin + off + bj * 128 + n * 16); *(pg8::f32x4*)(o + off + bj * 128 + n * 16) = xv + gv[bj][n] * acc[ai][bj][m][n]; } }
    }
};
struct FEpi3 {
    static constexpr bool PERM = true, AFTER_DRAIN = false;
    bf16_t* XR; bf16_t* SG; float* XRC;
    DEVI void operator()(const pg8::f32x4 (&acc)[2][2][4][2], const pg8::Unit& u, int wr, int wc, int fr, int fq) const {
        const int t = u.pn, row0 = u.pm * 256 + wr * 64 + fr, cw = wc * 32 + 8 * fq;
        if (u.pm >= NLAT / 256) {
            float* sl = XRC + (size_t)(u.k0 >> 9) * NCTX * 2048;
#pragma unroll
            for (int ai = 0; ai < 2; ++ai)
#pragma unroll
                for (int m = 0; m < 4; ++m) { float* rp = sl + (size_t)(row0 - NLAT + ai * 128 + m * 16) * 2048 + t * 256 + cw;
#pragma unroll
                    for (int bj = 0; bj < 2; ++bj) { *(pg8::f32x4*)(rp + bj * 128) = acc[ai][bj][m][0]; *(pg8::f32x4*)(rp + bj * 128 + 4) = acc[ai][bj][m][1]; } }
            return;
        }
        bf16_t* base = t < 8 ? XR + (size_t)xr_pad_of_tile(u.pm) * 2048 + t * 256 : SG + (t - 8) * 256;
#pragma unroll
        for (int ai = 0; ai < 2; ++ai)
#pragma unroll
            for (int m = 0; m < 4; ++m) { bf16_t* rp = base + (size_t)(row0 + ai * 128 + m * 16) * 2048 + cw;
#pragma unroll
                for (int bj = 0; bj < 2; ++bj) { pg8::f32x4 v0 = acc[ai][bj][m][0], v1 = acc[ai][bj][m][1]; if (t >= 8) { v0 = silu4(v0); v1 = silu4(v1); }
                    *(pg8::u32x4*)(rp + bj * 128) = pack8(v0, v1); } }
    }
};
#ifndef FAST_GEMM
#define FAST_GEMM 1
#endif


#define LASP __attribute__((address_space(3)))
__device__ void st_glawalk(const Params& p, int vb, int nvb, unsigned char* lds_, const bf16_t* QIN, const bf16_t* KET, const bf16_t* SC, const float* DEC, const bf16_t* VT, bf16_t* OF, bf16_t* OB) {
    typedef pg8::bf16x8 bx8; typedef pg8::f32x4 f4; typedef unsigned u32x2 __attribute__((ext_vector_type(2))); typedef pg8::u32x4 u4;
    LASP unsigned char* lds = (LASP unsigned char*)lds_;
    constexpr int QOFF = 0, KOFF = 17408, SOFF = KOFF + 18432, VOFF = SOFF + 9216, DOFF = VOFF + 4608, BUFSZ = 50176;
    const int tid = threadIdx.x, wid = __builtin_amdgcn_readfirstlane(tid >> 6), lane = tid & 63, c = lane & 15, g = lane >> 4;
    for (int it0 = vb; it0 < 256; it0 += nvb) {
        const int item = (nvb == 256) ? ((it0 & 7) * 32 + (it0 >> 3)) : it0;
        const int vs = item & 7, combo = item >> 3, d = combo & 1, h = (combo >> 1) & 3, bb = combo >> 3;
        LDS_BARRIER();
        if (wid >= 2) {
            const int lt = tid - 128;
            unsigned long long cst[8]; unsigned mult[8]; int doff[8];
#pragma unroll
            for (int j = 0; j < 8; ++j) { const int pp = lt + 384 * j;
                if (pp < 1024) { cst[j] = (unsigned long long)QIN + (pp >> 4) * 256 + (pp & 15) * 16; mult[j] = 16384u; doff[j] = QOFF + (pp >> 4) * 272 + (pp & 15) * 16; }
                else if (pp < 2048) { const int q = pp - 1024; cst[j] = (unsigned long long)KET + (q >> 3) * 128 + (q & 7) * 16; mult[j] = 16384u; doff[j] = KOFF + (q >> 3) * 144 + (q & 7) * 16; }
                else if (pp < 2560) { const int q = pp - 2048; cst[j] = (unsigned long long)SC + (q >> 3) * 128 + (q & 7) * 16; mult[j] = 8192u; doff[j] = SOFF + (q >> 3) * 144 + (q & 7) * 16; }
                else if (pp < 2816) { const int q = pp - 2560; cst[j] = (unsigned long long)VT + (vs * 32 + (q >> 3)) * 128 + (q & 7) * 16 - (unsigned long long)d * 16384; mult[j] = 16384u; doff[j] = VOFF + (q >> 3) * 144 + (q & 7) * 16; }
                else if (pp < 2848) { const int q = pp - 2816; cst[j] = (unsigned long long)DEC + q * 16; mult[j] = 512u; doff[j] = DOFF + q * 16; }
                else { cst[j] = (unsigned long long)DEC; mult[j] = 0u; doff[j] = -1; } }
            u4 r0[8], r1[8];
#define GW_LOAD(R, step) do { const int cc_ = d == 0 ? ((step) < 4 ? 64 + (step) : (step) - 4) : 67 - (step); const unsigned u_ = (unsigned)(((bb * NCH + cc_) * 4 + h) * 2 + d); \
                _Pragma("unroll") for (int j_ = 0; j_ < 8; ++j_) R[j_] = *(const u4*)(cst[j_] + (unsigned long long)u_ * mult[j_]); } while (0)
#define GW_WRITE(R, bufi) do { LASP unsigned char* b_ = lds + (bufi) * BUFSZ; _Pragma("unroll") for (int j_ = 0; j_ < 8; ++j_) if (doff[j_] >= 0) *(LASP u4*)(b_ + doff[j_]) = R[j_]; } while (0)
            GW_LOAD(r0, 0); GW_WRITE(r0, 0); GW_LOAD(r0, 1); GW_LOAD(r1, 2);
            LDS_BARRIER();
            for (int step = 0; step < NCH; step += 2) {
                GW_WRITE(r0, 1); if (step + 3 < NCH) GW_LOAD(r0, step + 3);
                LDS_BARRIER();
                if (step + 2 < NCH) { GW_WRITE(r1, 0); if (step + 4 < NCH) GW_LOAD(r1, step + 4); }
                LDS_BARRIER();
            }
#undef GW_LOAD
#undef GW_WRITE
        } else {
            f4 S[8];
#pragma unroll
            for (int m = 0; m < 8; ++m) S[m] = (f4){0.f, 0.f, 0.f, 0.f};
            bf16_t* O = d == 0 ? OF : OB;
            LDS_BARRIER();
            for (int step = 0; step < NCH; ++step) {
                const LASP unsigned char* B = lds + (step & 1) * BUFSZ;
#define SB0() __builtin_amdgcn_sched_barrier(0)
#define RDQ(dst_lo, dst_hi, ks) do { _Pragma("unroll") for (int mt = 0; mt < 4; ++mt) { const LASP unsigned char* qa = B + QOFF + (16 * mt + c) * 272 + (32 * (ks) + 4 * g) * 2; dst_lo[mt] = *(const LASP u32x2*)qa; dst_hi[mt] = *(const LASP u32x2*)(qa + 32); } } while (0)
#define MMQ(lo, hi, ks) do { _Pragma("unroll") for (int mt = 0; mt < 4; ++mt) { u4 w; w.x = lo[mt].x; w.y = lo[mt].y; w.z = hi[mt].x; w.w = hi[mt].y; o[mt] = __builtin_amdgcn_mfma_f32_16x16x32_bf16(sB[ks], __builtin_bit_cast(bx8, w), o[mt], 0, 0, 0); } } while (0)
#define RDK(kf, dv, m0) do { _Pragma("unroll") for (int mm = 0; mm < 4; ++mm) { const LASP unsigned char* ka = B + KOFF + (16 * ((m0) + mm) + c) * 144 + g * 16; kf[mm][0] = *(const LASP bx8*)ka; kf[mm][1] = *(const LASP bx8*)(ka + 64); dv[mm] = *(const LASP f4*)(B + DOFF + (16 * ((m0) + mm) + 4 * g) * 4); } } while (0)
#define MMK(kf, dv, m0) do { _Pragma("unroll") for (int mm = 0; mm < 4; ++mm) { S[(m0) + mm] = S[(m0) + mm] * dv[mm]; S[(m0) + mm] = __builtin_amdgcn_mfma_f32_16x16x32_bf16(kf[mm][0], bv0, S[(m0) + mm], 0, 0, 0); S[(m0) + mm] = __builtin_amdgcn_mfma_f32_16x16x32_bf16(kf[mm][1], bv1, S[(m0) + mm], 0, 0, 0); } } while (0)
                const bx8 bv0 = *(const LASP bx8*)(B + VOFF + (16 * wid + c) * 144 + g * 16), bv1 = *(const LASP bx8*)(B + VOFF + (16 * wid + c) * 144 + 64 + g * 16);
                u32x2 qa_lo[4], qa_hi[4], qb_lo[4], qb_hi[4];
                RDQ(qa_lo, qa_hi, 0); RDQ(qb_lo, qb_hi, 1);
                bx8 sB[4];
#pragma unroll
                for (int ks = 0; ks < 4; ++ks) { u4 w; w.x = pg8::cvt_pk_bf16(S[2 * ks][0], S[2 * ks][1]); w.y = pg8::cvt_pk_bf16(S[2 * ks][2], S[2 * ks][3]);
                    w.z = pg8::cvt_pk_bf16(S[2 * ks + 1][0], S[2 * ks + 1][1]); w.w = pg8::cvt_pk_bf16(S[2 * ks + 1][2], S[2 * ks + 1][3]); sB[ks] = __builtin_bit_cast(bx8, w); }
                f4 o[4];
#pragma unroll
                for (int mt = 0; mt < 4; ++mt) o[mt] = (f4){0.f, 0.f, 0.f, 0.f};
                SB0();
                MMQ(qa_lo, qa_hi, 0); SB0();
                RDQ(qa_lo, qa_hi, 2); SB0();
                MMQ(qb_lo, qb_hi, 1); SB0();
                RDQ(qb_lo, qb_hi, 3); SB0();
                MMQ(qa_lo, qa_hi, 2); SB0();
                bx8 sf[4][2];
#pragma unroll
                for (int mt = 0; mt < 4; ++mt) { const LASP unsigned char* sa = B + SOFF + (16 * mt + c) * 144 + g * 16; sf[mt][0] = *(const LASP bx8*)sa; sf[mt][1] = *(const LASP bx8*)(sa + 64); }
                SB0();
                MMQ(qb_lo, qb_hi, 3); SB0();
                bx8 kfa[4][2], kfb[4][2]; f4 dva[4], dvb[4];
                RDK(kfa, dva, 0); SB0();
#pragma unroll
                for (int mt = 0; mt < 4; ++mt) { o[mt] = __builtin_amdgcn_mfma_f32_16x16x32_bf16(bv0, sf[mt][0], o[mt], 0, 0, 0); o[mt] = __builtin_amdgcn_mfma_f32_16x16x32_bf16(bv1, sf[mt][1], o[mt], 0, 0, 0); }
                SB0();
                RDK(kfb, dvb, 4); SB0();
                MMK(kfa, dva, 0); SB0();
                MMK(kfb, dvb, 4); SB0();
#undef SB0
#undef RDQ
#undef MMQ
#undef RDK
#undef MMK
                const int cc = d == 0 ? (step < 4 ? 64 + step : step - 4) : 67 - step; const int row0 = row_of(bb, cc, 0);
#pragma unroll
                for (int mt = 0; mt < 4; ++mt) { u32x2 w; w.x = pg8::cvt_pk_bf16(o[mt][0], o[mt][1]); w.y = pg8::cvt_pk_bf16(o[mt][2], o[mt][3]);
                    *(u32x2*)(O + (size_t)(row0 + 16 * mt + c) * 1024 + h * 256 + vs * 32 + 16 * wid + 4 * g) = w; }
                LDS_BARRIER();
            }
        }
    }
}
#ifndef FAST_WALK
#define FAST_WALK 1
#endif

template <int MODE, int DIR>
__device__ __forceinline__ void st_rglru_impl(const Params& p, int vb, int nvb, unsigned char* lds_, const bf16_t* XR, const bf16_t* SG, const bf16_t* BD, float* SUMA, float* SUMH, bf16_t* Y) {
    typedef pg8::bf16x8 bx8; typedef pg8::f32x4 f4; typedef float f32x2v __attribute__((ext_vector_type(2)));
    LASP unsigned char* lds = (LASP unsigned char*)lds_;
    constexpr int AOFF = 0, FOFF = 17408, BUF = 51200, CWOFF = 2 * BUF;
    constexpr int ND = MODE == 0 ? 1 : 2, NCOMBO = MODE == 0 ? 32 : 16, NTILE = MODE == 0 ? NB * NCH : NB * 64;
    const int tid = threadIdx.x, wid = __builtin_amdgcn_readfirstlane(tid >> 6), lane = tid & 63, c = lane & 15, g = lane >> 4, cp = tid & 63, tg = tid >> 6;
    int P, part, cstep, combo0;
    if (nvb >= NCOMBO) { P = nvb / NCOMBO; part = vb / NCOMBO; cstep = NCOMBO; combo0 = vb % NCOMBO; if (part >= P) return; } else { P = 1; part = 0; cstep = nvb; combo0 = vb; }
    for (int combo = combo0; combo < NCOMBO; combo += cstep) {
        if (MODE == 0 && (combo & 1) != DIR) continue;
        const int nb = MODE == 0 ? (combo >> 1) : combo; constexpr int d0 = MODE == 0 ? DIR : 0;
        const int ch = nb * 128 + 16 * wid + c;
        bx8 wa[ND][4], wx[ND][4]; float ba[ND], bxx[ND], k8[ND];
        LDS_BARRIER();
#pragma unroll
        for (int dd = 0; dd < ND; ++dd) { constexpr int dzero = d0; const int d = dzero + dd;
            const bf16_t* wA = BD + ((size_t)(d * 16 + nb) * 128 + 16 * wid + c) * 128 + 8 * g; const bf16_t* wX = wA + (size_t)2 * 16 * 128 * 128;
#pragma unroll
            for (int ks = 0; ks < 4; ++ks) { wa[dd][ks] = *(const bx8*)(wA + 32 * ks); wx[dd][ks] = *(const bx8*)(wX + 32 * ks); }
            ba[dd] = p.o_b_a[d * 2048 + ch]; bxx[dd] = p.o_b_x[d * 2048 + ch]; k8[dd] = 8.f * 1.4426950408889634f * softplusf_(-p.o_lam[d * 2048 + ch]);
            if (tg < 5) { const f32x2v w2 = tg < 4 ? *(const f32x2v*)(p.o_conv_w + ((size_t)d * 4 + tg) * 2048 + nb * 128 + 2 * cp) : *(const f32x2v*)(p.o_conv_b + (size_t)d * 2048 + nb * 128 + 2 * cp);
                *(LASP f32x2v*)(lds + CWOFF + ((dd * 5 + tg) * 128 + 2 * cp) * 4) = w2; } }
        LDS_BARRIER();
        unsigned xr[14]; float cnext[2] = {0.f, 0.f};
#pragma unroll
        for (int jr = 0; jr < 14; ++jr) xr[jr] = 0u;
#define RG_PREF(tile) do { const int bb_ = MODE == 0 ? (tile) / NCH : (tile) >> 6, cc_ = MODE == 0 ? (tile) % NCH : (tile) & 63; const int row0_ = row_of(bb_, cc_, 0); \
            const bf16_t* xp_ = XR + (size_t)(row0_ + xr_pad_of_tile(row0_ >> 8) + 8 * tg - 3) * 2048 + nb * 128 + 2 * cp; \
            _Pragma("unroll") for (int jr = 0; jr < 14; ++jr) { if (MODE == 1 || (d0 == 0 ? jr < 11 : jr >= 3)) xr[jr] = *(const unsigned*)(xp_ + (size_t)jr * 2048); } \
            if (MODE == 1) { cnext[0] = SUMH[(((size_t)bb_ * 2 + 0) * NCH + cc_) * 2048 + ch]; cnext[1] = SUMH[(((size_t)bb_ * 2 + 1) * NCH + cc_) * 2048 + ch]; } } while (0)
        int it = 0;
        if (part < NTILE) RG_PREF(part);
        for (int tile = part; tile < NTILE; tile += P) {
            const int bb = MODE == 0 ? tile / NCH : tile >> 6, cc = MODE == 0 ? tile % NCH : tile & 63; const int row0 = row_of(bb, cc, 0);
            unsigned xcur[14]; float ccur[2];
#pragma unroll
            for (int jr = 0; jr < 14; ++jr) xcur[jr] = xr[jr];
            ccur[0] = cnext[0]; ccur[1] = cnext[1];
            if (tile + P < NTILE) RG_PREF(tile + P);
            float hsum[4][4];
#pragma unroll
            for (int dd = 0; dd < ND; ++dd) { constexpr int dzero = d0; const int d = dzero + dd;
                LASP unsigned char* B = lds + (it & 1) * BUF; ++it;
                { f32x2v cv[8]; const f32x2v cbv = *(const LASP f32x2v*)(lds + CWOFF + ((dd * 5 + 4) * 128 + 2 * cp) * 4);
#pragma unroll
                  for (int i = 0; i < 8; ++i) cv[i] = cbv;
#pragma unroll
                  for (int jj = 0; jj < 4; ++jj) { const f32x2v cwv = *(const LASP f32x2v*)(lds + CWOFF + ((dd * 5 + jj) * 128 + 2 * cp) * 4);
#pragma unroll
                      for (int i = 0; i < 8; ++i) { const int jr = d == 0 ? i + jj : i + 6 - jj; cv[i].x += cwv.x * __uint_as_float(xcur[jr] << 16); cv[i].y += cwv.y * __uint_as_float(xcur[jr] & 0xffff0000u); } }
#pragma unroll
                  for (int i = 0; i < 8; ++i) { const int rho = 16 * (2 * (tg & 1) + (i >> 2)) + 4 * (tg >> 1) + (i & 3);
                      *(LASP unsigned*)(B + AOFF + rho * 272 + 4 * cp) = pg8::cvt_pk_bf16(cv[i].x, cv[i].y); *(LASP f32x2v*)(B + FOFF + rho * 528 + 8 * cp) = cv[i]; } }
                LDS_BARRIER();
                const int gl = d == 0 ? g : 3 - g;
                const int src1 = d == 0 ? lane - 16 : lane + 16, src2 = d == 0 ? lane - 32 : lane + 32, srcT = d == 0 ? 48 + c : c;
                const size_t sidx = (((size_t)bb * 2 + d) * NCH + cc) * 2048 + ch;
                float av[16], uv[16]; float pa = 1.f, lh = 0.f;
#pragma unroll
                for (int mtl = 0; mtl < 4; ++mtl) { const int mt = d == 0 ? mtl : 3 - mtl;
                    f4 aam = (f4){0.f, 0.f, 0.f, 0.f}, axm = (f4){0.f, 0.f, 0.f, 0.f};
#pragma unroll
                    for (int ks = 0; ks < 4; ++ks) { const bx8 af = *(const LASP bx8*)(B + AOFF + (16 * mt + c) * 272 + (32 * ks + 8 * g) * 2);
                        aam = __builtin_amdgcn_mfma_f32_16x16x32_bf16(af, wa[dd][ks], aam, 0, 0, 0); axm = __builtin_amdgcn_mfma_f32_16x16x32_bf16(af, wx[dd][ks], axm, 0, 0, 0); }
#pragma unroll
                    for (int sq = 0; sq < 4; ++sq) { const int r = d == 0 ? sq : 3 - sq;
                        const float xv = *(const LASP float*)(B + FOFF + (16 * mt + 4 * g + r) * 528 + (16 * wid + c) * 4);
                        const float rr = sigmoidf_(aam[r] + ba[dd]), ii = sigmoidf_(axm[r] + bxx[dd]);
                        const float a = fexp2_(-k8[dd] * rr), u = __builtin_amdgcn_sqrtf(fmaxf(1.f - a * a, 0.f)) * (ii * xv);
                        lh = a * lh + u; pa *= a; if (MODE == 1) { av[mt * 4 + r] = a; uv[mt * 4 + r] = u; } }
                }
                float XA = pa, XU = lh, tA, tU;
                tA = __shfl(XA, src1); tU = __shfl(XU, src1); if (gl >= 1) { XU = tU * XA + XU; XA = tA * XA; }
                tA = __shfl(XA, src2); tU = __shfl(XU, src2); if (gl >= 2) { XU = tU * XA + XU; XA = tA * XA; }
                if (MODE == 0) { if (gl == 3) { SUMA[sidx] = XA; SUMH[sidx] = XU; } }
                else {
                    float eA = __shfl(XA, src1), eU = __shfl(XU, src1); if (gl == 0) { eA = 1.f; eU = 0.f; }
                    float hh = ccur[dd] * eA + eU;
#pragma unroll
                    for (int mtl = 0; mtl < 4; ++mtl) { const int mt = d == 0 ? mtl : 3 - mtl;
#pragma unroll
                        for (int sq = 0; sq < 4; ++sq) { const int r = d == 0 ? sq : 3 - sq; hh = av[mt * 4 + r] * hh + uv[mt * 4 + r]; if (dd == 0) hsum[mt][r] = hh; else hsum[mt][r] += hh; } }
                }
            }
            if (MODE == 1) {
#pragma unroll
                for (int mt = 0; mt < 4; ++mt)
#pragma unroll
                    for (int r = 0; r < 4; ++r) { const size_t o = (size_t)(row0 + 16 * g + 4 * mt + r) * 2048 + ch; Y[o] = f2bf(hsum[mt][r] * bf2f(SG[o])); }
            }
        }
        LDS_BARRIER();
#undef RG_PREF
    }
}
template <int MODE>
__device__ __forceinline__ void st_rglru(const Params& p, int vb, int nvb, unsigned char* lds_, const bf16_t* XR, const bf16_t* SG, const bf16_t* BD, float* SUMA, float* SUMH, bf16_t* Y) {
    if (MODE == 1) { st_rglru_impl<1, 0>(p, vb, nvb, lds_, XR, SG, BD, SUMA, SUMH, Y); return; }
    const int combo0 = nvb >= 32 ? vb % 32 : vb;
    if (nvb >= 32) { if ((combo0 & 1) == 0) st_rglru_impl<0, 0>(p, vb, nvb, lds_, XR, SG, BD, SUMA, SUMH, Y); else st_rglru_impl<0, 1>(p, vb, nvb, lds_, XR, SG, BD, SUMA, SUMH, Y); }
    else { st_rglru_impl<0, 0>(p, vb, nvb, lds_, XR, SG, BD, SUMA, SUMH, Y); st_rglru_impl<0, 1>(p, vb, nvb, lds_, XR, SG, BD, SUMA, SUMH, Y); }
}
#ifndef FAST_RG
#define FAST_RG 1
#endif


template <int WD>
__device__ __forceinline__ void rg1p_body(const Params& p, LASP unsigned char* lds, const bf16_t* XR, bf16_t* SGY, bf16_t* HXh, const bf16_t* BD, int bb, int nb, int sl) {
    typedef pg8::bf16x8 bx8; typedef pg8::f32x4 f4; typedef float f32x2v __attribute__((ext_vector_type(2)));
    constexpr int A0 = 0, A1 = 17408, CWOFF = 34816, EXOFF = CWOFF + 5120;
    const int tid = threadIdx.x, wid = __builtin_amdgcn_readfirstlane(tid >> 6), lane = tid & 63, c = lane & 15, g = lane >> 4, cp = lane, tg = wid;
    const int nt = (wid >> 1) & 1, hf = wid & 1;
    const int jch = sl * 32 + nt * 16 + c, ch = nb * 128 + jch;
    bx8 wa[4], wx[4];
    { const bf16_t* wA = BD + ((size_t)(WD * 16 + nb) * 128 + jch) * 128 + 8 * g; const bf16_t* wX = wA + (size_t)2 * 16 * 128 * 128;
#pragma unroll
      for (int ks = 0; ks < 4; ++ks) { wa[ks] = *(const bx8*)(wA + 32 * ks); wx[ks] = *(const bx8*)(wX + 32 * ks); } }
    const float ba = p.o_b_a[WD * 2048 + ch], bxx = p.o_b_x[WD * 2048 + ch], k8 = 8.f * 1.4426950408889634f * softplusf_(-p.o_lam[WD * 2048 + ch]);
    LDS_BARRIER();
#pragma unroll
    for (int dd = 0; dd < 2; ++dd)
        if (tg < 5) { const f32x2v w2 = tg < 4 ? *(const f32x2v*)(p.o_conv_w + ((size_t)dd * 4 + tg) * 2048 + nb * 128 + 2 * cp) : *(const f32x2v*)(p.o_conv_b + (size_t)dd * 2048 + nb * 128 + 2 * cp);
            *(LASP f32x2v*)(lds + CWOFF + ((dd * 5 + tg) * 128 + 2 * cp) * 4) = w2; }
    LDS_BARRIER();
    unsigned xr[22];
#define RG_CH(dd, step) ((dd) == 0 ? ((step) < 4 ? 64 + (step) : (step) - 4) : 67 - (step))
#define RG_PREF(step) do { _Pragma("unroll") for (int dd = 0; dd < 2; ++dd) { const int row0_ = row_of(bb, RG_CH(dd, step), 0); \
            const unsigned char* ub_ = (const unsigned char*)(XR + (size_t)(row0_ + xr_pad_of_tile(row0_ >> 8) + 8 * tg - 3 + 3 * dd) * 2048 + nb * 128);     \
            _Pragma("unroll") for (int j = 0; j < 11; ++j) xr[dd * 11 + j] = *(const unsigned*)(ub_ + (size_t)j * 4096 + (unsigned)(4 * cp)); } } while (0)
#ifndef REP_RG
#define REP_RG 0
#endif
  for (int rep_ = 0; rep_ <= REP_RG; ++rep_) {
    const bool dry = rep_ < REP_RG;
    RG_PREF(0);
    float carry = 0.f;
    const int gl = WD == 0 ? g : 3 - g;
    const int src1 = WD == 0 ? lane - 16 : lane + 16, src2 = WD == 0 ? lane - 32 : lane + 32, srcT = WD == 0 ? 48 + c : c;
    const bool amfirst = (hf == WD);
    for (int step = 0; step < NCH; ++step) {
        asm volatile("s_waitcnt vmcnt(0)" ::: "memory");
#pragma unroll
        for (int dd = 0; dd < 2; ++dd) {
            f32x2v cv[8], cw4[4]; const f32x2v cbv = *(const LASP f32x2v*)(lds + CWOFF + ((dd * 5 + 4) * 128 + 2 * cp) * 4);
#pragma unroll
            for (int jj = 0; jj < 4; ++jj) cw4[jj] = *(const LASP f32x2v*)(lds + CWOFF + ((dd * 5 + jj) * 128 + 2 * cp) * 4);
#pragma unroll
            for (int i = 0; i < 8; ++i) cv[i] = cbv;
#pragma unroll
            for (int jx = 0; jx < 11; ++jx) { const unsigned xw = xr[dd * 11 + jx]; const f32x2v xv2 = (f32x2v){__uint_as_float(xw << 16), __uint_as_float(xw & 0xffff0000u)};
#pragma unroll
                for (int jj = 0; jj < 4; ++jj) { const int i = dd == 0 ? jx - jj : jx - 3 + jj; if (i >= 0 && i < 8) cv[i] = __builtin_elementwise_fma(cw4[jj], xv2, cv[i]); } }
#pragma unroll
            for (int i = 0; i < 8; ++i) { const int rho = 32 * (tg >> 2) + 16 * (i >> 2) + 4 * (tg & 3) + (i & 3);
                *(LASP unsigned*)(lds + (dd == 0 ? A0 : A1) + rho * 272 + 4 * cp) = pg8::cvt_pk_bf16(cv[i].x, cv[i].y); }
        }
        LDS_BARRIER();
        if (step + 1 < NCH) RG_PREF(step + 1);
        const int cc = RG_CH(WD, step); const bool latent = cc < 64 && !dry, second = step - 4 > 31;
        const size_t orow = (size_t)row_of(bb, cc, 0) + 32 * hf + 8 * g;
        unsigned short hxv[8], sgv[8];
        if (latent && second) {
#pragma unroll
            for (int e = 0; e < 8; ++e) { hxv[e] = HXh[(orow + e) * 1024 + (ch & 1023)]; sgv[e] = SGY[(orow + e) * 2048 + ch]; } }
        const LASP unsigned char* A = lds + (WD == 0 ? A0 : A1);
        float av[8], uv[8]; float pa = 1.f, lh = 0.f;
#pragma unroll
        for (int ml = 0; ml < 2; ++ml) { const int mt = WD == 0 ? ml : 1 - ml;
            f4 aam = (f4){0.f, 0.f, 0.f, 0.f}, axm = (f4){0.f, 0.f, 0.f, 0.f};
#pragma unroll
            for (int ks = 0; ks < 4; ++ks) { const bx8 af = *(const LASP bx8*)(A + (32 * hf + 16 * mt + c) * 272 + (32 * ks + 8 * g) * 2);
                aam = __builtin_amdgcn_mfma_f32_16x16x32_bf16(af, wa[ks], aam, 0, 0, 0); axm = __builtin_amdgcn_mfma_f32_16x16x32_bf16(af, wx[ks], axm, 0, 0, 0); }
#pragma unroll
            for (int sq = 0; sq < 4; ++sq) { const int r = WD == 0 ? sq : 3 - sq;
                const float xv = bf2f(*(const LASP unsigned short*)(A + (32 * hf + 16 * mt + 4 * g + r) * 272 + jch * 2));
                const float rr = sigmoidf_(aam[r] + ba), ii = sigmoidf_(axm[r] + bxx);
                const float a = fexp2_(-k8 * rr), u = __builtin_amdgcn_sqrtf(fmaxf(1.f - a * a, 0.f)) * (ii * xv);
                lh = a * lh + u; pa *= a; av[mt * 4 + r] = a; uv[mt * 4 + r] = u; }
        }
        float XA = pa, XU = lh, tA, tU;
        tA = __shfl(XA, src1); tU = __shfl(XU, src1); if (gl >= 1) { XU = tU * XA + XU; XA = tA * XA; }
        tA = __shfl(XA, src2); tU = __shfl(XU, src2); if (gl >= 2) { XU = tU * XA + XU; XA = tA * XA; }
        float eA = __shfl(XA, src1), eU = __shfl(XU, src1); if (gl == 0) { eA = 1.f; eU = 0.f; }
        const float myA = __shfl(XA, srcT), myU = __shfl(XU, srcT);
        if (gl == 3) *(LASP f32x2v*)(lds + EXOFF + (((WD * 2 + nt) * 2 + hf) * 16 + c) * 8) = (f32x2v){XA, XU};
        LDS_BARRIER();
        const f32x2v oth = *(const LASP f32x2v*)(lds + EXOFF + (((WD * 2 + nt) * 2 + (1 - hf)) * 16 + c) * 8);
        const float hin_half = amfirst ? carry : carry * oth.x + oth.y;
        carry = amfirst ? (carry * myA + myU) * oth.x + oth.y : (carry * oth.x + oth.y) * myA + myU;
        if (latent) {
            float hh = hin_half * eA + eU;
#pragma unroll
            for (int ml = 0; ml < 2; ++ml) { const int mt = WD == 0 ? ml : 1 - ml;
#pragma unroll
                for (int sq = 0; sq < 4; ++sq) { const int r = WD == 0 ? sq : 3 - sq; const int e = mt * 4 + r; hh = av[e] * hh + uv[e];
                    const bf16_t hb = f2bf(hh);
                    if (!second) HXh[(orow + e) * 1024 + (ch & 1023)] = hb;
                    else SGY[(orow + e) * 2048 + ch] = f2bf((bf2f(hb) + bf2f(hxv[e])) * bf2f(sgv[e])); } }
        }
    }
    asm volatile("" :: "v"(carry));
    LDS_BARRIER();
  }
#undef RG_PREF
#undef RG_CH
}
__device__ __forceinline__ void st_rg1p(const Params& p, int vb, int nvb, unsigned char* lds_, const bf16_t* XR, bf16_t* SGY, bf16_t* HX0, bf16_t* HX1, const bf16_t* BD, const float* XRC) {
    LASP unsigned char* lds = (LASP unsigned char*)lds_;
    const int wid = __builtin_amdgcn_readfirstlane(threadIdx.x >> 6);
    for (int it0 = vb; it0 < 256; it0 += nvb) {
        const int item = (nvb == 256) ? ((it0 & 7) * 32 + (it0 >> 3)) : it0;
        const int sl = item & 3, nb = (item >> 2) & 15, bb = item >> 6;
        bf16_t* HXh = nb < 8 ? HX0 : HX1;
        {
          bf16_t* xd = (bf16_t*)XR + (size_t)(NLAT + bb * 256 + 20 + 4 * bb) * 2048 + nb * 128; const float* xs = XRC + (size_t)(bb * 256) * 2048 + nb * 128;
          for (int e = threadIdx.x; e < 256 * 64; e += NTHREADS) { const int r = e >> 6, cpair = e & 63; const float2 v0 = *(const float2*)(xs + (size_t)r * 2048 + 2 * cpair), v1 = *(const float2*)(xs + (size_t)NCTX * 2048 + (size_t)r * 2048 + 2 * cpair); *(unsigned*)(xd + (size_t)r * 2048 + 2 * cpair) = pg8::cvt_pk_bf16(v0.x + v1.x, v0.y + v1.y); }
          asm volatile("s_waitcnt vmcnt(0)" ::: "memory"); LDS_BARRIER(); }
        if (wid < 4) rg1p_body<0>(p, lds, XR, SGY, HXh, BD, bb, nb, sl); else rg1p_body<1>(p, lds, XR, SGY, HXh, BD, bb, nb, sl);
    }
}
#define XB_TMO      128
#define XB_XCNT(j)  (256  + 64 * (j))
#define XB_XSUB(j)  (1280 + 64 * (j))
#define XB_XGEN(j)  (2304 + 64 * (j))
#define XB_TOP      3328
#define XB_TOPGEN   3392
#define XB_SPIN_CAP (1u << 20)
DEVI unsigned xb_ld(unsigned* p)              { return __hip_atomic_load(p, __ATOMIC_RELAXED, __HIP_MEMORY_SCOPE_AGENT); }
DEVI unsigned xb_add(unsigned* p, unsigned v) { return __hip_atomic_fetch_add(p, v, __ATOMIC_RELAXED, __HIP_MEMORY_SCOPE_AGENT); }
DEVI unsigned xb_xcc_id() { return (unsigned)__builtin_amdgcn_s_getreg((3 << 11) | 20) & 0xFu; }
#define XB_SPIN(cond, bar) do { unsigned _sp = 0; while (cond) { __builtin_amdgcn_s_sleep(1); \
    if ((++_sp & 255u) == 0u) { if (xb_ld(&(bar)[XB_TMO])) break; if (_sp > XB_SPIN_CAP) { atomicAdd(&(bar)[XB_TMO], 1u); break; } } } } while (0)
struct XcdBarrier { unsigned* bar; unsigned x; volatile __attribute__((address_space(3))) unsigned* st; };
DEVI XcdBarrier xcd_barrier_post(unsigned* bar, volatile __attribute__((address_space(3))) unsigned* st) {
    XcdBarrier b; b.bar = bar; b.x = xb_xcc_id(); b.st = st;
    if (threadIdx.x == 0) (void)xb_add(&bar[XB_XCNT(b.x)], 1u);
    return b;
}
DEVI void xcd_barrier_complete(unsigned* bar, unsigned x, unsigned& nloc, unsigned& nx) {
    const unsigned G = gridDim.x * gridDim.y * gridDim.z;
    unsigned sum, cnt, mine, sp = 0u;
    for (;;) {
        sum = 0u; cnt = 0u; mine = 0u;
#pragma unroll
        for (unsigned j = 0; j < 16; ++j) { const unsigned c = xb_ld(&bar[XB_XCNT(j)]); sum += c; cnt += (c > 0u) ? 1u : 0u; mine = (j == x) ? c : mine; }
        if (sum == G) break;
        __builtin_amdgcn_s_sleep(1);
        if ((++sp & 255u) == 0u) { if (xb_ld(&bar[XB_TMO])) break; if (sp > XB_SPIN_CAP) { atomicAdd(&bar[XB_TMO], 1u); break; } }
    }
    nloc = mine > 0u ? mine : 1u; nx = cnt > 0u ? cnt : 1u;
}
DEVI void xcd_barrier(const XcdBarrier& b) {
    asm volatile("s_waitcnt vmcnt(0)" ::: "memory");
    __syncthreads();
    if (threadIdx.x == 0) {
        unsigned* bar = b.bar;
        __builtin_amdgcn_s_waitcnt(0);
        unsigned nloc = b.st[0], nx = b.st[1];
        if (nloc == 0u) { xcd_barrier_complete(bar, b.x, nloc, nx); b.st[0] = nloc; b.st[1] = nx; }
        const unsigned old = xb_add(&bar[XB_XSUB(b.x)], 1u);
        const unsigned gen = old / nloc;
        if (old + 1u == (gen + 1u) * nloc) {
            __builtin_amdgcn_fence(__ATOMIC_RELEASE, "agent");
            asm volatile("s_waitcnt vmcnt(0)" ::: "memory");
            const unsigned og = xb_add(&bar[XB_TOP], 1u);
            const unsigned tg = og / nx;
            if (og + 1u == (tg + 1u) * nx) xb_add(&bar[XB_TOPGEN], 1u);
            else XB_SPIN(xb_ld(&bar[XB_TOPGEN]) == tg, bar);
            __builtin_amdgcn_fence(__ATOMIC_ACQUIRE, "agent");
            xb_add(&bar[XB_XGEN(b.x)], 1u);
            asm volatile("s_waitcnt vmcnt(0)" ::: "memory");
        } else {
            XB_SPIN(xb_ld(&bar[XB_XGEN(b.x)]) == gen, bar);
            __builtin_amdgcn_fence(__ATOMIC_ACQUIRE, "agent");
            asm volatile("s_waitcnt vmcnt(0)" ::: "memory");
        }
    }
    __syncthreads();
}
__device__ __forceinline__ void run_stage(const Params& p, int st, int vb, int nvb, unsigned char* lds) {
    unsigned char* ws = p.ws;
    float* MOD = (float*)(ws + WS_MOD); float* ALR = (float*)(ws + WS_ALR); float* X1C = (float*)(ws + WS_X1C);
    float* SUMA = (float*)(ws + WS_SUMA); float* SUMH = (float*)(ws + WS_SUMH); float* DEC = (float*)(ws + WS_DEC);
    bf16_t* Bt1 = (bf16_t*)(ws + WS_BT1); bf16_t* Bt2 = (bf16_t*)(ws + WS_BT2); bf16_t* Bt3 = (bf16_t*)(ws + WS_BT3); bf16_t* Bt4 = (bf16_t*)(ws + WS_BT4);
    bf16_t* S0 = (bf16_t*)(ws + WS_SLOT(0)); bf16_t* S1 = (bf16_t*)(ws + WS_SLOT(1)); bf16_t* S2 = (bf16_t*)(ws + WS_SLOT(2));
    bf16_t* S3 = (bf16_t*)(ws + WS_SLOT(3)); bf16_t* S4 = (bf16_t*)(ws + WS_SLOT(4)); bf16_t* S5 = (bf16_t*)(ws + WS_SLOT(5));
    bf16_t* DO0 = (bf16_t*)p.out; bf16_t* DOSC = (bf16_t*)((unsigned char*)p.out + 34 * MiB); bf16_t* DOZA = (bf16_t*)((unsigned char*)p.out + 51 * MiB);
    float* XRC = (float*)(ws + WS_BT1);
    float* SLAB2 = (float*)(ws + WS_SLOT(5) + 262144);
    switch (st) {
    case 0: st_mod(p, vb, nvb, (float*)lds); st_wprep(p, vb, nvb, lds); break;
    case 1: st_modulate(p, vb, nvb, 0, p.x, p.ctx, S0); break;
    case 3: st_glaprep(p, vb, nvb, lds, S1, S2, ALR, S3, S4, DOSC, DEC, S5); break;
#if FAST_WALK
    case 4: st_glawalk(p, vb, nvb, lds, S3, S4, DOSC, DEC, S5, S2, DO0); break;
#else
    case 4: st_glawalk_naive(p, vb, nvb, (float*)lds, S3, S4, DOSC, DEC, S5, S2, DO0); break;
#endif
    case 6: st_inner(p, vb, nvb, S2, DO0, S3, S4, S5, S0, DOZA, X1C); break;
    case 8: st_modulate(p, vb, nvb, 1, p.out, p.ctx, S2, SLAB2, 8, MOD + 4 * 3072 + 2048);
            {
              for (int e = vb * NTHREADS + threadIdx.x; e < 9 * 4 * 256; e += nvb * NTHREADS) { const int gi = e >> 10, w = e & 1023; const int r0 = gi < 4 ? 4096 * gi + 4 * gi : (gi < 8 ? NLAT + 16 + 256 * (gi - 4) + 4 * (gi - 4) : NT + 32);
                  *(uint4*)(S3 + (size_t)r0 * 2048 + w * 8) = uint4{0u, 0u, 0u, 0u}; } }
            break;
    case 10: st_rg1p(p, vb, nvb, lds, S3, S0, S2, S5 + 131072, (const bf16_t*)(ws + WS_BD), XRC); break;
    case 14: st_final(p, vb, nvb); break;
#if FAST_GEMM
    case 2: { FEpi1 E{S1, S2, S3, S4, S5, ALR, DOZA}; pg8::Gemm g{S0, Bt1, NT, N1, 1024}; pg8::TileOrder S; S.init(NT / 256, 11, 16, nvb, vb, 0, 8, 0, 12);
              pg8::gemm_phase<FEpi1, pg8::TileOrder, true, true>((PG8_LAS unsigned char*)lds, g, S, E); } break;
    case 5: { FEpi1 E{S1, S2, S3, S4, S5, ALR, DOZA}; pg8::Gemm g{S0, Bt1, NT, N1, 1024}; pg8::TileOrder S; S.init(NT / 256, 18, 16, nvb, vb, 0, 4, 8, 15);
              pg8::gemm_phase<FEpi1, pg8::TileOrder, true, true>((PG8_LAS unsigned char*)lds, g, S, E); } break;
    case 7: { FEpiRes<true> E{p.x, p.ctx, p.out, SLAB2, MOD}; pg8::Gemm g{S0, Bt2, NT, 1024, 2048}; pg8::TileOrder S; S.init(NLAT / 256, 4, 32, nvb, vb, 0, 1 << 30, 0, 0, NCTX / 256, 4, NLAT / 256, 8, 4);
              pg8::gemm_phase<FEpiRes<true>, pg8::TileOrder, true, true>((PG8_LAS unsigned char*)lds, g, S, E); } break;
    case 9: { FEpi3 E{S3, S0, XRC}; pg8::Gemm g{S2, Bt3, NT, 4096, 1024}; pg8::TileOrder S; S.init(NLAT / 256, 16, 16, nvb, vb, 0, 1 << 30, 0, 0, NCTX / 256, 8, NLAT / 256, 2, 8);
              pg8::gemm_phase<FEpi3, pg8::TileOrder, true, true>((PG8_LAS unsigned char*)lds, g, S, E); } break;
    case 13: { FEpiRes<false> E{p.out, nullptr, p.out, nullptr, MOD + 5 * 3072}; pg8::Gemm g{S0, Bt4, NLAT, 1024, 2048}; pg8::TileOrder S; S.init(NLAT / 256, 4, 32, nvb, vb);
              pg8::gemm_phase<FEpiRes<false>, pg8::TileOrder, true, true>((PG8_LAS unsigned char*)lds, g, S, E); } break;
#else
    case 2: { Epi1 E{S1, S2, S3, S4, S5, ALR}; st_gemm_naive(vb, nvb, (float*)lds, S0, Bt1, 0, NT / 32, 0, 8, 1024, E); st_gemm_naive(vb, nvb, (float*)lds, S0, Bt1, 0, NT / 32, 12, 13, 1024, E); } break;
    case 5: { Epi1 E{S1, S2, S3, S4, S5, ALR}; st_gemm_naive(vb, nvb, (float*)lds, S0, Bt1, 0, NT / 32, 8, 12, 1024, E); st_gemm_naive(vb, nvb, (float*)lds, S0, Bt1, 0, NT / 32, 13, 29, 1024, E); } break;
    case 7: { EpiRes E{p.x, p.ctx, p.out, X1C, MOD}; st_gemm_naive(vb, nvb, (float*)lds, S0, Bt2, 0, NT / 32, 0, 4, 2048, E); } break;
    case 9: { Epi3 E{S3, S0}; st_gemm_naive(vb, nvb, (float*)lds, S2, Bt3, 0, NLAT / 32, 0, 16, 1024, E); st_gemm_naive(vb, nvb, (float*)lds, S2, Bt3, NLAT / 32, NT / 32, 0, 8, 1024, E); } break;
    case 13: { EpiRes E{p.out, nullptr, p.out, nullptr, MOD + 5 * 3072}; st_gemm_naive(vb, nvb, (float*)lds, S0, Bt4, 0, NLAT / 32, 0, 4, 2048, E); } break;
#endif
    }
}
constexpr int NSTAGES = 15;
constexpr int LDS_BYTES = 147456;

#ifndef ONE_LAUNCH
#define ONE_LAUNCH 1
#endif
#if !ONE_LAUNCH
__global__ void __launch_bounds__(NTHREADS) k_mega(Params p, int st) {
    extern __shared__ __attribute__((aligned(16))) unsigned char lds[];
    run_stage(p, st, blockIdx.x, gridDim.x, lds);
}
#else
__global__ void __launch_bounds__(NTHREADS) k_mega(Params p) {
    extern __shared__ __attribute__((aligned(16))) unsigned char lds[];
    volatile __attribute__((address_space(3))) unsigned* st = (volatile __attribute__((address_space(3))) unsigned*)((__attribute__((address_space(3))) unsigned char*)lds + (LDS_BYTES - 64));
    if (threadIdx.x < 2) st[threadIdx.x] = 0u;
    __syncthreads();
    const XcdBarrier bar = xcd_barrier_post((unsigned*)(p.ws + WS_CTL) + 4096, st);
#ifndef REP_STAGE
#define REP_STAGE -1
#endif
#ifndef REP_N
#define REP_N 1
#endif
#define RS(k) do { run_stage(p, k, blockIdx.x, gridDim.x, lds); if ((k) == REP_STAGE) { for (int rep_ = 0; rep_ < REP_N; ++rep_) { xcd_barrier(bar); run_stage(p, k, blockIdx.x, gridDim.x, lds); } } } while (0)
#define GS() xcd_barrier(bar)
    RS(0); GS(); RS(1); GS(); RS(2); GS(); RS(3); GS(); RS(4); GS(); RS(5); GS(); RS(6); GS(); RS(7); GS();
    RS(8); GS(); RS(9); GS(); RS(10); GS(); RS(13); GS(); RS(14);
#undef RS
#undef GS
}
#endif

extern "C" void kernel_launch(void* const* d_in, const int* in_sizes, int n_in, void* d_out, int out_size, void* d_ws, size_t ws_size, hipStream_t stream) {
    static int inited = 0, grid_blocks = 0;
    if (!inited) {
        if (n_in != 23 || ws_size < WS_END || out_size != NLAT * D) { fprintf(stderr, "kernel_launch: unexpected shapes n_in %d ws %zu out %d\n", n_in, ws_size, out_size); inited = -1; return; }
        if (hipFuncSetAttribute((const void*)k_mega, hipFuncAttributeMaxDynamicSharedMemorySize, LDS_BYTES) != hipSuccess) { fprintf(stderr, "hipFuncSetAttribute failed\n"); inited = -1; return; }
        int dev = 0, cus = 0, per_cu = 0;
        (void)hipGetDevice(&dev); (void)hipDeviceGetAttribute(&cus, hipDeviceAttributeMultiprocessorCount, dev);
        (void)hipOccupancyMaxActiveBlocksPerMultiprocessor(&per_cu, (const void*)k_mega, NTHREADS, LDS_BYTES);
        if (per_cu < 1) { fprintf(stderr, "kernel_launch: occupancy query says %d blocks per CU\n", per_cu); per_cu = 1; }
        if (per_cu > 1) per_cu = 1;
        grid_blocks = cus * per_cu;
        inited = 1;
    }
    if (inited < 0) return;
    Params p{};
    const float** f = (const float**)&p;
    for (int i = 0; i < 23; ++i) f[i] = (const float*)d_in[i];
    p.out = (float*)d_out; p.ws = (unsigned char*)d_ws;
    (void)hipMemsetAsync((unsigned char*)d_ws + WS_CTL, 0, 2 * MiB, stream);
#if ONE_LAUNCH
    void* args[] = {&p};
    hipError_t e = hipLaunchCooperativeKernel((const void*)k_mega, dim3(grid_blocks), dim3(NTHREADS), args, LDS_BYTES, stream);
    if (e != hipSuccess) fprintf(stderr, "cooperative launch failed: %s (grid %d)\n", hipGetErrorString(e), grid_blocks);
#else
    for (int st = 0; st < NSTAGES; ++st) hipLaunchKernelGGL(k_mega, dim3(1024), dim3(NTHREADS), LDS_BYTES, stream, p, st);
#endif
}
```

```cpp
#include <hip/hip_runtime.h>
#include <hip/hip_cooperative_groups.h>
namespace cg = cooperative_groups;
#include <cstdio>
#include <cstdint>

typedef unsigned short bf16_t;
#define DEVI __device__ __forceinline__
#define LDS_BARRIER() do { asm volatile("s_waitcnt lgkmcnt(0)" ::: "memory"); __builtin_amdgcn_s_barrier(); asm volatile("" ::: "memory"); } while (0)

constexpr int D = 1024, NB = 4, SEQ = 4096, CTXL = 256;
constexpr int NLAT = NB * SEQ;
constexpr int NCTX = NB * CTXL;
constexpr int NT = NLAT + NCTX;
constexpr int NCH = 68;
constexpr int EVEN_IN = 7200;
constexpr int N1 = 7424;
constexpr int N1A = 13 * 256;
constexpr int RGW = 2048;
constexpr float EPS = 1e-6f;

constexpr size_t MiB = 1u << 20;
constexpr size_t WS_CTL = 0;
constexpr size_t WS_MOD = 1 * MiB;
constexpr size_t WS_ALR = 2 * MiB;
constexpr size_t WS_X1C = 5 * MiB;
constexpr size_t WS_SUMA = 9 * MiB;
constexpr size_t WS_SUMH = 9 * MiB + 4608 * 1024;
constexpr size_t WS_DEC = 18 * MiB;
constexpr size_t WS_BT1 = 19 * MiB + 512 * 1024;
constexpr size_t WS_BT2 = 34 * MiB;
constexpr size_t WS_BT3 = 38 * MiB;
constexpr size_t WS_BT4 = 46 * MiB;
constexpr size_t WS_BD = 50 * MiB;
constexpr size_t WS_S0 = 52 * MiB;
constexpr size_t SLOT = 34 * MiB;
constexpr size_t WS_END = WS_S0 + 6 * SLOT;
static_assert(WS_END == 256 * MiB, "ws map");
#define WS_SLOT(i) (WS_S0 + (size_t)(i) * SLOT)

struct Params {
    const float* x; const float* c; const float* ctx; const float* c_ctx; const float* norm_g; const float* w_mod; const float* b_mod;
    const float* e_w_in; const float* e_w_a2; const float* e_b_a2; const float* e_gla_g; const float* e_conv_w; const float* e_w_out;
    const float* o_w_in; const float* o_conv_w; const float* o_conv_b; const float* o_w_a; const float* o_b_a; const float* o_w_x; const float* o_b_x;
    const float* o_lam; const float* o_w_out; const float* final_g;
    float* out; unsigned char* ws;
};

DEVI float bf2f(bf16_t v) { return __uint_as_float((unsigned)v << 16); }
DEVI bf16_t f2bf(float f) { unsigned u = __float_as_uint(f); return (bf16_t)((u + 0x7fffu + ((u >> 16) & 1u)) >> 16); }
DEVI unsigned pk2(float lo, float hi) { return (unsigned)f2bf(lo) | ((unsigned)f2bf(hi) << 16); }
DEVI float fexp2_(float x) { return __builtin_amdgcn_exp2f(x); }
DEVI float frcp_(float x) { return __builtin_amdgcn_rcpf(x); }
DEVI float sigmoidf_(float x) { return frcp_(1.0f + fexp2_(-1.4426950408889634f * x)); }
DEVI float siluf_(float x) { return x * frcp_(1.0f + fexp2_(-1.4426950408889634f * x)); }
DEVI float softplusf_(float x) { return fmaxf(x, 0.f) + log1pf(__expf(-fabsf(x))); }
DEVI float logsigmoidf_(float x) { return fminf(x, 0.f) - 0.6931471805599453f * __builtin_amdgcn_logf(1.0f + fexp2_(-1.4426950408889634f * fabsf(x))); }
DEVI int row_of(int bb, int c, int t) { return c < 64 ? bb * 4096 + c * 64 + t : NLAT + bb * 256 + (c - 64) * 64 + t; }
DEVI int mod_idx(int row) { return row < NLAT ? (row >> 12) : 4; }
DEVI int xr_pad_of_tile(int pm) { return pm < 64 ? 4 * ((pm >> 4) + 1) : 20 + 4 * (pm - 64); }
constexpr int XR_ROWS = NT + 36;
DEVI float wave_sum(float v) {
#pragma unroll
    for (int o = 1; o < 64; o <<= 1) v += __shfl_xor(v, o);
    return v;
}
__host__ __device__ inline int colmap1(int n) {
    const int t = n >> 8, c = n & 255;
    if (t < 12) return n;
    if (t == 12) return c < 32 ? 3072 + c : -1;
    if (t < 21) { const int j = t - 13; return c < 128 ? 4128 + 128 * j + c : 5152 + 128 * j + (c - 128); }
    const int j = t - 21; return c < 128 ? 3104 + 128 * j + c : 6176 + 128 * j + (c - 128);
}

#define NTHREADS 512

__device__ void st_mod(const Params& p, int vb, int nvb, float* lds) {
    float* MOD = (float*)(p.ws + WS_MOD);
    for (int i = threadIdx.x; i < 5 * 1024; i += NTHREADS) { const int s = i >> 10, k = i & 1023; const float v = s < 4 ? p.c[s * 1024 + k] : p.c_ctx[k]; lds[i] = siluf_(v); }
    __syncthreads();
    const int lane = threadIdx.x & 63, gw = vb * (NTHREADS / 64) + (threadIdx.x >> 6), ngw = nvb * (NTHREADS / 64);
    for (int it = gw; it < 2 * 48 * 32; it += ngw) {
        const int kc = it & 31, cb = (it >> 5) % 48, li = it / (32 * 48), j = cb * 64 + lane, k0 = kc * 32;
        const float* W = p.w_mod + ((size_t)li * 1024 + k0) * 3072 + j;
        float wv[32];
#pragma unroll
        for (int k = 0; k < 32; ++k) wv[k] = W[(size_t)k * 3072];
        float a0 = 0.f, a1 = 0.f, a2 = 0.f, a3 = 0.f, a4 = 0.f;
#pragma unroll
        for (int k = 0; k < 32; ++k) { const float w = wv[k]; a0 += lds[k0 + k] * w; a1 += lds[1024 + k0 + k] * w; a2 += lds[2048 + k0 + k] * w; a3 += lds[3072 + k0 + k] * w; a4 += lds[4096 + k0 + k] * w; }
        const float bv = kc == 0 ? p.b_mod[li * 3072 + j] : 0.f;
        float* o = MOD + (size_t)li * 5 * 3072 + j;
        atomicAdd(o, a0 + bv); atomicAdd(o + 3072, a1 + bv); atomicAdd(o + 2 * 3072, a2 + bv); atomicAdd(o + 3 * 3072, a3 + bv); atomicAdd(o + 4 * 3072, a4 + bv);
    }
    __syncthreads();
}

__device__ __forceinline__ void wt_item(const float* src, int ldw, bf16_t* dst, int K, int k0, __attribute__((address_space(3))) float* scr, int lane) {
    typedef unsigned v4u __attribute__((ext_vector_type(4)));
    if (src) {
#pragma unroll 8
        for (int i = 0; i < 32; ++i) { const int kk = 2 * i + (lane >> 5); scr[kk * 33 + (lane & 31)] = src[(size_t)(k0 + kk) * ldw + (lane & 31)]; }
    }
    asm volatile("s_waitcnt lgkmcnt(0)" ::: "memory");
    const int cch = lane & 7;
#pragma unroll
    for (int j = 0; j < 4; ++j) { const int n = (lane >> 3) + 8 * j; const __attribute__((address_space(3))) float* sp = scr + (8 * cch) * 33 + n;
        v4u o = {0u, 0u, 0u, 0u};
        if (src) { o.x = pk2(sp[0 * 33], sp[1 * 33]); o.y = pk2(sp[2 * 33], sp[3 * 33]); o.z = pk2(sp[4 * 33], sp[5 * 33]); o.w = pk2(sp[6 * 33], sp[7 * 33]); }
        *(v4u*)(dst + (size_t)n * K + k0 + 8 * cch) = o; }
    asm volatile("s_waitcnt lgkmcnt(0)" ::: "memory");
}
__device__ void st_wprep(const Params& p, int vb, int nvb, unsigned char* lds_) {
    bf16_t* Bt1 = (bf16_t*)(p.ws + WS_BT1); bf16_t* Bt2 = (bf16_t*)(p.ws + WS_BT2); bf16_t* Bt3 = (bf16_t*)(p.ws + WS_BT3); bf16_t* Bt4 = (bf16_t*)(p.ws + WS_BT4);
    bf16_t* BD = (bf16_t*)(p.ws + WS_BD);
    const int lane = threadIdx.x & 63, wv = threadIdx.x >> 6, gw = vb * (NTHREADS / 64) + wv, ngw = nvb * (NTHREADS / 64);
    __attribute__((address_space(3))) float* scr = (__attribute__((address_space(3))) float*)lds_ + 8192 + wv * (64 * 33);
    constexpr int I1 = 16 * (N1 / 32), I2 = 32 * 32, I3 = 16 * 128, I4 = 32 * 32, I5 = 64 * 8;
    for (int it = gw; it < I1 + I2 + I3 + I4 + I5; it += ngw) {
        int r = it;
        if (r < I1) { const int nbk = N1 / 32, kb = r / nbk, nb = r % nbk; const int sc = colmap1(nb * 32); wt_item(sc < 0 ? nullptr : p.e_w_in + sc, EVEN_IN, Bt1 + (size_t)nb * 32 * 1024, 1024, kb * 64, scr, lane); continue; } r -= I1;
        if (r < I2) { const int kb = r / 32, nb = r % 32; wt_item(p.e_w_out + nb * 32, 1024, Bt2 + (size_t)nb * 32 * 2048, 2048, kb * 64, scr, lane); continue; } r -= I2;
        if (r < I3) { const int kb = r / 128, nb = r % 128; wt_item(p.o_w_in + nb * 32, 4096, Bt3 + (size_t)nb * 32 * 1024, 1024, kb * 64, scr, lane); continue; } r -= I3;
        if (r < I4) { const int kb = r / 32, nb = r % 32; wt_item(p.o_w_out + nb * 32, 1024, Bt4 + (size_t)nb * 32 * 2048, 2048, kb * 64, scr, lane); continue; } r -= I4;
        { const int m = r >> 8, dn = (r >> 3) & 31, kb = (r >> 2) & 1, nb = r & 3; const float* W = (m == 0 ? p.o_w_a : p.o_w_x) + (size_t)dn * 16384;
          wt_item(W + nb * 32, 128, BD + (size_t)m * 2 * 16 * 16384 + (size_t)dn * 16384 + (size_t)nb * 32 * 128, 128, kb * 64, scr, lane); }
    }
}

__device__ void st_modulate(const Params& p, int vb, int nvb, int li, const float* xlat, const float* xctx, bf16_t* H, const float* slab = nullptr, int nslab = 0, const float* gatec = nullptr) {
    const float* MOD = (const float*)(p.ws + WS_MOD) + (size_t)li * 5 * 3072;
    const float* g = p.norm_g + li * 1024;
    const int lane = threadIdx.x & 63, gw = vb * (NTHREADS / 64) + (threadIdx.x >> 6), ngw = nvb * (NTHREADS / 64);
    for (int row = gw; row < NT; row += ngw) {
        const float* xr = row < NLAT ? xlat + (size_t)row * 1024 : xctx + (size_t)(row - NLAT) * 1024;
        const float* md = MOD + (size_t)mod_idx(row) * 3072;
        float4 v[4]; float ss = 0.f;
#pragma unroll
        for (int j = 0; j < 4; ++j) { v[j] = *(const float4*)(xr + j * 256 + lane * 4);
            if (slab && row >= NLAT) {
                float4 a = {0.f, 0.f, 0.f, 0.f};
                for (int ks = 0; ks < nslab; ++ks) { const float4 t = *(const float4*)(slab + ((size_t)ks * NCTX + (row - NLAT)) * 1024 + j * 256 + lane * 4); a.x += t.x; a.y += t.y; a.z += t.z; a.w += t.w; }
                const float4 gt = *(const float4*)(gatec + j * 256 + lane * 4); v[j].x += gt.x * a.x; v[j].y += gt.y * a.y; v[j].z += gt.z * a.z; v[j].w += gt.w * a.w; }
            ss += v[j].x * v[j].x + v[j].y * v[j].y + v[j].z * v[j].z + v[j].w * v[j].w; }
        const float rinv = rsqrtf(wave_sum(ss) * (1.f / 1024.f) + EPS);
#pragma unroll
        for (int j = 0; j < 4; ++j) { const int c0 = j * 256 + lane * 4; const float4 gg = *(const float4*)(g + c0), sh = *(const float4*)(md + c0), sc = *(const float4*)(md + 1024 + c0);
            ushort4 o; o.x = f2bf(v[j].x * rinv * gg.x * (1.f + sc.x) + sh.x); o.y = f2bf(v[j].y * rinv * gg.y * (1.f + sc.y) + sh.y);
            o.z = f2bf(v[j].z * rinv * gg.z * (1.f + sc.z) + sh.z); o.w = f2bf(v[j].w * rinv * gg.w * (1.f + sc.w) + sh.w);
            *(ushort4*)(H + (size_t)row * 1024 + c0) = o; }
    }
}

template <class Epi>
__device__ void st_gemm_naive(int vb, int nvb, float* lds, const bf16_t* A, const bf16_t* Bt, int mt0, int mt1, int nt0, int nt1, int K, const Epi& E) {
    float* As = lds;
    float* Bs = lds + 32 * 33;
    const int tid = threadIdx.x, tx = tid & 63, ty = tid >> 6;
    const int nmt = mt1 - mt0, nnt = nt1 - nt0;
    for (int it = vb; it < nmt * nnt; it += nvb) {
        const int m0 = (mt0 + it / nnt) * 32, n0 = (nt0 + it % nnt) * 256;
        float acc[4][4];
#pragma unroll
        for (int i = 0; i < 4; ++i)
#pragma unroll
            for (int j = 0; j < 4; ++j) acc[i][j] = 0.f;
        for (int k0 = 0; k0 < K; k0 += 32) {
            __syncthreads();
            for (int e = tid; e < 32 * 32; e += NTHREADS) { const int r = e >> 5, kk = e & 31; As[r * 33 + kk] = bf2f(A[(size_t)(m0 + r) * K + k0 + kk]); }
            for (int e = tid; e < 256 * 32; e += NTHREADS) { const int r = e >> 5, kk = e & 31; Bs[r * 33 + kk] = bf2f(Bt[(size_t)(n0 + r) * K + k0 + kk]); }
            __syncthreads();
#pragma unroll 8
            for (int kk = 0; kk < 32; ++kk) {
                float a[4], b[4];
#pragma unroll
                for (int i = 0; i < 4; ++i) a[i] = As[(ty * 4 + i) * 33 + kk];
#pragma unroll
                for (int j = 0; j < 4; ++j) b[j] = Bs[(tx + 64 * j) * 33 + kk];
#pragma unroll
                for (int i = 0; i < 4; ++i)
#pragma unroll
                    for (int j = 0; j < 4; ++j) acc[i][j] += a[i] * b[j];
            }
        }
#pragma unroll
        for (int i = 0; i < 4; ++i) E(m0 + ty * 4 + i, n0, tx, acc[i]);
    }
    __syncthreads();
}

struct Epi1 {
    bf16_t *QK, *V, *SGA, *Z, *CBG; float* ALR;
    DEVI void operator()(int row, int n0, int cl, const float (&v)[4]) const {
        const int t = n0 >> 8;
        if (t < 4) { for (int j = 0; j < 4; ++j) QK[(size_t)row * 1024 + n0 + cl + 64 * j] = f2bf(v[j]); }
        else if (t < 8) { for (int j = 0; j < 4; ++j) V[(size_t)row * 1024 + (n0 - 1024) + cl + 64 * j] = f2bf(v[j]); }
        else if (t < 12) { for (int j = 0; j < 4; ++j) SGA[(size_t)row * 1024 + (n0 - 2048) + cl + 64 * j] = f2bf(siluf_(v[j])); }
        else if (t == 12) { if (cl < 32) ALR[(size_t)row * 32 + cl] = v[0]; }
        else if (t < 21) { const int jt = t - 13; Z[(size_t)row * 1024 + 128 * jt + cl] = f2bf(v[0] * v[2]); Z[(size_t)row * 1024 + 128 * jt + cl + 64] = f2bf(v[1] * v[3]); }
        else { const int jt = t - 21; CBG[(size_t)row * 1024 + 128 * jt + cl] = f2bf(v[0] * siluf_(v[2])); CBG[(size_t)row * 1024 + 128 * jt + cl + 64] = f2bf(v[1] * siluf_(v[3])); }
    }
};
struct EpiRes {
    const float* xl; const float* xc; float* outl; float* outc; const float* MODl;
    DEVI void operator()(int row, int n0, int cl, const float (&v)[4]) const {
        const float* gate = MODl + (size_t)mod_idx(row) * 3072 + 2048;
        for (int j = 0; j < 4; ++j) { const int col = n0 + cl + 64 * j;
            if (row < NLAT) outl[(size_t)row * 1024 + col] = xl[(size_t)row * 1024 + col] + gate[col] * v[j];
            else if (outc) outc[(size_t)(row - NLAT) * 1024 + col] = xc[(size_t)(row - NLAT) * 1024 + col] + gate[col] * v[j]; }
    }
};
struct Epi3 {
    bf16_t* XR; bf16_t* SG;
    DEVI void operator()(int row, int n0, int cl, const float (&v)[4]) const {
        for (int j = 0; j < 4; ++j) { const int col = n0 + cl + 64 * j;
            if (col < 2048) XR[(size_t)row * 2048 + col] = f2bf(v[j]); else if (row < NLAT) SG[(size_t)row * 2048 + col - 2048] = f2bf(siluf_(v[j])); }
    }
};

#define LASQ __attribute__((address_space(3)))
__device__ void st_glaprep(const Params& p, int vb, int nvb, unsigned char* ldsb, const bf16_t* QK, const bf16_t* V, const float* ALR, bf16_t* QIN, bf16_t* KET, bf16_t* SC, float* DEC, bf16_t* VT) {
    typedef unsigned u4 __attribute__((ext_vector_type(4))); typedef unsigned u2 __attribute__((ext_vector_type(2))); typedef float f4 __attribute__((ext_vector_type(4))); typedef short bx8 __attribute__((ext_vector_type(8)));
    LASQ unsigned char* lds = (LASQ unsigned char*)ldsb;
    constexpr int RQ = 0, RK = 17408, Q0 = 34816, K0 = 52224, VR = 69632, AL = VR + 33792, TT = AL + 8192;
    const int tid = threadIdx.x, kk = tid & 127, tq = tid >> 7, wv = tid >> 6, ln = tid & 63, cl = ln & 15, gq = ln >> 4;
    u4 r[9];
#define GP_LOAD(item) do { const int h_ = (item) & 3, bc_ = (item) >> 2, c_ = bc_ % NCH, bb_ = bc_ / NCH; const size_t row0_ = (size_t)row_of(bb_, c_, 0); \
        _Pragma("unroll") for (int j_ = 0; j_ < 2; ++j_) { const int p_ = tid + 512 * j_; r[j_] = *(const u4*)(QK + (row0_ + (p_ >> 4)) * 1024 + h_ * 128 + (p_ & 15) * 8); r[2 + j_] = *(const u4*)(QK + (row0_ + (p_ >> 4)) * 1024 + 512 + h_ * 128 + (p_ & 15) * 8); } \
        _Pragma("unroll") for (int j_ = 0; j_ < 4; ++j_) { const int p_ = tid + 512 * j_; r[4 + j_] = *(const u4*)(V + (row0_ + (p_ >> 5)) * 1024 + h_ * 256 + (p_ & 31) * 8); } \
        r[8] = *(const u4*)(ALR + (row0_ + (tid >> 3)) * 32 + (tid & 7) * 4); } while (0)
    const int NIT = NB * NCH * 4;
    if (vb < NIT) GP_LOAD(vb);
    for (int item = vb; item < NIT; item += nvb) {
        const int h = item & 3;
        LDS_BARRIER();
#pragma unroll
        for (int j = 0; j < 2; ++j) { const int pp = tid + 512 * j; *(LASQ u4*)(lds + RQ + (pp >> 4) * 272 + (pp & 15) * 16) = r[j]; *(LASQ u4*)(lds + RK + (pp >> 4) * 272 + (pp & 15) * 16) = r[2 + j]; }
#pragma unroll
        for (int j = 0; j < 4; ++j) { const int pp = tid + 512 * j; *(LASQ u4*)(lds + VR + (pp >> 5) * 528 + (pp & 31) * 16) = r[4 + j]; }
        *(LASQ u4*)(lds + AL + (tid >> 3) * 128 + (tid & 7) * 16) = r[8];
        float w2a[2][16], b2a[2];
#pragma unroll
        for (int d = 0; d < 2; ++d) {
#pragma unroll
            for (int rr = 0; rr < 16; ++rr) w2a[d][rr] = p.e_w_a2[((size_t)d * 16 + rr) * 512 + h * 128 + kk];
            b2a[d] = p.e_b_a2[d * 512 + h * 128 + kk]; }
        asm volatile("" ::: "memory");
        if (item + nvb < NIT) GP_LOAD(item + nvb);
        LDS_BARRIER();
        unsigned qkr[16];
#pragma unroll
        for (int i = 0; i < 16; ++i) { qkr[i] = (unsigned)*(const LASQ unsigned short*)(lds + RQ + (tq * 16 + i) * 272 + kk * 2) | ((unsigned)*(const LASQ unsigned short*)(lds + RK + (tq * 16 + i) * 272 + kk * 2) << 16); }
        float bc[2][16];
#pragma unroll
        for (int d = 0; d < 2; ++d) {
            const float (&w2)[16] = w2a[d]; const float b2 = b2a[d];
#pragma unroll
            for (int ib = 0; ib < 8; ++ib) {
                f4 ar[2][4];
#pragma unroll
                for (int ii = 0; ii < 2; ++ii) { const LASQ f4* a = (const LASQ f4*)(lds + AL + (tq * 16 + ib * 2 + ii) * 128 + d * 64); ar[ii][0] = a[0]; ar[ii][1] = a[1]; ar[ii][2] = a[2]; ar[ii][3] = a[3]; }
#pragma unroll
                for (int ii = 0; ii < 2; ++ii) { float z = b2;
#pragma unroll
                    for (int q4 = 0; q4 < 4; ++q4) z += ar[ii][q4][0] * w2[4 * q4] + ar[ii][q4][1] * w2[4 * q4 + 1] + ar[ii][q4][2] * w2[4 * q4 + 2] + ar[ii][q4][3] * w2[4 * q4 + 3];
                    bc[d][ib * 2 + ii] = logsigmoidf_(z) * (1.f / 16.f); }
            }
            float sacc = 0.f;
            if (d == 0) {
#pragma unroll
                for (int i = 0; i < 16; ++i) { sacc += bc[d][i]; bc[d][i] = sacc; } }
            else {
#pragma unroll
                for (int i = 15; i >= 0; --i) { sacc += bc[d][i]; bc[d][i] = sacc; } }
            *(LASQ float*)(lds + TT + ((d * 4 + tq) * 128 + kk) * 4) = sacc;
        }
        LDS_BARRIER();
        const float scale = 0.08838834764831845f;
#pragma unroll
        for (int d = 0; d < 2; ++d) {
            const size_t u = (size_t)item * 2 + d;
            float off = 0.f, blast = 0.f;
#pragma unroll
            for (int q = 0; q < 4; ++q) { const float tv = *(const LASQ float*)(lds + TT + ((d * 4 + q) * 128 + kk) * 4); blast += tv; if (d == 0 ? (q < tq) : (q > tq)) off += tv; }
            LASQ unsigned char* qd = lds + (d == 0 ? Q0 : RQ); LASQ unsigned char* kd = lds + (d == 0 ? K0 : RK);
            unsigned ke[8];
#pragma unroll
            for (int i = 0; i < 16; ++i) { const int t = tq * 16 + i; const float bq = bc[d][i] + off;
                const float qv = __uint_as_float(qkr[i] << 16) * scale, kv = __uint_as_float(qkr[i] & 0xffff0000u);
                const float eb = fexp2_(1.4426950408889634f * bq);
                *(LASQ unsigned short*)(qd + t * 272 + kk * 2) = f2bf(qv * eb); *(LASQ unsigned short*)(kd + t * 272 + kk * 2) = f2bf(kv * frcp_(eb));
                const unsigned kev = f2bf(kv * fexp2_(1.4426950408889634f * (blast - bq)));
                if (i & 1) ke[i >> 1] |= kev << 16; else ke[i >> 1] = kev; }
            { u4 w0 = {ke[0], ke[1], ke[2], ke[3]}, w1 = {ke[4], ke[5], ke[6], ke[7]}; u4* dst = (u4*)(KET + (u * 128 + kk) * 64 + tq * 16); dst[0] = w0; dst[1] = w1; }
            if (tq == 0) DEC[u * 128 + kk] = fexp2_(1.4426950408889634f * blast);
        }
        LDS_BARRIER();
#pragma unroll
        for (int d = 0; d < 2; ++d) {
            const size_t u = (size_t)item * 2 + d;
            const LASQ unsigned char* qd = lds + (d == 0 ? Q0 : RQ); const LASQ unsigned char* kd = lds + (d == 0 ? K0 : RK);
#pragma unroll
            for (int j = 0; j < 2; ++j) { const int pp = tid + 512 * j; *(u4*)(QIN + u * 8192 + (pp >> 4) * 128 + (pp & 15) * 8) = *(const LASQ u4*)(qd + (pp >> 4) * 272 + (pp & 15) * 16); }
            const int mt = wv >> 1;
#pragma unroll
            for (int nn = 0; nn < 2; ++nn) { const int nt = 2 * (wv & 1) + nn; f4 acc = {0.f, 0.f, 0.f, 0.f};
#pragma unroll
                for (int k4 = 0; k4 < 4; ++k4) { const bx8 kf = *(const LASQ bx8*)(kd + (16 * nt + cl) * 272 + (32 * k4 + 8 * gq) * 2), qf = *(const LASQ bx8*)(qd + (16 * mt + cl) * 272 + (32 * k4 + 8 * gq) * 2);
                    acc = __builtin_amdgcn_mfma_f32_16x16x32_bf16(kf, qf, acc, 0, 0, 0); }
                const int t = 16 * mt + cl, s0 = 16 * nt + 4 * gq; float v[4];
#pragma unroll
                for (int rr = 0; rr < 4; ++rr) { const int sx = s0 + rr; v[rr] = (d == 0 ? (sx <= t) : (sx >= t)) ? acc[rr] : 0.f; }
                u2 w; w.x = pk2(v[0], v[1]); w.y = pk2(v[2], v[3]); *(u2*)(SC + (u * 64 + t) * 64 + s0) = w; }
        }
        { const int vc = tid & 255, th = tid >> 8; unsigned vv[16];
#pragma unroll
          for (int i = 0; i < 32; ++i) { const unsigned x = *(const LASQ unsigned short*)(lds + VR + (32 * th + i) * 528 + vc * 2); if (i & 1) vv[i >> 1] |= x << 16; else vv[i >> 1] = x; }
          u4* dst = (u4*)(VT + ((size_t)item * 256 + vc) * 64 + 32 * th);
          dst[0] = (u4){vv[0], vv[1], vv[2], vv[3]}; dst[1] = (u4){vv[4], vv[5], vv[6], vv[7]}; dst[2] = (u4){vv[8], vv[9], vv[10], vv[11]}; dst[3] = (u4){vv[12], vv[13], vv[14], vv[15]}; }
    }
    LDS_BARRIER();
#undef GP_LOAD
}

__device__ void st_glawalk_naive(const Params& p, int vb, int nvb, float* Sl, const bf16_t* QIN, const bf16_t* KET, const bf16_t* SC, const float* DEC, const bf16_t* VT, bf16_t* OF, bf16_t* OB) {
    const int vc = threadIdx.x & 255, half = threadIdx.x >> 8;
    for (int combo = vb; combo < 32; combo += nvb) {
        const int d = combo & 1, h = (combo >> 1) & 3, bb = combo >> 3;
        __syncthreads();
        for (int k = half * 64; k < half * 64 + 64; ++k) Sl[k * 256 + vc] = 0.f;
        __syncthreads();
        bf16_t* O = d == 0 ? OF : OB;
        for (int step = 0; step < NCH; ++step) {
            const int c = d == 0 ? (step < 4 ? 64 + step : step - 4) : 67 - step;
            const int u = ((bb * NCH + c) * 4 + h) * 2 + d;
            const bf16_t* q = QIN + (size_t)u * 64 * 128; const bf16_t* ke = KET + (size_t)u * 128 * 64; const bf16_t* sc = SC + (size_t)u * 64 * 64;
            const bf16_t* vt = VT + (((size_t)(u >> 1)) * 256 + vc) * 64;
            float vv[64];
#pragma unroll
            for (int t = 0; t < 64; ++t) vv[t] = bf2f(vt[t]);
            const int row0 = row_of(bb, c, 0);
            for (int t = half * 32; t < half * 32 + 32; ++t) { float a = 0.f;
                for (int k = 0; k < 128; ++k) a += bf2f(q[t * 128 + k]) * bf2f(f2bf(Sl[k * 256 + vc]));
#pragma unroll
                for (int s = 0; s < 64; ++s) a += bf2f(sc[t * 64 + s]) * vv[s];
                O[(size_t)(row0 + t) * 1024 + h * 256 + vc] = f2bf(a); }
            __syncthreads();
            for (int k = half * 64; k < half * 64 + 64; ++k) { float a = DEC[(size_t)u * 128 + k] * Sl[k * 256 + vc];
#pragma unroll
                for (int t = 0; t < 64; ++t) a += bf2f(ke[k * 64 + t]) * vv[t];
                Sl[k * 256 + vc] = a; }
            __syncthreads();
        }
    }
}

__device__ void st_inner(const Params& p, int vb, int nvb, const bf16_t* OF, const bf16_t* OB, const bf16_t* SGA, const bf16_t* Z, const bf16_t* CBG, bf16_t* INNER, const bf16_t* ZA, float* X1C) {
    const int lane = threadIdx.x & 63, gw = vb * (NTHREADS / 64) + (threadIdx.x >> 6), ngw = nvb * (NTHREADS / 64);
    float4 gg = *(const float4*)(p.e_gla_g + lane * 4);
    for (int row = gw; row < NT; row += ngw) {
        bool hasp, hasn;
        if (row < NLAT) { const int t = row & 63; hasp = t != 0; hasn = t != 63; } else { const int t = (row - NLAT) & 255; hasp = t != 0; hasn = t != 255; }
        const size_t rp = hasp ? row - 1 : row, rn = hasn ? row + 1 : row; const float mp = hasp ? 1.f : 0.f, mn = hasn ? 1.f : 0.f;
        ushort4 a[4], b[4], sg[4], zc[4], zp[4], zn[4], cb[4];
#pragma unroll
        for (int h = 0; h < 4; ++h) { const int c0 = h * 256 + lane * 4;
            a[h] = *(const ushort4*)(OF + (size_t)row * 1024 + c0); b[h] = *(const ushort4*)(OB + (size_t)row * 1024 + c0); sg[h] = *(const ushort4*)(SGA + (size_t)row * 1024 + c0);
            const bf16_t* zb = h == 0 ? ZA + lane * 4 : Z + c0; const size_t zpitch = h == 0 ? 256 : 1024;
            zc[h] = *(const ushort4*)(zb + (size_t)row * zpitch); zp[h] = *(const ushort4*)(zb + rp * zpitch); zn[h] = *(const ushort4*)(zb + rn * zpitch);
            cb[h] = *(const ushort4*)(CBG + (size_t)row * 1024 + c0); }
#pragma unroll
        for (int h = 0; h < 4; ++h) { const int c0 = h * 256 + lane * 4;
            const float o0 = bf2f(a[h].x) + bf2f(b[h].x), o1 = bf2f(a[h].y) + bf2f(b[h].y), o2 = bf2f(a[h].z) + bf2f(b[h].z), o3 = bf2f(a[h].w) + bf2f(b[h].w);
            const float rinv = rsqrtf(wave_sum(o0 * o0 + o1 * o1 + o2 * o2 + o3 * o3) * (1.f / 256.f) + EPS);
            uint2 o; o.x = pk2(o0 * rinv * gg.x * bf2f(sg[h].x), o1 * rinv * gg.y * bf2f(sg[h].y)); o.y = pk2(o2 * rinv * gg.z * bf2f(sg[h].z), o3 * rinv * gg.w * bf2f(sg[h].w));
            *(uint2*)(INNER + (size_t)row * 2048 + c0) = o;
            const float4 w0 = *(const float4*)(p.e_conv_w + c0), w1 = *(const float4*)(p.e_conv_w + 1024 + c0), w2 = *(const float4*)(p.e_conv_w + 2048 + c0);
            uint2 y; y.x = pk2(bf2f(cb[h].x) * (mp * w0.x * bf2f(zp[h].x) + w1.x * bf2f(zc[h].x) + mn * w2.x * bf2f(zn[h].x)), bf2f(cb[h].y) * (mp * w0.y * bf2f(zp[h].y) + w1.y * bf2f(zc[h].y) + mn * w2.y * bf2f(zn[h].y)));
            y.y = pk2(bf2f(cb[h].z) * (mp * w0.z * bf2f(zp[h].z) + w1.z * bf2f(zc[h].z) + mn * w2.z * bf2f(zn[h].z)), bf2f(cb[h].w) * (mp * w0.w * bf2f(zp[h].w) + w1.w * bf2f(zc[h].w) + mn * w2.w * bf2f(zn[h].w)));
            *(uint2*)(INNER + (size_t)row * 2048 + 1024 + c0) = y; }
    }
}

template <int MODE>
__device__ void st_rglru_naive(const Params& p, int vb, int nvb, float* lds, const bf16_t* XR, const bf16_t* SG, float* SUMA, float* SUMH, bf16_t* Y) {
    float* xc = lds;
    float* av = xc + 64 * 128;
    float* uv = av + 64 * 128;
    float* hf = uv + 64 * 128;
    const int tid = threadIdx.x, j = tid & 127, tq = tid >> 7;
    const int nitems = MODE == 0 ? NB * NCH * 16 * 2 : NB * 64 * 16;
    for (int it = vb; it < nitems; it += nvb) {
        int bb, c, nb;
        if (MODE == 0) { nb = (it >> 1) & 15; const int bc = it >> 5; c = bc % NCH; bb = bc / NCH; } else { nb = it & 15; const int bc = it >> 4; c = bc & 63; bb = bc >> 6; }
        const int row0 = row_of(bb, c, 0);
        const int seg0 = c < 64 ? bb * 4096 : NLAT + bb * 256, segn = c < 64 ? 4096 : 256;
        const int tl0 = row0 - seg0;
        for (int dd = 0; dd < (MODE == 0 ? 1 : 2); ++dd) {
            const int d = MODE == 0 ? (it & 1) : dd;
            __syncthreads();
            for (int e = tid; e < 64 * 128; e += NTHREADS) { const int t = e >> 7, i = e & 127, ch = nb * 128 + i; float a = p.o_conv_b[d * 2048 + ch];
#pragma unroll
                for (int jj = 0; jj < 4; ++jj) { const int tt = d == 0 ? tl0 + t - 3 + jj : tl0 + t + 3 - jj;
                    if (tt >= 0 && tt < segn) a += p.o_conv_w[((size_t)d * 4 + jj) * 2048 + ch] * bf2f(XR[(size_t)(seg0 + tt) * 2048 + ch]); }
                xc[e] = a; }
            __syncthreads();
            const float* WA = p.o_w_a + ((size_t)d * 16 + nb) * 128 * 128; const float* WX = p.o_w_x + ((size_t)d * 16 + nb) * 128 * 128;
            const int ch = nb * 128 + j;
            const float ba = p.o_b_a[d * 2048 + ch], bx = p.o_b_x[d * 2048 + ch], sp = softplusf_(-p.o_lam[d * 2048 + ch]);
            for (int i16 = 0; i16 < 16; ++i16) { const int t = tq * 16 + i16; float ra = ba, rx = bx;
                for (int i = 0; i < 128; ++i) { const float xv = bf2f(f2bf(xc[t * 128 + i])); ra += xv * bf2f(f2bf(WA[i * 128 + j])); rx += xv * bf2f(f2bf(WX[i * 128 + j])); }
                const float r = sigmoidf_(ra), ig = sigmoidf_(rx); const float la = -8.f * r * sp; const float a = __expf(la);
                av[t * 128 + j] = a; uv[t * 128 + j] = sqrtf(-expm1f(2.f * la)) * (ig * xc[t * 128 + j]); }
            __syncthreads();
            if (tid < 128) {
                const size_t sidx = (((size_t)bb * 2 + d) * NCH + c) * 2048 + ch;
                if (MODE == 0) { float A = 1.f, hh = 0.f;
                    if (d == 0) for (int t = 0; t < 64; ++t) { const float a = av[t * 128 + j]; hh = a * hh + uv[t * 128 + j]; A *= a; }
                    else for (int t = 63; t >= 0; --t) { const float a = av[t * 128 + j]; hh = a * hh + uv[t * 128 + j]; A *= a; }
                    SUMA[sidx] = A; SUMH[sidx] = hh;
                } else { float hh = SUMH[sidx];
                    if (d == 0) for (int t = 0; t < 64; ++t) { hh = av[t * 128 + j] * hh + uv[t * 128 + j]; hf[t * 128 + j] = hh; }
                    else for (int t = 63; t >= 0; --t) { hh = av[t * 128 + j] * hh + uv[t * 128 + j]; const size_t o = (size_t)(row0 + t) * 2048 + ch; Y[o] = f2bf((hf[t * 128 + j] + hh) * bf2f(SG[o])); }
                }
            }
        }
    }
    __syncthreads();
}
__device__ void st_carry(const Params& p, int vb, int nvb, const float* SUMA, float* SUMH) {
    for (int e = vb * NTHREADS + threadIdx.x; e < NB * 2 * 2048; e += nvb * NTHREADS) {
        const int ch = e & 2047, d = (e >> 11) & 1, bb = e >> 12; float hh = 0.f;
        for (int s0 = 0; s0 < NCH; s0 += 17) {
            float A[17], H[17];
#pragma unroll
            for (int i = 0; i < 17; ++i) { const int step = s0 + i, c = d == 0 ? (step < 4 ? 64 + step : step - 4) : 67 - step; const size_t sidx = (((size_t)bb * 2 + d) * NCH + c) * 2048 + ch; A[i] = SUMA[sidx]; H[i] = SUMH[sidx]; }
#pragma unroll
            for (int i = 0; i < 17; ++i) { const int step = s0 + i, c = d == 0 ? (step < 4 ? 64 + step : step - 4) : 67 - step; const size_t sidx = (((size_t)bb * 2 + d) * NCH + c) * 2048 + ch; SUMH[sidx] = hh; hh = A[i] * hh + H[i]; }
        }
    }
}
__device__ void st_final(const Params& p, int vb, int nvb) {
    const int lane = threadIdx.x & 63, gw = vb * (NTHREADS / 64) + (threadIdx.x >> 6), ngw = nvb * (NTHREADS / 64);
    for (int row = gw; row < NLAT; row += ngw) { float* xr = p.out + (size_t)row * 1024; float4 v[4]; float ss = 0.f;
#pragma unroll
        for (int j = 0; j < 4; ++j) { v[j] = *(const float4*)(xr + j * 256 + lane * 4); ss += v[j].x * v[j].x + v[j].y * v[j].y + v[j].z * v[j].z + v[j].w * v[j].w; }
        const float rinv = rsqrtf(wave_sum(ss) * (1.f / 1024.f) + EPS);
#pragma unroll
        for (int j = 0; j < 4; ++j) { const float4 g = *(const float4*)(p.final_g + j * 256 + lane * 4); float4 o; o.x = v[j].x * rinv * g.x; o.y = v[j].y * rinv * g.y; o.z = v[j].z * rinv * g.z; o.w = v[j].w * rinv * g.w; *(float4*)(xr + j * 256 + lane * 4) = o; }
    }
}


namespace pg8 {
#define PG8_LAS __attribute__((address_space(3)))
typedef short bf16x8 __attribute__((ext_vector_type(8)));
typedef float f32x4 __attribute__((ext_vector_type(4)));
typedef unsigned u32x4 __attribute__((ext_vector_type(4)));
constexpr int BM = 256, BK = 64, HALF = 128, HTB = HALF * BK * 2, STAGE_BYTES = 8 * HTB, NXCD = 8, WGM = 8;
__host__ __device__ __forceinline__ int lds_byte(int r, int c) { const int st = (r >> 4) * 2 + (c >> 5), rr = r & 15, cc = c & 31, ob = rr * 64 + cc * 2; return st * 1024 + (ob ^ (((ob >> 9) & 1) << 5)); }
__host__ __device__ __forceinline__ void stage_rc(int b, int& R, int& C) { const int st = b / 1024, sb = b % 1024, swz = sb ^ (((sb >> 9) & 1) << 5); R = (st >> 1) * 16 + swz / 64; C = (st & 1) * 32 + (swz % 64) / 2; }
__host__ __device__ __forceinline__ int perm32(int rho) { const int n = rho >> 4, i = rho & 15; return 8 * (i >> 2) + 4 * n + (i & 3); }
struct Unit { int pm, pn, k0, nk; };
struct Gemm { const bf16_t* A; const bf16_t* Bt; int M, N, K; };
struct TileOrder {
    int nM, nN, nwg, G, c, m0, split, base0, base1, nkfull, nM2, nN2, m02, nKS, nk2;
    __device__ void init(int nM_, int nN_, int nkfull_, int G_, int c_, int m0_ = 0, int split_ = 1 << 30, int base0_ = 0, int base1_ = 0, int nM2_ = 0, int nN2_ = 0, int m02_ = 0, int nKS_ = 1, int nk2_ = 0) {
        nM = nM_; nN = nN_; nwg = nM * nN; nkfull = nkfull_; G = G_; c = c_; m0 = m0_; split = split_; base0 = base0_; base1 = base1_; nM2 = nM2_; nN2 = nN2_; m02 = m02_; nKS = nKS_; nk2 = nk2_; }
    __device__ bool next(int i, Unit& u) const {
        const long L = (long)i * G + c;
        if (L >= nwg) { const long L2 = L - nwg; if (L2 >= (long)nM2 * nN2 * nKS) return false; const int ks = (int)(L2 % nKS), rest = (int)(L2 / nKS);
            u.pm = m02 + rest / nN2; u.pn = rest % nN2; u.k0 = ks * nk2 * 64; u.nk = nk2; return true; }
        int wgid = (int)L; { const int q = nwg / NXCD, r = nwg % NXCD, xcd = wgid % NXCD, off = wgid / NXCD; wgid = (xcd < r ? xcd * (q + 1) : r * (q + 1) + (xcd - r) * q) + off; }
        const int nig = WGM * nN, gid = wgid / nig, fm = gid * WGM, gsz = (nM - fm) < WGM ? (nM - fm) : WGM;
        const int pm = fm + ((wgid % nig) % gsz), j = (wgid % nig) / gsz;
        u.pm = m0 + pm; u.pn = j < split ? base0 + j : base1 + (j - split); u.k0 = 0; u.nk = nkfull; return true;
    }
    __device__ __forceinline__ void a_ready(const Unit&) const {}
    __device__ __forceinline__ void done(const Unit&) const {}
};
typedef float f32x2_t __attribute__((ext_vector_type(2))); typedef __bf16 bf16x2_t __attribute__((ext_vector_type(2)));
__device__ __forceinline__ unsigned cvt_pk_bf16(float lo, float hi) { f32x2_t v = {lo, hi}; bf16x2_t b = __builtin_convertvector(v, bf16x2_t); return __builtin_bit_cast(unsigned, b); }
template <class Epi, class Sched, bool ALIGN_EPI = false, bool SP2 = false>
__device__ __forceinline__ void gemm_phase(PG8_LAS unsigned char* lds, const Gemm g, const Sched& S, const Epi& E) {
    const int tid = threadIdx.x, wid = __builtin_amdgcn_readfirstlane(tid >> 6), lane = tid & 63, wr = wid >> 2, wc = wid & 3, fr = lane & 15, fq = lane >> 4;
    const int K = g.K;
    unsigned voffA[2], voffB[2];
#pragma unroll
    for (int i = 0; i < 2; ++i) { int R, C; stage_rc(tid * 16 + i * 8192, R, C); const int Rb = Epi::PERM ? ((R & ~31) + perm32(R & 31)) : R;
        voffA[i] = (unsigned)(R * K + C) * 2u; voffB[i] = (unsigned)(Rb * K + C) * 2u; }
    const size_t kstep = (size_t)(BK * 2);
    const size_t hstep = (size_t)HALF * K * 2;
    const size_t tstep = 2 * hstep;
    const unsigned ldsw = (unsigned)wid * 1024u;
    const int aoff = lds_byte(wr * 64 + fr, fq * 8), boff = lds_byte(wc * 32 + fr, fq * 8);
#define PG8_SA(b, h) (((b) * 2 + (h)) * HTB)
#define PG8_SB(b, h) ((4 + (b) * 2 + (h)) * HTB)
#define PG8_STAGE(bufoff, gbase, voff) do { _Pragma("unroll") for (int _i = 0; _i < 2; ++_i) \
        __builtin_amdgcn_global_load_lds((const unsigned*)((const char*)(gbase) + (voff)[_i]), (PG8_LAS unsigned*)(lds + (bufoff) + ldsw + _i * 8192), 16, 0, 0); } while (0)
#define PG8_LDA(dst, b, h) do { _Pragma("unroll") for (int m = 0; m < 4; ++m) _Pragma("unroll") for (int k = 0; k < 2; ++k) dst[m][k] = *(const PG8_LAS bf16x8*)(lds + PG8_SA(b, h) + aoff + m * 2048 + k * 1024); } while (0)
#define PG8_LDB(dst, b, h) do { _Pragma("unroll") for (int n = 0; n < 2; ++n) _Pragma("unroll") for (int k = 0; k < 2; ++k) dst[n][k] = *(const PG8_LAS bf16x8*)(lds + PG8_SB(b, h) + boff + n * 2048 + k * 1024); } while (0)
#define PG8_MMA(ai, bj, At, Bt) do { __builtin_amdgcn_s_setprio(1); _Pragma("unroll") for (int m = 0; m < 4; ++m) _Pragma("unroll") for (int n = 0; n < 2; ++n) _Pragma("unroll") for (int k = 0; k < 2; ++k) \
        acc[ai][bj][m][n] = __builtin_amdgcn_mfma_f32_16x16x32_bf16(Bt[n][k], At[m][k], acc[ai][bj][m][n], 0, 0, 0); __builtin_amdgcn_s_setprio(0); } while (0)
#define PG8_WAIT_V(n) asm volatile("s_waitcnt vmcnt(" #n ")" ::: "memory")
#define PG8_WAIT_L(n) asm volatile("s_waitcnt lgkmcnt(" #n ")" ::: "memory")
#define PG8_BAR __builtin_amdgcn_s_barrier()
#define PG8_SCHED __builtin_amdgcn_sched_barrier(0)
    Unit cur, nxt; int ui = 0;
    if (!S.next(0, cur)) return;
    f32x4 acc[2][2][4][2];
#pragma unroll
    for (int a = 0; a < 2; ++a)
#pragma unroll
        for (int b = 0; b < 2; ++b)
#pragma unroll
            for (int m = 0; m < 4; ++m)
#pragma unroll
                for (int n = 0; n < 2; ++n) acc[a][b][m][n] = (f32x4){0.f, 0.f, 0.f, 0.f};
    bf16x8 At[4][2], B0[2][2], B1[2][2];
    const char* cA = (const char*)g.A + (size_t)cur.pm * tstep + (size_t)cur.k0 * 2; const char* cB = (const char*)g.Bt + (size_t)cur.pn * tstep + (size_t)cur.k0 * 2;
    S.a_ready(cur);
    if constexpr (SP2) {
        PG8_STAGE(PG8_SB(0, 0), cB, voffB); PG8_STAGE(PG8_SB(0, 1), cB + hstep, voffB); PG8_STAGE(PG8_SA(0, 0), cA, voffA); PG8_STAGE(PG8_SA(0, 1), cA + hstep, voffA);
        if (wr == 1) PG8_BAR;
        PG8_WAIT_V(2); PG8_BAR;
        PG8_STAGE(PG8_SB(1, 0), cB + kstep, voffB); PG8_STAGE(PG8_SA(1, 0), cA + kstep, voffA); PG8_STAGE(PG8_SB(1, 1), cB + hstep + kstep, voffB);
        PG8_WAIT_V(6); PG8_BAR;
    } else {
        PG8_STAGE(PG8_SB(0, 0), cB, voffB); PG8_STAGE(PG8_SA(0, 0), cA, voffA); PG8_STAGE(PG8_SB(0, 1), cB + hstep, voffB); PG8_STAGE(PG8_SA(0, 1), cA + hstep, voffA);
        if (wr == 1) PG8_BAR;
        PG8_WAIT_V(4); PG8_BAR;
        PG8_STAGE(PG8_SB(1, 0), cB + kstep, voffB); PG8_STAGE(PG8_SA(1, 0), cA + kstep, voffA); PG8_STAGE(PG8_SB(1, 1), cB + hstep + kstep, voffB);
        PG8_WAIT_V(6); PG8_BAR;
    }
    for (;;) {
        const bool has_next = S.next(ui + 1, nxt);
        const char* nA = has_next ? (const char*)g.A + (size_t)nxt.pm * tstep + (size_t)nxt.k0 * 2 : cA; const char* nB = has_next ? (const char*)g.Bt + (size_t)nxt.pn * tstep + (size_t)nxt.k0 * 2 : cB;
        const int nt = cur.nk;
        for (int t = 0; t < nt; t += 2) {
            const bool last = (t == nt - 2);
            const char* a1 = cA + (size_t)(t + 1) * kstep;
            const char* a2 = last ? nA : cA + (size_t)(t + 2) * kstep; const char* b2 = last ? nB : cB + (size_t)(t + 2) * kstep;
            const char* a3 = a2 + kstep; const char* b3 = b2 + kstep;
            if (last && has_next) S.a_ready(nxt);
            if constexpr (SP2) {
            PG8_LDB(B0, 0, 0); PG8_LDB(B1, 0, 1); PG8_SCHED; PG8_LDA(At, 0, 0); PG8_STAGE(PG8_SA(1, 1), a1 + hstep, voffA);
            PG8_WAIT_V(8); PG8_WAIT_L(0); PG8_BAR; PG8_MMA(0, 0, At, B0); PG8_MMA(0, 1, At, B1); PG8_BAR; PG8_SCHED;
            PG8_LDA(At, 0, 1); PG8_STAGE(PG8_SB(0, 0), b2, voffB); PG8_STAGE(PG8_SB(0, 1), b2 + hstep, voffB); PG8_STAGE(PG8_SA(0, 0), a2, voffA);
            PG8_WAIT_V(8); PG8_WAIT_L(0); PG8_BAR; PG8_MMA(1, 0, At, B0); PG8_MMA(1, 1, At, B1); PG8_BAR; PG8_SCHED;
            PG8_LDB(B0, 1, 0); PG8_LDB(B1, 1, 1); PG8_SCHED; PG8_LDA(At, 1, 0); PG8_STAGE(PG8_SA(0, 1), a2 + hstep, voffA);
            PG8_WAIT_V(8); PG8_WAIT_L(0); PG8_BAR; PG8_MMA(0, 0, At, B0); PG8_MMA(0, 1, At, B1); PG8_BAR; PG8_SCHED;
            PG8_LDA(At, 1, 1); PG8_STAGE(PG8_SB(1, 0), b3, voffB); PG8_STAGE(PG8_SB(1, 1), b3 + hstep, voffB); PG8_STAGE(PG8_SA(1, 0), a3, voffA);
            PG8_WAIT_V(8); PG8_WAIT_L(0); PG8_BAR; PG8_MMA(1, 0, At, B0); PG8_MMA(1, 1, At, B1); PG8_BAR; PG8_SCHED;
            } else {
            PG8_LDB(B0, 0, 0); PG8_SCHED; PG8_LDA(At, 0, 0); PG8_STAGE(PG8_SA(1, 1), a1 + hstep, voffA);
            PG8_WAIT_L(8); PG8_BAR; PG8_WAIT_L(0); PG8_MMA(0, 0, At, B0); PG8_BAR; PG8_SCHED;
            PG8_LDB(B1, 0, 1); PG8_STAGE(PG8_SB(0, 0), b2, voffB);
            PG8_BAR; PG8_WAIT_L(0); PG8_MMA(0, 1, At, B1); PG8_BAR;
            PG8_LDA(At, 0, 1); PG8_STAGE(PG8_SA(0, 0), a2, voffA);
            PG8_BAR; PG8_WAIT_L(0); PG8_MMA(1, 0, At, B0); PG8_BAR; PG8_SCHED;
            PG8_STAGE(PG8_SB(0, 1), b2 + hstep, voffB);
            PG8_WAIT_V(6); PG8_BAR; PG8_MMA(1, 1, At, B1); PG8_BAR;
            PG8_LDB(B0, 1, 0); PG8_SCHED; PG8_LDA(At, 1, 0); PG8_STAGE(PG8_SA(0, 1), a2 + hstep, voffA);
            PG8_WAIT_L(8); PG8_BAR; PG8_WAIT_L(0); PG8_MMA(0, 0, At, B0); PG8_BAR; PG8_SCHED;
            PG8_LDB(B1, 1, 1); PG8_STAGE(PG8_SB(1, 0), b3, voffB);
            PG8_BAR; PG8_WAIT_L(0); PG8_MMA(0, 1, At, B1); PG8_BAR;
            PG8_LDA(At, 1, 1); PG8_STAGE(PG8_SA(1, 0), a3, voffA);
            PG8_BAR; PG8_WAIT_L(0); PG8_MMA(1, 0, At, B0); PG8_BAR; PG8_SCHED;
            PG8_STAGE(PG8_SB(1, 1), b3 + hstep, voffB);
            PG8_WAIT_V(6); PG8_BAR; PG8_MMA(1, 1, At, B1); PG8_BAR;
            }
        }
        if constexpr (ALIGN_EPI) { if (wr == 0) PG8_BAR; }
        if constexpr (!Epi::AFTER_DRAIN) { E(acc, cur, wr, wc, fr, fq); S.done(cur); }
        if (!has_next) break;
#pragma unroll
        for (int a = 0; a < 2; ++a)
#pragma unroll
            for (int b = 0; b < 2; ++b)
#pragma unroll
                for (int m = 0; m < 4; ++m)
#pragma unroll
                    for (int n = 0; n < 2; ++n) acc[a][b][m][n] = (f32x4){0.f, 0.f, 0.f, 0.f};
        cur = nxt; cA = nA; cB = nB; ++ui;
        if constexpr (ALIGN_EPI) { if (wr == 1) PG8_BAR; }
    }
    PG8_WAIT_V(0);
    if constexpr (!ALIGN_EPI) { if (wr == 0) PG8_BAR; }
    PG8_BAR;
    if constexpr (Epi::AFTER_DRAIN) { E.fused(acc, cur, wr, wc, fr, fq, lds, wid, lane); S.done(cur); }
#undef PG8_SA
#undef PG8_SB
#undef PG8_STAGE
#undef PG8_LDA
#undef PG8_LDB
#undef PG8_MMA
#undef PG8_WAIT_V
#undef PG8_WAIT_L
#undef PG8_BAR
#undef PG8_SCHED
}
}

DEVI pg8::u32x4 pack8(const pg8::f32x4& a, const pg8::f32x4& b) { pg8::u32x4 w; w.x = pg8::cvt_pk_bf16(a[0], a[1]); w.y = pg8::cvt_pk_bf16(a[2], a[3]); w.z = pg8::cvt_pk_bf16(b[0], b[1]); w.w = pg8::cvt_pk_bf16(b[2], b[3]); return w; }
DEVI pg8::f32x4 silu4(const pg8::f32x4& a) { pg8::f32x4 r; r[0] = siluf_(a[0]); r[1] = siluf_(a[1]); r[2] = siluf_(a[2]); r[3] = siluf_(a[3]); return r; }
struct FEpi1 {
    static constexpr bool PERM = true, AFTER_DRAIN = false;
    bf16_t *QK, *V, *SGA, *Z, *CBG; float* ALR; bf16_t* ZA;
    DEVI void operator()(const pg8::f32x4 (&acc)[2][2][4][2], const pg8::Unit& u, int wr, int wc, int fr, int fq) const {
        const int t = u.pn, row0 = u.pm * 256 + wr * 64 + fr, cw = wc * 32 + 8 * fq;
#pragma unroll
        for (int ai = 0; ai < 2; ++ai)
#pragma unroll
            for (int m = 0; m < 4; ++m) {
                const size_t row = (size_t)(row0 + ai * 128 + m * 16);
                if (t < 12) {
                    bf16_t* base = t < 4 ? QK + row * 1024 + t * 256 : (t < 8 ? V + row * 1024 + (t - 4) * 256 : SGA + row * 1024 + (t - 8) * 256);
#pragma unroll
                    for (int bj = 0; bj < 2; ++bj) { pg8::f32x4 v0 = acc[ai][bj][m][0], v1 = acc[ai][bj][m][1]; if (t >= 8) { v0 = silu4(v0); v1 = silu4(v1); }
                        *(pg8::u32x4*)(base + bj * 128 + cw) = pack8(v0, v1); }
                } else if (t == 12) {
                    if (wc == 0) { *(pg8::f32x4*)(ALR + row * 32 + 8 * fq) = acc[ai][0][m][0]; *(pg8::f32x4*)(ALR + row * 32 + 8 * fq + 4) = acc[ai][0][m][1]; }
                } else if (t < 21) {
                    bf16_t* zp = t < 15 ? ZA + row * 256 + (t - 13) * 128 + cw : Z + row * 1024 + (t - 13) * 128 + cw;
                    *(pg8::u32x4*)zp = pack8(acc[ai][0][m][0] * acc[ai][1][m][0], acc[ai][0][m][1] * acc[ai][1][m][1]);
                } else {
                    *(pg8::u32x4*)(CBG + row * 1024 + (t - 21) * 128 + cw) = pack8(acc[ai][0][m][0] * silu4(acc[ai][1][m][0]), acc[ai][0][m][1] * silu4(acc[ai][1][m][1]));
                }
            }
    }
};
template <bool HAS_TAIL> struct FEpiRes {
    static constexpr bool PERM = false, AFTER_DRAIN = false;
    const float* xl; const float* xc; float* outl; float* outc; const float* MODl;
    DEVI void operator()(const pg8::f32x4 (&acc)[2][2][4][2], const pg8::Unit& u, int wr, int wc, int fr, int fq) const {
        const int row0 = u.pm * 256 + wr * 64 + fr, col0 = u.pn * 256 + wc * 32 + 4 * fq;
        const bool lat = u.pm < NLAT / 256;
        const float* gate = MODl + (size_t)(lat ? (u.pm >> 4) : 4) * 3072 + 2048 + col0;
        pg8::f32x4 gv[2][2];
#pragma unroll
        for (int bj = 0; bj < 2; ++bj)
#pragma unroll
            for (int n = 0; n < 2; ++n) gv[bj][n] = *(const pg8::f32x4*)(gate + bj * 128 + n * 16);
        if (HAS_TAIL && !lat) {
            float* o = outc + (size_t)(u.k0 >> 8) * NCTX * 1024 - (size_t)NLAT * 1024;
#pragma unroll
            for (int ai = 0; ai < 2; ++ai)
#pragma unroll
                for (int m = 0; m < 4; ++m) { const size_t off = (size_t)(row0 + ai * 128 + m * 16) * 1024 + col0;
#pragma unroll
                    for (int bj = 0; bj < 2; ++bj)
#pragma unroll
                        for (int n = 0; n < 2; ++n) *(pg8::f32x4*)(o + off + bj * 128 + n * 16) = acc[ai][bj][m][n]; }
            return;
        }
        const float* xin = xl; float* o = outl;
#pragma unroll
        for (int ai = 0; ai < 2; ++ai)
#pragma unroll
            for (int m = 0; m < 4; ++m) { const size_t off = (size_t)(row0 + ai * 128 + m * 16) * 1024 + col0;
#pragma unroll
                for (int bj = 0; bj < 2; ++bj)
#pragma unroll
                    for (int n = 0; n < 2; ++n) { const pg8::f32x4 xv = *(const pg8::f32x4*)(xin + off + bj * 128 + n * 16); *(pg8::f32x4*)(o + off + bj * 128 + n * 16) = xv + gv[bj][n] * acc[ai][bj][m][n]; } }
    }
};
struct FEpi3 {
    static constexpr bool PERM = true, AFTER_DRAIN = false;
    bf16_t* XR; bf16_t* SG; float* XRC;
    DEVI void operator()(const pg8::f32x4 (&acc)[2][2][4][2], const pg8::Unit& u, int wr, int wc, int fr, int fq) const {
        const int t = u.pn, row0 = u.pm * 256 + wr * 64 + fr, cw = wc * 32 + 8 * fq;
        if (u.pm >= NLAT / 256) {
            float* sl = XRC + (size_t)(u.k0 >> 9) * NCTX * 2048;
#pragma unroll
            for (int ai = 0; ai < 2; ++ai)
#pragma unroll
                for (int m = 0; m < 4; ++m) { float* rp = sl + (size_t)(row0 - NLAT + ai * 128 + m * 16) * 2048 + t * 256 + cw;
#pragma unroll
                    for (int bj = 0; bj < 2; ++bj) { *(pg8::f32x4*)(rp + bj * 128) = acc[ai][bj][m][0]; *(pg8::f32x4*)(rp + bj * 128 + 4) = acc[ai][bj][m][1]; } }
            return;
        }
        bf16_t* base = t < 8 ? XR + (size_t)xr_pad_of_tile(u.pm) * 2048 + t * 256 : SG + (t - 8) * 256;
#pragma unroll
        for (int ai = 0; ai < 2; ++ai)
#pragma unroll
            for (int m = 0; m < 4; ++m) { bf16_t* rp = base + (size_t)(row0 + ai * 128 + m * 16) * 2048 + cw;
#pragma unroll
                for (int bj = 0; bj < 2; ++bj) { pg8::f32x4 v0 = acc[ai][bj][m][0], v1 = acc[ai][bj][m][1]; if (t >= 8) { v0 = silu4(v0); v1 = silu4(v1); }
                    *(pg8::u32x4*)(rp + bj * 128) = pack8(v0, v1); } }
    }
};

struct FEpiResRms {
    static constexpr bool PERM = false, AFTER_DRAIN = true;
    const float* xin; float* out; const float* MODl; const float* gfin; float* slots; unsigned* cnt;
    DEVI void fused(pg8::f32x4 (&acc)[2][2][4][2], const pg8::Unit& u, int wr, int wc, int fr, int fq, PG8_LAS unsigned char* lds, int wid, int lane) const {
        const int row0 = u.pm * 256 + wr * 64 + fr, col0 = u.pn * 256 + wc * 32 + 4 * fq;
        const float* gate = MODl + (size_t)(u.pm >> 4) * 3072 + 2048 + col0;
        PG8_LAS float* P = (PG8_LAS float*)lds;
        PG8_LAS float* S = (PG8_LAS float*)(lds + 8192);
        { pg8::f32x4 gv[2][2];
#pragma unroll
          for (int bj = 0; bj < 2; ++bj)
#pragma unroll
              for (int n = 0; n < 2; ++n) gv[bj][n] = *(const pg8::f32x4*)(gate + bj * 128 + n * 16);
#pragma unroll
          for (int ai = 0; ai < 2; ++ai)
#pragma unroll
              for (int m = 0; m < 4; ++m) { const float* xp = xin + (size_t)(row0 + ai * 128 + m * 16) * 1024 + col0;
#pragma unroll
                  for (int bj = 0; bj < 2; ++bj)
#pragma unroll
                      for (int n = 0; n < 2; ++n) { const pg8::f32x4 xv = *(const pg8::f32x4*)(xp + bj * 128 + n * 16); acc[ai][bj][m][n] = xv + gv[bj][n] * acc[ai][bj][m][n]; }
                  asm volatile("" : "+v"(acc[ai][0][m][0]), "+v"(acc[ai][0][m][1]), "+v"(acc[ai][1][m][0]), "+v"(acc[ai][1][m][1]));
                  if (m & 1) asm volatile("" ::: "memory"); } }
#pragma unroll
        for (int ai = 0; ai < 2; ++ai)
#pragma unroll
            for (int m = 0; m < 4; ++m) { float q = 0.f;
#pragma unroll
                for (int bj = 0; bj < 2; ++bj)
#pragma unroll
                    for (int n = 0; n < 2; ++n) { const pg8::f32x4 x = acc[ai][bj][m][n]; q += (x[0] * x[0] + x[1] * x[1]) + (x[2] * x[2] + x[3] * x[3]); }
                q += __shfl_xor(q, 16); q += __shfl_xor(q, 32);
                if (fq == 0) P[(ai * 128 + wr * 64 + m * 16 + fr) * 4 + wc] = q; }
        asm volatile("s_waitcnt lgkmcnt(0)" ::: "memory"); __builtin_amdgcn_s_barrier(); asm volatile("" ::: "memory");
        const int row = wid * 32 + (lane & 31);
        if (lane < 32) { const float t = (P[row * 4 + 0] + P[row * 4 + 1]) + (P[row * 4 + 2] + P[row * 4 + 3]);
            __hip_atomic_store(slots + ((size_t)(u.pm * 256 + row) * 4 + u.pn), t, __ATOMIC_RELAXED, __HIP_MEMORY_SCOPE_AGENT); }
        asm volatile("s_waitcnt vmcnt(0)" ::: "memory");
        if (lane == 0) __hip_atomic_fetch_add(cnt + 64 * u.pm, 1u, __ATOMIC_RELAXED, __HIP_MEMORY_SCOPE_AGENT);
        if (wid == 0) { unsigned sp = 0;
            while ((unsigned)__builtin_amdgcn_readfirstlane(__hip_atomic_load(cnt + 64 * u.pm, __ATOMIC_RELAXED, __HIP_MEMORY_SCOPE_AGENT)) < 32u) { __builtin_amdgcn_s_sleep(2); if (++sp > (1u << 22)) break; }
            __builtin_amdgcn_fence(__ATOMIC_ACQUIRE, "agent"); }
        asm volatile("s_waitcnt vmcnt(0) lgkmcnt(0)" ::: "memory"); __builtin_amdgcn_s_barrier(); asm volatile("" ::: "memory");
        if (lane < 32) { const float* sl = slots + (size_t)(u.pm * 256 + row) * 4; float t = 0.f;
#pragma unroll
            for (int k = 0; k < 4; ++k) t += __hip_atomic_load(sl + k, __ATOMIC_RELAXED, __HIP_MEMORY_SCOPE_AGENT);
            S[row] = rsqrtf(t * (1.f / 1024.f) + EPS); }
        asm volatile("s_waitcnt lgkmcnt(0)" ::: "memory"); __builtin_amdgcn_s_barrier(); asm volatile("" ::: "memory");
        pg8::f32x4 gf[2][2];
#pragma unroll
        for (int bj = 0; bj < 2; ++bj)
#pragma unroll
            for (int n = 0; n < 2; ++n) gf[bj][n] = *(const pg8::f32x4*)(gfin + col0 + bj * 128 + n * 16);
#pragma unroll
        for (int ai = 0; ai < 2; ++ai)
#pragma unroll
            for (int m = 0; m < 4; ++m) { const int r = ai * 128 + wr * 64 + m * 16 + fr; const float rinv = S[r]; const size_t off = (size_t)(u.pm * 256 + r) * 1024 + col0;
#pragma unroll
                for (int bj = 0; bj < 2; ++bj)
#pragma unroll
                    for (int n = 0; n < 2; ++n) *(pg8::f32x4*)(out + off + bj * 128 + n * 16) = acc[ai][bj][m][n] * rinv * gf[bj][n]; }
    }
    DEVI void operator()(const pg8::f32x4 (&)[2][2][4][2], const pg8::Unit&, int, int, int, int) const {}
};
#ifndef FAST_GEMM
#define FAST_GEMM 1
#endif


#define LASP __attribute__((address_space(3)))
__device__ void st_glawalk(const Params& p, int vb, int nvb, unsigned char* lds_, const bf16_t* QIN, const bf16_t* KET, const bf16_t* SC, const float* DEC, const bf16_t* VT, bf16_t* OF, bf16_t* OB) {
    typedef pg8::bf16x8 bx8; typedef pg8::f32x4 f4; typedef unsigned u32x2 __attribute__((ext_vector_type(2))); typedef pg8::u32x4 u4;
    LASP unsigned char* lds = (LASP unsigned char*)lds_;
    constexpr int QOFF = 0, KOFF = 17408, SOFF = KOFF + 18432, VOFF = SOFF + 9216, DOFF = VOFF + 4608, BUFSZ = 50176;
    const int tid = threadIdx.x, wid = __builtin_amdgcn_readfirstlane(tid >> 6), lane = tid & 63, c = lane & 15, g = lane >> 4;
    for (int it0 = vb; it0 < 256; it0 += nvb) {
        const int item = (nvb == 256) ? ((it0 & 7) * 32 + (it0 >> 3)) : it0;
        const int vs = item & 7, combo = item >> 3, d = combo & 1, h = (combo >> 1) & 3, bb = combo >> 3;
        LDS_BARRIER();
        if (wid >= 2) {
            const int lt = tid - 128;
            unsigned long long cst[8]; unsigned mult[8]; int doff[8];
#pragma unroll
            for (int j = 0; j < 8; ++j) { const int pp = lt + 384 * j;
                if (pp < 1024) { cst[j] = (unsigned long long)QIN + (pp >> 4) * 256 + (pp & 15) * 16; mult[j] = 16384u; doff[j] = QOFF + (pp >> 4) * 272 + (pp & 15) * 16; }
                else if (pp < 2048) { const int q = pp - 1024; cst[j] = (unsigned long long)KET + (q >> 3) * 128 + (q & 7) * 16; mult[j] = 16384u; doff[j] = KOFF + (q >> 3) * 144 + (q & 7) * 16; }
                else if (pp < 2560) { const int q = pp - 2048; cst[j] = (unsigned long long)SC + (q >> 3) * 128 + (q & 7) * 16; mult[j] = 8192u; doff[j] = SOFF + (q >> 3) * 144 + (q & 7) * 16; }
                else if (pp < 2816) { const int q = pp - 2560; cst[j] = (unsigned long long)VT + (vs * 32 + (q >> 3)) * 128 + (q & 7) * 16 - (unsigned long long)d * 16384; mult[j] = 16384u; doff[j] = VOFF + (q >> 3) * 144 + (q & 7) * 16; }
                else if (pp < 2848) { const int q = pp - 2816; cst[j] = (unsigned long long)DEC + q * 16; mult[j] = 512u; doff[j] = DOFF + q * 16; }
                else { cst[j] = (unsigned long long)DEC; mult[j] = 0u; doff[j] = -1; } }
            u4 r0[8], r1[8];
#define GW_LOAD(R, step) do { const int cc_ = d == 0 ? ((step) < 4 ? 64 + (step) : (step) - 4) : 67 - (step); const unsigned u_ = (unsigned)(((bb * NCH + cc_) * 4 + h) * 2 + d); \
                _Pragma("unroll") for (int j_ = 0; j_ < 8; ++j_) R[j_] = *(const u4*)(cst[j_] + (unsigned long long)u_ * mult[j_]); } while (0)
#define GW_WRITE(R, bufi) do { LASP unsigned char* b_ = lds + (bufi) * BUFSZ; _Pragma("unroll") for (int j_ = 0; j_ < 8; ++j_) if (doff[j_] >= 0) *(LASP u4*)(b_ + doff[j_]) = R[j_]; } while (0)
            GW_LOAD(r0, 0); GW_WRITE(r0, 0); GW_LOAD(r0, 1); GW_LOAD(r1, 2);
            LDS_BARRIER();
            for (int step = 0; step < NCH; step += 2) {
                GW_WRITE(r0, 1); if (step + 3 < NCH) GW_LOAD(r0, step + 3);
                LDS_BARRIER();
                if (step + 2 < NCH) { GW_WRITE(r1, 0); if (step + 4 < NCH) GW_LOAD(r1, step + 4); }
                LDS_BARRIER();
            }
#undef GW_LOAD
#undef GW_WRITE
        } else {
            f4 S[8];
#pragma unroll
            for (int m = 0; m < 8; ++m) S[m] = (f4){0.f, 0.f, 0.f, 0.f};
            bf16_t* O = d == 0 ? OF : OB;
            LDS_BARRIER();
            for (int step = 0; step < NCH; ++step) {
                const LASP unsigned char* B = lds + (step & 1) * BUFSZ;
#define SB0() __builtin_amdgcn_sched_barrier(0)
#define RDQ(dst_lo, dst_hi, ks) do { _Pragma("unroll") for (int mt = 0; mt < 4; ++mt) { const LASP unsigned char* qa = B + QOFF + (16 * mt + c) * 272 + (32 * (ks) + 4 * g) * 2; dst_lo[mt] = *(const LASP u32x2*)qa; dst_hi[mt] = *(const LASP u32x2*)(qa + 32); } } while (0)
#define MMQ(lo, hi, ks) do { _Pragma("unroll") for (int mt = 0; mt < 4; ++mt) { u4 w; w.x = lo[mt].x; w.y = lo[mt].y; w.z = hi[mt].x; w.w = hi[mt].y; o[mt] = __builtin_amdgcn_mfma_f32_16x16x32_bf16(sB[ks], __builtin_bit_cast(bx8, w), o[mt], 0, 0, 0); } } while (0)
#define RDK(kf, dv, m0) do { _Pragma("unroll") for (int mm = 0; mm < 4; ++mm) { const LASP unsigned char* ka = B + KOFF + (16 * ((m0) + mm) + c) * 144 + g * 16; kf[mm][0] = *(const LASP bx8*)ka; kf[mm][1] = *(const LASP bx8*)(ka + 64); dv[mm] = *(const LASP f4*)(B + DOFF + (16 * ((m0) + mm) + 4 * g) * 4); } } while (0)
#define MMK(kf, dv, m0) do { _Pragma("unroll") for (int mm = 0; mm < 4; ++mm) { S[(m0) + mm] = S[(m0) + mm] * dv[mm]; S[(m0) + mm] = __builtin_amdgcn_mfma_f32_16x16x32_bf16(kf[mm][0], bv0, S[(m0) + mm], 0, 0, 0); S[(m0) + mm] = __builtin_amdgcn_mfma_f32_16x16x32_bf16(kf[mm][1], bv1, S[(m0) + mm], 0, 0, 0); } } while (0)
                const bx8 bv0 = *(const LASP bx8*)(B + VOFF + (16 * wid + c) * 144 + g * 16), bv1 = *(const LASP bx8*)(B + VOFF + (16 * wid + c) * 144 + 64 + g * 16);
                u32x2 qa_lo[4], qa_hi[4], qb_lo[4], qb_hi[4];
                RDQ(qa_lo, qa_hi, 0); RDQ(qb_lo, qb_hi, 1);
                bx8 sB[4];
#pragma unroll
                for (int ks = 0; ks < 4; ++ks) { u4 w; w.x = pg8::cvt_pk_bf16(S[2 * ks][0], S[2 * ks][1]); w.y = pg8::cvt_pk_bf16(S[2 * ks][2], S[2 * ks][3]);
                    w.z = pg8::cvt_pk_bf16(S[2 * ks + 1][0], S[2 * ks + 1][1]); w.w = pg8::cvt_pk_bf16(S[2 * ks + 1][2], S[2 * ks + 1][3]); sB[ks] = __builtin_bit_cast(bx8, w); }
                f4 o[4];
#pragma unroll
                for (int mt = 0; mt < 4; ++mt) o[mt] = (f4){0.f, 0.f, 0.f, 0.f};
                SB0();
                MMQ(qa_lo, qa_hi, 0); SB0();
                RDQ(qa_lo, qa_hi, 2); SB0();
                MMQ(qb_lo, qb_hi, 1); SB0();
                RDQ(qb_lo, qb_hi, 3); SB0();
                MMQ(qa_lo, qa_hi, 2); SB0();
                bx8 sf[4][2];
#pragma unroll
                for (int mt = 0; mt < 4; ++mt) { const LASP unsigned char* sa = B + SOFF + (16 * mt + c) * 144 + g * 16; sf[mt][0] = *(const LASP bx8*)sa; sf[mt][1] = *(const LASP bx8*)(sa + 64); }
                SB0();
                MMQ(qb_lo, qb_hi, 3); SB0();
                bx8 kfa[4][2], kfb[4][2]; f4 dva[4], dvb[4];
                RDK(kfa, dva, 0); SB0();
#pragma unroll
                for (int mt = 0; mt < 4; ++mt) { o[mt] = __builtin_amdgcn_mfma_f32_16x16x32_bf16(bv0, sf[mt][0], o[mt], 0, 0, 0); o[mt] = __builtin_amdgcn_mfma_f32_16x16x32_bf16(bv1, sf[mt][1], o[mt], 0, 0, 0); }
                SB0();
                RDK(kfb, dvb, 4); SB0();
                MMK(kfa, dva, 0); SB0();
                MMK(kfb, dvb, 4); SB0();
#undef SB0
#undef RDQ
#undef MMQ
#undef RDK
#undef MMK
                const int cc = d == 0 ? (step < 4 ? 64 + step : step - 4) : 67 - step; const int row0 = row_of(bb, cc, 0);
#pragma unroll
                for (int mt = 0; mt < 4; ++mt) { u32x2 w; w.x = pg8::cvt_pk_bf16(o[mt][0], o[mt][1]); w.y = pg8::cvt_pk_bf16(o[mt][2], o[mt][3]);
                    *(u32x2*)(O + (size_t)(row0 + 16 * mt + c) * 1024 + h * 256 + vs * 32 + 16 * wid + 4 * g) = w; }
                LDS_BARRIER();
            }
        }
    }
}
#ifndef FAST_WALK
#define FAST_WALK 1
#endif

template <int MODE, int DIR>
__device__ __forceinline__ void st_rglru_impl(const Params& p, int vb, int nvb, unsigned char* lds_, const bf16_t* XR, const bf16_t* SG, const bf16_t* BD, float* SUMA, float* SUMH, bf16_t* Y) {
    typedef pg8::bf16x8 bx8; typedef pg8::f32x4 f4; typedef float f32x2v __attribute__((ext_vector_type(2)));
    LASP unsigned char* lds = (LASP unsigned char*)lds_;
    constexpr int AOFF = 0, FOFF = 17408, BUF = 51200, CWOFF = 2 * BUF;
    constexpr int ND = MODE == 0 ? 1 : 2, NCOMBO = MODE == 0 ? 32 : 16, NTILE = MODE == 0 ? NB * NCH : NB * 64;
    const int tid = threadIdx.x, wid = __builtin_amdgcn_readfirstlane(tid >> 6), lane = tid & 63, c = lane & 15, g = lane >> 4, cp = tid & 63, tg = tid >> 6;
    int P, part, cstep, combo0;
    if (nvb >= NCOMBO) { P = nvb / NCOMBO; part = vb / NCOMBO; cstep = NCOMBO; combo0 = vb % NCOMBO; if (part >= P) return; } else { P = 1; part = 0; cstep = nvb; combo0 = vb; }
    for (int combo = combo0; combo < NCOMBO; combo += cstep) {
        if (MODE == 0 && (combo & 1) != DIR) continue;
        const int nb = MODE == 0 ? (combo >> 1) : combo; constexpr int d0 = MODE == 0 ? DIR : 0;
        const int ch = nb * 128 + 16 * wid + c;
        bx8 wa[ND][4], wx[ND][4]; float ba[ND], bxx[ND], k8[ND];
        LDS_BARRIER();
#pragma unroll
        for (int dd = 0; dd < ND; ++dd) { constexpr int dzero = d0; const int d = dzero + dd;
            const bf16_t* wA = BD + ((size_t)(d * 16 + nb) * 128 + 16 * wid + c) * 128 + 8 * g; const bf16_t* wX = wA + (size_t)2 * 16 * 128 * 128;
#pragma unroll
            for (int ks = 0; ks < 4; ++ks) { wa[dd][ks] = *(const bx8*)(wA + 32 * ks); wx[dd][ks] = *(const bx8*)(wX + 32 * ks); }
            ba[dd] = p.o_b_a[d * 2048 + ch]; bxx[dd] = p.o_b_x[d * 2048 + ch]; k8[dd] = 8.f * 1.4426950408889634f * softplusf_(-p.o_lam[d * 2048 + ch]);
            if (tg < 5) { const f32x2v w2 = tg < 4 ? *(const f32x2v*)(p.o_conv_w + ((size_t)d * 4 + tg) * 2048 + nb * 128 + 2 * cp) : *(const f32x2v*)(p.o_conv_b + (size_t)d * 2048 + nb * 128 + 2 * cp);
                *(LASP f32x2v*)(lds + CWOFF + ((dd * 5 + tg) * 128 + 2 * cp) * 4) = w2; } }
        LDS_BARRIER();
        unsigned xr[14]; float cnext[2] = {0.f, 0.f};
#pragma unroll
        for (int jr = 0; jr < 14; ++jr) xr[jr] = 0u;
#define RG_PREF(tile) do { const int bb_ = MODE == 0 ? (tile) / NCH : (tile) >> 6, cc_ = MODE == 0 ? (tile) % NCH : (tile) & 63; const int row0_ = row_of(bb_, cc_, 0); \
            const bf16_t* xp_ = XR + (size_t)(row0_ + xr_pad_of_tile(row0_ >> 8) + 8 * tg - 3) * 2048 + nb * 128 + 2 * cp; \
            _Pragma("unroll") for (int jr = 0; jr < 14; ++jr) { if (MODE == 1 || (d0 == 0 ? jr < 11 : jr >= 3)) xr[jr] = *(const unsigned*)(xp_ + (size_t)jr * 2048); } \
            if (MODE == 1) { cnext[0] = SUMH[(((size_t)bb_ * 2 + 0) * NCH + cc_) * 2048 + ch]; cnext[1] = SUMH[(((size_t)bb_ * 2 + 1) * NCH + cc_) * 2048 + ch]; } } while (0)
        int it = 0;
        if (part < NTILE) RG_PREF(part);
        for (int tile = part; tile < NTILE; tile += P) {
            const int bb = MODE == 0 ? tile / NCH : tile >> 6, cc = MODE == 0 ? tile % NCH : tile & 63; const int row0 = row_of(bb, cc, 0);
            unsigned xcur[14]; float ccur[2];
#pragma unroll
            for (int jr = 0; jr < 14; ++jr) xcur[jr] = xr[jr];
            ccur[0] = cnext[0]; ccur[1] = cnext[1];
            if (tile + P < NTILE) RG_PREF(tile + P);
            float hsum[4][4];
#pragma unroll
            for (int dd = 0; dd < ND; ++dd) { constexpr int dzero = d0; const int d = dzero + dd;
                LASP unsigned char* B = lds + (it & 1) * BUF; ++it;
                { f32x2v cv[8]; const f32x2v cbv = *(const LASP f32x2v*)(lds + CWOFF + ((dd * 5 + 4) * 128 + 2 * cp) * 4);
#pragma unroll
                  for (int i = 0; i < 8; ++i) cv[i] = cbv;
#pragma unroll
                  for (int jj = 0; jj < 4; ++jj) { const f32x2v cwv = *(const LASP f32x2v*)(lds + CWOFF + ((dd * 5 + jj) * 128 + 2 * cp) * 4);
#pragma unroll
                      for (int i = 0; i < 8; ++i) { const int jr = d == 0 ? i + jj : i + 6 - jj; cv[i].x += cwv.x * __uint_as_float(xcur[jr] << 16); cv[i].y += cwv.y * __uint_as_float(xcur[jr] & 0xffff0000u); } }
#pragma unroll
                  for (int i = 0; i < 8; ++i) { const int rho = 16 * (2 * (tg & 1) + (i >> 2)) + 4 * (tg >> 1) + (i & 3);
                      *(LASP unsigned*)(B + AOFF + rho * 272 + 4 * cp) = pg8::cvt_pk_bf16(cv[i].x, cv[i].y); *(LASP f32x2v*)(B + FOFF + rho * 528 + 8 * cp) = cv[i]; } }
                LDS_BARRIER();
                const int gl = d == 0 ? g : 3 - g;
                const int src1 = d == 0 ? lane - 16 : lane + 16, src2 = d == 0 ? lane - 32 : lane + 32, srcT = d == 0 ? 48 + c : c;
                const size_t sidx = (((size_t)bb * 2 + d) * NCH + cc) * 2048 + ch;
                float av[16], uv[16]; float pa = 1.f, lh = 0.f;
#pragma unroll
                for (int mtl = 0; mtl < 4; ++mtl) { const int mt = d == 0 ? mtl : 3 - mtl;
                    f4 aam = (f4){0.f, 0.f, 0.f, 0.f}, axm = (f4){0.f, 0.f, 0.f, 0.f};
#pragma unroll
                    for (int ks = 0; ks < 4; ++ks) { const bx8 af = *(const LASP bx8*)(B + AOFF + (16 * mt + c) * 272 + (32 * ks + 8 * g) * 2);
                        aam = __builtin_amdgcn_mfma_f32_16x16x32_bf16(af, wa[dd][ks], aam, 0, 0, 0); axm = __builtin_amdgcn_mfma_f32_16x16x32_bf16(af, wx[dd][ks], axm, 0, 0, 0); }
#pragma unroll
                    for (int sq = 0; sq < 4; ++sq) { const int r = d == 0 ? sq : 3 - sq;
                        const float xv = *(const LASP float*)(B + FOFF + (16 * mt + 4 * g + r) * 528 + (16 * wid + c) * 4);
                        const float rr = sigmoidf_(aam[r] + ba[dd]), ii = sigmoidf_(axm[r] + bxx[dd]);
                        const float a = fexp2_(-k8[dd] * rr), u = __builtin_amdgcn_sqrtf(fmaxf(1.f - a * a, 0.f)) * (ii * xv);
                        lh = a * lh + u; pa *= a; if (MODE == 1) { av[mt * 4 + r] = a; uv[mt * 4 + r] = u; } }
                }
                float XA = pa, XU = lh, tA, tU;
                tA = __shfl(XA, src1); tU = __shfl(XU, src1); if (gl >= 1) { XU = tU * XA + XU; XA = tA * XA; }
                tA = __shfl(XA, src2); tU = __shfl(XU, src2); if (gl >= 2) { XU = tU * XA + XU; XA = tA * XA; }
                if (MODE == 0) { if (gl == 3) { SUMA[sidx] = XA; SUMH[sidx] = XU; } }
                else {
                    float eA = __shfl(XA, src1), eU = __shfl(XU, src1); if (gl == 0) { eA = 1.f; eU = 0.f; }
                    float hh = ccur[dd] * eA + eU;
#pragma unroll
                    for (int mtl = 0; mtl < 4; ++mtl) { const int mt = d == 0 ? mtl : 3 - mtl;
#pragma unroll
                        for (int sq = 0; sq < 4; ++sq) { const int r = d == 0 ? sq : 3 - sq; hh = av[mt * 4 + r] * hh + uv[mt * 4 + r]; if (dd == 0) hsum[mt][r] = hh; else hsum[mt][r] += hh; } }
                }
            }
            if (MODE == 1) {
#pragma unroll
                for (int mt = 0; mt < 4; ++mt)
#pragma unroll
                    for (int r = 0; r < 4; ++r) { const size_t o = (size_t)(row0 + 16 * g + 4 * mt + r) * 2048 + ch; Y[o] = f2bf(hsum[mt][r] * bf2f(SG[o])); }
            }
        }
        LDS_BARRIER();
#undef RG_PREF
    }
}
template <int MODE>
__device__ __forceinline__ void st_rglru(const Params& p, int vb, int nvb, unsigned char* lds_, const bf16_t* XR, const bf16_t* SG, const bf16_t* BD, float* SUMA, float* SUMH, bf16_t* Y) {
    if (MODE == 1) { st_rglru_impl<1, 0>(p, vb, nvb, lds_, XR, SG, BD, SUMA, SUMH, Y); return; }
    const int combo0 = nvb >= 32 ? vb % 32 : vb;
    if (nvb >= 32) { if ((combo0 & 1) == 0) st_rglru_impl<0, 0>(p, vb, nvb, lds_, XR, SG, BD, SUMA, SUMH, Y); else st_rglru_impl<0, 1>(p, vb, nvb, lds_, XR, SG, BD, SUMA, SUMH, Y); }
    else { st_rglru_impl<0, 0>(p, vb, nvb, lds_, XR, SG, BD, SUMA, SUMH, Y); st_rglru_impl<0, 1>(p, vb, nvb, lds_, XR, SG, BD, SUMA, SUMH, Y); }
}
#ifndef FAST_RG
#define FAST_RG 1
#endif


template <int WD>
__device__ __forceinline__ void rg1p_body(const Params& p, LASP unsigned char* lds, const bf16_t* XR, bf16_t* SGY, bf16_t* HXh, const bf16_t* BD, int bb, int nb, int sl) {
    typedef pg8::bf16x8 bx8; typedef pg8::f32x4 f4; typedef float f32x2v __attribute__((ext_vector_type(2)));
    constexpr int A0 = 0, A1 = 17408, CWOFF = 34816, EXOFF = CWOFF + 5120;
    const int tid = threadIdx.x, wid = __builtin_amdgcn_readfirstlane(tid >> 6), lane = tid & 63, c = lane & 15, g = lane >> 4, cp = lane, tg = wid;
    const int nt = (wid >> 1) & 1, hf = wid & 1;
    const int jch = sl * 32 + nt * 16 + c, ch = nb * 128 + jch;
    bx8 wa[4], wx[4];
    { const bf16_t* wA = BD + ((size_t)(WD * 16 + nb) * 128 + jch) * 128 + 8 * g; const bf16_t* wX = wA + (size_t)2 * 16 * 128 * 128;
#pragma unroll
      for (int ks = 0; ks < 4; ++ks) { wa[ks] = *(const bx8*)(wA + 32 * ks); wx[ks] = *(const bx8*)(wX + 32 * ks); } }
    const float ba = p.o_b_a[WD * 2048 + ch], bxx = p.o_b_x[WD * 2048 + ch], k8 = 8.f * 1.4426950408889634f * softplusf_(-p.o_lam[WD * 2048 + ch]);
    LDS_BARRIER();
#pragma unroll
    for (int dd = 0; dd < 2; ++dd)
        if (tg < 5) { const f32x2v w2 = tg < 4 ? *(const f32x2v*)(p.o_conv_w + ((size_t)dd * 4 + tg) * 2048 + nb * 128 + 2 * cp) : *(const f32x2v*)(p.o_conv_b + (size_t)dd * 2048 + nb * 128 + 2 * cp);
            *(LASP f32x2v*)(lds + CWOFF + ((dd * 5 + tg) * 128 + 2 * cp) * 4) = w2; }
    LDS_BARRIER();
    unsigned xr[22];
#define RG_CH(dd, step) ((dd) == 0 ? ((step) < 4 ? 64 + (step) : (step) - 4) : 67 - (step))
#define RG_PREF(step) do { _Pragma("unroll") for (int dd = 0; dd < 2; ++dd) { const int row0_ = row_of(bb, RG_CH(dd, step), 0); \
            const unsigned char* ub_ = (const unsigned char*)(XR + (size_t)(row0_ + xr_pad_of_tile(row0_ >> 8) + 8 * tg - 3 + 3 * dd) * 2048 + nb * 128);     \
            _Pragma("unroll") for (int j = 0; j < 11; ++j) xr[dd * 11 + j] = *(const unsigned*)(ub_ + (size_t)j * 4096 + (unsigned)(4 * cp)); } } while (0)
#ifndef REP_RG
#define REP_RG 0
#endif
  for (int rep_ = 0; rep_ <= REP_RG; ++rep_) {
    const bool dry = rep_ < REP_RG;
    RG_PREF(0);
    float carry = 0.f;
    const int gl = WD == 0 ? g : 3 - g;
    const int src1 = WD == 0 ? lane - 16 : lane + 16, src2 = WD == 0 ? lane - 32 : lane + 32, srcT = WD == 0 ? 48 + c : c;
    const bool amfirst = (hf == WD);
    for (int step = 0; step < NCH; ++step) {
        asm volatile("s_waitcnt vmcnt(0)" ::: "memory");
#pragma unroll
        for (int dd = 0; dd < 2; ++dd) {
            f32x2v cv[8], cw4[4]; const f32x2v cbv = *(const LASP f32x2v*)(lds + CWOFF + ((dd * 5 + 4) * 128 + 2 * cp) * 4);
#pragma unroll
            for (int jj = 0; jj < 4; ++jj) cw4[jj] = *(const LASP f32x2v*)(lds + CWOFF + ((dd * 5 + jj) * 128 + 2 * cp) * 4);
#pragma unroll
            for (int i = 0; i < 8; ++i) cv[i] = cbv;
#pragma unroll
            for (int jx = 0; jx < 11; ++jx) { const unsigned xw = xr[dd * 11 + jx]; const f32x2v xv2 = (f32x2v){__uint_as_float(xw << 16), __uint_as_float(xw & 0xffff0000u)};
#pragma unroll
                for (int jj = 0; jj < 4; ++jj) { const int i = dd == 0 ? jx - jj : jx - 3 + jj; if (i >= 0 && i < 8) cv[i] = __builtin_elementwise_fma(cw4[jj], xv2, cv[i]); } }
#pragma unroll
            for (int i = 0; i < 8; ++i) { const int rho = 32 * (tg >> 2) + 16 * (i >> 2) + 4 * (tg & 3) + (i & 3);
                *(LASP unsigned*)(lds + (dd == 0 ? A0 : A1) + rho * 272 + 4 * cp) = pg8::cvt_pk_bf16(cv[i].x, cv[i].y); }
        }
        LDS_BARRIER();
        if (step + 1 < NCH) RG_PREF(step + 1);
        const int cc = RG_CH(WD, step); const bool latent = cc < 64 && !dry, second = step - 4 > 31;
        const size_t orow = (size_t)row_of(bb, cc, 0) + 32 * hf + 8 * g;
        unsigned short hxv[8], sgv[8];
        if (latent && second) {
#pragma unroll
            for (int e = 0; e < 8; ++e) { hxv[e] = HXh[(orow + e) * 1024 + (ch & 1023)]; sgv[e] = SGY[(orow + e) * 2048 + ch]; } }
        const LASP unsigned char* A = lds + (WD == 0 ? A0 : A1);
        float av[8], uv[8]; float pa = 1.f, lh = 0.f;
#pragma unroll
        for (int ml = 0; ml < 2; ++ml) { const int mt = WD == 0 ? ml : 1 - ml;
            f4 aam = (f4){0.f, 0.f, 0.f, 0.f}, axm = (f4){0.f, 0.f, 0.f, 0.f};
#pragma unroll
            for (int ks = 0; ks < 4; ++ks) { const bx8 af = *(const LASP bx8*)(A + (32 * hf + 16 * mt + c) * 272 + (32 * ks + 8 * g) * 2);
                aam = __builtin_amdgcn_mfma_f32_16x16x32_bf16(af, wa[ks], aam, 0, 0, 0); axm = __builtin_amdgcn_mfma_f32_16x16x32_bf16(af, wx[ks], axm, 0, 0, 0); }
#pragma unroll
            for (int sq = 0; sq < 4; ++sq) { const int r = WD == 0 ? sq : 3 - sq;
                const float xv = bf2f(*(const LASP unsigned short*)(A + (32 * hf + 16 * mt + 4 * g + r) * 272 + jch * 2));
                const float rr = sigmoidf_(aam[r] + ba), ii = sigmoidf_(axm[r] + bxx);
                const float a = fexp2_(-k8 * rr), u = __builtin_amdgcn_sqrtf(fmaxf(1.f - a * a, 0.f)) * (ii * xv);
                lh = a * lh + u; pa *= a; av[mt * 4 + r] = a; uv[mt * 4 + r] = u; }
        }
        float XA = pa, XU = lh, tA, tU;
        tA = __shfl(XA, src1); tU = __shfl(XU, src1); if (gl >= 1) { XU = tU * XA + XU; XA = tA * XA; }
        tA = __shfl(XA, src2); tU = __shfl(XU, src2); if (gl >= 2) { XU = tU * XA + XU; XA = tA * XA; }
        float eA = __shfl(XA, src1), eU = __shfl(XU, src1); if (gl == 0) { eA = 1.f; eU = 0.f; }
        const float myA = __shfl(XA, srcT), myU = __shfl(XU, srcT);
        if (gl == 3) *(LASP f32x2v*)(lds + EXOFF + (((WD * 2 + nt) * 2 + hf) * 16 + c) * 8) = (f32x2v){XA, XU};
        LDS_BARRIER();
        const f32x2v oth = *(const LASP f32x2v*)(lds + EXOFF + (((WD * 2 + nt) * 2 + (1 - hf)) * 16 + c) * 8);
        const float hin_half = amfirst ? carry : carry * oth.x + oth.y;
        carry = amfirst ? (carry * myA + myU) * oth.x + oth.y : (carry * oth.x + oth.y) * myA + myU;
        if (latent) {
            float hh = hin_half * eA + eU;
#pragma unroll
            for (int ml = 0; ml < 2; ++ml) { const int mt = WD == 0 ? ml : 1 - ml;
#pragma unroll
                for (int sq = 0; sq < 4; ++sq) { const int r = WD == 0 ? sq : 3 - sq; const int e = mt * 4 + r; hh = av[e] * hh + uv[e];
                    const bf16_t hb = f2bf(hh);
                    if (!second) HXh[(orow + e) * 1024 + (ch & 1023)] = hb;
                    else SGY[(orow + e) * 2048 + ch] = f2bf((bf2f(hb) + bf2f(hxv[e])) * bf2f(sgv[e])); } }
        }
    }
    asm volatile("" :: "v"(carry));
    LDS_BARRIER();
  }
#undef RG_PREF
#undef RG_CH
}
__device__ __forceinline__ void st_rg1p(const Params& p, int vb, int nvb, unsigned char* lds_, const bf16_t* XR, bf16_t* SGY, bf16_t* HX0, bf16_t* HX1, const bf16_t* BD, const float* XRC) {
    LASP unsigned char* lds = (LASP unsigned char*)lds_;
    const int wid = __builtin_amdgcn_readfirstlane(threadIdx.x >> 6);
    for (int it0 = vb; it0 < 256; it0 += nvb) {
        const int item = (nvb == 256) ? ((it0 & 7) * 32 + (it0 >> 3)) : it0;
        const int sl = item & 3, nb = (item >> 2) & 15, bb = item >> 6;
        bf16_t* HXh = nb < 8 ? HX0 : HX1;
        {
          bf16_t* xd = (bf16_t*)XR + (size_t)(NLAT + bb * 256 + 20 + 4 * bb) * 2048 + nb * 128; const float* xs = XRC + (size_t)(bb * 256) * 2048 + nb * 128;
          for (int e = threadIdx.x; e < 256 * 64; e += NTHREADS) { const int r = e >> 6, cpair = e & 63; const float2 v0 = *(const float2*)(xs + (size_t)r * 2048 + 2 * cpair), v1 = *(const float2*)(xs + (size_t)NCTX * 2048 + (size_t)r * 2048 + 2 * cpair); *(unsigned*)(xd + (size_t)r * 2048 + 2 * cpair) = pg8::cvt_pk_bf16(v0.x + v1.x, v0.y + v1.y); }
          asm volatile("s_waitcnt vmcnt(0)" ::: "memory"); LDS_BARRIER(); }
        if (wid < 4) rg1p_body<0>(p, lds, XR, SGY, HXh, BD, bb, nb, sl); else rg1p_body<1>(p, lds, XR, SGY, HXh, BD, bb, nb, sl);
    }
}
#define XB_TMO      128
#define XB_XCNT(j)  (256  + 64 * (j))
#define XB_XSUB(j)  (1280 + 64 * (j))
#define XB_XGEN(j)  (2304 + 64 * (j))
#define XB_TOP      3328
#define XB_TOPGEN   3392
#define XB_SPIN_CAP (1u << 20)
DEVI unsigned xb_ld(unsigned* p)              { return __hip_atomic_load(p, __ATOMIC_RELAXED, __HIP_MEMORY_SCOPE_AGENT); }
DEVI unsigned xb_add(unsigned* p, unsigned v) { return __hip_atomic_fetch_add(p, v, __ATOMIC_RELAXED, __HIP_MEMORY_SCOPE_AGENT); }
DEVI unsigned xb_xcc_id() { return (unsigned)__builtin_amdgcn_s_getreg((3 << 11) | 20) & 0xFu; }
#define XB_SPIN(cond, bar) do { unsigned _sp = 0; while (cond) { __builtin_amdgcn_s_sleep(1); \
    if ((++_sp & 255u) == 0u) { if (xb_ld(&(bar)[XB_TMO])) break; if (_sp > XB_SPIN_CAP) { atomicAdd(&(bar)[XB_TMO], 1u); break; } } } } while (0)
struct XcdBarrier { unsigned* bar; unsigned x; volatile __attribute__((address_space(3))) unsigned* st; };
DEVI XcdBarrier xcd_barrier_post(unsigned* bar, volatile __attribute__((address_space(3))) unsigned* st) {
    XcdBarrier b; b.bar = bar; b.x = xb_xcc_id(); b.st = st;
    if (threadIdx.x == 0) (void)xb_add(&bar[XB_XCNT(b.x)], 1u);
    return b;
}
DEVI void xcd_barrier_complete(unsigned* bar, unsigned x, unsigned& nloc, unsigned& nx) {
    const unsigned G = gridDim.x * gridDim.y * gridDim.z;
    unsigned sum, cnt, mine, sp = 0u;
    for (;;) {
        sum = 0u; cnt = 0u; mine = 0u;
#pragma unroll
        for (unsigned j = 0; j < 16; ++j) { const unsigned c = xb_ld(&bar[XB_XCNT(j)]); sum += c; cnt += (c > 0u) ? 1u : 0u; mine = (j == x) ? c : mine; }
        if (sum == G) break;
        __builtin_amdgcn_s_sleep(1);
        if ((++sp & 255u) == 0u) { if (xb_ld(&bar[XB_TMO])) break; if (sp > XB_SPIN_CAP) { atomicAdd(&bar[XB_TMO], 1u); break; } }
    }
    nloc = mine > 0u ? mine : 1u; nx = cnt > 0u ? cnt : 1u;
}
DEVI void xcd_barrier(const XcdBarrier& b) {
    asm volatile("s_waitcnt vmcnt(0)" ::: "memory");
    __syncthreads();
    if (threadIdx.x == 0) {
        unsigned* bar = b.bar;
        __builtin_amdgcn_s_waitcnt(0);
        unsigned nloc = b.st[0], nx = b.st[1];
        if (nloc == 0u) { xcd_barrier_complete(bar, b.x, nloc, nx); b.st[0] = nloc; b.st[1] = nx; }
        const unsigned old = xb_add(&bar[XB_XSUB(b.x)], 1u);
        const unsigned gen = old / nloc;
        if (old + 1u == (gen + 1u) * nloc) {
            __builtin_amdgcn_fence(__ATOMIC_RELEASE, "agent");
            asm volatile("s_waitcnt vmcnt(0)" ::: "memory");
            const unsigned og = xb_add(&bar[XB_TOP], 1u);
            const unsigned tg = og / nx;
            if (og + 1u == (tg + 1u) * nx) xb_add(&bar[XB_TOPGEN], 1u);
            else XB_SPIN(xb_ld(&bar[XB_TOPGEN]) == tg, bar);
            __builtin_amdgcn_fence(__ATOMIC_ACQUIRE, "agent");
            xb_add(&bar[XB_XGEN(b.x)], 1u);
            asm volatile("s_waitcnt vmcnt(0)" ::: "memory");
        } else {
            XB_SPIN(xb_ld(&bar[XB_XGEN(b.x)]) == gen, bar);
            __builtin_amdgcn_fence(__ATOMIC_ACQUIRE, "agent");
            asm volatile("s_waitcnt vmcnt(0)" ::: "memory");
        }
    }
    __syncthreads();
}
__device__ __forceinline__ void run_stage(const Params& p, int st, int vb, int nvb, unsigned char* lds) {
    unsigned char* ws = p.ws;
    float* MOD = (float*)(ws + WS_MOD); float* ALR = (float*)(ws + WS_ALR); float* X1C = (float*)(ws + WS_X1C);
    float* SUMA = (float*)(ws + WS_SUMA); float* SUMH = (float*)(ws + WS_SUMH); float* DEC = (float*)(ws + WS_DEC);
    bf16_t* Bt1 = (bf16_t*)(ws + WS_BT1); bf16_t* Bt2 = (bf16_t*)(ws + WS_BT2); bf16_t* Bt3 = (bf16_t*)(ws + WS_BT3); bf16_t* Bt4 = (bf16_t*)(ws + WS_BT4);
    bf16_t* S0 = (bf16_t*)(ws + WS_SLOT(0)); bf16_t* S1 = (bf16_t*)(ws + WS_SLOT(1)); bf16_t* S2 = (bf16_t*)(ws + WS_SLOT(2));
    bf16_t* S3 = (bf16_t*)(ws + WS_SLOT(3)); bf16_t* S4 = (bf16_t*)(ws + WS_SLOT(4)); bf16_t* S5 = (bf16_t*)(ws + WS_SLOT(5));
    bf16_t* DO0 = (bf16_t*)p.out; bf16_t* DOSC = (bf16_t*)((unsigned char*)p.out + 34 * MiB); bf16_t* DOZA = (bf16_t*)((unsigned char*)p.out + 51 * MiB);
    float* XRC = (float*)(ws + WS_BT1);
    float* SLAB2 = (float*)(ws + WS_SLOT(5) + 262144);
    switch (st) {
    case 0: st_mod(p, vb, nvb, (float*)lds); st_wprep(p, vb, nvb, lds); break;
    case 1: st_modulate(p, vb, nvb, 0, p.x, p.ctx, S0); break;
    case 3: st_glaprep(p, vb, nvb, lds, S1, S2, ALR, S3, S4, DOSC, DEC, S5); break;
#if FAST_WALK
    case 4: st_glawalk(p, vb, nvb, lds, S3, S4, DOSC, DEC, S5, S2, DO0); break;
#else
    case 4: st_glawalk_naive(p, vb, nvb, (float*)lds, S3, S4, DOSC, DEC, S5, S2, DO0); break;
#endif
    case 6: st_inner(p, vb, nvb, S2, DO0, S3, S4, S5, S0, DOZA, X1C); break;
    case 8: st_modulate(p, vb, nvb, 1, p.out, p.ctx, S2, SLAB2, 8, MOD + 4 * 3072 + 2048);
            {
              for (int e = vb * NTHREADS + threadIdx.x; e < 9 * 4 * 256; e += nvb * NTHREADS) { const int gi = e >> 10, w = e & 1023; const int r0 = gi < 4 ? 4096 * gi + 4 * gi : (gi < 8 ? NLAT + 16 + 256 * (gi - 4) + 4 * (gi - 4) : NT + 32);
                  *(uint4*)(S3 + (size_t)r0 * 2048 + w * 8) = uint4{0u, 0u, 0u, 0u}; } }
            break;
    case 10: st_rg1p(p, vb, nvb, lds, S3, S0, S2, S5 + 131072, (const bf16_t*)(ws + WS_BD), XRC); break;
    case 14: if (nvb != 256) st_final(p, vb, nvb); break;
#if FAST_GEMM
    case 2: { FEpi1 E{S1, S2, S3, S4, S5, ALR, DOZA}; pg8::Gemm g{S0, Bt1, NT, N1, 1024}; pg8::TileOrder S; S.init(NT / 256, 11, 16, nvb, vb, 0, 8, 0, 12);
              pg8::gemm_phase<FEpi1, pg8::TileOrder, true, true>((PG8_LAS unsigned char*)lds, g, S, E); } break;
    case 5: { FEpi1 E{S1, S2, S3, S4, S5, ALR, DOZA}; pg8::Gemm g{S0, Bt1, NT, N1, 1024}; pg8::TileOrder S; S.init(NT / 256, 18, 16, nvb, vb, 0, 4, 8, 15);
              pg8::gemm_phase<FEpi1, pg8::TileOrder, true, true>((PG8_LAS unsigned char*)lds, g, S, E); } break;
    case 7: { FEpiRes<true> E{p.x, p.ctx, p.out, SLAB2, MOD}; pg8::Gemm g{S0, Bt2, NT, 1024, 2048}; pg8::TileOrder S; S.init(NLAT / 256, 4, 32, nvb, vb, 0, 1 << 30, 0, 0, NCTX / 256, 4, NLAT / 256, 8, 4);
              pg8::gemm_phase<FEpiRes<true>, pg8::TileOrder, true, true>((PG8_LAS unsigned char*)lds, g, S, E); } break;
    case 9: { FEpi3 E{S3, S0, XRC}; pg8::Gemm g{S2, Bt3, NT, 4096, 1024}; pg8::TileOrder S; S.init(NLAT / 256, 16, 16, nvb, vb, 0, 1 << 30, 0, 0, NCTX / 256, 8, NLAT / 256, 2, 8);
              pg8::gemm_phase<FEpi3, pg8::TileOrder, true, true>((PG8_LAS unsigned char*)lds, g, S, E); } break;
    case 13: if (nvb == 256) { FEpiResRms E{p.out, p.out, MOD + 5 * 3072, p.final_g, (float*)(ws + WS_CTL + 131072), (unsigned*)(ws + WS_CTL + 65536)}; pg8::Gemm g{S0, Bt4, NLAT, 1024, 2048}; pg8::TileOrder S; S.init(NLAT / 256, 4, 32, nvb, vb);
                  pg8::gemm_phase<FEpiResRms, pg8::TileOrder, false, true>((PG8_LAS unsigned char*)lds, g, S, E); }
             else { FEpiRes<false> E{p.out, nullptr, p.out, nullptr, MOD + 5 * 3072}; pg8::Gemm g{S0, Bt4, NLAT, 1024, 2048}; pg8::TileOrder S; S.init(NLAT / 256, 4, 32, nvb, vb);
                  pg8::gemm_phase<FEpiRes<false>, pg8::TileOrder, true, true>((PG8_LAS unsigned char*)lds, g, S, E); } break;
#else
    case 2: { Epi1 E{S1, S2, S3, S4, S5, ALR}; st_gemm_naive(vb, nvb, (float*)lds, S0, Bt1, 0, NT / 32, 0, 8, 1024, E); st_gemm_naive(vb, nvb, (float*)lds, S0, Bt1, 0, NT / 32, 12, 13, 1024, E); } break;
    case 5: { Epi1 E{S1, S2, S3, S4, S5, ALR}; st_gemm_naive(vb, nvb, (float*)lds, S0, Bt1, 0, NT / 32, 8, 12, 1024, E); st_gemm_naive(vb, nvb, (float*)lds, S0, Bt1, 0, NT / 32, 13, 29, 1024, E); } break;
    case 7: { EpiRes E{p.x, p.ctx, p.out, X1C, MOD}; st_gemm_naive(vb, nvb, (float*)lds, S0, Bt2, 0, NT / 32, 0, 4, 2048, E); } break;
    case 9: { Epi3 E{S3, S0}; st_gemm_naive(vb, nvb, (float*)lds, S2, Bt3, 0, NLAT / 32, 0, 16, 1024, E); st_gemm_naive(vb, nvb, (float*)lds, S2, Bt3, NLAT / 32, NT / 32, 0, 8, 1024, E); } break;
    case 13: { EpiRes E{p.out, nullptr, p.out, nullptr, MOD + 5 * 3072}; st_gemm_naive(vb, nvb, (float*)lds, S0, Bt4, 0, NLAT / 32, 0, 4, 2048, E); } break;
#endif
    }
}
constexpr int NSTAGES = 15;
constexpr int LDS_BYTES = 147456;

#ifndef ONE_LAUNCH
#define ONE_LAUNCH 1
#endif
#if !ONE_LAUNCH
__global__ void __launch_bounds__(NTHREADS) k_mega(Params p, int st) {
    extern __shared__ __attribute__((aligned(16))) unsigned char lds[];
    run_stage(p, st, blockIdx.x, gridDim.x, lds);
}
#else
__global__ void __launch_bounds__(NTHREADS) k_mega(Params p) {
    extern __shared__ __attribute__((aligned(16))) unsigned char lds[];
    volatile __attribute__((address_space(3))) unsigned* st = (volatile __attribute__((address_space(3))) unsigned*)((__attribute__((address_space(3))) unsigned char*)lds + (LDS_BYTES - 64));
    if (threadIdx.x < 2) st[threadIdx.x] = 0u;
    __syncthreads();
    const XcdBarrier bar = xcd_barrier_post((unsigned*)(p.ws + WS_CTL) + 4096, st);
#ifndef REP_STAGE
#define REP_STAGE -1
#endif
#ifndef REP_N
#define REP_N 1
#endif
#define RS(k) do { run_stage(p, k, blockIdx.x, gridDim.x, lds); if ((k) == REP_STAGE) { for (int rep_ = 0; rep_ < REP_N; ++rep_) { xcd_barrier(bar); run_stage(p, k, blockIdx.x, gridDim.x, lds); } } } while (0)
#define GS() xcd_barrier(bar)
    RS(0); GS(); RS(1); GS(); RS(2); GS(); RS(3); GS(); RS(4); GS(); RS(5); GS(); RS(6); GS(); RS(7); GS();
    RS(8); GS(); RS(9); GS(); RS(10); GS(); RS(13); if (gridDim.x != 256) { GS(); RS(14); }
#undef RS
#undef GS
}
#endif

extern "C" void kernel_launch(void* const* d_in, const int* in_sizes, int n_in, void* d_out, int out_size, void* d_ws, size_t ws_size, hipStream_t stream) {
    static int inited = 0, grid_blocks = 0;
    if (!inited) {
        if (n_in != 23 || ws_size < WS_END || out_size != NLAT * D) { fprintf(stderr, "kernel_launch: unexpected shapes n_in %d ws %zu out %d\n", n_in, ws_size, out_size); inited = -1; return; }
        if (hipFuncSetAttribute((const void*)k_mega, hipFuncAttributeMaxDynamicSharedMemorySize, LDS_BYTES) != hipSuccess) { fprintf(stderr, "hipFuncSetAttribute failed\n"); inited = -1; return; }
        int dev = 0, cus = 0, per_cu = 0;
        (void)hipGetDevice(&dev); (void)hipDeviceGetAttribute(&cus, hipDeviceAttributeMultiprocessorCount, dev);
        (void)hipOccupancyMaxActiveBlocksPerMultiprocessor(&per_cu, (const void*)k_mega, NTHREADS, LDS_BYTES);
        if (per_cu < 1) { fprintf(stderr, "kernel_launch: occupancy query says %d blocks per CU\n", per_cu); per_cu = 1; }
        if (per_cu > 1) per_cu = 1;
        grid_blocks = cus * per_cu;
        inited = 1;
    }
    if (inited < 0) return;
    Params p{};
    const float** f = (const float**)&p;
    for (int i = 0; i < 23; ++i) f[i] = (const float*)d_in[i];
    p.out = (float*)d_out; p.ws = (unsigned char*)d_ws;
    (void)hipMemsetAsync((unsigned char*)d_ws + WS_CTL, 0, 2 * MiB, stream);
#if ONE_LAUNCH
    void* args[] = {&p};
    hipError_t e = hipLaunchCooperativeKernel((const void*)k_mega, dim3(grid_blocks), dim3(NTHREADS), args, LDS_BYTES, stream);
    if (e != hipSuccess) fprintf(stderr, "cooperative launch failed: %s (grid %d)\n", hipGetErrorString(e), grid_blocks);
#else
    for (int st = 0; st < NSTAGES; ++st) hipLaunchKernelGGL(k_mega, dim3(1024), dim3(NTHREADS), LDS_BYTES, stream, p, st);
#endif
}
```

```cpp
#include <hip/hip_runtime.h>
#include <hip/hip_cooperative_groups.h>
namespace cg = cooperative_groups;
#include <cstdio>
#include <cstdint>

typedef unsigned short bf16_t;
#define DEVI __device__ __forceinline__
#define LDS_BARRIER() do { asm volatile("s_waitcnt lgkmcnt(0)" ::: "memory"); __builtin_amdgcn_s_barrier(); asm volatile("" ::: "memory"); } while (0)

constexpr int D = 1024, NB = 4, SEQ = 4096, CTXL = 256;
constexpr int NLAT = NB * SEQ;
constexpr int NCTX = NB * CTXL;
constexpr int NT = NLAT + NCTX;
constexpr int NCH = 68;
constexpr int EVEN_IN = 7200;
constexpr int N1 = 7424;
constexpr int N1A = 13 * 256;
constexpr int RGW = 2048;
constexpr float EPS = 1e-6f;

constexpr size_t MiB = 1u << 20;
constexpr size_t WS_CTL = 0;
constexpr size_t WS_MOD = 1 * MiB;
constexpr size_t WS_ALR = 2 * MiB;
constexpr size_t WS_X1C = 5 * MiB;
constexpr size_t WS_SUMA = 9 * MiB;
constexpr size_t WS_SUMH = 9 * MiB + 4608 * 1024;
constexpr size_t WS_DEC = 18 * MiB;
constexpr size_t WS_BT1 = 19 * MiB + 512 * 1024;
constexpr size_t WS_BT2 = 34 * MiB;
constexpr size_t WS_BT3 = 38 * MiB;
constexpr size_t WS_BT4 = 46 * MiB;
constexpr size_t WS_BD = 50 * MiB;
constexpr size_t WS_S0 = 52 * MiB;
constexpr size_t SLOT = 34 * MiB;
constexpr size_t WS_END = WS_S0 + 6 * SLOT;
static_assert(WS_END == 256 * MiB, "ws map");
#define WS_SLOT(i) (WS_S0 + (size_t)(i) * SLOT)

struct Params {
    const float* x; const float* c; const float* ctx; const float* c_ctx; const float* norm_g; const float* w_mod; const float* b_mod;
    const float* e_w_in; const float* e_w_a2; const float* e_b_a2; const float* e_gla_g; const float* e_conv_w; const float* e_w_out;
    const float* o_w_in; const float* o_conv_w; const float* o_conv_b; const float* o_w_a; const float* o_b_a; const float* o_w_x; const float* o_b_x;
    const float* o_lam; const float* o_w_out; const float* final_g;
    float* out; unsigned char* ws;
};

DEVI float bf2f(bf16_t v) { return __uint_as_float((unsigned)v << 16); }
DEVI bf16_t f2bf(float f) { unsigned u = __float_as_uint(f); return (bf16_t)((u + 0x7fffu + ((u >> 16) & 1u)) >> 16); }
DEVI unsigned pk2(float lo, float hi) { return (unsigned)f2bf(lo) | ((unsigned)f2bf(hi) << 16); }
DEVI float fexp2_(float x) { return __builtin_amdgcn_exp2f(x); }
DEVI float frcp_(float x) { return __builtin_amdgcn_rcpf(x); }
DEVI float sigmoidf_(float x) { return frcp_(1.0f + fexp2_(-1.4426950408889634f * x)); }
DEVI float siluf_(float x) { return x * frcp_(1.0f + fexp2_(-1.4426950408889634f * x)); }
DEVI float softplusf_(float x) { return fmaxf(x, 0.f) + log1pf(__expf(-fabsf(x))); }
DEVI float logsigmoidf_(float x) { return fminf(x, 0.f) - 0.6931471805599453f * __builtin_amdgcn_logf(1.0f + fexp2_(-1.4426950408889634f * fabsf(x))); }
DEVI int row_of(int bb, int c, int t) { return c < 64 ? bb * 4096 + c * 64 + t : NLAT + bb * 256 + (c - 64) * 64 + t; }
DEVI int mod_idx(int row) { return row < NLAT ? (row >> 12) : 4; }
DEVI int xr_pad_of_tile(int pm) { return pm < 64 ? 4 * ((pm >> 4) + 1) : 20 + 4 * (pm - 64); }
constexpr int XR_ROWS = NT + 36;
DEVI float wave_sum(float v) {
#pragma unroll
    for (int o = 1; o < 64; o <<= 1) v += __shfl_xor(v, o);
    return v;
}
__host__ __device__ inline int colmap1(int n) {
    const int t = n >> 8, c = n & 255;
    if (t < 12) return n;
    if (t == 12) return c < 32 ? 3072 + c : -1;
    if (t < 21) { const int j = t - 13; return c < 128 ? 4128 + 128 * j + c : 5152 + 128 * j + (c - 128); }
    const int j = t - 21; return c < 128 ? 3104 + 128 * j + c : 6176 + 128 * j + (c - 128);
}

#define NTHREADS 512

__device__ void st_mod(const Params& p, int vb, int nvb, float* lds) {
    float* MOD = (float*)(p.ws + WS_MOD);
    for (int i = threadIdx.x; i < 5 * 1024; i += NTHREADS) { const int s = i >> 10, k = i & 1023; const float v = s < 4 ? p.c[s * 1024 + k] : p.c_ctx[k]; lds[i] = siluf_(v); }
    __syncthreads();
    const int lane = threadIdx.x & 63, gw = vb * (NTHREADS / 64) + (threadIdx.x >> 6), ngw = nvb * (NTHREADS / 64);
    for (int it = gw; it < 2 * 48 * 32; it += ngw) {
        const int kc = it & 31, cb = (it >> 5) % 48, li = it / (32 * 48), j = cb * 64 + lane, k0 = kc * 32;
        const float* W = p.w_mod + ((size_t)li * 1024 + k0) * 3072 + j;
        float wv[32];
#pragma unroll
        for (int k = 0; k < 32; ++k) wv[k] = W[(size_t)k * 3072];
        float a0 = 0.f, a1 = 0.f, a2 = 0.f, a3 = 0.f, a4 = 0.f;
#pragma unroll
        for (int k = 0; k < 32; ++k) { const float w = wv[k]; a0 += lds[k0 + k] * w; a1 += lds[1024 + k0 + k] * w; a2 += lds[2048 + k0 + k] * w; a3 += lds[3072 + k0 + k] * w; a4 += lds[4096 + k0 + k] * w; }
        const float bv = kc == 0 ? p.b_mod[li * 3072 + j] : 0.f;
        float* o = MOD + (size_t)li * 5 * 3072 + j;
        atomicAdd(o, a0 + bv); atomicAdd(o + 3072, a1 + bv); atomicAdd(o + 2 * 3072, a2 + bv); atomicAdd(o + 3 * 3072, a3 + bv); atomicAdd(o + 4 * 3072, a4 + bv);
    }
    __syncthreads();
}

__device__ __forceinline__ void wt_item(const float* src, int ldw, bf16_t* dst, int K, int k0, __attribute__((address_space(3))) float* scr, int lane) {
    typedef unsigned v4u __attribute__((ext_vector_type(4)));
    if (src) {
#pragma unroll 8
        for (int i = 0; i < 32; ++i) { const int kk = 2 * i + (lane >> 5); scr[kk * 33 + (lane & 31)] = src[(size_t)(k0 + kk) * ldw + (lane & 31)]; }
    }
    asm volatile("s_waitcnt lgkmcnt(0)" ::: "memory");
    const int cch = lane & 7;
#pragma unroll
    for (int j = 0; j < 4; ++j) { const int n = (lane >> 3) + 8 * j; const __attribute__((address_space(3))) float* sp = scr + (8 * cch) * 33 + n;
        v4u o = {0u, 0u, 0u, 0u};
        if (src) { o.x = pk2(sp[0 * 33], sp[1 * 33]); o.y = pk2(sp[2 * 33], sp[3 * 33]); o.z = pk2(sp[4 * 33], sp[5 * 33]); o.w = pk2(sp[6 * 33], sp[7 * 33]); }
        *(v4u*)(dst + (size_t)n * K + k0 + 8 * cch) = o; }
    asm volatile("s_waitcnt lgkmcnt(0)" ::: "memory");
}
__device__ void st_wprep(const Params& p, int vb, int nvb, unsigned char* lds_) {
    bf16_t* Bt1 = (bf16_t*)(p.ws + WS_BT1); bf16_t* Bt2 = (bf16_t*)(p.ws + WS_BT2); bf16_t* Bt3 = (bf16_t*)(p.ws + WS_BT3); bf16_t* Bt4 = (bf16_t*)(p.ws + WS_BT4);
    bf16_t* BD = (bf16_t*)(p.ws + WS_BD);
    const int lane = threadIdx.x & 63, wv = threadIdx.x >> 6, gw = vb * (NTHREADS / 64) + wv, ngw = nvb * (NTHREADS / 64);
    __attribute__((address_space(3))) float* scr = (__attribute__((address_space(3))) float*)lds_ + 8192 + wv * (64 * 33);
    constexpr int I1 = 16 * (N1 / 32), I2 = 32 * 32, I3 = 16 * 128, I4 = 32 * 32, I5 = 64 * 8;
    for (int it = gw; it < I1 + I2 + I3 + I4 + I5; it += ngw) {
        int r = it;
        if (r < I1) { const int nbk = N1 / 32, kb = r / nbk, nb = r % nbk; const int sc = colmap1(nb * 32); wt_item(sc < 0 ? nullptr : p.e_w_in + sc, EVEN_IN, Bt1 + (size_t)nb * 32 * 1024, 1024, kb * 64, scr, lane); continue; } r -= I1;
        if (r < I2) { const int kb = r / 32, nb = r % 32; wt_item(p.e_w_out + nb * 32, 1024, Bt2 + (size_t)nb * 32 * 2048, 2048, kb * 64, scr, lane); continue; } r -= I2;
        if (r < I3) { const int kb = r / 128, nb = r % 128; wt_item(p.o_w_in + nb * 32, 4096, Bt3 + (size_t)nb * 32 * 1024, 1024, kb * 64, scr, lane); continue; } r -= I3;
        if (r < I4) { const int kb = r / 32, nb = r % 32; wt_item(p.o_w_out + nb * 32, 1024, Bt4 + (size_t)nb * 32 * 2048, 2048, kb * 64, scr, lane); continue; } r -= I4;
        { const int m = r >> 8, dn = (r >> 3) & 31, kb = (r >> 2) & 1, nb = r & 3; const float* W = (m == 0 ? p.o_w_a : p.o_w_x) + (size_t)dn * 16384;
          wt_item(W + nb * 32, 128, BD + (size_t)m * 2 * 16 * 16384 + (size_t)dn * 16384 + (size_t)nb * 32 * 128, 128, kb * 64, scr, lane); }
    }
}

__device__ void st_modulate(const Params& p, int vb, int nvb, int li, const float* xlat, const float* xctx, bf16_t* H, const float* slab = nullptr, int nslab = 0, const float* gatec = nullptr, int row_begin = 0) {
    const float* MOD = (const float*)(p.ws + WS_MOD) + (size_t)li * 5 * 3072;
    const float* g = p.norm_g + li * 1024;
    const int lane = threadIdx.x & 63, gw = vb * (NTHREADS / 64) + (threadIdx.x >> 6), ngw = nvb * (NTHREADS / 64);
    for (int row = row_begin + gw; row < NT; row += ngw) {
        const float* xr = row < NLAT ? xlat + (size_t)row * 1024 : xctx + (size_t)(row - NLAT) * 1024;
        const float* md = MOD + (size_t)mod_idx(row) * 3072;
        float4 v[4]; float ss = 0.f;
#pragma unroll
        for (int j = 0; j < 4; ++j) { v[j] = *(const float4*)(xr + j * 256 + lane * 4);
            if (slab && row >= NLAT) {
                float4 a = {0.f, 0.f, 0.f, 0.f};
                for (int ks = 0; ks < nslab; ++ks) { const float4 t = *(const float4*)(slab + ((size_t)ks * NCTX + (row - NLAT)) * 1024 + j * 256 + lane * 4); a.x += t.x; a.y += t.y; a.z += t.z; a.w += t.w; }
                const float4 gt = *(const float4*)(gatec + j * 256 + lane * 4); v[j].x += gt.x * a.x; v[j].y += gt.y * a.y; v[j].z += gt.z * a.z; v[j].w += gt.w * a.w; }
            ss += v[j].x * v[j].x + v[j].y * v[j].y + v[j].z * v[j].z + v[j].w * v[j].w; }
        const float rinv = rsqrtf(wave_sum(ss) * (1.f / 1024.f) + EPS);
#pragma unroll
        for (int j = 0; j < 4; ++j) { const int c0 = j * 256 + lane * 4; const float4 gg = *(const float4*)(g + c0), sh = *(const float4*)(md + c0), sc = *(const float4*)(md + 1024 + c0);
            ushort4 o; o.x = f2bf(v[j].x * rinv * gg.x * (1.f + sc.x) + sh.x); o.y = f2bf(v[j].y * rinv * gg.y * (1.f + sc.y) + sh.y);
            o.z = f2bf(v[j].z * rinv * gg.z * (1.f + sc.z) + sh.z); o.w = f2bf(v[j].w * rinv * gg.w * (1.f + sc.w) + sh.w);
            *(ushort4*)(H + (size_t)row * 1024 + c0) = o; }
    }
}

template <class Epi>
__device__ void st_gemm_naive(int vb, int nvb, float* lds, const bf16_t* A, const bf16_t* Bt, int mt0, int mt1, int nt0, int nt1, int K, const Epi& E) {
    float* As = lds;
    float* Bs = lds + 32 * 33;
    const int tid = threadIdx.x, tx = tid & 63, ty = tid >> 6;
    const int nmt = mt1 - mt0, nnt = nt1 - nt0;
    for (int it = vb; it < nmt * nnt; it += nvb) {
        const int m0 = (mt0 + it / nnt) * 32, n0 = (nt0 + it % nnt) * 256;
        float acc[4][4];
#pragma unroll
        for (int i = 0; i < 4; ++i)
#pragma unroll
            for (int j = 0; j < 4; ++j) acc[i][j] = 0.f;
        for (int k0 = 0; k0 < K; k0 += 32) {
            __syncthreads();
            for (int e = tid; e < 32 * 32; e += NTHREADS) { const int r = e >> 5, kk = e & 31; As[r * 33 + kk] = bf2f(A[(size_t)(m0 + r) * K + k0 + kk]); }
            for (int e = tid; e < 256 * 32; e += NTHREADS) { const int r = e >> 5, kk = e & 31; Bs[r * 33 + kk] = bf2f(Bt[(size_t)(n0 + r) * K + k0 + kk]); }
            __syncthreads();
#pragma unroll 8
            for (int kk = 0; kk < 32; ++kk) {
                float a[4], b[4];
#pragma unroll
                for (int i = 0; i < 4; ++i) a[i] = As[(ty * 4 + i) * 33 + kk];
#pragma unroll
                for (int j = 0; j < 4; ++j) b[j] = Bs[(tx + 64 * j) * 33 + kk];
#pragma unroll
                for (int i = 0; i < 4; ++i)
#pragma unroll
                    for (int j = 0; j < 4; ++j) acc[i][j] += a[i] * b[j];
            }
        }
#pragma unroll
        for (int i = 0; i < 4; ++i) E(m0 + ty * 4 + i, n0, tx, acc[i]);
    }
    __syncthreads();
}

struct Epi1 {
    bf16_t *QK, *V, *SGA, *Z, *CBG; float* ALR;
    DEVI void operator()(int row, int n0, int cl, const float (&v)[4]) const {
        const int t = n0 >> 8;
        if (t < 4) { for (int j = 0; j < 4; ++j) QK[(size_t)row * 1024 + n0 + cl + 64 * j] = f2bf(v[j]); }
        else if (t < 8) { for (int j = 0; j < 4; ++j) V[(size_t)row * 1024 + (n0 - 1024) + cl + 64 * j] = f2bf(v[j]); }
        else if (t < 12) { for (int j = 0; j < 4; ++j) SGA[(size_t)row * 1024 + (n0 - 2048) + cl + 64 * j] = f2bf(siluf_(v[j])); }
        else if (t == 12) { if (cl < 32) ALR[(size_t)row * 32 + cl] = v[0]; }
        else if (t < 21) { const int jt = t - 13; Z[(size_t)row * 1024 + 128 * jt + cl] = f2bf(v[0] * v[2]); Z[(size_t)row * 1024 + 128 * jt + cl + 64] = f2bf(v[1] * v[3]); }
        else { const int jt = t - 21; CBG[(size_t)row * 1024 + 128 * jt + cl] = f2bf(v[0] * siluf_(v[2])); CBG[(size_t)row * 1024 + 128 * jt + cl + 64] = f2bf(v[1] * siluf_(v[3])); }
    }
};
struct EpiRes {
    const float* xl; const float* xc; float* outl; float* outc; const float* MODl;
    DEVI void operator()(int row, int n0, int cl, const float (&v)[4]) const {
        const float* gate = MODl + (size_t)mod_idx(row) * 3072 + 2048;
        for (int j = 0; j < 4; ++j) { const int col = n0 + cl + 64 * j;
            if (row < NLAT) outl[(size_t)row * 1024 + col] = xl[(size_t)row * 1024 + col] + gate[col] * v[j];
            else if (outc) outc[(size_t)(row - NLAT) * 1024 + col] = xc[(size_t)(row - NLAT) * 1024 + col] + gate[col] * v[j]; }
    }
};
struct Epi3 {
    bf16_t* XR; bf16_t* SG;
    DEVI void operator()(int row, int n0, int cl, const float (&v)[4]) const {
        for (int j = 0; j < 4; ++j) { const int col = n0 + cl + 64 * j;
            if (col < 2048) XR[(size_t)row * 2048 + col] = f2bf(v[j]); else if (row < NLAT) SG[(size_t)row * 2048 + col - 2048] = f2bf(siluf_(v[j])); }
    }
};

#define LASQ __attribute__((address_space(3)))
__device__ void st_glaprep(const Params& p, int vb, int nvb, unsigned char* ldsb, const bf16_t* QK, const bf16_t* V, const float* ALR, bf16_t* QIN, bf16_t* KET, bf16_t* SC, float* DEC, bf16_t* VT) {
    typedef unsigned u4 __attribute__((ext_vector_type(4))); typedef unsigned u2 __attribute__((ext_vector_type(2))); typedef float f4 __attribute__((ext_vector_type(4))); typedef short bx8 __attribute__((ext_vector_type(8)));
    LASQ unsigned char* lds = (LASQ unsigned char*)ldsb;
    constexpr int RQ = 0, RK = 17408, Q0 = 34816, K0 = 52224, VR = 69632, AL = VR + 33792, TT = AL + 8192;
    const int tid = threadIdx.x, kk = tid & 127, tq = tid >> 7, wv = tid >> 6, ln = tid & 63, cl = ln & 15, gq = ln >> 4;
    u4 r[9];
#define GP_LOAD(item) do { const int h_ = (item) & 3, bc_ = (item) >> 2, c_ = bc_ % NCH, bb_ = bc_ / NCH; const size_t row0_ = (size_t)row_of(bb_, c_, 0); \
        _Pragma("unroll") for (int j_ = 0; j_ < 2; ++j_) { const int p_ = tid + 512 * j_; r[j_] = *(const u4*)(QK + (row0_ + (p_ >> 4)) * 1024 + h_ * 128 + (p_ & 15) * 8); r[2 + j_] = *(const u4*)(QK + (row0_ + (p_ >> 4)) * 1024 + 512 + h_ * 128 + (p_ & 15) * 8); } \
        _Pragma("unroll") for (int j_ = 0; j_ < 4; ++j_) { const int p_ = tid + 512 * j_; r[4 + j_] = *(const u4*)(V + (row0_ + (p_ >> 5)) * 1024 + h_ * 256 + (p_ & 31) * 8); } \
        r[8] = *(const u4*)(ALR + (row0_ + (tid >> 3)) * 32 + (tid & 7) * 4); } while (0)
    const int NIT = NB * NCH * 4;
    if (vb < NIT) GP_LOAD(vb);
    for (int item = vb; item < NIT; item += nvb) {
        const int h = item & 3;
        LDS_BARRIER();
#pragma unroll
        for (int j = 0; j < 2; ++j) { const int pp = tid + 512 * j; *(LASQ u4*)(lds + RQ + (pp >> 4) * 272 + (pp & 15) * 16) = r[j]; *(LASQ u4*)(lds + RK + (pp >> 4) * 272 + (pp & 15) * 16) = r[2 + j]; }
#pragma unroll
        for (int j = 0; j < 4; ++j) { const int pp = tid + 512 * j; *(LASQ u4*)(lds + VR + (pp >> 5) * 528 + (pp & 31) * 16) = r[4 + j]; }
        *(LASQ u4*)(lds + AL + (tid >> 3) * 128 + (tid & 7) * 16) = r[8];
        float w2a[2][16], b2a[2];
#pragma unroll
        for (int d = 0; d < 2; ++d) {
#pragma unroll
            for (int rr = 0; rr < 16; ++rr) w2a[d][rr] = p.e_w_a2[((size_t)d * 16 + rr) * 512 + h * 128 + kk];
            b2a[d] = p.e_b_a2[d * 512 + h * 128 + kk]; }
        asm volatile("" ::: "memory");
        if (item + nvb < NIT) GP_LOAD(item + nvb);
        LDS_BARRIER();
        unsigned qkr[16];
#pragma unroll
        for (int i = 0; i < 16; ++i) { qkr[i] = (unsigned)*(const LASQ unsigned short*)(lds + RQ + (tq * 16 + i) * 272 + kk * 2) | ((unsigned)*(const LASQ unsigned short*)(lds + RK + (tq * 16 + i) * 272 + kk * 2) << 16); }
        float bc[2][16];
#pragma unroll
        for (int d = 0; d < 2; ++d) {
            const float (&w2)[16] = w2a[d]; const float b2 = b2a[d];
#pragma unroll
            for (int ib = 0; ib < 8; ++ib) {
                f4 ar[2][4];
#pragma unroll
                for (int ii = 0; ii < 2; ++ii) { const LASQ f4* a = (const LASQ f4*)(lds + AL + (tq * 16 + ib * 2 + ii) * 128 + d * 64); ar[ii][0] = a[0]; ar[ii][1] = a[1]; ar[ii][2] = a[2]; ar[ii][3] = a[3]; }
#pragma unroll
                for (int ii = 0; ii < 2; ++ii) { float z = b2;
#pragma unroll
                    for (int q4 = 0; q4 < 4; ++q4) z += ar[ii][q4][0] * w2[4 * q4] + ar[ii][q4][1] * w2[4 * q4 + 1] + ar[ii][q4][2] * w2[4 * q4 + 2] + ar[ii][q4][3] * w2[4 * q4 + 3];
                    bc[d][ib * 2 + ii] = logsigmoidf_(z) * (1.f / 16.f); }
            }
            float sacc = 0.f;
            if (d == 0) {
#pragma unroll
                for (int i = 0; i < 16; ++i) { sacc += bc[d][i]; bc[d][i] = sacc; } }
            else {
#pragma unroll
                for (int i = 15; i >= 0; --i) { sacc += bc[d][i]; bc[d][i] = sacc; } }
            *(LASQ float*)(lds + TT + ((d * 4 + tq) * 128 + kk) * 4) = sacc;
        }
        LDS_BARRIER();
        const float scale = 0.08838834764831845f;
#pragma unroll
        for (int d = 0; d < 2; ++d) {
            const size_t u = (size_t)item * 2 + d;
            float off = 0.f, blast = 0.f;
#pragma unroll
            for (int q = 0; q < 4; ++q) { const float tv = *(const LASQ float*)(lds + TT + ((d * 4 + q) * 128 + kk) * 4); blast += tv; if (d == 0 ? (q < tq) : (q > tq)) off += tv; }
            LASQ unsigned char* qd = lds + (d == 0 ? Q0 : RQ); LASQ unsigned char* kd = lds + (d == 0 ? K0 : RK);
            unsigned ke[8];
#pragma unroll
            for (int i = 0; i < 16; ++i) { const int t = tq * 16 + i; const float bq = bc[d][i] + off;
                const float qv = __uint_as_float(qkr[i] << 16) * scale, kv = __uint_as_float(qkr[i] & 0xffff0000u);
                const float eb = fexp2_(1.4426950408889634f * bq);
                *(LASQ unsigned short*)(qd + t * 272 + kk * 2) = f2bf(qv * eb); *(LASQ unsigned short*)(kd + t * 272 + kk * 2) = f2bf(kv * frcp_(eb));
                const unsigned kev = f2bf(kv * fexp2_(1.4426950408889634f * (blast - bq)));
                if (i & 1) ke[i >> 1] |= kev << 16; else ke[i >> 1] = kev; }
            { u4 w0 = {ke[0], ke[1], ke[2], ke[3]}, w1 = {ke[4], ke[5], ke[6], ke[7]}; u4* dst = (u4*)(KET + (u * 128 + kk) * 64 + tq * 16); dst[0] = w0; dst[1] = w1; }
            if (tq == 0) DEC[u * 128 + kk] = fexp2_(1.4426950408889634f * blast);
        }
        LDS_BARRIER();
#pragma unroll
        for (int d = 0; d < 2; ++d) {
            const size_t u = (size_t)item * 2 + d;
            const LASQ unsigned char* qd = lds + (d == 0 ? Q0 : RQ); const LASQ unsigned char* kd = lds + (d == 0 ? K0 : RK);
#pragma unroll
            for (int j = 0; j < 2; ++j) { const int pp = tid + 512 * j; *(u4*)(QIN + u * 8192 + (pp >> 4) * 128 + (pp & 15) * 8) = *(const LASQ u4*)(qd + (pp >> 4) * 272 + (pp & 15) * 16); }
            const int mt = wv >> 1;
#pragma unroll
            for (int nn = 0; nn < 2; ++nn) { const int nt = 2 * (wv & 1) + nn; f4 acc = {0.f, 0.f, 0.f, 0.f};
#pragma unroll
                for (int k4 = 0; k4 < 4; ++k4) { const bx8 kf = *(const LASQ bx8*)(kd + (16 * nt + cl) * 272 + (32 * k4 + 8 * gq) * 2), qf = *(const LASQ bx8*)(qd + (16 * mt + cl) * 272 + (32 * k4 + 8 * gq) * 2);
                    acc = __builtin_amdgcn_mfma_f32_16x16x32_bf16(kf, qf, acc, 0, 0, 0); }
                const int t = 16 * mt + cl, s0 = 16 * nt + 4 * gq; float v[4];
#pragma unroll
                for (int rr = 0; rr < 4; ++rr) { const int sx = s0 + rr; v[rr] = (d == 0 ? (sx <= t) : (sx >= t)) ? acc[rr] : 0.f; }
                u2 w; w.x = pk2(v[0], v[1]); w.y = pk2(v[2], v[3]); *(u2*)(SC + (u * 64 + t) * 64 + s0) = w; }
        }
        { const int vc = tid & 255, th = tid >> 8; unsigned vv[16];
#pragma unroll
          for (int i = 0; i < 32; ++i) { const unsigned x = *(const LASQ unsigned short*)(lds + VR + (32 * th + i) * 528 + vc * 2); if (i & 1) vv[i >> 1] |= x << 16; else vv[i >> 1] = x; }
          u4* dst = (u4*)(VT + ((size_t)item * 256 + vc) * 64 + 32 * th);
          dst[0] = (u4){vv[0], vv[1], vv[2], vv[3]}; dst[1] = (u4){vv[4], vv[5], vv[6], vv[7]}; dst[2] = (u4){vv[8], vv[9], vv[10], vv[11]}; dst[3] = (u4){vv[12], vv[13], vv[14], vv[15]}; }
    }
    LDS_BARRIER();
#undef GP_LOAD
}

__device__ void st_glawalk_naive(const Params& p, int vb, int nvb, float* Sl, const bf16_t* QIN, const bf16_t* KET, const bf16_t* SC, const float* DEC, const bf16_t* VT, bf16_t* OF, bf16_t* OB) {
    const int vc = threadIdx.x & 255, half = threadIdx.x >> 8;
    for (int combo = vb; combo < 32; combo += nvb) {
        const int d = combo & 1, h = (combo >> 1) & 3, bb = combo >> 3;
        __syncthreads();
        for (int k = half * 64; k < half * 64 + 64; ++k) Sl[k * 256 + vc] = 0.f;
        __syncthreads();
        bf16_t* O = d == 0 ? OF : OB;
        for (int step = 0; step < NCH; ++step) {
            const int c = d == 0 ? (step < 4 ? 64 + step : step - 4) : 67 - step;
            const int u = ((bb * NCH + c) * 4 + h) * 2 + d;
            const bf16_t* q = QIN + (size_t)u * 64 * 128; const bf16_t* ke = KET + (size_t)u * 128 * 64; const bf16_t* sc = SC + (size_t)u * 64 * 64;
            const bf16_t* vt = VT + (((size_t)(u >> 1)) * 256 + vc) * 64;
            float vv[64];
#pragma unroll
            for (int t = 0; t < 64; ++t) vv[t] = bf2f(vt[t]);
            const int row0 = row_of(bb, c, 0);
            for (int t = half * 32; t < half * 32 + 32; ++t) { float a = 0.f;
                for (int k = 0; k < 128; ++k) a += bf2f(q[t * 128 + k]) * bf2f(f2bf(Sl[k * 256 + vc]));
#pragma unroll
                for (int s = 0; s < 64; ++s) a += bf2f(sc[t * 64 + s]) * vv[s];
                O[(size_t)(row0 + t) * 1024 + h * 256 + vc] = f2bf(a); }
            __syncthreads();
            for (int k = half * 64; k < half * 64 + 64; ++k) { float a = DEC[(size_t)u * 128 + k] * Sl[k * 256 + vc];
#pragma unroll
                for (int t = 0; t < 64; ++t) a += bf2f(ke[k * 64 + t]) * vv[t];
                Sl[k * 256 + vc] = a; }
            __syncthreads();
        }
    }
}

__device__ void st_inner(const Params& p, int vb, int nvb, const bf16_t* OF, const bf16_t* OB, const bf16_t* SGA, const bf16_t* Z, const bf16_t* CBG, bf16_t* INNER, const bf16_t* ZA, float* X1C) {
    const int lane = threadIdx.x & 63, gw = vb * (NTHREADS / 64) + (threadIdx.x >> 6), ngw = nvb * (NTHREADS / 64);
    float4 gg = *(const float4*)(p.e_gla_g + lane * 4);
    for (int row = gw; row < NT; row += ngw) {
        bool hasp, hasn;
        if (row < NLAT) { const int t = row & 63; hasp = t != 0; hasn = t != 63; } else { const int t = (row - NLAT) & 255; hasp = t != 0; hasn = t != 255; }
        const size_t rp = hasp ? row - 1 : row, rn = hasn ? row + 1 : row; const float mp = hasp ? 1.f : 0.f, mn = hasn ? 1.f : 0.f;
        ushort4 a[4], b[4], sg[4], zc[4], zp[4], zn[4], cb[4];
#pragma unroll
        for (int h = 0; h < 4; ++h) { const int c0 = h * 256 + lane * 4;
            a[h] = *(const ushort4*)(OF + (size_t)row * 1024 + c0); b[h] = *(const ushort4*)(OB + (size_t)row * 1024 + c0); sg[h] = *(const ushort4*)(SGA + (size_t)row * 1024 + c0);
            const bf16_t* zb = h == 0 ? ZA + lane * 4 : Z + c0; const size_t zpitch = h == 0 ? 256 : 1024;
            zc[h] = *(const ushort4*)(zb + (size_t)row * zpitch); zp[h] = *(const ushort4*)(zb + rp * zpitch); zn[h] = *(const ushort4*)(zb + rn * zpitch);
            cb[h] = *(const ushort4*)(CBG + (size_t)row * 1024 + c0); }
#pragma unroll
        for (int h = 0; h < 4; ++h) { const int c0 = h * 256 + lane * 4;
            const float o0 = bf2f(a[h].x) + bf2f(b[h].x), o1 = bf2f(a[h].y) + bf2f(b[h].y), o2 = bf2f(a[h].z) + bf2f(b[h].z), o3 = bf2f(a[h].w) + bf2f(b[h].w);
            const float rinv = rsqrtf(wave_sum(o0 * o0 + o1 * o1 + o2 * o2 + o3 * o3) * (1.f / 256.f) + EPS);
            uint2 o; o.x = pk2(o0 * rinv * gg.x * bf2f(sg[h].x), o1 * rinv * gg.y * bf2f(sg[h].y)); o.y = pk2(o2 * rinv * gg.z * bf2f(sg[h].z), o3 * rinv * gg.w * bf2f(sg[h].w));
            *(uint2*)(INNER + (size_t)row * 2048 + c0) = o;
            const float4 w0 = *(const float4*)(p.e_conv_w + c0), w1 = *(const float4*)(p.e_conv_w + 1024 + c0), w2 = *(const float4*)(p.e_conv_w + 2048 + c0);
            uint2 y; y.x = pk2(bf2f(cb[h].x) * (mp * w0.x * bf2f(zp[h].x) + w1.x * bf2f(zc[h].x) + mn * w2.x * bf2f(zn[h].x)), bf2f(cb[h].y) * (mp * w0.y * bf2f(zp[h].y) + w1.y * bf2f(zc[h].y) + mn * w2.y * bf2f(zn[h].y)));
            y.y = pk2(bf2f(cb[h].z) * (mp * w0.z * bf2f(zp[h].z) + w1.z * bf2f(zc[h].z) + mn * w2.z * bf2f(zn[h].z)), bf2f(cb[h].w) * (mp * w0.w * bf2f(zp[h].w) + w1.w * bf2f(zc[h].w) + mn * w2.w * bf2f(zn[h].w)));
            *(uint2*)(INNER + (size_t)row * 2048 + 1024 + c0) = y; }
    }
}

template <int MODE>
__device__ void st_rglru_naive(const Params& p, int vb, int nvb, float* lds, const bf16_t* XR, const bf16_t* SG, float* SUMA, float* SUMH, bf16_t* Y) {
    float* xc = lds;
    float* av = xc + 64 * 128;
    float* uv = av + 64 * 128;
    float* hf = uv + 64 * 128;
    const int tid = threadIdx.x, j = tid & 127, tq = tid >> 7;
    const int nitems = MODE == 0 ? NB * NCH * 16 * 2 : NB * 64 * 16;
    for (int it = vb; it < nitems; it += nvb) {
        int bb, c, nb;
        if (MODE == 0) { nb = (it >> 1) & 15; const int bc = it >> 5; c = bc % NCH; bb = bc / NCH; } else { nb = it & 15; const int bc = it >> 4; c = bc & 63; bb = bc >> 6; }
        const int row0 = row_of(bb, c, 0);
        const int seg0 = c < 64 ? bb * 4096 : NLAT + bb * 256, segn = c < 64 ? 4096 : 256;
        const int tl0 = row0 - seg0;
        for (int dd = 0; dd < (MODE == 0 ? 1 : 2); ++dd) {
            const int d = MODE == 0 ? (it & 1) : dd;
            __syncthreads();
            for (int e = tid; e < 64 * 128; e += NTHREADS) { const int t = e >> 7, i = e & 127, ch = nb * 128 + i; float a = p.o_conv_b[d * 2048 + ch];
#pragma unroll
                for (int jj = 0; jj < 4; ++jj) { const int tt = d == 0 ? tl0 + t - 3 + jj : tl0 + t + 3 - jj;
                    if (tt >= 0 && tt < segn) a += p.o_conv_w[((size_t)d * 4 + jj) * 2048 + ch] * bf2f(XR[(size_t)(seg0 + tt) * 2048 + ch]); }
                xc[e] = a; }
            __syncthreads();
            const float* WA = p.o_w_a + ((size_t)d * 16 + nb) * 128 * 128; const float* WX = p.o_w_x + ((size_t)d * 16 + nb) * 128 * 128;
            const int ch = nb * 128 + j;
            const float ba = p.o_b_a[d * 2048 + ch], bx = p.o_b_x[d * 2048 + ch], sp = softplusf_(-p.o_lam[d * 2048 + ch]);
            for (int i16 = 0; i16 < 16; ++i16) { const int t = tq * 16 + i16; float ra = ba, rx = bx;
                for (int i = 0; i < 128; ++i) { const float xv = bf2f(f2bf(xc[t * 128 + i])); ra += xv * bf2f(f2bf(WA[i * 128 + j])); rx += xv * bf2f(f2bf(WX[i * 128 + j])); }
                const float r = sigmoidf_(ra), ig = sigmoidf_(rx); const float la = -8.f * r * sp; const float a = __expf(la);
                av[t * 128 + j] = a; uv[t * 128 + j] = sqrtf(-expm1f(2.f * la)) * (ig * xc[t * 128 + j]); }
            __syncthreads();
            if (tid < 128) {
                const size_t sidx = (((size_t)bb * 2 + d) * NCH + c) * 2048 + ch;
                if (MODE == 0) { float A = 1.f, hh = 0.f;
                    if (d == 0) for (int t = 0; t < 64; ++t) { const float a = av[t * 128 + j]; hh = a * hh + uv[t * 128 + j]; A *= a; }
                    else for (int t = 63; t >= 0; --t) { const float a = av[t * 128 + j]; hh = a * hh + uv[t * 128 + j]; A *= a; }
                    SUMA[sidx] = A; SUMH[sidx] = hh;
                } else { float hh = SUMH[sidx];
                    if (d == 0) for (int t = 0; t < 64; ++t) { hh = av[t * 128 + j] * hh + uv[t * 128 + j]; hf[t * 128 + j] = hh; }
                    else for (int t = 63; t >= 0; --t) { hh = av[t * 128 + j] * hh + uv[t * 128 + j]; const size_t o = (size_t)(row0 + t) * 2048 + ch; Y[o] = f2bf((hf[t * 128 + j] + hh) * bf2f(SG[o])); }
                }
            }
        }
    }
    __syncthreads();
}
__device__ void st_carry(const Params& p, int vb, int nvb, const float* SUMA, float* SUMH) {
    for (int e = vb * NTHREADS + threadIdx.x; e < NB * 2 * 2048; e += nvb * NTHREADS) {
        const int ch = e & 2047, d = (e >> 11) & 1, bb = e >> 12; float hh = 0.f;
        for (int s0 = 0; s0 < NCH; s0 += 17) {
            float A[17], H[17];
#pragma unroll
            for (int i = 0; i < 17; ++i) { const int step = s0 + i, c = d == 0 ? (step < 4 ? 64 + step : step - 4) : 67 - step; const size_t sidx = (((size_t)bb * 2 + d) * NCH + c) * 2048 + ch; A[i] = SUMA[sidx]; H[i] = SUMH[sidx]; }
#pragma unroll
            for (int i = 0; i < 17; ++i) { const int step = s0 + i, c = d == 0 ? (step < 4 ? 64 + step : step - 4) : 67 - step; const size_t sidx = (((size_t)bb * 2 + d) * NCH + c) * 2048 + ch; SUMH[sidx] = hh; hh = A[i] * hh + H[i]; }
        }
    }
}
__device__ void st_final(const Params& p, int vb, int nvb) {
    const int lane = threadIdx.x & 63, gw = vb * (NTHREADS / 64) + (threadIdx.x >> 6), ngw = nvb * (NTHREADS / 64);
    for (int row = gw; row < NLAT; row += ngw) { float* xr = p.out + (size_t)row * 1024; float4 v[4]; float ss = 0.f;
#pragma unroll
        for (int j = 0; j < 4; ++j) { v[j] = *(const float4*)(xr + j * 256 + lane * 4); ss += v[j].x * v[j].x + v[j].y * v[j].y + v[j].z * v[j].z + v[j].w * v[j].w; }
        const float rinv = rsqrtf(wave_sum(ss) * (1.f / 1024.f) + EPS);
#pragma unroll
        for (int j = 0; j < 4; ++j) { const float4 g = *(const float4*)(p.final_g + j * 256 + lane * 4); float4 o; o.x = v[j].x * rinv * g.x; o.y = v[j].y * rinv * g.y; o.z = v[j].z * rinv * g.z; o.w = v[j].w * rinv * g.w; *(float4*)(xr + j * 256 + lane * 4) = o; }
    }
}


namespace pg8 {
#define PG8_LAS __attribute__((address_space(3)))
typedef short bf16x8 __attribute__((ext_vector_type(8)));
typedef float f32x4 __attribute__((ext_vector_type(4)));
typedef unsigned u32x4 __attribute__((ext_vector_type(4)));
constexpr int BM = 256, BK = 64, HALF = 128, HTB = HALF * BK * 2, STAGE_BYTES = 8 * HTB, NXCD = 8, WGM = 8;
__host__ __device__ __forceinline__ int lds_byte(int r, int c) { const int st = (r >> 4) * 2 + (c >> 5), rr = r & 15, cc = c & 31, ob = rr * 64 + cc * 2; return st * 1024 + (ob ^ (((ob >> 9) & 1) << 5)); }
__host__ __device__ __forceinline__ void stage_rc(int b, int& R, int& C) { const int st = b / 1024, sb = b % 1024, swz = sb ^ (((sb >> 9) & 1) << 5); R = (st >> 1) * 16 + swz / 64; C = (st & 1) * 32 + (swz % 64) / 2; }
__host__ __device__ __forceinline__ int perm32(int rho) { const int n = rho >> 4, i = rho & 15; return 8 * (i >> 2) + 4 * n + (i & 3); }
struct Unit { int pm, pn, k0, nk; };
struct Gemm { const bf16_t* A; const bf16_t* Bt; int M, N, K; };
struct TileOrder {
    int nM, nN, nwg, G, c, m0, split, base0, base1, nkfull, nM2, nN2, m02, nKS, nk2, tail_first;
    __device__ void init(int nM_, int nN_, int nkfull_, int G_, int c_, int m0_ = 0, int split_ = 1 << 30, int base0_ = 0, int base1_ = 0, int nM2_ = 0, int nN2_ = 0, int m02_ = 0, int nKS_ = 1, int nk2_ = 0) {
        nM = nM_; nN = nN_; nwg = nM * nN; nkfull = nkfull_; G = G_; c = c_; m0 = m0_; split = split_; base0 = base0_; base1 = base1_; nM2 = nM2_; nN2 = nN2_; m02 = m02_; nKS = nKS_; nk2 = nk2_; tail_first = 0; }
    __device__ bool next(int i, Unit& u) const {
        long L = (long)i * G + c;
        if (tail_first) {
            const int ntail = nM2 * nN2 * nKS;
            if (c < ntail) { if (i == 0) L = (long)nwg + c; else L = (long)(i - 1) * G + c; }
            if (i > 0 && c >= ntail && L >= nwg) return false;
            if (i > 0 && c < ntail && L >= nwg) return false;
        }
        if (L >= nwg) { const long L2 = L - nwg; if (L2 >= (long)nM2 * nN2 * nKS) return false; const int ks = (int)(L2 % nKS), rest = (int)(L2 / nKS);
            u.pm = m02 + rest / nN2; u.pn = rest % nN2; u.k0 = ks * nk2 * 64; u.nk = nk2; return true; }
        int wgid = (int)L; { const int q = nwg / NXCD, r = nwg % NXCD, xcd = wgid % NXCD, off = wgid / NXCD; wgid = (xcd < r ? xcd * (q + 1) : r * (q + 1) + (xcd - r) * q) + off; }
        const int nig = WGM * nN, gid = wgid / nig, fm = gid * WGM, gsz = (nM - fm) < WGM ? (nM - fm) : WGM;
        const int pm = fm + ((wgid % nig) % gsz), j = (wgid % nig) / gsz;
        u.pm = m0 + pm; u.pn = j < split ? base0 + j : base1 + (j - split); u.k0 = 0; u.nk = nkfull; return true;
    }
    __device__ __forceinline__ void a_ready(const Unit&) const {}
    __device__ __forceinline__ void done(const Unit&) const {}
};
typedef float f32x2_t __attribute__((ext_vector_type(2))); typedef __bf16 bf16x2_t __attribute__((ext_vector_type(2)));
__device__ __forceinline__ unsigned cvt_pk_bf16(float lo, float hi) { f32x2_t v = {lo, hi}; bf16x2_t b = __builtin_convertvector(v, bf16x2_t); return __builtin_bit_cast(unsigned, b); }
template <class Epi, class Sched, bool ALIGN_EPI = false, bool SP2 = false>
__device__ __forceinline__ void gemm_phase(PG8_LAS unsigned char* lds, const Gemm g, const Sched& S, const Epi& E) {
    const int tid = threadIdx.x, wid = __builtin_amdgcn_readfirstlane(tid >> 6), lane = tid & 63, wr = wid >> 2, wc = wid & 3, fr = lane & 15, fq = lane >> 4;
    const int K = g.K;
    unsigned voffA[2], voffB[2];
#pragma unroll
    for (int i = 0; i < 2; ++i) { int R, C; stage_rc(tid * 16 + i * 8192, R, C); const int Rb = Epi::PERM ? ((R & ~31) + perm32(R & 31)) : R;
        voffA[i] = (unsigned)(R * K + C) * 2u; voffB[i] = (unsigned)(Rb * K + C) * 2u; }
    const size_t kstep = (size_t)(BK * 2);
    const size_t hstep = (size_t)HALF * K * 2;
    const size_t tstep = 2 * hstep;
    const unsigned ldsw = (unsigned)wid * 1024u;
    const int aoff = lds_byte(wr * 64 + fr, fq * 8), boff = lds_byte(wc * 32 + fr, fq * 8);
#define PG8_SA(b, h) (((b) * 2 + (h)) * HTB)
#define PG8_SB(b, h) ((4 + (b) * 2 + (h)) * HTB)
#define PG8_STAGE(bufoff, gbase, voff) do { _Pragma("unroll") for (int _i = 0; _i < 2; ++_i) \
        __builtin_amdgcn_global_load_lds((const unsigned*)((const char*)(gbase) + (voff)[_i]), (PG8_LAS unsigned*)(lds + (bufoff) + ldsw + _i * 8192), 16, 0, 0); } while (0)
#define PG8_LDA(dst, b, h) do { _Pragma("unroll") for (int m = 0; m < 4; ++m) _Pragma("unroll") for (int k = 0; k < 2; ++k) dst[m][k] = *(const PG8_LAS bf16x8*)(lds + PG8_SA(b, h) + aoff + m * 2048 + k * 1024); } while (0)
#define PG8_LDB(dst, b, h) do { _Pragma("unroll") for (int n = 0; n < 2; ++n) _Pragma("unroll") for (int k = 0; k < 2; ++k) dst[n][k] = *(const PG8_LAS bf16x8*)(lds + PG8_SB(b, h) + boff + n * 2048 + k * 1024); } while (0)
#define PG8_MMA(ai, bj, At, Bt) do { __builtin_amdgcn_s_setprio(1); _Pragma("unroll") for (int m = 0; m < 4; ++m) _Pragma("unroll") for (int n = 0; n < 2; ++n) _Pragma("unroll") for (int k = 0; k < 2; ++k) \
        acc[ai][bj][m][n] = __builtin_amdgcn_mfma_f32_16x16x32_bf16(Bt[n][k], At[m][k], acc[ai][bj][m][n], 0, 0, 0); __builtin_amdgcn_s_setprio(0); } while (0)
#define PG8_WAIT_V(n) asm volatile("s_waitcnt vmcnt(" #n ")" ::: "memory")
#define PG8_WAIT_L(n) asm volatile("s_waitcnt lgkmcnt(" #n ")" ::: "memory")
#define PG8_BAR __builtin_amdgcn_s_barrier()
#define PG8_SCHED __builtin_amdgcn_sched_barrier(0)
    Unit cur, nxt; int ui = 0;
    if (!S.next(0, cur)) return;
    f32x4 acc[2][2][4][2];
#pragma unroll
    for (int a = 0; a < 2; ++a)
#pragma unroll
        for (int b = 0; b < 2; ++b)
#pragma unroll
            for (int m = 0; m < 4; ++m)
#pragma unroll
                for (int n = 0; n < 2; ++n) acc[a][b][m][n] = (f32x4){0.f, 0.f, 0.f, 0.f};
    bf16x8 At[4][2], B0[2][2], B1[2][2];
    const char* cA = (const char*)g.A + (size_t)cur.pm * tstep + (size_t)cur.k0 * 2; const char* cB = (const char*)g.Bt + (size_t)cur.pn * tstep + (size_t)cur.k0 * 2;
    S.a_ready(cur);
    if constexpr (SP2) {
        PG8_STAGE(PG8_SB(0, 0), cB, voffB); PG8_STAGE(PG8_SB(0, 1), cB + hstep, voffB); PG8_STAGE(PG8_SA(0, 0), cA, voffA); PG8_STAGE(PG8_SA(0, 1), cA + hstep, voffA);
        if (wr == 1) PG8_BAR;
        PG8_WAIT_V(2); PG8_BAR;
        PG8_STAGE(PG8_SB(1, 0), cB + kstep, voffB); PG8_STAGE(PG8_SA(1, 0), cA + kstep, voffA); PG8_STAGE(PG8_SB(1, 1), cB + hstep + kstep, voffB);
        PG8_WAIT_V(6); PG8_BAR;
    } else {
        PG8_STAGE(PG8_SB(0, 0), cB, voffB); PG8_STAGE(PG8_SA(0, 0), cA, voffA); PG8_STAGE(PG8_SB(0, 1), cB + hstep, voffB); PG8_STAGE(PG8_SA(0, 1), cA + hstep, voffA);
        if (wr == 1) PG8_BAR;
        PG8_WAIT_V(4); PG8_BAR;
        PG8_STAGE(PG8_SB(1, 0), cB + kstep, voffB); PG8_STAGE(PG8_SA(1, 0), cA + kstep, voffA); PG8_STAGE(PG8_SB(1, 1), cB + hstep + kstep, voffB);
        PG8_WAIT_V(6); PG8_BAR;
    }
    for (;;) {
        const bool has_next = S.next(ui + 1, nxt);
        const char* nA = has_next ? (const char*)g.A + (size_t)nxt.pm * tstep + (size_t)nxt.k0 * 2 : cA; const char* nB = has_next ? (const char*)g.Bt + (size_t)nxt.pn * tstep + (size_t)nxt.k0 * 2 : cB;
        const int nt = cur.nk;
        for (int t = 0; t < nt; t += 2) {
            const bool last = (t == nt - 2);
            const char* a1 = cA + (size_t)(t + 1) * kstep;
            const char* a2 = last ? nA : cA + (size_t)(t + 2) * kstep; const char* b2 = last ? nB : cB + (size_t)(t + 2) * kstep;
            const char* a3 = a2 + kstep; const char* b3 = b2 + kstep;
            if (last && has_next) S.a_ready(nxt);
            if constexpr (SP2) {
            PG8_LDB(B0, 0, 0); PG8_LDB(B1, 0, 1); PG8_SCHED; PG8_LDA(At, 0, 0); PG8_STAGE(PG8_SA(1, 1), a1 + hstep, voffA);
            PG8_WAIT_V(8); PG8_WAIT_L(0); PG8_BAR; PG8_MMA(0, 0, At, B0); PG8_MMA(0, 1, At, B1); PG8_BAR; PG8_SCHED;
            PG8_LDA(At, 0, 1); PG8_STAGE(PG8_SB(0, 0), b2, voffB); PG8_STAGE(PG8_SB(0, 1), b2 + hstep, voffB); PG8_STAGE(PG8_SA(0, 0), a2, voffA);
            PG8_WAIT_V(8); PG8_WAIT_L(0); PG8_BAR; PG8_MMA(1, 0, At, B0); PG8_MMA(1, 1, At, B1); PG8_BAR; PG8_SCHED;
            PG8_LDB(B0, 1, 0); PG8_LDB(B1, 1, 1); PG8_SCHED; PG8_LDA(At, 1, 0); PG8_STAGE(PG8_SA(0, 1), a2 + hstep, voffA);
            PG8_WAIT_V(8); PG8_WAIT_L(0); PG8_BAR; PG8_MMA(0, 0, At, B0); PG8_MMA(0, 1, At, B1); PG8_BAR; PG8_SCHED;
            PG8_LDA(At, 1, 1); PG8_STAGE(PG8_SB(1, 0), b3, voffB); PG8_STAGE(PG8_SB(1, 1), b3 + hstep, voffB); PG8_STAGE(PG8_SA(1, 0), a3, voffA);
            PG8_WAIT_V(8); PG8_WAIT_L(0); PG8_BAR; PG8_MMA(1, 0, At, B0); PG8_MMA(1, 1, At, B1); PG8_BAR; PG8_SCHED;
            } else {
            PG8_LDB(B0, 0, 0); PG8_SCHED; PG8_LDA(At, 0, 0); PG8_STAGE(PG8_SA(1, 1), a1 + hstep, voffA);
            PG8_WAIT_L(8); PG8_BAR; PG8_WAIT_L(0); PG8_MMA(0, 0, At, B0); PG8_BAR; PG8_SCHED;
            PG8_LDB(B1, 0, 1); PG8_STAGE(PG8_SB(0, 0), b2, voffB);
            PG8_BAR; PG8_WAIT_L(0); PG8_MMA(0, 1, At, B1); PG8_BAR;
            PG8_LDA(At, 0, 1); PG8_STAGE(PG8_SA(0, 0), a2, voffA);
            PG8_BAR; PG8_WAIT_L(0); PG8_MMA(1, 0, At, B0); PG8_BAR; PG8_SCHED;
            PG8_STAGE(PG8_SB(0, 1), b2 + hstep, voffB);
            PG8_WAIT_V(6); PG8_BAR; PG8_MMA(1, 1, At, B1); PG8_BAR;
            PG8_LDB(B0, 1, 0); PG8_SCHED; PG8_LDA(At, 1, 0); PG8_STAGE(PG8_SA(0, 1), a2 + hstep, voffA);
            PG8_WAIT_L(8); PG8_BAR; PG8_WAIT_L(0); PG8_MMA(0, 0, At, B0); PG8_BAR; PG8_SCHED;
            PG8_LDB(B1, 1, 1); PG8_STAGE(PG8_SB(1, 0), b3, voffB);
            PG8_BAR; PG8_WAIT_L(0); PG8_MMA(0, 1, At, B1); PG8_BAR;
            PG8_LDA(At, 1, 1); PG8_STAGE(PG8_SA(1, 0), a3, voffA);
            PG8_BAR; PG8_WAIT_L(0); PG8_MMA(1, 0, At, B0); PG8_BAR; PG8_SCHED;
            PG8_STAGE(PG8_SB(1, 1), b3 + hstep, voffB);
            PG8_WAIT_V(6); PG8_BAR; PG8_MMA(1, 1, At, B1); PG8_BAR;
            }
        }
        if constexpr (ALIGN_EPI) { if (wr == 0) PG8_BAR; }
        if constexpr (!Epi::AFTER_DRAIN) { E(acc, cur, wr, wc, fr, fq); S.done(cur); } else { if (has_next) { E(acc, cur, wr, wc, fr, fq); S.done(cur); } }
        if (!has_next) break;
#pragma unroll
        for (int a = 0; a < 2; ++a)
#pragma unroll
            for (int b = 0; b < 2; ++b)
#pragma unroll
                for (int m = 0; m < 4; ++m)
#pragma unroll
                    for (int n = 0; n < 2; ++n) acc[a][b][m][n] = (f32x4){0.f, 0.f, 0.f, 0.f};
        cur = nxt; cA = nA; cB = nB; ++ui;
        if constexpr (ALIGN_EPI) { if (wr == 1) PG8_BAR; }
    }
    PG8_WAIT_V(0);
    if constexpr (!ALIGN_EPI) { if (wr == 0) PG8_BAR; }
    PG8_BAR;
    if constexpr (Epi::AFTER_DRAIN) { E.fused(acc, cur, wr, wc, fr, fq, lds, wid, lane); S.done(cur); }
#undef PG8_SA
#undef PG8_SB
#undef PG8_STAGE
#undef PG8_LDA
#undef PG8_LDB
#undef PG8_MMA
#undef PG8_WAIT_V
#undef PG8_WAIT_L
#undef PG8_BAR
#undef PG8_SCHED
}
}

DEVI pg8::u32x4 pack8(const pg8::f32x4& a, const pg8::f32x4& b) { pg8::u32x4 w; w.x = pg8::cvt_pk_bf16(a[0], a[1]); w.y = pg8::cvt_pk_bf16(a[2], a[3]); w.z = pg8::cvt_pk_bf16(b[0], b[1]); w.w = pg8::cvt_pk_bf16(b[2], b[3]); return w; }
DEVI pg8::f32x4 silu4(const pg8::f32x4& a) { pg8::f32x4 r; r[0] = siluf_(a[0]); r[1] = siluf_(a[1]); r[2] = siluf_(a[2]); r[3] = siluf_(a[3]); return r; }
struct FEpi1 {
    static constexpr bool PERM = true, AFTER_DRAIN = false;
    bf16_t *QK, *V, *SGA, *Z, *CBG; float* ALR; bf16_t* ZA;
    DEVI void operator()(const pg8::f32x4 (&acc)[2][2][4][2], const pg8::Unit& u, int wr, int wc, int fr, int fq) const {
        const int t = u.pn, row0 = u.pm * 256 + wr * 64 + fr, cw = wc * 32 + 8 * fq;
#pragma unroll
        for (int ai = 0; ai < 2; ++ai)
#pragma unroll
            for (int m = 0; m < 4; ++m) {
                const size_t row = (size_t)(row0 + ai * 128 + m * 16);
                if (t < 12) {
                    bf16_t* base = t < 4 ? QK + row * 1024 + t * 256 : (t < 8 ? V + row * 1024 + (t - 4) * 256 : SGA + row * 1024 + (t - 8) * 256);
#pragma unroll
                    for (int bj = 0; bj < 2; ++bj) { pg8::f32x4 v0 = acc[ai][bj][m][0], v1 = acc[ai][bj][m][1]; if (t >= 8) { v0 = silu4(v0); v1 = silu4(v1); }
                        *(pg8::u32x4*)(base + bj * 128 + cw) = pack8(v0, v1); }
                } else if (t == 12) {
                    if (wc == 0) { *(pg8::f32x4*)(ALR + row * 32 + 8 * fq) = acc[ai][0][m][0]; *(pg8::f32x4*)(ALR + row * 32 + 8 * fq + 4) = acc[ai][0][m][1]; }
                } else if (t < 21) {
                    bf16_t* zp = t < 15 ? ZA + row * 256 + (t - 13) * 128 + cw : Z + row * 1024 + (t - 13) * 128 + cw;
                    *(pg8::u32x4*)zp = pack8(acc[ai][0][m][0] * acc[ai][1][m][0], acc[ai][0][m][1] * acc[ai][1][m][1]);
                } else {
                    *(pg8::u32x4*)(CBG + row * 1024 + (t - 21) * 128 + cw) = pack8(acc[ai][0][m][0] * silu4(acc[ai][1][m][0]), acc[ai][0][m][1] * silu4(acc[ai][1][m][1]));
                }
            }
    }
};
template <bool HAS_TAIL> struct FEpiRes {
    static constexpr bool PERM = false, AFTER_DRAIN = false;
    const float* xl; const float* xc; float* outl; float* outc; const float* MODl;
    DEVI void operator()(const pg8::f32x4 (&acc)[2][2][4][2], const pg8::Unit& u, int wr, int wc, int fr, int fq) const {
        const int row0 = u.pm * 256 + wr * 64 + fr, col0 = u.pn * 256 + wc * 32 + 4 * fq;
        const bool lat = u.pm < NLAT / 256;
        const float* gate = MODl + (size_t)(lat ? (u.pm >> 4) : 4) * 3072 + 2048 + col0;
        pg8::f32x4 gv[2][2];
#pragma unroll
        for (int bj = 0; bj < 2; ++bj)
#pragma unroll
            for (int n = 0; n < 2; ++n) gv[bj][n] = *(const pg8::f32x4*)(gate + bj * 128 + n * 16);
        if (HAS_TAIL && !lat) {
            float* o = outc + (size_t)(u.k0 >> 8) * NCTX * 1024 - (size_t)NLAT * 1024;
#pragma unroll
            for (int ai = 0; ai < 2; ++ai)
#pragma unroll
                for (int m = 0; m < 4; ++m) { const size_t off = (size_t)(row0 + ai * 128 + m * 16) * 1024 + col0;
#pragma unroll
                    for (int bj = 0; bj < 2; ++bj)
#pragma unroll
                        for (int n = 0; n < 2; ++n) *(pg8::f32x4*)(o + off + bj * 128 + n * 16) = acc[ai][bj][m][n]; }
            return;
        }
        const float* xin = xl; float* o = outl;
#pragma unroll
        for (int ai = 0; ai < 2; ++ai)
#pragma unroll
            for (int m = 0; m < 4; ++m) { const size_t off = (size_t)(row0 + ai * 128 + m * 16) * 1024 + col0;
#pragma unroll
                for (int bj = 0; bj < 2; ++bj)
#pragma unroll
                    for (int n = 0; n < 2; ++n) { const pg8::f32x4 xv = *(const pg8::f32x4*)(xin + off + bj * 128 + n * 16); *(pg8::f32x4*)(o + off + bj * 128 + n * 16) = xv + gv[bj][n] * acc[ai][bj][m][n]; } }
    }
};
struct FEpi3 {
    static constexpr bool PERM = true, AFTER_DRAIN = false;
    bf16_t* XR; bf16_t* SG; float* XRC;
    DEVI void operator()(const pg8::f32x4 (&acc)[2][2][4][2], const pg8::Unit& u, int wr, int wc, int fr, int fq) const {
        const int t = u.pn, row0 = u.pm * 256 + wr * 64 + fr, cw = wc * 32 + 8 * fq;
        if (u.pm >= NLAT / 256) {
            float* sl = XRC + (size_t)(u.k0 >> 9) * NCTX * 2048;
#pragma unroll
            for (int ai = 0; ai < 2; ++ai)
#pragma unroll
                for (int m = 0; m < 4; ++m) { float* rp = sl + (size_t)(row0 - NLAT + ai * 128 + m * 16) * 2048 + t * 256 + cw;
#pragma unroll
                    for (int bj = 0; bj < 2; ++bj) { *(pg8::f32x4*)(rp + bj * 128) = acc[ai][bj][m][0]; *(pg8::f32x4*)(rp + bj * 128 + 4) = acc[ai][bj][m][1]; } }
            return;
        }
        bf16_t* base = t < 8 ? XR + (size_t)xr_pad_of_tile(u.pm) * 2048 + t * 256 : SG + (t - 8) * 256;
#pragma unroll
        for (int ai = 0; ai < 2; ++ai)
#pragma unroll
            for (int m = 0; m < 4; ++m) { bf16_t* rp = base + (size_t)(row0 + ai * 128 + m * 16) * 2048 + cw;
#pragma unroll
                for (int bj = 0; bj < 2; ++bj) { pg8::f32x4 v0 = acc[ai][bj][m][0], v1 = acc[ai][bj][m][1]; if (t >= 8) { v0 = silu4(v0); v1 = silu4(v1); }
                    *(pg8::u32x4*)(rp + bj * 128) = pack8(v0, v1); } }
    }
};

struct FEpiResRms {
    static constexpr bool PERM = false, AFTER_DRAIN = true;
    const float* xin; float* out; const float* MODl; const float* gfin; float* slots; unsigned* cnt;
    DEVI void fused(pg8::f32x4 (&acc)[2][2][4][2], const pg8::Unit& u, int wr, int wc, int fr, int fq, PG8_LAS unsigned char* lds, int wid, int lane) const {
        const int row0 = u.pm * 256 + wr * 64 + fr, col0 = u.pn * 256 + wc * 32 + 4 * fq;
        const float* gate = MODl + (size_t)(u.pm >> 4) * 3072 + 2048 + col0;
        PG8_LAS float* P = (PG8_LAS float*)lds;
        PG8_LAS float* S = (PG8_LAS float*)(lds + 8192);
        { pg8::f32x4 gv[2][2];
#pragma unroll
          for (int bj = 0; bj < 2; ++bj)
#pragma unroll
              for (int n = 0; n < 2; ++n) gv[bj][n] = *(const pg8::f32x4*)(gate + bj * 128 + n * 16);
#pragma unroll
          for (int ai = 0; ai < 2; ++ai)
#pragma unroll
              for (int m = 0; m < 4; ++m) { const float* xp = xin + (size_t)(row0 + ai * 128 + m * 16) * 1024 + col0;
#pragma unroll
                  for (int bj = 0; bj < 2; ++bj)
#pragma unroll
                      for (int n = 0; n < 2; ++n) { const pg8::f32x4 xv = *(const pg8::f32x4*)(xp + bj * 128 + n * 16); acc[ai][bj][m][n] = xv + gv[bj][n] * acc[ai][bj][m][n]; }
                  asm volatile("" : "+v"(acc[ai][0][m][0]), "+v"(acc[ai][0][m][1]), "+v"(acc[ai][1][m][0]), "+v"(acc[ai][1][m][1]));
                  if (m & 1) asm volatile("" ::: "memory"); } }
#pragma unroll
        for (int ai = 0; ai < 2; ++ai)
#pragma unroll
            for (int m = 0; m < 4; ++m) { float q = 0.f;
#pragma unroll
                for (int bj = 0; bj < 2; ++bj)
#pragma unroll
                    for (int n = 0; n < 2; ++n) { const pg8::f32x4 x = acc[ai][bj][m][n]; q += (x[0] * x[0] + x[1] * x[1]) + (x[2] * x[2] + x[3] * x[3]); }
                q += __shfl_xor(q, 16); q += __shfl_xor(q, 32);
                if (fq == 0) P[(ai * 128 + wr * 64 + m * 16 + fr) * 4 + wc] = q; }
        asm volatile("s_waitcnt lgkmcnt(0)" ::: "memory"); __builtin_amdgcn_s_barrier(); asm volatile("" ::: "memory");
        const int row = wid * 32 + (lane & 31);
        if (lane < 32) { const float t = (P[row * 4 + 0] + P[row * 4 + 1]) + (P[row * 4 + 2] + P[row * 4 + 3]);
            __hip_atomic_store(slots + ((size_t)(u.pm * 256 + row) * 4 + u.pn), t, __ATOMIC_RELAXED, __HIP_MEMORY_SCOPE_AGENT); }
        asm volatile("s_waitcnt vmcnt(0)" ::: "memory");
        if (lane == 0) __hip_atomic_fetch_add(cnt + 64 * u.pm, 1u, __ATOMIC_RELAXED, __HIP_MEMORY_SCOPE_AGENT);
        if (wid == 0) { unsigned sp = 0;
            while ((unsigned)__builtin_amdgcn_readfirstlane(__hip_atomic_load(cnt + 64 * u.pm, __ATOMIC_RELAXED, __HIP_MEMORY_SCOPE_AGENT)) < 32u) { __builtin_amdgcn_s_sleep(2); if (++sp > (1u << 22)) break; }
            __builtin_amdgcn_fence(__ATOMIC_ACQUIRE, "agent"); }
        asm volatile("s_waitcnt vmcnt(0) lgkmcnt(0)" ::: "memory"); __builtin_amdgcn_s_barrier(); asm volatile("" ::: "memory");
        if (lane < 32) { const float* sl = slots + (size_t)(u.pm * 256 + row) * 4; float t = 0.f;
#pragma unroll
            for (int k = 0; k < 4; ++k) t += __hip_atomic_load(sl + k, __ATOMIC_RELAXED, __HIP_MEMORY_SCOPE_AGENT);
            S[row] = rsqrtf(t * (1.f / 1024.f) + EPS); }
        asm volatile("s_waitcnt lgkmcnt(0)" ::: "memory"); __builtin_amdgcn_s_barrier(); asm volatile("" ::: "memory");
        pg8::f32x4 gf[2][2];
#pragma unroll
        for (int bj = 0; bj < 2; ++bj)
#pragma unroll
            for (int n = 0; n < 2; ++n) gf[bj][n] = *(const pg8::f32x4*)(gfin + col0 + bj * 128 + n * 16);
#pragma unroll
        for (int ai = 0; ai < 2; ++ai)
#pragma unroll
            for (int m = 0; m < 4; ++m) { const int r = ai * 128 + wr * 64 + m * 16 + fr; const float rinv = S[r]; const size_t off = (size_t)(u.pm * 256 + r) * 1024 + col0;
#pragma unroll
                for (int bj = 0; bj < 2; ++bj)
#pragma unroll
                    for (int n = 0; n < 2; ++n) *(pg8::f32x4*)(out + off + bj * 128 + n * 16) = acc[ai][bj][m][n] * rinv * gf[bj][n]; }
    }
    DEVI void operator()(const pg8::f32x4 (&)[2][2][4][2], const pg8::Unit&, int, int, int, int) const {}
};

struct FEpiResMod {
    static constexpr bool PERM = false, AFTER_DRAIN = true;
    const float* xin; float* x1; bf16_t* H1; const float* MOD0; const float* MOD1; const float* g1; float* slab; float* slots; unsigned* cnt;
    DEVI void operator()(const pg8::f32x4 (&acc)[2][2][4][2], const pg8::Unit& u, int wr, int wc, int fr, int fq) const {
        if (u.pm < NLAT / 256) return;
        const int row0 = u.pm * 256 + wr * 64 + fr, col0 = u.pn * 256 + wc * 32 + 4 * fq;
        float* o = slab + (size_t)(u.k0 >> 8) * NCTX * 1024 - (size_t)NLAT * 1024;
#pragma unroll
        for (int ai = 0; ai < 2; ++ai)
#pragma unroll
            for (int m = 0; m < 4; ++m) { const size_t off = (size_t)(row0 + ai * 128 + m * 16) * 1024 + col0;
#pragma unroll
                for (int bj = 0; bj < 2; ++bj)
#pragma unroll
                    for (int n = 0; n < 2; ++n) *(pg8::f32x4*)(o + off + bj * 128 + n * 16) = acc[ai][bj][m][n]; }
    }
    DEVI void fused(pg8::f32x4 (&acc)[2][2][4][2], const pg8::Unit& u, int wr, int wc, int fr, int fq, PG8_LAS unsigned char* lds, int wid, int lane) const {
        typedef unsigned u32x2v __attribute__((ext_vector_type(2)));
        const int row0 = u.pm * 256 + wr * 64 + fr, col0 = u.pn * 256 + wc * 32 + 4 * fq, b = u.pm >> 4;
        PG8_LAS float* P = (PG8_LAS float*)lds; PG8_LAS float* S = (PG8_LAS float*)(lds + 8192);
        { const float* gate = MOD0 + (size_t)b * 3072 + 2048 + col0; pg8::f32x4 gv[2][2];
#pragma unroll
          for (int bj = 0; bj < 2; ++bj)
#pragma unroll
              for (int n = 0; n < 2; ++n) gv[bj][n] = *(const pg8::f32x4*)(gate + bj * 128 + n * 16);
#pragma unroll
          for (int ai = 0; ai < 2; ++ai)
#pragma unroll
              for (int m = 0; m < 4; ++m) { const size_t off = (size_t)(row0 + ai * 128 + m * 16) * 1024 + col0;
#pragma unroll
                  for (int bj = 0; bj < 2; ++bj)
#pragma unroll
                      for (int n = 0; n < 2; ++n) { const pg8::f32x4 xv = *(const pg8::f32x4*)(xin + off + bj * 128 + n * 16); acc[ai][bj][m][n] = xv + gv[bj][n] * acc[ai][bj][m][n]; *(pg8::f32x4*)(x1 + off + bj * 128 + n * 16) = acc[ai][bj][m][n]; }
                  asm volatile("" : "+v"(acc[ai][0][m][0]), "+v"(acc[ai][0][m][1]), "+v"(acc[ai][1][m][0]), "+v"(acc[ai][1][m][1]));
                  if (m & 1) asm volatile("" ::: "memory"); } }
#pragma unroll
        for (int ai = 0; ai < 2; ++ai)
#pragma unroll
            for (int m = 0; m < 4; ++m) { float q = 0.f;
#pragma unroll
                for (int bj = 0; bj < 2; ++bj)
#pragma unroll
                    for (int n = 0; n < 2; ++n) { const pg8::f32x4 x = acc[ai][bj][m][n]; q += (x[0] * x[0] + x[1] * x[1]) + (x[2] * x[2] + x[3] * x[3]); }
                q += __shfl_xor(q, 16); q += __shfl_xor(q, 32);
                if (fq == 0) P[(ai * 128 + wr * 64 + m * 16 + fr) * 4 + wc] = q; }
        asm volatile("s_waitcnt lgkmcnt(0)" ::: "memory"); __builtin_amdgcn_s_barrier(); asm volatile("" ::: "memory");
        const int row = wid * 32 + (lane & 31);
        if (lane < 32) { const float t = (P[row * 4 + 0] + P[row * 4 + 1]) + (P[row * 4 + 2] + P[row * 4 + 3]);
            __hip_atomic_store(slots + ((size_t)(u.pm * 256 + row) * 4 + u.pn), t, __ATOMIC_RELAXED, __HIP_MEMORY_SCOPE_AGENT); }
        asm volatile("s_waitcnt vmcnt(0)" ::: "memory");
        if (lane == 0) __hip_atomic_fetch_add(cnt + 64 * u.pm, 1u, __ATOMIC_RELAXED, __HIP_MEMORY_SCOPE_AGENT);
        if (wid == 0) { unsigned sp = 0;
            while ((unsigned)__builtin_amdgcn_readfirstlane(__hip_atomic_load(cnt + 64 * u.pm, __ATOMIC_RELAXED, __HIP_MEMORY_SCOPE_AGENT)) < 32u) { __builtin_amdgcn_s_sleep(2); if (++sp > (1u << 22)) break; }
            __builtin_amdgcn_fence(__ATOMIC_ACQUIRE, "agent"); }
        asm volatile("s_waitcnt vmcnt(0) lgkmcnt(0)" ::: "memory"); __builtin_amdgcn_s_barrier(); asm volatile("" ::: "memory");
        if (lane < 32) { const float* sl = slots + (size_t)(u.pm * 256 + row) * 4; float t = 0.f;
#pragma unroll
            for (int k = 0; k < 4; ++k) t += __hip_atomic_load(sl + k, __ATOMIC_RELAXED, __HIP_MEMORY_SCOPE_AGENT);
            S[row] = rsqrtf(t * (1.f / 1024.f) + EPS); }
        asm volatile("s_waitcnt lgkmcnt(0)" ::: "memory"); __builtin_amdgcn_s_barrier(); asm volatile("" ::: "memory");
        const float* md = MOD1 + (size_t)b * 3072 + col0;
#pragma unroll
        for (int bj = 0; bj < 2; ++bj)
#pragma unroll
            for (int n = 0; n < 2; ++n) { const int co = bj * 128 + n * 16; const pg8::f32x4 gg = *(const pg8::f32x4*)(g1 + col0 + co), sh = *(const pg8::f32x4*)(md + co), sc = *(const pg8::f32x4*)(md + 1024 + co);
                const pg8::f32x4 mul = gg * (sc + 1.0f);
#pragma unroll
                for (int ai = 0; ai < 2; ++ai)
#pragma unroll
                    for (int m = 0; m < 4; ++m) { const int r = ai * 128 + wr * 64 + m * 16 + fr; const pg8::f32x4 hv = acc[ai][bj][m][n] * S[r] * mul + sh;
                        u32x2v w; w.x = pg8::cvt_pk_bf16(hv[0], hv[1]); w.y = pg8::cvt_pk_bf16(hv[2], hv[3]); *(u32x2v*)(H1 + (size_t)(u.pm * 256 + r) * 1024 + col0 + co) = w; } }
    }
};
#ifndef FAST_GEMM
#define FAST_GEMM 1
#endif


#define LASP __attribute__((address_space(3)))
__device__ void st_glawalk(const Params& p, int vb, int nvb, unsigned char* lds_, const bf16_t* QIN, const bf16_t* KET, const bf16_t* SC, const float* DEC, const bf16_t* VT, bf16_t* OF, bf16_t* OB) {
    typedef pg8::bf16x8 bx8; typedef pg8::f32x4 f4; typedef unsigned u32x2 __attribute__((ext_vector_type(2))); typedef pg8::u32x4 u4;
    LASP unsigned char* lds = (LASP unsigned char*)lds_;
    constexpr int QOFF = 0, KOFF = 17408, SOFF = KOFF + 18432, VOFF = SOFF + 9216, DOFF = VOFF + 4608, BUFSZ = 50176;
    const int tid = threadIdx.x, wid = __builtin_amdgcn_readfirstlane(tid >> 6), lane = tid & 63, c = lane & 15, g = lane >> 4;
    for (int it0 = vb; it0 < 256; it0 += nvb) {
        const int item = (nvb == 256) ? ((it0 & 7) * 32 + (it0 >> 3)) : it0;
        const int vs = item & 7, combo = item >> 3, d = combo & 1, h = (combo >> 1) & 3, bb = combo >> 3;
        LDS_BARRIER();
        if (wid >= 2) {
            const int lt = tid - 128;
            unsigned long long cst[8]; unsigned mult[8]; int doff[8];
#pragma unroll
            for (int j = 0; j < 8; ++j) { const int pp = lt + 384 * j;
                if (pp < 1024) { cst[j] = (unsigned long long)QIN + (pp >> 4) * 256 + (pp & 15) * 16; mult[j] = 16384u; doff[j] = QOFF + (pp >> 4) * 272 + (pp & 15) * 16; }
                else if (pp < 2048) { const int q = pp - 1024; cst[j] = (unsigned long long)KET + (q >> 3) * 128 + (q & 7) * 16; mult[j] = 16384u; doff[j] = KOFF + (q >> 3) * 144 + (q & 7) * 16; }
                else if (pp < 2560) { const int q = pp - 2048; cst[j] = (unsigned long long)SC + (q >> 3) * 128 + (q & 7) * 16; mult[j] = 8192u; doff[j] = SOFF + (q >> 3) * 144 + (q & 7) * 16; }
                else if (pp < 2816) { const int q = pp - 2560; cst[j] = (unsigned long long)VT + (vs * 32 + (q >> 3)) * 128 + (q & 7) * 16 - (unsigned long long)d * 16384; mult[j] = 16384u; doff[j] = VOFF + (q >> 3) * 144 + (q & 7) * 16; }
                else if (pp < 2848) { const int q = pp - 2816; cst[j] = (unsigned long long)DEC + q * 16; mult[j] = 512u; doff[j] = DOFF + q * 16; }
                else { cst[j] = (unsigned long long)DEC; mult[j] = 0u; doff[j] = -1; } }
            u4 r0[8], r1[8];
#define GW_LOAD(R, step) do { const int cc_ = d == 0 ? ((step) < 4 ? 64 + (step) : (step) - 4) : 67 - (step); const unsigned u_ = (unsigned)(((bb * NCH + cc_) * 4 + h) * 2 + d); \
                _Pragma("unroll") for (int j_ = 0; j_ < 8; ++j_) R[j_] = *(const u4*)(cst[j_] + (unsigned long long)u_ * mult[j_]); } while (0)
#define GW_WRITE(R, bufi) do { LASP unsigned char* b_ = lds + (bufi) * BUFSZ; _Pragma("unroll") for (int j_ = 0; j_ < 8; ++j_) if (doff[j_] >= 0) *(LASP u4*)(b_ + doff[j_]) = R[j_]; } while (0)
            GW_LOAD(r0, 0); GW_WRITE(r0, 0); GW_LOAD(r0, 1); GW_LOAD(r1, 2);
            LDS_BARRIER();
            for (int step = 0; step < NCH; step += 2) {
                GW_WRITE(r0, 1); if (step + 3 < NCH) GW_LOAD(r0, step + 3);
                LDS_BARRIER();
                if (step + 2 < NCH) { GW_WRITE(r1, 0); if (step + 4 < NCH) GW_LOAD(r1, step + 4); }
                LDS_BARRIER();
            }
#undef GW_LOAD
#undef GW_WRITE
        } else {
            f4 S[8];
#pragma unroll
            for (int m = 0; m < 8; ++m) S[m] = (f4){0.f, 0.f, 0.f, 0.f};
            bf16_t* O = d == 0 ? OF : OB;
            LDS_BARRIER();
            for (int step = 0; step < NCH; ++step) {
                const LASP unsigned char* B = lds + (step & 1) * BUFSZ;
#define SB0() __builtin_amdgcn_sched_barrier(0)
#define RDQ(dst_lo, dst_hi, ks) do { _Pragma("unroll") for (int mt = 0; mt < 4; ++mt) { const LASP unsigned char* qa = B + QOFF + (16 * mt + c) * 272 + (32 * (ks) + 4 * g) * 2; dst_lo[mt] = *(const LASP u32x2*)qa; dst_hi[mt] = *(const LASP u32x2*)(qa + 32); } } while (0)
#define MMQ(lo, hi, ks) do { _Pragma("unroll") for (int mt = 0; mt < 4; ++mt) { u4 w; w.x = lo[mt].x; w.y = lo[mt].y; w.z = hi[mt].x; w.w = hi[mt].y; o[mt] = __builtin_amdgcn_mfma_f32_16x16x32_bf16(sB[ks], __builtin_bit_cast(bx8, w), o[mt], 0, 0, 0); } } while (0)
#define RDK(kf, dv, m0) do { _Pragma("unroll") for (int mm = 0; mm < 4; ++mm) { const LASP unsigned char* ka = B + KOFF + (16 * ((m0) + mm) + c) * 144 + g * 16; kf[mm][0] = *(const LASP bx8*)ka; kf[mm][1] = *(const LASP bx8*)(ka + 64); dv[mm] = *(const LASP f4*)(B + DOFF + (16 * ((m0) + mm) + 4 * g) * 4); } } while (0)
#define MMK(kf, dv, m0) do { _Pragma("unroll") for (int mm = 0; mm < 4; ++mm) { S[(m0) + mm] = S[(m0) + mm] * dv[mm]; S[(m0) + mm] = __builtin_amdgcn_mfma_f32_16x16x32_bf16(kf[mm][0], bv0, S[(m0) + mm], 0, 0, 0); S[(m0) + mm] = __builtin_amdgcn_mfma_f32_16x16x32_bf16(kf[mm][1], bv1, S[(m0) + mm], 0, 0, 0); } } while (0)
                const bx8 bv0 = *(const LASP bx8*)(B + VOFF + (16 * wid + c) * 144 + g * 16), bv1 = *(const LASP bx8*)(B + VOFF + (16 * wid + c) * 144 + 64 + g * 16);
                u32x2 qa_lo[4], qa_hi[4], qb_lo[4], qb_hi[4];
                RDQ(qa_lo, qa_hi, 0); RDQ(qb_lo, qb_hi, 1);
                bx8 sB[4];
#pragma unroll
                for (int ks = 0; ks < 4; ++ks) { u4 w; w.x = pg8::cvt_pk_bf16(S[2 * ks][0], S[2 * ks][1]); w.y = pg8::cvt_pk_bf16(S[2 * ks][2], S[2 * ks][3]);
                    w.z = pg8::cvt_pk_bf16(S[2 * ks + 1][0], S[2 * ks + 1][1]); w.w = pg8::cvt_pk_bf16(S[2 * ks + 1][2], S[2 * ks + 1][3]); sB[ks] = __builtin_bit_cast(bx8, w); }
                f4 o[4];
#pragma unroll
                for (int mt = 0; mt < 4; ++mt) o[mt] = (f4){0.f, 0.f, 0.f, 0.f};
                SB0();
                MMQ(qa_lo, qa_hi, 0); SB0();
                RDQ(qa_lo, qa_hi, 2); SB0();
                MMQ(qb_lo, qb_hi, 1); SB0();
                RDQ(qb_lo, qb_hi, 3); SB0();
                MMQ(qa_lo, qa_hi, 2); SB0();
                bx8 sf[4][2];
#pragma unroll
                for (int mt = 0; mt < 4; ++mt) { const LASP unsigned char* sa = B + SOFF + (16 * mt + c) * 144 + g * 16; sf[mt][0] = *(const LASP bx8*)sa; sf[mt][1] = *(const LASP bx8*)(sa + 64); }
                SB0();
                MMQ(qb_lo, qb_hi, 3); SB0();
                bx8 kfa[4][2], kfb[4][2]; f4 dva[4], dvb[4];
                RDK(kfa, dva, 0); SB0();
#pragma unroll
                for (int mt = 0; mt < 4; ++mt) { o[mt] = __builtin_amdgcn_mfma_f32_16x16x32_bf16(bv0, sf[mt][0], o[mt], 0, 0, 0); o[mt] = __builtin_amdgcn_mfma_f32_16x16x32_bf16(bv1, sf[mt][1], o[mt], 0, 0, 0); }
                SB0();
                RDK(kfb, dvb, 4); SB0();
                MMK(kfa, dva, 0); SB0();
                MMK(kfb, dvb, 4); SB0();
#undef SB0
#undef RDQ
#undef MMQ
#undef RDK
#undef MMK
                const int cc = d == 0 ? (step < 4 ? 64 + step : step - 4) : 67 - step; const int row0 = row_of(bb, cc, 0);
#pragma unroll
                for (int mt = 0; mt < 4; ++mt) { u32x2 w; w.x = pg8::cvt_pk_bf16(o[mt][0], o[mt][1]); w.y = pg8::cvt_pk_bf16(o[mt][2], o[mt][3]);
                    *(u32x2*)(O + (size_t)(row0 + 16 * mt + c) * 1024 + h * 256 + vs * 32 + 16 * wid + 4 * g) = w; }
                LDS_BARRIER();
            }
        }
    }
}
#ifndef FAST_WALK
#define FAST_WALK 1
#endif

template <int MODE, int DIR>
__device__ __forceinline__ void st_rglru_impl(const Params& p, int vb, int nvb, unsigned char* lds_, const bf16_t* XR, const bf16_t* SG, const bf16_t* BD, float* SUMA, float* SUMH, bf16_t* Y) {
    typedef pg8::bf16x8 bx8; typedef pg8::f32x4 f4; typedef float f32x2v __attribute__((ext_vector_type(2)));
    LASP unsigned char* lds = (LASP unsigned char*)lds_;
    constexpr int AOFF = 0, FOFF = 17408, BUF = 51200, CWOFF = 2 * BUF;
    constexpr int ND = MODE == 0 ? 1 : 2, NCOMBO = MODE == 0 ? 32 : 16, NTILE = MODE == 0 ? NB * NCH : NB * 64;
    const int tid = threadIdx.x, wid = __builtin_amdgcn_readfirstlane(tid >> 6), lane = tid & 63, c = lane & 15, g = lane >> 4, cp = tid & 63, tg = tid >> 6;
    int P, part, cstep, combo0;
    if (nvb >= NCOMBO) { P = nvb / NCOMBO; part = vb / NCOMBO; cstep = NCOMBO; combo0 = vb % NCOMBO; if (part >= P) return; } else { P = 1; part = 0; cstep = nvb; combo0 = vb; }
    for (int combo = combo0; combo < NCOMBO; combo += cstep) {
        if (MODE == 0 && (combo & 1) != DIR) continue;
        const int nb = MODE == 0 ? (combo >> 1) : combo; constexpr int d0 = MODE == 0 ? DIR : 0;
        const int ch = nb * 128 + 16 * wid + c;
        bx8 wa[ND][4], wx[ND][4]; float ba[ND], bxx[ND], k8[ND];
        LDS_BARRIER();
#pragma unroll
        for (int dd = 0; dd < ND; ++dd) { constexpr int dzero = d0; const int d = dzero + dd;
            const bf16_t* wA = BD + ((size_t)(d * 16 + nb) * 128 + 16 * wid + c) * 128 + 8 * g; const bf16_t* wX = wA + (size_t)2 * 16 * 128 * 128;
#pragma unroll
            for (int ks = 0; ks < 4; ++ks) { wa[dd][ks] = *(const bx8*)(wA + 32 * ks); wx[dd][ks] = *(const bx8*)(wX + 32 * ks); }
            ba[dd] = p.o_b_a[d * 2048 + ch]; bxx[dd] = p.o_b_x[d * 2048 + ch]; k8[dd] = 8.f * 1.4426950408889634f * softplusf_(-p.o_lam[d * 2048 + ch]);
            if (tg < 5) { const f32x2v w2 = tg < 4 ? *(const f32x2v*)(p.o_conv_w + ((size_t)d * 4 + tg) * 2048 + nb * 128 + 2 * cp) : *(const f32x2v*)(p.o_conv_b + (size_t)d * 2048 + nb * 128 + 2 * cp);
                *(LASP f32x2v*)(lds + CWOFF + ((dd * 5 + tg) * 128 + 2 * cp) * 4) = w2; } }
        LDS_BARRIER();
        unsigned xr[14]; float cnext[2] = {0.f, 0.f};
#pragma unroll
        for (int jr = 0; jr < 14; ++jr) xr[jr] = 0u;
#define RG_PREF(tile) do { const int bb_ = MODE == 0 ? (tile) / NCH : (tile) >> 6, cc_ = MODE == 0 ? (tile) % NCH : (tile) & 63; const int row0_ = row_of(bb_, cc_, 0); \
            const bf16_t* xp_ = XR + (size_t)(row0_ + xr_pad_of_tile(row0_ >> 8) + 8 * tg - 3) * 2048 + nb * 128 + 2 * cp; \
            _Pragma("unroll") for (int jr = 0; jr < 14; ++jr) { if (MODE == 1 || (d0 == 0 ? jr < 11 : jr >= 3)) xr[jr] = *(const unsigned*)(xp_ + (size_t)jr * 2048); } \
            if (MODE == 1) { cnext[0] = SUMH[(((size_t)bb_ * 2 + 0) * NCH + cc_) * 2048 + ch]; cnext[1] = SUMH[(((size_t)bb_ * 2 + 1) * NCH + cc_) * 2048 + ch]; } } while (0)
        int it = 0;
        if (part < NTILE) RG_PREF(part);
        for (int tile = part; tile < NTILE; tile += P) {
            const int bb = MODE == 0 ? tile / NCH : tile >> 6, cc = MODE == 0 ? tile % NCH : tile & 63; const int row0 = row_of(bb, cc, 0);
            unsigned xcur[14]; float ccur[2];
#pragma unroll
            for (int jr = 0; jr < 14; ++jr) xcur[jr] = xr[jr];
            ccur[0] = cnext[0]; ccur[1] = cnext[1];
            if (tile + P < NTILE) RG_PREF(tile + P);
            float hsum[4][4];
#pragma unroll
            for (int dd = 0; dd < ND; ++dd) { constexpr int dzero = d0; const int d = dzero + dd;
                LASP unsigned char* B = lds + (it & 1) * BUF; ++it;
                { f32x2v cv[8]; const f32x2v cbv = *(const LASP f32x2v*)(lds + CWOFF + ((dd * 5 + 4) * 128 + 2 * cp) * 4);
#pragma unroll
                  for (int i = 0; i < 8; ++i) cv[i] = cbv;
#pragma unroll
                  for (int jj = 0; jj < 4; ++jj) { const f32x2v cwv = *(const LASP f32x2v*)(lds + CWOFF + ((dd * 5 + jj) * 128 + 2 * cp) * 4);
#pragma unroll
                      for (int i = 0; i < 8; ++i) { const int jr = d == 0 ? i + jj : i + 6 - jj; cv[i].x += cwv.x * __uint_as_float(xcur[jr] << 16); cv[i].y += cwv.y * __uint_as_float(xcur[jr] & 0xffff0000u); } }
#pragma unroll
                  for (int i = 0; i < 8; ++i) { const int rho = 16 * (2 * (tg & 1) + (i >> 2)) + 4 * (tg >> 1) + (i & 3);
                      *(LASP unsigned*)(B + AOFF + rho * 272 + 4 * cp) = pg8::cvt_pk_bf16(cv[i].x, cv[i].y); *(LASP f32x2v*)(B + FOFF + rho * 528 + 8 * cp) = cv[i]; } }
                LDS_BARRIER();
                const int gl = d == 0 ? g : 3 - g;
                const int src1 = d == 0 ? lane - 16 : lane + 16, src2 = d == 0 ? lane - 32 : lane + 32, srcT = d == 0 ? 48 + c : c;
                const size_t sidx = (((size_t)bb * 2 + d) * NCH + cc) * 2048 + ch;
                float av[16], uv[16]; float pa = 1.f, lh = 0.f;
#pragma unroll
                for (int mtl = 0; mtl < 4; ++mtl) { const int mt = d == 0 ? mtl : 3 - mtl;
                    f4 aam = (f4){0.f, 0.f, 0.f, 0.f}, axm = (f4){0.f, 0.f, 0.f, 0.f};
#pragma unroll
                    for (int ks = 0; ks < 4; ++ks) { const bx8 af = *(const LASP bx8*)(B + AOFF + (16 * mt + c) * 272 + (32 * ks + 8 * g) * 2);
                        aam = __builtin_amdgcn_mfma_f32_16x16x32_bf16(af, wa[dd][ks], aam, 0, 0, 0); axm = __builtin_amdgcn_mfma_f32_16x16x32_bf16(af, wx[dd][ks], axm, 0, 0, 0); }
#pragma unroll
                    for (int sq = 0; sq < 4; ++sq) { const int r = d == 0 ? sq : 3 - sq;
                        const float xv = *(const LASP float*)(B + FOFF + (16 * mt + 4 * g + r) * 528 + (16 * wid + c) * 4);
                        const float rr = sigmoidf_(aam[r] + ba[dd]), ii = sigmoidf_(axm[r] + bxx[dd]);
                        const float a = fexp2_(-k8[dd] * rr), u = __builtin_amdgcn_sqrtf(fmaxf(1.f - a * a, 0.f)) * (ii * xv);
                        lh = a * lh + u; pa *= a; if (MODE == 1) { av[mt * 4 + r] = a; uv[mt * 4 + r] = u; } }
                }
                float XA = pa, XU = lh, tA, tU;
                tA = __shfl(XA, src1); tU = __shfl(XU, src1); if (gl >= 1) { XU = tU * XA + XU; XA = tA * XA; }
                tA = __shfl(XA, src2); tU = __shfl(XU, src2); if (gl >= 2) { XU = tU * XA + XU; XA = tA * XA; }
                if (MODE == 0) { if (gl == 3) { SUMA[sidx] = XA; SUMH[sidx] = XU; } }
                else {
                    float eA = __shfl(XA, src1), eU = __shfl(XU, src1); if (gl == 0) { eA = 1.f; eU = 0.f; }
                    float hh = ccur[dd] * eA + eU;
#pragma unroll
                    for (int mtl = 0; mtl < 4; ++mtl) { const int mt = d == 0 ? mtl : 3 - mtl;
#pragma unroll
                        for (int sq = 0; sq < 4; ++sq) { const int r = d == 0 ? sq : 3 - sq; hh = av[mt * 4 + r] * hh + uv[mt * 4 + r]; if (dd == 0) hsum[mt][r] = hh; else hsum[mt][r] += hh; } }
                }
            }
            if (MODE == 1) {
#pragma unroll
                for (int mt = 0; mt < 4; ++mt)
#pragma unroll
                    for (int r = 0; r < 4; ++r) { const size_t o = (size_t)(row0 + 16 * g + 4 * mt + r) * 2048 + ch; Y[o] = f2bf(hsum[mt][r] * bf2f(SG[o])); }
            }
        }
        LDS_BARRIER();
#undef RG_PREF
    }
}
template <int MODE>
__device__ __forceinline__ void st_rglru(const Params& p, int vb, int nvb, unsigned char* lds_, const bf16_t* XR, const bf16_t* SG, const bf16_t* BD, float* SUMA, float* SUMH, bf16_t* Y) {
    if (MODE == 1) { st_rglru_impl<1, 0>(p, vb, nvb, lds_, XR, SG, BD, SUMA, SUMH, Y); return; }
    const int combo0 = nvb >= 32 ? vb % 32 : vb;
    if (nvb >= 32) { if ((combo0 & 1) == 0) st_rglru_impl<0, 0>(p, vb, nvb, lds_, XR, SG, BD, SUMA, SUMH, Y); else st_rglru_impl<0, 1>(p, vb, nvb, lds_, XR, SG, BD, SUMA, SUMH, Y); }
    else { st_rglru_impl<0, 0>(p, vb, nvb, lds_, XR, SG, BD, SUMA, SUMH, Y); st_rglru_impl<0, 1>(p, vb, nvb, lds_, XR, SG, BD, SUMA, SUMH, Y); }
}
#ifndef FAST_RG
#define FAST_RG 1
#endif


template <int WD>
__device__ __forceinline__ void rg1p_body(const Params& p, LASP unsigned char* lds, const bf16_t* XR, bf16_t* SGY, bf16_t* HXh, const bf16_t* BD, int bb, int nb, int sl) {
    typedef pg8::bf16x8 bx8; typedef pg8::f32x4 f4; typedef float f32x2v __attribute__((ext_vector_type(2)));
    constexpr int A0 = 0, A1 = 17408, CWOFF = 34816, EXOFF = CWOFF + 5120;
    const int tid = threadIdx.x, wid = __builtin_amdgcn_readfirstlane(tid >> 6), lane = tid & 63, c = lane & 15, g = lane >> 4, cp = lane, tg = wid;
    const int nt = (wid >> 1) & 1, hf = wid & 1;
    const int jch = sl * 32 + nt * 16 + c, ch = nb * 128 + jch;
    bx8 wa[4], wx[4];
    { const bf16_t* wA = BD + ((size_t)(WD * 16 + nb) * 128 + jch) * 128 + 8 * g; const bf16_t* wX = wA + (size_t)2 * 16 * 128 * 128;
#pragma unroll
      for (int ks = 0; ks < 4; ++ks) { wa[ks] = *(const bx8*)(wA + 32 * ks); wx[ks] = *(const bx8*)(wX + 32 * ks); } }
    const float ba = p.o_b_a[WD * 2048 + ch], bxx = p.o_b_x[WD * 2048 + ch], k8 = 8.f * 1.4426950408889634f * softplusf_(-p.o_lam[WD * 2048 + ch]);
    LDS_BARRIER();
#pragma unroll
    for (int dd = 0; dd < 2; ++dd)
        if (tg < 5) { const f32x2v w2 = tg < 4 ? *(const f32x2v*)(p.o_conv_w + ((size_t)dd * 4 + tg) * 2048 + nb * 128 + 2 * cp) : *(const f32x2v*)(p.o_conv_b + (size_t)dd * 2048 + nb * 128 + 2 * cp);
            *(LASP f32x2v*)(lds + CWOFF + ((dd * 5 + tg) * 128 + 2 * cp) * 4) = w2; }
    LDS_BARRIER();
    unsigned xr[22];
#define RG_CH(dd, step) ((dd) == 0 ? ((step) < 4 ? 64 + (step) : (step) - 4) : 67 - (step))
#define RG_PREF(step) do { _Pragma("unroll") for (int dd = 0; dd < 2; ++dd) { const int row0_ = row_of(bb, RG_CH(dd, step), 0); \
            const unsigned char* ub_ = (const unsigned char*)(XR + (size_t)(row0_ + xr_pad_of_tile(row0_ >> 8) + 8 * tg - 3 + 3 * dd) * 2048 + nb * 128);     \
            _Pragma("unroll") for (int j = 0; j < 11; ++j) xr[dd * 11 + j] = *(const unsigned*)(ub_ + (size_t)j * 4096 + (unsigned)(4 * cp)); } } while (0)
#ifndef REP_RG
#define REP_RG 0
#endif
  for (int rep_ = 0; rep_ <= REP_RG; ++rep_) {
    const bool dry = rep_ < REP_RG;
    RG_PREF(0);
    float carry = 0.f;
    const int gl = WD == 0 ? g : 3 - g;
    const int src1 = WD == 0 ? lane - 16 : lane + 16, src2 = WD == 0 ? lane - 32 : lane + 32, srcT = WD == 0 ? 48 + c : c;
    const bool amfirst = (hf == WD);
    for (int step = 0; step < NCH; ++step) {
        asm volatile("s_waitcnt vmcnt(0)" ::: "memory");
#pragma unroll
        for (int dd = 0; dd < 2; ++dd) {
            f32x2v cv[8], cw4[4]; const f32x2v cbv = *(const LASP f32x2v*)(lds + CWOFF + ((dd * 5 + 4) * 128 + 2 * cp) * 4);
#pragma unroll
            for (int jj = 0; jj < 4; ++jj) cw4[jj] = *(const LASP f32x2v*)(lds + CWOFF + ((dd * 5 + jj) * 128 + 2 * cp) * 4);
#pragma unroll
            for (int i = 0; i < 8; ++i) cv[i] = cbv;
#pragma unroll
            for (int jx = 0; jx < 11; ++jx) { const unsigned xw = xr[dd * 11 + jx]; const f32x2v xv2 = (f32x2v){__uint_as_float(xw << 16), __uint_as_float(xw & 0xffff0000u)};
#pragma unroll
                for (int jj = 0; jj < 4; ++jj) { const int i = dd == 0 ? jx - jj : jx - 3 + jj; if (i >= 0 && i < 8) cv[i] = __builtin_elementwise_fma(cw4[jj], xv2, cv[i]); } }
#pragma unroll
            for (int i = 0; i < 8; ++i) { const int rho = 32 * (tg >> 2) + 16 * (i >> 2) + 4 * (tg & 3) + (i & 3);
                *(LASP unsigned*)(lds + (dd == 0 ? A0 : A1) + rho * 272 + 4 * cp) = pg8::cvt_pk_bf16(cv[i].x, cv[i].y); }
        }
        LDS_BARRIER();
        if (step + 1 < NCH) RG_PREF(step + 1);
        const int cc = RG_CH(WD, step); const bool latent = cc < 64 && !dry, second = step - 4 > 31;
        const size_t orow = (size_t)row_of(bb, cc, 0) + 32 * hf + 8 * g;
        unsigned short hxv[8], sgv[8];
        if (latent && second) {
#pragma unroll
            for (int e = 0; e < 8; ++e) { hxv[e] = HXh[(orow + e) * 1024 + (ch & 1023)]; sgv[e] = SGY[(orow + e) * 2048 + ch]; } }
        const LASP unsigned char* A = lds + (WD == 0 ? A0 : A1);
        float av[8], uv[8]; float pa = 1.f, lh = 0.f;
#pragma unroll
        for (int ml = 0; ml < 2; ++ml) { const int mt = WD == 0 ? ml : 1 - ml;
            f4 aam = (f4){0.f, 0.f, 0.f, 0.f}, axm = (f4){0.f, 0.f, 0.f, 0.f};
#pragma unroll
            for (int ks = 0; ks < 4; ++ks) { const bx8 af = *(const LASP bx8*)(A + (32 * hf + 16 * mt + c) * 272 + (32 * ks + 8 * g) * 2);
                aam = __builtin_amdgcn_mfma_f32_16x16x32_bf16(af, wa[ks], aam, 0, 0, 0); axm = __builtin_amdgcn_mfma_f32_16x16x32_bf16(af, wx[ks], axm, 0, 0, 0); }
#pragma unroll
            for (int sq = 0; sq < 4; ++sq) { const int r = WD == 0 ? sq : 3 - sq;
                const float xv = bf2f(*(const LASP unsigned short*)(A + (32 * hf + 16 * mt + 4 * g + r) * 272 + jch * 2));
                const float rr = sigmoidf_(aam[r] + ba), ii = sigmoidf_(axm[r] + bxx);
                const float a = fexp2_(-k8 * rr), u = __builtin_amdgcn_sqrtf(fmaxf(1.f - a * a, 0.f)) * (ii * xv);
                lh = a * lh + u; pa *= a; av[mt * 4 + r] = a; uv[mt * 4 + r] = u; }
        }
        float XA = pa, XU = lh, tA, tU;
        tA = __shfl(XA, src1); tU = __shfl(XU, src1); if (gl >= 1) { XU = tU * XA + XU; XA = tA * XA; }
        tA = __shfl(XA, src2); tU = __shfl(XU, src2); if (gl >= 2) { XU = tU * XA + XU; XA = tA * XA; }
        float eA = __shfl(XA, src1), eU = __shfl(XU, src1); if (gl == 0) { eA = 1.f; eU = 0.f; }
        const float myA = __shfl(XA, srcT), myU = __shfl(XU, srcT);
        if (gl == 3) *(LASP f32x2v*)(lds + EXOFF + (((WD * 2 + nt) * 2 + hf) * 16 + c) * 8) = (f32x2v){XA, XU};
        LDS_BARRIER();
        const f32x2v oth = *(const LASP f32x2v*)(lds + EXOFF + (((WD * 2 + nt) * 2 + (1 - hf)) * 16 + c) * 8);
        const float hin_half = amfirst ? carry : carry * oth.x + oth.y;
        carry = amfirst ? (carry * myA + myU) * oth.x + oth.y : (carry * oth.x + oth.y) * myA + myU;
        if (latent) {
            float hh = hin_half * eA + eU;
#pragma unroll
            for (int ml = 0; ml < 2; ++ml) { const int mt = WD == 0 ? ml : 1 - ml;
#pragma unroll
                for (int sq = 0; sq < 4; ++sq) { const int r = WD == 0 ? sq : 3 - sq; const int e = mt * 4 + r; hh = av[e] * hh + uv[e];
                    const bf16_t hb = f2bf(hh);
                    if (!second) HXh[(orow + e) * 1024 + (ch & 1023)] = hb;
                    else SGY[(orow + e) * 2048 + ch] = f2bf((bf2f(hb) + bf2f(hxv[e])) * bf2f(sgv[e])); } }
        }
    }
    asm volatile("" :: "v"(carry));
    LDS_BARRIER();
  }
#undef RG_PREF
#undef RG_CH
}
__device__ __forceinline__ void st_rg1p(const Params& p, int vb, int nvb, unsigned char* lds_, const bf16_t* XR, bf16_t* SGY, bf16_t* HX0, bf16_t* HX1, const bf16_t* BD, const float* XRC) {
    LASP unsigned char* lds = (LASP unsigned char*)lds_;
    const int wid = __builtin_amdgcn_readfirstlane(threadIdx.x >> 6);
    for (int it0 = vb; it0 < 256; it0 += nvb) {
        const int item = (nvb == 256) ? ((it0 & 7) * 32 + (it0 >> 3)) : it0;
        const int sl = item & 3, nb = (item >> 2) & 15, bb = item >> 6;
        bf16_t* HXh = nb < 8 ? HX0 : HX1;
        {
          bf16_t* xd = (bf16_t*)XR + (size_t)(NLAT + bb * 256 + 20 + 4 * bb) * 2048 + nb * 128; const float* xs = XRC + (size_t)(bb * 256) * 2048 + nb * 128;
          for (int e = threadIdx.x; e < 256 * 64; e += NTHREADS) { const int r = e >> 6, cpair = e & 63; const float2 v0 = *(const float2*)(xs + (size_t)r * 2048 + 2 * cpair), v1 = *(const float2*)(xs + (size_t)NCTX * 2048 + (size_t)r * 2048 + 2 * cpair); *(unsigned*)(xd + (size_t)r * 2048 + 2 * cpair) = pg8::cvt_pk_bf16(v0.x + v1.x, v0.y + v1.y); }
          asm volatile("s_waitcnt vmcnt(0)" ::: "memory"); LDS_BARRIER(); }
        if (wid < 4) rg1p_body<0>(p, lds, XR, SGY, HXh, BD, bb, nb, sl); else rg1p_body<1>(p, lds, XR, SGY, HXh, BD, bb, nb, sl);
    }
}
#define XB_TMO      128
#define XB_XCNT(j)  (256  + 64 * (j))
#define XB_XSUB(j)  (1280 + 64 * (j))
#define XB_XGEN(j)  (2304 + 64 * (j))
#define XB_TOP      3328
#define XB_TOPGEN   3392
#define XB_SPIN_CAP (1u << 20)
DEVI unsigned xb_ld(unsigned* p)              { return __hip_atomic_load(p, __ATOMIC_RELAXED, __HIP_MEMORY_SCOPE_AGENT); }
DEVI unsigned xb_add(unsigned* p, unsigned v) { return __hip_atomic_fetch_add(p, v, __ATOMIC_RELAXED, __HIP_MEMORY_SCOPE_AGENT); }
DEVI unsigned xb_xcc_id() { return (unsigned)__builtin_amdgcn_s_getreg((3 << 11) | 20) & 0xFu; }
#define XB_SPIN(cond, bar) do { unsigned _sp = 0; while (cond) { __builtin_amdgcn_s_sleep(1); \
    if ((++_sp & 255u) == 0u) { if (xb_ld(&(bar)[XB_TMO])) break; if (_sp > XB_SPIN_CAP) { atomicAdd(&(bar)[XB_TMO], 1u); break; } } } } while (0)
struct XcdBarrier { unsigned* bar; unsigned x; volatile __attribute__((address_space(3))) unsigned* st; };
DEVI XcdBarrier xcd_barrier_post(unsigned* bar, volatile __attribute__((address_space(3))) unsigned* st) {
    XcdBarrier b; b.bar = bar; b.x = xb_xcc_id(); b.st = st;
    if (threadIdx.x == 0) (void)xb_add(&bar[XB_XCNT(b.x)], 1u);
    return b;
}
DEVI void xcd_barrier_complete(unsigned* bar, unsigned x, unsigned& nloc, unsigned& nx) {
    const unsigned G = gridDim.x * gridDim.y * gridDim.z;
    unsigned sum, cnt, mine, sp = 0u;
    for (;;) {
        sum = 0u; cnt = 0u; mine = 0u;
#pragma unroll
        for (unsigned j = 0; j < 16; ++j) { const unsigned c = xb_ld(&bar[XB_XCNT(j)]); sum += c; cnt += (c > 0u) ? 1u : 0u; mine = (j == x) ? c : mine; }
        if (sum == G) break;
        __builtin_amdgcn_s_sleep(1);
        if ((++sp & 255u) == 0u) { if (xb_ld(&bar[XB_TMO])) break; if (sp > XB_SPIN_CAP) { atomicAdd(&bar[XB_TMO], 1u); break; } }
    }
    nloc = mine > 0u ? mine : 1u; nx = cnt > 0u ? cnt : 1u;
}
DEVI void xcd_barrier(const XcdBarrier& b) {
    asm volatile("s_waitcnt vmcnt(0)" ::: "memory");
    __syncthreads();
    if (threadIdx.x == 0) {
        unsigned* bar = b.bar;
        __builtin_amdgcn_s_waitcnt(0);
        unsigned nloc = b.st[0], nx = b.st[1];
        if (nloc == 0u) { xcd_barrier_complete(bar, b.x, nloc, nx); b.st[0] = nloc; b.st[1] = nx; }
        const unsigned old = xb_add(&bar[XB_XSUB(b.x)], 1u);
        const unsigned gen = old / nloc;
        if (old + 1u == (gen + 1u) * nloc) {
            __builtin_amdgcn_fence(__ATOMIC_RELEASE, "agent");
            asm volatile("s_waitcnt vmcnt(0)" ::: "memory");
            const unsigned og = xb_add(&bar[XB_TOP], 1u);
            const unsigned tg = og / nx;
            if (og + 1u == (tg + 1u) * nx) xb_add(&bar[XB_TOPGEN], 1u);
            else XB_SPIN(xb_ld(&bar[XB_TOPGEN]) == tg, bar);
            __builtin_amdgcn_fence(__ATOMIC_ACQUIRE, "agent");
            xb_add(&bar[XB_XGEN(b.x)], 1u);
            asm volatile("s_waitcnt vmcnt(0)" ::: "memory");
        } else {
            XB_SPIN(xb_ld(&bar[XB_XGEN(b.x)]) == gen, bar);
            __builtin_amdgcn_fence(__ATOMIC_ACQUIRE, "agent");
            asm volatile("s_waitcnt vmcnt(0)" ::: "memory");
        }
    }
    __syncthreads();
}
__device__ __forceinline__ void run_stage(const Params& p, int st, int vb, int nvb, unsigned char* lds) {
    unsigned char* ws = p.ws;
    float* MOD = (float*)(ws + WS_MOD); float* ALR = (float*)(ws + WS_ALR); float* X1C = (float*)(ws + WS_X1C);
    float* SUMA = (float*)(ws + WS_SUMA); float* SUMH = (float*)(ws + WS_SUMH); float* DEC = (float*)(ws + WS_DEC);
    bf16_t* Bt1 = (bf16_t*)(ws + WS_BT1); bf16_t* Bt2 = (bf16_t*)(ws + WS_BT2); bf16_t* Bt3 = (bf16_t*)(ws + WS_BT3); bf16_t* Bt4 = (bf16_t*)(ws + WS_BT4);
    bf16_t* S0 = (bf16_t*)(ws + WS_SLOT(0)); bf16_t* S1 = (bf16_t*)(ws + WS_SLOT(1)); bf16_t* S2 = (bf16_t*)(ws + WS_SLOT(2));
    bf16_t* S3 = (bf16_t*)(ws + WS_SLOT(3)); bf16_t* S4 = (bf16_t*)(ws + WS_SLOT(4)); bf16_t* S5 = (bf16_t*)(ws + WS_SLOT(5));
    bf16_t* DO0 = (bf16_t*)p.out; bf16_t* DOSC = (bf16_t*)((unsigned char*)p.out + 34 * MiB); bf16_t* DOZA = (bf16_t*)((unsigned char*)p.out + 51 * MiB);
    float* XRC = (float*)(ws + WS_BT1);
    float* SLAB2 = (float*)(ws + WS_SLOT(5) + 262144);
    switch (st) {
    case 0: st_mod(p, vb, nvb, (float*)lds); st_wprep(p, vb, nvb, lds); break;
    case 1: st_modulate(p, vb, nvb, 0, p.x, p.ctx, S0); break;
    case 3: st_glaprep(p, vb, nvb, lds, S1, S2, ALR, S3, S4, DOSC, DEC, S5); break;
#if FAST_WALK
    case 4: st_glawalk(p, vb, nvb, lds, S3, S4, DOSC, DEC, S5, S2, DO0); break;
#else
    case 4: st_glawalk_naive(p, vb, nvb, (float*)lds, S3, S4, DOSC, DEC, S5, S2, DO0); break;
#endif
    case 6: st_inner(p, vb, nvb, S2, DO0, S3, S4, S5, S0, DOZA, X1C); break;
    case 8: st_modulate(p, vb, nvb, 1, p.out, p.ctx, S2, SLAB2, 8, MOD + 4 * 3072 + 2048, nvb == 256 ? NLAT : 0);
            {
              for (int e = vb * NTHREADS + threadIdx.x; e < 9 * 4 * 256; e += nvb * NTHREADS) { const int gi = e >> 10, w = e & 1023; const int r0 = gi < 4 ? 4096 * gi + 4 * gi : (gi < 8 ? NLAT + 16 + 256 * (gi - 4) + 4 * (gi - 4) : NT + 32);
                  *(uint4*)(S3 + (size_t)r0 * 2048 + w * 8) = uint4{0u, 0u, 0u, 0u}; } }
            break;
    case 10: st_rg1p(p, vb, nvb, lds, S3, S0, S2, S5 + 131072, (const bf16_t*)(ws + WS_BD), XRC); break;
    case 14: if (nvb != 256) st_final(p, vb, nvb); break;
#if FAST_GEMM
    case 2: { FEpi1 E{S1, S2, S3, S4, S5, ALR, DOZA}; pg8::Gemm g{S0, Bt1, NT, N1, 1024}; pg8::TileOrder S; S.init(NT / 256, 11, 16, nvb, vb, 0, 8, 0, 12);
              pg8::gemm_phase<FEpi1, pg8::TileOrder, true, true>((PG8_LAS unsigned char*)lds, g, S, E); } break;
    case 5: { FEpi1 E{S1, S2, S3, S4, S5, ALR, DOZA}; pg8::Gemm g{S0, Bt1, NT, N1, 1024}; pg8::TileOrder S; S.init(NT / 256, 18, 16, nvb, vb, 0, 4, 8, 15);
              pg8::gemm_phase<FEpi1, pg8::TileOrder, true, true>((PG8_LAS unsigned char*)lds, g, S, E); } break;
    case 7: if (nvb == 256) { FEpiResMod E{p.x, p.out, S2, MOD, MOD + 5 * 3072, p.norm_g + 1024, SLAB2, (float*)(ws + WS_CTL + 131072 + 262144), (unsigned*)(ws + WS_CTL + 65536 + 16384)};
                  pg8::Gemm g{S0, Bt2, NT, 1024, 2048}; pg8::TileOrder S; S.init(NLAT / 256, 4, 32, nvb, vb, 0, 1 << 30, 0, 0, NCTX / 256, 4, NLAT / 256, 8, 4); S.tail_first = 1;
                  pg8::gemm_phase<FEpiResMod, pg8::TileOrder, false, true>((PG8_LAS unsigned char*)lds, g, S, E); }
            else { FEpiRes<true> E{p.x, p.ctx, p.out, SLAB2, MOD}; pg8::Gemm g{S0, Bt2, NT, 1024, 2048}; pg8::TileOrder S; S.init(NLAT / 256, 4, 32, nvb, vb, 0, 1 << 30, 0, 0, NCTX / 256, 4, NLAT / 256, 8, 4);
                  pg8::gemm_phase<FEpiRes<true>, pg8::TileOrder, true, true>((PG8_LAS unsigned char*)lds, g, S, E); } break;
    case 9: { FEpi3 E{S3, S0, XRC}; pg8::Gemm g{S2, Bt3, NT, 4096, 1024}; pg8::TileOrder S; S.init(NLAT / 256, 16, 16, nvb, vb, 0, 1 << 30, 0, 0, NCTX / 256, 8, NLAT / 256, 2, 8);
              pg8::gemm_phase<FEpi3, pg8::TileOrder, true, true>((PG8_LAS unsigned char*)lds, g, S, E); } break;
    case 13: if (nvb == 256) { FEpiResRms E{p.out, p.out, MOD + 5 * 3072, p.final_g, (float*)(ws + WS_CTL + 131072), (unsigned*)(ws + WS_CTL + 65536)}; pg8::Gemm g{S0, Bt4, NLAT, 1024, 2048}; pg8::TileOrder S; S.init(NLAT / 256, 4, 32, nvb, vb);
                  pg8::gemm_phase<FEpiResRms, pg8::TileOrder, false, true>((PG8_LAS unsigned char*)lds, g, S, E); }
             else { FEpiRes<false> E{p.out, nullptr, p.out, nullptr, MOD + 5 * 3072}; pg8::Gemm g{S0, Bt4, NLAT, 1024, 2048}; pg8::TileOrder S; S.init(NLAT / 256, 4, 32, nvb, vb);
                  pg8::gemm_phase<FEpiRes<false>, pg8::TileOrder, true, true>((PG8_LAS unsigned char*)lds, g, S, E); } break;
#else
    case 2: { Epi1 E{S1, S2, S3, S4, S5, ALR}; st_gemm_naive(vb, nvb, (float*)lds, S0, Bt1, 0, NT / 32, 0, 8, 1024, E); st_gemm_naive(vb, nvb, (float*)lds, S0, Bt1, 0, NT / 32, 12, 13, 1024, E); } break;
    case 5: { Epi1 E{S1, S2, S3, S4, S5, ALR}; st_gemm_naive(vb, nvb, (float*)lds, S0, Bt1, 0, NT / 32, 8, 12, 1024, E); st_gemm_naive(vb, nvb, (float*)lds, S0, Bt1, 0, NT / 32, 13, 29, 1024, E); } break;
    case 7: { EpiRes E{p.x, p.ctx, p.out, X1C, MOD}; st_gemm_naive(vb, nvb, (float*)lds, S0, Bt2, 0, NT / 32, 0, 4, 2048, E); } break;
    case 9: { Epi3 E{S3, S0}; st_gemm_naive(vb, nvb, (float*)lds, S2, Bt3, 0, NLAT / 32, 0, 16, 1024, E); st_gemm_naive(vb, nvb, (float*)lds, S2, Bt3, NLAT / 32, NT / 32, 0, 8, 1024, E); } break;
    case 13: { EpiRes E{p.out, nullptr, p.out, nullptr, MOD + 5 * 3072}; st_gemm_naive(vb, nvb, (float*)lds, S0, Bt4, 0, NLAT / 32, 0, 4, 2048, E); } break;
#endif
    }
}
constexpr int NSTAGES = 15;
constexpr int LDS_BYTES = 147456;

#ifndef ONE_LAUNCH
#define ONE_LAUNCH 1
#endif
#if !ONE_LAUNCH
__global__ void __launch_bounds__(NTHREADS) k_mega(Params p, int st) {
    extern __shared__ __attribute__((aligned(16))) unsigned char lds[];
    run_stage(p, st, blockIdx.x, gridDim.x, lds);
}
#else
__global__ void __launch_bounds__(NTHREADS) k_mega(Params p) {
    extern __shared__ __attribute__((aligned(16))) unsigned char lds[];
    volatile __attribute__((address_space(3))) unsigned* st = (volatile __attribute__((address_space(3))) unsigned*)((__attribute__((address_space(3))) unsigned char*)lds + (LDS_BYTES - 64));
    if (threadIdx.x < 2) st[threadIdx.x] = 0u;
    __syncthreads();
    const XcdBarrier bar = xcd_barrier_post((unsigned*)(p.ws + WS_CTL) + 4096, st);
#ifndef REP_STAGE
#define REP_STAGE -1
#endif
#ifndef REP_N
#define REP_N 1
#endif
#define RS(k) do { run_stage(p, k, blockIdx.x, gridDim.x, lds); if ((k) == REP_STAGE) { for (int rep_ = 0; rep_ < REP_N; ++rep_) { xcd_barrier(bar); run_stage(p, k, blockIdx.x, gridDim.x, lds); } } } while (0)
#define GS() xcd_barrier(bar)
    RS(0); GS(); RS(1); GS(); RS(2); GS(); RS(3); GS(); RS(4); GS(); RS(5); GS(); RS(6); GS(); RS(7); GS();
    RS(8); GS(); RS(9); GS(); RS(10); GS(); RS(13); if (gridDim.x != 256) { GS(); RS(14); }
#undef RS
#undef GS
}
#endif

extern "C" void kernel_launch(void* const* d_in, const int* in_sizes, int n_in, void* d_out, int out_size, void* d_ws, size_t ws_size, hipStream_t stream) {
    static int inited = 0, grid_blocks = 0;
    if (!inited) {
        if (n_in != 23 || ws_size < WS_END || out_size != NLAT * D) { fprintf(stderr, "kernel_launch: unexpected shapes n_in %d ws %zu out %d\n", n_in, ws_size, out_size); inited = -1; return; }
        if (hipFuncSetAttribute((const void*)k_mega, hipFuncAttributeMaxDynamicSharedMemorySize, LDS_BYTES) != hipSuccess) { fprintf(stderr, "hipFuncSetAttribute failed\n"); inited = -1; return; }
        int dev = 0, cus = 0, per_cu = 0;
        (void)hipGetDevice(&dev); (void)hipDeviceGetAttribute(&cus, hipDeviceAttributeMultiprocessorCount, dev);
        (void)hipOccupancyMaxActiveBlocksPerMultiprocessor(&per_cu, (const void*)k_mega, NTHREADS, LDS_BYTES);
        if (per_cu < 1) { fprintf(stderr, "kernel_launch: occupancy query says %d blocks per CU\n", per_cu); per_cu = 1; }
        if (per_cu > 1) per_cu = 1;
        grid_blocks = cus * per_cu;
        inited = 1;
    }
    if (inited < 0) return;
    Params p{};
    const float** f = (const float**)&p;
    for (int i = 0; i < 23; ++i) f[i] = (const float*)d_in[i];
    p.out = (float*)d_out; p.ws = (unsigned char*)d_ws;
    (void)hipMemsetAsync((unsigned char*)d_ws + WS_CTL, 0, 2 * MiB, stream);
#if ONE_LAUNCH
    void* args[] = {&p};
    hipError_t e = hipLaunchCooperativeKernel((const void*)k_mega, dim3(grid_blocks), dim3(NTHREADS), args, LDS_BYTES, stream);
    if (e != hipSuccess) fprintf(stderr, "cooperative launch failed: %s (grid %d)\n", hipGetErrorString(e), grid_blocks);
#else
    for (int st = 0; st < NSTAGES; ++st) hipLaunchKernelGGL(k_mega, dim3(1024), dim3(NTHREADS), LDS_BYTES, stream, p, st);
#endif
}
```

```cpp
#include <hip/hip_runtime.h>
#include <hip/hip_cooperative_groups.h>
namespace cg = cooperative_groups;
#include <cstdio>
#include <cstdint>

typedef unsigned short bf16_t;
#define DEVI __device__ __forceinline__
#define LDS_BARRIER() do { asm volatile("s_waitcnt lgkmcnt(0)" ::: "memory"); __builtin_amdgcn_s_barrier(); asm volatile("" ::: "memory"); } while (0)

constexpr int D = 1024, NB = 4, SEQ = 4096, CTXL = 256;
constexpr int NLAT = NB * SEQ;
constexpr int NCTX = NB * CTXL;
constexpr int NT = NLAT + NCTX;
constexpr int NCH = 68;
constexpr int EVEN_IN = 7200;
constexpr int N1 = 7424;
constexpr int N1A = 13 * 256;
constexpr int RGW = 2048;
constexpr float EPS = 1e-6f;

constexpr size_t MiB = 1u << 20;
constexpr size_t WS_CTL = 0;
constexpr size_t WS_MOD = 1 * MiB;
constexpr size_t WS_ALR = 2 * MiB;
constexpr size_t WS_X1C = 5 * MiB;
constexpr size_t WS_SUMA = 9 * MiB;
constexpr size_t WS_SUMH = 9 * MiB + 4608 * 1024;
constexpr size_t WS_DEC = 18 * MiB;
constexpr size_t WS_BT1 = 19 * MiB + 512 * 1024;
constexpr size_t WS_BT2 = 34 * MiB;
constexpr size_t WS_BT3 = 38 * MiB;
constexpr size_t WS_BT4 = 46 * MiB;
constexpr size_t WS_BD = 50 * MiB;
constexpr size_t WS_S0 = 52 * MiB;
constexpr size_t SLOT = 34 * MiB;
constexpr size_t WS_END = WS_S0 + 6 * SLOT;
static_assert(WS_END == 256 * MiB, "ws map");
#define WS_SLOT(i) (WS_S0 + (size_t)(i) * SLOT)

struct Params {
    const float* x; const float* c; const float* ctx; const float* c_ctx; const float* norm_g; const float* w_mod; const float* b_mod;
    const float* e_w_in; const float* e_w_a2; const float* e_b_a2; const float* e_gla_g; const float* e_conv_w; const float* e_w_out;
    const float* o_w_in; const float* o_conv_w; const float* o_conv_b; const float* o_w_a; const float* o_b_a; const float* o_w_x; const float* o_b_x;
    const float* o_lam; const float* o_w_out; const float* final_g;
    float* out; unsigned char* ws;
};

DEVI float bf2f(bf16_t v) { return __uint_as_float((unsigned)v << 16); }
DEVI bf16_t f2bf(float f) { unsigned u = __float_as_uint(f); return (bf16_t)((u + 0x7fffu + ((u >> 16) & 1u)) >> 16); }
DEVI unsigned pk2(float lo, float hi) { return (unsigned)f2bf(lo) | ((unsigned)f2bf(hi) << 16); }
DEVI float fexp2_(float x) { return __builtin_amdgcn_exp2f(x); }
DEVI float frcp_(float x) { return __builtin_amdgcn_rcpf(x); }
DEVI float sigmoidf_(float x) { return frcp_(1.0f + fexp2_(-1.4426950408889634f * x)); }
DEVI float siluf_(float x) { return x * frcp_(1.0f + fexp2_(-1.4426950408889634f * x)); }
DEVI float softplusf_(float x) { return fmaxf(x, 0.f) + log1pf(__expf(-fabsf(x))); }
DEVI float logsigmoidf_(float x) { return fminf(x, 0.f) - 0.6931471805599453f * __builtin_amdgcn_logf(1.0f + fexp2_(-1.4426950408889634f * fabsf(x))); }
DEVI int row_of(int bb, int c, int t) { return c < 64 ? bb * 4096 + c * 64 + t : NLAT + bb * 256 + (c - 64) * 64 + t; }
DEVI int mod_idx(int row) { return row < NLAT ? (row >> 12) : 4; }
DEVI int xr_pad_of_tile(int pm) { return pm < 64 ? 4 * ((pm >> 4) + 1) : 20 + 4 * (pm - 64); }
constexpr int XR_ROWS = NT + 36;
DEVI float wave_sum(float v) {
#pragma unroll
    for (int o = 1; o < 64; o <<= 1) v += __shfl_xor(v, o);
    return v;
}
__host__ __device__ inline int colmap1(int n) {
    const int t = n >> 8, c = n & 255;
    if (t < 12) return n;
    if (t == 12) return c < 32 ? 3072 + c : -1;
    if (t < 21) { const int j = t - 13; return c < 128 ? 4128 + 128 * j + c : 5152 + 128 * j + (c - 128); }
    const int j = t - 21; return c < 128 ? 3104 + 128 * j + c : 6176 + 128 * j + (c - 128);
}

#define NTHREADS 512

__device__ void st_mod(const Params& p, int vb, int nvb, float* lds) {
    float* MOD = (float*)(p.ws + WS_MOD);
    for (int i = threadIdx.x; i < 5 * 1024; i += NTHREADS) { const int s = i >> 10, k = i & 1023; const float v = s < 4 ? p.c[s * 1024 + k] : p.c_ctx[k]; lds[i] = siluf_(v); }
    __syncthreads();
    const int lane = threadIdx.x & 63, gw = vb * (NTHREADS / 64) + (threadIdx.x >> 6), ngw = nvb * (NTHREADS / 64);
    for (int it = gw; it < 2 * 48 * 32; it += ngw) {
        const int kc = it & 31, cb = (it >> 5) % 48, li = it / (32 * 48), j = cb * 64 + lane, k0 = kc * 32;
        const float* W = p.w_mod + ((size_t)li * 1024 + k0) * 3072 + j;
        float wv[32];
#pragma unroll
        for (int k = 0; k < 32; ++k) wv[k] = W[(size_t)k * 3072];
        float a0 = 0.f, a1 = 0.f, a2 = 0.f, a3 = 0.f, a4 = 0.f;
#pragma unroll
        for (int k = 0; k < 32; ++k) { const float w = wv[k]; a0 += lds[k0 + k] * w; a1 += lds[1024 + k0 + k] * w; a2 += lds[2048 + k0 + k] * w; a3 += lds[3072 + k0 + k] * w; a4 += lds[4096 + k0 + k] * w; }
        const float bv = kc == 0 ? p.b_mod[li * 3072 + j] : 0.f;
        float* o = MOD + (size_t)li * 5 * 3072 + j;
        atomicAdd(o, a0 + bv); atomicAdd(o + 3072, a1 + bv); atomicAdd(o + 2 * 3072, a2 + bv); atomicAdd(o + 3 * 3072, a3 + bv); atomicAdd(o + 4 * 3072, a4 + bv);
    }
    __syncthreads();
}

__device__ __forceinline__ void wt_item(const float* src, int ldw, bf16_t* dst, int K, int k0, __attribute__((address_space(3))) float* scr, int lane) {
    typedef unsigned v4u __attribute__((ext_vector_type(4)));
    if (src) {
#pragma unroll 8
        for (int i = 0; i < 32; ++i) { const int kk = 2 * i + (lane >> 5); scr[kk * 33 + (lane & 31)] = src[(size_t)(k0 + kk) * ldw + (lane & 31)]; }
    }
    asm volatile("s_waitcnt lgkmcnt(0)" ::: "memory");
    const int cch = lane & 7;
#pragma unroll
    for (int j = 0; j < 4; ++j) { const int n = (lane >> 3) + 8 * j; const __attribute__((address_space(3))) float* sp = scr + (8 * cch) * 33 + n;
        v4u o = {0u, 0u, 0u, 0u};
        if (src) { o.x = pk2(sp[0 * 33], sp[1 * 33]); o.y = pk2(sp[2 * 33], sp[3 * 33]); o.z = pk2(sp[4 * 33], sp[5 * 33]); o.w = pk2(sp[6 * 33], sp[7 * 33]); }
        *(v4u*)(dst + (size_t)n * K + k0 + 8 * cch) = o; }
    asm volatile("s_waitcnt lgkmcnt(0)" ::: "memory");
}
__device__ void st_wprep(const Params& p, int vb, int nvb, unsigned char* lds_) {
    bf16_t* Bt1 = (bf16_t*)(p.ws + WS_BT1); bf16_t* Bt2 = (bf16_t*)(p.ws + WS_BT2); bf16_t* Bt3 = (bf16_t*)(p.ws + WS_BT3); bf16_t* Bt4 = (bf16_t*)(p.ws + WS_BT4);
    bf16_t* BD = (bf16_t*)(p.ws + WS_BD);
    const int lane = threadIdx.x & 63, wv = threadIdx.x >> 6, gw = vb * (NTHREADS / 64) + wv, ngw = nvb * (NTHREADS / 64);
    __attribute__((address_space(3))) float* scr = (__attribute__((address_space(3))) float*)lds_ + 8192 + wv * (64 * 33);
    constexpr int I1 = 16 * (N1 / 32), I2 = 32 * 32, I3 = 16 * 128, I4 = 32 * 32, I5 = 64 * 8;
    for (int it = gw; it < I1 + I2 + I3 + I4 + I5; it += ngw) {
        int r = it;
        if (r < I1) { const int nbk = N1 / 32, kb = r / nbk, nb = r % nbk; const int sc = colmap1(nb * 32); wt_item(sc < 0 ? nullptr : p.e_w_in + sc, EVEN_IN, Bt1 + (size_t)nb * 32 * 1024, 1024, kb * 64, scr, lane); continue; } r -= I1;
        if (r < I2) { const int kb = r / 32, nb = r % 32; wt_item(p.e_w_out + nb * 32, 1024, Bt2 + (size_t)nb * 32 * 2048, 2048, kb * 64, scr, lane); continue; } r -= I2;
        if (r < I3) { const int kb = r / 128, nb = r % 128; wt_item(p.o_w_in + nb * 32, 4096, Bt3 + (size_t)nb * 32 * 1024, 1024, kb * 64, scr, lane); continue; } r -= I3;
        if (r < I4) { const int kb = r / 32, nb = r % 32; wt_item(p.o_w_out + nb * 32, 1024, Bt4 + (size_t)nb * 32 * 2048, 2048, kb * 64, scr, lane); continue; } r -= I4;
        { const int m = r >> 8, dn = (r >> 3) & 31, kb = (r >> 2) & 1, nb = r & 3; const float* W = (m == 0 ? p.o_w_a : p.o_w_x) + (size_t)dn * 16384;
          wt_item(W + nb * 32, 128, BD + (size_t)m * 2 * 16 * 16384 + (size_t)dn * 16384 + (size_t)nb * 32 * 128, 128, kb * 64, scr, lane); }
    }
}

__device__ void st_modulate(const Params& p, int vb, int nvb, int li, const float* xlat, const float* xctx, bf16_t* H, const float* slab = nullptr, int nslab = 0, const float* gatec = nullptr, int row_begin = 0) {
    const float* MOD = (const float*)(p.ws + WS_MOD) + (size_t)li * 5 * 3072;
    const float* g = p.norm_g + li * 1024;
    const int lane = threadIdx.x & 63, gw = vb * (NTHREADS / 64) + (threadIdx.x >> 6), ngw = nvb * (NTHREADS / 64);
    for (int row = row_begin + gw; row < NT; row += ngw) {
        const float* xr = row < NLAT ? xlat + (size_t)row * 1024 : xctx + (size_t)(row - NLAT) * 1024;
        const float* md = MOD + (size_t)mod_idx(row) * 3072;
        float4 v[4]; float ss = 0.f;
#pragma unroll
        for (int j = 0; j < 4; ++j) { v[j] = *(const float4*)(xr + j * 256 + lane * 4);
            if (slab && row >= NLAT) {
                float4 a = {0.f, 0.f, 0.f, 0.f};
                for (int ks = 0; ks < nslab; ++ks) { const float4 t = *(const float4*)(slab + ((size_t)ks * NCTX + (row - NLAT)) * 1024 + j * 256 + lane * 4); a.x += t.x; a.y += t.y; a.z += t.z; a.w += t.w; }
                const float4 gt = *(const float4*)(gatec + j * 256 + lane * 4); v[j].x += gt.x * a.x; v[j].y += gt.y * a.y; v[j].z += gt.z * a.z; v[j].w += gt.w * a.w; }
            ss += v[j].x * v[j].x + v[j].y * v[j].y + v[j].z * v[j].z + v[j].w * v[j].w; }
        const float rinv = rsqrtf(wave_sum(ss) * (1.f / 1024.f) + EPS);
#pragma unroll
        for (int j = 0; j < 4; ++j) { const int c0 = j * 256 + lane * 4; const float4 gg = *(const float4*)(g + c0), sh = *(const float4*)(md + c0), sc = *(const float4*)(md + 1024 + c0);
            ushort4 o; o.x = f2bf(v[j].x * rinv * gg.x * (1.f + sc.x) + sh.x); o.y = f2bf(v[j].y * rinv * gg.y * (1.f + sc.y) + sh.y);
            o.z = f2bf(v[j].z * rinv * gg.z * (1.f + sc.z) + sh.z); o.w = f2bf(v[j].w * rinv * gg.w * (1.f + sc.w) + sh.w);
            *(ushort4*)(H + (size_t)row * 1024 + c0) = o; }
    }
}

template <class Epi>
__device__ void st_gemm_naive(int vb, int nvb, float* lds, const bf16_t* A, const bf16_t* Bt, int mt0, int mt1, int nt0, int nt1, int K, const Epi& E) {
    float* As = lds;
    float* Bs = lds + 32 * 33;
    const int tid = threadIdx.x, tx = tid & 63, ty = tid >> 6;
    const int nmt = mt1 - mt0, nnt = nt1 - nt0;
    for (int it = vb; it < nmt * nnt; it += nvb) {
        const int m0 = (mt0 + it / nnt) * 32, n0 = (nt0 + it % nnt) * 256;
        float acc[4][4];
#pragma unroll
        for (int i = 0; i < 4; ++i)
#pragma unroll
            for (int j = 0; j < 4; ++j) acc[i][j] = 0.f;
        for (int k0 = 0; k0 < K; k0 += 32) {
            __syncthreads();
            for (int e = tid; e < 32 * 32; e += NTHREADS) { const int r = e >> 5, kk = e & 31; As[r * 33 + kk] = bf2f(A[(size_t)(m0 + r) * K + k0 + kk]); }
            for (int e = tid; e < 256 * 32; e += NTHREADS) { const int r = e >> 5, kk = e & 31; Bs[r * 33 + kk] = bf2f(Bt[(size_t)(n0 + r) * K + k0 + kk]); }
            __syncthreads();
#pragma unroll 8
            for (int kk = 0; kk < 32; ++kk) {
                float a[4], b[4];
#pragma unroll
                for (int i = 0; i < 4; ++i) a[i] = As[(ty * 4 + i) * 33 + kk];
#pragma unroll
                for (int j = 0; j < 4; ++j) b[j] = Bs[(tx + 64 * j) * 33 + kk];
#pragma unroll
                for (int i = 0; i < 4; ++i)
#pragma unroll
                    for (int j = 0; j < 4; ++j) acc[i][j] += a[i] * b[j];
            }
        }
#pragma unroll
        for (int i = 0; i < 4; ++i) E(m0 + ty * 4 + i, n0, tx, acc[i]);
    }
    __syncthreads();
}

struct Epi1 {
    bf16_t *QK, *V, *SGA, *Z, *CBG; float* ALR;
    DEVI void operator()(int row, int n0, int cl, const float (&v)[4]) const {
        const int t = n0 >> 8;
        if (t < 4) { for (int j = 0; j < 4; ++j) QK[(size_t)row * 1024 + n0 + cl + 64 * j] = f2bf(v[j]); }
        else if (t < 8) { for (int j = 0; j < 4; ++j) V[(size_t)row * 1024 + (n0 - 1024) + cl + 64 * j] = f2bf(v[j]); }
        else if (t < 12) { for (int j = 0; j < 4; ++j) SGA[(size_t)row * 1024 + (n0 - 2048) + cl + 64 * j] = f2bf(siluf_(v[j])); }
        else if (t == 12) { if (cl < 32) ALR[(size_t)row * 32 + cl] = v[0]; }
        else if (t < 21) { const int jt = t - 13; Z[(size_t)row * 1024 + 128 * jt + cl] = f2bf(v[0] * v[2]); Z[(size_t)row * 1024 + 128 * jt + cl + 64] = f2bf(v[1] * v[3]); }
        else { const int jt = t - 21; CBG[(size_t)row * 1024 + 128 * jt + cl] = f2bf(v[0] * siluf_(v[2])); CBG[(size_t)row * 1024 + 128 * jt + cl + 64] = f2bf(v[1] * siluf_(v[3])); }
    }
};
struct EpiRes {
    const float* xl; const float* xc; float* outl; float* outc; const float* MODl;
    DEVI void operator()(int row, int n0, int cl, const float (&v)[4]) const {
        const float* gate = MODl + (size_t)mod_idx(row) * 3072 + 2048;
        for (int j = 0; j < 4; ++j) { const int col = n0 + cl + 64 * j;
            if (row < NLAT) outl[(size_t)row * 1024 + col] = xl[(size_t)row * 1024 + col] + gate[col] * v[j];
            else if (outc) outc[(size_t)(row - NLAT) * 1024 + col] = xc[(size_t)(row - NLAT) * 1024 + col] + gate[col] * v[j]; }
    }
};
struct Epi3 {
    bf16_t* XR; bf16_t* SG;
    DEVI void operator()(int row, int n0, int cl, const float (&v)[4]) const {
        for (int j = 0; j < 4; ++j) { const int col = n0 + cl + 64 * j;
            if (col < 2048) XR[(size_t)row * 2048 + col] = f2bf(v[j]); else if (row < NLAT) SG[(size_t)row * 2048 + col - 2048] = f2bf(siluf_(v[j])); }
    }
};

#define LASQ __attribute__((address_space(3)))
__device__ void st_glaprep(const Params& p, int vb, int nvb, unsigned char* ldsb, const bf16_t* QK, const bf16_t* V, const float* ALR, bf16_t* QIN, bf16_t* KET, bf16_t* SC, float* DEC, bf16_t* VT) {
    typedef unsigned u4 __attribute__((ext_vector_type(4))); typedef unsigned u2 __attribute__((ext_vector_type(2))); typedef float f4 __attribute__((ext_vector_type(4))); typedef short bx8 __attribute__((ext_vector_type(8)));
    LASQ unsigned char* lds = (LASQ unsigned char*)ldsb;
    constexpr int RQ = 0, RK = 17408, Q0 = 34816, K0 = 52224, VR = 69632, AL = VR + 33792, TT = AL + 8192;
    const int tid = threadIdx.x, kk = tid & 127, tq = tid >> 7, wv = tid >> 6, ln = tid & 63, cl = ln & 15, gq = ln >> 4;
    u4 r[9];
#define GP_LOAD(item) do { const int h_ = (item) & 3, bc_ = (item) >> 2, c_ = bc_ % NCH, bb_ = bc_ / NCH; const size_t row0_ = (size_t)row_of(bb_, c_, 0); \
        _Pragma("unroll") for (int j_ = 0; j_ < 2; ++j_) { const int p_ = tid + 512 * j_; r[j_] = *(const u4*)(QK + (row0_ + (p_ >> 4)) * 1024 + h_ * 128 + (p_ & 15) * 8); r[2 + j_] = *(const u4*)(QK + (row0_ + (p_ >> 4)) * 1024 + 512 + h_ * 128 + (p_ & 15) * 8); } \
        _Pragma("unroll") for (int j_ = 0; j_ < 4; ++j_) { const int p_ = tid + 512 * j_; r[4 + j_] = *(const u4*)(V + (row0_ + (p_ >> 5)) * 1024 + h_ * 256 + (p_ & 31) * 8); } \
        r[8] = *(const u4*)(ALR + (row0_ + (tid >> 3)) * 32 + (tid & 7) * 4); } while (0)
    const int NIT = NB * NCH * 4;
    if (vb < NIT) GP_LOAD(vb);
    for (int item = vb; item < NIT; item += nvb) {
        const int h = item & 3;
        LDS_BARRIER();
#pragma unroll
        for (int j = 0; j < 2; ++j) { const int pp = tid + 512 * j; *(LASQ u4*)(lds + RQ + (pp >> 4) * 272 + (pp & 15) * 16) = r[j]; *(LASQ u4*)(lds + RK + (pp >> 4) * 272 + (pp & 15) * 16) = r[2 + j]; }
#pragma unroll
        for (int j = 0; j < 4; ++j) { const int pp = tid + 512 * j; *(LASQ u4*)(lds + VR + (pp >> 5) * 528 + (pp & 31) * 16) = r[4 + j]; }
        *(LASQ u4*)(lds + AL + (tid >> 3) * 128 + (tid & 7) * 16) = r[8];
        float w2a[2][16], b2a[2];
#pragma unroll
        for (int d = 0; d < 2; ++d) {
#pragma unroll
            for (int rr = 0; rr < 16; ++rr) w2a[d][rr] = p.e_w_a2[((size_t)d * 16 + rr) * 512 + h * 128 + kk];
            b2a[d] = p.e_b_a2[d * 512 + h * 128 + kk]; }
        asm volatile("" ::: "memory");
        if (item + nvb < NIT) GP_LOAD(item + nvb);
        LDS_BARRIER();
        unsigned qkr[16];
#pragma unroll
        for (int i = 0; i < 16; ++i) { qkr[i] = (unsigned)*(const LASQ unsigned short*)(lds + RQ + (tq * 16 + i) * 272 + kk * 2) | ((unsigned)*(const LASQ unsigned short*)(lds + RK + (tq * 16 + i) * 272 + kk * 2) << 16); }
        float bc[2][16];
#pragma unroll
        for (int d = 0; d < 2; ++d) {
            const float (&w2)[16] = w2a[d]; const float b2 = b2a[d];
#pragma unroll
            for (int ib = 0; ib < 8; ++ib) {
                f4 ar[2][4];
#pragma unroll
                for (int ii = 0; ii < 2; ++ii) { const LASQ f4* a = (const LASQ f4*)(lds + AL + (tq * 16 + ib * 2 + ii) * 128 + d * 64); ar[ii][0] = a[0]; ar[ii][1] = a[1]; ar[ii][2] = a[2]; ar[ii][3] = a[3]; }
#pragma unroll
                for (int ii = 0; ii < 2; ++ii) { float z = b2;
#pragma unroll
                    for (int q4 = 0; q4 < 4; ++q4) z += ar[ii][q4][0] * w2[4 * q4] + ar[ii][q4][1] * w2[4 * q4 + 1] + ar[ii][q4][2] * w2[4 * q4 + 2] + ar[ii][q4][3] * w2[4 * q4 + 3];
                    bc[d][ib * 2 + ii] = logsigmoidf_(z) * (1.f / 16.f); }
            }
            float sacc = 0.f;
            if (d == 0) {
#pragma unroll
                for (int i = 0; i < 16; ++i) { sacc += bc[d][i]; bc[d][i] = sacc; } }
            else {
#pragma unroll
                for (int i = 15; i >= 0; --i) { sacc += bc[d][i]; bc[d][i] = sacc; } }
            *(LASQ float*)(lds + TT + ((d * 4 + tq) * 128 + kk) * 4) = sacc;
        }
        LDS_BARRIER();
        const float scale = 0.08838834764831845f;
#pragma unroll
        for (int d = 0; d < 2; ++d) {
            const size_t u = (size_t)item * 2 + d;
            float off = 0.f, blast = 0.f;
#pragma unroll
            for (int q = 0; q < 4; ++q) { const float tv = *(const LASQ float*)(lds + TT + ((d * 4 + q) * 128 + kk) * 4); blast += tv; if (d == 0 ? (q < tq) : (q > tq)) off += tv; }
            LASQ unsigned char* qd = lds + (d == 0 ? Q0 : RQ); LASQ unsigned char* kd = lds + (d == 0 ? K0 : RK);
            unsigned ke[8];
#pragma unroll
            for (int i = 0; i < 16; ++i) { const int t = tq * 16 + i; const float bq = bc[d][i] + off;
                const float qv = __uint_as_float(qkr[i] << 16) * scale, kv = __uint_as_float(qkr[i] & 0xffff0000u);
                const float eb = fexp2_(1.4426950408889634f * bq);
                *(LASQ unsigned short*)(qd + t * 272 + kk * 2) = f2bf(qv * eb); *(LASQ unsigned short*)(kd + t * 272 + kk * 2) = f2bf(kv * frcp_(eb));
                const unsigned kev = f2bf(kv * fexp2_(1.4426950408889634f * (blast - bq)));
                if (i & 1) ke[i >> 1] |= kev << 16; else ke[i >> 1] = kev; }
            { u4 w0 = {ke[0], ke[1], ke[2], ke[3]}, w1 = {ke[4], ke[5], ke[6], ke[7]}; u4* dst = (u4*)(KET + (u * 128 + kk) * 64 + tq * 16); dst[0] = w0; dst[1] = w1; }
            if (tq == 0) DEC[u * 128 + kk] = fexp2_(1.4426950408889634f * blast);
        }
        LDS_BARRIER();
#pragma unroll
        for (int d = 0; d < 2; ++d) {
            const size_t u = (size_t)item * 2 + d;
            const LASQ unsigned char* qd = lds + (d == 0 ? Q0 : RQ); const LASQ unsigned char* kd = lds + (d == 0 ? K0 : RK);
#pragma unroll
            for (int j = 0; j < 2; ++j) { const int pp = tid + 512 * j; *(u4*)(QIN + u * 8192 + (pp >> 4) * 128 + (pp & 15) * 8) = *(const LASQ u4*)(qd + (pp >> 4) * 272 + (pp & 15) * 16); }
            const int mt = wv >> 1;
#pragma unroll
            for (int nn = 0; nn < 2; ++nn) { const int nt = 2 * (wv & 1) + nn; f4 acc = {0.f, 0.f, 0.f, 0.f};
#pragma unroll
                for (int k4 = 0; k4 < 4; ++k4) { const bx8 kf = *(const LASQ bx8*)(kd + (16 * nt + cl) * 272 + (32 * k4 + 8 * gq) * 2), qf = *(const LASQ bx8*)(qd + (16 * mt + cl) * 272 + (32 * k4 + 8 * gq) * 2);
                    acc = __builtin_amdgcn_mfma_f32_16x16x32_bf16(kf, qf, acc, 0, 0, 0); }
                const int t = 16 * mt + cl, s0 = 16 * nt + 4 * gq; float v[4];
#pragma unroll
                for (int rr = 0; rr < 4; ++rr) { const int sx = s0 + rr; v[rr] = (d == 0 ? (sx <= t) : (sx >= t)) ? acc[rr] : 0.f; }
                u2 w; w.x = pk2(v[0], v[1]); w.y = pk2(v[2], v[3]); *(u2*)(SC + (u * 64 + t) * 64 + s0) = w; }
        }
        { const int vc = tid & 255, th = tid >> 8; unsigned vv[16];
#pragma unroll
          for (int i = 0; i < 32; ++i) { const unsigned x = *(const LASQ unsigned short*)(lds + VR + (32 * th + i) * 528 + vc * 2); if (i & 1) vv[i >> 1] |= x << 16; else vv[i >> 1] = x; }
          u4* dst = (u4*)(VT + ((size_t)item * 256 + vc) * 64 + 32 * th);
          dst[0] = (u4){vv[0], vv[1], vv[2], vv[3]}; dst[1] = (u4){vv[4], vv[5], vv[6], vv[7]}; dst[2] = (u4){vv[8], vv[9], vv[10], vv[11]}; dst[3] = (u4){vv[12], vv[13], vv[14], vv[15]}; }
    }
    LDS_BARRIER();
#undef GP_LOAD
}

__device__ void st_glawalk_naive(const Params& p, int vb, int nvb, float* Sl, const bf16_t* QIN, const bf16_t* KET, const bf16_t* SC, const float* DEC, const bf16_t* VT, bf16_t* OF, bf16_t* OB) {
    const int vc = threadIdx.x & 255, half = threadIdx.x >> 8;
    for (int combo = vb; combo < 32; combo += nvb) {
        const int d = combo & 1, h = (combo >> 1) & 3, bb = combo >> 3;
        __syncthreads();
        for (int k = half * 64; k < half * 64 + 64; ++k) Sl[k * 256 + vc] = 0.f;
        __syncthreads();
        bf16_t* O = d == 0 ? OF : OB;
        for (int step = 0; step < NCH; ++step) {
            const int c = d == 0 ? (step < 4 ? 64 + step : step - 4) : 67 - step;
            const int u = ((bb * NCH + c) * 4 + h) * 2 + d;
            const bf16_t* q = QIN + (size_t)u * 64 * 128; const bf16_t* ke = KET + (size_t)u * 128 * 64; const bf16_t* sc = SC + (size_t)u * 64 * 64;
            const bf16_t* vt = VT + (((size_t)(u >> 1)) * 256 + vc) * 64;
            float vv[64];
#pragma unroll
            for (int t = 0; t < 64; ++t) vv[t] = bf2f(vt[t]);
            const int row0 = row_of(bb, c, 0);
            for (int t = half * 32; t < half * 32 + 32; ++t) { float a = 0.f;
                for (int k = 0; k < 128; ++k) a += bf2f(q[t * 128 + k]) * bf2f(f2bf(Sl[k * 256 + vc]));
#pragma unroll
                for (int s = 0; s < 64; ++s) a += bf2f(sc[t * 64 + s]) * vv[s];
                O[(size_t)(row0 + t) * 1024 + h * 256 + vc] = f2bf(a); }
            __syncthreads();
            for (int k = half * 64; k < half * 64 + 64; ++k) { float a = DEC[(size_t)u * 128 + k] * Sl[k * 256 + vc];
#pragma unroll
                for (int t = 0; t < 64; ++t) a += bf2f(ke[k * 64 + t]) * vv[t];
                Sl[k * 256 + vc] = a; }
            __syncthreads();
        }
    }
}

__device__ void st_inner(const Params& p, int vb, int nvb, const bf16_t* OF, const bf16_t* OB, const bf16_t* SGA, const bf16_t* Z, const bf16_t* CBG, bf16_t* INNER, const bf16_t* ZA, float* X1C) {
    const int lane = threadIdx.x & 63, gw = vb * (NTHREADS / 64) + (threadIdx.x >> 6), ngw = nvb * (NTHREADS / 64);
    float4 gg = *(const float4*)(p.e_gla_g + lane * 4);
    for (int row = gw; row < NT; row += ngw) {
        bool hasp, hasn;
        if (row < NLAT) { const int t = row & 63; hasp = t != 0; hasn = t != 63; } else { const int t = (row - NLAT) & 255; hasp = t != 0; hasn = t != 255; }
        const size_t rp = hasp ? row - 1 : row, rn = hasn ? row + 1 : row; const float mp = hasp ? 1.f : 0.f, mn = hasn ? 1.f : 0.f;
        ushort4 a[4], b[4], sg[4], zc[4], zp[4], zn[4], cb[4];
#pragma unroll
        for (int h = 0; h < 4; ++h) { const int c0 = h * 256 + lane * 4;
            a[h] = *(const ushort4*)(OF + (size_t)row * 1024 + c0); b[h] = *(const ushort4*)(OB + (size_t)row * 1024 + c0); sg[h] = *(const ushort4*)(SGA + (size_t)row * 1024 + c0);
            const bf16_t* zb = h == 0 ? ZA + lane * 4 : Z + c0; const size_t zpitch = h == 0 ? 256 : 1024;
            zc[h] = *(const ushort4*)(zb + (size_t)row * zpitch); zp[h] = *(const ushort4*)(zb + rp * zpitch); zn[h] = *(const ushort4*)(zb + rn * zpitch);
            cb[h] = *(const ushort4*)(CBG + (size_t)row * 1024 + c0); }
#pragma unroll
        for (int h = 0; h < 4; ++h) { const int c0 = h * 256 + lane * 4;
            const float o0 = bf2f(a[h].x) + bf2f(b[h].x), o1 = bf2f(a[h].y) + bf2f(b[h].y), o2 = bf2f(a[h].z) + bf2f(b[h].z), o3 = bf2f(a[h].w) + bf2f(b[h].w);
            const float rinv = rsqrtf(wave_sum(o0 * o0 + o1 * o1 + o2 * o2 + o3 * o3) * (1.f / 256.f) + EPS);
            uint2 o; o.x = pk2(o0 * rinv * gg.x * bf2f(sg[h].x), o1 * rinv * gg.y * bf2f(sg[h].y)); o.y = pk2(o2 * rinv * gg.z * bf2f(sg[h].z), o3 * rinv * gg.w * bf2f(sg[h].w));
            *(uint2*)(INNER + (size_t)row * 2048 + c0) = o;
            const float4 w0 = *(const float4*)(p.e_conv_w + c0), w1 = *(const float4*)(p.e_conv_w + 1024 + c0), w2 = *(const float4*)(p.e_conv_w + 2048 + c0);
            uint2 y; y.x = pk2(bf2f(cb[h].x) * (mp * w0.x * bf2f(zp[h].x) + w1.x * bf2f(zc[h].x) + mn * w2.x * bf2f(zn[h].x)), bf2f(cb[h].y) * (mp * w0.y * bf2f(zp[h].y) + w1.y * bf2f(zc[h].y) + mn * w2.y * bf2f(zn[h].y)));
            y.y = pk2(bf2f(cb[h].z) * (mp * w0.z * bf2f(zp[h].z) + w1.z * bf2f(zc[h].z) + mn * w2.z * bf2f(zn[h].z)), bf2f(cb[h].w) * (mp * w0.w * bf2f(zp[h].w) + w1.w * bf2f(zc[h].w) + mn * w2.w * bf2f(zn[h].w)));
            *(uint2*)(INNER + (size_t)row * 2048 + 1024 + c0) = y; }
    }
}

template <int MODE>
__device__ void st_rglru_naive(const Params& p, int vb, int nvb, float* lds, const bf16_t* XR, const bf16_t* SG, float* SUMA, float* SUMH, bf16_t* Y) {
    float* xc = lds;
    float* av = xc + 64 * 128;
    float* uv = av + 64 * 128;
    float* hf = uv + 64 * 128;
    const int tid = threadIdx.x, j = tid & 127, tq = tid >> 7;
    const int nitems = MODE == 0 ? NB * NCH * 16 * 2 : NB * 64 * 16;
    for (int it = vb; it < nitems; it += nvb) {
        int bb, c, nb;
        if (MODE == 0) { nb = (it >> 1) & 15; const int bc = it >> 5; c = bc % NCH; bb = bc / NCH; } else { nb = it & 15; const int bc = it >> 4; c = bc & 63; bb = bc >> 6; }
        const int row0 = row_of(bb, c, 0);
        const int seg0 = c < 64 ? bb * 4096 : NLAT + bb * 256, segn = c < 64 ? 4096 : 256;
        const int tl0 = row0 - seg0;
        for (int dd = 0; dd < (MODE == 0 ? 1 : 2); ++dd) {
            const int d = MODE == 0 ? (it & 1) : dd;
            __syncthreads();
            for (int e = tid; e < 64 * 128; e += NTHREADS) { const int t = e >> 7, i = e & 127, ch = nb * 128 + i; float a = p.o_conv_b[d * 2048 + ch];
#pragma unroll
                for (int jj = 0; jj < 4; ++jj) { const int tt = d == 0 ? tl0 + t - 3 + jj : tl0 + t + 3 - jj;
                    if (tt >= 0 && tt < segn) a += p.o_conv_w[((size_t)d * 4 + jj) * 2048 + ch] * bf2f(XR[(size_t)(seg0 + tt) * 2048 + ch]); }
                xc[e] = a; }
            __syncthreads();
            const float* WA = p.o_w_a + ((size_t)d * 16 + nb) * 128 * 128; const float* WX = p.o_w_x + ((size_t)d * 16 + nb) * 128 * 128;
            const int ch = nb * 128 + j;
            const float ba = p.o_b_a[d * 2048 + ch], bx = p.o_b_x[d * 2048 + ch], sp = softplusf_(-p.o_lam[d * 2048 + ch]);
            for (int i16 = 0; i16 < 16; ++i16) { const int t = tq * 16 + i16; float ra = ba, rx = bx;
                for (int i = 0; i < 128; ++i) { const float xv = bf2f(f2bf(xc[t * 128 + i])); ra += xv * bf2f(f2bf(WA[i * 128 + j])); rx += xv * bf2f(f2bf(WX[i * 128 + j])); }
                const float r = sigmoidf_(ra), ig = sigmoidf_(rx); const float la = -8.f * r * sp; const float a = __expf(la);
                av[t * 128 + j] = a; uv[t * 128 + j] = sqrtf(-expm1f(2.f * la)) * (ig * xc[t * 128 + j]); }
            __syncthreads();
            if (tid < 128) {
                const size_t sidx = (((size_t)bb * 2 + d) * NCH + c) * 2048 + ch;
                if (MODE == 0) { float A = 1.f, hh = 0.f;
                    if (d == 0) for (int t = 0; t < 64; ++t) { const float a = av[t * 128 + j]; hh = a * hh + uv[t * 128 + j]; A *= a; }
                    else for (int t = 63; t >= 0; --t) { const float a = av[t * 128 + j]; hh = a * hh + uv[t * 128 + j]; A *= a; }
                    SUMA[sidx] = A; SUMH[sidx] = hh;
                } else { float hh = SUMH[sidx];
                    if (d == 0) for (int t = 0; t < 64; ++t) { hh = av[t * 128 + j] * hh + uv[t * 128 + j]; hf[t * 128 + j] = hh; }
                    else for (int t = 63; t >= 0; --t) { hh = av[t * 128 + j] * hh + uv[t * 128 + j]; const size_t o = (size_t)(row0 + t) * 2048 + ch; Y[o] = f2bf((hf[t * 128 + j] + hh) * bf2f(SG[o])); }
                }
            }
        }
    }
    __syncthreads();
}
__device__ void st_carry(const Params& p, int vb, int nvb, const float* SUMA, float* SUMH) {
    for (int e = vb * NTHREADS + threadIdx.x; e < NB * 2 * 2048; e += nvb * NTHREADS) {
        const int ch = e & 2047, d = (e >> 11) & 1, bb = e >> 12; float hh = 0.f;
        for (int s0 = 0; s0 < NCH; s0 += 17) {
            float A[17], H[17];
#pragma unroll
            for (int i = 0; i < 17; ++i) { const int step = s0 + i, c = d == 0 ? (step < 4 ? 64 + step : step - 4) : 67 - step; const size_t sidx = (((size_t)bb * 2 + d) * NCH + c) * 2048 + ch; A[i] = SUMA[sidx]; H[i] = SUMH[sidx]; }
#pragma unroll
            for (int i = 0; i < 17; ++i) { const int step = s0 + i, c = d == 0 ? (step < 4 ? 64 + step : step - 4) : 67 - step; const size_t sidx = (((size_t)bb * 2 + d) * NCH + c) * 2048 + ch; SUMH[sidx] = hh; hh = A[i] * hh + H[i]; }
        }
    }
}
__device__ void st_final(const Params& p, int vb, int nvb) {
    const int lane = threadIdx.x & 63, gw = vb * (NTHREADS / 64) + (threadIdx.x >> 6), ngw = nvb * (NTHREADS / 64);
    for (int row = gw; row < NLAT; row += ngw) { float* xr = p.out + (size_t)row * 1024; float4 v[4]; float ss = 0.f;
#pragma unroll
        for (int j = 0; j < 4; ++j) { v[j] = *(const float4*)(xr + j * 256 + lane * 4); ss += v[j].x * v[j].x + v[j].y * v[j].y + v[j].z * v[j].z + v[j].w * v[j].w; }
        const float rinv = rsqrtf(wave_sum(ss) * (1.f / 1024.f) + EPS);
#pragma unroll
        for (int j = 0; j < 4; ++j) { const float4 g = *(const float4*)(p.final_g + j * 256 + lane * 4); float4 o; o.x = v[j].x * rinv * g.x; o.y = v[j].y * rinv * g.y; o.z = v[j].z * rinv * g.z; o.w = v[j].w * rinv * g.w; *(float4*)(xr + j * 256 + lane * 4) = o; }
    }
}


namespace pg8 {
#define PG8_LAS __attribute__((address_space(3)))
typedef short bf16x8 __attribute__((ext_vector_type(8)));
typedef float f32x4 __attribute__((ext_vector_type(4)));
typedef unsigned u32x4 __attribute__((ext_vector_type(4)));
constexpr int BM = 256, BK = 64, HALF = 128, HTB = HALF * BK * 2, STAGE_BYTES = 8 * HTB, NXCD = 8, WGM = 8;
__host__ __device__ __forceinline__ int lds_byte(int r, int c) { const int st = (r >> 4) * 2 + (c >> 5), rr = r & 15, cc = c & 31, ob = rr * 64 + cc * 2; return st * 1024 + (ob ^ (((ob >> 9) & 1) << 5)); }
__host__ __device__ __forceinline__ void stage_rc(int b, int& R, int& C) { const int st = b / 1024, sb = b % 1024, swz = sb ^ (((sb >> 9) & 1) << 5); R = (st >> 1) * 16 + swz / 64; C = (st & 1) * 32 + (swz % 64) / 2; }
__host__ __device__ __forceinline__ int perm32(int rho) { const int n = rho >> 4, i = rho & 15; return 8 * (i >> 2) + 4 * n + (i & 3); }
struct Unit { int pm, pn, k0, nk; };
struct Gemm { const bf16_t* A; const bf16_t* Bt; int M, N, K; };
struct TileOrder {
    int nM, nN, nwg, G, c, m0, split, base0, base1, nkfull, nM2, nN2, m02, nKS, nk2, tail_first;
    __device__ void init(int nM_, int nN_, int nkfull_, int G_, int c_, int m0_ = 0, int split_ = 1 << 30, int base0_ = 0, int base1_ = 0, int nM2_ = 0, int nN2_ = 0, int m02_ = 0, int nKS_ = 1, int nk2_ = 0) {
        nM = nM_; nN = nN_; nwg = nM * nN; nkfull = nkfull_; G = G_; c = c_; m0 = m0_; split = split_; base0 = base0_; base1 = base1_; nM2 = nM2_; nN2 = nN2_; m02 = m02_; nKS = nKS_; nk2 = nk2_; tail_first = 0; }
    __device__ bool next(int i, Unit& u) const {
        long L = (long)i * G + c;
        if (tail_first) {
            const int ntail = nM2 * nN2 * nKS;
            if (c < ntail) { if (i == 0) L = (long)nwg + c; else L = (long)(i - 1) * G + c; }
            if (i > 0 && c >= ntail && L >= nwg) return false;
            if (i > 0 && c < ntail && L >= nwg) return false;
        }
        if (L >= nwg) { const long L2 = L - nwg; if (L2 >= (long)nM2 * nN2 * nKS) return false; const int ks = (int)(L2 % nKS), rest = (int)(L2 / nKS);
            u.pm = m02 + rest / nN2; u.pn = rest % nN2; u.k0 = ks * nk2 * 64; u.nk = nk2; return true; }
        int wgid = (int)L; { const int q = nwg / NXCD, r = nwg % NXCD, xcd = wgid % NXCD, off = wgid / NXCD; wgid = (xcd < r ? xcd * (q + 1) : r * (q + 1) + (xcd - r) * q) + off; }
        const int nig = WGM * nN, gid = wgid / nig, fm = gid * WGM, gsz = (nM - fm) < WGM ? (nM - fm) : WGM;
        const int pm = fm + ((wgid % nig) % gsz), j = (wgid % nig) / gsz;
        u.pm = m0 + pm; u.pn = j < split ? base0 + j : base1 + (j - split); u.k0 = 0; u.nk = nkfull; return true;
    }
    __device__ __forceinline__ void a_ready(const Unit&) const {}
    __device__ __forceinline__ void done(const Unit&) const {}
};
typedef float f32x2_t __attribute__((ext_vector_type(2))); typedef __bf16 bf16x2_t __attribute__((ext_vector_type(2)));
__device__ __forceinline__ unsigned cvt_pk_bf16(float lo, float hi) { f32x2_t v = {lo, hi}; bf16x2_t b = __builtin_convertvector(v, bf16x2_t); return __builtin_bit_cast(unsigned, b); }
template <class Epi, class Sched, bool ALIGN_EPI = false, bool SP2 = false>
__device__ __forceinline__ void gemm_phase(PG8_LAS unsigned char* lds, const Gemm g, const Sched& S, const Epi& E) {
    const int tid = threadIdx.x, wid = __builtin_amdgcn_readfirstlane(tid >> 6), lane = tid & 63, wr = wid >> 2, wc = wid & 3, fr = lane & 15, fq = lane >> 4;
    const int K = g.K;
    unsigned voffA[2], voffB[2];
#pragma unroll
    for (int i = 0; i < 2; ++i) { int R, C; stage_rc(tid * 16 + i * 8192, R, C); const int Rb = Epi::PERM ? ((R & ~31) + perm32(R & 31)) : R;
        voffA[i] = (unsigned)(R * K + C) * 2u; voffB[i] = (unsigned)(Rb * K + C) * 2u; }
    const size_t kstep = (size_t)(BK * 2);
    const size_t hstep = (size_t)HALF * K * 2;
    const size_t tstep = 2 * hstep;
    const unsigned ldsw = (unsigned)wid * 1024u;
    const int aoff = lds_byte(wr * 64 + fr, fq * 8), boff = lds_byte(wc * 32 + fr, fq * 8);
#define PG8_SA(b, h) (((b) * 2 + (h)) * HTB)
#define PG8_SB(b, h) ((4 + (b) * 2 + (h)) * HTB)
#define PG8_STAGE(bufoff, gbase, voff) do { _Pragma("unroll") for (int _i = 0; _i < 2; ++_i) \
        __builtin_amdgcn_global_load_lds((const unsigned*)((const char*)(gbase) + (voff)[_i]), (PG8_LAS unsigned*)(lds + (bufoff) + ldsw + _i * 8192), 16, 0, 0); } while (0)
#define PG8_LDA(dst, b, h) do { _Pragma("unroll") for (int m = 0; m < 4; ++m) _Pragma("unroll") for (int k = 0; k < 2; ++k) dst[m][k] = *(const PG8_LAS bf16x8*)(lds + PG8_SA(b, h) + aoff + m * 2048 + k * 1024); } while (0)
#define PG8_LDB(dst, b, h) do { _Pragma("unroll") for (int n = 0; n < 2; ++n) _Pragma("unroll") for (int k = 0; k < 2; ++k) dst[n][k] = *(const PG8_LAS bf16x8*)(lds + PG8_SB(b, h) + boff + n * 2048 + k * 1024); } while (0)
#define PG8_MMA(ai, bj, At, Bt) do { __builtin_amdgcn_s_setprio(1); _Pragma("unroll") for (int m = 0; m < 4; ++m) _Pragma("unroll") for (int n = 0; n < 2; ++n) _Pragma("unroll") for (int k = 0; k < 2; ++k) \
        acc[ai][bj][m][n] = __builtin_amdgcn_mfma_f32_16x16x32_bf16(Bt[n][k], At[m][k], acc[ai][bj][m][n], 0, 0, 0); __builtin_amdgcn_s_setprio(0); } while (0)
#define PG8_WAIT_V(n) asm volatile("s_waitcnt vmcnt(" #n ")" ::: "memory")
#define PG8_WAIT_L(n) asm volatile("s_waitcnt lgkmcnt(" #n ")" ::: "memory")
#define PG8_BAR __builtin_amdgcn_s_barrier()
#define PG8_SCHED __builtin_amdgcn_sched_barrier(0)
    Unit cur, nxt; int ui = 0;
    if (!S.next(0, cur)) return;
    f32x4 acc[2][2][4][2];
#pragma unroll
    for (int a = 0; a < 2; ++a)
#pragma unroll
        for (int b = 0; b < 2; ++b)
#pragma unroll
            for (int m = 0; m < 4; ++m)
#pragma unroll
                for (int n = 0; n < 2; ++n) acc[a][b][m][n] = (f32x4){0.f, 0.f, 0.f, 0.f};
    bf16x8 At[4][2], B0[2][2], B1[2][2];
    const char* cA = (const char*)g.A + (size_t)cur.pm * tstep + (size_t)cur.k0 * 2; const char* cB = (const char*)g.Bt + (size_t)cur.pn * tstep + (size_t)cur.k0 * 2;
    S.a_ready(cur);
    if constexpr (SP2) {
        PG8_STAGE(PG8_SB(0, 0), cB, voffB); PG8_STAGE(PG8_SB(0, 1), cB + hstep, voffB); PG8_STAGE(PG8_SA(0, 0), cA, voffA); PG8_STAGE(PG8_SA(0, 1), cA + hstep, voffA);
        if (wr == 1) PG8_BAR;
        PG8_WAIT_V(2); PG8_BAR;
        PG8_STAGE(PG8_SB(1, 0), cB + kstep, voffB); PG8_STAGE(PG8_SA(1, 0), cA + kstep, voffA); PG8_STAGE(PG8_SB(1, 1), cB + hstep + kstep, voffB);
        PG8_WAIT_V(6); PG8_BAR;
    } else {
        PG8_STAGE(PG8_SB(0, 0), cB, voffB); PG8_STAGE(PG8_SA(0, 0), cA, voffA); PG8_STAGE(PG8_SB(0, 1), cB + hstep, voffB); PG8_STAGE(PG8_SA(0, 1), cA + hstep, voffA);
        if (wr == 1) PG8_BAR;
        PG8_WAIT_V(4); PG8_BAR;
        PG8_STAGE(PG8_SB(1, 0), cB + kstep, voffB); PG8_STAGE(PG8_SA(1, 0), cA + kstep, voffA); PG8_STAGE(PG8_SB(1, 1), cB + hstep + kstep, voffB);
        PG8_WAIT_V(6); PG8_BAR;
    }
    for (;;) {
        const bool has_next = S.next(ui + 1, nxt);
        const char* nA = has_next ? (const char*)g.A + (size_t)nxt.pm * tstep + (size_t)nxt.k0 * 2 : cA; const char* nB = has_next ? (const char*)g.Bt + (size_t)nxt.pn * tstep + (size_t)nxt.k0 * 2 : cB;
        const int nt = cur.nk;
        for (int t = 0; t < nt; t += 2) {
            const bool last = (t == nt - 2);
            const char* a1 = cA + (size_t)(t + 1) * kstep;
            const char* a2 = last ? nA : cA + (size_t)(t + 2) * kstep; const char* b2 = last ? nB : cB + (size_t)(t + 2) * kstep;
            const char* a3 = a2 + kstep; const char* b3 = b2 + kstep;
            if (last && has_next) S.a_ready(nxt);
            if constexpr (SP2) {
            PG8_LDB(B0, 0, 0); PG8_LDB(B1, 0, 1); PG8_SCHED; PG8_LDA(At, 0, 0); PG8_STAGE(PG8_SA(1, 1), a1 + hstep, voffA);
            PG8_WAIT_V(8); PG8_WAIT_L(0); PG8_BAR; PG8_MMA(0, 0, At, B0); PG8_MMA(0, 1, At, B1); PG8_BAR; PG8_SCHED;
            PG8_LDA(At, 0, 1); PG8_STAGE(PG8_SB(0, 0), b2, voffB); PG8_STAGE(PG8_SB(0, 1), b2 + hstep, voffB); PG8_STAGE(PG8_SA(0, 0), a2, voffA);
            PG8_WAIT_V(8); PG8_WAIT_L(0); PG8_BAR; PG8_MMA(1, 0, At, B0); PG8_MMA(1, 1, At, B1); PG8_BAR; PG8_SCHED;
            PG8_LDB(B0, 1, 0); PG8_LDB(B1, 1, 1); PG8_SCHED; PG8_LDA(At, 1, 0); PG8_STAGE(PG8_SA(0, 1), a2 + hstep, voffA);
            PG8_WAIT_V(8); PG8_WAIT_L(0); PG8_BAR; PG8_MMA(0, 0, At, B0); PG8_MMA(0, 1, At, B1); PG8_BAR; PG8_SCHED;
            PG8_LDA(At, 1, 1); PG8_STAGE(PG8_SB(1, 0), b3, voffB); PG8_STAGE(PG8_SB(1, 1), b3 + hstep, voffB); PG8_STAGE(PG8_SA(1, 0), a3, voffA);
            PG8_WAIT_V(8); PG8_WAIT_L(0); PG8_BAR; PG8_MMA(1, 0, At, B0); PG8_MMA(1, 1, At, B1); PG8_BAR; PG8_SCHED;
            } else {
            PG8_LDB(B0, 0, 0); PG8_SCHED; PG8_LDA(At, 0, 0); PG8_STAGE(PG8_SA(1, 1), a1 + hstep, voffA);
            PG8_WAIT_L(8); PG8_BAR; PG8_WAIT_L(0); PG8_MMA(0, 0, At, B0); PG8_BAR; PG8_SCHED;
            PG8_LDB(B1, 0, 1); PG8_STAGE(PG8_SB(0, 0), b2, voffB);
            PG8_BAR; PG8_WAIT_L(0); PG8_MMA(0, 1, At, B1); PG8_BAR;
            PG8_LDA(At, 0, 1); PG8_STAGE(PG8_SA(0, 0), a2, voffA);
            PG8_BAR; PG8_WAIT_L(0); PG8_MMA(1, 0, At, B0); PG8_BAR; PG8_SCHED;
            PG8_STAGE(PG8_SB(0, 1), b2 + hstep, voffB);
            PG8_WAIT_V(6); PG8_BAR; PG8_MMA(1, 1, At, B1); PG8_BAR;
            PG8_LDB(B0, 1, 0); PG8_SCHED; PG8_LDA(At, 1, 0); PG8_STAGE(PG8_SA(0, 1), a2 + hstep, voffA);
            PG8_WAIT_L(8); PG8_BAR; PG8_WAIT_L(0); PG8_MMA(0, 0, At, B0); PG8_BAR; PG8_SCHED;
            PG8_LDB(B1, 1, 1); PG8_STAGE(PG8_SB(1, 0), b3, voffB);
            PG8_BAR; PG8_WAIT_L(0); PG8_MMA(0, 1, At, B1); PG8_BAR;
            PG8_LDA(At, 1, 1); PG8_STAGE(PG8_SA(1, 0), a3, voffA);
            PG8_BAR; PG8_WAIT_L(0); PG8_MMA(1, 0, At, B0); PG8_BAR; PG8_SCHED;
            PG8_STAGE(PG8_SB(1, 1), b3 + hstep, voffB);
            PG8_WAIT_V(6); PG8_BAR; PG8_MMA(1, 1, At, B1); PG8_BAR;
            }
        }
        if constexpr (ALIGN_EPI) { if (wr == 0) PG8_BAR; }
        if constexpr (!Epi::AFTER_DRAIN) { E(acc, cur, wr, wc, fr, fq); S.done(cur); } else { if (has_next) { E(acc, cur, wr, wc, fr, fq); S.done(cur); } }
        if (!has_next) break;
#pragma unroll
        for (int a = 0; a < 2; ++a)
#pragma unroll
            for (int b = 0; b < 2; ++b)
#pragma unroll
                for (int m = 0; m < 4; ++m)
#pragma unroll
                    for (int n = 0; n < 2; ++n) acc[a][b][m][n] = (f32x4){0.f, 0.f, 0.f, 0.f};
        cur = nxt; cA = nA; cB = nB; ++ui;
        if constexpr (ALIGN_EPI) { if (wr == 1) PG8_BAR; }
    }
    PG8_WAIT_V(0);
    if constexpr (!ALIGN_EPI) { if (wr == 0) PG8_BAR; }
    PG8_BAR;
    if constexpr (Epi::AFTER_DRAIN) { E.fused(acc, cur, wr, wc, fr, fq, lds, wid, lane); S.done(cur); }
#undef PG8_SA
#undef PG8_SB
#undef PG8_STAGE
#undef PG8_LDA
#undef PG8_LDB
#undef PG8_MMA
#undef PG8_WAIT_V
#undef PG8_WAIT_L
#undef PG8_BAR
#undef PG8_SCHED
}
}

DEVI pg8::u32x4 pack8(const pg8::f32x4& a, const pg8::f32x4& b) { pg8::u32x4 w; w.x = pg8::cvt_pk_bf16(a[0], a[1]); w.y = pg8::cvt_pk_bf16(a[2], a[3]); w.z = pg8::cvt_pk_bf16(b[0], b[1]); w.w = pg8::cvt_pk_bf16(b[2], b[3]); return w; }
DEVI pg8::f32x4 silu4(const pg8::f32x4& a) { pg8::f32x4 r; r[0] = siluf_(a[0]); r[1] = siluf_(a[1]); r[2] = siluf_(a[2]); r[3] = siluf_(a[3]); return r; }
struct FEpi1 {
    static constexpr bool PERM = true, AFTER_DRAIN = false;
    bf16_t *QK, *V, *SGA, *Z, *CBG; float* ALR; bf16_t* ZA;
    DEVI void operator()(const pg8::f32x4 (&acc)[2][2][4][2], const pg8::Unit& u, int wr, int wc, int fr, int fq) const {
        const int t = u.pn, row0 = u.pm * 256 + wr * 64 + fr, cw = wc * 32 + 8 * fq;
#pragma unroll
        for (int ai = 0; ai < 2; ++ai)
#pragma unroll
            for (int m = 0; m < 4; ++m) {
                const size_t row = (size_t)(row0 + ai * 128 + m * 16);
                if (t < 12) {
                    bf16_t* base = t < 4 ? QK + row * 1024 + t * 256 : (t < 8 ? V + row * 1024 + (t - 4) * 256 : SGA + row * 1024 + (t - 8) * 256);
#pragma unroll
                    for (int bj = 0; bj < 2; ++bj) { pg8::f32x4 v0 = acc[ai][bj][m][0], v1 = acc[ai][bj][m][1]; if (t >= 8) { v0 = silu4(v0); v1 = silu4(v1); }
                        *(pg8::u32x4*)(base + bj * 128 + cw) = pack8(v0, v1); }
                } else if (t == 12) {
                    if (wc == 0) { *(pg8::f32x4*)(ALR + row * 32 + 8 * fq) = acc[ai][0][m][0]; *(pg8::f32x4*)(ALR + row * 32 + 8 * fq + 4) = acc[ai][0][m][1]; }
                } else if (t < 21) {
                    bf16_t* zp = t < 15 ? ZA + row * 256 + (t - 13) * 128 + cw : Z + row * 1024 + (t - 13) * 128 + cw;
                    *(pg8::u32x4*)zp = pack8(acc[ai][0][m][0] * acc[ai][1][m][0], acc[ai][0][m][1] * acc[ai][1][m][1]);
                } else {
                    *(pg8::u32x4*)(CBG + row * 1024 + (t - 21) * 128 + cw) = pack8(acc[ai][0][m][0] * silu4(acc[ai][1][m][0]), acc[ai][0][m][1] * silu4(acc[ai][1][m][1]));
                }
            }
    }
};
template <bool HAS_TAIL> struct FEpiRes {
    static constexpr bool PERM = false, AFTER_DRAIN = false;
    const float* xl; const float* xc; float* outl; float* outc; const float* MODl;
    DEVI void operator()(const pg8::f32x4 (&acc)[2][2][4][2], const pg8::Unit& u, int wr, int wc, int fr, int fq) const {
        const int row0 = u.pm * 256 + wr * 64 + fr, col0 = u.pn * 256 + wc * 32 + 4 * fq;
        const bool lat = u.pm < NLAT / 256;
        const float* gate = MODl + (size_t)(lat ? (u.pm >> 4) : 4) * 3072 + 2048 + col0;
        pg8::f32x4 gv[2][2];
#pragma unroll
        for (int bj = 0; bj < 2; ++bj)
#pragma unroll
            for (int n = 0; n < 2; ++n) gv[bj][n] = *(const pg8::f32x4*)(gate + bj * 128 + n * 16);
        if (HAS_TAIL && !lat) {
            float* o = outc + (size_t)(u.k0 >> 8) * NCTX * 1024 - (size_t)NLAT * 1024;
#pragma unroll
            for (int ai = 0; ai < 2; ++ai)
#pragma unroll
                for (int m = 0; m < 4; ++m) { const size_t off = (size_t)(row0 + ai * 128 + m * 16) * 1024 + col0;
#pragma unroll
                    for (int bj = 0; bj < 2; ++bj)
#pragma unroll
                        for (int n = 0; n < 2; ++n) *(pg8::f32x4*)(o + off + bj * 128 + n * 16) = acc[ai][bj][m][n]; }
            return;
        }
        const float* xin = xl; float* o = outl;
#pragma unroll
        for (int ai = 0; ai < 2; ++ai)
#pragma unroll
            for (int m = 0; m < 4; ++m) { const size_t off = (size_t)(row0 + ai * 128 + m * 16) * 1024 + col0;
#pragma unroll
                for (int bj = 0; bj < 2; ++bj)
#pragma unroll
                    for (int n = 0; n < 2; ++n) { const pg8::f32x4 xv = *(const pg8::f32x4*)(xin + off + bj * 128 + n * 16); *(pg8::f32x4*)(o + off + bj * 128 + n * 16) = xv + gv[bj][n] * acc[ai][bj][m][n]; } }
    }
};
struct FEpi3 {
    static constexpr bool PERM = true, AFTER_DRAIN = false;
    bf16_t* XR; bf16_t* SG; float* XRC;
    DEVI void operator()(const pg8::f32x4 (&acc)[2][2][4][2], const pg8::Unit& u, int wr, int wc, int fr, int fq) const {
        const int t = u.pn, row0 = u.pm * 256 + wr * 64 + fr, cw = wc * 32 + 8 * fq;
        if (u.pm >= NLAT / 256) {
            float* sl = XRC + (size_t)(u.k0 >> 9) * NCTX * 2048;
#pragma unroll
            for (int ai = 0; ai < 2; ++ai)
#pragma unroll
                for (int m = 0; m < 4; ++m) { float* rp = sl + (size_t)(row0 - NLAT + ai * 128 + m * 16) * 2048 + t * 256 + cw;
#pragma unroll
                    for (int bj = 0; bj < 2; ++bj) { *(pg8::f32x4*)(rp + bj * 128) = acc[ai][bj][m][0]; *(pg8::f32x4*)(rp + bj * 128 + 4) = acc[ai][bj][m][1]; } }
            return;
        }
        bf16_t* base = t < 8 ? XR + (size_t)xr_pad_of_tile(u.pm) * 2048 + t * 256 : SG + (t - 8) * 256;
#pragma unroll
        for (int ai = 0; ai < 2; ++ai)
#pragma unroll
            for (int m = 0; m < 4; ++m) { bf16_t* rp = base + (size_t)(row0 + ai * 128 + m * 16) * 2048 + cw;
#pragma unroll
                for (int bj = 0; bj < 2; ++bj) { pg8::f32x4 v0 = acc[ai][bj][m][0], v1 = acc[ai][bj][m][1]; if (t >= 8) { v0 = silu4(v0); v1 = silu4(v1); }
                    *(pg8::u32x4*)(rp + bj * 128) = pack8(v0, v1); } }
    }
};

struct FEpiResRms {
    static constexpr bool PERM = false, AFTER_DRAIN = true;
    const float* xin; float* out; const float* MODl; const float* gfin; float* slots; unsigned* cnt;
    DEVI void fused(pg8::f32x4 (&acc)[2][2][4][2], const pg8::Unit& u, int wr, int wc, int fr, int fq, PG8_LAS unsigned char* lds, int wid, int lane) const {
        const int row0 = u.pm * 256 + wr * 64 + fr, col0 = u.pn * 256 + wc * 32 + 4 * fq;
        const float* gate = MODl + (size_t)(u.pm >> 4) * 3072 + 2048 + col0;
        PG8_LAS float* P = (PG8_LAS float*)lds;
        PG8_LAS float* S = (PG8_LAS float*)(lds + 8192);
        { pg8::f32x4 gv[2][2];
#pragma unroll
          for (int bj = 0; bj < 2; ++bj)
#pragma unroll
              for (int n = 0; n < 2; ++n) gv[bj][n] = *(const pg8::f32x4*)(gate + bj * 128 + n * 16);
#pragma unroll
          for (int ai = 0; ai < 2; ++ai)
#pragma unroll
              for (int m = 0; m < 4; ++m) { const float* xp = xin + (size_t)(row0 + ai * 128 + m * 16) * 1024 + col0;
#pragma unroll
                  for (int bj = 0; bj < 2; ++bj)
#pragma unroll
                      for (int n = 0; n < 2; ++n) { const pg8::f32x4 xv = *(const pg8::f32x4*)(xp + bj * 128 + n * 16); acc[ai][bj][m][n] = xv + gv[bj][n] * acc[ai][bj][m][n]; }
                  asm volatile("" : "+v"(acc[ai][0][m][0]), "+v"(acc[ai][0][m][1]), "+v"(acc[ai][1][m][0]), "+v"(acc[ai][1][m][1]));
                  if (m & 1) asm volatile("" ::: "memory"); } }
#pragma unroll
        for (int ai = 0; ai < 2; ++ai)
#pragma unroll
            for (int m = 0; m < 4; ++m) { float q = 0.f;
#pragma unroll
                for (int bj = 0; bj < 2; ++bj)
#pragma unroll
                    for (int n = 0; n < 2; ++n) { const pg8::f32x4 x = acc[ai][bj][m][n]; q += (x[0] * x[0] + x[1] * x[1]) + (x[2] * x[2] + x[3] * x[3]); }
                q += __shfl_xor(q, 16); q += __shfl_xor(q, 32);
                if (fq == 0) P[(ai * 128 + wr * 64 + m * 16 + fr) * 4 + wc] = q; }
        asm volatile("s_waitcnt lgkmcnt(0)" ::: "memory"); __builtin_amdgcn_s_barrier(); asm volatile("" ::: "memory");
        const int row = wid * 32 + (lane & 31);
        if (lane < 32) { const float t = (P[row * 4 + 0] + P[row * 4 + 1]) + (P[row * 4 + 2] + P[row * 4 + 3]);
            __hip_atomic_store(slots + ((size_t)(u.pm * 256 + row) * 4 + u.pn), t, __ATOMIC_RELAXED, __HIP_MEMORY_SCOPE_AGENT); }
        asm volatile("s_waitcnt vmcnt(0)" ::: "memory");
        if (lane == 0) __hip_atomic_fetch_add(cnt + 64 * u.pm, 1u, __ATOMIC_RELAXED, __HIP_MEMORY_SCOPE_AGENT);
        if (wid == 0) { unsigned sp = 0;
            while ((unsigned)__builtin_amdgcn_readfirstlane(__hip_atomic_load(cnt + 64 * u.pm, __ATOMIC_RELAXED, __HIP_MEMORY_SCOPE_AGENT)) < 32u) { __builtin_amdgcn_s_sleep(2); if (++sp > (1u << 22)) break; }
            __builtin_amdgcn_fence(__ATOMIC_ACQUIRE, "agent"); }
        asm volatile("s_waitcnt vmcnt(0) lgkmcnt(0)" ::: "memory"); __builtin_amdgcn_s_barrier(); asm volatile("" ::: "memory");
        if (lane < 32) { const float* sl = slots + (size_t)(u.pm * 256 + row) * 4; float t = 0.f;
#pragma unroll
            for (int k = 0; k < 4; ++k) t += __hip_atomic_load(sl + k, __ATOMIC_RELAXED, __HIP_MEMORY_SCOPE_AGENT);
            S[row] = rsqrtf(t * (1.f / 1024.f) + EPS); }
        asm volatile("s_waitcnt lgkmcnt(0)" ::: "memory"); __builtin_amdgcn_s_barrier(); asm volatile("" ::: "memory");
        pg8::f32x4 gf[2][2];
#pragma unroll
        for (int bj = 0; bj < 2; ++bj)
#pragma unroll
            for (int n = 0; n < 2; ++n) gf[bj][n] = *(const pg8::f32x4*)(gfin + col0 + bj * 128 + n * 16);
#pragma unroll
        for (int ai = 0; ai < 2; ++ai)
#pragma unroll
            for (int m = 0; m < 4; ++m) { const int r = ai * 128 + wr * 64 + m * 16 + fr; const float rinv = S[r]; const size_t off = (size_t)(u.pm * 256 + r) * 1024 + col0;
#pragma unroll
                for (int bj = 0; bj < 2; ++bj)
#pragma unroll
                    for (int n = 0; n < 2; ++n) *(pg8::f32x4*)(out + off + bj * 128 + n * 16) = acc[ai][bj][m][n] * rinv * gf[bj][n]; }
    }
    DEVI void operator()(const pg8::f32x4 (&)[2][2][4][2], const pg8::Unit&, int, int, int, int) const {}
};

struct FEpiResMod {
    static constexpr bool PERM = false, AFTER_DRAIN = true;
    const float* xin; float* x1; bf16_t* H1; const float* MOD0; const float* MOD1; const float* g1; float* slab; float* slots; unsigned* cnt;
    DEVI void operator()(const pg8::f32x4 (&acc)[2][2][4][2], const pg8::Unit& u, int wr, int wc, int fr, int fq) const {
        if (u.pm < NLAT / 256) return;
        const int row0 = u.pm * 256 + wr * 64 + fr, col0 = u.pn * 256 + wc * 32 + 4 * fq;
        float* o = slab + (size_t)(u.k0 >> 8) * NCTX * 1024 - (size_t)NLAT * 1024;
#pragma unroll
        for (int ai = 0; ai < 2; ++ai)
#pragma unroll
            for (int m = 0; m < 4; ++m) { const size_t off = (size_t)(row0 + ai * 128 + m * 16) * 1024 + col0;
#pragma unroll
                for (int bj = 0; bj < 2; ++bj)
#pragma unroll
                    for (int n = 0; n < 2; ++n) *(pg8::f32x4*)(o + off + bj * 128 + n * 16) = acc[ai][bj][m][n]; }
    }
    DEVI void fused(pg8::f32x4 (&acc)[2][2][4][2], const pg8::Unit& u, int wr, int wc, int fr, int fq, PG8_LAS unsigned char* lds, int wid, int lane) const {
        typedef unsigned u32x2v __attribute__((ext_vector_type(2)));
        const int row0 = u.pm * 256 + wr * 64 + fr, col0 = u.pn * 256 + wc * 32 + 4 * fq, b = u.pm >> 4;
        PG8_LAS float* P = (PG8_LAS float*)lds; PG8_LAS float* S = (PG8_LAS float*)(lds + 8192);
        { const float* gate = MOD0 + (size_t)b * 3072 + 2048 + col0; pg8::f32x4 gv[2][2];
#pragma unroll
          for (int bj = 0; bj < 2; ++bj)
#pragma unroll
              for (int n = 0; n < 2; ++n) gv[bj][n] = *(const pg8::f32x4*)(gate + bj * 128 + n * 16);
#pragma unroll
          for (int ai = 0; ai < 2; ++ai)
#pragma unroll
              for (int m = 0; m < 4; ++m) { const size_t off = (size_t)(row0 + ai * 128 + m * 16) * 1024 + col0;
#pragma unroll
                  for (int bj = 0; bj < 2; ++bj)
#pragma unroll
                      for (int n = 0; n < 2; ++n) { const pg8::f32x4 xv = *(const pg8::f32x4*)(xin + off + bj * 128 + n * 16); acc[ai][bj][m][n] = xv + gv[bj][n] * acc[ai][bj][m][n]; *(pg8::f32x4*)(x1 + off + bj * 128 + n * 16) = acc[ai][bj][m][n]; }
                  asm volatile("" : "+v"(acc[ai][0][m][0]), "+v"(acc[ai][0][m][1]), "+v"(acc[ai][1][m][0]), "+v"(acc[ai][1][m][1]));
                  if (m & 1) asm volatile("" ::: "memory"); } }
#pragma unroll
        for (int ai = 0; ai < 2; ++ai)
#pragma unroll
            for (int m = 0; m < 4; ++m) { float q = 0.f;
#pragma unroll
                for (int bj = 0; bj < 2; ++bj)
#pragma unroll
                    for (int n = 0; n < 2; ++n) { const pg8::f32x4 x = acc[ai][bj][m][n]; q += (x[0] * x[0] + x[1] * x[1]) + (x[2] * x[2] + x[3] * x[3]); }
                q += __shfl_xor(q, 16); q += __shfl_xor(q, 32);
                if (fq == 0) P[(ai * 128 + wr * 64 + m * 16 + fr) * 4 + wc] = q; }
        asm volatile("s_waitcnt lgkmcnt(0)" ::: "memory"); __builtin_amdgcn_s_barrier(); asm volatile("" ::: "memory");
        const int row = wid * 32 + (lane & 31);
        if (lane < 32) { const float t = (P[row * 4 + 0] + P[row * 4 + 1]) + (P[row * 4 + 2] + P[row * 4 + 3]);
            __hip_atomic_store(slots + ((size_t)(u.pm * 256 + row) * 4 + u.pn), t, __ATOMIC_RELAXED, __HIP_MEMORY_SCOPE_AGENT); }
        asm volatile("s_waitcnt vmcnt(0)" ::: "memory");
        if (lane == 0) __hip_atomic_fetch_add(cnt + 64 * u.pm, 1u, __ATOMIC_RELAXED, __HIP_MEMORY_SCOPE_AGENT);
        if (wid == 0) { unsigned sp = 0;
            while ((unsigned)__builtin_amdgcn_readfirstlane(__hip_atomic_load(cnt + 64 * u.pm, __ATOMIC_RELAXED, __HIP_MEMORY_SCOPE_AGENT)) < 32u) { __builtin_amdgcn_s_sleep(2); if (++sp > (1u << 22)) break; }
            __builtin_amdgcn_fence(__ATOMIC_ACQUIRE, "agent"); }
        asm volatile("s_waitcnt vmcnt(0) lgkmcnt(0)" ::: "memory"); __builtin_amdgcn_s_barrier(); asm volatile("" ::: "memory");
        if (lane < 32) { const float* sl = slots + (size_t)(u.pm * 256 + row) * 4; float t = 0.f;
#pragma unroll
            for (int k = 0; k < 4; ++k) t += __hip_atomic_load(sl + k, __ATOMIC_RELAXED, __HIP_MEMORY_SCOPE_AGENT);
            S[row] = rsqrtf(t * (1.f / 1024.f) + EPS); }
        asm volatile("s_waitcnt lgkmcnt(0)" ::: "memory"); __builtin_amdgcn_s_barrier(); asm volatile("" ::: "memory");
        const float* md = MOD1 + (size_t)b * 3072 + col0;
#pragma unroll
        for (int bj = 0; bj < 2; ++bj)
#pragma unroll
            for (int n = 0; n < 2; ++n) { const int co = bj * 128 + n * 16; const pg8::f32x4 gg = *(const pg8::f32x4*)(g1 + col0 + co), sh = *(const pg8::f32x4*)(md + co), sc = *(const pg8::f32x4*)(md + 1024 + co);
                const pg8::f32x4 mul = gg * (sc + 1.0f);
#pragma unroll
                for (int ai = 0; ai < 2; ++ai)
#pragma unroll
                    for (int m = 0; m < 4; ++m) { const int r = ai * 128 + wr * 64 + m * 16 + fr; const pg8::f32x4 hv = acc[ai][bj][m][n] * S[r] * mul + sh;
                        u32x2v w; w.x = pg8::cvt_pk_bf16(hv[0], hv[1]); w.y = pg8::cvt_pk_bf16(hv[2], hv[3]); *(u32x2v*)(H1 + (size_t)(u.pm * 256 + r) * 1024 + col0 + co) = w; } }
    }
};
#ifndef FAST_GEMM
#define FAST_GEMM 1
#endif


#define LASP __attribute__((address_space(3)))
__device__ void st_glawalk(const Params& p, int vb, int nvb, unsigned char* lds_, const bf16_t* QIN, const bf16_t* KET, const bf16_t* SC, const float* DEC, const bf16_t* VT, bf16_t* OF, bf16_t* OB) {
    typedef pg8::bf16x8 bx8; typedef pg8::f32x4 f4; typedef unsigned u32x2 __attribute__((ext_vector_type(2))); typedef pg8::u32x4 u4;
    LASP unsigned char* lds = (LASP unsigned char*)lds_;
    constexpr int QOFF = 0, KOFF = 17408, SOFF = KOFF + 18432, VOFF = SOFF + 9216, DOFF = VOFF + 4608, BUFSZ = 50176;
    const int tid = threadIdx.x, wid = __builtin_amdgcn_readfirstlane(tid >> 6), lane = tid & 63, c = lane & 15, g = lane >> 4;
    for (int it0 = vb; it0 < 256; it0 += nvb) {
        const int item = (nvb == 256) ? ((it0 & 7) * 32 + (it0 >> 3)) : it0;
        const int vs = item & 7, combo = item >> 3, d = combo & 1, h = (combo >> 1) & 3, bb = combo >> 3;
        LDS_BARRIER();
        if (wid >= 2) {
            const int lt = tid - 128;
            unsigned long long cst[8]; unsigned mult[8]; int doff[8];
#pragma unroll
            for (int j = 0; j < 8; ++j) { const int pp = lt + 384 * j;
                if (pp < 1024) { cst[j] = (unsigned long long)QIN + (pp >> 4) * 256 + (pp & 15) * 16; mult[j] = 16384u; doff[j] = QOFF + (pp >> 4) * 272 + (pp & 15) * 16; }
                else if (pp < 2048) { const int q = pp - 1024; cst[j] = (unsigned long long)KET + (q >> 3) * 128 + (q & 7) * 16; mult[j] = 16384u; doff[j] = KOFF + (q >> 3) * 144 + (q & 7) * 16; }
                else if (pp < 2560) { const int q = pp - 2048; cst[j] = (unsigned long long)SC + (q >> 3) * 128 + (q & 7) * 16; mult[j] = 8192u; doff[j] = SOFF + (q >> 3) * 144 + (q & 7) * 16; }
                else if (pp < 2816) { const int q = pp - 2560; cst[j] = (unsigned long long)VT + (vs * 32 + (q >> 3)) * 128 + (q & 7) * 16 - (unsigned long long)d * 16384; mult[j] = 16384u; doff[j] = VOFF + (q >> 3) * 144 + (q & 7) * 16; }
                else if (pp < 2848) { const int q = pp - 2816; cst[j] = (unsigned long long)DEC + q * 16; mult[j] = 512u; doff[j] = DOFF + q * 16; }
                else { cst[j] = (unsigned long long)DEC; mult[j] = 0u; doff[j] = -1; } }
            u4 r0[8], r1[8];
#define GW_LOAD(R, step) do { const int cc_ = d == 0 ? ((step) < 4 ? 64 + (step) : (step) - 4) : 67 - (step); const unsigned u_ = (unsigned)(((bb * NCH + cc_) * 4 + h) * 2 + d); \
                _Pragma("unroll") for (int j_ = 0; j_ < 8; ++j_) R[j_] = *(const u4*)(cst[j_] + (unsigned long long)u_ * mult[j_]); } while (0)
#define GW_WRITE(R, bufi) do { LASP unsigned char* b_ = lds + (bufi) * BUFSZ; _Pragma("unroll") for (int j_ = 0; j_ < 8; ++j_) if (doff[j_] >= 0) *(LASP u4*)(b_ + doff[j_]) = R[j_]; } while (0)
            GW_LOAD(r0, 0); GW_WRITE(r0, 0); GW_LOAD(r0, 1); GW_LOAD(r1, 2);
            LDS_BARRIER();
            for (int step = 0; step < NCH; step += 2) {
                GW_WRITE(r0, 1); if (step + 3 < NCH) GW_LOAD(r0, step + 3);
                LDS_BARRIER();
                if (step + 2 < NCH) { GW_WRITE(r1, 0); if (step + 4 < NCH) GW_LOAD(r1, step + 4); }
                LDS_BARRIER();
            }
#undef GW_LOAD
#undef GW_WRITE
        } else {
            f4 S[8];
#pragma unroll
            for (int m = 0; m < 8; ++m) S[m] = (f4){0.f, 0.f, 0.f, 0.f};
            bf16_t* O = d == 0 ? OF : OB;
            LDS_BARRIER();
            for (int step = 0; step < NCH; ++step) {
                const LASP unsigned char* B = lds + (step & 1) * BUFSZ;
#define SB0() __builtin_amdgcn_sched_barrier(0)
#define RDQ(dst_lo, dst_hi, ks) do { _Pragma("unroll") for (int mt = 0; mt < 4; ++mt) { const LASP unsigned char* qa = B + QOFF + (16 * mt + c) * 272 + (32 * (ks) + 4 * g) * 2; dst_lo[mt] = *(const LASP u32x2*)qa; dst_hi[mt] = *(const LASP u32x2*)(qa + 32); } } while (0)
#define MMQ(lo, hi, ks) do { _Pragma("unroll") for (int mt = 0; mt < 4; ++mt) { u4 w; w.x = lo[mt].x; w.y = lo[mt].y; w.z = hi[mt].x; w.w = hi[mt].y; o[mt] = __builtin_amdgcn_mfma_f32_16x16x32_bf16(sB[ks], __builtin_bit_cast(bx8, w), o[mt], 0, 0, 0); } } while (0)
#define RDK(kf, dv, m0) do { _Pragma("unroll") for (int mm = 0; mm < 4; ++mm) { const LASP unsigned char* ka = B + KOFF + (16 * ((m0) + mm) + c) * 144 + g * 16; kf[mm][0] = *(const LASP bx8*)ka; kf[mm][1] = *(const LASP bx8*)(ka + 64); dv[mm] = *(const LASP f4*)(B + DOFF + (16 * ((m0) + mm) + 4 * g) * 4); } } while (0)
#define MMK(kf, dv, m0) do { _Pragma("unroll") for (int mm = 0; mm < 4; ++mm) { S[(m0) + mm] = S[(m0) + mm] * dv[mm]; S[(m0) + mm] = __builtin_amdgcn_mfma_f32_16x16x32_bf16(kf[mm][0], bv0, S[(m0) + mm], 0, 0, 0); S[(m0) + mm] = __builtin_amdgcn_mfma_f32_16x16x32_bf16(kf[mm][1], bv1, S[(m0) + mm], 0, 0, 0); } } while (0)
                const bx8 bv0 = *(const LASP bx8*)(B + VOFF + (16 * wid + c) * 144 + g * 16), bv1 = *(const LASP bx8*)(B + VOFF + (16 * wid + c) * 144 + 64 + g * 16);
                u32x2 qa_lo[4], qa_hi[4], qb_lo[4], qb_hi[4];
                RDQ(qa_lo, qa_hi, 0); RDQ(qb_lo, qb_hi, 1);
                bx8 sB[4];
#pragma unroll
                for (int ks = 0; ks < 4; ++ks) { u4 w; w.x = pg8::cvt_pk_bf16(S[2 * ks][0], S[2 * ks][1]); w.y = pg8::cvt_pk_bf16(S[2 * ks][2], S[2 * ks][3]);
                    w.z = pg8::cvt_pk_bf16(S[2 * ks + 1][0], S[2 * ks + 1][1]); w.w = pg8::cvt_pk_bf16(S[2 * ks + 1][2], S[2 * ks + 1][3]); sB[ks] = __builtin_bit_cast(bx8, w); }
                f4 o[4];
#pragma unroll
                for (int mt = 0; mt < 4; ++mt) o[mt] = (f4){0.f, 0.f, 0.f, 0.f};
                SB0();
                MMQ(qa_lo, qa_hi, 0); SB0();
                RDQ(qa_lo, qa_hi, 2); SB0();
                MMQ(qb_lo, qb_hi, 1); SB0();
                RDQ(qb_lo, qb_hi, 3); SB0();
                MMQ(qa_lo, qa_hi, 2); SB0();
                bx8 sf[4][2];
#pragma unroll
                for (int mt = 0; mt < 4; ++mt) { const LASP unsigned char* sa = B + SOFF + (16 * mt + c) * 144 + g * 16; sf[mt][0] = *(const LASP bx8*)sa; sf[mt][1] = *(const LASP bx8*)(sa + 64); }
                SB0();
                MMQ(qb_lo, qb_hi, 3); SB0();
                bx8 kfa[4][2], kfb[4][2]; f4 dva[4], dvb[4];
                RDK(kfa, dva, 0); SB0();
#pragma unroll
                for (int mt = 0; mt < 4; ++mt) { o[mt] = __builtin_amdgcn_mfma_f32_16x16x32_bf16(bv0, sf[mt][0], o[mt], 0, 0, 0); o[mt] = __builtin_amdgcn_mfma_f32_16x16x32_bf16(bv1, sf[mt][1], o[mt], 0, 0, 0); }
                SB0();
                RDK(kfb, dvb, 4); SB0();
                MMK(kfa, dva, 0); SB0();
                MMK(kfb, dvb, 4); SB0();
#undef SB0
#undef RDQ
#undef MMQ
#undef RDK
#undef MMK
                const int cc = d == 0 ? (step < 4 ? 64 + step : step - 4) : 67 - step; const int row0 = row_of(bb, cc, 0);
#pragma unroll
                for (int mt = 0; mt < 4; ++mt) { u32x2 w; w.x = pg8::cvt_pk_bf16(o[mt][0], o[mt][1]); w.y = pg8::cvt_pk_bf16(o[mt][2], o[mt][3]);
                    *(u32x2*)(O + (size_t)(row0 + 16 * mt + c) * 1024 + h * 256 + vs * 32 + 16 * wid + 4 * g) = w; }
                LDS_BARRIER();
            }
        }
    }
}
#ifndef FAST_WALK
#define FAST_WALK 1
#endif

template <int MODE, int DIR>
__device__ __forceinline__ void st_rglru_impl(const Params& p, int vb, int nvb, unsigned char* lds_, const bf16_t* XR, const bf16_t* SG, const bf16_t* BD, float* SUMA, float* SUMH, bf16_t* Y) {
    typedef pg8::bf16x8 bx8; typedef pg8::f32x4 f4; typedef float f32x2v __attribute__((ext_vector_type(2)));
    LASP unsigned char* lds = (LASP unsigned char*)lds_;
    constexpr int AOFF = 0, FOFF = 17408, BUF = 51200, CWOFF = 2 * BUF;
    constexpr int ND = MODE == 0 ? 1 : 2, NCOMBO = MODE == 0 ? 32 : 16, NTILE = MODE == 0 ? NB * NCH : NB * 64;
    const int tid = threadIdx.x, wid = __builtin_amdgcn_readfirstlane(tid >> 6), lane = tid & 63, c = lane & 15, g = lane >> 4, cp = tid & 63, tg = tid >> 6;
    int P, part, cstep, combo0;
    if (nvb >= NCOMBO) { P = nvb / NCOMBO; part = vb / NCOMBO; cstep = NCOMBO; combo0 = vb % NCOMBO; if (part >= P) return; } else { P = 1; part = 0; cstep = nvb; combo0 = vb; }
    for (int combo = combo0; combo < NCOMBO; combo += cstep) {
        if (MODE == 0 && (combo & 1) != DIR) continue;
        const int nb = MODE == 0 ? (combo >> 1) : combo; constexpr int d0 = MODE == 0 ? DIR : 0;
        const int ch = nb * 128 + 16 * wid + c;
        bx8 wa[ND][4], wx[ND][4]; float ba[ND], bxx[ND], k8[ND];
        LDS_BARRIER();
#pragma unroll
        for (int dd = 0; dd < ND; ++dd) { constexpr int dzero = d0; const int d = dzero + dd;
            const bf16_t* wA = BD + ((size_t)(d * 16 + nb) * 128 + 16 * wid + c) * 128 + 8 * g; const bf16_t* wX = wA + (size_t)2 * 16 * 128 * 128;
#pragma unroll
            for (int ks = 0; ks < 4; ++ks) { wa[dd][ks] = *(const bx8*)(wA + 32 * ks); wx[dd][ks] = *(const bx8*)(wX + 32 * ks); }
            ba[dd] = p.o_b_a[d * 2048 + ch]; bxx[dd] = p.o_b_x[d * 2048 + ch]; k8[dd] = 8.f * 1.4426950408889634f * softplusf_(-p.o_lam[d * 2048 + ch]);
            if (tg < 5) { const f32x2v w2 = tg < 4 ? *(const f32x2v*)(p.o_conv_w + ((size_t)d * 4 + tg) * 2048 + nb * 128 + 2 * cp) : *(const f32x2v*)(p.o_conv_b + (size_t)d * 2048 + nb * 128 + 2 * cp);
                *(LASP f32x2v*)(lds + CWOFF + ((dd * 5 + tg) * 128 + 2 * cp) * 4) = w2; } }
        LDS_BARRIER();
        unsigned xr[14]; float cnext[2] = {0.f, 0.f};
#pragma unroll
        for (int jr = 0; jr < 14; ++jr) xr[jr] = 0u;
#define RG_PREF(tile) do { const int bb_ = MODE == 0 ? (tile) / NCH : (tile) >> 6, cc_ = MODE == 0 ? (tile) % NCH : (tile) & 63; const int row0_ = row_of(bb_, cc_, 0); \
            const bf16_t* xp_ = XR + (size_t)(row0_ + xr_pad_of_tile(row0_ >> 8) + 8 * tg - 3) * 2048 + nb * 128 + 2 * cp; \
            _Pragma("unroll") for (int jr = 0; jr < 14; ++jr) { if (MODE == 1 || (d0 == 0 ? jr < 11 : jr >= 3)) xr[jr] = *(const unsigned*)(xp_ + (size_t)jr * 2048); } \
            if (MODE == 1) { cnext[0] = SUMH[(((size_t)bb_ * 2 + 0) * NCH + cc_) * 2048 + ch]; cnext[1] = SUMH[(((size_t)bb_ * 2 + 1) * NCH + cc_) * 2048 + ch]; } } while (0)
        int it = 0;
        if (part < NTILE) RG_PREF(part);
        for (int tile = part; tile < NTILE; tile += P) {
            const int bb = MODE == 0 ? tile / NCH : tile >> 6, cc = MODE == 0 ? tile % NCH : tile & 63; const int row0 = row_of(bb, cc, 0);
            unsigned xcur[14]; float ccur[2];
#pragma unroll
            for (int jr = 0; jr < 14; ++jr) xcur[jr] = xr[jr];
            ccur[0] = cnext[0]; ccur[1] = cnext[1];
            if (tile + P < NTILE) RG_PREF(tile + P);
            float hsum[4][4];
#pragma unroll
            for (int dd = 0; dd < ND; ++dd) { constexpr int dzero = d0; const int d = dzero + dd;
                LASP unsigned char* B = lds + (it & 1) * BUF; ++it;
                { f32x2v cv[8]; const f32x2v cbv = *(const LASP f32x2v*)(lds + CWOFF + ((dd * 5 + 4) * 128 + 2 * cp) * 4);
#pragma unroll
                  for (int i = 0; i < 8; ++i) cv[i] = cbv;
#pragma unroll
                  for (int jj = 0; jj < 4; ++jj) { const f32x2v cwv = *(const LASP f32x2v*)(lds + CWOFF + ((dd * 5 + jj) * 128 + 2 * cp) * 4);
#pragma unroll
                      for (int i = 0; i < 8; ++i) { const int jr = d == 0 ? i + jj : i + 6 - jj; cv[i].x += cwv.x * __uint_as_float(xcur[jr] << 16); cv[i].y += cwv.y * __uint_as_float(xcur[jr] & 0xffff0000u); } }
#pragma unroll
                  for (int i = 0; i < 8; ++i) { const int rho = 16 * (2 * (tg & 1) + (i >> 2)) + 4 * (tg >> 1) + (i & 3);
                      *(LASP unsigned*)(B + AOFF + rho * 272 + 4 * cp) = pg8::cvt_pk_bf16(cv[i].x, cv[i].y); *(LASP f32x2v*)(B + FOFF + rho * 528 + 8 * cp) = cv[i]; } }
                LDS_BARRIER();
                const int gl = d == 0 ? g : 3 - g;
                const int src1 = d == 0 ? lane - 16 : lane + 16, src2 = d == 0 ? lane - 32 : lane + 32, srcT = d == 0 ? 48 + c : c;
                const size_t sidx = (((size_t)bb * 2 + d) * NCH + cc) * 2048 + ch;
                float av[16], uv[16]; float pa = 1.f, lh = 0.f;
#pragma unroll
                for (int mtl = 0; mtl < 4; ++mtl) { const int mt = d == 0 ? mtl : 3 - mtl;
                    f4 aam = (f4){0.f, 0.f, 0.f, 0.f}, axm = (f4){0.f, 0.f, 0.f, 0.f};
#pragma unroll
                    for (int ks = 0; ks < 4; ++ks) { const bx8 af = *(const LASP bx8*)(B + AOFF + (16 * mt + c) * 272 + (32 * ks + 8 * g) * 2);
                        aam = __builtin_amdgcn_mfma_f32_16x16x32_bf16(af, wa[dd][ks], aam, 0, 0, 0); axm = __builtin_amdgcn_mfma_f32_16x16x32_bf16(af, wx[dd][ks], axm, 0, 0, 0); }
#pragma unroll
                    for (int sq = 0; sq < 4; ++sq) { const int r = d == 0 ? sq : 3 - sq;
                        const float xv = *(const LASP float*)(B + FOFF + (16 * mt + 4 * g + r) * 528 + (16 * wid + c) * 4);
                        const float rr = sigmoidf_(aam[r] + ba[dd]), ii = sigmoidf_(axm[r] + bxx[dd]);
                        const float a = fexp2_(-k8[dd] * rr), u = __builtin_amdgcn_sqrtf(fmaxf(1.f - a * a, 0.f)) * (ii * xv);
                        lh = a * lh + u; pa *= a; if (MODE == 1) { av[mt * 4 + r] = a; uv[mt * 4 + r] = u; } }
                }
                float XA = pa, XU = lh, tA, tU;
                tA = __shfl(XA, src1); tU = __shfl(XU, src1); if (gl >= 1) { XU = tU * XA + XU; XA = tA * XA; }
                tA = __shfl(XA, src2); tU = __shfl(XU, src2); if (gl >= 2) { XU = tU * XA + XU; XA = tA * XA; }
                if (MODE == 0) { if (gl == 3) { SUMA[sidx] = XA; SUMH[sidx] = XU; } }
                else {
                    float eA = __shfl(XA, src1), eU = __shfl(XU, src1); if (gl == 0) { eA = 1.f; eU = 0.f; }
                    float hh = ccur[dd] * eA + eU;
#pragma unroll
                    for (int mtl = 0; mtl < 4; ++mtl) { const int mt = d == 0 ? mtl : 3 - mtl;
#pragma unroll
                        for (int sq = 0; sq < 4; ++sq) { const int r = d == 0 ? sq : 3 - sq; hh = av[mt * 4 + r] * hh + uv[mt * 4 + r]; if (dd == 0) hsum[mt][r] = hh; else hsum[mt][r] += hh; } }
                }
            }
            if (MODE == 1) {
#pragma unroll
                for (int mt = 0; mt < 4; ++mt)
#pragma unroll
                    for (int r = 0; r < 4; ++r) { const size_t o = (size_t)(row0 + 16 * g + 4 * mt + r) * 2048 + ch; Y[o] = f2bf(hsum[mt][r] * bf2f(SG[o])); }
            }
        }
        LDS_BARRIER();
#undef RG_PREF
    }
}
template <int MODE>
__device__ __forceinline__ void st_rglru(const Params& p, int vb, int nvb, unsigned char* lds_, const bf16_t* XR, const bf16_t* SG, const bf16_t* BD, float* SUMA, float* SUMH, bf16_t* Y) {
    if (MODE == 1) { st_rglru_impl<1, 0>(p, vb, nvb, lds_, XR, SG, BD, SUMA, SUMH, Y); return; }
    const int combo0 = nvb >= 32 ? vb % 32 : vb;
    if (nvb >= 32) { if ((combo0 & 1) == 0) st_rglru_impl<0, 0>(p, vb, nvb, lds_, XR, SG, BD, SUMA, SUMH, Y); else st_rglru_impl<0, 1>(p, vb, nvb, lds_, XR, SG, BD, SUMA, SUMH, Y); }
    else { st_rglru_impl<0, 0>(p, vb, nvb, lds_, XR, SG, BD, SUMA, SUMH, Y); st_rglru_impl<0, 1>(p, vb, nvb, lds_, XR, SG, BD, SUMA, SUMH, Y); }
}
#ifndef FAST_RG
#define FAST_RG 1
#endif


#define RG_CH(dd, step) ((dd) == 0 ? ((step) < 4 ? 64 + (step) : (step) - 4) : 67 - (step))
constexpr int RG_ABUF = 2 * 17408, RG_CWOFF = 2 * RG_ABUF;
__device__ __forceinline__ void rg1p_producer(const Params& p, LASP unsigned char* lds, const bf16_t* XR, int bb, int nb, int pw) {
    typedef float f32x2v __attribute__((ext_vector_type(2)));
    const int lane = threadIdx.x & 63, cp = lane;
    unsigned xr[38];
#define RG_PREF(step) do { _Pragma("unroll") for (int dd = 0; dd < 2; ++dd) { const int row0_ = row_of(bb, RG_CH(dd, step), 0); \
            const unsigned char* ub_ = (const unsigned char*)(XR + (size_t)(row0_ + xr_pad_of_tile(row0_ >> 8) + 16 * pw - 3 + 3 * dd) * 2048 + nb * 128);     \
            _Pragma("unroll") for (int j = 0; j < 19; ++j) xr[dd * 19 + j] = *(const unsigned*)(ub_ + (size_t)j * 4096 + (unsigned)(4 * cp)); } } while (0)
#define RG_CONV(bufi) do { _Pragma("unroll") for (int dd = 0; dd < 2; ++dd) { \
            f32x2v cw4[4]; const f32x2v cbv = *(const LASP f32x2v*)(lds + RG_CWOFF + ((dd * 5 + 4) * 128 + 2 * cp) * 4); \
            _Pragma("unroll") for (int jj = 0; jj < 4; ++jj) cw4[jj] = *(const LASP f32x2v*)(lds + RG_CWOFF + ((dd * 5 + jj) * 128 + 2 * cp) * 4); \
            _Pragma("unroll") for (int hq = 0; hq < 2; ++hq) { f32x2v cv[8]; \
                _Pragma("unroll") for (int i = 0; i < 8; ++i) cv[i] = cbv; \
                _Pragma("unroll") for (int jx = 0; jx < 11; ++jx) { const unsigned xw = xr[dd * 19 + 8 * hq + jx]; const f32x2v xv2 = (f32x2v){__uint_as_float(xw << 16), __uint_as_float(xw & 0xffff0000u)}; \
                    _Pragma("unroll") for (int jj = 0; jj < 4; ++jj) { const int i = dd == 0 ? jx - jj : jx - 3 + jj; if (i >= 0 && i < 8) cv[i] = __builtin_elementwise_fma(cw4[jj], xv2, cv[i]); } } \
                _Pragma("unroll") for (int i = 0; i < 8; ++i) { const int t = 16 * pw + 8 * hq + i, rho = 16 * ((t >> 2) & 3) + 4 * (t >> 4) + (t & 3); \
                    *(LASP unsigned*)(lds + (bufi) * RG_ABUF + dd * 17408 + rho * 272 + 4 * cp) = pg8::cvt_pk_bf16(cv[i].x, cv[i].y); } } } } while (0)
    RG_PREF(0);
    RG_CONV(0);
    RG_PREF(1);
    LDS_BARRIER();
    for (int step = 0; step < NCH; ++step) {
        if (step + 1 < NCH) { RG_CONV((step + 1) & 1); if (step + 2 < NCH) RG_PREF(step + 2); }
        LDS_BARRIER();
    }
#undef RG_PREF
#undef RG_CONV
}
template <int WD>
__device__ __forceinline__ void rg1p_consumer(const Params& p, LASP unsigned char* lds, bf16_t* SGY, bf16_t* HXh, const bf16_t* BD, int bb, int nb, int sl, int nt) {
    typedef pg8::bf16x8 bx8; typedef pg8::f32x4 f4;
    const int lane = threadIdx.x & 63, c = lane & 15, g = lane >> 4;
    const int jch = sl * 32 + nt * 16 + c, ch = nb * 128 + jch;
    bx8 wa[4], wx[4];
    { const bf16_t* wA = BD + ((size_t)(WD * 16 + nb) * 128 + jch) * 128 + 8 * g; const bf16_t* wX = wA + (size_t)2 * 16 * 128 * 128;
#pragma unroll
      for (int ks = 0; ks < 4; ++ks) { wa[ks] = *(const bx8*)(wA + 32 * ks); wx[ks] = *(const bx8*)(wX + 32 * ks); } }
    const float ba = p.o_b_a[WD * 2048 + ch], bxx = p.o_b_x[WD * 2048 + ch], k8 = 8.f * 1.4426950408889634f * softplusf_(-p.o_lam[WD * 2048 + ch]);
    float carry = 0.f;
    const int gl = WD == 0 ? g : 3 - g;
    const int src1 = WD == 0 ? lane - 16 : lane + 16, src2 = WD == 0 ? lane - 32 : lane + 32, srcT = WD == 0 ? 48 + c : c;
    LDS_BARRIER();
    for (int step = 0; step < NCH; ++step) {
        const int cc = RG_CH(WD, step); const bool latent = cc < 64, second = step - 4 > 31;
        const int row0u = row_of(bb, cc, 0);
        const unsigned hoff = (unsigned)(16 * g) * 1024u + (unsigned)(ch & 1023), soff = (unsigned)(16 * g) * 2048u + (unsigned)ch;
        unsigned short hxv[16], sgv[16];
        if (latent && second) {
#pragma unroll
            for (int e = 0; e < 16; ++e) { const bf16_t* hb_ = HXh + (size_t)(row0u + e) * 1024; const bf16_t* sb_ = SGY + (size_t)(row0u + e) * 2048; hxv[e] = hb_[hoff]; sgv[e] = sb_[soff]; } }
        const LASP unsigned char* A = lds + (step & 1) * RG_ABUF + WD * 17408;
        float av[16], uv[16]; float pa = 1.f, lh = 0.f;
#pragma unroll
        for (int ml = 0; ml < 4; ++ml) { const int mt = WD == 0 ? ml : 3 - ml;
            f4 aam = (f4){0.f, 0.f, 0.f, 0.f}, axm = (f4){0.f, 0.f, 0.f, 0.f};
#pragma unroll
            for (int ks = 0; ks < 4; ++ks) { const bx8 af = *(const LASP bx8*)(A + (16 * mt + c) * 272 + (32 * ks + 8 * g) * 2);
                aam = __builtin_amdgcn_mfma_f32_16x16x32_bf16(af, wa[ks], aam, 0, 0, 0); axm = __builtin_amdgcn_mfma_f32_16x16x32_bf16(af, wx[ks], axm, 0, 0, 0); }
#pragma unroll
            for (int sq = 0; sq < 4; ++sq) { const int r = WD == 0 ? sq : 3 - sq;
                const float xv = bf2f(*(const LASP unsigned short*)(A + (16 * mt + 4 * g + r) * 272 + jch * 2));
                const float rr = sigmoidf_(aam[r] + ba), ii = sigmoidf_(axm[r] + bxx);
                const float a = fexp2_(-k8 * rr), u = __builtin_amdgcn_sqrtf(fmaxf(1.f - a * a, 0.f)) * (ii * xv);
                lh = a * lh + u; pa *= a; av[mt * 4 + r] = a; uv[mt * 4 + r] = u; }
        }
        float XA = pa, XU = lh, tA, tU;
        tA = __shfl(XA, src1); tU = __shfl(XU, src1); if (gl >= 1) { XU = tU * XA + XU; XA = tA * XA; }
        tA = __shfl(XA, src2); tU = __shfl(XU, src2); if (gl >= 2) { XU = tU * XA + XU; XA = tA * XA; }
        float eA = __shfl(XA, src1), eU = __shfl(XU, src1); if (gl == 0) { eA = 1.f; eU = 0.f; }
        const float totA = __shfl(XA, srcT), totU = __shfl(XU, srcT);
        if (latent) {
            float hh = carry * eA + eU; float hv[16];
#pragma unroll
            for (int ml = 0; ml < 4; ++ml) { const int mt = WD == 0 ? ml : 3 - ml;
#pragma unroll
                for (int sq = 0; sq < 4; ++sq) { const int r = WD == 0 ? sq : 3 - sq; const int e = mt * 4 + r; hh = av[e] * hh + uv[e]; hv[e] = hh; } }
            if (!second) {
#pragma unroll
                for (int e = 0; e < 16; ++e) { bf16_t* hb_ = HXh + (size_t)(row0u + e) * 1024; hb_[hoff] = f2bf(hv[e]); } }
            else {
#pragma unroll
                for (int e = 0; e < 16; ++e) { bf16_t* sb_ = SGY + (size_t)(row0u + e) * 2048; sb_[soff] = f2bf((bf2f(f2bf(hv[e])) + bf2f(hxv[e])) * bf2f(sgv[e])); } }
        }
        carry = carry * totA + totU;
        if (step == 35) asm volatile("s_waitcnt vmcnt(0)" ::: "memory");
        LDS_BARRIER();
    }
}
__device__ __forceinline__ void st_rg1p(const Params& p, int vb, int nvb, unsigned char* lds_, const bf16_t* XR, bf16_t* SGY, bf16_t* HX0, bf16_t* HX1, const bf16_t* BD, const float* XRC) {
    typedef float f32x2v __attribute__((ext_vector_type(2)));
    LASP unsigned char* lds = (LASP unsigned char*)lds_;
    const int wid = __builtin_amdgcn_readfirstlane(threadIdx.x >> 6), lane = threadIdx.x & 63;
    for (int it0 = vb; it0 < 256; it0 += nvb) {
        const int item = (nvb == 256) ? ((it0 & 7) * 32 + (it0 >> 3)) : it0;
        const int sl = item & 3, nb = (item >> 2) & 15, bb = item >> 6;
        bf16_t* HXh = nb < 8 ? HX0 : HX1;
        {
          bf16_t* xd = (bf16_t*)XR + (size_t)(NLAT + bb * 256 + 20 + 4 * bb) * 2048 + nb * 128; const float* xs = XRC + (size_t)(bb * 256) * 2048 + nb * 128;
          for (int e = threadIdx.x; e < 256 * 64; e += NTHREADS) { const int r = e >> 6, cpair = e & 63; const float2 v0 = *(const float2*)(xs + (size_t)r * 2048 + 2 * cpair), v1 = *(const float2*)(xs + (size_t)NCTX * 2048 + (size_t)r * 2048 + 2 * cpair); *(unsigned*)(xd + (size_t)r * 2048 + 2 * cpair) = pg8::cvt_pk_bf16(v0.x + v1.x, v0.y + v1.y); }
#pragma unroll
          for (int dd = 0; dd < 2; ++dd)
              if (wid < 5) { const f32x2v w2 = wid < 4 ? *(const f32x2v*)(p.o_conv_w + ((size_t)dd * 4 + wid) * 2048 + nb * 128 + 2 * lane) : *(const f32x2v*)(p.o_conv_b + (size_t)dd * 2048 + nb * 128 + 2 * lane);
                  *(LASP f32x2v*)(lds + RG_CWOFF + ((dd * 5 + wid) * 128 + 2 * lane) * 4) = w2; }
          asm volatile("s_waitcnt vmcnt(0)" ::: "memory"); LDS_BARRIER(); }
        if (wid >= 4) rg1p_producer(p, lds, XR, bb, nb, wid - 4);
        else if (wid < 2) rg1p_consumer<0>(p, lds, SGY, HXh, BD, bb, nb, sl, wid & 1);
        else rg1p_consumer<1>(p, lds, SGY, HXh, BD, bb, nb, sl, wid & 1);
    }
}
#define XB_TMO      128
#define XB_XCNT(j)  (256  + 64 * (j))
#define XB_XSUB(j)  (1280 + 64 * (j))
#define XB_XGEN(j)  (2304 + 64 * (j))
#define XB_TOP      3328
#define XB_TOPGEN   3392
#define XB_SPIN_CAP (1u << 20)
DEVI unsigned xb_ld(unsigned* p)              { return __hip_atomic_load(p, __ATOMIC_RELAXED, __HIP_MEMORY_SCOPE_AGENT); }
DEVI unsigned xb_add(unsigned* p, unsigned v) { return __hip_atomic_fetch_add(p, v, __ATOMIC_RELAXED, __HIP_MEMORY_SCOPE_AGENT); }
DEVI unsigned xb_xcc_id() { return (unsigned)__builtin_amdgcn_s_getreg((3 << 11) | 20) & 0xFu; }
#define XB_SPIN(cond, bar) do { unsigned _sp = 0; while (cond) { __builtin_amdgcn_s_sleep(1); \
    if ((++_sp & 255u) == 0u) { if (xb_ld(&(bar)[XB_TMO])) break; if (_sp > XB_SPIN_CAP) { atomicAdd(&(bar)[XB_TMO], 1u); break; } } } } while (0)
struct XcdBarrier { unsigned* bar; unsigned x; volatile __attribute__((address_space(3))) unsigned* st; };
DEVI XcdBarrier xcd_barrier_post(unsigned* bar, volatile __attribute__((address_space(3))) unsigned* st) {
    XcdBarrier b; b.bar = bar; b.x = xb_xcc_id(); b.st = st;
    if (threadIdx.x == 0) (void)xb_add(&bar[XB_XCNT(b.x)], 1u);
    return b;
}
DEVI void xcd_barrier_complete(unsigned* bar, unsigned x, unsigned& nloc, unsigned& nx) {
    const unsigned G = gridDim.x * gridDim.y * gridDim.z;
    unsigned sum, cnt, mine, sp = 0u;
    for (;;) {
        sum = 0u; cnt = 0u; mine = 0u;
#pragma unroll
        for (unsigned j = 0; j < 16; ++j) { const unsigned c = xb_ld(&bar[XB_XCNT(j)]); sum += c; cnt += (c > 0u) ? 1u : 0u; mine = (j == x) ? c : mine; }
        if (sum == G) break;
        __builtin_amdgcn_s_sleep(1);
        if ((++sp & 255u) == 0u) { if (xb_ld(&bar[XB_TMO])) break; if (sp > XB_SPIN_CAP) { atomicAdd(&bar[XB_TMO], 1u); break; } }
    }
    nloc = mine > 0u ? mine : 1u; nx = cnt > 0u ? cnt : 1u;
}
DEVI void xcd_barrier(const XcdBarrier& b) {
    asm volatile("s_waitcnt vmcnt(0)" ::: "memory");
    __syncthreads();
    if (threadIdx.x == 0) {
        unsigned* bar = b.bar;
        __builtin_amdgcn_s_waitcnt(0);
        unsigned nloc = b.st[0], nx = b.st[1];
        if (nloc == 0u) { xcd_barrier_complete(bar, b.x, nloc, nx); b.st[0] = nloc; b.st[1] = nx; }
        const unsigned old = xb_add(&bar[XB_XSUB(b.x)], 1u);
        const unsigned gen = old / nloc;
        if (old + 1u == (gen + 1u) * nloc) {
            __builtin_amdgcn_fence(__ATOMIC_RELEASE, "agent");
            asm volatile("s_waitcnt vmcnt(0)" ::: "memory");
            const unsigned og = xb_add(&bar[XB_TOP], 1u);
            const unsigned tg = og / nx;
            if (og + 1u == (tg + 1u) * nx) xb_add(&bar[XB_TOPGEN], 1u);
            else XB_SPIN(xb_ld(&bar[XB_TOPGEN]) == tg, bar);
            __builtin_amdgcn_fence(__ATOMIC_ACQUIRE, "agent");
            xb_add(&bar[XB_XGEN(b.x)], 1u);
            asm volatile("s_waitcnt vmcnt(0)" ::: "memory");
        } else {
            XB_SPIN(xb_ld(&bar[XB_XGEN(b.x)]) == gen, bar);
            __builtin_amdgcn_fence(__ATOMIC_ACQUIRE, "agent");
            asm volatile("s_waitcnt vmcnt(0)" ::: "memory");
        }
    }
    __syncthreads();
}
__device__ __forceinline__ void run_stage(const Params& p, int st, int vb, int nvb, unsigned char* lds) {
    unsigned char* ws = p.ws;
    float* MOD = (float*)(ws + WS_MOD); float* ALR = (float*)(ws + WS_ALR); float* X1C = (float*)(ws + WS_X1C);
    float* SUMA = (float*)(ws + WS_SUMA); float* SUMH = (float*)(ws + WS_SUMH); float* DEC = (float*)(ws + WS_DEC);
    bf16_t* Bt1 = (bf16_t*)(ws + WS_BT1); bf16_t* Bt2 = (bf16_t*)(ws + WS_BT2); bf16_t* Bt3 = (bf16_t*)(ws + WS_BT3); bf16_t* Bt4 = (bf16_t*)(ws + WS_BT4);
    bf16_t* S0 = (bf16_t*)(ws + WS_SLOT(0)); bf16_t* S1 = (bf16_t*)(ws + WS_SLOT(1)); bf16_t* S2 = (bf16_t*)(ws + WS_SLOT(2));
    bf16_t* S3 = (bf16_t*)(ws + WS_SLOT(3)); bf16_t* S4 = (bf16_t*)(ws + WS_SLOT(4)); bf16_t* S5 = (bf16_t*)(ws + WS_SLOT(5));
    bf16_t* DO0 = (bf16_t*)p.out; bf16_t* DOSC = (bf16_t*)((unsigned char*)p.out + 34 * MiB); bf16_t* DOZA = (bf16_t*)((unsigned char*)p.out + 51 * MiB);
    float* XRC = (float*)(ws + WS_BT1);
    float* SLAB2 = (float*)(ws + WS_SLOT(5) + 262144);
    switch (st) {
    case 0: st_mod(p, vb, nvb, (float*)lds); st_wprep(p, vb, nvb, lds); break;
    case 1: st_modulate(p, vb, nvb, 0, p.x, p.ctx, S0); break;
    case 3: st_glaprep(p, vb, nvb, lds, S1, S2, ALR, S3, S4, DOSC, DEC, S5); break;
#if FAST_WALK
    case 4: st_glawalk(p, vb, nvb, lds, S3, S4, DOSC, DEC, S5, S2, DO0); break;
#else
    case 4: st_glawalk_naive(p, vb, nvb, (float*)lds, S3, S4, DOSC, DEC, S5, S2, DO0); break;
#endif
    case 6: st_inner(p, vb, nvb, S2, DO0, S3, S4, S5, S0, DOZA, X1C); break;
    case 8: st_modulate(p, vb, nvb, 1, p.out, p.ctx, S2, SLAB2, 8, MOD + 4 * 3072 + 2048, nvb == 256 ? NLAT : 0);
            {
              for (int e = vb * NTHREADS + threadIdx.x; e < 9 * 4 * 256; e += nvb * NTHREADS) { const int gi = e >> 10, w = e & 1023; const int r0 = gi < 4 ? 4096 * gi + 4 * gi : (gi < 8 ? NLAT + 16 + 256 * (gi - 4) + 4 * (gi - 4) : NT + 32);
                  *(uint4*)(S3 + (size_t)r0 * 2048 + w * 8) = uint4{0u, 0u, 0u, 0u}; } }
            break;
    case 10: st_rg1p(p, vb, nvb, lds, S3, S0, S2, S5 + 131072, (const bf16_t*)(ws + WS_BD), XRC); break;
    case 14: if (nvb != 256) st_final(p, vb, nvb); break;
#if FAST_GEMM
    case 2: { FEpi1 E{S1, S2, S3, S4, S5, ALR, DOZA}; pg8::Gemm g{S0, Bt1, NT, N1, 1024}; pg8::TileOrder S; S.init(NT / 256, 11, 16, nvb, vb, 0, 8, 0, 12);
              pg8::gemm_phase<FEpi1, pg8::TileOrder, true, true>((PG8_LAS unsigned char*)lds, g, S, E); } break;
    case 5: { FEpi1 E{S1, S2, S3, S4, S5, ALR, DOZA}; pg8::Gemm g{S0, Bt1, NT, N1, 1024}; pg8::TileOrder S; S.init(NT / 256, 18, 16, nvb, vb, 0, 4, 8, 15);
              pg8::gemm_phase<FEpi1, pg8::TileOrder, true, true>((PG8_LAS unsigned char*)lds, g, S, E); } break;
    case 7: if (nvb == 256) { FEpiResMod E{p.x, p.out, S2, MOD, MOD + 5 * 3072, p.norm_g + 1024, SLAB2, (float*)(ws + WS_CTL + 131072 + 262144), (unsigned*)(ws + WS_CTL + 65536 + 16384)};
                  pg8::Gemm g{S0, Bt2, NT, 1024, 2048}; pg8::TileOrder S; S.init(NLAT / 256, 4, 32, nvb, vb, 0, 1 << 30, 0, 0, NCTX / 256, 4, NLAT / 256, 8, 4); S.tail_first = 1;
                  pg8::gemm_phase<FEpiResMod, pg8::TileOrder, false, true>((PG8_LAS unsigned char*)lds, g, S, E); }
            else { FEpiRes<true> E{p.x, p.ctx, p.out, SLAB2, MOD}; pg8::Gemm g{S0, Bt2, NT, 1024, 2048}; pg8::TileOrder S; S.init(NLAT / 256, 4, 32, nvb, vb, 0, 1 << 30, 0, 0, NCTX / 256, 4, NLAT / 256, 8, 4);
                  pg8::gemm_phase<FEpiRes<true>, pg8::TileOrder, true, true>((PG8_LAS unsigned char*)lds, g, S, E); } break;
    case 9: { FEpi3 E{S3, S0, XRC}; pg8::Gemm g{S2, Bt3, NT, 4096, 1024}; pg8::TileOrder S; S.init(NLAT / 256, 16, 16, nvb, vb, 0, 1 << 30, 0, 0, NCTX / 256, 8, NLAT / 256, 2, 8);
              pg8::gemm_phase<FEpi3, pg8::TileOrder, true, true>((PG8_LAS unsigned char*)lds, g, S, E); } break;
    case 13: if (nvb == 256) { FEpiResRms E{p.out, p.out, MOD + 5 * 3072, p.final_g, (float*)(ws + WS_CTL + 131072), (unsigned*)(ws + WS_CTL + 65536)}; pg8::Gemm g{S0, Bt4, NLAT, 1024, 2048}; pg8::TileOrder S; S.init(NLAT / 256, 4, 32, nvb, vb);
                  pg8::gemm_phase<FEpiResRms, pg8::TileOrder, false, true>((PG8_LAS unsigned char*)lds, g, S, E); }
             else { FEpiRes<false> E{p.out, nullptr, p.out, nullptr, MOD + 5 * 3072}; pg8::Gemm g{S0, Bt4, NLAT, 1024, 2048}; pg8::TileOrder S; S.init(NLAT / 256, 4, 32, nvb, vb);
                  pg8::gemm_phase<FEpiRes<false>, pg8::TileOrder, true, true>((PG8_LAS unsigned char*)lds, g, S, E); } break;
#else
    case 2: { Epi1 E{S1, S2, S3, S4, S5, ALR}; st_gemm_naive(vb, nvb, (float*)lds, S0, Bt1, 0, NT / 32, 0, 8, 1024, E); st_gemm_naive(vb, nvb, (float*)lds, S0, Bt1, 0, NT / 32, 12, 13, 1024, E); } break;
    case 5: { Epi1 E{S1, S2, S3, S4, S5, ALR}; st_gemm_naive(vb, nvb, (float*)lds, S0, Bt1, 0, NT / 32, 8, 12, 1024, E); st_gemm_naive(vb, nvb, (float*)lds, S0, Bt1, 0, NT / 32, 13, 29, 1024, E); } break;
    case 7: { EpiRes E{p.x, p.ctx, p.out, X1C, MOD}; st_gemm_naive(vb, nvb, (float*)lds, S0, Bt2, 0, NT / 32, 0, 4, 2048, E); } break;
    case 9: { Epi3 E{S3, S0}; st_gemm_naive(vb, nvb, (float*)lds, S2, Bt3, 0, NLAT / 32, 0, 16, 1024, E); st_gemm_naive(vb, nvb, (float*)lds, S2, Bt3, NLAT / 32, NT / 32, 0, 8, 1024, E); } break;
    case 13: { EpiRes E{p.out, nullptr, p.out, nullptr, MOD + 5 * 3072}; st_gemm_naive(vb, nvb, (float*)lds, S0, Bt4, 0, NLAT / 32, 0, 4, 2048, E); } break;
#endif
    }
}
constexpr int NSTAGES = 15;
constexpr int LDS_BYTES = 147456;

#ifndef ONE_LAUNCH
#define ONE_LAUNCH 1
#endif
#if !ONE_LAUNCH
__global__ void __launch_bounds__(NTHREADS) k_mega(Params p, int st) {
    extern __shared__ __attribute__((aligned(16))) unsigned char lds[];
    run_stage(p, st, blockIdx.x, gridDim.x, lds);
}
#else
__global__ void __launch_bounds__(NTHREADS) k_mega(Params p) {
    extern __shared__ __attribute__((aligned(16))) unsigned char lds[];
    volatile __attribute__((address_space(3))) unsigned* st = (volatile __attribute__((address_space(3))) unsigned*)((__attribute__((address_space(3))) unsigned char*)lds + (LDS_BYTES - 64));
    if (threadIdx.x < 2) st[threadIdx.x] = 0u;
    __syncthreads();
    const XcdBarrier bar = xcd_barrier_post((unsigned*)(p.ws + WS_CTL) + 4096, st);
#ifndef REP_STAGE
#define REP_STAGE -1
#endif
#ifndef REP_N
#define REP_N 1
#endif
#define RS(k) do { run_stage(p, k, blockIdx.x, gridDim.x, lds); if ((k) == REP_STAGE) { for (int rep_ = 0; rep_ < REP_N; ++rep_) { xcd_barrier(bar); run_stage(p, k, blockIdx.x, gridDim.x, lds); } } } while (0)
#define GS() xcd_barrier(bar)
    RS(0); GS(); RS(1); GS(); RS(2); GS(); RS(3); GS(); RS(4); GS(); RS(5); GS(); RS(6); GS(); RS(7); GS();
    RS(8); GS(); RS(9); GS(); RS(10); GS(); RS(13); if (gridDim.x != 256) { GS(); RS(14); }
#undef RS
#undef GS
}
#endif

extern "C" void kernel_launch(void* const* d_in, const int* in_sizes, int n_in, void* d_out, int out_size, void* d_ws, size_t ws_size, hipStream_t stream) {
    static int inited = 0, grid_blocks = 0;
    if (!inited) {
        if (n_in != 23 || ws_size < WS_END || out_size != NLAT * D) { fprintf(stderr, "kernel_launch: unexpected shapes n_in %d ws %zu out %d\n", n_in, ws_size, out_size); inited = -1; return; }
        if (hipFuncSetAttribute((const void*)k_mega, hipFuncAttributeMaxDynamicSharedMemorySize, LDS_BYTES) != hipSuccess) { fprintf(stderr, "hipFuncSetAttribute failed\n"); inited = -1; return; }
        int dev = 0, cus = 0, per_cu = 0;
        (void)hipGetDevice(&dev); (void)hipDeviceGetAttribute(&cus, hipDeviceAttributeMultiprocessorCount, dev);
        (void)hipOccupancyMaxActiveBlocksPerMultiprocessor(&per_cu, (const void*)k_mega, NTHREADS, LDS_BYTES);
        if (per_cu < 1) { fprintf(stderr, "kernel_launch: occupancy query says %d blocks per CU\n", per_cu); per_cu = 1; }
        if (per_cu > 1) per_cu = 1;
        grid_blocks = cus * per_cu;
        inited = 1;
    }
    if (inited < 0) return;
    Params p{};
    const float** f = (const float**)&p;
    for (int i = 0; i < 23; ++i) f[i] = (const float*)d_in[i];
    p.out = (float*)d_out; p.ws = (unsigned char*)d_ws;
    (void)hipMemsetAsync((unsigned char*)d_ws + WS_CTL, 0, 2 * MiB, stream);
#if ONE_LAUNCH
    void* args[] = {&p};
    hipError_t e = hipLaunchCooperativeKernel((const void*)k_mega, dim3(grid_blocks), dim3(NTHREADS), args, LDS_BYTES, stream);
    if (e != hipSuccess) fprintf(stderr, "cooperative launch failed: %s (grid %d)\n", hipGetErrorString(e), grid_blocks);
#else
    for (int st = 0; st < NSTAGES; ++st) hipLaunchKernelGGL(k_mega, dim3(1024), dim3(NTHREADS), LDS_BYTES, stream, p, st);
#endif
}
```

```cpp
#include <hip/hip_runtime.h>
#include <hip/hip_cooperative_groups.h>
namespace cg = cooperative_groups;
#include <cstdio>
#include <cstdint>

typedef unsigned short bf16_t;
#define DEVI __device__ __forceinline__
#define LDS_BARRIER() do { asm volatile("s_waitcnt lgkmcnt(0)" ::: "memory"); __builtin_amdgcn_s_barrier(); asm volatile("" ::: "memory"); } while (0)

constexpr int D = 1024, NB = 4, SEQ = 4096, CTXL = 256;
constexpr int NLAT = NB * SEQ;
constexpr int NCTX = NB * CTXL;
constexpr int NT = NLAT + NCTX;
constexpr int NCH = 68;
constexpr int EVEN_IN = 7200;
constexpr int N1 = 7424;
constexpr int N1A = 13 * 256;
constexpr int RGW = 2048;
constexpr float EPS = 1e-6f;

constexpr size_t MiB = 1u << 20;
constexpr size_t WS_CTL = 0;
constexpr size_t WS_MOD = 1 * MiB;
constexpr size_t WS_ALR = 2 * MiB;
constexpr size_t WS_X1C = 5 * MiB;
constexpr size_t WS_SUMA = 9 * MiB;
constexpr size_t WS_SUMH = 9 * MiB + 4608 * 1024;
constexpr size_t WS_DEC = 18 * MiB;
constexpr size_t WS_BT1 = 19 * MiB + 512 * 1024;
constexpr size_t WS_BT2 = 34 * MiB;
constexpr size_t WS_BT3 = 38 * MiB;
constexpr size_t WS_BT4 = 46 * MiB;
constexpr size_t WS_BD = 50 * MiB;
constexpr size_t WS_S0 = 52 * MiB;
constexpr size_t SLOT = 34 * MiB;
constexpr size_t WS_END = WS_S0 + 6 * SLOT;
static_assert(WS_END == 256 * MiB, "ws map");
#define WS_SLOT(i) (WS_S0 + (size_t)(i) * SLOT)

struct Params {
    const float* x; const float* c; const float* ctx; const float* c_ctx; const float* norm_g; const float* w_mod; const float* b_mod;
    const float* e_w_in; const float* e_w_a2; const float* e_b_a2; const float* e_gla_g; const float* e_conv_w; const float* e_w_out;
    const float* o_w_in; const float* o_conv_w; const float* o_conv_b; const float* o_w_a; const float* o_b_a; const float* o_w_x; const float* o_b_x;
    const float* o_lam; const float* o_w_out; const float* final_g;
    float* out; unsigned char* ws;
};

DEVI float bf2f(bf16_t v) { return __uint_as_float((unsigned)v << 16); }
DEVI bf16_t f2bf(float f) { unsigned u = __float_as_uint(f); return (bf16_t)((u + 0x7fffu + ((u >> 16) & 1u)) >> 16); }
DEVI unsigned pk2(float lo, float hi) { return (unsigned)f2bf(lo) | ((unsigned)f2bf(hi) << 16); }
DEVI float fexp2_(float x) { return __builtin_amdgcn_exp2f(x); }
DEVI float frcp_(float x) { return __builtin_amdgcn_rcpf(x); }
DEVI float sigmoidf_(float x) { return frcp_(1.0f + fexp2_(-1.4426950408889634f * x)); }
DEVI float siluf_(float x) { return x * frcp_(1.0f + fexp2_(-1.4426950408889634f * x)); }
DEVI float softplusf_(float x) { return fmaxf(x, 0.f) + log1pf(__expf(-fabsf(x))); }
DEVI float logsigmoidf_(float x) { return fminf(x, 0.f) - 0.6931471805599453f * __builtin_amdgcn_logf(1.0f + fexp2_(-1.4426950408889634f * fabsf(x))); }
DEVI int row_of(int bb, int c, int t) { return c < 64 ? bb * 4096 + c * 64 + t : NLAT + bb * 256 + (c - 64) * 64 + t; }
DEVI int mod_idx(int row) { return row < NLAT ? (row >> 12) : 4; }
DEVI int xr_pad_of_tile(int pm) { return pm < 64 ? 4 * ((pm >> 4) + 1) : 20 + 4 * (pm - 64); }
constexpr int XR_ROWS = NT + 36;
DEVI float wave_sum(float v) {
#pragma unroll
    for (int o = 1; o < 64; o <<= 1) v += __shfl_xor(v, o);
    return v;
}
__host__ __device__ inline int colmap1(int n) {
    const int t = n >> 8, c = n & 255;
    if (t < 12) return n;
    if (t == 12) return c < 32 ? 3072 + c : -1;
    if (t < 21) { const int j = t - 13; return c < 128 ? 4128 + 128 * j + c : 5152 + 128 * j + (c - 128); }
    const int j = t - 21; return c < 128 ? 3104 + 128 * j + c : 6176 + 128 * j + (c - 128);
}

#define NTHREADS 512

__device__ void st_mod(const Params& p, int vb, int nvb, float* lds) {
    float* MOD = (float*)(p.ws + WS_MOD);
    for (int i = threadIdx.x; i < 5 * 1024; i += NTHREADS) { const int s = i >> 10, k = i & 1023; const float v = s < 4 ? p.c[s * 1024 + k] : p.c_ctx[k]; lds[i] = siluf_(v); }
    __syncthreads();
    const int lane = threadIdx.x & 63, gw = vb * (NTHREADS / 64) + (threadIdx.x >> 6), ngw = nvb * (NTHREADS / 64);
    for (int it = gw; it < 2 * 48 * 32; it += ngw) {
        const int kc = it & 31, cb = (it >> 5) % 48, li = it / (32 * 48), j = cb * 64 + lane, k0 = kc * 32;
        const float* W = p.w_mod + ((size_t)li * 1024 + k0) * 3072 + j;
        float wv[32];
#pragma unroll
        for (int k = 0; k < 32; ++k) wv[k] = W[(size_t)k * 3072];
        float a0 = 0.f, a1 = 0.f, a2 = 0.f, a3 = 0.f, a4 = 0.f;
#pragma unroll
        for (int k = 0; k < 32; ++k) { const float w = wv[k]; a0 += lds[k0 + k] * w; a1 += lds[1024 + k0 + k] * w; a2 += lds[2048 + k0 + k] * w; a3 += lds[3072 + k0 + k] * w; a4 += lds[4096 + k0 + k] * w; }
        const float bv = kc == 0 ? p.b_mod[li * 3072 + j] : 0.f;
        float* o = MOD + (size_t)li * 5 * 3072 + j;
        atomicAdd(o, a0 + bv); atomicAdd(o + 3072, a1 + bv); atomicAdd(o + 2 * 3072, a2 + bv); atomicAdd(o + 3 * 3072, a3 + bv); atomicAdd(o + 4 * 3072, a4 + bv);
    }
    __syncthreads();
}

__device__ __forceinline__ void wt_item(const float* src, int ldw, bf16_t* dst, int K, int k0, __attribute__((address_space(3))) float* scr, int lane) {
    typedef unsigned v4u __attribute__((ext_vector_type(4)));
    if (src) {
        float rv[32];
#pragma unroll
        for (int i = 0; i < 32; ++i) { const int kk = 2 * i + (lane >> 5); rv[i] = src[(size_t)(k0 + kk) * ldw + (lane & 31)]; }
#pragma unroll
        for (int i = 0; i < 32; ++i) { const int kk = 2 * i + (lane >> 5); scr[kk * 33 + (lane & 31)] = rv[i]; }
    }
    asm volatile("s_waitcnt lgkmcnt(0)" ::: "memory");
    const int cch = lane & 7;
#pragma unroll
    for (int j = 0; j < 4; ++j) { const int n = (lane >> 3) + 8 * j; const __attribute__((address_space(3))) float* sp = scr + (8 * cch) * 33 + n;
        v4u o = {0u, 0u, 0u, 0u};
        if (src) { o.x = pk2(sp[0 * 33], sp[1 * 33]); o.y = pk2(sp[2 * 33], sp[3 * 33]); o.z = pk2(sp[4 * 33], sp[5 * 33]); o.w = pk2(sp[6 * 33], sp[7 * 33]); }
        *(v4u*)(dst + (size_t)n * K + k0 + 8 * cch) = o; }
    asm volatile("s_waitcnt lgkmcnt(0)" ::: "memory");
}
__device__ void st_wprep(const Params& p, int vb, int nvb, unsigned char* lds_) {
    bf16_t* Bt1 = (bf16_t*)(p.ws + WS_BT1); bf16_t* Bt2 = (bf16_t*)(p.ws + WS_BT2); bf16_t* Bt3 = (bf16_t*)(p.ws + WS_BT3); bf16_t* Bt4 = (bf16_t*)(p.ws + WS_BT4);
    bf16_t* BD = (bf16_t*)(p.ws + WS_BD);
    const int lane = threadIdx.x & 63, wv = threadIdx.x >> 6, gw = vb * (NTHREADS / 64) + wv, ngw = nvb * (NTHREADS / 64);
    __attribute__((address_space(3))) float* scr = (__attribute__((address_space(3))) float*)lds_ + 8192 + wv * (64 * 33);
    constexpr int I1 = 16 * (N1 / 32), I2 = 32 * 32, I3 = 16 * 128, I4 = 32 * 32, I5 = 64 * 8;
    for (int it = gw; it < I1 + I2 + I3 + I4 + I5; it += ngw) {
        int r = it;
        if (r < I1) { const int nbk = N1 / 32, kb = r / nbk, nb = r % nbk; const int sc = colmap1(nb * 32); wt_item(sc < 0 ? nullptr : p.e_w_in + sc, EVEN_IN, Bt1 + (size_t)nb * 32 * 1024, 1024, kb * 64, scr, lane); continue; } r -= I1;
        if (r < I2) { const int kb = r / 32, nb = r % 32; wt_item(p.e_w_out + nb * 32, 1024, Bt2 + (size_t)nb * 32 * 2048, 2048, kb * 64, scr, lane); continue; } r -= I2;
        if (r < I3) { const int kb = r / 128, nb = r % 128; wt_item(p.o_w_in + nb * 32, 4096, Bt3 + (size_t)nb * 32 * 1024, 1024, kb * 64, scr, lane); continue; } r -= I3;
        if (r < I4) { const int kb = r / 32, nb = r % 32; wt_item(p.o_w_out + nb * 32, 1024, Bt4 + (size_t)nb * 32 * 2048, 2048, kb * 64, scr, lane); continue; } r -= I4;
        { const int m = r >> 8, dn = (r >> 3) & 31, kb = (r >> 2) & 1, nb = r & 3; const float* W = (m == 0 ? p.o_w_a : p.o_w_x) + (size_t)dn * 16384;
          wt_item(W + nb * 32, 128, BD + (size_t)m * 2 * 16 * 16384 + (size_t)dn * 16384 + (size_t)nb * 32 * 128, 128, kb * 64, scr, lane); }
    }
}

__device__ void st_modulate(const Params& p, int vb, int nvb, int li, const float* xlat, const float* xctx, bf16_t* H, const float* slab = nullptr, int nslab = 0, const float* gatec = nullptr, int row_begin = 0) {
    const float* MOD = (const float*)(p.ws + WS_MOD) + (size_t)li * 5 * 3072;
    const float* g = p.norm_g + li * 1024;
    const int lane = threadIdx.x & 63, gw = vb * (NTHREADS / 64) + (threadIdx.x >> 6), ngw = nvb * (NTHREADS / 64);
    for (int row = row_begin + gw; row < NT; row += ngw) {
        const float* xr = row < NLAT ? xlat + (size_t)row * 1024 : xctx + (size_t)(row - NLAT) * 1024;
        const float* md = MOD + (size_t)mod_idx(row) * 3072;
        float4 v[4]; float ss = 0.f;
#pragma unroll
        for (int j = 0; j < 4; ++j) { v[j] = *(const float4*)(xr + j * 256 + lane * 4);
            if (slab && row >= NLAT) {
                float4 a = {0.f, 0.f, 0.f, 0.f};
                for (int ks = 0; ks < nslab; ++ks) { const float4 t = *(const float4*)(slab + ((size_t)ks * NCTX + (row - NLAT)) * 1024 + j * 256 + lane * 4); a.x += t.x; a.y += t.y; a.z += t.z; a.w += t.w; }
                const float4 gt = *(const float4*)(gatec + j * 256 + lane * 4); v[j].x += gt.x * a.x; v[j].y += gt.y * a.y; v[j].z += gt.z * a.z; v[j].w += gt.w * a.w; }
            ss += v[j].x * v[j].x + v[j].y * v[j].y + v[j].z * v[j].z + v[j].w * v[j].w; }
        const float rinv = rsqrtf(wave_sum(ss) * (1.f / 1024.f) + EPS);
#pragma unroll
        for (int j = 0; j < 4; ++j) { const int c0 = j * 256 + lane * 4; const float4 gg = *(const float4*)(g + c0), sh = *(const float4*)(md + c0), sc = *(const float4*)(md + 1024 + c0);
            ushort4 o; o.x = f2bf(v[j].x * rinv * gg.x * (1.f + sc.x) + sh.x); o.y = f2bf(v[j].y * rinv * gg.y * (1.f + sc.y) + sh.y);
            o.z = f2bf(v[j].z * rinv * gg.z * (1.f + sc.z) + sh.z); o.w = f2bf(v[j].w * rinv * gg.w * (1.f + sc.w) + sh.w);
            *(ushort4*)(H + (size_t)row * 1024 + c0) = o; }
    }
}

template <class Epi>
__device__ void st_gemm_naive(int vb, int nvb, float* lds, const bf16_t* A, const bf16_t* Bt, int mt0, int mt1, int nt0, int nt1, int K, const Epi& E) {
    float* As = lds;
    float* Bs = lds + 32 * 33;
    const int tid = threadIdx.x, tx = tid & 63, ty = tid >> 6;
    const int nmt = mt1 - mt0, nnt = nt1 - nt0;
    for (int it = vb; it < nmt * nnt; it += nvb) {
        const int m0 = (mt0 + it / nnt) * 32, n0 = (nt0 + it % nnt) * 256;
        float acc[4][4];
#pragma unroll
        for (int i = 0; i < 4; ++i)
#pragma unroll
            for (int j = 0; j < 4; ++j) acc[i][j] = 0.f;
        for (int k0 = 0; k0 < K; k0 += 32) {
            __syncthreads();
            for (int e = tid; e < 32 * 32; e += NTHREADS) { const int r = e >> 5, kk = e & 31; As[r * 33 + kk] = bf2f(A[(size_t)(m0 + r) * K + k0 + kk]); }
            for (int e = tid; e < 256 * 32; e += NTHREADS) { const int r = e >> 5, kk = e & 31; Bs[r * 33 + kk] = bf2f(Bt[(size_t)(n0 + r) * K + k0 + kk]); }
            __syncthreads();
#pragma unroll 8
            for (int kk = 0; kk < 32; ++kk) {
                float a[4], b[4];
#pragma unroll
                for (int i = 0; i < 4; ++i) a[i] = As[(ty * 4 + i) * 33 + kk];
#pragma unroll
                for (int j = 0; j < 4; ++j) b[j] = Bs[(tx + 64 * j) * 33 + kk];
#pragma unroll
                for (int i = 0; i < 4; ++i)
#pragma unroll
                    for (int j = 0; j < 4; ++j) acc[i][j] += a[i] * b[j];
            }
        }
#pragma unroll
        for (int i = 0; i < 4; ++i) E(m0 + ty * 4 + i, n0, tx, acc[i]);
    }
    __syncthreads();
}

struct Epi1 {
    bf16_t *QK, *V, *SGA, *Z, *CBG; float* ALR;
    DEVI void operator()(int row, int n0, int cl, const float (&v)[4]) const {
        const int t = n0 >> 8;
        if (t < 4) { for (int j = 0; j < 4; ++j) QK[(size_t)row * 1024 + n0 + cl + 64 * j] = f2bf(v[j]); }
        else if (t < 8) { for (int j = 0; j < 4; ++j) V[(size_t)row * 1024 + (n0 - 1024) + cl + 64 * j] = f2bf(v[j]); }
        else if (t < 12) { for (int j = 0; j < 4; ++j) SGA[(size_t)row * 1024 + (n0 - 2048) + cl + 64 * j] = f2bf(siluf_(v[j])); }
        else if (t == 12) { if (cl < 32) ALR[(size_t)row * 32 + cl] = v[0]; }
        else if (t < 21) { const int jt = t - 13; Z[(size_t)row * 1024 + 128 * jt + cl] = f2bf(v[0] * v[2]); Z[(size_t)row * 1024 + 128 * jt + cl + 64] = f2bf(v[1] * v[3]); }
        else { const int jt = t - 21; CBG[(size_t)row * 1024 + 128 * jt + cl] = f2bf(v[0] * siluf_(v[2])); CBG[(size_t)row * 1024 + 128 * jt + cl + 64] = f2bf(v[1] * siluf_(v[3])); }
    }
};
struct EpiRes {
    const float* xl; const float* xc; float* outl; float* outc; const float* MODl;
    DEVI void operator()(int row, int n0, int cl, const float (&v)[4]) const {
        const float* gate = MODl + (size_t)mod_idx(row) * 3072 + 2048;
        for (int j = 0; j < 4; ++j) { const int col = n0 + cl + 64 * j;
            if (row < NLAT) outl[(size_t)row * 1024 + col] = xl[(size_t)row * 1024 + col] + gate[col] * v[j];
            else if (outc) outc[(size_t)(row - NLAT) * 1024 + col] = xc[(size_t)(row - NLAT) * 1024 + col] + gate[col] * v[j]; }
    }
};
struct Epi3 {
    bf16_t* XR; bf16_t* SG;
    DEVI void operator()(int row, int n0, int cl, const float (&v)[4]) const {
        for (int j = 0; j < 4; ++j) { const int col = n0 + cl + 64 * j;
            if (col < 2048) XR[(size_t)row * 2048 + col] = f2bf(v[j]); else if (row < NLAT) SG[(size_t)row * 2048 + col - 2048] = f2bf(siluf_(v[j])); }
    }
};

#define LASQ __attribute__((address_space(3)))
__device__ void st_glaprep(const Params& p, int vb, int nvb, unsigned char* ldsb, const bf16_t* QK, const bf16_t* V, const float* ALR, bf16_t* QIN, bf16_t* KET, bf16_t* SC, float* DEC, bf16_t* VT) {
    typedef unsigned u4 __attribute__((ext_vector_type(4))); typedef unsigned u2 __attribute__((ext_vector_type(2))); typedef float f4 __attribute__((ext_vector_type(4))); typedef short bx8 __attribute__((ext_vector_type(8)));
    LASQ unsigned char* lds = (LASQ unsigned char*)ldsb;
    constexpr int RQ = 0, RK = 17408, Q0 = 34816, K0 = 52224, VR = 69632, AL = VR + 33792, TT = AL + 8192;
    const int tid = threadIdx.x, kk = tid & 127, tq = tid >> 7, wv = tid >> 6, ln = tid & 63, cl = ln & 15, gq = ln >> 4;
    u4 r[9];
#define GP_LOAD(item) do { const int h_ = (item) & 3, bc_ = (item) >> 2, c_ = bc_ % NCH, bb_ = bc_ / NCH; const size_t row0_ = (size_t)row_of(bb_, c_, 0); \
        _Pragma("unroll") for (int j_ = 0; j_ < 2; ++j_) { const int p_ = tid + 512 * j_; r[j_] = *(const u4*)(QK + (row0_ + (p_ >> 4)) * 1024 + h_ * 128 + (p_ & 15) * 8); r[2 + j_] = *(const u4*)(QK + (row0_ + (p_ >> 4)) * 1024 + 512 + h_ * 128 + (p_ & 15) * 8); } \
        _Pragma("unroll") for (int j_ = 0; j_ < 4; ++j_) { const int p_ = tid + 512 * j_; r[4 + j_] = *(const u4*)(V + (row0_ + (p_ >> 5)) * 1024 + h_ * 256 + (p_ & 31) * 8); } \
        r[8] = *(const u4*)(ALR + (row0_ + (tid >> 3)) * 32 + (tid & 7) * 4); } while (0)
    const int NIT = NB * NCH * 4;
    if (vb < NIT) GP_LOAD(vb);
    for (int item = vb; item < NIT; item += nvb) {
        const int h = item & 3;
        LDS_BARRIER();
#pragma unroll
        for (int j = 0; j < 2; ++j) { const int pp = tid + 512 * j; *(LASQ u4*)(lds + RQ + (pp >> 4) * 272 + (pp & 15) * 16) = r[j]; *(LASQ u4*)(lds + RK + (pp >> 4) * 272 + (pp & 15) * 16) = r[2 + j]; }
#pragma unroll
        for (int j = 0; j < 4; ++j) { const int pp = tid + 512 * j; *(LASQ u4*)(lds + VR + (pp >> 5) * 528 + (pp & 31) * 16) = r[4 + j]; }
        *(LASQ u4*)(lds + AL + (tid >> 3) * 128 + (tid & 7) * 16) = r[8];
        float w2a[2][16], b2a[2];
#pragma unroll
        for (int d = 0; d < 2; ++d) {
#pragma unroll
            for (int rr = 0; rr < 16; ++rr) w2a[d][rr] = p.e_w_a2[((size_t)d * 16 + rr) * 512 + h * 128 + kk];
            b2a[d] = p.e_b_a2[d * 512 + h * 128 + kk]; }
        asm volatile("" ::: "memory");
        if (item + nvb < NIT) GP_LOAD(item + nvb);
        LDS_BARRIER();
        unsigned qkr[16];
#pragma unroll
        for (int i = 0; i < 16; ++i) { qkr[i] = (unsigned)*(const LASQ unsigned short*)(lds + RQ + (tq * 16 + i) * 272 + kk * 2) | ((unsigned)*(const LASQ unsigned short*)(lds + RK + (tq * 16 + i) * 272 + kk * 2) << 16); }
        float bc[2][16];
#pragma unroll
        for (int d = 0; d < 2; ++d) {
            const float (&w2)[16] = w2a[d]; const float b2 = b2a[d];
#pragma unroll
            for (int ib = 0; ib < 8; ++ib) {
                f4 ar[2][4];
#pragma unroll
                for (int ii = 0; ii < 2; ++ii) { const LASQ f4* a = (const LASQ f4*)(lds + AL + (tq * 16 + ib * 2 + ii) * 128 + d * 64); ar[ii][0] = a[0]; ar[ii][1] = a[1]; ar[ii][2] = a[2]; ar[ii][3] = a[3]; }
#pragma unroll
                for (int ii = 0; ii < 2; ++ii) { float z = b2;
#pragma unroll
                    for (int q4 = 0; q4 < 4; ++q4) z += ar[ii][q4][0] * w2[4 * q4] + ar[ii][q4][1] * w2[4 * q4 + 1] + ar[ii][q4][2] * w2[4 * q4 + 2] + ar[ii][q4][3] * w2[4 * q4 + 3];
                    bc[d][ib * 2 + ii] = logsigmoidf_(z) * (1.f / 16.f); }
            }
            float sacc = 0.f;
            if (d == 0) {
#pragma unroll
                for (int i = 0; i < 16; ++i) { sacc += bc[d][i]; bc[d][i] = sacc; } }
            else {
#pragma unroll
                for (int i = 15; i >= 0; --i) { sacc += bc[d][i]; bc[d][i] = sacc; } }
            *(LASQ float*)(lds + TT + ((d * 4 + tq) * 128 + kk) * 4) = sacc;
        }
        LDS_BARRIER();
        const float scale = 0.08838834764831845f;
#pragma unroll
        for (int d = 0; d < 2; ++d) {
            const size_t u = (size_t)item * 2 + d;
            float off = 0.f, blast = 0.f;
#pragma unroll
            for (int q = 0; q < 4; ++q) { const float tv = *(const LASQ float*)(lds + TT + ((d * 4 + q) * 128 + kk) * 4); blast += tv; if (d == 0 ? (q < tq) : (q > tq)) off += tv; }
            LASQ unsigned char* qd = lds + (d == 0 ? Q0 : RQ); LASQ unsigned char* kd = lds + (d == 0 ? K0 : RK);
            unsigned ke[8];
#pragma unroll
            for (int i = 0; i < 16; ++i) { const int t = tq * 16 + i; const float bq = bc[d][i] + off;
                const float qv = __uint_as_float(qkr[i] << 16) * scale, kv = __uint_as_float(qkr[i] & 0xffff0000u);
                const float eb = fexp2_(1.4426950408889634f * bq);
                *(LASQ unsigned short*)(qd + t * 272 + kk * 2) = f2bf(qv * eb); *(LASQ unsigned short*)(kd + t * 272 + kk * 2) = f2bf(kv * frcp_(eb));
                const unsigned kev = f2bf(kv * fexp2_(1.4426950408889634f * (blast - bq)));
                if (i & 1) ke[i >> 1] |= kev << 16; else ke[i >> 1] = kev; }
            { u4 w0 = {ke[0], ke[1], ke[2], ke[3]}, w1 = {ke[4], ke[5], ke[6], ke[7]}; u4* dst = (u4*)(KET + (u * 128 + kk) * 64 + tq * 16); dst[0] = w0; dst[1] = w1; }
            if (tq == 0) DEC[u * 128 + kk] = fexp2_(1.4426950408889634f * blast);
        }
        LDS_BARRIER();
#pragma unroll
        for (int d = 0; d < 2; ++d) {
            const size_t u = (size_t)item * 2 + d;
            const LASQ unsigned char* qd = lds + (d == 0 ? Q0 : RQ); const LASQ unsigned char* kd = lds + (d == 0 ? K0 : RK);
#pragma unroll
            for (int j = 0; j < 2; ++j) { const int pp = tid + 512 * j; *(u4*)(QIN + u * 8192 + (pp >> 4) * 128 + (pp & 15) * 8) = *(const LASQ u4*)(qd + (pp >> 4) * 272 + (pp & 15) * 16); }
            const int mt = wv >> 1;
#pragma unroll
            for (int nn = 0; nn < 2; ++nn) { const int nt = 2 * (wv & 1) + nn; f4 acc = {0.f, 0.f, 0.f, 0.f};
#pragma unroll
                for (int k4 = 0; k4 < 4; ++k4) { const bx8 kf = *(const LASQ bx8*)(kd + (16 * nt + cl) * 272 + (32 * k4 + 8 * gq) * 2), qf = *(const LASQ bx8*)(qd + (16 * mt + cl) * 272 + (32 * k4 + 8 * gq) * 2);
                    acc = __builtin_amdgcn_mfma_f32_16x16x32_bf16(kf, qf, acc, 0, 0, 0); }
                const int t = 16 * mt + cl, s0 = 16 * nt + 4 * gq; float v[4];
#pragma unroll
                for (int rr = 0; rr < 4; ++rr) { const int sx = s0 + rr; v[rr] = (d == 0 ? (sx <= t) : (sx >= t)) ? acc[rr] : 0.f; }
                u2 w; w.x = pk2(v[0], v[1]); w.y = pk2(v[2], v[3]); *(u2*)(SC + (u * 64 + t) * 64 + s0) = w; }
        }
        { const int vc = tid & 255, th = tid >> 8; unsigned vv[16];
#pragma unroll
          for (int i = 0; i < 32; ++i) { const unsigned x = *(const LASQ unsigned short*)(lds + VR + (32 * th + i) * 528 + vc * 2); if (i & 1) vv[i >> 1] |= x << 16; else vv[i >> 1] = x; }
          u4* dst = (u4*)(VT + ((size_t)item * 256 + vc) * 64 + 32 * th);
          dst[0] = (u4){vv[0], vv[1], vv[2], vv[3]}; dst[1] = (u4){vv[4], vv[5], vv[6], vv[7]}; dst[2] = (u4){vv[8], vv[9], vv[10], vv[11]}; dst[3] = (u4){vv[12], vv[13], vv[14], vv[15]}; }
    }
    LDS_BARRIER();
#undef GP_LOAD
}

__device__ void st_glawalk_naive(const Params& p, int vb, int nvb, float* Sl, const bf16_t* QIN, const bf16_t* KET, const bf16_t* SC, const float* DEC, const bf16_t* VT, bf16_t* OF, bf16_t* OB) {
    const int vc = threadIdx.x & 255, half = threadIdx.x >> 8;
    for (int combo = vb; combo < 32; combo += nvb) {
        const int d = combo & 1, h = (combo >> 1) & 3, bb = combo >> 3;
        __syncthreads();
        for (int k = half * 64; k < half * 64 + 64; ++k) Sl[k * 256 + vc] = 0.f;
        __syncthreads();
        bf16_t* O = d == 0 ? OF : OB;
        for (int step = 0; step < NCH; ++step) {
            const int c = d == 0 ? (step < 4 ? 64 + step : step - 4) : 67 - step;
            const int u = ((bb * NCH + c) * 4 + h) * 2 + d;
            const bf16_t* q = QIN + (size_t)u * 64 * 128; const bf16_t* ke = KET + (size_t)u * 128 * 64; const bf16_t* sc = SC + (size_t)u * 64 * 64;
            const bf16_t* vt = VT + (((size_t)(u >> 1)) * 256 + vc) * 64;
            float vv[64];
#pragma unroll
            for (int t = 0; t < 64; ++t) vv[t] = bf2f(vt[t]);
            const int row0 = row_of(bb, c, 0);
            for (int t = half * 32; t < half * 32 + 32; ++t) { float a = 0.f;
                for (int k = 0; k < 128; ++k) a += bf2f(q[t * 128 + k]) * bf2f(f2bf(Sl[k * 256 + vc]));
#pragma unroll
                for (int s = 0; s < 64; ++s) a += bf2f(sc[t * 64 + s]) * vv[s];
                O[(size_t)(row0 + t) * 1024 + h * 256 + vc] = f2bf(a); }
            __syncthreads();
            for (int k = half * 64; k < half * 64 + 64; ++k) { float a = DEC[(size_t)u * 128 + k] * Sl[k * 256 + vc];
#pragma unroll
                for (int t = 0; t < 64; ++t) a += bf2f(ke[k * 64 + t]) * vv[t];
                Sl[k * 256 + vc] = a; }
            __syncthreads();
        }
    }
}

__device__ void st_inner(const Params& p, int vb, int nvb, const bf16_t* OF, const bf16_t* OB, const bf16_t* SGA, const bf16_t* Z, const bf16_t* CBG, bf16_t* INNER, const bf16_t* ZA, float* X1C) {
    const int lane = threadIdx.x & 63, gw = vb * (NTHREADS / 64) + (threadIdx.x >> 6), ngw = nvb * (NTHREADS / 64);
    float4 gg = *(const float4*)(p.e_gla_g + lane * 4);
    for (int row = gw; row < NT; row += ngw) {
        bool hasp, hasn;
        if (row < NLAT) { const int t = row & 63; hasp = t != 0; hasn = t != 63; } else { const int t = (row - NLAT) & 255; hasp = t != 0; hasn = t != 255; }
        const size_t rp = hasp ? row - 1 : row, rn = hasn ? row + 1 : row; const float mp = hasp ? 1.f : 0.f, mn = hasn ? 1.f : 0.f;
        ushort4 a[4], b[4], sg[4], zc[4], zp[4], zn[4], cb[4];
#pragma unroll
        for (int h = 0; h < 4; ++h) { const int c0 = h * 256 + lane * 4;
            a[h] = *(const ushort4*)(OF + (size_t)row * 1024 + c0); b[h] = *(const ushort4*)(OB + (size_t)row * 1024 + c0); sg[h] = *(const ushort4*)(SGA + (size_t)row * 1024 + c0);
            const bf16_t* zb = h == 0 ? ZA + lane * 4 : Z + c0; const size_t zpitch = h == 0 ? 256 : 1024;
            zc[h] = *(const ushort4*)(zb + (size_t)row * zpitch); zp[h] = *(const ushort4*)(zb + rp * zpitch); zn[h] = *(const ushort4*)(zb + rn * zpitch);
            cb[h] = *(const ushort4*)(CBG + (size_t)row * 1024 + c0); }
#pragma unroll
        for (int h = 0; h < 4; ++h) { const int c0 = h * 256 + lane * 4;
            const float o0 = bf2f(a[h].x) + bf2f(b[h].x), o1 = bf2f(a[h].y) + bf2f(b[h].y), o2 = bf2f(a[h].z) + bf2f(b[h].z), o3 = bf2f(a[h].w) + bf2f(b[h].w);
            const float rinv = rsqrtf(wave_sum(o0 * o0 + o1 * o1 + o2 * o2 + o3 * o3) * (1.f / 256.f) + EPS);
            uint2 o; o.x = pk2(o0 * rinv * gg.x * bf2f(sg[h].x), o1 * rinv * gg.y * bf2f(sg[h].y)); o.y = pk2(o2 * rinv * gg.z * bf2f(sg[h].z), o3 * rinv * gg.w * bf2f(sg[h].w));
            *(uint2*)(INNER + (size_t)row * 2048 + c0) = o;
            const float4 w0 = *(const float4*)(p.e_conv_w + c0), w1 = *(const float4*)(p.e_conv_w + 1024 + c0), w2 = *(const float4*)(p.e_conv_w + 2048 + c0);
            uint2 y; y.x = pk2(bf2f(cb[h].x) * (mp * w0.x * bf2f(zp[h].x) + w1.x * bf2f(zc[h].x) + mn * w2.x * bf2f(zn[h].x)), bf2f(cb[h].y) * (mp * w0.y * bf2f(zp[h].y) + w1.y * bf2f(zc[h].y) + mn * w2.y * bf2f(zn[h].y)));
            y.y = pk2(bf2f(cb[h].z) * (mp * w0.z * bf2f(zp[h].z) + w1.z * bf2f(zc[h].z) + mn * w2.z * bf2f(zn[h].z)), bf2f(cb[h].w) * (mp * w0.w * bf2f(zp[h].w) + w1.w * bf2f(zc[h].w) + mn * w2.w * bf2f(zn[h].w)));
            *(uint2*)(INNER + (size_t)row * 2048 + 1024 + c0) = y; }
    }
}

template <int MODE>
__device__ void st_rglru_naive(const Params& p, int vb, int nvb, float* lds, const bf16_t* XR, const bf16_t* SG, float* SUMA, float* SUMH, bf16_t* Y) {
    float* xc = lds;
    float* av = xc + 64 * 128;
    float* uv = av + 64 * 128;
    float* hf = uv + 64 * 128;
    const int tid = threadIdx.x, j = tid & 127, tq = tid >> 7;
    const int nitems = MODE == 0 ? NB * NCH * 16 * 2 : NB * 64 * 16;
    for (int it = vb; it < nitems; it += nvb) {
        int bb, c, nb;
        if (MODE == 0) { nb = (it >> 1) & 15; const int bc = it >> 5; c = bc % NCH; bb = bc / NCH; } else { nb = it & 15; const int bc = it >> 4; c = bc & 63; bb = bc >> 6; }
        const int row0 = row_of(bb, c, 0);
        const int seg0 = c < 64 ? bb * 4096 : NLAT + bb * 256, segn = c < 64 ? 4096 : 256;
        const int tl0 = row0 - seg0;
        for (int dd = 0; dd < (MODE == 0 ? 1 : 2); ++dd) {
            const int d = MODE == 0 ? (it & 1) : dd;
            __syncthreads();
            for (int e = tid; e < 64 * 128; e += NTHREADS) { const int t = e >> 7, i = e & 127, ch = nb * 128 + i; float a = p.o_conv_b[d * 2048 + ch];
#pragma unroll
                for (int jj = 0; jj < 4; ++jj) { const int tt = d == 0 ? tl0 + t - 3 + jj : tl0 + t + 3 - jj;
                    if (tt >= 0 && tt < segn) a += p.o_conv_w[((size_t)d * 4 + jj) * 2048 + ch] * bf2f(XR[(size_t)(seg0 + tt) * 2048 + ch]); }
                xc[e] = a; }
            __syncthreads();
            const float* WA = p.o_w_a + ((size_t)d * 16 + nb) * 128 * 128; const float* WX = p.o_w_x + ((size_t)d * 16 + nb) * 128 * 128;
            const int ch = nb * 128 + j;
            const float ba = p.o_b_a[d * 2048 + ch], bx = p.o_b_x[d * 2048 + ch], sp = softplusf_(-p.o_lam[d * 2048 + ch]);
            for (int i16 = 0; i16 < 16; ++i16) { const int t = tq * 16 + i16; float ra = ba, rx = bx;
                for (int i = 0; i < 128; ++i) { const float xv = bf2f(f2bf(xc[t * 128 + i])); ra += xv * bf2f(f2bf(WA[i * 128 + j])); rx += xv * bf2f(f2bf(WX[i * 128 + j])); }
                const float r = sigmoidf_(ra), ig = sigmoidf_(rx); const float la = -8.f * r * sp; const float a = __expf(la);
                av[t * 128 + j] = a; uv[t * 128 + j] = sqrtf(-expm1f(2.f * la)) * (ig * xc[t * 128 + j]); }
            __syncthreads();
            if (tid < 128) {
                const size_t sidx = (((size_t)bb * 2 + d) * NCH + c) * 2048 + ch;
                if (MODE == 0) { float A = 1.f, hh = 0.f;
                    if (d == 0) for (int t = 0; t < 64; ++t) { const float a = av[t * 128 + j]; hh = a * hh + uv[t * 128 + j]; A *= a; }
                    else for (int t = 63; t >= 0; --t) { const float a = av[t * 128 + j]; hh = a * hh + uv[t * 128 + j]; A *= a; }
                    SUMA[sidx] = A; SUMH[sidx] = hh;
                } else { float hh = SUMH[sidx];
                    if (d == 0) for (int t = 0; t < 64; ++t) { hh = av[t * 128 + j] * hh + uv[t * 128 + j]; hf[t * 128 + j] = hh; }
                    else for (int t = 63; t >= 0; --t) { hh = av[t * 128 + j] * hh + uv[t * 128 + j]; const size_t o = (size_t)(row0 + t) * 2048 + ch; Y[o] = f2bf((hf[t * 128 + j] + hh) * bf2f(SG[o])); }
                }
            }
        }
    }
    __syncthreads();
}
__device__ void st_carry(const Params& p, int vb, int nvb, const float* SUMA, float* SUMH) {
    for (int e = vb * NTHREADS + threadIdx.x; e < NB * 2 * 2048; e += nvb * NTHREADS) {
        const int ch = e & 2047, d = (e >> 11) & 1, bb = e >> 12; float hh = 0.f;
        for (int s0 = 0; s0 < NCH; s0 += 17) {
            float A[17], H[17];
#pragma unroll
            for (int i = 0; i < 17; ++i) { const int step = s0 + i, c = d == 0 ? (step < 4 ? 64 + step : step - 4) : 67 - step; const size_t sidx = (((size_t)bb * 2 + d) * NCH + c) * 2048 + ch; A[i] = SUMA[sidx]; H[i] = SUMH[sidx]; }
#pragma unroll
            for (int i = 0; i < 17; ++i) { const int step = s0 + i, c = d == 0 ? (step < 4 ? 64 + step : step - 4) : 67 - step; const size_t sidx = (((size_t)bb * 2 + d) * NCH + c) * 2048 + ch; SUMH[sidx] = hh; hh = A[i] * hh + H[i]; }
        }
    }
}
__device__ void st_final(const Params& p, int vb, int nvb) {
    const int lane = threadIdx.x & 63, gw = vb * (NTHREADS / 64) + (threadIdx.x >> 6), ngw = nvb * (NTHREADS / 64);
    for (int row = gw; row < NLAT; row += ngw) { float* xr = p.out + (size_t)row * 1024; float4 v[4]; float ss = 0.f;
#pragma unroll
        for (int j = 0; j < 4; ++j) { v[j] = *(const float4*)(xr + j * 256 + lane * 4); ss += v[j].x * v[j].x + v[j].y * v[j].y + v[j].z * v[j].z + v[j].w * v[j].w; }
        const float rinv = rsqrtf(wave_sum(ss) * (1.f / 1024.f) + EPS);
#pragma unroll
        for (int j = 0; j < 4; ++j) { const float4 g = *(const float4*)(p.final_g + j * 256 + lane * 4); float4 o; o.x = v[j].x * rinv * g.x; o.y = v[j].y * rinv * g.y; o.z = v[j].z * rinv * g.z; o.w = v[j].w * rinv * g.w; *(float4*)(xr + j * 256 + lane * 4) = o; }
    }
}


namespace pg8 {
#define PG8_LAS __attribute__((address_space(3)))
typedef short bf16x8 __attribute__((ext_vector_type(8)));
typedef float f32x4 __attribute__((ext_vector_type(4)));
typedef unsigned u32x4 __attribute__((ext_vector_type(4)));
constexpr int BM = 256, BK = 64, HALF = 128, HTB = HALF * BK * 2, STAGE_BYTES = 8 * HTB, NXCD = 8, WGM = 8;
__host__ __device__ __forceinline__ int lds_byte(int r, int c) { const int st = (r >> 4) * 2 + (c >> 5), rr = r & 15, cc = c & 31, ob = rr * 64 + cc * 2; return st * 1024 + (ob ^ (((ob >> 9) & 1) << 5)); }
__host__ __device__ __forceinline__ void stage_rc(int b, int& R, int& C) { const int st = b / 1024, sb = b % 1024, swz = sb ^ (((sb >> 9) & 1) << 5); R = (st >> 1) * 16 + swz / 64; C = (st & 1) * 32 + (swz % 64) / 2; }
__host__ __device__ __forceinline__ int perm32(int rho) { const int n = rho >> 4, i = rho & 15; return 8 * (i >> 2) + 4 * n + (i & 3); }
struct Unit { int pm, pn, k0, nk; };
struct Gemm { const bf16_t* A; const bf16_t* Bt; int M, N, K; };
struct TileOrder {
    int nM, nN, nwg, G, c, m0, split, base0, base1, nkfull, nM2, nN2, m02, nKS, nk2, tail_first;
    __device__ void init(int nM_, int nN_, int nkfull_, int G_, int c_, int m0_ = 0, int split_ = 1 << 30, int base0_ = 0, int base1_ = 0, int nM2_ = 0, int nN2_ = 0, int m02_ = 0, int nKS_ = 1, int nk2_ = 0) {
        nM = nM_; nN = nN_; nwg = nM * nN; nkfull = nkfull_; G = G_; c = c_; m0 = m0_; split = split_; base0 = base0_; base1 = base1_; nM2 = nM2_; nN2 = nN2_; m02 = m02_; nKS = nKS_; nk2 = nk2_; tail_first = 0; }
    __device__ bool next(int i, Unit& u) const {
        long L = (long)i * G + c;
        if (tail_first) {
            const int ntail = nM2 * nN2 * nKS;
            if (c < ntail) { if (i == 0) L = (long)nwg + c; else L = (long)(i - 1) * G + c; }
            if (i > 0 && c >= ntail && L >= nwg) return false;
            if (i > 0 && c < ntail && L >= nwg) return false;
        }
        if (L >= nwg) { const long L2 = L - nwg; if (L2 >= (long)nM2 * nN2 * nKS) return false; const int ks = (int)(L2 % nKS), rest = (int)(L2 / nKS);
            u.pm = m02 + rest / nN2; u.pn = rest % nN2; u.k0 = ks * nk2 * 64; u.nk = nk2; return true; }
        int wgid = (int)L; { const int q = nwg / NXCD, r = nwg % NXCD, xcd = wgid % NXCD, off = wgid / NXCD; wgid = (xcd < r ? xcd * (q + 1) : r * (q + 1) + (xcd - r) * q) + off; }
        const int nig = WGM * nN, gid = wgid / nig, fm = gid * WGM, gsz = (nM - fm) < WGM ? (nM - fm) : WGM;
        const int pm = fm + ((wgid % nig) % gsz), j = (wgid % nig) / gsz;
        u.pm = m0 + pm; u.pn = j < split ? base0 + j : base1 + (j - split); u.k0 = 0; u.nk = nkfull; return true;
    }
    __device__ __forceinline__ void a_ready(const Unit&) const {}
    __device__ __forceinline__ void done(const Unit&) const {}
};
typedef float f32x2_t __attribute__((ext_vector_type(2))); typedef __bf16 bf16x2_t __attribute__((ext_vector_type(2)));
__device__ __forceinline__ unsigned cvt_pk_bf16(float lo, float hi) { f32x2_t v = {lo, hi}; bf16x2_t b = __builtin_convertvector(v, bf16x2_t); return __builtin_bit_cast(unsigned, b); }
template <class Epi, class Sched, bool ALIGN_EPI = false, bool SP2 = false>
__device__ __forceinline__ void gemm_phase(PG8_LAS unsigned char* lds, const Gemm g, const Sched& S, const Epi& E) {
    const int tid = threadIdx.x, wid = __builtin_amdgcn_readfirstlane(tid >> 6), lane = tid & 63, wr = wid >> 2, wc = wid & 3, fr = lane & 15, fq = lane >> 4;
    const int K = g.K;
    unsigned voffA[2], voffB[2];
#pragma unroll
    for (int i = 0; i < 2; ++i) { int R, C; stage_rc(tid * 16 + i * 8192, R, C); const int Rb = Epi::PERM ? ((R & ~31) + perm32(R & 31)) : R;
        voffA[i] = (unsigned)(R * K + C) * 2u; voffB[i] = (unsigned)(Rb * K + C) * 2u; }
    const size_t kstep = (size_t)(BK * 2);
    const size_t hstep = (size_t)HALF * K * 2;
    const size_t tstep = 2 * hstep;
    const unsigned ldsw = (unsigned)wid * 1024u;
    const int aoff = lds_byte(wr * 64 + fr, fq * 8), boff = lds_byte(wc * 32 + fr, fq * 8);
#define PG8_SA(b, h) (((b) * 2 + (h)) * HTB)
#define PG8_SB(b, h) ((4 + (b) * 2 + (h)) * HTB)
#define PG8_STAGE(bufoff, gbase, voff) do { _Pragma("unroll") for (int _i = 0; _i < 2; ++_i) \
        __builtin_amdgcn_global_load_lds((const unsigned*)((const char*)(gbase) + (voff)[_i]), (PG8_LAS unsigned*)(lds + (bufoff) + ldsw + _i * 8192), 16, 0, 0); } while (0)
#define PG8_LDA(dst, b, h) do { _Pragma("unroll") for (int m = 0; m < 4; ++m) _Pragma("unroll") for (int k = 0; k < 2; ++k) dst[m][k] = *(const PG8_LAS bf16x8*)(lds + PG8_SA(b, h) + aoff + m * 2048 + k * 1024); } while (0)
#define PG8_LDB(dst, b, h) do { _Pragma("unroll") for (int n = 0; n < 2; ++n) _Pragma("unroll") for (int k = 0; k < 2; ++k) dst[n][k] = *(const PG8_LAS bf16x8*)(lds + PG8_SB(b, h) + boff + n * 2048 + k * 1024); } while (0)
#define PG8_MMA(ai, bj, At, Bt) do { __builtin_amdgcn_s_setprio(1); _Pragma("unroll") for (int m = 0; m < 4; ++m) _Pragma("unroll") for (int n = 0; n < 2; ++n) _Pragma("unroll") for (int k = 0; k < 2; ++k) \
        acc[ai][bj][m][n] = __builtin_amdgcn_mfma_f32_16x16x32_bf16(Bt[n][k], At[m][k], acc[ai][bj][m][n], 0, 0, 0); __builtin_amdgcn_s_setprio(0); } while (0)
#define PG8_WAIT_V(n) asm volatile("s_waitcnt vmcnt(" #n ")" ::: "memory")
#define PG8_WAIT_L(n) asm volatile("s_waitcnt lgkmcnt(" #n ")" ::: "memory")
#define PG8_BAR __builtin_amdgcn_s_barrier()
#define PG8_SCHED __builtin_amdgcn_sched_barrier(0)
    Unit cur, nxt; int ui = 0;
    if (!S.next(0, cur)) return;
    f32x4 acc[2][2][4][2];
#pragma unroll
    for (int a = 0; a < 2; ++a)
#pragma unroll
        for (int b = 0; b < 2; ++b)
#pragma unroll
            for (int m = 0; m < 4; ++m)
#pragma unroll
                for (int n = 0; n < 2; ++n) acc[a][b][m][n] = (f32x4){0.f, 0.f, 0.f, 0.f};
    bf16x8 At[4][2], B0[2][2], B1[2][2];
    const char* cA = (const char*)g.A + (size_t)cur.pm * tstep + (size_t)cur.k0 * 2; const char* cB = (const char*)g.Bt + (size_t)cur.pn * tstep + (size_t)cur.k0 * 2;
    S.a_ready(cur);
    if constexpr (SP2) {
        PG8_STAGE(PG8_SB(0, 0), cB, voffB); PG8_STAGE(PG8_SB(0, 1), cB + hstep, voffB); PG8_STAGE(PG8_SA(0, 0), cA, voffA); PG8_STAGE(PG8_SA(0, 1), cA + hstep, voffA);
        if (wr == 1) PG8_BAR;
        PG8_WAIT_V(2); PG8_BAR;
        PG8_STAGE(PG8_SB(1, 0), cB + kstep, voffB); PG8_STAGE(PG8_SA(1, 0), cA + kstep, voffA); PG8_STAGE(PG8_SB(1, 1), cB + hstep + kstep, voffB);
        PG8_WAIT_V(6); PG8_BAR;
    } else {
        PG8_STAGE(PG8_SB(0, 0), cB, voffB); PG8_STAGE(PG8_SA(0, 0), cA, voffA); PG8_STAGE(PG8_SB(0, 1), cB + hstep, voffB); PG8_STAGE(PG8_SA(0, 1), cA + hstep, voffA);
        if (wr == 1) PG8_BAR;
        PG8_WAIT_V(4); PG8_BAR;
        PG8_STAGE(PG8_SB(1, 0), cB + kstep, voffB); PG8_STAGE(PG8_SA(1, 0), cA + kstep, voffA); PG8_STAGE(PG8_SB(1, 1), cB + hstep + kstep, voffB);
        PG8_WAIT_V(6); PG8_BAR;
    }
    for (;;) {
        const bool has_next = S.next(ui + 1, nxt);
        const char* nA = has_next ? (const char*)g.A + (size_t)nxt.pm * tstep + (size_t)nxt.k0 * 2 : cA; const char* nB = has_next ? (const char*)g.Bt + (size_t)nxt.pn * tstep + (size_t)nxt.k0 * 2 : cB;
        const int nt = cur.nk;
        for (int t = 0; t < nt; t += 2) {
            const bool last = (t == nt - 2);
            const char* a1 = cA + (size_t)(t + 1) * kstep;
            const char* a2 = last ? nA : cA + (size_t)(t + 2) * kstep; const char* b2 = last ? nB : cB + (size_t)(t + 2) * kstep;
            const char* a3 = a2 + kstep; const char* b3 = b2 + kstep;
            if (last && has_next) S.a_ready(nxt);
            if constexpr (SP2) {
            PG8_LDB(B0, 0, 0); PG8_LDB(B1, 0, 1); PG8_SCHED; PG8_LDA(At, 0, 0); PG8_STAGE(PG8_SA(1, 1), a1 + hstep, voffA);
            PG8_WAIT_V(8); PG8_WAIT_L(0); PG8_BAR; PG8_MMA(0, 0, At, B0); PG8_MMA(0, 1, At, B1); PG8_BAR; PG8_SCHED;
            PG8_LDA(At, 0, 1); PG8_STAGE(PG8_SB(0, 0), b2, voffB); PG8_STAGE(PG8_SB(0, 1), b2 + hstep, voffB); PG8_STAGE(PG8_SA(0, 0), a2, voffA);
            PG8_WAIT_V(8); PG8_WAIT_L(0); PG8_BAR; PG8_MMA(1, 0, At, B0); PG8_MMA(1, 1, At, B1); PG8_BAR; PG8_SCHED;
            PG8_LDB(B0, 1, 0); PG8_LDB(B1, 1, 1); PG8_SCHED; PG8_LDA(At, 1, 0); PG8_STAGE(PG8_SA(0, 1), a2 + hstep, voffA);
            PG8_WAIT_V(8); PG8_WAIT_L(0); PG8_BAR; PG8_MMA(0, 0, At, B0); PG8_MMA(0, 1, At, B1); PG8_BAR; PG8_SCHED;
            PG8_LDA(At, 1, 1); PG8_STAGE(PG8_SB(1, 0), b3, voffB); PG8_STAGE(PG8_SB(1, 1), b3 + hstep, voffB); PG8_STAGE(PG8_SA(1, 0), a3, voffA);
            PG8_WAIT_V(8); PG8_WAIT_L(0); PG8_BAR; PG8_MMA(1, 0, At, B0); PG8_MMA(1, 1, At, B1); PG8_BAR; PG8_SCHED;
            } else {
            PG8_LDB(B0, 0, 0); PG8_SCHED; PG8_LDA(At, 0, 0); PG8_STAGE(PG8_SA(1, 1), a1 + hstep, voffA);
            PG8_WAIT_L(8); PG8_BAR; PG8_WAIT_L(0); PG8_MMA(0, 0, At, B0); PG8_BAR; PG8_SCHED;
            PG8_LDB(B1, 0, 1); PG8_STAGE(PG8_SB(0, 0), b2, voffB);
            PG8_BAR; PG8_WAIT_L(0); PG8_MMA(0, 1, At, B1); PG8_BAR;
            PG8_LDA(At, 0, 1); PG8_STAGE(PG8_SA(0, 0), a2, voffA);
            PG8_BAR; PG8_WAIT_L(0); PG8_MMA(1, 0, At, B0); PG8_BAR; PG8_SCHED;
            PG8_STAGE(PG8_SB(0, 1), b2 + hstep, voffB);
            PG8_WAIT_V(6); PG8_BAR; PG8_MMA(1, 1, At, B1); PG8_BAR;
            PG8_LDB(B0, 1, 0); PG8_SCHED; PG8_LDA(At, 1, 0); PG8_STAGE(PG8_SA(0, 1), a2 + hstep, voffA);
            PG8_WAIT_L(8); PG8_BAR; PG8_WAIT_L(0); PG8_MMA(0, 0, At, B0); PG8_BAR; PG8_SCHED;
            PG8_LDB(B1, 1, 1); PG8_STAGE(PG8_SB(1, 0), b3, voffB);
            PG8_BAR; PG8_WAIT_L(0); PG8_MMA(0, 1, At, B1); PG8_BAR;
            PG8_LDA(At, 1, 1); PG8_STAGE(PG8_SA(1, 0), a3, voffA);
            PG8_BAR; PG8_WAIT_L(0); PG8_MMA(1, 0, At, B0); PG8_BAR; PG8_SCHED;
            PG8_STAGE(PG8_SB(1, 1), b3 + hstep, voffB);
            PG8_WAIT_V(6); PG8_BAR; PG8_MMA(1, 1, At, B1); PG8_BAR;
            }
        }
        if constexpr (ALIGN_EPI) { if (wr == 0) PG8_BAR; }
        if constexpr (!Epi::AFTER_DRAIN) { E(acc, cur, wr, wc, fr, fq); S.done(cur); } else { if (has_next) { E(acc, cur, wr, wc, fr, fq); S.done(cur); } }
        if (!has_next) break;
#pragma unroll
        for (int a = 0; a < 2; ++a)
#pragma unroll
            for (int b = 0; b < 2; ++b)
#pragma unroll
                for (int m = 0; m < 4; ++m)
#pragma unroll
                    for (int n = 0; n < 2; ++n) acc[a][b][m][n] = (f32x4){0.f, 0.f, 0.f, 0.f};
        cur = nxt; cA = nA; cB = nB; ++ui;
        if constexpr (ALIGN_EPI) { if (wr == 1) PG8_BAR; }
    }
    PG8_WAIT_V(0);
    if constexpr (!ALIGN_EPI) { if (wr == 0) PG8_BAR; }
    PG8_BAR;
    if constexpr (Epi::AFTER_DRAIN) { E.fused(acc, cur, wr, wc, fr, fq, lds, wid, lane); S.done(cur); }
#undef PG8_SA
#undef PG8_SB
#undef PG8_STAGE
#undef PG8_LDA
#undef PG8_LDB
#undef PG8_MMA
#undef PG8_WAIT_V
#undef PG8_WAIT_L
#undef PG8_BAR
#undef PG8_SCHED
}
}

DEVI pg8::u32x4 pack8(const pg8::f32x4& a, const pg8::f32x4& b) { pg8::u32x4 w; w.x = pg8::cvt_pk_bf16(a[0], a[1]); w.y = pg8::cvt_pk_bf16(a[2], a[3]); w.z = pg8::cvt_pk_bf16(b[0], b[1]); w.w = pg8::cvt_pk_bf16(b[2], b[3]); return w; }
DEVI pg8::f32x4 silu4(const pg8::f32x4& a) { pg8::f32x4 r; r[0] = siluf_(a[0]); r[1] = siluf_(a[1]); r[2] = siluf_(a[2]); r[3] = siluf_(a[3]); return r; }
struct FEpi1 {
    static constexpr bool PERM = true, AFTER_DRAIN = false;
    bf16_t *QK, *V, *SGA, *Z, *CBG; float* ALR; bf16_t* ZA;
    DEVI void operator()(const pg8::f32x4 (&acc)[2][2][4][2], const pg8::Unit& u, int wr, int wc, int fr, int fq) const {
        const int t = u.pn, row0 = u.pm * 256 + wr * 64 + fr, cw = wc * 32 + 8 * fq;
#pragma unroll
        for (int ai = 0; ai < 2; ++ai)
#pragma unroll
            for (int m = 0; m < 4; ++m) {
                const size_t row = (size_t)(row0 + ai * 128 + m * 16);
                if (t < 12) {
                    bf16_t* base = t < 4 ? QK + row * 1024 + t * 256 : (t < 8 ? V + row * 1024 + (t - 4) * 256 : SGA + row * 1024 + (t - 8) * 256);
#pragma unroll
                    for (int bj = 0; bj < 2; ++bj) { pg8::f32x4 v0 = acc[ai][bj][m][0], v1 = acc[ai][bj][m][1]; if (t >= 8) { v0 = silu4(v0); v1 = silu4(v1); }
                        *(pg8::u32x4*)(base + bj * 128 + cw) = pack8(v0, v1); }
                } else if (t == 12) {
                    if (wc == 0) { *(pg8::f32x4*)(ALR + row * 32 + 8 * fq) = acc[ai][0][m][0]; *(pg8::f32x4*)(ALR + row * 32 + 8 * fq + 4) = acc[ai][0][m][1]; }
                } else if (t < 21) {
                    bf16_t* zp = t < 15 ? ZA + row * 256 + (t - 13) * 128 + cw : Z + row * 1024 + (t - 13) * 128 + cw;
                    *(pg8::u32x4*)zp = pack8(acc[ai][0][m][0] * acc[ai][1][m][0], acc[ai][0][m][1] * acc[ai][1][m][1]);
                } else {
                    *(pg8::u32x4*)(CBG + row * 1024 + (t - 21) * 128 + cw) = pack8(acc[ai][0][m][0] * silu4(acc[ai][1][m][0]), acc[ai][0][m][1] * silu4(acc[ai][1][m][1]));
                }
            }
    }
};
template <bool HAS_TAIL> struct FEpiRes {
    static constexpr bool PERM = false, AFTER_DRAIN = false;
    const float* xl; const float* xc; float* outl; float* outc; const float* MODl;
    DEVI void operator()(const pg8::f32x4 (&acc)[2][2][4][2], const pg8::Unit& u, int wr, int wc, int fr, int fq) const {
        const int row0 = u.pm * 256 + wr * 64 + fr, col0 = u.pn * 256 + wc * 32 + 4 * fq;
        const bool lat = u.pm < NLAT / 256;
        const float* gate = MODl + (size_t)(lat ? (u.pm >> 4) : 4) * 3072 + 2048 + col0;
        pg8::f32x4 gv[2][2];
#pragma unroll
        for (int bj = 0; bj < 2; ++bj)
#pragma unroll
            for (int n = 0; n < 2; ++n) gv[bj][n] = *(const pg8::f32x4*)(gate + bj * 128 + n * 16);
        if (HAS_TAIL && !lat) {
            float* o = outc + (size_t)(u.k0 >> 8) * NCTX * 1024 - (size_t)NLAT * 1024;
#pragma unroll
            for (int ai = 0; ai < 2; ++ai)
#pragma unroll
                for (int m = 0; m < 4; ++m) { const size_t off = (size_t)(row0 + ai * 128 + m * 16) * 1024 + col0;
#pragma unroll
                    for (int bj = 0; bj < 2; ++bj)
#pragma unroll
                        for (int n = 0; n < 2; ++n) *(pg8::f32x4*)(o + off + bj * 128 + n * 16) = acc[ai][bj][m][n]; }
            return;
        }
        const float* xin = xl; float* o = outl;
#pragma unroll
        for (int ai = 0; ai < 2; ++ai)
#pragma unroll
            for (int m = 0; m < 4; ++m) { const size_t off = (size_t)(row0 + ai * 128 + m * 16) * 1024 + col0;
#pragma unroll
                for (int bj = 0; bj < 2; ++bj)
#pragma unroll
                    for (int n = 0; n < 2; ++n) { const pg8::f32x4 xv = *(const pg8::f32x4*)(xin + off + bj * 128 + n * 16); *(pg8::f32x4*)(o + off + bj * 128 + n * 16) = xv + gv[bj][n] * acc[ai][bj][m][n]; } }
    }
};
struct FEpi3 {
    static constexpr bool PERM = true, AFTER_DRAIN = false;
    bf16_t* XR; bf16_t* SG; float* XRC;
    DEVI void operator()(const pg8::f32x4 (&acc)[2][2][4][2], const pg8::Unit& u, int wr, int wc, int fr, int fq) const {
        const int t = u.pn, row0 = u.pm * 256 + wr * 64 + fr, cw = wc * 32 + 8 * fq;
        if (u.pm >= NLAT / 256) {
            float* sl = XRC + (size_t)(u.k0 >> 9) * NCTX * 2048;
#pragma unroll
            for (int ai = 0; ai < 2; ++ai)
#pragma unroll
                for (int m = 0; m < 4; ++m) { float* rp = sl + (size_t)(row0 - NLAT + ai * 128 + m * 16) * 2048 + t * 256 + cw;
#pragma unroll
                    for (int bj = 0; bj < 2; ++bj) { *(pg8::f32x4*)(rp + bj * 128) = acc[ai][bj][m][0]; *(pg8::f32x4*)(rp + bj * 128 + 4) = acc[ai][bj][m][1]; } }
            return;
        }
        bf16_t* base = t < 8 ? XR + (size_t)xr_pad_of_tile(u.pm) * 2048 + t * 256 : SG + (t - 8) * 256;
#pragma unroll
        for (int ai = 0; ai < 2; ++ai)
#pragma unroll
            for (int m = 0; m < 4; ++m) { bf16_t* rp = base + (size_t)(row0 + ai * 128 + m * 16) * 2048 + cw;
#pragma unroll
                for (int bj = 0; bj < 2; ++bj) { pg8::f32x4 v0 = acc[ai][bj][m][0], v1 = acc[ai][bj][m][1]; if (t >= 8) { v0 = silu4(v0); v1 = silu4(v1); }
                    *(pg8::u32x4*)(rp + bj * 128) = pack8(v0, v1); } }
    }
};

struct FEpiResRms {
    static constexpr bool PERM = false, AFTER_DRAIN = true;
    const float* xin; float* out; const float* MODl; const float* gfin; float* slots; unsigned* cnt;
    DEVI void fused(pg8::f32x4 (&acc)[2][2][4][2], const pg8::Unit& u, int wr, int wc, int fr, int fq, PG8_LAS unsigned char* lds, int wid, int lane) const {
        const int row0 = u.pm * 256 + wr * 64 + fr, col0 = u.pn * 256 + wc * 32 + 4 * fq;
        const float* gate = MODl + (size_t)(u.pm >> 4) * 3072 + 2048 + col0;
        PG8_LAS float* P = (PG8_LAS float*)lds;
        PG8_LAS float* S = (PG8_LAS float*)(lds + 8192);
        { pg8::f32x4 gv[2][2];
#pragma unroll
          for (int bj = 0; bj < 2; ++bj)
#pragma unroll
              for (int n = 0; n < 2; ++n) gv[bj][n] = *(const pg8::f32x4*)(gate + bj * 128 + n * 16);
#pragma unroll
          for (int ai = 0; ai < 2; ++ai)
#pragma unroll
              for (int m = 0; m < 4; ++m) { const float* xp = xin + (size_t)(row0 + ai * 128 + m * 16) * 1024 + col0;
#pragma unroll
                  for (int bj = 0; bj < 2; ++bj)
#pragma unroll
                      for (int n = 0; n < 2; ++n) { const pg8::f32x4 xv = *(const pg8::f32x4*)(xp + bj * 128 + n * 16); acc[ai][bj][m][n] = xv + gv[bj][n] * acc[ai][bj][m][n]; }
                  asm volatile("" : "+v"(acc[ai][0][m][0]), "+v"(acc[ai][0][m][1]), "+v"(acc[ai][1][m][0]), "+v"(acc[ai][1][m][1]));
                  if (m & 1) asm volatile("" ::: "memory"); } }
#pragma unroll
        for (int ai = 0; ai < 2; ++ai)
#pragma unroll
            for (int m = 0; m < 4; ++m) { float q = 0.f;
#pragma unroll
                for (int bj = 0; bj < 2; ++bj)
#pragma unroll
                    for (int n = 0; n < 2; ++n) { const pg8::f32x4 x = acc[ai][bj][m][n]; q += (x[0] * x[0] + x[1] * x[1]) + (x[2] * x[2] + x[3] * x[3]); }
                q += __shfl_xor(q, 16); q += __shfl_xor(q, 32);
                if (fq == 0) P[(ai * 128 + wr * 64 + m * 16 + fr) * 4 + wc] = q; }
        asm volatile("s_waitcnt lgkmcnt(0)" ::: "memory"); __builtin_amdgcn_s_barrier(); asm volatile("" ::: "memory");
        const int row = wid * 32 + (lane & 31);
        if (lane < 32) { const float t = (P[row * 4 + 0] + P[row * 4 + 1]) + (P[row * 4 + 2] + P[row * 4 + 3]);
            __hip_atomic_store(slots + ((size_t)(u.pm * 256 + row) * 4 + u.pn), t, __ATOMIC_RELAXED, __HIP_MEMORY_SCOPE_AGENT); }
        asm volatile("s_waitcnt vmcnt(0)" ::: "memory");
        if (lane == 0) __hip_atomic_fetch_add(cnt + 64 * u.pm, 1u, __ATOMIC_RELAXED, __HIP_MEMORY_SCOPE_AGENT);
        if (wid == 0) { unsigned sp = 0;
            while ((unsigned)__builtin_amdgcn_readfirstlane(__hip_atomic_load(cnt + 64 * u.pm, __ATOMIC_RELAXED, __HIP_MEMORY_SCOPE_AGENT)) < 32u) { __builtin_amdgcn_s_sleep(2); if (++sp > (1u << 22)) break; }
            __builtin_amdgcn_fence(__ATOMIC_ACQUIRE, "agent"); }
        asm volatile("s_waitcnt vmcnt(0) lgkmcnt(0)" ::: "memory"); __builtin_amdgcn_s_barrier(); asm volatile("" ::: "memory");
        if (lane < 32) { const float* sl = slots + (size_t)(u.pm * 256 + row) * 4; float t = 0.f;
#pragma unroll
            for (int k = 0; k < 4; ++k) t += __hip_atomic_load(sl + k, __ATOMIC_RELAXED, __HIP_MEMORY_SCOPE_AGENT);
            S[row] = rsqrtf(t * (1.f / 1024.f) + EPS); }
        asm volatile("s_waitcnt lgkmcnt(0)" ::: "memory"); __builtin_amdgcn_s_barrier(); asm volatile("" ::: "memory");
        pg8::f32x4 gf[2][2];
#pragma unroll
        for (int bj = 0; bj < 2; ++bj)
#pragma unroll
            for (int n = 0; n < 2; ++n) gf[bj][n] = *(const pg8::f32x4*)(gfin + col0 + bj * 128 + n * 16);
#pragma unroll
        for (int ai = 0; ai < 2; ++ai)
#pragma unroll
            for (int m = 0; m < 4; ++m) { const int r = ai * 128 + wr * 64 + m * 16 + fr; const float rinv = S[r]; const size_t off = (size_t)(u.pm * 256 + r) * 1024 + col0;
#pragma unroll
                for (int bj = 0; bj < 2; ++bj)
#pragma unroll
                    for (int n = 0; n < 2; ++n) *(pg8::f32x4*)(out + off + bj * 128 + n * 16) = acc[ai][bj][m][n] * rinv * gf[bj][n]; }
    }
    DEVI void operator()(const pg8::f32x4 (&)[2][2][4][2], const pg8::Unit&, int, int, int, int) const {}
};

struct FEpiResMod {
    static constexpr bool PERM = false, AFTER_DRAIN = true;
    const float* xin; float* x1; bf16_t* H1; const float* MOD0; const float* MOD1; const float* g1; float* slab; float* slots; unsigned* cnt;
    DEVI void operator()(const pg8::f32x4 (&acc)[2][2][4][2], const pg8::Unit& u, int wr, int wc, int fr, int fq) const {
        if (u.pm < NLAT / 256) return;
        const int row0 = u.pm * 256 + wr * 64 + fr, col0 = u.pn * 256 + wc * 32 + 4 * fq;
        float* o = slab + (size_t)(u.k0 >> 8) * NCTX * 1024 - (size_t)NLAT * 1024;
#pragma unroll
        for (int ai = 0; ai < 2; ++ai)
#pragma unroll
            for (int m = 0; m < 4; ++m) { const size_t off = (size_t)(row0 + ai * 128 + m * 16) * 1024 + col0;
#pragma unroll
                for (int bj = 0; bj < 2; ++bj)
#pragma unroll
                    for (int n = 0; n < 2; ++n) *(pg8::f32x4*)(o + off + bj * 128 + n * 16) = acc[ai][bj][m][n]; }
    }
    DEVI void fused(pg8::f32x4 (&acc)[2][2][4][2], const pg8::Unit& u, int wr, int wc, int fr, int fq, PG8_LAS unsigned char* lds, int wid, int lane) const {
        typedef unsigned u32x2v __attribute__((ext_vector_type(2)));
        const int row0 = u.pm * 256 + wr * 64 + fr, col0 = u.pn * 256 + wc * 32 + 4 * fq, b = u.pm >> 4;
        PG8_LAS float* P = (PG8_LAS float*)lds; PG8_LAS float* S = (PG8_LAS float*)(lds + 8192);
        { const float* gate = MOD0 + (size_t)b * 3072 + 2048 + col0; pg8::f32x4 gv[2][2];
#pragma unroll
          for (int bj = 0; bj < 2; ++bj)
#pragma unroll
              for (int n = 0; n < 2; ++n) gv[bj][n] = *(const pg8::f32x4*)(gate + bj * 128 + n * 16);
#pragma unroll
          for (int ai = 0; ai < 2; ++ai)
#pragma unroll
              for (int m = 0; m < 4; ++m) { const size_t off = (size_t)(row0 + ai * 128 + m * 16) * 1024 + col0;
#pragma unroll
                  for (int bj = 0; bj < 2; ++bj)
#pragma unroll
                      for (int n = 0; n < 2; ++n) { const pg8::f32x4 xv = *(const pg8::f32x4*)(xin + off + bj * 128 + n * 16); acc[ai][bj][m][n] = xv + gv[bj][n] * acc[ai][bj][m][n]; *(pg8::f32x4*)(x1 + off + bj * 128 + n * 16) = acc[ai][bj][m][n]; }
                  asm volatile("" : "+v"(acc[ai][0][m][0]), "+v"(acc[ai][0][m][1]), "+v"(acc[ai][1][m][0]), "+v"(acc[ai][1][m][1]));
                  if (m & 1) asm volatile("" ::: "memory"); } }
#pragma unroll
        for (int ai = 0; ai < 2; ++ai)
#pragma unroll
            for (int m = 0; m < 4; ++m) { float q = 0.f;
#pragma unroll
                for (int bj = 0; bj < 2; ++bj)
#pragma unroll
                    for (int n = 0; n < 2; ++n) { const pg8::f32x4 x = acc[ai][bj][m][n]; q += (x[0] * x[0] + x[1] * x[1]) + (x[2] * x[2] + x[3] * x[3]); }
                q += __shfl_xor(q, 16); q += __shfl_xor(q, 32);
                if (fq == 0) P[(ai * 128 + wr * 64 + m * 16 + fr) * 4 + wc] = q; }
        asm volatile("s_waitcnt lgkmcnt(0)" ::: "memory"); __builtin_amdgcn_s_barrier(); asm volatile("" ::: "memory");
        const int row = wid * 32 + (lane & 31);
        if (lane < 32) { const float t = (P[row * 4 + 0] + P[row * 4 + 1]) + (P[row * 4 + 2] + P[row * 4 + 3]);
            __hip_atomic_store(slots + ((size_t)(u.pm * 256 + row) * 4 + u.pn), t, __ATOMIC_RELAXED, __HIP_MEMORY_SCOPE_AGENT); }
        asm volatile("s_waitcnt vmcnt(0)" ::: "memory");
        if (lane == 0) __hip_atomic_fetch_add(cnt + 64 * u.pm, 1u, __ATOMIC_RELAXED, __HIP_MEMORY_SCOPE_AGENT);
        if (wid == 0) { unsigned sp = 0;
            while ((unsigned)__builtin_amdgcn_readfirstlane(__hip_atomic_load(cnt + 64 * u.pm, __ATOMIC_RELAXED, __HIP_MEMORY_SCOPE_AGENT)) < 32u) { __builtin_amdgcn_s_sleep(2); if (++sp > (1u << 22)) break; }
            __builtin_amdgcn_fence(__ATOMIC_ACQUIRE, "agent"); }
        asm volatile("s_waitcnt vmcnt(0) lgkmcnt(0)" ::: "memory"); __builtin_amdgcn_s_barrier(); asm volatile("" ::: "memory");
        if (lane < 32) { const float* sl = slots + (size_t)(u.pm * 256 + row) * 4; float t = 0.f;
#pragma unroll
            for (int k = 0; k < 4; ++k) t += __hip_atomic_load(sl + k, __ATOMIC_RELAXED, __HIP_MEMORY_SCOPE_AGENT);
            S[row] = rsqrtf(t * (1.f / 1024.f) + EPS); }
        asm volatile("s_waitcnt lgkmcnt(0)" ::: "memory"); __builtin_amdgcn_s_barrier(); asm volatile("" ::: "memory");
        const float* md = MOD1 + (size_t)b * 3072 + col0;
#pragma unroll
        for (int bj = 0; bj < 2; ++bj)
#pragma unroll
            for (int n = 0; n < 2; ++n) { const int co = bj * 128 + n * 16; const pg8::f32x4 gg = *(const pg8::f32x4*)(g1 + col0 + co), sh = *(const pg8::f32x4*)(md + co), sc = *(const pg8::f32x4*)(md + 1024 + co);
                const pg8::f32x4 mul = gg * (sc + 1.0f);
#pragma unroll
                for (int ai = 0; ai < 2; ++ai)
#pragma unroll
                    for (int m = 0; m < 4; ++m) { const int r = ai * 128 + wr * 64 + m * 16 + fr; const pg8::f32x4 hv = acc[ai][bj][m][n] * S[r] * mul + sh;
                        u32x2v w; w.x = pg8::cvt_pk_bf16(hv[0], hv[1]); w.y = pg8::cvt_pk_bf16(hv[2], hv[3]); *(u32x2v*)(H1 + (size_t)(u.pm * 256 + r) * 1024 + col0 + co) = w; } }
    }
};
#ifndef FAST_GEMM
#define FAST_GEMM 1
#endif


#define LASP __attribute__((address_space(3)))
__device__ void st_glawalk(const Params& p, int vb, int nvb, unsigned char* lds_, const bf16_t* QIN, const bf16_t* KET, const bf16_t* SC, const float* DEC, const bf16_t* VT, bf16_t* OF, bf16_t* OB) {
    typedef pg8::bf16x8 bx8; typedef pg8::f32x4 f4; typedef unsigned u32x2 __attribute__((ext_vector_type(2))); typedef pg8::u32x4 u4;
    LASP unsigned char* lds = (LASP unsigned char*)lds_;
    constexpr int QOFF = 0, KOFF = 17408, SOFF = KOFF + 18432, VOFF = SOFF + 9216, DOFF = VOFF + 4608, BUFSZ = 50176;
    const int tid = threadIdx.x, wid = __builtin_amdgcn_readfirstlane(tid >> 6), lane = tid & 63, c = lane & 15, g = lane >> 4;
    for (int it0 = vb; it0 < 256; it0 += nvb) {
        const int item = (nvb == 256) ? ((it0 & 7) * 32 + (it0 >> 3)) : it0;
        const int vs = item & 7, combo = item >> 3, d = combo & 1, h = (combo >> 1) & 3, bb = combo >> 3;
        LDS_BARRIER();
        if (wid >= 2) {
            const int lt = tid - 128;
            unsigned long long cst[8]; unsigned mult[8]; int doff[8];
#pragma unroll
            for (int j = 0; j < 8; ++j) { const int pp = lt + 384 * j;
                if (pp < 1024) { cst[j] = (unsigned long long)QIN + (pp >> 4) * 256 + (pp & 15) * 16; mult[j] = 16384u; doff[j] = QOFF + (pp >> 4) * 272 + (pp & 15) * 16; }
                else if (pp < 2048) { const int q = pp - 1024; cst[j] = (unsigned long long)KET + (q >> 3) * 128 + (q & 7) * 16; mult[j] = 16384u; doff[j] = KOFF + (q >> 3) * 144 + (q & 7) * 16; }
                else if (pp < 2560) { const int q = pp - 2048; cst[j] = (unsigned long long)SC + (q >> 3) * 128 + (q & 7) * 16; mult[j] = 8192u; doff[j] = SOFF + (q >> 3) * 144 + (q & 7) * 16; }
                else if (pp < 2816) { const int q = pp - 2560; cst[j] = (unsigned long long)VT + (vs * 32 + (q >> 3)) * 128 + (q & 7) * 16 - (unsigned long long)d * 16384; mult[j] = 16384u; doff[j] = VOFF + (q >> 3) * 144 + (q & 7) * 16; }
                else if (pp < 2848) { const int q = pp - 2816; cst[j] = (unsigned long long)DEC + q * 16; mult[j] = 512u; doff[j] = DOFF + q * 16; }
                else { cst[j] = (unsigned long long)DEC; mult[j] = 0u; doff[j] = -1; } }
            u4 r0[8], r1[8];
#define GW_LOAD(R, step) do { const int cc_ = d == 0 ? ((step) < 4 ? 64 + (step) : (step) - 4) : 67 - (step); const unsigned u_ = (unsigned)(((bb * NCH + cc_) * 4 + h) * 2 + d); \
                _Pragma("unroll") for (int j_ = 0; j_ < 8; ++j_) R[j_] = *(const u4*)(cst[j_] + (unsigned long long)u_ * mult[j_]); } while (0)
#define GW_WRITE(R, bufi) do { LASP unsigned char* b_ = lds + (bufi) * BUFSZ; _Pragma("unroll") for (int j_ = 0; j_ < 8; ++j_) if (doff[j_] >= 0) *(LASP u4*)(b_ + doff[j_]) = R[j_]; } while (0)
            GW_LOAD(r0, 0); GW_WRITE(r0, 0); GW_LOAD(r0, 1); GW_LOAD(r1, 2);
            LDS_BARRIER();
            for (int step = 0; step < NCH; step += 2) {
                GW_WRITE(r0, 1); if (step + 3 < NCH) GW_LOAD(r0, step + 3);
                LDS_BARRIER();
                if (step + 2 < NCH) { GW_WRITE(r1, 0); if (step + 4 < NCH) GW_LOAD(r1, step + 4); }
                LDS_BARRIER();
            }
#undef GW_LOAD
#undef GW_WRITE
        } else {
            f4 S[8];
#pragma unroll
            for (int m = 0; m < 8; ++m) S[m] = (f4){0.f, 0.f, 0.f, 0.f};
            bf16_t* O = d == 0 ? OF : OB;
            LDS_BARRIER();
            for (int step = 0; step < NCH; ++step) {
                const LASP unsigned char* B = lds + (step & 1) * BUFSZ;
#define SB0() __builtin_amdgcn_sched_barrier(0)
#define RDQ(dst_lo, dst_hi, ks) do { _Pragma("unroll") for (int mt = 0; mt < 4; ++mt) { const LASP unsigned char* qa = B + QOFF + (16 * mt + c) * 272 + (32 * (ks) + 4 * g) * 2; dst_lo[mt] = *(const LASP u32x2*)qa; dst_hi[mt] = *(const LASP u32x2*)(qa + 32); } } while (0)
#define MMQ(lo, hi, ks) do { _Pragma("unroll") for (int mt = 0; mt < 4; ++mt) { u4 w; w.x = lo[mt].x; w.y = lo[mt].y; w.z = hi[mt].x; w.w = hi[mt].y; o[mt] = __builtin_amdgcn_mfma_f32_16x16x32_bf16(sB[ks], __builtin_bit_cast(bx8, w), o[mt], 0, 0, 0); } } while (0)
#define RDK(kf, dv, m0) do { _Pragma("unroll") for (int mm = 0; mm < 4; ++mm) { const LASP unsigned char* ka = B + KOFF + (16 * ((m0) + mm) + c) * 144 + g * 16; kf[mm][0] = *(const LASP bx8*)ka; kf[mm][1] = *(const LASP bx8*)(ka + 64); dv[mm] = *(const LASP f4*)(B + DOFF + (16 * ((m0) + mm) + 4 * g) * 4); } } while (0)
#define MMK(kf, dv, m0) do { _Pragma("unroll") for (int mm = 0; mm < 4; ++mm) { S[(m0) + mm] = S[(m0) + mm] * dv[mm]; S[(m0) + mm] = __builtin_amdgcn_mfma_f32_16x16x32_bf16(kf[mm][0], bv0, S[(m0) + mm], 0, 0, 0); S[(m0) + mm] = __builtin_amdgcn_mfma_f32_16x16x32_bf16(kf[mm][1], bv1, S[(m0) + mm], 0, 0, 0); } } while (0)
                const bx8 bv0 = *(const LASP bx8*)(B + VOFF + (16 * wid + c) * 144 + g * 16), bv1 = *(const LASP bx8*)(B + VOFF + (16 * wid + c) * 144 + 64 + g * 16);
                u32x2 qa_lo[4], qa_hi[4], qb_lo[4], qb_hi[4];
                RDQ(qa_lo, qa_hi, 0); RDQ(qb_lo, qb_hi, 1);
                bx8 sB[4];
#pragma unroll
                for (int ks = 0; ks < 4; ++ks) { u4 w; w.x = pg8::cvt_pk_bf16(S[2 * ks][0], S[2 * ks][1]); w.y = pg8::cvt_pk_bf16(S[2 * ks][2], S[2 * ks][3]);
                    w.z = pg8::cvt_pk_bf16(S[2 * ks + 1][0], S[2 * ks + 1][1]); w.w = pg8::cvt_pk_bf16(S[2 * ks + 1][2], S[2 * ks + 1][3]); sB[ks] = __builtin_bit_cast(bx8, w); }
                f4 o[4];
#pragma unroll
                for (int mt = 0; mt < 4; ++mt) o[mt] = (f4){0.f, 0.f, 0.f, 0.f};
                SB0();
                MMQ(qa_lo, qa_hi, 0); SB0();
                RDQ(qa_lo, qa_hi, 2); SB0();
                MMQ(qb_lo, qb_hi, 1); SB0();
                RDQ(qb_lo, qb_hi, 3); SB0();
                MMQ(qa_lo, qa_hi, 2); SB0();
                bx8 sf[4][2];
#pragma unroll
                for (int mt = 0; mt < 4; ++mt) { const LASP unsigned char* sa = B + SOFF + (16 * mt + c) * 144 + g * 16; sf[mt][0] = *(const LASP bx8*)sa; sf[mt][1] = *(const LASP bx8*)(sa + 64); }
                SB0();
                MMQ(qb_lo, qb_hi, 3); SB0();
                bx8 kfa[4][2], kfb[4][2]; f4 dva[4], dvb[4];
                RDK(kfa, dva, 0); SB0();
#pragma unroll
                for (int mt = 0; mt < 4; ++mt) { o[mt] = __builtin_amdgcn_mfma_f32_16x16x32_bf16(bv0, sf[mt][0], o[mt], 0, 0, 0); o[mt] = __builtin_amdgcn_mfma_f32_16x16x32_bf16(bv1, sf[mt][1], o[mt], 0, 0, 0); }
                SB0();
                RDK(kfb, dvb, 4); SB0();
                MMK(kfa, dva, 0); SB0();
                MMK(kfb, dvb, 4); SB0();
#undef SB0
#undef RDQ
#undef MMQ
#undef RDK
#undef MMK
                const int cc = d == 0 ? (step < 4 ? 64 + step : step - 4) : 67 - step; const int row0 = row_of(bb, cc, 0);
#pragma unroll
                for (int mt = 0; mt < 4; ++mt) { u32x2 w; w.x = pg8::cvt_pk_bf16(o[mt][0], o[mt][1]); w.y = pg8::cvt_pk_bf16(o[mt][2], o[mt][3]);
                    *(u32x2*)(O + (size_t)(row0 + 16 * mt + c) * 1024 + h * 256 + vs * 32 + 16 * wid + 4 * g) = w; }
                LDS_BARRIER();
            }
        }
    }
}
#ifndef FAST_WALK
#define FAST_WALK 1
#endif

template <int MODE, int DIR>
__device__ __forceinline__ void st_rglru_impl(const Params& p, int vb, int nvb, unsigned char* lds_, const bf16_t* XR, const bf16_t* SG, const bf16_t* BD, float* SUMA, float* SUMH, bf16_t* Y) {
    typedef pg8::bf16x8 bx8; typedef pg8::f32x4 f4; typedef float f32x2v __attribute__((ext_vector_type(2)));
    LASP unsigned char* lds = (LASP unsigned char*)lds_;
    constexpr int AOFF = 0, FOFF = 17408, BUF = 51200, CWOFF = 2 * BUF;
    constexpr int ND = MODE == 0 ? 1 : 2, NCOMBO = MODE == 0 ? 32 : 16, NTILE = MODE == 0 ? NB * NCH : NB * 64;
    const int tid = threadIdx.x, wid = __builtin_amdgcn_readfirstlane(tid >> 6), lane = tid & 63, c = lane & 15, g = lane >> 4, cp = tid & 63, tg = tid >> 6;
    int P, part, cstep, combo0;
    if (nvb >= NCOMBO) { P = nvb / NCOMBO; part = vb / NCOMBO; cstep = NCOMBO; combo0 = vb % NCOMBO; if (part >= P) return; } else { P = 1; part = 0; cstep = nvb; combo0 = vb; }
    for (int combo = combo0; combo < NCOMBO; combo += cstep) {
        if (MODE == 0 && (combo & 1) != DIR) continue;
        const int nb = MODE == 0 ? (combo >> 1) : combo; constexpr int d0 = MODE == 0 ? DIR : 0;
        const int ch = nb * 128 + 16 * wid + c;
        bx8 wa[ND][4], wx[ND][4]; float ba[ND], bxx[ND], k8[ND];
        LDS_BARRIER();
#pragma unroll
        for (int dd = 0; dd < ND; ++dd) { constexpr int dzero = d0; const int d = dzero + dd;
            const bf16_t* wA = BD + ((size_t)(d * 16 + nb) * 128 + 16 * wid + c) * 128 + 8 * g; const bf16_t* wX = wA + (size_t)2 * 16 * 128 * 128;
#pragma unroll
            for (int ks = 0; ks < 4; ++ks) { wa[dd][ks] = *(const bx8*)(wA + 32 * ks); wx[dd][ks] = *(const bx8*)(wX + 32 * ks); }
            ba[dd] = p.o_b_a[d * 2048 + ch]; bxx[dd] = p.o_b_x[d * 2048 + ch]; k8[dd] = 8.f * 1.4426950408889634f * softplusf_(-p.o_lam[d * 2048 + ch]);
            if (tg < 5) { const f32x2v w2 = tg < 4 ? *(const f32x2v*)(p.o_conv_w + ((size_t)d * 4 + tg) * 2048 + nb * 128 + 2 * cp) : *(const f32x2v*)(p.o_conv_b + (size_t)d * 2048 + nb * 128 + 2 * cp);
                *(LASP f32x2v*)(lds + CWOFF + ((dd * 5 + tg) * 128 + 2 * cp) * 4) = w2; } }
        LDS_BARRIER();
        unsigned xr[14]; float cnext[2] = {0.f, 0.f};
#pragma unroll
        for (int jr = 0; jr < 14; ++jr) xr[jr] = 0u;
#define RG_PREF(tile) do { const int bb_ = MODE == 0 ? (tile) / NCH : (tile) >> 6, cc_ = MODE == 0 ? (tile) % NCH : (tile) & 63; const int row0_ = row_of(bb_, cc_, 0); \
            const bf16_t* xp_ = XR + (size_t)(row0_ + xr_pad_of_tile(row0_ >> 8) + 8 * tg - 3) * 2048 + nb * 128 + 2 * cp; \
            _Pragma("unroll") for (int jr = 0; jr < 14; ++jr) { if (MODE == 1 || (d0 == 0 ? jr < 11 : jr >= 3)) xr[jr] = *(const unsigned*)(xp_ + (size_t)jr * 2048); } \
            if (MODE == 1) { cnext[0] = SUMH[(((size_t)bb_ * 2 + 0) * NCH + cc_) * 2048 + ch]; cnext[1] = SUMH[(((size_t)bb_ * 2 + 1) * NCH + cc_) * 2048 + ch]; } } while (0)
        int it = 0;
        if (part < NTILE) RG_PREF(part);
        for (int tile = part; tile < NTILE; tile += P) {
            const int bb = MODE == 0 ? tile / NCH : tile >> 6, cc = MODE == 0 ? tile % NCH : tile & 63; const int row0 = row_of(bb, cc, 0);
            unsigned xcur[14]; float ccur[2];
#pragma unroll
            for (int jr = 0; jr < 14; ++jr) xcur[jr] = xr[jr];
            ccur[0] = cnext[0]; ccur[1] = cnext[1];
            if (tile + P < NTILE) RG_PREF(tile + P);
            float hsum[4][4];
#pragma unroll
            for (int dd = 0; dd < ND; ++dd) { constexpr int dzero = d0; const int d = dzero + dd;
                LASP unsigned char* B = lds + (it & 1) * BUF; ++it;
                { f32x2v cv[8]; const f32x2v cbv = *(const LASP f32x2v*)(lds + CWOFF + ((dd * 5 + 4) * 128 + 2 * cp) * 4);
#pragma unroll
                  for (int i = 0; i < 8; ++i) cv[i] = cbv;
#pragma unroll
                  for (int jj = 0; jj < 4; ++jj) { const f32x2v cwv = *(const LASP f32x2v*)(lds + CWOFF + ((dd * 5 + jj) * 128 + 2 * cp) * 4);
#pragma unroll
                      for (int i = 0; i < 8; ++i) { const int jr = d == 0 ? i + jj : i + 6 - jj; cv[i].x += cwv.x * __uint_as_float(xcur[jr] << 16); cv[i].y += cwv.y * __uint_as_float(xcur[jr] & 0xffff0000u); } }
#pragma unroll
                  for (int i = 0; i < 8; ++i) { const int rho = 16 * (2 * (tg & 1) + (i >> 2)) + 4 * (tg >> 1) + (i & 3);
                      *(LASP unsigned*)(B + AOFF + rho * 272 + 4 * cp) = pg8::cvt_pk_bf16(cv[i].x, cv[i].y); *(LASP f32x2v*)(B + FOFF + rho * 528 + 8 * cp) = cv[i]; } }
                LDS_BARRIER();
                const int gl = d == 0 ? g : 3 - g;
                const int src1 = d == 0 ? lane - 16 : lane + 16, src2 = d == 0 ? lane - 32 : lane + 32, srcT = d == 0 ? 48 + c : c;
                const size_t sidx = (((size_t)bb * 2 + d) * NCH + cc) * 2048 + ch;
                float av[16], uv[16]; float pa = 1.f, lh = 0.f;
#pragma unroll
                for (int mtl = 0; mtl < 4; ++mtl) { const int mt = d == 0 ? mtl : 3 - mtl;
                    f4 aam = (f4){0.f, 0.f, 0.f, 0.f}, axm = (f4){0.f, 0.f, 0.f, 0.f};
#pragma unroll
                    for (int ks = 0; ks < 4; ++ks) { const bx8 af = *(const LASP bx8*)(B + AOFF + (16 * mt + c) * 272 + (32 * ks + 8 * g) * 2);
                        aam = __builtin_amdgcn_mfma_f32_16x16x32_bf16(af, wa[dd][ks], aam, 0, 0, 0); axm = __builtin_amdgcn_mfma_f32_16x16x32_bf16(af, wx[dd][ks], axm, 0, 0, 0); }
#pragma unroll
                    for (int sq = 0; sq < 4; ++sq) { const int r = d == 0 ? sq : 3 - sq;
                        const float xv = *(const LASP float*)(B + FOFF + (16 * mt + 4 * g + r) * 528 + (16 * wid + c) * 4);
                        const float rr = sigmoidf_(aam[r] + ba[dd]), ii = sigmoidf_(axm[r] + bxx[dd]);
                        const float a = fexp2_(-k8[dd] * rr), u = __builtin_amdgcn_sqrtf(fmaxf(1.f - a * a, 0.f)) * (ii * xv);
                        lh = a * lh + u; pa *= a; if (MODE == 1) { av[mt * 4 + r] = a; uv[mt * 4 + r] = u; } }
                }
                float XA = pa, XU = lh, tA, tU;
                tA = __shfl(XA, src1); tU = __shfl(XU, src1); if (gl >= 1) { XU = tU * XA + XU; XA = tA * XA; }
                tA = __shfl(XA, src2); tU = __shfl(XU, src2); if (gl >= 2) { XU = tU * XA + XU; XA = tA * XA; }
                if (MODE == 0) { if (gl == 3) { SUMA[sidx] = XA; SUMH[sidx] = XU; } }
                else {
                    float eA = __shfl(XA, src1), eU = __shfl(XU, src1); if (gl == 0) { eA = 1.f; eU = 0.f; }
                    float hh = ccur[dd] * eA + eU;
#pragma unroll
                    for (int mtl = 0; mtl < 4; ++mtl) { const int mt = d == 0 ? mtl : 3 - mtl;
#pragma unroll
                        for (int sq = 0; sq < 4; ++sq) { const int r = d == 0 ? sq : 3 - sq; hh = av[mt * 4 + r] * hh + uv[mt * 4 + r]; if (dd == 0) hsum[mt][r] = hh; else hsum[mt][r] += hh; } }
                }
            }
            if (MODE == 1) {
#pragma unroll
                for (int mt = 0; mt < 4; ++mt)
#pragma unroll
                    for (int r = 0; r < 4; ++r) { const size_t o = (size_t)(row0 + 16 * g + 4 * mt + r) * 2048 + ch; Y[o] = f2bf(hsum[mt][r] * bf2f(SG[o])); }
            }
        }
        LDS_BARRIER();
#undef RG_PREF
    }
}
template <int MODE>
__device__ __forceinline__ void st_rglru(const Params& p, int vb, int nvb, unsigned char* lds_, const bf16_t* XR, const bf16_t* SG, const bf16_t* BD, float* SUMA, float* SUMH, bf16_t* Y) {
    if (MODE == 1) { st_rglru_impl<1, 0>(p, vb, nvb, lds_, XR, SG, BD, SUMA, SUMH, Y); return; }
    const int combo0 = nvb >= 32 ? vb % 32 : vb;
    if (nvb >= 32) { if ((combo0 & 1) == 0) st_rglru_impl<0, 0>(p, vb, nvb, lds_, XR, SG, BD, SUMA, SUMH, Y); else st_rglru_impl<0, 1>(p, vb, nvb, lds_, XR, SG, BD, SUMA, SUMH, Y); }
    else { st_rglru_impl<0, 0>(p, vb, nvb, lds_, XR, SG, BD, SUMA, SUMH, Y); st_rglru_impl<0, 1>(p, vb, nvb, lds_, XR, SG, BD, SUMA, SUMH, Y); }
}
#ifndef FAST_RG
#define FAST_RG 1
#endif


#define RG_CH(dd, step) ((dd) == 0 ? ((step) < 4 ? 64 + (step) : (step) - 4) : 67 - (step))
constexpr int RG_ABUF = 2 * 17408, RG_CWOFF = 2 * RG_ABUF;
__device__ __forceinline__ void rg1p_producer(const Params& p, LASP unsigned char* lds, const bf16_t* XR, int bb, int nb, int pw) {
    typedef float f32x2v __attribute__((ext_vector_type(2)));
    const int lane = threadIdx.x & 63, cp = lane;
    unsigned xr[38];
#define RG_PREF(step) do { _Pragma("unroll") for (int dd = 0; dd < 2; ++dd) { const int row0_ = row_of(bb, RG_CH(dd, step), 0); \
            const unsigned char* ub_ = (const unsigned char*)(XR + (size_t)(row0_ + xr_pad_of_tile(row0_ >> 8) + 16 * pw - 3 + 3 * dd) * 2048 + nb * 128);     \
            _Pragma("unroll") for (int j = 0; j < 19; ++j) xr[dd * 19 + j] = *(const unsigned*)(ub_ + (size_t)j * 4096 + (unsigned)(4 * cp)); } } while (0)
#define RG_CONV(bufi) do { _Pragma("unroll") for (int dd = 0; dd < 2; ++dd) { \
            f32x2v cw4[4]; const f32x2v cbv = *(const LASP f32x2v*)(lds + RG_CWOFF + ((dd * 5 + 4) * 128 + 2 * cp) * 4); \
            _Pragma("unroll") for (int jj = 0; jj < 4; ++jj) cw4[jj] = *(const LASP f32x2v*)(lds + RG_CWOFF + ((dd * 5 + jj) * 128 + 2 * cp) * 4); \
            _Pragma("unroll") for (int hq = 0; hq < 2; ++hq) { f32x2v cv[8]; \
                _Pragma("unroll") for (int i = 0; i < 8; ++i) cv[i] = cbv; \
                _Pragma("unroll") for (int jx = 0; jx < 11; ++jx) { const unsigned xw = xr[dd * 19 + 8 * hq + jx]; const f32x2v xv2 = (f32x2v){__uint_as_float(xw << 16), __uint_as_float(xw & 0xffff0000u)}; \
                    _Pragma("unroll") for (int jj = 0; jj < 4; ++jj) { const int i = dd == 0 ? jx - jj : jx - 3 + jj; if (i >= 0 && i < 8) cv[i] = __builtin_elementwise_fma(cw4[jj], xv2, cv[i]); } } \
                _Pragma("unroll") for (int i = 0; i < 8; ++i) { const int t = 16 * pw + 8 * hq + i, rho = 16 * ((t >> 2) & 3) + 4 * (t >> 4) + (t & 3); \
                    *(LASP unsigned*)(lds + (bufi) * RG_ABUF + dd * 17408 + rho * 272 + 4 * cp) = pg8::cvt_pk_bf16(cv[i].x, cv[i].y); } } } } while (0)
    RG_PREF(0);
    RG_CONV(0);
    RG_PREF(1);
    LDS_BARRIER();
    for (int step = 0; step < NCH; ++step) {
        if (step + 1 < NCH) { RG_CONV((step + 1) & 1); if (step + 2 < NCH) RG_PREF(step + 2); }
        LDS_BARRIER();
    }
#undef RG_PREF
#undef RG_CONV
}
template <int WD>
__device__ __forceinline__ void rg1p_consumer(const Params& p, LASP unsigned char* lds, bf16_t* SGY, bf16_t* HXh, const bf16_t* BD, int bb, int nb, int sl, int nt) {
    typedef pg8::bf16x8 bx8; typedef pg8::f32x4 f4;
    const int lane = threadIdx.x & 63, c = lane & 15, g = lane >> 4;
    const int jch = sl * 32 + nt * 16 + c, ch = nb * 128 + jch;
    bx8 wa[4], wx[4];
    { const bf16_t* wA = BD + ((size_t)(WD * 16 + nb) * 128 + jch) * 128 + 8 * g; const bf16_t* wX = wA + (size_t)2 * 16 * 128 * 128;
#pragma unroll
      for (int ks = 0; ks < 4; ++ks) { wa[ks] = *(const bx8*)(wA + 32 * ks); wx[ks] = *(const bx8*)(wX + 32 * ks); } }
    const float ba = p.o_b_a[WD * 2048 + ch], bxx = p.o_b_x[WD * 2048 + ch], k8 = 8.f * 1.4426950408889634f * softplusf_(-p.o_lam[WD * 2048 + ch]);
    float carry = 0.f;
    const int gl = WD == 0 ? g : 3 - g;
    const int src1 = WD == 0 ? lane - 16 : lane + 16, src2 = WD == 0 ? lane - 32 : lane + 32, srcT = WD == 0 ? 48 + c : c;
    LDS_BARRIER();
    for (int step = 0; step < NCH; ++step) {
        const int cc = RG_CH(WD, step); const bool latent = cc < 64, second = step - 4 > 31;
        const int row0u = row_of(bb, cc, 0);
        const unsigned hoff = (unsigned)(16 * g) * 1024u + (unsigned)(ch & 1023), soff = (unsigned)(16 * g) * 2048u + (unsigned)ch;
        unsigned short hxv[16], sgv[16];
        if (latent && second) {
#pragma unroll
            for (int e = 0; e < 16; ++e) { const bf16_t* hb_ = HXh + (size_t)(row0u + e) * 1024; const bf16_t* sb_ = SGY + (size_t)(row0u + e) * 2048; hxv[e] = hb_[hoff]; sgv[e] = sb_[soff]; } }
        const LASP unsigned char* A = lds + (step & 1) * RG_ABUF + WD * 17408;
        float av[16], uv[16]; float pa = 1.f, lh = 0.f;
#pragma unroll
        for (int ml = 0; ml < 4; ++ml) { const int mt = WD == 0 ? ml : 3 - ml;
            f4 aam = (f4){0.f, 0.f, 0.f, 0.f}, axm = (f4){0.f, 0.f, 0.f, 0.f};
#pragma unroll
            for (int ks = 0; ks < 4; ++ks) { const bx8 af = *(const LASP bx8*)(A + (16 * mt + c) * 272 + (32 * ks + 8 * g) * 2);
                aam = __builtin_amdgcn_mfma_f32_16x16x32_bf16(af, wa[ks], aam, 0, 0, 0); axm = __builtin_amdgcn_mfma_f32_16x16x32_bf16(af, wx[ks], axm, 0, 0, 0); }
#pragma unroll
            for (int sq = 0; sq < 4; ++sq) { const int r = WD == 0 ? sq : 3 - sq;
                const float xv = bf2f(*(const LASP unsigned short*)(A + (16 * mt + 4 * g + r) * 272 + jch * 2));
                const float rr = sigmoidf_(aam[r] + ba), ii = sigmoidf_(axm[r] + bxx);
                const float a = fexp2_(-k8 * rr), u = __builtin_amdgcn_sqrtf(fmaxf(1.f - a * a, 0.f)) * (ii * xv);
                lh = a * lh + u; pa *= a; av[mt * 4 + r] = a; uv[mt * 4 + r] = u; }
        }
        float XA = pa, XU = lh, tA, tU;
        tA = __shfl(XA, src1); tU = __shfl(XU, src1); if (gl >= 1) { XU = tU * XA + XU; XA = tA * XA; }
        tA = __shfl(XA, src2); tU = __shfl(XU, src2); if (gl >= 2) { XU = tU * XA + XU; XA = tA * XA; }
        float eA = __shfl(XA, src1), eU = __shfl(XU, src1); if (gl == 0) { eA = 1.f; eU = 0.f; }
        const float totA = __shfl(XA, srcT), totU = __shfl(XU, srcT);
        if (latent) {
            float hh = carry * eA + eU; float hv[16];
#pragma unroll
            for (int ml = 0; ml < 4; ++ml) { const int mt = WD == 0 ? ml : 3 - ml;
#pragma unroll
                for (int sq = 0; sq < 4; ++sq) { const int r = WD == 0 ? sq : 3 - sq; const int e = mt * 4 + r; hh = av[e] * hh + uv[e]; hv[e] = hh; } }
            if (!second) {
#pragma unroll
                for (int e = 0; e < 16; ++e) { bf16_t* hb_ = HXh + (size_t)(row0u + e) * 1024; hb_[hoff] = f2bf(hv[e]); } }
            else {
#pragma unroll
                for (int e = 0; e < 16; ++e) { bf16_t* sb_ = SGY + (size_t)(row0u + e) * 2048; sb_[soff] = f2bf((bf2f(f2bf(hv[e])) + bf2f(hxv[e])) * bf2f(sgv[e])); } }
        }
        carry = carry * totA + totU;
        if (step == 35) asm volatile("s_waitcnt vmcnt(0)" ::: "memory");
        LDS_BARRIER();
    }
}
__device__ __forceinline__ void st_rg1p(const Params& p, int vb, int nvb, unsigned char* lds_, const bf16_t* XR, bf16_t* SGY, bf16_t* HX0, bf16_t* HX1, const bf16_t* BD, const float* XRC) {
    typedef float f32x2v __attribute__((ext_vector_type(2)));
    LASP unsigned char* lds = (LASP unsigned char*)lds_;
    const int wid = __builtin_amdgcn_readfirstlane(threadIdx.x >> 6), lane = threadIdx.x & 63;
    for (int it0 = vb; it0 < 256; it0 += nvb) {
        const int item = (nvb == 256) ? ((it0 & 7) * 32 + (it0 >> 3)) : it0;
        const int sl = item & 3, nb = (item >> 2) & 15, bb = item >> 6;
        bf16_t* HXh = nb < 8 ? HX0 : HX1;
        {
          bf16_t* xd = (bf16_t*)XR + (size_t)(NLAT + bb * 256 + 20 + 4 * bb) * 2048 + nb * 128; const float* xs = XRC + (size_t)(bb * 256) * 2048 + nb * 128;
          for (int e = threadIdx.x; e < 256 * 64; e += NTHREADS) { const int r = e >> 6, cpair = e & 63; const float2 v0 = *(const float2*)(xs + (size_t)r * 2048 + 2 * cpair), v1 = *(const float2*)(xs + (size_t)NCTX * 2048 + (size_t)r * 2048 + 2 * cpair); *(unsigned*)(xd + (size_t)r * 2048 + 2 * cpair) = pg8::cvt_pk_bf16(v0.x + v1.x, v0.y + v1.y); }
#pragma unroll
          for (int dd = 0; dd < 2; ++dd)
              if (wid < 5) { const f32x2v w2 = wid < 4 ? *(const f32x2v*)(p.o_conv_w + ((size_t)dd * 4 + wid) * 2048 + nb * 128 + 2 * lane) : *(const f32x2v*)(p.o_conv_b + (size_t)dd * 2048 + nb * 128 + 2 * lane);
                  *(LASP f32x2v*)(lds + RG_CWOFF + ((dd * 5 + wid) * 128 + 2 * lane) * 4) = w2; }
          asm volatile("s_waitcnt vmcnt(0)" ::: "memory"); LDS_BARRIER(); }
        if (wid >= 4) rg1p_producer(p, lds, XR, bb, nb, wid - 4);
        else if (wid < 2) rg1p_consumer<0>(p, lds, SGY, HXh, BD, bb, nb, sl, wid & 1);
        else rg1p_consumer<1>(p, lds, SGY, HXh, BD, bb, nb, sl, wid & 1);
    }
}
#define XB_TMO      128
#define XB_XCNT(j)  (256  + 64 * (j))
#define XB_XSUB(j)  (1280 + 64 * (j))
#define XB_XGEN(j)  (2304 + 64 * (j))
#define XB_TOP      3328
#define XB_TOPGEN   3392
#define XB_SPIN_CAP (1u << 20)
DEVI unsigned xb_ld(unsigned* p)              { return __hip_atomic_load(p, __ATOMIC_RELAXED, __HIP_MEMORY_SCOPE_AGENT); }
DEVI unsigned xb_add(unsigned* p, unsigned v) { return __hip_atomic_fetch_add(p, v, __ATOMIC_RELAXED, __HIP_MEMORY_SCOPE_AGENT); }
DEVI unsigned xb_xcc_id() { return (unsigned)__builtin_amdgcn_s_getreg((3 << 11) | 20) & 0xFu; }
#define XB_SPIN(cond, bar) do { unsigned _sp = 0; while (cond) { __builtin_amdgcn_s_sleep(1); \
    if ((++_sp & 255u) == 0u) { if (xb_ld(&(bar)[XB_TMO])) break; if (_sp > XB_SPIN_CAP) { atomicAdd(&(bar)[XB_TMO], 1u); break; } } } } while (0)
struct XcdBarrier { unsigned* bar; unsigned x; volatile __attribute__((address_space(3))) unsigned* st; };
DEVI XcdBarrier xcd_barrier_post(unsigned* bar, volatile __attribute__((address_space(3))) unsigned* st) {
    XcdBarrier b; b.bar = bar; b.x = xb_xcc_id(); b.st = st;
    if (threadIdx.x == 0) (void)xb_add(&bar[XB_XCNT(b.x)], 1u);
    return b;
}
DEVI void xcd_barrier_complete(unsigned* bar, unsigned x, unsigned& nloc, unsigned& nx) {
    const unsigned G = gridDim.x * gridDim.y * gridDim.z;
    unsigned sum, cnt, mine, sp = 0u;
    for (;;) {
        sum = 0u; cnt = 0u; mine = 0u;
#pragma unroll
        for (unsigned j = 0; j < 16; ++j) { const unsigned c = xb_ld(&bar[XB_XCNT(j)]); sum += c; cnt += (c > 0u) ? 1u : 0u; mine = (j == x) ? c : mine; }
        if (sum == G) break;
        __builtin_amdgcn_s_sleep(1);
        if ((++sp & 255u) == 0u) { if (xb_ld(&bar[XB_TMO])) break; if (sp > XB_SPIN_CAP) { atomicAdd(&bar[XB_TMO], 1u); break; } }
    }
    nloc = mine > 0u ? mine : 1u; nx = cnt > 0u ? cnt : 1u;
}
DEVI void xcd_barrier(const XcdBarrier& b) {
    asm volatile("s_waitcnt vmcnt(0)" ::: "memory");
    __syncthreads();
    if (threadIdx.x == 0) {
        unsigned* bar = b.bar;
        __builtin_amdgcn_s_waitcnt(0);
        unsigned nloc = b.st[0], nx = b.st[1];
        if (nloc == 0u) { xcd_barrier_complete(bar, b.x, nloc, nx); b.st[0] = nloc; b.st[1] = nx; }
        const unsigned old = xb_add(&bar[XB_XSUB(b.x)], 1u);
        const unsigned gen = old / nloc;
        if (old + 1u == (gen + 1u) * nloc) {
            __builtin_amdgcn_fence(__ATOMIC_RELEASE, "agent");
            asm volatile("s_waitcnt vmcnt(0)" ::: "memory");
            const unsigned og = xb_add(&bar[XB_TOP], 1u);
            const unsigned tg = og / nx;
            if (og + 1u == (tg + 1u) * nx) xb_add(&bar[XB_TOPGEN], 1u);
            else XB_SPIN(xb_ld(&bar[XB_TOPGEN]) == tg, bar);
            __builtin_amdgcn_fence(__ATOMIC_ACQUIRE, "agent");
            xb_add(&bar[XB_XGEN(b.x)], 1u);
            asm volatile("s_waitcnt vmcnt(0)" ::: "memory");
        } else {
            XB_SPIN(xb_ld(&bar[XB_XGEN(b.x)]) == gen, bar);
            __builtin_amdgcn_fence(__ATOMIC_ACQUIRE, "agent");
            asm volatile("s_waitcnt vmcnt(0)" ::: "memory");
        }
    }
    __syncthreads();
}
__device__ __forceinline__ void run_stage(const Params& p, int st, int vb, int nvb, unsigned char* lds) {
    unsigned char* ws = p.ws;
    float* MOD = (float*)(ws + WS_MOD); float* ALR = (float*)(ws + WS_ALR); float* X1C = (float*)(ws + WS_X1C);
    float* SUMA = (float*)(ws + WS_SUMA); float* SUMH = (float*)(ws + WS_SUMH); float* DEC = (float*)(ws + WS_DEC);
    bf16_t* Bt1 = (bf16_t*)(ws + WS_BT1); bf16_t* Bt2 = (bf16_t*)(ws + WS_BT2); bf16_t* Bt3 = (bf16_t*)(ws + WS_BT3); bf16_t* Bt4 = (bf16_t*)(ws + WS_BT4);
    bf16_t* S0 = (bf16_t*)(ws + WS_SLOT(0)); bf16_t* S1 = (bf16_t*)(ws + WS_SLOT(1)); bf16_t* S2 = (bf16_t*)(ws + WS_SLOT(2));
    bf16_t* S3 = (bf16_t*)(ws + WS_SLOT(3)); bf16_t* S4 = (bf16_t*)(ws + WS_SLOT(4)); bf16_t* S5 = (bf16_t*)(ws + WS_SLOT(5));
    bf16_t* DO0 = (bf16_t*)p.out; bf16_t* DOSC = (bf16_t*)((unsigned char*)p.out + 34 * MiB); bf16_t* DOZA = (bf16_t*)((unsigned char*)p.out + 51 * MiB);
    float* XRC = (float*)(ws + WS_BT1);
    float* SLAB2 = (float*)(ws + WS_SLOT(5) + 262144);
    switch (st) {
    case 0: st_mod(p, vb, nvb, (float*)lds); st_wprep(p, vb, nvb, lds); break;
    case 1: st_modulate(p, vb, nvb, 0, p.x, p.ctx, S0); break;
    case 3: st_glaprep(p, vb, nvb, lds, S1, S2, ALR, S3, S4, DOSC, DEC, S5); break;
#if FAST_WALK
    case 4: st_glawalk(p, vb, nvb, lds, S3, S4, DOSC, DEC, S5, S2, DO0); break;
#else
    case 4: st_glawalk_naive(p, vb, nvb, (float*)lds, S3, S4, DOSC, DEC, S5, S2, DO0); break;
#endif
    case 6: st_inner(p, vb, nvb, S2, DO0, S3, S4, S5, S0, DOZA, X1C); break;
    case 8: st_modulate(p, vb, nvb, 1, p.out, p.ctx, S2, SLAB2, 8, MOD + 4 * 3072 + 2048, nvb == 256 ? NLAT : 0);
            {
              for (int e = vb * NTHREADS + threadIdx.x; e < 9 * 4 * 256; e += nvb * NTHREADS) { const int gi = e >> 10, w = e & 1023; const int r0 = gi < 4 ? 4096 * gi + 4 * gi : (gi < 8 ? NLAT + 16 + 256 * (gi - 4) + 4 * (gi - 4) : NT + 32);
                  *(uint4*)(S3 + (size_t)r0 * 2048 + w * 8) = uint4{0u, 0u, 0u, 0u}; } }
            break;
    case 10: st_rg1p(p, vb, nvb, lds, S3, S0, S2, S5 + 131072, (const bf16_t*)(ws + WS_BD), XRC); break;
    case 14: if (nvb != 256) st_final(p, vb, nvb); break;
#if FAST_GEMM
    case 2: { FEpi1 E{S1, S2, S3, S4, S5, ALR, DOZA}; pg8::Gemm g{S0, Bt1, NT, N1, 1024}; pg8::TileOrder S; S.init(NT / 256, 11, 16, nvb, vb, 0, 8, 0, 12);
              pg8::gemm_phase<FEpi1, pg8::TileOrder, true, true>((PG8_LAS unsigned char*)lds, g, S, E); } break;
    case 5: { FEpi1 E{S1, S2, S3, S4, S5, ALR, DOZA}; pg8::Gemm g{S0, Bt1, NT, N1, 1024}; pg8::TileOrder S; S.init(NT / 256, 18, 16, nvb, vb, 0, 4, 8, 15);
              pg8::gemm_phase<FEpi1, pg8::TileOrder, true, true>((PG8_LAS unsigned char*)lds, g, S, E); } break;
    case 7: if (nvb == 256) { FEpiResMod E{p.x, p.out, S2, MOD, MOD + 5 * 3072, p.norm_g + 1024, SLAB2, (float*)(ws + WS_CTL + 131072 + 262144), (unsigned*)(ws + WS_CTL + 65536 + 16384)};
                  pg8::Gemm g{S0, Bt2, NT, 1024, 2048}; pg8::TileOrder S; S.init(NLAT / 256, 4, 32, nvb, vb, 0, 1 << 30, 0, 0, NCTX / 256, 4, NLAT / 256, 8, 4); S.tail_first = 1;
                  pg8::gemm_phase<FEpiResMod, pg8::TileOrder, false, true>((PG8_LAS unsigned char*)lds, g, S, E); }
            else { FEpiRes<true> E{p.x, p.ctx, p.out, SLAB2, MOD}; pg8::Gemm g{S0, Bt2, NT, 1024, 2048}; pg8::TileOrder S; S.init(NLAT / 256, 4, 32, nvb, vb, 0, 1 << 30, 0, 0, NCTX / 256, 4, NLAT / 256, 8, 4);
                  pg8::gemm_phase<FEpiRes<true>, pg8::TileOrder, true, true>((PG8_LAS unsigned char*)lds, g, S, E); } break;
    case 9: { FEpi3 E{S3, S0, XRC}; pg8::Gemm g{S2, Bt3, NT, 4096, 1024}; pg8::TileOrder S; S.init(NLAT / 256, 16, 16, nvb, vb, 0, 1 << 30, 0, 0, NCTX / 256, 8, NLAT / 256, 2, 8);
              pg8::gemm_phase<FEpi3, pg8::TileOrder, true, true>((PG8_LAS unsigned char*)lds, g, S, E); } break;
    case 13: if (nvb == 256) { FEpiResRms E{p.out, p.out, MOD + 5 * 3072, p.final_g, (float*)(ws + WS_CTL + 131072), (unsigned*)(ws + WS_CTL + 65536)}; pg8::Gemm g{S0, Bt4, NLAT, 1024, 2048}; pg8::TileOrder S; S.init(NLAT / 256, 4, 32, nvb, vb);
                  pg8::gemm_phase<FEpiResRms, pg8::TileOrder, false, true>((PG8_LAS unsigned char*)lds, g, S, E); }
             else { FEpiRes<false> E{p.out, nullptr, p.out, nullptr, MOD + 5 * 3072}; pg8::Gemm g{S0, Bt4, NLAT, 1024, 2048}; pg8::TileOrder S; S.init(NLAT / 256, 4, 32, nvb, vb);
                  pg8::gemm_phase<FEpiRes<false>, pg8::TileOrder, true, true>((PG8_LAS unsigned char*)lds, g, S, E); } break;
#else
    case 2: { Epi1 E{S1, S2, S3, S4, S5, ALR}; st_gemm_naive(vb, nvb, (float*)lds, S0, Bt1, 0, NT / 32, 0, 8, 1024, E); st_gemm_naive(vb, nvb, (float*)lds, S0, Bt1, 0, NT / 32, 12, 13, 1024, E); } break;
    case 5: { Epi1 E{S1, S2, S3, S4, S5, ALR}; st_gemm_naive(vb, nvb, (float*)lds, S0, Bt1, 0, NT / 32, 8, 12, 1024, E); st_gemm_naive(vb, nvb, (float*)lds, S0, Bt1, 0, NT / 32, 13, 29, 1024, E); } break;
    case 7: { EpiRes E{p.x, p.ctx, p.out, X1C, MOD}; st_gemm_naive(vb, nvb, (float*)lds, S0, Bt2, 0, NT / 32, 0, 4, 2048, E); } break;
    case 9: { Epi3 E{S3, S0}; st_gemm_naive(vb, nvb, (float*)lds, S2, Bt3, 0, NLAT / 32, 0, 16, 1024, E); st_gemm_naive(vb, nvb, (float*)lds, S2, Bt3, NLAT / 32, NT / 32, 0, 8, 1024, E); } break;
    case 13: { EpiRes E{p.out, nullptr, p.out, nullptr, MOD + 5 * 3072}; st_gemm_naive(vb, nvb, (float*)lds, S0, Bt4, 0, NLAT / 32, 0, 4, 2048, E); } break;
#endif
    }
}
constexpr int NSTAGES = 15;
constexpr int LDS_BYTES = 147456;

#ifndef ONE_LAUNCH
#define ONE_LAUNCH 1
#endif
#if !ONE_LAUNCH
__global__ void __launch_bounds__(NTHREADS) k_mega(Params p, int st) {
    extern __shared__ __attribute__((aligned(16))) unsigned char lds[];
    run_stage(p, st, blockIdx.x, gridDim.x, lds);
}
#else
__global__ void __launch_bounds__(NTHREADS) k_mega(Params p) {
    extern __shared__ __attribute__((aligned(16))) unsigned char lds[];
    volatile __attribute__((address_space(3))) unsigned* st = (volatile __attribute__((address_space(3))) unsigned*)((__attribute__((address_space(3))) unsigned char*)lds + (LDS_BYTES - 64));
    if (threadIdx.x < 2) st[threadIdx.x] = 0u;
    __syncthreads();
    const XcdBarrier bar = xcd_barrier_post((unsigned*)(p.ws + WS_CTL) + 4096, st);
#ifndef REP_STAGE
#define REP_STAGE -1
#endif
#ifndef REP_N
#define REP_N 1
#endif
#define RS(k) do { run_stage(p, k, blockIdx.x, gridDim.x, lds); if ((k) == REP_STAGE) { for (int rep_ = 0; rep_ < REP_N; ++rep_) { xcd_barrier(bar); run_stage(p, k, blockIdx.x, gridDim.x, lds); } } } while (0)
#define GS() xcd_barrier(bar)
    RS(0); GS(); RS(1); GS(); RS(2); GS(); RS(3); GS(); RS(4); GS(); RS(5); GS(); RS(6); GS(); RS(7); GS();
    RS(8); GS(); RS(9); GS(); RS(10); GS(); RS(13); if (gridDim.x != 256) { GS(); RS(14); }
#undef RS
#undef GS
}
#endif

extern "C" void kernel_launch(void* const* d_in, const int* in_sizes, int n_in, void* d_out, int out_size, void* d_ws, size_t ws_size, hipStream_t stream) {
    static int inited = 0, grid_blocks = 0;
    if (!inited) {
        if (n_in != 23 || ws_size < WS_END || out_size != NLAT * D) { fprintf(stderr, "kernel_launch: unexpected shapes n_in %d ws %zu out %d\n", n_in, ws_size, out_size); inited = -1; return; }
        if (hipFuncSetAttribute((const void*)k_mega, hipFuncAttributeMaxDynamicSharedMemorySize, LDS_BYTES) != hipSuccess) { fprintf(stderr, "hipFuncSetAttribute failed\n"); inited = -1; return; }
        int dev = 0, cus = 0, per_cu = 0;
        (void)hipGetDevice(&dev); (void)hipDeviceGetAttribute(&cus, hipDeviceAttributeMultiprocessorCount, dev);
        (void)hipOccupancyMaxActiveBlocksPerMultiprocessor(&per_cu, (const void*)k_mega, NTHREADS, LDS_BYTES);
        if (per_cu < 1) { fprintf(stderr, "kernel_launch: occupancy query says %d blocks per CU\n", per_cu); per_cu = 1; }
        if (per_cu > 1) per_cu = 1;
        grid_blocks = cus * per_cu;
        inited = 1;
    }
    if (inited < 0) return;
    Params p{};
    const float** f = (const float**)&p;
    for (int i = 0; i < 23; ++i) f[i] = (const float*)d_in[i];
    p.out = (float*)d_out; p.ws = (unsigned char*)d_ws;
    (void)hipMemsetAsync((unsigned char*)d_ws + WS_CTL, 0, 2 * MiB, stream);
#if ONE_LAUNCH
    void* args[] = {&p};
    hipError_t e = hipLaunchCooperativeKernel((const void*)k_mega, dim3(grid_blocks), dim3(NTHREADS), args, LDS_BYTES, stream);
    if (e != hipSuccess) fprintf(stderr, "cooperative launch failed: %s (grid %d)\n", hipGetErrorString(e), grid_blocks);
#else
    for (int st = 0; st < NSTAGES; ++st) hipLaunchKernelGGL(k_mega, dim3(1024), dim3(NTHREADS), LDS_BYTES, stream, p, st);
#endif
}
```

```cpp
#include <hip/hip_runtime.h>
#include <hip/hip_cooperative_groups.h>
namespace cg = cooperative_groups;
#include <cstdio>
#include <cstdint>

typedef unsigned short bf16_t;
#define DEVI __device__ __forceinline__
#define LDS_BARRIER() do { asm volatile("s_waitcnt lgkmcnt(0)" ::: "memory"); __builtin_amdgcn_s_barrier(); asm volatile("" ::: "memory"); } while (0)

constexpr int D = 1024, NB = 4, SEQ = 4096, CTXL = 256;
constexpr int NLAT = NB * SEQ;
constexpr int NCTX = NB * CTXL;
constexpr int NT = NLAT + NCTX;
constexpr int NCH = 68;
constexpr int EVEN_IN = 7200;
constexpr int N1 = 7424;
constexpr int N1A = 13 * 256;
constexpr int RGW = 2048;
constexpr float EPS = 1e-6f;

constexpr size_t MiB = 1u << 20;
constexpr size_t WS_CTL = 0;
constexpr size_t WS_MOD = 1 * MiB;
constexpr size_t WS_ALR = 2 * MiB;
constexpr size_t WS_X1C = 5 * MiB;
constexpr size_t WS_SUMA = 9 * MiB;
constexpr size_t WS_SUMH = 9 * MiB + 4608 * 1024;
constexpr size_t WS_DEC = 18 * MiB;
constexpr size_t WS_BT1 = 19 * MiB + 512 * 1024;
constexpr size_t WS_BT2 = 34 * MiB;
constexpr size_t WS_BT3 = 38 * MiB;
constexpr size_t WS_BT4 = 46 * MiB;
constexpr size_t WS_BD = 50 * MiB;
constexpr size_t WS_S0 = 52 * MiB;
constexpr size_t SLOT = 34 * MiB;
constexpr size_t WS_END = WS_S0 + 6 * SLOT;
static_assert(WS_END == 256 * MiB, "ws map");
#define WS_SLOT(i) (WS_S0 + (size_t)(i) * SLOT)

struct Params {
    const float* x; const float* c; const float* ctx; const float* c_ctx; const float* norm_g; const float* w_mod; const float* b_mod;
    const float* e_w_in; const float* e_w_a2; const float* e_b_a2; const float* e_gla_g; const float* e_conv_w; const float* e_w_out;
    const float* o_w_in; const float* o_conv_w; const float* o_conv_b; const float* o_w_a; const float* o_b_a; const float* o_w_x; const float* o_b_x;
    const float* o_lam; const float* o_w_out; const float* final_g;
    float* out; unsigned char* ws;
};

DEVI float bf2f(bf16_t v) { return __uint_as_float((unsigned)v << 16); }
typedef float hw_f2 __attribute__((ext_vector_type(2))); typedef __bf16 hw_b2 __attribute__((ext_vector_type(2)));
DEVI unsigned hw_pk(float lo, float hi) { hw_f2 v = {lo, hi}; hw_b2 b = __builtin_convertvector(v, hw_b2); return __builtin_bit_cast(unsigned, b); }
DEVI bf16_t f2bf(float f) { return (bf16_t)(hw_pk(f, 0.f) & 0xffffu); }
DEVI unsigned pk2(float lo, float hi) { return hw_pk(lo, hi); }
DEVI float fexp2_(float x) { return __builtin_amdgcn_exp2f(x); }
DEVI float frcp_(float x) { return __builtin_amdgcn_rcpf(x); }
DEVI float sigmoidf_(float x) { return frcp_(1.0f + fexp2_(-1.4426950408889634f * x)); }
DEVI float siluf_(float x) { return x * frcp_(1.0f + fexp2_(-1.4426950408889634f * x)); }
DEVI float softplusf_(float x) { return fmaxf(x, 0.f) + log1pf(__expf(-fabsf(x))); }
DEVI float logsigmoidf_(float x) { return fminf(x, 0.f) - 0.6931471805599453f * __builtin_amdgcn_logf(1.0f + fexp2_(-1.4426950408889634f * fabsf(x))); }
DEVI int row_of(int bb, int c, int t) { return c < 64 ? bb * 4096 + c * 64 + t : NLAT + bb * 256 + (c - 64) * 64 + t; }
DEVI int mod_idx(int row) { return row < NLAT ? (row >> 12) : 4; }
DEVI int xr_pad_of_tile(int pm) { return pm < 64 ? 4 * ((pm >> 4) + 1) : 20 + 4 * (pm - 64); }
constexpr int XR_ROWS = NT + 36;
DEVI float wave_sum(float v) {
#pragma unroll
    for (int o = 1; o < 64; o <<= 1) v += __shfl_xor(v, o);
    return v;
}
__host__ __device__ inline int colmap1(int n) {
    const int t = n >> 8, c = n & 255;
    if (t < 12) return n;
    if (t == 12) return c < 32 ? 3072 + c : -1;
    if (t < 21) { const int j = t - 13; return c < 128 ? 4128 + 128 * j + c : 5152 + 128 * j + (c - 128); }
    const int j = t - 21; return c < 128 ? 3104 + 128 * j + c : 6176 + 128 * j + (c - 128);
}

#define NTHREADS 512

__device__ void st_mod(const Params& p, int vb, int nvb, float* lds) {
    float* MOD = (float*)(p.ws + WS_MOD);
    for (int i = threadIdx.x; i < 5 * 1024; i += NTHREADS) { const int s = i >> 10, k = i & 1023; const float v = s < 4 ? p.c[s * 1024 + k] : p.c_ctx[k]; lds[i] = siluf_(v); }
    __syncthreads();
    const int lane = threadIdx.x & 63, gw = vb * (NTHREADS / 64) + (threadIdx.x >> 6), ngw = nvb * (NTHREADS / 64);
    for (int it = gw; it < 2 * 48 * 32; it += ngw) {
        const int kc = it & 31, cb = (it >> 5) % 48, li = it / (32 * 48), j = cb * 64 + lane, k0 = kc * 32;
        const float* W = p.w_mod + ((size_t)li * 1024 + k0) * 3072 + j;
        float wv[32];
#pragma unroll
        for (int k = 0; k < 32; ++k) wv[k] = W[(size_t)k * 3072];
        float a0 = 0.f, a1 = 0.f, a2 = 0.f, a3 = 0.f, a4 = 0.f;
#pragma unroll
        for (int k = 0; k < 32; ++k) { const float w = wv[k]; a0 += lds[k0 + k] * w; a1 += lds[1024 + k0 + k] * w; a2 += lds[2048 + k0 + k] * w; a3 += lds[3072 + k0 + k] * w; a4 += lds[4096 + k0 + k] * w; }
        const float bv = kc == 0 ? p.b_mod[li * 3072 + j] : 0.f;
        float* o = MOD + (size_t)li * 5 * 3072 + j;
        atomicAdd(o, a0 + bv); atomicAdd(o + 3072, a1 + bv); atomicAdd(o + 2 * 3072, a2 + bv); atomicAdd(o + 3 * 3072, a3 + bv); atomicAdd(o + 4 * 3072, a4 + bv);
    }
    __syncthreads();
}

__device__ __forceinline__ void wt_item(const float* src, int ldw, bf16_t* dst, int K, int k0, __attribute__((address_space(3))) float* scr, int lane) {
    typedef unsigned v4u __attribute__((ext_vector_type(4)));
    if (src) {
        float rv[32];
#pragma unroll
        for (int i = 0; i < 32; ++i) { const int kk = 2 * i + (lane >> 5); rv[i] = src[(size_t)(k0 + kk) * ldw + (lane & 31)]; }
#pragma unroll
        for (int i = 0; i < 32; ++i) { const int kk = 2 * i + (lane >> 5); scr[kk * 33 + (lane & 31)] = rv[i]; }
    }
    asm volatile("s_waitcnt lgkmcnt(0)" ::: "memory");
    const int cch = lane & 7;
#pragma unroll
    for (int j = 0; j < 4; ++j) { const int n = (lane >> 3) + 8 * j; const __attribute__((address_space(3))) float* sp = scr + (8 * cch) * 33 + n;
        v4u o = {0u, 0u, 0u, 0u};
        if (src) { o.x = pk2(sp[0 * 33], sp[1 * 33]); o.y = pk2(sp[2 * 33], sp[3 * 33]); o.z = pk2(sp[4 * 33], sp[5 * 33]); o.w = pk2(sp[6 * 33], sp[7 * 33]); }
        *(v4u*)(dst + (size_t)n * K + k0 + 8 * cch) = o; }
    asm volatile("s_waitcnt lgkmcnt(0)" ::: "memory");
}
__device__ void st_wprep(const Params& p, int vb, int nvb, unsigned char* lds_) {
    bf16_t* Bt1 = (bf16_t*)(p.ws + WS_BT1); bf16_t* Bt2 = (bf16_t*)(p.ws + WS_BT2); bf16_t* Bt3 = (bf16_t*)(p.ws + WS_BT3); bf16_t* Bt4 = (bf16_t*)(p.ws + WS_BT4);
    bf16_t* BD = (bf16_t*)(p.ws + WS_BD);
    const int lane = threadIdx.x & 63, wv = threadIdx.x >> 6, gw = vb * (NTHREADS / 64) + wv, ngw = nvb * (NTHREADS / 64);
    __attribute__((address_space(3))) float* scr = (__attribute__((address_space(3))) float*)lds_ + 8192 + wv * (64 * 33);
    constexpr int I1 = 16 * (N1 / 32), I2 = 32 * 32, I3 = 16 * 128, I4 = 32 * 32, I5 = 64 * 8;
    for (int it = gw; it < I1 + I2 + I3 + I4 + I5; it += ngw) {
        int r = it;
        if (r < I1) { const int nbk = N1 / 32, kb = r / nbk, nb = r % nbk; const int sc = colmap1(nb * 32); wt_item(sc < 0 ? nullptr : p.e_w_in + sc, EVEN_IN, Bt1 + (size_t)nb * 32 * 1024, 1024, kb * 64, scr, lane); continue; } r -= I1;
        if (r < I2) { const int kb = r / 32, nb = r % 32; wt_item(p.e_w_out + nb * 32, 1024, Bt2 + (size_t)nb * 32 * 2048, 2048, kb * 64, scr, lane); continue; } r -= I2;
        if (r < I3) { const int kb = r / 128, nb = r % 128; wt_item(p.o_w_in + nb * 32, 4096, Bt3 + (size_t)nb * 32 * 1024, 1024, kb * 64, scr, lane); continue; } r -= I3;
        if (r < I4) { const int kb = r / 32, nb = r % 32; wt_item(p.o_w_out + nb * 32, 1024, Bt4 + (size_t)nb * 32 * 2048, 2048, kb * 64, scr, lane); continue; } r -= I4;
        { const int m = r >> 8, dn = (r >> 3) & 31, kb = (r >> 2) & 1, nb = r & 3; const float* W = (m == 0 ? p.o_w_a : p.o_w_x) + (size_t)dn * 16384;
          wt_item(W + nb * 32, 128, BD + (size_t)m * 2 * 16 * 16384 + (size_t)dn * 16384 + (size_t)nb * 32 * 128, 128, kb * 64, scr, lane); }
    }
}

__device__ void st_modulate(const Params& p, int vb, int nvb, int li, const float* xlat, const float* xctx, bf16_t* H, const float* slab = nullptr, int nslab = 0, const float* gatec = nullptr, int row_begin = 0) {
    const float* MOD = (const float*)(p.ws + WS_MOD) + (size_t)li * 5 * 3072;
    const float* g = p.norm_g + li * 1024;
    const int lane = threadIdx.x & 63, gw = vb * (NTHREADS / 64) + (threadIdx.x >> 6), ngw = nvb * (NTHREADS / 64);
    for (int row = row_begin + gw; row < NT; row += ngw) {
        const float* xr = row < NLAT ? xlat + (size_t)row * 1024 : xctx + (size_t)(row - NLAT) * 1024;
        const float* md = MOD + (size_t)mod_idx(row) * 3072;
        float4 v[4]; float ss = 0.f;
#pragma unroll
        for (int j = 0; j < 4; ++j) { v[j] = *(const float4*)(xr + j * 256 + lane * 4);
            if (slab && row >= NLAT) {
                float4 a = {0.f, 0.f, 0.f, 0.f};
                for (int ks = 0; ks < nslab; ++ks) { const float4 t = *(const float4*)(slab + ((size_t)ks * NCTX + (row - NLAT)) * 1024 + j * 256 + lane * 4); a.x += t.x; a.y += t.y; a.z += t.z; a.w += t.w; }
                const float4 gt = *(const float4*)(gatec + j * 256 + lane * 4); v[j].x += gt.x * a.x; v[j].y += gt.y * a.y; v[j].z += gt.z * a.z; v[j].w += gt.w * a.w; }
            ss += v[j].x * v[j].x + v[j].y * v[j].y + v[j].z * v[j].z + v[j].w * v[j].w; }
        const float rinv = rsqrtf(wave_sum(ss) * (1.f / 1024.f) + EPS);
#pragma unroll
        for (int j = 0; j < 4; ++j) { const int c0 = j * 256 + lane * 4; const float4 gg = *(const float4*)(g + c0), sh = *(const float4*)(md + c0), sc = *(const float4*)(md + 1024 + c0);
            ushort4 o; o.x = f2bf(v[j].x * rinv * gg.x * (1.f + sc.x) + sh.x); o.y = f2bf(v[j].y * rinv * gg.y * (1.f + sc.y) + sh.y);
            o.z = f2bf(v[j].z * rinv * gg.z * (1.f + sc.z) + sh.z); o.w = f2bf(v[j].w * rinv * gg.w * (1.f + sc.w) + sh.w);
            *(ushort4*)(H + (size_t)row * 1024 + c0) = o; }
    }
}

template <class Epi>
__device__ void st_gemm_naive(int vb, int nvb, float* lds, const bf16_t* A, const bf16_t* Bt, int mt0, int mt1, int nt0, int nt1, int K, const Epi& E) {
    float* As = lds;
    float* Bs = lds + 32 * 33;
    const int tid = threadIdx.x, tx = tid & 63, ty = tid >> 6;
    const int nmt = mt1 - mt0, nnt = nt1 - nt0;
    for (int it = vb; it < nmt * nnt; it += nvb) {
        const int m0 = (mt0 + it / nnt) * 32, n0 = (nt0 + it % nnt) * 256;
        float acc[4][4];
#pragma unroll
        for (int i = 0; i < 4; ++i)
#pragma unroll
            for (int j = 0; j < 4; ++j) acc[i][j] = 0.f;
        for (int k0 = 0; k0 < K; k0 += 32) {
            __syncthreads();
            for (int e = tid; e < 32 * 32; e += NTHREADS) { const int r = e >> 5, kk = e & 31; As[r * 33 + kk] = bf2f(A[(size_t)(m0 + r) * K + k0 + kk]); }
            for (int e = tid; e < 256 * 32; e += NTHREADS) { const int r = e >> 5, kk = e & 31; Bs[r * 33 + kk] = bf2f(Bt[(size_t)(n0 + r) * K + k0 + kk]); }
            __syncthreads();
#pragma unroll 8
            for (int kk = 0; kk < 32; ++kk) {
                float a[4], b[4];
#pragma unroll
                for (int i = 0; i < 4; ++i) a[i] = As[(ty * 4 + i) * 33 + kk];
#pragma unroll
                for (int j = 0; j < 4; ++j) b[j] = Bs[(tx + 64 * j) * 33 + kk];
#pragma unroll
                for (int i = 0; i < 4; ++i)
#pragma unroll
                    for (int j = 0; j < 4; ++j) acc[i][j] += a[i] * b[j];
            }
        }
#pragma unroll
        for (int i = 0; i < 4; ++i) E(m0 + ty * 4 + i, n0, tx, acc[i]);
    }
    __syncthreads();
}

struct Epi1 {
    bf16_t *QK, *V, *SGA, *Z, *CBG; float* ALR;
    DEVI void operator()(int row, int n0, int cl, const float (&v)[4]) const {
        const int t = n0 >> 8;
        if (t < 4) { for (int j = 0; j < 4; ++j) QK[(size_t)row * 1024 + n0 + cl + 64 * j] = f2bf(v[j]); }
        else if (t < 8) { for (int j = 0; j < 4; ++j) V[(size_t)row * 1024 + (n0 - 1024) + cl + 64 * j] = f2bf(v[j]); }
        else if (t < 12) { for (int j = 0; j < 4; ++j) SGA[(size_t)row * 1024 + (n0 - 2048) + cl + 64 * j] = f2bf(siluf_(v[j])); }
        else if (t == 12) { if (cl < 32) ALR[(size_t)row * 32 + cl] = v[0]; }
        else if (t < 21) { const int jt = t - 13; Z[(size_t)row * 1024 + 128 * jt + cl] = f2bf(v[0] * v[2]); Z[(size_t)row * 1024 + 128 * jt + cl + 64] = f2bf(v[1] * v[3]); }
        else { const int jt = t - 21; CBG[(size_t)row * 1024 + 128 * jt + cl] = f2bf(v[0] * siluf_(v[2])); CBG[(size_t)row * 1024 + 128 * jt + cl + 64] = f2bf(v[1] * siluf_(v[3])); }
    }
};
struct EpiRes {
    const float* xl; const float* xc; float* outl; float* outc; const float* MODl;
    DEVI void operator()(int row, int n0, int cl, const float (&v)[4]) const {
        const float* gate = MODl + (size_t)mod_idx(row) * 3072 + 2048;
        for (int j = 0; j < 4; ++j) { const int col = n0 + cl + 64 * j;
            if (row < NLAT) outl[(size_t)row * 1024 + col] = xl[(size_t)row * 1024 + col] + gate[col] * v[j];
            else if (outc) outc[(size_t)(row - NLAT) * 1024 + col] = xc[(size_t)(row - NLAT) * 1024 + col] + gate[col] * v[j]; }
    }
};
struct Epi3 {
    bf16_t* XR; bf16_t* SG;
    DEVI void operator()(int row, int n0, int cl, const float (&v)[4]) const {
        for (int j = 0; j < 4; ++j) { const int col = n0 + cl + 64 * j;
            if (col < 2048) XR[(size_t)row * 2048 + col] = f2bf(v[j]); else if (row < NLAT) SG[(size_t)row * 2048 + col - 2048] = f2bf(siluf_(v[j])); }
    }
};

#define LASQ __attribute__((address_space(3)))
__device__ void st_glaprep(const Params& p, int vb, int nvb, unsigned char* ldsb, const bf16_t* QK, const bf16_t* V, const float* ALR, bf16_t* QIN, bf16_t* KET, bf16_t* SC, float* DEC, bf16_t* VT) {
    typedef unsigned u4 __attribute__((ext_vector_type(4))); typedef unsigned u2 __attribute__((ext_vector_type(2))); typedef float f4 __attribute__((ext_vector_type(4))); typedef short bx8 __attribute__((ext_vector_type(8)));
    LASQ unsigned char* lds = (LASQ unsigned char*)ldsb;
    constexpr int RQ = 0, RK = 17408, Q0 = 34816, K0 = 52224, VR = 69632, AL = VR + 33792, TT = AL + 8192;
    const int tid = threadIdx.x, kk = tid & 127, tq = tid >> 7, wv = tid >> 6, ln = tid & 63, cl = ln & 15, gq = ln >> 4;
    u4 r[9];
#define GP_LOAD(item) do { const int h_ = (item) & 3, bc_ = (item) >> 2, c_ = bc_ % NCH, bb_ = bc_ / NCH; const size_t row0_ = (size_t)row_of(bb_, c_, 0); \
        _Pragma("unroll") for (int j_ = 0; j_ < 2; ++j_) { const int p_ = tid + 512 * j_; r[j_] = *(const u4*)(QK + (row0_ + (p_ >> 4)) * 1024 + h_ * 128 + (p_ & 15) * 8); r[2 + j_] = *(const u4*)(QK + (row0_ + (p_ >> 4)) * 1024 + 512 + h_ * 128 + (p_ & 15) * 8); } \
        _Pragma("unroll") for (int j_ = 0; j_ < 4; ++j_) { const int p_ = tid + 512 * j_; r[4 + j_] = *(const u4*)(V + (row0_ + (p_ >> 5)) * 1024 + h_ * 256 + (p_ & 31) * 8); } \
        r[8] = *(const u4*)(ALR + (row0_ + (tid >> 3)) * 32 + (tid & 7) * 4); } while (0)
    const int NIT = NB * NCH * 4;
    if (vb < NIT) GP_LOAD(vb);
    for (int item = vb; item < NIT; item += nvb) {
        const int h = item & 3;
        LDS_BARRIER();
#pragma unroll
        for (int j = 0; j < 2; ++j) { const int pp = tid + 512 * j; *(LASQ u4*)(lds + RQ + (pp >> 4) * 272 + (pp & 15) * 16) = r[j]; *(LASQ u4*)(lds + RK + (pp >> 4) * 272 + (pp & 15) * 16) = r[2 + j]; }
#pragma unroll
        for (int j = 0; j < 4; ++j) { const int pp = tid + 512 * j; *(LASQ u4*)(lds + VR + (pp >> 5) * 528 + (pp & 31) * 16) = r[4 + j]; }
        *(LASQ u4*)(lds + AL + (tid >> 3) * 128 + (tid & 7) * 16) = r[8];
        float w2a[2][16], b2a[2];
#pragma unroll
        for (int d = 0; d < 2; ++d) {
#pragma unroll
            for (int rr = 0; rr < 16; ++rr) w2a[d][rr] = p.e_w_a2[((size_t)d * 16 + rr) * 512 + h * 128 + kk];
            b2a[d] = p.e_b_a2[d * 512 + h * 128 + kk]; }
        asm volatile("" ::: "memory");
        if (item + nvb < NIT) GP_LOAD(item + nvb);
        LDS_BARRIER();
        unsigned qkr[16];
#pragma unroll
        for (int i = 0; i < 16; ++i) { qkr[i] = (unsigned)*(const LASQ unsigned short*)(lds + RQ + (tq * 16 + i) * 272 + kk * 2) | ((unsigned)*(const LASQ unsigned short*)(lds + RK + (tq * 16 + i) * 272 + kk * 2) << 16); }
        float bc[2][16];
#pragma unroll
        for (int d = 0; d < 2; ++d) {
            const float (&w2)[16] = w2a[d]; const float b2 = b2a[d];
#pragma unroll
            for (int ib = 0; ib < 8; ++ib) {
                f4 ar[2][4];
#pragma unroll
                for (int ii = 0; ii < 2; ++ii) { const LASQ f4* a = (const LASQ f4*)(lds + AL + (tq * 16 + ib * 2 + ii) * 128 + d * 64); ar[ii][0] = a[0]; ar[ii][1] = a[1]; ar[ii][2] = a[2]; ar[ii][3] = a[3]; }
#pragma unroll
                for (int ii = 0; ii < 2; ++ii) { float z = b2;
#pragma unroll
                    for (int q4 = 0; q4 < 4; ++q4) z += ar[ii][q4][0] * w2[4 * q4] + ar[ii][q4][1] * w2[4 * q4 + 1] + ar[ii][q4][2] * w2[4 * q4 + 2] + ar[ii][q4][3] * w2[4 * q4 + 3];
                    bc[d][ib * 2 + ii] = logsigmoidf_(z) * (1.f / 16.f); }
            }
            float sacc = 0.f;
            if (d == 0) {
#pragma unroll
                for (int i = 0; i < 16; ++i) { sacc += bc[d][i]; bc[d][i] = sacc; } }
            else {
#pragma unroll
                for (int i = 15; i >= 0; --i) { sacc += bc[d][i]; bc[d][i] = sacc; } }
            *(LASQ float*)(lds + TT + ((d * 4 + tq) * 128 + kk) * 4) = sacc;
        }
        LDS_BARRIER();
        const float scale = 0.08838834764831845f;
#pragma unroll
        for (int d = 0; d < 2; ++d) {
            const size_t u = (size_t)item * 2 + d;
            float off = 0.f, blast = 0.f;
#pragma unroll
            for (int q = 0; q < 4; ++q) { const float tv = *(const LASQ float*)(lds + TT + ((d * 4 + q) * 128 + kk) * 4); blast += tv; if (d == 0 ? (q < tq) : (q > tq)) off += tv; }
            LASQ unsigned char* qd = lds + (d == 0 ? Q0 : RQ); LASQ unsigned char* kd = lds + (d == 0 ? K0 : RK);
            unsigned ke[8];
#pragma unroll
            for (int i = 0; i < 16; ++i) { const int t = tq * 16 + i; const float bq = bc[d][i] + off;
                const float qv = __uint_as_float(qkr[i] << 16) * scale, kv = __uint_as_float(qkr[i] & 0xffff0000u);
                const float eb = fexp2_(1.4426950408889634f * bq);
                *(LASQ unsigned short*)(qd + t * 272 + kk * 2) = f2bf(qv * eb); *(LASQ unsigned short*)(kd + t * 272 + kk * 2) = f2bf(kv * frcp_(eb));
                const unsigned kev = f2bf(kv * fexp2_(1.4426950408889634f * (blast - bq)));
                if (i & 1) ke[i >> 1] |= kev << 16; else ke[i >> 1] = kev; }
            { u4 w0 = {ke[0], ke[1], ke[2], ke[3]}, w1 = {ke[4], ke[5], ke[6], ke[7]}; u4* dst = (u4*)(KET + (u * 128 + kk) * 64 + tq * 16); dst[0] = w0; dst[1] = w1; }
            if (tq == 0) DEC[u * 128 + kk] = fexp2_(1.4426950408889634f * blast);
        }
        LDS_BARRIER();
#pragma unroll
        for (int d = 0; d < 2; ++d) {
            const size_t u = (size_t)item * 2 + d;
            const LASQ unsigned char* qd = lds + (d == 0 ? Q0 : RQ); const LASQ unsigned char* kd = lds + (d == 0 ? K0 : RK);
#pragma unroll
            for (int j = 0; j < 2; ++j) { const int pp = tid + 512 * j; *(u4*)(QIN + u * 8192 + (pp >> 4) * 128 + (pp & 15) * 8) = *(const LASQ u4*)(qd + (pp >> 4) * 272 + (pp & 15) * 16); }
            const int mt = wv >> 1;
#pragma unroll
            for (int nn = 0; nn < 2; ++nn) { const int nt = 2 * (wv & 1) + nn; f4 acc = {0.f, 0.f, 0.f, 0.f};
#pragma unroll
                for (int k4 = 0; k4 < 4; ++k4) { const bx8 kf = *(const LASQ bx8*)(kd + (16 * nt + cl) * 272 + (32 * k4 + 8 * gq) * 2), qf = *(const LASQ bx8*)(qd + (16 * mt + cl) * 272 + (32 * k4 + 8 * gq) * 2);
                    acc = __builtin_amdgcn_mfma_f32_16x16x32_bf16(kf, qf, acc, 0, 0, 0); }
                const int t = 16 * mt + cl, s0 = 16 * nt + 4 * gq; float v[4];
#pragma unroll
                for (int rr = 0; rr < 4; ++rr) { const int sx = s0 + rr; v[rr] = (d == 0 ? (sx <= t) : (sx >= t)) ? acc[rr] : 0.f; }
                u2 w; w.x = pk2(v[0], v[1]); w.y = pk2(v[2], v[3]); *(u2*)(SC + (u * 64 + t) * 64 + s0) = w; }
        }
        { const int vc = tid & 255, th = tid >> 8; unsigned vv[16];
#pragma unroll
          for (int i = 0; i < 32; ++i) { const unsigned x = *(const LASQ unsigned short*)(lds + VR + (32 * th + i) * 528 + vc * 2); if (i & 1) vv[i >> 1] |= x << 16; else vv[i >> 1] = x; }
          u4* dst = (u4*)(VT + ((size_t)item * 256 + vc) * 64 + 32 * th);
          dst[0] = (u4){vv[0], vv[1], vv[2], vv[3]}; dst[1] = (u4){vv[4], vv[5], vv[6], vv[7]}; dst[2] = (u4){vv[8], vv[9], vv[10], vv[11]}; dst[3] = (u4){vv[12], vv[13], vv[14], vv[15]}; }
    }
    LDS_BARRIER();
#undef GP_LOAD
}

__device__ void st_glawalk_naive(const Params& p, int vb, int nvb, float* Sl, const bf16_t* QIN, const bf16_t* KET, const bf16_t* SC, const float* DEC, const bf16_t* VT, bf16_t* OF, bf16_t* OB) {
    const int vc = threadIdx.x & 255, half = threadIdx.x >> 8;
    for (int combo = vb; combo < 32; combo += nvb) {
        const int d = combo & 1, h = (combo >> 1) & 3, bb = combo >> 3;
        __syncthreads();
        for (int k = half * 64; k < half * 64 + 64; ++k) Sl[k * 256 + vc] = 0.f;
        __syncthreads();
        bf16_t* O = d == 0 ? OF : OB;
        for (int step = 0; step < NCH; ++step) {
            const int c = d == 0 ? (step < 4 ? 64 + step : step - 4) : 67 - step;
            const int u = ((bb * NCH + c) * 4 + h) * 2 + d;
            const bf16_t* q = QIN + (size_t)u * 64 * 128; const bf16_t* ke = KET + (size_t)u * 128 * 64; const bf16_t* sc = SC + (size_t)u * 64 * 64;
            const bf16_t* vt = VT + (((size_t)(u >> 1)) * 256 + vc) * 64;
            float vv[64];
#pragma unroll
            for (int t = 0; t < 64; ++t) vv[t] = bf2f(vt[t]);
            const int row0 = row_of(bb, c, 0);
            for (int t = half * 32; t < half * 32 + 32; ++t) { float a = 0.f;
                for (int k = 0; k < 128; ++k) a += bf2f(q[t * 128 + k]) * bf2f(f2bf(Sl[k * 256 + vc]));
#pragma unroll
                for (int s = 0; s < 64; ++s) a += bf2f(sc[t * 64 + s]) * vv[s];
                O[(size_t)(row0 + t) * 1024 + h * 256 + vc] = f2bf(a); }
            __syncthreads();
            for (int k = half * 64; k < half * 64 + 64; ++k) { float a = DEC[(size_t)u * 128 + k] * Sl[k * 256 + vc];
#pragma unroll
                for (int t = 0; t < 64; ++t) a += bf2f(ke[k * 64 + t]) * vv[t];
                Sl[k * 256 + vc] = a; }
            __syncthreads();
        }
    }
}

__device__ void st_inner(const Params& p, int vb, int nvb, const bf16_t* OF, const bf16_t* OB, const bf16_t* SGA, const bf16_t* Z, const bf16_t* CBG, bf16_t* INNER, const bf16_t* ZA, float* X1C) {
    const int lane = threadIdx.x & 63, gw = vb * (NTHREADS / 64) + (threadIdx.x >> 6), ngw = nvb * (NTHREADS / 64);
    float4 gg = *(const float4*)(p.e_gla_g + lane * 4);
    for (int row = gw; row < NT; row += ngw) {
        bool hasp, hasn;
        if (row < NLAT) { const int t = row & 63; hasp = t != 0; hasn = t != 63; } else { const int t = (row - NLAT) & 255; hasp = t != 0; hasn = t != 255; }
        const size_t rp = hasp ? row - 1 : row, rn = hasn ? row + 1 : row; const float mp = hasp ? 1.f : 0.f, mn = hasn ? 1.f : 0.f;
        ushort4 a[4], b[4], sg[4], zc[4], zp[4], zn[4], cb[4];
#pragma unroll
        for (int h = 0; h < 4; ++h) { const int c0 = h * 256 + lane * 4;
            a[h] = *(const ushort4*)(OF + (size_t)row * 1024 + c0); b[h] = *(const ushort4*)(OB + (size_t)row * 1024 + c0); sg[h] = *(const ushort4*)(SGA + (size_t)row * 1024 + c0);
            const bf16_t* zb = h == 0 ? ZA + lane * 4 : Z + c0; const size_t zpitch = h == 0 ? 256 : 1024;
            zc[h] = *(const ushort4*)(zb + (size_t)row * zpitch); zp[h] = *(const ushort4*)(zb + rp * zpitch); zn[h] = *(const ushort4*)(zb + rn * zpitch);
            cb[h] = *(const ushort4*)(CBG + (size_t)row * 1024 + c0); }
#pragma unroll
        for (int h = 0; h < 4; ++h) { const int c0 = h * 256 + lane * 4;
            const float o0 = bf2f(a[h].x) + bf2f(b[h].x), o1 = bf2f(a[h].y) + bf2f(b[h].y), o2 = bf2f(a[h].z) + bf2f(b[h].z), o3 = bf2f(a[h].w) + bf2f(b[h].w);
            const float rinv = rsqrtf(wave_sum(o0 * o0 + o1 * o1 + o2 * o2 + o3 * o3) * (1.f / 256.f) + EPS);
            uint2 o; o.x = pk2(o0 * rinv * gg.x * bf2f(sg[h].x), o1 * rinv * gg.y * bf2f(sg[h].y)); o.y = pk2(o2 * rinv * gg.z * bf2f(sg[h].z), o3 * rinv * gg.w * bf2f(sg[h].w));
            *(uint2*)(INNER + (size_t)row * 2048 + c0) = o;
            const float4 w0 = *(const float4*)(p.e_conv_w + c0), w1 = *(const float4*)(p.e_conv_w + 1024 + c0), w2 = *(const float4*)(p.e_conv_w + 2048 + c0);
            uint2 y; y.x = pk2(bf2f(cb[h].x) * (mp * w0.x * bf2f(zp[h].x) + w1.x * bf2f(zc[h].x) + mn * w2.x * bf2f(zn[h].x)), bf2f(cb[h].y) * (mp * w0.y * bf2f(zp[h].y) + w1.y * bf2f(zc[h].y) + mn * w2.y * bf2f(zn[h].y)));
            y.y = pk2(bf2f(cb[h].z) * (mp * w0.z * bf2f(zp[h].z) + w1.z * bf2f(zc[h].z) + mn * w2.z * bf2f(zn[h].z)), bf2f(cb[h].w) * (mp * w0.w * bf2f(zp[h].w) + w1.w * bf2f(zc[h].w) + mn * w2.w * bf2f(zn[h].w)));
            *(uint2*)(INNER + (size_t)row * 2048 + 1024 + c0) = y; }
    }
}

template <int MODE>
__device__ void st_rglru_naive(const Params& p, int vb, int nvb, float* lds, const bf16_t* XR, const bf16_t* SG, float* SUMA, float* SUMH, bf16_t* Y) {
    float* xc = lds;
    float* av = xc + 64 * 128;
    float* uv = av + 64 * 128;
    float* hf = uv + 64 * 128;
    const int tid = threadIdx.x, j = tid & 127, tq = tid >> 7;
    const int nitems = MODE == 0 ? NB * NCH * 16 * 2 : NB * 64 * 16;
    for (int it = vb; it < nitems; it += nvb) {
        int bb, c, nb;
        if (MODE == 0) { nb = (it >> 1) & 15; const int bc = it >> 5; c = bc % NCH; bb = bc / NCH; } else { nb = it & 15; const int bc = it >> 4; c = bc & 63; bb = bc >> 6; }
        const int row0 = row_of(bb, c, 0);
        const int seg0 = c < 64 ? bb * 4096 : NLAT + bb * 256, segn = c < 64 ? 4096 : 256;
        const int tl0 = row0 - seg0;
        for (int dd = 0; dd < (MODE == 0 ? 1 : 2); ++dd) {
            const int d = MODE == 0 ? (it & 1) : dd;
            __syncthreads();
            for (int e = tid; e < 64 * 128; e += NTHREADS) { const int t = e >> 7, i = e & 127, ch = nb * 128 + i; float a = p.o_conv_b[d * 2048 + ch];
#pragma unroll
                for (int jj = 0; jj < 4; ++jj) { const int tt = d == 0 ? tl0 + t - 3 + jj : tl0 + t + 3 - jj;
                    if (tt >= 0 && tt < segn) a += p.o_conv_w[((size_t)d * 4 + jj) * 2048 + ch] * bf2f(XR[(size_t)(seg0 + tt) * 2048 + ch]); }
                xc[e] = a; }
            __syncthreads();
            const float* WA = p.o_w_a + ((size_t)d * 16 + nb) * 128 * 128; const float* WX = p.o_w_x + ((size_t)d * 16 + nb) * 128 * 128;
            const int ch = nb * 128 + j;
            const float ba = p.o_b_a[d * 2048 + ch], bx = p.o_b_x[d * 2048 + ch], sp = softplusf_(-p.o_lam[d * 2048 + ch]);
            for (int i16 = 0; i16 < 16; ++i16) { const int t = tq * 16 + i16; float ra = ba, rx = bx;
                for (int i = 0; i < 128; ++i) { const float xv = bf2f(f2bf(xc[t * 128 + i])); ra += xv * bf2f(f2bf(WA[i * 128 + j])); rx += xv * bf2f(f2bf(WX[i * 128 + j])); }
                const float r = sigmoidf_(ra), ig = sigmoidf_(rx); const float la = -8.f * r * sp; const float a = __expf(la);
                av[t * 128 + j] = a; uv[t * 128 + j] = sqrtf(-expm1f(2.f * la)) * (ig * xc[t * 128 + j]); }
            __syncthreads();
            if (tid < 128) {
                const size_t sidx = (((size_t)bb * 2 + d) * NCH + c) * 2048 + ch;
                if (MODE == 0) { float A = 1.f, hh = 0.f;
                    if (d == 0) for (int t = 0; t < 64; ++t) { const float a = av[t * 128 + j]; hh = a * hh + uv[t * 128 + j]; A *= a; }
                    else for (int t = 63; t >= 0; --t) { const float a = av[t * 128 + j]; hh = a * hh + uv[t * 128 + j]; A *= a; }
                    SUMA[sidx] = A; SUMH[sidx] = hh;
                } else { float hh = SUMH[sidx];
                    if (d == 0) for (int t = 0; t < 64; ++t) { hh = av[t * 128 + j] * hh + uv[t * 128 + j]; hf[t * 128 + j] = hh; }
                    else for (int t = 63; t >= 0; --t) { hh = av[t * 128 + j] * hh + uv[t * 128 + j]; const size_t o = (size_t)(row0 + t) * 2048 + ch; Y[o] = f2bf((hf[t * 128 + j] + hh) * bf2f(SG[o])); }
                }
            }
        }
    }
    __syncthreads();
}
__device__ void st_carry(const Params& p, int vb, int nvb, const float* SUMA, float* SUMH) {
    for (int e = vb * NTHREADS + threadIdx.x; e < NB * 2 * 2048; e += nvb * NTHREADS) {
        const int ch = e & 2047, d = (e >> 11) & 1, bb = e >> 12; float hh = 0.f;
        for (int s0 = 0; s0 < NCH; s0 += 17) {
            float A[17], H[17];
#pragma unroll
            for (int i = 0; i < 17; ++i) { const int step = s0 + i, c = d == 0 ? (step < 4 ? 64 + step : step - 4) : 67 - step; const size_t sidx = (((size_t)bb * 2 + d) * NCH + c) * 2048 + ch; A[i] = SUMA[sidx]; H[i] = SUMH[sidx]; }
#pragma unroll
            for (int i = 0; i < 17; ++i) { const int step = s0 + i, c = d == 0 ? (step < 4 ? 64 + step : step - 4) : 67 - step; const size_t sidx = (((size_t)bb * 2 + d) * NCH + c) * 2048 + ch; SUMH[sidx] = hh; hh = A[i] * hh + H[i]; }
        }
    }
}
__device__ void st_final(const Params& p, int vb, int nvb) {
    const int lane = threadIdx.x & 63, gw = vb * (NTHREADS / 64) + (threadIdx.x >> 6), ngw = nvb * (NTHREADS / 64);
    for (int row = gw; row < NLAT; row += ngw) { float* xr = p.out + (size_t)row * 1024; float4 v[4]; float ss = 0.f;
#pragma unroll
        for (int j = 0; j < 4; ++j) { v[j] = *(const float4*)(xr + j * 256 + lane * 4); ss += v[j].x * v[j].x + v[j].y * v[j].y + v[j].z * v[j].z + v[j].w * v[j].w; }
        const float rinv = rsqrtf(wave_sum(ss) * (1.f / 1024.f) + EPS);
#pragma unroll
        for (int j = 0; j < 4; ++j) { const float4 g = *(const float4*)(p.final_g + j * 256 + lane * 4); float4 o; o.x = v[j].x * rinv * g.x; o.y = v[j].y * rinv * g.y; o.z = v[j].z * rinv * g.z; o.w = v[j].w * rinv * g.w; *(float4*)(xr + j * 256 + lane * 4) = o; }
    }
}


namespace pg8 {
#define PG8_LAS __attribute__((address_space(3)))
typedef short bf16x8 __attribute__((ext_vector_type(8)));
typedef float f32x4 __attribute__((ext_vector_type(4)));
typedef unsigned u32x4 __attribute__((ext_vector_type(4)));
constexpr int BM = 256, BK = 64, HALF = 128, HTB = HALF * BK * 2, STAGE_BYTES = 8 * HTB, NXCD = 8, WGM = 8;
__host__ __device__ __forceinline__ int lds_byte(int r, int c) { const int st = (r >> 4) * 2 + (c >> 5), rr = r & 15, cc = c & 31, ob = rr * 64 + cc * 2; return st * 1024 + (ob ^ (((ob >> 9) & 1) << 5)); }
__host__ __device__ __forceinline__ void stage_rc(int b, int& R, int& C) { const int st = b / 1024, sb = b % 1024, swz = sb ^ (((sb >> 9) & 1) << 5); R = (st >> 1) * 16 + swz / 64; C = (st & 1) * 32 + (swz % 64) / 2; }
__host__ __device__ __forceinline__ int perm32(int rho) { const int n = rho >> 4, i = rho & 15; return 8 * (i >> 2) + 4 * n + (i & 3); }
struct Unit { int pm, pn, k0, nk; };
struct Gemm { const bf16_t* A; const bf16_t* Bt; int M, N, K; };
struct TileOrder {
    int nM, nN, nwg, G, c, m0, split, base0, base1, nkfull, nM2, nN2, m02, nKS, nk2, tail_first;
    __device__ void init(int nM_, int nN_, int nkfull_, int G_, int c_, int m0_ = 0, int split_ = 1 << 30, int base0_ = 0, int base1_ = 0, int nM2_ = 0, int nN2_ = 0, int m02_ = 0, int nKS_ = 1, int nk2_ = 0) {
        nM = nM_; nN = nN_; nwg = nM * nN; nkfull = nkfull_; G = G_; c = c_; m0 = m0_; split = split_; base0 = base0_; base1 = base1_; nM2 = nM2_; nN2 = nN2_; m02 = m02_; nKS = nKS_; nk2 = nk2_; tail_first = 0; }
    __device__ bool next(int i, Unit& u) const {
        long L = (long)i * G + c;
        if (tail_first) {
            const int ntail = nM2 * nN2 * nKS;
            if (c < ntail) { if (i == 0) L = (long)nwg + c; else L = (long)(i - 1) * G + c; }
            if (i > 0 && c >= ntail && L >= nwg) return false;
            if (i > 0 && c < ntail && L >= nwg) return false;
        }
        if (L >= nwg) { const long L2 = L - nwg; if (L2 >= (long)nM2 * nN2 * nKS) return false; const int ks = (int)(L2 % nKS), rest = (int)(L2 / nKS);
            u.pm = m02 + rest / nN2; u.pn = rest % nN2; u.k0 = ks * nk2 * 64; u.nk = nk2; return true; }
        int wgid = (int)L; { const int q = nwg / NXCD, r = nwg % NXCD, xcd = wgid % NXCD, off = wgid / NXCD; wgid = (xcd < r ? xcd * (q + 1) : r * (q + 1) + (xcd - r) * q) + off; }
        const int nig = WGM * nN, gid = wgid / nig, fm = gid * WGM, gsz = (nM - fm) < WGM ? (nM - fm) : WGM;
        const int pm = fm + ((wgid % nig) % gsz), j = (wgid % nig) / gsz;
        u.pm = m0 + pm; u.pn = j < split ? base0 + j : base1 + (j - split); u.k0 = 0; u.nk = nkfull; return true;
    }
    __device__ __forceinline__ void a_ready(const Unit&) const {}
    __device__ __forceinline__ void done(const Unit&) const {}
};
typedef float f32x2_t __attribute__((ext_vector_type(2))); typedef __bf16 bf16x2_t __attribute__((ext_vector_type(2)));
__device__ __forceinline__ unsigned cvt_pk_bf16(float lo, float hi) { f32x2_t v = {lo, hi}; bf16x2_t b = __builtin_convertvector(v, bf16x2_t); return __builtin_bit_cast(unsigned, b); }
template <class Epi, class Sched, bool ALIGN_EPI = false, bool SP2 = false>
__device__ __forceinline__ void gemm_phase(PG8_LAS unsigned char* lds, const Gemm g, const Sched& S, const Epi& E) {
    const int tid = threadIdx.x, wid = __builtin_amdgcn_readfirstlane(tid >> 6), lane = tid & 63, wr = wid >> 2, wc = wid & 3, fr = lane & 15, fq = lane >> 4;
    const int K = g.K;
    unsigned voffA[2], voffB[2];
#pragma unroll
    for (int i = 0; i < 2; ++i) { int R, C; stage_rc(tid * 16 + i * 8192, R, C); const int Rb = Epi::PERM ? ((R & ~31) + perm32(R & 31)) : R;
        voffA[i] = (unsigned)(R * K + C) * 2u; voffB[i] = (unsigned)(Rb * K + C) * 2u; }
    const size_t kstep = (size_t)(BK * 2);
    const size_t hstep = (size_t)HALF * K * 2;
    const size_t tstep = 2 * hstep;
    const unsigned ldsw = (unsigned)wid * 1024u;
    const int aoff = lds_byte(wr * 64 + fr, fq * 8), boff = lds_byte(wc * 32 + fr, fq * 8);
#define PG8_SA(b, h) (((b) * 2 + (h)) * HTB)
#define PG8_SB(b, h) ((4 + (b) * 2 + (h)) * HTB)
#define PG8_STAGE(bufoff, gbase, voff) do { _Pragma("unroll") for (int _i = 0; _i < 2; ++_i) \
        __builtin_amdgcn_global_load_lds((const unsigned*)((const char*)(gbase) + (voff)[_i]), (PG8_LAS unsigned*)(lds + (bufoff) + ldsw + _i * 8192), 16, 0, 0); } while (0)
#define PG8_LDA(dst, b, h) do { _Pragma("unroll") for (int m = 0; m < 4; ++m) _Pragma("unroll") for (int k = 0; k < 2; ++k) dst[m][k] = *(const PG8_LAS bf16x8*)(lds + PG8_SA(b, h) + aoff + m * 2048 + k * 1024); } while (0)
#define PG8_LDB(dst, b, h) do { _Pragma("unroll") for (int n = 0; n < 2; ++n) _Pragma("unroll") for (int k = 0; k < 2; ++k) dst[n][k] = *(const PG8_LAS bf16x8*)(lds + PG8_SB(b, h) + boff + n * 2048 + k * 1024); } while (0)
#define PG8_MMA(ai, bj, At, Bt) do { __builtin_amdgcn_s_setprio(1); _Pragma("unroll") for (int m = 0; m < 4; ++m) _Pragma("unroll") for (int n = 0; n < 2; ++n) _Pragma("unroll") for (int k = 0; k < 2; ++k) \
        acc[ai][bj][m][n] = __builtin_amdgcn_mfma_f32_16x16x32_bf16(Bt[n][k], At[m][k], acc[ai][bj][m][n], 0, 0, 0); __builtin_amdgcn_s_setprio(0); } while (0)
#define PG8_WAIT_V(n) asm volatile("s_waitcnt vmcnt(" #n ")" ::: "memory")
#define PG8_WAIT_L(n) asm volatile("s_waitcnt lgkmcnt(" #n ")" ::: "memory")
#define PG8_BAR __builtin_amdgcn_s_barrier()
#define PG8_SCHED __builtin_amdgcn_sched_barrier(0)
    Unit cur, nxt; int ui = 0;
    if (!S.next(0, cur)) return;
    f32x4 acc[2][2][4][2];
#pragma unroll
    for (int a = 0; a < 2; ++a)
#pragma unroll
        for (int b = 0; b < 2; ++b)
#pragma unroll
            for (int m = 0; m < 4; ++m)
#pragma unroll
                for (int n = 0; n < 2; ++n) acc[a][b][m][n] = (f32x4){0.f, 0.f, 0.f, 0.f};
    bf16x8 At[4][2], B0[2][2], B1[2][2];
    const char* cA = (const char*)g.A + (size_t)cur.pm * tstep + (size_t)cur.k0 * 2; const char* cB = (const char*)g.Bt + (size_t)cur.pn * tstep + (size_t)cur.k0 * 2;
    S.a_ready(cur);
    if constexpr (SP2) {
        PG8_STAGE(PG8_SB(0, 0), cB, voffB); PG8_STAGE(PG8_SB(0, 1), cB + hstep, voffB); PG8_STAGE(PG8_SA(0, 0), cA, voffA); PG8_STAGE(PG8_SA(0, 1), cA + hstep, voffA);
        if (wr == 1) PG8_BAR;
        PG8_WAIT_V(2); PG8_BAR;
        PG8_STAGE(PG8_SB(1, 0), cB + kstep, voffB); PG8_STAGE(PG8_SA(1, 0), cA + kstep, voffA); PG8_STAGE(PG8_SB(1, 1), cB + hstep + kstep, voffB);
        PG8_WAIT_V(6); PG8_BAR;
    } else {
        PG8_STAGE(PG8_SB(0, 0), cB, voffB); PG8_STAGE(PG8_SA(0, 0), cA, voffA); PG8_STAGE(PG8_SB(0, 1), cB + hstep, voffB); PG8_STAGE(PG8_SA(0, 1), cA + hstep, voffA);
        if (wr == 1) PG8_BAR;
        PG8_WAIT_V(4); PG8_BAR;
        PG8_STAGE(PG8_SB(1, 0), cB + kstep, voffB); PG8_STAGE(PG8_SA(1, 0), cA + kstep, voffA); PG8_STAGE(PG8_SB(1, 1), cB + hstep + kstep, voffB);
        PG8_WAIT_V(6); PG8_BAR;
    }
    for (;;) {
        const bool has_next = S.next(ui + 1, nxt);
        const char* nA = has_next ? (const char*)g.A + (size_t)nxt.pm * tstep + (size_t)nxt.k0 * 2 : cA; const char* nB = has_next ? (const char*)g.Bt + (size_t)nxt.pn * tstep + (size_t)nxt.k0 * 2 : cB;
        const int nt = cur.nk;
        for (int t = 0; t < nt; t += 2) {
            const bool last = (t == nt - 2);
            const char* a1 = cA + (size_t)(t + 1) * kstep;
            const char* a2 = last ? nA : cA + (size_t)(t + 2) * kstep; const char* b2 = last ? nB : cB + (size_t)(t + 2) * kstep;
            const char* a3 = a2 + kstep; const char* b3 = b2 + kstep;
            if (last && has_next) S.a_ready(nxt);
            if constexpr (SP2) {
            PG8_LDB(B0, 0, 0); PG8_LDB(B1, 0, 1); PG8_SCHED; PG8_LDA(At, 0, 0); PG8_STAGE(PG8_SA(1, 1), a1 + hstep, voffA);
            PG8_WAIT_V(8); PG8_WAIT_L(0); PG8_BAR; PG8_MMA(0, 0, At, B0); PG8_MMA(0, 1, At, B1); PG8_BAR; PG8_SCHED;
            PG8_LDA(At, 0, 1); PG8_STAGE(PG8_SB(0, 0), b2, voffB); PG8_STAGE(PG8_SB(0, 1), b2 + hstep, voffB); PG8_STAGE(PG8_SA(0, 0), a2, voffA);
            PG8_WAIT_V(8); PG8_WAIT_L(0); PG8_BAR; PG8_MMA(1, 0, At, B0); PG8_MMA(1, 1, At, B1); PG8_BAR; PG8_SCHED;
            PG8_LDB(B0, 1, 0); PG8_LDB(B1, 1, 1); PG8_SCHED; PG8_LDA(At, 1, 0); PG8_STAGE(PG8_SA(0, 1), a2 + hstep, voffA);
            PG8_WAIT_V(8); PG8_WAIT_L(0); PG8_BAR; PG8_MMA(0, 0, At, B0); PG8_MMA(0, 1, At, B1); PG8_BAR; PG8_SCHED;
            PG8_LDA(At, 1, 1); PG8_STAGE(PG8_SB(1, 0), b3, voffB); PG8_STAGE(PG8_SB(1, 1), b3 + hstep, voffB); PG8_STAGE(PG8_SA(1, 0), a3, voffA);
            PG8_WAIT_V(8); PG8_WAIT_L(0); PG8_BAR; PG8_MMA(1, 0, At, B0); PG8_MMA(1, 1, At, B1); PG8_BAR; PG8_SCHED;
            } else {
            PG8_LDB(B0, 0, 0); PG8_SCHED; PG8_LDA(At, 0, 0); PG8_STAGE(PG8_SA(1, 1), a1 + hstep, voffA);
            PG8_WAIT_L(8); PG8_BAR; PG8_WAIT_L(0); PG8_MMA(0, 0, At, B0); PG8_BAR; PG8_SCHED;
            PG8_LDB(B1, 0, 1); PG8_STAGE(PG8_SB(0, 0), b2, voffB);
            PG8_BAR; PG8_WAIT_L(0); PG8_MMA(0, 1, At, B1); PG8_BAR;
            PG8_LDA(At, 0, 1); PG8_STAGE(PG8_SA(0, 0), a2, voffA);
            PG8_BAR; PG8_WAIT_L(0); PG8_MMA(1, 0, At, B0); PG8_BAR; PG8_SCHED;
            PG8_STAGE(PG8_SB(0, 1), b2 + hstep, voffB);
            PG8_WAIT_V(6); PG8_BAR; PG8_MMA(1, 1, At, B1); PG8_BAR;
            PG8_LDB(B0, 1, 0); PG8_SCHED; PG8_LDA(At, 1, 0); PG8_STAGE(PG8_SA(0, 1), a2 + hstep, voffA);
            PG8_WAIT_L(8); PG8_BAR; PG8_WAIT_L(0); PG8_MMA(0, 0, At, B0); PG8_BAR; PG8_SCHED;
            PG8_LDB(B1, 1, 1); PG8_STAGE(PG8_SB(1, 0), b3, voffB);
            PG8_BAR; PG8_WAIT_L(0); PG8_MMA(0, 1, At, B1); PG8_BAR;
            PG8_LDA(At, 1, 1); PG8_STAGE(PG8_SA(1, 0), a3, voffA);
            PG8_BAR; PG8_WAIT_L(0); PG8_MMA(1, 0, At, B0); PG8_BAR; PG8_SCHED;
            PG8_STAGE(PG8_SB(1, 1), b3 + hstep, voffB);
            PG8_WAIT_V(6); PG8_BAR; PG8_MMA(1, 1, At, B1); PG8_BAR;
            }
        }
        if constexpr (ALIGN_EPI) { if (wr == 0) PG8_BAR; }
        if constexpr (!Epi::AFTER_DRAIN) { E(acc, cur, wr, wc, fr, fq); S.done(cur); } else { if (has_next) { E(acc, cur, wr, wc, fr, fq); S.done(cur); } }
        if (!has_next) break;
#pragma unroll
        for (int a = 0; a < 2; ++a)
#pragma unroll
            for (int b = 0; b < 2; ++b)
#pragma unroll
                for (int m = 0; m < 4; ++m)
#pragma unroll
                    for (int n = 0; n < 2; ++n) acc[a][b][m][n] = (f32x4){0.f, 0.f, 0.f, 0.f};
        cur = nxt; cA = nA; cB = nB; ++ui;
        if constexpr (ALIGN_EPI) { if (wr == 1) PG8_BAR; }
    }
    PG8_WAIT_V(0);
    if constexpr (!ALIGN_EPI) { if (wr == 0) PG8_BAR; }
    PG8_BAR;
    if constexpr (Epi::AFTER_DRAIN) { E.fused(acc, cur, wr, wc, fr, fq, lds, wid, lane); S.done(cur); }
#undef PG8_SA
#undef PG8_SB
#undef PG8_STAGE
#undef PG8_LDA
#undef PG8_LDB
#undef PG8_MMA
#undef PG8_WAIT_V
#undef PG8_WAIT_L
#undef PG8_BAR
#undef PG8_SCHED
}
}

DEVI pg8::u32x4 pack8(const pg8::f32x4& a, const pg8::f32x4& b) { pg8::u32x4 w; w.x = pg8::cvt_pk_bf16(a[0], a[1]); w.y = pg8::cvt_pk_bf16(a[2], a[3]); w.z = pg8::cvt_pk_bf16(b[0], b[1]); w.w = pg8::cvt_pk_bf16(b[2], b[3]); return w; }
DEVI pg8::f32x4 silu4(const pg8::f32x4& a) { pg8::f32x4 r; r[0] = siluf_(a[0]); r[1] = siluf_(a[1]); r[2] = siluf_(a[2]); r[3] = siluf_(a[3]); return r; }
struct FEpi1 {
    static constexpr bool PERM = true, AFTER_DRAIN = false;
    bf16_t *QK, *V, *SGA, *Z, *CBG; float* ALR; bf16_t* ZA;
    DEVI void operator()(const pg8::f32x4 (&acc)[2][2][4][2], const pg8::Unit& u, int wr, int wc, int fr, int fq) const {
        const int t = u.pn, row0 = u.pm * 256 + wr * 64 + fr, cw = wc * 32 + 8 * fq;
#pragma unroll
        for (int ai = 0; ai < 2; ++ai)
#pragma unroll
            for (int m = 0; m < 4; ++m) {
                const size_t row = (size_t)(row0 + ai * 128 + m * 16);
                if (t < 12) {
                    bf16_t* base = t < 4 ? QK + row * 1024 + t * 256 : (t < 8 ? V + row * 1024 + (t - 4) * 256 : SGA + row * 1024 + (t - 8) * 256);
#pragma unroll
                    for (int bj = 0; bj < 2; ++bj) { pg8::f32x4 v0 = acc[ai][bj][m][0], v1 = acc[ai][bj][m][1]; if (t >= 8) { v0 = silu4(v0); v1 = silu4(v1); }
                        *(pg8::u32x4*)(base + bj * 128 + cw) = pack8(v0, v1); }
                } else if (t == 12) {
                    if (wc == 0) { *(pg8::f32x4*)(ALR + row * 32 + 8 * fq) = acc[ai][0][m][0]; *(pg8::f32x4*)(ALR + row * 32 + 8 * fq + 4) = acc[ai][0][m][1]; }
                } else if (t < 21) {
                    bf16_t* zp = t < 15 ? ZA + row * 256 + (t - 13) * 128 + cw : Z + row * 1024 + (t - 13) * 128 + cw;
                    *(pg8::u32x4*)zp = pack8(acc[ai][0][m][0] * acc[ai][1][m][0], acc[ai][0][m][1] * acc[ai][1][m][1]);
                } else {
                    *(pg8::u32x4*)(CBG + row * 1024 + (t - 21) * 128 + cw) = pack8(acc[ai][0][m][0] * silu4(acc[ai][1][m][0]), acc[ai][0][m][1] * silu4(acc[ai][1][m][1]));
                }
            }
    }
};
template <bool HAS_TAIL> struct FEpiRes {
    static constexpr bool PERM = false, AFTER_DRAIN = false;
    const float* xl; const float* xc; float* outl; float* outc; const float* MODl;
    DEVI void operator()(const pg8::f32x4 (&acc)[2][2][4][2], const pg8::Unit& u, int wr, int wc, int fr, int fq) const {
        const int row0 = u.pm * 256 + wr * 64 + fr, col0 = u.pn * 256 + wc * 32 + 4 * fq;
        const bool lat = u.pm < NLAT / 256;
        const float* gate = MODl + (size_t)(lat ? (u.pm >> 4) : 4) * 3072 + 2048 + col0;
        pg8::f32x4 gv[2][2];
#pragma unroll
        for (int bj = 0; bj < 2; ++bj)
#pragma unroll
            for (int n = 0; n < 2; ++n) gv[bj][n] = *(const pg8::f32x4*)(gate + bj * 128 + n * 16);
        if (HAS_TAIL && !lat) {
            float* o = outc + (size_t)(u.k0 >> 8) * NCTX * 1024 - (size_t)NLAT * 1024;
#pragma unroll
            for (int ai = 0; ai < 2; ++ai)
#pragma unroll
                for (int m = 0; m < 4; ++m) { const size_t off = (size_t)(row0 + ai * 128 + m * 16) * 1024 + col0;
#pragma unroll
                    for (int bj = 0; bj < 2; ++bj)
#pragma unroll
                        for (int n = 0; n < 2; ++n) *(pg8::f32x4*)(o + off + bj * 128 + n * 16) = acc[ai][bj][m][n]; }
            return;
        }
        const float* xin = xl; float* o = outl;
#pragma unroll
        for (int ai = 0; ai < 2; ++ai)
#pragma unroll
            for (int m = 0; m < 4; ++m) { const size_t off = (size_t)(row0 + ai * 128 + m * 16) * 1024 + col0;
#pragma unroll
                for (int bj = 0; bj < 2; ++bj)
#pragma unroll
                    for (int n = 0; n < 2; ++n) { const pg8::f32x4 xv = *(const pg8::f32x4*)(xin + off + bj * 128 + n * 16); *(pg8::f32x4*)(o + off + bj * 128 + n * 16) = xv + gv[bj][n] * acc[ai][bj][m][n]; } }
    }
};
struct FEpi3 {
    static constexpr bool PERM = true, AFTER_DRAIN = false;
    bf16_t* XR; bf16_t* SG; float* XRC;
    DEVI void operator()(const pg8::f32x4 (&acc)[2][2][4][2], const pg8::Unit& u, int wr, int wc, int fr, int fq) const {
        const int t = u.pn, row0 = u.pm * 256 + wr * 64 + fr, cw = wc * 32 + 8 * fq;
        if (u.pm >= NLAT / 256) {
            float* sl = XRC + (size_t)(u.k0 >> 9) * NCTX * 2048;
#pragma unroll
            for (int ai = 0; ai < 2; ++ai)
#pragma unroll
                for (int m = 0; m < 4; ++m) { float* rp = sl + (size_t)(row0 - NLAT + ai * 128 + m * 16) * 2048 + t * 256 + cw;
#pragma unroll
                    for (int bj = 0; bj < 2; ++bj) { *(pg8::f32x4*)(rp + bj * 128) = acc[ai][bj][m][0]; *(pg8::f32x4*)(rp + bj * 128 + 4) = acc[ai][bj][m][1]; } }
            return;
        }
        bf16_t* base = t < 8 ? XR + (size_t)xr_pad_of_tile(u.pm) * 2048 + t * 256 : SG + (t - 8) * 256;
#pragma unroll
        for (int ai = 0; ai < 2; ++ai)
#pragma unroll
            for (int m = 0; m < 4; ++m) { bf16_t* rp = base + (size_t)(row0 + ai * 128 + m * 16) * 2048 + cw;
#pragma unroll
                for (int bj = 0; bj < 2; ++bj) { pg8::f32x4 v0 = acc[ai][bj][m][0], v1 = acc[ai][bj][m][1]; if (t >= 8) { v0 = silu4(v0); v1 = silu4(v1); }
                    *(pg8::u32x4*)(rp + bj * 128) = pack8(v0, v1); } }
    }
};

struct FEpiResRms {
    static constexpr bool PERM = false, AFTER_DRAIN = true;
    const float* xin; float* out; const float* MODl; const float* gfin; float* slots; unsigned* cnt;
    DEVI void fused(pg8::f32x4 (&acc)[2][2][4][2], const pg8::Unit& u, int wr, int wc, int fr, int fq, PG8_LAS unsigned char* lds, int wid, int lane) const {
        const int row0 = u.pm * 256 + wr * 64 + fr, col0 = u.pn * 256 + wc * 32 + 4 * fq;
        const float* gate = MODl + (size_t)(u.pm >> 4) * 3072 + 2048 + col0;
        PG8_LAS float* P = (PG8_LAS float*)lds;
        PG8_LAS float* S = (PG8_LAS float*)(lds + 8192);
        { pg8::f32x4 gv[2][2];
#pragma unroll
          for (int bj = 0; bj < 2; ++bj)
#pragma unroll
              for (int n = 0; n < 2; ++n) gv[bj][n] = *(const pg8::f32x4*)(gate + bj * 128 + n * 16);
#pragma unroll
          for (int ai = 0; ai < 2; ++ai)
#pragma unroll
              for (int m = 0; m < 4; ++m) { const float* xp = xin + (size_t)(row0 + ai * 128 + m * 16) * 1024 + col0;
#pragma unroll
                  for (int bj = 0; bj < 2; ++bj)
#pragma unroll
                      for (int n = 0; n < 2; ++n) { const pg8::f32x4 xv = *(const pg8::f32x4*)(xp + bj * 128 + n * 16); acc[ai][bj][m][n] = xv + gv[bj][n] * acc[ai][bj][m][n]; }
                  asm volatile("" : "+v"(acc[ai][0][m][0]), "+v"(acc[ai][0][m][1]), "+v"(acc[ai][1][m][0]), "+v"(acc[ai][1][m][1]));
                  if (m & 1) asm volatile("" ::: "memory"); } }
#pragma unroll
        for (int ai = 0; ai < 2; ++ai)
#pragma unroll
            for (int m = 0; m < 4; ++m) { float q = 0.f;
#pragma unroll
                for (int bj = 0; bj < 2; ++bj)
#pragma unroll
                    for (int n = 0; n < 2; ++n) { const pg8::f32x4 x = acc[ai][bj][m][n]; q += (x[0] * x[0] + x[1] * x[1]) + (x[2] * x[2] + x[3] * x[3]); }
                q += __shfl_xor(q, 16); q += __shfl_xor(q, 32);
                if (fq == 0) P[(ai * 128 + wr * 64 + m * 16 + fr) * 4 + wc] = q; }
        asm volatile("s_waitcnt lgkmcnt(0)" ::: "memory"); __builtin_amdgcn_s_barrier(); asm volatile("" ::: "memory");
        const int row = wid * 32 + (lane & 31);
        if (lane < 32) { const float t = (P[row * 4 + 0] + P[row * 4 + 1]) + (P[row * 4 + 2] + P[row * 4 + 3]);
            __hip_atomic_store(slots + ((size_t)(u.pm * 256 + row) * 4 + u.pn), t, __ATOMIC_RELAXED, __HIP_MEMORY_SCOPE_AGENT); }
        asm volatile("s_waitcnt vmcnt(0)" ::: "memory");
        if (lane == 0) __hip_atomic_fetch_add(cnt + 64 * u.pm, 1u, __ATOMIC_RELAXED, __HIP_MEMORY_SCOPE_AGENT);
        if (wid == 0) { unsigned sp = 0;
            while ((unsigned)__builtin_amdgcn_readfirstlane(__hip_atomic_load(cnt + 64 * u.pm, __ATOMIC_RELAXED, __HIP_MEMORY_SCOPE_AGENT)) < 32u) { __builtin_amdgcn_s_sleep(2); if (++sp > (1u << 22)) break; }
            __builtin_amdgcn_fence(__ATOMIC_ACQUIRE, "agent"); }
        asm volatile("s_waitcnt vmcnt(0) lgkmcnt(0)" ::: "memory"); __builtin_amdgcn_s_barrier(); asm volatile("" ::: "memory");
        if (lane < 32) { const float* sl = slots + (size_t)(u.pm * 256 + row) * 4; float t = 0.f;
#pragma unroll
            for (int k = 0; k < 4; ++k) t += __hip_atomic_load(sl + k, __ATOMIC_RELAXED, __HIP_MEMORY_SCOPE_AGENT);
            S[row] = rsqrtf(t * (1.f / 1024.f) + EPS); }
        asm volatile("s_waitcnt lgkmcnt(0)" ::: "memory"); __builtin_amdgcn_s_barrier(); asm volatile("" ::: "memory");
        pg8::f32x4 gf[2][2];
#pragma unroll
        for (int bj = 0; bj < 2; ++bj)
#pragma unroll
            for (int n = 0; n < 2; ++n) gf[bj][n] = *(const pg8::f32x4*)(gfin + col0 + bj * 128 + n * 16);
#pragma unroll
        for (int ai = 0; ai < 2; ++ai)
#pragma unroll
            for (int m = 0; m < 4; ++m) { const int r = ai * 128 + wr * 64 + m * 16 + fr; const float rinv = S[r]; const size_t off = (size_t)(u.pm * 256 + r) * 1024 + col0;
#pragma unroll
                for (int bj = 0; bj < 2; ++bj)
#pragma unroll
                    for (int n = 0; n < 2; ++n) *(pg8::f32x4*)(out + off + bj * 128 + n * 16) = acc[ai][bj][m][n] * rinv * gf[bj][n]; }
    }
    DEVI void operator()(const pg8::f32x4 (&)[2][2][4][2], const pg8::Unit&, int, int, int, int) const {}
};

struct FEpiResMod {
    static constexpr bool PERM = false, AFTER_DRAIN = true;
    const float* xin; float* x1; bf16_t* H1; const float* MOD0; const float* MOD1; const float* g1; float* slab; float* slots; unsigned* cnt;
    DEVI void operator()(const pg8::f32x4 (&acc)[2][2][4][2], const pg8::Unit& u, int wr, int wc, int fr, int fq) const {
        if (u.pm < NLAT / 256) return;
        const int row0 = u.pm * 256 + wr * 64 + fr, col0 = u.pn * 256 + wc * 32 + 4 * fq;
        float* o = slab + (size_t)(u.k0 >> 8) * NCTX * 1024 - (size_t)NLAT * 1024;
#pragma unroll
        for (int ai = 0; ai < 2; ++ai)
#pragma unroll
            for (int m = 0; m < 4; ++m) { const size_t off = (size_t)(row0 + ai * 128 + m * 16) * 1024 + col0;
#pragma unroll
                for (int bj = 0; bj < 2; ++bj)
#pragma unroll
                    for (int n = 0; n < 2; ++n) *(pg8::f32x4*)(o + off + bj * 128 + n * 16) = acc[ai][bj][m][n]; }
    }
    DEVI void fused(pg8::f32x4 (&acc)[2][2][4][2], const pg8::Unit& u, int wr, int wc, int fr, int fq, PG8_LAS unsigned char* lds, int wid, int lane) const {
        typedef unsigned u32x2v __attribute__((ext_vector_type(2)));
        const int row0 = u.pm * 256 + wr * 64 + fr, col0 = u.pn * 256 + wc * 32 + 4 * fq, b = u.pm >> 4;
        PG8_LAS float* P = (PG8_LAS float*)lds; PG8_LAS float* S = (PG8_LAS float*)(lds + 8192);
        { const float* gate = MOD0 + (size_t)b * 3072 + 2048 + col0; pg8::f32x4 gv[2][2];
#pragma unroll
          for (int bj = 0; bj < 2; ++bj)
#pragma unroll
              for (int n = 0; n < 2; ++n) gv[bj][n] = *(const pg8::f32x4*)(gate + bj * 128 + n * 16);
#pragma unroll
          for (int ai = 0; ai < 2; ++ai)
#pragma unroll
              for (int m = 0; m < 4; ++m) { const size_t off = (size_t)(row0 + ai * 128 + m * 16) * 1024 + col0;
#pragma unroll
                  for (int bj = 0; bj < 2; ++bj)
#pragma unroll
                      for (int n = 0; n < 2; ++n) { const pg8::f32x4 xv = *(const pg8::f32x4*)(xin + off + bj * 128 + n * 16); acc[ai][bj][m][n] = xv + gv[bj][n] * acc[ai][bj][m][n]; *(pg8::f32x4*)(x1 + off + bj * 128 + n * 16) = acc[ai][bj][m][n]; }
                  asm volatile("" : "+v"(acc[ai][0][m][0]), "+v"(acc[ai][0][m][1]), "+v"(acc[ai][1][m][0]), "+v"(acc[ai][1][m][1]));
                  if (m & 1) asm volatile("" ::: "memory"); } }
#pragma unroll
        for (int ai = 0; ai < 2; ++ai)
#pragma unroll
            for (int m = 0; m < 4; ++m) { float q = 0.f;
#pragma unroll
                for (int bj = 0; bj < 2; ++bj)
#pragma unroll
                    for (int n = 0; n < 2; ++n) { const pg8::f32x4 x = acc[ai][bj][m][n]; q += (x[0] * x[0] + x[1] * x[1]) + (x[2] * x[2] + x[3] * x[3]); }
                q += __shfl_xor(q, 16); q += __shfl_xor(q, 32);
                if (fq == 0) P[(ai * 128 + wr * 64 + m * 16 + fr) * 4 + wc] = q; }
        asm volatile("s_waitcnt lgkmcnt(0)" ::: "memory"); __builtin_amdgcn_s_barrier(); asm volatile("" ::: "memory");
        const int row = wid * 32 + (lane & 31);
        if (lane < 32) { const float t = (P[row * 4 + 0] + P[row * 4 + 1]) + (P[row * 4 + 2] + P[row * 4 + 3]);
            __hip_atomic_store(slots + ((size_t)(u.pm * 256 + row) * 4 + u.pn), t, __ATOMIC_RELAXED, __HIP_MEMORY_SCOPE_AGENT); }
        asm volatile("s_waitcnt vmcnt(0)" ::: "memory");
        if (lane == 0) __hip_atomic_fetch_add(cnt + 64 * u.pm, 1u, __ATOMIC_RELAXED, __HIP_MEMORY_SCOPE_AGENT);
        if (wid == 0) { unsigned sp = 0;
            while ((unsigned)__builtin_amdgcn_readfirstlane(__hip_atomic_load(cnt + 64 * u.pm, __ATOMIC_RELAXED, __HIP_MEMORY_SCOPE_AGENT)) < 32u) { __builtin_amdgcn_s_sleep(2); if (++sp > (1u << 22)) break; }
            __builtin_amdgcn_fence(__ATOMIC_ACQUIRE, "agent"); }
        asm volatile("s_waitcnt vmcnt(0) lgkmcnt(0)" ::: "memory"); __builtin_amdgcn_s_barrier(); asm volatile("" ::: "memory");
        if (lane < 32) { const float* sl = slots + (size_t)(u.pm * 256 + row) * 4; float t = 0.f;
#pragma unroll
            for (int k = 0; k < 4; ++k) t += __hip_atomic_load(sl + k, __ATOMIC_RELAXED, __HIP_MEMORY_SCOPE_AGENT);
            S[row] = rsqrtf(t * (1.f / 1024.f) + EPS); }
        asm volatile("s_waitcnt lgkmcnt(0)" ::: "memory"); __builtin_amdgcn_s_barrier(); asm volatile("" ::: "memory");
        const float* md = MOD1 + (size_t)b * 3072 + col0;
#pragma unroll
        for (int bj = 0; bj < 2; ++bj)
#pragma unroll
            for (int n = 0; n < 2; ++n) { const int co = bj * 128 + n * 16; const pg8::f32x4 gg = *(const pg8::f32x4*)(g1 + col0 + co), sh = *(const pg8::f32x4*)(md + co), sc = *(const pg8::f32x4*)(md + 1024 + co);
                const pg8::f32x4 mul = gg * (sc + 1.0f);
#pragma unroll
                for (int ai = 0; ai < 2; ++ai)
#pragma unroll
                    for (int m = 0; m < 4; ++m) { const int r = ai * 128 + wr * 64 + m * 16 + fr; const pg8::f32x4 hv = acc[ai][bj][m][n] * S[r] * mul + sh;
                        u32x2v w; w.x = pg8::cvt_pk_bf16(hv[0], hv[1]); w.y = pg8::cvt_pk_bf16(hv[2], hv[3]); *(u32x2v*)(H1 + (size_t)(u.pm * 256 + r) * 1024 + col0 + co) = w; } }
    }
};
#ifndef FAST_GEMM
#define FAST_GEMM 1
#endif


#define LASP __attribute__((address_space(3)))
__device__ void st_glawalk(const Params& p, int vb, int nvb, unsigned char* lds_, const bf16_t* QIN, const bf16_t* KET, const bf16_t* SC, const float* DEC, const bf16_t* VT, bf16_t* OF, bf16_t* OB) {
    typedef pg8::bf16x8 bx8; typedef pg8::f32x4 f4; typedef unsigned u32x2 __attribute__((ext_vector_type(2))); typedef pg8::u32x4 u4;
    LASP unsigned char* lds = (LASP unsigned char*)lds_;
    constexpr int QOFF = 0, KOFF = 17408, SOFF = KOFF + 18432, VOFF = SOFF + 9216, DOFF = VOFF + 4608, BUFSZ = 50176;
    const int tid = threadIdx.x, wid = __builtin_amdgcn_readfirstlane(tid >> 6), lane = tid & 63, c = lane & 15, g = lane >> 4;
    for (int it0 = vb; it0 < 256; it0 += nvb) {
        const int item = (nvb == 256) ? ((it0 & 7) * 32 + (it0 >> 3)) : it0;
        const int vs = item & 7, combo = item >> 3, d = combo & 1, h = (combo >> 1) & 3, bb = combo >> 3;
        LDS_BARRIER();
        if (wid >= 2) {
            const int lt = tid - 128;
            unsigned long long cst[8]; unsigned mult[8]; int doff[8];
#pragma unroll
            for (int j = 0; j < 8; ++j) { const int pp = lt + 384 * j;
                if (pp < 1024) { cst[j] = (unsigned long long)QIN + (pp >> 4) * 256 + (pp & 15) * 16; mult[j] = 16384u; doff[j] = QOFF + (pp >> 4) * 272 + (pp & 15) * 16; }
                else if (pp < 2048) { const int q = pp - 1024; cst[j] = (unsigned long long)KET + (q >> 3) * 128 + (q & 7) * 16; mult[j] = 16384u; doff[j] = KOFF + (q >> 3) * 144 + (q & 7) * 16; }
                else if (pp < 2560) { const int q = pp - 2048; cst[j] = (unsigned long long)SC + (q >> 3) * 128 + (q & 7) * 16; mult[j] = 8192u; doff[j] = SOFF + (q >> 3) * 144 + (q & 7) * 16; }
                else if (pp < 2816) { const int q = pp - 2560; cst[j] = (unsigned long long)VT + (vs * 32 + (q >> 3)) * 128 + (q & 7) * 16 - (unsigned long long)d * 16384; mult[j] = 16384u; doff[j] = VOFF + (q >> 3) * 144 + (q & 7) * 16; }
                else if (pp < 2848) { const int q = pp - 2816; cst[j] = (unsigned long long)DEC + q * 16; mult[j] = 512u; doff[j] = DOFF + q * 16; }
                else { cst[j] = (unsigned long long)DEC; mult[j] = 0u; doff[j] = -1; } }
            u4 r0[8], r1[8];
#define GW_LOAD(R, step) do { const int cc_ = d == 0 ? ((step) < 4 ? 64 + (step) : (step) - 4) : 67 - (step); const unsigned u_ = (unsigned)(((bb * NCH + cc_) * 4 + h) * 2 + d); \
                _Pragma("unroll") for (int j_ = 0; j_ < 8; ++j_) R[j_] = *(const u4*)(cst[j_] + (unsigned long long)u_ * mult[j_]); } while (0)
#define GW_WRITE(R, bufi) do { LASP unsigned char* b_ = lds + (bufi) * BUFSZ; _Pragma("unroll") for (int j_ = 0; j_ < 8; ++j_) if (doff[j_] >= 0) *(LASP u4*)(b_ + doff[j_]) = R[j_]; } while (0)
            GW_LOAD(r0, 0); GW_WRITE(r0, 0); GW_LOAD(r0, 1); GW_LOAD(r1, 2);
            LDS_BARRIER();
            for (int step = 0; step < NCH; step += 2) {
                GW_WRITE(r0, 1); if (step + 3 < NCH) GW_LOAD(r0, step + 3);
                LDS_BARRIER();
                if (step + 2 < NCH) { GW_WRITE(r1, 0); if (step + 4 < NCH) GW_LOAD(r1, step + 4); }
                LDS_BARRIER();
            }
#undef GW_LOAD
#undef GW_WRITE
        } else {
            f4 S[8];
#pragma unroll
            for (int m = 0; m < 8; ++m) S[m] = (f4){0.f, 0.f, 0.f, 0.f};
            bf16_t* O = d == 0 ? OF : OB;
            LDS_BARRIER();
            for (int step = 0; step < NCH; ++step) {
                const LASP unsigned char* B = lds + (step & 1) * BUFSZ;
#define SB0() __builtin_amdgcn_sched_barrier(0)
#define RDQ(dst_lo, dst_hi, ks) do { _Pragma("unroll") for (int mt = 0; mt < 4; ++mt) { const LASP unsigned char* qa = B + QOFF + (16 * mt + c) * 272 + (32 * (ks) + 4 * g) * 2; dst_lo[mt] = *(const LASP u32x2*)qa; dst_hi[mt] = *(const LASP u32x2*)(qa + 32); } } while (0)
#define MMQ(lo, hi, ks) do { _Pragma("unroll") for (int mt = 0; mt < 4; ++mt) { u4 w; w.x = lo[mt].x; w.y = lo[mt].y; w.z = hi[mt].x; w.w = hi[mt].y; o[mt] = __builtin_amdgcn_mfma_f32_16x16x32_bf16(sB[ks], __builtin_bit_cast(bx8, w), o[mt], 0, 0, 0); } } while (0)
#define RDK(kf, dv, m0) do { _Pragma("unroll") for (int mm = 0; mm < 4; ++mm) { const LASP unsigned char* ka = B + KOFF + (16 * ((m0) + mm) + c) * 144 + g * 16; kf[mm][0] = *(const LASP bx8*)ka; kf[mm][1] = *(const LASP bx8*)(ka + 64); dv[mm] = *(const LASP f4*)(B + DOFF + (16 * ((m0) + mm) + 4 * g) * 4); } } while (0)
#define MMK(kf, dv, m0) do { _Pragma("unroll") for (int mm = 0; mm < 4; ++mm) { S[(m0) + mm] = S[(m0) + mm] * dv[mm]; S[(m0) + mm] = __builtin_amdgcn_mfma_f32_16x16x32_bf16(kf[mm][0], bv0, S[(m0) + mm], 0, 0, 0); S[(m0) + mm] = __builtin_amdgcn_mfma_f32_16x16x32_bf16(kf[mm][1], bv1, S[(m0) + mm], 0, 0, 0); } } while (0)
                const bx8 bv0 = *(const LASP bx8*)(B + VOFF + (16 * wid + c) * 144 + g * 16), bv1 = *(const LASP bx8*)(B + VOFF + (16 * wid + c) * 144 + 64 + g * 16);
                u32x2 qa_lo[4], qa_hi[4], qb_lo[4], qb_hi[4];
                RDQ(qa_lo, qa_hi, 0); RDQ(qb_lo, qb_hi, 1);
                bx8 sB[4];
#pragma unroll
                for (int ks = 0; ks < 4; ++ks) { u4 w; w.x = pg8::cvt_pk_bf16(S[2 * ks][0], S[2 * ks][1]); w.y = pg8::cvt_pk_bf16(S[2 * ks][2], S[2 * ks][3]);
                    w.z = pg8::cvt_pk_bf16(S[2 * ks + 1][0], S[2 * ks + 1][1]); w.w = pg8::cvt_pk_bf16(S[2 * ks + 1][2], S[2 * ks + 1][3]); sB[ks] = __builtin_bit_cast(bx8, w); }
                f4 o[4];
#pragma unroll
                for (int mt = 0; mt < 4; ++mt) o[mt] = (f4){0.f, 0.f, 0.f, 0.f};
                SB0();
                MMQ(qa_lo, qa_hi, 0); SB0();
                RDQ(qa_lo, qa_hi, 2); SB0();
                MMQ(qb_lo, qb_hi, 1); SB0();
                RDQ(qb_lo, qb_hi, 3); SB0();
                MMQ(qa_lo, qa_hi, 2); SB0();
                bx8 sf[4][2];
#pragma unroll
                for (int mt = 0; mt < 4; ++mt) { const LASP unsigned char* sa = B + SOFF + (16 * mt + c) * 144 + g * 16; sf[mt][0] = *(const LASP bx8*)sa; sf[mt][1] = *(const LASP bx8*)(sa + 64); }
                SB0();
                MMQ(qb_lo, qb_hi, 3); SB0();
                bx8 kfa[4][2], kfb[4][2]; f4 dva[4], dvb[4];
                RDK(kfa, dva, 0); SB0();
#pragma unroll
                for (int mt = 0; mt < 4; ++mt) { o[mt] = __builtin_amdgcn_mfma_f32_16x16x32_bf16(bv0, sf[mt][0], o[mt], 0, 0, 0); o[mt] = __builtin_amdgcn_mfma_f32_16x16x32_bf16(bv1, sf[mt][1], o[mt], 0, 0, 0); }
                SB0();
                RDK(kfb, dvb, 4); SB0();
                MMK(kfa, dva, 0); SB0();
                MMK(kfb, dvb, 4); SB0();
#undef SB0
#undef RDQ
#undef MMQ
#undef RDK
#undef MMK
                const int cc = d == 0 ? (step < 4 ? 64 + step : step - 4) : 67 - step; const int row0 = row_of(bb, cc, 0);
#pragma unroll
                for (int mt = 0; mt < 4; ++mt) { u32x2 w; w.x = pg8::cvt_pk_bf16(o[mt][0], o[mt][1]); w.y = pg8::cvt_pk_bf16(o[mt][2], o[mt][3]);
                    *(u32x2*)(O + (size_t)(row0 + 16 * mt + c) * 1024 + h * 256 + vs * 32 + 16 * wid + 4 * g) = w; }
                LDS_BARRIER();
            }
        }
    }
}
#ifndef FAST_WALK
#define FAST_WALK 1
#endif

template <int MODE, int DIR>
__device__ __forceinline__ void st_rglru_impl(const Params& p, int vb, int nvb, unsigned char* lds_, const bf16_t* XR, const bf16_t* SG, const bf16_t* BD, float* SUMA, float* SUMH, bf16_t* Y) {
    typedef pg8::bf16x8 bx8; typedef pg8::f32x4 f4; typedef float f32x2v __attribute__((ext_vector_type(2)));
    LASP unsigned char* lds = (LASP unsigned char*)lds_;
    constexpr int AOFF = 0, FOFF = 17408, BUF = 51200, CWOFF = 2 * BUF;
    constexpr int ND = MODE == 0 ? 1 : 2, NCOMBO = MODE == 0 ? 32 : 16, NTILE = MODE == 0 ? NB * NCH : NB * 64;
    const int tid = threadIdx.x, wid = __builtin_amdgcn_readfirstlane(tid >> 6), lane = tid & 63, c = lane & 15, g = lane >> 4, cp = tid & 63, tg = tid >> 6;
    int P, part, cstep, combo0;
    if (nvb >= NCOMBO) { P = nvb / NCOMBO; part = vb / NCOMBO; cstep = NCOMBO; combo0 = vb % NCOMBO; if (part >= P) return; } else { P = 1; part = 0; cstep = nvb; combo0 = vb; }
    for (int combo = combo0; combo < NCOMBO; combo += cstep) {
        if (MODE == 0 && (combo & 1) != DIR) continue;
        const int nb = MODE == 0 ? (combo >> 1) : combo; constexpr int d0 = MODE == 0 ? DIR : 0;
        const int ch = nb * 128 + 16 * wid + c;
        bx8 wa[ND][4], wx[ND][4]; float ba[ND], bxx[ND], k8[ND];
        LDS_BARRIER();
#pragma unroll
        for (int dd = 0; dd < ND; ++dd) { constexpr int dzero = d0; const int d = dzero + dd;
            const bf16_t* wA = BD + ((size_t)(d * 16 + nb) * 128 + 16 * wid + c) * 128 + 8 * g; const bf16_t* wX = wA + (size_t)2 * 16 * 128 * 128;
#pragma unroll
            for (int ks = 0; ks < 4; ++ks) { wa[dd][ks] = *(const bx8*)(wA + 32 * ks); wx[dd][ks] = *(const bx8*)(wX + 32 * ks); }
            ba[dd] = p.o_b_a[d * 2048 + ch]; bxx[dd] = p.o_b_x[d * 2048 + ch]; k8[dd] = 8.f * 1.4426950408889634f * softplusf_(-p.o_lam[d * 2048 + ch]);
            if (tg < 5) { const f32x2v w2 = tg < 4 ? *(const f32x2v*)(p.o_conv_w + ((size_t)d * 4 + tg) * 2048 + nb * 128 + 2 * cp) : *(const f32x2v*)(p.o_conv_b + (size_t)d * 2048 + nb * 128 + 2 * cp);
                *(LASP f32x2v*)(lds + CWOFF + ((dd * 5 + tg) * 128 + 2 * cp) * 4) = w2; } }
        LDS_BARRIER();
        unsigned xr[14]; float cnext[2] = {0.f, 0.f};
#pragma unroll
        for (int jr = 0; jr < 14; ++jr) xr[jr] = 0u;
#define RG_PREF(tile) do { const int bb_ = MODE == 0 ? (tile) / NCH : (tile) >> 6, cc_ = MODE == 0 ? (tile) % NCH : (tile) & 63; const int row0_ = row_of(bb_, cc_, 0); \
            const bf16_t* xp_ = XR + (size_t)(row0_ + xr_pad_of_tile(row0_ >> 8) + 8 * tg - 3) * 2048 + nb * 128 + 2 * cp; \
            _Pragma("unroll") for (int jr = 0; jr < 14; ++jr) { if (MODE == 1 || (d0 == 0 ? jr < 11 : jr >= 3)) xr[jr] = *(const unsigned*)(xp_ + (size_t)jr * 2048); } \
            if (MODE == 1) { cnext[0] = SUMH[(((size_t)bb_ * 2 + 0) * NCH + cc_) * 2048 + ch]; cnext[1] = SUMH[(((size_t)bb_ * 2 + 1) * NCH + cc_) * 2048 + ch]; } } while (0)
        int it = 0;
        if (part < NTILE) RG_PREF(part);
        for (int tile = part; tile < NTILE; tile += P) {
            const int bb = MODE == 0 ? tile / NCH : tile >> 6, cc = MODE == 0 ? tile % NCH : tile & 63; const int row0 = row_of(bb, cc, 0);
            unsigned xcur[14]; float ccur[2];
#pragma unroll
            for (int jr = 0; jr < 14; ++jr) xcur[jr] = xr[jr];
            ccur[0] = cnext[0]; ccur[1] = cnext[1];
            if (tile + P < NTILE) RG_PREF(tile + P);
            float hsum[4][4];
#pragma unroll
            for (int dd = 0; dd < ND; ++dd) { constexpr int dzero = d0; const int d = dzero + dd;
                LASP unsigned char* B = lds + (it & 1) * BUF; ++it;
                { f32x2v cv[8]; const f32x2v cbv = *(const LASP f32x2v*)(lds + CWOFF + ((dd * 5 + 4) * 128 + 2 * cp) * 4);
#pragma unroll
                  for (int i = 0; i < 8; ++i) cv[i] = cbv;
#pragma unroll
                  for (int jj = 0; jj < 4; ++jj) { const f32x2v cwv = *(const LASP f32x2v*)(lds + CWOFF + ((dd * 5 + jj) * 128 + 2 * cp) * 4);
#pragma unroll
                      for (int i = 0; i < 8; ++i) { const int jr = d == 0 ? i + jj : i + 6 - jj; cv[i].x += cwv.x * __uint_as_float(xcur[jr] << 16); cv[i].y += cwv.y * __uint_as_float(xcur[jr] & 0xffff0000u); } }
#pragma unroll
                  for (int i = 0; i < 8; ++i) { const int rho = 16 * (2 * (tg & 1) + (i >> 2)) + 4 * (tg >> 1) + (i & 3);
                      *(LASP unsigned*)(B + AOFF + rho * 272 + 4 * cp) = pg8::cvt_pk_bf16(cv[i].x, cv[i].y); *(LASP f32x2v*)(B + FOFF + rho * 528 + 8 * cp) = cv[i]; } }
                LDS_BARRIER();
                const int gl = d == 0 ? g : 3 - g;
                const int src1 = d == 0 ? lane - 16 : lane + 16, src2 = d == 0 ? lane - 32 : lane + 32, srcT = d == 0 ? 48 + c : c;
                const size_t sidx = (((size_t)bb * 2 + d) * NCH + cc) * 2048 + ch;
                float av[16], uv[16]; float pa = 1.f, lh = 0.f;
#pragma unroll
                for (int mtl = 0; mtl < 4; ++mtl) { const int mt = d == 0 ? mtl : 3 - mtl;
                    f4 aam = (f4){0.f, 0.f, 0.f, 0.f}, axm = (f4){0.f, 0.f, 0.f, 0.f};
#pragma unroll
                    for (int ks = 0; ks < 4; ++ks) { const bx8 af = *(const LASP bx8*)(B + AOFF + (16 * mt + c) * 272 + (32 * ks + 8 * g) * 2);
                        aam = __builtin_amdgcn_mfma_f32_16x16x32_bf16(af, wa[dd][ks], aam, 0, 0, 0); axm = __builtin_amdgcn_mfma_f32_16x16x32_bf16(af, wx[dd][ks], axm, 0, 0, 0); }
#pragma unroll
                    for (int sq = 0; sq < 4; ++sq) { const int r = d == 0 ? sq : 3 - sq;
                        const float xv = *(const LASP float*)(B + FOFF + (16 * mt + 4 * g + r) * 528 + (16 * wid + c) * 4);
                        const float rr = sigmoidf_(aam[r] + ba[dd]), ii = sigmoidf_(axm[r] + bxx[dd]);
                        const float a = fexp2_(-k8[dd] * rr), u = __builtin_amdgcn_sqrtf(fmaxf(1.f - a * a, 0.f)) * (ii * xv);
                        lh = a * lh + u; pa *= a; if (MODE == 1) { av[mt * 4 + r] = a; uv[mt * 4 + r] = u; } }
                }
                float XA = pa, XU = lh, tA, tU;
                tA = __shfl(XA, src1); tU = __shfl(XU, src1); if (gl >= 1) { XU = tU * XA + XU; XA = tA * XA; }
                tA = __shfl(XA, src2); tU = __shfl(XU, src2); if (gl >= 2) { XU = tU * XA + XU; XA = tA * XA; }
                if (MODE == 0) { if (gl == 3) { SUMA[sidx] = XA; SUMH[sidx] = XU; } }
                else {
                    float eA = __shfl(XA, src1), eU = __shfl(XU, src1); if (gl == 0) { eA = 1.f; eU = 0.f; }
                    float hh = ccur[dd] * eA + eU;
#pragma unroll
                    for (int mtl = 0; mtl < 4; ++mtl) { const int mt = d == 0 ? mtl : 3 - mtl;
#pragma unroll
                        for (int sq = 0; sq < 4; ++sq) { const int r = d == 0 ? sq : 3 - sq; hh = av[mt * 4 + r] * hh + uv[mt * 4 + r]; if (dd == 0) hsum[mt][r] = hh; else hsum[mt][r] += hh; } }
                }
            }
            if (MODE == 1) {
#pragma unroll
                for (int mt = 0; mt < 4; ++mt)
#pragma unroll
                    for (int r = 0; r < 4; ++r) { const size_t o = (size_t)(row0 + 16 * g + 4 * mt + r) * 2048 + ch; Y[o] = f2bf(hsum[mt][r] * bf2f(SG[o])); }
            }
        }
        LDS_BARRIER();
#undef RG_PREF
    }
}
template <int MODE>
__device__ __forceinline__ void st_rglru(const Params& p, int vb, int nvb, unsigned char* lds_, const bf16_t* XR, const bf16_t* SG, const bf16_t* BD, float* SUMA, float* SUMH, bf16_t* Y) {
    if (MODE == 1) { st_rglru_impl<1, 0>(p, vb, nvb, lds_, XR, SG, BD, SUMA, SUMH, Y); return; }
    const int combo0 = nvb >= 32 ? vb % 32 : vb;
    if (nvb >= 32) { if ((combo0 & 1) == 0) st_rglru_impl<0, 0>(p, vb, nvb, lds_, XR, SG, BD, SUMA, SUMH, Y); else st_rglru_impl<0, 1>(p, vb, nvb, lds_, XR, SG, BD, SUMA, SUMH, Y); }
    else { st_rglru_impl<0, 0>(p, vb, nvb, lds_, XR, SG, BD, SUMA, SUMH, Y); st_rglru_impl<0, 1>(p, vb, nvb, lds_, XR, SG, BD, SUMA, SUMH, Y); }
}
#ifndef FAST_RG
#define FAST_RG 1
#endif


#define RG_CH(dd, step) ((dd) == 0 ? ((step) < 4 ? 64 + (step) : (step) - 4) : 67 - (step))
constexpr int RG_ABUF = 2 * 17408, RG_CWOFF = 2 * RG_ABUF;
__device__ __forceinline__ void rg1p_producer(const Params& p, LASP unsigned char* lds, const bf16_t* XR, int bb, int nb, int pw) {
    typedef float f32x2v __attribute__((ext_vector_type(2)));
    const int lane = threadIdx.x & 63, cp = lane;
    unsigned xr[38];
#define RG_PREF(step) do { _Pragma("unroll") for (int dd = 0; dd < 2; ++dd) { const int row0_ = row_of(bb, RG_CH(dd, step), 0); \
            const unsigned char* ub_ = (const unsigned char*)(XR + (size_t)(row0_ + xr_pad_of_tile(row0_ >> 8) + 16 * pw - 3 + 3 * dd) * 2048 + nb * 128);     \
            _Pragma("unroll") for (int j = 0; j < 19; ++j) xr[dd * 19 + j] = *(const unsigned*)(ub_ + (size_t)j * 4096 + (unsigned)(4 * cp)); } } while (0)
#define RG_CONV(bufi) do { _Pragma("unroll") for (int dd = 0; dd < 2; ++dd) { \
            f32x2v cw4[4]; const f32x2v cbv = *(const LASP f32x2v*)(lds + RG_CWOFF + ((dd * 5 + 4) * 128 + 2 * cp) * 4); \
            _Pragma("unroll") for (int jj = 0; jj < 4; ++jj) cw4[jj] = *(const LASP f32x2v*)(lds + RG_CWOFF + ((dd * 5 + jj) * 128 + 2 * cp) * 4); \
            _Pragma("unroll") for (int hq = 0; hq < 2; ++hq) { f32x2v cv[8]; \
                _Pragma("unroll") for (int i = 0; i < 8; ++i) cv[i] = cbv; \
                _Pragma("unroll") for (int jx = 0; jx < 11; ++jx) { const unsigned xw = xr[dd * 19 + 8 * hq + jx]; const f32x2v xv2 = (f32x2v){__uint_as_float(xw << 16), __uint_as_float(xw & 0xffff0000u)}; \
                    _Pragma("unroll") for (int jj = 0; jj < 4; ++jj) { const int i = dd == 0 ? jx - jj : jx - 3 + jj; if (i >= 0 && i < 8) cv[i] = __builtin_elementwise_fma(cw4[jj], xv2, cv[i]); } } \
                _Pragma("unroll") for (int i = 0; i < 8; ++i) { const int t = 16 * pw + 8 * hq + i, rho = 16 * ((t >> 2) & 3) + 4 * (t >> 4) + (t & 3); \
                    *(LASP unsigned*)(lds + (bufi) * RG_ABUF + dd * 17408 + rho * 272 + 4 * cp) = pg8::cvt_pk_bf16(cv[i].x, cv[i].y); } } } } while (0)
    RG_PREF(0);
    RG_CONV(0);
    RG_PREF(1);
    LDS_BARRIER();
    for (int step = 0; step < NCH; ++step) {
        if (step + 1 < NCH) { RG_CONV((step + 1) & 1); if (step + 2 < NCH) RG_PREF(step + 2); }
        LDS_BARRIER();
    }
#undef RG_PREF
#undef RG_CONV
}
template <int WD>
__device__ __forceinline__ void rg1p_consumer(const Params& p, LASP unsigned char* lds, bf16_t* SGY, bf16_t* HXh, const bf16_t* BD, int bb, int nb, int sl, int nt) {
    typedef pg8::bf16x8 bx8; typedef pg8::f32x4 f4;
    const int lane = threadIdx.x & 63, c = lane & 15, g = lane >> 4;
    const int jch = sl * 32 + nt * 16 + c, ch = nb * 128 + jch;
    bx8 wa[4], wx[4];
    { const bf16_t* wA = BD + ((size_t)(WD * 16 + nb) * 128 + jch) * 128 + 8 * g; const bf16_t* wX = wA + (size_t)2 * 16 * 128 * 128;
#pragma unroll
      for (int ks = 0; ks < 4; ++ks) { wa[ks] = *(const bx8*)(wA + 32 * ks); wx[ks] = *(const bx8*)(wX + 32 * ks); } }
    const float ba = p.o_b_a[WD * 2048 + ch], bxx = p.o_b_x[WD * 2048 + ch], k8 = 8.f * 1.4426950408889634f * softplusf_(-p.o_lam[WD * 2048 + ch]);
    float carry = 0.f;
    const int gl = WD == 0 ? g : 3 - g;
    const int src1 = WD == 0 ? lane - 16 : lane + 16, src2 = WD == 0 ? lane - 32 : lane + 32, srcT = WD == 0 ? 48 + c : c;
    LDS_BARRIER();
    for (int step = 0; step < NCH; ++step) {
        const int cc = RG_CH(WD, step); const bool latent = cc < 64, second = step - 4 > 31;
        const int row0u = row_of(bb, cc, 0);
        const unsigned hoff = (unsigned)(16 * g) * 1024u + (unsigned)(ch & 1023), soff = (unsigned)(16 * g) * 2048u + (unsigned)ch;
        unsigned short hxv[16], sgv[16];
        if (latent && second) {
#pragma unroll
            for (int e = 0; e < 16; ++e) { const bf16_t* hb_ = HXh + (size_t)(row0u + e) * 1024; const bf16_t* sb_ = SGY + (size_t)(row0u + e) * 2048; hxv[e] = hb_[hoff]; sgv[e] = sb_[soff]; } }
        const LASP unsigned char* A = lds + (step & 1) * RG_ABUF + WD * 17408;
        float av[16], uv[16]; float pa = 1.f, lh = 0.f;
#pragma unroll
        for (int ml = 0; ml < 4; ++ml) { const int mt = WD == 0 ? ml : 3 - ml;
            f4 aam = (f4){0.f, 0.f, 0.f, 0.f}, axm = (f4){0.f, 0.f, 0.f, 0.f};
#pragma unroll
            for (int ks = 0; ks < 4; ++ks) { const bx8 af = *(const LASP bx8*)(A + (16 * mt + c) * 272 + (32 * ks + 8 * g) * 2);
                aam = __builtin_amdgcn_mfma_f32_16x16x32_bf16(af, wa[ks], aam, 0, 0, 0); axm = __builtin_amdgcn_mfma_f32_16x16x32_bf16(af, wx[ks], axm, 0, 0, 0); }
            typedef float f2 __attribute__((ext_vector_type(2)));
            float am[4], um[4];
#pragma unroll
            for (int hp = 0; hp < 2; ++hp) {
                const f2 xv2 = (f2){bf2f(*(const LASP unsigned short*)(A + (16 * mt + 4 * g + 2 * hp) * 272 + jch * 2)), bf2f(*(const LASP unsigned short*)(A + (16 * mt + 4 * g + 2 * hp + 1) * 272 + jch * 2))};
                const f2 ta = ((f2){aam[2 * hp], aam[2 * hp + 1]} + ba) * (-1.4426950408889634f), tx = ((f2){axm[2 * hp], axm[2 * hp + 1]} + bxx) * (-1.4426950408889634f);
                const f2 pa1 = (f2){fexp2_(ta.x), fexp2_(ta.y)} + 1.0f, px1 = (f2){fexp2_(tx.x), fexp2_(tx.y)} + 1.0f;
                const f2 rr = (f2){frcp_(pa1.x), frcp_(pa1.y)}, ii = (f2){frcp_(px1.x), frcp_(px1.y)};
                const f2 tk = rr * (-k8); const f2 a2 = (f2){fexp2_(tk.x), fexp2_(tk.y)};
                f2 q = __builtin_elementwise_fma(-a2, a2, (f2){1.0f, 1.0f}); q = __builtin_elementwise_max(q, (f2){0.f, 0.f});
                const f2 u2 = (f2){__builtin_amdgcn_sqrtf(q.x), __builtin_amdgcn_sqrtf(q.y)} * (ii * xv2);
                am[2 * hp] = a2.x; am[2 * hp + 1] = a2.y; um[2 * hp] = u2.x; um[2 * hp + 1] = u2.y; }
#pragma unroll
            for (int sq = 0; sq < 4; ++sq) { const int r = WD == 0 ? sq : 3 - sq; lh = am[r] * lh + um[r]; pa *= am[r]; av[mt * 4 + r] = am[r]; uv[mt * 4 + r] = um[r]; }
        }
        float XA = pa, XU = lh, tA, tU;
        tA = __shfl(XA, src1); tU = __shfl(XU, src1); if (gl >= 1) { XU = tU * XA + XU; XA = tA * XA; }
        tA = __shfl(XA, src2); tU = __shfl(XU, src2); if (gl >= 2) { XU = tU * XA + XU; XA = tA * XA; }
        float eA = __shfl(XA, src1), eU = __shfl(XU, src1); if (gl == 0) { eA = 1.f; eU = 0.f; }
        const float totA = __shfl(XA, srcT), totU = __shfl(XU, srcT);
        if (latent) {
            float hh = carry * eA + eU; float hv[16];
#pragma unroll
            for (int ml = 0; ml < 4; ++ml) { const int mt = WD == 0 ? ml : 3 - ml;
#pragma unroll
                for (int sq = 0; sq < 4; ++sq) { const int r = WD == 0 ? sq : 3 - sq; const int e = mt * 4 + r; hh = av[e] * hh + uv[e]; hv[e] = hh; } }
            if (!second) {
#pragma unroll
                for (int e = 0; e < 16; ++e) { bf16_t* hb_ = HXh + (size_t)(row0u + e) * 1024; hb_[hoff] = (bf16_t)(pg8::cvt_pk_bf16(hv[e], 0.f) & 0xffffu); } }
            else {
#pragma unroll
                for (int e = 0; e < 16; ++e) { bf16_t* sb_ = SGY + (size_t)(row0u + e) * 2048; sb_[soff] = (bf16_t)(pg8::cvt_pk_bf16((__uint_as_float(pg8::cvt_pk_bf16(hv[e], 0.f) << 16) + bf2f(hxv[e])) * bf2f(sgv[e]), 0.f) & 0xffffu); } }
        }
        carry = carry * totA + totU;
        if (step == 35) asm volatile("s_waitcnt vmcnt(0)" ::: "memory");
        LDS_BARRIER();
    }
}
__device__ __forceinline__ void st_rg1p(const Params& p, int vb, int nvb, unsigned char* lds_, const bf16_t* XR, bf16_t* SGY, bf16_t* HX0, bf16_t* HX1, const bf16_t* BD, const float* XRC) {
    typedef float f32x2v __attribute__((ext_vector_type(2)));
    LASP unsigned char* lds = (LASP unsigned char*)lds_;
    const int wid = __builtin_amdgcn_readfirstlane(threadIdx.x >> 6), lane = threadIdx.x & 63;
    for (int it0 = vb; it0 < 256; it0 += nvb) {
        const int item = (nvb == 256) ? ((it0 & 7) * 32 + (it0 >> 3)) : it0;
        const int sl = item & 3, nb = (item >> 2) & 15, bb = item >> 6;
        bf16_t* HXh = nb < 8 ? HX0 : HX1;
        {
          bf16_t* xd = (bf16_t*)XR + (size_t)(NLAT + bb * 256 + 20 + 4 * bb) * 2048 + nb * 128; const float* xs = XRC + (size_t)(bb * 256) * 2048 + nb * 128;
          for (int e = threadIdx.x; e < 256 * 64; e += NTHREADS) { const int r = e >> 6, cpair = e & 63; const float2 v0 = *(const float2*)(xs + (size_t)r * 2048 + 2 * cpair), v1 = *(const float2*)(xs + (size_t)NCTX * 2048 + (size_t)r * 2048 + 2 * cpair); *(unsigned*)(xd + (size_t)r * 2048 + 2 * cpair) = pg8::cvt_pk_bf16(v0.x + v1.x, v0.y + v1.y); }
#pragma unroll
          for (int dd = 0; dd < 2; ++dd)
              if (wid < 5) { const f32x2v w2 = wid < 4 ? *(const f32x2v*)(p.o_conv_w + ((size_t)dd * 4 + wid) * 2048 + nb * 128 + 2 * lane) : *(const f32x2v*)(p.o_conv_b + (size_t)dd * 2048 + nb * 128 + 2 * lane);
                  *(LASP f32x2v*)(lds + RG_CWOFF + ((dd * 5 + wid) * 128 + 2 * lane) * 4) = w2; }
          asm volatile("s_waitcnt vmcnt(0)" ::: "memory"); LDS_BARRIER(); }
        if (wid >= 4) rg1p_producer(p, lds, XR, bb, nb, wid - 4);
        else if (wid < 2) rg1p_consumer<0>(p, lds, SGY, HXh, BD, bb, nb, sl, wid & 1);
        else rg1p_consumer<1>(p, lds, SGY, HXh, BD, bb, nb, sl, wid & 1);
    }
}
#define XB_TMO      128
#define XB_XCNT(j)  (256  + 64 * (j))
#define XB_XSUB(j)  (1280 + 64 * (j))
#define XB_XGEN(j)  (2304 + 64 * (j))
#define XB_TOP      3328
#define XB_TOPGEN   3392
#define XB_SPIN_CAP (1u << 20)
DEVI unsigned xb_ld(unsigned* p)              { return __hip_atomic_load(p, __ATOMIC_RELAXED, __HIP_MEMORY_SCOPE_AGENT); }
DEVI unsigned xb_add(unsigned* p, unsigned v) { return __hip_atomic_fetch_add(p, v, __ATOMIC_RELAXED, __HIP_MEMORY_SCOPE_AGENT); }
DEVI unsigned xb_xcc_id() { return (unsigned)__builtin_amdgcn_s_getreg((3 << 11) | 20) & 0xFu; }
#define XB_SPIN(cond, bar) do { unsigned _sp = 0; while (cond) { __builtin_amdgcn_s_sleep(1); \
    if ((++_sp & 255u) == 0u) { if (xb_ld(&(bar)[XB_TMO])) break; if (_sp > XB_SPIN_CAP) { atomicAdd(&(bar)[XB_TMO], 1u); break; } } } } while (0)
struct XcdBarrier { unsigned* bar; unsigned x; volatile __attribute__((address_space(3))) unsigned* st; };
DEVI XcdBarrier xcd_barrier_post(unsigned* bar, volatile __attribute__((address_space(3))) unsigned* st) {
    XcdBarrier b; b.bar = bar; b.x = xb_xcc_id(); b.st = st;
    if (threadIdx.x == 0) (void)xb_add(&bar[XB_XCNT(b.x)], 1u);
    return b;
}
DEVI void xcd_barrier_complete(unsigned* bar, unsigned x, unsigned& nloc, unsigned& nx) {
    const unsigned G = gridDim.x * gridDim.y * gridDim.z;
    unsigned sum, cnt, mine, sp = 0u;
    for (;;) {
        sum = 0u; cnt = 0u; mine = 0u;
#pragma unroll
        for (unsigned j = 0; j < 16; ++j) { const unsigned c = xb_ld(&bar[XB_XCNT(j)]); sum += c; cnt += (c > 0u) ? 1u : 0u; mine = (j == x) ? c : mine; }
        if (sum == G) break;
        __builtin_amdgcn_s_sleep(1);
        if ((++sp & 255u) == 0u) { if (xb_ld(&bar[XB_TMO])) break; if (sp > XB_SPIN_CAP) { atomicAdd(&bar[XB_TMO], 1u); break; } }
    }
    nloc = mine > 0u ? mine : 1u; nx = cnt > 0u ? cnt : 1u;
}
DEVI void xcd_barrier(const XcdBarrier& b) {
    asm volatile("s_waitcnt vmcnt(0)" ::: "memory");
    __syncthreads();
    if (threadIdx.x == 0) {
        unsigned* bar = b.bar;
        __builtin_amdgcn_s_waitcnt(0);
        unsigned nloc = b.st[0], nx = b.st[1];
        if (nloc == 0u) { xcd_barrier_complete(bar, b.x, nloc, nx); b.st[0] = nloc; b.st[1] = nx; }
        const unsigned old = xb_add(&bar[XB_XSUB(b.x)], 1u);
        const unsigned gen = old / nloc;
        if (old + 1u == (gen + 1u) * nloc) {
            __builtin_amdgcn_fence(__ATOMIC_RELEASE, "agent");
            asm volatile("s_waitcnt vmcnt(0)" ::: "memory");
            const unsigned og = xb_add(&bar[XB_TOP], 1u);
            const unsigned tg = og / nx;
            if (og + 1u == (tg + 1u) * nx) xb_add(&bar[XB_TOPGEN], 1u);
            else XB_SPIN(xb_ld(&bar[XB_TOPGEN]) == tg, bar);
            __builtin_amdgcn_fence(__ATOMIC_ACQUIRE, "agent");
            xb_add(&bar[XB_XGEN(b.x)], 1u);
            asm volatile("s_waitcnt vmcnt(0)" ::: "memory");
        } else {
            XB_SPIN(xb_ld(&bar[XB_XGEN(b.x)]) == gen, bar);
            __builtin_amdgcn_fence(__ATOMIC_ACQUIRE, "agent");
            asm volatile("s_waitcnt vmcnt(0)" ::: "memory");
        }
    }
    __syncthreads();
}
__device__ __forceinline__ void run_stage(const Params& p, int st, int vb, int nvb, unsigned char* lds) {
    unsigned char* ws = p.ws;
    float* MOD = (float*)(ws + WS_MOD); float* ALR = (float*)(ws + WS_ALR); float* X1C = (float*)(ws + WS_X1C);
    float* SUMA = (float*)(ws + WS_SUMA); float* SUMH = (float*)(ws + WS_SUMH); float* DEC = (float*)(ws + WS_DEC);
    bf16_t* Bt1 = (bf16_t*)(ws + WS_BT1); bf16_t* Bt2 = (bf16_t*)(ws + WS_BT2); bf16_t* Bt3 = (bf16_t*)(ws + WS_BT3); bf16_t* Bt4 = (bf16_t*)(ws + WS_BT4);
    bf16_t* S0 = (bf16_t*)(ws + WS_SLOT(0)); bf16_t* S1 = (bf16_t*)(ws + WS_SLOT(1)); bf16_t* S2 = (bf16_t*)(ws + WS_SLOT(2));
    bf16_t* S3 = (bf16_t*)(ws + WS_SLOT(3)); bf16_t* S4 = (bf16_t*)(ws + WS_SLOT(4)); bf16_t* S5 = (bf16_t*)(ws + WS_SLOT(5));
    bf16_t* DO0 = (bf16_t*)p.out; bf16_t* DOSC = (bf16_t*)((unsigned char*)p.out + 34 * MiB); bf16_t* DOZA = (bf16_t*)((unsigned char*)p.out + 51 * MiB);
    float* XRC = (float*)(ws + WS_BT1);
    float* SLAB2 = (float*)(ws + WS_SLOT(5) + 262144);
    switch (st) {
    case 0: st_mod(p, vb, nvb, (float*)lds); st_wprep(p, vb, nvb, lds); break;
    case 1: st_modulate(p, vb, nvb, 0, p.x, p.ctx, S0); break;
    case 3: st_glaprep(p, vb, nvb, lds, S1, S2, ALR, S3, S4, DOSC, DEC, S5); break;
#if FAST_WALK
    case 4: st_glawalk(p, vb, nvb, lds, S3, S4, DOSC, DEC, S5, S2, DO0); break;
#else
    case 4: st_glawalk_naive(p, vb, nvb, (float*)lds, S3, S4, DOSC, DEC, S5, S2, DO0); break;
#endif
    case 6: st_inner(p, vb, nvb, S2, DO0, S3, S4, S5, S0, DOZA, X1C); break;
    case 8: st_modulate(p, vb, nvb, 1, p.out, p.ctx, S2, SLAB2, 8, MOD + 4 * 3072 + 2048, nvb == 256 ? NLAT : 0);
            {
              for (int e = vb * NTHREADS + threadIdx.x; e < 9 * 4 * 256; e += nvb * NTHREADS) { const int gi = e >> 10, w = e & 1023; const int r0 = gi < 4 ? 4096 * gi + 4 * gi : (gi < 8 ? NLAT + 16 + 256 * (gi - 4) + 4 * (gi - 4) : NT + 32);
                  *(uint4*)(S3 + (size_t)r0 * 2048 + w * 8) = uint4{0u, 0u, 0u, 0u}; } }
            break;
    case 10: st_rg1p(p, vb, nvb, lds, S3, S0, S2, S5 + 131072, (const bf16_t*)(ws + WS_BD), XRC); break;
    case 14: if (nvb != 256) st_final(p, vb, nvb); break;
#if FAST_GEMM
    case 2: { FEpi1 E{S1, S2, S3, S4, S5, ALR, DOZA}; pg8::Gemm g{S0, Bt1, NT, N1, 1024}; pg8::TileOrder S; S.init(NT / 256, 11, 16, nvb, vb, 0, 8, 0, 12);
              pg8::gemm_phase<FEpi1, pg8::TileOrder, true, true>((PG8_LAS unsigned char*)lds, g, S, E); } break;
    case 5: { FEpi1 E{S1, S2, S3, S4, S5, ALR, DOZA}; pg8::Gemm g{S0, Bt1, NT, N1, 1024}; pg8::TileOrder S; S.init(NT / 256, 18, 16, nvb, vb, 0, 4, 8, 15);
              pg8::gemm_phase<FEpi1, pg8::TileOrder, true, true>((PG8_LAS unsigned char*)lds, g, S, E); } break;
    case 7: if (nvb == 256) { FEpiResMod E{p.x, p.out, S2, MOD, MOD + 5 * 3072, p.norm_g + 1024, SLAB2, (float*)(ws + WS_CTL + 131072 + 262144), (unsigned*)(ws + WS_CTL + 65536 + 16384)};
                  pg8::Gemm g{S0, Bt2, NT, 1024, 2048}; pg8::TileOrder S; S.init(NLAT / 256, 4, 32, nvb, vb, 0, 1 << 30, 0, 0, NCTX / 256, 4, NLAT / 256, 8, 4); S.tail_first = 1;
                  pg8::gemm_phase<FEpiResMod, pg8::TileOrder, false, true>((PG8_LAS unsigned char*)lds, g, S, E); }
            else { FEpiRes<true> E{p.x, p.ctx, p.out, SLAB2, MOD}; pg8::Gemm g{S0, Bt2, NT, 1024, 2048}; pg8::TileOrder S; S.init(NLAT / 256, 4, 32, nvb, vb, 0, 1 << 30, 0, 0, NCTX / 256, 4, NLAT / 256, 8, 4);
                  pg8::gemm_phase<FEpiRes<true>, pg8::TileOrder, true, true>((PG8_LAS unsigned char*)lds, g, S, E); } break;
    case 9: { FEpi3 E{S3, S0, XRC}; pg8::Gemm g{S2, Bt3, NT, 4096, 1024}; pg8::TileOrder S; S.init(NLAT / 256, 16, 16, nvb, vb, 0, 1 << 30, 0, 0, NCTX / 256, 8, NLAT / 256, 2, 8);
              pg8::gemm_phase<FEpi3, pg8::TileOrder, true, true>((PG8_LAS unsigned char*)lds, g, S, E); } break;
    case 13: if (nvb == 256) { FEpiResRms E{p.out, p.out, MOD + 5 * 3072, p.final_g, (float*)(ws + WS_CTL + 131072), (unsigned*)(ws + WS_CTL + 65536)}; pg8::Gemm g{S0, Bt4, NLAT, 1024, 2048}; pg8::TileOrder S; S.init(NLAT / 256, 4, 32, nvb, vb);
                  pg8::gemm_phase<FEpiResRms, pg8::TileOrder, false, true>((PG8_LAS unsigned char*)lds, g, S, E); }
             else { FEpiRes<false> E{p.out, nullptr, p.out, nullptr, MOD + 5 * 3072}; pg8::Gemm g{S0, Bt4, NLAT, 1024, 2048}; pg8::TileOrder S; S.init(NLAT / 256, 4, 32, nvb, vb);
                  pg8::gemm_phase<FEpiRes<false>, pg8::TileOrder, true, true>((PG8_LAS unsigned char*)lds, g, S, E); } break;
#else
    case 2: { Epi1 E{S1, S2, S3, S4, S5, ALR}; st_gemm_naive(vb, nvb, (float*)lds, S0, Bt1, 0, NT / 32, 0, 8, 1024, E); st_gemm_naive(vb, nvb, (float*)lds, S0, Bt1, 0, NT / 32, 12, 13, 1024, E); } break;
    case 5: { Epi1 E{S1, S2, S3, S4, S5, ALR}; st_gemm_naive(vb, nvb, (float*)lds, S0, Bt1, 0, NT / 32, 8, 12, 1024, E); st_gemm_naive(vb, nvb, (float*)lds, S0, Bt1, 0, NT / 32, 13, 29, 1024, E); } break;
    case 7: { EpiRes E{p.x, p.ctx, p.out, X1C, MOD}; st_gemm_naive(vb, nvb, (float*)lds, S0, Bt2, 0, NT / 32, 0, 4, 2048, E); } break;
    case 9: { Epi3 E{S3, S0}; st_gemm_naive(vb, nvb, (float*)lds, S2, Bt3, 0, NLAT / 32, 0, 16, 1024, E); st_gemm_naive(vb, nvb, (float*)lds, S2, Bt3, NLAT / 32, NT / 32, 0, 8, 1024, E); } break;
    case 13: { EpiRes E{p.out, nullptr, p.out, nullptr, MOD + 5 * 3072}; st_gemm_naive(vb, nvb, (float*)lds, S0, Bt4, 0, NLAT / 32, 0, 4, 2048, E); } break;
#endif
    }
}
constexpr int NSTAGES = 15;
constexpr int LDS_BYTES = 147456;

#ifndef ONE_LAUNCH
#define ONE_LAUNCH 1
#endif
#if !ONE_LAUNCH
__global__ void __launch_bounds__(NTHREADS) k_mega(Params p, int st) {
    extern __shared__ __attribute__((aligned(16))) unsigned char lds[];
    run_stage(p, st, blockIdx.x, gridDim.x, lds);
}
#else
__global__ void __launch_bounds__(NTHREADS) k_mega(Params p) {
    extern __shared__ __attribute__((aligned(16))) unsigned char lds[];
    volatile __attribute__((address_space(3))) unsigned* st = (volatile __attribute__((address_space(3))) unsigned*)((__attribute__((address_space(3))) unsigned char*)lds + (LDS_BYTES - 64));
    if (threadIdx.x < 2) st[threadIdx.x] = 0u;
    __syncthreads();
    const XcdBarrier bar = xcd_barrier_post((unsigned*)(p.ws + WS_CTL) + 4096, st);
#ifndef REP_STAGE
#define REP_STAGE -1
#endif
#ifndef REP_N
#define REP_N 1
#endif
#define RS(k) do { run_stage(p, k, blockIdx.x, gridDim.x, lds); if ((k) == REP_STAGE) { for (int rep_ = 0; rep_ < REP_N; ++rep_) { xcd_barrier(bar); run_stage(p, k, blockIdx.x, gridDim.x, lds); } } } while (0)
#define GS() xcd_barrier(bar)
    RS(0); GS(); RS(1); GS(); RS(2); GS(); RS(3); GS(); RS(4); GS(); RS(5); GS(); RS(6); GS(); RS(7); GS();
    RS(8); GS(); RS(9); GS(); RS(10); GS(); RS(13); if (gridDim.x != 256) { GS(); RS(14); }
#undef RS
#undef GS
}
#endif

extern "C" void kernel_launch(void* const* d_in, const int* in_sizes, int n_in, void* d_out, int out_size, void* d_ws, size_t ws_size, hipStream_t stream) {
    static int inited = 0, grid_blocks = 0;
    if (!inited) {
        if (n_in != 23 || ws_size < WS_END || out_size != NLAT * D) { fprintf(stderr, "kernel_launch: unexpected shapes n_in %d ws %zu out %d\n", n_in, ws_size, out_size); inited = -1; return; }
        if (hipFuncSetAttribute((const void*)k_mega, hipFuncAttributeMaxDynamicSharedMemorySize, LDS_BYTES) != hipSuccess) { fprintf(stderr, "hipFuncSetAttribute failed\n"); inited = -1; return; }
        int dev = 0, cus = 0, per_cu = 0;
        (void)hipGetDevice(&dev); (void)hipDeviceGetAttribute(&cus, hipDeviceAttributeMultiprocessorCount, dev);
        (void)hipOccupancyMaxActiveBlocksPerMultiprocessor(&per_cu, (const void*)k_mega, NTHREADS, LDS_BYTES);
        if (per_cu < 1) { fprintf(stderr, "kernel_launch: occupancy query says %d blocks per CU\n", per_cu); per_cu = 1; }
        if (per_cu > 1) per_cu = 1;
        grid_blocks = cus * per_cu;
        inited = 1;
    }
    if (inited < 0) return;
    Params p{};
    const float** f = (const float**)&p;
    for (int i = 0; i < 23; ++i) f[i] = (const float*)d_in[i];
    p.out = (float*)d_out; p.ws = (unsigned char*)d_ws;
    (void)hipMemsetAsync((unsigned char*)d_ws + WS_CTL, 0, 2 * MiB, stream);
#if ONE_LAUNCH
    void* args[] = {&p};
    hipError_t e = hipLaunchCooperativeKernel((const void*)k_mega, dim3(grid_blocks), dim3(NTHREADS), args, LDS_BYTES, stream);
    if (e != hipSuccess) fprintf(stderr, "cooperative launch failed: %s (grid %d)\n", hipGetErrorString(e), grid_blocks);
#else
    for (int st = 0; st < NSTAGES; ++st) hipLaunchKernelGGL(k_mega, dim3(1024), dim3(NTHREADS), LDS_BYTES, stream, p, st);
#endif
}
```

```cpp
#include <hip/hip_runtime.h>
#include <hip/hip_cooperative_groups.h>
namespace cg = cooperative_groups;
#include <cstdio>
#include <cstdint>

typedef unsigned short bf16_t;
#define DEVI __device__ __forceinline__
#define LDS_BARRIER() do { asm volatile("s_waitcnt lgkmcnt(0)" ::: "memory"); __builtin_amdgcn_s_barrier(); asm volatile("" ::: "memory"); } while (0)

constexpr int D = 1024, NB = 4, SEQ = 4096, CTXL = 256;
constexpr int NLAT = NB * SEQ;
constexpr int NCTX = NB * CTXL;
constexpr int NT = NLAT + NCTX;
constexpr int NCH = 68;
constexpr int EVEN_IN = 7200;
constexpr int N1 = 7424;
constexpr int N1A = 13 * 256;
constexpr int RGW = 2048;
constexpr float EPS = 1e-6f;

constexpr size_t MiB = 1u << 20;
constexpr size_t WS_CTL = 0;
constexpr size_t WS_MOD = 1 * MiB;
constexpr size_t WS_ALR = 2 * MiB;
constexpr size_t WS_X1C = 5 * MiB;
constexpr size_t WS_SUMA = 9 * MiB;
constexpr size_t WS_SUMH = 9 * MiB + 4608 * 1024;
constexpr size_t WS_DEC = 18 * MiB;
constexpr size_t WS_BT1 = 19 * MiB + 512 * 1024;
constexpr size_t WS_BT2 = 34 * MiB;
constexpr size_t WS_BT3 = 38 * MiB;
constexpr size_t WS_BT4 = 46 * MiB;
constexpr size_t WS_BD = 50 * MiB;
constexpr size_t WS_S0 = 52 * MiB;
constexpr size_t SLOT = 34 * MiB;
constexpr size_t WS_END = WS_S0 + 6 * SLOT;
static_assert(WS_END == 256 * MiB, "ws map");
#define WS_SLOT(i) (WS_S0 + (size_t)(i) * SLOT)

struct Params {
    const float* x; const float* c; const float* ctx; const float* c_ctx; const float* norm_g; const float* w_mod; const float* b_mod;
    const float* e_w_in; const float* e_w_a2; const float* e_b_a2; const float* e_gla_g; const float* e_conv_w; const float* e_w_out;
    const float* o_w_in; const float* o_conv_w; const float* o_conv_b; const float* o_w_a; const float* o_b_a; const float* o_w_x; const float* o_b_x;
    const float* o_lam; const float* o_w_out; const float* final_g;
    float* out; unsigned char* ws;
};

DEVI float bf2f(bf16_t v) { return __uint_as_float((unsigned)v << 16); }
typedef float hw_f2 __attribute__((ext_vector_type(2))); typedef __bf16 hw_b2 __attribute__((ext_vector_type(2)));
DEVI unsigned hw_pk(float lo, float hi) { hw_f2 v = {lo, hi}; hw_b2 b = __builtin_convertvector(v, hw_b2); return __builtin_bit_cast(unsigned, b); }
DEVI bf16_t f2bf(float f) { return (bf16_t)(hw_pk(f, 0.f) & 0xffffu); }
DEVI unsigned pk2(float lo, float hi) { return hw_pk(lo, hi); }
DEVI float fexp2_(float x) { return __builtin_amdgcn_exp2f(x); }
DEVI float frcp_(float x) { return __builtin_amdgcn_rcpf(x); }
DEVI float sigmoidf_(float x) { return frcp_(1.0f + fexp2_(-1.4426950408889634f * x)); }
DEVI float siluf_(float x) { return x * frcp_(1.0f + fexp2_(-1.4426950408889634f * x)); }
DEVI float softplusf_(float x) { return fmaxf(x, 0.f) + log1pf(__expf(-fabsf(x))); }
DEVI float logsigmoidf_(float x) { return fminf(x, 0.f) - 0.6931471805599453f * __builtin_amdgcn_logf(1.0f + fexp2_(-1.4426950408889634f * fabsf(x))); }
DEVI int row_of(int bb, int c, int t) { return c < 64 ? bb * 4096 + c * 64 + t : NLAT + bb * 256 + (c - 64) * 64 + t; }
DEVI int mod_idx(int row) { return row < NLAT ? (row >> 12) : 4; }
DEVI int xr_pad_of_tile(int pm) { return pm < 64 ? 4 * ((pm >> 4) + 1) : 20 + 4 * (pm - 64); }
constexpr int XR_ROWS = NT + 36;
DEVI float wave_sum(float v) {
#pragma unroll
    for (int o = 1; o < 64; o <<= 1) v += __shfl_xor(v, o);
    return v;
}
__host__ __device__ inline int colmap1(int n) {
    const int t = n >> 8, c = n & 255;
    if (t < 12) return n;
    if (t == 12) return c < 32 ? 3072 + c : -1;
    if (t < 21) { const int j = t - 13; return c < 128 ? 4128 + 128 * j + c : 5152 + 128 * j + (c - 128); }
    const int j = t - 21; return c < 128 ? 3104 + 128 * j + c : 6176 + 128 * j + (c - 128);
}

#define NTHREADS 512

__device__ void st_mod(const Params& p, int vb, int nvb, float* lds) {
    float* MOD = (float*)(p.ws + WS_MOD);
    for (int i = threadIdx.x; i < 5 * 1024; i += NTHREADS) { const int s = i >> 10, k = i & 1023; const float v = s < 4 ? p.c[s * 1024 + k] : p.c_ctx[k]; lds[i] = siluf_(v); }
    __syncthreads();
    const int lane = threadIdx.x & 63, gw = vb * (NTHREADS / 64) + (threadIdx.x >> 6), ngw = nvb * (NTHREADS / 64);
    for (int it = gw; it < 2 * 24 * 32; it += ngw) {
        const int kc = it & 31, cb = (it >> 5) % 24, li = it / (32 * 24), j = cb * 128 + 2 * lane, k0 = kc * 32;
        const float* W = p.w_mod + ((size_t)li * 1024 + k0) * 3072 + j;
        float2 wv[32];
#pragma unroll
        for (int k = 0; k < 32; ++k) wv[k] = *(const float2*)(W + (size_t)k * 3072);
        float2 a0 = {0.f, 0.f}, a1 = a0, a2 = a0, a3 = a0, a4 = a0;
#pragma unroll
        for (int k = 0; k < 32; ++k) { const float2 w = wv[k]; const float s0 = lds[k0 + k], s1 = lds[1024 + k0 + k], s2 = lds[2048 + k0 + k], s3 = lds[3072 + k0 + k], s4 = lds[4096 + k0 + k];
            a0.x += s0 * w.x; a0.y += s0 * w.y; a1.x += s1 * w.x; a1.y += s1 * w.y; a2.x += s2 * w.x; a2.y += s2 * w.y; a3.x += s3 * w.x; a3.y += s3 * w.y; a4.x += s4 * w.x; a4.y += s4 * w.y; }
        float2 bv = {0.f, 0.f}; if (kc == 0) bv = *(const float2*)(p.b_mod + li * 3072 + j);
        float* o = MOD + (size_t)li * 5 * 3072 + j;
        atomicAdd(o, a0.x + bv.x); atomicAdd(o + 1, a0.y + bv.y); atomicAdd(o + 3072, a1.x + bv.x); atomicAdd(o + 3073, a1.y + bv.y); atomicAdd(o + 2 * 3072, a2.x + bv.x); atomicAdd(o + 2 * 3072 + 1, a2.y + bv.y);
        atomicAdd(o + 3 * 3072, a3.x + bv.x); atomicAdd(o + 3 * 3072 + 1, a3.y + bv.y); atomicAdd(o + 4 * 3072, a4.x + bv.x); atomicAdd(o + 4 * 3072 + 1, a4.y + bv.y);
    }
    __syncthreads();
}

__device__ __forceinline__ void wt_item(const float* src, int ldw, bf16_t* dst, int K, int k0, __attribute__((address_space(3))) float* scr, int lane) {
    typedef unsigned v4u __attribute__((ext_vector_type(4)));
    if (src) {
        float rv[32];
#pragma unroll
        for (int i = 0; i < 32; ++i) { const int kk = 2 * i + (lane >> 5); rv[i] = src[(size_t)(k0 + kk) * ldw + (lane & 31)]; }
#pragma unroll
        for (int i = 0; i < 32; ++i) { const int kk = 2 * i + (lane >> 5); scr[kk * 33 + (lane & 31)] = rv[i]; }
    }
    asm volatile("s_waitcnt lgkmcnt(0)" ::: "memory");
    const int cch = lane & 7;
#pragma unroll
    for (int j = 0; j < 4; ++j) { const int n = (lane >> 3) + 8 * j; const __attribute__((address_space(3))) float* sp = scr + (8 * cch) * 33 + n;
        v4u o = {0u, 0u, 0u, 0u};
        if (src) { o.x = pk2(sp[0 * 33], sp[1 * 33]); o.y = pk2(sp[2 * 33], sp[3 * 33]); o.z = pk2(sp[4 * 33], sp[5 * 33]); o.w = pk2(sp[6 * 33], sp[7 * 33]); }
        *(v4u*)(dst + (size_t)n * K + k0 + 8 * cch) = o; }
    asm volatile("s_waitcnt lgkmcnt(0)" ::: "memory");
}
__device__ void st_wprep(const Params& p, int vb, int nvb, unsigned char* lds_) {
    bf16_t* Bt1 = (bf16_t*)(p.ws + WS_BT1); bf16_t* Bt2 = (bf16_t*)(p.ws + WS_BT2); bf16_t* Bt3 = (bf16_t*)(p.ws + WS_BT3); bf16_t* Bt4 = (bf16_t*)(p.ws + WS_BT4);
    bf16_t* BD = (bf16_t*)(p.ws + WS_BD);
    const int lane = threadIdx.x & 63, wv = threadIdx.x >> 6, gw = vb * (NTHREADS / 64) + wv, ngw = nvb * (NTHREADS / 64);
    __attribute__((address_space(3))) float* scr = (__attribute__((address_space(3))) float*)lds_ + 8192 + wv * (64 * 33);
    constexpr int I1 = 16 * (N1 / 32), I2 = 32 * 32, I3 = 16 * 128, I4 = 32 * 32, I5 = 64 * 8;
    for (int it = gw; it < I1 + I2 + I3 + I4 + I5; it += ngw) {
        int r = it;
        if (r < I1) { const int nbk = N1 / 32, kb = r / nbk, nb = r % nbk; const int sc = colmap1(nb * 32); wt_item(sc < 0 ? nullptr : p.e_w_in + sc, EVEN_IN, Bt1 + (size_t)nb * 32 * 1024, 1024, kb * 64, scr, lane); continue; } r -= I1;
        if (r < I2) { const int kb = r / 32, nb = r % 32; wt_item(p.e_w_out + nb * 32, 1024, Bt2 + (size_t)nb * 32 * 2048, 2048, kb * 64, scr, lane); continue; } r -= I2;
        if (r < I3) { const int kb = r / 128, nb = r % 128; wt_item(p.o_w_in + nb * 32, 4096, Bt3 + (size_t)nb * 32 * 1024, 1024, kb * 64, scr, lane); continue; } r -= I3;
        if (r < I4) { const int kb = r / 32, nb = r % 32; wt_item(p.o_w_out + nb * 32, 1024, Bt4 + (size_t)nb * 32 * 2048, 2048, kb * 64, scr, lane); continue; } r -= I4;
        { const int m = r >> 8, dn = (r >> 3) & 31, kb = (r >> 2) & 1, nb = r & 3; const float* W = (m == 0 ? p.o_w_a : p.o_w_x) + (size_t)dn * 16384;
          wt_item(W + nb * 32, 128, BD + (size_t)m * 2 * 16 * 16384 + (size_t)dn * 16384 + (size_t)nb * 32 * 128, 128, kb * 64, scr, lane); }
    }
}

__device__ void st_modulate(const Params& p, int vb, int nvb, int li, const float* xlat, const float* xctx, bf16_t* H, const float* slab = nullptr, int nslab = 0, const float* gatec = nullptr, int row_begin = 0) {
    const float* MOD = (const float*)(p.ws + WS_MOD) + (size_t)li * 5 * 3072;
    const float* g = p.norm_g + li * 1024;
    const int lane = threadIdx.x & 63, gw = vb * (NTHREADS / 64) + (threadIdx.x >> 6), ngw = nvb * (NTHREADS / 64);
    const int nrows = NT - row_begin, per = (nrows + ngw - 1) / ngw, r0 = row_begin + gw * per, r1 = (r0 + per < NT) ? r0 + per : NT;
    float4 mulv[4], shv[4]; int cur_mi = -1;
    for (int row = r0; row < r1; ++row) {
        const float* xr = row < NLAT ? xlat + (size_t)row * 1024 : xctx + (size_t)(row - NLAT) * 1024;
        float4 v[4];
#pragma unroll
        for (int j = 0; j < 4; ++j) v[j] = *(const float4*)(xr + j * 256 + lane * 4);
        const int mi = mod_idx(row);
        if (mi != cur_mi) { cur_mi = mi; const float* md = MOD + (size_t)mi * 3072;
#pragma unroll
            for (int j = 0; j < 4; ++j) { const int c0 = j * 256 + lane * 4; const float4 gg = *(const float4*)(g + c0), sc = *(const float4*)(md + 1024 + c0); shv[j] = *(const float4*)(md + c0);
                mulv[j] = float4{gg.x * (1.f + sc.x), gg.y * (1.f + sc.y), gg.z * (1.f + sc.z), gg.w * (1.f + sc.w)}; } }
        float ss = 0.f;
#pragma unroll
        for (int j = 0; j < 4; ++j) {
            if (slab && row >= NLAT) {
                float4 a = {0.f, 0.f, 0.f, 0.f};
                for (int ks = 0; ks < nslab; ++ks) { const float4 t = *(const float4*)(slab + ((size_t)ks * NCTX + (row - NLAT)) * 1024 + j * 256 + lane * 4); a.x += t.x; a.y += t.y; a.z += t.z; a.w += t.w; }
                const float4 gt = *(const float4*)(gatec + j * 256 + lane * 4); v[j].x += gt.x * a.x; v[j].y += gt.y * a.y; v[j].z += gt.z * a.z; v[j].w += gt.w * a.w; }
            ss += v[j].x * v[j].x + v[j].y * v[j].y + v[j].z * v[j].z + v[j].w * v[j].w; }
        const float rinv = rsqrtf(wave_sum(ss) * (1.f / 1024.f) + EPS);
#pragma unroll
        for (int j = 0; j < 4; ++j) { const int c0 = j * 256 + lane * 4;
            uint2 o; o.x = pk2(v[j].x * rinv * mulv[j].x + shv[j].x, v[j].y * rinv * mulv[j].y + shv[j].y); o.y = pk2(v[j].z * rinv * mulv[j].z + shv[j].z, v[j].w * rinv * mulv[j].w + shv[j].w);
            *(uint2*)(H + (size_t)row * 1024 + c0) = o; }
    }
}

template <class Epi>
__device__ void st_gemm_naive(int vb, int nvb, float* lds, const bf16_t* A, const bf16_t* Bt, int mt0, int mt1, int nt0, int nt1, int K, const Epi& E) {
    float* As = lds;
    float* Bs = lds + 32 * 33;
    const int tid = threadIdx.x, tx = tid & 63, ty = tid >> 6;
    const int nmt = mt1 - mt0, nnt = nt1 - nt0;
    for (int it = vb; it < nmt * nnt; it += nvb) {
        const int m0 = (mt0 + it / nnt) * 32, n0 = (nt0 + it % nnt) * 256;
        float acc[4][4];
#pragma unroll
        for (int i = 0; i < 4; ++i)
#pragma unroll
            for (int j = 0; j < 4; ++j) acc[i][j] = 0.f;
        for (int k0 = 0; k0 < K; k0 += 32) {
            __syncthreads();
            for (int e = tid; e < 32 * 32; e += NTHREADS) { const int r = e >> 5, kk = e & 31; As[r * 33 + kk] = bf2f(A[(size_t)(m0 + r) * K + k0 + kk]); }
            for (int e = tid; e < 256 * 32; e += NTHREADS) { const int r = e >> 5, kk = e & 31; Bs[r * 33 + kk] = bf2f(Bt[(size_t)(n0 + r) * K + k0 + kk]); }
            __syncthreads();
#pragma unroll 8
            for (int kk = 0; kk < 32; ++kk) {
                float a[4], b[4];
#pragma unroll
                for (int i = 0; i < 4; ++i) a[i] = As[(ty * 4 + i) * 33 + kk];
#pragma unroll
                for (int j = 0; j < 4; ++j) b[j] = Bs[(tx + 64 * j) * 33 + kk];
#pragma unroll
                for (int i = 0; i < 4; ++i)
#pragma unroll
                    for (int j = 0; j < 4; ++j) acc[i][j] += a[i] * b[j];
            }
        }
#pragma unroll
        for (int i = 0; i < 4; ++i) E(m0 + ty * 4 + i, n0, tx, acc[i]);
    }
    __syncthreads();
}

struct Epi1 {
    bf16_t *QK, *V, *SGA, *Z, *CBG; float* ALR;
    DEVI void operator()(int row, int n0, int cl, const float (&v)[4]) const {
        const int t = n0 >> 8;
        if (t < 4) { for (int j = 0; j < 4; ++j) QK[(size_t)row * 1024 + n0 + cl + 64 * j] = f2bf(v[j]); }
        else if (t < 8) { for (int j = 0; j < 4; ++j) V[(size_t)row * 1024 + (n0 - 1024) + cl + 64 * j] = f2bf(v[j]); }
        else if (t < 12) { for (int j = 0; j < 4; ++j) SGA[(size_t)row * 1024 + (n0 - 2048) + cl + 64 * j] = f2bf(siluf_(v[j])); }
        else if (t == 12) { if (cl < 32) ALR[(size_t)row * 32 + cl] = v[0]; }
        else if (t < 21) { const int jt = t - 13; Z[(size_t)row * 1024 + 128 * jt + cl] = f2bf(v[0] * v[2]); Z[(size_t)row * 1024 + 128 * jt + cl + 64] = f2bf(v[1] * v[3]); }
        else { const int jt = t - 21; CBG[(size_t)row * 1024 + 128 * jt + cl] = f2bf(v[0] * siluf_(v[2])); CBG[(size_t)row * 1024 + 128 * jt + cl + 64] = f2bf(v[1] * siluf_(v[3])); }
    }
};
struct EpiRes {
    const float* xl; const float* xc; float* outl; float* outc; const float* MODl;
    DEVI void operator()(int row, int n0, int cl, const float (&v)[4]) const {
        const float* gate = MODl + (size_t)mod_idx(row) * 3072 + 2048;
        for (int j = 0; j < 4; ++j) { const int col = n0 + cl + 64 * j;
            if (row < NLAT) outl[(size_t)row * 1024 + col] = xl[(size_t)row * 1024 + col] + gate[col] * v[j];
            else if (outc) outc[(size_t)(row - NLAT) * 1024 + col] = xc[(size_t)(row - NLAT) * 1024 + col] + gate[col] * v[j]; }
    }
};
struct Epi3 {
    bf16_t* XR; bf16_t* SG;
    DEVI void operator()(int row, int n0, int cl, const float (&v)[4]) const {
        for (int j = 0; j < 4; ++j) { const int col = n0 + cl + 64 * j;
            if (col < 2048) XR[(size_t)row * 2048 + col] = f2bf(v[j]); else if (row < NLAT) SG[(size_t)row * 2048 + col - 2048] = f2bf(siluf_(v[j])); }
    }
};

#define LASQ __attribute__((address_space(3)))
__device__ void st_glaprep(const Params& p, int vb, int nvb, unsigned char* ldsb, const bf16_t* QK, const bf16_t* V, const float* ALR, bf16_t* QIN, bf16_t* KET, bf16_t* SC, float* DEC, bf16_t* VT) {
    typedef unsigned u4 __attribute__((ext_vector_type(4))); typedef unsigned u2 __attribute__((ext_vector_type(2))); typedef float f4 __attribute__((ext_vector_type(4))); typedef short bx8 __attribute__((ext_vector_type(8)));
    LASQ unsigned char* lds = (LASQ unsigned char*)ldsb;
    constexpr int RQ = 0, RK = 17408, Q0 = 34816, K0 = 52224, VR = 69632, AL = VR + 33792, TT = AL + 8192;
    const int tid = threadIdx.x, kk = tid & 127, tq = tid >> 7, wv = tid >> 6, ln = tid & 63, cl = ln & 15, gq = ln >> 4;
    u4 r[9];
#define GP_LOAD(item) do { const int h_ = (item) & 3, bc_ = (item) >> 2, c_ = bc_ % NCH, bb_ = bc_ / NCH; const size_t row0_ = (size_t)row_of(bb_, c_, 0); \
        _Pragma("unroll") for (int j_ = 0; j_ < 2; ++j_) { const int p_ = tid + 512 * j_; r[j_] = *(const u4*)(QK + (row0_ + (p_ >> 4)) * 1024 + h_ * 128 + (p_ & 15) * 8); r[2 + j_] = *(const u4*)(QK + (row0_ + (p_ >> 4)) * 1024 + 512 + h_ * 128 + (p_ & 15) * 8); } \
        _Pragma("unroll") for (int j_ = 0; j_ < 4; ++j_) { const int p_ = tid + 512 * j_; r[4 + j_] = *(const u4*)(V + (row0_ + (p_ >> 5)) * 1024 + h_ * 256 + (p_ & 31) * 8); } \
        r[8] = *(const u4*)(ALR + (row0_ + (tid >> 3)) * 32 + (tid & 7) * 4); } while (0)
    const int NIT = NB * NCH * 4;
    if (vb < NIT) GP_LOAD(vb);
    for (int item = vb; item < NIT; item += nvb) {
        const int h = item & 3;
        LDS_BARRIER();
#pragma unroll
        for (int j = 0; j < 2; ++j) { const int pp = tid + 512 * j; *(LASQ u4*)(lds + RQ + (pp >> 4) * 272 + (pp & 15) * 16) = r[j]; *(LASQ u4*)(lds + RK + (pp >> 4) * 272 + (pp & 15) * 16) = r[2 + j]; }
#pragma unroll
        for (int j = 0; j < 4; ++j) { const int pp = tid + 512 * j; *(LASQ u4*)(lds + VR + (pp >> 5) * 528 + (pp & 31) * 16) = r[4 + j]; }
        *(LASQ u4*)(lds + AL + (tid >> 3) * 128 + (tid & 7) * 16) = r[8];
        bx8 wfr[2]; float b2v[2];
#pragma unroll
        for (int d = 0; d < 2; ++d) { float wv8[8];
#pragma unroll
            for (int j = 0; j < 8; ++j) wv8[j] = gq < 2 ? p.e_w_a2[((size_t)d * 16 + 8 * gq + j) * 512 + h * 128 + 16 * wv + cl] : 0.f;
            u4 w; w.x = pk2(wv8[0], wv8[1]); w.y = pk2(wv8[2], wv8[3]); w.z = pk2(wv8[4], wv8[5]); w.w = pk2(wv8[6], wv8[7]); wfr[d] = __builtin_bit_cast(bx8, w);
            b2v[d] = p.e_b_a2[d * 512 + h * 128 + 16 * wv + cl]; }
        asm volatile("" ::: "memory");
        if (item + nvb < NIT) GP_LOAD(item + nvb);
        LDS_BARRIER();
        unsigned qkr[16];
#pragma unroll
        for (int i = 0; i < 16; ++i) { qkr[i] = (unsigned)*(const LASQ unsigned short*)(lds + RQ + (tq * 16 + i) * 272 + kk * 2) | ((unsigned)*(const LASQ unsigned short*)(lds + RK + (tq * 16 + i) * 272 + kk * 2) << 16); }
#define GP_Z(d, zoff) do { _Pragma("unroll") for (int mt = 0; mt < 4; ++mt) { bx8 af = {0, 0, 0, 0, 0, 0, 0, 0}; \
            if (gq < 2) { const LASQ f4* ap_ = (const LASQ f4*)(lds + AL + (16 * mt + cl) * 128 + (d) * 64 + gq * 32); const f4 a0_ = ap_[0], a1_ = ap_[1]; \
                u4 w_; w_.x = pk2(a0_[0], a0_[1]); w_.y = pk2(a0_[2], a0_[3]); w_.z = pk2(a1_[0], a1_[1]); w_.w = pk2(a1_[2], a1_[3]); af = __builtin_bit_cast(bx8, w_); } \
            f4 acc_ = {b2v[d], b2v[d], b2v[d], b2v[d]}; acc_ = __builtin_amdgcn_mfma_f32_16x16x32_bf16(af, wfr[d], acc_, 0, 0, 0); \
            _Pragma("unroll") for (int rr_ = 0; rr_ < 4; ++rr_) *(LASQ float*)(lds + (zoff) + (16 * mt + 4 * gq + rr_) * 528 + (16 * wv + cl) * 4) = acc_[rr_]; } } while (0)
        GP_Z(0, Q0);
        LDS_BARRIER();
        GP_Z(1, RQ);
        LDS_BARRIER();
#undef GP_Z
        float bc[2][16];
#pragma unroll
        for (int d = 0; d < 2; ++d) {
#pragma unroll
            for (int i = 0; i < 16; ++i) { const float z = *(const LASQ float*)(lds + (d == 0 ? Q0 : RQ) + (tq * 16 + i) * 528 + kk * 4); bc[d][i] = logsigmoidf_(z) * (1.f / 16.f); }
            float sacc = 0.f;
            if (d == 0) {
#pragma unroll
                for (int i = 0; i < 16; ++i) { sacc += bc[d][i]; bc[d][i] = sacc; } }
            else {
#pragma unroll
                for (int i = 15; i >= 0; --i) { sacc += bc[d][i]; bc[d][i] = sacc; } }
            *(LASQ float*)(lds + TT + ((d * 4 + tq) * 128 + kk) * 4) = sacc;
        }
        LDS_BARRIER();
        const float scale = 0.08838834764831845f;
#pragma unroll
        for (int d = 0; d < 2; ++d) {
            const size_t u = (size_t)item * 2 + d;
            float off = 0.f, blast = 0.f;
#pragma unroll
            for (int q = 0; q < 4; ++q) { const float tv = *(const LASQ float*)(lds + TT + ((d * 4 + q) * 128 + kk) * 4); blast += tv; if (d == 0 ? (q < tq) : (q > tq)) off += tv; }
            LASQ unsigned char* qd = lds + (d == 0 ? Q0 : RQ); LASQ unsigned char* kd = lds + (d == 0 ? K0 : RK);
            unsigned ke[8];
#pragma unroll
            for (int i = 0; i < 16; ++i) { const int t = tq * 16 + i; const float bq = bc[d][i] + off;
                const float qv = __uint_as_float(qkr[i] << 16) * scale, kv = __uint_as_float(qkr[i] & 0xffff0000u);
                const float eb = fexp2_(1.4426950408889634f * bq);
                *(LASQ unsigned short*)(qd + t * 272 + kk * 2) = f2bf(qv * eb); *(LASQ unsigned short*)(kd + t * 272 + kk * 2) = f2bf(kv * frcp_(eb));
                const unsigned kev = f2bf(kv * fexp2_(1.4426950408889634f * (blast - bq)));
                if (i & 1) ke[i >> 1] |= kev << 16; else ke[i >> 1] = kev; }
            { u4 w0 = {ke[0], ke[1], ke[2], ke[3]}, w1 = {ke[4], ke[5], ke[6], ke[7]}; u4* dst = (u4*)(KET + (u * 128 + kk) * 64 + tq * 16); dst[0] = w0; dst[1] = w1; }
            if (tq == 0) DEC[u * 128 + kk] = fexp2_(1.4426950408889634f * blast);
        }
        LDS_BARRIER();
#pragma unroll
        for (int d = 0; d < 2; ++d) {
            const size_t u = (size_t)item * 2 + d;
            const LASQ unsigned char* qd = lds + (d == 0 ? Q0 : RQ); const LASQ unsigned char* kd = lds + (d == 0 ? K0 : RK);
#pragma unroll
            for (int j = 0; j < 2; ++j) { const int pp = tid + 512 * j; *(u4*)(QIN + u * 8192 + (pp >> 4) * 128 + (pp & 15) * 8) = *(const LASQ u4*)(qd + (pp >> 4) * 272 + (pp & 15) * 16); }
            const int mt = wv >> 1;
#pragma unroll
            for (int nn = 0; nn < 2; ++nn) { const int nt = 2 * (wv & 1) + nn; f4 acc = {0.f, 0.f, 0.f, 0.f};
#pragma unroll
                for (int k4 = 0; k4 < 4; ++k4) { const bx8 kf = *(const LASQ bx8*)(kd + (16 * nt + cl) * 272 + (32 * k4 + 8 * gq) * 2), qf = *(const LASQ bx8*)(qd + (16 * mt + cl) * 272 + (32 * k4 + 8 * gq) * 2);
                    acc = __builtin_amdgcn_mfma_f32_16x16x32_bf16(kf, qf, acc, 0, 0, 0); }
                const int t = 16 * mt + cl, s0 = 16 * nt + 4 * gq; float v[4];
#pragma unroll
                for (int rr = 0; rr < 4; ++rr) { const int sx = s0 + rr; v[rr] = (d == 0 ? (sx <= t) : (sx >= t)) ? acc[rr] : 0.f; }
                u2 w; w.x = pk2(v[0], v[1]); w.y = pk2(v[2], v[3]); *(u2*)(SC + (u * 64 + t) * 64 + s0) = w; }
        }
        { const int vc = tid & 255, th = tid >> 8; unsigned vv[16];
#pragma unroll
          for (int i = 0; i < 32; ++i) { const unsigned x = *(const LASQ unsigned short*)(lds + VR + (32 * th + i) * 528 + vc * 2); if (i & 1) vv[i >> 1] |= x << 16; else vv[i >> 1] = x; }
          u4* dst = (u4*)(VT + ((size_t)item * 256 + vc) * 64 + 32 * th);
          dst[0] = (u4){vv[0], vv[1], vv[2], vv[3]}; dst[1] = (u4){vv[4], vv[5], vv[6], vv[7]}; dst[2] = (u4){vv[8], vv[9], vv[10], vv[11]}; dst[3] = (u4){vv[12], vv[13], vv[14], vv[15]}; }
    }
    LDS_BARRIER();
#undef GP_LOAD
}

__device__ void st_glawalk_naive(const Params& p, int vb, int nvb, float* Sl, const bf16_t* QIN, const bf16_t* KET, const bf16_t* SC, const float* DEC, const bf16_t* VT, bf16_t* OF, bf16_t* OB) {
    const int vc = threadIdx.x & 255, half = threadIdx.x >> 8;
    for (int combo = vb; combo < 32; combo += nvb) {
        const int d = combo & 1, h = (combo >> 1) & 3, bb = combo >> 3;
        __syncthreads();
        for (int k = half * 64; k < half * 64 + 64; ++k) Sl[k * 256 + vc] = 0.f;
        __syncthreads();
        bf16_t* O = d == 0 ? OF : OB;
        for (int step = 0; step < NCH; ++step) {
            const int c = d == 0 ? (step < 4 ? 64 + step : step - 4) : 67 - step;
            const int u = ((bb * NCH + c) * 4 + h) * 2 + d;
            const bf16_t* q = QIN + (size_t)u * 64 * 128; const bf16_t* ke = KET + (size_t)u * 128 * 64; const bf16_t* sc = SC + (size_t)u * 64 * 64;
            const bf16_t* vt = VT + (((size_t)(u >> 1)) * 256 + vc) * 64;
            float vv[64];
#pragma unroll
            for (int t = 0; t < 64; ++t) vv[t] = bf2f(vt[t]);
            const int row0 = row_of(bb, c, 0);
            for (int t = half * 32; t < half * 32 + 32; ++t) { float a = 0.f;
                for (int k = 0; k < 128; ++k) a += bf2f(q[t * 128 + k]) * bf2f(f2bf(Sl[k * 256 + vc]));
#pragma unroll
                for (int s = 0; s < 64; ++s) a += bf2f(sc[t * 64 + s]) * vv[s];
                O[(size_t)(row0 + t) * 1024 + h * 256 + vc] = f2bf(a); }
            __syncthreads();
            for (int k = half * 64; k < half * 64 + 64; ++k) { float a = DEC[(size_t)u * 128 + k] * Sl[k * 256 + vc];
#pragma unroll
                for (int t = 0; t < 64; ++t) a += bf2f(ke[k * 64 + t]) * vv[t];
                Sl[k * 256 + vc] = a; }
            __syncthreads();
        }
    }
}

__device__ void st_inner(const Params& p, int vb, int nvb, const bf16_t* OF, const bf16_t* OB, const bf16_t* SGA, const bf16_t* Z, const bf16_t* CBG, bf16_t* INNER, const bf16_t* ZA, float* X1C) {
    const int lane = threadIdx.x & 63, gw = vb * (NTHREADS / 64) + (threadIdx.x >> 6), ngw = nvb * (NTHREADS / 64);
    const float4 gg = *(const float4*)(p.e_gla_g + lane * 4);
    float4 cw0[4], cw1[4], cw2[4];
#pragma unroll
    for (int h = 0; h < 4; ++h) { const int c0 = h * 256 + lane * 4; cw0[h] = *(const float4*)(p.e_conv_w + c0); cw1[h] = *(const float4*)(p.e_conv_w + 1024 + c0); cw2[h] = *(const float4*)(p.e_conv_w + 2048 + c0); }
    const int per = (NT + ngw - 1) / ngw, r0 = gw * per, r1 = (r0 + per < NT) ? r0 + per : NT;
#define LO(u) __uint_as_float((u) << 16)
#define HI(u) __uint_as_float((u) & 0xffff0000u)
#define ZROW(dst, r_) do { _Pragma("unroll") for (int h = 0; h < 4; ++h) { const bf16_t* zb = h == 0 ? ZA + lane * 4 : Z + h * 256 + lane * 4; const size_t zpitch = h == 0 ? 256 : 1024; dst[h] = *(const uint2*)(zb + (size_t)(r_) * zpitch); } } while (0)
    uint2 zp[4], zc[4], zn[4];
    if (r0 < r1) { ZROW(zp, r0 > 0 ? r0 - 1 : 0); ZROW(zc, r0); }
    for (int row = r0; row < r1; ++row) {
        bool hasp, hasn;
        if (row < NLAT) { const int t = row & 63; hasp = t != 0; hasn = t != 63; } else { const int t = (row - NLAT) & 255; hasp = t != 0; hasn = t != 255; }
        const float mp = hasp ? 1.f : 0.f, mn = hasn ? 1.f : 0.f;
        ZROW(zn, row + 1 < NT ? row + 1 : row);
        uint2 a[4], b[4], sg[4], cb[4];
#pragma unroll
        for (int h = 0; h < 4; ++h) { const int c0 = h * 256 + lane * 4;
            a[h] = *(const uint2*)(OF + (size_t)row * 1024 + c0); b[h] = *(const uint2*)(OB + (size_t)row * 1024 + c0); sg[h] = *(const uint2*)(SGA + (size_t)row * 1024 + c0); cb[h] = *(const uint2*)(CBG + (size_t)row * 1024 + c0); }
#pragma unroll
        for (int h = 0; h < 4; ++h) { const int c0 = h * 256 + lane * 4;
            const float o0 = LO(a[h].x) + LO(b[h].x), o1 = HI(a[h].x) + HI(b[h].x), o2 = LO(a[h].y) + LO(b[h].y), o3 = HI(a[h].y) + HI(b[h].y);
            const float rinv = rsqrtf(wave_sum(o0 * o0 + o1 * o1 + o2 * o2 + o3 * o3) * (1.f / 256.f) + EPS);
            uint2 o; o.x = pk2(o0 * rinv * gg.x * LO(sg[h].x), o1 * rinv * gg.y * HI(sg[h].x)); o.y = pk2(o2 * rinv * gg.z * LO(sg[h].y), o3 * rinv * gg.w * HI(sg[h].y));
            *(uint2*)(INNER + (size_t)row * 2048 + c0) = o;
            const float4 w0 = cw0[h], w1 = cw1[h], w2 = cw2[h];
            uint2 y; y.x = pk2(LO(cb[h].x) * (mp * w0.x * LO(zp[h].x) + w1.x * LO(zc[h].x) + mn * w2.x * LO(zn[h].x)), HI(cb[h].x) * (mp * w0.y * HI(zp[h].x) + w1.y * HI(zc[h].x) + mn * w2.y * HI(zn[h].x)));
            y.y = pk2(LO(cb[h].y) * (mp * w0.z * LO(zp[h].y) + w1.z * LO(zc[h].y) + mn * w2.z * LO(zn[h].y)), HI(cb[h].y) * (mp * w0.w * HI(zp[h].y) + w1.w * HI(zc[h].y) + mn * w2.w * HI(zn[h].y)));
            *(uint2*)(INNER + (size_t)row * 2048 + 1024 + c0) = y; }
#pragma unroll
        for (int h = 0; h < 4; ++h) { zp[h] = zc[h]; zc[h] = zn[h]; }
    }
#undef LO
#undef HI
#undef ZROW
}

template <int MODE>
__device__ void st_rglru_naive(const Params& p, int vb, int nvb, float* lds, const bf16_t* XR, const bf16_t* SG, float* SUMA, float* SUMH, bf16_t* Y) {
    float* xc = lds;
    float* av = xc + 64 * 128;
    float* uv = av + 64 * 128;
    float* hf = uv + 64 * 128;
    const int tid = threadIdx.x, j = tid & 127, tq = tid >> 7;
    const int nitems = MODE == 0 ? NB * NCH * 16 * 2 : NB * 64 * 16;
    for (int it = vb; it < nitems; it += nvb) {
        int bb, c, nb;
        if (MODE == 0) { nb = (it >> 1) & 15; const int bc = it >> 5; c = bc % NCH; bb = bc / NCH; } else { nb = it & 15; const int bc = it >> 4; c = bc & 63; bb = bc >> 6; }
        const int row0 = row_of(bb, c, 0);
        const int seg0 = c < 64 ? bb * 4096 : NLAT + bb * 256, segn = c < 64 ? 4096 : 256;
        const int tl0 = row0 - seg0;
        for (int dd = 0; dd < (MODE == 0 ? 1 : 2); ++dd) {
            const int d = MODE == 0 ? (it & 1) : dd;
            __syncthreads();
            for (int e = tid; e < 64 * 128; e += NTHREADS) { const int t = e >> 7, i = e & 127, ch = nb * 128 + i; float a = p.o_conv_b[d * 2048 + ch];
#pragma unroll
                for (int jj = 0; jj < 4; ++jj) { const int tt = d == 0 ? tl0 + t - 3 + jj : tl0 + t + 3 - jj;
                    if (tt >= 0 && tt < segn) a += p.o_conv_w[((size_t)d * 4 + jj) * 2048 + ch] * bf2f(XR[(size_t)(seg0 + tt) * 2048 + ch]); }
                xc[e] = a; }
            __syncthreads();
            const float* WA = p.o_w_a + ((size_t)d * 16 + nb) * 128 * 128; const float* WX = p.o_w_x + ((size_t)d * 16 + nb) * 128 * 128;
            const int ch = nb * 128 + j;
            const float ba = p.o_b_a[d * 2048 + ch], bx = p.o_b_x[d * 2048 + ch], sp = softplusf_(-p.o_lam[d * 2048 + ch]);
            for (int i16 = 0; i16 < 16; ++i16) { const int t = tq * 16 + i16; float ra = ba, rx = bx;
                for (int i = 0; i < 128; ++i) { const float xv = bf2f(f2bf(xc[t * 128 + i])); ra += xv * bf2f(f2bf(WA[i * 128 + j])); rx += xv * bf2f(f2bf(WX[i * 128 + j])); }
                const float r = sigmoidf_(ra), ig = sigmoidf_(rx); const float la = -8.f * r * sp; const float a = __expf(la);
                av[t * 128 + j] = a; uv[t * 128 + j] = sqrtf(-expm1f(2.f * la)) * (ig * xc[t * 128 + j]); }
            __syncthreads();
            if (tid < 128) {
                const size_t sidx = (((size_t)bb * 2 + d) * NCH + c) * 2048 + ch;
                if (MODE == 0) { float A = 1.f, hh = 0.f;
                    if (d == 0) for (int t = 0; t < 64; ++t) { const float a = av[t * 128 + j]; hh = a * hh + uv[t * 128 + j]; A *= a; }
                    else for (int t = 63; t >= 0; --t) { const float a = av[t * 128 + j]; hh = a * hh + uv[t * 128 + j]; A *= a; }
                    SUMA[sidx] = A; SUMH[sidx] = hh;
                } else { float hh = SUMH[sidx];
                    if (d == 0) for (int t = 0; t < 64; ++t) { hh = av[t * 128 + j] * hh + uv[t * 128 + j]; hf[t * 128 + j] = hh; }
                    else for (int t = 63; t >= 0; --t) { hh = av[t * 128 + j] * hh + uv[t * 128 + j]; const size_t o = (size_t)(row0 + t) * 2048 + ch; Y[o] = f2bf((hf[t * 128 + j] + hh) * bf2f(SG[o])); }
                }
            }
        }
    }
    __syncthreads();
}
__device__ void st_carry(const Params& p, int vb, int nvb, const float* SUMA, float* SUMH) {
    for (int e = vb * NTHREADS + threadIdx.x; e < NB * 2 * 2048; e += nvb * NTHREADS) {
        const int ch = e & 2047, d = (e >> 11) & 1, bb = e >> 12; float hh = 0.f;
        for (int s0 = 0; s0 < NCH; s0 += 17) {
            float A[17], H[17];
#pragma unroll
            for (int i = 0; i < 17; ++i) { const int step = s0 + i, c = d == 0 ? (step < 4 ? 64 + step : step - 4) : 67 - step; const size_t sidx = (((size_t)bb * 2 + d) * NCH + c) * 2048 + ch; A[i] = SUMA[sidx]; H[i] = SUMH[sidx]; }
#pragma unroll
            for (int i = 0; i < 17; ++i) { const int step = s0 + i, c = d == 0 ? (step < 4 ? 64 + step : step - 4) : 67 - step; const size_t sidx = (((size_t)bb * 2 + d) * NCH + c) * 2048 + ch; SUMH[sidx] = hh; hh = A[i] * hh + H[i]; }
        }
    }
}
__device__ void st_final(const Params& p, int vb, int nvb) {
    const int lane = threadIdx.x & 63, gw = vb * (NTHREADS / 64) + (threadIdx.x >> 6), ngw = nvb * (NTHREADS / 64);
    for (int row = gw; row < NLAT; row += ngw) { float* xr = p.out + (size_t)row * 1024; float4 v[4]; float ss = 0.f;
#pragma unroll
        for (int j = 0; j < 4; ++j) { v[j] = *(const float4*)(xr + j * 256 + lane * 4); ss += v[j].x * v[j].x + v[j].y * v[j].y + v[j].z * v[j].z + v[j].w * v[j].w; }
        const float rinv = rsqrtf(wave_sum(ss) * (1.f / 1024.f) + EPS);
#pragma unroll
        for (int j = 0; j < 4; ++j) { const float4 g = *(const float4*)(p.final_g + j * 256 + lane * 4); float4 o; o.x = v[j].x * rinv * g.x; o.y = v[j].y * rinv * g.y; o.z = v[j].z * rinv * g.z; o.w = v[j].w * rinv * g.w; *(float4*)(xr + j * 256 + lane * 4) = o; }
    }
}


namespace pg8 {
#define PG8_LAS __attribute__((address_space(3)))
typedef short bf16x8 __attribute__((ext_vector_type(8)));
typedef float f32x4 __attribute__((ext_vector_type(4)));
typedef unsigned u32x4 __attribute__((ext_vector_type(4)));
constexpr int BM = 256, BK = 64, HALF = 128, HTB = HALF * BK * 2, STAGE_BYTES = 8 * HTB, NXCD = 8, WGM = 8;
__host__ __device__ __forceinline__ int lds_byte(int r, int c) { const int st = (r >> 4) * 2 + (c >> 5), rr = r & 15, cc = c & 31, ob = rr * 64 + cc * 2; return st * 1024 + (ob ^ (((ob >> 9) & 1) << 5)); }
__host__ __device__ __forceinline__ void stage_rc(int b, int& R, int& C) { const int st = b / 1024, sb = b % 1024, swz = sb ^ (((sb >> 9) & 1) << 5); R = (st >> 1) * 16 + swz / 64; C = (st & 1) * 32 + (swz % 64) / 2; }
__host__ __device__ __forceinline__ int perm32(int rho) { const int n = rho >> 4, i = rho & 15; return 8 * (i >> 2) + 4 * n + (i & 3); }
struct Unit { int pm, pn, k0, nk; };
struct Gemm { const bf16_t* A; const bf16_t* Bt; int M, N, K; };
struct TileOrder {
    int nM, nN, nwg, G, c, m0, split, base0, base1, nkfull, nM2, nN2, m02, nKS, nk2, tail_first;
    __device__ void init(int nM_, int nN_, int nkfull_, int G_, int c_, int m0_ = 0, int split_ = 1 << 30, int base0_ = 0, int base1_ = 0, int nM2_ = 0, int nN2_ = 0, int m02_ = 0, int nKS_ = 1, int nk2_ = 0) {
        nM = nM_; nN = nN_; nwg = nM * nN; nkfull = nkfull_; G = G_; c = c_; m0 = m0_; split = split_; base0 = base0_; base1 = base1_; nM2 = nM2_; nN2 = nN2_; m02 = m02_; nKS = nKS_; nk2 = nk2_; tail_first = 0; }
    __device__ bool next(int i, Unit& u) const {
        long L = (long)i * G + c;
        if (tail_first) {
            const int ntail = nM2 * nN2 * nKS;
            if (c < ntail) { if (i == 0) L = (long)nwg + c; else L = (long)(i - 1) * G + c; }
            if (i > 0 && c >= ntail && L >= nwg) return false;
            if (i > 0 && c < ntail && L >= nwg) return false;
        }
        if (L >= nwg) { const long L2 = L - nwg; if (L2 >= (long)nM2 * nN2 * nKS) return false; const int ks = (int)(L2 % nKS), rest = (int)(L2 / nKS);
            u.pm = m02 + rest / nN2; u.pn = rest % nN2; u.k0 = ks * nk2 * 64; u.nk = nk2; return true; }
        int wgid = (int)L; { const int q = nwg / NXCD, r = nwg % NXCD, xcd = wgid % NXCD, off = wgid / NXCD; wgid = (xcd < r ? xcd * (q + 1) : r * (q + 1) + (xcd - r) * q) + off; }
        const int nig = WGM * nN, gid = wgid / nig, fm = gid * WGM, gsz = (nM - fm) < WGM ? (nM - fm) : WGM;
        const int pm = fm + ((wgid % nig) % gsz), j = (wgid % nig) / gsz;
        u.pm = m0 + pm; u.pn = j < split ? base0 + j : base1 + (j - split); u.k0 = 0; u.nk = nkfull; return true;
    }
    __device__ __forceinline__ void a_ready(const Unit&) const {}
    __device__ __forceinline__ void done(const Unit&) const {}
};
typedef float f32x2_t __attribute__((ext_vector_type(2))); typedef __bf16 bf16x2_t __attribute__((ext_vector_type(2)));
__device__ __forceinline__ unsigned cvt_pk_bf16(float lo, float hi) { f32x2_t v = {lo, hi}; bf16x2_t b = __builtin_convertvector(v, bf16x2_t); return __builtin_bit_cast(unsigned, b); }
template <class Epi, class Sched, bool ALIGN_EPI = false, bool SP2 = false>
__device__ __forceinline__ void gemm_phase(PG8_LAS unsigned char* lds, const Gemm g, const Sched& S, const Epi& E) {
    const int tid = threadIdx.x, wid = __builtin_amdgcn_readfirstlane(tid >> 6), lane = tid & 63, wr = wid >> 2, wc = wid & 3, fr = lane & 15, fq = lane >> 4;
    const int K = g.K;
    unsigned voffA[2], voffB[2];
#pragma unroll
    for (int i = 0; i < 2; ++i) { int R, C; stage_rc(tid * 16 + i * 8192, R, C); const int Rb = Epi::PERM ? ((R & ~31) + perm32(R & 31)) : R;
        voffA[i] = (unsigned)(R * K + C) * 2u; voffB[i] = (unsigned)(Rb * K + C) * 2u; }
    const size_t kstep = (size_t)(BK * 2);
    const size_t hstep = (size_t)HALF * K * 2;
    const size_t tstep = 2 * hstep;
    const unsigned ldsw = (unsigned)wid * 1024u;
    const int aoff = lds_byte(wr * 64 + fr, fq * 8), boff = lds_byte(wc * 32 + fr, fq * 8);
#define PG8_SA(b, h) (((b) * 2 + (h)) * HTB)
#define PG8_SB(b, h) ((4 + (b) * 2 + (h)) * HTB)
#define PG8_STAGE(bufoff, gbase, voff) do { _Pragma("unroll") for (int _i = 0; _i < 2; ++_i) \
        __builtin_amdgcn_global_load_lds((const unsigned*)((const char*)(gbase) + (voff)[_i]), (PG8_LAS unsigned*)(lds + (bufoff) + ldsw + _i * 8192), 16, 0, 0); } while (0)
#define PG8_LDA(dst, b, h) do { _Pragma("unroll") for (int m = 0; m < 4; ++m) _Pragma("unroll") for (int k = 0; k < 2; ++k) dst[m][k] = *(const PG8_LAS bf16x8*)(lds + PG8_SA(b, h) + aoff + m * 2048 + k * 1024); } while (0)
#define PG8_LDB(dst, b, h) do { _Pragma("unroll") for (int n = 0; n < 2; ++n) _Pragma("unroll") for (int k = 0; k < 2; ++k) dst[n][k] = *(const PG8_LAS bf16x8*)(lds + PG8_SB(b, h) + boff + n * 2048 + k * 1024); } while (0)
#define PG8_MMA(ai, bj, At, Bt) do { __builtin_amdgcn_s_setprio(1); _Pragma("unroll") for (int m = 0; m < 4; ++m) _Pragma("unroll") for (int n = 0; n < 2; ++n) _Pragma("unroll") for (int k = 0; k < 2; ++k) \
        acc[ai][bj][m][n] = __builtin_amdgcn_mfma_f32_16x16x32_bf16(Bt[n][k], At[m][k], acc[ai][bj][m][n], 0, 0, 0); __builtin_amdgcn_s_setprio(0); } while (0)
#define PG8_WAIT_V(n) asm volatile("s_waitcnt vmcnt(" #n ")" ::: "memory")
#define PG8_WAIT_L(n) asm volatile("s_waitcnt lgkmcnt(" #n ")" ::: "memory")
#define PG8_BAR __builtin_amdgcn_s_barrier()
#define PG8_SCHED __builtin_amdgcn_sched_barrier(0)
    Unit cur, nxt; int ui = 0;
    if (!S.next(0, cur)) return;
    f32x4 acc[2][2][4][2];
#pragma unroll
    for (int a = 0; a < 2; ++a)
#pragma unroll
        for (int b = 0; b < 2; ++b)
#pragma unroll
            for (int m = 0; m < 4; ++m)
#pragma unroll
                for (int n = 0; n < 2; ++n) acc[a][b][m][n] = (f32x4){0.f, 0.f, 0.f, 0.f};
    bf16x8 At[4][2], B0[2][2], B1[2][2];
    const char* cA = (const char*)g.A + (size_t)cur.pm * tstep + (size_t)cur.k0 * 2; const char* cB = (const char*)g.Bt + (size_t)cur.pn * tstep + (size_t)cur.k0 * 2;
    S.a_ready(cur);
    if constexpr (SP2) {
        PG8_STAGE(PG8_SB(0, 0), cB, voffB); PG8_STAGE(PG8_SB(0, 1), cB + hstep, voffB); PG8_STAGE(PG8_SA(0, 0), cA, voffA); PG8_STAGE(PG8_SA(0, 1), cA + hstep, voffA);
        if (wr == 1) PG8_BAR;
        PG8_WAIT_V(2); PG8_BAR;
        PG8_STAGE(PG8_SB(1, 0), cB + kstep, voffB); PG8_STAGE(PG8_SA(1, 0), cA + kstep, voffA); PG8_STAGE(PG8_SB(1, 1), cB + hstep + kstep, voffB);
        PG8_WAIT_V(6); PG8_BAR;
    } else {
        PG8_STAGE(PG8_SB(0, 0), cB, voffB); PG8_STAGE(PG8_SA(0, 0), cA, voffA); PG8_STAGE(PG8_SB(0, 1), cB + hstep, voffB); PG8_STAGE(PG8_SA(0, 1), cA + hstep, voffA);
        if (wr == 1) PG8_BAR;
        PG8_WAIT_V(4); PG8_BAR;
        PG8_STAGE(PG8_SB(1, 0), cB + kstep, voffB); PG8_STAGE(PG8_SA(1, 0), cA + kstep, voffA); PG8_STAGE(PG8_SB(1, 1), cB + hstep + kstep, voffB);
        PG8_WAIT_V(6); PG8_BAR;
    }
    for (;;) {
        const bool has_next = S.next(ui + 1, nxt);
        const char* nA = has_next ? (const char*)g.A + (size_t)nxt.pm * tstep + (size_t)nxt.k0 * 2 : cA; const char* nB = has_next ? (const char*)g.Bt + (size_t)nxt.pn * tstep + (size_t)nxt.k0 * 2 : cB;
        const int nt = cur.nk;
        for (int t = 0; t < nt; t += 2) {
            const bool last = (t == nt - 2);
            const char* a1 = cA + (size_t)(t + 1) * kstep;
            const char* a2 = last ? nA : cA + (size_t)(t + 2) * kstep; const char* b2 = last ? nB : cB + (size_t)(t + 2) * kstep;
            const char* a3 = a2 + kstep; const char* b3 = b2 + kstep;
            if (last && has_next) S.a_ready(nxt);
            if constexpr (SP2) {
            PG8_LDB(B0, 0, 0); PG8_LDB(B1, 0, 1); PG8_SCHED; PG8_LDA(At, 0, 0); PG8_STAGE(PG8_SA(1, 1), a1 + hstep, voffA);
            PG8_WAIT_V(8); PG8_WAIT_L(0); PG8_BAR; PG8_MMA(0, 0, At, B0); PG8_MMA(0, 1, At, B1); PG8_BAR; PG8_SCHED;
            PG8_LDA(At, 0, 1); PG8_STAGE(PG8_SB(0, 0), b2, voffB); PG8_STAGE(PG8_SB(0, 1), b2 + hstep, voffB); PG8_STAGE(PG8_SA(0, 0), a2, voffA);
            PG8_WAIT_V(8); PG8_WAIT_L(0); PG8_BAR; PG8_MMA(1, 0, At, B0); PG8_MMA(1, 1, At, B1); PG8_BAR; PG8_SCHED;
            PG8_LDB(B0, 1, 0); PG8_LDB(B1, 1, 1); PG8_SCHED; PG8_LDA(At, 1, 0); PG8_STAGE(PG8_SA(0, 1), a2 + hstep, voffA);
            PG8_WAIT_V(8); PG8_WAIT_L(0); PG8_BAR; PG8_MMA(0, 0, At, B0); PG8_MMA(0, 1, At, B1); PG8_BAR; PG8_SCHED;
            PG8_LDA(At, 1, 1); PG8_STAGE(PG8_SB(1, 0), b3, voffB); PG8_STAGE(PG8_SB(1, 1), b3 + hstep, voffB); PG8_STAGE(PG8_SA(1, 0), a3, voffA);
            PG8_WAIT_V(8); PG8_WAIT_L(0); PG8_BAR; PG8_MMA(1, 0, At, B0); PG8_MMA(1, 1, At, B1); PG8_BAR; PG8_SCHED;
            } else {
            PG8_LDB(B0, 0, 0); PG8_SCHED; PG8_LDA(At, 0, 0); PG8_STAGE(PG8_SA(1, 1), a1 + hstep, voffA);
            PG8_WAIT_L(8); PG8_BAR; PG8_WAIT_L(0); PG8_MMA(0, 0, At, B0); PG8_BAR; PG8_SCHED;
            PG8_LDB(B1, 0, 1); PG8_STAGE(PG8_SB(0, 0), b2, voffB);
            PG8_BAR; PG8_WAIT_L(0); PG8_MMA(0, 1, At, B1); PG8_BAR;
            PG8_LDA(At, 0, 1); PG8_STAGE(PG8_SA(0, 0), a2, voffA);
            PG8_BAR; PG8_WAIT_L(0); PG8_MMA(1, 0, At, B0); PG8_BAR; PG8_SCHED;
            PG8_STAGE(PG8_SB(0, 1), b2 + hstep, voffB);
            PG8_WAIT_V(6); PG8_BAR; PG8_MMA(1, 1, At, B1); PG8_BAR;
            PG8_LDB(B0, 1, 0); PG8_SCHED; PG8_LDA(At, 1, 0); PG8_STAGE(PG8_SA(0, 1), a2 + hstep, voffA);
            PG8_WAIT_L(8); PG8_BAR; PG8_WAIT_L(0); PG8_MMA(0, 0, At, B0); PG8_BAR; PG8_SCHED;
            PG8_LDB(B1, 1, 1); PG8_STAGE(PG8_SB(1, 0), b3, voffB);
            PG8_BAR; PG8_WAIT_L(0); PG8_MMA(0, 1, At, B1); PG8_BAR;
            PG8_LDA(At, 1, 1); PG8_STAGE(PG8_SA(1, 0), a3, voffA);
            PG8_BAR; PG8_WAIT_L(0); PG8_MMA(1, 0, At, B0); PG8_BAR; PG8_SCHED;
            PG8_STAGE(PG8_SB(1, 1), b3 + hstep, voffB);
            PG8_WAIT_V(6); PG8_BAR; PG8_MMA(1, 1, At, B1); PG8_BAR;
            }
        }
        if constexpr (ALIGN_EPI) { if (wr == 0) PG8_BAR; }
        if constexpr (!Epi::AFTER_DRAIN) { E(acc, cur, wr, wc, fr, fq); S.done(cur); } else { if (has_next) { E(acc, cur, wr, wc, fr, fq); S.done(cur); } }
        if (!has_next) break;
#pragma unroll
        for (int a = 0; a < 2; ++a)
#pragma unroll
            for (int b = 0; b < 2; ++b)
#pragma unroll
                for (int m = 0; m < 4; ++m)
#pragma unroll
                    for (int n = 0; n < 2; ++n) acc[a][b][m][n] = (f32x4){0.f, 0.f, 0.f, 0.f};
        cur = nxt; cA = nA; cB = nB; ++ui;
        if constexpr (ALIGN_EPI) { if (wr == 1) PG8_BAR; }
    }
    PG8_WAIT_V(0);
    if constexpr (!ALIGN_EPI) { if (wr == 0) PG8_BAR; }
    PG8_BAR;
    if constexpr (Epi::AFTER_DRAIN) { E.fused(acc, cur, wr, wc, fr, fq, lds, wid, lane); S.done(cur); }
#undef PG8_SA
#undef PG8_SB
#undef PG8_STAGE
#undef PG8_LDA
#undef PG8_LDB
#undef PG8_MMA
#undef PG8_WAIT_V
#undef PG8_WAIT_L
#undef PG8_BAR
#undef PG8_SCHED
}
}

DEVI pg8::u32x4 pack8(const pg8::f32x4& a, const pg8::f32x4& b) { pg8::u32x4 w; w.x = pg8::cvt_pk_bf16(a[0], a[1]); w.y = pg8::cvt_pk_bf16(a[2], a[3]); w.z = pg8::cvt_pk_bf16(b[0], b[1]); w.w = pg8::cvt_pk_bf16(b[2], b[3]); return w; }
DEVI pg8::f32x4 silu4(const pg8::f32x4& a) { pg8::f32x4 r; r[0] = siluf_(a[0]); r[1] = siluf_(a[1]); r[2] = siluf_(a[2]); r[3] = siluf_(a[3]); return r; }
struct FEpi1 {
    static constexpr bool PERM = true, AFTER_DRAIN = false;
    bf16_t *QK, *V, *SGA, *Z, *CBG; float* ALR; bf16_t* ZA;
    DEVI void operator()(const pg8::f32x4 (&acc)[2][2][4][2], const pg8::Unit& u, int wr, int wc, int fr, int fq) const {
        const int t = u.pn, row0 = u.pm * 256 + wr * 64 + fr, cw = wc * 32 + 8 * fq;
#pragma unroll
        for (int ai = 0; ai < 2; ++ai)
#pragma unroll
            for (int m = 0; m < 4; ++m) {
                const size_t row = (size_t)(row0 + ai * 128 + m * 16);
                if (t < 12) {
                    bf16_t* base = t < 4 ? QK + row * 1024 + t * 256 : (t < 8 ? V + row * 1024 + (t - 4) * 256 : SGA + row * 1024 + (t - 8) * 256);
#pragma unroll
                    for (int bj = 0; bj < 2; ++bj) { pg8::f32x4 v0 = acc[ai][bj][m][0], v1 = acc[ai][bj][m][1]; if (t >= 8) { v0 = silu4(v0); v1 = silu4(v1); }
                        *(pg8::u32x4*)(base + bj * 128 + cw) = pack8(v0, v1); }
                } else if (t == 12) {
                    if (wc == 0) { *(pg8::f32x4*)(ALR + row * 32 + 8 * fq) = acc[ai][0][m][0]; *(pg8::f32x4*)(ALR + row * 32 + 8 * fq + 4) = acc[ai][0][m][1]; }
                } else if (t < 21) {
                    bf16_t* zp = t < 15 ? ZA + row * 256 + (t - 13) * 128 + cw : Z + row * 1024 + (t - 13) * 128 + cw;
                    *(pg8::u32x4*)zp = pack8(acc[ai][0][m][0] * acc[ai][1][m][0], acc[ai][0][m][1] * acc[ai][1][m][1]);
                } else {
                    *(pg8::u32x4*)(CBG + row * 1024 + (t - 21) * 128 + cw) = pack8(acc[ai][0][m][0] * silu4(acc[ai][1][m][0]), acc[ai][0][m][1] * silu4(acc[ai][1][m][1]));
                }
            }
    }
};
template <bool HAS_TAIL> struct FEpiRes {
    static constexpr bool PERM = false, AFTER_DRAIN = false;
    const float* xl; const float* xc; float* outl; float* outc; const float* MODl;
    DEVI void operator()(const pg8::f32x4 (&acc)[2][2][4][2], const pg8::Unit& u, int wr, int wc, int fr, int fq) const {
        const int row0 = u.pm * 256 + wr * 64 + fr, col0 = u.pn * 256 + wc * 32 + 4 * fq;
        const bool lat = u.pm < NLAT / 256;
        const float* gate = MODl + (size_t)(lat ? (u.pm >> 4) : 4) * 3072 + 2048 + col0;
        pg8::f32x4 gv[2][2];
#pragma unroll
        for (int bj = 0; bj < 2; ++bj)
#pragma unroll
            for (int n = 0; n < 2; ++n) gv[bj][n] = *(const pg8::f32x4*)(gate + bj * 128 + n * 16);
        if (HAS_TAIL && !lat) {
            float* o = outc + (size_t)(u.k0 >> 8) * NCTX * 1024 - (size_t)NLAT * 1024;
#pragma unroll
            for (int ai = 0; ai < 2; ++ai)
#pragma unroll
                for (int m = 0; m < 4; ++m) { const size_t off = (size_t)(row0 + ai * 128 + m * 16) * 1024 + col0;
#pragma unroll
                    for (int bj = 0; bj < 2; ++bj)
#pragma unroll
                        for (int n = 0; n < 2; ++n) *(pg8::f32x4*)(o + off + bj * 128 + n * 16) = acc[ai][bj][m][n]; }
            return;
        }
        const float* xin = xl; float* o = outl;
#pragma unroll
        for (int ai = 0; ai < 2; ++ai)
#pragma unroll
            for (int m = 0; m < 4; ++m) { const size_t off = (size_t)(row0 + ai * 128 + m * 16) * 1024 + col0;
#pragma unroll
                for (int bj = 0; bj < 2; ++bj)
#pragma unroll
                    for (int n = 0; n < 2; ++n) { const pg8::f32x4 xv = *(const pg8::f32x4*)(xin + off + bj * 128 + n * 16); *(pg8::f32x4*)(o + off + bj * 128 + n * 16) = xv + gv[bj][n] * acc[ai][bj][m][n]; } }
    }
};
struct FEpi3 {
    static constexpr bool PERM = true, AFTER_DRAIN = false;
    bf16_t* XR; bf16_t* SG; float* XRC;
    DEVI void operator()(const pg8::f32x4 (&acc)[2][2][4][2], const pg8::Unit& u, int wr, int wc, int fr, int fq) const {
        const int t = u.pn, row0 = u.pm * 256 + wr * 64 + fr, cw = wc * 32 + 8 * fq;
        if (u.pm >= NLAT / 256) {
            float* sl = XRC + (size_t)(u.k0 >> 9) * NCTX * 2048;
#pragma unroll
            for (int ai = 0; ai < 2; ++ai)
#pragma unroll
                for (int m = 0; m < 4; ++m) { float* rp = sl + (size_t)(row0 - NLAT + ai * 128 + m * 16) * 2048 + t * 256 + cw;
#pragma unroll
                    for (int bj = 0; bj < 2; ++bj) { *(pg8::f32x4*)(rp + bj * 128) = acc[ai][bj][m][0]; *(pg8::f32x4*)(rp + bj * 128 + 4) = acc[ai][bj][m][1]; } }
            return;
        }
        bf16_t* base = t < 8 ? XR + (size_t)xr_pad_of_tile(u.pm) * 2048 + t * 256 : SG + (t - 8) * 256;
#pragma unroll
        for (int ai = 0; ai < 2; ++ai)
#pragma unroll
            for (int m = 0; m < 4; ++m) { bf16_t* rp = base + (size_t)(row0 + ai * 128 + m * 16) * 2048 + cw;
#pragma unroll
                for (int bj = 0; bj < 2; ++bj) { pg8::f32x4 v0 = acc[ai][bj][m][0], v1 = acc[ai][bj][m][1]; if (t >= 8) { v0 = silu4(v0); v1 = silu4(v1); }
                    *(pg8::u32x4*)(rp + bj * 128) = pack8(v0, v1); } }
    }
};

struct FEpiResRms {
    static constexpr bool PERM = false, AFTER_DRAIN = true;
    const float* xin; float* out; const float* MODl; const float* gfin; float* slots; unsigned* cnt;
    DEVI void fused(pg8::f32x4 (&acc)[2][2][4][2], const pg8::Unit& u, int wr, int wc, int fr, int fq, PG8_LAS unsigned char* lds, int wid, int lane) const {
        const int row0 = u.pm * 256 + wr * 64 + fr, col0 = u.pn * 256 + wc * 32 + 4 * fq;
        const float* gate = MODl + (size_t)(u.pm >> 4) * 3072 + 2048 + col0;
        PG8_LAS float* P = (PG8_LAS float*)lds;
        PG8_LAS float* S = (PG8_LAS float*)(lds + 8192);
        { pg8::f32x4 gv[2][2];
#pragma unroll
          for (int bj = 0; bj < 2; ++bj)
#pragma unroll
              for (int n = 0; n < 2; ++n) gv[bj][n] = *(const pg8::f32x4*)(gate + bj * 128 + n * 16);
#pragma unroll
          for (int ai = 0; ai < 2; ++ai)
#pragma unroll
              for (int m = 0; m < 4; ++m) { const float* xp = xin + (size_t)(row0 + ai * 128 + m * 16) * 1024 + col0;
#pragma unroll
                  for (int bj = 0; bj < 2; ++bj)
#pragma unroll
                      for (int n = 0; n < 2; ++n) { const pg8::f32x4 xv = *(const pg8::f32x4*)(xp + bj * 128 + n * 16); acc[ai][bj][m][n] = xv + gv[bj][n] * acc[ai][bj][m][n]; }
                  asm volatile("" : "+v"(acc[ai][0][m][0]), "+v"(acc[ai][0][m][1]), "+v"(acc[ai][1][m][0]), "+v"(acc[ai][1][m][1]));
                  if (m & 1) asm volatile("" ::: "memory"); } }
#pragma unroll
        for (int ai = 0; ai < 2; ++ai)
#pragma unroll
            for (int m = 0; m < 4; ++m) { float q = 0.f;
#pragma unroll
                for (int bj = 0; bj < 2; ++bj)
#pragma unroll
                    for (int n = 0; n < 2; ++n) { const pg8::f32x4 x = acc[ai][bj][m][n]; q += (x[0] * x[0] + x[1] * x[1]) + (x[2] * x[2] + x[3] * x[3]); }
                q += __shfl_xor(q, 16); q += __shfl_xor(q, 32);
                if (fq == 0) P[(ai * 128 + wr * 64 + m * 16 + fr) * 4 + wc] = q; }
        asm volatile("s_waitcnt lgkmcnt(0)" ::: "memory"); __builtin_amdgcn_s_barrier(); asm volatile("" ::: "memory");
        const int row = wid * 32 + (lane & 31);
        if (lane < 32) { const float t = (P[row * 4 + 0] + P[row * 4 + 1]) + (P[row * 4 + 2] + P[row * 4 + 3]);
            __hip_atomic_store(slots + ((size_t)(u.pm * 256 + row) * 4 + u.pn), t, __ATOMIC_RELAXED, __HIP_MEMORY_SCOPE_AGENT); }
        asm volatile("s_waitcnt vmcnt(0)" ::: "memory");
        if (lane == 0) __hip_atomic_fetch_add(cnt + 64 * u.pm, 1u, __ATOMIC_RELAXED, __HIP_MEMORY_SCOPE_AGENT);
        if (wid == 0) { unsigned sp = 0;
            while ((unsigned)__builtin_amdgcn_readfirstlane(__hip_atomic_load(cnt + 64 * u.pm, __ATOMIC_RELAXED, __HIP_MEMORY_SCOPE_AGENT)) < 32u) { __builtin_amdgcn_s_sleep(2); if (++sp > (1u << 22)) break; }
            __builtin_amdgcn_fence(__ATOMIC_ACQUIRE, "agent"); }
        asm volatile("s_waitcnt vmcnt(0) lgkmcnt(0)" ::: "memory"); __builtin_amdgcn_s_barrier(); asm volatile("" ::: "memory");
        if (lane < 32) { const float* sl = slots + (size_t)(u.pm * 256 + row) * 4; float t = 0.f;
#pragma unroll
            for (int k = 0; k < 4; ++k) t += __hip_atomic_load(sl + k, __ATOMIC_RELAXED, __HIP_MEMORY_SCOPE_AGENT);
            S[row] = rsqrtf(t * (1.f / 1024.f) + EPS); }
        asm volatile("s_waitcnt lgkmcnt(0)" ::: "memory"); __builtin_amdgcn_s_barrier(); asm volatile("" ::: "memory");
        pg8::f32x4 gf[2][2];
#pragma unroll
        for (int bj = 0; bj < 2; ++bj)
#pragma unroll
            for (int n = 0; n < 2; ++n) gf[bj][n] = *(const pg8::f32x4*)(gfin + col0 + bj * 128 + n * 16);
#pragma unroll
        for (int ai = 0; ai < 2; ++ai)
#pragma unroll
            for (int m = 0; m < 4; ++m) { const int r = ai * 128 + wr * 64 + m * 16 + fr; const float rinv = S[r]; const size_t off = (size_t)(u.pm * 256 + r) * 1024 + col0;
#pragma unroll
                for (int bj = 0; bj < 2; ++bj)
#pragma unroll
                    for (int n = 0; n < 2; ++n) *(pg8::f32x4*)(out + off + bj * 128 + n * 16) = acc[ai][bj][m][n] * rinv * gf[bj][n]; }
    }
    DEVI void operator()(const pg8::f32x4 (&)[2][2][4][2], const pg8::Unit&, int, int, int, int) const {}
};

struct FEpiResMod {
    static constexpr bool PERM = false, AFTER_DRAIN = true;
    const float* xin; float* x1; bf16_t* H1; const float* MOD0; const float* MOD1; const float* g1; float* slab; float* slots; unsigned* cnt;
    DEVI void operator()(const pg8::f32x4 (&acc)[2][2][4][2], const pg8::Unit& u, int wr, int wc, int fr, int fq) const {
        if (u.pm < NLAT / 256) return;
        const int row0 = u.pm * 256 + wr * 64 + fr, col0 = u.pn * 256 + wc * 32 + 4 * fq;
        float* o = slab + (size_t)(u.k0 >> 8) * NCTX * 1024 - (size_t)NLAT * 1024;
#pragma unroll
        for (int ai = 0; ai < 2; ++ai)
#pragma unroll
            for (int m = 0; m < 4; ++m) { const size_t off = (size_t)(row0 + ai * 128 + m * 16) * 1024 + col0;
#pragma unroll
                for (int bj = 0; bj < 2; ++bj)
#pragma unroll
                    for (int n = 0; n < 2; ++n) *(pg8::f32x4*)(o + off + bj * 128 + n * 16) = acc[ai][bj][m][n]; }
    }
    DEVI void fused(pg8::f32x4 (&acc)[2][2][4][2], const pg8::Unit& u, int wr, int wc, int fr, int fq, PG8_LAS unsigned char* lds, int wid, int lane) const {
        typedef unsigned u32x2v __attribute__((ext_vector_type(2)));
        const int row0 = u.pm * 256 + wr * 64 + fr, col0 = u.pn * 256 + wc * 32 + 4 * fq, b = u.pm >> 4;
        PG8_LAS float* P = (PG8_LAS float*)lds; PG8_LAS float* S = (PG8_LAS float*)(lds + 8192);
        { const float* gate = MOD0 + (size_t)b * 3072 + 2048 + col0; pg8::f32x4 gv[2][2];
#pragma unroll
          for (int bj = 0; bj < 2; ++bj)
#pragma unroll
              for (int n = 0; n < 2; ++n) gv[bj][n] = *(const pg8::f32x4*)(gate + bj * 128 + n * 16);
#pragma unroll
          for (int ai = 0; ai < 2; ++ai)
#pragma unroll
              for (int m = 0; m < 4; ++m) { const size_t off = (size_t)(row0 + ai * 128 + m * 16) * 1024 + col0;
#pragma unroll
                  for (int bj = 0; bj < 2; ++bj)
#pragma unroll
                      for (int n = 0; n < 2; ++n) { const pg8::f32x4 xv = *(const pg8::f32x4*)(xin + off + bj * 128 + n * 16); acc[ai][bj][m][n] = xv + gv[bj][n] * acc[ai][bj][m][n]; *(pg8::f32x4*)(x1 + off + bj * 128 + n * 16) = acc[ai][bj][m][n]; }
                  asm volatile("" : "+v"(acc[ai][0][m][0]), "+v"(acc[ai][0][m][1]), "+v"(acc[ai][1][m][0]), "+v"(acc[ai][1][m][1]));
                  if (m & 1) asm volatile("" ::: "memory"); } }
#pragma unroll
        for (int ai = 0; ai < 2; ++ai)
#pragma unroll
            for (int m = 0; m < 4; ++m) { float q = 0.f;
#pragma unroll
                for (int bj = 0; bj < 2; ++bj)
#pragma unroll
                    for (int n = 0; n < 2; ++n) { const pg8::f32x4 x = acc[ai][bj][m][n]; q += (x[0] * x[0] + x[1] * x[1]) + (x[2] * x[2] + x[3] * x[3]); }
                q += __shfl_xor(q, 16); q += __shfl_xor(q, 32);
                if (fq == 0) P[(ai * 128 + wr * 64 + m * 16 + fr) * 4 + wc] = q; }
        asm volatile("s_waitcnt lgkmcnt(0)" ::: "memory"); __builtin_amdgcn_s_barrier(); asm volatile("" ::: "memory");
        const int row = wid * 32 + (lane & 31);
        if (lane < 32) { const float t = (P[row * 4 + 0] + P[row * 4 + 1]) + (P[row * 4 + 2] + P[row * 4 + 3]);
            __hip_atomic_store(slots + ((size_t)(u.pm * 256 + row) * 4 + u.pn), t, __ATOMIC_RELAXED, __HIP_MEMORY_SCOPE_AGENT); }
        asm volatile("s_waitcnt vmcnt(0)" ::: "memory");
        if (lane == 0) __hip_atomic_fetch_add(cnt + 64 * u.pm, 1u, __ATOMIC_RELAXED, __HIP_MEMORY_SCOPE_AGENT);
        if (wid == 0) { unsigned sp = 0;
            while ((unsigned)__builtin_amdgcn_readfirstlane(__hip_atomic_load(cnt + 64 * u.pm, __ATOMIC_RELAXED, __HIP_MEMORY_SCOPE_AGENT)) < 32u) { __builtin_amdgcn_s_sleep(2); if (++sp > (1u << 22)) break; }
            __builtin_amdgcn_fence(__ATOMIC_ACQUIRE, "agent"); }
        asm volatile("s_waitcnt vmcnt(0) lgkmcnt(0)" ::: "memory"); __builtin_amdgcn_s_barrier(); asm volatile("" ::: "memory");
        if (lane < 32) { const float* sl = slots + (size_t)(u.pm * 256 + row) * 4; float t = 0.f;
#pragma unroll
            for (int k = 0; k < 4; ++k) t += __hip_atomic_load(sl + k, __ATOMIC_RELAXED, __HIP_MEMORY_SCOPE_AGENT);
            S[row] = rsqrtf(t * (1.f / 1024.f) + EPS); }
        asm volatile("s_waitcnt lgkmcnt(0)" ::: "memory"); __builtin_amdgcn_s_barrier(); asm volatile("" ::: "memory");
        const float* md = MOD1 + (size_t)b * 3072 + col0;
#pragma unroll
        for (int bj = 0; bj < 2; ++bj)
#pragma unroll
            for (int n = 0; n < 2; ++n) { const int co = bj * 128 + n * 16; const pg8::f32x4 gg = *(const pg8::f32x4*)(g1 + col0 + co), sh = *(const pg8::f32x4*)(md + co), sc = *(const pg8::f32x4*)(md + 1024 + co);
                const pg8::f32x4 mul = gg * (sc + 1.0f);
#pragma unroll
                for (int ai = 0; ai < 2; ++ai)
#pragma unroll
                    for (int m = 0; m < 4; ++m) { const int r = ai * 128 + wr * 64 + m * 16 + fr; const pg8::f32x4 hv = acc[ai][bj][m][n] * S[r] * mul + sh;
                        u32x2v w; w.x = pg8::cvt_pk_bf16(hv[0], hv[1]); w.y = pg8::cvt_pk_bf16(hv[2], hv[3]); *(u32x2v*)(H1 + (size_t)(u.pm * 256 + r) * 1024 + col0 + co) = w; } }
    }
};
#ifndef FAST_GEMM
#define FAST_GEMM 1
#endif


#define LASP __attribute__((address_space(3)))
__device__ void st_glawalk(const Params& p, int vb, int nvb, unsigned char* lds_, const bf16_t* QIN, const bf16_t* KET, const bf16_t* SC, const float* DEC, const bf16_t* VT, bf16_t* OF, bf16_t* OB) {
    typedef pg8::bf16x8 bx8; typedef pg8::f32x4 f4; typedef unsigned u32x2 __attribute__((ext_vector_type(2))); typedef pg8::u32x4 u4;
    LASP unsigned char* lds = (LASP unsigned char*)lds_;
    constexpr int QOFF = 0, KOFF = 17408, SOFF = KOFF + 18432, VOFF = SOFF + 9216, DOFF = VOFF + 4608, BUFSZ = 50176;
    const int tid = threadIdx.x, wid = __builtin_amdgcn_readfirstlane(tid >> 6), lane = tid & 63, c = lane & 15, g = lane >> 4;
    for (int it0 = vb; it0 < 256; it0 += nvb) {
        const int item = (nvb == 256) ? ((it0 & 7) * 32 + (it0 >> 3)) : it0;
        const int vs = item & 7, combo = item >> 3, d = combo & 1, h = (combo >> 1) & 3, bb = combo >> 3;
        LDS_BARRIER();
        if (wid >= 2) {
            const int lt = tid - 128;
            unsigned long long cst[8]; unsigned mult[8]; int doff[8];
#pragma unroll
            for (int j = 0; j < 8; ++j) { const int pp = lt + 384 * j;
                if (pp < 1024) { cst[j] = (unsigned long long)QIN + (pp >> 4) * 256 + (pp & 15) * 16; mult[j] = 16384u; doff[j] = QOFF + (pp >> 4) * 272 + (pp & 15) * 16; }
                else if (pp < 2048) { const int q = pp - 1024; cst[j] = (unsigned long long)KET + (q >> 3) * 128 + (q & 7) * 16; mult[j] = 16384u; doff[j] = KOFF + (q >> 3) * 144 + (q & 7) * 16; }
                else if (pp < 2560) { const int q = pp - 2048; cst[j] = (unsigned long long)SC + (q >> 3) * 128 + (q & 7) * 16; mult[j] = 8192u; doff[j] = SOFF + (q >> 3) * 144 + (q & 7) * 16; }
                else if (pp < 2816) { const int q = pp - 2560; cst[j] = (unsigned long long)VT + (vs * 32 + (q >> 3)) * 128 + (q & 7) * 16 - (unsigned long long)d * 16384; mult[j] = 16384u; doff[j] = VOFF + (q >> 3) * 144 + (q & 7) * 16; }
                else if (pp < 2848) { const int q = pp - 2816; cst[j] = (unsigned long long)DEC + q * 16; mult[j] = 512u; doff[j] = DOFF + q * 16; }
                else { cst[j] = (unsigned long long)DEC; mult[j] = 0u; doff[j] = -1; } }
            u4 r0[8], r1[8];
#define GW_LOAD(R, step) do { const int cc_ = d == 0 ? ((step) < 4 ? 64 + (step) : (step) - 4) : 67 - (step); const unsigned u_ = (unsigned)(((bb * NCH + cc_) * 4 + h) * 2 + d); \
                _Pragma("unroll") for (int j_ = 0; j_ < 8; ++j_) R[j_] = *(const u4*)(cst[j_] + (unsigned long long)u_ * mult[j_]); } while (0)
#define GW_WRITE(R, bufi) do { LASP unsigned char* b_ = lds + (bufi) * BUFSZ; _Pragma("unroll") for (int j_ = 0; j_ < 8; ++j_) if (doff[j_] >= 0) *(LASP u4*)(b_ + doff[j_]) = R[j_]; } while (0)
            GW_LOAD(r0, 0); GW_WRITE(r0, 0); GW_LOAD(r0, 1); GW_LOAD(r1, 2);
            LDS_BARRIER();
            for (int step = 0; step < NCH; step += 2) {
                GW_WRITE(r0, 1); if (step + 3 < NCH) GW_LOAD(r0, step + 3);
                LDS_BARRIER();
                if (step + 2 < NCH) { GW_WRITE(r1, 0); if (step + 4 < NCH) GW_LOAD(r1, step + 4); }
                LDS_BARRIER();
            }
#undef GW_LOAD
#undef GW_WRITE
        } else {
            f4 S[8];
#pragma unroll
            for (int m = 0; m < 8; ++m) S[m] = (f4){0.f, 0.f, 0.f, 0.f};
            bf16_t* O = d == 0 ? OF : OB;
            LDS_BARRIER();
            for (int step = 0; step < NCH; ++step) {
                const LASP unsigned char* B = lds + (step & 1) * BUFSZ;
#define SB0() __builtin_amdgcn_sched_barrier(0)
#define RDQ(dst_lo, dst_hi, ks) do { _Pragma("unroll") for (int mt = 0; mt < 4; ++mt) { const LASP unsigned char* qa = B + QOFF + (16 * mt + c) * 272 + (32 * (ks) + 4 * g) * 2; dst_lo[mt] = *(const LASP u32x2*)qa; dst_hi[mt] = *(const LASP u32x2*)(qa + 32); } } while (0)
#define MMQ(lo, hi, ks) do { _Pragma("unroll") for (int mt = 0; mt < 4; ++mt) { u4 w; w.x = lo[mt].x; w.y = lo[mt].y; w.z = hi[mt].x; w.w = hi[mt].y; o[mt] = __builtin_amdgcn_mfma_f32_16x16x32_bf16(sB[ks], __builtin_bit_cast(bx8, w), o[mt], 0, 0, 0); } } while (0)
#define RDK(kf, dv, m0) do { _Pragma("unroll") for (int mm = 0; mm < 4; ++mm) { const LASP unsigned char* ka = B + KOFF + (16 * ((m0) + mm) + c) * 144 + g * 16; kf[mm][0] = *(const LASP bx8*)ka; kf[mm][1] = *(const LASP bx8*)(ka + 64); dv[mm] = *(const LASP f4*)(B + DOFF + (16 * ((m0) + mm) + 4 * g) * 4); } } while (0)
#define MMK(kf, dv, m0) do { _Pragma("unroll") for (int mm = 0; mm < 4; ++mm) { S[(m0) + mm] = S[(m0) + mm] * dv[mm]; S[(m0) + mm] = __builtin_amdgcn_mfma_f32_16x16x32_bf16(kf[mm][0], bv0, S[(m0) + mm], 0, 0, 0); S[(m0) + mm] = __builtin_amdgcn_mfma_f32_16x16x32_bf16(kf[mm][1], bv1, S[(m0) + mm], 0, 0, 0); } } while (0)
                const bx8 bv0 = *(const LASP bx8*)(B + VOFF + (16 * wid + c) * 144 + g * 16), bv1 = *(const LASP bx8*)(B + VOFF + (16 * wid + c) * 144 + 64 + g * 16);
                u32x2 qa_lo[4], qa_hi[4], qb_lo[4], qb_hi[4];
                RDQ(qa_lo, qa_hi, 0); RDQ(qb_lo, qb_hi, 1);
                bx8 sB[4];
#pragma unroll
                for (int ks = 0; ks < 4; ++ks) { u4 w; w.x = pg8::cvt_pk_bf16(S[2 * ks][0], S[2 * ks][1]); w.y = pg8::cvt_pk_bf16(S[2 * ks][2], S[2 * ks][3]);
                    w.z = pg8::cvt_pk_bf16(S[2 * ks + 1][0], S[2 * ks + 1][1]); w.w = pg8::cvt_pk_bf16(S[2 * ks + 1][2], S[2 * ks + 1][3]); sB[ks] = __builtin_bit_cast(bx8, w); }
                f4 o[4];
#pragma unroll
                for (int mt = 0; mt < 4; ++mt) o[mt] = (f4){0.f, 0.f, 0.f, 0.f};
                SB0();
                MMQ(qa_lo, qa_hi, 0); SB0();
                RDQ(qa_lo, qa_hi, 2); SB0();
                MMQ(qb_lo, qb_hi, 1); SB0();
                RDQ(qb_lo, qb_hi, 3); SB0();
                MMQ(qa_lo, qa_hi, 2); SB0();
                bx8 sf[4][2];
#pragma unroll
                for (int mt = 0; mt < 4; ++mt) { const LASP unsigned char* sa = B + SOFF + (16 * mt + c) * 144 + g * 16; sf[mt][0] = *(const LASP bx8*)sa; sf[mt][1] = *(const LASP bx8*)(sa + 64); }
                SB0();
                MMQ(qb_lo, qb_hi, 3); SB0();
                bx8 kfa[4][2], kfb[4][2]; f4 dva[4], dvb[4];
                RDK(kfa, dva, 0); SB0();
#pragma unroll
                for (int mt = 0; mt < 4; ++mt) { o[mt] = __builtin_amdgcn_mfma_f32_16x16x32_bf16(bv0, sf[mt][0], o[mt], 0, 0, 0); o[mt] = __builtin_amdgcn_mfma_f32_16x16x32_bf16(bv1, sf[mt][1], o[mt], 0, 0, 0); }
                SB0();
                RDK(kfb, dvb, 4); SB0();
                MMK(kfa, dva, 0); SB0();
                MMK(kfb, dvb, 4); SB0();
#undef SB0
#undef RDQ
#undef MMQ
#undef RDK
#undef MMK
                const int cc = d == 0 ? (step < 4 ? 64 + step : step - 4) : 67 - step; const int row0 = row_of(bb, cc, 0);
#pragma unroll
                for (int mt = 0; mt < 4; ++mt) { u32x2 w; w.x = pg8::cvt_pk_bf16(o[mt][0], o[mt][1]); w.y = pg8::cvt_pk_bf16(o[mt][2], o[mt][3]);
                    *(u32x2*)(O + (size_t)(row0 + 16 * mt + c) * 1024 + h * 256 + vs * 32 + 16 * wid + 4 * g) = w; }
                LDS_BARRIER();
            }
        }
    }
}
#ifndef FAST_WALK
#define FAST_WALK 1
#endif

template <int MODE, int DIR>
__device__ __forceinline__ void st_rglru_impl(const Params& p, int vb, int nvb, unsigned char* lds_, const bf16_t* XR, const bf16_t* SG, const bf16_t* BD, float* SUMA, float* SUMH, bf16_t* Y) {
    typedef pg8::bf16x8 bx8; typedef pg8::f32x4 f4; typedef float f32x2v __attribute__((ext_vector_type(2)));
    LASP unsigned char* lds = (LASP unsigned char*)lds_;
    constexpr int AOFF = 0, FOFF = 17408, BUF = 51200, CWOFF = 2 * BUF;
    constexpr int ND = MODE == 0 ? 1 : 2, NCOMBO = MODE == 0 ? 32 : 16, NTILE = MODE == 0 ? NB * NCH : NB * 64;
    const int tid = threadIdx.x, wid = __builtin_amdgcn_readfirstlane(tid >> 6), lane = tid & 63, c = lane & 15, g = lane >> 4, cp = tid & 63, tg = tid >> 6;
    int P, part, cstep, combo0;
    if (nvb >= NCOMBO) { P = nvb / NCOMBO; part = vb / NCOMBO; cstep = NCOMBO; combo0 = vb % NCOMBO; if (part >= P) return; } else { P = 1; part = 0; cstep = nvb; combo0 = vb; }
    for (int combo = combo0; combo < NCOMBO; combo += cstep) {
        if (MODE == 0 && (combo & 1) != DIR) continue;
        const int nb = MODE == 0 ? (combo >> 1) : combo; constexpr int d0 = MODE == 0 ? DIR : 0;
        const int ch = nb * 128 + 16 * wid + c;
        bx8 wa[ND][4], wx[ND][4]; float ba[ND], bxx[ND], k8[ND];
        LDS_BARRIER();
#pragma unroll
        for (int dd = 0; dd < ND; ++dd) { constexpr int dzero = d0; const int d = dzero + dd;
            const bf16_t* wA = BD + ((size_t)(d * 16 + nb) * 128 + 16 * wid + c) * 128 + 8 * g; const bf16_t* wX = wA + (size_t)2 * 16 * 128 * 128;
#pragma unroll
            for (int ks = 0; ks < 4; ++ks) { wa[dd][ks] = *(const bx8*)(wA + 32 * ks); wx[dd][ks] = *(const bx8*)(wX + 32 * ks); }
            ba[dd] = p.o_b_a[d * 2048 + ch]; bxx[dd] = p.o_b_x[d * 2048 + ch]; k8[dd] = 8.f * 1.4426950408889634f * softplusf_(-p.o_lam[d * 2048 + ch]);
            if (tg < 5) { const f32x2v w2 = tg < 4 ? *(const f32x2v*)(p.o_conv_w + ((size_t)d * 4 + tg) * 2048 + nb * 128 + 2 * cp) : *(const f32x2v*)(p.o_conv_b + (size_t)d * 2048 + nb * 128 + 2 * cp);
                *(LASP f32x2v*)(lds + CWOFF + ((dd * 5 + tg) * 128 + 2 * cp) * 4) = w2; } }
        LDS_BARRIER();
        unsigned xr[14]; float cnext[2] = {0.f, 0.f};
#pragma unroll
        for (int jr = 0; jr < 14; ++jr) xr[jr] = 0u;
#define RG_PREF(tile) do { const int bb_ = MODE == 0 ? (tile) / NCH : (tile) >> 6, cc_ = MODE == 0 ? (tile) % NCH : (tile) & 63; const int row0_ = row_of(bb_, cc_, 0); \
            const bf16_t* xp_ = XR + (size_t)(row0_ + xr_pad_of_tile(row0_ >> 8) + 8 * tg - 3) * 2048 + nb * 128 + 2 * cp; \
            _Pragma("unroll") for (int jr = 0; jr < 14; ++jr) { if (MODE == 1 || (d0 == 0 ? jr < 11 : jr >= 3)) xr[jr] = *(const unsigned*)(xp_ + (size_t)jr * 2048); } \
            if (MODE == 1) { cnext[0] = SUMH[(((size_t)bb_ * 2 + 0) * NCH + cc_) * 2048 + ch]; cnext[1] = SUMH[(((size_t)bb_ * 2 + 1) * NCH + cc_) * 2048 + ch]; } } while (0)
        int it = 0;
        if (part < NTILE) RG_PREF(part);
        for (int tile = part; tile < NTILE; tile += P) {
            const int bb = MODE == 0 ? tile / NCH : tile >> 6, cc = MODE == 0 ? tile % NCH : tile & 63; const int row0 = row_of(bb, cc, 0);
            unsigned xcur[14]; float ccur[2];
#pragma unroll
            for (int jr = 0; jr < 14; ++jr) xcur[jr] = xr[jr];
            ccur[0] = cnext[0]; ccur[1] = cnext[1];
            if (tile + P < NTILE) RG_PREF(tile + P);
            float hsum[4][4];
#pragma unroll
            for (int dd = 0; dd < ND; ++dd) { constexpr int dzero = d0; const int d = dzero + dd;
                LASP unsigned char* B = lds + (it & 1) * BUF; ++it;
                { f32x2v cv[8]; const f32x2v cbv = *(const LASP f32x2v*)(lds + CWOFF + ((dd * 5 + 4) * 128 + 2 * cp) * 4);
#pragma unroll
                  for (int i = 0; i < 8; ++i) cv[i] = cbv;
#pragma unroll
                  for (int jj = 0; jj < 4; ++jj) { const f32x2v cwv = *(const LASP f32x2v*)(lds + CWOFF + ((dd * 5 + jj) * 128 + 2 * cp) * 4);
#pragma unroll
                      for (int i = 0; i < 8; ++i) { const int jr = d == 0 ? i + jj : i + 6 - jj; cv[i].x += cwv.x * __uint_as_float(xcur[jr] << 16); cv[i].y += cwv.y * __uint_as_float(xcur[jr] & 0xffff0000u); } }
#pragma unroll
                  for (int i = 0; i < 8; ++i) { const int rho = 16 * (2 * (tg & 1) + (i >> 2)) + 4 * (tg >> 1) + (i & 3);
                      *(LASP unsigned*)(B + AOFF + rho * 272 + 4 * cp) = pg8::cvt_pk_bf16(cv[i].x, cv[i].y); *(LASP f32x2v*)(B + FOFF + rho * 528 + 8 * cp) = cv[i]; } }
                LDS_BARRIER();
                const int gl = d == 0 ? g : 3 - g;
                const int src1 = d == 0 ? lane - 16 : lane + 16, src2 = d == 0 ? lane - 32 : lane + 32, srcT = d == 0 ? 48 + c : c;
                const size_t sidx = (((size_t)bb * 2 + d) * NCH + cc) * 2048 + ch;
                float av[16], uv[16]; float pa = 1.f, lh = 0.f;
#pragma unroll
                for (int mtl = 0; mtl < 4; ++mtl) { const int mt = d == 0 ? mtl : 3 - mtl;
                    f4 aam = (f4){0.f, 0.f, 0.f, 0.f}, axm = (f4){0.f, 0.f, 0.f, 0.f};
#pragma unroll
                    for (int ks = 0; ks < 4; ++ks) { const bx8 af = *(const LASP bx8*)(B + AOFF + (16 * mt + c) * 272 + (32 * ks + 8 * g) * 2);
                        aam = __builtin_amdgcn_mfma_f32_16x16x32_bf16(af, wa[dd][ks], aam, 0, 0, 0); axm = __builtin_amdgcn_mfma_f32_16x16x32_bf16(af, wx[dd][ks], axm, 0, 0, 0); }
#pragma unroll
                    for (int sq = 0; sq < 4; ++sq) { const int r = d == 0 ? sq : 3 - sq;
                        const float xv = *(const LASP float*)(B + FOFF + (16 * mt + 4 * g + r) * 528 + (16 * wid + c) * 4);
                        const float rr = sigmoidf_(aam[r] + ba[dd]), ii = sigmoidf_(axm[r] + bxx[dd]);
                        const float a = fexp2_(-k8[dd] * rr), u = __builtin_amdgcn_sqrtf(fmaxf(1.f - a * a, 0.f)) * (ii * xv);
                        lh = a * lh + u; pa *= a; if (MODE == 1) { av[mt * 4 + r] = a; uv[mt * 4 + r] = u; } }
                }
                float XA = pa, XU = lh, tA, tU;
                tA = __shfl(XA, src1); tU = __shfl(XU, src1); if (gl >= 1) { XU = tU * XA + XU; XA = tA * XA; }
                tA = __shfl(XA, src2); tU = __shfl(XU, src2); if (gl >= 2) { XU = tU * XA + XU; XA = tA * XA; }
                if (MODE == 0) { if (gl == 3) { SUMA[sidx] = XA; SUMH[sidx] = XU; } }
                else {
                    float eA = __shfl(XA, src1), eU = __shfl(XU, src1); if (gl == 0) { eA = 1.f; eU = 0.f; }
                    float hh = ccur[dd] * eA + eU;
#pragma unroll
                    for (int mtl = 0; mtl < 4; ++mtl) { const int mt = d == 0 ? mtl : 3 - mtl;
#pragma unroll
                        for (int sq = 0; sq < 4; ++sq) { const int r = d == 0 ? sq : 3 - sq; hh = av[mt * 4 + r] * hh + uv[mt * 4 + r]; if (dd == 0) hsum[mt][r] = hh; else hsum[mt][r] += hh; } }
                }
            }
            if (MODE == 1) {
#pragma unroll
                for (int mt = 0; mt < 4; ++mt)
#pragma unroll
                    for (int r = 0; r < 4; ++r) { const size_t o = (size_t)(row0 + 16 * g + 4 * mt + r) * 2048 + ch; Y[o] = f2bf(hsum[mt][r] * bf2f(SG[o])); }
            }
        }
        LDS_BARRIER();
#undef RG_PREF
    }
}
template <int MODE>
__device__ __forceinline__ void st_rglru(const Params& p, int vb, int nvb, unsigned char* lds_, const bf16_t* XR, const bf16_t* SG, const bf16_t* BD, float* SUMA, float* SUMH, bf16_t* Y) {
    if (MODE == 1) { st_rglru_impl<1, 0>(p, vb, nvb, lds_, XR, SG, BD, SUMA, SUMH, Y); return; }
    const int combo0 = nvb >= 32 ? vb % 32 : vb;
    if (nvb >= 32) { if ((combo0 & 1) == 0) st_rglru_impl<0, 0>(p, vb, nvb, lds_, XR, SG, BD, SUMA, SUMH, Y); else st_rglru_impl<0, 1>(p, vb, nvb, lds_, XR, SG, BD, SUMA, SUMH, Y); }
    else { st_rglru_impl<0, 0>(p, vb, nvb, lds_, XR, SG, BD, SUMA, SUMH, Y); st_rglru_impl<0, 1>(p, vb, nvb, lds_, XR, SG, BD, SUMA, SUMH, Y); }
}
#ifndef FAST_RG
#define FAST_RG 1
#endif


#define RG_CH(dd, step) ((dd) == 0 ? ((step) < 4 ? 64 + (step) : (step) - 4) : 67 - (step))
constexpr int RG_ABUF = 2 * 17408, RG_CWOFF = 2 * RG_ABUF;
__device__ __forceinline__ void rg1p_producer(const Params& p, LASP unsigned char* lds, const bf16_t* XR, int bb, int nb, int pw) {
    typedef float f32x2v __attribute__((ext_vector_type(2)));
    const int lane = threadIdx.x & 63, cp = lane;
    unsigned xr[38];
#define RG_PREF(step) do { _Pragma("unroll") for (int dd = 0; dd < 2; ++dd) { const int row0_ = row_of(bb, RG_CH(dd, step), 0); \
            const unsigned char* ub_ = (const unsigned char*)(XR + (size_t)(row0_ + xr_pad_of_tile(row0_ >> 8) + 16 * pw - 3 + 3 * dd) * 2048 + nb * 128);     \
            _Pragma("unroll") for (int j = 0; j < 19; ++j) xr[dd * 19 + j] = *(const unsigned*)(ub_ + (size_t)j * 4096 + (unsigned)(4 * cp)); } } while (0)
#define RG_CONV(bufi) do { _Pragma("unroll") for (int dd = 0; dd < 2; ++dd) { \
            f32x2v cw4[4]; const f32x2v cbv = *(const LASP f32x2v*)(lds + RG_CWOFF + ((dd * 5 + 4) * 128 + 2 * cp) * 4); \
            _Pragma("unroll") for (int jj = 0; jj < 4; ++jj) cw4[jj] = *(const LASP f32x2v*)(lds + RG_CWOFF + ((dd * 5 + jj) * 128 + 2 * cp) * 4); \
            _Pragma("unroll") for (int hq = 0; hq < 2; ++hq) { f32x2v cv[8]; \
                _Pragma("unroll") for (int i = 0; i < 8; ++i) cv[i] = cbv; \
                _Pragma("unroll") for (int jx = 0; jx < 11; ++jx) { const unsigned xw = xr[dd * 19 + 8 * hq + jx]; const f32x2v xv2 = (f32x2v){__uint_as_float(xw << 16), __uint_as_float(xw & 0xffff0000u)}; \
                    _Pragma("unroll") for (int jj = 0; jj < 4; ++jj) { const int i = dd == 0 ? jx - jj : jx - 3 + jj; if (i >= 0 && i < 8) cv[i] = __builtin_elementwise_fma(cw4[jj], xv2, cv[i]); } } \
                _Pragma("unroll") for (int i = 0; i < 8; ++i) { const int t = 16 * pw + 8 * hq + i, rho = 16 * ((t >> 2) & 3) + 4 * (t >> 4) + (t & 3); \
                    *(LASP unsigned*)(lds + (bufi) * RG_ABUF + dd * 17408 + rho * 272 + 4 * cp) = pg8::cvt_pk_bf16(cv[i].x, cv[i].y); } } } } while (0)
    RG_PREF(0);
    RG_CONV(0);
    RG_PREF(1);
    LDS_BARRIER();
    for (int step = 0; step < NCH; ++step) {
        if (step + 1 < NCH) { RG_CONV((step + 1) & 1); if (step + 2 < NCH) RG_PREF(step + 2); }
        LDS_BARRIER();
    }
#undef RG_PREF
#undef RG_CONV
}
template <int WD>
__device__ __forceinline__ void rg1p_consumer(const Params& p, LASP unsigned char* lds, bf16_t* SGY, bf16_t* HXh, const bf16_t* BD, int bb, int nb, int sl, int nt) {
    typedef pg8::bf16x8 bx8; typedef pg8::f32x4 f4;
    const int lane = threadIdx.x & 63, c = lane & 15, g = lane >> 4;
    const int jch = sl * 32 + nt * 16 + c, ch = nb * 128 + jch;
    bx8 wa[4], wx[4];
    { const bf16_t* wA = BD + ((size_t)(WD * 16 + nb) * 128 + jch) * 128 + 8 * g; const bf16_t* wX = wA + (size_t)2 * 16 * 128 * 128;
#pragma unroll
      for (int ks = 0; ks < 4; ++ks) { wa[ks] = *(const bx8*)(wA + 32 * ks); wx[ks] = *(const bx8*)(wX + 32 * ks); } }
    const float ba = p.o_b_a[WD * 2048 + ch], bxx = p.o_b_x[WD * 2048 + ch], k8 = 8.f * 1.4426950408889634f * softplusf_(-p.o_lam[WD * 2048 + ch]);
    float carry = 0.f;
    const int gl = WD == 0 ? g : 3 - g;
    const int src1 = WD == 0 ? lane - 16 : lane + 16, src2 = WD == 0 ? lane - 32 : lane + 32, srcT = WD == 0 ? 48 + c : c;
    LDS_BARRIER();
    for (int step = 0; step < NCH; ++step) {
        const int cc = RG_CH(WD, step); const bool latent = cc < 64, second = step - 4 > 31;
        const int row0u = row_of(bb, cc, 0);
        const unsigned hoff = (unsigned)(16 * g) * 1024u + (unsigned)(ch & 1023), soff = (unsigned)(16 * g) * 2048u + (unsigned)ch;
        unsigned short hxv[16], sgv[16];
        if (latent && second) {
#pragma unroll
            for (int e = 0; e < 16; ++e) { const bf16_t* hb_ = HXh + (size_t)(row0u + e) * 1024; const bf16_t* sb_ = SGY + (size_t)(row0u + e) * 2048; hxv[e] = hb_[hoff]; sgv[e] = sb_[soff]; } }
        const LASP unsigned char* A = lds + (step & 1) * RG_ABUF + WD * 17408;
        float av[16], uv[16]; float pa = 1.f, lh = 0.f;
#pragma unroll
        for (int ml = 0; ml < 4; ++ml) { const int mt = WD == 0 ? ml : 3 - ml;
            f4 aam = (f4){0.f, 0.f, 0.f, 0.f}, axm = (f4){0.f, 0.f, 0.f, 0.f};
#pragma unroll
            for (int ks = 0; ks < 4; ++ks) { const bx8 af = *(const LASP bx8*)(A + (16 * mt + c) * 272 + (32 * ks + 8 * g) * 2);
                aam = __builtin_amdgcn_mfma_f32_16x16x32_bf16(af, wa[ks], aam, 0, 0, 0); axm = __builtin_amdgcn_mfma_f32_16x16x32_bf16(af, wx[ks], axm, 0, 0, 0); }
            typedef float f2 __attribute__((ext_vector_type(2)));
            float am[4], um[4];
#pragma unroll
            for (int hp = 0; hp < 2; ++hp) {
                const f2 xv2 = (f2){bf2f(*(const LASP unsigned short*)(A + (16 * mt + 4 * g + 2 * hp) * 272 + jch * 2)), bf2f(*(const LASP unsigned short*)(A + (16 * mt + 4 * g + 2 * hp + 1) * 272 + jch * 2))};
                const f2 ta = ((f2){aam[2 * hp], aam[2 * hp + 1]} + ba) * (-1.4426950408889634f), tx = ((f2){axm[2 * hp], axm[2 * hp + 1]} + bxx) * (-1.4426950408889634f);
                const f2 pa1 = (f2){fexp2_(ta.x), fexp2_(ta.y)} + 1.0f, px1 = (f2){fexp2_(tx.x), fexp2_(tx.y)} + 1.0f;
                const f2 rr = (f2){frcp_(pa1.x), frcp_(pa1.y)}, ii = (f2){frcp_(px1.x), frcp_(px1.y)};
                const f2 tk = rr * (-k8); const f2 a2 = (f2){fexp2_(tk.x), fexp2_(tk.y)};
                f2 q = __builtin_elementwise_fma(-a2, a2, (f2){1.0f, 1.0f}); q = __builtin_elementwise_max(q, (f2){0.f, 0.f});
                const f2 u2 = (f2){__builtin_amdgcn_sqrtf(q.x), __builtin_amdgcn_sqrtf(q.y)} * (ii * xv2);
                am[2 * hp] = a2.x; am[2 * hp + 1] = a2.y; um[2 * hp] = u2.x; um[2 * hp + 1] = u2.y; }
#pragma unroll
            for (int sq = 0; sq < 4; ++sq) { const int r = WD == 0 ? sq : 3 - sq; lh = am[r] * lh + um[r]; pa *= am[r]; av[mt * 4 + r] = am[r]; uv[mt * 4 + r] = um[r]; }
        }
        float XA = pa, XU = lh, tA, tU;
        tA = __shfl(XA, src1); tU = __shfl(XU, src1); if (gl >= 1) { XU = tU * XA + XU; XA = tA * XA; }
        tA = __shfl(XA, src2); tU = __shfl(XU, src2); if (gl >= 2) { XU = tU * XA + XU; XA = tA * XA; }
        float eA = __shfl(XA, src1), eU = __shfl(XU, src1); if (gl == 0) { eA = 1.f; eU = 0.f; }
        const float totA = __shfl(XA, srcT), totU = __shfl(XU, srcT);
        if (latent) {
            float hh = carry * eA + eU; float hv[16];
#pragma unroll
            for (int ml = 0; ml < 4; ++ml) { const int mt = WD == 0 ? ml : 3 - ml;
#pragma unroll
                for (int sq = 0; sq < 4; ++sq) { const int r = WD == 0 ? sq : 3 - sq; const int e = mt * 4 + r; hh = av[e] * hh + uv[e]; hv[e] = hh; } }
            if (!second) {
#pragma unroll
                for (int e = 0; e < 16; ++e) { bf16_t* hb_ = HXh + (size_t)(row0u + e) * 1024; hb_[hoff] = (bf16_t)(pg8::cvt_pk_bf16(hv[e], 0.f) & 0xffffu); } }
            else {
#pragma unroll
                for (int e = 0; e < 16; ++e) { bf16_t* sb_ = SGY + (size_t)(row0u + e) * 2048; sb_[soff] = (bf16_t)(pg8::cvt_pk_bf16((__uint_as_float(pg8::cvt_pk_bf16(hv[e], 0.f) << 16) + bf2f(hxv[e])) * bf2f(sgv[e]), 0.f) & 0xffffu); } }
        }
        carry = carry * totA + totU;
        if (step == 35) asm volatile("s_waitcnt vmcnt(0)" ::: "memory");
        LDS_BARRIER();
    }
}
__device__ __forceinline__ void st_rg1p(const Params& p, int vb, int nvb, unsigned char* lds_, const bf16_t* XR, bf16_t* SGY, bf16_t* HX0, bf16_t* HX1, const bf16_t* BD, const float* XRC) {
    typedef float f32x2v __attribute__((ext_vector_type(2)));
    LASP unsigned char* lds = (LASP unsigned char*)lds_;
    const int wid = __builtin_amdgcn_readfirstlane(threadIdx.x >> 6), lane = threadIdx.x & 63;
    for (int it0 = vb; it0 < 256; it0 += nvb) {
        const int item = (nvb == 256) ? ((it0 & 7) * 32 + (it0 >> 3)) : it0;
        const int sl = item & 3, nb = (item >> 2) & 15, bb = item >> 6;
        bf16_t* HXh = nb < 8 ? HX0 : HX1;
        {
          bf16_t* xd = (bf16_t*)XR + (size_t)(NLAT + bb * 256 + 20 + 4 * bb) * 2048 + nb * 128; const float* xs = XRC + (size_t)(bb * 256) * 2048 + nb * 128;
          for (int e = threadIdx.x; e < 256 * 64; e += NTHREADS) { const int r = e >> 6, cpair = e & 63; const float2 v0 = *(const float2*)(xs + (size_t)r * 2048 + 2 * cpair), v1 = *(const float2*)(xs + (size_t)NCTX * 2048 + (size_t)r * 2048 + 2 * cpair); *(unsigned*)(xd + (size_t)r * 2048 + 2 * cpair) = pg8::cvt_pk_bf16(v0.x + v1.x, v0.y + v1.y); }
#pragma unroll
          for (int dd = 0; dd < 2; ++dd)
              if (wid < 5) { const f32x2v w2 = wid < 4 ? *(const f32x2v*)(p.o_conv_w + ((size_t)dd * 4 + wid) * 2048 + nb * 128 + 2 * lane) : *(const f32x2v*)(p.o_conv_b + (size_t)dd * 2048 + nb * 128 + 2 * lane);
                  *(LASP f32x2v*)(lds + RG_CWOFF + ((dd * 5 + wid) * 128 + 2 * lane) * 4) = w2; }
          asm volatile("s_waitcnt vmcnt(0)" ::: "memory"); LDS_BARRIER(); }
        if (wid >= 4) rg1p_producer(p, lds, XR, bb, nb, wid - 4);
        else if (wid < 2) rg1p_consumer<0>(p, lds, SGY, HXh, BD, bb, nb, sl, wid & 1);
        else rg1p_consumer<1>(p, lds, SGY, HXh, BD, bb, nb, sl, wid & 1);
    }
}
#define XB_TMO      128
#define XB_XCNT(j)  (256  + 64 * (j))
#define XB_XSUB(j)  (1280 + 64 * (j))
#define XB_XGEN(j)  (2304 + 64 * (j))
#define XB_TOP      3328
#define XB_TOPGEN   3392
#define XB_SPIN_CAP (1u << 20)
DEVI unsigned xb_ld(unsigned* p)              { return __hip_atomic_load(p, __ATOMIC_RELAXED, __HIP_MEMORY_SCOPE_AGENT); }
DEVI unsigned xb_add(unsigned* p, unsigned v) { return __hip_atomic_fetch_add(p, v, __ATOMIC_RELAXED, __HIP_MEMORY_SCOPE_AGENT); }
DEVI unsigned xb_xcc_id() { return (unsigned)__builtin_amdgcn_s_getreg((3 << 11) | 20) & 0xFu; }
#define XB_SPIN(cond, bar) do { unsigned _sp = 0; while (cond) { __builtin_amdgcn_s_sleep(1); \
    if ((++_sp & 255u) == 0u) { if (xb_ld(&(bar)[XB_TMO])) break; if (_sp > XB_SPIN_CAP) { atomicAdd(&(bar)[XB_TMO], 1u); break; } } } } while (0)
struct XcdBarrier { unsigned* bar; unsigned x; volatile __attribute__((address_space(3))) unsigned* st; };
DEVI XcdBarrier xcd_barrier_post(unsigned* bar, volatile __attribute__((address_space(3))) unsigned* st) {
    XcdBarrier b; b.bar = bar; b.x = xb_xcc_id(); b.st = st;
    if (threadIdx.x == 0) (void)xb_add(&bar[XB_XCNT(b.x)], 1u);
    return b;
}
DEVI void xcd_barrier_complete(unsigned* bar, unsigned x, unsigned& nloc, unsigned& nx) {
    const unsigned G = gridDim.x * gridDim.y * gridDim.z;
    unsigned sum, cnt, mine, sp = 0u;
    for (;;) {
        sum = 0u; cnt = 0u; mine = 0u;
#pragma unroll
        for (unsigned j = 0; j < 16; ++j) { const unsigned c = xb_ld(&bar[XB_XCNT(j)]); sum += c; cnt += (c > 0u) ? 1u : 0u; mine = (j == x) ? c : mine; }
        if (sum == G) break;
        __builtin_amdgcn_s_sleep(1);
        if ((++sp & 255u) == 0u) { if (xb_ld(&bar[XB_TMO])) break; if (sp > XB_SPIN_CAP) { atomicAdd(&bar[XB_TMO], 1u); break; } }
    }
    nloc = mine > 0u ? mine : 1u; nx = cnt > 0u ? cnt : 1u;
}
DEVI void xcd_barrier(const XcdBarrier& b) {
    asm volatile("s_waitcnt vmcnt(0)" ::: "memory");
    __syncthreads();
    if (threadIdx.x == 0) {
        unsigned* bar = b.bar;
        __builtin_amdgcn_s_waitcnt(0);
        unsigned nloc = b.st[0], nx = b.st[1];
        if (nloc == 0u) { xcd_barrier_complete(bar, b.x, nloc, nx); b.st[0] = nloc; b.st[1] = nx; }
        const unsigned old = xb_add(&bar[XB_XSUB(b.x)], 1u);
        const unsigned gen = old / nloc;
        if (old + 1u == (gen + 1u) * nloc) {
            __builtin_amdgcn_fence(__ATOMIC_RELEASE, "agent");
            asm volatile("s_waitcnt vmcnt(0)" ::: "memory");
            const unsigned og = xb_add(&bar[XB_TOP], 1u);
            const unsigned tg = og / nx;
            if (og + 1u == (tg + 1u) * nx) xb_add(&bar[XB_TOPGEN], 1u);
            else XB_SPIN(xb_ld(&bar[XB_TOPGEN]) == tg, bar);
            __builtin_amdgcn_fence(__ATOMIC_ACQUIRE, "agent");
            xb_add(&bar[XB_XGEN(b.x)], 1u);
            asm volatile("s_waitcnt vmcnt(0)" ::: "memory");
        } else {
            XB_SPIN(xb_ld(&bar[XB_XGEN(b.x)]) == gen, bar);
            __builtin_amdgcn_fence(__ATOMIC_ACQUIRE, "agent");
            asm volatile("s_waitcnt vmcnt(0)" ::: "memory");
        }
    }
    __syncthreads();
}
__device__ __forceinline__ void run_stage(const Params& p, int st, int vb, int nvb, unsigned char* lds) {
    unsigned char* ws = p.ws;
    float* MOD = (float*)(ws + WS_MOD); float* ALR = (float*)(ws + WS_ALR); float* X1C = (float*)(ws + WS_X1C);
    float* SUMA = (float*)(ws + WS_SUMA); float* SUMH = (float*)(ws + WS_SUMH); float* DEC = (float*)(ws + WS_DEC);
    bf16_t* Bt1 = (bf16_t*)(ws + WS_BT1); bf16_t* Bt2 = (bf16_t*)(ws + WS_BT2); bf16_t* Bt3 = (bf16_t*)(ws + WS_BT3); bf16_t* Bt4 = (bf16_t*)(ws + WS_BT4);
    bf16_t* S0 = (bf16_t*)(ws + WS_SLOT(0)); bf16_t* S1 = (bf16_t*)(ws + WS_SLOT(1)); bf16_t* S2 = (bf16_t*)(ws + WS_SLOT(2));
    bf16_t* S3 = (bf16_t*)(ws + WS_SLOT(3)); bf16_t* S4 = (bf16_t*)(ws + WS_SLOT(4)); bf16_t* S5 = (bf16_t*)(ws + WS_SLOT(5));
    bf16_t* DO0 = (bf16_t*)p.out; bf16_t* DOSC = (bf16_t*)((unsigned char*)p.out + 34 * MiB); bf16_t* DOZA = (bf16_t*)((unsigned char*)p.out + 51 * MiB);
    float* XRC = (float*)(ws + WS_BT1);
    float* SLAB2 = (float*)(ws + WS_SLOT(5) + 262144);
    switch (st) {
    case 0: st_mod(p, vb, nvb, (float*)lds); st_wprep(p, vb, nvb, lds); break;
    case 1: st_modulate(p, vb, nvb, 0, p.x, p.ctx, S0); break;
    case 3: st_glaprep(p, vb, nvb, lds, S1, S2, ALR, S3, S4, DOSC, DEC, S5); break;
#if FAST_WALK
    case 4: st_glawalk(p, vb, nvb, lds, S3, S4, DOSC, DEC, S5, S2, DO0); break;
#else
    case 4: st_glawalk_naive(p, vb, nvb, (float*)lds, S3, S4, DOSC, DEC, S5, S2, DO0); break;
#endif
    case 6: st_inner(p, vb, nvb, S2, DO0, S3, S4, S5, S0, DOZA, X1C); break;
    case 8: st_modulate(p, vb, nvb, 1, p.out, p.ctx, S2, SLAB2, 8, MOD + 4 * 3072 + 2048, nvb == 256 ? NLAT : 0);
            {
              for (int e = vb * NTHREADS + threadIdx.x; e < 9 * 4 * 256; e += nvb * NTHREADS) { const int gi = e >> 10, w = e & 1023; const int r0 = gi < 4 ? 4096 * gi + 4 * gi : (gi < 8 ? NLAT + 16 + 256 * (gi - 4) + 4 * (gi - 4) : NT + 32);
                  *(uint4*)(S3 + (size_t)r0 * 2048 + w * 8) = uint4{0u, 0u, 0u, 0u}; } }
            break;
    case 10: st_rg1p(p, vb, nvb, lds, S3, S0, S2, S5 + 131072, (const bf16_t*)(ws + WS_BD), XRC); break;
    case 14: if (nvb != 256) st_final(p, vb, nvb); break;
#if FAST_GEMM
    case 2: { FEpi1 E{S1, S2, S3, S4, S5, ALR, DOZA}; pg8::Gemm g{S0, Bt1, NT, N1, 1024}; pg8::TileOrder S; S.init(NT / 256, 11, 16, nvb, vb, 0, 8, 0, 12);
              pg8::gemm_phase<FEpi1, pg8::TileOrder, true, true>((PG8_LAS unsigned char*)lds, g, S, E); } break;
    case 5: { FEpi1 E{S1, S2, S3, S4, S5, ALR, DOZA}; pg8::Gemm g{S0, Bt1, NT, N1, 1024}; pg8::TileOrder S; S.init(NT / 256, 18, 16, nvb, vb, 0, 4, 8, 15);
              pg8::gemm_phase<FEpi1, pg8::TileOrder, true, true>((PG8_LAS unsigned char*)lds, g, S, E); } break;
    case 7: if (nvb == 256) { FEpiResMod E{p.x, p.out, S2, MOD, MOD + 5 * 3072, p.norm_g + 1024, SLAB2, (float*)(ws + WS_CTL + 131072 + 262144), (unsigned*)(ws + WS_CTL + 65536 + 16384)};
                  pg8::Gemm g{S0, Bt2, NT, 1024, 2048}; pg8::TileOrder S; S.init(NLAT / 256, 4, 32, nvb, vb, 0, 1 << 30, 0, 0, NCTX / 256, 4, NLAT / 256, 8, 4); S.tail_first = 1;
                  pg8::gemm_phase<FEpiResMod, pg8::TileOrder, false, true>((PG8_LAS unsigned char*)lds, g, S, E); }
            else { FEpiRes<true> E{p.x, p.ctx, p.out, SLAB2, MOD}; pg8::Gemm g{S0, Bt2, NT, 1024, 2048}; pg8::TileOrder S; S.init(NLAT / 256, 4, 32, nvb, vb, 0, 1 << 30, 0, 0, NCTX / 256, 4, NLAT / 256, 8, 4);
                  pg8::gemm_phase<FEpiRes<true>, pg8::TileOrder, true, true>((PG8_LAS unsigned char*)lds, g, S, E); } break;
    case 9: { FEpi3 E{S3, S0, XRC}; pg8::Gemm g{S2, Bt3, NT, 4096, 1024}; pg8::TileOrder S; S.init(NLAT / 256, 16, 16, nvb, vb, 0, 1 << 30, 0, 0, NCTX / 256, 8, NLAT / 256, 2, 8);
              pg8::gemm_phase<FEpi3, pg8::TileOrder, true, true>((PG8_LAS unsigned char*)lds, g, S, E); } break;
    case 13: if (nvb == 256) { FEpiResRms E{p.out, p.out, MOD + 5 * 3072, p.final_g, (float*)(ws + WS_CTL + 131072), (unsigned*)(ws + WS_CTL + 65536)}; pg8::Gemm g{S0, Bt4, NLAT, 1024, 2048}; pg8::TileOrder S; S.init(NLAT / 256, 4, 32, nvb, vb);
                  pg8::gemm_phase<FEpiResRms, pg8::TileOrder, false, true>((PG8_LAS unsigned char*)lds, g, S, E); }
             else { FEpiRes<false> E{p.out, nullptr, p.out, nullptr, MOD + 5 * 3072}; pg8::Gemm g{S0, Bt4, NLAT, 1024, 2048}; pg8::TileOrder S; S.init(NLAT / 256, 4, 32, nvb, vb);
                  pg8::gemm_phase<FEpiRes<false>, pg8::TileOrder, true, true>((PG8_LAS unsigned char*)lds, g, S, E); } break;
#else
    case 2: { Epi1 E{S1, S2, S3, S4, S5, ALR}; st_gemm_naive(vb, nvb, (float*)lds, S0, Bt1, 0, NT / 32, 0, 8, 1024, E); st_gemm_naive(vb, nvb, (float*)lds, S0, Bt1, 0, NT / 32, 12, 13, 1024, E); } break;
    case 5: { Epi1 E{S1, S2, S3, S4, S5, ALR}; st_gemm_naive(vb, nvb, (float*)lds, S0, Bt1, 0, NT / 32, 8, 12, 1024, E); st_gemm_naive(vb, nvb, (float*)lds, S0, Bt1, 0, NT / 32, 13, 29, 1024, E); } break;
    case 7: { EpiRes E{p.x, p.ctx, p.out, X1C, MOD}; st_gemm_naive(vb, nvb, (float*)lds, S0, Bt2, 0, NT / 32, 0, 4, 2048, E); } break;
    case 9: { Epi3 E{S3, S0}; st_gemm_naive(vb, nvb, (float*)lds, S2, Bt3, 0, NLAT / 32, 0, 16, 1024, E); st_gemm_naive(vb, nvb, (float*)lds, S2, Bt3, NLAT / 32, NT / 32, 0, 8, 1024, E); } break;
    case 13: { EpiRes E{p.out, nullptr, p.out, nullptr, MOD + 5 * 3072}; st_gemm_naive(vb, nvb, (float*)lds, S0, Bt4, 0, NLAT / 32, 0, 4, 2048, E); } break;
#endif
    }
}
constexpr int NSTAGES = 15;
constexpr int LDS_BYTES = 147456;

#ifndef ONE_LAUNCH
#define ONE_LAUNCH 1
#endif
#if !ONE_LAUNCH
__global__ void __launch_bounds__(NTHREADS) k_mega(Params p, int st) {
    extern __shared__ __attribute__((aligned(16))) unsigned char lds[];
    run_stage(p, st, blockIdx.x, gridDim.x, lds);
}
#else
__global__ void __launch_bounds__(NTHREADS) k_mega(Params p) {
    extern __shared__ __attribute__((aligned(16))) unsigned char lds[];
    volatile __attribute__((address_space(3))) unsigned* st = (volatile __attribute__((address_space(3))) unsigned*)((__attribute__((address_space(3))) unsigned char*)lds + (LDS_BYTES - 64));
    if (threadIdx.x < 2) st[threadIdx.x] = 0u;
    __syncthreads();
    const XcdBarrier bar = xcd_barrier_post((unsigned*)(p.ws + WS_CTL) + 4096, st);
#ifndef REP_STAGE
#define REP_STAGE -1
#endif
#ifndef REP_N
#define REP_N 1
#endif
#define RS(k) do { run_stage(p, k, blockIdx.x, gridDim.x, lds); if ((k) == REP_STAGE) { for (int rep_ = 0; rep_ < REP_N; ++rep_) { xcd_barrier(bar); run_stage(p, k, blockIdx.x, gridDim.x, lds); } } } while (0)
#define GS() xcd_barrier(bar)
    RS(0); GS(); RS(1); GS(); RS(2); GS(); RS(3); GS(); RS(4); GS(); RS(5); GS(); RS(6); GS(); RS(7); GS();
    RS(8); GS(); RS(9); GS(); RS(10); GS(); RS(13); if (gridDim.x != 256) { GS(); RS(14); }
#undef RS
#undef GS
}
#endif

extern "C" void kernel_launch(void* const* d_in, const int* in_sizes, int n_in, void* d_out, int out_size, void* d_ws, size_t ws_size, hipStream_t stream) {
    static int inited = 0, grid_blocks = 0;
    if (!inited) {
        if (n_in != 23 || ws_size < WS_END || out_size != NLAT * D) { fprintf(stderr, "kernel_launch: unexpected shapes n_in %d ws %zu out %d\n", n_in, ws_size, out_size); inited = -1; return; }
        if (hipFuncSetAttribute((const void*)k_mega, hipFuncAttributeMaxDynamicSharedMemorySize, LDS_BYTES) != hipSuccess) { fprintf(stderr, "hipFuncSetAttribute failed\n"); inited = -1; return; }
        int dev = 0, cus = 0, per_cu = 0;
        (void)hipGetDevice(&dev); (void)hipDeviceGetAttribute(&cus, hipDeviceAttributeMultiprocessorCount, dev);
        (void)hipOccupancyMaxActiveBlocksPerMultiprocessor(&per_cu, (const void*)k_mega, NTHREADS, LDS_BYTES);
        if (per_cu < 1) { fprintf(stderr, "kernel_launch: occupancy query says %d blocks per CU\n", per_cu); per_cu = 1; }
        if (per_cu > 1) per_cu = 1;
        grid_blocks = cus * per_cu;
        inited = 1;
    }
    if (inited < 0) return;
    Params p{};
    const float** f = (const float**)&p;
    for (int i = 0; i < 23; ++i) f[i] = (const float*)d_in[i];
    p.out = (float*)d_out; p.ws = (unsigned char*)d_ws;
    (void)hipMemsetAsync((unsigned char*)d_ws + WS_CTL, 0, 2 * MiB, stream);
#if ONE_LAUNCH
    void* args[] = {&p};
    hipError_t e = hipLaunchCooperativeKernel((const void*)k_mega, dim3(grid_blocks), dim3(NTHREADS), args, LDS_BYTES, stream);
    if (e != hipSuccess) fprintf(stderr, "cooperative launch failed: %s (grid %d)\n", hipGetErrorString(e), grid_blocks);
#else
    for (int st = 0; st < NSTAGES; ++st) hipLaunchKernelGGL(k_mega, dim3(1024), dim3(NTHREADS), LDS_BYTES, stream, p, st);
#endif
}
```

```cpp
#include <hip/hip_runtime.h>
#include <hip/hip_cooperative_groups.h>
namespace cg = cooperative_groups;
#include <cstdio>
#include <cstdint>

typedef unsigned short bf16_t;
#define DEVI __device__ __forceinline__
__device__ __forceinline__ int tidx_() { int t = __builtin_amdgcn_workitem_id_x(); asm volatile("" : "+v"(t)); return t; }
#define LDS_BARRIER() do { asm volatile("s_waitcnt lgkmcnt(0)" ::: "memory"); __builtin_amdgcn_s_barrier(); asm volatile("" ::: "memory"); } while (0)

constexpr int D = 1024, NB = 4, SEQ = 4096, CTXL = 256;
constexpr int NLAT = NB * SEQ;
constexpr int NCTX = NB * CTXL;
constexpr int NT = NLAT + NCTX;
constexpr int NCH = 68;
constexpr int EVEN_IN = 7200;
constexpr int N1 = 7424;
constexpr int N1A = 13 * 256;
constexpr int RGW = 2048;
constexpr float EPS = 1e-6f;

constexpr size_t MiB = 1u << 20;
constexpr size_t WS_CTL = 0;
constexpr size_t WS_MOD = 1 * MiB;
constexpr size_t WS_ALR = 2 * MiB;
constexpr size_t WS_X1C = 5 * MiB;
constexpr size_t WS_SUMA = 9 * MiB;
constexpr size_t WS_SUMH = 9 * MiB + 4608 * 1024;
constexpr size_t WS_DEC = 18 * MiB;
constexpr size_t WS_BT1 = 19 * MiB + 512 * 1024;
constexpr size_t WS_BT2 = 34 * MiB;
constexpr size_t WS_BT3 = 38 * MiB;
constexpr size_t WS_BT4 = 46 * MiB;
constexpr size_t WS_BD = 50 * MiB;
constexpr size_t WS_S0 = 52 * MiB;
constexpr size_t SLOT = 34 * MiB;
constexpr size_t WS_END = WS_S0 + 6 * SLOT;
static_assert(WS_END == 256 * MiB, "ws map");
#define WS_SLOT(i) (WS_S0 + (size_t)(i) * SLOT)

struct Params {
    const float* x; const float* c; const float* ctx; const float* c_ctx; const float* norm_g; const float* w_mod; const float* b_mod;
    const float* e_w_in; const float* e_w_a2; const float* e_b_a2; const float* e_gla_g; const float* e_conv_w; const float* e_w_out;
    const float* o_w_in; const float* o_conv_w; const float* o_conv_b; const float* o_w_a; const float* o_b_a; const float* o_w_x; const float* o_b_x;
    const float* o_lam; const float* o_w_out; const float* final_g;
    float* out; unsigned char* ws;
};

DEVI float bf2f(bf16_t v) { return __uint_as_float((unsigned)v << 16); }
typedef float hw_f2 __attribute__((ext_vector_type(2))); typedef __bf16 hw_b2 __attribute__((ext_vector_type(2)));
DEVI unsigned hw_pk(float lo, float hi) { hw_f2 v = {lo, hi}; hw_b2 b = __builtin_convertvector(v, hw_b2); return __builtin_bit_cast(unsigned, b); }
DEVI bf16_t f2bf(float f) { return (bf16_t)(hw_pk(f, 0.f) & 0xffffu); }
DEVI unsigned pk2(float lo, float hi) { return hw_pk(lo, hi); }
typedef _Float16 hf2_t __attribute__((ext_vector_type(2))); typedef _Float16 hf8_t __attribute__((ext_vector_type(8)));
DEVI unsigned pk2h(float lo, float hi) { hf2_t v = {(_Float16)lo, (_Float16)hi}; return __builtin_bit_cast(unsigned, v); }
DEVI float fexp2_(float x) { return __builtin_amdgcn_exp2f(x); }
DEVI float frcp_(float x) { return __builtin_amdgcn_rcpf(x); }
DEVI float sigmoidf_(float x) { return frcp_(1.0f + fexp2_(-1.4426950408889634f * x)); }
DEVI float siluf_(float x) { return x * frcp_(1.0f + fexp2_(-1.4426950408889634f * x)); }
DEVI float softplusf_(float x) { return fmaxf(x, 0.f) + log1pf(__expf(-fabsf(x))); }
DEVI float logsigmoidf_(float x) { return fminf(x, 0.f) - 0.6931471805599453f * __builtin_amdgcn_logf(1.0f + fexp2_(-1.4426950408889634f * fabsf(x))); }
DEVI int row_of(int bb, int c, int t) { return c < 64 ? bb * 4096 + c * 64 + t : NLAT + bb * 256 + (c - 64) * 64 + t; }
DEVI int mod_idx(int row) { return row < NLAT ? (row >> 12) : 4; }
DEVI int xr_pad_of_tile(int pm) { return pm < 64 ? 4 * ((pm >> 4) + 1) : 20 + 4 * (pm - 64); }
constexpr int XR_ROWS = NT + 36;
DEVI float wave_sum(float v) {
#pragma unroll
    for (int o = 1; o < 64; o <<= 1) v += __shfl_xor(v, o);
    return v;
}
__host__ __device__ inline int colmap1(int n) {
    const int t = n >> 8, c = n & 255;
    if (t < 12) return n;
    if (t == 12) return c < 32 ? 3072 + c : -1;
    if (t < 21) { const int j = t - 13; return c < 128 ? 4128 + 128 * j + c : 5152 + 128 * j + (c - 128); }
    const int j = t - 21; return c < 128 ? 3104 + 128 * j + c : 6176 + 128 * j + (c - 128);
}

#define NTHREADS 512

__device__ void st_mod(const Params& p, int vb, int nvb, float* lds) {
    float* MOD = (float*)(p.ws + WS_MOD);
    for (int i = tidx_(); i < 5 * 1024; i += NTHREADS) { const int s = i >> 10, k = i & 1023; const float v = s < 4 ? p.c[s * 1024 + k] : p.c_ctx[k]; lds[i] = siluf_(v); }
    __syncthreads();
    const int lane = tidx_() & 63, gw = vb * (NTHREADS / 64) + (tidx_() >> 6), ngw = nvb * (NTHREADS / 64);
    for (int it = gw; it < 2 * 24 * 32; it += ngw) {
        const int kc = it & 31, cb = (it >> 5) % 24, li = it / (32 * 24), j = cb * 128 + 2 * lane, k0 = kc * 32;
        const float* W = p.w_mod + ((size_t)li * 1024 + k0) * 3072 + j;
        float2 a0 = {0.f, 0.f}, a1 = a0, a2 = a0, a3 = a0, a4 = a0;
#pragma unroll
        for (int kh = 0; kh < 2; ++kh) {
            float2 wv[16];
#pragma unroll
            for (int k = 0; k < 16; ++k) wv[k] = *(const float2*)(W + (size_t)(16 * kh + k) * 3072);
#pragma unroll
            for (int k = 0; k < 16; ++k) { const float2 w = wv[k]; const int kk = k0 + 16 * kh + k; const float s0 = lds[kk], s1 = lds[1024 + kk], s2 = lds[2048 + kk], s3 = lds[3072 + kk], s4 = lds[4096 + kk];
                a0.x += s0 * w.x; a0.y += s0 * w.y; a1.x += s1 * w.x; a1.y += s1 * w.y; a2.x += s2 * w.x; a2.y += s2 * w.y; a3.x += s3 * w.x; a3.y += s3 * w.y; a4.x += s4 * w.x; a4.y += s4 * w.y; }
            asm volatile("" ::: "memory"); }
        float2 bv = {0.f, 0.f}; if (kc == 0) bv = *(const float2*)(p.b_mod + li * 3072 + j);
        float* o = MOD + (size_t)li * 5 * 3072 + j;
        atomicAdd(o, a0.x + bv.x); atomicAdd(o + 1, a0.y + bv.y); atomicAdd(o + 3072, a1.x + bv.x); atomicAdd(o + 3073, a1.y + bv.y); atomicAdd(o + 2 * 3072, a2.x + bv.x); atomicAdd(o + 2 * 3072 + 1, a2.y + bv.y);
        atomicAdd(o + 3 * 3072, a3.x + bv.x); atomicAdd(o + 3 * 3072 + 1, a3.y + bv.y); atomicAdd(o + 4 * 3072, a4.x + bv.x); atomicAdd(o + 4 * 3072 + 1, a4.y + bv.y);
    }
}

template <bool F16 = false>
__device__ __forceinline__ void wt_item(const float* src, int ldw, bf16_t* dst, int K, int k0, __attribute__((address_space(3))) float* scr, int lane) {
    typedef unsigned v4u __attribute__((ext_vector_type(4)));
    if (src) {
        float rv[32];
#pragma unroll
        for (int i = 0; i < 32; ++i) { const int kk = 2 * i + (lane >> 5); rv[i] = src[(size_t)(k0 + kk) * ldw + (lane & 31)]; }
#pragma unroll
        for (int i = 0; i < 32; ++i) { const int kk = 2 * i + (lane >> 5); scr[kk * 33 + (lane & 31)] = rv[i]; }
    }
    asm volatile("s_waitcnt lgkmcnt(0)" ::: "memory");
    const int cch = lane & 7;
#pragma unroll
    for (int j = 0; j < 4; ++j) { const int n = (lane >> 3) + 8 * j; const __attribute__((address_space(3))) float* sp = scr + (8 * cch) * 33 + n;
        v4u o = {0u, 0u, 0u, 0u};
        if (src) { if (F16) { o.x = pk2h(sp[0 * 33], sp[1 * 33]); o.y = pk2h(sp[2 * 33], sp[3 * 33]); o.z = pk2h(sp[4 * 33], sp[5 * 33]); o.w = pk2h(sp[6 * 33], sp[7 * 33]); }
                   else { o.x = pk2(sp[0 * 33], sp[1 * 33]); o.y = pk2(sp[2 * 33], sp[3 * 33]); o.z = pk2(sp[4 * 33], sp[5 * 33]); o.w = pk2(sp[6 * 33], sp[7 * 33]); } }
        *(v4u*)(dst + (size_t)n * K + k0 + 8 * cch) = o; }
    asm volatile("s_waitcnt lgkmcnt(0)" ::: "memory");
}
__device__ void st_wprep(const Params& p, int vb, int nvb, unsigned char* lds_) {
    bf16_t* Bt1 = (bf16_t*)(p.ws + WS_BT1); bf16_t* Bt2 = (bf16_t*)(p.ws + WS_BT2); bf16_t* Bt3 = (bf16_t*)(p.ws + WS_BT3); bf16_t* Bt4 = (bf16_t*)(p.ws + WS_BT4);
    bf16_t* BD = (bf16_t*)(p.ws + WS_BD);
    const int lane = tidx_() & 63, wv = tidx_() >> 6, gw = vb * (NTHREADS / 64) + wv, ngw = nvb * (NTHREADS / 64);
    __attribute__((address_space(3))) float* scr = (__attribute__((address_space(3))) float*)lds_ + 8192 + wv * (64 * 33);
    constexpr int I1 = 16 * (N1 / 32), I2 = 32 * 32, I3 = 16 * 128, I4 = 32 * 32, I5 = 64 * 8;
    for (int it = gw; it < I1 + I2 + I3 + I4 + I5; it += ngw) {
        int r = it;
        if (r < I1) { const int nbk = N1 / 32, kb = r / nbk, nb = r % nbk; const int sc = colmap1(nb * 32); wt_item(sc < 0 ? nullptr : p.e_w_in + sc, EVEN_IN, Bt1 + (size_t)nb * 32 * 1024, 1024, kb * 64, scr, lane); continue; } r -= I1;
        if (r < I2) { const int kb = r / 32, nb = r % 32; wt_item(p.e_w_out + nb * 32, 1024, Bt2 + (size_t)nb * 32 * 2048, 2048, kb * 64, scr, lane); continue; } r -= I2;
        if (r < I3) { const int kb = r / 128, nb = r % 128; wt_item(p.o_w_in + nb * 32, 4096, Bt3 + (size_t)nb * 32 * 1024, 1024, kb * 64, scr, lane); continue; } r -= I3;
        if (r < I4) { const int kb = r / 32, nb = r % 32; wt_item(p.o_w_out + nb * 32, 1024, Bt4 + (size_t)nb * 32 * 2048, 2048, kb * 64, scr, lane); continue; } r -= I4;
        { const int m = r >> 8, dn = (r >> 3) & 31, kb = (r >> 2) & 1, nb = r & 3; const float* W = (m == 0 ? p.o_w_a : p.o_w_x) + (size_t)dn * 16384;
          wt_item<true>(W + nb * 32, 128, BD + (size_t)m * 2 * 16 * 16384 + (size_t)dn * 16384 + (size_t)nb * 32 * 128, 128, kb * 64, scr, lane); }
    }
}

__device__ void st_modulate(const Params& p, int vb, int nvb, int li, const float* xlat, const float* xctx, bf16_t* H, const float* slab = nullptr, int nslab = 0, const float* gatec = nullptr, int row_begin = 0) {
    const float* MOD = (const float*)(p.ws + WS_MOD) + (size_t)li * 5 * 3072;
    const float* g = p.norm_g + li * 1024;
    const int lane = tidx_() & 63, gw = vb * (NTHREADS / 64) + (tidx_() >> 6), ngw = nvb * (NTHREADS / 64);
    const int nrows = NT - row_begin, per = (nrows + ngw - 1) / ngw, r0 = row_begin + gw * per, r1 = (r0 + per < NT) ? r0 + per : NT;
    float4 mulv[4], shv[4]; int cur_mi = -1;
    for (int row = r0; row < r1; ++row) {
        const float* xr = row < NLAT ? xlat + (size_t)row * 1024 : xctx + (size_t)(row - NLAT) * 1024;
        float4 v[4];
#pragma unroll
        for (int j = 0; j < 4; ++j) v[j] = *(const float4*)(xr + j * 256 + lane * 4);
        const int mi = mod_idx(row);
        if (mi != cur_mi) { cur_mi = mi; const float* md = MOD + (size_t)mi * 3072;
#pragma unroll
            for (int j = 0; j < 4; ++j) { const int c0 = j * 256 + lane * 4; const float4 gg = *(const float4*)(g + c0), sc = *(const float4*)(md + 1024 + c0); shv[j] = *(const float4*)(md + c0);
                mulv[j] = float4{gg.x * (1.f + sc.x), gg.y * (1.f + sc.y), gg.z * (1.f + sc.z), gg.w * (1.f + sc.w)}; } }
        float ss = 0.f;
#pragma unroll
        for (int j = 0; j < 4; ++j) {
            if (slab && row >= NLAT) {
                float4 a = {0.f, 0.f, 0.f, 0.f};
                for (int ks = 0; ks < nslab; ++ks) { const float4 t = *(const float4*)(slab + ((size_t)ks * NCTX + (row - NLAT)) * 1024 + j * 256 + lane * 4); a.x += t.x; a.y += t.y; a.z += t.z; a.w += t.w; }
                const float4 gt = *(const float4*)(gatec + j * 256 + lane * 4); v[j].x += gt.x * a.x; v[j].y += gt.y * a.y; v[j].z += gt.z * a.z; v[j].w += gt.w * a.w; }
            ss += v[j].x * v[j].x + v[j].y * v[j].y + v[j].z * v[j].z + v[j].w * v[j].w; }
        const float rinv = rsqrtf(wave_sum(ss) * (1.f / 1024.f) + EPS);
#pragma unroll
        for (int j = 0; j < 4; ++j) { const int c0 = j * 256 + lane * 4;
            uint2 o; o.x = pk2(v[j].x * rinv * mulv[j].x + shv[j].x, v[j].y * rinv * mulv[j].y + shv[j].y); o.y = pk2(v[j].z * rinv * mulv[j].z + shv[j].z, v[j].w * rinv * mulv[j].w + shv[j].w);
            *(uint2*)(H + (size_t)row * 1024 + c0) = o; }
    }
}

template <class Epi>
__device__ void st_gemm_naive(int vb, int nvb, float* lds, const bf16_t* A, const bf16_t* Bt, int mt0, int mt1, int nt0, int nt1, int K, const Epi& E) {
    float* As = lds;
    float* Bs = lds + 32 * 33;
    const int tid = tidx_(), tx = tid & 63, ty = tid >> 6;
    const int nmt = mt1 - mt0, nnt = nt1 - nt0;
    for (int it = vb; it < nmt * nnt; it += nvb) {
        const int m0 = (mt0 + it / nnt) * 32, n0 = (nt0 + it % nnt) * 256;
        float acc[4][4];
#pragma unroll
        for (int i = 0; i < 4; ++i)
#pragma unroll
            for (int j = 0; j < 4; ++j) acc[i][j] = 0.f;
        for (int k0 = 0; k0 < K; k0 += 32) {
            __syncthreads();
            for (int e = tid; e < 32 * 32; e += NTHREADS) { const int r = e >> 5, kk = e & 31; As[r * 33 + kk] = bf2f(A[(size_t)(m0 + r) * K + k0 + kk]); }
            for (int e = tid; e < 256 * 32; e += NTHREADS) { const int r = e >> 5, kk = e & 31; Bs[r * 33 + kk] = bf2f(Bt[(size_t)(n0 + r) * K + k0 + kk]); }
            __syncthreads();
#pragma unroll 8
            for (int kk = 0; kk < 32; ++kk) {
                float a[4], b[4];
#pragma unroll
                for (int i = 0; i < 4; ++i) a[i] = As[(ty * 4 + i) * 33 + kk];
#pragma unroll
                for (int j = 0; j < 4; ++j) b[j] = Bs[(tx + 64 * j) * 33 + kk];
#pragma unroll
                for (int i = 0; i < 4; ++i)
#pragma unroll
                    for (int j = 0; j < 4; ++j) acc[i][j] += a[i] * b[j];
            }
        }
#pragma unroll
        for (int i = 0; i < 4; ++i) E(m0 + ty * 4 + i, n0, tx, acc[i]);
    }
    __syncthreads();
}

struct Epi1 {
    bf16_t *QK, *V, *SGA, *Z, *CBG; float* ALR;
    DEVI void operator()(int row, int n0, int cl, const float (&v)[4]) const {
        const int t = n0 >> 8;
        if (t < 4) { for (int j = 0; j < 4; ++j) QK[(size_t)row * 1024 + n0 + cl + 64 * j] = f2bf(v[j]); }
        else if (t < 8) { for (int j = 0; j < 4; ++j) V[(size_t)row * 1024 + (n0 - 1024) + cl + 64 * j] = f2bf(v[j]); }
        else if (t < 12) { for (int j = 0; j < 4; ++j) SGA[(size_t)row * 1024 + (n0 - 2048) + cl + 64 * j] = f2bf(siluf_(v[j])); }
        else if (t == 12) { if (cl < 32) ALR[(size_t)row * 32 + cl] = v[0]; }
        else if (t < 21) { const int jt = t - 13; Z[(size_t)row * 1024 + 128 * jt + cl] = f2bf(v[0] * v[2]); Z[(size_t)row * 1024 + 128 * jt + cl + 64] = f2bf(v[1] * v[3]); }
        else { const int jt = t - 21; CBG[(size_t)row * 1024 + 128 * jt + cl] = f2bf(v[0] * siluf_(v[2])); CBG[(size_t)row * 1024 + 128 * jt + cl + 64] = f2bf(v[1] * siluf_(v[3])); }
    }
};
struct EpiRes {
    const float* xl; const float* xc; float* outl; float* outc; const float* MODl;
    DEVI void operator()(int row, int n0, int cl, const float (&v)[4]) const {
        const float* gate = MODl + (size_t)mod_idx(row) * 3072 + 2048;
        for (int j = 0; j < 4; ++j) { const int col = n0 + cl + 64 * j;
            if (row < NLAT) outl[(size_t)row * 1024 + col] = xl[(size_t)row * 1024 + col] + gate[col] * v[j];
            else if (outc) outc[(size_t)(row - NLAT) * 1024 + col] = xc[(size_t)(row - NLAT) * 1024 + col] + gate[col] * v[j]; }
    }
};
struct Epi3 {
    bf16_t* XR; bf16_t* SG;
    DEVI void operator()(int row, int n0, int cl, const float (&v)[4]) const {
        for (int j = 0; j < 4; ++j) { const int col = n0 + cl + 64 * j;
            if (col < 2048) XR[(size_t)row * 2048 + col] = f2bf(v[j]); else if (row < NLAT) SG[(size_t)row * 2048 + col - 2048] = f2bf(siluf_(v[j])); }
    }
};

#define LASQ __attribute__((address_space(3)))
__device__ void st_glaprep(const Params& p, int vb, int nvb, unsigned char* ldsb, const bf16_t* QK, const bf16_t* V, const float* ALR, bf16_t* QIN, bf16_t* KET, bf16_t* SC, float* DEC, bf16_t* VT) {
    typedef unsigned u4 __attribute__((ext_vector_type(4))); typedef unsigned u2 __attribute__((ext_vector_type(2))); typedef float f4 __attribute__((ext_vector_type(4))); typedef short bx8 __attribute__((ext_vector_type(8)));
    LASQ unsigned char* lds = (LASQ unsigned char*)ldsb;
    constexpr int RQ = 0, RK = 17408, Q0 = 34816, K0 = 52224, VR = 69632, AL = VR + 33792, TT = AL + 8192;
    const int tid = tidx_(), kk = tid & 127, tq = tid >> 7, wv = tid >> 6, ln = tid & 63, cl = ln & 15, gq = ln >> 4;
    u4 r[9];
#define GP_LOAD(item) do { const int h_ = (item) & 3, bc_ = (item) >> 2, c_ = bc_ % NCH, bb_ = bc_ / NCH; const size_t row0_ = (size_t)row_of(bb_, c_, 0); \
        _Pragma("unroll") for (int j_ = 0; j_ < 2; ++j_) { const int p_ = tid + 512 * j_; r[j_] = *(const u4*)(QK + (row0_ + (p_ >> 4)) * 1024 + h_ * 128 + (p_ & 15) * 8); r[2 + j_] = *(const u4*)(QK + (row0_ + (p_ >> 4)) * 1024 + 512 + h_ * 128 + (p_ & 15) * 8); } \
        _Pragma("unroll") for (int j_ = 0; j_ < 4; ++j_) { const int p_ = tid + 512 * j_; r[4 + j_] = *(const u4*)(V + (row0_ + (p_ >> 5)) * 1024 + h_ * 256 + (p_ & 31) * 8); } \
        r[8] = *(const u4*)(ALR + (row0_ + (tid >> 3)) * 32 + (tid & 7) * 4); } while (0)
    const int NIT = NB * NCH * 4; bx8 wfr[2] = {}; float b2v[2] = {0.f, 0.f}; int hcur = -1;
    if (vb < NIT) GP_LOAD(vb);
    for (int item = vb; item < NIT; item += nvb) {
        const int h = item & 3;
        LDS_BARRIER();
#pragma unroll
        for (int j = 0; j < 2; ++j) { const int pp = tid + 512 * j; *(LASQ u4*)(lds + RQ + (pp >> 4) * 272 + (pp & 15) * 16) = r[j]; *(LASQ u4*)(lds + RK + (pp >> 4) * 272 + (pp & 15) * 16) = r[2 + j]; }
#pragma unroll
        for (int j = 0; j < 4; ++j) { const int pp = tid + 512 * j; *(LASQ u4*)(lds + VR + (pp >> 5) * 528 + (pp & 31) * 16) = r[4 + j]; }
        *(LASQ u4*)(lds + AL + (tid >> 3) * 128 + (tid & 7) * 16) = r[8];
        if (h != hcur) { hcur = h;
#pragma unroll
        for (int d = 0; d < 2; ++d) { float wv8[8];
#pragma unroll
            for (int j = 0; j < 8; ++j) wv8[j] = gq < 2 ? p.e_w_a2[((size_t)d * 16 + 8 * gq + j) * 512 + h * 128 + 16 * wv + cl] : 0.f;
            u4 w; w.x = pk2(wv8[0], wv8[1]); w.y = pk2(wv8[2], wv8[3]); w.z = pk2(wv8[4], wv8[5]); w.w = pk2(wv8[6], wv8[7]); wfr[d] = __builtin_bit_cast(bx8, w);
            b2v[d] = p.e_b_a2[d * 512 + h * 128 + 16 * wv + cl]; } }
        asm volatile("" ::: "memory");
        if (item + nvb < NIT) GP_LOAD(item + nvb);
        LDS_BARRIER();
        unsigned qkr[16];
#pragma unroll
        for (int i = 0; i < 16; ++i) { qkr[i] = (unsigned)*(const LASQ unsigned short*)(lds + RQ + (tq * 16 + i) * 272 + kk * 2) | ((unsigned)*(const LASQ unsigned short*)(lds + RK + (tq * 16 + i) * 272 + kk * 2) << 16); }
#define GP_Z(d, zoff) do { _Pragma("unroll") for (int mt = 0; mt < 4; ++mt) { bx8 af = {0, 0, 0, 0, 0, 0, 0, 0}; \
            if (gq < 2) { const LASQ f4* ap_ = (const LASQ f4*)(lds + AL + (16 * mt + cl) * 128 + (d) * 64 + gq * 32); const f4 a0_ = ap_[0], a1_ = ap_[1]; \
                u4 w_; w_.x = pk2(a0_[0], a0_[1]); w_.y = pk2(a0_[2], a0_[3]); w_.z = pk2(a1_[0], a1_[1]); w_.w = pk2(a1_[2], a1_[3]); af = __builtin_bit_cast(bx8, w_); } \
            f4 acc_ = {b2v[d], b2v[d], b2v[d], b2v[d]}; acc_ = __builtin_amdgcn_mfma_f32_16x16x32_bf16(af, wfr[d], acc_, 0, 0, 0); \
            _Pragma("unroll") for (int rr_ = 0; rr_ < 4; ++rr_) *(LASQ float*)(lds + (zoff) + (16 * mt + 4 * gq + rr_) * 528 + (16 * wv + cl) * 4) = acc_[rr_]; } } while (0)
        GP_Z(0, Q0);
        LDS_BARRIER();
        GP_Z(1, RQ);
        LDS_BARRIER();
#undef GP_Z
        float bc[2][16];
#pragma unroll
        for (int d = 0; d < 2; ++d) {
#pragma unroll
            for (int i = 0; i < 16; ++i) { const float z = *(const LASQ float*)(lds + (d == 0 ? Q0 : RQ) + (tq * 16 + i) * 528 + kk * 4); bc[d][i] = logsigmoidf_(z) * (1.f / 16.f); }
            float sacc = 0.f;
            if (d == 0) {
#pragma unroll
                for (int i = 0; i < 16; ++i) { sacc += bc[d][i]; bc[d][i] = sacc; } }
            else {
#pragma unroll
                for (int i = 15; i >= 0; --i) { sacc += bc[d][i]; bc[d][i] = sacc; } }
            *(LASQ float*)(lds + TT + ((d * 4 + tq) * 128 + kk) * 4) = sacc;
        }
        LDS_BARRIER();
        const float scale = 0.08838834764831845f;
#pragma unroll
        for (int d = 0; d < 2; ++d) {
            const size_t u = (size_t)item * 2 + d;
            float off = 0.f, blast = 0.f;
#pragma unroll
            for (int q = 0; q < 4; ++q) { const float tv = *(const LASQ float*)(lds + TT + ((d * 4 + q) * 128 + kk) * 4); blast += tv; if (d == 0 ? (q < tq) : (q > tq)) off += tv; }
            LASQ unsigned char* qd = lds + (d == 0 ? Q0 : RQ); LASQ unsigned char* kd = lds + (d == 0 ? K0 : RK);
            unsigned ke[8]; const float dcy = fexp2_(1.4426950408889634f * blast);
#pragma unroll
            for (int i = 0; i < 16; ++i) { const int t = tq * 16 + i; const float bq = bc[d][i] + off;
                const float qv = __uint_as_float(qkr[i] << 16) * scale, kv = __uint_as_float(qkr[i] & 0xffff0000u);
                const float eb = fexp2_(1.4426950408889634f * bq), kin = kv * frcp_(eb);
                *(LASQ unsigned short*)(qd + t * 272 + kk * 2) = f2bf(qv * eb); *(LASQ unsigned short*)(kd + t * 272 + kk * 2) = f2bf(kin);
                const unsigned kev = f2bf(kin * dcy);
                if (i & 1) ke[i >> 1] |= kev << 16; else ke[i >> 1] = kev; }
            { u4 w0 = {ke[0], ke[1], ke[2], ke[3]}, w1 = {ke[4], ke[5], ke[6], ke[7]}; u4* dst = (u4*)(KET + (u * 128 + kk) * 64 + tq * 16); dst[0] = w0; dst[1] = w1; }
            if (tq == 0) DEC[u * 128 + kk] = dcy;
        }
        LDS_BARRIER();
#pragma unroll
        for (int d = 0; d < 2; ++d) {
            const size_t u = (size_t)item * 2 + d;
            const LASQ unsigned char* qd = lds + (d == 0 ? Q0 : RQ); const LASQ unsigned char* kd = lds + (d == 0 ? K0 : RK);
#pragma unroll
            for (int j = 0; j < 2; ++j) { const int pp = tid + 512 * j; *(u4*)(QIN + u * 8192 + (pp >> 4) * 128 + (pp & 15) * 8) = *(const LASQ u4*)(qd + (pp >> 4) * 272 + (pp & 15) * 16); }
            const int mt = wv >> 1;
#pragma unroll
            for (int nn = 0; nn < 2; ++nn) { const int nt = 2 * (wv & 1) + nn; f4 acc = {0.f, 0.f, 0.f, 0.f};
#pragma unroll
                for (int k4 = 0; k4 < 4; ++k4) { const bx8 kf = *(const LASQ bx8*)(kd + (16 * nt + cl) * 272 + (32 * k4 + 8 * gq) * 2), qf = *(const LASQ bx8*)(qd + (16 * mt + cl) * 272 + (32 * k4 + 8 * gq) * 2);
                    acc = __builtin_amdgcn_mfma_f32_16x16x32_bf16(kf, qf, acc, 0, 0, 0); }
                const int t = 16 * mt + cl, s0 = 16 * nt + 4 * gq; float v[4];
#pragma unroll
                for (int rr = 0; rr < 4; ++rr) { const int sx = s0 + rr; v[rr] = (d == 0 ? (sx <= t) : (sx >= t)) ? acc[rr] : 0.f; }
                u2 w; w.x = pk2(v[0], v[1]); w.y = pk2(v[2], v[3]); *(u2*)(SC + (u * 64 + t) * 64 + s0) = w; }
        }
        { const int vc = tid & 255, th = tid >> 8; unsigned vv[16];
#pragma unroll
          for (int i = 0; i < 32; ++i) { const unsigned x = *(const LASQ unsigned short*)(lds + VR + (32 * th + i) * 528 + vc * 2); if (i & 1) vv[i >> 1] |= x << 16; else vv[i >> 1] = x; }
          u4* dst = (u4*)(VT + ((size_t)item * 256 + vc) * 64 + 32 * th);
          dst[0] = (u4){vv[0], vv[1], vv[2], vv[3]}; dst[1] = (u4){vv[4], vv[5], vv[6], vv[7]}; dst[2] = (u4){vv[8], vv[9], vv[10], vv[11]}; dst[3] = (u4){vv[12], vv[13], vv[14], vv[15]}; }
    }
    LDS_BARRIER();
#undef GP_LOAD
}

__device__ void st_glawalk_naive(const Params& p, int vb, int nvb, float* Sl, const bf16_t* QIN, const bf16_t* KET, const bf16_t* SC, const float* DEC, const bf16_t* VT, bf16_t* OF, bf16_t* OB) {
    const int vc = tidx_() & 255, half = tidx_() >> 8;
    for (int combo = vb; combo < 32; combo += nvb) {
        const int d = combo & 1, h = (combo >> 1) & 3, bb = combo >> 3;
        __syncthreads();
        for (int k = half * 64; k < half * 64 + 64; ++k) Sl[k * 256 + vc] = 0.f;
        __syncthreads();
        bf16_t* O = d == 0 ? OF : OB;
        for (int step = 0; step < NCH; ++step) {
            const int c = d == 0 ? (step < 4 ? 64 + step : step - 4) : 67 - step;
            const int u = ((bb * NCH + c) * 4 + h) * 2 + d;
            const bf16_t* q = QIN + (size_t)u * 64 * 128; const bf16_t* ke = KET + (size_t)u * 128 * 64; const bf16_t* sc = SC + (size_t)u * 64 * 64;
            const bf16_t* vt = VT + (((size_t)(u >> 1)) * 256 + vc) * 64;
            float vv[64];
#pragma unroll
            for (int t = 0; t < 64; ++t) vv[t] = bf2f(vt[t]);
            const int row0 = row_of(bb, c, 0);
            for (int t = half * 32; t < half * 32 + 32; ++t) { float a = 0.f;
                for (int k = 0; k < 128; ++k) a += bf2f(q[t * 128 + k]) * bf2f(f2bf(Sl[k * 256 + vc]));
#pragma unroll
                for (int s = 0; s < 64; ++s) a += bf2f(sc[t * 64 + s]) * vv[s];
                O[(size_t)(row0 + t) * 1024 + h * 256 + vc] = f2bf(a); }
            __syncthreads();
            for (int k = half * 64; k < half * 64 + 64; ++k) { float a = DEC[(size_t)u * 128 + k] * Sl[k * 256 + vc];
#pragma unroll
                for (int t = 0; t < 64; ++t) a += bf2f(ke[k * 64 + t]) * vv[t];
                Sl[k * 256 + vc] = a; }
            __syncthreads();
        }
    }
}

__device__ void st_inner(const Params& p, int vb, int nvb, const bf16_t* OF, const bf16_t* OB, const bf16_t* SGA, const bf16_t* Z, const bf16_t* CBG, bf16_t* INNER, const bf16_t* ZA, float* X1C) {
    const int lane = tidx_() & 63, gw = vb * (NTHREADS / 64) + (tidx_() >> 6), ngw = nvb * (NTHREADS / 64);
    const float4 gg = *(const float4*)(p.e_gla_g + lane * 4);
    float4 cw0[4], cw1[4], cw2[4];
#pragma unroll
    for (int h = 0; h < 4; ++h) { const int c0 = h * 256 + lane * 4; cw0[h] = *(const float4*)(p.e_conv_w + c0); cw1[h] = *(const float4*)(p.e_conv_w + 1024 + c0); cw2[h] = *(const float4*)(p.e_conv_w + 2048 + c0); }
    const int per = (NT + ngw - 1) / ngw, r0 = gw * per, r1 = (r0 + per < NT) ? r0 + per : NT;
#define LO(u) __uint_as_float((u) << 16)
#define HI(u) __uint_as_float((u) & 0xffff0000u)
#define ZROW(dst, r_) do { _Pragma("unroll") for (int h = 0; h < 4; ++h) { const bf16_t* zb = h == 0 ? ZA + lane * 4 : Z + h * 256 + lane * 4; const size_t zpitch = h == 0 ? 256 : 1024; dst[h] = *(const uint2*)(zb + (size_t)(r_) * zpitch); } } while (0)
    uint2 zp[4], zc[4], zn[4];
    if (r0 < r1) { ZROW(zp, r0 > 0 ? r0 - 1 : 0); ZROW(zc, r0); }
    for (int row = r0; row < r1; ++row) {
        bool hasp, hasn;
        if (row < NLAT) { const int t = row & 63; hasp = t != 0; hasn = t != 63; } else { const int t = (row - NLAT) & 255; hasp = t != 0; hasn = t != 255; }
        const float mp = hasp ? 1.f : 0.f, mn = hasn ? 1.f : 0.f;
        ZROW(zn, row + 1 < NT ? row + 1 : row);
        uint2 a[4], b[4], sg[4], cb[4];
#pragma unroll
        for (int h = 0; h < 4; ++h) { const int c0 = h * 256 + lane * 4;
            a[h] = *(const uint2*)(OF + (size_t)row * 1024 + c0); b[h] = *(const uint2*)(OB + (size_t)row * 1024 + c0); sg[h] = *(const uint2*)(SGA + (size_t)row * 1024 + c0); cb[h] = *(const uint2*)(CBG + (size_t)row * 1024 + c0); }
#pragma unroll
        for (int h = 0; h < 4; ++h) { const int c0 = h * 256 + lane * 4;
            const float o0 = LO(a[h].x) + LO(b[h].x), o1 = HI(a[h].x) + HI(b[h].x), o2 = LO(a[h].y) + LO(b[h].y), o3 = HI(a[h].y) + HI(b[h].y);
            const float rinv = rsqrtf(wave_sum(o0 * o0 + o1 * o1 + o2 * o2 + o3 * o3) * (1.f / 256.f) + EPS);
            uint2 o; o.x = pk2(o0 * rinv * gg.x * LO(sg[h].x), o1 * rinv * gg.y * HI(sg[h].x)); o.y = pk2(o2 * rinv * gg.z * LO(sg[h].y), o3 * rinv * gg.w * HI(sg[h].y));
            *(uint2*)(INNER + (size_t)row * 2048 + c0) = o;
            const float4 w0 = cw0[h], w1 = cw1[h], w2 = cw2[h];
            uint2 y; y.x = pk2(LO(cb[h].x) * (mp * w0.x * LO(zp[h].x) + w1.x * LO(zc[h].x) + mn * w2.x * LO(zn[h].x)), HI(cb[h].x) * (mp * w0.y * HI(zp[h].x) + w1.y * HI(zc[h].x) + mn * w2.y * HI(zn[h].x)));
            y.y = pk2(LO(cb[h].y) * (mp * w0.z * LO(zp[h].y) + w1.z * LO(zc[h].y) + mn * w2.z * LO(zn[h].y)), HI(cb[h].y) * (mp * w0.w * HI(zp[h].y) + w1.w * HI(zc[h].y) + mn * w2.w * HI(zn[h].y)));
            *(uint2*)(INNER + (size_t)row * 2048 + 1024 + c0) = y; }
#pragma unroll
        for (int h = 0; h < 4; ++h) { zp[h] = zc[h]; zc[h] = zn[h]; }
    }
#undef LO
#undef HI
#undef ZROW
}

template <int MODE>
__device__ void st_rglru_naive(const Params& p, int vb, int nvb, float* lds, const bf16_t* XR, const bf16_t* SG, float* SUMA, float* SUMH, bf16_t* Y) {
    float* xc = lds;
    float* av = xc + 64 * 128;
    float* uv = av + 64 * 128;
    float* hf = uv + 64 * 128;
    const int tid = tidx_(), j = tid & 127, tq = tid >> 7;
    const int nitems = MODE == 0 ? NB * NCH * 16 * 2 : NB * 64 * 16;
    for (int it = vb; it < nitems; it += nvb) {
        int bb, c, nb;
        if (MODE == 0) { nb = (it >> 1) & 15; const int bc = it >> 5; c = bc % NCH; bb = bc / NCH; } else { nb = it & 15; const int bc = it >> 4; c = bc & 63; bb = bc >> 6; }
        const int row0 = row_of(bb, c, 0);
        const int seg0 = c < 64 ? bb * 4096 : NLAT + bb * 256, segn = c < 64 ? 4096 : 256;
        const int tl0 = row0 - seg0;
        for (int dd = 0; dd < (MODE == 0 ? 1 : 2); ++dd) {
            const int d = MODE == 0 ? (it & 1) : dd;
            __syncthreads();
            for (int e = tid; e < 64 * 128; e += NTHREADS) { const int t = e >> 7, i = e & 127, ch = nb * 128 + i; float a = p.o_conv_b[d * 2048 + ch];
#pragma unroll
                for (int jj = 0; jj < 4; ++jj) { const int tt = d == 0 ? tl0 + t - 3 + jj : tl0 + t + 3 - jj;
                    if (tt >= 0 && tt < segn) a += p.o_conv_w[((size_t)d * 4 + jj) * 2048 + ch] * bf2f(XR[(size_t)(seg0 + tt) * 2048 + ch]); }
                xc[e] = a; }
            __syncthreads();
            const float* WA = p.o_w_a + ((size_t)d * 16 + nb) * 128 * 128; const float* WX = p.o_w_x + ((size_t)d * 16 + nb) * 128 * 128;
            const int ch = nb * 128 + j;
            const float ba = p.o_b_a[d * 2048 + ch], bx = p.o_b_x[d * 2048 + ch], sp = softplusf_(-p.o_lam[d * 2048 + ch]);
            for (int i16 = 0; i16 < 16; ++i16) { const int t = tq * 16 + i16; float ra = ba, rx = bx;
                for (int i = 0; i < 128; ++i) { const float xv = bf2f(f2bf(xc[t * 128 + i])); ra += xv * bf2f(f2bf(WA[i * 128 + j])); rx += xv * bf2f(f2bf(WX[i * 128 + j])); }
                const float r = sigmoidf_(ra), ig = sigmoidf_(rx); const float la = -8.f * r * sp; const float a = __expf(la);
                av[t * 128 + j] = a; uv[t * 128 + j] = sqrtf(-expm1f(2.f * la)) * (ig * xc[t * 128 + j]); }
            __syncthreads();
            if (tid < 128) {
                const size_t sidx = (((size_t)bb * 2 + d) * NCH + c) * 2048 + ch;
                if (MODE == 0) { float A = 1.f, hh = 0.f;
                    if (d == 0) for (int t = 0; t < 64; ++t) { const float a = av[t * 128 + j]; hh = a * hh + uv[t * 128 + j]; A *= a; }
                    else for (int t = 63; t >= 0; --t) { const float a = av[t * 128 + j]; hh = a * hh + uv[t * 128 + j]; A *= a; }
                    SUMA[sidx] = A; SUMH[sidx] = hh;
                } else { float hh = SUMH[sidx];
                    if (d == 0) for (int t = 0; t < 64; ++t) { hh = av[t * 128 + j] * hh + uv[t * 128 + j]; hf[t * 128 + j] = hh; }
                    else for (int t = 63; t >= 0; --t) { hh = av[t * 128 + j] * hh + uv[t * 128 + j]; const size_t o = (size_t)(row0 + t) * 2048 + ch; Y[o] = f2bf((hf[t * 128 + j] + hh) * bf2f(SG[o])); }
                }
            }
        }
    }
    __syncthreads();
}
__device__ void st_carry(const Params& p, int vb, int nvb, const float* SUMA, float* SUMH) {
    for (int e = vb * NTHREADS + tidx_(); e < NB * 2 * 2048; e += nvb * NTHREADS) {
        const int ch = e & 2047, d = (e >> 11) & 1, bb = e >> 12; float hh = 0.f;
        for (int s0 = 0; s0 < NCH; s0 += 17) {
            float A[17], H[17];
#pragma unroll
            for (int i = 0; i < 17; ++i) { const int step = s0 + i, c = d == 0 ? (step < 4 ? 64 + step : step - 4) : 67 - step; const size_t sidx = (((size_t)bb * 2 + d) * NCH + c) * 2048 + ch; A[i] = SUMA[sidx]; H[i] = SUMH[sidx]; }
#pragma unroll
            for (int i = 0; i < 17; ++i) { const int step = s0 + i, c = d == 0 ? (step < 4 ? 64 + step : step - 4) : 67 - step; const size_t sidx = (((size_t)bb * 2 + d) * NCH + c) * 2048 + ch; SUMH[sidx] = hh; hh = A[i] * hh + H[i]; }
        }
    }
}
__device__ void st_final(const Params& p, int vb, int nvb) {
    const int lane = tidx_() & 63, gw = vb * (NTHREADS / 64) + (tidx_() >> 6), ngw = nvb * (NTHREADS / 64);
    for (int row = gw; row < NLAT; row += ngw) { float* xr = p.out + (size_t)row * 1024; float4 v[4]; float ss = 0.f;
#pragma unroll
        for (int j = 0; j < 4; ++j) { v[j] = *(const float4*)(xr + j * 256 + lane * 4); ss += v[j].x * v[j].x + v[j].y * v[j].y + v[j].z * v[j].z + v[j].w * v[j].w; }
        const float rinv = rsqrtf(wave_sum(ss) * (1.f / 1024.f) + EPS);
#pragma unroll
        for (int j = 0; j < 4; ++j) { const float4 g = *(const float4*)(p.final_g + j * 256 + lane * 4); float4 o; o.x = v[j].x * rinv * g.x; o.y = v[j].y * rinv * g.y; o.z = v[j].z * rinv * g.z; o.w = v[j].w * rinv * g.w; *(float4*)(xr + j * 256 + lane * 4) = o; }
    }
}


namespace pg8 {
#define PG8_LAS __attribute__((address_space(3)))
typedef short bf16x8 __attribute__((ext_vector_type(8)));
typedef float f32x4 __attribute__((ext_vector_type(4)));
typedef unsigned u32x4 __attribute__((ext_vector_type(4)));
constexpr int BM = 256, BK = 64, HALF = 128, HTB = HALF * BK * 2, STAGE_BYTES = 8 * HTB, NXCD = 8, WGM = 8;
__host__ __device__ __forceinline__ int lds_byte(int r, int c) { const int st = (r >> 4) * 2 + (c >> 5), rr = r & 15, cc = c & 31, ob = rr * 64 + cc * 2; return st * 1024 + (ob ^ (((ob >> 9) & 1) << 5)); }
__host__ __device__ __forceinline__ void stage_rc(int b, int& R, int& C) { const int st = b / 1024, sb = b % 1024, swz = sb ^ (((sb >> 9) & 1) << 5); R = (st >> 1) * 16 + swz / 64; C = (st & 1) * 32 + (swz % 64) / 2; }
__host__ __device__ __forceinline__ int perm32(int rho) { const int n = rho >> 4, i = rho & 15; return 8 * (i >> 2) + 4 * n + (i & 3); }
struct Unit { int pm, pn, k0, nk; };
struct Gemm { const bf16_t* A; const bf16_t* Bt; int M, N, K; };
struct TileOrder {
    int nM, nN, nwg, G, c, m0, split, base0, base1, nkfull, nM2, nN2, m02, nKS, nk2, tail_first;
    __device__ void init(int nM_, int nN_, int nkfull_, int G_, int c_, int m0_ = 0, int split_ = 1 << 30, int base0_ = 0, int base1_ = 0, int nM2_ = 0, int nN2_ = 0, int m02_ = 0, int nKS_ = 1, int nk2_ = 0) {
        nM = nM_; nN = nN_; nwg = nM * nN; nkfull = nkfull_; G = G_; c = c_; m0 = m0_; split = split_; base0 = base0_; base1 = base1_; nM2 = nM2_; nN2 = nN2_; m02 = m02_; nKS = nKS_; nk2 = nk2_; tail_first = 0; }
    __device__ bool next(int i, Unit& u) const {
        long L = (long)i * G + c;
        if (tail_first) {
            const int ntail = nM2 * nN2 * nKS;
            if (c < ntail) { if (i == 0) L = (long)nwg + c; else L = (long)(i - 1) * G + c; }
            if (i > 0 && c >= ntail && L >= nwg) return false;
            if (i > 0 && c < ntail && L >= nwg) return false;
        }
        if (L >= nwg) { const long L2 = L - nwg; if (L2 >= (long)nM2 * nN2 * nKS) return false; const int ks = (int)(L2 % nKS), rest = (int)(L2 / nKS);
            u.pm = m02 + rest / nN2; u.pn = rest % nN2; u.k0 = ks * nk2 * 64; u.nk = nk2; return true; }
        int wgid = (int)L; { const int q = nwg / NXCD, r = nwg % NXCD, xcd = wgid % NXCD, off = wgid / NXCD; wgid = (xcd < r ? xcd * (q + 1) : r * (q + 1) + (xcd - r) * q) + off; }
        const int nig = WGM * nN, gid = wgid / nig, fm = gid * WGM, gsz = (nM - fm) < WGM ? (nM - fm) : WGM;
        const int pm = fm + ((wgid % nig) % gsz), j = (wgid % nig) / gsz;
        u.pm = m0 + pm; u.pn = j < split ? base0 + j : base1 + (j - split); u.k0 = 0; u.nk = nkfull; return true;
    }
    __device__ __forceinline__ void a_ready(const Unit&) const {}
    __device__ __forceinline__ void done(const Unit&) const {}
};
typedef float f32x2_t __attribute__((ext_vector_type(2))); typedef __bf16 bf16x2_t __attribute__((ext_vector_type(2)));
__device__ __forceinline__ unsigned cvt_pk_bf16(float lo, float hi) { f32x2_t v = {lo, hi}; bf16x2_t b = __builtin_convertvector(v, bf16x2_t); return __builtin_bit_cast(unsigned, b); }
template <class Epi, class Sched, bool ALIGN_EPI = false, bool SP2 = false>
__device__ __forceinline__ void gemm_phase(PG8_LAS unsigned char* lds, const Gemm g, const Sched& S, const Epi& E) {
    const int tid = tidx_(), wid = __builtin_amdgcn_readfirstlane(tid >> 6), lane = tid & 63, wr = wid >> 2, wc = wid & 3, fr = lane & 15, fq = lane >> 4;
    const int K = g.K;
    unsigned voffA[2], voffB[2];
#pragma unroll
    for (int i = 0; i < 2; ++i) { int R, C; stage_rc(tid * 16 + i * 8192, R, C); const int Rb = Epi::PERM ? ((R & ~31) + perm32(R & 31)) : R;
        voffA[i] = (unsigned)(R * K + C) * 2u; voffB[i] = (unsigned)(Rb * K + C) * 2u; }
    const size_t kstep = (size_t)(BK * 2);
    const size_t hstep = (size_t)HALF * K * 2;
    const size_t tstep = 2 * hstep;
    const unsigned ldsw = (unsigned)wid * 1024u;
    const int aoff = lds_byte(wr * 64 + fr, fq * 8), boff = lds_byte(wc * 32 + fr, fq * 8);
#define PG8_SA(b, h) (((b) * 2 + (h)) * HTB)
#define PG8_SB(b, h) ((4 + (b) * 2 + (h)) * HTB)
#define PG8_STAGE(bufoff, gbase, voff) do { _Pragma("unroll") for (int _i = 0; _i < 2; ++_i) \
        __builtin_amdgcn_global_load_lds((const unsigned*)((const char*)(gbase) + (voff)[_i]), (PG8_LAS unsigned*)(lds + (bufoff) + ldsw + _i * 8192), 16, 0, 0); } while (0)
#define PG8_LDA(dst, b, h) do { _Pragma("unroll") for (int m = 0; m < 4; ++m) _Pragma("unroll") for (int k = 0; k < 2; ++k) dst[m][k] = *(const PG8_LAS bf16x8*)(lds + PG8_SA(b, h) + aoff + m * 2048 + k * 1024); } while (0)
#define PG8_LDB(dst, b, h) do { _Pragma("unroll") for (int n = 0; n < 2; ++n) _Pragma("unroll") for (int k = 0; k < 2; ++k) dst[n][k] = *(const PG8_LAS bf16x8*)(lds + PG8_SB(b, h) + boff + n * 2048 + k * 1024); } while (0)
#define PG8_MMA(ai, bj, At, Bt) do { __builtin_amdgcn_s_setprio(1); _Pragma("unroll") for (int m = 0; m < 4; ++m) _Pragma("unroll") for (int n = 0; n < 2; ++n) _Pragma("unroll") for (int k = 0; k < 2; ++k) \
        acc[ai][bj][m][n] = __builtin_amdgcn_mfma_f32_16x16x32_bf16(Bt[n][k], At[m][k], acc[ai][bj][m][n], 0, 0, 0); __builtin_amdgcn_s_setprio(0); } while (0)
#define PG8_WAIT_V(n) asm volatile("s_waitcnt vmcnt(" #n ")" ::: "memory")
#define PG8_WAIT_L(n) asm volatile("s_waitcnt lgkmcnt(" #n ")" ::: "memory")
#define PG8_BAR __builtin_amdgcn_s_barrier()
#define PG8_SCHED __builtin_amdgcn_sched_barrier(0)
    Unit cur, nxt; int ui = 0;
    if (!S.next(0, cur)) return;
    f32x4 acc[2][2][4][2];
#pragma unroll
    for (int a = 0; a < 2; ++a)
#pragma unroll
        for (int b = 0; b < 2; ++b)
#pragma unroll
            for (int m = 0; m < 4; ++m)
#pragma unroll
                for (int n = 0; n < 2; ++n) acc[a][b][m][n] = (f32x4){0.f, 0.f, 0.f, 0.f};
    bf16x8 At[4][2], B0[2][2], B1[2][2];
    const char* cA = (const char*)g.A + (size_t)cur.pm * tstep + (size_t)cur.k0 * 2; const char* cB = (const char*)g.Bt + (size_t)cur.pn * tstep + (size_t)cur.k0 * 2;
    S.a_ready(cur);
    if constexpr (SP2) {
        PG8_STAGE(PG8_SB(0, 0), cB, voffB); PG8_STAGE(PG8_SB(0, 1), cB + hstep, voffB); PG8_STAGE(PG8_SA(0, 0), cA, voffA); PG8_STAGE(PG8_SA(0, 1), cA + hstep, voffA);
        if (wr == 1) PG8_BAR;
        PG8_WAIT_V(2); PG8_BAR;
        PG8_STAGE(PG8_SB(1, 0), cB + kstep, voffB); PG8_STAGE(PG8_SA(1, 0), cA + kstep, voffA); PG8_STAGE(PG8_SB(1, 1), cB + hstep + kstep, voffB);
        PG8_WAIT_V(6); PG8_BAR;
    } else {
        PG8_STAGE(PG8_SB(0, 0), cB, voffB); PG8_STAGE(PG8_SA(0, 0), cA, voffA); PG8_STAGE(PG8_SB(0, 1), cB + hstep, voffB); PG8_STAGE(PG8_SA(0, 1), cA + hstep, voffA);
        if (wr == 1) PG8_BAR;
        PG8_WAIT_V(4); PG8_BAR;
        PG8_STAGE(PG8_SB(1, 0), cB + kstep, voffB); PG8_STAGE(PG8_SA(1, 0), cA + kstep, voffA); PG8_STAGE(PG8_SB(1, 1), cB + hstep + kstep, voffB);
        PG8_WAIT_V(6); PG8_BAR;
    }
    for (;;) {
        const bool has_next = S.next(ui + 1, nxt);
        const char* nA = has_next ? (const char*)g.A + (size_t)nxt.pm * tstep + (size_t)nxt.k0 * 2 : cA; const char* nB = has_next ? (const char*)g.Bt + (size_t)nxt.pn * tstep + (size_t)nxt.k0 * 2 : cB;
        const int nt = cur.nk;
        for (int t = 0; t < nt; t += 2) {
            const bool last = (t == nt - 2);
            const char* a1 = cA + (size_t)(t + 1) * kstep;
            const char* a2 = last ? nA : cA + (size_t)(t + 2) * kstep; const char* b2 = last ? nB : cB + (size_t)(t + 2) * kstep;
            const char* a3 = a2 + kstep; const char* b3 = b2 + kstep;
            if (last && has_next) S.a_ready(nxt);
            if constexpr (SP2) {
            PG8_LDB(B0, 0, 0); PG8_LDB(B1, 0, 1); PG8_SCHED; PG8_LDA(At, 0, 0); PG8_STAGE(PG8_SA(1, 1), a1 + hstep, voffA);
            PG8_WAIT_V(8); PG8_WAIT_L(0); PG8_BAR; PG8_MMA(0, 0, At, B0); PG8_MMA(0, 1, At, B1); PG8_BAR; PG8_SCHED;
            PG8_LDA(At, 0, 1); PG8_STAGE(PG8_SB(0, 0), b2, voffB); PG8_STAGE(PG8_SB(0, 1), b2 + hstep, voffB); PG8_STAGE(PG8_SA(0, 0), a2, voffA);
            PG8_WAIT_V(8); PG8_WAIT_L(0); PG8_BAR; PG8_MMA(1, 0, At, B0); PG8_MMA(1, 1, At, B1); PG8_BAR; PG8_SCHED;
            PG8_LDB(B0, 1, 0); PG8_LDB(B1, 1, 1); PG8_SCHED; PG8_LDA(At, 1, 0); PG8_STAGE(PG8_SA(0, 1), a2 + hstep, voffA);
            PG8_WAIT_V(8); PG8_WAIT_L(0); PG8_BAR; PG8_MMA(0, 0, At, B0); PG8_MMA(0, 1, At, B1); PG8_BAR; PG8_SCHED;
            PG8_LDA(At, 1, 1); PG8_STAGE(PG8_SB(1, 0), b3, voffB); PG8_STAGE(PG8_SB(1, 1), b3 + hstep, voffB); PG8_STAGE(PG8_SA(1, 0), a3, voffA);
            PG8_WAIT_V(8); PG8_WAIT_L(0); PG8_BAR; PG8_MMA(1, 0, At, B0); PG8_MMA(1, 1, At, B1); PG8_BAR; PG8_SCHED;
            } else {
            PG8_LDB(B0, 0, 0); PG8_SCHED; PG8_LDA(At, 0, 0); PG8_STAGE(PG8_SA(1, 1), a1 + hstep, voffA);
            PG8_WAIT_L(8); PG8_BAR; PG8_WAIT_L(0); PG8_MMA(0, 0, At, B0); PG8_BAR; PG8_SCHED;
            PG8_LDB(B1, 0, 1); PG8_STAGE(PG8_SB(0, 0), b2, voffB);
            PG8_BAR; PG8_WAIT_L(0); PG8_MMA(0, 1, At, B1); PG8_BAR;
            PG8_LDA(At, 0, 1); PG8_STAGE(PG8_SA(0, 0), a2, voffA);
            PG8_BAR; PG8_WAIT_L(0); PG8_MMA(1, 0, At, B0); PG8_BAR; PG8_SCHED;
            PG8_STAGE(PG8_SB(0, 1), b2 + hstep, voffB);
            PG8_WAIT_V(6); PG8_BAR; PG8_MMA(1, 1, At, B1); PG8_BAR;
            PG8_LDB(B0, 1, 0); PG8_SCHED; PG8_LDA(At, 1, 0); PG8_STAGE(PG8_SA(0, 1), a2 + hstep, voffA);
            PG8_WAIT_L(8); PG8_BAR; PG8_WAIT_L(0); PG8_MMA(0, 0, At, B0); PG8_BAR; PG8_SCHED;
            PG8_LDB(B1, 1, 1); PG8_STAGE(PG8_SB(1, 0), b3, voffB);
            PG8_BAR; PG8_WAIT_L(0); PG8_MMA(0, 1, At, B1); PG8_BAR;
            PG8_LDA(At, 1, 1); PG8_STAGE(PG8_SA(1, 0), a3, voffA);
            PG8_BAR; PG8_WAIT_L(0); PG8_MMA(1, 0, At, B0); PG8_BAR; PG8_SCHED;
            PG8_STAGE(PG8_SB(1, 1), b3 + hstep, voffB);
            PG8_WAIT_V(6); PG8_BAR; PG8_MMA(1, 1, At, B1); PG8_BAR;
            }
        }
        if constexpr (ALIGN_EPI) { if (wr == 0) PG8_BAR; }
        if constexpr (!Epi::AFTER_DRAIN) { E(acc, cur, wr, wc, fr, fq); S.done(cur); } else { if (has_next) { E(acc, cur, wr, wc, fr, fq); S.done(cur); } }
        if (!has_next) break;
#pragma unroll
        for (int a = 0; a < 2; ++a)
#pragma unroll
            for (int b = 0; b < 2; ++b)
#pragma unroll
                for (int m = 0; m < 4; ++m)
#pragma unroll
                    for (int n = 0; n < 2; ++n) acc[a][b][m][n] = (f32x4){0.f, 0.f, 0.f, 0.f};
        cur = nxt; cA = nA; cB = nB; ++ui;
        if constexpr (ALIGN_EPI) { if (wr == 1) PG8_BAR; }
    }
    PG8_WAIT_V(0);
    if constexpr (!ALIGN_EPI) { if (wr == 0) PG8_BAR; }
    PG8_BAR;
    if constexpr (Epi::AFTER_DRAIN) { E.fused(acc, cur, wr, wc, fr, fq, lds, wid, lane); S.done(cur); }
#undef PG8_SA
#undef PG8_SB
#undef PG8_STAGE
#undef PG8_LDA
#undef PG8_LDB
#undef PG8_MMA
#undef PG8_WAIT_V
#undef PG8_WAIT_L
#undef PG8_BAR
#undef PG8_SCHED
}
}

DEVI pg8::u32x4 pack8(const pg8::f32x4& a, const pg8::f32x4& b) { pg8::u32x4 w; w.x = pg8::cvt_pk_bf16(a[0], a[1]); w.y = pg8::cvt_pk_bf16(a[2], a[3]); w.z = pg8::cvt_pk_bf16(b[0], b[1]); w.w = pg8::cvt_pk_bf16(b[2], b[3]); return w; }
DEVI pg8::f32x4 silu4(const pg8::f32x4& a) { pg8::f32x4 r; r[0] = siluf_(a[0]); r[1] = siluf_(a[1]); r[2] = siluf_(a[2]); r[3] = siluf_(a[3]); return r; }
struct FEpi1 {
    static constexpr bool PERM = true, AFTER_DRAIN = false;
    bf16_t *QK, *V, *SGA, *Z, *CBG; float* ALR; bf16_t* ZA;
    DEVI void operator()(const pg8::f32x4 (&acc)[2][2][4][2], const pg8::Unit& u, int wr, int wc, int fr, int fq) const {
        const int t = u.pn, row0 = u.pm * 256 + wr * 64 + fr, cw = wc * 32 + 8 * fq;
#pragma unroll
        for (int ai = 0; ai < 2; ++ai)
#pragma unroll
            for (int m = 0; m < 4; ++m) {
                const size_t row = (size_t)(row0 + ai * 128 + m * 16);
                if (t < 12) {
                    bf16_t* base = t < 4 ? QK + row * 1024 + t * 256 : (t < 8 ? V + row * 1024 + (t - 4) * 256 : SGA + row * 1024 + (t - 8) * 256);
#pragma unroll
                    for (int bj = 0; bj < 2; ++bj) { pg8::f32x4 v0 = acc[ai][bj][m][0], v1 = acc[ai][bj][m][1]; if (t >= 8) { v0 = silu4(v0); v1 = silu4(v1); }
                        *(pg8::u32x4*)(base + bj * 128 + cw) = pack8(v0, v1); }
                } else if (t == 12) {
                    if (wc == 0) { *(pg8::f32x4*)(ALR + row * 32 + 8 * fq) = acc[ai][0][m][0]; *(pg8::f32x4*)(ALR + row * 32 + 8 * fq + 4) = acc[ai][0][m][1]; }
                } else if (t < 21) {
                    bf16_t* zp = t < 15 ? ZA + row * 256 + (t - 13) * 128 + cw : Z + row * 1024 + (t - 13) * 128 + cw;
                    *(pg8::u32x4*)zp = pack8(acc[ai][0][m][0] * acc[ai][1][m][0], acc[ai][0][m][1] * acc[ai][1][m][1]);
                } else {
                    *(pg8::u32x4*)(CBG + row * 1024 + (t - 21) * 128 + cw) = pack8(acc[ai][0][m][0] * silu4(acc[ai][1][m][0]), acc[ai][0][m][1] * silu4(acc[ai][1][m][1]));
                }
            }
    }
};
template <bool HAS_TAIL> struct FEpiRes {
    static constexpr bool PERM = false, AFTER_DRAIN = false;
    const float* xl; const float* xc; float* outl; float* outc; const float* MODl;
    DEVI void operator()(const pg8::f32x4 (&acc)[2][2][4][2], const pg8::Unit& u, int wr, int wc, int fr, int fq) const {
        const int row0 = u.pm * 256 + wr * 64 + fr, col0 = u.pn * 256 + wc * 32 + 4 * fq;
        const bool lat = u.pm < NLAT / 256;
        const float* gate = MODl + (size_t)(lat ? (u.pm >> 4) : 4) * 3072 + 2048 + col0;
        pg8::f32x4 gv[2][2];
#pragma unroll
        for (int bj = 0; bj < 2; ++bj)
#pragma unroll
            for (int n = 0; n < 2; ++n) gv[bj][n] = *(const pg8::f32x4*)(gate + bj * 128 + n * 16);
        if (HAS_TAIL && !lat) {
            float* o = outc + (size_t)(u.k0 >> 8) * NCTX * 1024 - (size_t)NLAT * 1024;
#pragma unroll
            for (int ai = 0; ai < 2; ++ai)
#pragma unroll
                for (int m = 0; m < 4; ++m) { const size_t off = (size_t)(row0 + ai * 128 + m * 16) * 1024 + col0;
#pragma unroll
                    for (int bj = 0; bj < 2; ++bj)
#pragma unroll
                        for (int n = 0; n < 2; ++n) *(pg8::f32x4*)(o + off + bj * 128 + n * 16) = acc[ai][bj][m][n]; }
            return;
        }
        const float* xin = xl; float* o = outl;
#pragma unroll
        for (int ai = 0; ai < 2; ++ai)
#pragma unroll
            for (int m = 0; m < 4; ++m) { const size_t off = (size_t)(row0 + ai * 128 + m * 16) * 1024 + col0;
#pragma unroll
                for (int bj = 0; bj < 2; ++bj)
#pragma unroll
                    for (int n = 0; n < 2; ++n) { const pg8::f32x4 xv = *(const pg8::f32x4*)(xin + off + bj * 128 + n * 16); *(pg8::f32x4*)(o + off + bj * 128 + n * 16) = xv + gv[bj][n] * acc[ai][bj][m][n]; } }
    }
};
struct FEpi3 {
    static constexpr bool PERM = true, AFTER_DRAIN = false;
    bf16_t* XR; bf16_t* SG; float* XRC;
    DEVI void operator()(const pg8::f32x4 (&acc)[2][2][4][2], const pg8::Unit& u, int wr, int wc, int fr, int fq) const {
        const int t = u.pn, row0 = u.pm * 256 + wr * 64 + fr, cw = wc * 32 + 8 * fq;
        if (u.pm >= NLAT / 256) {
            float* sl = XRC + (size_t)(u.k0 >> 9) * NCTX * 2048;
#pragma unroll
            for (int ai = 0; ai < 2; ++ai)
#pragma unroll
                for (int m = 0; m < 4; ++m) { float* rp = sl + (size_t)(row0 - NLAT + ai * 128 + m * 16) * 2048 + t * 256 + cw;
#pragma unroll
                    for (int bj = 0; bj < 2; ++bj) { *(pg8::f32x4*)(rp + bj * 128) = acc[ai][bj][m][0]; *(pg8::f32x4*)(rp + bj * 128 + 4) = acc[ai][bj][m][1]; } }
            return;
        }
        bf16_t* base = t < 8 ? XR + (size_t)xr_pad_of_tile(u.pm) * 2048 + t * 256 : SG + (t - 8) * 256;
#pragma unroll
        for (int ai = 0; ai < 2; ++ai)
#pragma unroll
            for (int m = 0; m < 4; ++m) { bf16_t* rp = base + (size_t)(row0 + ai * 128 + m * 16) * 2048 + cw;
#pragma unroll
                for (int bj = 0; bj < 2; ++bj) { pg8::f32x4 v0 = acc[ai][bj][m][0], v1 = acc[ai][bj][m][1]; pg8::u32x4 w;
                    if (t >= 8) { w = pack8(silu4(v0), silu4(v1)); }
                    else { w.x = pk2h(v0[0], v0[1]); w.y = pk2h(v0[2], v0[3]); w.z = pk2h(v1[0], v1[1]); w.w = pk2h(v1[2], v1[3]); }
                    *(pg8::u32x4*)(rp + bj * 128) = w; } }
    }
};

struct FEpiResRms {
    static constexpr bool PERM = false, AFTER_DRAIN = true;
    const float* xin; float* out; const float* MODl; const float* gfin; float* slots; unsigned* cnt;
    DEVI void fused(pg8::f32x4 (&acc)[2][2][4][2], const pg8::Unit& u, int wr, int wc, int fr, int fq, PG8_LAS unsigned char* lds, int wid, int lane) const {
        const int row0 = u.pm * 256 + wr * 64 + fr, col0 = u.pn * 256 + wc * 32 + 4 * fq;
        const float* gate = MODl + (size_t)(u.pm >> 4) * 3072 + 2048 + col0;
        PG8_LAS float* P = (PG8_LAS float*)lds;
        PG8_LAS float* S = (PG8_LAS float*)(lds + 8192);
        { pg8::f32x4 gv[2][2];
#pragma unroll
          for (int bj = 0; bj < 2; ++bj)
#pragma unroll
              for (int n = 0; n < 2; ++n) gv[bj][n] = *(const pg8::f32x4*)(gate + bj * 128 + n * 16);
#pragma unroll
          for (int ai = 0; ai < 2; ++ai)
#pragma unroll
              for (int m = 0; m < 4; ++m) { const float* xp = xin + (size_t)(row0 + ai * 128 + m * 16) * 1024 + col0;
#pragma unroll
                  for (int bj = 0; bj < 2; ++bj)
#pragma unroll
                      for (int n = 0; n < 2; ++n) { const pg8::f32x4 xv = *(const pg8::f32x4*)(xp + bj * 128 + n * 16); acc[ai][bj][m][n] = xv + gv[bj][n] * acc[ai][bj][m][n]; }
                  asm volatile("" : "+v"(acc[ai][0][m][0]), "+v"(acc[ai][0][m][1]), "+v"(acc[ai][1][m][0]), "+v"(acc[ai][1][m][1]));
                  if (m & 1) asm volatile("" ::: "memory"); } }
#pragma unroll
        for (int ai = 0; ai < 2; ++ai)
#pragma unroll
            for (int m = 0; m < 4; ++m) { float q = 0.f;
#pragma unroll
                for (int bj = 0; bj < 2; ++bj)
#pragma unroll
                    for (int n = 0; n < 2; ++n) { const pg8::f32x4 x = acc[ai][bj][m][n]; q += (x[0] * x[0] + x[1] * x[1]) + (x[2] * x[2] + x[3] * x[3]); }
                q += __shfl_xor(q, 16); q += __shfl_xor(q, 32);
                if (fq == 0) P[(ai * 128 + wr * 64 + m * 16 + fr) * 4 + wc] = q; }
        asm volatile("s_waitcnt lgkmcnt(0)" ::: "memory"); __builtin_amdgcn_s_barrier(); asm volatile("" ::: "memory");
        const int row = wid * 32 + (lane & 31);
        if (lane < 32) { const float t = (P[row * 4 + 0] + P[row * 4 + 1]) + (P[row * 4 + 2] + P[row * 4 + 3]);
            __hip_atomic_store(slots + ((size_t)(u.pm * 256 + row) * 4 + u.pn), t, __ATOMIC_RELAXED, __HIP_MEMORY_SCOPE_AGENT); }
        asm volatile("s_waitcnt vmcnt(0)" ::: "memory");
        if (lane == 0) __hip_atomic_fetch_add(cnt + 64 * u.pm, 1u, __ATOMIC_RELAXED, __HIP_MEMORY_SCOPE_AGENT);
        if (wid == 0) { unsigned sp = 0;
            while ((unsigned)__builtin_amdgcn_readfirstlane(__hip_atomic_load(cnt + 64 * u.pm, __ATOMIC_RELAXED, __HIP_MEMORY_SCOPE_AGENT)) < 32u) { __builtin_amdgcn_s_sleep(2); if (++sp > (1u << 22)) break; }
            __builtin_amdgcn_fence(__ATOMIC_ACQUIRE, "agent"); }
        asm volatile("s_waitcnt vmcnt(0) lgkmcnt(0)" ::: "memory"); __builtin_amdgcn_s_barrier(); asm volatile("" ::: "memory");
        if (lane < 32) { const float* sl = slots + (size_t)(u.pm * 256 + row) * 4; float t = 0.f;
#pragma unroll
            for (int k = 0; k < 4; ++k) t += __hip_atomic_load(sl + k, __ATOMIC_RELAXED, __HIP_MEMORY_SCOPE_AGENT);
            S[row] = rsqrtf(t * (1.f / 1024.f) + EPS); }
        asm volatile("s_waitcnt lgkmcnt(0)" ::: "memory"); __builtin_amdgcn_s_barrier(); asm volatile("" ::: "memory");
        pg8::f32x4 gf[2][2];
#pragma unroll
        for (int bj = 0; bj < 2; ++bj)
#pragma unroll
            for (int n = 0; n < 2; ++n) gf[bj][n] = *(const pg8::f32x4*)(gfin + col0 + bj * 128 + n * 16);
#pragma unroll
        for (int ai = 0; ai < 2; ++ai)
#pragma unroll
            for (int m = 0; m < 4; ++m) { const int r = ai * 128 + wr * 64 + m * 16 + fr; const float rinv = S[r]; const size_t off = (size_t)(u.pm * 256 + r) * 1024 + col0;
#pragma unroll
                for (int bj = 0; bj < 2; ++bj)
#pragma unroll
                    for (int n = 0; n < 2; ++n) *(pg8::f32x4*)(out + off + bj * 128 + n * 16) = acc[ai][bj][m][n] * rinv * gf[bj][n]; }
    }
    DEVI void operator()(const pg8::f32x4 (&)[2][2][4][2], const pg8::Unit&, int, int, int, int) const {}
};

struct FEpiResMod {
    static constexpr bool PERM = false, AFTER_DRAIN = true;
    const float* xin; float* x1; bf16_t* H1; const float* MOD0; const float* MOD1; const float* g1; float* slab; float* slots; unsigned* cnt;
    DEVI void operator()(const pg8::f32x4 (&acc)[2][2][4][2], const pg8::Unit& u, int wr, int wc, int fr, int fq) const {
        if (u.pm < NLAT / 256) return;
        const int row0 = u.pm * 256 + wr * 64 + fr, col0 = u.pn * 256 + wc * 32 + 4 * fq;
        float* o = slab + (size_t)(u.k0 >> 8) * NCTX * 1024 - (size_t)NLAT * 1024;
#pragma unroll
        for (int ai = 0; ai < 2; ++ai)
#pragma unroll
            for (int m = 0; m < 4; ++m) { const size_t off = (size_t)(row0 + ai * 128 + m * 16) * 1024 + col0;
#pragma unroll
                for (int bj = 0; bj < 2; ++bj)
#pragma unroll
                    for (int n = 0; n < 2; ++n) *(pg8::f32x4*)(o + off + bj * 128 + n * 16) = acc[ai][bj][m][n]; }
    }
    DEVI void fused(pg8::f32x4 (&acc)[2][2][4][2], const pg8::Unit& u, int wr, int wc, int fr, int fq, PG8_LAS unsigned char* lds, int wid, int lane) const {
        typedef unsigned u32x2v __attribute__((ext_vector_type(2)));
        const int row0 = u.pm * 256 + wr * 64 + fr, col0 = u.pn * 256 + wc * 32 + 4 * fq, b = u.pm >> 4;
        PG8_LAS float* P = (PG8_LAS float*)lds; PG8_LAS float* S = (PG8_LAS float*)(lds + 8192);
        { const float* gate = MOD0 + (size_t)b * 3072 + 2048 + col0; pg8::f32x4 gv[2][2];
#pragma unroll
          for (int bj = 0; bj < 2; ++bj)
#pragma unroll
              for (int n = 0; n < 2; ++n) gv[bj][n] = *(const pg8::f32x4*)(gate + bj * 128 + n * 16);
#pragma unroll
          for (int ai = 0; ai < 2; ++ai)
#pragma unroll
              for (int m = 0; m < 4; ++m) { const size_t off = (size_t)(row0 + ai * 128 + m * 16) * 1024 + col0;
#pragma unroll
                  for (int bj = 0; bj < 2; ++bj)
#pragma unroll
                      for (int n = 0; n < 2; ++n) { const pg8::f32x4 xv = *(const pg8::f32x4*)(xin + off + bj * 128 + n * 16); acc[ai][bj][m][n] = xv + gv[bj][n] * acc[ai][bj][m][n]; *(pg8::f32x4*)(x1 + off + bj * 128 + n * 16) = acc[ai][bj][m][n]; }
                  asm volatile("" : "+v"(acc[ai][0][m][0]), "+v"(acc[ai][0][m][1]), "+v"(acc[ai][1][m][0]), "+v"(acc[ai][1][m][1]));
                  if (m & 1) asm volatile("" ::: "memory"); } }
#pragma unroll
        for (int ai = 0; ai < 2; ++ai)
#pragma unroll
            for (int m = 0; m < 4; ++m) { float q = 0.f;
#pragma unroll
                for (int bj = 0; bj < 2; ++bj)
#pragma unroll
                    for (int n = 0; n < 2; ++n) { const pg8::f32x4 x = acc[ai][bj][m][n]; q += (x[0] * x[0] + x[1] * x[1]) + (x[2] * x[2] + x[3] * x[3]); }
                q += __shfl_xor(q, 16); q += __shfl_xor(q, 32);
                if (fq == 0) P[(ai * 128 + wr * 64 + m * 16 + fr) * 4 + wc] = q; }
        asm volatile("s_waitcnt lgkmcnt(0)" ::: "memory"); __builtin_amdgcn_s_barrier(); asm volatile("" ::: "memory");
        const int row = wid * 32 + (lane & 31);
        if (lane < 32) { const float t = (P[row * 4 + 0] + P[row * 4 + 1]) + (P[row * 4 + 2] + P[row * 4 + 3]);
            __hip_atomic_store(slots + ((size_t)(u.pm * 256 + row) * 4 + u.pn), t, __ATOMIC_RELAXED, __HIP_MEMORY_SCOPE_AGENT); }
        asm volatile("s_waitcnt vmcnt(0)" ::: "memory");
        if (lane == 0) __hip_atomic_fetch_add(cnt + 64 * u.pm, 1u, __ATOMIC_RELAXED, __HIP_MEMORY_SCOPE_AGENT);
        if (wid == 0) { unsigned sp = 0;
            while ((unsigned)__builtin_amdgcn_readfirstlane(__hip_atomic_load(cnt + 64 * u.pm, __ATOMIC_RELAXED, __HIP_MEMORY_SCOPE_AGENT)) < 32u) { __builtin_amdgcn_s_sleep(2); if (++sp > (1u << 22)) break; }
            __builtin_amdgcn_fence(__ATOMIC_ACQUIRE, "agent"); }
        asm volatile("s_waitcnt vmcnt(0) lgkmcnt(0)" ::: "memory"); __builtin_amdgcn_s_barrier(); asm volatile("" ::: "memory");
        if (lane < 32) { const float* sl = slots + (size_t)(u.pm * 256 + row) * 4; float t = 0.f;
#pragma unroll
            for (int k = 0; k < 4; ++k) t += __hip_atomic_load(sl + k, __ATOMIC_RELAXED, __HIP_MEMORY_SCOPE_AGENT);
            S[row] = rsqrtf(t * (1.f / 1024.f) + EPS); }
        asm volatile("s_waitcnt lgkmcnt(0)" ::: "memory"); __builtin_amdgcn_s_barrier(); asm volatile("" ::: "memory");
        const float* md = MOD1 + (size_t)b * 3072 + col0;
#pragma unroll
        for (int bj = 0; bj < 2; ++bj)
#pragma unroll
            for (int n = 0; n < 2; ++n) { const int co = bj * 128 + n * 16; const pg8::f32x4 gg = *(const pg8::f32x4*)(g1 + col0 + co), sh = *(const pg8::f32x4*)(md + co), sc = *(const pg8::f32x4*)(md + 1024 + co);
                const pg8::f32x4 mul = gg * (sc + 1.0f);
#pragma unroll
                for (int ai = 0; ai < 2; ++ai)
#pragma unroll
                    for (int m = 0; m < 4; ++m) { const int r = ai * 128 + wr * 64 + m * 16 + fr; const pg8::f32x4 hv = acc[ai][bj][m][n] * S[r] * mul + sh;
                        u32x2v w; w.x = pg8::cvt_pk_bf16(hv[0], hv[1]); w.y = pg8::cvt_pk_bf16(hv[2], hv[3]); *(u32x2v*)(H1 + (size_t)(u.pm * 256 + r) * 1024 + col0 + co) = w; } }
    }
};
#ifndef FAST_GEMM
#define FAST_GEMM 1
#endif


#define LASP __attribute__((address_space(3)))
__device__ void st_glawalk(const Params& p, int vb, int nvb, unsigned char* lds_, const bf16_t* QIN, const bf16_t* KET, const bf16_t* SC, const float* DEC, const bf16_t* VT, bf16_t* OF, bf16_t* OB) {
    typedef pg8::bf16x8 bx8; typedef pg8::f32x4 f4; typedef unsigned u32x2 __attribute__((ext_vector_type(2))); typedef pg8::u32x4 u4;
    LASP unsigned char* lds = (LASP unsigned char*)lds_;
    constexpr int QOFF = 0, KOFF = 17408, SOFF = KOFF + 18432, VOFF = SOFF + 9216, DOFF = VOFF + 4608, BUFSZ = 50176;
    const int tid = tidx_(), wid = __builtin_amdgcn_readfirstlane(tid >> 6), lane = tid & 63, c = lane & 15, g = lane >> 4;
    for (int it0 = vb; it0 < 256; it0 += nvb) {
        const int item = (nvb == 256) ? ((it0 & 7) * 32 + (it0 >> 3)) : it0;
        const int vs = item & 7, combo = item >> 3, d = combo & 1, h = (combo >> 1) & 3, bb = combo >> 3;
        LDS_BARRIER();
        if (wid >= 2) {
            const int lt = tid - 128;
            unsigned long long cst[8]; unsigned mult[8]; int doff[8];
#pragma unroll
            for (int j = 0; j < 8; ++j) { const int pp = lt + 384 * j;
                if (pp < 1024) { cst[j] = (unsigned long long)QIN + (pp >> 4) * 256 + (pp & 15) * 16; mult[j] = 16384u; doff[j] = QOFF + (pp >> 4) * 272 + (pp & 15) * 16; }
                else if (pp < 2048) { const int q = pp - 1024; cst[j] = (unsigned long long)KET + (q >> 3) * 128 + (q & 7) * 16; mult[j] = 16384u; doff[j] = KOFF + (q >> 3) * 144 + (q & 7) * 16; }
                else if (pp < 2560) { const int q = pp - 2048; cst[j] = (unsigned long long)SC + (q >> 3) * 128 + (q & 7) * 16; mult[j] = 8192u; doff[j] = SOFF + (q >> 3) * 144 + (q & 7) * 16; }
                else if (pp < 2816) { const int q = pp - 2560; cst[j] = (unsigned long long)VT + (vs * 32 + (q >> 3)) * 128 + (q & 7) * 16 - (unsigned long long)d * 16384; mult[j] = 16384u; doff[j] = VOFF + (q >> 3) * 144 + (q & 7) * 16; }
                else if (pp < 2848) { const int q = pp - 2816; cst[j] = (unsigned long long)DEC + q * 16; mult[j] = 512u; doff[j] = DOFF + q * 16; }
                else { cst[j] = (unsigned long long)DEC; mult[j] = 0u; doff[j] = -1; } }
            u4 r0[8], r1[8];
#define GW_LOAD(R, step) do { const int cc_ = d == 0 ? ((step) < 4 ? 64 + (step) : (step) - 4) : 67 - (step); const unsigned u_ = (unsigned)(((bb * NCH + cc_) * 4 + h) * 2 + d); \
                _Pragma("unroll") for (int j_ = 0; j_ < 8; ++j_) R[j_] = *(const u4*)(cst[j_] + (unsigned long long)u_ * mult[j_]); } while (0)
#define GW_WRITE(R, bufi) do { LASP unsigned char* b_ = lds + (bufi) * BUFSZ; _Pragma("unroll") for (int j_ = 0; j_ < 8; ++j_) if (doff[j_] >= 0) *(LASP u4*)(b_ + doff[j_]) = R[j_]; } while (0)
            GW_LOAD(r0, 0); GW_WRITE(r0, 0); GW_LOAD(r0, 1); GW_LOAD(r1, 2);
            LDS_BARRIER();
            for (int step = 0; step < NCH; step += 2) {
                GW_WRITE(r0, 1); if (step + 3 < NCH) GW_LOAD(r0, step + 3);
                LDS_BARRIER();
                if (step + 2 < NCH) { GW_WRITE(r1, 0); if (step + 4 < NCH) GW_LOAD(r1, step + 4); }
                LDS_BARRIER();
            }
#undef GW_LOAD
#undef GW_WRITE
        } else {
            f4 S[8];
#pragma unroll
            for (int m = 0; m < 8; ++m) S[m] = (f4){0.f, 0.f, 0.f, 0.f};
            bf16_t* O = d == 0 ? OF : OB;
            LDS_BARRIER();
            for (int step = 0; step < NCH; ++step) {
                const LASP unsigned char* B = lds + (step & 1) * BUFSZ;
#define SB0() __builtin_amdgcn_sched_barrier(0)
#define RDQ(dst_lo, dst_hi, ks) do { _Pragma("unroll") for (int mt = 0; mt < 4; ++mt) { const LASP unsigned char* qa = B + QOFF + (16 * mt + c) * 272 + (32 * (ks) + 4 * g) * 2; dst_lo[mt] = *(const LASP u32x2*)qa; dst_hi[mt] = *(const LASP u32x2*)(qa + 32); } } while (0)
#define MMQ(lo, hi, ks) do { _Pragma("unroll") for (int mt = 0; mt < 4; ++mt) { u4 w; w.x = lo[mt].x; w.y = lo[mt].y; w.z = hi[mt].x; w.w = hi[mt].y; o[mt] = __builtin_amdgcn_mfma_f32_16x16x32_bf16(sB[ks], __builtin_bit_cast(bx8, w), o[mt], 0, 0, 0); } } while (0)
#define RDK(kf, dv, m0) do { _Pragma("unroll") for (int mm = 0; mm < 4; ++mm) { const LASP unsigned char* ka = B + KOFF + (16 * ((m0) + mm) + c) * 144 + g * 16; kf[mm][0] = *(const LASP bx8*)ka; kf[mm][1] = *(const LASP bx8*)(ka + 64); dv[mm] = *(const LASP f4*)(B + DOFF + (16 * ((m0) + mm) + 4 * g) * 4); } } while (0)
#define MMK(kf, dv, m0) do { _Pragma("unroll") for (int mm = 0; mm < 4; ++mm) { S[(m0) + mm] = S[(m0) + mm] * dv[mm]; S[(m0) + mm] = __builtin_amdgcn_mfma_f32_16x16x32_bf16(kf[mm][0], bv0, S[(m0) + mm], 0, 0, 0); S[(m0) + mm] = __builtin_amdgcn_mfma_f32_16x16x32_bf16(kf[mm][1], bv1, S[(m0) + mm], 0, 0, 0); } } while (0)
                const bx8 bv0 = *(const LASP bx8*)(B + VOFF + (16 * wid + c) * 144 + g * 16), bv1 = *(const LASP bx8*)(B + VOFF + (16 * wid + c) * 144 + 64 + g * 16);
                u32x2 qa_lo[4], qa_hi[4], qb_lo[4], qb_hi[4];
                RDQ(qa_lo, qa_hi, 0); RDQ(qb_lo, qb_hi, 1);
                bx8 sB[4];
#pragma unroll
                for (int ks = 0; ks < 4; ++ks) { u4 w; w.x = pg8::cvt_pk_bf16(S[2 * ks][0], S[2 * ks][1]); w.y = pg8::cvt_pk_bf16(S[2 * ks][2], S[2 * ks][3]);
                    w.z = pg8::cvt_pk_bf16(S[2 * ks + 1][0], S[2 * ks + 1][1]); w.w = pg8::cvt_pk_bf16(S[2 * ks + 1][2], S[2 * ks + 1][3]); sB[ks] = __builtin_bit_cast(bx8, w); }
                f4 o[4];
#pragma unroll
                for (int mt = 0; mt < 4; ++mt) o[mt] = (f4){0.f, 0.f, 0.f, 0.f};
                SB0();
                MMQ(qa_lo, qa_hi, 0); SB0();
                RDQ(qa_lo, qa_hi, 2); SB0();
                MMQ(qb_lo, qb_hi, 1); SB0();
                RDQ(qb_lo, qb_hi, 3); SB0();
                MMQ(qa_lo, qa_hi, 2); SB0();
                bx8 sf[4][2];
#pragma unroll
                for (int mt = 0; mt < 4; ++mt) { const LASP unsigned char* sa = B + SOFF + (16 * mt + c) * 144 + g * 16; sf[mt][0] = *(const LASP bx8*)sa; sf[mt][1] = *(const LASP bx8*)(sa + 64); }
                SB0();
                MMQ(qb_lo, qb_hi, 3); SB0();
                bx8 kfa[4][2], kfb[4][2]; f4 dva[4], dvb[4];
                RDK(kfa, dva, 0); SB0();
#pragma unroll
                for (int mt = 0; mt < 4; ++mt) { o[mt] = __builtin_amdgcn_mfma_f32_16x16x32_bf16(bv0, sf[mt][0], o[mt], 0, 0, 0); o[mt] = __builtin_amdgcn_mfma_f32_16x16x32_bf16(bv1, sf[mt][1], o[mt], 0, 0, 0); }
                SB0();
                RDK(kfb, dvb, 4); SB0();
                MMK(kfa, dva, 0); SB0();
                MMK(kfb, dvb, 4); SB0();
#undef SB0
#undef RDQ
#undef MMQ
#undef RDK
#undef MMK
                const int cc = d == 0 ? (step < 4 ? 64 + step : step - 4) : 67 - step; const int row0 = row_of(bb, cc, 0);
#pragma unroll
                for (int mt = 0; mt < 4; ++mt) { u32x2 w; w.x = pg8::cvt_pk_bf16(o[mt][0], o[mt][1]); w.y = pg8::cvt_pk_bf16(o[mt][2], o[mt][3]);
                    *(u32x2*)(O + (size_t)(row0 + 16 * mt + c) * 1024 + h * 256 + vs * 32 + 16 * wid + 4 * g) = w; }
                LDS_BARRIER();
            }
        }
    }
}
#ifndef FAST_WALK
#define FAST_WALK 1
#endif

template <int MODE, int DIR>
__device__ __forceinline__ void st_rglru_impl(const Params& p, int vb, int nvb, unsigned char* lds_, const bf16_t* XR, const bf16_t* SG, const bf16_t* BD, float* SUMA, float* SUMH, bf16_t* Y) {
    typedef pg8::bf16x8 bx8; typedef pg8::f32x4 f4; typedef float f32x2v __attribute__((ext_vector_type(2)));
    LASP unsigned char* lds = (LASP unsigned char*)lds_;
    constexpr int AOFF = 0, FOFF = 17408, BUF = 51200, CWOFF = 2 * BUF;
    constexpr int ND = MODE == 0 ? 1 : 2, NCOMBO = MODE == 0 ? 32 : 16, NTILE = MODE == 0 ? NB * NCH : NB * 64;
    const int tid = tidx_(), wid = __builtin_amdgcn_readfirstlane(tid >> 6), lane = tid & 63, c = lane & 15, g = lane >> 4, cp = tid & 63, tg = tid >> 6;
    int P, part, cstep, combo0;
    if (nvb >= NCOMBO) { P = nvb / NCOMBO; part = vb / NCOMBO; cstep = NCOMBO; combo0 = vb % NCOMBO; if (part >= P) return; } else { P = 1; part = 0; cstep = nvb; combo0 = vb; }
    for (int combo = combo0; combo < NCOMBO; combo += cstep) {
        if (MODE == 0 && (combo & 1) != DIR) continue;
        const int nb = MODE == 0 ? (combo >> 1) : combo; constexpr int d0 = MODE == 0 ? DIR : 0;
        const int ch = nb * 128 + 16 * wid + c;
        bx8 wa[ND][4], wx[ND][4]; float ba[ND], bxx[ND], k8[ND];
        LDS_BARRIER();
#pragma unroll
        for (int dd = 0; dd < ND; ++dd) { constexpr int dzero = d0; const int d = dzero + dd;
            const bf16_t* wA = BD + ((size_t)(d * 16 + nb) * 128 + 16 * wid + c) * 128 + 8 * g; const bf16_t* wX = wA + (size_t)2 * 16 * 128 * 128;
#pragma unroll
            for (int ks = 0; ks < 4; ++ks) { wa[dd][ks] = *(const bx8*)(wA + 32 * ks); wx[dd][ks] = *(const bx8*)(wX + 32 * ks); }
            ba[dd] = p.o_b_a[d * 2048 + ch]; bxx[dd] = p.o_b_x[d * 2048 + ch]; k8[dd] = 8.f * 1.4426950408889634f * softplusf_(-p.o_lam[d * 2048 + ch]);
            if (tg < 5) { const f32x2v w2 = tg < 4 ? *(const f32x2v*)(p.o_conv_w + ((size_t)d * 4 + tg) * 2048 + nb * 128 + 2 * cp) : *(const f32x2v*)(p.o_conv_b + (size_t)d * 2048 + nb * 128 + 2 * cp);
                *(LASP f32x2v*)(lds + CWOFF + ((dd * 5 + tg) * 128 + 2 * cp) * 4) = w2; } }
        LDS_BARRIER();
        unsigned xr[14]; float cnext[2] = {0.f, 0.f};
#pragma unroll
        for (int jr = 0; jr < 14; ++jr) xr[jr] = 0u;
#define RG_PREF(tile) do { const int bb_ = MODE == 0 ? (tile) / NCH : (tile) >> 6, cc_ = MODE == 0 ? (tile) % NCH : (tile) & 63; const int row0_ = row_of(bb_, cc_, 0); \
            const bf16_t* xp_ = XR + (size_t)(row0_ + xr_pad_of_tile(row0_ >> 8) + 8 * tg - 3) * 2048 + nb * 128 + 2 * cp; \
            _Pragma("unroll") for (int jr = 0; jr < 14; ++jr) { if (MODE == 1 || (d0 == 0 ? jr < 11 : jr >= 3)) xr[jr] = *(const unsigned*)(xp_ + (size_t)jr * 2048); } \
            if (MODE == 1) { cnext[0] = SUMH[(((size_t)bb_ * 2 + 0) * NCH + cc_) * 2048 + ch]; cnext[1] = SUMH[(((size_t)bb_ * 2 + 1) * NCH + cc_) * 2048 + ch]; } } while (0)
        int it = 0;
        if (part < NTILE) RG_PREF(part);
        for (int tile = part; tile < NTILE; tile += P) {
            const int bb = MODE == 0 ? tile / NCH : tile >> 6, cc = MODE == 0 ? tile % NCH : tile & 63; const int row0 = row_of(bb, cc, 0);
            unsigned xcur[14]; float ccur[2];
#pragma unroll
            for (int jr = 0; jr < 14; ++jr) xcur[jr] = xr[jr];
            ccur[0] = cnext[0]; ccur[1] = cnext[1];
            if (tile + P < NTILE) RG_PREF(tile + P);
            float hsum[4][4];
#pragma unroll
            for (int dd = 0; dd < ND; ++dd) { constexpr int dzero = d0; const int d = dzero + dd;
                LASP unsigned char* B = lds + (it & 1) * BUF; ++it;
                { f32x2v cv[8]; const f32x2v cbv = *(const LASP f32x2v*)(lds + CWOFF + ((dd * 5 + 4) * 128 + 2 * cp) * 4);
#pragma unroll
                  for (int i = 0; i < 8; ++i) cv[i] = cbv;
#pragma unroll
                  for (int jj = 0; jj < 4; ++jj) { const f32x2v cwv = *(const LASP f32x2v*)(lds + CWOFF + ((dd * 5 + jj) * 128 + 2 * cp) * 4);
#pragma unroll
                      for (int i = 0; i < 8; ++i) { const int jr = d == 0 ? i + jj : i + 6 - jj; cv[i].x += cwv.x * __uint_as_float(xcur[jr] << 16); cv[i].y += cwv.y * __uint_as_float(xcur[jr] & 0xffff0000u); } }
#pragma unroll
                  for (int i = 0; i < 8; ++i) { const int rho = 16 * (2 * (tg & 1) + (i >> 2)) + 4 * (tg >> 1) + (i & 3);
                      *(LASP unsigned*)(B + AOFF + rho * 272 + 4 * cp) = pg8::cvt_pk_bf16(cv[i].x, cv[i].y); *(LASP f32x2v*)(B + FOFF + rho * 528 + 8 * cp) = cv[i]; } }
                LDS_BARRIER();
                const int gl = d == 0 ? g : 3 - g;
                const int src1 = d == 0 ? lane - 16 : lane + 16, src2 = d == 0 ? lane - 32 : lane + 32, srcT = d == 0 ? 48 + c : c;
                const size_t sidx = (((size_t)bb * 2 + d) * NCH + cc) * 2048 + ch;
                float av[16], uv[16]; float pa = 1.f, lh = 0.f;
#pragma unroll
                for (int mtl = 0; mtl < 4; ++mtl) { const int mt = d == 0 ? mtl : 3 - mtl;
                    f4 aam = (f4){0.f, 0.f, 0.f, 0.f}, axm = (f4){0.f, 0.f, 0.f, 0.f};
#pragma unroll
                    for (int ks = 0; ks < 4; ++ks) { const bx8 af = *(const LASP bx8*)(B + AOFF + (16 * mt + c) * 272 + (32 * ks + 8 * g) * 2);
                        aam = __builtin_amdgcn_mfma_f32_16x16x32_bf16(af, wa[dd][ks], aam, 0, 0, 0); axm = __builtin_amdgcn_mfma_f32_16x16x32_bf16(af, wx[dd][ks], axm, 0, 0, 0); }
#pragma unroll
                    for (int sq = 0; sq < 4; ++sq) { const int r = d == 0 ? sq : 3 - sq;
                        const float xv = *(const LASP float*)(B + FOFF + (16 * mt + 4 * g + r) * 528 + (16 * wid + c) * 4);
                        const float rr = sigmoidf_(aam[r] + ba[dd]), ii = sigmoidf_(axm[r] + bxx[dd]);
                        const float a = fexp2_(-k8[dd] * rr), u = __builtin_amdgcn_sqrtf(fmaxf(1.f - a * a, 0.f)) * (ii * xv);
                        lh = a * lh + u; pa *= a; if (MODE == 1) { av[mt * 4 + r] = a; uv[mt * 4 + r] = u; } }
                }
                float XA = pa, XU = lh, tA, tU;
                tA = __shfl(XA, src1); tU = __shfl(XU, src1); if (gl >= 1) { XU = tU * XA + XU; XA = tA * XA; }
                tA = __shfl(XA, src2); tU = __shfl(XU, src2); if (gl >= 2) { XU = tU * XA + XU; XA = tA * XA; }
                if (MODE == 0) { if (gl == 3) { SUMA[sidx] = XA; SUMH[sidx] = XU; } }
                else {
                    float eA = __shfl(XA, src1), eU = __shfl(XU, src1); if (gl == 0) { eA = 1.f; eU = 0.f; }
                    float hh = ccur[dd] * eA + eU;
#pragma unroll
                    for (int mtl = 0; mtl < 4; ++mtl) { const int mt = d == 0 ? mtl : 3 - mtl;
#pragma unroll
                        for (int sq = 0; sq < 4; ++sq) { const int r = d == 0 ? sq : 3 - sq; hh = av[mt * 4 + r] * hh + uv[mt * 4 + r]; if (dd == 0) hsum[mt][r] = hh; else hsum[mt][r] += hh; } }
                }
            }
            if (MODE == 1) {
#pragma unroll
                for (int mt = 0; mt < 4; ++mt)
#pragma unroll
                    for (int r = 0; r < 4; ++r) { const size_t o = (size_t)(row0 + 16 * g + 4 * mt + r) * 2048 + ch; Y[o] = f2bf(hsum[mt][r] * bf2f(SG[o])); }
            }
        }
        LDS_BARRIER();
#undef RG_PREF
    }
}
template <int MODE>
__device__ __forceinline__ void st_rglru(const Params& p, int vb, int nvb, unsigned char* lds_, const bf16_t* XR, const bf16_t* SG, const bf16_t* BD, float* SUMA, float* SUMH, bf16_t* Y) {
    if (MODE == 1) { st_rglru_impl<1, 0>(p, vb, nvb, lds_, XR, SG, BD, SUMA, SUMH, Y); return; }
    const int combo0 = nvb >= 32 ? vb % 32 : vb;
    if (nvb >= 32) { if ((combo0 & 1) == 0) st_rglru_impl<0, 0>(p, vb, nvb, lds_, XR, SG, BD, SUMA, SUMH, Y); else st_rglru_impl<0, 1>(p, vb, nvb, lds_, XR, SG, BD, SUMA, SUMH, Y); }
    else { st_rglru_impl<0, 0>(p, vb, nvb, lds_, XR, SG, BD, SUMA, SUMH, Y); st_rglru_impl<0, 1>(p, vb, nvb, lds_, XR, SG, BD, SUMA, SUMH, Y); }
}
#ifndef FAST_RG
#define FAST_RG 1
#endif


#define RG_CH(dd, step) ((dd) == 0 ? ((step) < 4 ? 64 + (step) : (step) - 4) : 67 - (step))
constexpr int RG_ABUF = 2 * 17408, RG_CWOFF = 2 * RG_ABUF;
constexpr int RG_HVOFF = RG_CWOFF + 5120;
template <int CDD>
__device__ __forceinline__ void rg1p_producer(const Params& p, LASP unsigned char* lds, const bf16_t* XR, bf16_t* SGY, bf16_t* HXh, int bb, int nb, int sl, int pw) {
    typedef float f32x2v __attribute__((ext_vector_type(2))); typedef pg8::u32x4 u4; typedef pg8::f32x4 f4;
    const int lane = tidx_() & 63, cg = lane & 15, tq = lane >> 4, oo = lane & 1, tp = lane >> 1;
    const int WDc = pw >> 1, ntc = pw & 1, chb = nb * 128 + sl * 32 + ntc * 16 + 8 * oo;
    constexpr int cdd = CDD; const int chalf = pw & 1;
    u4 xa[11], xb[11];
    const unsigned loff = (unsigned)(8 * tq) * 4096u + 16u * (unsigned)cg;
#define RG_PREF(XR_, step) do { const int row0_ = row_of(bb, cdd == 0 ? RG_CH(0, step) : RG_CH(1, step), 0); \
            const unsigned char* ub_ = (const unsigned char*)(XR + (size_t)(row0_ + xr_pad_of_tile(row0_ >> 8) + 32 * chalf - 3 + 3 * cdd) * 2048 + nb * 128) + loff; \
            _Pragma("unroll") for (int j = 0; j < 11; ++j) asm volatile("global_load_dwordx4 %0, %1, off" : "=v"(XR_[j]) : "v"(ub_ + (size_t)j * 4096) : "memory"); } while (0)
#define RG_WAITSET(XR_, N) do { asm volatile("s_waitcnt vmcnt(" #N ")" : "+v"(XR_[0]), "+v"(XR_[1]), "+v"(XR_[2]), "+v"(XR_[3]), "+v"(XR_[4]), "+v"(XR_[5]), "+v"(XR_[6]), "+v"(XR_[7]), "+v"(XR_[8]), "+v"(XR_[9]), "+v"(XR_[10]) :: "memory"); \
            __builtin_amdgcn_sched_barrier(0); } while (0)
#define RG_CONVD(XR_, bufi, dd) do { hf8_t cwh[5];        \
            _Pragma("unroll") for (int jj = 0; jj < 5; ++jj) cwh[jj] = *(const LASP hf8_t*)(lds + RG_CWOFF + ((dd * 5 + jj) * 128 + 8 * cg) * 2); \
            _Pragma("unroll") for (int i = 0; i < 8; ++i) { hf8_t cv = cwh[4]; \
                _Pragma("unroll") for (int jj = 0; jj < 4; ++jj) { const int jx = dd == 0 ? i + jj : i + 3 - jj; \
                    cv = __builtin_elementwise_fma(cwh[jj], __builtin_bit_cast(hf8_t, XR_[jx]), cv); } \
                const int t = 32 * chalf + 8 * tq + i, rho = 16 * ((t >> 2) & 3) + 4 * (t >> 4) + (t & 3); \
                *(LASP hf8_t*)(lds + (bufi) * RG_ABUF + dd * 17408 + rho * 272 + 16 * cg) = cv; } } while (0)
#define RG_CONV(XR_, bufi) RG_CONVD(XR_, bufi, CDD)
#define RG_PSTEP(XC_, step) do { if ((step) + 1 < NCH) { if ((step) + 2 < NCH) RG_WAITSET(XC_, 11); else RG_WAITSET(XC_, 0); RG_CONV(XC_, ((step) + 1) & 1); if ((step) + 3 < NCH) RG_PREF(XC_, (step) + 3); } LDS_BARRIER(); } while (0)
    RG_PREF(xa, 0);
    RG_WAITSET(xa, 0);
    RG_CONV(xa, 0);
    RG_PREF(xa, 1);
    RG_PREF(xb, 2);
    LDS_BARRIER();
    for (int step = 0; step < NCH; step += 2) {
        RG_PSTEP(xa, step);
        RG_PSTEP(xb, step + 1);
    }
#undef RG_CONVD
#undef RG_CONV
#undef RG_PREF
#undef RG_WAITSET
#undef RG_PSTEP
}
template <int WD>
__device__ __forceinline__ void rg1p_consumer(const Params& p, LASP unsigned char* lds, bf16_t* SGY, bf16_t* HXh, const bf16_t* BD, int bb, int nb, int sl, int nt, int cid) {
    typedef pg8::bf16x8 bx8; typedef pg8::f32x4 f4; typedef pg8::u32x4 u4;
    const int lane = tidx_() & 63, c = lane & 15, g = lane >> 4;
    const int jch = sl * 32 + nt * 16 + c, ch = nb * 128 + jch;
    bx8 wa[4], wx[4];
    { const bf16_t* wA = BD + ((size_t)(WD * 16 + nb) * 128 + jch) * 128 + 8 * g; const bf16_t* wX = wA + (size_t)2 * 16 * 128 * 128;
#pragma unroll
      for (int ks = 0; ks < 4; ++ks) { wa[ks] = *(const bx8*)(wA + 32 * ks); wx[ks] = *(const bx8*)(wX + 32 * ks); }
#pragma unroll
      for (int ks = 0; ks < 4; ++ks) asm volatile("" : "+v"(wa[ks]), "+v"(wx[ks])); }
    float ba = p.o_b_a[WD * 2048 + ch], bxx = p.o_b_x[WD * 2048 + ch], k8 = 8.f * 1.4426950408889634f * softplusf_(-p.o_lam[WD * 2048 + ch]);
    asm volatile("" : "+v"(ba), "+v"(bxx), "+v"(k8));
    float carry = 0.f;
    const int gl = WD == 0 ? g : 3 - g;
    const int src1 = WD == 0 ? lane - 16 : lane + 16, src2 = WD == 0 ? lane - 32 : lane + 32, srcT = WD == 0 ? 48 + c : c;
    const int oo = lane & 1, tp = lane >> 1, chb = nb * 128 + sl * 32 + nt * 16 + 8 * oo;
    LDS_BARRIER();
    for (int step = 0; step < NCH; ++step) {
      {
        const int cc = RG_CH(WD, step); const bool latent = cc < 64, second = step - 4 > 31;
        const int row0u = row_of(bb, cc, 0);
        u4 hx2[2], sg2[2];
        if (latent && second) {
#pragma unroll
            for (int k = 0; k < 2; ++k) { hx2[k] = *(const u4*)(HXh + (size_t)(row0u + 2 * tp + k) * 1024 + (chb & 1023)); sg2[k] = *(const u4*)(SGY + (size_t)(row0u + 2 * tp + k) * 2048 + chb); } }
        const LASP unsigned char* A = lds + (step & 1) * RG_ABUF + WD * 17408;
        float av[16], uv[16]; float pa = 1.f, lh = 0.f;
#pragma unroll
        for (int ml = 0; ml < 4; ++ml) { const int mt = WD == 0 ? ml : 3 - ml;
            f4 aam = (f4){0.f, 0.f, 0.f, 0.f}, axm = (f4){0.f, 0.f, 0.f, 0.f};
#pragma unroll
            for (int ks = 0; ks < 4; ++ks) { const bx8 af = *(const LASP bx8*)(A + (16 * mt + c) * 272 + (32 * ks + 8 * g) * 2);
                aam = __builtin_amdgcn_mfma_f32_16x16x32_f16(__builtin_bit_cast(hf8_t, af), __builtin_bit_cast(hf8_t, wa[ks]), aam, 0, 0, 0); axm = __builtin_amdgcn_mfma_f32_16x16x32_f16(__builtin_bit_cast(hf8_t, af), __builtin_bit_cast(hf8_t, wx[ks]), axm, 0, 0, 0); }
            typedef float f2 __attribute__((ext_vector_type(2)));
            float am[4], um[4];
#pragma unroll
            for (int hp = 0; hp < 2; ++hp) {
                const f2 xv2 = (f2){(float)__builtin_bit_cast(_Float16, *(const LASP unsigned short*)(A + (16 * mt + 4 * g + 2 * hp) * 272 + jch * 2)), (float)__builtin_bit_cast(_Float16, *(const LASP unsigned short*)(A + (16 * mt + 4 * g + 2 * hp + 1) * 272 + jch * 2))};
                const f2 ta = ((f2){aam[2 * hp], aam[2 * hp + 1]} + ba) * (-1.4426950408889634f), tx = ((f2){axm[2 * hp], axm[2 * hp + 1]} + bxx) * (-1.4426950408889634f);
                const f2 pa1 = (f2){fexp2_(ta.x), fexp2_(ta.y)} + 1.0f, px1 = (f2){fexp2_(tx.x), fexp2_(tx.y)} + 1.0f;
                const f2 rr = (f2){frcp_(pa1.x), frcp_(pa1.y)}, ii = (f2){frcp_(px1.x), frcp_(px1.y)};
                const f2 tk = rr * (-k8); const f2 a2 = (f2){fexp2_(tk.x), fexp2_(tk.y)};
                f2 q = __builtin_elementwise_fma(-a2, a2, (f2){1.0f, 1.0f}); q = __builtin_elementwise_max(q, (f2){0.f, 0.f});
                const f2 u2 = (f2){__builtin_amdgcn_sqrtf(q.x), __builtin_amdgcn_sqrtf(q.y)} * (ii * xv2);
                am[2 * hp] = a2.x; am[2 * hp + 1] = a2.y; um[2 * hp] = u2.x; um[2 * hp + 1] = u2.y; }
#pragma unroll
            for (int sq = 0; sq < 4; ++sq) { const int r = WD == 0 ? sq : 3 - sq; lh = am[r] * lh + um[r]; pa *= am[r]; av[mt * 4 + r] = am[r]; uv[mt * 4 + r] = um[r]; }
        }
        float XA = pa, XU = lh, tA, tU;
        tA = __shfl(XA, src1); tU = __shfl(XU, src1); if (gl >= 1) { XU = tU * XA + XU; XA = tA * XA; }
        tA = __shfl(XA, src2); tU = __shfl(XU, src2); if (gl >= 2) { XU = tU * XA + XU; XA = tA * XA; }
        float eA = __shfl(XA, src1), eU = __shfl(XU, src1); if (gl == 0) { eA = 1.f; eU = 0.f; }
        const float totA = __shfl(XA, srcT), totU = __shfl(XU, srcT);
        if (latent) {
            float hh = carry * eA + eU; float hv[16];
#pragma unroll
            for (int ml = 0; ml < 4; ++ml) { const int mt = WD == 0 ? ml : 3 - ml;
#pragma unroll
                for (int sq = 0; sq < 4; ++sq) { const int r = WD == 0 ? sq : 3 - sq; const int e = mt * 4 + r; hh = av[e] * hh + uv[e]; hv[e] = hh; } }
            u4 w0, w1; w0.x = pg8::cvt_pk_bf16(hv[0], hv[1]); w0.y = pg8::cvt_pk_bf16(hv[2], hv[3]); w0.z = pg8::cvt_pk_bf16(hv[4], hv[5]); w0.w = pg8::cvt_pk_bf16(hv[6], hv[7]);
            w1.x = pg8::cvt_pk_bf16(hv[8], hv[9]); w1.y = pg8::cvt_pk_bf16(hv[10], hv[11]); w1.z = pg8::cvt_pk_bf16(hv[12], hv[13]); w1.w = pg8::cvt_pk_bf16(hv[14], hv[15]);
            LASP unsigned char* hvb = lds + RG_HVOFF + cid * 2048;
            { LASP u4* hp = (LASP u4*)(hvb + lane * 32); hp[0] = w0; hp[1] = w1; }
            asm volatile("s_waitcnt lgkmcnt(0)" ::: "memory");
#pragma unroll
            for (int k = 0; k < 2; ++k) { const int tk = 2 * tp + k; unsigned hw[4];
#pragma unroll
                for (int j = 0; j < 8; ++j) { const unsigned x_ = *(const LASP unsigned short*)(hvb + (((tk >> 4) * 16 + 8 * oo + j) * 32 + (tk & 15) * 2)); if (j & 1) hw[j >> 1] |= x_ << 16; else hw[j >> 1] = x_; }
                if (!second) { *(u4*)(HXh + (size_t)(row0u + tk) * 1024 + (chb & 1023)) = (u4){hw[0], hw[1], hw[2], hw[3]}; }
                else { const unsigned hh_[4] = {hx2[k].x, hx2[k].y, hx2[k].z, hx2[k].w}, ss_[4] = {sg2[k].x, sg2[k].y, sg2[k].z, sg2[k].w}; unsigned yo[4];
#pragma unroll
                    for (int q = 0; q < 4; ++q) { const float y0 = (__uint_as_float(hw[q] << 16) + __uint_as_float(hh_[q] << 16)) * __uint_as_float(ss_[q] << 16),
                        y1 = (__uint_as_float(hw[q] & 0xffff0000u) + __uint_as_float(hh_[q] & 0xffff0000u)) * __uint_as_float(ss_[q] & 0xffff0000u); yo[q] = pg8::cvt_pk_bf16(y0, y1); }
                    *(u4*)(SGY + (size_t)(row0u + tk) * 2048 + chb) = (u4){yo[0], yo[1], yo[2], yo[3]}; } }
        }
        carry = carry * totA + totU;
      }
        if (step == 35) asm volatile("s_waitcnt vmcnt(0)" ::: "memory");
        LDS_BARRIER();
    }
}
__device__ __forceinline__ void st_rg1p(const Params& p, int vb, int nvb, unsigned char* lds_, const bf16_t* XR, bf16_t* SGY, bf16_t* HX0, bf16_t* HX1, const bf16_t* BD, const float* XRC) {
    typedef float f32x2v __attribute__((ext_vector_type(2)));
    LASP unsigned char* lds = (LASP unsigned char*)lds_;
    const int wid = __builtin_amdgcn_readfirstlane(tidx_() >> 6), lane = tidx_() & 63;
    for (int it0 = vb; it0 < 256; it0 += nvb) {
        const int item = (nvb == 256) ? ((it0 & 7) * 32 + (it0 >> 3)) : it0;
        const int sl = item & 3, nb = (item >> 2) & 15, bb = item >> 6;
        bf16_t* HXh = nb < 8 ? HX0 : HX1;
        {
          bf16_t* xd = (bf16_t*)XR + (size_t)(NLAT + bb * 256 + 20 + 4 * bb) * 2048 + nb * 128; const float* xs = XRC + (size_t)(bb * 256) * 2048 + nb * 128;
          for (int e = tidx_(); e < 256 * 64; e += NTHREADS) { const int r = e >> 6, cpair = e & 63; const float2 v0 = *(const float2*)(xs + (size_t)r * 2048 + 2 * cpair), v1 = *(const float2*)(xs + (size_t)NCTX * 2048 + (size_t)r * 2048 + 2 * cpair); *(unsigned*)(xd + (size_t)r * 2048 + 2 * cpair) = pk2h(v0.x + v1.x, v0.y + v1.y); }
#pragma unroll
          for (int dd = 0; dd < 2; ++dd)
              if (wid < 5) { const f32x2v w2 = wid < 4 ? *(const f32x2v*)(p.o_conv_w + ((size_t)dd * 4 + wid) * 2048 + nb * 128 + 2 * lane) : *(const f32x2v*)(p.o_conv_b + (size_t)dd * 2048 + nb * 128 + 2 * lane);
                  *(LASP unsigned*)(lds + RG_CWOFF + ((dd * 5 + wid) * 128 + 2 * lane) * 2) = pk2h(w2.x, w2.y); }
          asm volatile("s_waitcnt vmcnt(0)" ::: "memory"); LDS_BARRIER(); }
        if (wid >= 6) rg1p_producer<1>(p, lds, XR, SGY, HXh, bb, nb, sl, wid - 4);
        else if (wid >= 4) rg1p_producer<0>(p, lds, XR, SGY, HXh, bb, nb, sl, wid - 4);
        else if (wid < 2) rg1p_consumer<0>(p, lds, SGY, HXh, BD, bb, nb, sl, wid & 1, wid);
        else rg1p_consumer<1>(p, lds, SGY, HXh, BD, bb, nb, sl, wid & 1, wid);
    }
}
#define XB_TMO      128
#define XB_XCNT(j)  (256  + 64 * (j))
#define XB_XSUB(j)  (1280 + 64 * (j))
#define XB_XGEN(j)  (2304 + 64 * (j))
#define XB_TOP      3328
#define XB_TOPGEN   3392
#define XB_SPIN_CAP (1u << 20)
DEVI unsigned xb_ld(unsigned* p)              { return __hip_atomic_load(p, __ATOMIC_RELAXED, __HIP_MEMORY_SCOPE_AGENT); }
DEVI unsigned xb_add(unsigned* p, unsigned v) { return __hip_atomic_fetch_add(p, v, __ATOMIC_RELAXED, __HIP_MEMORY_SCOPE_AGENT); }
DEVI unsigned xb_xcc_id() { return (unsigned)__builtin_amdgcn_s_getreg((3 << 11) | 20) & 0xFu; }
#define XB_SPIN(cond, bar) do { unsigned _sp = 0; while (cond) { __builtin_amdgcn_s_sleep(1); \
    if ((++_sp & 255u) == 0u) { if (xb_ld(&(bar)[XB_TMO])) break; if (_sp > XB_SPIN_CAP) { atomicAdd(&(bar)[XB_TMO], 1u); break; } } } } while (0)
struct XcdBarrier { unsigned* bar; unsigned x; volatile __attribute__((address_space(3))) unsigned* st; };
DEVI XcdBarrier xcd_barrier_post(unsigned* bar, volatile __attribute__((address_space(3))) unsigned* st) {
    XcdBarrier b; b.bar = bar; b.x = xb_xcc_id(); b.st = st;
    if (threadIdx.x == 0) (void)xb_add(&bar[XB_XCNT(b.x)], 1u);
    return b;
}
DEVI void xcd_barrier_complete(unsigned* bar, unsigned x, unsigned& nloc, unsigned& nx) {
    const unsigned G = gridDim.x * gridDim.y * gridDim.z;
    unsigned sum, cnt, mine, sp = 0u;
    for (;;) {
        sum = 0u; cnt = 0u; mine = 0u;
#pragma unroll
        for (unsigned j = 0; j < 16; ++j) { const unsigned c = xb_ld(&bar[XB_XCNT(j)]); sum += c; cnt += (c > 0u) ? 1u : 0u; mine = (j == x) ? c : mine; }
        if (sum == G) break;
        __builtin_amdgcn_s_sleep(1);
        if ((++sp & 255u) == 0u) { if (xb_ld(&bar[XB_TMO])) break; if (sp > XB_SPIN_CAP) { atomicAdd(&bar[XB_TMO], 1u); break; } }
    }
    nloc = mine > 0u ? mine : 1u; nx = cnt > 0u ? cnt : 1u;
}
DEVI void xcd_barrier(const XcdBarrier& b) {
    asm volatile("s_waitcnt vmcnt(0)" ::: "memory");
    __syncthreads();
    if (threadIdx.x == 0) {
        unsigned* bar = b.bar;
        __builtin_amdgcn_s_waitcnt(0);
        unsigned nloc = b.st[0], nx = b.st[1];
        if (nloc == 0u) { xcd_barrier_complete(bar, b.x, nloc, nx); b.st[0] = nloc; b.st[1] = nx; }
        const unsigned old = xb_add(&bar[XB_XSUB(b.x)], 1u);
        const unsigned gen = old / nloc;
        if (old + 1u == (gen + 1u) * nloc) {
            __builtin_amdgcn_fence(__ATOMIC_RELEASE, "agent");
            asm volatile("s_waitcnt vmcnt(0)" ::: "memory");
            const unsigned og = xb_add(&bar[XB_TOP], 1u);
            const unsigned tg = og / nx;
            if (og + 1u == (tg + 1u) * nx) xb_add(&bar[XB_TOPGEN], 1u);
            else XB_SPIN(xb_ld(&bar[XB_TOPGEN]) == tg, bar);
            __builtin_amdgcn_fence(__ATOMIC_ACQUIRE, "agent");
            xb_add(&bar[XB_XGEN(b.x)], 1u);
            asm volatile("s_waitcnt vmcnt(0)" ::: "memory");
        } else {
            XB_SPIN(xb_ld(&bar[XB_XGEN(b.x)]) == gen, bar);
            __builtin_amdgcn_fence(__ATOMIC_ACQUIRE, "agent");
            asm volatile("s_waitcnt vmcnt(0)" ::: "memory");
        }
    }
    __syncthreads();
}
__device__ __forceinline__ void run_stage(const Params& p, int st, int vb, int nvb, unsigned char* lds) {
    unsigned char* ws = p.ws;
    float* MOD = (float*)(ws + WS_MOD); float* ALR = (float*)(ws + WS_ALR); float* X1C = (float*)(ws + WS_X1C);
    float* SUMA = (float*)(ws + WS_SUMA); float* SUMH = (float*)(ws + WS_SUMH); float* DEC = (float*)(ws + WS_DEC);
    bf16_t* Bt1 = (bf16_t*)(ws + WS_BT1); bf16_t* Bt2 = (bf16_t*)(ws + WS_BT2); bf16_t* Bt3 = (bf16_t*)(ws + WS_BT3); bf16_t* Bt4 = (bf16_t*)(ws + WS_BT4);
    bf16_t* S0 = (bf16_t*)(ws + WS_SLOT(0)); bf16_t* S1 = (bf16_t*)(ws + WS_SLOT(1)); bf16_t* S2 = (bf16_t*)(ws + WS_SLOT(2));
    bf16_t* S3 = (bf16_t*)(ws + WS_SLOT(3)); bf16_t* S4 = (bf16_t*)(ws + WS_SLOT(4)); bf16_t* S5 = (bf16_t*)(ws + WS_SLOT(5));
    bf16_t* DO0 = (bf16_t*)p.out; bf16_t* DOSC = (bf16_t*)((unsigned char*)p.out + 34 * MiB); bf16_t* DOZA = (bf16_t*)((unsigned char*)p.out + 51 * MiB);
    float* XRC = (float*)(ws + WS_BT1);
    float* SLAB2 = (float*)(ws + WS_SLOT(5) + 262144);
    switch (st) {
    case 0: st_mod(p, vb, nvb, (float*)lds); st_wprep(p, vb, nvb, lds); break;
    case 1: st_modulate(p, vb, nvb, 0, p.x, p.ctx, S0); break;
    case 3: st_glaprep(p, vb, nvb, lds, S1, S2, ALR, S3, S4, DOSC, DEC, S5); break;
#if FAST_WALK
    case 4: st_glawalk(p, vb, nvb, lds, S3, S4, DOSC, DEC, S5, S2, DO0); break;
#else
    case 4: st_glawalk_naive(p, vb, nvb, (float*)lds, S3, S4, DOSC, DEC, S5, S2, DO0); break;
#endif
    case 6: st_inner(p, vb, nvb, S2, DO0, S3, S4, S5, S0, DOZA, X1C); break;
    case 8: st_modulate(p, vb, nvb, 1, p.out, p.ctx, S2, SLAB2, 8, MOD + 4 * 3072 + 2048, nvb == 256 ? NLAT : 0);
            {
              for (int e = vb * NTHREADS + tidx_(); e < 9 * 4 * 256; e += nvb * NTHREADS) { const int gi = e >> 10, w = e & 1023; const int r0 = gi < 4 ? 4096 * gi + 4 * gi : (gi < 8 ? NLAT + 16 + 256 * (gi - 4) + 4 * (gi - 4) : NT + 32);
                  *(uint4*)(S3 + (size_t)r0 * 2048 + w * 8) = uint4{0u, 0u, 0u, 0u}; } }
            break;
    case 10: st_rg1p(p, vb, nvb, lds, S3, S0, S2, S5 + 131072, (const bf16_t*)(ws + WS_BD), XRC); break;
    case 14: if (nvb != 256) st_final(p, vb, nvb); break;
#if FAST_GEMM
    case 2: { FEpi1 E{S1, S2, S3, S4, S5, ALR, DOZA}; pg8::Gemm g{S0, Bt1, NT, N1, 1024}; pg8::TileOrder S; S.init(NT / 256, 11, 16, nvb, vb, 0, 8, 0, 12);
              pg8::gemm_phase<FEpi1, pg8::TileOrder, true, true>((PG8_LAS unsigned char*)lds, g, S, E); } break;
    case 5: { FEpi1 E{S1, S2, S3, S4, S5, ALR, DOZA}; pg8::Gemm g{S0, Bt1, NT, N1, 1024}; pg8::TileOrder S; S.init(NT / 256, 18, 16, nvb, vb, 0, 4, 8, 15);
              pg8::gemm_phase<FEpi1, pg8::TileOrder, true, true>((PG8_LAS unsigned char*)lds, g, S, E); } break;
    case 7: if (nvb == 256) { FEpiResMod E{p.x, p.out, S2, MOD, MOD + 5 * 3072, p.norm_g + 1024, SLAB2, (float*)(ws + WS_CTL + 131072 + 262144), (unsigned*)(ws + WS_CTL + 65536 + 16384)};
                  pg8::Gemm g{S0, Bt2, NT, 1024, 2048}; pg8::TileOrder S; S.init(NLAT / 256, 4, 32, nvb, vb, 0, 1 << 30, 0, 0, NCTX / 256, 4, NLAT / 256, 8, 4); S.tail_first = 1;
                  pg8::gemm_phase<FEpiResMod, pg8::TileOrder, false, true>((PG8_LAS unsigned char*)lds, g, S, E); }
            else { FEpiRes<true> E{p.x, p.ctx, p.out, SLAB2, MOD}; pg8::Gemm g{S0, Bt2, NT, 1024, 2048}; pg8::TileOrder S; S.init(NLAT / 256, 4, 32, nvb, vb, 0, 1 << 30, 0, 0, NCTX / 256, 4, NLAT / 256, 8, 4);
                  pg8::gemm_phase<FEpiRes<true>, pg8::TileOrder, true, true>((PG8_LAS unsigned char*)lds, g, S, E); } break;
    case 9: { FEpi3 E{S3, S0, XRC}; pg8::Gemm g{S2, Bt3, NT, 4096, 1024}; pg8::TileOrder S; S.init(NLAT / 256, 16, 16, nvb, vb, 0, 1 << 30, 0, 0, NCTX / 256, 8, NLAT / 256, 2, 8);
              pg8::gemm_phase<FEpi3, pg8::TileOrder, true, true>((PG8_LAS unsigned char*)lds, g, S, E); } break;
    case 13: if (nvb == 256) { FEpiResRms E{p.out, p.out, MOD + 5 * 3072, p.final_g, (float*)(ws + WS_CTL + 131072), (unsigned*)(ws + WS_CTL + 65536)}; pg8::Gemm g{S0, Bt4, NLAT, 1024, 2048}; pg8::TileOrder S; S.init(NLAT / 256, 4, 32, nvb, vb);
                  pg8::gemm_phase<FEpiResRms, pg8::TileOrder, false, true>((PG8_LAS unsigned char*)lds, g, S, E); }
             else { FEpiRes<false> E{p.out, nullptr, p.out, nullptr, MOD + 5 * 3072}; pg8::Gemm g{S0, Bt4, NLAT, 1024, 2048}; pg8::TileOrder S; S.init(NLAT / 256, 4, 32, nvb, vb);
                  pg8::gemm_phase<FEpiRes<false>, pg8::TileOrder, true, true>((PG8_LAS unsigned char*)lds, g, S, E); } break;
#else
    case 2: { Epi1 E{S1, S2, S3, S4, S5, ALR}; st_gemm_naive(vb, nvb, (float*)lds, S0, Bt1, 0, NT / 32, 0, 8, 1024, E); st_gemm_naive(vb, nvb, (float*)lds, S0, Bt1, 0, NT / 32, 12, 13, 1024, E); } break;
    case 5: { Epi1 E{S1, S2, S3, S4, S5, ALR}; st_gemm_naive(vb, nvb, (float*)lds, S0, Bt1, 0, NT / 32, 8, 12, 1024, E); st_gemm_naive(vb, nvb, (float*)lds, S0, Bt1, 0, NT / 32, 13, 29, 1024, E); } break;
    case 7: { EpiRes E{p.x, p.ctx, p.out, X1C, MOD}; st_gemm_naive(vb, nvb, (float*)lds, S0, Bt2, 0, NT / 32, 0, 4, 2048, E); } break;
    case 9: { Epi3 E{S3, S0}; st_gemm_naive(vb, nvb, (float*)lds, S2, Bt3, 0, NLAT / 32, 0, 16, 1024, E); st_gemm_naive(vb, nvb, (float*)lds, S2, Bt3, NLAT / 32, NT / 32, 0, 8, 1024, E); } break;
    case 13: { EpiRes E{p.out, nullptr, p.out, nullptr, MOD + 5 * 3072}; st_gemm_naive(vb, nvb, (float*)lds, S0, Bt4, 0, NLAT / 32, 0, 4, 2048, E); } break;
#endif
    }
}
constexpr int NSTAGES = 15;
constexpr int LDS_BYTES = 147456;

#ifndef ONE_LAUNCH
#define ONE_LAUNCH 1
#endif
#if !ONE_LAUNCH
__global__ void __launch_bounds__(NTHREADS) k_mega(Params p, int st) {
    extern __shared__ __attribute__((aligned(16))) unsigned char lds[];
    run_stage(p, st, blockIdx.x, gridDim.x, lds);
}
#else
__global__ void __launch_bounds__(NTHREADS) k_mega(Params p) {
    extern __shared__ __attribute__((aligned(16))) unsigned char lds[];
    volatile __attribute__((address_space(3))) unsigned* st = (volatile __attribute__((address_space(3))) unsigned*)((__attribute__((address_space(3))) unsigned char*)lds + (LDS_BYTES - 64));
    if (threadIdx.x < 2) st[threadIdx.x] = 0u;
    __syncthreads();
    const XcdBarrier bar = xcd_barrier_post((unsigned*)(p.ws + WS_CTL) + 4096, st);
#ifndef REP_STAGE
#define REP_STAGE -1
#endif
#ifndef REP_N
#define REP_N 1
#endif
#define RS(k) do { run_stage(p, k, blockIdx.x, gridDim.x, lds); if ((k) == REP_STAGE) { for (int rep_ = 0; rep_ < REP_N; ++rep_) { xcd_barrier(bar); run_stage(p, k, blockIdx.x, gridDim.x, lds); } } } while (0)
#define GS() xcd_barrier(bar)
    RS(0); GS(); RS(1); GS(); RS(2); GS(); RS(3); GS(); RS(4); GS(); RS(5); GS(); RS(6); GS(); RS(7); GS();
    RS(8); GS(); RS(9); GS(); RS(10); GS(); RS(13); if (gridDim.x != 256) { GS(); RS(14); }
#undef RS
#undef GS
}
#endif

extern "C" void kernel_launch(void* const* d_in, const int* in_sizes, int n_in, void* d_out, int out_size, void* d_ws, size_t ws_size, hipStream_t stream) {
    static int inited = 0, grid_blocks = 0;
    if (!inited) {
        if (n_in != 23 || ws_size < WS_END || out_size != NLAT * D) { fprintf(stderr, "kernel_launch: unexpected shapes n_in %d ws %zu out %d\n", n_in, ws_size, out_size); inited = -1; return; }
        if (hipFuncSetAttribute((const void*)k_mega, hipFuncAttributeMaxDynamicSharedMemorySize, LDS_BYTES) != hipSuccess) { fprintf(stderr, "hipFuncSetAttribute failed\n"); inited = -1; return; }
        int dev = 0, cus = 0, per_cu = 0;
        (void)hipGetDevice(&dev); (void)hipDeviceGetAttribute(&cus, hipDeviceAttributeMultiprocessorCount, dev);
        (void)hipOccupancyMaxActiveBlocksPerMultiprocessor(&per_cu, (const void*)k_mega, NTHREADS, LDS_BYTES);
        if (per_cu < 1) { fprintf(stderr, "kernel_launch: occupancy query says %d blocks per CU\n", per_cu); per_cu = 1; }
        if (per_cu > 1) per_cu = 1;
        grid_blocks = cus * per_cu;
        inited = 1;
    }
    if (inited < 0) return;
    Params p{};
    const float** f = (const float**)&p;
    for (int i = 0; i < 23; ++i) f[i] = (const float*)d_in[i];
    p.out = (float*)d_out; p.ws = (unsigned char*)d_ws;
    (void)hipMemsetAsync((unsigned char*)d_ws + WS_CTL, 0, 2 * MiB, stream);
#if ONE_LAUNCH
    void* args[] = {&p};
    hipError_t e = hipLaunchCooperativeKernel((const void*)k_mega, dim3(grid_blocks), dim3(NTHREADS), args, LDS_BYTES, stream);
    if (e != hipSuccess) fprintf(stderr, "cooperative launch failed: %s (grid %d)\n", hipGetErrorString(e), grid_blocks);
#else
    for (int st = 0; st < NSTAGES; ++st) hipLaunchKernelGGL(k_mega, dim3(1024), dim3(NTHREADS), LDS_BYTES, stream, p, st);
#endif
}
```
